# Optimizing an MI355X kernel written in HIP

```python
import jax
import jax.numpy as jnp
from jax import lax
import numpy as np

D_MODEL = 1024
BATCH = 16
SEQ = 2048
DEPTH = 1

ML_HEADS = 4
ML_DQK = 128
ML_DV = 128
ML_W = ML_HEADS * ML_DQK
ML_CHUNK = 64
ML_CONV = 4
NSA_QH = 8
NSA_KVH = 2
NSA_DH = 64
NSA_GROUP = NSA_QH // NSA_KVH
NSA_W = NSA_QH * NSA_DH
NSA_KV_W = NSA_KVH * NSA_DH
CMP_BLOCK = 32
CMP_STRIDE = 16
CMP_HIDDEN = 256
SEL_BLOCK = 64
SEL_TOPN = 8
SEL_FORCE_BONUS = 1e4
WINDOW = 512
Q_BLOCK = 128
MEM_LEN = 256
MEM_HEADS = 4
MEM_DH = 128
MEM_W = MEM_HEADS * MEM_DH
N_EXPERTS = 32
TOP_K = 4
D_FF = D_MODEL
SWIGLU_ALPHA = 1.702
SWIGLU_LIMIT = 7.0
MOE_BLOCK = 256
N_BRANCH = 3
ROPE_THETA = 10000.0
EPS = 1e-6
NEG = -1e30

IN_SPLITS = (ML_W, ML_W, ML_HEADS * ML_DV, ML_HEADS * ML_DV, ML_HEADS, ML_HEADS,
             NSA_W, NSA_KV_W, NSA_KV_W, NSA_KV_W, NSA_KV_W, NSA_KV_W, NSA_KV_W, NSA_QH * 3,
             MEM_W, N_BRANCH * D_MODEL)
D_IN = sum(IN_SPLITS)

kernel_name = "hybrid_mlstm_nsa_memxattn_moe_block"


def _rmsnorm(t, g):
    t32 = t.astype(jnp.float32)
    y = t32 * lax.rsqrt(jnp.mean(t32 * t32, axis=-1, keepdims=True) + EPS)
    return (y * g.astype(jnp.float32)).astype(t.dtype)


def _rope(t, pos):
    half = t.shape[-1] // 2
    inv_freq = jnp.power(ROPE_THETA, -jnp.arange(half, dtype=jnp.float32) / half)
    ang = pos.astype(jnp.float32)[:, None] * inv_freq[None, :]
    cos = jnp.cos(ang)[:, None, :]
    sin = jnp.sin(ang)[:, None, :]
    t32 = t.astype(jnp.float32)
    t1, t2 = t32[..., :half], t32[..., half:]
    return jnp.concatenate([t1 * cos - t2 * sin, t2 * cos + t1 * sin], axis=-1).astype(t.dtype)


def _masked_softmax(s, mask):
    s = jnp.where(mask, s.astype(jnp.float32), NEG)
    e = jnp.exp(s - jnp.max(s, axis=-1, keepdims=True)) * mask
    return e / jnp.maximum(jnp.sum(e, axis=-1, keepdims=True), 1e-30)


def _split_cols(t, sizes):
    out, off = [], 0
    for s in sizes:
        out.append(t[..., off:off + s])
        off += s
    return out


def _causal_conv(t, w, b):
    c = t.shape[-1]
    y = lax.conv_general_dilated(t, w.astype(t.dtype)[:, None, :], window_strides=(1,),
                                 padding=[(ML_CONV - 1, 0)],
                                 dimension_numbers=("NWC", "WIO", "NWC"),
                                 feature_group_count=c)
    return y + b.astype(t.dtype)


def _mlstm(q, k, v, i_pre, f_pre):
    bsz, seq, nh, _ = q.shape
    nc = seq // ML_CHUNK
    f32 = jnp.float32

    def chunks(t):
        return t.astype(f32).reshape(bsz, nc, ML_CHUNK, nh, -1).transpose(0, 3, 1, 2, 4)

    def gchunks(t):
        return t.astype(f32).reshape(bsz, nc, ML_CHUNK, nh).transpose(0, 3, 1, 2)

    q = chunks(q) * (ML_DQK ** -0.5)
    k = chunks(k)
    v = chunks(v)
    ig = gchunks(i_pre)
    b = jnp.cumsum(jax.nn.log_sigmoid(gchunks(f_pre)), axis=-1)
    b_last = b[..., -1]

    g = b_last[..., None] - b + ig
    m_c = jnp.max(g, axis=-1)
    w = jnp.exp(g - m_c[..., None])
    kv_c = jnp.einsum("bhclk,bhclv->bhckv", k * w[..., None], v)
    n_c = jnp.einsum("bhcl,bhclk->bhck", w, k)

    def step(carry, xs):
        c_st, n_st, m_st = carry
        kv, nn, mc, bl = xs
        m_new = jnp.maximum(bl + m_st, mc)
        a_old = jnp.exp(bl + m_st - m_new)
        a_new = jnp.exp(mc - m_new)
        c_next = a_old[..., None, None] * c_st + a_new[..., None, None] * kv
        n_next = a_old[..., None] * n_st + a_new[..., None] * nn
        return (c_next, n_next, m_new), (c_st, n_st, m_st)

    init = (jnp.zeros((bsz, nh, ML_DQK, ML_DV), f32), jnp.zeros((bsz, nh, ML_DQK), f32),
            jnp.zeros((bsz, nh), f32))
    xs = (jnp.moveaxis(kv_c, 2, 0), jnp.moveaxis(n_c, 2, 0), jnp.moveaxis(m_c, 2, 0),
          jnp.moveaxis(b_last, 2, 0))
    _, (c_prev, n_prev, m_prev) = lax.scan(step, init, xs)
    c_prev = jnp.moveaxis(c_prev, 0, 2)
    n_prev = jnp.moveaxis(n_prev, 0, 2)
    m_prev = jnp.moveaxis(m_prev, 0, 2)

    tri = jnp.tril(jnp.ones((ML_CHUNK, ML_CHUNK), bool))
    d_log = jnp.where(tri, b[..., :, None] - b[..., None, :] + ig[..., None, :], NEG)
    a_log = b + m_prev[..., None]
    m_t = jnp.maximum(a_log, jnp.max(d_log, axis=-1))
    wd = jnp.exp(d_log - m_t[..., None]) * jnp.einsum("bhctd,bhcsd->bhcts", q, k)
    inter = jnp.exp(a_log - m_t)
    num = inter[..., None] * jnp.einsum("bhctk,bhckv->bhctv", q, c_prev) + \
        jnp.einsum("bhcts,bhcsv->bhctv", wd, v)
    den = inter * jnp.einsum("bhctk,bhck->bhct", q, n_prev) + jnp.sum(wd, axis=-1)
    h = num / jnp.maximum(jnp.abs(den), jnp.exp(-m_t))[..., None]
    return h.transpose(0, 2, 3, 1, 4).reshape(bsz, seq, nh, ML_DV)


def _nsa(q, k_cmp, v_cmp, k_sel, v_sel, k_win, v_win, gate, g_q, g_k,
         pos_k, w1_k, b1_k, w2_k, pos_v, w1_v, b1_v, w2_v):
    bsz, seq = q.shape[:2]
    pos = jnp.arange(seq)

    def heads(t, h):
        return t.reshape(bsz, seq, h, NSA_DH)

    q = _rope(_rmsnorm(heads(q, NSA_QH), g_q), pos) * (NSA_DH ** -0.5)
    qg = q.reshape(bsz, seq, NSA_KVH, NSA_GROUP, NSA_DH)

    n_cmp = (seq - CMP_BLOCK) // CMP_STRIDE + 1
    cmp_start = jnp.arange(n_cmp) * CMP_STRIDE
    cmp_end = cmp_start + CMP_BLOCK - 1
    win_idx = cmp_start[:, None] + jnp.arange(CMP_BLOCK)[None, :]

    def compress(t, pe, w1, b1, w2):
        blocks = heads(t, NSA_KVH)[:, win_idx] + pe[None, None, :, None, :]
        hid = jax.nn.silu(jnp.einsum("bnlhd,ldf->bnhf", blocks, w1) + b1)
        return hid @ w2

    kc = _rope(_rmsnorm(compress(k_cmp, pos_k, w1_k, b1_k, w2_k), g_k[0]), cmp_end)
    vc = compress(v_cmp, pos_v, w1_v, b1_v, w2_v)
    s_cmp = jnp.einsum("bshgd,bnhd->bshgn", qg, kc)
    mask_cmp = (cmp_end[None, :] <= pos[:, None])[None, :, None, None, :]
    p_cmp = _masked_softmax(s_cmp, mask_cmp)
    o_cmp = jnp.einsum("bshgn,bnhd->bshgd", p_cmp.astype(vc.dtype), vc)

    n_sel = seq // SEL_BLOCK
    sel_start = jnp.arange(n_sel) * SEL_BLOCK
    cmp_to_sel = ((cmp_start[:, None] < sel_start[None, :] + SEL_BLOCK) &
                  (cmp_start[:, None] + CMP_BLOCK > sel_start[None, :])).astype(jnp.float32)
    importance = jnp.einsum("bshn,nj->bshj", jnp.sum(p_cmp, axis=3), cmp_to_sel)
    blk = jnp.arange(n_sel)[None, :]
    cur = (pos // SEL_BLOCK)[:, None]
    forced = (blk == 0) | (blk == cur) | (blk == cur - 1)
    score = jnp.where((blk > cur)[None, :, None, :], NEG,
                      importance + SEL_FORCE_BONUS * forced[None, :, None, :])
    _, sel_idx = lax.top_k(score, min(SEL_TOPN, n_sel))
    n_top = sel_idx.shape[-1]

    ks = _rope(_rmsnorm(heads(k_sel, NSA_KVH), g_k[1]), pos)
    ks_blk = ks.reshape(bsz, n_sel, SEL_BLOCK, NSA_KVH, NSA_DH).transpose(0, 3, 1, 2, 4)
    vs_blk = heads(v_sel, NSA_KVH).reshape(bsz, n_sel, SEL_BLOCK, NSA_KVH, NSA_DH).transpose(0, 3, 1, 2, 4)
    kw = _rope(_rmsnorm(heads(k_win, NSA_KVH), g_k[2]), pos)
    pad = ((0, 0), (WINDOW, 0), (0, 0), (0, 0))
    kw_pad = jnp.pad(kw, pad)
    vw_pad = jnp.pad(heads(v_win, NSA_KVH), pad)
    b_ix = jnp.arange(bsz)[:, None, None, None]
    h_ix = jnp.arange(NSA_KVH)[None, None, :, None]

    def query_block(args):
        qb_i, q_blk, idx_blk = args
        start = qb_i * Q_BLOCK
        tq = start + jnp.arange(Q_BLOCK)
        kg = ks_blk[b_ix, h_ix, idx_blk]
        vg = vs_blk[b_ix, h_ix, idx_blk]
        s_sel = jnp.einsum("bqhgd,bqhnld->bqhgnl", q_blk, kg)
        kpos = idx_blk[..., None] * SEL_BLOCK + jnp.arange(SEL_BLOCK)
        m_sel = (kpos <= tq[None, :, None, None, None]).reshape(bsz, Q_BLOCK, NSA_KVH, 1, n_top * SEL_BLOCK)
        p_sel = _masked_softmax(s_sel.reshape(bsz, Q_BLOCK, NSA_KVH, NSA_GROUP, -1), m_sel)
        o_sel = jnp.einsum("bqhgk,bqhkd->bqhgd", p_sel.astype(vg.dtype),
                           vg.reshape(bsz, Q_BLOCK, NSA_KVH, n_top * SEL_BLOCK, NSA_DH))
        kwb = lax.dynamic_slice_in_dim(kw_pad, start, Q_BLOCK + WINDOW, axis=1)
        vwb = lax.dynamic_slice_in_dim(vw_pad, start, Q_BLOCK + WINDOW, axis=1)
        kpos_w = start - WINDOW + jnp.arange(Q_BLOCK + WINDOW)
        diff = tq[:, None] - kpos_w[None, :]
        m_win = (diff >= 0) & (diff < WINDOW) & (kpos_w[None, :] >= 0)
        s_win = jnp.einsum("bqhgd,bkhd->bqhgk", q_blk, kwb)
        p_win = _masked_softmax(s_win, m_win[None, :, None, None, :])
        o_win = jnp.einsum("bqhgk,bkhd->bqhgd", p_win.astype(vwb.dtype), vwb)
        return o_sel, o_win

    n_qb = seq // Q_BLOCK
    q_blocks = qg.reshape(bsz, n_qb, Q_BLOCK, NSA_KVH, NSA_GROUP, NSA_DH).swapaxes(0, 1)
    idx_blocks = sel_idx.reshape(bsz, n_qb, Q_BLOCK, NSA_KVH, n_top).swapaxes(0, 1)
    o_sel, o_win = lax.map(query_block, (jnp.arange(n_qb), q_blocks, idx_blocks))
    o_sel = o_sel.swapaxes(0, 1).reshape(bsz, seq, NSA_KVH, NSA_GROUP, NSA_DH)
    o_win = o_win.swapaxes(0, 1).reshape(bsz, seq, NSA_KVH, NSA_GROUP, NSA_DH)

    g = jax.nn.sigmoid(gate.reshape(bsz, seq, NSA_KVH, NSA_GROUP, 3))
    o = g[..., 0:1] * o_cmp + g[..., 1:2] * o_sel + g[..., 2:3] * o_win
    return o.reshape(bsz, seq, NSA_W)


def _mem_attn(q, mem, g_mem, w_mem_kv, g_q, g_k):
    bsz, seq = q.shape[:2]
    m_len = mem.shape[1]
    kv = _rmsnorm(mem, g_mem) @ w_mem_kv
    k = _rmsnorm(kv[..., :MEM_W].reshape(bsz, m_len, MEM_HEADS, MEM_DH), g_k)
    v = kv[..., MEM_W:].reshape(bsz, m_len, MEM_HEADS, MEM_DH)
    q = _rmsnorm(q.reshape(bsz, seq, MEM_HEADS, MEM_DH), g_q) * (MEM_DH ** -0.5)
    p = jax.nn.softmax(jnp.einsum("bshd,bmhd->bhsm", q, k).astype(jnp.float32), axis=-1)
    return jnp.einsum("bhsm,bmhd->bshd", p.astype(v.dtype), v).reshape(bsz, seq, MEM_W)


def _moe(t, w_router, b_router, w_gu, b_gu, w_down, b_down):
    bsz, seq, d = t.shape
    tok = t.reshape(-1, d)
    n_tok = tok.shape[0]
    n_rows = n_tok * TOP_K
    logits = (tok @ w_router + b_router).astype(jnp.float32)
    top_val, top_idx = lax.top_k(logits, TOP_K)
    top_w = jax.nn.softmax(top_val, axis=-1)
    flat_e = top_idx.reshape(-1)
    flat_w = top_w.reshape(-1)
    order = jnp.argsort(flat_e)
    sorted_e = flat_e[order]
    counts = jnp.bincount(flat_e, length=N_EXPERTS)
    padded = (counts + MOE_BLOCK - 1) // MOE_BLOCK * MOE_BLOCK
    start = jnp.cumsum(counts) - counts
    pad_end = jnp.cumsum(padded)
    pad_start = pad_end - padded
    dest = pad_start[sorted_e] + jnp.arange(n_rows) - start[sorted_e]
    n_blocks = -(-(n_rows + N_EXPERTS * (MOE_BLOCK - 1)) // MOE_BLOCK)
    cap = n_blocks * MOE_BLOCK
    row_tok = jnp.zeros((cap,), jnp.int32).at[dest].set((order // TOP_K).astype(jnp.int32))
    row_w = jnp.zeros((cap,), jnp.float32).at[dest].set(flat_w[order])
    blk_e = jnp.minimum(jnp.searchsorted(pad_end, jnp.arange(n_blocks) * MOE_BLOCK, side="right"),
                        N_EXPERTS - 1)

    def expert_block(args):
        rows, wts, e = args
        hgu = tok[rows] @ w_gu[e] + b_gu[e]
        gate = jnp.minimum(hgu[:, 0::2], SWIGLU_LIMIT)
        up = jnp.clip(hgu[:, 1::2], -SWIGLU_LIMIT, SWIGLU_LIMIT)
        act = (up + 1.0) * (gate * jax.nn.sigmoid(SWIGLU_ALPHA * gate))
        y = act @ w_down[e] + b_down[e]
        return y.astype(jnp.float32) * wts[:, None]

    ys = lax.map(expert_block, (row_tok.reshape(n_blocks, MOE_BLOCK),
                                row_w.reshape(n_blocks, MOE_BLOCK), blk_e))
    out = jnp.zeros((n_tok, d), jnp.float32).at[row_tok].add(ys.reshape(cap, d))
    return out.astype(t.dtype).reshape(bsz, seq, d)


def _hybrid_layer(x, mem, g_mix, w_in, ml_conv_w, ml_conv_b, ml_b_i, ml_b_f, ml_g_out,
                  nsa_g_q, nsa_g_k, cmp_pos_k, cmp_w1_k, cmp_b1_k, cmp_w2_k,
                  cmp_pos_v, cmp_w1_v, cmp_b1_v, cmp_w2_v, g_mem, w_mem_kv, mem_g_q, mem_g_k,
                  w_br_ml, w_br_nsa, w_br_mem, w_out, g_ffn, w_router, b_router,
                  w_gu, b_gu, w_down, b_down):
    bsz, seq, d = x.shape
    u = _rmsnorm(x, g_mix)
    (ml_q, ml_k, ml_v, ml_o, ml_i, ml_f, n_q, n_kc, n_vc, n_ks, n_vs, n_kw, n_vw, n_gate,
     m_q, br_gate) = _split_cols(u @ w_in, IN_SPLITS)

    qk = jax.nn.silu(_causal_conv(jnp.concatenate([ml_q, ml_k], axis=-1), ml_conv_w, ml_conv_b))

    def mh(t):
        return t.reshape(bsz, seq, ML_HEADS, -1)

    h_ml = _mlstm(mh(qk[..., :ML_W]), mh(qk[..., ML_W:]), mh(ml_v), ml_i + ml_b_i, ml_f + ml_b_f)
    h_ml = (_rmsnorm(h_ml, ml_g_out).astype(x.dtype) * jax.nn.sigmoid(mh(ml_o))).reshape(bsz, seq, -1)

    h_nsa = _nsa(n_q, n_kc, n_vc, n_ks, n_vs, n_kw, n_vw, n_gate, nsa_g_q, nsa_g_k,
                 cmp_pos_k, cmp_w1_k, cmp_b1_k, cmp_w2_k, cmp_pos_v, cmp_w1_v, cmp_b1_v, cmp_w2_v)

    h_mem = _mem_attn(m_q, mem, g_mem, w_mem_kv, mem_g_q, mem_g_k)

    gates = jax.nn.sigmoid(br_gate.reshape(bsz, seq, N_BRANCH, d))
    merged = (gates[:, :, 0] * (h_ml @ w_br_ml) + gates[:, :, 1] * (h_nsa @ w_br_nsa)
              + gates[:, :, 2] * (h_mem @ w_br_mem))
    x = x + merged @ w_out
    return x + _moe(_rmsnorm(x, g_ffn), w_router, b_router, w_gu, b_gu, w_down, b_down)


def setup_inputs(seed: int = 0) -> dict:
    key = jax.random.key(seed)
    keys = iter(jax.random.split(key, 40))
    L, D = DEPTH, D_MODEL

    def normal(shape, scale):
        return jax.random.normal(next(keys), shape, jnp.float32) * scale

    def gain(shape):
        return 1.0 + normal(shape, 0.02)

    return {
        "x": normal((BATCH, SEQ, D), 1.0),
        "mem": normal((BATCH, MEM_LEN, D), 1.0),
        "g_mix": gain((L, D)),
        "w_in": normal((L, D, D_IN), D ** -0.5),
        "ml_conv_w": normal((L, ML_CONV, 2 * ML_W), ML_CONV ** -0.5),
        "ml_conv_b": normal((L, 2 * ML_W), 0.02),
        "ml_b_i": normal((L, ML_HEADS), 0.1),
        "ml_b_f": jnp.linspace(3.0, 6.0, ML_HEADS, dtype=jnp.float32)[None, :] + normal((L, ML_HEADS), 0.1),
        "ml_g_out": gain((L, ML_HEADS, ML_DV)),
        "nsa_g_q": gain((L, NSA_DH)),
        "nsa_g_k": gain((L, 3, NSA_DH)),
        "cmp_pos_k": normal((L, CMP_BLOCK, NSA_DH), 0.1),
        "cmp_w1_k": normal((L, CMP_BLOCK, NSA_DH, CMP_HIDDEN), (CMP_BLOCK * NSA_DH) ** -0.5),
        "cmp_b1_k": normal((L, CMP_HIDDEN), 0.02),
        "cmp_w2_k": normal((L, CMP_HIDDEN, NSA_DH), CMP_HIDDEN ** -0.5),
        "cmp_pos_v": normal((L, CMP_BLOCK, NSA_DH), 0.1),
        "cmp_w1_v": normal((L, CMP_BLOCK, NSA_DH, CMP_HIDDEN), (CMP_BLOCK * NSA_DH) ** -0.5),
        "cmp_b1_v": normal((L, CMP_HIDDEN), 0.02),
        "cmp_w2_v": normal((L, CMP_HIDDEN, NSA_DH), CMP_HIDDEN ** -0.5),
        "g_mem": gain((L, D)),
        "w_mem_kv": normal((L, D, 2 * MEM_W), D ** -0.5),
        "mem_g_q": gain((L, MEM_DH)),
        "mem_g_k": gain((L, MEM_DH)),
        "w_br_ml": normal((L, ML_HEADS * ML_DV, D), (ML_HEADS * ML_DV) ** -0.5),
        "w_br_nsa": normal((L, NSA_W, D), NSA_W ** -0.5),
        "w_br_mem": normal((L, MEM_W, D), MEM_W ** -0.5),
        "w_out": normal((L, D, D), D ** -0.5),
        "g_ffn": gain((L, D)),
        "w_router": normal((L, D, N_EXPERTS), D ** -0.5),
        "b_router": normal((L, N_EXPERTS), 0.01),
        "w_gu": normal((L, N_EXPERTS, D, 2 * D_FF), D ** -0.5),
        "b_gu": normal((L, N_EXPERTS, 2 * D_FF), 0.01),
        "w_down": normal((L, N_EXPERTS, D_FF, D), D_FF ** -0.5),
        "b_down": normal((L, N_EXPERTS, D), 0.01),
    }


def reference(x, mem, g_mix, w_in, ml_conv_w, ml_conv_b, ml_b_i, ml_b_f, ml_g_out,
              nsa_g_q, nsa_g_k, cmp_pos_k, cmp_w1_k, cmp_b1_k, cmp_w2_k,
              cmp_pos_v, cmp_w1_v, cmp_b1_v, cmp_w2_v, g_mem, w_mem_kv, mem_g_q, mem_g_k,
              w_br_ml, w_br_nsa, w_br_mem, w_out, g_ffn, w_router, b_router,
              w_gu, b_gu, w_down, b_down):
    h = x
    for l in range(DEPTH):
        h = _hybrid_layer(h, mem, g_mix[l], w_in[l], ml_conv_w[l], ml_conv_b[l], ml_b_i[l], ml_b_f[l],
                          ml_g_out[l], nsa_g_q[l], nsa_g_k[l], cmp_pos_k[l], cmp_w1_k[l], cmp_b1_k[l],
                          cmp_w2_k[l], cmp_pos_v[l], cmp_w1_v[l], cmp_b1_v[l], cmp_w2_v[l], g_mem[l],
                          w_mem_kv[l], mem_g_q[l], mem_g_k[l], w_br_ml[l], w_br_nsa[l], w_br_mem[l],
                          w_out[l], g_ffn[l], w_router[l], b_router[l], w_gu[l], b_gu[l], w_down[l],
                          b_down[l])
    return h
```

```cpp
#include <hip/hip_runtime.h>
#include <cstdio>
#include <cstdint>
namespace pg8 {
#define PG8_LAS __attribute__((address_space(3)))
typedef unsigned short bf16_t;
typedef short bf16x8 __attribute__((ext_vector_type(8)));
typedef float f32x4 __attribute__((ext_vector_type(4)));
typedef unsigned u32x4 __attribute__((ext_vector_type(4)));
constexpr int BM = 256, BK = 64, HALF = 128, HTB = HALF * BK * 2  , STAGE_BYTES = 8 * HTB, NXCD = 8, WGM = 8;

__host__ __device__ __forceinline__ int lds_byte(int r, int c) { const int st = (r >> 4) * 2 + (c >> 5), rr = r & 15, cc = c & 31, ob = rr * 64 + cc * 2; return st * 1024 + (ob ^ (((ob >> 9) & 1) << 5)); }
__host__ __device__ __forceinline__ void stage_rc(int b, int& R, int& C) { const int st = b / 1024, sb = b % 1024, swz = sb ^ (((sb >> 9) & 1) << 5); R = (st >> 1) * 16 + swz / 64; C = (st & 1) * 32 + (swz % 64) / 2; }
__host__ __device__ __forceinline__ int perm32(int rho) { const int n = rho >> 4, i = rho & 15; return 8 * (i >> 2) + 4 * n + (i & 3); }

struct Unit { int pm, pn; };
struct Gemm { const bf16_t* A; const bf16_t* Bt; int M, N, K; };

struct StaticOrder {
    int nM, nN, nwg, G, c;
    __host__ __device__ void init(int M, int N, int G_, int c_) { nM = M / BM; nN = N / BM; nwg = nM * nN; G = G_; c = c_; }
    __host__ __device__ bool next(int i, Unit& u) const {
        const long L = (long)i * G + c; if (L >= nwg) return false;
        int wgid = (int)L; { const int q = nwg / NXCD, r = nwg % NXCD, xcd = wgid % NXCD, off = wgid / NXCD; wgid = (xcd < r ? xcd * (q + 1) : r * (q + 1) + (xcd - r) * q) + off; }
        const int nig = WGM * nN, gid = wgid / nig, fm = gid * WGM, gsz = (nM - fm) < WGM ? (nM - fm) : WGM;
        u.pm = fm + ((wgid % nig) % gsz); u.pn = (wgid % nig) / gsz; return true;
    }
    __device__ __forceinline__ void a_ready(const Unit&) const {}
    __device__ __forceinline__ void done(const Unit&) const {}
};

__device__ __forceinline__ unsigned cvt_pk_bf16(float lo, float hi) { unsigned r; asm volatile("v_cvt_pk_bf16_f32 %0, %1, %2" : "=v"(r) : "v"(lo), "v"(hi)); return r; }
typedef float f32x2 __attribute__((ext_vector_type(2)));
__device__ __forceinline__ f32x2 gelu_pk(f32x2 v) {
    const f32x2 av = __builtin_elementwise_abs(v), d = av * 0.2316418882f + 1.0f;
    f32x2 t; t.x = __builtin_amdgcn_rcpf(d.x); t.y = __builtin_amdgcn_rcpf(d.y);
    f32x2 q = t * 0.5307027145f + (-0.7265760135f); q = q * t + 0.7107068705f; q = q * t + (-0.142248368f); q = q * t + 0.127414796f; q = q * t;
    const f32x2 s = (v * v) * (-0.72134752044f);
    f32x2 e; e.x = __builtin_amdgcn_exp2f(s.x); e.y = __builtin_amdgcn_exp2f(s.y);
    const f32x2 m = v * (q * e), r = v - m;
    f32x2 o; o.x = v.x < 0.f ? m.x : r.x; o.y = v.y < 0.f ? m.y : r.y; return o;
}

template <int ACT  > struct EpiBf16 {
    static constexpr bool PERM = true, AFTER_DRAIN = false; static_assert(ACT == 0 || ACT == 1, "EpiBf16: ACT is 0 (none) or 1 (gelu_pk)");
    bf16_t* O; int ldc; const float* bias; int split_cols; size_t split_stride; float scale0;
    __device__ __forceinline__ void operator()(const f32x4 (&acc)[2][2][4][2], const Unit& u, int wr, int wc, int fr, int fq) const {
        const int row0 = u.pm * BM + wr * 64 + fr; int colt = u.pn * BM; bf16_t* base = O;
        float sc = 1.f; if (split_cols) { const int t = colt / split_cols; base += (size_t)t * split_stride; colt -= t * split_cols; if (t == 0) sc = scale0; }
        const int col0 = colt + wc * 32 + 8 * fq, bcol0 = u.pn * BM + wc * 32 + 8 * fq;
        f32x4 bv[2][2];
#pragma unroll
        for (int bj = 0; bj < 2; ++bj)
#pragma unroll
            for (int n = 0; n < 2; ++n) bv[bj][n] = bias ? *(const f32x4*)(bias + bcol0 + bj * HALF + 4 * n) : (f32x4){0.f, 0.f, 0.f, 0.f};
#pragma unroll
        for (int ai = 0; ai < 2; ++ai)
#pragma unroll
            for (int m = 0; m < 4; ++m) { bf16_t* rowp = base + (size_t)(row0 + ai * HALF + m * 16) * ldc + col0;
#pragma unroll
                for (int bj = 0; bj < 2; ++bj) { f32x4 v0 = acc[ai][bj][m][0] + bv[bj][0], v1 = acc[ai][bj][m][1] + bv[bj][1];
                    if (ACT == 1) { f32x2 a = gelu_pk((f32x2){v0[0], v0[1]}), b = gelu_pk((f32x2){v0[2], v0[3]}), c = gelu_pk((f32x2){v1[0], v1[1]}), d = gelu_pk((f32x2){v1[2], v1[3]});
                        v0 = (f32x4){a.x, a.y, b.x, b.y}; v1 = (f32x4){c.x, c.y, d.x, d.y}; }
                    v0 = v0 * sc; v1 = v1 * sc; u32x4 w; w.x = cvt_pk_bf16(v0[0], v0[1]); w.y = cvt_pk_bf16(v0[2], v0[3]); w.z = cvt_pk_bf16(v1[0], v1[1]); w.w = cvt_pk_bf16(v1[2], v1[3]);
                    *(u32x4*)(rowp + bj * HALF) = w; } }
    }
};

struct PanelStats {
    unsigned* xbuf;
    unsigned* cnt;
    unsigned* tmo;
    int ntn; float eps;
    unsigned code;
    __device__ __forceinline__ bool run(const f32x4 (&v)[2][2][4][2], const Unit& u, int wr, int wc, int fr, int fq, PG8_LAS unsigned char* lds, int wid, int lane) const {
        typedef float f32x2v __attribute__((ext_vector_type(2)));
        PG8_LAS f32x2v* P = (PG8_LAS f32x2v*)lds;
        PG8_LAS f32x2v* S = (PG8_LAS f32x2v*)(lds + 8192);
        PG8_LAS unsigned* flag = (PG8_LAS unsigned*)(lds + 8192 + 2048);
#pragma unroll
        for (int ai = 0; ai < 2; ++ai)
#pragma unroll
            for (int m = 0; m < 4; ++m) {
                float s = 0.f;
#pragma unroll
                for (int bj = 0; bj < 2; ++bj)
#pragma unroll
                    for (int n = 0; n < 2; ++n) { const f32x4 x = v[ai][bj][m][n]; s += (x[0] + x[1]) + (x[2] + x[3]); }
                s += __shfl_xor(s, 16); s += __shfl_xor(s, 32);
                const float mw = s * (1.0f / 64.0f); float q = 0.f;
#pragma unroll
                for (int bj = 0; bj < 2; ++bj)
#pragma unroll
                    for (int n = 0; n < 2; ++n) { const f32x4 d = v[ai][bj][m][n] - mw; q += (d[0] * d[0] + d[1] * d[1]) + (d[2] * d[2] + d[3] * d[3]); }
                q += __shfl_xor(q, 16); q += __shfl_xor(q, 32);
                if (fq == 0) P[(ai * HALF + wr * 64 + m * 16 + fr) * 4 + wc] = (f32x2v){mw, q};
            }
        asm volatile("s_waitcnt lgkmcnt(0)" ::: "memory"); __builtin_amdgcn_s_barrier(); asm volatile("" ::: "memory");
#if defined(BROKEN_EXCHANGE_NO_WAIT)
#warning BROKEN CONTROL BUILD: the row-statistics exchange does not wait; results are wrong by design
        if (blockIdx.x >= 64) { const long long t0_ = clock64(); while (clock64() - t0_ < 60000) __builtin_amdgcn_s_sleep(8); }
#endif
        const int row = wid * 32 + (lane & 31);
        if (lane < 32) {
            const f32x2v a = P[row * 4 + 0], b = P[row * 4 + 1], c = P[row * 4 + 2], d = P[row * 4 + 3];
            const float mt = (a.x + b.x + c.x + d.x) * 0.25f;
            const float da = a.x - mt, db = b.x - mt, dc = c.x - mt, dd = d.x - mt;
            const float m2 = (a.y + b.y) + (c.y + d.y) + 64.0f * ((da * da + db * db) + (dc * dc + dd * dd));
            unsigned long long* slot = (unsigned long long*)xbuf + ((size_t)(u.pm * BM + row) * 4 + u.pn);
            __hip_atomic_store(slot, ((unsigned long long)__float_as_uint(m2) << 32) | __float_as_uint(mt), __ATOMIC_RELAXED, __HIP_MEMORY_SCOPE_AGENT);
        }
        asm volatile("s_waitcnt vmcnt(0)" ::: "memory");
        if (lane == 0) __hip_atomic_fetch_add(cnt + 64 * u.pm, 1u, __ATOMIC_RELAXED, __HIP_MEMORY_SCOPE_AGENT);
        if (wid == 0) {
            bool dead = false; const unsigned long long t0 = __builtin_amdgcn_s_memrealtime(); const unsigned want = 8u * (unsigned)ntn;
            for (;;) {
#if defined(BROKEN_EXCHANGE_NO_WAIT)
                break;
#endif
                if ((unsigned)__builtin_amdgcn_readfirstlane(__hip_atomic_load(cnt + 64 * u.pm, __ATOMIC_RELAXED, __HIP_MEMORY_SCOPE_AGENT)) >= want) break;
                if (__builtin_amdgcn_s_memrealtime() - t0 > 2000000ull) {
                    if (lane == 0) { unsigned expect = 0u; __hip_atomic_compare_exchange_strong(tmo + 1, &expect, code | (unsigned)(u.pm & 0xff), __ATOMIC_RELAXED, __ATOMIC_RELAXED, __HIP_MEMORY_SCOPE_AGENT);
                                     __hip_atomic_store(tmo, 1u, __ATOMIC_RELAXED, __HIP_MEMORY_SCOPE_AGENT); }
                    dead = true; break; }
                __builtin_amdgcn_s_sleep(2);
            }
            __builtin_amdgcn_fence(__ATOMIC_ACQUIRE, "agent");
            if (lane == 0) flag[0] = dead ? 1u : 0u;
        }
        asm volatile("s_waitcnt vmcnt(0) lgkmcnt(0)" ::: "memory"); __builtin_amdgcn_s_barrier(); asm volatile("" ::: "memory");
        const bool bad = flag[0] != 0u;
        if (lane < 32) {
            const unsigned long long* slot = (const unsigned long long*)xbuf + (size_t)(u.pm * BM + row) * 4; float mt[4], m2[4]; float ms = 0.f;
#pragma unroll
            for (int t = 0; t < 4; ++t) { if (t < ntn) { const unsigned long long w = __hip_atomic_load(slot + t, __ATOMIC_RELAXED, __HIP_MEMORY_SCOPE_AGENT); mt[t] = __uint_as_float((unsigned)w); m2[t] = __uint_as_float((unsigned)(w >> 32)); } else { mt[t] = 0.f; m2[t] = 0.f; } ms += mt[t]; }
            const float mean = ms / (float)ntn; float q = 0.f;
#pragma unroll
            for (int t = 0; t < 4; ++t) if (t < ntn) { const float dm = mt[t] - mean; q += m2[t] + 256.0f * dm * dm; }
            S[row] = (f32x2v){mean, 1.0f / sqrtf(q / (256.0f * (float)ntn) + eps)};
        }
        asm volatile("s_waitcnt lgkmcnt(0)" ::: "memory"); __builtin_amdgcn_s_barrier(); asm volatile("" ::: "memory");
        return bad;
    }
};
struct EpiLnRes {
    static constexpr bool PERM = false, AFTER_DRAIN = true;
    const float* base; float* out; int ldc; const float* bias; PanelStats st; unsigned poison;
    __device__ __forceinline__ void fused(f32x4 (&acc)[2][2][4][2], const Unit& u, int wr, int wc, int fr, int fq, PG8_LAS unsigned char* lds, int wid, int lane) const {
        typedef float f32x2v __attribute__((ext_vector_type(2)));
        const PG8_LAS f32x2v* S = (const PG8_LAS f32x2v*)(lds + 8192);
        const int col0 = u.pn * BM + wc * 32 + 4 * fq;
#pragma unroll
        for (int bj = 0; bj < 2; ++bj)
#pragma unroll
            for (int n = 0; n < 2; ++n) { const f32x4 bv = bias ? *(const f32x4*)(bias + col0 + bj * HALF + n * 16) : (f32x4){0.f, 0.f, 0.f, 0.f};
#pragma unroll
                for (int ai = 0; ai < 2; ++ai)
#pragma unroll
                    for (int m = 0; m < 4; ++m) acc[ai][bj][m][n] += bv; }
        f32x4 pre[4][2][2];
#pragma unroll
        for (int m = 0; m < 4; ++m) { const size_t off = (size_t)(u.pm * BM + wr * 64 + m * 16 + fr) * ldc + col0;
#pragma unroll
            for (int bj = 0; bj < 2; ++bj)
#pragma unroll
                for (int n = 0; n < 2; ++n) pre[m][bj][n] = *(const f32x4*)(base + off + bj * HALF + n * 16); }
        const bool bad = st.run(acc, u, wr, wc, fr, fq, lds, wid, lane) || poison != 0u;
        const float qnan = __builtin_nanf("");
#pragma unroll
        for (int ai = 0; ai < 2; ++ai)
#pragma unroll
            for (int m = 0; m < 4; ++m) { const int r = ai * HALF + wr * 64 + m * 16 + fr; const f32x2v sr = S[r]; const size_t off = (size_t)(u.pm * BM + r) * ldc + col0;
#pragma unroll
                for (int bj = 0; bj < 2; ++bj)
#pragma unroll
                    for (int n = 0; n < 2; ++n) { const f32x4 bs = ai == 0 ? pre[m][bj][n] : *(const f32x4*)(base + off + bj * HALF + n * 16); f32x4 o = bs + (acc[ai][bj][m][n] - sr.x) * sr.y;
                        if (bad) o = (f32x4){qnan, qnan, qnan, qnan}; *(f32x4*)(out + off + bj * HALF + n * 16) = o; }
                if (m & 1) asm volatile("" ::: "memory"); }
    }
};
struct EpiLnResLn {
    static constexpr bool PERM = false, AFTER_DRAIN = true;
    const float* base; float* out; bf16_t* xn; int ldc; const float* bias; PanelStats st1, st2; unsigned poison;
    __device__ __forceinline__ void fused(f32x4 (&acc)[2][2][4][2], const Unit& u, int wr, int wc, int fr, int fq, PG8_LAS unsigned char* lds, int wid, int lane) const {
        typedef float f32x2v __attribute__((ext_vector_type(2))); typedef unsigned u32x2v __attribute__((ext_vector_type(2)));
        const PG8_LAS f32x2v* S = (const PG8_LAS f32x2v*)(lds + 8192);
        const int col0 = u.pn * BM + wc * 32 + 4 * fq;
#pragma unroll
        for (int bj = 0; bj < 2; ++bj)
#pragma unroll
            for (int n = 0; n < 2; ++n) { const f32x4 bv = bias ? *(const f32x4*)(bias + col0 + bj * HALF + n * 16) : (f32x4){0.f, 0.f, 0.f, 0.f};
#pragma unroll
                for (int ai = 0; ai < 2; ++ai)
#pragma unroll
                    for (int m = 0; m < 4; ++m) acc[ai][bj][m][n] += bv; }
        bool bad = st1.run(acc, u, wr, wc, fr, fq, lds, wid, lane) || poison != 0u;
        const float qnan = __builtin_nanf("");
#pragma unroll
        for (int ai = 0; ai < 2; ++ai)
#pragma unroll
            for (int m = 0; m < 4; ++m) { const int r = ai * HALF + wr * 64 + m * 16 + fr; const f32x2v sr = S[r]; const size_t off = (size_t)(u.pm * BM + r) * ldc + col0;
#pragma unroll
                for (int bj = 0; bj < 2; ++bj)
#pragma unroll
                    for (int n = 0; n < 2; ++n) { const f32x4 bs = *(const f32x4*)(base + off + bj * HALF + n * 16); acc[ai][bj][m][n] = bs + (acc[ai][bj][m][n] - sr.x) * sr.y; }
                asm volatile("" : "+v"(acc[ai][0][m][0]), "+v"(acc[ai][0][m][1]), "+v"(acc[ai][1][m][0]), "+v"(acc[ai][1][m][1]));
                if (m & 1) asm volatile("" ::: "memory"); }
        const bool bad1 = bad;
        bad = st2.run(acc, u, wr, wc, fr, fq, lds, wid, lane) || bad;
#pragma unroll
        for (int ai = 0; ai < 2; ++ai)
#pragma unroll
            for (int m = 0; m < 4; ++m) { const int r = ai * HALF + wr * 64 + m * 16 + fr; const f32x2v sr = S[r]; const size_t off = (size_t)(u.pm * BM + r) * ldc + col0;
#pragma unroll
                for (int bj = 0; bj < 2; ++bj)
#pragma unroll
                    for (int n = 0; n < 2; ++n) { const f32x4 x1 = acc[ai][bj][m][n]; *(f32x4*)(out + off + bj * HALF + n * 16) = bad1 ? (f32x4){qnan, qnan, qnan, qnan} : x1;
                        const f32x4 o = (x1 - sr.x) * sr.y; u32x2v w; w.x = cvt_pk_bf16(o[0], o[1]); w.y = cvt_pk_bf16(o[2], o[3]);
                        if (bad) { w.x = 0x7fc07fc0u; w.y = 0x7fc07fc0u; } *(u32x2v*)(xn + off + bj * HALF + n * 16) = w; }
                asm volatile("" ::: "memory"); }
    }
};

template <class Epi, class Sched, bool ALIGN_EPI = false, bool SP2 = false>
__device__ __forceinline__ void gemm_phase(PG8_LAS unsigned char* lds, const Gemm g, const Sched& S, const Epi& E) {
    const int tid = threadIdx.x, wid = __builtin_amdgcn_readfirstlane(tid >> 6), lane = tid & 63, wr = wid >> 2, wc = wid & 3, fr = lane & 15, fq = lane >> 4;
    const int K = g.K, nt = K / BK;
    unsigned voffA[2], voffB[2];
#pragma unroll
    for (int i = 0; i < 2; ++i) { int R, C; stage_rc(tid * 16 + i * 8192, R, C); const int Rb = Epi::PERM ? ((R & ~31) + perm32(R & 31)) : R;
        voffA[i] = (unsigned)(R * K + C) * 2u; voffB[i] = (unsigned)(Rb * K + C) * 2u; }
    const size_t kstep = (size_t)(BK * 2);
    const size_t hstep = (size_t)HALF * K * 2;
    const size_t tstep = 2 * hstep;
    const unsigned ldsw = (unsigned)wid * 1024u;
    const int aoff = lds_byte(wr * 64 + fr, fq * 8), boff = lds_byte(wc * 32 + fr, fq * 8);
#define PG8_SA(b, h) (((b) * 2 + (h)) * HTB)
#define PG8_SB(b, h) ((4 + (b) * 2 + (h)) * HTB)
#define PG8_STAGE(bufoff, gbase, voff) do { _Pragma("unroll") for (int _i = 0; _i < 2; ++_i) \
        __builtin_amdgcn_global_load_lds((const unsigned*)((const char*)(gbase) + (voff)[_i]), (PG8_LAS unsigned*)(lds + (bufoff) + ldsw + _i * 8192), 16, 0, 0); } while (0)
#define PG8_LDA(dst, b, h) do { _Pragma("unroll") for (int m = 0; m < 4; ++m) _Pragma("unroll") for (int k = 0; k < 2; ++k) dst[m][k] = *(const PG8_LAS bf16x8*)(lds + PG8_SA(b, h) + aoff + m * 2048 + k * 1024); } while (0)
#define PG8_LDB(dst, b, h) do { _Pragma("unroll") for (int n = 0; n < 2; ++n) _Pragma("unroll") for (int k = 0; k < 2; ++k) dst[n][k] = *(const PG8_LAS bf16x8*)(lds + PG8_SB(b, h) + boff + n * 2048 + k * 1024); } while (0)
#define PG8_MMA(ai, bj, At, Bt) do { __builtin_amdgcn_s_setprio(1); _Pragma("unroll") for (int m = 0; m < 4; ++m) _Pragma("unroll") for (int n = 0; n < 2; ++n) _Pragma("unroll") for (int k = 0; k < 2; ++k) \
        acc[ai][bj][m][n] = __builtin_amdgcn_mfma_f32_16x16x32_bf16(Bt[n][k], At[m][k], acc[ai][bj][m][n], 0, 0, 0); __builtin_amdgcn_s_setprio(0); } while (0)
#define PG8_WAIT_V(n) asm volatile("s_waitcnt vmcnt(" #n ")" ::: "memory")
#define PG8_WAIT_L(n) asm volatile("s_waitcnt lgkmcnt(" #n ")" ::: "memory")
#define PG8_BAR __builtin_amdgcn_s_barrier()
#define PG8_SCHED __builtin_amdgcn_sched_barrier(0)
    Unit cur, nxt; int ui = 0;
    if (!S.next(0, cur)) return;
    f32x4 acc[2][2][4][2];
#pragma unroll
    for (int a = 0; a < 2; ++a)
#pragma unroll
        for (int b = 0; b < 2; ++b)
#pragma unroll
            for (int m = 0; m < 4; ++m)
#pragma unroll
                for (int n = 0; n < 2; ++n) acc[a][b][m][n] = (f32x4){0.f, 0.f, 0.f, 0.f};
    bf16x8 At[4][2], B0[2][2], B1[2][2];
    const char* cA = (const char*)g.A + (size_t)cur.pm * tstep; const char* cB = (const char*)g.Bt + (size_t)cur.pn * tstep;
    S.a_ready(cur);
    if constexpr (SP2) {
        PG8_STAGE(PG8_SB(0, 0), cB, voffB); PG8_STAGE(PG8_SB(0, 1), cB + hstep, voffB); PG8_STAGE(PG8_SA(0, 0), cA, voffA); PG8_STAGE(PG8_SA(0, 1), cA + hstep, voffA);
        if (wr == 1) PG8_BAR;
        PG8_WAIT_V(2); PG8_BAR;
        PG8_STAGE(PG8_SB(1, 0), cB + kstep, voffB); PG8_STAGE(PG8_SA(1, 0), cA + kstep, voffA); PG8_STAGE(PG8_SB(1, 1), cB + hstep + kstep, voffB);
        PG8_WAIT_V(6); PG8_BAR;
    } else {
        PG8_STAGE(PG8_SB(0, 0), cB, voffB); PG8_STAGE(PG8_SA(0, 0), cA, voffA); PG8_STAGE(PG8_SB(0, 1), cB + hstep, voffB); PG8_STAGE(PG8_SA(0, 1), cA + hstep, voffA);
        if (wr == 1) PG8_BAR;
        PG8_WAIT_V(4); PG8_BAR;
        PG8_STAGE(PG8_SB(1, 0), cB + kstep, voffB); PG8_STAGE(PG8_SA(1, 0), cA + kstep, voffA); PG8_STAGE(PG8_SB(1, 1), cB + hstep + kstep, voffB);
        PG8_WAIT_V(6); PG8_BAR;
    }
    for (;;) {
        const bool has_next = S.next(ui + 1, nxt);
        const char* nA = has_next ? (const char*)g.A + (size_t)nxt.pm * tstep : cA; const char* nB = has_next ? (const char*)g.Bt + (size_t)nxt.pn * tstep : cB;
        for (int t = 0; t < nt; t += 2) {
            const bool last = (t == nt - 2);
            const char* a1 = cA + (size_t)(t + 1) * kstep;
            const char* a2 = last ? nA : cA + (size_t)(t + 2) * kstep; const char* b2 = last ? nB : cB + (size_t)(t + 2) * kstep;
            const char* a3 = a2 + kstep; const char* b3 = b2 + kstep;
            if (last && has_next) S.a_ready(nxt);
            if constexpr (SP2) {
            PG8_LDB(B0, 0, 0); PG8_LDB(B1, 0, 1); PG8_SCHED; PG8_LDA(At, 0, 0); PG8_STAGE(PG8_SA(1, 1), a1 + hstep, voffA);
            PG8_WAIT_V(8); PG8_WAIT_L(0); PG8_BAR; PG8_MMA(0, 0, At, B0); PG8_MMA(0, 1, At, B1); PG8_BAR; PG8_SCHED;
            PG8_LDA(At, 0, 1); PG8_STAGE(PG8_SB(0, 0), b2, voffB); PG8_STAGE(PG8_SB(0, 1), b2 + hstep, voffB); PG8_STAGE(PG8_SA(0, 0), a2, voffA);
            PG8_WAIT_V(8); PG8_WAIT_L(0); PG8_BAR; PG8_MMA(1, 0, At, B0); PG8_MMA(1, 1, At, B1); PG8_BAR; PG8_SCHED;
            PG8_LDB(B0, 1, 0); PG8_LDB(B1, 1, 1); PG8_SCHED; PG8_LDA(At, 1, 0); PG8_STAGE(PG8_SA(0, 1), a2 + hstep, voffA);
            PG8_WAIT_V(8); PG8_WAIT_L(0); PG8_BAR; PG8_MMA(0, 0, At, B0); PG8_MMA(0, 1, At, B1); PG8_BAR; PG8_SCHED;
            PG8_LDA(At, 1, 1); PG8_STAGE(PG8_SB(1, 0), b3, voffB); PG8_STAGE(PG8_SB(1, 1), b3 + hstep, voffB); PG8_STAGE(PG8_SA(1, 0), a3, voffA);
            PG8_WAIT_V(8); PG8_WAIT_L(0); PG8_BAR; PG8_MMA(1, 0, At, B0); PG8_MMA(1, 1, At, B1); PG8_BAR; PG8_SCHED;
            } else {
            PG8_LDB(B0, 0, 0); PG8_SCHED; PG8_LDA(At, 0, 0); PG8_STAGE(PG8_SA(1, 1), a1 + hstep, voffA);
            PG8_WAIT_L(8); PG8_BAR; PG8_WAIT_L(0); PG8_MMA(0, 0, At, B0); PG8_BAR; PG8_SCHED;
            PG8_LDB(B1, 0, 1); PG8_STAGE(PG8_SB(0, 0), b2, voffB);
            PG8_BAR; PG8_WAIT_L(0); PG8_MMA(0, 1, At, B1); PG8_BAR;
            PG8_LDA(At, 0, 1); PG8_STAGE(PG8_SA(0, 0), a2, voffA);
            PG8_BAR; PG8_WAIT_L(0); PG8_MMA(1, 0, At, B0); PG8_BAR; PG8_SCHED;
            PG8_STAGE(PG8_SB(0, 1), b2 + hstep, voffB);
            PG8_WAIT_V(6); PG8_BAR; PG8_MMA(1, 1, At, B1); PG8_BAR;
            PG8_LDB(B0, 1, 0); PG8_SCHED; PG8_LDA(At, 1, 0); PG8_STAGE(PG8_SA(0, 1), a2 + hstep, voffA);
            PG8_WAIT_L(8); PG8_BAR; PG8_WAIT_L(0); PG8_MMA(0, 0, At, B0); PG8_BAR; PG8_SCHED;
            PG8_LDB(B1, 1, 1); PG8_STAGE(PG8_SB(1, 0), b3, voffB);
            PG8_BAR; PG8_WAIT_L(0); PG8_MMA(0, 1, At, B1); PG8_BAR;
            PG8_LDA(At, 1, 1); PG8_STAGE(PG8_SA(1, 0), a3, voffA);
            PG8_BAR; PG8_WAIT_L(0); PG8_MMA(1, 0, At, B0); PG8_BAR; PG8_SCHED;
            PG8_STAGE(PG8_SB(1, 1), b3 + hstep, voffB);
            PG8_WAIT_V(6); PG8_BAR; PG8_MMA(1, 1, At, B1); PG8_BAR;
            }
        }
        if constexpr (ALIGN_EPI) { if (wr == 0) PG8_BAR; }
        if constexpr (!Epi::AFTER_DRAIN) { E(acc, cur, wr, wc, fr, fq); S.done(cur); }
        if (!has_next) break;
#pragma unroll
        for (int a = 0; a < 2; ++a)
#pragma unroll
            for (int b = 0; b < 2; ++b)
#pragma unroll
                for (int m = 0; m < 4; ++m)
#pragma unroll
                    for (int n = 0; n < 2; ++n) acc[a][b][m][n] = (f32x4){0.f, 0.f, 0.f, 0.f};
        cur = nxt; cA = nA; cB = nB; ++ui;
        if constexpr (ALIGN_EPI) { if (wr == 1) PG8_BAR; }
    }
    PG8_WAIT_V(0);
    if constexpr (!ALIGN_EPI) { if (wr == 0) PG8_BAR; }
    PG8_BAR;
    if constexpr (Epi::AFTER_DRAIN) { E.fused(acc, cur, wr, wc, fr, fq, lds, wid, lane); S.done(cur); }
#undef PG8_SA
#undef PG8_SB
#undef PG8_STAGE
#undef PG8_LDA
#undef PG8_LDB
#undef PG8_MMA
#undef PG8_WAIT_V
#undef PG8_WAIT_L
#undef PG8_BAR
#undef PG8_SCHED
}
}
#define GAS __attribute__((address_space(1)))
#define LAS __attribute__((address_space(3)))
typedef unsigned short bf16;
typedef unsigned v4u __attribute__((ext_vector_type(4)));
typedef float f32x4 __attribute__((ext_vector_type(4)));
typedef short bf16x8 __attribute__((ext_vector_type(8)));
typedef GAS unsigned gu32;
typedef GAS unsigned long long gu64;
#define RLX_AGENT __ATOMIC_RELAXED, __HIP_MEMORY_SCOPE_AGENT
#define LDS_WAIT() asm volatile("s_waitcnt lgkmcnt(0)" ::: "memory")
#define VM_WAIT() asm volatile("s_waitcnt vmcnt(0)" ::: "memory")
__device__ __forceinline__ unsigned long long rt() { return __builtin_amdgcn_s_memrealtime(); }
__device__ __forceinline__ unsigned f2bf(float f) { unsigned u = __builtin_bit_cast(unsigned, f); return (u + 0x7fffu + ((u >> 16) & 1u)) >> 16; }
__device__ __forceinline__ unsigned pk2(float lo, float hi) { return f2bf(lo) | (f2bf(hi) << 16); }

#define XB_TMO      128
#define XB_XCNT(j)  (256  + 64 * (j))
#define XB_XSUB(j)  (1280 + 64 * (j))
#define XB_XGEN(j)  (2304 + 64 * (j))
#define XB_TOP      3328
#define XB_TOPGEN   3392
#define XCD_BAR_WORDS 3456
#define XB_SPIN_CAP (1u << 18)

__device__ __forceinline__ unsigned xb_ld(unsigned* p)              { return __hip_atomic_load(p, __ATOMIC_RELAXED, __HIP_MEMORY_SCOPE_AGENT); }
__device__ __forceinline__ unsigned xb_add(unsigned* p, unsigned v) { return __hip_atomic_fetch_add(p, v, __ATOMIC_RELAXED, __HIP_MEMORY_SCOPE_AGENT); }
__device__ __forceinline__ unsigned xb_xcc_id() { return (unsigned)__builtin_amdgcn_s_getreg((3 << 11) | 20) & 0xFu; }
#define XB_SPIN(cond, bar) do { unsigned _sp = 0; while (cond) { __builtin_amdgcn_s_sleep(1); \
    if ((++_sp & 255u) == 0u) { if (xb_ld(&(bar)[XB_TMO])) break; if (_sp > XB_SPIN_CAP) { atomicAdd(&(bar)[XB_TMO], 1u); break; } } } } while (0)

struct XcdBarrier {
    unsigned* bar; unsigned x;
    volatile LAS unsigned* st;
};

__device__ __forceinline__ XcdBarrier xcd_barrier_post(unsigned* bar, volatile LAS unsigned* st) {
    XcdBarrier b; b.bar = bar; b.x = xb_xcc_id(); b.st = st;
    if (threadIdx.x == 0) (void)xb_add(&bar[XB_XCNT(b.x)], 1u);
    return b;
}
__device__ __forceinline__ void xcd_barrier_complete(unsigned* bar, unsigned x, unsigned& nloc, unsigned& nx) {
    const unsigned G = gridDim.x * gridDim.y * gridDim.z;
    unsigned sum, cnt, mine, sp = 0u;
    for (;;) {
        sum = 0u; cnt = 0u; mine = 0u;
#pragma unroll
        for (unsigned j = 0; j < 16; ++j) { const unsigned c = xb_ld(&bar[XB_XCNT(j)]); sum += c; cnt += (c > 0u) ? 1u : 0u; mine = (j == x) ? c : mine; }
        if (sum == G) break;
        __builtin_amdgcn_s_sleep(1);
        if ((++sp & 255u) == 0u) { if (xb_ld(&bar[XB_TMO])) break; if (sp > XB_SPIN_CAP) { atomicAdd(&bar[XB_TMO], 1u); break; } }
    }
    nloc = mine > 0u ? mine : 1u; nx = cnt > 0u ? cnt : 1u;
}

__device__ __forceinline__ void xcd_barrier(const XcdBarrier& b) {
    asm volatile("s_waitcnt vmcnt(0)" ::: "memory");
    __syncthreads();
    if (threadIdx.x == 0) {
        unsigned* bar = b.bar;
        __builtin_amdgcn_s_waitcnt(0);
        unsigned nloc = b.st[0], nx = b.st[1];
        if (nloc == 0u) { xcd_barrier_complete(bar, b.x, nloc, nx); b.st[0] = nloc; b.st[1] = nx; }
        const unsigned old = xb_add(&bar[XB_XSUB(b.x)], 1u);
        const unsigned gen = old / nloc;
        if (old + 1u == (gen + 1u) * nloc) {
            __builtin_amdgcn_fence(__ATOMIC_RELEASE, "agent");
            asm volatile("s_waitcnt vmcnt(0)" ::: "memory");
            const unsigned og = xb_add(&bar[XB_TOP], 1u);
            const unsigned tg = og / nx;
            if (og + 1u == (tg + 1u) * nx) xb_add(&bar[XB_TOPGEN], 1u);
            else XB_SPIN(xb_ld(&bar[XB_TOPGEN]) == tg, bar);
            __builtin_amdgcn_fence(__ATOMIC_ACQUIRE, "agent");
            xb_add(&bar[XB_XGEN(b.x)], 1u);
            asm volatile("s_waitcnt vmcnt(0)" ::: "memory");
        } else {
            XB_SPIN(xb_ld(&bar[XB_XGEN(b.x)]) == gen, bar);
            __builtin_amdgcn_fence(__ATOMIC_ACQUIRE, "agent");
            asm volatile("s_waitcnt vmcnt(0)" ::: "memory");
        }
    }
    __syncthreads();
}
#define DI __device__ __forceinline__
constexpr int NWAVES = 8;
constexpr int NB = 16, SEQ = 2048, DM = 1024, MT = NB * SEQ;
constexpr int DIN_SRC = 6944, NPROJ = 7168;
constexpr int MEML = 256, MROWS = NB * MEML;
constexpr int NEXP = 32, TOPK = 4, DFF = 1024, MOEB = 256;
constexpr int NROWS = MT * TOPK;
constexpr int NBLK_MAX = (NROWS + NEXP * (MOEB - 1) + MOEB - 1) / MOEB;
constexpr int CAP = NBLK_MAX * MOEB;
constexpr float EPS = 1e-6f;
constexpr float NEGF = -1e30f;
constexpr int PC_MLQ = 0, PC_MLK = 512, PC_MLV = 1024, PC_MLO = 1536, PC_NQ = 2048, PC_NKC = 2560, PC_NVC = 2688, PC_NKS = 2816, PC_NVS = 2944,
              PC_NKW = 3072, PC_NVW = 3200, PC_MQ = 3328, PC_BRG = 3840, PC_MLI = 6912, PC_MLF = 6916, PC_NG = 6920, PC_END = 6944;
__host__ __device__ constexpr int proj_srccol(int j) {
    return j < 2048 ? j : j < 2560 ? 2056 + (j - 2048) : j < 3328 ? 2568 + (j - 2560) : j < 3840 ? 3360 + (j - 3328) : j < 6912 ? 3872 + (j - 3840)
         : j < 6920 ? 2048 + (j - 6912) : j < 6944 ? 3336 + (j - 6920) : -1;
}

constexpr size_t MiB = 1u << 20;
constexpr size_t WS_CTL = 0, CTL_ZERO_BYTES = 1 * MiB;
constexpr size_t WS_WIN = 1 * MiB, WS_WGU = 15 * MiB, WS_WDN = 143 * MiB, WS_WMKV = 207 * MiB, WS_WBR = 209 * MiB, WS_WOUT = 212 * MiB, WS_WC1 = 214 * MiB;
constexpr size_t WS_SMALL = 216 * MiB;
constexpr size_t WS_R1 = 218 * MiB;
constexpr size_t WS_PROJ = 282 * MiB;
constexpr size_t WS_R3 = 730 * MiB;
constexpr size_t WS_MEMKV = WS_R3, WS_MEMKN = WS_R3 + 8 * MiB, WS_QN = WS_R3 + 12 * MiB, WS_KSN = WS_R3 + 44 * MiB, WS_KWN = WS_R3 + 52 * MiB,
                 WS_MQN = WS_R3 + 60 * MiB, WS_MLQK = WS_R3 + 92 * MiB, WS_HID = WS_R3 + 156 * MiB, WS_KC = WS_R3 + 160 * MiB, WS_VC = WS_KC + MiB / 2,
                 WS_H0 = WS_R3 + 161 * MiB, WS_H1 = WS_H0 + 32 * MiB, WS_H2 = WS_H1 + 32 * MiB, WS_ROUTE = WS_H2 + 32 * MiB, WS_END = WS_ROUTE + 6 * MiB;
constexpr size_t WS_MEMN = WS_H0;
constexpr size_t WS_ACMP = WS_H1;
constexpr size_t WS_APERM = WS_PROJ;
constexpr size_t WS_ACT = WS_PROJ + 272 * MiB;
static_assert(WS_ACT + 272 * MiB <= WS_H0 + 96 * MiB && WS_END <= 1024 * MiB, "ws map");
constexpr size_t SM_ROPEC = 0, SM_ROPES = 256 * 1024, SM_CBIAS = 512 * 1024;
constexpr size_t RT_TOKE = 0, RT_TOKPOS = 512 * 1024, RT_TOKW = 1024 * 1024, RT_TOKDEST = 1536 * 1024, RT_ROWW = 2048 * 1024;
constexpr int CW_BAR = 4096;
constexpr int CW_ECNT = 16384;
constexpr int CW_QCTR = 16384 + 64;

constexpr int RING_BYTES = 131072, LDSCTL_OFF = RING_BYTES, MISC_OFF = LDSCTL_OFF + 320, LDS_BYTES = 147456;

struct Args { const float* in[34]; float* out; unsigned char* ws; int ph_lo, ph_hi, li, pad; };

DI float bf2f(unsigned short h) { return __uint_as_float((unsigned)h << 16); }
DI float wave_sum(float v) {
#pragma unroll
    for (int o = 1; o < 64; o <<= 1) v += __shfl_xor(v, o);
    return v;
}
DI float wave_max(float v) {
#pragma unroll
    for (int o = 1; o < 64; o <<= 1) v = fmaxf(v, __shfl_xor(v, o));
    return v;
}
DI float sigm(float x) { return 1.f / (1.f + __expf(-x)); }
DI float logsig(float x) { return fminf(x, 0.f) - log1pf(__expf(-fabsf(x))); }

namespace pg8 {
struct EpiBf16Silu {
    static constexpr bool PERM = true, AFTER_DRAIN = false;
    bf16_t* O; int ldc; const float* bias; int silu;
    DI void operator()(const f32x4 (&acc)[2][2][4][2], const Unit& u, int wr, int wc, int fr, int fq) const {
        const int row0 = u.pm * BM + wr * 64 + fr; const int col0 = u.pn * BM + wc * 32 + 8 * fq;
#pragma unroll
        for (int ai = 0; ai < 2; ++ai)
#pragma unroll
            for (int m = 0; m < 4; ++m) { bf16_t* rowp = O + (size_t)(row0 + ai * HALF + m * 16) * ldc + col0;
#pragma unroll
                for (int bj = 0; bj < 2; ++bj) { f32x4 v0 = acc[ai][bj][m][0], v1 = acc[ai][bj][m][1];
                    if (bias) { v0 += *(const f32x4*)(bias + col0 + bj * HALF); v1 += *(const f32x4*)(bias + col0 + bj * HALF + 4); }
                    if (silu) {
#pragma unroll
                        for (int j = 0; j < 4; ++j) { v0[j] = v0[j] / (1.f + __expf(-v0[j])); v1[j] = v1[j] / (1.f + __expf(-v1[j])); } }
                    u32x4 w; w.x = cvt_pk_bf16(v0[0], v0[1]); w.y = cvt_pk_bf16(v0[2], v0[3]); w.z = cvt_pk_bf16(v1[0], v1[1]); w.w = cvt_pk_bf16(v1[2], v1[3]);
                    *(u32x4*)(rowp + bj * HALF) = w; } }
    }
};
template <int B> struct EpiGate {
    static constexpr bool PERM = false, AFTER_DRAIN = false;
    const bf16_t* proj; float* tmp; bf16_t* merged;
    DI void operator()(const f32x4 (&acc)[2][2][4][2], const Unit& u, int wr, int wc, int fr, int fq) const {
        typedef unsigned u32x2v __attribute__((ext_vector_type(2)));
        const int col0 = u.pn * BM + wc * 32 + 4 * fq;
#pragma unroll
        for (int ai = 0; ai < 2; ++ai)
#pragma unroll
            for (int m = 0; m < 4; ++m) { const size_t r = (size_t)(u.pm * BM + ai * HALF + wr * 64 + m * 16 + fr);
#pragma unroll
                for (int bj = 0; bj < 2; ++bj)
#pragma unroll
                    for (int n = 0; n < 2; ++n) { const int c = col0 + bj * HALF + n * 16;
                        const u32x2v gw = *(const u32x2v*)(proj + r * NPROJ + PC_BRG + B * DM + c);
                        f32x4 g; g[0] = __uint_as_float(gw.x << 16); g[1] = __uint_as_float(gw.x & 0xffff0000u); g[2] = __uint_as_float(gw.y << 16); g[3] = __uint_as_float(gw.y & 0xffff0000u);
                        f32x4 v = acc[ai][bj][m][n];
#pragma unroll
                        for (int j = 0; j < 4; ++j) v[j] = v[j] / (1.f + __expf(-g[j]));
                        float* tp = tmp + r * DM + c;
                        if (B == 0) { *(f32x4*)tp = v; }
                        else if (B == 1) { *(f32x4*)tp = *(const f32x4*)tp + v; }
                        else { v = *(const f32x4*)tp + v; u32x2v w; w.x = cvt_pk_bf16(v[0], v[1]); w.y = cvt_pk_bf16(v[2], v[3]); *(u32x2v*)(merged + r * DM + c) = w; } } }
    }
};
struct EpiRes {
    static constexpr bool PERM = false, AFTER_DRAIN = false;
    const float* base; float* out;
    DI void operator()(const f32x4 (&acc)[2][2][4][2], const Unit& u, int wr, int wc, int fr, int fq) const {
        const int col0 = u.pn * BM + wc * 32 + 4 * fq;
#pragma unroll
        for (int ai = 0; ai < 2; ++ai)
#pragma unroll
            for (int m = 0; m < 4; ++m) { const size_t r = (size_t)(u.pm * BM + ai * HALF + wr * 64 + m * 16 + fr);
#pragma unroll
                for (int bj = 0; bj < 2; ++bj)
#pragma unroll
                    for (int n = 0; n < 2; ++n) { const int c = col0 + bj * HALF + n * 16; *(f32x4*)(out + r * DM + c) = *(const f32x4*)(base + r * DM + c) + acc[ai][bj][m][n]; } }
    }
};
struct EpiSwiglu {
    static constexpr bool PERM = true, AFTER_DRAIN = false;
    bf16_t* act; const float* bgu;
    DI void operator()(const f32x4 (&acc)[2][2][4][2], const Unit& u, int wr, int wc, int fr, int fq) const {
        typedef unsigned u32x2v __attribute__((ext_vector_type(2)));
        const int e = u.pn >> 3, pnl = u.pn & 7;
        const int lc0 = pnl * BM + wc * 32 + 8 * fq;
        const int row0 = u.pm * BM + wr * 64 + fr;
#pragma unroll
        for (int ai = 0; ai < 2; ++ai)
#pragma unroll
            for (int m = 0; m < 4; ++m) { bf16_t* rowp = act + (size_t)(row0 + ai * HALF + m * 16) * DFF;
#pragma unroll
                for (int bj = 0; bj < 2; ++bj) {
                    const int lc = lc0 + bj * HALF;
                    const f32x4 b0 = *(const f32x4*)(bgu + e * 2048 + lc), b1 = *(const f32x4*)(bgu + e * 2048 + lc + 4);
                    const f32x4 v0 = acc[ai][bj][m][0] + b0, v1 = acc[ai][bj][m][1] + b1;
                    float o[4];
#pragma unroll
                    for (int q = 0; q < 4; ++q) { const float gt = fminf(q < 2 ? v0[2 * q] : v1[2 * q - 4], 7.0f); float up = q < 2 ? v0[2 * q + 1] : v1[2 * q - 3]; up = fminf(fmaxf(up, -7.0f), 7.0f);
                        o[q] = (up + 1.0f) * (gt / (1.f + __expf(-1.702f * gt))); }
                    u32x2v w; w.x = cvt_pk_bf16(o[0], o[1]); w.y = cvt_pk_bf16(o[2], o[3]);
                    *(u32x2v*)(rowp + (lc >> 1)) = w; } }
    }
};
struct EpiDown {
    static constexpr bool PERM = false, AFTER_DRAIN = false;
    bf16_t* y; const float* bdn; const float* roww;
    DI void operator()(const f32x4 (&acc)[2][2][4][2], const Unit& u, int wr, int wc, int fr, int fq) const {
        typedef unsigned u32x2v __attribute__((ext_vector_type(2)));
        const int e = u.pn >> 2, pnl = u.pn & 3;
        const int col0 = pnl * BM + wc * 32 + 4 * fq;
#pragma unroll
        for (int ai = 0; ai < 2; ++ai)
#pragma unroll
            for (int m = 0; m < 4; ++m) { const size_t r = (size_t)(u.pm * BM + ai * HALF + wr * 64 + m * 16 + fr); const float rw = roww[r];
#pragma unroll
                for (int bj = 0; bj < 2; ++bj)
#pragma unroll
                    for (int n = 0; n < 2; ++n) { const int c = col0 + bj * HALF + n * 16; const f32x4 v = (acc[ai][bj][m][n] + *(const f32x4*)(bdn + e * DM + c)) * rw;
                        u32x2v w; w.x = cvt_pk_bf16(v[0], v[1]); w.y = cvt_pk_bf16(v[2], v[3]); *(u32x2v*)(y + r * DM + c) = w; } }
    }
};
template <int NPN> struct MoeOrder {
    int nunits, G, c; const PG8_LAS unsigned char* blk_e;
    DI bool next(int i, Unit& u) const { const int L = i * G + c; if (L >= nunits) return false; const int rb = L / NPN; u.pm = rb; u.pn = (int)blk_e[rb] * NPN + (L % NPN); return true; }
    DI void a_ready(const Unit&) const {}
    DI void done(const Unit&) const {}
};
}

struct Frame {
    LAS unsigned char* lds; volatile LAS unsigned* MISC; unsigned* ctl; unsigned char* ws;
    int tid, lane, wave, G, bx;
    const float* const* in; float* out;
};
enum { I_X = 0, I_MEM, I_GMIX, I_WIN, I_CONVW, I_CONVB, I_MLBI, I_MLBF, I_MLGOUT, I_NGQ, I_NGK, I_CPK, I_CW1K, I_CB1K, I_CW2K, I_CPV, I_CW1V, I_CB1V, I_CW2V,
       I_GMEM, I_WMKV, I_MGQ, I_MGK, I_WBRML, I_WBRNSA, I_WBRMEM, I_WOUT, I_GFFN, I_WR, I_BR, I_WGU, I_BGU, I_WDN, I_BDN, N_IN };

template <class CM>
DI void tr_item(const float* W, int ldw, int K, bf16* WT, int k0, int n0, CM cm, LAS float* scr, int lane) {
    const int sc = cm(n0 + (lane & 31));
#pragma unroll 8
    for (int i = 0; i < 32; ++i) { const int kk = 2 * i + (lane >> 5); scr[kk * 33 + (lane & 31)] = sc >= 0 ? W[(size_t)(k0 + kk) * ldw + sc] : 0.f; }
    LDS_WAIT(); asm volatile("" ::: "memory");
    const int c = lane & 7;
#pragma unroll
    for (int j = 0; j < 4; ++j) { const int n = (lane >> 3) + 8 * j; const LAS float* s = scr + (8 * c) * 33 + n;
        v4u o; o.x = pk2(s[0 * 33], s[1 * 33]); o.y = pk2(s[2 * 33], s[3 * 33]); o.z = pk2(s[4 * 33], s[5 * 33]); o.w = pk2(s[6 * 33], s[7 * 33]);
        *(v4u*)(WT + (size_t)(n0 + n) * K + k0 + 8 * c) = o; }
    LDS_WAIT(); asm volatile("" ::: "memory");
}
struct CmId { DI int operator()(int j) const { return j; } };
struct CmProj { DI int operator()(int j) const { return proj_srccol(j); } };

DI void rms_row_bf16(const float* xrow, const float* g, bf16* orow, int lane) {
    const f32x4* xr = (const f32x4*)xrow + lane; const f32x4* gr = (const f32x4*)g + lane;
    f32x4 v[4]; float s = 0.f;
#pragma unroll
    for (int j = 0; j < 4; ++j) { v[j] = xr[64 * j]; s += (v[j].x * v[j].x + v[j].y * v[j].y) + (v[j].z * v[j].z + v[j].w * v[j].w); }
    const float rstd = rsqrtf(wave_sum(s) * (1.f / DM) + EPS);
    unsigned long long* o8 = (unsigned long long*)orow + lane;
#pragma unroll
    for (int j = 0; j < 4; ++j) { const f32x4 gg = gr[64 * j];
        o8[64 * j] = (unsigned long long)pk2(v[j].x * rstd * gg.x, v[j].y * rstd * gg.y) | ((unsigned long long)pk2(v[j].z * rstd * gg.z, v[j].w * rstd * gg.w) << 32); }
}

DI void p0_prologue(Frame& F) {
    LAS float* scr = (LAS float*)(F.lds + F.wave * 16384);
    const int gw = F.bx * NWAVES + F.wave, NGW = F.G * NWAVES;
    unsigned char* ws = F.ws;
    constexpr int IT_IN = 16 * (NPROJ / 32), IT_GU = 32 * 16 * 64, IT_DN = 32 * 16 * 32, IT_MKV = 16 * 32, IT_BR = 3 * 8 * 32, IT_OUT = 16 * 32, IT_C1 = 2 * 32 * 8;
    constexpr int NITEMS = IT_IN + IT_GU + IT_DN + IT_MKV + IT_BR + IT_OUT + IT_C1;
    for (int it = gw; it < NITEMS; it += NGW) {
        int r = it;
        if (r < IT_IN) { const int kb = r / (NPROJ / 32), nb = r % (NPROJ / 32); tr_item(F.in[I_WIN], DIN_SRC, DM, (bf16*)(ws + WS_WIN), 64 * kb, 32 * nb, CmProj(), scr, F.lane); continue; } r -= IT_IN;
        if (r < IT_GU) { const int e = r / 1024, q = r % 1024, kb = q / 64, nb = q % 64; tr_item(F.in[I_WGU] + (size_t)e * DM * 2048, 2048, DM, (bf16*)(ws + WS_WGU) + (size_t)e * 2048 * DM, 64 * kb, 32 * nb, CmId(), scr, F.lane); continue; } r -= IT_GU;
        if (r < IT_DN) { const int e = r / 512, q = r % 512, kb = q / 32, nb = q % 32; tr_item(F.in[I_WDN] + (size_t)e * DFF * DM, DM, DFF, (bf16*)(ws + WS_WDN) + (size_t)e * DM * DFF, 64 * kb, 32 * nb, CmId(), scr, F.lane); continue; } r -= IT_DN;
        if (r < IT_MKV) { const int kb = r / 32, nb = r % 32; tr_item(F.in[I_WMKV], 1024, 1024, (bf16*)(ws + WS_WMKV), 64 * kb, 32 * nb, CmId(), scr, F.lane); continue; } r -= IT_MKV;
        if (r < IT_BR) { const int b = r / 256, q = r % 256, kb = q / 32, nb = q % 32; tr_item(F.in[I_WBRML + b], 1024, 512, (bf16*)(ws + WS_WBR) + (size_t)b * 1024 * 512, 64 * kb, 32 * nb, CmId(), scr, F.lane); continue; } r -= IT_BR;
        if (r < IT_OUT) { const int kb = r / 32, nb = r % 32; tr_item(F.in[I_WOUT], 1024, 1024, (bf16*)(ws + WS_WOUT), 64 * kb, 32 * nb, CmId(), scr, F.lane); continue; } r -= IT_OUT;
        { const int kv = r / 256, q = r % 256, kb = q / 8, nb = q % 8; tr_item(F.in[kv ? I_CW1V : I_CW1K], 256, 2048, (bf16*)(ws + WS_WC1) + (size_t)kv * 256 * 2048, 64 * kb, 32 * nb, CmId(), scr, F.lane); }
    }
    for (int m = gw; m < MT; m += NGW) rms_row_bf16(F.in[I_X] + (size_t)m * DM, F.in[I_GMIX], (bf16*)(ws + WS_R1) + (size_t)m * DM, F.lane);
    for (int m = gw; m < MROWS; m += NGW) rms_row_bf16(F.in[I_MEM] + (size_t)m * DM, F.in[I_GMEM], (bf16*)(ws + WS_MEMN) + (size_t)m * DM, F.lane);
    float* rc = (float*)(ws + WS_SMALL + SM_ROPEC); float* rs = (float*)(ws + WS_SMALL + SM_ROPES);
    for (int i = F.bx * 512 + F.tid; i < SEQ * 32; i += F.G * 512) {
        const int p = i >> 5, k = i & 31;
        const float invf = exp2f(-(float)k * (13.287712379549449f / 32.0f));
        const float ang = (float)p * invf;
        const float kf = rintf(ang * 0.15915494309189535f);
        float r = fmaf(-kf, 6.28125f, ang); r = fmaf(-kf, 1.9353071795864769e-3f, r);
        rc[i] = cosf(r); rs[i] = sinf(r);
    }
    if (F.bx == F.G - 1) {
        const int kv = F.tid >> 8, f = F.tid & 255;
        const float* pe = F.in[kv ? I_CPV : I_CPK]; const float* w1 = F.in[kv ? I_CW1V : I_CW1K];
        float a = F.in[kv ? I_CB1V : I_CB1K][f];
        for (int k = 0; k < 2048; ++k) a = fmaf(pe[k], w1[(size_t)k * 256 + f], a);
        ((float*)(ws + WS_SMALL + SM_CBIAS))[kv * 256 + f] = a;
    }
}

DI void p2_prep(Frame& F) {
    unsigned char* ws = F.ws;
    const int gw = F.bx * NWAVES + F.wave, NGW = F.G * NWAVES, lane = F.lane;
    const bf16* proj = (const bf16*)(ws + WS_PROJ);
    const float* rc = (const float*)(ws + WS_SMALL + SM_ROPEC); const float* rs = (const float*)(ws + WS_SMALL + SM_ROPES);
    bf16* qn = (bf16*)(ws + WS_QN); bf16* ksn = (bf16*)(ws + WS_KSN); bf16* kwn = (bf16*)(ws + WS_KWN); bf16* mqn = (bf16*)(ws + WS_MQN); bf16* mlqk = (bf16*)(ws + WS_MLQK);
    bf16* acmp = (bf16*)(ws + WS_ACMP);
    const float gq = F.in[I_NGQ][lane], gks = F.in[I_NGK][64 + lane], gkw = F.in[I_NGK][128 + lane];
    const float mg0 = F.in[I_MGQ][lane], mg1 = F.in[I_MGQ][64 + lane];
    for (int t = gw; t < MT; t += NGW) {
        const int b = t >> 11, tau = t & 2047;
        const bf16* pr = proj + (size_t)t * NPROJ;
        const float c = rc[tau * 32 + (lane & 31)], s = rs[tau * 32 + (lane & 31)];
#pragma unroll
        for (int h = 0; h < 12; ++h) {
            const int col = h < 8 ? PC_NQ + h * 64 : h < 10 ? PC_NKS + (h - 8) * 64 : PC_NKW + (h - 10) * 64;
            const float g = h < 8 ? gq : h < 10 ? gks : gkw;
            const float v = bf2f(pr[col + lane]);
            const float y = v * rsqrtf(wave_sum(v * v) * (1.f / 64.f) + EPS) * g;
            const float pt = __shfl_xor(y, 32);
            float o = lane < 32 ? y * c - pt * s : y * c + pt * s;
            if (h < 8) qn[(size_t)t * 512 + h * 64 + lane] = (bf16)f2bf(o * 0.125f);
            else if (h < 10) ksn[(size_t)t * 128 + (h - 8) * 64 + lane] = (bf16)f2bf(o);
            else kwn[(size_t)t * 128 + (h - 10) * 64 + lane] = (bf16)f2bf(o);
        }
#pragma unroll
        for (int h = 0; h < 4; ++h) {
            const float v0 = bf2f(pr[PC_MQ + h * 128 + lane]), v1 = bf2f(pr[PC_MQ + h * 128 + 64 + lane]);
            const float rstd = rsqrtf(wave_sum(v0 * v0 + v1 * v1) * (1.f / 128.f) + EPS) * 0.08838834764831845f;
            mqn[(size_t)t * 512 + h * 128 + lane] = (bf16)f2bf(v0 * rstd * mg0); mqn[(size_t)t * 512 + h * 128 + 64 + lane] = (bf16)f2bf(v1 * rstd * mg1);
        }
        for (int cc = lane; cc < 1024; cc += 64) {
            float a = F.in[I_CONVB][cc];
#pragma unroll
            for (int j = 0; j < 4; ++j) { const int tt = tau - 3 + j; if (tt >= 0) a = fmaf(F.in[I_CONVW][j * 1024 + cc], bf2f(proj[(size_t)(t - 3 + j) * NPROJ + cc]), a); }
            mlqk[(size_t)t * 1024 + cc] = (bf16)f2bf(a * sigm(a));
        }
#pragma unroll
        for (int kv = 0; kv < 2; ++kv)
#pragma unroll
            for (int h = 0; h < 2; ++h) {
                const bf16 val = pr[PC_NKC + kv * 128 + h * 64 + lane];
                const int nA = tau >> 4;
#pragma unroll
                for (int dn = 0; dn < 2; ++dn) { const int n = nA - dn; if (n >= 0 && n <= 126) { const int l = tau - 16 * n;
                    acmp[(size_t)kv * 4096 * 2048 + (size_t)((b * 2 + h) * 128 + n) * 2048 + l * 64 + lane] = val; } }
            }
    }
    for (int i = F.bx * 512 + F.tid; i < 2 * 32 * 2048; i += F.G * 512) { const int kv = i / (32 * 2048), q = i % (32 * 2048), bh = q / 2048, col = q % 2048;
        acmp[(size_t)kv * 4096 * 2048 + (size_t)(bh * 128 + 127) * 2048 + col] = 0; }
    const bf16* memkv = (const bf16*)(ws + WS_MEMKV); bf16* memkn = (bf16*)(ws + WS_MEMKN);
    const float kg0 = F.in[I_MGK][lane], kg1 = F.in[I_MGK][64 + lane];
    for (int r = gw; r < MROWS; r += NGW) {
#pragma unroll
        for (int h = 0; h < 4; ++h) {
            const float v0 = bf2f(memkv[(size_t)r * 1024 + h * 128 + lane]), v1 = bf2f(memkv[(size_t)r * 1024 + h * 128 + 64 + lane]);
            const float rstd = rsqrtf(wave_sum(v0 * v0 + v1 * v1) * (1.f / 128.f) + EPS);
            memkn[(size_t)r * 512 + h * 128 + lane] = (bf16)f2bf(v0 * rstd * kg0); memkn[(size_t)r * 512 + h * 128 + 64 + lane] = (bf16)f2bf(v1 * rstd * kg1);
        }
    }
}

DI void p4_kcvc(Frame& F) {
    unsigned char* ws = F.ws;
    const int gw = F.bx * NWAVES + F.wave, NGW = F.G * NWAVES, lane = F.lane;
    const bf16* hid = (const bf16*)(ws + WS_HID);
    const float* rc = (const float*)(ws + WS_SMALL + SM_ROPEC); const float* rs = (const float*)(ws + WS_SMALL + SM_ROPES);
    const float gk = F.in[I_NGK][lane];
    for (int it = gw; it < 2 * 4096; it += NGW) {
        const int kv = it >> 12, r = it & 4095, n = r & 127;
        bf16* dst = (bf16*)(ws + (kv ? WS_VC : WS_KC)) + (size_t)r * 64 + lane;
        if (n == 127) { *dst = 0; continue; }
        const bf16* hr = hid + (size_t)kv * 4096 * 256 + (size_t)r * 256; const float* w2 = F.in[kv ? I_CW2V : I_CW2K];
        float a = 0.f;
        for (int f = 0; f < 256; ++f) a = fmaf(bf2f(hr[f]), w2[f * 64 + lane], a);
        if (kv == 0) {
            const float y = a * rsqrtf(wave_sum(a * a) * (1.f / 64.f) + EPS) * gk;
            const int pos = 16 * n + 31; const float c = rc[pos * 32 + (lane & 31)], s = rs[pos * 32 + (lane & 31)];
            const float pt = __shfl_xor(y, 32);
            a = lane < 32 ? y * c - pt * s : y * c + pt * s;
        }
        *dst = (bf16)f2bf(a);
    }
}

DI void mlstm_unit(Frame& F, int unit) {
    unsigned char* ws = F.ws;
    const int b = unit >> 2, h = unit & 3, tid = F.tid, kk = tid >> 7, c = tid & 127;
    const bf16* proj = (const bf16*)(ws + WS_PROJ); const bf16* mlqk = (const bf16*)(ws + WS_MLQK); bf16* H0 = (bf16*)(ws + WS_H0);
    LAS float* qs = (LAS float*)F.lds;
    LAS float* ks = qs + 16 * 128;
    LAS float* vs = ks + 16 * 128;
    LAS float* gi = vs + 16 * 128;
    LAS float* gf = gi + 16;
    LAS float* part = gf + 16;
    LAS float* pden = part + 2 * 4 * 128;
    LAS float* hb = pden + 8;
    float C[32], nn[32];
#pragma unroll
    for (int i = 0; i < 32; ++i) { C[i] = 0.f; nn[i] = 0.f; }
    float m = 0.f;
    const float bi = F.in[I_MLBI][h], bfv = F.in[I_MLBF][h];
    const float scale = 0.08838834764831845f;
#pragma unroll 1
    for (int t0 = 0; t0 < SEQ; t0 += 16) {
        __syncthreads();
        for (int i = tid; i < 16 * 128; i += 512) { const int s = i >> 7, d = i & 127; const size_t t = (size_t)b * SEQ + t0 + s;
            qs[i] = bf2f(mlqk[t * 1024 + h * 128 + d]); ks[i] = bf2f(mlqk[t * 1024 + 512 + h * 128 + d]); vs[i] = bf2f(proj[t * NPROJ + PC_MLV + h * 128 + d]); }
        if (tid < 16) { const size_t t = (size_t)b * SEQ + t0 + tid; gi[tid] = bf2f(proj[t * NPROJ + PC_MLI + h]) + bi; gf[tid] = logsig(bf2f(proj[t * NPROJ + PC_MLF + h]) + bfv); }
        __syncthreads();
#pragma unroll 1
        for (int s = 0; s < 16; ++s) {
            const float lf = gf[s], ig = gi[s];
            const float mn = fmaxf(lf + m, ig), a = __expf(lf + m - mn), bb = __expf(ig - mn);
            m = mn;
            const float v = vs[s * 128 + c];
            float pn = 0.f, pd = 0.f;
#pragma unroll
            for (int i = 0; i < 32; ++i) { const float kvv = ks[s * 128 + kk * 32 + i], qv = qs[s * 128 + kk * 32 + i];
                C[i] = a * C[i] + bb * kvv * v; nn[i] = a * nn[i] + bb * kvv; pn = fmaf(qv, C[i], pn); pd = fmaf(qv, nn[i], pd); }
            const int par = s & 1;
            part[(par * 4 + kk) * 128 + c] = pn; if (c == 0) pden[par * 4 + kk] = pd;
            __syncthreads();
            if (kk == 0) {
                const float num = (part[(par * 4 + 0) * 128 + c] + part[(par * 4 + 1) * 128 + c]) + (part[(par * 4 + 2) * 128 + c] + part[(par * 4 + 3) * 128 + c]);
                const float den = (pden[par * 4 + 0] + pden[par * 4 + 1]) + (pden[par * 4 + 2] + pden[par * 4 + 3]);
                hb[s * 128 + c] = num * scale / fmaxf(fabsf(den * scale), __expf(-mn));
            }
        }
        __syncthreads();
#pragma unroll
        for (int rr = 0; rr < 2; ++rr) { const int s = F.wave * 2 + rr; const size_t t = (size_t)b * SEQ + t0 + s;
            const float v0 = hb[s * 128 + F.lane], v1 = hb[s * 128 + 64 + F.lane];
            const float rstd = rsqrtf(wave_sum(v0 * v0 + v1 * v1) * (1.f / 128.f) + EPS);
            const float o0 = bf2f(proj[t * NPROJ + PC_MLO + h * 128 + F.lane]), o1 = bf2f(proj[t * NPROJ + PC_MLO + h * 128 + 64 + F.lane]);
            H0[t * 512 + h * 128 + F.lane] = (bf16)f2bf(v0 * rstd * F.in[I_MLGOUT][h * 128 + F.lane] * sigm(o0));
            H0[t * 512 + h * 128 + 64 + F.lane] = (bf16)f2bf(v1 * rstd * F.in[I_MLGOUT][h * 128 + 64 + F.lane] * sigm(o1)); }
    }
    __syncthreads();
}

DI void nsa_scores(const bf16* krow, bool valid, const LAS float* qs, float (&s)[4]) {
    s[0] = s[1] = s[2] = s[3] = 0.f;
    if (valid) {
#pragma unroll 2
        for (int c8 = 0; c8 < 8; ++c8) { const v4u kk = *(const v4u*)(krow + c8 * 8);
            const unsigned w[4] = {kk.x, kk.y, kk.z, kk.w};
#pragma unroll
            for (int j = 0; j < 4; ++j) { const float k0 = __uint_as_float(w[j] << 16), k1 = __uint_as_float(w[j] & 0xffff0000u); const int d = c8 * 8 + 2 * j;
#pragma unroll
                for (int g = 0; g < 4; ++g) s[g] = fmaf(k1, qs[g * 64 + d + 1], fmaf(k0, qs[g * 64 + d], s[g])); } }
    }
}
DI void nsa_wave(Frame& F, int item, LAS float* wl) {
    unsigned char* ws = F.ws; const int lane = F.lane;
    const int t = item >> 1, hkv = item & 1, b = t >> 11, tau = t & 2047;
    const bf16* proj = (const bf16*)(ws + WS_PROJ);
    const bf16* qn = (const bf16*)(ws + WS_QN); const bf16* ksn = (const bf16*)(ws + WS_KSN); const bf16* kwn = (const bf16*)(ws + WS_KWN);
    const bf16* kc = (const bf16*)(ws + WS_KC); const bf16* vc = (const bf16*)(ws + WS_VC); bf16* H1 = (bf16*)(ws + WS_H1);
    LAS float* qs = wl;
    LAS float* ps = wl + 256;
    LAS float* psum = wl + 768;
#pragma unroll
    for (int g = 0; g < 4; ++g) qs[g * 64 + lane] = bf2f(qn[(size_t)t * 512 + (hkv * 4 + g) * 64 + lane]);
    float ofin[4] = {0.f, 0.f, 0.f, 0.f};
    float gate[4][3];
#pragma unroll
    for (int g = 0; g < 4; ++g)
#pragma unroll
        for (int cidx = 0; cidx < 3; ++cidx) gate[g][cidx] = sigm(bf2f(proj[(size_t)t * NPROJ + PC_NG + (hkv * 4 + g) * 3 + cidx]));
    const int ncmp = tau >= 31 ? ((tau - 31) >> 4) + 1 : 0;
    {
        float l[4] = {0.f, 0.f, 0.f, 0.f}, o[4] = {0.f, 0.f, 0.f, 0.f};
        const size_t rbase = (size_t)(b * 2 + hkv) * 128;
#pragma unroll
        for (int blk = 0; blk < 2; ++blk) { const int n = blk * 64 + lane; const bool valid = n < ncmp; float s[4];
            nsa_scores(kc + (rbase + n) * 64, valid, qs, s);
#pragma unroll
            for (int g = 0; g < 4; ++g) { const float p = valid ? __expf(s[g]) : 0.f; l[g] += p; ps[g * 128 + n] = p; } }
        float inv[4];
#pragma unroll
        for (int g = 0; g < 4; ++g) { const float L = wave_sum(l[g]); inv[g] = L > 0.f ? 1.f / L : 0.f; }
#pragma unroll
        for (int blk = 0; blk < 2; ++blk) { const int n = blk * 64 + lane; psum[n] = (ps[0 * 128 + n] * inv[0] + ps[1 * 128 + n] * inv[1]) + (ps[2 * 128 + n] * inv[2] + ps[3 * 128 + n] * inv[3]); }
#pragma unroll 2
        for (int n = 0; n < ncmp; ++n) { const float vv = bf2f(vc[(rbase + n) * 64 + lane]);
#pragma unroll
            for (int g = 0; g < 4; ++g) o[g] = fmaf(ps[g * 128 + n], vv, o[g]); }
#pragma unroll
        for (int g = 0; g < 4; ++g) ofin[g] += gate[g][0] * o[g] * inv[g];
    }
    const int cur = tau >> 6;
    unsigned selmask = 0u;
    {
        float score = -3.0e38f;
        if (lane < 32) { const int j = lane; float imp = 0.f;
#pragma unroll
            for (int dn = -1; dn <= 3; ++dn) { const int n = 4 * j + dn; if (n >= 0 && n <= 126) imp += psum[n]; }
            const bool forced = (j == 0) || (j == cur) || (j == cur - 1);
            score = j > cur ? NEGF : imp + (forced ? 1.0e4f : 0.f); }
#pragma unroll 1
        for (int r = 0; r < 8; ++r) { const float mx = wave_max(score); const unsigned long long bal = __ballot(score == mx); const int win = __ffsll((long long)bal) - 1;
            selmask |= 1u << win; if (lane == win) score = -3.4e38f; }
    }
    {
        float l[4] = {0.f, 0.f, 0.f, 0.f}, o[4] = {0.f, 0.f, 0.f, 0.f};
#pragma unroll 1
        for (int j = 0; j <= cur; ++j) { if (!((selmask >> j) & 1u)) continue;
            const int kpos = 64 * j + lane; const bool valid = kpos <= tau; float s[4];
            nsa_scores(ksn + ((size_t)b * SEQ + kpos) * 128 + hkv * 64, valid, qs, s);
#pragma unroll
            for (int g = 0; g < 4; ++g) { const float p = valid ? __expf(s[g]) : 0.f; l[g] += p; ps[g * 128 + lane] = p; }
            const int nk = j == cur ? (tau & 63) + 1 : 64;
            const bf16* vb = proj + ((size_t)b * SEQ + 64 * j) * NPROJ + PC_NVS + hkv * 64 + lane;
#pragma unroll 2
            for (int k = 0; k < nk; ++k) { const float vv = bf2f(vb[(size_t)k * NPROJ]);
#pragma unroll
                for (int g = 0; g < 4; ++g) o[g] = fmaf(ps[g * 128 + k], vv, o[g]); } }
#pragma unroll
        for (int g = 0; g < 4; ++g) { const float L = wave_sum(l[g]); ofin[g] += gate[g][1] * o[g] * (L > 0.f ? 1.f / L : 0.f); }
    }
    {
        float l[4] = {0.f, 0.f, 0.f, 0.f}, o[4] = {0.f, 0.f, 0.f, 0.f};
        const int start = tau - 511 > 0 ? tau - 511 : 0;
#pragma unroll 1
        for (int base = start & ~63; base <= tau; base += 64) {
            const int kpos = base + lane; const bool valid = kpos >= start && kpos <= tau; float s[4];
            nsa_scores(kwn + ((size_t)b * SEQ + kpos) * 128 + hkv * 64, valid, qs, s);
#pragma unroll
            for (int g = 0; g < 4; ++g) { const float p = valid ? __expf(s[g]) : 0.f; l[g] += p; ps[g * 128 + lane] = p; }
            const int k0 = start > base ? start - base : 0, k1 = tau - base < 63 ? tau - base : 63;
            const bf16* vb = proj + ((size_t)b * SEQ + base) * NPROJ + PC_NVW + hkv * 64 + lane;
#pragma unroll 2
            for (int k = k0; k <= k1; ++k) { const float vv = bf2f(vb[(size_t)k * NPROJ]);
#pragma unroll
                for (int g = 0; g < 4; ++g) o[g] = fmaf(ps[g * 128 + k], vv, o[g]); } }
#pragma unroll
        for (int g = 0; g < 4; ++g) { const float L = wave_sum(l[g]); ofin[g] += gate[g][2] * o[g] * (L > 0.f ? 1.f / L : 0.f); }
    }
#pragma unroll
    for (int g = 0; g < 4; ++g) H1[(size_t)t * 512 + (hkv * 4 + g) * 64 + lane] = (bf16)f2bf(ofin[g]);
}
DI void mem_wave(Frame& F, int t, LAS float* wl) {
    unsigned char* ws = F.ws; const int lane = F.lane; const int b = t >> 11;
    const bf16* mqn = (const bf16*)(ws + WS_MQN); const bf16* memkn = (const bf16*)(ws + WS_MEMKN); const bf16* memkv = (const bf16*)(ws + WS_MEMKV); bf16* H2 = (bf16*)(ws + WS_H2);
    LAS float* qs = wl;
    LAS float* ps = wl + 128;
#pragma unroll 1
    for (int h = 0; h < 4; ++h) {
        qs[lane] = bf2f(mqn[(size_t)t * 512 + h * 128 + lane]); qs[64 + lane] = bf2f(mqn[(size_t)t * 512 + h * 128 + 64 + lane]);
        float l = 0.f;
#pragma unroll 1
        for (int kq = 0; kq < 4; ++kq) { const int key = kq * 64 + lane; const bf16* kr = memkn + ((size_t)b * MEML + key) * 512 + h * 128; float s = 0.f;
#pragma unroll 2
            for (int c8 = 0; c8 < 16; ++c8) { const v4u kk = *(const v4u*)(kr + c8 * 8); const unsigned w[4] = {kk.x, kk.y, kk.z, kk.w};
#pragma unroll
                for (int j = 0; j < 4; ++j) s = fmaf(__uint_as_float(w[j] & 0xffff0000u), qs[c8 * 8 + 2 * j + 1], fmaf(__uint_as_float(w[j] << 16), qs[c8 * 8 + 2 * j], s)); }
            const float p = __expf(s); l += p; ps[key] = p; }
        const float inv = 1.f / wave_sum(l);
        float o0 = 0.f, o1 = 0.f;
        const bf16* vb = memkv + (size_t)b * MEML * 1024 + 512 + h * 128;
#pragma unroll 4
        for (int key = 0; key < MEML; ++key) { const float p = ps[key]; o0 = fmaf(p, bf2f(vb[(size_t)key * 1024 + lane]), o0); o1 = fmaf(p, bf2f(vb[(size_t)key * 1024 + 64 + lane]), o1); }
        H2[(size_t)t * 512 + h * 128 + lane] = (bf16)f2bf(o0 * inv); H2[(size_t)t * 512 + h * 128 + 64 + lane] = (bf16)f2bf(o1 * inv);
    }
}
DI void p5_mixers(Frame& F) {
    const int nml = F.G >= 128 ? 64 : 0;
#ifndef NO_ML
    if (F.bx < nml || nml == 0) { for (int u = F.bx; u < 64; u += (nml ? nml : F.G)) mlstm_unit(F, u); }
#endif
    if (F.bx >= nml) {
        LAS float* wl = (LAS float*)(F.lds + F.wave * 4096);
        const int gw = (F.bx - nml) * NWAVES + F.wave, NGW = (F.G - nml) * NWAVES;
#ifndef NO_NSA
        for (int it = gw; it < MT * 2; it += NGW) nsa_wave(F, it, wl);
#endif
#ifndef NO_MEM
        for (int t = gw; t < MT; t += NGW) mem_wave(F, t, wl);
#endif
    }
}

DI void p8_router(Frame& F) {
    unsigned char* ws = F.ws; const int lane = F.lane, tid = F.tid;
    bf16* xn2 = (bf16*)(ws + WS_R1);
    int* tok_e = (int*)(ws + WS_ROUTE + RT_TOKE); int* tok_pos = (int*)(ws + WS_ROUTE + RT_TOKPOS); float* tok_w = (float*)(ws + WS_ROUTE + RT_TOKW);
    unsigned* gcnt = F.ctl + CW_ECNT;
    LAS float* rowb = (LAS float*)(F.lds + F.wave * 4096);
    LAS int* lcnt = (LAS int*)(F.lds + 32768);
    LAS int* lbase = lcnt + 32;
    LAS int* se = lbase + 32;
    LAS int* sp = se + 512;
    LAS float* sw = (LAS float*)(sp + 512);
    const float* wr = F.in[I_WR]; const float* gf = F.in[I_GFFN];
    for (int bt = F.bx; bt < MT / 128; bt += F.G) {
        if (tid < 32) lcnt[tid] = 0;
        __syncthreads();
        for (int i = 0; i < 16; ++i) {
            const int tl = F.wave * 16 + i, t = bt * 128 + tl;
            const f32x4* xr = (const f32x4*)(F.out + (size_t)t * DM) + lane; const f32x4* gr = (const f32x4*)gf + lane;
            f32x4 v[4]; float s = 0.f;
#pragma unroll
            for (int j = 0; j < 4; ++j) { v[j] = xr[64 * j]; s += (v[j].x * v[j].x + v[j].y * v[j].y) + (v[j].z * v[j].z + v[j].w * v[j].w); }
            const float rstd = rsqrtf(wave_sum(s) * (1.f / DM) + EPS);
            unsigned long long* o8 = (unsigned long long*)(xn2 + (size_t)t * DM) + lane;
#pragma unroll
            for (int j = 0; j < 4; ++j) { const f32x4 gg = gr[64 * j]; f32x4 y; y.x = v[j].x * rstd * gg.x; y.y = v[j].y * rstd * gg.y; y.z = v[j].z * rstd * gg.z; y.w = v[j].w * rstd * gg.w;
                o8[64 * j] = (unsigned long long)pk2(y.x, y.y) | ((unsigned long long)pk2(y.z, y.w) << 32);
                *(LAS f32x4*)(rowb + 4 * lane + 256 * j) = y; }
            const int e = lane & 31, half = lane >> 5; float a = 0.f;
            for (int d = half * 512; d < half * 512 + 512; ++d) a = fmaf(rowb[d], wr[d * 32 + e], a);
            a += __shfl_xor(a, 32); a += F.in[I_BR][e];
            float sc = a; int ek[4]; float vk[4];
#pragma unroll
            for (int r = 0; r < 4; ++r) { const float mx = wave_max(sc); const unsigned long long bal = __ballot(sc == mx); const int win = (__ffsll((long long)bal) - 1) & 31;
                ek[r] = win; vk[r] = mx; if (e == win) sc = -3.4e38f; }
            const float e1 = __expf(vk[1] - vk[0]), e2 = __expf(vk[2] - vk[0]), e3 = __expf(vk[3] - vk[0]); const float inv = 1.f / (1.f + e1 + e2 + e3);
            if (lane == 0) {
                const float wk[4] = {inv, e1 * inv, e2 * inv, e3 * inv};
#pragma unroll
                for (int r = 0; r < 4; ++r) { se[tl * 4 + r] = ek[r]; sw[tl * 4 + r] = wk[r]; sp[tl * 4 + r] = atomicAdd((int*)&lcnt[ek[r]], 1); }
            }
        }
        __syncthreads();
        if (tid < 32) lbase[tid] = (int)atomicAdd(&gcnt[tid], (unsigned)lcnt[tid]);
        __syncthreads();
        { const int t = bt * 128 + (tid >> 2), k = tid & 3; const int e = se[tid];
          tok_e[t * 4 + k] = e; tok_pos[t * 4 + k] = lbase[e] + sp[tid]; tok_w[t * 4 + k] = sw[tid]; }
        __syncthreads();
    }
}
DI int moe_tables(Frame& F, LAS int* pstart, LAS unsigned char* blk_e) {
    unsigned* gcnt = F.ctl + CW_ECNT;
    __syncthreads();
    if (F.tid == 0) { int acc = 0; for (int e = 0; e < NEXP; ++e) { const int cnt = (int)__hip_atomic_load(&gcnt[e], __ATOMIC_RELAXED, __HIP_MEMORY_SCOPE_AGENT); pstart[e] = acc; acc += (cnt + MOEB - 1) / MOEB * MOEB; } pstart[NEXP] = acc; }
    __syncthreads();
    const int nblk = pstart[NEXP] / MOEB;
    for (int rb = F.tid; rb < nblk; rb += 512) { int e = 0; while (e < NEXP - 1 && pstart[e + 1] <= rb * MOEB) ++e; blk_e[rb] = (unsigned char)e; }
    __syncthreads();
    return nblk;
}
DI void p9_scatter(Frame& F) {
    unsigned char* ws = F.ws; const int lane = F.lane;
    LAS int* pstart = (LAS int*)(F.lds + 65536); LAS unsigned char* blk_e = (LAS unsigned char*)(F.lds + 65536 + 256);
    moe_tables(F, pstart, blk_e);
    const bf16* xn2 = (const bf16*)(ws + WS_R1); bf16* aperm = (bf16*)(ws + WS_APERM);
    const int* tok_e = (const int*)(ws + WS_ROUTE + RT_TOKE); const int* tok_pos = (const int*)(ws + WS_ROUTE + RT_TOKPOS); const float* tok_w = (const float*)(ws + WS_ROUTE + RT_TOKW);
    int* tok_dest = (int*)(ws + WS_ROUTE + RT_TOKDEST); float* roww = (float*)(ws + WS_ROUTE + RT_ROWW);
    unsigned* gcnt = F.ctl + CW_ECNT;
    const int gw = F.bx * NWAVES + F.wave, NGW = F.G * NWAVES;
    for (int it = gw; it < NROWS; it += NGW) {
        const int t = it >> 2; const int e = tok_e[it]; const int dest = pstart[e] + tok_pos[it];
        const v4u* src = (const v4u*)(xn2 + (size_t)t * DM); v4u* dst = (v4u*)(aperm + (size_t)dest * DM);
        dst[lane] = src[lane]; dst[64 + lane] = src[64 + lane];
        if (lane == 0) { tok_dest[it] = dest; roww[dest] = tok_w[it]; }
    }
    for (int it = gw; it < NEXP * MOEB; it += NGW) { const int e = it >> 8, i = it & 255; const int cnt = (int)__hip_atomic_load(&gcnt[e], __ATOMIC_RELAXED, __HIP_MEMORY_SCOPE_AGENT); const int padded = (cnt + MOEB - 1) / MOEB * MOEB;
        if (i < padded - cnt) { const int dest = pstart[e] + cnt + i; v4u* dst = (v4u*)(aperm + (size_t)dest * DM); const v4u z = {0u, 0u, 0u, 0u}; dst[lane] = z; dst[64 + lane] = z; if (lane == 0) roww[dest] = 0.f; } }
}
DI void p12_combine(Frame& F) {
    unsigned char* ws = F.ws; const int lane = F.lane;
    const bf16* ybuf = (const bf16*)(ws + WS_APERM); const int* tok_dest = (const int*)(ws + WS_ROUTE + RT_TOKDEST);
    const int gw = F.bx * NWAVES + F.wave, NGW = F.G * NWAVES;
    for (int t = gw; t < MT; t += NGW) {
        f32x4* orow = (f32x4*)(F.out + (size_t)t * DM);
        int d[4];
#pragma unroll
        for (int k = 0; k < 4; ++k) d[k] = tok_dest[t * 4 + k];
#pragma unroll
        for (int j = 0; j < 4; ++j) { f32x4 a = orow[lane + 64 * j];
#pragma unroll
            for (int k = 0; k < 4; ++k) { const unsigned long long w = *((const unsigned long long*)(ybuf + (size_t)d[k] * DM) + lane + 64 * j);
                a.x += __uint_as_float((unsigned)w << 16); a.y += __uint_as_float((unsigned)w & 0xffff0000u); a.z += __uint_as_float((unsigned)(w >> 32) << 16); a.w += __uint_as_float((unsigned)(w >> 32) & 0xffff0000u); }
            orow[lane + 64 * j] = a; }
    }
}

constexpr int N_PHASES = 13;
#ifndef MK_PER_PHASE
#define MK_PER_PHASE 1
#endif
__global__ void __launch_bounds__(NWAVES * 64, 2) fwd_kernel(Args args) {
    extern __shared__ __attribute__((aligned(16))) unsigned char lds_raw[];
    Frame F;
    F.lds = (LAS unsigned char*)lds_raw; F.MISC = (volatile LAS unsigned*)(F.lds + MISC_OFF);
    F.tid = threadIdx.x; F.lane = F.tid & 63; F.wave = __builtin_amdgcn_readfirstlane(F.tid >> 6); F.G = gridDim.x; F.bx = blockIdx.x;
    F.ws = args.ws; F.ctl = (unsigned*)(args.ws + WS_CTL); F.in = args.in; F.out = args.out;
    unsigned char* ws = args.ws;
    for (int u = F.tid; u < (LDS_BYTES - LDSCTL_OFF) / 4; u += NWAVES * 64) ((LAS unsigned*)(F.lds + LDSCTL_OFF))[u] = 0u;
    __syncthreads();
    const int lo = args.ph_lo, hi = args.ph_hi;
    XcdBarrier bar; bar.bar = F.ctl + CW_BAR; bar.x = 0; bar.st = nullptr;
    if (hi - lo > 1) bar = xcd_barrier_post(F.ctl + CW_BAR, F.MISC + 8);
#ifndef PH_MASK
#define PH_MASK 0x1fff
#endif
#define IN(k) (((PH_MASK >> (k)) & 1) && lo <= (k) && (k) < hi)
#define SEAM(k) do { if (IN(k) && IN((k) + 1)) xcd_barrier(bar); } while (0)
    typedef pg8::bf16_t b16;
    if (IN(0)) { p0_prologue(F); } SEAM(0);
    if (IN(1)) {
        { pg8::Gemm g{(const b16*)(ws + WS_R1), (const b16*)(ws + WS_WIN), MT, NPROJ, DM}; pg8::StaticOrder S; S.init(MT, NPROJ, F.G, F.bx);
          pg8::EpiBf16Silu E{(b16*)(ws + WS_PROJ), NPROJ, nullptr, 0};
          pg8::gemm_phase<pg8::EpiBf16Silu, pg8::StaticOrder, true, true>(F.lds, g, S, E); }
        { pg8::Gemm g{(const b16*)(ws + WS_MEMN), (const b16*)(ws + WS_WMKV), MROWS, 1024, DM}; pg8::StaticOrder S; S.init(MROWS, 1024, F.G, (F.bx + 64) % F.G);
          pg8::EpiBf16Silu E{(b16*)(ws + WS_MEMKV), 1024, nullptr, 0};
          pg8::gemm_phase<pg8::EpiBf16Silu, pg8::StaticOrder, true, true>(F.lds, g, S, E); }
    } SEAM(1);
    if (IN(2)) { p2_prep(F); } SEAM(2);
    if (IN(3)) {
#pragma unroll
        for (int kv = 0; kv < 2; ++kv) {
            pg8::Gemm g{(const b16*)(ws + WS_ACMP) + (size_t)kv * 4096 * 2048, (const b16*)(ws + WS_WC1) + (size_t)kv * 256 * 2048, 4096, 256, 2048}; pg8::StaticOrder S; S.init(4096, 256, F.G, (F.bx + F.G - 16 * kv) % F.G);
            pg8::EpiBf16Silu E{(b16*)(ws + WS_HID) + (size_t)kv * 4096 * 256, 256, (const float*)(ws + WS_SMALL + SM_CBIAS) + kv * 256, 1};
            pg8::gemm_phase<pg8::EpiBf16Silu, pg8::StaticOrder, true, true>(F.lds, g, S, E); }
    } SEAM(3);
    if (IN(4)) { p4_kcvc(F); } SEAM(4);
    if (IN(5)) { p5_mixers(F); } SEAM(5);
    if (IN(6)) {
        pg8::StaticOrder S; S.init(MT, DM, F.G, F.bx);
        { pg8::Gemm g{(const b16*)(ws + WS_H0), (const b16*)(ws + WS_WBR), MT, DM, 512}; pg8::EpiGate<0> E{(const b16*)(ws + WS_PROJ), F.out, (b16*)(ws + WS_R1)};
          pg8::gemm_phase<pg8::EpiGate<0>, pg8::StaticOrder, true, true>(F.lds, g, S, E); }
        { pg8::Gemm g{(const b16*)(ws + WS_H1), (const b16*)(ws + WS_WBR) + 1024 * 512, MT, DM, 512}; pg8::EpiGate<1> E{(const b16*)(ws + WS_PROJ), F.out, (b16*)(ws + WS_R1)};
          pg8::gemm_phase<pg8::EpiGate<1>, pg8::StaticOrder, true, true>(F.lds, g, S, E); }
        { pg8::Gemm g{(const b16*)(ws + WS_H2), (const b16*)(ws + WS_WBR) + 2 * 1024 * 512, MT, DM, 512}; pg8::EpiGate<2> E{(const b16*)(ws + WS_PROJ), F.out, (b16*)(ws + WS_R1)};
          pg8::gemm_phase<pg8::EpiGate<2>, pg8::StaticOrder, true, true>(F.lds, g, S, E); }
    } SEAM(6);
    if (IN(7)) {
        pg8::Gemm g{(const b16*)(ws + WS_R1), (const b16*)(ws + WS_WOUT), MT, DM, DM}; pg8::StaticOrder S; S.init(MT, DM, F.G, F.bx);
        pg8::EpiRes E{F.in[I_X], F.out};
        pg8::gemm_phase<pg8::EpiRes, pg8::StaticOrder, true, true>(F.lds, g, S, E);
    } SEAM(7);
    if (IN(8)) { p8_router(F); } SEAM(8);
    if (IN(9)) { p9_scatter(F); } SEAM(9);
    if (IN(10)) {
        LAS int* pstart = (LAS int*)(F.lds + RING_BYTES + 1024); LAS unsigned char* blk_e = (LAS unsigned char*)(F.lds + RING_BYTES + 1024 + 256);
        const int nblk = moe_tables(F, pstart, blk_e);
        pg8::Gemm g{(const b16*)(ws + WS_APERM), (const b16*)(ws + WS_WGU), CAP, NEXP * 2048, DM};
        pg8::MoeOrder<8> S{nblk * 8, F.G, F.bx, (const PG8_LAS unsigned char*)blk_e};
        pg8::EpiSwiglu E{(b16*)(ws + WS_ACT), F.in[I_BGU]};
        pg8::gemm_phase<pg8::EpiSwiglu, pg8::MoeOrder<8>, true, true>(F.lds, g, S, E);
    } SEAM(10);
    if (IN(11)) {
        LAS int* pstart = (LAS int*)(F.lds + RING_BYTES + 1024); LAS unsigned char* blk_e = (LAS unsigned char*)(F.lds + RING_BYTES + 1024 + 256);
        const int nblk = moe_tables(F, pstart, blk_e);
        pg8::Gemm g{(const b16*)(ws + WS_ACT), (const b16*)(ws + WS_WDN), CAP, NEXP * DM, DFF};
        pg8::MoeOrder<4> S{nblk * 4, F.G, F.bx, (const PG8_LAS unsigned char*)blk_e};
        pg8::EpiDown E{(b16*)(ws + WS_APERM), F.in[I_BDN], (const float*)(ws + WS_ROUTE + RT_ROWW)};
        pg8::gemm_phase<pg8::EpiDown, pg8::MoeOrder<4>, true, true>(F.lds, g, S, E);
    } SEAM(11);
    if (IN(12)) { p12_combine(F); }
#undef IN
#undef SEAM
}

extern "C" void kernel_launch(void* const* d_in, const int* in_sizes, int n_in, void* d_out, int out_size, void* d_ws, size_t ws_size, hipStream_t stream) {
    static int grid = 0;
    if (grid == 0) {
        if (n_in != N_IN || out_size != MT * DM || ws_size < WS_END) { fprintf(stderr, "kernel_launch: unexpected shapes (n_in %d, out %d, ws %zu need %zu)\n", n_in, out_size, ws_size, (size_t)WS_END); grid = -1; return; }
        int dev = 0, cus = 0, per_cu = 0;
        if (hipGetDevice(&dev) != hipSuccess || hipDeviceGetAttribute(&cus, hipDeviceAttributeMultiprocessorCount, dev) != hipSuccess) { grid = -1; return; }
        if (hipFuncSetAttribute((const void*)fwd_kernel, hipFuncAttributeMaxDynamicSharedMemorySize, LDS_BYTES) != hipSuccess) { fprintf(stderr, "kernel_launch: hipFuncSetAttribute failed\n"); grid = -1; return; }
        if (hipOccupancyMaxActiveBlocksPerMultiprocessor(&per_cu, (const void*)fwd_kernel, NWAVES * 64, LDS_BYTES) != hipSuccess || per_cu < 1) { fprintf(stderr, "kernel_launch: occupancy query says %d\n", per_cu); }
        (void)hipGetLastError();
        grid = cus;
    }
    if (grid < 0) return;
    if (hipMemsetAsync((char*)d_ws + WS_CTL, 0, CTL_ZERO_BYTES, stream) != hipSuccess) return;
    Args a{};
    for (int i = 0; i < N_IN; ++i) a.in[i] = (const float*)d_in[i];
    a.out = (float*)d_out; a.ws = (unsigned char*)d_ws;
#if MK_PER_PHASE
    for (int p = 0; p < N_PHASES; ++p) { a.ph_lo = p; a.ph_hi = p + 1; a.li = 0; hipLaunchKernelGGL(fwd_kernel, dim3(grid), dim3(NWAVES * 64), LDS_BYTES, stream, a); }
#else
    a.ph_lo = 0; a.ph_hi = N_PHASES; a.li = 0;
    hipLaunchKernelGGL(fwd_kernel, dim3(grid), dim3(NWAVES * 64), LDS_BYTES, stream, a);
#endif
}
```

```cpp
#include <hip/hip_runtime.h>
#include <cstdio>
#include <cstdint>
namespace pg8 {
#define PG8_LAS __attribute__((address_space(3)))
typedef unsigned short bf16_t;
typedef short bf16x8 __attribute__((ext_vector_type(8)));
typedef float f32x4 __attribute__((ext_vector_type(4)));
typedef unsigned u32x4 __attribute__((ext_vector_type(4)));
constexpr int BM = 256, BK = 64, HALF = 128, HTB = HALF * BK * 2  , STAGE_BYTES = 8 * HTB, NXCD = 8, WGM = 8;

__host__ __device__ __forceinline__ int lds_byte(int r, int c) { const int st = (r >> 4) * 2 + (c >> 5), rr = r & 15, cc = c & 31, ob = rr * 64 + cc * 2; return st * 1024 + (ob ^ (((ob >> 9) & 1) << 5)); }
__host__ __device__ __forceinline__ void stage_rc(int b, int& R, int& C) { const int st = b / 1024, sb = b % 1024, swz = sb ^ (((sb >> 9) & 1) << 5); R = (st >> 1) * 16 + swz / 64; C = (st & 1) * 32 + (swz % 64) / 2; }
__host__ __device__ __forceinline__ int perm32(int rho) { const int n = rho >> 4, i = rho & 15; return 8 * (i >> 2) + 4 * n + (i & 3); }

struct Unit { int pm, pn; };
struct Gemm { const bf16_t* A; const bf16_t* Bt; int M, N, K; };

struct StaticOrder {
    int nM, nN, nwg, G, c;
    __host__ __device__ void init(int M, int N, int G_, int c_) { nM = M / BM; nN = N / BM; nwg = nM * nN; G = G_; c = c_; }
    __host__ __device__ bool next(int i, Unit& u) const {
        const long L = (long)i * G + c; if (L >= nwg) return false;
        int wgid = (int)L; { const int q = nwg / NXCD, r = nwg % NXCD, xcd = wgid % NXCD, off = wgid / NXCD; wgid = (xcd < r ? xcd * (q + 1) : r * (q + 1) + (xcd - r) * q) + off; }
        const int nig = WGM * nN, gid = wgid / nig, fm = gid * WGM, gsz = (nM - fm) < WGM ? (nM - fm) : WGM;
        u.pm = fm + ((wgid % nig) % gsz); u.pn = (wgid % nig) / gsz; return true;
    }
    __device__ __forceinline__ void a_ready(const Unit&) const {}
    __device__ __forceinline__ void done(const Unit&) const {}
};

__device__ __forceinline__ unsigned cvt_pk_bf16(float lo, float hi) { unsigned r; asm volatile("v_cvt_pk_bf16_f32 %0, %1, %2" : "=v"(r) : "v"(lo), "v"(hi)); return r; }
typedef float f32x2 __attribute__((ext_vector_type(2)));
__device__ __forceinline__ f32x2 gelu_pk(f32x2 v) {
    const f32x2 av = __builtin_elementwise_abs(v), d = av * 0.2316418882f + 1.0f;
    f32x2 t; t.x = __builtin_amdgcn_rcpf(d.x); t.y = __builtin_amdgcn_rcpf(d.y);
    f32x2 q = t * 0.5307027145f + (-0.7265760135f); q = q * t + 0.7107068705f; q = q * t + (-0.142248368f); q = q * t + 0.127414796f; q = q * t;
    const f32x2 s = (v * v) * (-0.72134752044f);
    f32x2 e; e.x = __builtin_amdgcn_exp2f(s.x); e.y = __builtin_amdgcn_exp2f(s.y);
    const f32x2 m = v * (q * e), r = v - m;
    f32x2 o; o.x = v.x < 0.f ? m.x : r.x; o.y = v.y < 0.f ? m.y : r.y; return o;
}

template <int ACT  > struct EpiBf16 {
    static constexpr bool PERM = true, AFTER_DRAIN = false; static_assert(ACT == 0 || ACT == 1, "EpiBf16: ACT is 0 (none) or 1 (gelu_pk)");
    bf16_t* O; int ldc; const float* bias; int split_cols; size_t split_stride; float scale0;
    __device__ __forceinline__ void operator()(const f32x4 (&acc)[2][2][4][2], const Unit& u, int wr, int wc, int fr, int fq) const {
        const int row0 = u.pm * BM + wr * 64 + fr; int colt = u.pn * BM; bf16_t* base = O;
        float sc = 1.f; if (split_cols) { const int t = colt / split_cols; base += (size_t)t * split_stride; colt -= t * split_cols; if (t == 0) sc = scale0; }
        const int col0 = colt + wc * 32 + 8 * fq, bcol0 = u.pn * BM + wc * 32 + 8 * fq;
        f32x4 bv[2][2];
#pragma unroll
        for (int bj = 0; bj < 2; ++bj)
#pragma unroll
            for (int n = 0; n < 2; ++n) bv[bj][n] = bias ? *(const f32x4*)(bias + bcol0 + bj * HALF + 4 * n) : (f32x4){0.f, 0.f, 0.f, 0.f};
#pragma unroll
        for (int ai = 0; ai < 2; ++ai)
#pragma unroll
            for (int m = 0; m < 4; ++m) { bf16_t* rowp = base + (size_t)(row0 + ai * HALF + m * 16) * ldc + col0;
#pragma unroll
                for (int bj = 0; bj < 2; ++bj) { f32x4 v0 = acc[ai][bj][m][0] + bv[bj][0], v1 = acc[ai][bj][m][1] + bv[bj][1];
                    if (ACT == 1) { f32x2 a = gelu_pk((f32x2){v0[0], v0[1]}), b = gelu_pk((f32x2){v0[2], v0[3]}), c = gelu_pk((f32x2){v1[0], v1[1]}), d = gelu_pk((f32x2){v1[2], v1[3]});
                        v0 = (f32x4){a.x, a.y, b.x, b.y}; v1 = (f32x4){c.x, c.y, d.x, d.y}; }
                    v0 = v0 * sc; v1 = v1 * sc; u32x4 w; w.x = cvt_pk_bf16(v0[0], v0[1]); w.y = cvt_pk_bf16(v0[2], v0[3]); w.z = cvt_pk_bf16(v1[0], v1[1]); w.w = cvt_pk_bf16(v1[2], v1[3]);
                    *(u32x4*)(rowp + bj * HALF) = w; } }
    }
};

struct PanelStats {
    unsigned* xbuf;
    unsigned* cnt;
    unsigned* tmo;
    int ntn; float eps;
    unsigned code;
    __device__ __forceinline__ bool run(const f32x4 (&v)[2][2][4][2], const Unit& u, int wr, int wc, int fr, int fq, PG8_LAS unsigned char* lds, int wid, int lane) const {
        typedef float f32x2v __attribute__((ext_vector_type(2)));
        PG8_LAS f32x2v* P = (PG8_LAS f32x2v*)lds;
        PG8_LAS f32x2v* S = (PG8_LAS f32x2v*)(lds + 8192);
        PG8_LAS unsigned* flag = (PG8_LAS unsigned*)(lds + 8192 + 2048);
#pragma unroll
        for (int ai = 0; ai < 2; ++ai)
#pragma unroll
            for (int m = 0; m < 4; ++m) {
                float s = 0.f;
#pragma unroll
                for (int bj = 0; bj < 2; ++bj)
#pragma unroll
                    for (int n = 0; n < 2; ++n) { const f32x4 x = v[ai][bj][m][n]; s += (x[0] + x[1]) + (x[2] + x[3]); }
                s += __shfl_xor(s, 16); s += __shfl_xor(s, 32);
                const float mw = s * (1.0f / 64.0f); float q = 0.f;
#pragma unroll
                for (int bj = 0; bj < 2; ++bj)
#pragma unroll
                    for (int n = 0; n < 2; ++n) { const f32x4 d = v[ai][bj][m][n] - mw; q += (d[0] * d[0] + d[1] * d[1]) + (d[2] * d[2] + d[3] * d[3]); }
                q += __shfl_xor(q, 16); q += __shfl_xor(q, 32);
                if (fq == 0) P[(ai * HALF + wr * 64 + m * 16 + fr) * 4 + wc] = (f32x2v){mw, q};
            }
        asm volatile("s_waitcnt lgkmcnt(0)" ::: "memory"); __builtin_amdgcn_s_barrier(); asm volatile("" ::: "memory");
#if defined(BROKEN_EXCHANGE_NO_WAIT)
#warning BROKEN CONTROL BUILD: the row-statistics exchange does not wait; results are wrong by design
        if (blockIdx.x >= 64) { const long long t0_ = clock64(); while (clock64() - t0_ < 60000) __builtin_amdgcn_s_sleep(8); }
#endif
        const int row = wid * 32 + (lane & 31);
        if (lane < 32) {
            const f32x2v a = P[row * 4 + 0], b = P[row * 4 + 1], c = P[row * 4 + 2], d = P[row * 4 + 3];
            const float mt = (a.x + b.x + c.x + d.x) * 0.25f;
            const float da = a.x - mt, db = b.x - mt, dc = c.x - mt, dd = d.x - mt;
            const float m2 = (a.y + b.y) + (c.y + d.y) + 64.0f * ((da * da + db * db) + (dc * dc + dd * dd));
            unsigned long long* slot = (unsigned long long*)xbuf + ((size_t)(u.pm * BM + row) * 4 + u.pn);
            __hip_atomic_store(slot, ((unsigned long long)__float_as_uint(m2) << 32) | __float_as_uint(mt), __ATOMIC_RELAXED, __HIP_MEMORY_SCOPE_AGENT);
        }
        asm volatile("s_waitcnt vmcnt(0)" ::: "memory");
        if (lane == 0) __hip_atomic_fetch_add(cnt + 64 * u.pm, 1u, __ATOMIC_RELAXED, __HIP_MEMORY_SCOPE_AGENT);
        if (wid == 0) {
            bool dead = false; const unsigned long long t0 = __builtin_amdgcn_s_memrealtime(); const unsigned want = 8u * (unsigned)ntn;
            for (;;) {
#if defined(BROKEN_EXCHANGE_NO_WAIT)
                break;
#endif
                if ((unsigned)__builtin_amdgcn_readfirstlane(__hip_atomic_load(cnt + 64 * u.pm, __ATOMIC_RELAXED, __HIP_MEMORY_SCOPE_AGENT)) >= want) break;
                if (__builtin_amdgcn_s_memrealtime() - t0 > 2000000ull) {
                    if (lane == 0) { unsigned expect = 0u; __hip_atomic_compare_exchange_strong(tmo + 1, &expect, code | (unsigned)(u.pm & 0xff), __ATOMIC_RELAXED, __ATOMIC_RELAXED, __HIP_MEMORY_SCOPE_AGENT);
                                     __hip_atomic_store(tmo, 1u, __ATOMIC_RELAXED, __HIP_MEMORY_SCOPE_AGENT); }
                    dead = true; break; }
                __builtin_amdgcn_s_sleep(2);
            }
            __builtin_amdgcn_fence(__ATOMIC_ACQUIRE, "agent");
            if (lane == 0) flag[0] = dead ? 1u : 0u;
        }
        asm volatile("s_waitcnt vmcnt(0) lgkmcnt(0)" ::: "memory"); __builtin_amdgcn_s_barrier(); asm volatile("" ::: "memory");
        const bool bad = flag[0] != 0u;
        if (lane < 32) {
            const unsigned long long* slot = (const unsigned long long*)xbuf + (size_t)(u.pm * BM + row) * 4; float mt[4], m2[4]; float ms = 0.f;
#pragma unroll
            for (int t = 0; t < 4; ++t) { if (t < ntn) { const unsigned long long w = __hip_atomic_load(slot + t, __ATOMIC_RELAXED, __HIP_MEMORY_SCOPE_AGENT); mt[t] = __uint_as_float((unsigned)w); m2[t] = __uint_as_float((unsigned)(w >> 32)); } else { mt[t] = 0.f; m2[t] = 0.f; } ms += mt[t]; }
            const float mean = ms / (float)ntn; float q = 0.f;
#pragma unroll
            for (int t = 0; t < 4; ++t) if (t < ntn) { const float dm = mt[t] - mean; q += m2[t] + 256.0f * dm * dm; }
            S[row] = (f32x2v){mean, 1.0f / sqrtf(q / (256.0f * (float)ntn) + eps)};
        }
        asm volatile("s_waitcnt lgkmcnt(0)" ::: "memory"); __builtin_amdgcn_s_barrier(); asm volatile("" ::: "memory");
        return bad;
    }
};
struct EpiLnRes {
    static constexpr bool PERM = false, AFTER_DRAIN = true;
    const float* base; float* out; int ldc; const float* bias; PanelStats st; unsigned poison;
    __device__ __forceinline__ void fused(f32x4 (&acc)[2][2][4][2], const Unit& u, int wr, int wc, int fr, int fq, PG8_LAS unsigned char* lds, int wid, int lane) const {
        typedef float f32x2v __attribute__((ext_vector_type(2)));
        const PG8_LAS f32x2v* S = (const PG8_LAS f32x2v*)(lds + 8192);
        const int col0 = u.pn * BM + wc * 32 + 4 * fq;
#pragma unroll
        for (int bj = 0; bj < 2; ++bj)
#pragma unroll
            for (int n = 0; n < 2; ++n) { const f32x4 bv = bias ? *(const f32x4*)(bias + col0 + bj * HALF + n * 16) : (f32x4){0.f, 0.f, 0.f, 0.f};
#pragma unroll
                for (int ai = 0; ai < 2; ++ai)
#pragma unroll
                    for (int m = 0; m < 4; ++m) acc[ai][bj][m][n] += bv; }
        f32x4 pre[4][2][2];
#pragma unroll
        for (int m = 0; m < 4; ++m) { const size_t off = (size_t)(u.pm * BM + wr * 64 + m * 16 + fr) * ldc + col0;
#pragma unroll
            for (int bj = 0; bj < 2; ++bj)
#pragma unroll
                for (int n = 0; n < 2; ++n) pre[m][bj][n] = *(const f32x4*)(base + off + bj * HALF + n * 16); }
        const bool bad = st.run(acc, u, wr, wc, fr, fq, lds, wid, lane) || poison != 0u;
        const float qnan = __builtin_nanf("");
#pragma unroll
        for (int ai = 0; ai < 2; ++ai)
#pragma unroll
            for (int m = 0; m < 4; ++m) { const int r = ai * HALF + wr * 64 + m * 16 + fr; const f32x2v sr = S[r]; const size_t off = (size_t)(u.pm * BM + r) * ldc + col0;
#pragma unroll
                for (int bj = 0; bj < 2; ++bj)
#pragma unroll
                    for (int n = 0; n < 2; ++n) { const f32x4 bs = ai == 0 ? pre[m][bj][n] : *(const f32x4*)(base + off + bj * HALF + n * 16); f32x4 o = bs + (acc[ai][bj][m][n] - sr.x) * sr.y;
                        if (bad) o = (f32x4){qnan, qnan, qnan, qnan}; *(f32x4*)(out + off + bj * HALF + n * 16) = o; }
                if (m & 1) asm volatile("" ::: "memory"); }
    }
};
struct EpiLnResLn {
    static constexpr bool PERM = false, AFTER_DRAIN = true;
    const float* base; float* out; bf16_t* xn; int ldc; const float* bias; PanelStats st1, st2; unsigned poison;
    __device__ __forceinline__ void fused(f32x4 (&acc)[2][2][4][2], const Unit& u, int wr, int wc, int fr, int fq, PG8_LAS unsigned char* lds, int wid, int lane) const {
        typedef float f32x2v __attribute__((ext_vector_type(2))); typedef unsigned u32x2v __attribute__((ext_vector_type(2)));
        const PG8_LAS f32x2v* S = (const PG8_LAS f32x2v*)(lds + 8192);
        const int col0 = u.pn * BM + wc * 32 + 4 * fq;
#pragma unroll
        for (int bj = 0; bj < 2; ++bj)
#pragma unroll
            for (int n = 0; n < 2; ++n) { const f32x4 bv = bias ? *(const f32x4*)(bias + col0 + bj * HALF + n * 16) : (f32x4){0.f, 0.f, 0.f, 0.f};
#pragma unroll
                for (int ai = 0; ai < 2; ++ai)
#pragma unroll
                    for (int m = 0; m < 4; ++m) acc[ai][bj][m][n] += bv; }
        bool bad = st1.run(acc, u, wr, wc, fr, fq, lds, wid, lane) || poison != 0u;
        const float qnan = __builtin_nanf("");
#pragma unroll
        for (int ai = 0; ai < 2; ++ai)
#pragma unroll
            for (int m = 0; m < 4; ++m) { const int r = ai * HALF + wr * 64 + m * 16 + fr; const f32x2v sr = S[r]; const size_t off = (size_t)(u.pm * BM + r) * ldc + col0;
#pragma unroll
                for (int bj = 0; bj < 2; ++bj)
#pragma unroll
                    for (int n = 0; n < 2; ++n) { const f32x4 bs = *(const f32x4*)(base + off + bj * HALF + n * 16); acc[ai][bj][m][n] = bs + (acc[ai][bj][m][n] - sr.x) * sr.y; }
                asm volatile("" : "+v"(acc[ai][0][m][0]), "+v"(acc[ai][0][m][1]), "+v"(acc[ai][1][m][0]), "+v"(acc[ai][1][m][1]));
                if (m & 1) asm volatile("" ::: "memory"); }
        const bool bad1 = bad;
        bad = st2.run(acc, u, wr, wc, fr, fq, lds, wid, lane) || bad;
#pragma unroll
        for (int ai = 0; ai < 2; ++ai)
#pragma unroll
            for (int m = 0; m < 4; ++m) { const int r = ai * HALF + wr * 64 + m * 16 + fr; const f32x2v sr = S[r]; const size_t off = (size_t)(u.pm * BM + r) * ldc + col0;
#pragma unroll
                for (int bj = 0; bj < 2; ++bj)
#pragma unroll
                    for (int n = 0; n < 2; ++n) { const f32x4 x1 = acc[ai][bj][m][n]; *(f32x4*)(out + off + bj * HALF + n * 16) = bad1 ? (f32x4){qnan, qnan, qnan, qnan} : x1;
                        const f32x4 o = (x1 - sr.x) * sr.y; u32x2v w; w.x = cvt_pk_bf16(o[0], o[1]); w.y = cvt_pk_bf16(o[2], o[3]);
                        if (bad) { w.x = 0x7fc07fc0u; w.y = 0x7fc07fc0u; } *(u32x2v*)(xn + off + bj * HALF + n * 16) = w; }
                asm volatile("" ::: "memory"); }
    }
};

template <class Epi, class Sched, bool ALIGN_EPI = false, bool SP2 = false>
__device__ __forceinline__ void gemm_phase(PG8_LAS unsigned char* lds, const Gemm g, const Sched& S, const Epi& E) {
    const int tid = threadIdx.x, wid = __builtin_amdgcn_readfirstlane(tid >> 6), lane = tid & 63, wr = wid >> 2, wc = wid & 3, fr = lane & 15, fq = lane >> 4;
    const int K = g.K, nt = K / BK;
    unsigned voffA[2], voffB[2];
#pragma unroll
    for (int i = 0; i < 2; ++i) { int R, C; stage_rc(tid * 16 + i * 8192, R, C); const int Rb = Epi::PERM ? ((R & ~31) + perm32(R & 31)) : R;
        voffA[i] = (unsigned)(R * K + C) * 2u; voffB[i] = (unsigned)(Rb * K + C) * 2u; }
    const size_t kstep = (size_t)(BK * 2);
    const size_t hstep = (size_t)HALF * K * 2;
    const size_t tstep = 2 * hstep;
    const unsigned ldsw = (unsigned)wid * 1024u;
    const int aoff = lds_byte(wr * 64 + fr, fq * 8), boff = lds_byte(wc * 32 + fr, fq * 8);
#define PG8_SA(b, h) (((b) * 2 + (h)) * HTB)
#define PG8_SB(b, h) ((4 + (b) * 2 + (h)) * HTB)
#define PG8_STAGE(bufoff, gbase, voff) do { _Pragma("unroll") for (int _i = 0; _i < 2; ++_i) \
        __builtin_amdgcn_global_load_lds((const unsigned*)((const char*)(gbase) + (voff)[_i]), (PG8_LAS unsigned*)(lds + (bufoff) + ldsw + _i * 8192), 16, 0, 0); } while (0)
#define PG8_LDA(dst, b, h) do { _Pragma("unroll") for (int m = 0; m < 4; ++m) _Pragma("unroll") for (int k = 0; k < 2; ++k) dst[m][k] = *(const PG8_LAS bf16x8*)(lds + PG8_SA(b, h) + aoff + m * 2048 + k * 1024); } while (0)
#define PG8_LDB(dst, b, h) do { _Pragma("unroll") for (int n = 0; n < 2; ++n) _Pragma("unroll") for (int k = 0; k < 2; ++k) dst[n][k] = *(const PG8_LAS bf16x8*)(lds + PG8_SB(b, h) + boff + n * 2048 + k * 1024); } while (0)
#define PG8_MMA(ai, bj, At, Bt) do { __builtin_amdgcn_s_setprio(1); _Pragma("unroll") for (int m = 0; m < 4; ++m) _Pragma("unroll") for (int n = 0; n < 2; ++n) _Pragma("unroll") for (int k = 0; k < 2; ++k) \
        acc[ai][bj][m][n] = __builtin_amdgcn_mfma_f32_16x16x32_bf16(Bt[n][k], At[m][k], acc[ai][bj][m][n], 0, 0, 0); __builtin_amdgcn_s_setprio(0); } while (0)
#define PG8_WAIT_V(n) asm volatile("s_waitcnt vmcnt(" #n ")" ::: "memory")
#define PG8_WAIT_L(n) asm volatile("s_waitcnt lgkmcnt(" #n ")" ::: "memory")
#define PG8_BAR __builtin_amdgcn_s_barrier()
#define PG8_SCHED __builtin_amdgcn_sched_barrier(0)
    Unit cur, nxt; int ui = 0;
    if (!S.next(0, cur)) return;
    f32x4 acc[2][2][4][2];
#pragma unroll
    for (int a = 0; a < 2; ++a)
#pragma unroll
        for (int b = 0; b < 2; ++b)
#pragma unroll
            for (int m = 0; m < 4; ++m)
#pragma unroll
                for (int n = 0; n < 2; ++n) acc[a][b][m][n] = (f32x4){0.f, 0.f, 0.f, 0.f};
    bf16x8 At[4][2], B0[2][2], B1[2][2];
    const char* cA = (const char*)g.A + (size_t)cur.pm * tstep; const char* cB = (const char*)g.Bt + (size_t)cur.pn * tstep;
    S.a_ready(cur);
    if constexpr (SP2) {
        PG8_STAGE(PG8_SB(0, 0), cB, voffB); PG8_STAGE(PG8_SB(0, 1), cB + hstep, voffB); PG8_STAGE(PG8_SA(0, 0), cA, voffA); PG8_STAGE(PG8_SA(0, 1), cA + hstep, voffA);
        if (wr == 1) PG8_BAR;
        PG8_WAIT_V(2); PG8_BAR;
        PG8_STAGE(PG8_SB(1, 0), cB + kstep, voffB); PG8_STAGE(PG8_SA(1, 0), cA + kstep, voffA); PG8_STAGE(PG8_SB(1, 1), cB + hstep + kstep, voffB);
        PG8_WAIT_V(6); PG8_BAR;
    } else {
        PG8_STAGE(PG8_SB(0, 0), cB, voffB); PG8_STAGE(PG8_SA(0, 0), cA, voffA); PG8_STAGE(PG8_SB(0, 1), cB + hstep, voffB); PG8_STAGE(PG8_SA(0, 1), cA + hstep, voffA);
        if (wr == 1) PG8_BAR;
        PG8_WAIT_V(4); PG8_BAR;
        PG8_STAGE(PG8_SB(1, 0), cB + kstep, voffB); PG8_STAGE(PG8_SA(1, 0), cA + kstep, voffA); PG8_STAGE(PG8_SB(1, 1), cB + hstep + kstep, voffB);
        PG8_WAIT_V(6); PG8_BAR;
    }
    for (;;) {
        const bool has_next = S.next(ui + 1, nxt);
        const char* nA = has_next ? (const char*)g.A + (size_t)nxt.pm * tstep : cA; const char* nB = has_next ? (const char*)g.Bt + (size_t)nxt.pn * tstep : cB;
        for (int t = 0; t < nt; t += 2) {
            const bool last = (t == nt - 2);
            const char* a1 = cA + (size_t)(t + 1) * kstep;
            const char* a2 = last ? nA : cA + (size_t)(t + 2) * kstep; const char* b2 = last ? nB : cB + (size_t)(t + 2) * kstep;
            const char* a3 = a2 + kstep; const char* b3 = b2 + kstep;
            if (last && has_next) S.a_ready(nxt);
            if constexpr (SP2) {
            PG8_LDB(B0, 0, 0); PG8_LDB(B1, 0, 1); PG8_SCHED; PG8_LDA(At, 0, 0); PG8_STAGE(PG8_SA(1, 1), a1 + hstep, voffA);
            PG8_WAIT_V(8); PG8_WAIT_L(0); PG8_BAR; PG8_MMA(0, 0, At, B0); PG8_MMA(0, 1, At, B1); PG8_BAR; PG8_SCHED;
            PG8_LDA(At, 0, 1); PG8_STAGE(PG8_SB(0, 0), b2, voffB); PG8_STAGE(PG8_SB(0, 1), b2 + hstep, voffB); PG8_STAGE(PG8_SA(0, 0), a2, voffA);
            PG8_WAIT_V(8); PG8_WAIT_L(0); PG8_BAR; PG8_MMA(1, 0, At, B0); PG8_MMA(1, 1, At, B1); PG8_BAR; PG8_SCHED;
            PG8_LDB(B0, 1, 0); PG8_LDB(B1, 1, 1); PG8_SCHED; PG8_LDA(At, 1, 0); PG8_STAGE(PG8_SA(0, 1), a2 + hstep, voffA);
            PG8_WAIT_V(8); PG8_WAIT_L(0); PG8_BAR; PG8_MMA(0, 0, At, B0); PG8_MMA(0, 1, At, B1); PG8_BAR; PG8_SCHED;
            PG8_LDA(At, 1, 1); PG8_STAGE(PG8_SB(1, 0), b3, voffB); PG8_STAGE(PG8_SB(1, 1), b3 + hstep, voffB); PG8_STAGE(PG8_SA(1, 0), a3, voffA);
            PG8_WAIT_V(8); PG8_WAIT_L(0); PG8_BAR; PG8_MMA(1, 0, At, B0); PG8_MMA(1, 1, At, B1); PG8_BAR; PG8_SCHED;
            } else {
            PG8_LDB(B0, 0, 0); PG8_SCHED; PG8_LDA(At, 0, 0); PG8_STAGE(PG8_SA(1, 1), a1 + hstep, voffA);
            PG8_WAIT_L(8); PG8_BAR; PG8_WAIT_L(0); PG8_MMA(0, 0, At, B0); PG8_BAR; PG8_SCHED;
            PG8_LDB(B1, 0, 1); PG8_STAGE(PG8_SB(0, 0), b2, voffB);
            PG8_BAR; PG8_WAIT_L(0); PG8_MMA(0, 1, At, B1); PG8_BAR;
            PG8_LDA(At, 0, 1); PG8_STAGE(PG8_SA(0, 0), a2, voffA);
            PG8_BAR; PG8_WAIT_L(0); PG8_MMA(1, 0, At, B0); PG8_BAR; PG8_SCHED;
            PG8_STAGE(PG8_SB(0, 1), b2 + hstep, voffB);
            PG8_WAIT_V(6); PG8_BAR; PG8_MMA(1, 1, At, B1); PG8_BAR;
            PG8_LDB(B0, 1, 0); PG8_SCHED; PG8_LDA(At, 1, 0); PG8_STAGE(PG8_SA(0, 1), a2 + hstep, voffA);
            PG8_WAIT_L(8); PG8_BAR; PG8_WAIT_L(0); PG8_MMA(0, 0, At, B0); PG8_BAR; PG8_SCHED;
            PG8_LDB(B1, 1, 1); PG8_STAGE(PG8_SB(1, 0), b3, voffB);
            PG8_BAR; PG8_WAIT_L(0); PG8_MMA(0, 1, At, B1); PG8_BAR;
            PG8_LDA(At, 1, 1); PG8_STAGE(PG8_SA(1, 0), a3, voffA);
            PG8_BAR; PG8_WAIT_L(0); PG8_MMA(1, 0, At, B0); PG8_BAR; PG8_SCHED;
            PG8_STAGE(PG8_SB(1, 1), b3 + hstep, voffB);
            PG8_WAIT_V(6); PG8_BAR; PG8_MMA(1, 1, At, B1); PG8_BAR;
            }
        }
        if constexpr (ALIGN_EPI) { if (wr == 0) PG8_BAR; }
        if constexpr (!Epi::AFTER_DRAIN) { E(acc, cur, wr, wc, fr, fq); S.done(cur); }
        if (!has_next) break;
#pragma unroll
        for (int a = 0; a < 2; ++a)
#pragma unroll
            for (int b = 0; b < 2; ++b)
#pragma unroll
                for (int m = 0; m < 4; ++m)
#pragma unroll
                    for (int n = 0; n < 2; ++n) acc[a][b][m][n] = (f32x4){0.f, 0.f, 0.f, 0.f};
        cur = nxt; cA = nA; cB = nB; ++ui;
        if constexpr (ALIGN_EPI) { if (wr == 1) PG8_BAR; }
    }
    PG8_WAIT_V(0);
    if constexpr (!ALIGN_EPI) { if (wr == 0) PG8_BAR; }
    PG8_BAR;
    if constexpr (Epi::AFTER_DRAIN) { E.fused(acc, cur, wr, wc, fr, fq, lds, wid, lane); S.done(cur); }
#undef PG8_SA
#undef PG8_SB
#undef PG8_STAGE
#undef PG8_LDA
#undef PG8_LDB
#undef PG8_MMA
#undef PG8_WAIT_V
#undef PG8_WAIT_L
#undef PG8_BAR
#undef PG8_SCHED
}
}
#define GAS __attribute__((address_space(1)))
#define LAS __attribute__((address_space(3)))
typedef unsigned short bf16;
typedef unsigned v4u __attribute__((ext_vector_type(4)));
typedef float f32x4 __attribute__((ext_vector_type(4)));
typedef short bf16x8 __attribute__((ext_vector_type(8)));
typedef GAS unsigned gu32;
typedef GAS unsigned long long gu64;
#define RLX_AGENT __ATOMIC_RELAXED, __HIP_MEMORY_SCOPE_AGENT
#define LDS_WAIT() asm volatile("s_waitcnt lgkmcnt(0)" ::: "memory")
#define VM_WAIT() asm volatile("s_waitcnt vmcnt(0)" ::: "memory")
__device__ __forceinline__ unsigned long long rt() { return __builtin_amdgcn_s_memrealtime(); }
__device__ __forceinline__ unsigned f2bf(float f) { unsigned u = __builtin_bit_cast(unsigned, f); return (u + 0x7fffu + ((u >> 16) & 1u)) >> 16; }
__device__ __forceinline__ unsigned pk2(float lo, float hi) { return f2bf(lo) | (f2bf(hi) << 16); }

#define XB_TMO      128
#define XB_XCNT(j)  (256  + 64 * (j))
#define XB_XSUB(j)  (1280 + 64 * (j))
#define XB_XGEN(j)  (2304 + 64 * (j))
#define XB_TOP      3328
#define XB_TOPGEN   3392
#define XCD_BAR_WORDS 3456
#define XB_SPIN_CAP (1u << 18)

__device__ __forceinline__ unsigned xb_ld(unsigned* p)              { return __hip_atomic_load(p, __ATOMIC_RELAXED, __HIP_MEMORY_SCOPE_AGENT); }
__device__ __forceinline__ unsigned xb_add(unsigned* p, unsigned v) { return __hip_atomic_fetch_add(p, v, __ATOMIC_RELAXED, __HIP_MEMORY_SCOPE_AGENT); }
__device__ __forceinline__ unsigned xb_xcc_id() { return (unsigned)__builtin_amdgcn_s_getreg((3 << 11) | 20) & 0xFu; }
#define XB_SPIN(cond, bar) do { unsigned _sp = 0; while (cond) { __builtin_amdgcn_s_sleep(1); \
    if ((++_sp & 255u) == 0u) { if (xb_ld(&(bar)[XB_TMO])) break; if (_sp > XB_SPIN_CAP) { atomicAdd(&(bar)[XB_TMO], 1u); break; } } } } while (0)

struct XcdBarrier {
    unsigned* bar; unsigned x;
    volatile LAS unsigned* st;
};

__device__ __forceinline__ XcdBarrier xcd_barrier_post(unsigned* bar, volatile LAS unsigned* st) {
    XcdBarrier b; b.bar = bar; b.x = xb_xcc_id(); b.st = st;
    if (threadIdx.x == 0) (void)xb_add(&bar[XB_XCNT(b.x)], 1u);
    return b;
}
__device__ __forceinline__ void xcd_barrier_complete(unsigned* bar, unsigned x, unsigned& nloc, unsigned& nx) {
    const unsigned G = gridDim.x * gridDim.y * gridDim.z;
    unsigned sum, cnt, mine, sp = 0u;
    for (;;) {
        sum = 0u; cnt = 0u; mine = 0u;
#pragma unroll
        for (unsigned j = 0; j < 16; ++j) { const unsigned c = xb_ld(&bar[XB_XCNT(j)]); sum += c; cnt += (c > 0u) ? 1u : 0u; mine = (j == x) ? c : mine; }
        if (sum == G) break;
        __builtin_amdgcn_s_sleep(1);
        if ((++sp & 255u) == 0u) { if (xb_ld(&bar[XB_TMO])) break; if (sp > XB_SPIN_CAP) { atomicAdd(&bar[XB_TMO], 1u); break; } }
    }
    nloc = mine > 0u ? mine : 1u; nx = cnt > 0u ? cnt : 1u;
}

__device__ __forceinline__ void xcd_barrier(const XcdBarrier& b) {
    asm volatile("s_waitcnt vmcnt(0)" ::: "memory");
    __syncthreads();
    if (threadIdx.x == 0) {
        unsigned* bar = b.bar;
        __builtin_amdgcn_s_waitcnt(0);
        unsigned nloc = b.st[0], nx = b.st[1];
        if (nloc == 0u) { xcd_barrier_complete(bar, b.x, nloc, nx); b.st[0] = nloc; b.st[1] = nx; }
        const unsigned old = xb_add(&bar[XB_XSUB(b.x)], 1u);
        const unsigned gen = old / nloc;
        if (old + 1u == (gen + 1u) * nloc) {
            __builtin_amdgcn_fence(__ATOMIC_RELEASE, "agent");
            asm volatile("s_waitcnt vmcnt(0)" ::: "memory");
            const unsigned og = xb_add(&bar[XB_TOP], 1u);
            const unsigned tg = og / nx;
            if (og + 1u == (tg + 1u) * nx) xb_add(&bar[XB_TOPGEN], 1u);
            else XB_SPIN(xb_ld(&bar[XB_TOPGEN]) == tg, bar);
            __builtin_amdgcn_fence(__ATOMIC_ACQUIRE, "agent");
            xb_add(&bar[XB_XGEN(b.x)], 1u);
            asm volatile("s_waitcnt vmcnt(0)" ::: "memory");
        } else {
            XB_SPIN(xb_ld(&bar[XB_XGEN(b.x)]) == gen, bar);
            __builtin_amdgcn_fence(__ATOMIC_ACQUIRE, "agent");
            asm volatile("s_waitcnt vmcnt(0)" ::: "memory");
        }
    }
    __syncthreads();
}
#define DI __device__ __forceinline__
constexpr int NWAVES = 8;
constexpr int NB = 16, SEQ = 2048, DM = 1024, MT = NB * SEQ;
constexpr int DIN_SRC = 6944, NPROJ = 7168;
constexpr int MEML = 256, MROWS = NB * MEML;
constexpr int NEXP = 32, TOPK = 4, DFF = 1024, MOEB = 256;
constexpr int NROWS = MT * TOPK;
constexpr int NBLK_MAX = (NROWS + NEXP * (MOEB - 1) + MOEB - 1) / MOEB;
constexpr int CAP = NBLK_MAX * MOEB;
constexpr float EPS = 1e-6f;
constexpr float NEGF = -1e30f;
constexpr int PC_MLQ = 0, PC_MLK = 512, PC_MLV = 1024, PC_MLO = 1536, PC_NQ = 2048, PC_NKC = 2560, PC_NVC = 2688, PC_NKS = 2816, PC_NVS = 2944,
              PC_NKW = 3072, PC_NVW = 3200, PC_MQ = 3328, PC_BRG = 3840, PC_MLI = 6912, PC_MLF = 6916, PC_NG = 6920, PC_END = 6944;
__host__ __device__ constexpr int proj_srccol(int j) {
    return j < 2048 ? j : j < 2560 ? 2056 + (j - 2048) : j < 3328 ? 2568 + (j - 2560) : j < 3840 ? 3360 + (j - 3328) : j < 6912 ? 3872 + (j - 3840)
         : j < 6920 ? 2048 + (j - 6912) : j < 6944 ? 3336 + (j - 6920) : -1;
}

constexpr size_t MiB = 1u << 20;
constexpr size_t WS_CTL = 0, CTL_ZERO_BYTES = 1 * MiB;
constexpr size_t WS_WIN = 1 * MiB, WS_WGU = 15 * MiB, WS_WDN = 143 * MiB, WS_WMKV = 207 * MiB, WS_WBR = 209 * MiB, WS_WOUT = 212 * MiB, WS_WC1 = 214 * MiB;
constexpr size_t WS_SMALL = 216 * MiB;
constexpr size_t WS_R1 = 218 * MiB;
constexpr size_t WS_PROJ = 282 * MiB;
constexpr size_t WS_R3 = 730 * MiB;
constexpr size_t WS_MEMKV = WS_R3, WS_MEMKN = WS_R3 + 8 * MiB, WS_QN = WS_R3 + 12 * MiB, WS_KSN = WS_R3 + 44 * MiB, WS_KWN = WS_R3 + 52 * MiB,
                 WS_MQN = WS_R3 + 60 * MiB, WS_MLQK = WS_R3 + 92 * MiB, WS_HID = WS_R3 + 156 * MiB, WS_KC = WS_R3 + 160 * MiB, WS_VC = WS_KC + MiB / 2,
                 WS_H0 = WS_R3 + 161 * MiB, WS_H1 = WS_H0 + 32 * MiB, WS_H2 = WS_H1 + 32 * MiB, WS_ROUTE = WS_H2 + 32 * MiB, WS_END = WS_ROUTE + 6 * MiB;
constexpr size_t WS_MEMN = WS_H0;
constexpr size_t WS_ACMP = WS_H1;
constexpr size_t WS_APERM = WS_PROJ;
constexpr size_t WS_ACT = WS_PROJ + 272 * MiB;
static_assert(WS_ACT + 272 * MiB <= WS_H0 + 96 * MiB && WS_END <= 1024 * MiB, "ws map");
constexpr size_t SM_ROPEC = 0, SM_ROPES = 256 * 1024, SM_CBIAS = 512 * 1024;
constexpr size_t RT_TOKE = 0, RT_TOKPOS = 512 * 1024, RT_TOKW = 1024 * 1024, RT_TOKDEST = 1536 * 1024, RT_ROWW = 2048 * 1024;
constexpr int CW_BAR = 4096;
constexpr int CW_ECNT = 16384;
constexpr int CW_QCTR = 16384 + 64;

constexpr int RING_BYTES = 131072, LDSCTL_OFF = RING_BYTES, MISC_OFF = LDSCTL_OFF + 320, LDS_BYTES = 147456;

struct Args { const float* in[34]; float* out; unsigned char* ws; int ph_lo, ph_hi, li, pad; };

DI float bf2f(unsigned short h) { return __uint_as_float((unsigned)h << 16); }
DI float wave_sum(float v) {
#pragma unroll
    for (int o = 1; o < 64; o <<= 1) v += __shfl_xor(v, o);
    return v;
}
DI float wave_max(float v) {
#pragma unroll
    for (int o = 1; o < 64; o <<= 1) v = fmaxf(v, __shfl_xor(v, o));
    return v;
}
DI float sigm(float x) { return 1.f / (1.f + __expf(-x)); }
DI float logsig(float x) { return fminf(x, 0.f) - log1pf(__expf(-fabsf(x))); }

namespace pg8 {
struct EpiBf16Silu {
    static constexpr bool PERM = true, AFTER_DRAIN = false;
    bf16_t* O; int ldc; const float* bias; int silu;
    DI void operator()(const f32x4 (&acc)[2][2][4][2], const Unit& u, int wr, int wc, int fr, int fq) const {
        const int row0 = u.pm * BM + wr * 64 + fr; const int col0 = u.pn * BM + wc * 32 + 8 * fq;
#pragma unroll
        for (int ai = 0; ai < 2; ++ai)
#pragma unroll
            for (int m = 0; m < 4; ++m) { bf16_t* rowp = O + (size_t)(row0 + ai * HALF + m * 16) * ldc + col0;
#pragma unroll
                for (int bj = 0; bj < 2; ++bj) { f32x4 v0 = acc[ai][bj][m][0], v1 = acc[ai][bj][m][1];
                    if (bias) { v0 += *(const f32x4*)(bias + col0 + bj * HALF); v1 += *(const f32x4*)(bias + col0 + bj * HALF + 4); }
                    if (silu) {
#pragma unroll
                        for (int j = 0; j < 4; ++j) { v0[j] = v0[j] / (1.f + __expf(-v0[j])); v1[j] = v1[j] / (1.f + __expf(-v1[j])); } }
                    u32x4 w; w.x = cvt_pk_bf16(v0[0], v0[1]); w.y = cvt_pk_bf16(v0[2], v0[3]); w.z = cvt_pk_bf16(v1[0], v1[1]); w.w = cvt_pk_bf16(v1[2], v1[3]);
                    *(u32x4*)(rowp + bj * HALF) = w; } }
    }
};
template <int B> struct EpiGate {
    static constexpr bool PERM = false, AFTER_DRAIN = false;
    const bf16_t* proj; float* tmp; bf16_t* merged;
    DI void operator()(const f32x4 (&acc)[2][2][4][2], const Unit& u, int wr, int wc, int fr, int fq) const {
        typedef unsigned u32x2v __attribute__((ext_vector_type(2)));
        const int col0 = u.pn * BM + wc * 32 + 4 * fq;
#pragma unroll
        for (int ai = 0; ai < 2; ++ai)
#pragma unroll
            for (int m = 0; m < 4; ++m) { const size_t r = (size_t)(u.pm * BM + ai * HALF + wr * 64 + m * 16 + fr);
#pragma unroll
                for (int bj = 0; bj < 2; ++bj)
#pragma unroll
                    for (int n = 0; n < 2; ++n) { const int c = col0 + bj * HALF + n * 16;
                        const u32x2v gw = *(const u32x2v*)(proj + r * NPROJ + PC_BRG + B * DM + c);
                        f32x4 g; g[0] = __uint_as_float(gw.x << 16); g[1] = __uint_as_float(gw.x & 0xffff0000u); g[2] = __uint_as_float(gw.y << 16); g[3] = __uint_as_float(gw.y & 0xffff0000u);
                        f32x4 v = acc[ai][bj][m][n];
#pragma unroll
                        for (int j = 0; j < 4; ++j) v[j] = v[j] / (1.f + __expf(-g[j]));
                        float* tp = tmp + r * DM + c;
                        if (B == 0) { *(f32x4*)tp = v; }
                        else if (B == 1) { *(f32x4*)tp = *(const f32x4*)tp + v; }
                        else { v = *(const f32x4*)tp + v; u32x2v w; w.x = cvt_pk_bf16(v[0], v[1]); w.y = cvt_pk_bf16(v[2], v[3]); *(u32x2v*)(merged + r * DM + c) = w; } } }
    }
};
struct EpiRes {
    static constexpr bool PERM = false, AFTER_DRAIN = false;
    const float* base; float* out;
    DI void operator()(const f32x4 (&acc)[2][2][4][2], const Unit& u, int wr, int wc, int fr, int fq) const {
        const int col0 = u.pn * BM + wc * 32 + 4 * fq;
#pragma unroll
        for (int ai = 0; ai < 2; ++ai)
#pragma unroll
            for (int m = 0; m < 4; ++m) { const size_t r = (size_t)(u.pm * BM + ai * HALF + wr * 64 + m * 16 + fr);
#pragma unroll
                for (int bj = 0; bj < 2; ++bj)
#pragma unroll
                    for (int n = 0; n < 2; ++n) { const int c = col0 + bj * HALF + n * 16; *(f32x4*)(out + r * DM + c) = *(const f32x4*)(base + r * DM + c) + acc[ai][bj][m][n]; } }
    }
};
struct EpiSwiglu {
    static constexpr bool PERM = true, AFTER_DRAIN = false;
    bf16_t* act; const float* bgu;
    DI void operator()(const f32x4 (&acc)[2][2][4][2], const Unit& u, int wr, int wc, int fr, int fq) const {
        typedef unsigned u32x2v __attribute__((ext_vector_type(2)));
        const int e = u.pn >> 3, pnl = u.pn & 7;
        const int lc0 = pnl * BM + wc * 32 + 8 * fq;
        const int row0 = u.pm * BM + wr * 64 + fr;
#pragma unroll
        for (int ai = 0; ai < 2; ++ai)
#pragma unroll
            for (int m = 0; m < 4; ++m) { bf16_t* rowp = act + (size_t)(row0 + ai * HALF + m * 16) * DFF;
#pragma unroll
                for (int bj = 0; bj < 2; ++bj) {
                    const int lc = lc0 + bj * HALF;
                    const f32x4 b0 = *(const f32x4*)(bgu + e * 2048 + lc), b1 = *(const f32x4*)(bgu + e * 2048 + lc + 4);
                    const f32x4 v0 = acc[ai][bj][m][0] + b0, v1 = acc[ai][bj][m][1] + b1;
                    float o[4];
#pragma unroll
                    for (int q = 0; q < 4; ++q) { const float gt = fminf(q < 2 ? v0[2 * q] : v1[2 * q - 4], 7.0f); float up = q < 2 ? v0[2 * q + 1] : v1[2 * q - 3]; up = fminf(fmaxf(up, -7.0f), 7.0f);
                        o[q] = (up + 1.0f) * (gt / (1.f + __expf(-1.702f * gt))); }
                    u32x2v w; w.x = cvt_pk_bf16(o[0], o[1]); w.y = cvt_pk_bf16(o[2], o[3]);
                    *(u32x2v*)(rowp + (lc >> 1)) = w; } }
    }
};
struct EpiDown {
    static constexpr bool PERM = false, AFTER_DRAIN = false;
    bf16_t* y; const float* bdn; const float* roww;
    DI void operator()(const f32x4 (&acc)[2][2][4][2], const Unit& u, int wr, int wc, int fr, int fq) const {
        typedef unsigned u32x2v __attribute__((ext_vector_type(2)));
        const int e = u.pn >> 2, pnl = u.pn & 3;
        const int col0 = pnl * BM + wc * 32 + 4 * fq;
#pragma unroll
        for (int ai = 0; ai < 2; ++ai)
#pragma unroll
            for (int m = 0; m < 4; ++m) { const size_t r = (size_t)(u.pm * BM + ai * HALF + wr * 64 + m * 16 + fr); const float rw = roww[r];
#pragma unroll
                for (int bj = 0; bj < 2; ++bj)
#pragma unroll
                    for (int n = 0; n < 2; ++n) { const int c = col0 + bj * HALF + n * 16; const f32x4 v = (acc[ai][bj][m][n] + *(const f32x4*)(bdn + e * DM + c)) * rw;
                        u32x2v w; w.x = cvt_pk_bf16(v[0], v[1]); w.y = cvt_pk_bf16(v[2], v[3]); *(u32x2v*)(y + r * DM + c) = w; } }
    }
};
template <int NPN> struct MoeOrder {
    int nunits, G, c; const PG8_LAS unsigned char* blk_e;
    DI bool next(int i, Unit& u) const { const int L = i * G + c; if (L >= nunits) return false; const int rb = L / NPN; u.pm = rb; u.pn = (int)blk_e[rb] * NPN + (L % NPN); return true; }
    DI void a_ready(const Unit&) const {}
    DI void done(const Unit&) const {}
};
}

struct Frame {
    LAS unsigned char* lds; volatile LAS unsigned* MISC; unsigned* ctl; unsigned char* ws;
    int tid, lane, wave, G, bx;
    const float* const* in; float* out;
};
enum { I_X = 0, I_MEM, I_GMIX, I_WIN, I_CONVW, I_CONVB, I_MLBI, I_MLBF, I_MLGOUT, I_NGQ, I_NGK, I_CPK, I_CW1K, I_CB1K, I_CW2K, I_CPV, I_CW1V, I_CB1V, I_CW2V,
       I_GMEM, I_WMKV, I_MGQ, I_MGK, I_WBRML, I_WBRNSA, I_WBRMEM, I_WOUT, I_GFFN, I_WR, I_BR, I_WGU, I_BGU, I_WDN, I_BDN, N_IN };

template <class CM>
DI void tr_item(const float* W, int ldw, int K, bf16* WT, int k0, int n0, CM cm, LAS float* scr, int lane) {
    const int sc = cm(n0 + (lane & 31));
#pragma unroll 8
    for (int i = 0; i < 32; ++i) { const int kk = 2 * i + (lane >> 5); scr[kk * 33 + (lane & 31)] = sc >= 0 ? W[(size_t)(k0 + kk) * ldw + sc] : 0.f; }
    LDS_WAIT(); asm volatile("" ::: "memory");
    const int c = lane & 7;
#pragma unroll
    for (int j = 0; j < 4; ++j) { const int n = (lane >> 3) + 8 * j; const LAS float* s = scr + (8 * c) * 33 + n;
        v4u o; o.x = pk2(s[0 * 33], s[1 * 33]); o.y = pk2(s[2 * 33], s[3 * 33]); o.z = pk2(s[4 * 33], s[5 * 33]); o.w = pk2(s[6 * 33], s[7 * 33]);
        *(v4u*)(WT + (size_t)(n0 + n) * K + k0 + 8 * c) = o; }
    LDS_WAIT(); asm volatile("" ::: "memory");
}
struct CmId { DI int operator()(int j) const { return j; } };
struct CmProj { DI int operator()(int j) const { return proj_srccol(j); } };

DI void rms_row_bf16(const float* xrow, const float* g, bf16* orow, int lane) {
    const f32x4* xr = (const f32x4*)xrow + lane; const f32x4* gr = (const f32x4*)g + lane;
    f32x4 v[4]; float s = 0.f;
#pragma unroll
    for (int j = 0; j < 4; ++j) { v[j] = xr[64 * j]; s += (v[j].x * v[j].x + v[j].y * v[j].y) + (v[j].z * v[j].z + v[j].w * v[j].w); }
    const float rstd = rsqrtf(wave_sum(s) * (1.f / DM) + EPS);
    unsigned long long* o8 = (unsigned long long*)orow + lane;
#pragma unroll
    for (int j = 0; j < 4; ++j) { const f32x4 gg = gr[64 * j];
        o8[64 * j] = (unsigned long long)pk2(v[j].x * rstd * gg.x, v[j].y * rstd * gg.y) | ((unsigned long long)pk2(v[j].z * rstd * gg.z, v[j].w * rstd * gg.w) << 32); }
}

DI void p0_prologue(Frame& F) {
    LAS float* scr = (LAS float*)(F.lds + F.wave * 16384);
    const int gw = F.bx * NWAVES + F.wave, NGW = F.G * NWAVES;
    unsigned char* ws = F.ws;
    constexpr int IT_IN = 16 * (NPROJ / 32), IT_GU = 32 * 16 * 64, IT_DN = 32 * 16 * 32, IT_MKV = 16 * 32, IT_BR = 3 * 8 * 32, IT_OUT = 16 * 32, IT_C1 = 2 * 32 * 8;
    constexpr int NITEMS = IT_IN + IT_GU + IT_DN + IT_MKV + IT_BR + IT_OUT + IT_C1;
    for (int it = gw; it < NITEMS; it += NGW) {
        int r = it;
        if (r < IT_IN) { const int kb = r / (NPROJ / 32), nb = r % (NPROJ / 32); tr_item(F.in[I_WIN], DIN_SRC, DM, (bf16*)(ws + WS_WIN), 64 * kb, 32 * nb, CmProj(), scr, F.lane); continue; } r -= IT_IN;
        if (r < IT_GU) { const int e = r / 1024, q = r % 1024, kb = q / 64, nb = q % 64; tr_item(F.in[I_WGU] + (size_t)e * DM * 2048, 2048, DM, (bf16*)(ws + WS_WGU) + (size_t)e * 2048 * DM, 64 * kb, 32 * nb, CmId(), scr, F.lane); continue; } r -= IT_GU;
        if (r < IT_DN) { const int e = r / 512, q = r % 512, kb = q / 32, nb = q % 32; tr_item(F.in[I_WDN] + (size_t)e * DFF * DM, DM, DFF, (bf16*)(ws + WS_WDN) + (size_t)e * DM * DFF, 64 * kb, 32 * nb, CmId(), scr, F.lane); continue; } r -= IT_DN;
        if (r < IT_MKV) { const int kb = r / 32, nb = r % 32; tr_item(F.in[I_WMKV], 1024, 1024, (bf16*)(ws + WS_WMKV), 64 * kb, 32 * nb, CmId(), scr, F.lane); continue; } r -= IT_MKV;
        if (r < IT_BR) { const int b = r / 256, q = r % 256, kb = q / 32, nb = q % 32; tr_item(F.in[I_WBRML + b], 1024, 512, (bf16*)(ws + WS_WBR) + (size_t)b * 1024 * 512, 64 * kb, 32 * nb, CmId(), scr, F.lane); continue; } r -= IT_BR;
        if (r < IT_OUT) { const int kb = r / 32, nb = r % 32; tr_item(F.in[I_WOUT], 1024, 1024, (bf16*)(ws + WS_WOUT), 64 * kb, 32 * nb, CmId(), scr, F.lane); continue; } r -= IT_OUT;
        { const int kv = r / 256, q = r % 256, kb = q / 8, nb = q % 8; tr_item(F.in[kv ? I_CW1V : I_CW1K], 256, 2048, (bf16*)(ws + WS_WC1) + (size_t)kv * 256 * 2048, 64 * kb, 32 * nb, CmId(), scr, F.lane); }
    }
    for (int m = gw; m < MT; m += NGW) rms_row_bf16(F.in[I_X] + (size_t)m * DM, F.in[I_GMIX], (bf16*)(ws + WS_R1) + (size_t)m * DM, F.lane);
    for (int m = gw; m < MROWS; m += NGW) rms_row_bf16(F.in[I_MEM] + (size_t)m * DM, F.in[I_GMEM], (bf16*)(ws + WS_MEMN) + (size_t)m * DM, F.lane);
    float* rc = (float*)(ws + WS_SMALL + SM_ROPEC); float* rs = (float*)(ws + WS_SMALL + SM_ROPES);
    for (int i = F.bx * 512 + F.tid; i < SEQ * 32; i += F.G * 512) {
        const int p = i >> 5, k = i & 31;
        const float invf = exp2f(-(float)k * (13.287712379549449f / 32.0f));
        const float ang = (float)p * invf;
        const float kf = rintf(ang * 0.15915494309189535f);
        float r = fmaf(-kf, 6.28125f, ang); r = fmaf(-kf, 1.9353071795864769e-3f, r);
        rc[i] = cosf(r); rs[i] = sinf(r);
    }
    if (F.bx == F.G - 1) {
        const int kv = F.tid >> 8, f = F.tid & 255;
        const float* pe = F.in[kv ? I_CPV : I_CPK]; const float* w1 = F.in[kv ? I_CW1V : I_CW1K];
        float a = F.in[kv ? I_CB1V : I_CB1K][f];
        for (int k = 0; k < 2048; ++k) a = fmaf(pe[k], w1[(size_t)k * 256 + f], a);
        ((float*)(ws + WS_SMALL + SM_CBIAS))[kv * 256 + f] = a;
    }
}

DI void p2_prep(Frame& F) {
    unsigned char* ws = F.ws;
    const int gw = F.bx * NWAVES + F.wave, NGW = F.G * NWAVES, lane = F.lane;
    const bf16* proj = (const bf16*)(ws + WS_PROJ);
    const float* rc = (const float*)(ws + WS_SMALL + SM_ROPEC); const float* rs = (const float*)(ws + WS_SMALL + SM_ROPES);
    bf16* qn = (bf16*)(ws + WS_QN); bf16* ksn = (bf16*)(ws + WS_KSN); bf16* kwn = (bf16*)(ws + WS_KWN); bf16* mqn = (bf16*)(ws + WS_MQN); bf16* mlqk = (bf16*)(ws + WS_MLQK);
    bf16* acmp = (bf16*)(ws + WS_ACMP);
    const float gq = F.in[I_NGQ][lane], gks = F.in[I_NGK][64 + lane], gkw = F.in[I_NGK][128 + lane];
    const float mg0 = F.in[I_MGQ][lane], mg1 = F.in[I_MGQ][64 + lane];
    for (int t = gw; t < MT; t += NGW) {
        const int b = t >> 11, tau = t & 2047;
        const bf16* pr = proj + (size_t)t * NPROJ;
        const float c = rc[tau * 32 + (lane & 31)], s = rs[tau * 32 + (lane & 31)];
#pragma unroll
        for (int h = 0; h < 12; ++h) {
            const int col = h < 8 ? PC_NQ + h * 64 : h < 10 ? PC_NKS + (h - 8) * 64 : PC_NKW + (h - 10) * 64;
            const float g = h < 8 ? gq : h < 10 ? gks : gkw;
            const float v = bf2f(pr[col + lane]);
            const float y = v * rsqrtf(wave_sum(v * v) * (1.f / 64.f) + EPS) * g;
            const float pt = __shfl_xor(y, 32);
            float o = lane < 32 ? y * c - pt * s : y * c + pt * s;
            if (h < 8) qn[(size_t)t * 512 + h * 64 + lane] = (bf16)f2bf(o * 0.125f);
            else if (h < 10) ksn[(size_t)t * 128 + (h - 8) * 64 + lane] = (bf16)f2bf(o);
            else kwn[(size_t)t * 128 + (h - 10) * 64 + lane] = (bf16)f2bf(o);
        }
#pragma unroll
        for (int h = 0; h < 4; ++h) {
            const float v0 = bf2f(pr[PC_MQ + h * 128 + lane]), v1 = bf2f(pr[PC_MQ + h * 128 + 64 + lane]);
            const float rstd = rsqrtf(wave_sum(v0 * v0 + v1 * v1) * (1.f / 128.f) + EPS) * 0.08838834764831845f;
            mqn[(size_t)t * 512 + h * 128 + lane] = (bf16)f2bf(v0 * rstd * mg0); mqn[(size_t)t * 512 + h * 128 + 64 + lane] = (bf16)f2bf(v1 * rstd * mg1);
        }
        for (int cc = lane; cc < 1024; cc += 64) {
            float a = F.in[I_CONVB][cc];
#pragma unroll
            for (int j = 0; j < 4; ++j) { const int tt = tau - 3 + j; if (tt >= 0) a = fmaf(F.in[I_CONVW][j * 1024 + cc], bf2f(proj[(size_t)(t - 3 + j) * NPROJ + cc]), a); }
            mlqk[(size_t)t * 1024 + cc] = (bf16)f2bf(a * sigm(a));
        }
#pragma unroll
        for (int kv = 0; kv < 2; ++kv)
#pragma unroll
            for (int h = 0; h < 2; ++h) {
                const bf16 val = pr[PC_NKC + kv * 128 + h * 64 + lane];
                const int nA = tau >> 4;
#pragma unroll
                for (int dn = 0; dn < 2; ++dn) { const int n = nA - dn; if (n >= 0 && n <= 126) { const int l = tau - 16 * n;
                    acmp[(size_t)kv * 4096 * 2048 + (size_t)((b * 2 + h) * 128 + n) * 2048 + l * 64 + lane] = val; } }
            }
    }
    for (int i = F.bx * 512 + F.tid; i < 2 * 32 * 2048; i += F.G * 512) { const int kv = i / (32 * 2048), q = i % (32 * 2048), bh = q / 2048, col = q % 2048;
        acmp[(size_t)kv * 4096 * 2048 + (size_t)(bh * 128 + 127) * 2048 + col] = 0; }
    const bf16* memkv = (const bf16*)(ws + WS_MEMKV); bf16* memkn = (bf16*)(ws + WS_MEMKN);
    const float kg0 = F.in[I_MGK][lane], kg1 = F.in[I_MGK][64 + lane];
    for (int r = gw; r < MROWS; r += NGW) {
#pragma unroll
        for (int h = 0; h < 4; ++h) {
            const float v0 = bf2f(memkv[(size_t)r * 1024 + h * 128 + lane]), v1 = bf2f(memkv[(size_t)r * 1024 + h * 128 + 64 + lane]);
            const float rstd = rsqrtf(wave_sum(v0 * v0 + v1 * v1) * (1.f / 128.f) + EPS);
            memkn[(size_t)r * 512 + h * 128 + lane] = (bf16)f2bf(v0 * rstd * kg0); memkn[(size_t)r * 512 + h * 128 + 64 + lane] = (bf16)f2bf(v1 * rstd * kg1);
        }
    }
}

DI void p4_kcvc(Frame& F) {
    unsigned char* ws = F.ws;
    const int gw = F.bx * NWAVES + F.wave, NGW = F.G * NWAVES, lane = F.lane;
    const bf16* hid = (const bf16*)(ws + WS_HID);
    const float* rc = (const float*)(ws + WS_SMALL + SM_ROPEC); const float* rs = (const float*)(ws + WS_SMALL + SM_ROPES);
    const float gk = F.in[I_NGK][lane];
    for (int it = gw; it < 2 * 4096; it += NGW) {
        const int kv = it >> 12, r = it & 4095, n = r & 127;
        bf16* dst = (bf16*)(ws + (kv ? WS_VC : WS_KC)) + (size_t)r * 64 + lane;
        if (n == 127) { *dst = 0; continue; }
        const bf16* hr = hid + (size_t)kv * 4096 * 256 + (size_t)r * 256; const float* w2 = F.in[kv ? I_CW2V : I_CW2K];
        float a = 0.f;
        for (int f = 0; f < 256; ++f) a = fmaf(bf2f(hr[f]), w2[f * 64 + lane], a);
        if (kv == 0) {
            const float y = a * rsqrtf(wave_sum(a * a) * (1.f / 64.f) + EPS) * gk;
            const int pos = 16 * n + 31; const float c = rc[pos * 32 + (lane & 31)], s = rs[pos * 32 + (lane & 31)];
            const float pt = __shfl_xor(y, 32);
            a = lane < 32 ? y * c - pt * s : y * c + pt * s;
        }
        *dst = (bf16)f2bf(a);
    }
}

DI void mlstm_unit(Frame& F, int unit) {
    unsigned char* ws = F.ws;
    const int b = unit >> 2, h = unit & 3, tid = F.tid, kk = tid >> 7, c = tid & 127;
    const bf16* proj = (const bf16*)(ws + WS_PROJ); const bf16* mlqk = (const bf16*)(ws + WS_MLQK); bf16* H0 = (bf16*)(ws + WS_H0);
    LAS float* qs = (LAS float*)F.lds;
    LAS float* ks = qs + 16 * 128;
    LAS float* vs = ks + 16 * 128;
    LAS float* gi = vs + 16 * 128;
    LAS float* gf = gi + 16;
    LAS float* part = gf + 16;
    LAS float* pden = part + 2 * 4 * 128;
    LAS float* hb = pden + 8;
    float C[32], nn[32];
#pragma unroll
    for (int i = 0; i < 32; ++i) { C[i] = 0.f; nn[i] = 0.f; }
    float m = 0.f;
    const float bi = F.in[I_MLBI][h], bfv = F.in[I_MLBF][h];
    const float scale = 0.08838834764831845f;
#pragma unroll 1
    for (int t0 = 0; t0 < SEQ; t0 += 16) {
        __syncthreads();
        for (int i = tid; i < 16 * 128; i += 512) { const int s = i >> 7, d = i & 127; const size_t t = (size_t)b * SEQ + t0 + s;
            qs[i] = bf2f(mlqk[t * 1024 + h * 128 + d]); ks[i] = bf2f(mlqk[t * 1024 + 512 + h * 128 + d]); vs[i] = bf2f(proj[t * NPROJ + PC_MLV + h * 128 + d]); }
        if (tid < 16) { const size_t t = (size_t)b * SEQ + t0 + tid; gi[tid] = bf2f(proj[t * NPROJ + PC_MLI + h]) + bi; gf[tid] = logsig(bf2f(proj[t * NPROJ + PC_MLF + h]) + bfv); }
        __syncthreads();
#pragma unroll 1
        for (int s = 0; s < 16; ++s) {
            const float lf = gf[s], ig = gi[s];
            const float mn = fmaxf(lf + m, ig), a = __expf(lf + m - mn), bb = __expf(ig - mn);
            m = mn;
            const float v = vs[s * 128 + c];
            float pn = 0.f, pd = 0.f;
#pragma unroll
            for (int i = 0; i < 32; ++i) { const float kvv = ks[s * 128 + kk * 32 + i], qv = qs[s * 128 + kk * 32 + i];
                C[i] = a * C[i] + bb * kvv * v; nn[i] = a * nn[i] + bb * kvv; pn = fmaf(qv, C[i], pn); pd = fmaf(qv, nn[i], pd); }
            const int par = s & 1;
            part[(par * 4 + kk) * 128 + c] = pn; if (c == 0) pden[par * 4 + kk] = pd;
            __syncthreads();
            if (kk == 0) {
                const float num = (part[(par * 4 + 0) * 128 + c] + part[(par * 4 + 1) * 128 + c]) + (part[(par * 4 + 2) * 128 + c] + part[(par * 4 + 3) * 128 + c]);
                const float den = (pden[par * 4 + 0] + pden[par * 4 + 1]) + (pden[par * 4 + 2] + pden[par * 4 + 3]);
                hb[s * 128 + c] = num * scale / fmaxf(fabsf(den * scale), __expf(-mn));
            }
        }
        __syncthreads();
#pragma unroll
        for (int rr = 0; rr < 2; ++rr) { const int s = F.wave * 2 + rr; const size_t t = (size_t)b * SEQ + t0 + s;
            const float v0 = hb[s * 128 + F.lane], v1 = hb[s * 128 + 64 + F.lane];
            const float rstd = rsqrtf(wave_sum(v0 * v0 + v1 * v1) * (1.f / 128.f) + EPS);
            const float o0 = bf2f(proj[t * NPROJ + PC_MLO + h * 128 + F.lane]), o1 = bf2f(proj[t * NPROJ + PC_MLO + h * 128 + 64 + F.lane]);
            H0[t * 512 + h * 128 + F.lane] = (bf16)f2bf(v0 * rstd * F.in[I_MLGOUT][h * 128 + F.lane] * sigm(o0));
            H0[t * 512 + h * 128 + 64 + F.lane] = (bf16)f2bf(v1 * rstd * F.in[I_MLGOUT][h * 128 + 64 + F.lane] * sigm(o1)); }
    }
    __syncthreads();
}

DI void nsa_scores(const bf16* krow, bool valid, const LAS float* qs, float (&s)[4]) {
    s[0] = s[1] = s[2] = s[3] = 0.f;
    if (valid) {
#pragma unroll 2
        for (int c8 = 0; c8 < 8; ++c8) { const v4u kk = *(const v4u*)(krow + c8 * 8);
            const unsigned w[4] = {kk.x, kk.y, kk.z, kk.w};
#pragma unroll
            for (int j = 0; j < 4; ++j) { const float k0 = __uint_as_float(w[j] << 16), k1 = __uint_as_float(w[j] & 0xffff0000u); const int d = c8 * 8 + 2 * j;
#pragma unroll
                for (int g = 0; g < 4; ++g) s[g] = fmaf(k1, qs[g * 64 + d + 1], fmaf(k0, qs[g * 64 + d], s[g])); } }
    }
}
DI void nsa_wave(Frame& F, int item, LAS float* wl) {
    unsigned char* ws = F.ws; const int lane = F.lane;
    const int t = item >> 1, hkv = item & 1, b = t >> 11, tau = t & 2047;
    const bf16* proj = (const bf16*)(ws + WS_PROJ);
    const bf16* qn = (const bf16*)(ws + WS_QN); const bf16* ksn = (const bf16*)(ws + WS_KSN); const bf16* kwn = (const bf16*)(ws + WS_KWN);
    const bf16* kc = (const bf16*)(ws + WS_KC); const bf16* vc = (const bf16*)(ws + WS_VC); bf16* H1 = (bf16*)(ws + WS_H1);
    LAS float* qs = wl;
    LAS float* ps = wl + 256;
    LAS float* psum = wl + 768;
#pragma unroll
    for (int g = 0; g < 4; ++g) qs[g * 64 + lane] = bf2f(qn[(size_t)t * 512 + (hkv * 4 + g) * 64 + lane]);
    float ofin[4] = {0.f, 0.f, 0.f, 0.f};
    float gate[4][3];
#pragma unroll
    for (int g = 0; g < 4; ++g)
#pragma unroll
        for (int cidx = 0; cidx < 3; ++cidx) gate[g][cidx] = sigm(bf2f(proj[(size_t)t * NPROJ + PC_NG + (hkv * 4 + g) * 3 + cidx]));
    const int ncmp = tau >= 31 ? ((tau - 31) >> 4) + 1 : 0;
    {
        float l[4] = {0.f, 0.f, 0.f, 0.f}, o[4] = {0.f, 0.f, 0.f, 0.f};
        const size_t rbase = (size_t)(b * 2 + hkv) * 128;
#pragma unroll
        for (int blk = 0; blk < 2; ++blk) { const int n = blk * 64 + lane; const bool valid = n < ncmp; float s[4];
            nsa_scores(kc + (rbase + n) * 64, valid, qs, s);
#pragma unroll
            for (int g = 0; g < 4; ++g) { const float p = valid ? __expf(s[g]) : 0.f; l[g] += p; ps[g * 128 + n] = p; } }
        float inv[4];
#pragma unroll
        for (int g = 0; g < 4; ++g) { const float L = wave_sum(l[g]); inv[g] = L > 0.f ? 1.f / L : 0.f; }
#pragma unroll
        for (int blk = 0; blk < 2; ++blk) { const int n = blk * 64 + lane; psum[n] = (ps[0 * 128 + n] * inv[0] + ps[1 * 128 + n] * inv[1]) + (ps[2 * 128 + n] * inv[2] + ps[3 * 128 + n] * inv[3]); }
#pragma unroll 2
        for (int n = 0; n < ncmp; ++n) { const float vv = bf2f(vc[(rbase + n) * 64 + lane]);
#pragma unroll
            for (int g = 0; g < 4; ++g) o[g] = fmaf(ps[g * 128 + n], vv, o[g]); }
#pragma unroll
        for (int g = 0; g < 4; ++g) ofin[g] += gate[g][0] * o[g] * inv[g];
    }
    const int cur = tau >> 6;
    unsigned selmask = 0u;
    {
        float score = -3.0e38f;
        if (lane < 32) { const int j = lane; float imp = 0.f;
#pragma unroll
            for (int dn = -1; dn <= 3; ++dn) { const int n = 4 * j + dn; if (n >= 0 && n <= 126) imp += psum[n]; }
            const bool forced = (j == 0) || (j == cur) || (j == cur - 1);
            score = j > cur ? NEGF : imp + (forced ? 1.0e4f : 0.f); }
#pragma unroll 1
        for (int r = 0; r < 8; ++r) { const float mx = wave_max(score); const unsigned long long bal = __ballot(score == mx); const int win = __ffsll((long long)bal) - 1;
            selmask |= 1u << win; if (lane == win) score = -3.4e38f; }
    }
    {
        float l[4] = {0.f, 0.f, 0.f, 0.f}, o[4] = {0.f, 0.f, 0.f, 0.f};
#pragma unroll 1
        for (int j = 0; j <= cur; ++j) { if (!((selmask >> j) & 1u)) continue;
            const int kpos = 64 * j + lane; const bool valid = kpos <= tau; float s[4];
            nsa_scores(ksn + ((size_t)b * SEQ + kpos) * 128 + hkv * 64, valid, qs, s);
#pragma unroll
            for (int g = 0; g < 4; ++g) { const float p = valid ? __expf(s[g]) : 0.f; l[g] += p; ps[g * 128 + lane] = p; }
            const int nk = j == cur ? (tau & 63) + 1 : 64;
            const bf16* vb = proj + ((size_t)b * SEQ + 64 * j) * NPROJ + PC_NVS + hkv * 64 + lane;
#pragma unroll 2
            for (int k = 0; k < nk; ++k) { const float vv = bf2f(vb[(size_t)k * NPROJ]);
#pragma unroll
                for (int g = 0; g < 4; ++g) o[g] = fmaf(ps[g * 128 + k], vv, o[g]); } }
#pragma unroll
        for (int g = 0; g < 4; ++g) { const float L = wave_sum(l[g]); ofin[g] += gate[g][1] * o[g] * (L > 0.f ? 1.f / L : 0.f); }
    }
    {
        float l[4] = {0.f, 0.f, 0.f, 0.f}, o[4] = {0.f, 0.f, 0.f, 0.f};
        const int start = tau - 511 > 0 ? tau - 511 : 0;
#pragma unroll 1
        for (int base = start & ~63; base <= tau; base += 64) {
            const int kpos = base + lane; const bool valid = kpos >= start && kpos <= tau; float s[4];
            nsa_scores(kwn + ((size_t)b * SEQ + kpos) * 128 + hkv * 64, valid, qs, s);
#pragma unroll
            for (int g = 0; g < 4; ++g) { const float p = valid ? __expf(s[g]) : 0.f; l[g] += p; ps[g * 128 + lane] = p; }
            const int k0 = start > base ? start - base : 0, k1 = tau - base < 63 ? tau - base : 63;
            const bf16* vb = proj + ((size_t)b * SEQ + base) * NPROJ + PC_NVW + hkv * 64 + lane;
#pragma unroll 2
            for (int k = k0; k <= k1; ++k) { const float vv = bf2f(vb[(size_t)k * NPROJ]);
#pragma unroll
                for (int g = 0; g < 4; ++g) o[g] = fmaf(ps[g * 128 + k], vv, o[g]); } }
#pragma unroll
        for (int g = 0; g < 4; ++g) { const float L = wave_sum(l[g]); ofin[g] += gate[g][2] * o[g] * (L > 0.f ? 1.f / L : 0.f); }
    }
#pragma unroll
    for (int g = 0; g < 4; ++g) H1[(size_t)t * 512 + (hkv * 4 + g) * 64 + lane] = (bf16)f2bf(ofin[g]);
}
DI void mem_wave(Frame& F, int t, LAS float* wl) {
    unsigned char* ws = F.ws; const int lane = F.lane; const int b = t >> 11;
    const bf16* mqn = (const bf16*)(ws + WS_MQN); const bf16* memkn = (const bf16*)(ws + WS_MEMKN); const bf16* memkv = (const bf16*)(ws + WS_MEMKV); bf16* H2 = (bf16*)(ws + WS_H2);
    LAS float* qs = wl;
    LAS float* ps = wl + 128;
#pragma unroll 1
    for (int h = 0; h < 4; ++h) {
        qs[lane] = bf2f(mqn[(size_t)t * 512 + h * 128 + lane]); qs[64 + lane] = bf2f(mqn[(size_t)t * 512 + h * 128 + 64 + lane]);
        float l = 0.f;
#pragma unroll 1
        for (int kq = 0; kq < 4; ++kq) { const int key = kq * 64 + lane; const bf16* kr = memkn + ((size_t)b * MEML + key) * 512 + h * 128; float s = 0.f;
#pragma unroll 2
            for (int c8 = 0; c8 < 16; ++c8) { const v4u kk = *(const v4u*)(kr + c8 * 8); const unsigned w[4] = {kk.x, kk.y, kk.z, kk.w};
#pragma unroll
                for (int j = 0; j < 4; ++j) s = fmaf(__uint_as_float(w[j] & 0xffff0000u), qs[c8 * 8 + 2 * j + 1], fmaf(__uint_as_float(w[j] << 16), qs[c8 * 8 + 2 * j], s)); }
            const float p = __expf(s); l += p; ps[key] = p; }
        const float inv = 1.f / wave_sum(l);
        float o0 = 0.f, o1 = 0.f;
        const bf16* vb = memkv + (size_t)b * MEML * 1024 + 512 + h * 128;
#pragma unroll 4
        for (int key = 0; key < MEML; ++key) { const float p = ps[key]; o0 = fmaf(p, bf2f(vb[(size_t)key * 1024 + lane]), o0); o1 = fmaf(p, bf2f(vb[(size_t)key * 1024 + 64 + lane]), o1); }
        H2[(size_t)t * 512 + h * 128 + lane] = (bf16)f2bf(o0 * inv); H2[(size_t)t * 512 + h * 128 + 64 + lane] = (bf16)f2bf(o1 * inv);
    }
}
DI void p5_mixers(Frame& F) {
    const int nml = F.G >= 128 ? 64 : 0;
#ifndef NO_ML
    if (F.bx < nml || nml == 0) { for (int u = F.bx; u < 64; u += (nml ? nml : F.G)) mlstm_unit(F, u); }
#endif
    if (F.bx >= nml) {
        LAS float* wl = (LAS float*)(F.lds + F.wave * 4096);
        const int gw = (F.bx - nml) * NWAVES + F.wave, NGW = (F.G - nml) * NWAVES;
#ifndef NO_NSA
        for (int it = gw; it < MT * 2; it += NGW) nsa_wave(F, it, wl);
#endif
#ifndef NO_MEM
        for (int t = gw; t < MT; t += NGW) mem_wave(F, t, wl);
#endif
    }
}

DI void p8_router(Frame& F) {
    unsigned char* ws = F.ws; const int lane = F.lane, tid = F.tid;
    bf16* xn2 = (bf16*)(ws + WS_R1);
    int* tok_e = (int*)(ws + WS_ROUTE + RT_TOKE); int* tok_pos = (int*)(ws + WS_ROUTE + RT_TOKPOS); float* tok_w = (float*)(ws + WS_ROUTE + RT_TOKW);
    unsigned* gcnt = F.ctl + CW_ECNT;
    LAS float* rowb = (LAS float*)(F.lds + F.wave * 4096);
    LAS int* lcnt = (LAS int*)(F.lds + 32768);
    LAS int* lbase = lcnt + 32;
    LAS int* se = lbase + 32;
    LAS int* sp = se + 512;
    LAS float* sw = (LAS float*)(sp + 512);
    const float* wr = F.in[I_WR]; const float* gf = F.in[I_GFFN];
    for (int bt = F.bx; bt < MT / 128; bt += F.G) {
        if (tid < 32) lcnt[tid] = 0;
        __syncthreads();
        for (int i = 0; i < 16; ++i) {
            const int tl = F.wave * 16 + i, t = bt * 128 + tl;
            const f32x4* xr = (const f32x4*)(F.out + (size_t)t * DM) + lane; const f32x4* gr = (const f32x4*)gf + lane;
            f32x4 v[4]; float s = 0.f;
#pragma unroll
            for (int j = 0; j < 4; ++j) { v[j] = xr[64 * j]; s += (v[j].x * v[j].x + v[j].y * v[j].y) + (v[j].z * v[j].z + v[j].w * v[j].w); }
            const float rstd = rsqrtf(wave_sum(s) * (1.f / DM) + EPS);
            unsigned long long* o8 = (unsigned long long*)(xn2 + (size_t)t * DM) + lane;
#pragma unroll
            for (int j = 0; j < 4; ++j) { const f32x4 gg = gr[64 * j]; f32x4 y; y.x = v[j].x * rstd * gg.x; y.y = v[j].y * rstd * gg.y; y.z = v[j].z * rstd * gg.z; y.w = v[j].w * rstd * gg.w;
                o8[64 * j] = (unsigned long long)pk2(y.x, y.y) | ((unsigned long long)pk2(y.z, y.w) << 32);
                *(LAS f32x4*)(rowb + 4 * lane + 256 * j) = y; }
            const int e = lane & 31, half = lane >> 5; float a = 0.f;
            for (int d = half * 512; d < half * 512 + 512; ++d) a = fmaf(rowb[d], wr[d * 32 + e], a);
            a += __shfl_xor(a, 32); a += F.in[I_BR][e];
            float sc = a; int ek[4]; float vk[4];
#pragma unroll
            for (int r = 0; r < 4; ++r) { const float mx = wave_max(sc); const unsigned long long bal = __ballot(sc == mx); const int win = (__ffsll((long long)bal) - 1) & 31;
                ek[r] = win; vk[r] = mx; if (e == win) sc = -3.4e38f; }
            const float e1 = __expf(vk[1] - vk[0]), e2 = __expf(vk[2] - vk[0]), e3 = __expf(vk[3] - vk[0]); const float inv = 1.f / (1.f + e1 + e2 + e3);
            if (lane == 0) {
                const float wk[4] = {inv, e1 * inv, e2 * inv, e3 * inv};
#pragma unroll
                for (int r = 0; r < 4; ++r) { se[tl * 4 + r] = ek[r]; sw[tl * 4 + r] = wk[r]; sp[tl * 4 + r] = atomicAdd((int*)&lcnt[ek[r]], 1); }
            }
        }
        __syncthreads();
        if (tid < 32) lbase[tid] = (int)atomicAdd(&gcnt[tid], (unsigned)lcnt[tid]);
        __syncthreads();
        { const int t = bt * 128 + (tid >> 2), k = tid & 3; const int e = se[tid];
          tok_e[t * 4 + k] = e; tok_pos[t * 4 + k] = lbase[e] + sp[tid]; tok_w[t * 4 + k] = sw[tid]; }
        __syncthreads();
    }
}
DI int moe_tables(Frame& F, LAS int* pstart, LAS unsigned char* blk_e) {
    unsigned* gcnt = F.ctl + CW_ECNT;
    __syncthreads();
    if (F.tid == 0) { int acc = 0; for (int e = 0; e < NEXP; ++e) { const int cnt = (int)__hip_atomic_load(&gcnt[e], __ATOMIC_RELAXED, __HIP_MEMORY_SCOPE_AGENT); pstart[e] = acc; acc += (cnt + MOEB - 1) / MOEB * MOEB; } pstart[NEXP] = acc; }
    __syncthreads();
    const int nblk = pstart[NEXP] / MOEB;
    for (int rb = F.tid; rb < nblk; rb += 512) { int e = 0; while (e < NEXP - 1 && pstart[e + 1] <= rb * MOEB) ++e; blk_e[rb] = (unsigned char)e; }
    __syncthreads();
    return nblk;
}
DI void p9_scatter(Frame& F) {
    unsigned char* ws = F.ws; const int lane = F.lane;
    LAS int* pstart = (LAS int*)(F.lds + 65536); LAS unsigned char* blk_e = (LAS unsigned char*)(F.lds + 65536 + 256);
    moe_tables(F, pstart, blk_e);
    const bf16* xn2 = (const bf16*)(ws + WS_R1); bf16* aperm = (bf16*)(ws + WS_APERM);
    const int* tok_e = (const int*)(ws + WS_ROUTE + RT_TOKE); const int* tok_pos = (const int*)(ws + WS_ROUTE + RT_TOKPOS); const float* tok_w = (const float*)(ws + WS_ROUTE + RT_TOKW);
    int* tok_dest = (int*)(ws + WS_ROUTE + RT_TOKDEST); float* roww = (float*)(ws + WS_ROUTE + RT_ROWW);
    unsigned* gcnt = F.ctl + CW_ECNT;
    const int gw = F.bx * NWAVES + F.wave, NGW = F.G * NWAVES;
    for (int it = gw; it < NROWS; it += NGW) {
        const int t = it >> 2; const int e = tok_e[it]; const int dest = pstart[e] + tok_pos[it];
        const v4u* src = (const v4u*)(xn2 + (size_t)t * DM); v4u* dst = (v4u*)(aperm + (size_t)dest * DM);
        dst[lane] = src[lane]; dst[64 + lane] = src[64 + lane];
        if (lane == 0) { tok_dest[it] = dest; roww[dest] = tok_w[it]; }
    }
    for (int it = gw; it < NEXP * MOEB; it += NGW) { const int e = it >> 8, i = it & 255; const int cnt = (int)__hip_atomic_load(&gcnt[e], __ATOMIC_RELAXED, __HIP_MEMORY_SCOPE_AGENT); const int padded = (cnt + MOEB - 1) / MOEB * MOEB;
        if (i < padded - cnt) { const int dest = pstart[e] + cnt + i; v4u* dst = (v4u*)(aperm + (size_t)dest * DM); const v4u z = {0u, 0u, 0u, 0u}; dst[lane] = z; dst[64 + lane] = z; if (lane == 0) roww[dest] = 0.f; } }
}
DI void p12_combine(Frame& F) {
    unsigned char* ws = F.ws; const int lane = F.lane;
    const bf16* ybuf = (const bf16*)(ws + WS_APERM); const int* tok_dest = (const int*)(ws + WS_ROUTE + RT_TOKDEST);
    const int gw = F.bx * NWAVES + F.wave, NGW = F.G * NWAVES;
    for (int t = gw; t < MT; t += NGW) {
        f32x4* orow = (f32x4*)(F.out + (size_t)t * DM);
        int d[4];
#pragma unroll
        for (int k = 0; k < 4; ++k) d[k] = tok_dest[t * 4 + k];
#pragma unroll
        for (int j = 0; j < 4; ++j) { f32x4 a = orow[lane + 64 * j];
#pragma unroll
            for (int k = 0; k < 4; ++k) { const unsigned long long w = *((const unsigned long long*)(ybuf + (size_t)d[k] * DM) + lane + 64 * j);
                a.x += __uint_as_float((unsigned)w << 16); a.y += __uint_as_float((unsigned)w & 0xffff0000u); a.z += __uint_as_float((unsigned)(w >> 32) << 16); a.w += __uint_as_float((unsigned)(w >> 32) & 0xffff0000u); }
            orow[lane + 64 * j] = a; }
    }
}

constexpr int N_PHASES = 13;
#ifndef MK_PER_PHASE
#define MK_PER_PHASE 0
#endif
__global__ void __launch_bounds__(NWAVES * 64, 2) fwd_kernel(Args args) {
    extern __shared__ __attribute__((aligned(16))) unsigned char lds_raw[];
    Frame F;
    F.lds = (LAS unsigned char*)lds_raw; F.MISC = (volatile LAS unsigned*)(F.lds + MISC_OFF);
    F.tid = threadIdx.x; F.lane = F.tid & 63; F.wave = __builtin_amdgcn_readfirstlane(F.tid >> 6); F.G = gridDim.x; F.bx = blockIdx.x;
    F.ws = args.ws; F.ctl = (unsigned*)(args.ws + WS_CTL); F.in = args.in; F.out = args.out;
    unsigned char* ws = args.ws;
    for (int u = F.tid; u < (LDS_BYTES - LDSCTL_OFF) / 4; u += NWAVES * 64) ((LAS unsigned*)(F.lds + LDSCTL_OFF))[u] = 0u;
    __syncthreads();
    const int lo = args.ph_lo, hi = args.ph_hi;
    XcdBarrier bar; bar.bar = F.ctl + CW_BAR; bar.x = 0; bar.st = nullptr;
    if (hi - lo > 1) bar = xcd_barrier_post(F.ctl + CW_BAR, F.MISC + 8);
#ifndef PH_MASK
#define PH_MASK 0x1fff
#endif
#define IN(k) (((PH_MASK >> (k)) & 1) && lo <= (k) && (k) < hi)
#define SEAM(k) do { if (IN(k) && IN((k) + 1)) xcd_barrier(bar); } while (0)
    typedef pg8::bf16_t b16;
    if (IN(0)) { p0_prologue(F); } SEAM(0);
    if (IN(1)) {
        { pg8::Gemm g{(const b16*)(ws + WS_R1), (const b16*)(ws + WS_WIN), MT, NPROJ, DM}; pg8::StaticOrder S; S.init(MT, NPROJ, F.G, F.bx);
          pg8::EpiBf16Silu E{(b16*)(ws + WS_PROJ), NPROJ, nullptr, 0};
          pg8::gemm_phase<pg8::EpiBf16Silu, pg8::StaticOrder, true, true>(F.lds, g, S, E); }
        { pg8::Gemm g{(const b16*)(ws + WS_MEMN), (const b16*)(ws + WS_WMKV), MROWS, 1024, DM}; pg8::StaticOrder S; S.init(MROWS, 1024, F.G, (F.bx + 64) % F.G);
          pg8::EpiBf16Silu E{(b16*)(ws + WS_MEMKV), 1024, nullptr, 0};
          pg8::gemm_phase<pg8::EpiBf16Silu, pg8::StaticOrder, true, true>(F.lds, g, S, E); }
    } SEAM(1);
    if (IN(2)) { p2_prep(F); } SEAM(2);
    if (IN(3)) {
#pragma unroll
        for (int kv = 0; kv < 2; ++kv) {
            pg8::Gemm g{(const b16*)(ws + WS_ACMP) + (size_t)kv * 4096 * 2048, (const b16*)(ws + WS_WC1) + (size_t)kv * 256 * 2048, 4096, 256, 2048}; pg8::StaticOrder S; S.init(4096, 256, F.G, (F.bx + F.G - 16 * kv) % F.G);
            pg8::EpiBf16Silu E{(b16*)(ws + WS_HID) + (size_t)kv * 4096 * 256, 256, (const float*)(ws + WS_SMALL + SM_CBIAS) + kv * 256, 1};
            pg8::gemm_phase<pg8::EpiBf16Silu, pg8::StaticOrder, true, true>(F.lds, g, S, E); }
    } SEAM(3);
    if (IN(4)) { p4_kcvc(F); } SEAM(4);
    if (IN(5)) { p5_mixers(F); } SEAM(5);
    if (IN(6)) {
        pg8::StaticOrder S; S.init(MT, DM, F.G, F.bx);
        { pg8::Gemm g{(const b16*)(ws + WS_H0), (const b16*)(ws + WS_WBR), MT, DM, 512}; pg8::EpiGate<0> E{(const b16*)(ws + WS_PROJ), F.out, (b16*)(ws + WS_R1)};
          pg8::gemm_phase<pg8::EpiGate<0>, pg8::StaticOrder, true, true>(F.lds, g, S, E); }
        { pg8::Gemm g{(const b16*)(ws + WS_H1), (const b16*)(ws + WS_WBR) + 1024 * 512, MT, DM, 512}; pg8::EpiGate<1> E{(const b16*)(ws + WS_PROJ), F.out, (b16*)(ws + WS_R1)};
          pg8::gemm_phase<pg8::EpiGate<1>, pg8::StaticOrder, true, true>(F.lds, g, S, E); }
        { pg8::Gemm g{(const b16*)(ws + WS_H2), (const b16*)(ws + WS_WBR) + 2 * 1024 * 512, MT, DM, 512}; pg8::EpiGate<2> E{(const b16*)(ws + WS_PROJ), F.out, (b16*)(ws + WS_R1)};
          pg8::gemm_phase<pg8::EpiGate<2>, pg8::StaticOrder, true, true>(F.lds, g, S, E); }
    } SEAM(6);
    if (IN(7)) {
        pg8::Gemm g{(const b16*)(ws + WS_R1), (const b16*)(ws + WS_WOUT), MT, DM, DM}; pg8::StaticOrder S; S.init(MT, DM, F.G, F.bx);
        pg8::EpiRes E{F.in[I_X], F.out};
        pg8::gemm_phase<pg8::EpiRes, pg8::StaticOrder, true, true>(F.lds, g, S, E);
    } SEAM(7);
    if (IN(8)) { p8_router(F); } SEAM(8);
    if (IN(9)) { p9_scatter(F); } SEAM(9);
    if (IN(10)) {
        LAS int* pstart = (LAS int*)(F.lds + RING_BYTES + 1024); LAS unsigned char* blk_e = (LAS unsigned char*)(F.lds + RING_BYTES + 1024 + 256);
        const int nblk = moe_tables(F, pstart, blk_e);
        pg8::Gemm g{(const b16*)(ws + WS_APERM), (const b16*)(ws + WS_WGU), CAP, NEXP * 2048, DM};
        pg8::MoeOrder<8> S{nblk * 8, F.G, F.bx, (const PG8_LAS unsigned char*)blk_e};
        pg8::EpiSwiglu E{(b16*)(ws + WS_ACT), F.in[I_BGU]};
        pg8::gemm_phase<pg8::EpiSwiglu, pg8::MoeOrder<8>, true, true>(F.lds, g, S, E);
    } SEAM(10);
    if (IN(11)) {
        LAS int* pstart = (LAS int*)(F.lds + RING_BYTES + 1024); LAS unsigned char* blk_e = (LAS unsigned char*)(F.lds + RING_BYTES + 1024 + 256);
        const int nblk = moe_tables(F, pstart, blk_e);
        pg8::Gemm g{(const b16*)(ws + WS_ACT), (const b16*)(ws + WS_WDN), CAP, NEXP * DM, DFF};
        pg8::MoeOrder<4> S{nblk * 4, F.G, F.bx, (const PG8_LAS unsigned char*)blk_e};
        pg8::EpiDown E{(b16*)(ws + WS_APERM), F.in[I_BDN], (const float*)(ws + WS_ROUTE + RT_ROWW)};
        pg8::gemm_phase<pg8::EpiDown, pg8::MoeOrder<4>, true, true>(F.lds, g, S, E);
    } SEAM(11);
    if (IN(12)) { p12_combine(F); }
#undef IN
#undef SEAM
}

extern "C" void kernel_launch(void* const* d_in, const int* in_sizes, int n_in, void* d_out, int out_size, void* d_ws, size_t ws_size, hipStream_t stream) {
    static int grid = 0;
    if (grid == 0) {
        if (n_in != N_IN || out_size != MT * DM || ws_size < WS_END) { fprintf(stderr, "kernel_launch: unexpected shapes (n_in %d, out %d, ws %zu need %zu)\n", n_in, out_size, ws_size, (size_t)WS_END); grid = -1; return; }
        int dev = 0, cus = 0, per_cu = 0;
        if (hipGetDevice(&dev) != hipSuccess || hipDeviceGetAttribute(&cus, hipDeviceAttributeMultiprocessorCount, dev) != hipSuccess) { grid = -1; return; }
        if (hipFuncSetAttribute((const void*)fwd_kernel, hipFuncAttributeMaxDynamicSharedMemorySize, LDS_BYTES) != hipSuccess) { fprintf(stderr, "kernel_launch: hipFuncSetAttribute failed\n"); grid = -1; return; }
        if (hipOccupancyMaxActiveBlocksPerMultiprocessor(&per_cu, (const void*)fwd_kernel, NWAVES * 64, LDS_BYTES) != hipSuccess || per_cu < 1) { fprintf(stderr, "kernel_launch: occupancy query says %d\n", per_cu); }
        (void)hipGetLastError();
        grid = cus;
    }
    if (grid < 0) return;
    if (hipMemsetAsync((char*)d_ws + WS_CTL, 0, CTL_ZERO_BYTES, stream) != hipSuccess) return;
    Args a{};
    for (int i = 0; i < N_IN; ++i) a.in[i] = (const float*)d_in[i];
    a.out = (float*)d_out; a.ws = (unsigned char*)d_ws;
#if MK_PER_PHASE
    for (int p = 0; p < N_PHASES; ++p) { a.ph_lo = p; a.ph_hi = p + 1; a.li = 0; hipLaunchKernelGGL(fwd_kernel, dim3(grid), dim3(NWAVES * 64), LDS_BYTES, stream, a); }
#else
    a.ph_lo = 0; a.ph_hi = N_PHASES; a.li = 0;
    hipLaunchKernelGGL(fwd_kernel, dim3(grid), dim3(NWAVES * 64), LDS_BYTES, stream, a);
#endif
}
```

```cpp
#include <hip/hip_runtime.h>
#include <cstdio>
#include <cstdint>
namespace pg8 {
#define PG8_LAS __attribute__((address_space(3)))
typedef unsigned short bf16_t;
typedef short bf16x8 __attribute__((ext_vector_type(8)));
typedef float f32x4 __attribute__((ext_vector_type(4)));
typedef unsigned u32x4 __attribute__((ext_vector_type(4)));
constexpr int BM = 256, BK = 64, HALF = 128, HTB = HALF * BK * 2  , STAGE_BYTES = 8 * HTB, NXCD = 8, WGM = 8;

__host__ __device__ __forceinline__ int lds_byte(int r, int c) { const int st = (r >> 4) * 2 + (c >> 5), rr = r & 15, cc = c & 31, ob = rr * 64 + cc * 2; return st * 1024 + (ob ^ (((ob >> 9) & 1) << 5)); }
__host__ __device__ __forceinline__ void stage_rc(int b, int& R, int& C) { const int st = b / 1024, sb = b % 1024, swz = sb ^ (((sb >> 9) & 1) << 5); R = (st >> 1) * 16 + swz / 64; C = (st & 1) * 32 + (swz % 64) / 2; }
__host__ __device__ __forceinline__ int perm32(int rho) { const int n = rho >> 4, i = rho & 15; return 8 * (i >> 2) + 4 * n + (i & 3); }

struct Unit { int pm, pn; };
struct Gemm { const bf16_t* A; const bf16_t* Bt; int M, N, K; };

struct StaticOrder {
    int nM, nN, nwg, G, c;
    __host__ __device__ void init(int M, int N, int G_, int c_) { nM = M / BM; nN = N / BM; nwg = nM * nN; G = G_; c = c_; }
    __host__ __device__ bool next(int i, Unit& u) const {
        const long L = (long)i * G + c; if (L >= nwg) return false;
        int wgid = (int)L; { const int q = nwg / NXCD, r = nwg % NXCD, xcd = wgid % NXCD, off = wgid / NXCD; wgid = (xcd < r ? xcd * (q + 1) : r * (q + 1) + (xcd - r) * q) + off; }
        const int nig = WGM * nN, gid = wgid / nig, fm = gid * WGM, gsz = (nM - fm) < WGM ? (nM - fm) : WGM;
        u.pm = fm + ((wgid % nig) % gsz); u.pn = (wgid % nig) / gsz; return true;
    }
    __device__ __forceinline__ void a_ready(const Unit&) const {}
    __device__ __forceinline__ void done(const Unit&) const {}
};

__device__ __forceinline__ unsigned cvt_pk_bf16(float lo, float hi) { unsigned r; asm volatile("v_cvt_pk_bf16_f32 %0, %1, %2" : "=v"(r) : "v"(lo), "v"(hi)); return r; }
typedef float f32x2 __attribute__((ext_vector_type(2)));
__device__ __forceinline__ f32x2 gelu_pk(f32x2 v) {
    const f32x2 av = __builtin_elementwise_abs(v), d = av * 0.2316418882f + 1.0f;
    f32x2 t; t.x = __builtin_amdgcn_rcpf(d.x); t.y = __builtin_amdgcn_rcpf(d.y);
    f32x2 q = t * 0.5307027145f + (-0.7265760135f); q = q * t + 0.7107068705f; q = q * t + (-0.142248368f); q = q * t + 0.127414796f; q = q * t;
    const f32x2 s = (v * v) * (-0.72134752044f);
    f32x2 e; e.x = __builtin_amdgcn_exp2f(s.x); e.y = __builtin_amdgcn_exp2f(s.y);
    const f32x2 m = v * (q * e), r = v - m;
    f32x2 o; o.x = v.x < 0.f ? m.x : r.x; o.y = v.y < 0.f ? m.y : r.y; return o;
}

template <int ACT  > struct EpiBf16 {
    static constexpr bool PERM = true, AFTER_DRAIN = false; static_assert(ACT == 0 || ACT == 1, "EpiBf16: ACT is 0 (none) or 1 (gelu_pk)");
    bf16_t* O; int ldc; const float* bias; int split_cols; size_t split_stride; float scale0;
    __device__ __forceinline__ void operator()(const f32x4 (&acc)[2][2][4][2], const Unit& u, int wr, int wc, int fr, int fq) const {
        const int row0 = u.pm * BM + wr * 64 + fr; int colt = u.pn * BM; bf16_t* base = O;
        float sc = 1.f; if (split_cols) { const int t = colt / split_cols; base += (size_t)t * split_stride; colt -= t * split_cols; if (t == 0) sc = scale0; }
        const int col0 = colt + wc * 32 + 8 * fq, bcol0 = u.pn * BM + wc * 32 + 8 * fq;
        f32x4 bv[2][2];
#pragma unroll
        for (int bj = 0; bj < 2; ++bj)
#pragma unroll
            for (int n = 0; n < 2; ++n) bv[bj][n] = bias ? *(const f32x4*)(bias + bcol0 + bj * HALF + 4 * n) : (f32x4){0.f, 0.f, 0.f, 0.f};
#pragma unroll
        for (int ai = 0; ai < 2; ++ai)
#pragma unroll
            for (int m = 0; m < 4; ++m) { bf16_t* rowp = base + (size_t)(row0 + ai * HALF + m * 16) * ldc + col0;
#pragma unroll
                for (int bj = 0; bj < 2; ++bj) { f32x4 v0 = acc[ai][bj][m][0] + bv[bj][0], v1 = acc[ai][bj][m][1] + bv[bj][1];
                    if (ACT == 1) { f32x2 a = gelu_pk((f32x2){v0[0], v0[1]}), b = gelu_pk((f32x2){v0[2], v0[3]}), c = gelu_pk((f32x2){v1[0], v1[1]}), d = gelu_pk((f32x2){v1[2], v1[3]});
                        v0 = (f32x4){a.x, a.y, b.x, b.y}; v1 = (f32x4){c.x, c.y, d.x, d.y}; }
                    v0 = v0 * sc; v1 = v1 * sc; u32x4 w; w.x = cvt_pk_bf16(v0[0], v0[1]); w.y = cvt_pk_bf16(v0[2], v0[3]); w.z = cvt_pk_bf16(v1[0], v1[1]); w.w = cvt_pk_bf16(v1[2], v1[3]);
                    *(u32x4*)(rowp + bj * HALF) = w; } }
    }
};

struct PanelStats {
    unsigned* xbuf;
    unsigned* cnt;
    unsigned* tmo;
    int ntn; float eps;
    unsigned code;
    __device__ __forceinline__ bool run(const f32x4 (&v)[2][2][4][2], const Unit& u, int wr, int wc, int fr, int fq, PG8_LAS unsigned char* lds, int wid, int lane) const {
        typedef float f32x2v __attribute__((ext_vector_type(2)));
        PG8_LAS f32x2v* P = (PG8_LAS f32x2v*)lds;
        PG8_LAS f32x2v* S = (PG8_LAS f32x2v*)(lds + 8192);
        PG8_LAS unsigned* flag = (PG8_LAS unsigned*)(lds + 8192 + 2048);
#pragma unroll
        for (int ai = 0; ai < 2; ++ai)
#pragma unroll
            for (int m = 0; m < 4; ++m) {
                float s = 0.f;
#pragma unroll
                for (int bj = 0; bj < 2; ++bj)
#pragma unroll
                    for (int n = 0; n < 2; ++n) { const f32x4 x = v[ai][bj][m][n]; s += (x[0] + x[1]) + (x[2] + x[3]); }
                s += __shfl_xor(s, 16); s += __shfl_xor(s, 32);
                const float mw = s * (1.0f / 64.0f); float q = 0.f;
#pragma unroll
                for (int bj = 0; bj < 2; ++bj)
#pragma unroll
                    for (int n = 0; n < 2; ++n) { const f32x4 d = v[ai][bj][m][n] - mw; q += (d[0] * d[0] + d[1] * d[1]) + (d[2] * d[2] + d[3] * d[3]); }
                q += __shfl_xor(q, 16); q += __shfl_xor(q, 32);
                if (fq == 0) P[(ai * HALF + wr * 64 + m * 16 + fr) * 4 + wc] = (f32x2v){mw, q};
            }
        asm volatile("s_waitcnt lgkmcnt(0)" ::: "memory"); __builtin_amdgcn_s_barrier(); asm volatile("" ::: "memory");
#if defined(BROKEN_EXCHANGE_NO_WAIT)
#warning BROKEN CONTROL BUILD: the row-statistics exchange does not wait; results are wrong by design
        if (blockIdx.x >= 64) { const long long t0_ = clock64(); while (clock64() - t0_ < 60000) __builtin_amdgcn_s_sleep(8); }
#endif
        const int row = wid * 32 + (lane & 31);
        if (lane < 32) {
            const f32x2v a = P[row * 4 + 0], b = P[row * 4 + 1], c = P[row * 4 + 2], d = P[row * 4 + 3];
            const float mt = (a.x + b.x + c.x + d.x) * 0.25f;
            const float da = a.x - mt, db = b.x - mt, dc = c.x - mt, dd = d.x - mt;
            const float m2 = (a.y + b.y) + (c.y + d.y) + 64.0f * ((da * da + db * db) + (dc * dc + dd * dd));
            unsigned long long* slot = (unsigned long long*)xbuf + ((size_t)(u.pm * BM + row) * 4 + u.pn);
            __hip_atomic_store(slot, ((unsigned long long)__float_as_uint(m2) << 32) | __float_as_uint(mt), __ATOMIC_RELAXED, __HIP_MEMORY_SCOPE_AGENT);
        }
        asm volatile("s_waitcnt vmcnt(0)" ::: "memory");
        if (lane == 0) __hip_atomic_fetch_add(cnt + 64 * u.pm, 1u, __ATOMIC_RELAXED, __HIP_MEMORY_SCOPE_AGENT);
        if (wid == 0) {
            bool dead = false; const unsigned long long t0 = __builtin_amdgcn_s_memrealtime(); const unsigned want = 8u * (unsigned)ntn;
            for (;;) {
#if defined(BROKEN_EXCHANGE_NO_WAIT)
                break;
#endif
                if ((unsigned)__builtin_amdgcn_readfirstlane(__hip_atomic_load(cnt + 64 * u.pm, __ATOMIC_RELAXED, __HIP_MEMORY_SCOPE_AGENT)) >= want) break;
                if (__builtin_amdgcn_s_memrealtime() - t0 > 2000000ull) {
                    if (lane == 0) { unsigned expect = 0u; __hip_atomic_compare_exchange_strong(tmo + 1, &expect, code | (unsigned)(u.pm & 0xff), __ATOMIC_RELAXED, __ATOMIC_RELAXED, __HIP_MEMORY_SCOPE_AGENT);
                                     __hip_atomic_store(tmo, 1u, __ATOMIC_RELAXED, __HIP_MEMORY_SCOPE_AGENT); }
                    dead = true; break; }
                __builtin_amdgcn_s_sleep(2);
            }
            __builtin_amdgcn_fence(__ATOMIC_ACQUIRE, "agent");
            if (lane == 0) flag[0] = dead ? 1u : 0u;
        }
        asm volatile("s_waitcnt vmcnt(0) lgkmcnt(0)" ::: "memory"); __builtin_amdgcn_s_barrier(); asm volatile("" ::: "memory");
        const bool bad = flag[0] != 0u;
        if (lane < 32) {
            const unsigned long long* slot = (const unsigned long long*)xbuf + (size_t)(u.pm * BM + row) * 4; float mt[4], m2[4]; float ms = 0.f;
#pragma unroll
            for (int t = 0; t < 4; ++t) { if (t < ntn) { const unsigned long long w = __hip_atomic_load(slot + t, __ATOMIC_RELAXED, __HIP_MEMORY_SCOPE_AGENT); mt[t] = __uint_as_float((unsigned)w); m2[t] = __uint_as_float((unsigned)(w >> 32)); } else { mt[t] = 0.f; m2[t] = 0.f; } ms += mt[t]; }
            const float mean = ms / (float)ntn; float q = 0.f;
#pragma unroll
            for (int t = 0; t < 4; ++t) if (t < ntn) { const float dm = mt[t] - mean; q += m2[t] + 256.0f * dm * dm; }
            S[row] = (f32x2v){mean, 1.0f / sqrtf(q / (256.0f * (float)ntn) + eps)};
        }
        asm volatile("s_waitcnt lgkmcnt(0)" ::: "memory"); __builtin_amdgcn_s_barrier(); asm volatile("" ::: "memory");
        return bad;
    }
};
struct EpiLnRes {
    static constexpr bool PERM = false, AFTER_DRAIN = true;
    const float* base; float* out; int ldc; const float* bias; PanelStats st; unsigned poison;
    __device__ __forceinline__ void fused(f32x4 (&acc)[2][2][4][2], const Unit& u, int wr, int wc, int fr, int fq, PG8_LAS unsigned char* lds, int wid, int lane) const {
        typedef float f32x2v __attribute__((ext_vector_type(2)));
        const PG8_LAS f32x2v* S = (const PG8_LAS f32x2v*)(lds + 8192);
        const int col0 = u.pn * BM + wc * 32 + 4 * fq;
#pragma unroll
        for (int bj = 0; bj < 2; ++bj)
#pragma unroll
            for (int n = 0; n < 2; ++n) { const f32x4 bv = bias ? *(const f32x4*)(bias + col0 + bj * HALF + n * 16) : (f32x4){0.f, 0.f, 0.f, 0.f};
#pragma unroll
                for (int ai = 0; ai < 2; ++ai)
#pragma unroll
                    for (int m = 0; m < 4; ++m) acc[ai][bj][m][n] += bv; }
        f32x4 pre[4][2][2];
#pragma unroll
        for (int m = 0; m < 4; ++m) { const size_t off = (size_t)(u.pm * BM + wr * 64 + m * 16 + fr) * ldc + col0;
#pragma unroll
            for (int bj = 0; bj < 2; ++bj)
#pragma unroll
                for (int n = 0; n < 2; ++n) pre[m][bj][n] = *(const f32x4*)(base + off + bj * HALF + n * 16); }
        const bool bad = st.run(acc, u, wr, wc, fr, fq, lds, wid, lane) || poison != 0u;
        const float qnan = __builtin_nanf("");
#pragma unroll
        for (int ai = 0; ai < 2; ++ai)
#pragma unroll
            for (int m = 0; m < 4; ++m) { const int r = ai * HALF + wr * 64 + m * 16 + fr; const f32x2v sr = S[r]; const size_t off = (size_t)(u.pm * BM + r) * ldc + col0;
#pragma unroll
                for (int bj = 0; bj < 2; ++bj)
#pragma unroll
                    for (int n = 0; n < 2; ++n) { const f32x4 bs = ai == 0 ? pre[m][bj][n] : *(const f32x4*)(base + off + bj * HALF + n * 16); f32x4 o = bs + (acc[ai][bj][m][n] - sr.x) * sr.y;
                        if (bad) o = (f32x4){qnan, qnan, qnan, qnan}; *(f32x4*)(out + off + bj * HALF + n * 16) = o; }
                if (m & 1) asm volatile("" ::: "memory"); }
    }
};
struct EpiLnResLn {
    static constexpr bool PERM = false, AFTER_DRAIN = true;
    const float* base; float* out; bf16_t* xn; int ldc; const float* bias; PanelStats st1, st2; unsigned poison;
    __device__ __forceinline__ void fused(f32x4 (&acc)[2][2][4][2], const Unit& u, int wr, int wc, int fr, int fq, PG8_LAS unsigned char* lds, int wid, int lane) const {
        typedef float f32x2v __attribute__((ext_vector_type(2))); typedef unsigned u32x2v __attribute__((ext_vector_type(2)));
        const PG8_LAS f32x2v* S = (const PG8_LAS f32x2v*)(lds + 8192);
        const int col0 = u.pn * BM + wc * 32 + 4 * fq;
#pragma unroll
        for (int bj = 0; bj < 2; ++bj)
#pragma unroll
            for (int n = 0; n < 2; ++n) { const f32x4 bv = bias ? *(const f32x4*)(bias + col0 + bj * HALF + n * 16) : (f32x4){0.f, 0.f, 0.f, 0.f};
#pragma unroll
                for (int ai = 0; ai < 2; ++ai)
#pragma unroll
                    for (int m = 0; m < 4; ++m) acc[ai][bj][m][n] += bv; }
        bool bad = st1.run(acc, u, wr, wc, fr, fq, lds, wid, lane) || poison != 0u;
        const float qnan = __builtin_nanf("");
#pragma unroll
        for (int ai = 0; ai < 2; ++ai)
#pragma unroll
            for (int m = 0; m < 4; ++m) { const int r = ai * HALF + wr * 64 + m * 16 + fr; const f32x2v sr = S[r]; const size_t off = (size_t)(u.pm * BM + r) * ldc + col0;
#pragma unroll
                for (int bj = 0; bj < 2; ++bj)
#pragma unroll
                    for (int n = 0; n < 2; ++n) { const f32x4 bs = *(const f32x4*)(base + off + bj * HALF + n * 16); acc[ai][bj][m][n] = bs + (acc[ai][bj][m][n] - sr.x) * sr.y; }
                asm volatile("" : "+v"(acc[ai][0][m][0]), "+v"(acc[ai][0][m][1]), "+v"(acc[ai][1][m][0]), "+v"(acc[ai][1][m][1]));
                if (m & 1) asm volatile("" ::: "memory"); }
        const bool bad1 = bad;
        bad = st2.run(acc, u, wr, wc, fr, fq, lds, wid, lane) || bad;
#pragma unroll
        for (int ai = 0; ai < 2; ++ai)
#pragma unroll
            for (int m = 0; m < 4; ++m) { const int r = ai * HALF + wr * 64 + m * 16 + fr; const f32x2v sr = S[r]; const size_t off = (size_t)(u.pm * BM + r) * ldc + col0;
#pragma unroll
                for (int bj = 0; bj < 2; ++bj)
#pragma unroll
                    for (int n = 0; n < 2; ++n) { const f32x4 x1 = acc[ai][bj][m][n]; *(f32x4*)(out + off + bj * HALF + n * 16) = bad1 ? (f32x4){qnan, qnan, qnan, qnan} : x1;
                        const f32x4 o = (x1 - sr.x) * sr.y; u32x2v w; w.x = cvt_pk_bf16(o[0], o[1]); w.y = cvt_pk_bf16(o[2], o[3]);
                        if (bad) { w.x = 0x7fc07fc0u; w.y = 0x7fc07fc0u; } *(u32x2v*)(xn + off + bj * HALF + n * 16) = w; }
                asm volatile("" ::: "memory"); }
    }
};

template <class Epi, class Sched, bool ALIGN_EPI = false, bool SP2 = false>
__device__ __forceinline__ void gemm_phase(PG8_LAS unsigned char* lds, const Gemm g, const Sched& S, const Epi& E) {
    const int tid = threadIdx.x, wid = __builtin_amdgcn_readfirstlane(tid >> 6), lane = tid & 63, wr = wid >> 2, wc = wid & 3, fr = lane & 15, fq = lane >> 4;
    const int K = g.K, nt = K / BK;
    unsigned voffA[2], voffB[2];
#pragma unroll
    for (int i = 0; i < 2; ++i) { int R, C; stage_rc(tid * 16 + i * 8192, R, C); const int Rb = Epi::PERM ? ((R & ~31) + perm32(R & 31)) : R;
        voffA[i] = (unsigned)(R * K + C) * 2u; voffB[i] = (unsigned)(Rb * K + C) * 2u; }
    const size_t kstep = (size_t)(BK * 2);
    const size_t hstep = (size_t)HALF * K * 2;
    const size_t tstep = 2 * hstep;
    const unsigned ldsw = (unsigned)wid * 1024u;
    const int aoff = lds_byte(wr * 64 + fr, fq * 8), boff = lds_byte(wc * 32 + fr, fq * 8);
#define PG8_SA(b, h) (((b) * 2 + (h)) * HTB)
#define PG8_SB(b, h) ((4 + (b) * 2 + (h)) * HTB)
#define PG8_STAGE(bufoff, gbase, voff) do { _Pragma("unroll") for (int _i = 0; _i < 2; ++_i) \
        __builtin_amdgcn_global_load_lds((const unsigned*)((const char*)(gbase) + (voff)[_i]), (PG8_LAS unsigned*)(lds + (bufoff) + ldsw + _i * 8192), 16, 0, 0); } while (0)
#define PG8_LDA(dst, b, h) do { _Pragma("unroll") for (int m = 0; m < 4; ++m) _Pragma("unroll") for (int k = 0; k < 2; ++k) dst[m][k] = *(const PG8_LAS bf16x8*)(lds + PG8_SA(b, h) + aoff + m * 2048 + k * 1024); } while (0)
#define PG8_LDB(dst, b, h) do { _Pragma("unroll") for (int n = 0; n < 2; ++n) _Pragma("unroll") for (int k = 0; k < 2; ++k) dst[n][k] = *(const PG8_LAS bf16x8*)(lds + PG8_SB(b, h) + boff + n * 2048 + k * 1024); } while (0)
#define PG8_MMA(ai, bj, At, Bt) do { __builtin_amdgcn_s_setprio(1); _Pragma("unroll") for (int m = 0; m < 4; ++m) _Pragma("unroll") for (int n = 0; n < 2; ++n) _Pragma("unroll") for (int k = 0; k < 2; ++k) \
        acc[ai][bj][m][n] = __builtin_amdgcn_mfma_f32_16x16x32_bf16(Bt[n][k], At[m][k], acc[ai][bj][m][n], 0, 0, 0); __builtin_amdgcn_s_setprio(0); } while (0)
#define PG8_WAIT_V(n) asm volatile("s_waitcnt vmcnt(" #n ")" ::: "memory")
#define PG8_WAIT_L(n) asm volatile("s_waitcnt lgkmcnt(" #n ")" ::: "memory")
#define PG8_BAR __builtin_amdgcn_s_barrier()
#define PG8_SCHED __builtin_amdgcn_sched_barrier(0)
    Unit cur, nxt; int ui = 0;
    if (!S.next(0, cur)) return;
    f32x4 acc[2][2][4][2];
#pragma unroll
    for (int a = 0; a < 2; ++a)
#pragma unroll
        for (int b = 0; b < 2; ++b)
#pragma unroll
            for (int m = 0; m < 4; ++m)
#pragma unroll
                for (int n = 0; n < 2; ++n) acc[a][b][m][n] = (f32x4){0.f, 0.f, 0.f, 0.f};
    bf16x8 At[4][2], B0[2][2], B1[2][2];
    const char* cA = (const char*)g.A + (size_t)cur.pm * tstep; const char* cB = (const char*)g.Bt + (size_t)cur.pn * tstep;
    S.a_ready(cur);
    if constexpr (SP2) {
        PG8_STAGE(PG8_SB(0, 0), cB, voffB); PG8_STAGE(PG8_SB(0, 1), cB + hstep, voffB); PG8_STAGE(PG8_SA(0, 0), cA, voffA); PG8_STAGE(PG8_SA(0, 1), cA + hstep, voffA);
        if (wr == 1) PG8_BAR;
        PG8_WAIT_V(2); PG8_BAR;
        PG8_STAGE(PG8_SB(1, 0), cB + kstep, voffB); PG8_STAGE(PG8_SA(1, 0), cA + kstep, voffA); PG8_STAGE(PG8_SB(1, 1), cB + hstep + kstep, voffB);
        PG8_WAIT_V(6); PG8_BAR;
    } else {
        PG8_STAGE(PG8_SB(0, 0), cB, voffB); PG8_STAGE(PG8_SA(0, 0), cA, voffA); PG8_STAGE(PG8_SB(0, 1), cB + hstep, voffB); PG8_STAGE(PG8_SA(0, 1), cA + hstep, voffA);
        if (wr == 1) PG8_BAR;
        PG8_WAIT_V(4); PG8_BAR;
        PG8_STAGE(PG8_SB(1, 0), cB + kstep, voffB); PG8_STAGE(PG8_SA(1, 0), cA + kstep, voffA); PG8_STAGE(PG8_SB(1, 1), cB + hstep + kstep, voffB);
        PG8_WAIT_V(6); PG8_BAR;
    }
    for (;;) {
        const bool has_next = S.next(ui + 1, nxt);
        const char* nA = has_next ? (const char*)g.A + (size_t)nxt.pm * tstep : cA; const char* nB = has_next ? (const char*)g.Bt + (size_t)nxt.pn * tstep : cB;
        for (int t = 0; t < nt; t += 2) {
            const bool last = (t == nt - 2);
            const char* a1 = cA + (size_t)(t + 1) * kstep;
            const char* a2 = last ? nA : cA + (size_t)(t + 2) * kstep; const char* b2 = last ? nB : cB + (size_t)(t + 2) * kstep;
            const char* a3 = a2 + kstep; const char* b3 = b2 + kstep;
            if (last && has_next) S.a_ready(nxt);
            if constexpr (SP2) {
            PG8_LDB(B0, 0, 0); PG8_LDB(B1, 0, 1); PG8_SCHED; PG8_LDA(At, 0, 0); PG8_STAGE(PG8_SA(1, 1), a1 + hstep, voffA);
            PG8_WAIT_V(8); PG8_WAIT_L(0); PG8_BAR; PG8_MMA(0, 0, At, B0); PG8_MMA(0, 1, At, B1); PG8_BAR; PG8_SCHED;
            PG8_LDA(At, 0, 1); PG8_STAGE(PG8_SB(0, 0), b2, voffB); PG8_STAGE(PG8_SB(0, 1), b2 + hstep, voffB); PG8_STAGE(PG8_SA(0, 0), a2, voffA);
            PG8_WAIT_V(8); PG8_WAIT_L(0); PG8_BAR; PG8_MMA(1, 0, At, B0); PG8_MMA(1, 1, At, B1); PG8_BAR; PG8_SCHED;
            PG8_LDB(B0, 1, 0); PG8_LDB(B1, 1, 1); PG8_SCHED; PG8_LDA(At, 1, 0); PG8_STAGE(PG8_SA(0, 1), a2 + hstep, voffA);
            PG8_WAIT_V(8); PG8_WAIT_L(0); PG8_BAR; PG8_MMA(0, 0, At, B0); PG8_MMA(0, 1, At, B1); PG8_BAR; PG8_SCHED;
            PG8_LDA(At, 1, 1); PG8_STAGE(PG8_SB(1, 0), b3, voffB); PG8_STAGE(PG8_SB(1, 1), b3 + hstep, voffB); PG8_STAGE(PG8_SA(1, 0), a3, voffA);
            PG8_WAIT_V(8); PG8_WAIT_L(0); PG8_BAR; PG8_MMA(1, 0, At, B0); PG8_MMA(1, 1, At, B1); PG8_BAR; PG8_SCHED;
            } else {
            PG8_LDB(B0, 0, 0); PG8_SCHED; PG8_LDA(At, 0, 0); PG8_STAGE(PG8_SA(1, 1), a1 + hstep, voffA);
            PG8_WAIT_L(8); PG8_BAR; PG8_WAIT_L(0); PG8_MMA(0, 0, At, B0); PG8_BAR; PG8_SCHED;
            PG8_LDB(B1, 0, 1); PG8_STAGE(PG8_SB(0, 0), b2, voffB);
            PG8_BAR; PG8_WAIT_L(0); PG8_MMA(0, 1, At, B1); PG8_BAR;
            PG8_LDA(At, 0, 1); PG8_STAGE(PG8_SA(0, 0), a2, voffA);
            PG8_BAR; PG8_WAIT_L(0); PG8_MMA(1, 0, At, B0); PG8_BAR; PG8_SCHED;
            PG8_STAGE(PG8_SB(0, 1), b2 + hstep, voffB);
            PG8_WAIT_V(6); PG8_BAR; PG8_MMA(1, 1, At, B1); PG8_BAR;
            PG8_LDB(B0, 1, 0); PG8_SCHED; PG8_LDA(At, 1, 0); PG8_STAGE(PG8_SA(0, 1), a2 + hstep, voffA);
            PG8_WAIT_L(8); PG8_BAR; PG8_WAIT_L(0); PG8_MMA(0, 0, At, B0); PG8_BAR; PG8_SCHED;
            PG8_LDB(B1, 1, 1); PG8_STAGE(PG8_SB(1, 0), b3, voffB);
            PG8_BAR; PG8_WAIT_L(0); PG8_MMA(0, 1, At, B1); PG8_BAR;
            PG8_LDA(At, 1, 1); PG8_STAGE(PG8_SA(1, 0), a3, voffA);
            PG8_BAR; PG8_WAIT_L(0); PG8_MMA(1, 0, At, B0); PG8_BAR; PG8_SCHED;
            PG8_STAGE(PG8_SB(1, 1), b3 + hstep, voffB);
            PG8_WAIT_V(6); PG8_BAR; PG8_MMA(1, 1, At, B1); PG8_BAR;
            }
        }
        if constexpr (ALIGN_EPI) { if (wr == 0) PG8_BAR; }
        if constexpr (!Epi::AFTER_DRAIN) { E(acc, cur, wr, wc, fr, fq); S.done(cur); }
        if (!has_next) break;
#pragma unroll
        for (int a = 0; a < 2; ++a)
#pragma unroll
            for (int b = 0; b < 2; ++b)
#pragma unroll
                for (int m = 0; m < 4; ++m)
#pragma unroll
                    for (int n = 0; n < 2; ++n) acc[a][b][m][n] = (f32x4){0.f, 0.f, 0.f, 0.f};
        cur = nxt; cA = nA; cB = nB; ++ui;
        if constexpr (ALIGN_EPI) { if (wr == 1) PG8_BAR; }
    }
    PG8_WAIT_V(0);
    if constexpr (!ALIGN_EPI) { if (wr == 0) PG8_BAR; }
    PG8_BAR;
    if constexpr (Epi::AFTER_DRAIN) { E.fused(acc, cur, wr, wc, fr, fq, lds, wid, lane); S.done(cur); }
#undef PG8_SA
#undef PG8_SB
#undef PG8_STAGE
#undef PG8_LDA
#undef PG8_LDB
#undef PG8_MMA
#undef PG8_WAIT_V
#undef PG8_WAIT_L
#undef PG8_BAR
#undef PG8_SCHED
}
}
#define GAS __attribute__((address_space(1)))
#define LAS __attribute__((address_space(3)))
typedef unsigned short bf16;
typedef unsigned v4u __attribute__((ext_vector_type(4)));
typedef float f32x4 __attribute__((ext_vector_type(4)));
typedef short bf16x8 __attribute__((ext_vector_type(8)));
typedef GAS unsigned gu32;
typedef GAS unsigned long long gu64;
#define RLX_AGENT __ATOMIC_RELAXED, __HIP_MEMORY_SCOPE_AGENT
#define LDS_WAIT() asm volatile("s_waitcnt lgkmcnt(0)" ::: "memory")
#define VM_WAIT() asm volatile("s_waitcnt vmcnt(0)" ::: "memory")
__device__ __forceinline__ unsigned long long rt() { return __builtin_amdgcn_s_memrealtime(); }
__device__ __forceinline__ unsigned f2bf(float f) { unsigned u = __builtin_bit_cast(unsigned, f); return (u + 0x7fffu + ((u >> 16) & 1u)) >> 16; }
__device__ __forceinline__ unsigned pk2(float lo, float hi) { return f2bf(lo) | (f2bf(hi) << 16); }

#define XB_TMO      128
#define XB_XCNT(j)  (256  + 64 * (j))
#define XB_XSUB(j)  (1280 + 64 * (j))
#define XB_XGEN(j)  (2304 + 64 * (j))
#define XB_TOP      3328
#define XB_TOPGEN   3392
#define XCD_BAR_WORDS 3456
#define XB_SPIN_CAP (1u << 18)

__device__ __forceinline__ unsigned xb_ld(unsigned* p)              { return __hip_atomic_load(p, __ATOMIC_RELAXED, __HIP_MEMORY_SCOPE_AGENT); }
__device__ __forceinline__ unsigned xb_add(unsigned* p, unsigned v) { return __hip_atomic_fetch_add(p, v, __ATOMIC_RELAXED, __HIP_MEMORY_SCOPE_AGENT); }
__device__ __forceinline__ unsigned xb_xcc_id() { return (unsigned)__builtin_amdgcn_s_getreg((3 << 11) | 20) & 0xFu; }
#define XB_SPIN(cond, bar) do { unsigned _sp = 0; while (cond) { __builtin_amdgcn_s_sleep(1); \
    if ((++_sp & 255u) == 0u) { if (xb_ld(&(bar)[XB_TMO])) break; if (_sp > XB_SPIN_CAP) { atomicAdd(&(bar)[XB_TMO], 1u); break; } } } } while (0)

struct XcdBarrier {
    unsigned* bar; unsigned x;
    volatile LAS unsigned* st;
};

__device__ __forceinline__ XcdBarrier xcd_barrier_post(unsigned* bar, volatile LAS unsigned* st) {
    XcdBarrier b; b.bar = bar; b.x = xb_xcc_id(); b.st = st;
    if (threadIdx.x == 0) (void)xb_add(&bar[XB_XCNT(b.x)], 1u);
    return b;
}
__device__ __forceinline__ void xcd_barrier_complete(unsigned* bar, unsigned x, unsigned& nloc, unsigned& nx) {
    const unsigned G = gridDim.x * gridDim.y * gridDim.z;
    unsigned sum, cnt, mine, sp = 0u;
    for (;;) {
        sum = 0u; cnt = 0u; mine = 0u;
#pragma unroll
        for (unsigned j = 0; j < 16; ++j) { const unsigned c = xb_ld(&bar[XB_XCNT(j)]); sum += c; cnt += (c > 0u) ? 1u : 0u; mine = (j == x) ? c : mine; }
        if (sum == G) break;
        __builtin_amdgcn_s_sleep(1);
        if ((++sp & 255u) == 0u) { if (xb_ld(&bar[XB_TMO])) break; if (sp > XB_SPIN_CAP) { atomicAdd(&bar[XB_TMO], 1u); break; } }
    }
    nloc = mine > 0u ? mine : 1u; nx = cnt > 0u ? cnt : 1u;
}

__device__ __forceinline__ void xcd_barrier(const XcdBarrier& b) {
    asm volatile("s_waitcnt vmcnt(0)" ::: "memory");
    __syncthreads();
    if (threadIdx.x == 0) {
        unsigned* bar = b.bar;
        __builtin_amdgcn_s_waitcnt(0);
        unsigned nloc = b.st[0], nx = b.st[1];
        if (nloc == 0u) { xcd_barrier_complete(bar, b.x, nloc, nx); b.st[0] = nloc; b.st[1] = nx; }
        const unsigned old = xb_add(&bar[XB_XSUB(b.x)], 1u);
        const unsigned gen = old / nloc;
        if (old + 1u == (gen + 1u) * nloc) {
            __builtin_amdgcn_fence(__ATOMIC_RELEASE, "agent");
            asm volatile("s_waitcnt vmcnt(0)" ::: "memory");
            const unsigned og = xb_add(&bar[XB_TOP], 1u);
            const unsigned tg = og / nx;
            if (og + 1u == (tg + 1u) * nx) xb_add(&bar[XB_TOPGEN], 1u);
            else XB_SPIN(xb_ld(&bar[XB_TOPGEN]) == tg, bar);
            __builtin_amdgcn_fence(__ATOMIC_ACQUIRE, "agent");
            xb_add(&bar[XB_XGEN(b.x)], 1u);
            asm volatile("s_waitcnt vmcnt(0)" ::: "memory");
        } else {
            XB_SPIN(xb_ld(&bar[XB_XGEN(b.x)]) == gen, bar);
            __builtin_amdgcn_fence(__ATOMIC_ACQUIRE, "agent");
            asm volatile("s_waitcnt vmcnt(0)" ::: "memory");
        }
    }
    __syncthreads();
}
#define DI __device__ __forceinline__
constexpr int NWAVES = 8;
constexpr int NB = 16, SEQ = 2048, DM = 1024, MT = NB * SEQ;
constexpr int DIN_SRC = 6944, NPROJ = 7168;
constexpr int MEML = 256, MROWS = NB * MEML;
constexpr int NEXP = 32, TOPK = 4, DFF = 1024, MOEB = 256;
constexpr int NROWS = MT * TOPK;
constexpr int NBLK_MAX = (NROWS + NEXP * (MOEB - 1) + MOEB - 1) / MOEB;
constexpr int CAP = NBLK_MAX * MOEB;
constexpr float EPS = 1e-6f;
constexpr float NEGF = -1e30f;
constexpr int PC_MLQ = 0, PC_MLK = 512, PC_MLV = 1024, PC_MLO = 1536, PC_NQ = 2048, PC_NKC = 2560, PC_NVC = 2688, PC_NKS = 2816, PC_NVS = 2944,
              PC_NKW = 3072, PC_NVW = 3200, PC_MQ = 3328, PC_BRG = 3840, PC_MLI = 6912, PC_MLF = 6916, PC_NG = 6920, PC_END = 6944;
__host__ __device__ constexpr int proj_srccol(int j) {
    return j < 2048 ? j : j < 2560 ? 2056 + (j - 2048) : j < 3328 ? 2568 + (j - 2560) : j < 3840 ? 3360 + (j - 3328) : j < 6912 ? 3872 + (j - 3840)
         : j < 6920 ? 2048 + (j - 6912) : j < 6944 ? 3336 + (j - 6920) : -1;
}

constexpr size_t MiB = 1u << 20;
constexpr size_t WS_CTL = 0, CTL_ZERO_BYTES = 1 * MiB;
constexpr size_t WS_WIN = 1 * MiB, WS_WGU = 15 * MiB, WS_WDN = 143 * MiB, WS_WMKV = 207 * MiB, WS_WBR = 209 * MiB, WS_WOUT = 212 * MiB, WS_WC1 = 214 * MiB;
constexpr size_t WS_SMALL = 216 * MiB;
constexpr size_t WS_R1 = 218 * MiB;
constexpr size_t WS_PROJ = 282 * MiB;
constexpr size_t WS_R3 = 730 * MiB;
constexpr size_t WS_MEMKV = WS_R3, WS_MEMKN = WS_R3 + 8 * MiB, WS_QN = WS_R3 + 12 * MiB, WS_KSN = WS_R3 + 44 * MiB, WS_KWN = WS_R3 + 52 * MiB,
                 WS_MQN = WS_R3 + 60 * MiB, WS_MLQK = WS_R3 + 92 * MiB, WS_HID = WS_R3 + 156 * MiB, WS_KC = WS_R3 + 160 * MiB, WS_VC = WS_KC + MiB / 2,
                 WS_H0 = WS_R3 + 161 * MiB, WS_H1 = WS_H0 + 32 * MiB, WS_H2 = WS_H1 + 32 * MiB, WS_ROUTE = WS_H2 + 32 * MiB, WS_END = WS_ROUTE + 6 * MiB;
constexpr size_t WS_MEMN = WS_H0;
constexpr size_t WS_ACMP = WS_H1;
constexpr size_t WS_APERM = WS_PROJ;
constexpr size_t WS_ACT = WS_PROJ + 272 * MiB;
static_assert(WS_ACT + 272 * MiB <= WS_H0 + 96 * MiB && WS_END <= 1024 * MiB, "ws map");
constexpr size_t SM_ROPEC = 0, SM_ROPES = 256 * 1024, SM_CBIAS = 512 * 1024;
constexpr size_t RT_TOKE = 0, RT_TOKPOS = 512 * 1024, RT_TOKW = 1024 * 1024, RT_TOKDEST = 1536 * 1024, RT_ROWW = 2048 * 1024;
constexpr int CW_BAR = 4096;
constexpr int CW_ECNT = 16384;
constexpr int CW_QCTR = 16384 + 64;

constexpr int RING_BYTES = 131072, LDSCTL_OFF = RING_BYTES, MISC_OFF = LDSCTL_OFF + 320, LDS_BYTES = 147456;

struct Args { const float* in[34]; float* out; unsigned char* ws; int ph_lo, ph_hi, li, pad; };

DI float bf2f(unsigned short h) { return __uint_as_float((unsigned)h << 16); }
DI float wave_sum(float v) {
#pragma unroll
    for (int o = 1; o < 64; o <<= 1) v += __shfl_xor(v, o);
    return v;
}
DI float wave_max(float v) {
#pragma unroll
    for (int o = 1; o < 64; o <<= 1) v = fmaxf(v, __shfl_xor(v, o));
    return v;
}
DI float sigm(float x) { return 1.f / (1.f + __expf(-x)); }
DI float logsig(float x) { return fminf(x, 0.f) - log1pf(__expf(-fabsf(x))); }

namespace pg8 {
struct EpiBf16Silu {
    static constexpr bool PERM = true, AFTER_DRAIN = false;
    bf16_t* O; int ldc; const float* bias; int silu;
    DI void operator()(const f32x4 (&acc)[2][2][4][2], const Unit& u, int wr, int wc, int fr, int fq) const {
        const int row0 = u.pm * BM + wr * 64 + fr; const int col0 = u.pn * BM + wc * 32 + 8 * fq;
#pragma unroll
        for (int ai = 0; ai < 2; ++ai)
#pragma unroll
            for (int m = 0; m < 4; ++m) { bf16_t* rowp = O + (size_t)(row0 + ai * HALF + m * 16) * ldc + col0;
#pragma unroll
                for (int bj = 0; bj < 2; ++bj) { f32x4 v0 = acc[ai][bj][m][0], v1 = acc[ai][bj][m][1];
                    if (bias) { v0 += *(const f32x4*)(bias + col0 + bj * HALF); v1 += *(const f32x4*)(bias + col0 + bj * HALF + 4); }
                    if (silu) {
#pragma unroll
                        for (int j = 0; j < 4; ++j) { v0[j] = v0[j] / (1.f + __expf(-v0[j])); v1[j] = v1[j] / (1.f + __expf(-v1[j])); } }
                    u32x4 w; w.x = cvt_pk_bf16(v0[0], v0[1]); w.y = cvt_pk_bf16(v0[2], v0[3]); w.z = cvt_pk_bf16(v1[0], v1[1]); w.w = cvt_pk_bf16(v1[2], v1[3]);
                    *(u32x4*)(rowp + bj * HALF) = w; } }
    }
};
template <int B> struct EpiGate {
    static constexpr bool PERM = false, AFTER_DRAIN = false;
    const bf16_t* proj; float* tmp; bf16_t* merged;
    DI void operator()(const f32x4 (&acc)[2][2][4][2], const Unit& u, int wr, int wc, int fr, int fq) const {
        typedef unsigned u32x2v __attribute__((ext_vector_type(2)));
        const int col0 = u.pn * BM + wc * 32 + 4 * fq;
#pragma unroll
        for (int ai = 0; ai < 2; ++ai)
#pragma unroll
            for (int m = 0; m < 4; ++m) { const size_t r = (size_t)(u.pm * BM + ai * HALF + wr * 64 + m * 16 + fr);
#pragma unroll
                for (int bj = 0; bj < 2; ++bj)
#pragma unroll
                    for (int n = 0; n < 2; ++n) { const int c = col0 + bj * HALF + n * 16;
                        const u32x2v gw = *(const u32x2v*)(proj + r * NPROJ + PC_BRG + B * DM + c);
                        f32x4 g; g[0] = __uint_as_float(gw.x << 16); g[1] = __uint_as_float(gw.x & 0xffff0000u); g[2] = __uint_as_float(gw.y << 16); g[3] = __uint_as_float(gw.y & 0xffff0000u);
                        f32x4 v = acc[ai][bj][m][n];
#pragma unroll
                        for (int j = 0; j < 4; ++j) v[j] = v[j] / (1.f + __expf(-g[j]));
                        float* tp = tmp + r * DM + c;
                        if (B == 0) { *(f32x4*)tp = v; }
                        else if (B == 1) { *(f32x4*)tp = *(const f32x4*)tp + v; }
                        else { v = *(const f32x4*)tp + v; u32x2v w; w.x = cvt_pk_bf16(v[0], v[1]); w.y = cvt_pk_bf16(v[2], v[3]); *(u32x2v*)(merged + r * DM + c) = w; } } }
    }
};
struct EpiRes {
    static constexpr bool PERM = false, AFTER_DRAIN = false;
    const float* base; float* out;
    DI void operator()(const f32x4 (&acc)[2][2][4][2], const Unit& u, int wr, int wc, int fr, int fq) const {
        const int col0 = u.pn * BM + wc * 32 + 4 * fq;
#pragma unroll
        for (int ai = 0; ai < 2; ++ai)
#pragma unroll
            for (int m = 0; m < 4; ++m) { const size_t r = (size_t)(u.pm * BM + ai * HALF + wr * 64 + m * 16 + fr);
#pragma unroll
                for (int bj = 0; bj < 2; ++bj)
#pragma unroll
                    for (int n = 0; n < 2; ++n) { const int c = col0 + bj * HALF + n * 16; *(f32x4*)(out + r * DM + c) = *(const f32x4*)(base + r * DM + c) + acc[ai][bj][m][n]; } }
    }
};
struct EpiSwiglu {
    static constexpr bool PERM = true, AFTER_DRAIN = false;
    bf16_t* act; const float* bgu;
    DI void operator()(const f32x4 (&acc)[2][2][4][2], const Unit& u, int wr, int wc, int fr, int fq) const {
        typedef unsigned u32x2v __attribute__((ext_vector_type(2)));
        const int e = u.pn >> 3, pnl = u.pn & 7;
        const int lc0 = pnl * BM + wc * 32 + 8 * fq;
        const int row0 = u.pm * BM + wr * 64 + fr;
#pragma unroll
        for (int ai = 0; ai < 2; ++ai)
#pragma unroll
            for (int m = 0; m < 4; ++m) { bf16_t* rowp = act + (size_t)(row0 + ai * HALF + m * 16) * DFF;
#pragma unroll
                for (int bj = 0; bj < 2; ++bj) {
                    const int lc = lc0 + bj * HALF;
                    const f32x4 b0 = *(const f32x4*)(bgu + e * 2048 + lc), b1 = *(const f32x4*)(bgu + e * 2048 + lc + 4);
                    const f32x4 v0 = acc[ai][bj][m][0] + b0, v1 = acc[ai][bj][m][1] + b1;
                    float o[4];
#pragma unroll
                    for (int q = 0; q < 4; ++q) { const float gt = fminf(q < 2 ? v0[2 * q] : v1[2 * q - 4], 7.0f); float up = q < 2 ? v0[2 * q + 1] : v1[2 * q - 3]; up = fminf(fmaxf(up, -7.0f), 7.0f);
                        o[q] = (up + 1.0f) * (gt / (1.f + __expf(-1.702f * gt))); }
                    u32x2v w; w.x = cvt_pk_bf16(o[0], o[1]); w.y = cvt_pk_bf16(o[2], o[3]);
                    *(u32x2v*)(rowp + (lc >> 1)) = w; } }
    }
};
struct EpiDown {
    static constexpr bool PERM = false, AFTER_DRAIN = false;
    bf16_t* y; const float* bdn; const float* roww;
    DI void operator()(const f32x4 (&acc)[2][2][4][2], const Unit& u, int wr, int wc, int fr, int fq) const {
        typedef unsigned u32x2v __attribute__((ext_vector_type(2)));
        const int e = u.pn >> 2, pnl = u.pn & 3;
        const int col0 = pnl * BM + wc * 32 + 4 * fq;
#pragma unroll
        for (int ai = 0; ai < 2; ++ai)
#pragma unroll
            for (int m = 0; m < 4; ++m) { const size_t r = (size_t)(u.pm * BM + ai * HALF + wr * 64 + m * 16 + fr); const float rw = roww[r];
#pragma unroll
                for (int bj = 0; bj < 2; ++bj)
#pragma unroll
                    for (int n = 0; n < 2; ++n) { const int c = col0 + bj * HALF + n * 16; const f32x4 v = (acc[ai][bj][m][n] + *(const f32x4*)(bdn + e * DM + c)) * rw;
                        u32x2v w; w.x = cvt_pk_bf16(v[0], v[1]); w.y = cvt_pk_bf16(v[2], v[3]); *(u32x2v*)(y + r * DM + c) = w; } }
    }
};
template <int NPN> struct MoeOrder {
    int nunits, G, c; const PG8_LAS unsigned char* blk_e;
    DI bool next(int i, Unit& u) const { const int L = i * G + c; if (L >= nunits) return false; const int rb = L / NPN; u.pm = rb; u.pn = (int)blk_e[rb] * NPN + (L % NPN); return true; }
    DI void a_ready(const Unit&) const {}
    DI void done(const Unit&) const {}
};
}

struct Frame {
    LAS unsigned char* lds; volatile LAS unsigned* MISC; unsigned* ctl; unsigned char* ws;
    int tid, lane, wave, G, bx;
    const float* const* in; float* out;
};
enum { I_X = 0, I_MEM, I_GMIX, I_WIN, I_CONVW, I_CONVB, I_MLBI, I_MLBF, I_MLGOUT, I_NGQ, I_NGK, I_CPK, I_CW1K, I_CB1K, I_CW2K, I_CPV, I_CW1V, I_CB1V, I_CW2V,
       I_GMEM, I_WMKV, I_MGQ, I_MGK, I_WBRML, I_WBRNSA, I_WBRMEM, I_WOUT, I_GFFN, I_WR, I_BR, I_WGU, I_BGU, I_WDN, I_BDN, N_IN };

template <class CM>
DI void tr_item(const float* W, int ldw, int K, bf16* WT, int k0, int n0, CM cm, LAS float* scr, int lane) {
    const int sc = cm(n0 + (lane & 31));
#pragma unroll 8
    for (int i = 0; i < 32; ++i) { const int kk = 2 * i + (lane >> 5); scr[kk * 33 + (lane & 31)] = sc >= 0 ? W[(size_t)(k0 + kk) * ldw + sc] : 0.f; }
    LDS_WAIT(); asm volatile("" ::: "memory");
    const int c = lane & 7;
#pragma unroll
    for (int j = 0; j < 4; ++j) { const int n = (lane >> 3) + 8 * j; const LAS float* s = scr + (8 * c) * 33 + n;
        v4u o; o.x = pk2(s[0 * 33], s[1 * 33]); o.y = pk2(s[2 * 33], s[3 * 33]); o.z = pk2(s[4 * 33], s[5 * 33]); o.w = pk2(s[6 * 33], s[7 * 33]);
        *(v4u*)(WT + (size_t)(n0 + n) * K + k0 + 8 * c) = o; }
    LDS_WAIT(); asm volatile("" ::: "memory");
}
struct CmId { DI int operator()(int j) const { return j; } };
struct CmProj { DI int operator()(int j) const { return proj_srccol(j); } };

DI void rms_row_bf16(const float* xrow, const float* g, bf16* orow, int lane) {
    const f32x4* xr = (const f32x4*)xrow + lane; const f32x4* gr = (const f32x4*)g + lane;
    f32x4 v[4]; float s = 0.f;
#pragma unroll
    for (int j = 0; j < 4; ++j) { v[j] = xr[64 * j]; s += (v[j].x * v[j].x + v[j].y * v[j].y) + (v[j].z * v[j].z + v[j].w * v[j].w); }
    const float rstd = rsqrtf(wave_sum(s) * (1.f / DM) + EPS);
    unsigned long long* o8 = (unsigned long long*)orow + lane;
#pragma unroll
    for (int j = 0; j < 4; ++j) { const f32x4 gg = gr[64 * j];
        o8[64 * j] = (unsigned long long)pk2(v[j].x * rstd * gg.x, v[j].y * rstd * gg.y) | ((unsigned long long)pk2(v[j].z * rstd * gg.z, v[j].w * rstd * gg.w) << 32); }
}

DI void p0_prologue(Frame& F) {
    LAS float* scr = (LAS float*)(F.lds + F.wave * 16384);
    const int gw = F.bx * NWAVES + F.wave, NGW = F.G * NWAVES;
    unsigned char* ws = F.ws;
    constexpr int IT_IN = 16 * (NPROJ / 32), IT_GU = 32 * 16 * 64, IT_DN = 32 * 16 * 32, IT_MKV = 16 * 32, IT_BR = 3 * 8 * 32, IT_OUT = 16 * 32, IT_C1 = 2 * 32 * 8;
    constexpr int NITEMS = IT_IN + IT_GU + IT_DN + IT_MKV + IT_BR + IT_OUT + IT_C1;
    for (int it = gw; it < NITEMS; it += NGW) {
        int r = it;
        if (r < IT_IN) { const int kb = r / (NPROJ / 32), nb = r % (NPROJ / 32); tr_item(F.in[I_WIN], DIN_SRC, DM, (bf16*)(ws + WS_WIN), 64 * kb, 32 * nb, CmProj(), scr, F.lane); continue; } r -= IT_IN;
        if (r < IT_GU) { const int e = r / 1024, q = r % 1024, kb = q / 64, nb = q % 64; tr_item(F.in[I_WGU] + (size_t)e * DM * 2048, 2048, DM, (bf16*)(ws + WS_WGU) + (size_t)e * 2048 * DM, 64 * kb, 32 * nb, CmId(), scr, F.lane); continue; } r -= IT_GU;
        if (r < IT_DN) { const int e = r / 512, q = r % 512, kb = q / 32, nb = q % 32; tr_item(F.in[I_WDN] + (size_t)e * DFF * DM, DM, DFF, (bf16*)(ws + WS_WDN) + (size_t)e * DM * DFF, 64 * kb, 32 * nb, CmId(), scr, F.lane); continue; } r -= IT_DN;
        if (r < IT_MKV) { const int kb = r / 32, nb = r % 32; tr_item(F.in[I_WMKV], 1024, 1024, (bf16*)(ws + WS_WMKV), 64 * kb, 32 * nb, CmId(), scr, F.lane); continue; } r -= IT_MKV;
        if (r < IT_BR) { const int b = r / 256, q = r % 256, kb = q / 32, nb = q % 32; tr_item(F.in[I_WBRML + b], 1024, 512, (bf16*)(ws + WS_WBR) + (size_t)b * 1024 * 512, 64 * kb, 32 * nb, CmId(), scr, F.lane); continue; } r -= IT_BR;
        if (r < IT_OUT) { const int kb = r / 32, nb = r % 32; tr_item(F.in[I_WOUT], 1024, 1024, (bf16*)(ws + WS_WOUT), 64 * kb, 32 * nb, CmId(), scr, F.lane); continue; } r -= IT_OUT;
        { const int kv = r / 256, q = r % 256, kb = q / 8, nb = q % 8; tr_item(F.in[kv ? I_CW1V : I_CW1K], 256, 2048, (bf16*)(ws + WS_WC1) + (size_t)kv * 256 * 2048, 64 * kb, 32 * nb, CmId(), scr, F.lane); }
    }
    for (int m = gw; m < MT; m += NGW) rms_row_bf16(F.in[I_X] + (size_t)m * DM, F.in[I_GMIX], (bf16*)(ws + WS_R1) + (size_t)m * DM, F.lane);
    for (int m = gw; m < MROWS; m += NGW) rms_row_bf16(F.in[I_MEM] + (size_t)m * DM, F.in[I_GMEM], (bf16*)(ws + WS_MEMN) + (size_t)m * DM, F.lane);
    float* rc = (float*)(ws + WS_SMALL + SM_ROPEC); float* rs = (float*)(ws + WS_SMALL + SM_ROPES);
    for (int i = F.bx * 512 + F.tid; i < SEQ * 32; i += F.G * 512) {
        const int p = i >> 5, k = i & 31;
        const float invf = exp2f(-(float)k * (13.287712379549449f / 32.0f));
        const float ang = (float)p * invf;
        const float kf = rintf(ang * 0.15915494309189535f);
        float r = fmaf(-kf, 6.28125f, ang); r = fmaf(-kf, 1.9353071795864769e-3f, r);
        rc[i] = cosf(r); rs[i] = sinf(r);
    }
    if (F.bx == F.G - 1) {
        const int kv = F.tid >> 8, f = F.tid & 255;
        const float* pe = F.in[kv ? I_CPV : I_CPK]; const float* w1 = F.in[kv ? I_CW1V : I_CW1K];
        float a = F.in[kv ? I_CB1V : I_CB1K][f];
        for (int k = 0; k < 2048; ++k) a = fmaf(pe[k], w1[(size_t)k * 256 + f], a);
        ((float*)(ws + WS_SMALL + SM_CBIAS))[kv * 256 + f] = a;
    }
}

DI void p2_prep(Frame& F) {
    unsigned char* ws = F.ws;
    const int gw = F.bx * NWAVES + F.wave, NGW = F.G * NWAVES, lane = F.lane;
    const bf16* proj = (const bf16*)(ws + WS_PROJ);
    const float* rc = (const float*)(ws + WS_SMALL + SM_ROPEC); const float* rs = (const float*)(ws + WS_SMALL + SM_ROPES);
    bf16* qn = (bf16*)(ws + WS_QN); bf16* ksn = (bf16*)(ws + WS_KSN); bf16* kwn = (bf16*)(ws + WS_KWN); bf16* mqn = (bf16*)(ws + WS_MQN); bf16* mlqk = (bf16*)(ws + WS_MLQK);
    bf16* acmp = (bf16*)(ws + WS_ACMP);
    const float gq = F.in[I_NGQ][lane], gks = F.in[I_NGK][64 + lane], gkw = F.in[I_NGK][128 + lane];
    const float mg0 = F.in[I_MGQ][lane], mg1 = F.in[I_MGQ][64 + lane];
    for (int t = gw; t < MT; t += NGW) {
        const int b = t >> 11, tau = t & 2047;
        const bf16* pr = proj + (size_t)t * NPROJ;
        const float c = rc[tau * 32 + (lane & 31)], s = rs[tau * 32 + (lane & 31)];
#pragma unroll
        for (int h = 0; h < 12; ++h) {
            const int col = h < 8 ? PC_NQ + h * 64 : h < 10 ? PC_NKS + (h - 8) * 64 : PC_NKW + (h - 10) * 64;
            const float g = h < 8 ? gq : h < 10 ? gks : gkw;
            const float v = bf2f(pr[col + lane]);
            const float y = v * rsqrtf(wave_sum(v * v) * (1.f / 64.f) + EPS) * g;
            const float pt = __shfl_xor(y, 32);
            float o = lane < 32 ? y * c - pt * s : y * c + pt * s;
            if (h < 8) qn[(size_t)t * 512 + h * 64 + lane] = (bf16)f2bf(o * (0.125f * 1.4426950408889634f));
            else if (h < 10) ksn[(size_t)t * 128 + (h - 8) * 64 + lane] = (bf16)f2bf(o);
            else kwn[(size_t)t * 128 + (h - 10) * 64 + lane] = (bf16)f2bf(o);
        }
#pragma unroll
        for (int h = 0; h < 4; ++h) {
            const float v0 = bf2f(pr[PC_MQ + h * 128 + lane]), v1 = bf2f(pr[PC_MQ + h * 128 + 64 + lane]);
            const float rstd = rsqrtf(wave_sum(v0 * v0 + v1 * v1) * (1.f / 128.f) + EPS) * (0.08838834764831845f * 1.4426950408889634f);
            mqn[(size_t)t * 512 + h * 128 + lane] = (bf16)f2bf(v0 * rstd * mg0); mqn[(size_t)t * 512 + h * 128 + 64 + lane] = (bf16)f2bf(v1 * rstd * mg1);
        }
        for (int cc = lane; cc < 1024; cc += 64) {
            float a = F.in[I_CONVB][cc];
#pragma unroll
            for (int j = 0; j < 4; ++j) { const int tt = tau - 3 + j; if (tt >= 0) a = fmaf(F.in[I_CONVW][j * 1024 + cc], bf2f(proj[(size_t)(t - 3 + j) * NPROJ + cc]), a); }
            mlqk[(size_t)t * 1024 + cc] = (bf16)f2bf(a * sigm(a));
        }
#pragma unroll
        for (int kv = 0; kv < 2; ++kv)
#pragma unroll
            for (int h = 0; h < 2; ++h) {
                const bf16 val = pr[PC_NKC + kv * 128 + h * 64 + lane];
                const int nA = tau >> 4;
#pragma unroll
                for (int dn = 0; dn < 2; ++dn) { const int n = nA - dn; if (n >= 0 && n <= 126) { const int l = tau - 16 * n;
                    acmp[(size_t)kv * 4096 * 2048 + (size_t)((b * 2 + h) * 128 + n) * 2048 + l * 64 + lane] = val; } }
            }
    }
    for (int i = F.bx * 512 + F.tid; i < 2 * 32 * 2048; i += F.G * 512) { const int kv = i / (32 * 2048), q = i % (32 * 2048), bh = q / 2048, col = q % 2048;
        acmp[(size_t)kv * 4096 * 2048 + (size_t)(bh * 128 + 127) * 2048 + col] = 0; }
    const bf16* memkv = (const bf16*)(ws + WS_MEMKV); bf16* memkn = (bf16*)(ws + WS_MEMKN);
    const float kg0 = F.in[I_MGK][lane], kg1 = F.in[I_MGK][64 + lane];
    for (int r = gw; r < MROWS; r += NGW) {
#pragma unroll
        for (int h = 0; h < 4; ++h) {
            const float v0 = bf2f(memkv[(size_t)r * 1024 + h * 128 + lane]), v1 = bf2f(memkv[(size_t)r * 1024 + h * 128 + 64 + lane]);
            const float rstd = rsqrtf(wave_sum(v0 * v0 + v1 * v1) * (1.f / 128.f) + EPS);
            memkn[(size_t)r * 512 + h * 128 + lane] = (bf16)f2bf(v0 * rstd * kg0); memkn[(size_t)r * 512 + h * 128 + 64 + lane] = (bf16)f2bf(v1 * rstd * kg1);
        }
    }
}

DI void p4_kcvc(Frame& F) {
    unsigned char* ws = F.ws;
    const int gw = F.bx * NWAVES + F.wave, NGW = F.G * NWAVES, lane = F.lane;
    const bf16* hid = (const bf16*)(ws + WS_HID);
    const float* rc = (const float*)(ws + WS_SMALL + SM_ROPEC); const float* rs = (const float*)(ws + WS_SMALL + SM_ROPES);
    const float gk = F.in[I_NGK][lane];
    for (int it = gw; it < 2 * 4096; it += NGW) {
        const int kv = it >> 12, r = it & 4095, n = r & 127;
        bf16* dst = (bf16*)(ws + (kv ? WS_VC : WS_KC)) + (size_t)r * 64 + lane;
        if (n == 127) { *dst = 0; continue; }
        const bf16* hr = hid + (size_t)kv * 4096 * 256 + (size_t)r * 256; const float* w2 = F.in[kv ? I_CW2V : I_CW2K];
        float a = 0.f;
        for (int f = 0; f < 256; ++f) a = fmaf(bf2f(hr[f]), w2[f * 64 + lane], a);
        if (kv == 0) {
            const float y = a * rsqrtf(wave_sum(a * a) * (1.f / 64.f) + EPS) * gk;
            const int pos = 16 * n + 31; const float c = rc[pos * 32 + (lane & 31)], s = rs[pos * 32 + (lane & 31)];
            const float pt = __shfl_xor(y, 32);
            a = lane < 32 ? y * c - pt * s : y * c + pt * s;
        }
        *dst = (bf16)f2bf(a);
    }
}

DI void mlstm_unit(Frame& F, int unit) {
    unsigned char* ws = F.ws;
    const int b = unit >> 2, h = unit & 3, tid = F.tid, kk = tid >> 7, c = tid & 127;
    const bf16* proj = (const bf16*)(ws + WS_PROJ); const bf16* mlqk = (const bf16*)(ws + WS_MLQK); bf16* H0 = (bf16*)(ws + WS_H0);
    LAS float* qs = (LAS float*)F.lds;
    LAS float* ks = qs + 16 * 128;
    LAS float* vs = ks + 16 * 128;
    LAS float* gi = vs + 16 * 128;
    LAS float* gf = gi + 16;
    LAS float* part = gf + 16;
    LAS float* pden = part + 2 * 4 * 128;
    LAS float* hb = pden + 8;
    float C[32], nn[32];
#pragma unroll
    for (int i = 0; i < 32; ++i) { C[i] = 0.f; nn[i] = 0.f; }
    float m = 0.f;
    const float bi = F.in[I_MLBI][h], bfv = F.in[I_MLBF][h];
    const float scale = 0.08838834764831845f;
#pragma unroll 1
    for (int t0 = 0; t0 < SEQ; t0 += 16) {
        __syncthreads();
        for (int i = tid; i < 16 * 128; i += 512) { const int s = i >> 7, d = i & 127; const size_t t = (size_t)b * SEQ + t0 + s;
            qs[i] = bf2f(mlqk[t * 1024 + h * 128 + d]); ks[i] = bf2f(mlqk[t * 1024 + 512 + h * 128 + d]); vs[i] = bf2f(proj[t * NPROJ + PC_MLV + h * 128 + d]); }
        if (tid < 16) { const size_t t = (size_t)b * SEQ + t0 + tid; gi[tid] = bf2f(proj[t * NPROJ + PC_MLI + h]) + bi; gf[tid] = logsig(bf2f(proj[t * NPROJ + PC_MLF + h]) + bfv); }
        __syncthreads();
#pragma unroll 1
        for (int s = 0; s < 16; ++s) {
            const float lf = gf[s], ig = gi[s];
            const float mn = fmaxf(lf + m, ig), a = __expf(lf + m - mn), bb = __expf(ig - mn);
            m = mn;
            const float v = vs[s * 128 + c];
            float pn = 0.f, pd = 0.f;
#pragma unroll
            for (int i = 0; i < 32; ++i) { const float kvv = ks[s * 128 + kk * 32 + i], qv = qs[s * 128 + kk * 32 + i];
                C[i] = a * C[i] + bb * kvv * v; nn[i] = a * nn[i] + bb * kvv; pn = fmaf(qv, C[i], pn); pd = fmaf(qv, nn[i], pd); }
            const int par = s & 1;
            part[(par * 4 + kk) * 128 + c] = pn; if (c == 0) pden[par * 4 + kk] = pd;
            __syncthreads();
            if (kk == 0) {
                const float num = (part[(par * 4 + 0) * 128 + c] + part[(par * 4 + 1) * 128 + c]) + (part[(par * 4 + 2) * 128 + c] + part[(par * 4 + 3) * 128 + c]);
                const float den = (pden[par * 4 + 0] + pden[par * 4 + 1]) + (pden[par * 4 + 2] + pden[par * 4 + 3]);
                hb[s * 128 + c] = num * scale / fmaxf(fabsf(den * scale), __expf(-mn));
            }
        }
        __syncthreads();
#pragma unroll
        for (int rr = 0; rr < 2; ++rr) { const int s = F.wave * 2 + rr; const size_t t = (size_t)b * SEQ + t0 + s;
            const float v0 = hb[s * 128 + F.lane], v1 = hb[s * 128 + 64 + F.lane];
            const float rstd = rsqrtf(wave_sum(v0 * v0 + v1 * v1) * (1.f / 128.f) + EPS);
            const float o0 = bf2f(proj[t * NPROJ + PC_MLO + h * 128 + F.lane]), o1 = bf2f(proj[t * NPROJ + PC_MLO + h * 128 + 64 + F.lane]);
            H0[t * 512 + h * 128 + F.lane] = (bf16)f2bf(v0 * rstd * F.in[I_MLGOUT][h * 128 + F.lane] * sigm(o0));
            H0[t * 512 + h * 128 + 64 + F.lane] = (bf16)f2bf(v1 * rstd * F.in[I_MLGOUT][h * 128 + 64 + F.lane] * sigm(o1)); }
    }
    __syncthreads();
}

DI void nsa_scores(const bf16* krow, bool valid, const LAS float* qs, float (&s)[4]) {
    s[0] = s[1] = s[2] = s[3] = 0.f;
    if (valid) {
#pragma unroll 2
        for (int c8 = 0; c8 < 8; ++c8) { const v4u kk = *(const v4u*)(krow + c8 * 8);
            const unsigned w[4] = {kk.x, kk.y, kk.z, kk.w};
#pragma unroll
            for (int j = 0; j < 4; ++j) { const float k0 = __uint_as_float(w[j] << 16), k1 = __uint_as_float(w[j] & 0xffff0000u); const int d = c8 * 8 + 2 * j;
#pragma unroll
                for (int g = 0; g < 4; ++g) s[g] = fmaf(k1, qs[g * 64 + d + 1], fmaf(k0, qs[g * 64 + d], s[g])); } }
    }
}
DI void nsa_wave(Frame& F, int item, LAS float* wl) {
    unsigned char* ws = F.ws; const int lane = F.lane;
    const int t = item >> 1, hkv = item & 1, b = t >> 11, tau = t & 2047;
    const bf16* proj = (const bf16*)(ws + WS_PROJ);
    const bf16* qn = (const bf16*)(ws + WS_QN); const bf16* ksn = (const bf16*)(ws + WS_KSN); const bf16* kwn = (const bf16*)(ws + WS_KWN);
    const bf16* kc = (const bf16*)(ws + WS_KC); const bf16* vc = (const bf16*)(ws + WS_VC); bf16* H1 = (bf16*)(ws + WS_H1);
    LAS float* qs = wl;
    LAS float* ps = wl + 256;
    LAS float* psum = wl + 768;
#pragma unroll
    for (int g = 0; g < 4; ++g) qs[g * 64 + lane] = bf2f(qn[(size_t)t * 512 + (hkv * 4 + g) * 64 + lane]);
    float ofin[4] = {0.f, 0.f, 0.f, 0.f};
    float gate[4][3];
#pragma unroll
    for (int g = 0; g < 4; ++g)
#pragma unroll
        for (int cidx = 0; cidx < 3; ++cidx) gate[g][cidx] = sigm(bf2f(proj[(size_t)t * NPROJ + PC_NG + (hkv * 4 + g) * 3 + cidx]));
    const int ncmp = tau >= 31 ? ((tau - 31) >> 4) + 1 : 0;
    {
        float l[4] = {0.f, 0.f, 0.f, 0.f}, o[4] = {0.f, 0.f, 0.f, 0.f};
        const size_t rbase = (size_t)(b * 2 + hkv) * 128;
#pragma unroll
        for (int blk = 0; blk < 2; ++blk) { const int n = blk * 64 + lane; const bool valid = n < ncmp; float s[4];
            nsa_scores(kc + (rbase + n) * 64, valid, qs, s);
#pragma unroll
            for (int g = 0; g < 4; ++g) { const float p = valid ? __expf(s[g]) : 0.f; l[g] += p; ps[g * 128 + n] = p; } }
        float inv[4];
#pragma unroll
        for (int g = 0; g < 4; ++g) { const float L = wave_sum(l[g]); inv[g] = L > 0.f ? 1.f / L : 0.f; }
#pragma unroll
        for (int blk = 0; blk < 2; ++blk) { const int n = blk * 64 + lane; psum[n] = (ps[0 * 128 + n] * inv[0] + ps[1 * 128 + n] * inv[1]) + (ps[2 * 128 + n] * inv[2] + ps[3 * 128 + n] * inv[3]); }
#pragma unroll 2
        for (int n = 0; n < ncmp; ++n) { const float vv = bf2f(vc[(rbase + n) * 64 + lane]);
#pragma unroll
            for (int g = 0; g < 4; ++g) o[g] = fmaf(ps[g * 128 + n], vv, o[g]); }
#pragma unroll
        for (int g = 0; g < 4; ++g) ofin[g] += gate[g][0] * o[g] * inv[g];
    }
    const int cur = tau >> 6;
    unsigned selmask = 0u;
    {
        float score = -3.0e38f;
        if (lane < 32) { const int j = lane; float imp = 0.f;
#pragma unroll
            for (int dn = -1; dn <= 3; ++dn) { const int n = 4 * j + dn; if (n >= 0 && n <= 126) imp += psum[n]; }
            const bool forced = (j == 0) || (j == cur) || (j == cur - 1);
            score = j > cur ? NEGF : imp + (forced ? 1.0e4f : 0.f); }
#pragma unroll 1
        for (int r = 0; r < 8; ++r) { const float mx = wave_max(score); const unsigned long long bal = __ballot(score == mx); const int win = __ffsll((long long)bal) - 1;
            selmask |= 1u << win; if (lane == win) score = -3.4e38f; }
    }
    {
        float l[4] = {0.f, 0.f, 0.f, 0.f}, o[4] = {0.f, 0.f, 0.f, 0.f};
#pragma unroll 1
        for (int j = 0; j <= cur; ++j) { if (!((selmask >> j) & 1u)) continue;
            const int kpos = 64 * j + lane; const bool valid = kpos <= tau; float s[4];
            nsa_scores(ksn + ((size_t)b * SEQ + kpos) * 128 + hkv * 64, valid, qs, s);
#pragma unroll
            for (int g = 0; g < 4; ++g) { const float p = valid ? __expf(s[g]) : 0.f; l[g] += p; ps[g * 128 + lane] = p; }
            const int nk = j == cur ? (tau & 63) + 1 : 64;
            const bf16* vb = proj + ((size_t)b * SEQ + 64 * j) * NPROJ + PC_NVS + hkv * 64 + lane;
#pragma unroll 2
            for (int k = 0; k < nk; ++k) { const float vv = bf2f(vb[(size_t)k * NPROJ]);
#pragma unroll
                for (int g = 0; g < 4; ++g) o[g] = fmaf(ps[g * 128 + k], vv, o[g]); } }
#pragma unroll
        for (int g = 0; g < 4; ++g) { const float L = wave_sum(l[g]); ofin[g] += gate[g][1] * o[g] * (L > 0.f ? 1.f / L : 0.f); }
    }
    {
        float l[4] = {0.f, 0.f, 0.f, 0.f}, o[4] = {0.f, 0.f, 0.f, 0.f};
        const int start = tau - 511 > 0 ? tau - 511 : 0;
#pragma unroll 1
        for (int base = start & ~63; base <= tau; base += 64) {
            const int kpos = base + lane; const bool valid = kpos >= start && kpos <= tau; float s[4];
            nsa_scores(kwn + ((size_t)b * SEQ + kpos) * 128 + hkv * 64, valid, qs, s);
#pragma unroll
            for (int g = 0; g < 4; ++g) { const float p = valid ? __expf(s[g]) : 0.f; l[g] += p; ps[g * 128 + lane] = p; }
            const int k0 = start > base ? start - base : 0, k1 = tau - base < 63 ? tau - base : 63;
            const bf16* vb = proj + ((size_t)b * SEQ + base) * NPROJ + PC_NVW + hkv * 64 + lane;
#pragma unroll 2
            for (int k = k0; k <= k1; ++k) { const float vv = bf2f(vb[(size_t)k * NPROJ]);
#pragma unroll
                for (int g = 0; g < 4; ++g) o[g] = fmaf(ps[g * 128 + k], vv, o[g]); } }
#pragma unroll
        for (int g = 0; g < 4; ++g) { const float L = wave_sum(l[g]); ofin[g] += gate[g][2] * o[g] * (L > 0.f ? 1.f / L : 0.f); }
    }
#pragma unroll
    for (int g = 0; g < 4; ++g) H1[(size_t)t * 512 + (hkv * 4 + g) * 64 + lane] = (bf16)f2bf(ofin[g]);
}
DI void mem_wave(Frame& F, int t, LAS float* wl) {
    unsigned char* ws = F.ws; const int lane = F.lane; const int b = t >> 11;
    const bf16* mqn = (const bf16*)(ws + WS_MQN); const bf16* memkn = (const bf16*)(ws + WS_MEMKN); const bf16* memkv = (const bf16*)(ws + WS_MEMKV); bf16* H2 = (bf16*)(ws + WS_H2);
    LAS float* qs = wl;
    LAS float* ps = wl + 128;
#pragma unroll 1
    for (int h = 0; h < 4; ++h) {
        qs[lane] = bf2f(mqn[(size_t)t * 512 + h * 128 + lane]); qs[64 + lane] = bf2f(mqn[(size_t)t * 512 + h * 128 + 64 + lane]);
        float l = 0.f;
#pragma unroll 1
        for (int kq = 0; kq < 4; ++kq) { const int key = kq * 64 + lane; const bf16* kr = memkn + ((size_t)b * MEML + key) * 512 + h * 128; float s = 0.f;
#pragma unroll 2
            for (int c8 = 0; c8 < 16; ++c8) { const v4u kk = *(const v4u*)(kr + c8 * 8); const unsigned w[4] = {kk.x, kk.y, kk.z, kk.w};
#pragma unroll
                for (int j = 0; j < 4; ++j) s = fmaf(__uint_as_float(w[j] & 0xffff0000u), qs[c8 * 8 + 2 * j + 1], fmaf(__uint_as_float(w[j] << 16), qs[c8 * 8 + 2 * j], s)); }
            const float p = __expf(s); l += p; ps[key] = p; }
        const float inv = 1.f / wave_sum(l);
        float o0 = 0.f, o1 = 0.f;
        const bf16* vb = memkv + (size_t)b * MEML * 1024 + 512 + h * 128;
#pragma unroll 4
        for (int key = 0; key < MEML; ++key) { const float p = ps[key]; o0 = fmaf(p, bf2f(vb[(size_t)key * 1024 + lane]), o0); o1 = fmaf(p, bf2f(vb[(size_t)key * 1024 + 64 + lane]), o1); }
        H2[(size_t)t * 512 + h * 128 + lane] = (bf16)f2bf(o0 * inv); H2[(size_t)t * 512 + h * 128 + 64 + lane] = (bf16)f2bf(o1 * inv);
    }
}
typedef float f32x16 __attribute__((ext_vector_type(16)));
typedef float f32x2v __attribute__((ext_vector_type(2)));
typedef __bf16 bf16x2v __attribute__((ext_vector_type(2)));
typedef short s16x4 __attribute__((ext_vector_type(4)));
typedef unsigned u32x2 __attribute__((ext_vector_type(2)));
#define MFMA32(a, b, c) __builtin_amdgcn_mfma_f32_32x32x16_bf16((a), (b), (c), 0, 0, 0)
#define WG_BAR() do { asm volatile("s_waitcnt vmcnt(0) lgkmcnt(0)" ::: "memory"); __builtin_amdgcn_s_barrier(); asm volatile("" ::: "memory"); } while (0)
DI unsigned pkbf(float lo, float hi) { f32x2v v = {lo, hi}; return __builtin_bit_cast(unsigned, __builtin_convertvector(v, bf16x2v)); }
template <int S> DI bf16x8 pack8(const f32x16& x) {
    v4u p; p.x = pkbf(x[8 * S], x[8 * S + 1]); p.y = pkbf(x[8 * S + 2], x[8 * S + 3]); p.z = pkbf(x[8 * S + 4], x[8 * S + 5]); p.w = pkbf(x[8 * S + 6], x[8 * S + 7]);
    return __builtin_bit_cast(bf16x8, p);
}
DI int crow(int i, int h) { return (i & 3) + 8 * (i >> 2) + 4 * h; }
constexpr int AT_K = 0, AT_V = 16384, AT_IMP = 32768, AT_WM = 65536, AT_INV = 65536 + 64, AT_SC = 65536 + 64 + 1024;

DI void at_load(LAS unsigned char* lds, int par, const void* kb, size_t kpitch, const void* vb, size_t vpitch, int wave, int lane) {
    const int row = 8 * wave + (lane >> 3), pc = lane & 7;
    const int kc = pc ^ ((row >> 1) & 7), vc = pc ^ (((row >> 1) & 1) << 2);
    __builtin_amdgcn_global_load_lds((const unsigned*)((const char*)kb + (size_t)row * kpitch + 16 * kc), (LAS unsigned*)(lds + AT_K + par * 8192 + wave * 1024), 16, 0, 0);
    __builtin_amdgcn_global_load_lds((const unsigned*)((const char*)vb + (size_t)row * vpitch + 16 * vc), (LAS unsigned*)(lds + AT_V + par * 8192 + wave * 1024), 16, 0, 0);
}
DI void at_qk(const LAS unsigned char* kbuf, const int (&ka)[4], const bf16x8 (&qf)[4], f32x16 (&s)[2]) {
#pragma unroll
    for (int kb = 0; kb < 2; ++kb) {
        f32x16 a;
#pragma unroll
        for (int i = 0; i < 16; ++i) a[i] = 0.f;
#pragma unroll
        for (int st = 0; st < 4; ++st) { const bf16x8 kf = *(const LAS bf16x8*)(kbuf + ka[st] + kb * 4096); a = MFMA32(kf, qf[st], a); }
        s[kb] = a;
    }
}
DI void at_pv(const LAS unsigned char* vbuf, const int (&va)[2], const f32x16 (&p)[2], f32x16 (&o)[2]) {
    typedef __attribute__((address_space(3))) s16x4 lds_s16x4;
#pragma unroll
    for (int kb = 0; kb < 2; ++kb) {
        const bf16x8 pf0 = pack8<0>(p[kb]), pf1 = pack8<1>(p[kb]);
#pragma unroll
        for (int s2 = 0; s2 < 2; ++s2)
#pragma unroll
            for (int db = 0; db < 2; ++db) {
                const s16x4 lo = __builtin_amdgcn_ds_read_tr16_b64_v4i16((lds_s16x4*)(vbuf + va[db] + kb * 4096 + s2 * 2048));
                const s16x4 hi = __builtin_amdgcn_ds_read_tr16_b64_v4i16((lds_s16x4*)(vbuf + va[db] + kb * 4096 + s2 * 2048 + 1024));
                const bf16x8 vf = __builtin_shufflevector(lo, hi, 0, 1, 2, 3, 4, 5, 6, 7);
                o[db] = MFMA32(vf, s2 ? pf1 : pf0, o[db]);
            }
    }
}

DI void nsa_unit(Frame& F, int unit) {
    unsigned char* ws = F.ws; LAS unsigned char* lds = F.lds;
    int lane_ = F.lane; asm volatile("" : "+v"(lane_));
    const int lane = lane_, wave = F.wave, r = lane & 31, h = lane >> 5, g = wave >> 1, qh = wave & 1;
    const int bh = unit & 31, qt = 31 - (unit >> 5), b = bh >> 1, hkv = bh & 1;
    const int qloc = 32 * qh + r, tau = 64 * qt + qloc, qq = tau & 63; const size_t t = (size_t)b * SEQ + tau;
    const bf16* proj = (const bf16*)(ws + WS_PROJ);
    const bf16* qn = (const bf16*)(ws + WS_QN); const bf16* ksn = (const bf16*)(ws + WS_KSN); const bf16* kwn = (const bf16*)(ws + WS_KWN);
    const bf16* kc = (const bf16*)(ws + WS_KC); const bf16* vc = (const bf16*)(ws + WS_VC); bf16* H1 = (bf16*)(ws + WS_H1);
    int ka[4], va[2];
    { const int f = (r >> 1) & 7, fs = f >> 1, hb = h ^ (f & 1);
#pragma unroll
      for (int st = 0; st < 4; ++st) ka[st] = r * 128 + 16 * (((st ^ fs) << 1) | hb);
      const int i16 = lane & 15, q = i16 >> 2, p = i16 & 3, g1 = (lane >> 4) & 1;
#pragma unroll
      for (int db = 0; db < 2; ++db) va[db] = (4 * h + q) * 128 + 16 * ((4 * db + 2 * g1 + (p >> 1)) ^ (((q >> 1) & 1) << 2)) + 8 * (p & 1); }
    bf16x8 qf[4];
#pragma unroll
    for (int st = 0; st < 4; ++st) qf[st] = *(const bf16x8*)(qn + t * 512 + (hkv * 4 + g) * 64 + 16 * st + 8 * h);
    float gate[3];
#pragma unroll
    for (int c = 0; c < 3; ++c) gate[c] = sigm(bf2f(proj[t * NPROJ + PC_NG + (hkv * 4 + g) * 3 + c]));
    f32x16 ofin[2];
#pragma unroll
    for (int i = 0; i < 16; ++i) { ofin[0][i] = 0.f; ofin[1][i] = 0.f; }
    WG_BAR();
    {
        const int ncq = tau >= 31 ? ((tau - 31) >> 4) + 1 : 0;
        const int ntc = (((64 * qt + 63 - 31) >> 4) + 1 > 64) ? 2 : 1;
        const char* kb0 = (const char*)(kc + (size_t)(b * 2 + hkv) * 128 * 64); const char* vb0 = (const char*)(vc + (size_t)(b * 2 + hkv) * 128 * 64);
        at_load(lds, 0, kb0, 128, vb0, 128, wave, lane);
        if (ntc == 2) at_load(lds, 1, kb0 + 64 * 128, 128, vb0 + 64 * 128, 128, wave, lane);
        WG_BAR();
        f32x16 o[2]; float l = 0.f, prevEp = 0.f;
#pragma unroll
        for (int i = 0; i < 16; ++i) { o[0][i] = 0.f; o[1][i] = 0.f; }
        LAS float* I = (LAS float*)(lds + AT_IMP) + (g * 64 + qloc) * 32;
#pragma unroll 1
        for (int tile = 0; tile < 2; ++tile) {
            if (tile < ntc) {
                f32x16 s[2];
                at_qk(lds + AT_K + tile * 8192, ka, qf, s);
#pragma unroll
                for (int kb = 0; kb < 2; ++kb)
#pragma unroll
                    for (int i = 0; i < 16; ++i) { const int n = 64 * tile + 32 * kb + crow(i, h); const float p = n < ncq ? __builtin_amdgcn_exp2f(s[kb][i]) : 0.f; s[kb][i] = p; l += p; }
#pragma unroll
                for (int kb = 0; kb < 2; ++kb)
#pragma unroll
                    for (int a = 0; a < 4; ++a) { const int idx = tile * 8 + kb * 4 + a; const float Gv = (s[kb][4 * a] + s[kb][4 * a + 1]) + (s[kb][4 * a + 2] + s[kb][4 * a + 3]);
                        const float Epv = __shfl_xor(s[kb][4 * a + 3], 32);
                        I[2 * idx + h] = Gv + (h ? Epv : prevEp); prevEp = Epv; }
                at_pv(lds + AT_V + tile * 8192, va, s, o);
            } else {
#pragma unroll
                for (int idx = 8; idx < 16; ++idx) I[2 * idx + h] = 0.f;
            }
        }
        const float L = l + __shfl_xor(l, 32); const float inv = L > 0.f ? 1.f / L : 0.f;
        const float gi = gate[0] * inv;
#pragma unroll
        for (int i = 0; i < 16; ++i) { ofin[0][i] += gi * o[0][i]; ofin[1][i] += gi * o[1][i]; }
        if (h == 0) ((LAS float*)(lds + AT_INV))[g * 64 + qloc] = inv;
    }
    WG_BAR();
    unsigned sel = 0u, wm, um;
    {
        const LAS float* I = (const LAS float*)(lds + AT_IMP) + qloc * 32;
        const LAS float* IV = (const LAS float*)(lds + AT_INV) + qloc;
        const float iv0 = IV[0], iv1 = IV[64], iv2 = IV[128], iv3 = IV[192];
        LAS float* SC = (LAS float*)(lds + AT_SC) + (wave * 32 + r) * 33;
        if (h == 0) {
#pragma unroll 8
            for (int j = 0; j < 32; ++j) { const float imp = (I[j] * iv0 + I[64 * 32 + j] * iv1) + (I[2 * 64 * 32 + j] * iv2 + I[3 * 64 * 32 + j] * iv3);
                const bool forced = (j == 0) || (j == qt) || (j == qt - 1);
                SC[j] = j > qt ? NEGF : imp + (forced ? 1.0e4f : 0.f); }
        }
        asm volatile("s_waitcnt lgkmcnt(0)" ::: "memory");
#pragma unroll 1
        for (int rd = 0; rd < 8; ++rd) { float best = -3.4e38f; int bi = 0;
#pragma unroll 8
            for (int j = 0; j < 32; ++j) { const float v = ((sel >> j) & 1u) ? -3.4e38f : SC[j]; if (v > best) { best = v; bi = j; } }
            sel |= 1u << bi; }
        sel &= (qt == 31) ? 0xffffffffu : ((1u << (qt + 1)) - 1u);
        wm = sel;
#pragma unroll
        for (int o = 1; o < 32; o <<= 1) wm |= (unsigned)__shfl_xor((int)wm, o);
        wm = (unsigned)__builtin_amdgcn_readfirstlane((int)wm);
        if (lane == 0) ((LAS unsigned*)(lds + AT_WM))[wave] = wm;
        WG_BAR();
        um = 0u;
#pragma unroll
        for (int w = 0; w < 8; ++w) um |= ((const LAS unsigned*)(lds + AT_WM))[w];
        um = (unsigned)__builtin_amdgcn_readfirstlane((int)um);
    }
    {
        f32x16 o[2]; float l = 0.f;
#pragma unroll
        for (int i = 0; i < 16; ++i) { o[0][i] = 0.f; o[1][i] = 0.f; }
        const char* kbase = (const char*)(ksn + (size_t)b * SEQ * 128 + hkv * 64); const char* vbase = (const char*)(proj + (size_t)b * SEQ * NPROJ + PC_NVS + hkv * 64);
        unsigned rem = um; int par = 0;
        { const int j0 = __ffs((int)rem) - 1; at_load(lds, 0, kbase + (size_t)j0 * 64 * 256, 256, vbase + (size_t)j0 * 64 * NPROJ * 2, NPROJ * 2, wave, lane); }
#pragma unroll 1
        while (rem) {
            const int j = __ffs((int)rem) - 1; rem &= rem - 1u;
            WG_BAR();
            if (rem) { const int jn = __ffs((int)rem) - 1; at_load(lds, par ^ 1, kbase + (size_t)jn * 64 * 256, 256, vbase + (size_t)jn * 64 * NPROJ * 2, NPROJ * 2, wave, lane); }
            if ((wm >> j) & 1u) {
                f32x16 s[2];
                at_qk(lds + AT_K + par * 8192, ka, qf, s);
                const bool on = (sel >> j) & 1u; const int klim = j == qt ? qq : 63;
#pragma unroll
                for (int kb = 0; kb < 2; ++kb)
#pragma unroll
                    for (int i = 0; i < 16; ++i) { const int key = 32 * kb + crow(i, h); const float p = (on && key <= klim) ? __builtin_amdgcn_exp2f(s[kb][i]) : 0.f; s[kb][i] = p; l += p; }
                at_pv(lds + AT_V + par * 8192, va, s, o);
            }
            par ^= 1;
        }
        const float L = l + __shfl_xor(l, 32); const float gi = gate[1] * (L > 0.f ? 1.f / L : 0.f);
#pragma unroll
        for (int i = 0; i < 16; ++i) { ofin[0][i] += gi * o[0][i]; ofin[1][i] += gi * o[1][i]; }
    }
    WG_BAR();
    {
        f32x16 o[2]; float l = 0.f;
#pragma unroll
        for (int i = 0; i < 16; ++i) { o[0][i] = 0.f; o[1][i] = 0.f; }
        const char* kbase = (const char*)(kwn + (size_t)b * SEQ * 128 + hkv * 64); const char* vbase = (const char*)(proj + (size_t)b * SEQ * NPROJ + PC_NVW + hkv * 64);
        const int jlo = qt > 8 ? qt - 8 : 0; int par = 0;
        at_load(lds, 0, kbase + (size_t)jlo * 64 * 256, 256, vbase + (size_t)jlo * 64 * NPROJ * 2, NPROJ * 2, wave, lane);
#pragma unroll 1
        for (int j = jlo; j <= qt; ++j) {
            WG_BAR();
            if (j < qt) at_load(lds, par ^ 1, kbase + (size_t)(j + 1) * 64 * 256, 256, vbase + (size_t)(j + 1) * 64 * NPROJ * 2, NPROJ * 2, wave, lane);
            f32x16 s[2];
            at_qk(lds + AT_K + par * 8192, ka, qf, s);
            const int klo = (j == qt - 8) ? qq + 1 : 0, khi = (j == qt) ? qq : 63;
#pragma unroll
            for (int kb = 0; kb < 2; ++kb)
#pragma unroll
                for (int i = 0; i < 16; ++i) { const int key = 32 * kb + crow(i, h); const float p = (key >= klo && key <= khi) ? __builtin_amdgcn_exp2f(s[kb][i]) : 0.f; s[kb][i] = p; l += p; }
            at_pv(lds + AT_V + par * 8192, va, s, o);
            par ^= 1;
        }
        const float L = l + __shfl_xor(l, 32); const float gi = gate[2] * (L > 0.f ? 1.f / L : 0.f);
#pragma unroll
        for (int i = 0; i < 16; ++i) { ofin[0][i] += gi * o[0][i]; ofin[1][i] += gi * o[1][i]; }
    }
    bf16* orow = H1 + t * 512 + (hkv * 4 + g) * 64;
#pragma unroll
    for (int db = 0; db < 2; ++db)
#pragma unroll
        for (int a = 0; a < 4; ++a) { u32x2 w; w.x = pkbf(ofin[db][4 * a], ofin[db][4 * a + 1]); w.y = pkbf(ofin[db][4 * a + 2], ofin[db][4 * a + 3]); *(u32x2*)(orow + 32 * db + 8 * a + 4 * h) = w; }
}
constexpr int ML_K = 0, ML_V = 32768, ML_VW = 65536, ML_C = 81920, ML_N = 114688, ML_SS = 115200, ML_WS = 116224, ML_GO = 120320;
DI int ml_fk(int s) { return ((s & 3) << 2) | ((s >> 2) & 3); }
DI void ml_load(LAS unsigned char* lds, int par, const char* kb, const char* vb, int wave, int lane) {
#pragma unroll
    for (int n2 = 0; n2 < 2; ++n2) { const int n = 2 * wave + n2, row = 4 * n + (lane >> 4), pc = lane & 15;
        const int kc = pc ^ ml_fk(row), vc = pc ^ ((row & 3) << 2);
        __builtin_amdgcn_global_load_lds((const unsigned*)(kb + (size_t)row * 2048 + 16 * kc), (LAS unsigned*)(lds + ML_K + par * 16384 + n * 1024), 16, 0, 0);
        __builtin_amdgcn_global_load_lds((const unsigned*)(vb + (size_t)row * (NPROJ * 2) + 16 * vc), (LAS unsigned*)(lds + ML_V + par * 16384 + n * 1024), 16, 0, 0); }
}
DI bf16x8 ml_tr8(const LAS unsigned char* p) {
    typedef __attribute__((address_space(3))) s16x4 lds_s16x4;
    const s16x4 lo = __builtin_amdgcn_ds_read_tr16_b64_v4i16((lds_s16x4*)p); const s16x4 hi = __builtin_amdgcn_ds_read_tr16_b64_v4i16((lds_s16x4*)(p + 1024));
    return __builtin_shufflevector(lo, hi, 0, 1, 2, 3, 4, 5, 6, 7);
}
DI void mlstm_unit2(Frame& F, int unit) {
    unsigned char* ws = F.ws; LAS unsigned char* lds = F.lds;
    int lane_ = F.lane; asm volatile("" : "+v"(lane_));
    const int lane = lane_, wave = F.wave, tid = wave * 64 + lane, r = lane & 31, hh = lane >> 5, tb = wave >> 2, vb = wave & 3;
    const int b = unit >> 2, hd = unit & 3;
    const bf16* proj = (const bf16*)(ws + WS_PROJ); const bf16* mlqk = (const bf16*)(ws + WS_MLQK); bf16* H0 = (bf16*)(ws + WS_H0);
    const size_t tok0 = (size_t)b * SEQ;
    const char* kbase = (const char*)(mlqk + tok0 * 1024 + 512 + hd * 128); const char* vbase = (const char*)(proj + tok0 * NPROJ + PC_MLV + hd * 128);
    const float LOG2E = 1.4426950408889634f;
    const int i16 = lane & 15, q4 = i16 >> 2, p4 = i16 & 3, g1 = (lane >> 4) & 1;
    const int colsw = 16 * ((4 * vb + 2 * g1 + (p4 >> 1)) ^ (q4 << 2)) + 8 * (p4 & 1);
    const int base_c = (8 * hh + q4) * 256 + colsw;
    const int base_v = (4 * hh + q4) * 256 + colsw;
    const int fK = ml_fk(r), rowK = r * 256 + ((hh ^ (fK & 1)) << 4), F16 = (fK & 14) << 4;
    int base_kt[2][2];
#pragma unroll
    for (int blk = 0; blk < 2; ++blk)
#pragma unroll
        for (int hi = 0; hi < 2; ++hi) { const int kbp = 2 * tb + blk; base_kt[blk][hi] = (8 * hh + 4 * hi + q4) * 256 + 16 * ((4 * kbp + 2 * g1 + (p4 >> 1)) ^ ((q4 << 2) | ((2 * hh + hi) & 3))) + 8 * (p4 & 1); }
    LAS float* WS = (LAS float*)(lds + ML_WS) + wave * 128;
    LAS float* NV = (LAS float*)(lds + ML_N); LAS float* SS = (LAS float*)(lds + ML_SS);
    __syncthreads();
    for (int i = tid; i < 32768 / 16; i += 512) ((LAS v4u*)(lds + ML_C))[i] = (v4u){0u, 0u, 0u, 0u};
    if (tid < 128) NV[tid] = 0.f;
    f32x16 Cst[2];
#pragma unroll
    for (int i = 0; i < 16; ++i) { Cst[0][i] = 0.f; Cst[1][i] = 0.f; }
    if (tid < 128) ((LAS float*)(lds + ML_GO))[tid] = F.in[I_MLGOUT][hd * 128 + tid];
    const float bi = F.in[I_MLBI][hd], bfv = F.in[I_MLBF][hd];
    float m_prev = 0.f;
    ml_load(lds, 0, kbase, vbase, wave, lane);
    bf16x8 qf[8];
    { const bf16* qp = mlqk + (tok0 + 32 * tb + r) * 1024 + hd * 128 + 8 * hh;
#pragma unroll
      for (int st = 0; st < 8; ++st) qf[st] = *(const bf16x8*)(qp + 16 * st); }
    float gi_raw = bf2f(proj[(tok0 + lane) * NPROJ + PC_MLI + hd]), gf_raw = bf2f(proj[(tok0 + lane) * NPROJ + PC_MLF + hd]);
#pragma unroll 1
    for (int c = 0; c < 32; ++c) {
        const int par = c & 1; const size_t tokc = tok0 + 64 * c;
        WG_BAR();
        if (c < 31) ml_load(lds, par ^ 1, kbase + (size_t)(64 * (c + 1)) * 2048, vbase + (size_t)(64 * (c + 1)) * (NPROJ * 2), wave, lane);
        u32x2 og[4];
        { const bf16* op = proj + (tokc + 32 * tb + r) * NPROJ + PC_MLO + hd * 128 + 32 * vb + 4 * hh;
#pragma unroll
          for (int a = 0; a < 4; ++a) og[a] = *(const u32x2*)(op + 8 * a); }
        const float ig = gi_raw + bi, lf = logsig(gf_raw + bfv);
        float bc = lf;
#pragma unroll
        for (int o = 1; o < 64; o <<= 1) { const float v = __shfl_up(bc, o); if (lane >= o) bc += v; }
        const float rr = ig - bc;
        float cm = rr;
#pragma unroll
        for (int o = 1; o < 64; o <<= 1) { const float v = __shfl_up(cm, o); if (lane >= o) cm = fmaxf(cm, v); }
        const float M63 = fmaxf(m_prev, __shfl(cm, 63)), blast = __shfl(bc, 63);
        const float a_old = __expf(m_prev - M63), m_new = blast + M63;
        const int tl = 32 * tb + r;
        const float Mt = fmaxf(m_prev, __shfl(cm, tl)), bt = __shfl(bc, tl);
        const float inter = __expf(m_prev - Mt), m_t = bt + Mt;
        WS[lane] = rr * LOG2E; WS[64 + lane] = __expf(rr - M63);
        const float MtL = Mt * LOG2E;
        const LAS unsigned char* kbuf = lds + ML_K + par * 16384; const LAS unsigned char* vbuf = lds + ML_V + par * 16384;
        f32x16 wd[2]; float dsum = 0.f;
#pragma unroll
        for (int kb = 0; kb < 2; ++kb) {
#pragma unroll
            for (int i = 0; i < 16; ++i) wd[kb][i] = 0.f;
            if (kb <= tb) {
                f32x16 a = wd[kb];
#pragma unroll
                for (int st = 0; st < 8; ++st) { const bf16x8 kf = *(const LAS bf16x8*)(kbuf + kb * 8192 + rowK + ((32 * st) ^ F16)); a = MFMA32(kf, qf[st], a); }
#pragma unroll
                for (int i = 0; i < 16; ++i) { const int s = 32 * kb + crow(i, hh); const float e = __builtin_amdgcn_exp2f(WS[s] - MtL); const float w = (s <= tl) ? e * a[i] : 0.f; a[i] = w; dsum += w; }
                wd[kb] = a;
            }
        }
        f32x16 acc;
#pragma unroll
        for (int i = 0; i < 16; ++i) acc[i] = 0.f;
#pragma unroll
        for (int st = 0; st < 8; ++st) { const bf16x8 cf = ml_tr8(lds + ML_C + base_c + st * 4096); acc = MFMA32(cf, qf[st], acc); }
#pragma unroll
        for (int i = 0; i < 16; ++i) acc[i] *= inter;
#pragma unroll
        for (int kb = 0; kb < 2; ++kb) {
            if (kb <= tb) {
                const bf16x8 pf0 = pack8<0>(wd[kb]), pf1 = pack8<1>(wd[kb]);
                { typedef __attribute__((address_space(3))) s16x4 lds_s16x4;
#pragma unroll
                  for (int s2 = 0; s2 < 2; ++s2) { const LAS unsigned char* p = vbuf + base_v + kb * 8192 + s2 * 4096;
                    const s16x4 lo = __builtin_amdgcn_ds_read_tr16_b64_v4i16((lds_s16x4*)p); const s16x4 hi = __builtin_amdgcn_ds_read_tr16_b64_v4i16((lds_s16x4*)(p + 2048));
                    const bf16x8 vf = __builtin_shufflevector(lo, hi, 0, 1, 2, 3, 4, 5, 6, 7);
                    acc = MFMA32(vf, s2 ? pf1 : pf0, acc); } }
            }
        }
        float qn_ = 0.f;
#pragma unroll
        for (int st = 0; st < 8; ++st) { const v4u qw = __builtin_bit_cast(v4u, qf[st]); const LAS float* np = NV + 16 * st + 8 * hh; const f32x4 n0 = *(const LAS f32x4*)np, n1 = *(const LAS f32x4*)(np + 4);
            qn_ = fmaf(__uint_as_float(qw.x << 16), n0[0], qn_); qn_ = fmaf(__uint_as_float(qw.x & 0xffff0000u), n0[1], qn_); qn_ = fmaf(__uint_as_float(qw.y << 16), n0[2], qn_); qn_ = fmaf(__uint_as_float(qw.y & 0xffff0000u), n0[3], qn_);
            qn_ = fmaf(__uint_as_float(qw.z << 16), n1[0], qn_); qn_ = fmaf(__uint_as_float(qw.z & 0xffff0000u), n1[1], qn_); qn_ = fmaf(__uint_as_float(qw.w << 16), n1[2], qn_); qn_ = fmaf(__uint_as_float(qw.w & 0xffff0000u), n1[3], qn_); }
        qn_ += __shfl_xor(qn_, 32); dsum += __shfl_xor(dsum, 32);
        const float den = inter * qn_ + dsum; const float rden = 1.f / fmaxf(fabsf(den), __expf(-m_t));
        float ssq = 0.f;
#pragma unroll
        for (int i = 0; i < 16; ++i) { acc[i] *= rden; ssq = fmaf(acc[i], acc[i], ssq); }
        ssq += __shfl_xor(ssq, 32);
        if (hh == 0) SS[vb * 64 + tl] = ssq;
#pragma unroll
        for (int k2 = 0; k2 < 2; ++k2) { const int ci = tid + 512 * k2, s = ci >> 4; const float w = WS[64 + s];
            const v4u x = *(const LAS v4u*)(vbuf + ci * 16); v4u y; const unsigned xs[4] = {x.x, x.y, x.z, x.w}; unsigned ys[4];
#pragma unroll
            for (int j = 0; j < 4; ++j) ys[j] = pkbf(__uint_as_float(xs[j] << 16) * w, __uint_as_float(xs[j] & 0xffff0000u) * w);
            y.x = ys[0]; y.y = ys[1]; y.z = ys[2]; y.w = ys[3]; *(LAS v4u*)(lds + ML_VW + ci * 16) = y; }
        WG_BAR();
        { const LAS float* GO = (const LAS float*)(lds + ML_GO) + 32 * vb + 4 * hh;
          const float rstd = rsqrtf(((SS[tl] + SS[64 + tl]) + (SS[128 + tl] + SS[192 + tl])) * (1.f / 128.f) + EPS);
          bf16* orow = H0 + (tokc + tl) * 512 + hd * 128 + 32 * vb + 4 * hh;
#pragma unroll
          for (int a = 0; a < 4; ++a) { float o4[4]; const unsigned gw[2] = {og[a].x, og[a].y};
#pragma unroll
              for (int j = 0; j < 4; ++j) { const float ov = (j & 1) ? __uint_as_float(gw[j >> 1] & 0xffff0000u) : __uint_as_float(gw[j >> 1] << 16); o4[j] = acc[4 * a + j] * rstd * GO[8 * a + j] * sigm(ov); }
              u32x2 w; w.x = pkbf(o4[0], o4[1]); w.y = pkbf(o4[2], o4[3]); *(u32x2*)(orow + 8 * a) = w; } }
#pragma unroll
        for (int blk = 0; blk < 2; ++blk) {
            f32x16 cs = Cst[blk];
#pragma unroll
            for (int i = 0; i < 16; ++i) cs[i] *= a_old;
#pragma unroll
            for (int st = 0; st < 4; ++st) {
                typedef __attribute__((address_space(3))) s16x4 lds_s16x4;
                const bf16x8 af = ml_tr8(lds + ML_VW + base_c + st * 4096);
                const s16x4 lo = __builtin_amdgcn_ds_read_tr16_b64_v4i16((lds_s16x4*)(kbuf + base_kt[blk][0] + st * 4096)); const s16x4 hi = __builtin_amdgcn_ds_read_tr16_b64_v4i16((lds_s16x4*)(kbuf + base_kt[blk][1] + st * 4096));
                const bf16x8 kf = __builtin_shufflevector(lo, hi, 0, 1, 2, 3, 4, 5, 6, 7);
                cs = MFMA32(af, kf, cs);
            }
            Cst[blk] = cs;
            const int kk = 32 * (2 * tb + blk) + r;
#pragma unroll
            for (int a = 0; a < 4; ++a) { u32x2 w; w.x = pkbf(cs[4 * a], cs[4 * a + 1]); w.y = pkbf(cs[4 * a + 2], cs[4 * a + 3]);
                *(LAS u32x2*)(lds + ML_C + kk * 256 + 16 * ((4 * vb + a) ^ ((r & 3) << 2)) + 8 * hh) = w; }
        }
        if (tid < 128) { float nv = NV[tid] * a_old;
#pragma unroll 8
            for (int s = 0; s < 64; ++s) { const unsigned short kvs = *(const LAS unsigned short*)(kbuf + s * 256 + 16 * ((tid >> 3) ^ ml_fk(s)) + 2 * (tid & 7)); nv = fmaf(WS[64 + s], bf2f(kvs), nv); }
            NV[tid] = nv; }
        m_prev = m_new;
        if (c < 31) {
            const bf16* qp = mlqk + (tokc + 64 + 32 * tb + r) * 1024 + hd * 128 + 8 * hh;
#pragma unroll
            for (int st = 0; st < 8; ++st) qf[st] = *(const bf16x8*)(qp + 16 * st);
            gi_raw = bf2f(proj[(tokc + 64 + lane) * NPROJ + PC_MLI + hd]); gf_raw = bf2f(proj[(tokc + 64 + lane) * NPROJ + PC_MLF + hd]);
        }
    }
    __syncthreads();
}
DI void mem_load(LAS unsigned char* lds, int par, const char* kb, const char* vb, int wave, int lane) {
#pragma unroll
    for (int n2 = 0; n2 < 2; ++n2) { const int n = 2 * wave + n2, row = 4 * n + (lane >> 4), pc = lane & 15;
        const int kc = pc ^ ml_fk(row), vc = pc ^ ((row & 3) << 2);
        __builtin_amdgcn_global_load_lds((const unsigned*)(kb + (size_t)row * 1024 + 16 * kc), (LAS unsigned*)(lds + ML_K + par * 16384 + n * 1024), 16, 0, 0);
        __builtin_amdgcn_global_load_lds((const unsigned*)(vb + (size_t)row * 2048 + 16 * vc), (LAS unsigned*)(lds + ML_V + par * 16384 + n * 1024), 16, 0, 0); }
}
DI void mem_unit(Frame& F, int unit) {
    typedef __attribute__((address_space(3))) s16x4 lds_s16x4;
    unsigned char* ws = F.ws; LAS unsigned char* lds = F.lds;
    int lane_ = F.lane; asm volatile("" : "+v"(lane_));
    const int lane = lane_, wave = F.wave, r = lane & 31, hh = lane >> 5;
    const int b = unit >> 5, hd = (unit >> 3) & 3, qt = unit & 7;
    const bf16* mqn = (const bf16*)(ws + WS_MQN); const bf16* memkn = (const bf16*)(ws + WS_MEMKN); const bf16* memkv = (const bf16*)(ws + WS_MEMKV); bf16* H2 = (bf16*)(ws + WS_H2);
    const size_t t = (size_t)b * SEQ + 256 * qt + 32 * wave + r;
    const char* kbase = (const char*)(memkn + (size_t)b * MEML * 512 + hd * 128); const char* vbase = (const char*)(memkv + (size_t)b * MEML * 1024 + 512 + hd * 128);
    const int i16 = lane & 15, q4 = i16 >> 2, p4 = i16 & 3, g1 = (lane >> 4) & 1;
    int base_v[4];
#pragma unroll
    for (int db = 0; db < 4; ++db) base_v[db] = (4 * hh + q4) * 256 + 16 * ((4 * db + 2 * g1 + (p4 >> 1)) ^ (q4 << 2)) + 8 * (p4 & 1);
    const int fK = ml_fk(r), rowK = r * 256 + ((hh ^ (fK & 1)) << 4), F16 = (fK & 14) << 4;
    bf16x8 qf[8];
#pragma unroll
    for (int st = 0; st < 8; ++st) qf[st] = *(const bf16x8*)(mqn + t * 512 + hd * 128 + 16 * st + 8 * hh);
    f32x16 o[4]; float l = 0.f;
#pragma unroll
    for (int db = 0; db < 4; ++db)
#pragma unroll
        for (int i = 0; i < 16; ++i) o[db][i] = 0.f;
    WG_BAR();
    mem_load(lds, 0, kbase, vbase, wave, lane);
#pragma unroll 1
    for (int tile = 0; tile < 4; ++tile) {
        const int par = tile & 1;
        WG_BAR();
        if (tile < 3) mem_load(lds, par ^ 1, kbase + (size_t)(64 * (tile + 1)) * 1024, vbase + (size_t)(64 * (tile + 1)) * 2048, wave, lane);
        const LAS unsigned char* kbuf = lds + ML_K + par * 16384; const LAS unsigned char* vbuf = lds + ML_V + par * 16384;
#pragma unroll
        for (int kb = 0; kb < 2; ++kb) {
            f32x16 a;
#pragma unroll
            for (int i = 0; i < 16; ++i) a[i] = 0.f;
#pragma unroll
            for (int st = 0; st < 8; ++st) { const bf16x8 kf = *(const LAS bf16x8*)(kbuf + kb * 8192 + rowK + ((32 * st) ^ F16)); a = MFMA32(kf, qf[st], a); }
#pragma unroll
            for (int i = 0; i < 16; ++i) { a[i] = __builtin_amdgcn_exp2f(a[i]); l += a[i]; }
            const bf16x8 pf0 = pack8<0>(a), pf1 = pack8<1>(a);
#pragma unroll
            for (int s2 = 0; s2 < 2; ++s2)
#pragma unroll
                for (int db = 0; db < 4; ++db) { const LAS unsigned char* p = vbuf + base_v[db] + kb * 8192 + s2 * 4096;
                    const s16x4 lo = __builtin_amdgcn_ds_read_tr16_b64_v4i16((lds_s16x4*)p); const s16x4 hi = __builtin_amdgcn_ds_read_tr16_b64_v4i16((lds_s16x4*)(p + 2048));
                    const bf16x8 vf = __builtin_shufflevector(lo, hi, 0, 1, 2, 3, 4, 5, 6, 7);
                    o[db] = MFMA32(vf, s2 ? pf1 : pf0, o[db]); }
        }
    }
    const float inv = 1.f / (l + __shfl_xor(l, 32));
    bf16* orow = H2 + t * 512 + hd * 128 + 4 * hh;
#pragma unroll
    for (int db = 0; db < 4; ++db)
#pragma unroll
        for (int a = 0; a < 4; ++a) { u32x2 w; w.x = pkbf(o[db][4 * a] * inv, o[db][4 * a + 1] * inv); w.y = pkbf(o[db][4 * a + 2] * inv, o[db][4 * a + 3] * inv); *(u32x2*)(orow + 32 * db + 8 * a) = w; }
}
DI int q_pop(Frame& F, unsigned* qc) {
    __syncthreads();
    if (F.tid == 0) F.MISC[16] = atomicAdd(qc, 1u);
    __syncthreads();
    return (int)F.MISC[16];
}
DI void p5_queue(Frame& F) {
    unsigned* qc = F.ctl + CW_QCTR;
#ifndef NO_ML
#pragma unroll 1
    for (;;) { const int it = q_pop(F, qc); if (it >= 64) break; mlstm_unit2(F, it); }
#endif
#ifndef NO_NSA
#pragma unroll 1
    for (;;) { const int it = q_pop(F, qc + 64); if (it >= 1024) break; nsa_unit(F, it); }
#endif
#ifndef NO_MEM
#pragma unroll 1
    for (;;) { const int it = q_pop(F, qc + 128); if (it >= 512) break; mem_unit(F, it); }
#endif
    __syncthreads();
}
DI void p5_mixers(Frame& F) {
    const int nml = F.G >= 128 ? 64 : 0;
#ifndef RPT_ML
#define RPT_ML 1
#endif
#ifndef RPT_NSA
#define RPT_NSA 1
#endif
#ifndef RPT_MEM
#define RPT_MEM 1
#endif
    if (F.bx < nml || nml == 0) { for (int rp = 0; rp < RPT_ML; ++rp) for (int u = F.bx; u < 64; u += (nml ? nml : F.G)) mlstm_unit2(F, u); }
    if (F.bx >= nml) {
        LAS float* wl = (LAS float*)(F.lds + F.wave * 4096);
        const int gw = (F.bx - nml) * NWAVES + F.wave, NGW = (F.G - nml) * NWAVES;
        for (int rp = 0; rp < RPT_NSA; ++rp) for (int u = F.bx - nml; u < 1024; u += F.G - nml) nsa_unit(F, u);
        __syncthreads();
        for (int rp = 0; rp < RPT_MEM; ++rp) for (int t = gw; t < MT; t += NGW) mem_wave(F, t, wl);
    }
}

DI void p8_router(Frame& F) {
    unsigned char* ws = F.ws; const int lane = F.lane, tid = F.tid;
    bf16* xn2 = (bf16*)(ws + WS_R1);
    int* tok_e = (int*)(ws + WS_ROUTE + RT_TOKE); int* tok_pos = (int*)(ws + WS_ROUTE + RT_TOKPOS); float* tok_w = (float*)(ws + WS_ROUTE + RT_TOKW);
    unsigned* gcnt = F.ctl + CW_ECNT;
    LAS float* rowb = (LAS float*)(F.lds + F.wave * 4096);
    LAS int* lcnt = (LAS int*)(F.lds + 32768);
    LAS int* lbase = lcnt + 32;
    LAS int* se = lbase + 32;
    LAS int* sp = se + 512;
    LAS float* sw = (LAS float*)(sp + 512);
    const float* wr = F.in[I_WR]; const float* gf = F.in[I_GFFN];
    for (int bt = F.bx; bt < MT / 128; bt += F.G) {
        if (tid < 32) lcnt[tid] = 0;
        __syncthreads();
        for (int i = 0; i < 16; ++i) {
            const int tl = F.wave * 16 + i, t = bt * 128 + tl;
            const f32x4* xr = (const f32x4*)(F.out + (size_t)t * DM) + lane; const f32x4* gr = (const f32x4*)gf + lane;
            f32x4 v[4]; float s = 0.f;
#pragma unroll
            for (int j = 0; j < 4; ++j) { v[j] = xr[64 * j]; s += (v[j].x * v[j].x + v[j].y * v[j].y) + (v[j].z * v[j].z + v[j].w * v[j].w); }
            const float rstd = rsqrtf(wave_sum(s) * (1.f / DM) + EPS);
            unsigned long long* o8 = (unsigned long long*)(xn2 + (size_t)t * DM) + lane;
#pragma unroll
            for (int j = 0; j < 4; ++j) { const f32x4 gg = gr[64 * j]; f32x4 y; y.x = v[j].x * rstd * gg.x; y.y = v[j].y * rstd * gg.y; y.z = v[j].z * rstd * gg.z; y.w = v[j].w * rstd * gg.w;
                o8[64 * j] = (unsigned long long)pk2(y.x, y.y) | ((unsigned long long)pk2(y.z, y.w) << 32);
                *(LAS f32x4*)(rowb + 4 * lane + 256 * j) = y; }
            const int e = lane & 31, half = lane >> 5; float a = 0.f;
            for (int d = half * 512; d < half * 512 + 512; ++d) a = fmaf(rowb[d], wr[d * 32 + e], a);
            a += __shfl_xor(a, 32); a += F.in[I_BR][e];
            float sc = a; int ek[4]; float vk[4];
#pragma unroll
            for (int r = 0; r < 4; ++r) { const float mx = wave_max(sc); const unsigned long long bal = __ballot(sc == mx); const int win = (__ffsll((long long)bal) - 1) & 31;
                ek[r] = win; vk[r] = mx; if (e == win) sc = -3.4e38f; }
            const float e1 = __expf(vk[1] - vk[0]), e2 = __expf(vk[2] - vk[0]), e3 = __expf(vk[3] - vk[0]); const float inv = 1.f / (1.f + e1 + e2 + e3);
            if (lane == 0) {
                const float wk[4] = {inv, e1 * inv, e2 * inv, e3 * inv};
#pragma unroll
                for (int r = 0; r < 4; ++r) { se[tl * 4 + r] = ek[r]; sw[tl * 4 + r] = wk[r]; sp[tl * 4 + r] = atomicAdd((int*)&lcnt[ek[r]], 1); }
            }
        }
        __syncthreads();
        if (tid < 32) lbase[tid] = (int)atomicAdd(&gcnt[tid], (unsigned)lcnt[tid]);
        __syncthreads();
        { const int t = bt * 128 + (tid >> 2), k = tid & 3; const int e = se[tid];
          tok_e[t * 4 + k] = e; tok_pos[t * 4 + k] = lbase[e] + sp[tid]; tok_w[t * 4 + k] = sw[tid]; }
        __syncthreads();
    }
}
DI int moe_tables(Frame& F, LAS int* pstart, LAS unsigned char* blk_e) {
    unsigned* gcnt = F.ctl + CW_ECNT;
    __syncthreads();
    if (F.tid == 0) { int acc = 0; for (int e = 0; e < NEXP; ++e) { const int cnt = (int)__hip_atomic_load(&gcnt[e], __ATOMIC_RELAXED, __HIP_MEMORY_SCOPE_AGENT); pstart[e] = acc; acc += (cnt + MOEB - 1) / MOEB * MOEB; } pstart[NEXP] = acc; }
    __syncthreads();
    const int nblk = pstart[NEXP] / MOEB;
    for (int rb = F.tid; rb < nblk; rb += 512) { int e = 0; while (e < NEXP - 1 && pstart[e + 1] <= rb * MOEB) ++e; blk_e[rb] = (unsigned char)e; }
    __syncthreads();
    return nblk;
}
DI void p9_scatter(Frame& F) {
    unsigned char* ws = F.ws; const int lane = F.lane;
    LAS int* pstart = (LAS int*)(F.lds + 65536); LAS unsigned char* blk_e = (LAS unsigned char*)(F.lds + 65536 + 256);
    moe_tables(F, pstart, blk_e);
    const bf16* xn2 = (const bf16*)(ws + WS_R1); bf16* aperm = (bf16*)(ws + WS_APERM);
    const int* tok_e = (const int*)(ws + WS_ROUTE + RT_TOKE); const int* tok_pos = (const int*)(ws + WS_ROUTE + RT_TOKPOS); const float* tok_w = (const float*)(ws + WS_ROUTE + RT_TOKW);
    int* tok_dest = (int*)(ws + WS_ROUTE + RT_TOKDEST); float* roww = (float*)(ws + WS_ROUTE + RT_ROWW);
    unsigned* gcnt = F.ctl + CW_ECNT;
    const int gw = F.bx * NWAVES + F.wave, NGW = F.G * NWAVES;
    for (int it = gw; it < NROWS; it += NGW) {
        const int t = it >> 2; const int e = tok_e[it]; const int dest = pstart[e] + tok_pos[it];
        const v4u* src = (const v4u*)(xn2 + (size_t)t * DM); v4u* dst = (v4u*)(aperm + (size_t)dest * DM);
        dst[lane] = src[lane]; dst[64 + lane] = src[64 + lane];
        if (lane == 0) { tok_dest[it] = dest; roww[dest] = tok_w[it]; }
    }
    for (int it = gw; it < NEXP * MOEB; it += NGW) { const int e = it >> 8, i = it & 255; const int cnt = (int)__hip_atomic_load(&gcnt[e], __ATOMIC_RELAXED, __HIP_MEMORY_SCOPE_AGENT); const int padded = (cnt + MOEB - 1) / MOEB * MOEB;
        if (i < padded - cnt) { const int dest = pstart[e] + cnt + i; v4u* dst = (v4u*)(aperm + (size_t)dest * DM); const v4u z = {0u, 0u, 0u, 0u}; dst[lane] = z; dst[64 + lane] = z; if (lane == 0) roww[dest] = 0.f; } }
}
DI void p12_combine(Frame& F) {
    unsigned char* ws = F.ws; const int lane = F.lane;
    const bf16* ybuf = (const bf16*)(ws + WS_APERM); const int* tok_dest = (const int*)(ws + WS_ROUTE + RT_TOKDEST);
    const int gw = F.bx * NWAVES + F.wave, NGW = F.G * NWAVES;
    for (int t = gw; t < MT; t += NGW) {
        f32x4* orow = (f32x4*)(F.out + (size_t)t * DM);
        int d[4];
#pragma unroll
        for (int k = 0; k < 4; ++k) d[k] = tok_dest[t * 4 + k];
#pragma unroll
        for (int j = 0; j < 4; ++j) { f32x4 a = orow[lane + 64 * j];
#pragma unroll
            for (int k = 0; k < 4; ++k) { const unsigned long long w = *((const unsigned long long*)(ybuf + (size_t)d[k] * DM) + lane + 64 * j);
                a.x += __uint_as_float((unsigned)w << 16); a.y += __uint_as_float((unsigned)w & 0xffff0000u); a.z += __uint_as_float((unsigned)(w >> 32) << 16); a.w += __uint_as_float((unsigned)(w >> 32) & 0xffff0000u); }
            orow[lane + 64 * j] = a; }
    }
}

constexpr int N_PHASES = 13;
#ifndef MK_PER_PHASE
#define MK_PER_PHASE 0
#endif
__global__ void __launch_bounds__(NWAVES * 64, 2) fwd_kernel(Args args) {
    extern __shared__ __attribute__((aligned(16))) unsigned char lds_raw[];
    Frame F;
    F.lds = (LAS unsigned char*)lds_raw; F.MISC = (volatile LAS unsigned*)(F.lds + MISC_OFF);
    F.tid = threadIdx.x; F.lane = F.tid & 63; F.wave = __builtin_amdgcn_readfirstlane(F.tid >> 6); F.G = gridDim.x; F.bx = blockIdx.x;
    F.ws = args.ws; F.ctl = (unsigned*)(args.ws + WS_CTL); F.in = args.in; F.out = args.out;
    unsigned char* ws = args.ws;
    for (int u = F.tid; u < (LDS_BYTES - LDSCTL_OFF) / 4; u += NWAVES * 64) ((LAS unsigned*)(F.lds + LDSCTL_OFF))[u] = 0u;
    __syncthreads();
    const int lo = args.ph_lo, hi = args.ph_hi;
    XcdBarrier bar; bar.bar = F.ctl + CW_BAR; bar.x = 0; bar.st = nullptr;
    if (hi - lo > 1) bar = xcd_barrier_post(F.ctl + CW_BAR, F.MISC + 8);
#ifndef PH_MASK
#define PH_MASK 0x1fff
#endif
#define IN(k) (((PH_MASK >> (k)) & 1) && lo <= (k) && (k) < hi)
#define SEAM(k) do { if (IN(k) && IN((k) + 1)) xcd_barrier(bar); } while (0)
    typedef pg8::bf16_t b16;
#ifndef RPT_MASK
#define RPT_MASK 0
#endif
#define RPT(k) for (int rp_ = 0; rp_ < 1 + ((RPT_MASK >> (k)) & 1); ++rp_)
    if (IN(0)) { RPT(0) p0_prologue(F); } SEAM(0);
    if (IN(1)) {
        { pg8::Gemm g{(const b16*)(ws + WS_R1), (const b16*)(ws + WS_WIN), MT, NPROJ, DM}; pg8::StaticOrder S; S.init(MT, NPROJ, F.G, F.bx);
          pg8::EpiBf16Silu E{(b16*)(ws + WS_PROJ), NPROJ, nullptr, 0};
          pg8::gemm_phase<pg8::EpiBf16Silu, pg8::StaticOrder, true, true>(F.lds, g, S, E); }
        { pg8::Gemm g{(const b16*)(ws + WS_MEMN), (const b16*)(ws + WS_WMKV), MROWS, 1024, DM}; pg8::StaticOrder S; S.init(MROWS, 1024, F.G, (F.bx + 64) % F.G);
          pg8::EpiBf16Silu E{(b16*)(ws + WS_MEMKV), 1024, nullptr, 0};
          pg8::gemm_phase<pg8::EpiBf16Silu, pg8::StaticOrder, true, true>(F.lds, g, S, E); }
    } SEAM(1);
    if (IN(2)) { RPT(2) p2_prep(F); } SEAM(2);
    if (IN(3)) {
#pragma unroll
        for (int kv = 0; kv < 2; ++kv) {
            pg8::Gemm g{(const b16*)(ws + WS_ACMP) + (size_t)kv * 4096 * 2048, (const b16*)(ws + WS_WC1) + (size_t)kv * 256 * 2048, 4096, 256, 2048}; pg8::StaticOrder S; S.init(4096, 256, F.G, (F.bx + F.G - 16 * kv) % F.G);
            pg8::EpiBf16Silu E{(b16*)(ws + WS_HID) + (size_t)kv * 4096 * 256, 256, (const float*)(ws + WS_SMALL + SM_CBIAS) + kv * 256, 1};
            pg8::gemm_phase<pg8::EpiBf16Silu, pg8::StaticOrder, true, true>(F.lds, g, S, E); }
    } SEAM(3);
    if (IN(4)) { RPT(4) p4_kcvc(F); } SEAM(4);
    if (IN(5)) { p5_queue(F); } SEAM(5);
    if (IN(6)) {
        pg8::StaticOrder S; S.init(MT, DM, F.G, F.bx);
        { pg8::Gemm g{(const b16*)(ws + WS_H0), (const b16*)(ws + WS_WBR), MT, DM, 512}; pg8::EpiGate<0> E{(const b16*)(ws + WS_PROJ), F.out, (b16*)(ws + WS_R1)};
          pg8::gemm_phase<pg8::EpiGate<0>, pg8::StaticOrder, true, true>(F.lds, g, S, E); }
        { pg8::Gemm g{(const b16*)(ws + WS_H1), (const b16*)(ws + WS_WBR) + 1024 * 512, MT, DM, 512}; pg8::EpiGate<1> E{(const b16*)(ws + WS_PROJ), F.out, (b16*)(ws + WS_R1)};
          pg8::gemm_phase<pg8::EpiGate<1>, pg8::StaticOrder, true, true>(F.lds, g, S, E); }
        { pg8::Gemm g{(const b16*)(ws + WS_H2), (const b16*)(ws + WS_WBR) + 2 * 1024 * 512, MT, DM, 512}; pg8::EpiGate<2> E{(const b16*)(ws + WS_PROJ), F.out, (b16*)(ws + WS_R1)};
          pg8::gemm_phase<pg8::EpiGate<2>, pg8::StaticOrder, true, true>(F.lds, g, S, E); }
    } SEAM(6);
    if (IN(7)) {
        pg8::Gemm g{(const b16*)(ws + WS_R1), (const b16*)(ws + WS_WOUT), MT, DM, DM}; pg8::StaticOrder S; S.init(MT, DM, F.G, F.bx);
        pg8::EpiRes E{F.in[I_X], F.out};
        pg8::gemm_phase<pg8::EpiRes, pg8::StaticOrder, true, true>(F.lds, g, S, E);
    } SEAM(7);
    if (IN(8)) { p8_router(F); } SEAM(8);
    if (IN(9)) { p9_scatter(F); } SEAM(9);
    if (IN(10)) {
        LAS int* pstart = (LAS int*)(F.lds + RING_BYTES + 1024); LAS unsigned char* blk_e = (LAS unsigned char*)(F.lds + RING_BYTES + 1024 + 256);
        const int nblk = moe_tables(F, pstart, blk_e);
        pg8::Gemm g{(const b16*)(ws + WS_APERM), (const b16*)(ws + WS_WGU), CAP, NEXP * 2048, DM};
        pg8::MoeOrder<8> S{nblk * 8, F.G, F.bx, (const PG8_LAS unsigned char*)blk_e};
        pg8::EpiSwiglu E{(b16*)(ws + WS_ACT), F.in[I_BGU]};
        pg8::gemm_phase<pg8::EpiSwiglu, pg8::MoeOrder<8>, true, true>(F.lds, g, S, E);
    } SEAM(10);
    if (IN(11)) {
        LAS int* pstart = (LAS int*)(F.lds + RING_BYTES + 1024); LAS unsigned char* blk_e = (LAS unsigned char*)(F.lds + RING_BYTES + 1024 + 256);
        const int nblk = moe_tables(F, pstart, blk_e);
        pg8::Gemm g{(const b16*)(ws + WS_ACT), (const b16*)(ws + WS_WDN), CAP, NEXP * DM, DFF};
        pg8::MoeOrder<4> S{nblk * 4, F.G, F.bx, (const PG8_LAS unsigned char*)blk_e};
        pg8::EpiDown E{(b16*)(ws + WS_APERM), F.in[I_BDN], (const float*)(ws + WS_ROUTE + RT_ROWW)};
        pg8::gemm_phase<pg8::EpiDown, pg8::MoeOrder<4>, true, true>(F.lds, g, S, E);
    } SEAM(11);
    if (IN(12)) { p12_combine(F); }
#undef IN
#undef SEAM
}

extern "C" void kernel_launch(void* const* d_in, const int* in_sizes, int n_in, void* d_out, int out_size, void* d_ws, size_t ws_size, hipStream_t stream) {
    static int grid = 0;
    if (grid == 0) {
        if (n_in != N_IN || out_size != MT * DM || ws_size < WS_END) { fprintf(stderr, "kernel_launch: unexpected shapes (n_in %d, out %d, ws %zu need %zu)\n", n_in, out_size, ws_size, (size_t)WS_END); grid = -1; return; }
        int dev = 0, cus = 0, per_cu = 0;
        if (hipGetDevice(&dev) != hipSuccess || hipDeviceGetAttribute(&cus, hipDeviceAttributeMultiprocessorCount, dev) != hipSuccess) { grid = -1; return; }
        if (hipFuncSetAttribute((const void*)fwd_kernel, hipFuncAttributeMaxDynamicSharedMemorySize, LDS_BYTES) != hipSuccess) { fprintf(stderr, "kernel_launch: hipFuncSetAttribute failed\n"); grid = -1; return; }
        if (hipOccupancyMaxActiveBlocksPerMultiprocessor(&per_cu, (const void*)fwd_kernel, NWAVES * 64, LDS_BYTES) != hipSuccess || per_cu < 1) { fprintf(stderr, "kernel_launch: occupancy query says %d\n", per_cu); }
        (void)hipGetLastError();
        grid = cus;
    }
    if (grid < 0) return;
    if (hipMemsetAsync((char*)d_ws + WS_CTL, 0, CTL_ZERO_BYTES, stream) != hipSuccess) return;
    Args a{};
    for (int i = 0; i < N_IN; ++i) a.in[i] = (const float*)d_in[i];
    a.out = (float*)d_out; a.ws = (unsigned char*)d_ws;
#if MK_PER_PHASE
    for (int p = 0; p < N_PHASES; ++p) { a.ph_lo = p; a.ph_hi = p + 1; a.li = 0; hipLaunchKernelGGL(fwd_kernel, dim3(grid), dim3(NWAVES * 64), LDS_BYTES, stream, a); }
#else
    a.ph_lo = 0; a.ph_hi = N_PHASES; a.li = 0;
    hipLaunchKernelGGL(fwd_kernel, dim3(grid), dim3(NWAVES * 64), LDS_BYTES, stream, a);
#endif
}
```

```cpp
#include <hip/hip_runtime.h>
#include <cstdio>
#include <cstdint>
namespace pg8 {
#define PG8_LAS __attribute__((address_space(3)))
typedef unsigned short bf16_t;
typedef short bf16x8 __attribute__((ext_vector_type(8)));
typedef float f32x4 __attribute__((ext_vector_type(4)));
typedef unsigned u32x4 __attribute__((ext_vector_type(4)));
constexpr int BM = 256, BK = 64, HALF = 128, HTB = HALF * BK * 2  , STAGE_BYTES = 8 * HTB, NXCD = 8, WGM = 8;

__host__ __device__ __forceinline__ int lds_byte(int r, int c) { const int st = (r >> 4) * 2 + (c >> 5), rr = r & 15, cc = c & 31, ob = rr * 64 + cc * 2; return st * 1024 + (ob ^ (((ob >> 9) & 1) << 5)); }
__host__ __device__ __forceinline__ void stage_rc(int b, int& R, int& C) { const int st = b / 1024, sb = b % 1024, swz = sb ^ (((sb >> 9) & 1) << 5); R = (st >> 1) * 16 + swz / 64; C = (st & 1) * 32 + (swz % 64) / 2; }
__host__ __device__ __forceinline__ int perm32(int rho) { const int n = rho >> 4, i = rho & 15; return 8 * (i >> 2) + 4 * n + (i & 3); }

struct Unit { int pm, pn; };
struct Gemm { const bf16_t* A; const bf16_t* Bt; int M, N, K; };

struct StaticOrder {
    int nM, nN, nwg, G, c;
    __host__ __device__ void init(int M, int N, int G_, int c_) { nM = M / BM; nN = N / BM; nwg = nM * nN; G = G_; c = c_; }
    __host__ __device__ bool next(int i, Unit& u) const {
        const long L = (long)i * G + c; if (L >= nwg) return false;
        int wgid = (int)L; { const int q = nwg / NXCD, r = nwg % NXCD, xcd = wgid % NXCD, off = wgid / NXCD; wgid = (xcd < r ? xcd * (q + 1) : r * (q + 1) + (xcd - r) * q) + off; }
        const int nig = WGM * nN, gid = wgid / nig, fm = gid * WGM, gsz = (nM - fm) < WGM ? (nM - fm) : WGM;
        u.pm = fm + ((wgid % nig) % gsz); u.pn = (wgid % nig) / gsz; return true;
    }
    __device__ __forceinline__ void a_ready(const Unit&) const {}
    __device__ __forceinline__ void done(const Unit&) const {}
};

__device__ __forceinline__ unsigned cvt_pk_bf16(float lo, float hi) { unsigned r; asm volatile("v_cvt_pk_bf16_f32 %0, %1, %2" : "=v"(r) : "v"(lo), "v"(hi)); return r; }
typedef float f32x2 __attribute__((ext_vector_type(2)));
__device__ __forceinline__ f32x2 gelu_pk(f32x2 v) {
    const f32x2 av = __builtin_elementwise_abs(v), d = av * 0.2316418882f + 1.0f;
    f32x2 t; t.x = __builtin_amdgcn_rcpf(d.x); t.y = __builtin_amdgcn_rcpf(d.y);
    f32x2 q = t * 0.5307027145f + (-0.7265760135f); q = q * t + 0.7107068705f; q = q * t + (-0.142248368f); q = q * t + 0.127414796f; q = q * t;
    const f32x2 s = (v * v) * (-0.72134752044f);
    f32x2 e; e.x = __builtin_amdgcn_exp2f(s.x); e.y = __builtin_amdgcn_exp2f(s.y);
    const f32x2 m = v * (q * e), r = v - m;
    f32x2 o; o.x = v.x < 0.f ? m.x : r.x; o.y = v.y < 0.f ? m.y : r.y; return o;
}

template <int ACT  > struct EpiBf16 {
    static constexpr bool PERM = true, AFTER_DRAIN = false; static_assert(ACT == 0 || ACT == 1, "EpiBf16: ACT is 0 (none) or 1 (gelu_pk)");
    bf16_t* O; int ldc; const float* bias; int split_cols; size_t split_stride; float scale0;
    __device__ __forceinline__ void operator()(const f32x4 (&acc)[2][2][4][2], const Unit& u, int wr, int wc, int fr, int fq) const {
        const int row0 = u.pm * BM + wr * 64 + fr; int colt = u.pn * BM; bf16_t* base = O;
        float sc = 1.f; if (split_cols) { const int t = colt / split_cols; base += (size_t)t * split_stride; colt -= t * split_cols; if (t == 0) sc = scale0; }
        const int col0 = colt + wc * 32 + 8 * fq, bcol0 = u.pn * BM + wc * 32 + 8 * fq;
        f32x4 bv[2][2];
#pragma unroll
        for (int bj = 0; bj < 2; ++bj)
#pragma unroll
            for (int n = 0; n < 2; ++n) bv[bj][n] = bias ? *(const f32x4*)(bias + bcol0 + bj * HALF + 4 * n) : (f32x4){0.f, 0.f, 0.f, 0.f};
#pragma unroll
        for (int ai = 0; ai < 2; ++ai)
#pragma unroll
            for (int m = 0; m < 4; ++m) { bf16_t* rowp = base + (size_t)(row0 + ai * HALF + m * 16) * ldc + col0;
#pragma unroll
                for (int bj = 0; bj < 2; ++bj) { f32x4 v0 = acc[ai][bj][m][0] + bv[bj][0], v1 = acc[ai][bj][m][1] + bv[bj][1];
                    if (ACT == 1) { f32x2 a = gelu_pk((f32x2){v0[0], v0[1]}), b = gelu_pk((f32x2){v0[2], v0[3]}), c = gelu_pk((f32x2){v1[0], v1[1]}), d = gelu_pk((f32x2){v1[2], v1[3]});
                        v0 = (f32x4){a.x, a.y, b.x, b.y}; v1 = (f32x4){c.x, c.y, d.x, d.y}; }
                    v0 = v0 * sc; v1 = v1 * sc; u32x4 w; w.x = cvt_pk_bf16(v0[0], v0[1]); w.y = cvt_pk_bf16(v0[2], v0[3]); w.z = cvt_pk_bf16(v1[0], v1[1]); w.w = cvt_pk_bf16(v1[2], v1[3]);
                    *(u32x4*)(rowp + bj * HALF) = w; } }
    }
};

struct PanelStats {
    unsigned* xbuf;
    unsigned* cnt;
    unsigned* tmo;
    int ntn; float eps;
    unsigned code;
    __device__ __forceinline__ bool run(const f32x4 (&v)[2][2][4][2], const Unit& u, int wr, int wc, int fr, int fq, PG8_LAS unsigned char* lds, int wid, int lane) const {
        typedef float f32x2v __attribute__((ext_vector_type(2)));
        PG8_LAS f32x2v* P = (PG8_LAS f32x2v*)lds;
        PG8_LAS f32x2v* S = (PG8_LAS f32x2v*)(lds + 8192);
        PG8_LAS unsigned* flag = (PG8_LAS unsigned*)(lds + 8192 + 2048);
#pragma unroll
        for (int ai = 0; ai < 2; ++ai)
#pragma unroll
            for (int m = 0; m < 4; ++m) {
                float s = 0.f;
#pragma unroll
                for (int bj = 0; bj < 2; ++bj)
#pragma unroll
                    for (int n = 0; n < 2; ++n) { const f32x4 x = v[ai][bj][m][n]; s += (x[0] + x[1]) + (x[2] + x[3]); }
                s += __shfl_xor(s, 16); s += __shfl_xor(s, 32);
                const float mw = s * (1.0f / 64.0f); float q = 0.f;
#pragma unroll
                for (int bj = 0; bj < 2; ++bj)
#pragma unroll
                    for (int n = 0; n < 2; ++n) { const f32x4 d = v[ai][bj][m][n] - mw; q += (d[0] * d[0] + d[1] * d[1]) + (d[2] * d[2] + d[3] * d[3]); }
                q += __shfl_xor(q, 16); q += __shfl_xor(q, 32);
                if (fq == 0) P[(ai * HALF + wr * 64 + m * 16 + fr) * 4 + wc] = (f32x2v){mw, q};
            }
        asm volatile("s_waitcnt lgkmcnt(0)" ::: "memory"); __builtin_amdgcn_s_barrier(); asm volatile("" ::: "memory");
#if defined(BROKEN_EXCHANGE_NO_WAIT)
#warning BROKEN CONTROL BUILD: the row-statistics exchange does not wait; results are wrong by design
        if (blockIdx.x >= 64) { const long long t0_ = clock64(); while (clock64() - t0_ < 60000) __builtin_amdgcn_s_sleep(8); }
#endif
        const int row = wid * 32 + (lane & 31);
        if (lane < 32) {
            const f32x2v a = P[row * 4 + 0], b = P[row * 4 + 1], c = P[row * 4 + 2], d = P[row * 4 + 3];
            const float mt = (a.x + b.x + c.x + d.x) * 0.25f;
            const float da = a.x - mt, db = b.x - mt, dc = c.x - mt, dd = d.x - mt;
            const float m2 = (a.y + b.y) + (c.y + d.y) + 64.0f * ((da * da + db * db) + (dc * dc + dd * dd));
            unsigned long long* slot = (unsigned long long*)xbuf + ((size_t)(u.pm * BM + row) * 4 + u.pn);
            __hip_atomic_store(slot, ((unsigned long long)__float_as_uint(m2) << 32) | __float_as_uint(mt), __ATOMIC_RELAXED, __HIP_MEMORY_SCOPE_AGENT);
        }
        asm volatile("s_waitcnt vmcnt(0)" ::: "memory");
        if (lane == 0) __hip_atomic_fetch_add(cnt + 64 * u.pm, 1u, __ATOMIC_RELAXED, __HIP_MEMORY_SCOPE_AGENT);
        if (wid == 0) {
            bool dead = false; const unsigned long long t0 = __builtin_amdgcn_s_memrealtime(); const unsigned want = 8u * (unsigned)ntn;
            for (;;) {
#if defined(BROKEN_EXCHANGE_NO_WAIT)
                break;
#endif
                if ((unsigned)__builtin_amdgcn_readfirstlane(__hip_atomic_load(cnt + 64 * u.pm, __ATOMIC_RELAXED, __HIP_MEMORY_SCOPE_AGENT)) >= want) break;
                if (__builtin_amdgcn_s_memrealtime() - t0 > 2000000ull) {
                    if (lane == 0) { unsigned expect = 0u; __hip_atomic_compare_exchange_strong(tmo + 1, &expect, code | (unsigned)(u.pm & 0xff), __ATOMIC_RELAXED, __ATOMIC_RELAXED, __HIP_MEMORY_SCOPE_AGENT);
                                     __hip_atomic_store(tmo, 1u, __ATOMIC_RELAXED, __HIP_MEMORY_SCOPE_AGENT); }
                    dead = true; break; }
                __builtin_amdgcn_s_sleep(2);
            }
            __builtin_amdgcn_fence(__ATOMIC_ACQUIRE, "agent");
            if (lane == 0) flag[0] = dead ? 1u : 0u;
        }
        asm volatile("s_waitcnt vmcnt(0) lgkmcnt(0)" ::: "memory"); __builtin_amdgcn_s_barrier(); asm volatile("" ::: "memory");
        const bool bad = flag[0] != 0u;
        if (lane < 32) {
            const unsigned long long* slot = (const unsigned long long*)xbuf + (size_t)(u.pm * BM + row) * 4; float mt[4], m2[4]; float ms = 0.f;
#pragma unroll
            for (int t = 0; t < 4; ++t) { if (t < ntn) { const unsigned long long w = __hip_atomic_load(slot + t, __ATOMIC_RELAXED, __HIP_MEMORY_SCOPE_AGENT); mt[t] = __uint_as_float((unsigned)w); m2[t] = __uint_as_float((unsigned)(w >> 32)); } else { mt[t] = 0.f; m2[t] = 0.f; } ms += mt[t]; }
            const float mean = ms / (float)ntn; float q = 0.f;
#pragma unroll
            for (int t = 0; t < 4; ++t) if (t < ntn) { const float dm = mt[t] - mean; q += m2[t] + 256.0f * dm * dm; }
            S[row] = (f32x2v){mean, 1.0f / sqrtf(q / (256.0f * (float)ntn) + eps)};
        }
        asm volatile("s_waitcnt lgkmcnt(0)" ::: "memory"); __builtin_amdgcn_s_barrier(); asm volatile("" ::: "memory");
        return bad;
    }
};
struct EpiLnRes {
    static constexpr bool PERM = false, AFTER_DRAIN = true;
    const float* base; float* out; int ldc; const float* bias; PanelStats st; unsigned poison;
    __device__ __forceinline__ void fused(f32x4 (&acc)[2][2][4][2], const Unit& u, int wr, int wc, int fr, int fq, PG8_LAS unsigned char* lds, int wid, int lane) const {
        typedef float f32x2v __attribute__((ext_vector_type(2)));
        const PG8_LAS f32x2v* S = (const PG8_LAS f32x2v*)(lds + 8192);
        const int col0 = u.pn * BM + wc * 32 + 4 * fq;
#pragma unroll
        for (int bj = 0; bj < 2; ++bj)
#pragma unroll
            for (int n = 0; n < 2; ++n) { const f32x4 bv = bias ? *(const f32x4*)(bias + col0 + bj * HALF + n * 16) : (f32x4){0.f, 0.f, 0.f, 0.f};
#pragma unroll
                for (int ai = 0; ai < 2; ++ai)
#pragma unroll
                    for (int m = 0; m < 4; ++m) acc[ai][bj][m][n] += bv; }
        f32x4 pre[4][2][2];
#pragma unroll
        for (int m = 0; m < 4; ++m) { const size_t off = (size_t)(u.pm * BM + wr * 64 + m * 16 + fr) * ldc + col0;
#pragma unroll
            for (int bj = 0; bj < 2; ++bj)
#pragma unroll
                for (int n = 0; n < 2; ++n) pre[m][bj][n] = *(const f32x4*)(base + off + bj * HALF + n * 16); }
        const bool bad = st.run(acc, u, wr, wc, fr, fq, lds, wid, lane) || poison != 0u;
        const float qnan = __builtin_nanf("");
#pragma unroll
        for (int ai = 0; ai < 2; ++ai)
#pragma unroll
            for (int m = 0; m < 4; ++m) { const int r = ai * HALF + wr * 64 + m * 16 + fr; const f32x2v sr = S[r]; const size_t off = (size_t)(u.pm * BM + r) * ldc + col0;
#pragma unroll
                for (int bj = 0; bj < 2; ++bj)
#pragma unroll
                    for (int n = 0; n < 2; ++n) { const f32x4 bs = ai == 0 ? pre[m][bj][n] : *(const f32x4*)(base + off + bj * HALF + n * 16); f32x4 o = bs + (acc[ai][bj][m][n] - sr.x) * sr.y;
                        if (bad) o = (f32x4){qnan, qnan, qnan, qnan}; *(f32x4*)(out + off + bj * HALF + n * 16) = o; }
                if (m & 1) asm volatile("" ::: "memory"); }
    }
};
struct EpiLnResLn {
    static constexpr bool PERM = false, AFTER_DRAIN = true;
    const float* base; float* out; bf16_t* xn; int ldc; const float* bias; PanelStats st1, st2; unsigned poison;
    __device__ __forceinline__ void fused(f32x4 (&acc)[2][2][4][2], const Unit& u, int wr, int wc, int fr, int fq, PG8_LAS unsigned char* lds, int wid, int lane) const {
        typedef float f32x2v __attribute__((ext_vector_type(2))); typedef unsigned u32x2v __attribute__((ext_vector_type(2)));
        const PG8_LAS f32x2v* S = (const PG8_LAS f32x2v*)(lds + 8192);
        const int col0 = u.pn * BM + wc * 32 + 4 * fq;
#pragma unroll
        for (int bj = 0; bj < 2; ++bj)
#pragma unroll
            for (int n = 0; n < 2; ++n) { const f32x4 bv = bias ? *(const f32x4*)(bias + col0 + bj * HALF + n * 16) : (f32x4){0.f, 0.f, 0.f, 0.f};
#pragma unroll
                for (int ai = 0; ai < 2; ++ai)
#pragma unroll
                    for (int m = 0; m < 4; ++m) acc[ai][bj][m][n] += bv; }
        bool bad = st1.run(acc, u, wr, wc, fr, fq, lds, wid, lane) || poison != 0u;
        const float qnan = __builtin_nanf("");
#pragma unroll
        for (int ai = 0; ai < 2; ++ai)
#pragma unroll
            for (int m = 0; m < 4; ++m) { const int r = ai * HALF + wr * 64 + m * 16 + fr; const f32x2v sr = S[r]; const size_t off = (size_t)(u.pm * BM + r) * ldc + col0;
#pragma unroll
                for (int bj = 0; bj < 2; ++bj)
#pragma unroll
                    for (int n = 0; n < 2; ++n) { const f32x4 bs = *(const f32x4*)(base + off + bj * HALF + n * 16); acc[ai][bj][m][n] = bs + (acc[ai][bj][m][n] - sr.x) * sr.y; }
                asm volatile("" : "+v"(acc[ai][0][m][0]), "+v"(acc[ai][0][m][1]), "+v"(acc[ai][1][m][0]), "+v"(acc[ai][1][m][1]));
                if (m & 1) asm volatile("" ::: "memory"); }
        const bool bad1 = bad;
        bad = st2.run(acc, u, wr, wc, fr, fq, lds, wid, lane) || bad;
#pragma unroll
        for (int ai = 0; ai < 2; ++ai)
#pragma unroll
            for (int m = 0; m < 4; ++m) { const int r = ai * HALF + wr * 64 + m * 16 + fr; const f32x2v sr = S[r]; const size_t off = (size_t)(u.pm * BM + r) * ldc + col0;
#pragma unroll
                for (int bj = 0; bj < 2; ++bj)
#pragma unroll
                    for (int n = 0; n < 2; ++n) { const f32x4 x1 = acc[ai][bj][m][n]; *(f32x4*)(out + off + bj * HALF + n * 16) = bad1 ? (f32x4){qnan, qnan, qnan, qnan} : x1;
                        const f32x4 o = (x1 - sr.x) * sr.y; u32x2v w; w.x = cvt_pk_bf16(o[0], o[1]); w.y = cvt_pk_bf16(o[2], o[3]);
                        if (bad) { w.x = 0x7fc07fc0u; w.y = 0x7fc07fc0u; } *(u32x2v*)(xn + off + bj * HALF + n * 16) = w; }
                asm volatile("" ::: "memory"); }
    }
};

template <class Epi, class Sched, bool ALIGN_EPI = false, bool SP2 = false>
__device__ __forceinline__ void gemm_phase(PG8_LAS unsigned char* lds, const Gemm g, const Sched& S, const Epi& E) {
    const int tid = threadIdx.x, wid = __builtin_amdgcn_readfirstlane(tid >> 6), lane = tid & 63, wr = wid >> 2, wc = wid & 3, fr = lane & 15, fq = lane >> 4;
    const int K = g.K, nt = K / BK;
    unsigned voffA[2], voffB[2];
#pragma unroll
    for (int i = 0; i < 2; ++i) { int R, C; stage_rc(tid * 16 + i * 8192, R, C); const int Rb = Epi::PERM ? ((R & ~31) + perm32(R & 31)) : R;
        voffA[i] = (unsigned)(R * K + C) * 2u; voffB[i] = (unsigned)(Rb * K + C) * 2u; }
    const size_t kstep = (size_t)(BK * 2);
    const size_t hstep = (size_t)HALF * K * 2;
    const size_t tstep = 2 * hstep;
    const unsigned ldsw = (unsigned)wid * 1024u;
    const int aoff = lds_byte(wr * 64 + fr, fq * 8), boff = lds_byte(wc * 32 + fr, fq * 8);
#define PG8_SA(b, h) (((b) * 2 + (h)) * HTB)
#define PG8_SB(b, h) ((4 + (b) * 2 + (h)) * HTB)
#define PG8_STAGE(bufoff, gbase, voff) do { _Pragma("unroll") for (int _i = 0; _i < 2; ++_i) \
        __builtin_amdgcn_global_load_lds((const unsigned*)((const char*)(gbase) + (voff)[_i]), (PG8_LAS unsigned*)(lds + (bufoff) + ldsw + _i * 8192), 16, 0, 0); } while (0)
#define PG8_LDA(dst, b, h) do { _Pragma("unroll") for (int m = 0; m < 4; ++m) _Pragma("unroll") for (int k = 0; k < 2; ++k) dst[m][k] = *(const PG8_LAS bf16x8*)(lds + PG8_SA(b, h) + aoff + m * 2048 + k * 1024); } while (0)
#define PG8_LDB(dst, b, h) do { _Pragma("unroll") for (int n = 0; n < 2; ++n) _Pragma("unroll") for (int k = 0; k < 2; ++k) dst[n][k] = *(const PG8_LAS bf16x8*)(lds + PG8_SB(b, h) + boff + n * 2048 + k * 1024); } while (0)
#define PG8_MMA(ai, bj, At, Bt) do { __builtin_amdgcn_s_setprio(1); _Pragma("unroll") for (int m = 0; m < 4; ++m) _Pragma("unroll") for (int n = 0; n < 2; ++n) _Pragma("unroll") for (int k = 0; k < 2; ++k) \
        acc[ai][bj][m][n] = __builtin_amdgcn_mfma_f32_16x16x32_bf16(Bt[n][k], At[m][k], acc[ai][bj][m][n], 0, 0, 0); __builtin_amdgcn_s_setprio(0); } while (0)
#define PG8_WAIT_V(n) asm volatile("s_waitcnt vmcnt(" #n ")" ::: "memory")
#define PG8_WAIT_L(n) asm volatile("s_waitcnt lgkmcnt(" #n ")" ::: "memory")
#define PG8_BAR __builtin_amdgcn_s_barrier()
#define PG8_SCHED __builtin_amdgcn_sched_barrier(0)
    Unit cur, nxt; int ui = 0;
    if (!S.next(0, cur)) return;
    f32x4 acc[2][2][4][2];
#pragma unroll
    for (int a = 0; a < 2; ++a)
#pragma unroll
        for (int b = 0; b < 2; ++b)
#pragma unroll
            for (int m = 0; m < 4; ++m)
#pragma unroll
                for (int n = 0; n < 2; ++n) acc[a][b][m][n] = (f32x4){0.f, 0.f, 0.f, 0.f};
    bf16x8 At[4][2], B0[2][2], B1[2][2];
    const char* cA = (const char*)g.A + (size_t)cur.pm * tstep; const char* cB = (const char*)g.Bt + (size_t)cur.pn * tstep;
    S.a_ready(cur);
    if constexpr (SP2) {
        PG8_STAGE(PG8_SB(0, 0), cB, voffB); PG8_STAGE(PG8_SB(0, 1), cB + hstep, voffB); PG8_STAGE(PG8_SA(0, 0), cA, voffA); PG8_STAGE(PG8_SA(0, 1), cA + hstep, voffA);
        if (wr == 1) PG8_BAR;
        PG8_WAIT_V(2); PG8_BAR;
        PG8_STAGE(PG8_SB(1, 0), cB + kstep, voffB); PG8_STAGE(PG8_SA(1, 0), cA + kstep, voffA); PG8_STAGE(PG8_SB(1, 1), cB + hstep + kstep, voffB);
        PG8_WAIT_V(6); PG8_BAR;
    } else {
        PG8_STAGE(PG8_SB(0, 0), cB, voffB); PG8_STAGE(PG8_SA(0, 0), cA, voffA); PG8_STAGE(PG8_SB(0, 1), cB + hstep, voffB); PG8_STAGE(PG8_SA(0, 1), cA + hstep, voffA);
        if (wr == 1) PG8_BAR;
        PG8_WAIT_V(4); PG8_BAR;
        PG8_STAGE(PG8_SB(1, 0), cB + kstep, voffB); PG8_STAGE(PG8_SA(1, 0), cA + kstep, voffA); PG8_STAGE(PG8_SB(1, 1), cB + hstep + kstep, voffB);
        PG8_WAIT_V(6); PG8_BAR;
    }
    for (;;) {
        const bool has_next = S.next(ui + 1, nxt);
        const char* nA = has_next ? (const char*)g.A + (size_t)nxt.pm * tstep : cA; const char* nB = has_next ? (const char*)g.Bt + (size_t)nxt.pn * tstep : cB;
        for (int t = 0; t < nt; t += 2) {
            const bool last = (t == nt - 2);
            const char* a1 = cA + (size_t)(t + 1) * kstep;
            const char* a2 = last ? nA : cA + (size_t)(t + 2) * kstep; const char* b2 = last ? nB : cB + (size_t)(t + 2) * kstep;
            const char* a3 = a2 + kstep; const char* b3 = b2 + kstep;
            if (last && has_next) S.a_ready(nxt);
            if constexpr (SP2) {
            PG8_LDB(B0, 0, 0); PG8_LDB(B1, 0, 1); PG8_SCHED; PG8_LDA(At, 0, 0); PG8_STAGE(PG8_SA(1, 1), a1 + hstep, voffA);
            PG8_WAIT_V(8); PG8_WAIT_L(0); PG8_BAR; PG8_MMA(0, 0, At, B0); PG8_MMA(0, 1, At, B1); PG8_BAR; PG8_SCHED;
            PG8_LDA(At, 0, 1); PG8_STAGE(PG8_SB(0, 0), b2, voffB); PG8_STAGE(PG8_SB(0, 1), b2 + hstep, voffB); PG8_STAGE(PG8_SA(0, 0), a2, voffA);
            PG8_WAIT_V(8); PG8_WAIT_L(0); PG8_BAR; PG8_MMA(1, 0, At, B0); PG8_MMA(1, 1, At, B1); PG8_BAR; PG8_SCHED;
            PG8_LDB(B0, 1, 0); PG8_LDB(B1, 1, 1); PG8_SCHED; PG8_LDA(At, 1, 0); PG8_STAGE(PG8_SA(0, 1), a2 + hstep, voffA);
            PG8_WAIT_V(8); PG8_WAIT_L(0); PG8_BAR; PG8_MMA(0, 0, At, B0); PG8_MMA(0, 1, At, B1); PG8_BAR; PG8_SCHED;
            PG8_LDA(At, 1, 1); PG8_STAGE(PG8_SB(1, 0), b3, voffB); PG8_STAGE(PG8_SB(1, 1), b3 + hstep, voffB); PG8_STAGE(PG8_SA(1, 0), a3, voffA);
            PG8_WAIT_V(8); PG8_WAIT_L(0); PG8_BAR; PG8_MMA(1, 0, At, B0); PG8_MMA(1, 1, At, B1); PG8_BAR; PG8_SCHED;
            } else {
            PG8_LDB(B0, 0, 0); PG8_SCHED; PG8_LDA(At, 0, 0); PG8_STAGE(PG8_SA(1, 1), a1 + hstep, voffA);
            PG8_WAIT_L(8); PG8_BAR; PG8_WAIT_L(0); PG8_MMA(0, 0, At, B0); PG8_BAR; PG8_SCHED;
            PG8_LDB(B1, 0, 1); PG8_STAGE(PG8_SB(0, 0), b2, voffB);
            PG8_BAR; PG8_WAIT_L(0); PG8_MMA(0, 1, At, B1); PG8_BAR;
            PG8_LDA(At, 0, 1); PG8_STAGE(PG8_SA(0, 0), a2, voffA);
            PG8_BAR; PG8_WAIT_L(0); PG8_MMA(1, 0, At, B0); PG8_BAR; PG8_SCHED;
            PG8_STAGE(PG8_SB(0, 1), b2 + hstep, voffB);
            PG8_WAIT_V(6); PG8_BAR; PG8_MMA(1, 1, At, B1); PG8_BAR;
            PG8_LDB(B0, 1, 0); PG8_SCHED; PG8_LDA(At, 1, 0); PG8_STAGE(PG8_SA(0, 1), a2 + hstep, voffA);
            PG8_WAIT_L(8); PG8_BAR; PG8_WAIT_L(0); PG8_MMA(0, 0, At, B0); PG8_BAR; PG8_SCHED;
            PG8_LDB(B1, 1, 1); PG8_STAGE(PG8_SB(1, 0), b3, voffB);
            PG8_BAR; PG8_WAIT_L(0); PG8_MMA(0, 1, At, B1); PG8_BAR;
            PG8_LDA(At, 1, 1); PG8_STAGE(PG8_SA(1, 0), a3, voffA);
            PG8_BAR; PG8_WAIT_L(0); PG8_MMA(1, 0, At, B0); PG8_BAR; PG8_SCHED;
            PG8_STAGE(PG8_SB(1, 1), b3 + hstep, voffB);
            PG8_WAIT_V(6); PG8_BAR; PG8_MMA(1, 1, At, B1); PG8_BAR;
            }
        }
        if constexpr (ALIGN_EPI) { if (wr == 0) PG8_BAR; }
        if constexpr (!Epi::AFTER_DRAIN) { E(acc, cur, wr, wc, fr, fq); S.done(cur); }
        if (!has_next) break;
#pragma unroll
        for (int a = 0; a < 2; ++a)
#pragma unroll
            for (int b = 0; b < 2; ++b)
#pragma unroll
                for (int m = 0; m < 4; ++m)
#pragma unroll
                    for (int n = 0; n < 2; ++n) acc[a][b][m][n] = (f32x4){0.f, 0.f, 0.f, 0.f};
        cur = nxt; cA = nA; cB = nB; ++ui;
        if constexpr (ALIGN_EPI) { if (wr == 1) PG8_BAR; }
    }
    PG8_WAIT_V(0);
    if constexpr (!ALIGN_EPI) { if (wr == 0) PG8_BAR; }
    PG8_BAR;
    if constexpr (Epi::AFTER_DRAIN) { E.fused(acc, cur, wr, wc, fr, fq, lds, wid, lane); S.done(cur); }
#undef PG8_SA
#undef PG8_SB
#undef PG8_STAGE
#undef PG8_LDA
#undef PG8_LDB
#undef PG8_MMA
#undef PG8_WAIT_V
#undef PG8_WAIT_L
#undef PG8_BAR
#undef PG8_SCHED
}
}
#define GAS __attribute__((address_space(1)))
#define LAS __attribute__((address_space(3)))
typedef unsigned short bf16;
typedef unsigned v4u __attribute__((ext_vector_type(4)));
typedef float f32x4 __attribute__((ext_vector_type(4)));
typedef short bf16x8 __attribute__((ext_vector_type(8)));
typedef GAS unsigned gu32;
typedef GAS unsigned long long gu64;
#define RLX_AGENT __ATOMIC_RELAXED, __HIP_MEMORY_SCOPE_AGENT
#define LDS_WAIT() asm volatile("s_waitcnt lgkmcnt(0)" ::: "memory")
#define VM_WAIT() asm volatile("s_waitcnt vmcnt(0)" ::: "memory")
__device__ __forceinline__ unsigned long long rt() { return __builtin_amdgcn_s_memrealtime(); }
__device__ __forceinline__ unsigned f2bf(float f) { unsigned u = __builtin_bit_cast(unsigned, f); return (u + 0x7fffu + ((u >> 16) & 1u)) >> 16; }
__device__ __forceinline__ unsigned pk2(float lo, float hi) { return f2bf(lo) | (f2bf(hi) << 16); }

#define XB_TMO      128
#define XB_XCNT(j)  (256  + 64 * (j))
#define XB_XSUB(j)  (1280 + 64 * (j))
#define XB_XGEN(j)  (2304 + 64 * (j))
#define XB_TOP      3328
#define XB_TOPGEN   3392
#define XCD_BAR_WORDS 3456
#define XB_SPIN_CAP (1u << 18)

__device__ __forceinline__ unsigned xb_ld(unsigned* p)              { return __hip_atomic_load(p, __ATOMIC_RELAXED, __HIP_MEMORY_SCOPE_AGENT); }
__device__ __forceinline__ unsigned xb_add(unsigned* p, unsigned v) { return __hip_atomic_fetch_add(p, v, __ATOMIC_RELAXED, __HIP_MEMORY_SCOPE_AGENT); }
__device__ __forceinline__ unsigned xb_xcc_id() { return (unsigned)__builtin_amdgcn_s_getreg((3 << 11) | 20) & 0xFu; }
#define XB_SPIN(cond, bar) do { unsigned _sp = 0; while (cond) { __builtin_amdgcn_s_sleep(1); \
    if ((++_sp & 255u) == 0u) { if (xb_ld(&(bar)[XB_TMO])) break; if (_sp > XB_SPIN_CAP) { atomicAdd(&(bar)[XB_TMO], 1u); break; } } } } while (0)

struct XcdBarrier {
    unsigned* bar; unsigned x;
    volatile LAS unsigned* st;
};

__device__ __forceinline__ XcdBarrier xcd_barrier_post(unsigned* bar, volatile LAS unsigned* st) {
    XcdBarrier b; b.bar = bar; b.x = xb_xcc_id(); b.st = st;
    if (threadIdx.x == 0) (void)xb_add(&bar[XB_XCNT(b.x)], 1u);
    return b;
}
__device__ __forceinline__ void xcd_barrier_complete(unsigned* bar, unsigned x, unsigned& nloc, unsigned& nx) {
    const unsigned G = gridDim.x * gridDim.y * gridDim.z;
    unsigned sum, cnt, mine, sp = 0u;
    for (;;) {
        sum = 0u; cnt = 0u; mine = 0u;
#pragma unroll
        for (unsigned j = 0; j < 16; ++j) { const unsigned c = xb_ld(&bar[XB_XCNT(j)]); sum += c; cnt += (c > 0u) ? 1u : 0u; mine = (j == x) ? c : mine; }
        if (sum == G) break;
        __builtin_amdgcn_s_sleep(1);
        if ((++sp & 255u) == 0u) { if (xb_ld(&bar[XB_TMO])) break; if (sp > XB_SPIN_CAP) { atomicAdd(&bar[XB_TMO], 1u); break; } }
    }
    nloc = mine > 0u ? mine : 1u; nx = cnt > 0u ? cnt : 1u;
}

__device__ __forceinline__ void xcd_barrier(const XcdBarrier& b) {
    asm volatile("s_waitcnt vmcnt(0)" ::: "memory");
    __syncthreads();
    if (threadIdx.x == 0) {
        unsigned* bar = b.bar;
        __builtin_amdgcn_s_waitcnt(0);
        unsigned nloc = b.st[0], nx = b.st[1];
        if (nloc == 0u) { xcd_barrier_complete(bar, b.x, nloc, nx); b.st[0] = nloc; b.st[1] = nx; }
        const unsigned old = xb_add(&bar[XB_XSUB(b.x)], 1u);
        const unsigned gen = old / nloc;
        if (old + 1u == (gen + 1u) * nloc) {
            __builtin_amdgcn_fence(__ATOMIC_RELEASE, "agent");
            asm volatile("s_waitcnt vmcnt(0)" ::: "memory");
            const unsigned og = xb_add(&bar[XB_TOP], 1u);
            const unsigned tg = og / nx;
            if (og + 1u == (tg + 1u) * nx) xb_add(&bar[XB_TOPGEN], 1u);
            else XB_SPIN(xb_ld(&bar[XB_TOPGEN]) == tg, bar);
            __builtin_amdgcn_fence(__ATOMIC_ACQUIRE, "agent");
            xb_add(&bar[XB_XGEN(b.x)], 1u);
            asm volatile("s_waitcnt vmcnt(0)" ::: "memory");
        } else {
            XB_SPIN(xb_ld(&bar[XB_XGEN(b.x)]) == gen, bar);
            __builtin_amdgcn_fence(__ATOMIC_ACQUIRE, "agent");
            asm volatile("s_waitcnt vmcnt(0)" ::: "memory");
        }
    }
    __syncthreads();
}
#define DI __device__ __forceinline__
constexpr int NWAVES = 8;
constexpr int NB = 16, SEQ = 2048, DM = 1024, MT = NB * SEQ;
constexpr int DIN_SRC = 6944, NPROJ = 7168;
constexpr int MEML = 256, MROWS = NB * MEML;
constexpr int NEXP = 32, TOPK = 4, DFF = 1024, MOEB = 256;
constexpr int NROWS = MT * TOPK;
constexpr int NBLK_MAX = (NROWS + NEXP * (MOEB - 1) + MOEB - 1) / MOEB;
constexpr int CAP = NBLK_MAX * MOEB;
constexpr float EPS = 1e-6f;
constexpr float NEGF = -1e30f;
constexpr int PC_MLQ = 0, PC_MLK = 512, PC_MLV = 1024, PC_MLO = 1536, PC_NQ = 2048, PC_NKC = 2560, PC_NVC = 2688, PC_NKS = 2816, PC_NVS = 2944,
              PC_NKW = 3072, PC_NVW = 3200, PC_MQ = 3328, PC_BRG = 3840, PC_MLI = 6912, PC_MLF = 6916, PC_NG = 6920, PC_END = 6944;
__host__ __device__ constexpr int proj_srccol(int j) {
    return j < 2048 ? j : j < 2560 ? 2056 + (j - 2048) : j < 3328 ? 2568 + (j - 2560) : j < 3840 ? 3360 + (j - 3328) : j < 6912 ? 3872 + (j - 3840)
         : j < 6920 ? 2048 + (j - 6912) : j < 6944 ? 3336 + (j - 6920) : -1;
}

constexpr size_t MiB = 1u << 20;
constexpr size_t WS_CTL = 0, CTL_ZERO_BYTES = 1 * MiB;
constexpr size_t WS_WIN = 1 * MiB, WS_WGU = 15 * MiB, WS_WDN = 143 * MiB, WS_WMKV = 207 * MiB, WS_WBR = 209 * MiB, WS_WOUT = 212 * MiB, WS_WC1 = 214 * MiB;
constexpr size_t WS_SMALL = 216 * MiB;
constexpr size_t WS_R1 = 218 * MiB;
constexpr size_t WS_PROJ = 282 * MiB;
constexpr size_t WS_R3 = 730 * MiB;
constexpr size_t WS_MEMKV = WS_R3, WS_MEMKN = WS_R3 + 8 * MiB, WS_QN = WS_R3 + 12 * MiB, WS_KSN = WS_R3 + 44 * MiB, WS_KWN = WS_R3 + 52 * MiB,
                 WS_MQN = WS_R3 + 60 * MiB, WS_MLQK = WS_R3 + 92 * MiB, WS_HID = WS_R3 + 156 * MiB, WS_KC = WS_R3 + 160 * MiB, WS_VC = WS_KC + MiB / 2,
                 WS_H0 = WS_R3 + 161 * MiB, WS_H1 = WS_H0 + 32 * MiB, WS_H2 = WS_H1 + 32 * MiB, WS_ROUTE = WS_H2 + 32 * MiB, WS_END = WS_ROUTE + 6 * MiB;
constexpr size_t WS_MEMN = WS_H0;
constexpr size_t WS_ACMP = WS_H1;
constexpr size_t WS_APERM = WS_PROJ;
constexpr size_t WS_ACT = WS_PROJ + 272 * MiB;
static_assert(WS_ACT + 272 * MiB <= WS_H0 + 96 * MiB && WS_END <= 1024 * MiB, "ws map");
constexpr size_t SM_ROPEC = 0, SM_ROPES = 256 * 1024, SM_CBIAS = 512 * 1024, SM_WRT = 1024 * 1024;
constexpr size_t RT_TOKE = 0, RT_TOKPOS = 512 * 1024, RT_TOKW = 1024 * 1024, RT_TOKDEST = 1536 * 1024, RT_ROWW = 2048 * 1024;
constexpr int CW_BAR = 4096;
constexpr int CW_ECNT = 16384;
constexpr int CW_QCTR = 16384 + 64;

constexpr int RING_BYTES = 131072, LDSCTL_OFF = RING_BYTES, MISC_OFF = LDSCTL_OFF + 320, LDS_BYTES = 147456;

struct Args { const float* in[34]; float* out; unsigned char* ws; int ph_lo, ph_hi, li, pad; };

DI float bf2f(unsigned short h) { return __uint_as_float((unsigned)h << 16); }
DI float wave_sum(float v) {
#pragma unroll
    for (int o = 1; o < 64; o <<= 1) v += __shfl_xor(v, o);
    return v;
}
DI float wave_max(float v) {
#pragma unroll
    for (int o = 1; o < 64; o <<= 1) v = fmaxf(v, __shfl_xor(v, o));
    return v;
}
DI float sigm(float x) { return 1.f / (1.f + __expf(-x)); }
DI float logsig(float x) { return fminf(x, 0.f) - log1pf(__expf(-fabsf(x))); }

namespace pg8 {
struct EpiBf16Silu {
    static constexpr bool PERM = true, AFTER_DRAIN = false;
    bf16_t* O; int ldc; const float* bias; int silu;
    DI void operator()(const f32x4 (&acc)[2][2][4][2], const Unit& u, int wr, int wc, int fr, int fq) const {
        const int row0 = u.pm * BM + wr * 64 + fr; const int col0 = u.pn * BM + wc * 32 + 8 * fq;
#pragma unroll
        for (int ai = 0; ai < 2; ++ai)
#pragma unroll
            for (int m = 0; m < 4; ++m) { bf16_t* rowp = O + (size_t)(row0 + ai * HALF + m * 16) * ldc + col0;
#pragma unroll
                for (int bj = 0; bj < 2; ++bj) { f32x4 v0 = acc[ai][bj][m][0], v1 = acc[ai][bj][m][1];
                    if (bias) { v0 += *(const f32x4*)(bias + col0 + bj * HALF); v1 += *(const f32x4*)(bias + col0 + bj * HALF + 4); }
                    if (silu) {
#pragma unroll
                        for (int j = 0; j < 4; ++j) { v0[j] = v0[j] / (1.f + __expf(-v0[j])); v1[j] = v1[j] / (1.f + __expf(-v1[j])); } }
                    u32x4 w; w.x = cvt_pk_bf16(v0[0], v0[1]); w.y = cvt_pk_bf16(v0[2], v0[3]); w.z = cvt_pk_bf16(v1[0], v1[1]); w.w = cvt_pk_bf16(v1[2], v1[3]);
                    *(u32x4*)(rowp + bj * HALF) = w; } }
    }
};
template <int B> struct EpiGate {
    static constexpr bool PERM = false, AFTER_DRAIN = false;
    const bf16_t* proj; float* tmp; bf16_t* merged;
    DI void operator()(const f32x4 (&acc)[2][2][4][2], const Unit& u, int wr, int wc, int fr, int fq) const {
        typedef unsigned u32x2v __attribute__((ext_vector_type(2)));
        const int col0 = u.pn * BM + wc * 32 + 4 * fq;
#pragma unroll
        for (int ai = 0; ai < 2; ++ai)
#pragma unroll
            for (int m = 0; m < 4; ++m) { const size_t r = (size_t)(u.pm * BM + ai * HALF + wr * 64 + m * 16 + fr);
#pragma unroll
                for (int bj = 0; bj < 2; ++bj)
#pragma unroll
                    for (int n = 0; n < 2; ++n) { const int c = col0 + bj * HALF + n * 16;
                        const u32x2v gw = *(const u32x2v*)(proj + r * NPROJ + PC_BRG + B * DM + c);
                        f32x4 g; g[0] = __uint_as_float(gw.x << 16); g[1] = __uint_as_float(gw.x & 0xffff0000u); g[2] = __uint_as_float(gw.y << 16); g[3] = __uint_as_float(gw.y & 0xffff0000u);
                        f32x4 v = acc[ai][bj][m][n];
#pragma unroll
                        for (int j = 0; j < 4; ++j) v[j] = v[j] / (1.f + __expf(-g[j]));
                        float* tp = tmp + r * DM + c;
                        if (B == 0) { *(f32x4*)tp = v; }
                        else if (B == 1) { *(f32x4*)tp = *(const f32x4*)tp + v; }
                        else { v = *(const f32x4*)tp + v; u32x2v w; w.x = cvt_pk_bf16(v[0], v[1]); w.y = cvt_pk_bf16(v[2], v[3]); *(u32x2v*)(merged + r * DM + c) = w; } } }
    }
};
struct EpiRes {
    static constexpr bool PERM = false, AFTER_DRAIN = false;
    const float* base; float* out;
    DI void operator()(const f32x4 (&acc)[2][2][4][2], const Unit& u, int wr, int wc, int fr, int fq) const {
        const int col0 = u.pn * BM + wc * 32 + 4 * fq;
#pragma unroll
        for (int ai = 0; ai < 2; ++ai)
#pragma unroll
            for (int m = 0; m < 4; ++m) { const size_t r = (size_t)(u.pm * BM + ai * HALF + wr * 64 + m * 16 + fr);
#pragma unroll
                for (int bj = 0; bj < 2; ++bj)
#pragma unroll
                    for (int n = 0; n < 2; ++n) { const int c = col0 + bj * HALF + n * 16; *(f32x4*)(out + r * DM + c) = *(const f32x4*)(base + r * DM + c) + acc[ai][bj][m][n]; } }
    }
};
struct EpiSwiglu {
    static constexpr bool PERM = true, AFTER_DRAIN = false;
    bf16_t* act; const float* bgu;
    DI void operator()(const f32x4 (&acc)[2][2][4][2], const Unit& u, int wr, int wc, int fr, int fq) const {
        typedef unsigned u32x2v __attribute__((ext_vector_type(2)));
        const int e = u.pn >> 3, pnl = u.pn & 7;
        const int lc0 = pnl * BM + wc * 32 + 8 * fq;
        const int row0 = u.pm * BM + wr * 64 + fr;
#pragma unroll
        for (int ai = 0; ai < 2; ++ai)
#pragma unroll
            for (int m = 0; m < 4; ++m) { bf16_t* rowp = act + (size_t)(row0 + ai * HALF + m * 16) * DFF;
#pragma unroll
                for (int bj = 0; bj < 2; ++bj) {
                    const int lc = lc0 + bj * HALF;
                    const f32x4 b0 = *(const f32x4*)(bgu + e * 2048 + lc), b1 = *(const f32x4*)(bgu + e * 2048 + lc + 4);
                    const f32x4 v0 = acc[ai][bj][m][0] + b0, v1 = acc[ai][bj][m][1] + b1;
                    float o[4];
#pragma unroll
                    for (int q = 0; q < 4; ++q) { const float gt = fminf(q < 2 ? v0[2 * q] : v1[2 * q - 4], 7.0f); float up = q < 2 ? v0[2 * q + 1] : v1[2 * q - 3]; up = fminf(fmaxf(up, -7.0f), 7.0f);
                        o[q] = (up + 1.0f) * (gt / (1.f + __expf(-1.702f * gt))); }
                    u32x2v w; w.x = cvt_pk_bf16(o[0], o[1]); w.y = cvt_pk_bf16(o[2], o[3]);
                    *(u32x2v*)(rowp + (lc >> 1)) = w; } }
    }
};
struct EpiDown {
    static constexpr bool PERM = false, AFTER_DRAIN = false;
    bf16_t* y; const float* bdn; const float* roww;
    DI void operator()(const f32x4 (&acc)[2][2][4][2], const Unit& u, int wr, int wc, int fr, int fq) const {
        typedef unsigned u32x2v __attribute__((ext_vector_type(2)));
        const int e = u.pn >> 2, pnl = u.pn & 3;
        const int col0 = pnl * BM + wc * 32 + 4 * fq;
#pragma unroll
        for (int ai = 0; ai < 2; ++ai)
#pragma unroll
            for (int m = 0; m < 4; ++m) { const size_t r = (size_t)(u.pm * BM + ai * HALF + wr * 64 + m * 16 + fr); const float rw = roww[r];
#pragma unroll
                for (int bj = 0; bj < 2; ++bj)
#pragma unroll
                    for (int n = 0; n < 2; ++n) { const int c = col0 + bj * HALF + n * 16; const f32x4 v = (acc[ai][bj][m][n] + *(const f32x4*)(bdn + e * DM + c)) * rw;
                        u32x2v w; w.x = cvt_pk_bf16(v[0], v[1]); w.y = cvt_pk_bf16(v[2], v[3]); *(u32x2v*)(y + r * DM + c) = w; } }
    }
};
template <int NPN> struct MoeOrder {
    int nunits, G, c; const PG8_LAS unsigned char* blk_e;
    DI bool next(int i, Unit& u) const { const int L = i * G + c; if (L >= nunits) return false; const int rb = L / NPN; u.pm = rb; u.pn = (int)blk_e[rb] * NPN + (L % NPN); return true; }
    DI void a_ready(const Unit&) const {}
    DI void done(const Unit&) const {}
};
}

struct Frame {
    LAS unsigned char* lds; volatile LAS unsigned* MISC; unsigned* ctl; unsigned char* ws;
    int tid, lane, wave, G, bx;
    const float* const* in; float* out;
};
enum { I_X = 0, I_MEM, I_GMIX, I_WIN, I_CONVW, I_CONVB, I_MLBI, I_MLBF, I_MLGOUT, I_NGQ, I_NGK, I_CPK, I_CW1K, I_CB1K, I_CW2K, I_CPV, I_CW1V, I_CB1V, I_CW2V,
       I_GMEM, I_WMKV, I_MGQ, I_MGK, I_WBRML, I_WBRNSA, I_WBRMEM, I_WOUT, I_GFFN, I_WR, I_BR, I_WGU, I_BGU, I_WDN, I_BDN, N_IN };

template <class CM>
DI void tr_item(const float* W, int ldw, int K, bf16* WT, int k0, int n0, CM cm, LAS float* scr, int lane) {
    const int sc = cm(n0 + (lane & 31));
#pragma unroll 8
    for (int i = 0; i < 32; ++i) { const int kk = 2 * i + (lane >> 5); scr[kk * 33 + (lane & 31)] = sc >= 0 ? W[(size_t)(k0 + kk) * ldw + sc] : 0.f; }
    LDS_WAIT(); asm volatile("" ::: "memory");
    const int c = lane & 7;
#pragma unroll
    for (int j = 0; j < 4; ++j) { const int n = (lane >> 3) + 8 * j; const LAS float* s = scr + (8 * c) * 33 + n;
        v4u o; o.x = pk2(s[0 * 33], s[1 * 33]); o.y = pk2(s[2 * 33], s[3 * 33]); o.z = pk2(s[4 * 33], s[5 * 33]); o.w = pk2(s[6 * 33], s[7 * 33]);
        *(v4u*)(WT + (size_t)(n0 + n) * K + k0 + 8 * c) = o; }
    LDS_WAIT(); asm volatile("" ::: "memory");
}
struct CmId { DI int operator()(int j) const { return j; } };
struct CmProj { DI int operator()(int j) const { return proj_srccol(j); } };

DI void rms_row_bf16(const float* xrow, const float* g, bf16* orow, int lane) {
    const f32x4* xr = (const f32x4*)xrow + lane; const f32x4* gr = (const f32x4*)g + lane;
    f32x4 v[4]; float s = 0.f;
#pragma unroll
    for (int j = 0; j < 4; ++j) { v[j] = xr[64 * j]; s += (v[j].x * v[j].x + v[j].y * v[j].y) + (v[j].z * v[j].z + v[j].w * v[j].w); }
    const float rstd = rsqrtf(wave_sum(s) * (1.f / DM) + EPS);
    unsigned long long* o8 = (unsigned long long*)orow + lane;
#pragma unroll
    for (int j = 0; j < 4; ++j) { const f32x4 gg = gr[64 * j];
        o8[64 * j] = (unsigned long long)pk2(v[j].x * rstd * gg.x, v[j].y * rstd * gg.y) | ((unsigned long long)pk2(v[j].z * rstd * gg.z, v[j].w * rstd * gg.w) << 32); }
}

DI void p0_prologue(Frame& F) {
    LAS float* scr = (LAS float*)(F.lds + F.wave * 16384);
    const int gw = F.bx * NWAVES + F.wave, NGW = F.G * NWAVES;
    unsigned char* ws = F.ws;
    constexpr int IT_IN = 16 * (NPROJ / 32), IT_GU = 32 * 16 * 64, IT_DN = 32 * 16 * 32, IT_MKV = 16 * 32, IT_BR = 3 * 8 * 32, IT_OUT = 16 * 32, IT_C1 = 2 * 32 * 8;
    constexpr int NITEMS = IT_IN + IT_GU + IT_DN + IT_MKV + IT_BR + IT_OUT + IT_C1;
    for (int it = gw; it < NITEMS; it += NGW) {
        int r = it;
        if (r < IT_IN) { const int kb = r / (NPROJ / 32), nb = r % (NPROJ / 32); tr_item(F.in[I_WIN], DIN_SRC, DM, (bf16*)(ws + WS_WIN), 64 * kb, 32 * nb, CmProj(), scr, F.lane); continue; } r -= IT_IN;
        if (r < IT_GU) { const int e = r / 1024, q = r % 1024, kb = q / 64, nb = q % 64; tr_item(F.in[I_WGU] + (size_t)e * DM * 2048, 2048, DM, (bf16*)(ws + WS_WGU) + (size_t)e * 2048 * DM, 64 * kb, 32 * nb, CmId(), scr, F.lane); continue; } r -= IT_GU;
        if (r < IT_DN) { const int e = r / 512, q = r % 512, kb = q / 32, nb = q % 32; tr_item(F.in[I_WDN] + (size_t)e * DFF * DM, DM, DFF, (bf16*)(ws + WS_WDN) + (size_t)e * DM * DFF, 64 * kb, 32 * nb, CmId(), scr, F.lane); continue; } r -= IT_DN;
        if (r < IT_MKV) { const int kb = r / 32, nb = r % 32; tr_item(F.in[I_WMKV], 1024, 1024, (bf16*)(ws + WS_WMKV), 64 * kb, 32 * nb, CmId(), scr, F.lane); continue; } r -= IT_MKV;
        if (r < IT_BR) { const int b = r / 256, q = r % 256, kb = q / 32, nb = q % 32; tr_item(F.in[I_WBRML + b], 1024, 512, (bf16*)(ws + WS_WBR) + (size_t)b * 1024 * 512, 64 * kb, 32 * nb, CmId(), scr, F.lane); continue; } r -= IT_BR;
        if (r < IT_OUT) { const int kb = r / 32, nb = r % 32; tr_item(F.in[I_WOUT], 1024, 1024, (bf16*)(ws + WS_WOUT), 64 * kb, 32 * nb, CmId(), scr, F.lane); continue; } r -= IT_OUT;
        { const int kv = r / 256, q = r % 256, kb = q / 8, nb = q % 8; tr_item(F.in[kv ? I_CW1V : I_CW1K], 256, 2048, (bf16*)(ws + WS_WC1) + (size_t)kv * 256 * 2048, 64 * kb, 32 * nb, CmId(), scr, F.lane); }
    }
    for (int m = gw; m < MT; m += NGW) rms_row_bf16(F.in[I_X] + (size_t)m * DM, F.in[I_GMIX], (bf16*)(ws + WS_R1) + (size_t)m * DM, F.lane);
    for (int m = gw; m < MROWS; m += NGW) rms_row_bf16(F.in[I_MEM] + (size_t)m * DM, F.in[I_GMEM], (bf16*)(ws + WS_MEMN) + (size_t)m * DM, F.lane);
    float* rc = (float*)(ws + WS_SMALL + SM_ROPEC); float* rs = (float*)(ws + WS_SMALL + SM_ROPES);
    for (int i = F.bx * 512 + F.tid; i < SEQ * 32; i += F.G * 512) {
        const int p = i >> 5, k = i & 31;
        const float invf = exp2f(-(float)k * (13.287712379549449f / 32.0f));
        const float ang = (float)p * invf;
        const float kf = rintf(ang * 0.15915494309189535f);
        float r = fmaf(-kf, 6.28125f, ang); r = fmaf(-kf, 1.9353071795864769e-3f, r);
        rc[i] = cosf(r); rs[i] = sinf(r);
    }
    { bf16* wrt = (bf16*)(ws + WS_SMALL + SM_WRT);
      for (int i = F.bx * 512 + F.tid; i < 32 * 1024; i += F.G * 512) { const int e = i >> 10, k = i & 1023; const float w = F.in[I_WR][k * 32 + e]; const unsigned hi = f2bf(w); wrt[i] = (bf16)hi; wrt[32 * 1024 + i] = (bf16)f2bf(w - __uint_as_float(hi << 16)); } }
    if (F.bx == F.G - 1) {
        const int kv = F.tid >> 8, f = F.tid & 255;
        const float* pe = F.in[kv ? I_CPV : I_CPK]; const float* w1 = F.in[kv ? I_CW1V : I_CW1K];
        float a = F.in[kv ? I_CB1V : I_CB1K][f];
        for (int k = 0; k < 2048; ++k) a = fmaf(pe[k], w1[(size_t)k * 256 + f], a);
        ((float*)(ws + WS_SMALL + SM_CBIAS))[kv * 256 + f] = a;
    }
}

DI void unpack8(const v4u& w, float (&f)[8]) {
    f[0] = __uint_as_float(w.x << 16); f[1] = __uint_as_float(w.x & 0xffff0000u); f[2] = __uint_as_float(w.y << 16); f[3] = __uint_as_float(w.y & 0xffff0000u);
    f[4] = __uint_as_float(w.z << 16); f[5] = __uint_as_float(w.z & 0xffff0000u); f[6] = __uint_as_float(w.w << 16); f[7] = __uint_as_float(w.w & 0xffff0000u);
}
DI v4u pack8f(const float (&f)[8]) { v4u o; o.x = pk2(f[0], f[1]); o.y = pk2(f[2], f[3]); o.z = pk2(f[4], f[5]); o.w = pk2(f[6], f[7]); return o; }
DI void load8f(const float* p, float (&f)[8]) { const f32x4 a = *(const f32x4*)p, b = *(const f32x4*)(p + 4); f[0] = a.x; f[1] = a.y; f[2] = a.z; f[3] = a.w; f[4] = b.x; f[5] = b.y; f[6] = b.z; f[7] = b.w; }
DI void norm_rope64(float (&f)[8], const float (&g)[8], const float* rc, const float* rs, int pos, int lane, float scale) {
    float ss = 0.f;
#pragma unroll
    for (int i = 0; i < 8; ++i) ss = fmaf(f[i], f[i], ss);
    ss += __shfl_xor(ss, 1); ss += __shfl_xor(ss, 2); ss += __shfl_xor(ss, 4);
    const float rstd = rsqrtf(ss * (1.f / 64.f) + EPS);
    float c8[8], s8[8]; load8f(rc + pos * 32 + 8 * (lane & 3), c8); load8f(rs + pos * 32 + 8 * (lane & 3), s8);
    const bool hi = (lane & 4) != 0;
#pragma unroll
    for (int i = 0; i < 8; ++i) { const float y = f[i] * rstd * g[i]; const float pt = __shfl_xor(y, 4); f[i] = (hi ? fmaf(pt, s8[i], y * c8[i]) : fmaf(-pt, s8[i], y * c8[i])) * scale; }
}
DI void p2_prep(Frame& F) {
    unsigned char* ws = F.ws;
    const int gw = F.bx * NWAVES + F.wave, NGW = F.G * NWAVES, lane = F.lane;
    const bf16* proj = (const bf16*)(ws + WS_PROJ);
    const float* rc = (const float*)(ws + WS_SMALL + SM_ROPEC); const float* rs = (const float*)(ws + WS_SMALL + SM_ROPES);
    bf16* qn = (bf16*)(ws + WS_QN); bf16* ksn = (bf16*)(ws + WS_KSN); bf16* kwn = (bf16*)(ws + WS_KWN); bf16* mqn = (bf16*)(ws + WS_MQN); bf16* mlqk = (bf16*)(ws + WS_MLQK);
    bf16* acmp = (bf16*)(ws + WS_ACMP);
    {
        float gq8[8], mg8[8]; load8f(F.in[I_NGQ] + 8 * (lane & 7), gq8); load8f(F.in[I_MGQ] + 8 * (lane & 15), mg8);
        for (int t = gw; t < MT; t += NGW) {
            const int tau = t & 2047; const bf16* pr = proj + (size_t)t * NPROJ;
            float f[8]; unpack8(*(const v4u*)(pr + PC_NQ + 8 * lane), f);
            norm_rope64(f, gq8, rc, rs, tau, lane, 0.125f * 1.4426950408889634f);
            *(v4u*)(qn + (size_t)t * 512 + 8 * lane) = pack8f(f);
            unpack8(*(const v4u*)(pr + PC_MQ + 8 * lane), f);
            float ss = 0.f;
#pragma unroll
            for (int i = 0; i < 8; ++i) ss = fmaf(f[i], f[i], ss);
            ss += __shfl_xor(ss, 1); ss += __shfl_xor(ss, 2); ss += __shfl_xor(ss, 4); ss += __shfl_xor(ss, 8);
            const float rstd = rsqrtf(ss * (1.f / 128.f) + EPS) * (0.08838834764831845f * 1.4426950408889634f);
#pragma unroll
            for (int i = 0; i < 8; ++i) f[i] *= rstd * mg8[i];
            *(v4u*)(mqn + (size_t)t * 512 + 8 * lane) = pack8f(f);
        }
    }
    {
        const int L = lane & 31, hd4 = L >> 3, j = L & 7, half = lane >> 5;
        float gk8[8]; load8f(F.in[I_NGK] + (1 + (hd4 >> 1)) * 64 + 8 * j, gk8);
        const int kcol = (hd4 < 2 ? PC_NKS + hd4 * 64 : PC_NKW + (hd4 - 2) * 64) + 8 * j;
        bf16* kdst = (hd4 < 2 ? ksn : kwn) + (hd4 & 1) * 64 + 8 * j;
        const int kv = hd4 >> 1, hh = hd4 & 1;
        for (int tp = gw; tp < MT / 2; tp += NGW) {
            const int t = 2 * tp + half, b = t >> 11, tau = t & 2047; const bf16* pr = proj + (size_t)t * NPROJ;
            float f[8]; unpack8(*(const v4u*)(pr + kcol), f);
            norm_rope64(f, gk8, rc, rs, tau, lane, 1.0f);
            *(v4u*)(kdst + (size_t)t * 128) = pack8f(f);
            const v4u cv = *(const v4u*)(pr + PC_NKC + hd4 * 64 + 8 * j);
            const int nA = tau >> 4;
#pragma unroll
            for (int dn = 0; dn < 2; ++dn) { const int n = nA - dn; if (n >= 0 && n <= 126) { const int l = tau - 16 * n;
                *(v4u*)(acmp + (size_t)kv * 4096 * 2048 + (size_t)((b * 2 + hh) * 128 + n) * 2048 + l * 64 + 8 * j) = cv; } }
        }
    }
    for (int run = gw; run < MT / 16; run += NGW) {
        const int t0 = run * 16, tau0 = t0 & 2047;
#pragma unroll 1
        for (int sp = 0; sp < 2; ++sp) {
            const int ch = 512 * sp + 8 * lane;
            float w0[8], w1[8], w2[8], w3[8], bb[8];
            load8f(F.in[I_CONVW] + ch, w0); load8f(F.in[I_CONVW] + 1024 + ch, w1); load8f(F.in[I_CONVW] + 2048 + ch, w2); load8f(F.in[I_CONVW] + 3072 + ch, w3); load8f(F.in[I_CONVB] + ch, bb);
            float x0[8], x1[8], x2[8];
            if (tau0 >= 3) { unpack8(*(const v4u*)(proj + (size_t)(t0 - 3) * NPROJ + ch), x0); unpack8(*(const v4u*)(proj + (size_t)(t0 - 2) * NPROJ + ch), x1); unpack8(*(const v4u*)(proj + (size_t)(t0 - 1) * NPROJ + ch), x2); }
            else {
#pragma unroll
                for (int i = 0; i < 8; ++i) { x0[i] = 0.f; x1[i] = 0.f; x2[i] = 0.f; } }
#pragma unroll 4
            for (int k = 0; k < 16; ++k) {
                float x3[8], y[8]; unpack8(*(const v4u*)(proj + (size_t)(t0 + k) * NPROJ + ch), x3);
#pragma unroll
                for (int i = 0; i < 8; ++i) { const float a = fmaf(w3[i], x3[i], fmaf(w2[i], x2[i], fmaf(w1[i], x1[i], fmaf(w0[i], x0[i], bb[i])))); y[i] = a * sigm(a); x0[i] = x1[i]; x1[i] = x2[i]; x2[i] = x3[i]; }
                *(v4u*)(mlqk + (size_t)(t0 + k) * 1024 + ch) = pack8f(y);
            }
        }
    }
    for (int i = F.bx * 512 + F.tid; i < 2 * 32 * 2048; i += F.G * 512) { const int kv = i / (32 * 2048), q = i % (32 * 2048), bh = q / 2048, col = q % 2048;
        acmp[(size_t)kv * 4096 * 2048 + (size_t)(bh * 128 + 127) * 2048 + col] = 0; }
    {
        const bf16* memkv = (const bf16*)(ws + WS_MEMKV); bf16* memkn = (bf16*)(ws + WS_MEMKN);
        float kg8[8]; load8f(F.in[I_MGK] + 8 * (lane & 15), kg8);
        for (int r = gw; r < MROWS; r += NGW) {
            float f[8]; unpack8(*(const v4u*)(memkv + (size_t)r * 1024 + 8 * lane), f);
            float ss = 0.f;
#pragma unroll
            for (int i = 0; i < 8; ++i) ss = fmaf(f[i], f[i], ss);
            ss += __shfl_xor(ss, 1); ss += __shfl_xor(ss, 2); ss += __shfl_xor(ss, 4); ss += __shfl_xor(ss, 8);
            const float rstd = rsqrtf(ss * (1.f / 128.f) + EPS);
#pragma unroll
            for (int i = 0; i < 8; ++i) f[i] *= rstd * kg8[i];
            *(v4u*)(memkn + (size_t)r * 512 + 8 * lane) = pack8f(f);
        }
    }
}

DI void p4_kcvc(Frame& F) {
    unsigned char* ws = F.ws;
    const int gw = F.bx * NWAVES + F.wave, NGW = F.G * NWAVES, lane = F.lane;
    const bf16* hid = (const bf16*)(ws + WS_HID);
    const float* rc = (const float*)(ws + WS_SMALL + SM_ROPEC); const float* rs = (const float*)(ws + WS_SMALL + SM_ROPES);
    const float gk = F.in[I_NGK][lane];
    for (int it = gw; it < 2 * 4096; it += NGW) {
        const int kv = it >> 12, r = it & 4095, n = r & 127;
        bf16* dst = (bf16*)(ws + (kv ? WS_VC : WS_KC)) + (size_t)r * 64 + lane;
        if (n == 127) { *dst = 0; continue; }
        const bf16* hr = hid + (size_t)kv * 4096 * 256 + (size_t)r * 256; const float* w2 = F.in[kv ? I_CW2V : I_CW2K];
        float a = 0.f;
        for (int f = 0; f < 256; ++f) a = fmaf(bf2f(hr[f]), w2[f * 64 + lane], a);
        if (kv == 0) {
            const float y = a * rsqrtf(wave_sum(a * a) * (1.f / 64.f) + EPS) * gk;
            const int pos = 16 * n + 31; const float c = rc[pos * 32 + (lane & 31)], s = rs[pos * 32 + (lane & 31)];
            const float pt = __shfl_xor(y, 32);
            a = lane < 32 ? y * c - pt * s : y * c + pt * s;
        }
        *dst = (bf16)f2bf(a);
    }
}

DI void mlstm_unit(Frame& F, int unit) {
    unsigned char* ws = F.ws;
    const int b = unit >> 2, h = unit & 3, tid = F.tid, kk = tid >> 7, c = tid & 127;
    const bf16* proj = (const bf16*)(ws + WS_PROJ); const bf16* mlqk = (const bf16*)(ws + WS_MLQK); bf16* H0 = (bf16*)(ws + WS_H0);
    LAS float* qs = (LAS float*)F.lds;
    LAS float* ks = qs + 16 * 128;
    LAS float* vs = ks + 16 * 128;
    LAS float* gi = vs + 16 * 128;
    LAS float* gf = gi + 16;
    LAS float* part = gf + 16;
    LAS float* pden = part + 2 * 4 * 128;
    LAS float* hb = pden + 8;
    float C[32], nn[32];
#pragma unroll
    for (int i = 0; i < 32; ++i) { C[i] = 0.f; nn[i] = 0.f; }
    float m = 0.f;
    const float bi = F.in[I_MLBI][h], bfv = F.in[I_MLBF][h];
    const float scale = 0.08838834764831845f;
#pragma unroll 1
    for (int t0 = 0; t0 < SEQ; t0 += 16) {
        __syncthreads();
        for (int i = tid; i < 16 * 128; i += 512) { const int s = i >> 7, d = i & 127; const size_t t = (size_t)b * SEQ + t0 + s;
            qs[i] = bf2f(mlqk[t * 1024 + h * 128 + d]); ks[i] = bf2f(mlqk[t * 1024 + 512 + h * 128 + d]); vs[i] = bf2f(proj[t * NPROJ + PC_MLV + h * 128 + d]); }
        if (tid < 16) { const size_t t = (size_t)b * SEQ + t0 + tid; gi[tid] = bf2f(proj[t * NPROJ + PC_MLI + h]) + bi; gf[tid] = logsig(bf2f(proj[t * NPROJ + PC_MLF + h]) + bfv); }
        __syncthreads();
#pragma unroll 1
        for (int s = 0; s < 16; ++s) {
            const float lf = gf[s], ig = gi[s];
            const float mn = fmaxf(lf + m, ig), a = __expf(lf + m - mn), bb = __expf(ig - mn);
            m = mn;
            const float v = vs[s * 128 + c];
            float pn = 0.f, pd = 0.f;
#pragma unroll
            for (int i = 0; i < 32; ++i) { const float kvv = ks[s * 128 + kk * 32 + i], qv = qs[s * 128 + kk * 32 + i];
                C[i] = a * C[i] + bb * kvv * v; nn[i] = a * nn[i] + bb * kvv; pn = fmaf(qv, C[i], pn); pd = fmaf(qv, nn[i], pd); }
            const int par = s & 1;
            part[(par * 4 + kk) * 128 + c] = pn; if (c == 0) pden[par * 4 + kk] = pd;
            __syncthreads();
            if (kk == 0) {
                const float num = (part[(par * 4 + 0) * 128 + c] + part[(par * 4 + 1) * 128 + c]) + (part[(par * 4 + 2) * 128 + c] + part[(par * 4 + 3) * 128 + c]);
                const float den = (pden[par * 4 + 0] + pden[par * 4 + 1]) + (pden[par * 4 + 2] + pden[par * 4 + 3]);
                hb[s * 128 + c] = num * scale / fmaxf(fabsf(den * scale), __expf(-mn));
            }
        }
        __syncthreads();
#pragma unroll
        for (int rr = 0; rr < 2; ++rr) { const int s = F.wave * 2 + rr; const size_t t = (size_t)b * SEQ + t0 + s;
            const float v0 = hb[s * 128 + F.lane], v1 = hb[s * 128 + 64 + F.lane];
            const float rstd = rsqrtf(wave_sum(v0 * v0 + v1 * v1) * (1.f / 128.f) + EPS);
            const float o0 = bf2f(proj[t * NPROJ + PC_MLO + h * 128 + F.lane]), o1 = bf2f(proj[t * NPROJ + PC_MLO + h * 128 + 64 + F.lane]);
            H0[t * 512 + h * 128 + F.lane] = (bf16)f2bf(v0 * rstd * F.in[I_MLGOUT][h * 128 + F.lane] * sigm(o0));
            H0[t * 512 + h * 128 + 64 + F.lane] = (bf16)f2bf(v1 * rstd * F.in[I_MLGOUT][h * 128 + 64 + F.lane] * sigm(o1)); }
    }
    __syncthreads();
}

DI void nsa_scores(const bf16* krow, bool valid, const LAS float* qs, float (&s)[4]) {
    s[0] = s[1] = s[2] = s[3] = 0.f;
    if (valid) {
#pragma unroll 2
        for (int c8 = 0; c8 < 8; ++c8) { const v4u kk = *(const v4u*)(krow + c8 * 8);
            const unsigned w[4] = {kk.x, kk.y, kk.z, kk.w};
#pragma unroll
            for (int j = 0; j < 4; ++j) { const float k0 = __uint_as_float(w[j] << 16), k1 = __uint_as_float(w[j] & 0xffff0000u); const int d = c8 * 8 + 2 * j;
#pragma unroll
                for (int g = 0; g < 4; ++g) s[g] = fmaf(k1, qs[g * 64 + d + 1], fmaf(k0, qs[g * 64 + d], s[g])); } }
    }
}
DI void nsa_wave(Frame& F, int item, LAS float* wl) {
    unsigned char* ws = F.ws; const int lane = F.lane;
    const int t = item >> 1, hkv = item & 1, b = t >> 11, tau = t & 2047;
    const bf16* proj = (const bf16*)(ws + WS_PROJ);
    const bf16* qn = (const bf16*)(ws + WS_QN); const bf16* ksn = (const bf16*)(ws + WS_KSN); const bf16* kwn = (const bf16*)(ws + WS_KWN);
    const bf16* kc = (const bf16*)(ws + WS_KC); const bf16* vc = (const bf16*)(ws + WS_VC); bf16* H1 = (bf16*)(ws + WS_H1);
    LAS float* qs = wl;
    LAS float* ps = wl + 256;
    LAS float* psum = wl + 768;
#pragma unroll
    for (int g = 0; g < 4; ++g) qs[g * 64 + lane] = bf2f(qn[(size_t)t * 512 + (hkv * 4 + g) * 64 + lane]);
    float ofin[4] = {0.f, 0.f, 0.f, 0.f};
    float gate[4][3];
#pragma unroll
    for (int g = 0; g < 4; ++g)
#pragma unroll
        for (int cidx = 0; cidx < 3; ++cidx) gate[g][cidx] = sigm(bf2f(proj[(size_t)t * NPROJ + PC_NG + (hkv * 4 + g) * 3 + cidx]));
    const int ncmp = tau >= 31 ? ((tau - 31) >> 4) + 1 : 0;
    {
        float l[4] = {0.f, 0.f, 0.f, 0.f}, o[4] = {0.f, 0.f, 0.f, 0.f};
        const size_t rbase = (size_t)(b * 2 + hkv) * 128;
#pragma unroll
        for (int blk = 0; blk < 2; ++blk) { const int n = blk * 64 + lane; const bool valid = n < ncmp; float s[4];
            nsa_scores(kc + (rbase + n) * 64, valid, qs, s);
#pragma unroll
            for (int g = 0; g < 4; ++g) { const float p = valid ? __expf(s[g]) : 0.f; l[g] += p; ps[g * 128 + n] = p; } }
        float inv[4];
#pragma unroll
        for (int g = 0; g < 4; ++g) { const float L = wave_sum(l[g]); inv[g] = L > 0.f ? 1.f / L : 0.f; }
#pragma unroll
        for (int blk = 0; blk < 2; ++blk) { const int n = blk * 64 + lane; psum[n] = (ps[0 * 128 + n] * inv[0] + ps[1 * 128 + n] * inv[1]) + (ps[2 * 128 + n] * inv[2] + ps[3 * 128 + n] * inv[3]); }
#pragma unroll 2
        for (int n = 0; n < ncmp; ++n) { const float vv = bf2f(vc[(rbase + n) * 64 + lane]);
#pragma unroll
            for (int g = 0; g < 4; ++g) o[g] = fmaf(ps[g * 128 + n], vv, o[g]); }
#pragma unroll
        for (int g = 0; g < 4; ++g) ofin[g] += gate[g][0] * o[g] * inv[g];
    }
    const int cur = tau >> 6;
    unsigned selmask = 0u;
    {
        float score = -3.0e38f;
        if (lane < 32) { const int j = lane; float imp = 0.f;
#pragma unroll
            for (int dn = -1; dn <= 3; ++dn) { const int n = 4 * j + dn; if (n >= 0 && n <= 126) imp += psum[n]; }
            const bool forced = (j == 0) || (j == cur) || (j == cur - 1);
            score = j > cur ? NEGF : imp + (forced ? 1.0e4f : 0.f); }
#pragma unroll 1
        for (int r = 0; r < 8; ++r) { const float mx = wave_max(score); const unsigned long long bal = __ballot(score == mx); const int win = __ffsll((long long)bal) - 1;
            selmask |= 1u << win; if (lane == win) score = -3.4e38f; }
    }
    {
        float l[4] = {0.f, 0.f, 0.f, 0.f}, o[4] = {0.f, 0.f, 0.f, 0.f};
#pragma unroll 1
        for (int j = 0; j <= cur; ++j) { if (!((selmask >> j) & 1u)) continue;
            const int kpos = 64 * j + lane; const bool valid = kpos <= tau; float s[4];
            nsa_scores(ksn + ((size_t)b * SEQ + kpos) * 128 + hkv * 64, valid, qs, s);
#pragma unroll
            for (int g = 0; g < 4; ++g) { const float p = valid ? __expf(s[g]) : 0.f; l[g] += p; ps[g * 128 + lane] = p; }
            const int nk = j == cur ? (tau & 63) + 1 : 64;
            const bf16* vb = proj + ((size_t)b * SEQ + 64 * j) * NPROJ + PC_NVS + hkv * 64 + lane;
#pragma unroll 2
            for (int k = 0; k < nk; ++k) { const float vv = bf2f(vb[(size_t)k * NPROJ]);
#pragma unroll
                for (int g = 0; g < 4; ++g) o[g] = fmaf(ps[g * 128 + k], vv, o[g]); } }
#pragma unroll
        for (int g = 0; g < 4; ++g) { const float L = wave_sum(l[g]); ofin[g] += gate[g][1] * o[g] * (L > 0.f ? 1.f / L : 0.f); }
    }
    {
        float l[4] = {0.f, 0.f, 0.f, 0.f}, o[4] = {0.f, 0.f, 0.f, 0.f};
        const int start = tau - 511 > 0 ? tau - 511 : 0;
#pragma unroll 1
        for (int base = start & ~63; base <= tau; base += 64) {
            const int kpos = base + lane; const bool valid = kpos >= start && kpos <= tau; float s[4];
            nsa_scores(kwn + ((size_t)b * SEQ + kpos) * 128 + hkv * 64, valid, qs, s);
#pragma unroll
            for (int g = 0; g < 4; ++g) { const float p = valid ? __expf(s[g]) : 0.f; l[g] += p; ps[g * 128 + lane] = p; }
            const int k0 = start > base ? start - base : 0, k1 = tau - base < 63 ? tau - base : 63;
            const bf16* vb = proj + ((size_t)b * SEQ + base) * NPROJ + PC_NVW + hkv * 64 + lane;
#pragma unroll 2
            for (int k = k0; k <= k1; ++k) { const float vv = bf2f(vb[(size_t)k * NPROJ]);
#pragma unroll
                for (int g = 0; g < 4; ++g) o[g] = fmaf(ps[g * 128 + k], vv, o[g]); } }
#pragma unroll
        for (int g = 0; g < 4; ++g) { const float L = wave_sum(l[g]); ofin[g] += gate[g][2] * o[g] * (L > 0.f ? 1.f / L : 0.f); }
    }
#pragma unroll
    for (int g = 0; g < 4; ++g) H1[(size_t)t * 512 + (hkv * 4 + g) * 64 + lane] = (bf16)f2bf(ofin[g]);
}
DI void mem_wave(Frame& F, int t, LAS float* wl) {
    unsigned char* ws = F.ws; const int lane = F.lane; const int b = t >> 11;
    const bf16* mqn = (const bf16*)(ws + WS_MQN); const bf16* memkn = (const bf16*)(ws + WS_MEMKN); const bf16* memkv = (const bf16*)(ws + WS_MEMKV); bf16* H2 = (bf16*)(ws + WS_H2);
    LAS float* qs = wl;
    LAS float* ps = wl + 128;
#pragma unroll 1
    for (int h = 0; h < 4; ++h) {
        qs[lane] = bf2f(mqn[(size_t)t * 512 + h * 128 + lane]); qs[64 + lane] = bf2f(mqn[(size_t)t * 512 + h * 128 + 64 + lane]);
        float l = 0.f;
#pragma unroll 1
        for (int kq = 0; kq < 4; ++kq) { const int key = kq * 64 + lane; const bf16* kr = memkn + ((size_t)b * MEML + key) * 512 + h * 128; float s = 0.f;
#pragma unroll 2
            for (int c8 = 0; c8 < 16; ++c8) { const v4u kk = *(const v4u*)(kr + c8 * 8); const unsigned w[4] = {kk.x, kk.y, kk.z, kk.w};
#pragma unroll
                for (int j = 0; j < 4; ++j) s = fmaf(__uint_as_float(w[j] & 0xffff0000u), qs[c8 * 8 + 2 * j + 1], fmaf(__uint_as_float(w[j] << 16), qs[c8 * 8 + 2 * j], s)); }
            const float p = __expf(s); l += p; ps[key] = p; }
        const float inv = 1.f / wave_sum(l);
        float o0 = 0.f, o1 = 0.f;
        const bf16* vb = memkv + (size_t)b * MEML * 1024 + 512 + h * 128;
#pragma unroll 4
        for (int key = 0; key < MEML; ++key) { const float p = ps[key]; o0 = fmaf(p, bf2f(vb[(size_t)key * 1024 + lane]), o0); o1 = fmaf(p, bf2f(vb[(size_t)key * 1024 + 64 + lane]), o1); }
        H2[(size_t)t * 512 + h * 128 + lane] = (bf16)f2bf(o0 * inv); H2[(size_t)t * 512 + h * 128 + 64 + lane] = (bf16)f2bf(o1 * inv);
    }
}
typedef float f32x16 __attribute__((ext_vector_type(16)));
typedef float f32x2v __attribute__((ext_vector_type(2)));
typedef __bf16 bf16x2v __attribute__((ext_vector_type(2)));
typedef short s16x4 __attribute__((ext_vector_type(4)));
typedef unsigned u32x2 __attribute__((ext_vector_type(2)));
#define MFMA32(a, b, c) __builtin_amdgcn_mfma_f32_32x32x16_bf16((a), (b), (c), 0, 0, 0)
#define WG_BAR() do { asm volatile("s_waitcnt vmcnt(0) lgkmcnt(0)" ::: "memory"); __builtin_amdgcn_s_barrier(); asm volatile("" ::: "memory"); } while (0)
DI unsigned pkbf(float lo, float hi) { f32x2v v = {lo, hi}; return __builtin_bit_cast(unsigned, __builtin_convertvector(v, bf16x2v)); }
template <int S> DI bf16x8 pack8(const f32x16& x) {
    v4u p; p.x = pkbf(x[8 * S], x[8 * S + 1]); p.y = pkbf(x[8 * S + 2], x[8 * S + 3]); p.z = pkbf(x[8 * S + 4], x[8 * S + 5]); p.w = pkbf(x[8 * S + 6], x[8 * S + 7]);
    return __builtin_bit_cast(bf16x8, p);
}
DI int crow(int i, int h) { return (i & 3) + 8 * (i >> 2) + 4 * h; }
constexpr int AT_K = 0, AT_V = 16384, AT_IMP = 32768, AT_WM = 65536, AT_INV = 65536 + 64, AT_SC = 65536 + 64 + 1024;

DI void at_load(LAS unsigned char* lds, int par, const void* kb, size_t kpitch, const void* vb, size_t vpitch, int wave, int lane) {
    const int row = 8 * wave + (lane >> 3), pc = lane & 7;
    const int kc = pc ^ ((row >> 1) & 7), vc = pc ^ (((row >> 1) & 1) << 2);
    __builtin_amdgcn_global_load_lds((const unsigned*)((const char*)kb + (size_t)row * kpitch + 16 * kc), (LAS unsigned*)(lds + AT_K + par * 8192 + wave * 1024), 16, 0, 0);
    __builtin_amdgcn_global_load_lds((const unsigned*)((const char*)vb + (size_t)row * vpitch + 16 * vc), (LAS unsigned*)(lds + AT_V + par * 8192 + wave * 1024), 16, 0, 0);
}
DI void at_qk(const LAS unsigned char* kbuf, const int (&ka)[4], const bf16x8 (&qf)[4], f32x16 (&s)[2]) {
#pragma unroll
    for (int kb = 0; kb < 2; ++kb) {
        f32x16 a;
#pragma unroll
        for (int i = 0; i < 16; ++i) a[i] = 0.f;
#pragma unroll
        for (int st = 0; st < 4; ++st) { const bf16x8 kf = *(const LAS bf16x8*)(kbuf + ka[st] + kb * 4096); a = MFMA32(kf, qf[st], a); }
        s[kb] = a;
    }
}
DI void at_pv(const LAS unsigned char* vbuf, const int (&va)[2], const f32x16 (&p)[2], f32x16 (&o)[2]) {
    typedef __attribute__((address_space(3))) s16x4 lds_s16x4;
#pragma unroll
    for (int kb = 0; kb < 2; ++kb) {
        const bf16x8 pf0 = pack8<0>(p[kb]), pf1 = pack8<1>(p[kb]);
#pragma unroll
        for (int s2 = 0; s2 < 2; ++s2)
#pragma unroll
            for (int db = 0; db < 2; ++db) {
                const s16x4 lo = __builtin_amdgcn_ds_read_tr16_b64_v4i16((lds_s16x4*)(vbuf + va[db] + kb * 4096 + s2 * 2048));
                const s16x4 hi = __builtin_amdgcn_ds_read_tr16_b64_v4i16((lds_s16x4*)(vbuf + va[db] + kb * 4096 + s2 * 2048 + 1024));
                const bf16x8 vf = __builtin_shufflevector(lo, hi, 0, 1, 2, 3, 4, 5, 6, 7);
                o[db] = MFMA32(vf, s2 ? pf1 : pf0, o[db]);
            }
    }
}

DI void nsa_unit(Frame& F, int unit) {
    unsigned char* ws = F.ws; LAS unsigned char* lds = F.lds;
    int lane_ = F.lane; asm volatile("" : "+v"(lane_));
    const int lane = lane_, wave = F.wave, r = lane & 31, h = lane >> 5, g = wave >> 1, qh = wave & 1;
    const int bh = unit & 31, qt = 31 - (unit >> 5), b = bh >> 1, hkv = bh & 1;
    const int qloc = 32 * qh + r, tau = 64 * qt + qloc, qq = tau & 63; const size_t t = (size_t)b * SEQ + tau;
    const bf16* proj = (const bf16*)(ws + WS_PROJ);
    const bf16* qn = (const bf16*)(ws + WS_QN); const bf16* ksn = (const bf16*)(ws + WS_KSN); const bf16* kwn = (const bf16*)(ws + WS_KWN);
    const bf16* kc = (const bf16*)(ws + WS_KC); const bf16* vc = (const bf16*)(ws + WS_VC); bf16* H1 = (bf16*)(ws + WS_H1);
    int ka[4], va[2];
    { const int f = (r >> 1) & 7, fs = f >> 1, hb = h ^ (f & 1);
#pragma unroll
      for (int st = 0; st < 4; ++st) ka[st] = r * 128 + 16 * (((st ^ fs) << 1) | hb);
      const int i16 = lane & 15, q = i16 >> 2, p = i16 & 3, g1 = (lane >> 4) & 1;
#pragma unroll
      for (int db = 0; db < 2; ++db) va[db] = (4 * h + q) * 128 + 16 * ((4 * db + 2 * g1 + (p >> 1)) ^ (((q >> 1) & 1) << 2)) + 8 * (p & 1); }
    bf16x8 qf[4];
#pragma unroll
    for (int st = 0; st < 4; ++st) qf[st] = *(const bf16x8*)(qn + t * 512 + (hkv * 4 + g) * 64 + 16 * st + 8 * h);
    float gate[3];
#pragma unroll
    for (int c = 0; c < 3; ++c) gate[c] = sigm(bf2f(proj[t * NPROJ + PC_NG + (hkv * 4 + g) * 3 + c]));
    f32x16 ofin[2];
#pragma unroll
    for (int i = 0; i < 16; ++i) { ofin[0][i] = 0.f; ofin[1][i] = 0.f; }
    WG_BAR();
    {
        const int ncq = tau >= 31 ? ((tau - 31) >> 4) + 1 : 0;
        const int ntc = (((64 * qt + 63 - 31) >> 4) + 1 > 64) ? 2 : 1;
        const char* kb0 = (const char*)(kc + (size_t)(b * 2 + hkv) * 128 * 64); const char* vb0 = (const char*)(vc + (size_t)(b * 2 + hkv) * 128 * 64);
        at_load(lds, 0, kb0, 128, vb0, 128, wave, lane);
        if (ntc == 2) at_load(lds, 1, kb0 + 64 * 128, 128, vb0 + 64 * 128, 128, wave, lane);
        WG_BAR();
        f32x16 o[2]; float l = 0.f, prevEp = 0.f;
#pragma unroll
        for (int i = 0; i < 16; ++i) { o[0][i] = 0.f; o[1][i] = 0.f; }
        LAS float* I = (LAS float*)(lds + AT_IMP) + (g * 64 + qloc) * 32;
#pragma unroll 1
        for (int tile = 0; tile < 2; ++tile) {
            if (tile < ntc) {
                f32x16 s[2];
                at_qk(lds + AT_K + tile * 8192, ka, qf, s);
#pragma unroll
                for (int kb = 0; kb < 2; ++kb)
#pragma unroll
                    for (int i = 0; i < 16; ++i) { const int n = 64 * tile + 32 * kb + crow(i, h); const float p = n < ncq ? __builtin_amdgcn_exp2f(s[kb][i]) : 0.f; s[kb][i] = p; l += p; }
#pragma unroll
                for (int kb = 0; kb < 2; ++kb)
#pragma unroll
                    for (int a = 0; a < 4; ++a) { const int idx = tile * 8 + kb * 4 + a; const float Gv = (s[kb][4 * a] + s[kb][4 * a + 1]) + (s[kb][4 * a + 2] + s[kb][4 * a + 3]);
                        const float Epv = __shfl_xor(s[kb][4 * a + 3], 32);
                        I[2 * idx + h] = Gv + (h ? Epv : prevEp); prevEp = Epv; }
                at_pv(lds + AT_V + tile * 8192, va, s, o);
            } else {
#pragma unroll
                for (int idx = 8; idx < 16; ++idx) I[2 * idx + h] = 0.f;
            }
        }
        const float L = l + __shfl_xor(l, 32); const float inv = L > 0.f ? 1.f / L : 0.f;
        const float gi = gate[0] * inv;
#pragma unroll
        for (int i = 0; i < 16; ++i) { ofin[0][i] += gi * o[0][i]; ofin[1][i] += gi * o[1][i]; }
        if (h == 0) ((LAS float*)(lds + AT_INV))[g * 64 + qloc] = inv;
    }
    WG_BAR();
    unsigned sel = 0u, wm, um;
    {
        const LAS float* I = (const LAS float*)(lds + AT_IMP) + qloc * 32;
        const LAS float* IV = (const LAS float*)(lds + AT_INV) + qloc;
        const float iv0 = IV[0], iv1 = IV[64], iv2 = IV[128], iv3 = IV[192];
        LAS float* SC = (LAS float*)(lds + AT_SC) + (wave * 32 + r) * 33;
        if (h == 0) {
#pragma unroll 8
            for (int j = 0; j < 32; ++j) { const float imp = (I[j] * iv0 + I[64 * 32 + j] * iv1) + (I[2 * 64 * 32 + j] * iv2 + I[3 * 64 * 32 + j] * iv3);
                const bool forced = (j == 0) || (j == qt) || (j == qt - 1);
                SC[j] = j > qt ? NEGF : imp + (forced ? 1.0e4f : 0.f); }
        }
        asm volatile("s_waitcnt lgkmcnt(0)" ::: "memory");
#pragma unroll 1
        for (int rd = 0; rd < 8; ++rd) { float best = -3.4e38f; int bi = 0;
#pragma unroll 8
            for (int j = 0; j < 32; ++j) { const float v = ((sel >> j) & 1u) ? -3.4e38f : SC[j]; if (v > best) { best = v; bi = j; } }
            sel |= 1u << bi; }
        sel &= (qt == 31) ? 0xffffffffu : ((1u << (qt + 1)) - 1u);
        wm = sel;
#pragma unroll
        for (int o = 1; o < 32; o <<= 1) wm |= (unsigned)__shfl_xor((int)wm, o);
        wm = (unsigned)__builtin_amdgcn_readfirstlane((int)wm);
        if (lane == 0) ((LAS unsigned*)(lds + AT_WM))[wave] = wm;
        WG_BAR();
        um = 0u;
#pragma unroll
        for (int w = 0; w < 8; ++w) um |= ((const LAS unsigned*)(lds + AT_WM))[w];
        um = (unsigned)__builtin_amdgcn_readfirstlane((int)um);
    }
    {
        f32x16 o[2]; float l = 0.f;
#pragma unroll
        for (int i = 0; i < 16; ++i) { o[0][i] = 0.f; o[1][i] = 0.f; }
        const char* kbase = (const char*)(ksn + (size_t)b * SEQ * 128 + hkv * 64); const char* vbase = (const char*)(proj + (size_t)b * SEQ * NPROJ + PC_NVS + hkv * 64);
        unsigned rem = um; int par = 0;
        { const int j0 = __ffs((int)rem) - 1; at_load(lds, 0, kbase + (size_t)j0 * 64 * 256, 256, vbase + (size_t)j0 * 64 * NPROJ * 2, NPROJ * 2, wave, lane); }
#pragma unroll 1
        while (rem) {
            const int j = __ffs((int)rem) - 1; rem &= rem - 1u;
            WG_BAR();
            if (rem) { const int jn = __ffs((int)rem) - 1; at_load(lds, par ^ 1, kbase + (size_t)jn * 64 * 256, 256, vbase + (size_t)jn * 64 * NPROJ * 2, NPROJ * 2, wave, lane); }
            if ((wm >> j) & 1u) {
                f32x16 s[2];
                at_qk(lds + AT_K + par * 8192, ka, qf, s);
                const bool on = (sel >> j) & 1u; const int klim = j == qt ? qq : 63;
#pragma unroll
                for (int kb = 0; kb < 2; ++kb)
#pragma unroll
                    for (int i = 0; i < 16; ++i) { const int key = 32 * kb + crow(i, h); const float p = (on && key <= klim) ? __builtin_amdgcn_exp2f(s[kb][i]) : 0.f; s[kb][i] = p; l += p; }
                at_pv(lds + AT_V + par * 8192, va, s, o);
            }
            par ^= 1;
        }
        const float L = l + __shfl_xor(l, 32); const float gi = gate[1] * (L > 0.f ? 1.f / L : 0.f);
#pragma unroll
        for (int i = 0; i < 16; ++i) { ofin[0][i] += gi * o[0][i]; ofin[1][i] += gi * o[1][i]; }
    }
    WG_BAR();
    {
        f32x16 o[2]; float l = 0.f;
#pragma unroll
        for (int i = 0; i < 16; ++i) { o[0][i] = 0.f; o[1][i] = 0.f; }
        const char* kbase = (const char*)(kwn + (size_t)b * SEQ * 128 + hkv * 64); const char* vbase = (const char*)(proj + (size_t)b * SEQ * NPROJ + PC_NVW + hkv * 64);
        const int jlo = qt > 8 ? qt - 8 : 0; int par = 0;
        at_load(lds, 0, kbase + (size_t)jlo * 64 * 256, 256, vbase + (size_t)jlo * 64 * NPROJ * 2, NPROJ * 2, wave, lane);
#pragma unroll 1
        for (int j = jlo; j <= qt; ++j) {
            WG_BAR();
            if (j < qt) at_load(lds, par ^ 1, kbase + (size_t)(j + 1) * 64 * 256, 256, vbase + (size_t)(j + 1) * 64 * NPROJ * 2, NPROJ * 2, wave, lane);
            f32x16 s[2];
            at_qk(lds + AT_K + par * 8192, ka, qf, s);
            const int klo = (j == qt - 8) ? qq + 1 : 0, khi = (j == qt) ? qq : 63;
#pragma unroll
            for (int kb = 0; kb < 2; ++kb)
#pragma unroll
                for (int i = 0; i < 16; ++i) { const int key = 32 * kb + crow(i, h); const float p = (key >= klo && key <= khi) ? __builtin_amdgcn_exp2f(s[kb][i]) : 0.f; s[kb][i] = p; l += p; }
            at_pv(lds + AT_V + par * 8192, va, s, o);
            par ^= 1;
        }
        const float L = l + __shfl_xor(l, 32); const float gi = gate[2] * (L > 0.f ? 1.f / L : 0.f);
#pragma unroll
        for (int i = 0; i < 16; ++i) { ofin[0][i] += gi * o[0][i]; ofin[1][i] += gi * o[1][i]; }
    }
    bf16* orow = H1 + t * 512 + (hkv * 4 + g) * 64;
#pragma unroll
    for (int db = 0; db < 2; ++db)
#pragma unroll
        for (int a = 0; a < 4; ++a) { u32x2 w; w.x = pkbf(ofin[db][4 * a], ofin[db][4 * a + 1]); w.y = pkbf(ofin[db][4 * a + 2], ofin[db][4 * a + 3]); *(u32x2*)(orow + 32 * db + 8 * a + 4 * h) = w; }
}
constexpr int ML_K = 0, ML_V = 32768, ML_VW = 65536, ML_C = 81920, ML_N = 114688, ML_SS = 115200, ML_WS = 116224, ML_GO = 120320;
DI int ml_fk(int s) { return ((s & 3) << 2) | ((s >> 2) & 3); }
DI void ml_load(LAS unsigned char* lds, int par, const char* kb, const char* vb, int wave, int lane) {
#pragma unroll
    for (int n2 = 0; n2 < 2; ++n2) { const int n = 2 * wave + n2, row = 4 * n + (lane >> 4), pc = lane & 15;
        const int kc = pc ^ ml_fk(row), vc = pc ^ ((row & 3) << 2);
        __builtin_amdgcn_global_load_lds((const unsigned*)(kb + (size_t)row * 2048 + 16 * kc), (LAS unsigned*)(lds + ML_K + par * 16384 + n * 1024), 16, 0, 0);
        __builtin_amdgcn_global_load_lds((const unsigned*)(vb + (size_t)row * (NPROJ * 2) + 16 * vc), (LAS unsigned*)(lds + ML_V + par * 16384 + n * 1024), 16, 0, 0); }
}
DI bf16x8 ml_tr8(const LAS unsigned char* p) {
    typedef __attribute__((address_space(3))) s16x4 lds_s16x4;
    const s16x4 lo = __builtin_amdgcn_ds_read_tr16_b64_v4i16((lds_s16x4*)p); const s16x4 hi = __builtin_amdgcn_ds_read_tr16_b64_v4i16((lds_s16x4*)(p + 1024));
    return __builtin_shufflevector(lo, hi, 0, 1, 2, 3, 4, 5, 6, 7);
}
DI void mlstm_unit2(Frame& F, int unit) {
    unsigned char* ws = F.ws; LAS unsigned char* lds = F.lds;
    int lane_ = F.lane; asm volatile("" : "+v"(lane_));
    const int lane = lane_, wave = F.wave, tid = wave * 64 + lane, r = lane & 31, hh = lane >> 5, tb = wave >> 2, vb = wave & 3;
    const int b = unit >> 2, hd = unit & 3;
    const bf16* proj = (const bf16*)(ws + WS_PROJ); const bf16* mlqk = (const bf16*)(ws + WS_MLQK); bf16* H0 = (bf16*)(ws + WS_H0);
    const size_t tok0 = (size_t)b * SEQ;
    const char* kbase = (const char*)(mlqk + tok0 * 1024 + 512 + hd * 128); const char* vbase = (const char*)(proj + tok0 * NPROJ + PC_MLV + hd * 128);
    const float LOG2E = 1.4426950408889634f;
    const int i16 = lane & 15, q4 = i16 >> 2, p4 = i16 & 3, g1 = (lane >> 4) & 1;
    const int colsw = 16 * ((4 * vb + 2 * g1 + (p4 >> 1)) ^ (q4 << 2)) + 8 * (p4 & 1);
    const int base_c = (8 * hh + q4) * 256 + colsw;
    const int base_v = (4 * hh + q4) * 256 + colsw;
    const int fK = ml_fk(r), rowK = r * 256 + ((hh ^ (fK & 1)) << 4), F16 = (fK & 14) << 4;
    int base_kt[2][2];
#pragma unroll
    for (int blk = 0; blk < 2; ++blk)
#pragma unroll
        for (int hi = 0; hi < 2; ++hi) { const int kbp = 2 * tb + blk; base_kt[blk][hi] = (8 * hh + 4 * hi + q4) * 256 + 16 * ((4 * kbp + 2 * g1 + (p4 >> 1)) ^ ((q4 << 2) | ((2 * hh + hi) & 3))) + 8 * (p4 & 1); }
    LAS float* WS = (LAS float*)(lds + ML_WS) + wave * 128;
    LAS float* NV = (LAS float*)(lds + ML_N); LAS float* SS = (LAS float*)(lds + ML_SS);
    __syncthreads();
    for (int i = tid; i < 32768 / 16; i += 512) ((LAS v4u*)(lds + ML_C))[i] = (v4u){0u, 0u, 0u, 0u};
    if (tid < 128) NV[tid] = 0.f;
    f32x16 Cst[2];
#pragma unroll
    for (int i = 0; i < 16; ++i) { Cst[0][i] = 0.f; Cst[1][i] = 0.f; }
    if (tid < 128) ((LAS float*)(lds + ML_GO))[tid] = F.in[I_MLGOUT][hd * 128 + tid];
    const float bi = F.in[I_MLBI][hd], bfv = F.in[I_MLBF][hd];
    float m_prev = 0.f;
    ml_load(lds, 0, kbase, vbase, wave, lane);
    bf16x8 qf[8];
    { const bf16* qp = mlqk + (tok0 + 32 * tb + r) * 1024 + hd * 128 + 8 * hh;
#pragma unroll
      for (int st = 0; st < 8; ++st) qf[st] = *(const bf16x8*)(qp + 16 * st); }
    float gi_raw = bf2f(proj[(tok0 + lane) * NPROJ + PC_MLI + hd]), gf_raw = bf2f(proj[(tok0 + lane) * NPROJ + PC_MLF + hd]);
#pragma unroll 1
    for (int c = 0; c < 32; ++c) {
        const int par = c & 1; const size_t tokc = tok0 + 64 * c;
        WG_BAR();
        if (c < 31) ml_load(lds, par ^ 1, kbase + (size_t)(64 * (c + 1)) * 2048, vbase + (size_t)(64 * (c + 1)) * (NPROJ * 2), wave, lane);
        u32x2 og[4];
        { const bf16* op = proj + (tokc + 32 * tb + r) * NPROJ + PC_MLO + hd * 128 + 32 * vb + 4 * hh;
#pragma unroll
          for (int a = 0; a < 4; ++a) og[a] = *(const u32x2*)(op + 8 * a); }
        const float ig = gi_raw + bi, lf = logsig(gf_raw + bfv);
        float bc = lf;
#pragma unroll
        for (int o = 1; o < 64; o <<= 1) { const float v = __shfl_up(bc, o); if (lane >= o) bc += v; }
        const float rr = ig - bc;
        float cm = rr;
#pragma unroll
        for (int o = 1; o < 64; o <<= 1) { const float v = __shfl_up(cm, o); if (lane >= o) cm = fmaxf(cm, v); }
        const float M63 = fmaxf(m_prev, __shfl(cm, 63)), blast = __shfl(bc, 63);
        const float a_old = __expf(m_prev - M63), m_new = blast + M63;
        const int tl = 32 * tb + r;
        const float Mt = fmaxf(m_prev, __shfl(cm, tl)), bt = __shfl(bc, tl);
        const float inter = __expf(m_prev - Mt), m_t = bt + Mt;
        WS[lane] = rr * LOG2E; WS[64 + lane] = __expf(rr - M63);
        const float MtL = Mt * LOG2E;
        const LAS unsigned char* kbuf = lds + ML_K + par * 16384; const LAS unsigned char* vbuf = lds + ML_V + par * 16384;
        f32x16 wd[2]; float dsum = 0.f;
#pragma unroll
        for (int kb = 0; kb < 2; ++kb) {
#pragma unroll
            for (int i = 0; i < 16; ++i) wd[kb][i] = 0.f;
            if (kb <= tb) {
                f32x16 a = wd[kb];
#pragma unroll
                for (int st = 0; st < 8; ++st) { const bf16x8 kf = *(const LAS bf16x8*)(kbuf + kb * 8192 + rowK + ((32 * st) ^ F16)); a = MFMA32(kf, qf[st], a); }
#pragma unroll
                for (int i = 0; i < 16; ++i) { const int s = 32 * kb + crow(i, hh); const float e = __builtin_amdgcn_exp2f(WS[s] - MtL); const float w = (s <= tl) ? e * a[i] : 0.f; a[i] = w; dsum += w; }
                wd[kb] = a;
            }
        }
        f32x16 acc;
#pragma unroll
        for (int i = 0; i < 16; ++i) acc[i] = 0.f;
#pragma unroll
        for (int st = 0; st < 8; ++st) { const bf16x8 cf = ml_tr8(lds + ML_C + base_c + st * 4096); acc = MFMA32(cf, qf[st], acc); }
#pragma unroll
        for (int i = 0; i < 16; ++i) acc[i] *= inter;
#pragma unroll
        for (int kb = 0; kb < 2; ++kb) {
            if (kb <= tb) {
                const bf16x8 pf0 = pack8<0>(wd[kb]), pf1 = pack8<1>(wd[kb]);
                { typedef __attribute__((address_space(3))) s16x4 lds_s16x4;
#pragma unroll
                  for (int s2 = 0; s2 < 2; ++s2) { const LAS unsigned char* p = vbuf + base_v + kb * 8192 + s2 * 4096;
                    const s16x4 lo = __builtin_amdgcn_ds_read_tr16_b64_v4i16((lds_s16x4*)p); const s16x4 hi = __builtin_amdgcn_ds_read_tr16_b64_v4i16((lds_s16x4*)(p + 2048));
                    const bf16x8 vf = __builtin_shufflevector(lo, hi, 0, 1, 2, 3, 4, 5, 6, 7);
                    acc = MFMA32(vf, s2 ? pf1 : pf0, acc); } }
            }
        }
        float qn_ = 0.f;
#pragma unroll
        for (int st = 0; st < 8; ++st) { const v4u qw = __builtin_bit_cast(v4u, qf[st]); const LAS float* np = NV + 16 * st + 8 * hh; const f32x4 n0 = *(const LAS f32x4*)np, n1 = *(const LAS f32x4*)(np + 4);
            qn_ = fmaf(__uint_as_float(qw.x << 16), n0[0], qn_); qn_ = fmaf(__uint_as_float(qw.x & 0xffff0000u), n0[1], qn_); qn_ = fmaf(__uint_as_float(qw.y << 16), n0[2], qn_); qn_ = fmaf(__uint_as_float(qw.y & 0xffff0000u), n0[3], qn_);
            qn_ = fmaf(__uint_as_float(qw.z << 16), n1[0], qn_); qn_ = fmaf(__uint_as_float(qw.z & 0xffff0000u), n1[1], qn_); qn_ = fmaf(__uint_as_float(qw.w << 16), n1[2], qn_); qn_ = fmaf(__uint_as_float(qw.w & 0xffff0000u), n1[3], qn_); }
        qn_ += __shfl_xor(qn_, 32); dsum += __shfl_xor(dsum, 32);
        const float den = inter * qn_ + dsum; const float rden = 1.f / fmaxf(fabsf(den), __expf(-m_t));
        float ssq = 0.f;
#pragma unroll
        for (int i = 0; i < 16; ++i) { acc[i] *= rden; ssq = fmaf(acc[i], acc[i], ssq); }
        ssq += __shfl_xor(ssq, 32);
        if (hh == 0) SS[vb * 64 + tl] = ssq;
#pragma unroll
        for (int k2 = 0; k2 < 2; ++k2) { const int ci = tid + 512 * k2, s = ci >> 4; const float w = WS[64 + s];
            const v4u x = *(const LAS v4u*)(vbuf + ci * 16); v4u y; const unsigned xs[4] = {x.x, x.y, x.z, x.w}; unsigned ys[4];
#pragma unroll
            for (int j = 0; j < 4; ++j) ys[j] = pkbf(__uint_as_float(xs[j] << 16) * w, __uint_as_float(xs[j] & 0xffff0000u) * w);
            y.x = ys[0]; y.y = ys[1]; y.z = ys[2]; y.w = ys[3]; *(LAS v4u*)(lds + ML_VW + ci * 16) = y; }
        WG_BAR();
        { const LAS float* GO = (const LAS float*)(lds + ML_GO) + 32 * vb + 4 * hh;
          const float rstd = rsqrtf(((SS[tl] + SS[64 + tl]) + (SS[128 + tl] + SS[192 + tl])) * (1.f / 128.f) + EPS);
          bf16* orow = H0 + (tokc + tl) * 512 + hd * 128 + 32 * vb + 4 * hh;
#pragma unroll
          for (int a = 0; a < 4; ++a) { float o4[4]; const unsigned gw[2] = {og[a].x, og[a].y};
#pragma unroll
              for (int j = 0; j < 4; ++j) { const float ov = (j & 1) ? __uint_as_float(gw[j >> 1] & 0xffff0000u) : __uint_as_float(gw[j >> 1] << 16); o4[j] = acc[4 * a + j] * rstd * GO[8 * a + j] * sigm(ov); }
              u32x2 w; w.x = pkbf(o4[0], o4[1]); w.y = pkbf(o4[2], o4[3]); *(u32x2*)(orow + 8 * a) = w; } }
#pragma unroll
        for (int blk = 0; blk < 2; ++blk) {
            f32x16 cs = Cst[blk];
#pragma unroll
            for (int i = 0; i < 16; ++i) cs[i] *= a_old;
#pragma unroll
            for (int st = 0; st < 4; ++st) {
                typedef __attribute__((address_space(3))) s16x4 lds_s16x4;
                const bf16x8 af = ml_tr8(lds + ML_VW + base_c + st * 4096);
                const s16x4 lo = __builtin_amdgcn_ds_read_tr16_b64_v4i16((lds_s16x4*)(kbuf + base_kt[blk][0] + st * 4096)); const s16x4 hi = __builtin_amdgcn_ds_read_tr16_b64_v4i16((lds_s16x4*)(kbuf + base_kt[blk][1] + st * 4096));
                const bf16x8 kf = __builtin_shufflevector(lo, hi, 0, 1, 2, 3, 4, 5, 6, 7);
                cs = MFMA32(af, kf, cs);
            }
            Cst[blk] = cs;
            const int kk = 32 * (2 * tb + blk) + r;
#pragma unroll
            for (int a = 0; a < 4; ++a) { u32x2 w; w.x = pkbf(cs[4 * a], cs[4 * a + 1]); w.y = pkbf(cs[4 * a + 2], cs[4 * a + 3]);
                *(LAS u32x2*)(lds + ML_C + kk * 256 + 16 * ((4 * vb + a) ^ ((r & 3) << 2)) + 8 * hh) = w; }
        }
        if (tid < 128) { float nv = NV[tid] * a_old;
#pragma unroll 8
            for (int s = 0; s < 64; ++s) { const unsigned short kvs = *(const LAS unsigned short*)(kbuf + s * 256 + 16 * ((tid >> 3) ^ ml_fk(s)) + 2 * (tid & 7)); nv = fmaf(WS[64 + s], bf2f(kvs), nv); }
            NV[tid] = nv; }
        m_prev = m_new;
        if (c < 31) {
            const bf16* qp = mlqk + (tokc + 64 + 32 * tb + r) * 1024 + hd * 128 + 8 * hh;
#pragma unroll
            for (int st = 0; st < 8; ++st) qf[st] = *(const bf16x8*)(qp + 16 * st);
            gi_raw = bf2f(proj[(tokc + 64 + lane) * NPROJ + PC_MLI + hd]); gf_raw = bf2f(proj[(tokc + 64 + lane) * NPROJ + PC_MLF + hd]);
        }
    }
    __syncthreads();
}
DI void mem_load(LAS unsigned char* lds, int par, const char* kb, const char* vb, int wave, int lane) {
#pragma unroll
    for (int n2 = 0; n2 < 2; ++n2) { const int n = 2 * wave + n2, row = 4 * n + (lane >> 4), pc = lane & 15;
        const int kc = pc ^ ml_fk(row), vc = pc ^ ((row & 3) << 2);
        __builtin_amdgcn_global_load_lds((const unsigned*)(kb + (size_t)row * 1024 + 16 * kc), (LAS unsigned*)(lds + ML_K + par * 16384 + n * 1024), 16, 0, 0);
        __builtin_amdgcn_global_load_lds((const unsigned*)(vb + (size_t)row * 2048 + 16 * vc), (LAS unsigned*)(lds + ML_V + par * 16384 + n * 1024), 16, 0, 0); }
}
DI void mem_unit(Frame& F, int unit) {
    typedef __attribute__((address_space(3))) s16x4 lds_s16x4;
    unsigned char* ws = F.ws; LAS unsigned char* lds = F.lds;
    int lane_ = F.lane; asm volatile("" : "+v"(lane_));
    const int lane = lane_, wave = F.wave, r = lane & 31, hh = lane >> 5;
    const int b = unit >> 5, hd = (unit >> 3) & 3, qt = unit & 7;
    const bf16* mqn = (const bf16*)(ws + WS_MQN); const bf16* memkn = (const bf16*)(ws + WS_MEMKN); const bf16* memkv = (const bf16*)(ws + WS_MEMKV); bf16* H2 = (bf16*)(ws + WS_H2);
    const size_t t = (size_t)b * SEQ + 256 * qt + 32 * wave + r;
    const char* kbase = (const char*)(memkn + (size_t)b * MEML * 512 + hd * 128); const char* vbase = (const char*)(memkv + (size_t)b * MEML * 1024 + 512 + hd * 128);
    const int i16 = lane & 15, q4 = i16 >> 2, p4 = i16 & 3, g1 = (lane >> 4) & 1;
    int base_v[4];
#pragma unroll
    for (int db = 0; db < 4; ++db) base_v[db] = (4 * hh + q4) * 256 + 16 * ((4 * db + 2 * g1 + (p4 >> 1)) ^ (q4 << 2)) + 8 * (p4 & 1);
    const int fK = ml_fk(r), rowK = r * 256 + ((hh ^ (fK & 1)) << 4), F16 = (fK & 14) << 4;
    bf16x8 qf[8];
#pragma unroll
    for (int st = 0; st < 8; ++st) qf[st] = *(const bf16x8*)(mqn + t * 512 + hd * 128 + 16 * st + 8 * hh);
    f32x16 o[4]; float l = 0.f;
#pragma unroll
    for (int db = 0; db < 4; ++db)
#pragma unroll
        for (int i = 0; i < 16; ++i) o[db][i] = 0.f;
    WG_BAR();
    mem_load(lds, 0, kbase, vbase, wave, lane);
#pragma unroll 1
    for (int tile = 0; tile < 4; ++tile) {
        const int par = tile & 1;
        WG_BAR();
        if (tile < 3) mem_load(lds, par ^ 1, kbase + (size_t)(64 * (tile + 1)) * 1024, vbase + (size_t)(64 * (tile + 1)) * 2048, wave, lane);
        const LAS unsigned char* kbuf = lds + ML_K + par * 16384; const LAS unsigned char* vbuf = lds + ML_V + par * 16384;
#pragma unroll
        for (int kb = 0; kb < 2; ++kb) {
            f32x16 a;
#pragma unroll
            for (int i = 0; i < 16; ++i) a[i] = 0.f;
#pragma unroll
            for (int st = 0; st < 8; ++st) { const bf16x8 kf = *(const LAS bf16x8*)(kbuf + kb * 8192 + rowK + ((32 * st) ^ F16)); a = MFMA32(kf, qf[st], a); }
#pragma unroll
            for (int i = 0; i < 16; ++i) { a[i] = __builtin_amdgcn_exp2f(a[i]); l += a[i]; }
            const bf16x8 pf0 = pack8<0>(a), pf1 = pack8<1>(a);
#pragma unroll
            for (int s2 = 0; s2 < 2; ++s2)
#pragma unroll
                for (int db = 0; db < 4; ++db) { const LAS unsigned char* p = vbuf + base_v[db] + kb * 8192 + s2 * 4096;
                    const s16x4 lo = __builtin_amdgcn_ds_read_tr16_b64_v4i16((lds_s16x4*)p); const s16x4 hi = __builtin_amdgcn_ds_read_tr16_b64_v4i16((lds_s16x4*)(p + 2048));
                    const bf16x8 vf = __builtin_shufflevector(lo, hi, 0, 1, 2, 3, 4, 5, 6, 7);
                    o[db] = MFMA32(vf, s2 ? pf1 : pf0, o[db]); }
        }
    }
    const float inv = 1.f / (l + __shfl_xor(l, 32));
    bf16* orow = H2 + t * 512 + hd * 128 + 4 * hh;
#pragma unroll
    for (int db = 0; db < 4; ++db)
#pragma unroll
        for (int a = 0; a < 4; ++a) { u32x2 w; w.x = pkbf(o[db][4 * a] * inv, o[db][4 * a + 1] * inv); w.y = pkbf(o[db][4 * a + 2] * inv, o[db][4 * a + 3] * inv); *(u32x2*)(orow + 32 * db + 8 * a) = w; }
}
DI int q_pop(Frame& F, unsigned* qc) {
    __syncthreads();
    if (F.tid == 0) F.MISC[16] = atomicAdd(qc, 1u);
    __syncthreads();
    return (int)F.MISC[16];
}
template <bool ML, bool NSA, bool MEMA>
DI void p5_queue(Frame& F, int cbase) {
    unsigned* qc = F.ctl + CW_QCTR + cbase;
    if (ML) {
#pragma unroll 1
        for (;;) { const int it = q_pop(F, qc); if (it >= 64) break; mlstm_unit2(F, it); }
    }
    if (NSA) {
#pragma unroll 1
        for (;;) { const int it = q_pop(F, qc + 64); if (it >= 1024) break; nsa_unit(F, it); }
    }
    if (MEMA) {
#pragma unroll 1
        for (;;) { const int it = q_pop(F, qc + 128); if (it >= 512) break; mem_unit(F, it); }
    }
    __syncthreads();
}
DI void p5_mixers(Frame& F) {
    const int nml = F.G >= 128 ? 64 : 0;
#ifndef RPT_ML
#define RPT_ML 1
#endif
#ifndef RPT_NSA
#define RPT_NSA 1
#endif
#ifndef RPT_MEM
#define RPT_MEM 1
#endif
    if (F.bx < nml || nml == 0) { for (int rp = 0; rp < RPT_ML; ++rp) for (int u = F.bx; u < 64; u += (nml ? nml : F.G)) mlstm_unit2(F, u); }
    if (F.bx >= nml) {
        LAS float* wl = (LAS float*)(F.lds + F.wave * 4096);
        const int gw = (F.bx - nml) * NWAVES + F.wave, NGW = (F.G - nml) * NWAVES;
        for (int rp = 0; rp < RPT_NSA; ++rp) for (int u = F.bx - nml; u < 1024; u += F.G - nml) nsa_unit(F, u);
        __syncthreads();
        for (int rp = 0; rp < RPT_MEM; ++rp) for (int t = gw; t < MT; t += NGW) mem_wave(F, t, wl);
    }
}

DI void p8_router(Frame& F, int alt) {
    unsigned char* ws = F.ws + (size_t)alt * 3 * MiB; const int lane = F.lane, tid = F.tid, wave = F.wave, r = lane & 31, hh = lane >> 5;
    bf16* xn2 = (bf16*)(F.ws + WS_R1);
    int* tok_e = (int*)(ws + WS_ROUTE + RT_TOKE); int* tok_pos = (int*)(ws + WS_ROUTE + RT_TOKPOS); float* tok_w = (float*)(ws + WS_ROUTE + RT_TOKW);
    unsigned* gcnt = F.ctl + CW_ECNT + 64 * alt;
    const bf16* wrt = (const bf16*)(F.ws + WS_SMALL + SM_WRT);
    LAS unsigned char* img = F.lds;
    LAS float* part = (LAS float*)F.lds;
    LAS float* lg = (LAS float*)(F.lds + 4 * 64 * 33 * 4);
    LAS int* lcnt = (LAS int*)(F.lds + RING_BYTES + 1024);
    LAS int* lbase = lcnt + 32;
    LAS int* se = lbase + 32;
    LAS int* sp = se + 256;
    LAS float* sw = (LAS float*)(sp + 256);
    const float* gf = F.in[I_GFFN];
    for (int bt = F.bx; bt < MT / 64; bt += F.G) {
        __syncthreads();
        if (tid < 32) lcnt[tid] = 0;
#pragma unroll 2
        for (int i = 0; i < 8; ++i) {
            const int tl = wave * 8 + i, t = bt * 64 + tl;
            const f32x4* xr = (const f32x4*)(F.out + (size_t)t * DM) + lane; const f32x4* gr = (const f32x4*)gf + lane;
            f32x4 v[4]; float s = 0.f;
#pragma unroll
            for (int j = 0; j < 4; ++j) { v[j] = xr[64 * j]; s += (v[j].x * v[j].x + v[j].y * v[j].y) + (v[j].z * v[j].z + v[j].w * v[j].w); }
            const float rstd = rsqrtf(wave_sum(s) * (1.f / DM) + EPS);
            unsigned long long* o8 = (unsigned long long*)(xn2 + (size_t)t * DM) + lane;
#pragma unroll
            for (int j = 0; j < 4; ++j) { const f32x4 gg = gr[64 * j];
                const unsigned long long w = (unsigned long long)pk2(v[j].x * rstd * gg.x, v[j].y * rstd * gg.y) | ((unsigned long long)pk2(v[j].z * rstd * gg.z, v[j].w * rstd * gg.w) << 32);
                o8[64 * j] = w;
                const int d = 4 * lane + 256 * j, ch = d >> 3;
                *(LAS unsigned long long*)(img + tl * 2048 + 16 * (ch ^ (tl & 15)) + 2 * (d & 7)) = w; }
        }
        __syncthreads();
        {
            const int mb = wave & 1, kq = wave >> 1, trow = 32 * mb + r;
            f32x16 acc;
#pragma unroll
            for (int i = 0; i < 16; ++i) acc[i] = 0.f;
#pragma unroll 4
            for (int s2 = 0; s2 < 16; ++s2) { const int st = 16 * kq + s2;
                const bf16x8 xa = *(const LAS bf16x8*)(img + trow * 2048 + 16 * ((2 * st + hh) ^ (trow & 15)));
                const bf16x8 wh = *(const bf16x8*)(wrt + (size_t)r * 1024 + 16 * st + 8 * hh), wl = *(const bf16x8*)(wrt + 32 * 1024 + (size_t)r * 1024 + 16 * st + 8 * hh);
                acc = MFMA32(xa, wh, acc); acc = MFMA32(xa, wl, acc); }
            __syncthreads();
#pragma unroll
            for (int i = 0; i < 16; ++i) part[(kq * 64 + 32 * mb + crow(i, hh)) * 33 + r] = acc[i];
        }
        __syncthreads();
        for (int i = tid; i < 64 * 32; i += 512) { const int tk = i >> 5, e = i & 31; lg[tk * 33 + e] = ((part[(0 * 64 + tk) * 33 + e] + part[(1 * 64 + tk) * 33 + e]) + (part[(2 * 64 + tk) * 33 + e] + part[(3 * 64 + tk) * 33 + e])) + F.in[I_BR][e]; }
        __syncthreads();
        for (int i = 0; i < 8; ++i) {
            const int tl = wave * 8 + i, e = lane & 31;
            float sc = lg[tl * 33 + e]; int ek[4]; float vk[4];
#pragma unroll
            for (int rd = 0; rd < 4; ++rd) { const float mx = wave_max(sc); const unsigned long long bal = __ballot(sc == mx); const int win = (__ffsll((long long)bal) - 1) & 31;
                ek[rd] = win; vk[rd] = mx; if (e == win) sc = -3.4e38f; }
            const float e1 = __expf(vk[1] - vk[0]), e2 = __expf(vk[2] - vk[0]), e3 = __expf(vk[3] - vk[0]); const float inv = 1.f / (1.f + e1 + e2 + e3);
            if (lane == 0) {
                const float wk[4] = {inv, e1 * inv, e2 * inv, e3 * inv};
#pragma unroll
                for (int rd = 0; rd < 4; ++rd) { se[tl * 4 + rd] = ek[rd]; sw[tl * 4 + rd] = wk[rd]; sp[tl * 4 + rd] = atomicAdd((int*)&lcnt[ek[rd]], 1); }
            }
        }
        __syncthreads();
        if (tid < 32) lbase[tid] = (int)atomicAdd(&gcnt[tid], (unsigned)lcnt[tid]);
        __syncthreads();
        if (tid < 256) { const int t = bt * 64 + (tid >> 2), k = tid & 3; const int e = se[tid];
          tok_e[t * 4 + k] = e; tok_pos[t * 4 + k] = lbase[e] + sp[tid]; tok_w[t * 4 + k] = sw[tid]; }
    }
    __syncthreads();
}
DI int moe_tables(Frame& F, LAS int* pstart, LAS unsigned char* blk_e) {
    unsigned* gcnt = F.ctl + CW_ECNT;
    __syncthreads();
    if (F.tid == 0) { int acc = 0; for (int e = 0; e < NEXP; ++e) { const int cnt = (int)__hip_atomic_load(&gcnt[e], __ATOMIC_RELAXED, __HIP_MEMORY_SCOPE_AGENT); pstart[e] = acc; acc += (cnt + MOEB - 1) / MOEB * MOEB; } pstart[NEXP] = acc; }
    __syncthreads();
    const int nblk = pstart[NEXP] / MOEB;
    for (int rb = F.tid; rb < nblk; rb += 512) { int e = 0; while (e < NEXP - 1 && pstart[e + 1] <= rb * MOEB) ++e; blk_e[rb] = (unsigned char)e; }
    __syncthreads();
    return nblk;
}
DI void p9_scatter(Frame& F) {
    unsigned char* ws = F.ws; const int lane = F.lane;
    LAS int* pstart = (LAS int*)(F.lds + 65536); LAS unsigned char* blk_e = (LAS unsigned char*)(F.lds + 65536 + 256);
    moe_tables(F, pstart, blk_e);
    const bf16* xn2 = (const bf16*)(ws + WS_R1); bf16* aperm = (bf16*)(ws + WS_APERM);
    const int* tok_e = (const int*)(ws + WS_ROUTE + RT_TOKE); const int* tok_pos = (const int*)(ws + WS_ROUTE + RT_TOKPOS); const float* tok_w = (const float*)(ws + WS_ROUTE + RT_TOKW);
    int* tok_dest = (int*)(ws + WS_ROUTE + RT_TOKDEST); float* roww = (float*)(ws + WS_ROUTE + RT_ROWW);
    unsigned* gcnt = F.ctl + CW_ECNT;
    const int gw = F.bx * NWAVES + F.wave, NGW = F.G * NWAVES;
    for (int it = gw; it < NROWS; it += NGW) {
        const int t = it >> 2; const int e = tok_e[it]; const int dest = pstart[e] + tok_pos[it];
        const v4u* src = (const v4u*)(xn2 + (size_t)t * DM); v4u* dst = (v4u*)(aperm + (size_t)dest * DM);
        dst[lane] = src[lane]; dst[64 + lane] = src[64 + lane];
        if (lane == 0) { tok_dest[it] = dest; roww[dest] = tok_w[it]; }
    }
    for (int it = gw; it < NEXP * MOEB; it += NGW) { const int e = it >> 8, i = it & 255; const int cnt = (int)__hip_atomic_load(&gcnt[e], __ATOMIC_RELAXED, __HIP_MEMORY_SCOPE_AGENT); const int padded = (cnt + MOEB - 1) / MOEB * MOEB;
        if (i < padded - cnt) { const int dest = pstart[e] + cnt + i; v4u* dst = (v4u*)(aperm + (size_t)dest * DM); const v4u z = {0u, 0u, 0u, 0u}; dst[lane] = z; dst[64 + lane] = z; if (lane == 0) roww[dest] = 0.f; } }
}
DI void p12_combine(Frame& F) {
    unsigned char* ws = F.ws; const int lane = F.lane;
    const bf16* ybuf = (const bf16*)(ws + WS_APERM); const int* tok_dest = (const int*)(ws + WS_ROUTE + RT_TOKDEST);
    const int gw = F.bx * NWAVES + F.wave, NGW = F.G * NWAVES;
    for (int t = gw; t < MT; t += NGW) {
        f32x4* orow = (f32x4*)(F.out + (size_t)t * DM);
        int d[4];
#pragma unroll
        for (int k = 0; k < 4; ++k) d[k] = tok_dest[t * 4 + k];
#pragma unroll
        for (int j = 0; j < 4; ++j) { f32x4 a = orow[lane + 64 * j];
#pragma unroll
            for (int k = 0; k < 4; ++k) { const unsigned long long w = *((const unsigned long long*)(ybuf + (size_t)d[k] * DM) + lane + 64 * j);
                a.x += __uint_as_float((unsigned)w << 16); a.y += __uint_as_float((unsigned)w & 0xffff0000u); a.z += __uint_as_float((unsigned)(w >> 32) << 16); a.w += __uint_as_float((unsigned)(w >> 32) & 0xffff0000u); }
            orow[lane + 64 * j] = a; }
    }
}

constexpr int N_PHASES = 13;
#ifndef MK_PER_PHASE
#define MK_PER_PHASE 0
#endif
__global__ void __launch_bounds__(NWAVES * 64, 2) fwd_kernel(Args args) {
    extern __shared__ __attribute__((aligned(16))) unsigned char lds_raw[];
    Frame F;
    F.lds = (LAS unsigned char*)lds_raw; F.MISC = (volatile LAS unsigned*)(F.lds + MISC_OFF);
    F.tid = threadIdx.x; F.lane = F.tid & 63; F.wave = __builtin_amdgcn_readfirstlane(F.tid >> 6); F.G = gridDim.x; F.bx = blockIdx.x;
    F.ws = args.ws; F.ctl = (unsigned*)(args.ws + WS_CTL); F.in = args.in; F.out = args.out;
    unsigned char* ws = args.ws;
    for (int u = F.tid; u < (LDS_BYTES - LDSCTL_OFF) / 4; u += NWAVES * 64) ((LAS unsigned*)(F.lds + LDSCTL_OFF))[u] = 0u;
    __syncthreads();
    const int lo = args.ph_lo, hi = args.ph_hi;
    XcdBarrier bar; bar.bar = F.ctl + CW_BAR; bar.x = 0; bar.st = nullptr;
    if (hi - lo > 1) bar = xcd_barrier_post(F.ctl + CW_BAR, F.MISC + 8);
#ifndef PH_MASK
#define PH_MASK 0x1fff
#endif
#define IN(k) (((PH_MASK >> (k)) & 1) && lo <= (k) && (k) < hi)
#define SEAM(k) do { if (IN(k) && IN((k) + 1)) xcd_barrier(bar); } while (0)
    typedef pg8::bf16_t b16;
#ifndef RPT_MASK
#define RPT_MASK 0
#endif
#define RPT(k) _Pragma("unroll") for (int rp_ = 0; rp_ < 1 + ((RPT_MASK >> (k)) & 1); ++rp_)
    if (IN(0)) { RPT(0) p0_prologue(F); } SEAM(0);
    if (IN(1)) RPT(1) {
        { pg8::Gemm g{(const b16*)(ws + WS_R1), (const b16*)(ws + WS_WIN), MT, NPROJ, DM}; pg8::StaticOrder S; S.init(MT, NPROJ, F.G, F.bx);
          pg8::EpiBf16Silu E{(b16*)(ws + WS_PROJ), NPROJ, nullptr, 0};
          pg8::gemm_phase<pg8::EpiBf16Silu, pg8::StaticOrder, true, true>(F.lds, g, S, E); }
        { pg8::Gemm g{(const b16*)(ws + WS_MEMN), (const b16*)(ws + WS_WMKV), MROWS, 1024, DM}; pg8::StaticOrder S; S.init(MROWS, 1024, F.G, (F.bx + 64) % F.G);
          pg8::EpiBf16Silu E{(b16*)(ws + WS_MEMKV), 1024, nullptr, 0};
          pg8::gemm_phase<pg8::EpiBf16Silu, pg8::StaticOrder, true, true>(F.lds, g, S, E); }
    } SEAM(1);
    if (IN(2)) { RPT(2) p2_prep(F); } SEAM(2);
    if (IN(3)) RPT(3) {
#pragma unroll
        for (int kv = 0; kv < 2; ++kv) {
            pg8::Gemm g{(const b16*)(ws + WS_ACMP) + (size_t)kv * 4096 * 2048, (const b16*)(ws + WS_WC1) + (size_t)kv * 256 * 2048, 4096, 256, 2048}; pg8::StaticOrder S; S.init(4096, 256, F.G, (F.bx + F.G - 16 * kv) % F.G);
            pg8::EpiBf16Silu E{(b16*)(ws + WS_HID) + (size_t)kv * 4096 * 256, 256, (const float*)(ws + WS_SMALL + SM_CBIAS) + kv * 256, 1};
            pg8::gemm_phase<pg8::EpiBf16Silu, pg8::StaticOrder, true, true>(F.lds, g, S, E); }
    } SEAM(3);
    if (IN(4)) { RPT(4) p4_kcvc(F); } SEAM(4);
#ifndef RPT5_ML
#define RPT5_ML 0
#endif
#ifndef RPT5_NSA
#define RPT5_NSA 0
#endif
#ifndef RPT5_MEM
#define RPT5_MEM 0
#endif
    if (IN(5)) { p5_queue<true, true, true>(F, 0);
        if (RPT5_ML || RPT5_NSA || RPT5_MEM) { xcd_barrier(bar); p5_queue<RPT5_ML != 0, RPT5_NSA != 0, RPT5_MEM != 0>(F, 256); } } SEAM(5);
    if (IN(6)) RPT(6) {
        pg8::StaticOrder S; S.init(MT, DM, F.G, F.bx);
        { pg8::Gemm g{(const b16*)(ws + WS_H0), (const b16*)(ws + WS_WBR), MT, DM, 512}; pg8::EpiGate<0> E{(const b16*)(ws + WS_PROJ), F.out, (b16*)(ws + WS_R1)};
          pg8::gemm_phase<pg8::EpiGate<0>, pg8::StaticOrder, true, true>(F.lds, g, S, E); }
        { pg8::Gemm g{(const b16*)(ws + WS_H1), (const b16*)(ws + WS_WBR) + 1024 * 512, MT, DM, 512}; pg8::EpiGate<1> E{(const b16*)(ws + WS_PROJ), F.out, (b16*)(ws + WS_R1)};
          pg8::gemm_phase<pg8::EpiGate<1>, pg8::StaticOrder, true, true>(F.lds, g, S, E); }
        { pg8::Gemm g{(const b16*)(ws + WS_H2), (const b16*)(ws + WS_WBR) + 2 * 1024 * 512, MT, DM, 512}; pg8::EpiGate<2> E{(const b16*)(ws + WS_PROJ), F.out, (b16*)(ws + WS_R1)};
          pg8::gemm_phase<pg8::EpiGate<2>, pg8::StaticOrder, true, true>(F.lds, g, S, E); }
    } SEAM(6);
    if (IN(7)) RPT(7) {
        pg8::Gemm g{(const b16*)(ws + WS_R1), (const b16*)(ws + WS_WOUT), MT, DM, DM}; pg8::StaticOrder S; S.init(MT, DM, F.G, F.bx);
        pg8::EpiRes E{F.in[I_X], F.out};
        pg8::gemm_phase<pg8::EpiRes, pg8::StaticOrder, true, true>(F.lds, g, S, E);
    } SEAM(7);
    if (IN(8)) { p8_router(F, 0); if ((RPT_MASK >> 8) & 1) p8_router(F, 1); } SEAM(8);
    if (IN(9)) { RPT(9) p9_scatter(F); } SEAM(9);
    if (IN(10)) RPT(10) {
        LAS int* pstart = (LAS int*)(F.lds + RING_BYTES + 1024); LAS unsigned char* blk_e = (LAS unsigned char*)(F.lds + RING_BYTES + 1024 + 256);
        const int nblk = moe_tables(F, pstart, blk_e);
        pg8::Gemm g{(const b16*)(ws + WS_APERM), (const b16*)(ws + WS_WGU), CAP, NEXP * 2048, DM};
        pg8::MoeOrder<8> S{nblk * 8, F.G, F.bx, (const PG8_LAS unsigned char*)blk_e};
        pg8::EpiSwiglu E{(b16*)(ws + WS_ACT), F.in[I_BGU]};
        pg8::gemm_phase<pg8::EpiSwiglu, pg8::MoeOrder<8>, true, true>(F.lds, g, S, E);
    } SEAM(10);
    if (IN(11)) RPT(11) {
        LAS int* pstart = (LAS int*)(F.lds + RING_BYTES + 1024); LAS unsigned char* blk_e = (LAS unsigned char*)(F.lds + RING_BYTES + 1024 + 256);
        const int nblk = moe_tables(F, pstart, blk_e);
        pg8::Gemm g{(const b16*)(ws + WS_ACT), (const b16*)(ws + WS_WDN), CAP, NEXP * DM, DFF};
        pg8::MoeOrder<4> S{nblk * 4, F.G, F.bx, (const PG8_LAS unsigned char*)blk_e};
        pg8::EpiDown E{(b16*)(ws + WS_APERM), F.in[I_BDN], (const float*)(ws + WS_ROUTE + RT_ROWW)};
        pg8::gemm_phase<pg8::EpiDown, pg8::MoeOrder<4>, true, true>(F.lds, g, S, E);
    } SEAM(11);
    if (IN(12)) { p12_combine(F); }
#undef IN
#undef SEAM
}

extern "C" void kernel_launch(void* const* d_in, const int* in_sizes, int n_in, void* d_out, int out_size, void* d_ws, size_t ws_size, hipStream_t stream) {
    static int grid = 0;
    if (grid == 0) {
        if (n_in != N_IN || out_size != MT * DM || ws_size < WS_END) { fprintf(stderr, "kernel_launch: unexpected shapes (n_in %d, out %d, ws %zu need %zu)\n", n_in, out_size, ws_size, (size_t)WS_END); grid = -1; return; }
        int dev = 0, cus = 0, per_cu = 0;
        if (hipGetDevice(&dev) != hipSuccess || hipDeviceGetAttribute(&cus, hipDeviceAttributeMultiprocessorCount, dev) != hipSuccess) { grid = -1; return; }
        if (hipFuncSetAttribute((const void*)fwd_kernel, hipFuncAttributeMaxDynamicSharedMemorySize, LDS_BYTES) != hipSuccess) { fprintf(stderr, "kernel_launch: hipFuncSetAttribute failed\n"); grid = -1; return; }
        if (hipOccupancyMaxActiveBlocksPerMultiprocessor(&per_cu, (const void*)fwd_kernel, NWAVES * 64, LDS_BYTES) != hipSuccess || per_cu < 1) { fprintf(stderr, "kernel_launch: occupancy query says %d\n", per_cu); }
        (void)hipGetLastError();
        grid = cus;
    }
    if (grid < 0) return;
    if (hipMemsetAsync((char*)d_ws + WS_CTL, 0, CTL_ZERO_BYTES, stream) != hipSuccess) return;
    Args a{};
    for (int i = 0; i < N_IN; ++i) a.in[i] = (const float*)d_in[i];
    a.out = (float*)d_out; a.ws = (unsigned char*)d_ws;
#if MK_PER_PHASE
    for (int p = 0; p < N_PHASES; ++p) { a.ph_lo = p; a.ph_hi = p + 1; a.li = 0; hipLaunchKernelGGL(fwd_kernel, dim3(grid), dim3(NWAVES * 64), LDS_BYTES, stream, a); }
#else
    a.ph_lo = 0; a.ph_hi = N_PHASES; a.li = 0;
    hipLaunchKernelGGL(fwd_kernel, dim3(grid), dim3(NWAVES * 64), LDS_BYTES, stream, a);
#endif
}
```

```cpp
#include <hip/hip_runtime.h>
#include <cstdio>
#include <cstdint>
namespace pg8 {
#define PG8_LAS __attribute__((address_space(3)))
typedef unsigned short bf16_t;
typedef short bf16x8 __attribute__((ext_vector_type(8)));
typedef float f32x4 __attribute__((ext_vector_type(4)));
typedef unsigned u32x4 __attribute__((ext_vector_type(4)));
constexpr int BM = 256, BK = 64, HALF = 128, HTB = HALF * BK * 2  , STAGE_BYTES = 8 * HTB, NXCD = 8, WGM = 8;

__host__ __device__ __forceinline__ int lds_byte(int r, int c) { const int st = (r >> 4) * 2 + (c >> 5), rr = r & 15, cc = c & 31, ob = rr * 64 + cc * 2; return st * 1024 + (ob ^ (((ob >> 9) & 1) << 5)); }
__host__ __device__ __forceinline__ void stage_rc(int b, int& R, int& C) { const int st = b / 1024, sb = b % 1024, swz = sb ^ (((sb >> 9) & 1) << 5); R = (st >> 1) * 16 + swz / 64; C = (st & 1) * 32 + (swz % 64) / 2; }
__host__ __device__ __forceinline__ int perm32(int rho) { const int n = rho >> 4, i = rho & 15; return 8 * (i >> 2) + 4 * n + (i & 3); }

struct Unit { int pm, pn; };
struct Gemm { const bf16_t* A; const bf16_t* Bt; int M, N, K; };

struct StaticOrder {
    int nM, nN, nwg, G, c;
    __host__ __device__ void init(int M, int N, int G_, int c_) { nM = M / BM; nN = N / BM; nwg = nM * nN; G = G_; c = c_; }
    __host__ __device__ bool next(int i, Unit& u) const {
        const long L = (long)i * G + c; if (L >= nwg) return false;
        int wgid = (int)L; { const int q = nwg / NXCD, r = nwg % NXCD, xcd = wgid % NXCD, off = wgid / NXCD; wgid = (xcd < r ? xcd * (q + 1) : r * (q + 1) + (xcd - r) * q) + off; }
        const int nig = WGM * nN, gid = wgid / nig, fm = gid * WGM, gsz = (nM - fm) < WGM ? (nM - fm) : WGM;
        u.pm = fm + ((wgid % nig) % gsz); u.pn = (wgid % nig) / gsz; return true;
    }
    __device__ __forceinline__ void a_ready(const Unit&) const {}
    __device__ __forceinline__ void done(const Unit&) const {}
};

__device__ __forceinline__ unsigned cvt_pk_bf16(float lo, float hi) { unsigned r; asm volatile("v_cvt_pk_bf16_f32 %0, %1, %2" : "=v"(r) : "v"(lo), "v"(hi)); return r; }
typedef float f32x2 __attribute__((ext_vector_type(2)));
__device__ __forceinline__ f32x2 gelu_pk(f32x2 v) {
    const f32x2 av = __builtin_elementwise_abs(v), d = av * 0.2316418882f + 1.0f;
    f32x2 t; t.x = __builtin_amdgcn_rcpf(d.x); t.y = __builtin_amdgcn_rcpf(d.y);
    f32x2 q = t * 0.5307027145f + (-0.7265760135f); q = q * t + 0.7107068705f; q = q * t + (-0.142248368f); q = q * t + 0.127414796f; q = q * t;
    const f32x2 s = (v * v) * (-0.72134752044f);
    f32x2 e; e.x = __builtin_amdgcn_exp2f(s.x); e.y = __builtin_amdgcn_exp2f(s.y);
    const f32x2 m = v * (q * e), r = v - m;
    f32x2 o; o.x = v.x < 0.f ? m.x : r.x; o.y = v.y < 0.f ? m.y : r.y; return o;
}

template <int ACT  > struct EpiBf16 {
    static constexpr bool PERM = true, AFTER_DRAIN = false; static_assert(ACT == 0 || ACT == 1, "EpiBf16: ACT is 0 (none) or 1 (gelu_pk)");
    bf16_t* O; int ldc; const float* bias; int split_cols; size_t split_stride; float scale0;
    __device__ __forceinline__ void operator()(const f32x4 (&acc)[2][2][4][2], const Unit& u, int wr, int wc, int fr, int fq) const {
        const int row0 = u.pm * BM + wr * 64 + fr; int colt = u.pn * BM; bf16_t* base = O;
        float sc = 1.f; if (split_cols) { const int t = colt / split_cols; base += (size_t)t * split_stride; colt -= t * split_cols; if (t == 0) sc = scale0; }
        const int col0 = colt + wc * 32 + 8 * fq, bcol0 = u.pn * BM + wc * 32 + 8 * fq;
        f32x4 bv[2][2];
#pragma unroll
        for (int bj = 0; bj < 2; ++bj)
#pragma unroll
            for (int n = 0; n < 2; ++n) bv[bj][n] = bias ? *(const f32x4*)(bias + bcol0 + bj * HALF + 4 * n) : (f32x4){0.f, 0.f, 0.f, 0.f};
#pragma unroll
        for (int ai = 0; ai < 2; ++ai)
#pragma unroll
            for (int m = 0; m < 4; ++m) { bf16_t* rowp = base + (size_t)(row0 + ai * HALF + m * 16) * ldc + col0;
#pragma unroll
                for (int bj = 0; bj < 2; ++bj) { f32x4 v0 = acc[ai][bj][m][0] + bv[bj][0], v1 = acc[ai][bj][m][1] + bv[bj][1];
                    if (ACT == 1) { f32x2 a = gelu_pk((f32x2){v0[0], v0[1]}), b = gelu_pk((f32x2){v0[2], v0[3]}), c = gelu_pk((f32x2){v1[0], v1[1]}), d = gelu_pk((f32x2){v1[2], v1[3]});
                        v0 = (f32x4){a.x, a.y, b.x, b.y}; v1 = (f32x4){c.x, c.y, d.x, d.y}; }
                    v0 = v0 * sc; v1 = v1 * sc; u32x4 w; w.x = cvt_pk_bf16(v0[0], v0[1]); w.y = cvt_pk_bf16(v0[2], v0[3]); w.z = cvt_pk_bf16(v1[0], v1[1]); w.w = cvt_pk_bf16(v1[2], v1[3]);
                    *(u32x4*)(rowp + bj * HALF) = w; } }
    }
};

struct PanelStats {
    unsigned* xbuf;
    unsigned* cnt;
    unsigned* tmo;
    int ntn; float eps;
    unsigned code;
    __device__ __forceinline__ bool run(const f32x4 (&v)[2][2][4][2], const Unit& u, int wr, int wc, int fr, int fq, PG8_LAS unsigned char* lds, int wid, int lane) const {
        typedef float f32x2v __attribute__((ext_vector_type(2)));
        PG8_LAS f32x2v* P = (PG8_LAS f32x2v*)lds;
        PG8_LAS f32x2v* S = (PG8_LAS f32x2v*)(lds + 8192);
        PG8_LAS unsigned* flag = (PG8_LAS unsigned*)(lds + 8192 + 2048);
#pragma unroll
        for (int ai = 0; ai < 2; ++ai)
#pragma unroll
            for (int m = 0; m < 4; ++m) {
                float s = 0.f;
#pragma unroll
                for (int bj = 0; bj < 2; ++bj)
#pragma unroll
                    for (int n = 0; n < 2; ++n) { const f32x4 x = v[ai][bj][m][n]; s += (x[0] + x[1]) + (x[2] + x[3]); }
                s += __shfl_xor(s, 16); s += __shfl_xor(s, 32);
                const float mw = s * (1.0f / 64.0f); float q = 0.f;
#pragma unroll
                for (int bj = 0; bj < 2; ++bj)
#pragma unroll
                    for (int n = 0; n < 2; ++n) { const f32x4 d = v[ai][bj][m][n] - mw; q += (d[0] * d[0] + d[1] * d[1]) + (d[2] * d[2] + d[3] * d[3]); }
                q += __shfl_xor(q, 16); q += __shfl_xor(q, 32);
                if (fq == 0) P[(ai * HALF + wr * 64 + m * 16 + fr) * 4 + wc] = (f32x2v){mw, q};
            }
        asm volatile("s_waitcnt lgkmcnt(0)" ::: "memory"); __builtin_amdgcn_s_barrier(); asm volatile("" ::: "memory");
#if defined(BROKEN_EXCHANGE_NO_WAIT)
#warning BROKEN CONTROL BUILD: the row-statistics exchange does not wait; results are wrong by design
        if (blockIdx.x >= 64) { const long long t0_ = clock64(); while (clock64() - t0_ < 60000) __builtin_amdgcn_s_sleep(8); }
#endif
        const int row = wid * 32 + (lane & 31);
        if (lane < 32) {
            const f32x2v a = P[row * 4 + 0], b = P[row * 4 + 1], c = P[row * 4 + 2], d = P[row * 4 + 3];
            const float mt = (a.x + b.x + c.x + d.x) * 0.25f;
            const float da = a.x - mt, db = b.x - mt, dc = c.x - mt, dd = d.x - mt;
            const float m2 = (a.y + b.y) + (c.y + d.y) + 64.0f * ((da * da + db * db) + (dc * dc + dd * dd));
            unsigned long long* slot = (unsigned long long*)xbuf + ((size_t)(u.pm * BM + row) * 4 + u.pn);
            __hip_atomic_store(slot, ((unsigned long long)__float_as_uint(m2) << 32) | __float_as_uint(mt), __ATOMIC_RELAXED, __HIP_MEMORY_SCOPE_AGENT);
        }
        asm volatile("s_waitcnt vmcnt(0)" ::: "memory");
        if (lane == 0) __hip_atomic_fetch_add(cnt + 64 * u.pm, 1u, __ATOMIC_RELAXED, __HIP_MEMORY_SCOPE_AGENT);
        if (wid == 0) {
            bool dead = false; const unsigned long long t0 = __builtin_amdgcn_s_memrealtime(); const unsigned want = 8u * (unsigned)ntn;
            for (;;) {
#if defined(BROKEN_EXCHANGE_NO_WAIT)
                break;
#endif
                if ((unsigned)__builtin_amdgcn_readfirstlane(__hip_atomic_load(cnt + 64 * u.pm, __ATOMIC_RELAXED, __HIP_MEMORY_SCOPE_AGENT)) >= want) break;
                if (__builtin_amdgcn_s_memrealtime() - t0 > 2000000ull) {
                    if (lane == 0) { unsigned expect = 0u; __hip_atomic_compare_exchange_strong(tmo + 1, &expect, code | (unsigned)(u.pm & 0xff), __ATOMIC_RELAXED, __ATOMIC_RELAXED, __HIP_MEMORY_SCOPE_AGENT);
                                     __hip_atomic_store(tmo, 1u, __ATOMIC_RELAXED, __HIP_MEMORY_SCOPE_AGENT); }
                    dead = true; break; }
                __builtin_amdgcn_s_sleep(2);
            }
            __builtin_amdgcn_fence(__ATOMIC_ACQUIRE, "agent");
            if (lane == 0) flag[0] = dead ? 1u : 0u;
        }
        asm volatile("s_waitcnt vmcnt(0) lgkmcnt(0)" ::: "memory"); __builtin_amdgcn_s_barrier(); asm volatile("" ::: "memory");
        const bool bad = flag[0] != 0u;
        if (lane < 32) {
            const unsigned long long* slot = (const unsigned long long*)xbuf + (size_t)(u.pm * BM + row) * 4; float mt[4], m2[4]; float ms = 0.f;
#pragma unroll
            for (int t = 0; t < 4; ++t) { if (t < ntn) { const unsigned long long w = __hip_atomic_load(slot + t, __ATOMIC_RELAXED, __HIP_MEMORY_SCOPE_AGENT); mt[t] = __uint_as_float((unsigned)w); m2[t] = __uint_as_float((unsigned)(w >> 32)); } else { mt[t] = 0.f; m2[t] = 0.f; } ms += mt[t]; }
            const float mean = ms / (float)ntn; float q = 0.f;
#pragma unroll
            for (int t = 0; t < 4; ++t) if (t < ntn) { const float dm = mt[t] - mean; q += m2[t] + 256.0f * dm * dm; }
            S[row] = (f32x2v){mean, 1.0f / sqrtf(q / (256.0f * (float)ntn) + eps)};
        }
        asm volatile("s_waitcnt lgkmcnt(0)" ::: "memory"); __builtin_amdgcn_s_barrier(); asm volatile("" ::: "memory");
        return bad;
    }
};
struct EpiLnRes {
    static constexpr bool PERM = false, AFTER_DRAIN = true;
    const float* base; float* out; int ldc; const float* bias; PanelStats st; unsigned poison;
    __device__ __forceinline__ void fused(f32x4 (&acc)[2][2][4][2], const Unit& u, int wr, int wc, int fr, int fq, PG8_LAS unsigned char* lds, int wid, int lane) const {
        typedef float f32x2v __attribute__((ext_vector_type(2)));
        const PG8_LAS f32x2v* S = (const PG8_LAS f32x2v*)(lds + 8192);
        const int col0 = u.pn * BM + wc * 32 + 4 * fq;
#pragma unroll
        for (int bj = 0; bj < 2; ++bj)
#pragma unroll
            for (int n = 0; n < 2; ++n) { const f32x4 bv = bias ? *(const f32x4*)(bias + col0 + bj * HALF + n * 16) : (f32x4){0.f, 0.f, 0.f, 0.f};
#pragma unroll
                for (int ai = 0; ai < 2; ++ai)
#pragma unroll
                    for (int m = 0; m < 4; ++m) acc[ai][bj][m][n] += bv; }
        f32x4 pre[4][2][2];
#pragma unroll
        for (int m = 0; m < 4; ++m) { const size_t off = (size_t)(u.pm * BM + wr * 64 + m * 16 + fr) * ldc + col0;
#pragma unroll
            for (int bj = 0; bj < 2; ++bj)
#pragma unroll
                for (int n = 0; n < 2; ++n) pre[m][bj][n] = *(const f32x4*)(base + off + bj * HALF + n * 16); }
        const bool bad = st.run(acc, u, wr, wc, fr, fq, lds, wid, lane) || poison != 0u;
        const float qnan = __builtin_nanf("");
#pragma unroll
        for (int ai = 0; ai < 2; ++ai)
#pragma unroll
            for (int m = 0; m < 4; ++m) { const int r = ai * HALF + wr * 64 + m * 16 + fr; const f32x2v sr = S[r]; const size_t off = (size_t)(u.pm * BM + r) * ldc + col0;
#pragma unroll
                for (int bj = 0; bj < 2; ++bj)
#pragma unroll
                    for (int n = 0; n < 2; ++n) { const f32x4 bs = ai == 0 ? pre[m][bj][n] : *(const f32x4*)(base + off + bj * HALF + n * 16); f32x4 o = bs + (acc[ai][bj][m][n] - sr.x) * sr.y;
                        if (bad) o = (f32x4){qnan, qnan, qnan, qnan}; *(f32x4*)(out + off + bj * HALF + n * 16) = o; }
                if (m & 1) asm volatile("" ::: "memory"); }
    }
};
struct EpiLnResLn {
    static constexpr bool PERM = false, AFTER_DRAIN = true;
    const float* base; float* out; bf16_t* xn; int ldc; const float* bias; PanelStats st1, st2; unsigned poison;
    __device__ __forceinline__ void fused(f32x4 (&acc)[2][2][4][2], const Unit& u, int wr, int wc, int fr, int fq, PG8_LAS unsigned char* lds, int wid, int lane) const {
        typedef float f32x2v __attribute__((ext_vector_type(2))); typedef unsigned u32x2v __attribute__((ext_vector_type(2)));
        const PG8_LAS f32x2v* S = (const PG8_LAS f32x2v*)(lds + 8192);
        const int col0 = u.pn * BM + wc * 32 + 4 * fq;
#pragma unroll
        for (int bj = 0; bj < 2; ++bj)
#pragma unroll
            for (int n = 0; n < 2; ++n) { const f32x4 bv = bias ? *(const f32x4*)(bias + col0 + bj * HALF + n * 16) : (f32x4){0.f, 0.f, 0.f, 0.f};
#pragma unroll
                for (int ai = 0; ai < 2; ++ai)
#pragma unroll
                    for (int m = 0; m < 4; ++m) acc[ai][bj][m][n] += bv; }
        bool bad = st1.run(acc, u, wr, wc, fr, fq, lds, wid, lane) || poison != 0u;
        const float qnan = __builtin_nanf("");
#pragma unroll
        for (int ai = 0; ai < 2; ++ai)
#pragma unroll
            for (int m = 0; m < 4; ++m) { const int r = ai * HALF + wr * 64 + m * 16 + fr; const f32x2v sr = S[r]; const size_t off = (size_t)(u.pm * BM + r) * ldc + col0;
#pragma unroll
                for (int bj = 0; bj < 2; ++bj)
#pragma unroll
                    for (int n = 0; n < 2; ++n) { const f32x4 bs = *(const f32x4*)(base + off + bj * HALF + n * 16); acc[ai][bj][m][n] = bs + (acc[ai][bj][m][n] - sr.x) * sr.y; }
                asm volatile("" : "+v"(acc[ai][0][m][0]), "+v"(acc[ai][0][m][1]), "+v"(acc[ai][1][m][0]), "+v"(acc[ai][1][m][1]));
                if (m & 1) asm volatile("" ::: "memory"); }
        const bool bad1 = bad;
        bad = st2.run(acc, u, wr, wc, fr, fq, lds, wid, lane) || bad;
#pragma unroll
        for (int ai = 0; ai < 2; ++ai)
#pragma unroll
            for (int m = 0; m < 4; ++m) { const int r = ai * HALF + wr * 64 + m * 16 + fr; const f32x2v sr = S[r]; const size_t off = (size_t)(u.pm * BM + r) * ldc + col0;
#pragma unroll
                for (int bj = 0; bj < 2; ++bj)
#pragma unroll
                    for (int n = 0; n < 2; ++n) { const f32x4 x1 = acc[ai][bj][m][n]; *(f32x4*)(out + off + bj * HALF + n * 16) = bad1 ? (f32x4){qnan, qnan, qnan, qnan} : x1;
                        const f32x4 o = (x1 - sr.x) * sr.y; u32x2v w; w.x = cvt_pk_bf16(o[0], o[1]); w.y = cvt_pk_bf16(o[2], o[3]);
                        if (bad) { w.x = 0x7fc07fc0u; w.y = 0x7fc07fc0u; } *(u32x2v*)(xn + off + bj * HALF + n * 16) = w; }
                asm volatile("" ::: "memory"); }
    }
};

template <class Epi, class Sched, bool ALIGN_EPI = false, bool SP2 = false>
__device__ __forceinline__ void gemm_phase(PG8_LAS unsigned char* lds, const Gemm g, const Sched& S, const Epi& E) {
    const int tid = threadIdx.x, wid = __builtin_amdgcn_readfirstlane(tid >> 6), lane = tid & 63, wr = wid >> 2, wc = wid & 3, fr = lane & 15, fq = lane >> 4;
    const int K = g.K, nt = K / BK;
    unsigned voffA[2], voffB[2];
#pragma unroll
    for (int i = 0; i < 2; ++i) { int R, C; stage_rc(tid * 16 + i * 8192, R, C); const int Rb = Epi::PERM ? ((R & ~31) + perm32(R & 31)) : R;
        voffA[i] = (unsigned)(R * K + C) * 2u; voffB[i] = (unsigned)(Rb * K + C) * 2u; }
    const size_t kstep = (size_t)(BK * 2);
    const size_t hstep = (size_t)HALF * K * 2;
    const size_t tstep = 2 * hstep;
    const unsigned ldsw = (unsigned)wid * 1024u;
    const int aoff = lds_byte(wr * 64 + fr, fq * 8), boff = lds_byte(wc * 32 + fr, fq * 8);
#define PG8_SA(b, h) (((b) * 2 + (h)) * HTB)
#define PG8_SB(b, h) ((4 + (b) * 2 + (h)) * HTB)
#define PG8_STAGE(bufoff, gbase, voff) do { _Pragma("unroll") for (int _i = 0; _i < 2; ++_i) \
        __builtin_amdgcn_global_load_lds((const unsigned*)((const char*)(gbase) + (voff)[_i]), (PG8_LAS unsigned*)(lds + (bufoff) + ldsw + _i * 8192), 16, 0, 0); } while (0)
#define PG8_LDA(dst, b, h) do { _Pragma("unroll") for (int m = 0; m < 4; ++m) _Pragma("unroll") for (int k = 0; k < 2; ++k) dst[m][k] = *(const PG8_LAS bf16x8*)(lds + PG8_SA(b, h) + aoff + m * 2048 + k * 1024); } while (0)
#define PG8_LDB(dst, b, h) do { _Pragma("unroll") for (int n = 0; n < 2; ++n) _Pragma("unroll") for (int k = 0; k < 2; ++k) dst[n][k] = *(const PG8_LAS bf16x8*)(lds + PG8_SB(b, h) + boff + n * 2048 + k * 1024); } while (0)
#define PG8_MMA(ai, bj, At, Bt) do { __builtin_amdgcn_s_setprio(1); _Pragma("unroll") for (int m = 0; m < 4; ++m) _Pragma("unroll") for (int n = 0; n < 2; ++n) _Pragma("unroll") for (int k = 0; k < 2; ++k) \
        acc[ai][bj][m][n] = __builtin_amdgcn_mfma_f32_16x16x32_bf16(Bt[n][k], At[m][k], acc[ai][bj][m][n], 0, 0, 0); __builtin_amdgcn_s_setprio(0); } while (0)
#define PG8_WAIT_V(n) asm volatile("s_waitcnt vmcnt(" #n ")" ::: "memory")
#define PG8_WAIT_L(n) asm volatile("s_waitcnt lgkmcnt(" #n ")" ::: "memory")
#define PG8_BAR __builtin_amdgcn_s_barrier()
#define PG8_SCHED __builtin_amdgcn_sched_barrier(0)
    Unit cur, nxt; int ui = 0;
    if (!S.next(0, cur)) return;
    f32x4 acc[2][2][4][2];
#pragma unroll
    for (int a = 0; a < 2; ++a)
#pragma unroll
        for (int b = 0; b < 2; ++b)
#pragma unroll
            for (int m = 0; m < 4; ++m)
#pragma unroll
                for (int n = 0; n < 2; ++n) acc[a][b][m][n] = (f32x4){0.f, 0.f, 0.f, 0.f};
    bf16x8 At[4][2], B0[2][2], B1[2][2];
    const char* cA = (const char*)g.A + (size_t)cur.pm * tstep; const char* cB = (const char*)g.Bt + (size_t)cur.pn * tstep;
    S.a_ready(cur);
    if constexpr (SP2) {
        PG8_STAGE(PG8_SB(0, 0), cB, voffB); PG8_STAGE(PG8_SB(0, 1), cB + hstep, voffB); PG8_STAGE(PG8_SA(0, 0), cA, voffA); PG8_STAGE(PG8_SA(0, 1), cA + hstep, voffA);
        if (wr == 1) PG8_BAR;
        PG8_WAIT_V(2); PG8_BAR;
        PG8_STAGE(PG8_SB(1, 0), cB + kstep, voffB); PG8_STAGE(PG8_SA(1, 0), cA + kstep, voffA); PG8_STAGE(PG8_SB(1, 1), cB + hstep + kstep, voffB);
        PG8_WAIT_V(6); PG8_BAR;
    } else {
        PG8_STAGE(PG8_SB(0, 0), cB, voffB); PG8_STAGE(PG8_SA(0, 0), cA, voffA); PG8_STAGE(PG8_SB(0, 1), cB + hstep, voffB); PG8_STAGE(PG8_SA(0, 1), cA + hstep, voffA);
        if (wr == 1) PG8_BAR;
        PG8_WAIT_V(4); PG8_BAR;
        PG8_STAGE(PG8_SB(1, 0), cB + kstep, voffB); PG8_STAGE(PG8_SA(1, 0), cA + kstep, voffA); PG8_STAGE(PG8_SB(1, 1), cB + hstep + kstep, voffB);
        PG8_WAIT_V(6); PG8_BAR;
    }
    for (;;) {
        const bool has_next = S.next(ui + 1, nxt);
        const char* nA = has_next ? (const char*)g.A + (size_t)nxt.pm * tstep : cA; const char* nB = has_next ? (const char*)g.Bt + (size_t)nxt.pn * tstep : cB;
        for (int t = 0; t < nt; t += 2) {
            const bool last = (t == nt - 2);
            const char* a1 = cA + (size_t)(t + 1) * kstep;
            const char* a2 = last ? nA : cA + (size_t)(t + 2) * kstep; const char* b2 = last ? nB : cB + (size_t)(t + 2) * kstep;
            const char* a3 = a2 + kstep; const char* b3 = b2 + kstep;
            if (last && has_next) S.a_ready(nxt);
            if constexpr (SP2) {
            PG8_LDB(B0, 0, 0); PG8_LDB(B1, 0, 1); PG8_SCHED; PG8_LDA(At, 0, 0); PG8_STAGE(PG8_SA(1, 1), a1 + hstep, voffA);
            PG8_WAIT_V(8); PG8_WAIT_L(0); PG8_BAR; PG8_MMA(0, 0, At, B0); PG8_MMA(0, 1, At, B1); PG8_BAR; PG8_SCHED;
            PG8_LDA(At, 0, 1); PG8_STAGE(PG8_SB(0, 0), b2, voffB); PG8_STAGE(PG8_SB(0, 1), b2 + hstep, voffB); PG8_STAGE(PG8_SA(0, 0), a2, voffA);
            PG8_WAIT_V(8); PG8_WAIT_L(0); PG8_BAR; PG8_MMA(1, 0, At, B0); PG8_MMA(1, 1, At, B1); PG8_BAR; PG8_SCHED;
            PG8_LDB(B0, 1, 0); PG8_LDB(B1, 1, 1); PG8_SCHED; PG8_LDA(At, 1, 0); PG8_STAGE(PG8_SA(0, 1), a2 + hstep, voffA);
            PG8_WAIT_V(8); PG8_WAIT_L(0); PG8_BAR; PG8_MMA(0, 0, At, B0); PG8_MMA(0, 1, At, B1); PG8_BAR; PG8_SCHED;
            PG8_LDA(At, 1, 1); PG8_STAGE(PG8_SB(1, 0), b3, voffB); PG8_STAGE(PG8_SB(1, 1), b3 + hstep, voffB); PG8_STAGE(PG8_SA(1, 0), a3, voffA);
            PG8_WAIT_V(8); PG8_WAIT_L(0); PG8_BAR; PG8_MMA(1, 0, At, B0); PG8_MMA(1, 1, At, B1); PG8_BAR; PG8_SCHED;
            } else {
            PG8_LDB(B0, 0, 0); PG8_SCHED; PG8_LDA(At, 0, 0); PG8_STAGE(PG8_SA(1, 1), a1 + hstep, voffA);
            PG8_WAIT_L(8); PG8_BAR; PG8_WAIT_L(0); PG8_MMA(0, 0, At, B0); PG8_BAR; PG8_SCHED;
            PG8_LDB(B1, 0, 1); PG8_STAGE(PG8_SB(0, 0), b2, voffB);
            PG8_BAR; PG8_WAIT_L(0); PG8_MMA(0, 1, At, B1); PG8_BAR;
            PG8_LDA(At, 0, 1); PG8_STAGE(PG8_SA(0, 0), a2, voffA);
            PG8_BAR; PG8_WAIT_L(0); PG8_MMA(1, 0, At, B0); PG8_BAR; PG8_SCHED;
            PG8_STAGE(PG8_SB(0, 1), b2 + hstep, voffB);
            PG8_WAIT_V(6); PG8_BAR; PG8_MMA(1, 1, At, B1); PG8_BAR;
            PG8_LDB(B0, 1, 0); PG8_SCHED; PG8_LDA(At, 1, 0); PG8_STAGE(PG8_SA(0, 1), a2 + hstep, voffA);
            PG8_WAIT_L(8); PG8_BAR; PG8_WAIT_L(0); PG8_MMA(0, 0, At, B0); PG8_BAR; PG8_SCHED;
            PG8_LDB(B1, 1, 1); PG8_STAGE(PG8_SB(1, 0), b3, voffB);
            PG8_BAR; PG8_WAIT_L(0); PG8_MMA(0, 1, At, B1); PG8_BAR;
            PG8_LDA(At, 1, 1); PG8_STAGE(PG8_SA(1, 0), a3, voffA);
            PG8_BAR; PG8_WAIT_L(0); PG8_MMA(1, 0, At, B0); PG8_BAR; PG8_SCHED;
            PG8_STAGE(PG8_SB(1, 1), b3 + hstep, voffB);
            PG8_WAIT_V(6); PG8_BAR; PG8_MMA(1, 1, At, B1); PG8_BAR;
            }
        }
        if constexpr (ALIGN_EPI) { if (wr == 0) PG8_BAR; }
        if constexpr (!Epi::AFTER_DRAIN) { E(acc, cur, wr, wc, fr, fq); S.done(cur); }
        if (!has_next) break;
#pragma unroll
        for (int a = 0; a < 2; ++a)
#pragma unroll
            for (int b = 0; b < 2; ++b)
#pragma unroll
                for (int m = 0; m < 4; ++m)
#pragma unroll
                    for (int n = 0; n < 2; ++n) acc[a][b][m][n] = (f32x4){0.f, 0.f, 0.f, 0.f};
        cur = nxt; cA = nA; cB = nB; ++ui;
        if constexpr (ALIGN_EPI) { if (wr == 1) PG8_BAR; }
    }
    PG8_WAIT_V(0);
    if constexpr (!ALIGN_EPI) { if (wr == 0) PG8_BAR; }
    PG8_BAR;
    if constexpr (Epi::AFTER_DRAIN) { E.fused(acc, cur, wr, wc, fr, fq, lds, wid, lane); S.done(cur); }
#undef PG8_SA
#undef PG8_SB
#undef PG8_STAGE
#undef PG8_LDA
#undef PG8_LDB
#undef PG8_MMA
#undef PG8_WAIT_V
#undef PG8_WAIT_L
#undef PG8_BAR
#undef PG8_SCHED
}
}
namespace pg8 {
struct Gemm8 { const unsigned char* A; const unsigned char* Bt; int M, N, K; int scale_a, scale_b; };
template <class Epi, class Sched, bool ALIGN_EPI = false, bool SP2 = false>
__device__ __forceinline__ void gemm_phase_f8(PG8_LAS unsigned char* lds, const Gemm8 g, const Sched& S, const Epi& E) {
    const int tid = threadIdx.x, wid = __builtin_amdgcn_readfirstlane(tid >> 6), lane = tid & 63, wr = wid >> 2, wc = wid & 3, fr = lane & 15, fq = lane >> 4;
    const int K = g.K, nt = K / 128;
    unsigned voffA[2], voffB[2];
#pragma unroll
    for (int i = 0; i < 2; ++i) { int R, C; stage_rc(tid * 16 + i * 8192, R, C); const int Rb = Epi::PERM ? ((R & ~31) + perm32(R & 31)) : R;
        voffA[i] = (unsigned)(R * K + 2 * C); voffB[i] = (unsigned)(Rb * K + 2 * C); }
    const size_t kstep = (size_t)(BK * 2);
    const size_t hstep = (size_t)HALF * K;
    const size_t tstep = 2 * hstep;
    const unsigned ldsw = (unsigned)wid * 1024u;
    const int aoff = lds_byte(wr * 64 + fr, fq * 16), boff = lds_byte(wc * 32 + fr, fq * 16);
#define PG8_SA(b, h) (((b) * 2 + (h)) * HTB)
#define PG8_SB(b, h) ((4 + (b) * 2 + (h)) * HTB)
#define PG8_STAGE(bufoff, gbase, voff) do { _Pragma("unroll") for (int _i = 0; _i < 2; ++_i) { unsigned keep_; \
        asm volatile("s_mov_b32 %0, m0\n\ts_mov_b32 m0, %3\n\ts_nop 0\n\tglobal_load_lds_dwordx4 %1, %2\n\ts_mov_b32 m0, %0" : "=&s"(keep_) : "v"((voff)[_i]), "s"((const char*)(gbase)), "s"((unsigned)(size_t)(lds + (bufoff) + ldsw + _i * 8192)) : "memory"); } } while (0)
#define PG8_LDA(dst, b, h) do { _Pragma("unroll") for (int m = 0; m < 4; ++m) { const u32x4 lo_ = *(const PG8_LAS u32x4*)(lds + PG8_SA(b, h) + aoff + m * 2048), hi_ = *(const PG8_LAS u32x4*)(lds + PG8_SA(b, h) + aoff + m * 2048 + 16); dst[m] = __builtin_bit_cast(i32x8, __builtin_shufflevector(lo_, hi_, 0, 1, 2, 3, 4, 5, 6, 7)); } } while (0)
#define PG8_LDB(dst, b, h) do { _Pragma("unroll") for (int n = 0; n < 2; ++n) { const u32x4 lo_ = *(const PG8_LAS u32x4*)(lds + PG8_SB(b, h) + boff + n * 2048), hi_ = *(const PG8_LAS u32x4*)(lds + PG8_SB(b, h) + boff + n * 2048 + 16); dst[n] = __builtin_bit_cast(i32x8, __builtin_shufflevector(lo_, hi_, 0, 1, 2, 3, 4, 5, 6, 7)); } } while (0)
#define PG8_MMA(ai, bj, At, Bt) do { __builtin_amdgcn_s_setprio(1); _Pragma("unroll") for (int m = 0; m < 4; ++m) _Pragma("unroll") for (int n = 0; n < 2; ++n) \
        acc[ai][bj][m][n] = __builtin_amdgcn_mfma_scale_f32_16x16x128_f8f6f4(Bt[n], At[m], acc[ai][bj][m][n], 0, 0, 0, g.scale_b, 0, g.scale_a); __builtin_amdgcn_s_setprio(0); } while (0)
#define PG8_WAIT_V(n) asm volatile("s_waitcnt vmcnt(" #n ")" ::: "memory")
#define PG8_WAIT_L(n) asm volatile("s_waitcnt lgkmcnt(" #n ")" ::: "memory")
#define PG8_BAR __builtin_amdgcn_s_barrier()
#define PG8_SCHED __builtin_amdgcn_sched_barrier(0)
    Unit cur, nxt; int ui = 0;
    if (!S.next(0, cur)) return;
    f32x4 acc[2][2][4][2];
#pragma unroll
    for (int a = 0; a < 2; ++a)
#pragma unroll
        for (int b = 0; b < 2; ++b)
#pragma unroll
            for (int m = 0; m < 4; ++m)
#pragma unroll
                for (int n = 0; n < 2; ++n) acc[a][b][m][n] = (f32x4){0.f, 0.f, 0.f, 0.f};
    typedef int i32x8 __attribute__((ext_vector_type(8))); i32x8 At[4], B0[2], B1[2];
    const char* cA = (const char*)g.A + (size_t)cur.pm * tstep; const char* cB = (const char*)g.Bt + (size_t)cur.pn * tstep;
    S.a_ready(cur);
    if constexpr (SP2) {
        PG8_STAGE(PG8_SB(0, 0), cB, voffB); PG8_STAGE(PG8_SB(0, 1), cB + hstep, voffB); PG8_STAGE(PG8_SA(0, 0), cA, voffA); PG8_STAGE(PG8_SA(0, 1), cA + hstep, voffA);
        if (wr == 1) PG8_BAR;
        PG8_WAIT_V(2); PG8_BAR;
        PG8_STAGE(PG8_SB(1, 0), cB + kstep, voffB); PG8_STAGE(PG8_SA(1, 0), cA + kstep, voffA); PG8_STAGE(PG8_SB(1, 1), cB + hstep + kstep, voffB);
        PG8_WAIT_V(6); PG8_BAR;
    } else {
        PG8_STAGE(PG8_SB(0, 0), cB, voffB); PG8_STAGE(PG8_SA(0, 0), cA, voffA); PG8_STAGE(PG8_SB(0, 1), cB + hstep, voffB); PG8_STAGE(PG8_SA(0, 1), cA + hstep, voffA);
        if (wr == 1) PG8_BAR;
        PG8_WAIT_V(4); PG8_BAR;
        PG8_STAGE(PG8_SB(1, 0), cB + kstep, voffB); PG8_STAGE(PG8_SA(1, 0), cA + kstep, voffA); PG8_STAGE(PG8_SB(1, 1), cB + hstep + kstep, voffB);
        PG8_WAIT_V(6); PG8_BAR;
    }
    for (;;) {
        const bool has_next = S.next(ui + 1, nxt);
        const char* nA = has_next ? (const char*)g.A + (size_t)nxt.pm * tstep : cA; const char* nB = has_next ? (const char*)g.Bt + (size_t)nxt.pn * tstep : cB;
#pragma unroll 1
        for (int t = 0; t < nt; t += 2) {
            const bool last = (t == nt - 2);
            const char* a1 = cA + (size_t)(t + 1) * kstep;
            const char* a2 = last ? nA : cA + (size_t)(t + 2) * kstep; const char* b2 = last ? nB : cB + (size_t)(t + 2) * kstep;
            const char* a3 = a2 + kstep; const char* b3 = b2 + kstep;
            if (last && has_next) S.a_ready(nxt);
            if constexpr (SP2) {
            PG8_LDB(B0, 0, 0); PG8_LDB(B1, 0, 1); PG8_SCHED; PG8_LDA(At, 0, 0); PG8_STAGE(PG8_SA(1, 1), a1 + hstep, voffA);
            PG8_WAIT_V(8); PG8_WAIT_L(0); PG8_BAR; PG8_MMA(0, 0, At, B0); PG8_MMA(0, 1, At, B1); PG8_BAR; PG8_SCHED;
            PG8_LDA(At, 0, 1); PG8_STAGE(PG8_SB(0, 0), b2, voffB); PG8_STAGE(PG8_SB(0, 1), b2 + hstep, voffB); PG8_STAGE(PG8_SA(0, 0), a2, voffA);
            PG8_WAIT_V(8); PG8_WAIT_L(0); PG8_BAR; PG8_MMA(1, 0, At, B0); PG8_MMA(1, 1, At, B1); PG8_BAR; PG8_SCHED;
            PG8_LDB(B0, 1, 0); PG8_LDB(B1, 1, 1); PG8_SCHED; PG8_LDA(At, 1, 0); PG8_STAGE(PG8_SA(0, 1), a2 + hstep, voffA);
            PG8_WAIT_V(8); PG8_WAIT_L(0); PG8_BAR; PG8_MMA(0, 0, At, B0); PG8_MMA(0, 1, At, B1); PG8_BAR; PG8_SCHED;
            PG8_LDA(At, 1, 1); PG8_STAGE(PG8_SB(1, 0), b3, voffB); PG8_STAGE(PG8_SB(1, 1), b3 + hstep, voffB); PG8_STAGE(PG8_SA(1, 0), a3, voffA);
            PG8_WAIT_V(8); PG8_WAIT_L(0); PG8_BAR; PG8_MMA(1, 0, At, B0); PG8_MMA(1, 1, At, B1); PG8_BAR; PG8_SCHED;
            } else {
            PG8_LDB(B0, 0, 0); PG8_SCHED; PG8_LDA(At, 0, 0); PG8_STAGE(PG8_SA(1, 1), a1 + hstep, voffA);
            PG8_WAIT_L(8); PG8_BAR; PG8_WAIT_L(0); PG8_MMA(0, 0, At, B0); PG8_BAR; PG8_SCHED;
            PG8_LDB(B1, 0, 1); PG8_STAGE(PG8_SB(0, 0), b2, voffB);
            PG8_BAR; PG8_WAIT_L(0); PG8_MMA(0, 1, At, B1); PG8_BAR;
            PG8_LDA(At, 0, 1); PG8_STAGE(PG8_SA(0, 0), a2, voffA);
            PG8_BAR; PG8_WAIT_L(0); PG8_MMA(1, 0, At, B0); PG8_BAR; PG8_SCHED;
            PG8_STAGE(PG8_SB(0, 1), b2 + hstep, voffB);
            PG8_WAIT_V(6); PG8_BAR; PG8_MMA(1, 1, At, B1); PG8_BAR;
            PG8_LDB(B0, 1, 0); PG8_SCHED; PG8_LDA(At, 1, 0); PG8_STAGE(PG8_SA(0, 1), a2 + hstep, voffA);
            PG8_WAIT_L(8); PG8_BAR; PG8_WAIT_L(0); PG8_MMA(0, 0, At, B0); PG8_BAR; PG8_SCHED;
            PG8_LDB(B1, 1, 1); PG8_STAGE(PG8_SB(1, 0), b3, voffB);
            PG8_BAR; PG8_WAIT_L(0); PG8_MMA(0, 1, At, B1); PG8_BAR;
            PG8_LDA(At, 1, 1); PG8_STAGE(PG8_SA(1, 0), a3, voffA);
            PG8_BAR; PG8_WAIT_L(0); PG8_MMA(1, 0, At, B0); PG8_BAR; PG8_SCHED;
            PG8_STAGE(PG8_SB(1, 1), b3 + hstep, voffB);
            PG8_WAIT_V(6); PG8_BAR; PG8_MMA(1, 1, At, B1); PG8_BAR;
            }
        }
        if constexpr (ALIGN_EPI) { if (wr == 0) PG8_BAR; }
        if constexpr (!Epi::AFTER_DRAIN) { int t2_ = threadIdx.x; asm volatile("" : "+v"(t2_)); const int l2_ = t2_ & 63;
            E(acc, cur, wr, wc, l2_ & 15, l2_ >> 4); S.done(cur); }
        if (!has_next) break;
#pragma unroll
        for (int a = 0; a < 2; ++a)
#pragma unroll
            for (int b = 0; b < 2; ++b)
#pragma unroll
                for (int m = 0; m < 4; ++m)
#pragma unroll
                    for (int n = 0; n < 2; ++n) acc[a][b][m][n] = (f32x4){0.f, 0.f, 0.f, 0.f};
        cur = nxt; cA = nA; cB = nB; ++ui;
        if constexpr (ALIGN_EPI) { if (wr == 1) PG8_BAR; }
    }
    PG8_WAIT_V(0);
    if constexpr (!ALIGN_EPI) { if (wr == 0) PG8_BAR; }
    PG8_BAR;
    if constexpr (Epi::AFTER_DRAIN) { E.fused(acc, cur, wr, wc, fr, fq, lds, wid, lane); S.done(cur); }
#undef PG8_SA
#undef PG8_SB
#undef PG8_STAGE
#undef PG8_LDA
#undef PG8_LDB
#undef PG8_MMA
#undef PG8_WAIT_V
#undef PG8_WAIT_L
#undef PG8_BAR
#undef PG8_SCHED
}
}
#define GAS __attribute__((address_space(1)))
#define LAS __attribute__((address_space(3)))
typedef unsigned short bf16;
typedef unsigned v4u __attribute__((ext_vector_type(4)));
typedef float f32x4 __attribute__((ext_vector_type(4)));
typedef short bf16x8 __attribute__((ext_vector_type(8)));
typedef GAS unsigned gu32;
typedef GAS unsigned long long gu64;
#define RLX_AGENT __ATOMIC_RELAXED, __HIP_MEMORY_SCOPE_AGENT
#define LDS_WAIT() asm volatile("s_waitcnt lgkmcnt(0)" ::: "memory")
#define VM_WAIT() asm volatile("s_waitcnt vmcnt(0)" ::: "memory")
__device__ __forceinline__ unsigned long long rt() { return __builtin_amdgcn_s_memrealtime(); }
__device__ __forceinline__ unsigned f2bf(float f) { unsigned u = __builtin_bit_cast(unsigned, f); return (u + 0x7fffu + ((u >> 16) & 1u)) >> 16; }
__device__ __forceinline__ unsigned pk2(float lo, float hi) { return f2bf(lo) | (f2bf(hi) << 16); }

#define XB_TMO      128
#define XB_XCNT(j)  (256  + 64 * (j))
#define XB_XSUB(j)  (1280 + 64 * (j))
#define XB_XGEN(j)  (2304 + 64 * (j))
#define XB_TOP      3328
#define XB_TOPGEN   3392
#define XCD_BAR_WORDS 3456
#define XB_SPIN_CAP (1u << 18)

__device__ __forceinline__ unsigned xb_ld(unsigned* p)              { return __hip_atomic_load(p, __ATOMIC_RELAXED, __HIP_MEMORY_SCOPE_AGENT); }
__device__ __forceinline__ unsigned xb_add(unsigned* p, unsigned v) { return __hip_atomic_fetch_add(p, v, __ATOMIC_RELAXED, __HIP_MEMORY_SCOPE_AGENT); }
__device__ __forceinline__ unsigned xb_xcc_id() { return (unsigned)__builtin_amdgcn_s_getreg((3 << 11) | 20) & 0xFu; }
#define XB_SPIN(cond, bar) do { unsigned _sp = 0; while (cond) { __builtin_amdgcn_s_sleep(1); \
    if ((++_sp & 255u) == 0u) { if (xb_ld(&(bar)[XB_TMO])) break; if (_sp > XB_SPIN_CAP) { atomicAdd(&(bar)[XB_TMO], 1u); break; } } } } while (0)

struct XcdBarrier {
    unsigned* bar; unsigned x;
    volatile LAS unsigned* st;
};

__device__ __forceinline__ XcdBarrier xcd_barrier_post(unsigned* bar, volatile LAS unsigned* st) {
    XcdBarrier b; b.bar = bar; b.x = xb_xcc_id(); b.st = st;
    if (threadIdx.x == 0) (void)xb_add(&bar[XB_XCNT(b.x)], 1u);
    return b;
}
__device__ __forceinline__ void xcd_barrier_complete(unsigned* bar, unsigned x, unsigned& nloc, unsigned& nx) {
    const unsigned G = gridDim.x * gridDim.y * gridDim.z;
    unsigned sum, cnt, mine, sp = 0u;
    for (;;) {
        sum = 0u; cnt = 0u; mine = 0u;
#pragma unroll
        for (unsigned j = 0; j < 16; ++j) { const unsigned c = xb_ld(&bar[XB_XCNT(j)]); sum += c; cnt += (c > 0u) ? 1u : 0u; mine = (j == x) ? c : mine; }
        if (sum == G) break;
        __builtin_amdgcn_s_sleep(1);
        if ((++sp & 255u) == 0u) { if (xb_ld(&bar[XB_TMO])) break; if (sp > XB_SPIN_CAP) { atomicAdd(&bar[XB_TMO], 1u); break; } }
    }
    nloc = mine > 0u ? mine : 1u; nx = cnt > 0u ? cnt : 1u;
}

__device__ __forceinline__ void xcd_barrier(const XcdBarrier& b) {
    asm volatile("s_waitcnt vmcnt(0)" ::: "memory");
    __syncthreads();
    if (threadIdx.x == 0) {
        unsigned* bar = b.bar;
        __builtin_amdgcn_s_waitcnt(0);
        unsigned nloc = b.st[0], nx = b.st[1];
        if (nloc == 0u) { xcd_barrier_complete(bar, b.x, nloc, nx); b.st[0] = nloc; b.st[1] = nx; }
        const unsigned old = xb_add(&bar[XB_XSUB(b.x)], 1u);
        const unsigned gen = old / nloc;
        if (old + 1u == (gen + 1u) * nloc) {
            __builtin_amdgcn_fence(__ATOMIC_RELEASE, "agent");
            asm volatile("s_waitcnt vmcnt(0)" ::: "memory");
            const unsigned og = xb_add(&bar[XB_TOP], 1u);
            const unsigned tg = og / nx;
            if (og + 1u == (tg + 1u) * nx) xb_add(&bar[XB_TOPGEN], 1u);
            else XB_SPIN(xb_ld(&bar[XB_TOPGEN]) == tg, bar);
            __builtin_amdgcn_fence(__ATOMIC_ACQUIRE, "agent");
            xb_add(&bar[XB_XGEN(b.x)], 1u);
            asm volatile("s_waitcnt vmcnt(0)" ::: "memory");
        } else {
            XB_SPIN(xb_ld(&bar[XB_XGEN(b.x)]) == gen, bar);
            __builtin_amdgcn_fence(__ATOMIC_ACQUIRE, "agent");
            asm volatile("s_waitcnt vmcnt(0)" ::: "memory");
        }
    }
    __syncthreads();
}
#define DI __device__ __forceinline__
constexpr int NWAVES = 8;
constexpr int NB = 16, SEQ = 2048, DM = 1024, MT = NB * SEQ;
constexpr int DIN_SRC = 6944, NPROJ = 7168;
constexpr int MEML = 256, MROWS = NB * MEML;
constexpr int NEXP = 32, TOPK = 4, DFF = 1024, MOEB = 256;
constexpr int NROWS = MT * TOPK;
constexpr int NBLK_MAX = (NROWS + NEXP * (MOEB - 1) + MOEB - 1) / MOEB;
constexpr int CAP = NBLK_MAX * MOEB;
constexpr float EPS = 1e-6f;
constexpr float NEGF = -1e30f;
constexpr int PC_MLQ = 0, PC_MLK = 512, PC_MLV = 1024, PC_MLO = 1536, PC_NQ = 2048, PC_NKC = 2560, PC_NVC = 2688, PC_NKS = 2816, PC_NVS = 2944,
              PC_NKW = 3072, PC_NVW = 3200, PC_MQ = 3328, PC_BRG = 3840, PC_MLI = 6912, PC_MLF = 6916, PC_NG = 6920, PC_END = 6944;
__host__ __device__ constexpr int proj_srccol(int j) {
    return j < 2048 ? j : j < 2560 ? 2056 + (j - 2048) : j < 3328 ? 2568 + (j - 2560) : j < 3840 ? 3360 + (j - 3328) : j < 6912 ? 3872 + (j - 3840)
         : j < 6920 ? 2048 + (j - 6912) : j < 6944 ? 3336 + (j - 6920) : -1;
}

constexpr size_t MiB = 1u << 20;
constexpr size_t WS_CTL = 0, CTL_ZERO_BYTES = 1 * MiB;
constexpr size_t WS_WIN = 1 * MiB, WS_WGU = 15 * MiB, WS_WDN = 143 * MiB, WS_WMKV = 207 * MiB, WS_WBR = 209 * MiB, WS_WOUT = 212 * MiB, WS_WC1 = 214 * MiB;
constexpr size_t WS_SMALL = 216 * MiB;
constexpr size_t WS_R1 = 218 * MiB;
constexpr size_t WS_PROJ = 282 * MiB;
constexpr size_t WS_R3 = 730 * MiB;
constexpr size_t WS_MEMKV = WS_R3, WS_MEMKN = WS_R3 + 8 * MiB, WS_QN = WS_R3 + 12 * MiB, WS_KSN = WS_R3 + 44 * MiB, WS_KWN = WS_R3 + 52 * MiB,
                 WS_MQN = WS_R3 + 60 * MiB, WS_MLQK = WS_R3 + 92 * MiB, WS_HID = WS_R3 + 156 * MiB, WS_KC = WS_R3 + 160 * MiB, WS_VC = WS_KC + MiB / 2,
                 WS_H0 = WS_R3 + 161 * MiB, WS_H1 = WS_H0 + 32 * MiB, WS_H2 = WS_H1 + 32 * MiB, WS_ROUTE = WS_H2 + 32 * MiB, WS_END = WS_ROUTE + 6 * MiB;
constexpr size_t WS_MLV = WS_R1, WS_VSN = WS_R1 + 32 * MiB, WS_VWN = WS_R1 + 40 * MiB;
constexpr size_t WS_MEMN = WS_H0;
constexpr size_t WS_ACMP = WS_H1;
constexpr size_t WS_APERM = WS_PROJ;
constexpr size_t WS_ACT = WS_PROJ + 272 * MiB;
static_assert(WS_ACT + 272 * MiB <= WS_H0 + 96 * MiB && WS_END <= 1024 * MiB, "ws map");
constexpr size_t SM_ROPEC = 0, SM_ROPES = 256 * 1024, SM_CBIAS = 512 * 1024, SM_WRT = 1024 * 1024;
constexpr size_t RT_TOKE = 0, RT_TOKPOS = 512 * 1024, RT_TOKW = 1024 * 1024, RT_TOKDEST = 1536 * 1024, RT_ROWW = 2048 * 1024;
constexpr int CW_BAR = 4096;
constexpr int CW_ECNT = 16384;
constexpr int CW_QCTR = 16384 + 64;

constexpr int RING_BYTES = 131072, LDSCTL_OFF = RING_BYTES, MISC_OFF = LDSCTL_OFF + 320, LDS_BYTES = 147456;

struct Args { const float* in[34]; float* out; unsigned char* ws; int ph_lo, ph_hi, li, pad; };

DI float bf2f(unsigned short h) { return __uint_as_float((unsigned)h << 16); }
DI float wave_sum(float v) {
#pragma unroll
    for (int o = 1; o < 64; o <<= 1) v += __shfl_xor(v, o);
    return v;
}
DI float wave_max(float v) {
#pragma unroll
    for (int o = 1; o < 64; o <<= 1) v = fmaxf(v, __shfl_xor(v, o));
    return v;
}
DI float sigm(float x) { return __builtin_amdgcn_rcpf(1.f + __expf(-x)); }
DI float logsig(float x) { return fminf(x, 0.f) - log1pf(__expf(-fabsf(x))); }

namespace pg8 {
struct EpiBf16Silu {
    static constexpr bool PERM = true, AFTER_DRAIN = false;
    bf16_t* O; int ldc; const float* bias; int silu;
    DI void operator()(const f32x4 (&acc)[2][2][4][2], const Unit& u, int wr, int wc, int fr, int fq) const {
        const int row0 = u.pm * BM + wr * 64 + fr; const int col0 = u.pn * BM + wc * 32 + 8 * fq;
#pragma unroll
        for (int ai = 0; ai < 2; ++ai)
#pragma unroll
            for (int m = 0; m < 4; ++m) { bf16_t* rowp = O + (size_t)(row0 + ai * HALF + m * 16) * ldc + col0;
#pragma unroll
                for (int bj = 0; bj < 2; ++bj) { f32x4 v0 = acc[ai][bj][m][0], v1 = acc[ai][bj][m][1];
                    if (bias) { v0 += *(const f32x4*)(bias + col0 + bj * HALF); v1 += *(const f32x4*)(bias + col0 + bj * HALF + 4); }
                    if (silu) {
#pragma unroll
                        for (int j = 0; j < 4; ++j) { v0[j] = v0[j] * __builtin_amdgcn_rcpf(1.f + __expf(-v0[j])); v1[j] = v1[j] * __builtin_amdgcn_rcpf(1.f + __expf(-v1[j])); } }
                    u32x4 w; w.x = cvt_pk_bf16(v0[0], v0[1]); w.y = cvt_pk_bf16(v0[2], v0[3]); w.z = cvt_pk_bf16(v1[0], v1[1]); w.w = cvt_pk_bf16(v1[2], v1[3]);
                    *(u32x4*)(rowp + bj * HALF) = w; } }
    }
};
template <int B> struct EpiGate {
    static constexpr bool PERM = false, AFTER_DRAIN = false;
    const bf16_t* proj; float* tmp; bf16_t* merged;
    DI void operator()(const f32x4 (&acc)[2][2][4][2], const Unit& u, int wr, int wc, int fr, int fq) const {
        typedef unsigned u32x2v __attribute__((ext_vector_type(2)));
        const int col0 = u.pn * BM + wc * 32 + 4 * fq;
#pragma unroll
        for (int ai = 0; ai < 2; ++ai)
#pragma unroll
            for (int m = 0; m < 4; ++m) { const size_t r = (size_t)(u.pm * BM + ai * HALF + wr * 64 + m * 16 + fr);
#pragma unroll
                for (int bj = 0; bj < 2; ++bj)
#pragma unroll
                    for (int n = 0; n < 2; ++n) { const int c = col0 + bj * HALF + n * 16;
                        const u32x2v gw = *(const u32x2v*)(proj + r * NPROJ + PC_BRG + B * DM + c);
                        f32x4 g; g[0] = __uint_as_float(gw.x << 16); g[1] = __uint_as_float(gw.x & 0xffff0000u); g[2] = __uint_as_float(gw.y << 16); g[3] = __uint_as_float(gw.y & 0xffff0000u);
                        f32x4 v = acc[ai][bj][m][n];
#pragma unroll
                        for (int j = 0; j < 4; ++j) v[j] = v[j] * __builtin_amdgcn_rcpf(1.f + __expf(-g[j]));
                        float* tp = tmp + r * DM + c;
                        if (B == 0) { *(f32x4*)tp = v; }
                        else if (B == 1) { *(f32x4*)tp = *(const f32x4*)tp + v; }
                        else { v = *(const f32x4*)tp + v; u32x2v w; w.x = cvt_pk_bf16(v[0], v[1]); w.y = cvt_pk_bf16(v[2], v[3]); *(u32x2v*)(merged + r * DM + c) = w; } } }
    }
};
struct EpiRes {
    static constexpr bool PERM = false, AFTER_DRAIN = false;
    const float* base; float* out;
    DI void operator()(const f32x4 (&acc)[2][2][4][2], const Unit& u, int wr, int wc, int fr, int fq) const {
        const int col0 = u.pn * BM + wc * 32 + 4 * fq;
#pragma unroll
        for (int ai = 0; ai < 2; ++ai)
#pragma unroll
            for (int m = 0; m < 4; ++m) { const size_t r = (size_t)(u.pm * BM + ai * HALF + wr * 64 + m * 16 + fr);
#pragma unroll
                for (int bj = 0; bj < 2; ++bj)
#pragma unroll
                    for (int n = 0; n < 2; ++n) { const int c = col0 + bj * HALF + n * 16; *(f32x4*)(out + r * DM + c) = *(const f32x4*)(base + r * DM + c) + acc[ai][bj][m][n]; } }
    }
};
struct EpiSwiglu {
    static constexpr bool PERM = true, AFTER_DRAIN = false;
    unsigned char* act; const float* bgu;
    DI void operator()(const f32x4 (&acc)[2][2][4][2], const Unit& u, int wr, int wc, int fr, int fq) const {
        typedef unsigned u32x2v __attribute__((ext_vector_type(2)));
        const int e = u.pn >> 3, pnl = u.pn & 7;
        const int lc0 = pnl * BM + wc * 32 + 8 * fq;
        const unsigned row0 = (unsigned)(u.pm * BM + wr * 64 + fr);
        const float* bp = bgu + e * 2048;
#pragma unroll
        for (int ai = 0; ai < 2; ++ai)
#pragma unroll
            for (int m = 0; m < 4; ++m) { const unsigned rowoff = (row0 + ai * HALF + m * 16) * (unsigned)DFF;
#pragma unroll
                for (int bj = 0; bj < 2; ++bj) {
                    const unsigned lc = (unsigned)(lc0 + bj * HALF);
                    const f32x4 b0 = *(const f32x4*)(bp + lc), b1 = *(const f32x4*)(bp + lc + 4);
                    const f32x4 v0 = acc[ai][bj][m][0] + b0, v1 = acc[ai][bj][m][1] + b1;
                    float o[4];
#pragma unroll
                    for (int q = 0; q < 4; ++q) { const float gt = fminf(q < 2 ? v0[2 * q] : v1[2 * q - 4], 7.0f); float up = q < 2 ? v0[2 * q + 1] : v1[2 * q - 3]; up = fminf(fmaxf(up, -7.0f), 7.0f);
                        o[q] = (up + 1.0f) * (gt * __builtin_amdgcn_rcpf(1.f + __expf(-1.702f * gt))); }
                    int q8 = 0; q8 = __builtin_amdgcn_cvt_pk_fp8_f32(o[0], o[1], q8, false); q8 = __builtin_amdgcn_cvt_pk_fp8_f32(o[2], o[3], q8, true);
                    *(unsigned*)(act + (rowoff + (lc >> 1))) = (unsigned)q8; } }
    }
};
struct EpiDown {
    static constexpr bool PERM = false, AFTER_DRAIN = false;
    bf16_t* y; const float* bdn; const float* roww;
    DI void operator()(const f32x4 (&acc)[2][2][4][2], const Unit& u, int wr, int wc, int fr, int fq) const {
        typedef unsigned u32x2v __attribute__((ext_vector_type(2)));
        const int e = u.pn >> 2, pnl = u.pn & 3;
        const int col0 = pnl * BM + wc * 32 + 4 * fq;
#pragma unroll
        for (int ai = 0; ai < 2; ++ai)
#pragma unroll
            for (int m = 0; m < 4; ++m) { const size_t r = (size_t)(u.pm * BM + ai * HALF + wr * 64 + m * 16 + fr); const float rw = roww[r];
#pragma unroll
                for (int bj = 0; bj < 2; ++bj)
#pragma unroll
                    for (int n = 0; n < 2; ++n) { const int c = col0 + bj * HALF + n * 16; const f32x4 v = (acc[ai][bj][m][n] + *(const f32x4*)(bdn + e * DM + c)) * rw;
                        u32x2v w; w.x = cvt_pk_bf16(v[0], v[1]); w.y = cvt_pk_bf16(v[2], v[3]); *(u32x2v*)(y + r * DM + c) = w; } }
    }
};
template <int NPN> struct MoeOrder {
    int nblk, G, c; const PG8_LAS unsigned char* blk_e;
    DI bool next(int i, Unit& u) const {
        int rb, pn;
        if (G == 256) { const int x = c & 7, j = c >> 3; rb = i * (256 / NPN) + x * (32 / NPN) + j / NPN; pn = j % NPN; }
        else { const int L = i * G + c; rb = L / NPN; pn = L % NPN; }
        if (rb >= nblk) return false;
        u.pm = rb; u.pn = __builtin_amdgcn_readfirstlane((int)blk_e[rb]) * NPN + pn; return true; }
    DI void a_ready(const Unit&) const {}
    DI void done(const Unit&) const {}
};
}

struct Frame {
    LAS unsigned char* lds; volatile LAS unsigned* MISC; unsigned* ctl; unsigned char* ws;
    int tid, lane, wave, G, bx;
    const float* const* in; float* out;
};
enum { I_X = 0, I_MEM, I_GMIX, I_WIN, I_CONVW, I_CONVB, I_MLBI, I_MLBF, I_MLGOUT, I_NGQ, I_NGK, I_CPK, I_CW1K, I_CB1K, I_CW2K, I_CPV, I_CW1V, I_CB1V, I_CW2V,
       I_GMEM, I_WMKV, I_MGQ, I_MGK, I_WBRML, I_WBRNSA, I_WBRMEM, I_WOUT, I_GFFN, I_WR, I_BR, I_WGU, I_BGU, I_WDN, I_BDN, N_IN };

template <class CM>
DI void tr_item(const float* W, int ldw, int K, bf16* WT, int k0, int n0, CM cm, LAS float* scr, int lane) {
    const int sc = cm(n0 + (lane & 31));
#pragma unroll 8
    for (int i = 0; i < 32; ++i) { const int kk = 2 * i + (lane >> 5); scr[kk * 33 + (lane & 31)] = sc >= 0 ? W[(size_t)(k0 + kk) * ldw + sc] : 0.f; }
    LDS_WAIT(); asm volatile("" ::: "memory");
    const int c = lane & 7;
#pragma unroll
    for (int j = 0; j < 4; ++j) { const int n = (lane >> 3) + 8 * j; const LAS float* s = scr + (8 * c) * 33 + n;
        v4u o; o.x = pk2(s[0 * 33], s[1 * 33]); o.y = pk2(s[2 * 33], s[3 * 33]); o.z = pk2(s[4 * 33], s[5 * 33]); o.w = pk2(s[6 * 33], s[7 * 33]);
        *(v4u*)(WT + (size_t)(n0 + n) * K + k0 + 8 * c) = o; }
    LDS_WAIT(); asm volatile("" ::: "memory");
}
DI void tr_item_f8(const float* W, int ldw, int K, unsigned char* WT, int k0, int n0, LAS float* scr, int lane) {
#pragma unroll 8
    for (int i = 0; i < 32; ++i) { const int kk = 2 * i + (lane >> 5); scr[kk * 33 + (lane & 31)] = W[(size_t)(k0 + kk) * ldw + n0 + (lane & 31)] * 256.0f; }
    LDS_WAIT(); asm volatile("" ::: "memory");
    const int c = lane & 7;
#pragma unroll
    for (int j = 0; j < 4; ++j) { const int n = (lane >> 3) + 8 * j; const LAS float* sp = scr + (8 * c) * 33 + n;
        int lo = 0, hi = 0;
        lo = __builtin_amdgcn_cvt_pk_fp8_f32(sp[0 * 33], sp[1 * 33], lo, false); lo = __builtin_amdgcn_cvt_pk_fp8_f32(sp[2 * 33], sp[3 * 33], lo, true);
        hi = __builtin_amdgcn_cvt_pk_fp8_f32(sp[4 * 33], sp[5 * 33], hi, false); hi = __builtin_amdgcn_cvt_pk_fp8_f32(sp[6 * 33], sp[7 * 33], hi, true);
        typedef unsigned u32x2t __attribute__((ext_vector_type(2)));
        *(u32x2t*)(WT + (size_t)(n0 + n) * K + k0 + 8 * c) = (u32x2t){(unsigned)lo, (unsigned)hi}; }
    LDS_WAIT(); asm volatile("" ::: "memory");
}
struct CmId { DI int operator()(int j) const { return j; } };
struct CmProj { DI int operator()(int j) const { return proj_srccol(j); } };

DI void rms_row_bf16(const float* xrow, const float* g, bf16* orow, int lane) {
    const f32x4* xr = (const f32x4*)xrow + lane; const f32x4* gr = (const f32x4*)g + lane;
    f32x4 v[4]; float s = 0.f;
#pragma unroll
    for (int j = 0; j < 4; ++j) { v[j] = xr[64 * j]; s += (v[j].x * v[j].x + v[j].y * v[j].y) + (v[j].z * v[j].z + v[j].w * v[j].w); }
    const float rstd = rsqrtf(wave_sum(s) * (1.f / DM) + EPS);
    unsigned long long* o8 = (unsigned long long*)orow + lane;
#pragma unroll
    for (int j = 0; j < 4; ++j) { const f32x4 gg = gr[64 * j];
        o8[64 * j] = (unsigned long long)pk2(v[j].x * rstd * gg.x, v[j].y * rstd * gg.y) | ((unsigned long long)pk2(v[j].z * rstd * gg.z, v[j].w * rstd * gg.w) << 32); }
}

DI void p0_prologue(Frame& F) {
    LAS float* scr = (LAS float*)(F.lds + F.wave * 16384);
    const int gw = F.bx * NWAVES + F.wave, NGW = F.G * NWAVES;
    unsigned char* ws = F.ws;
    constexpr int IT_IN = 16 * (NPROJ / 32), IT_GU = 32 * 16 * 64, IT_DN = 32 * 16 * 32, IT_MKV = 16 * 32, IT_BR = 3 * 8 * 32, IT_OUT = 16 * 32, IT_C1 = 2 * 32 * 8;
    constexpr int NITEMS = IT_IN + IT_GU + IT_DN + IT_MKV + IT_BR + IT_OUT + IT_C1;
    for (int it = gw; it < NITEMS; it += NGW) {
        int r = it;
        if (r < IT_IN) { const int kb = r / (NPROJ / 32), nb = r % (NPROJ / 32); tr_item(F.in[I_WIN], DIN_SRC, DM, (bf16*)(ws + WS_WIN), 64 * kb, 32 * nb, CmProj(), scr, F.lane); continue; } r -= IT_IN;
        if (r < IT_GU) { const int e = r / 1024, q = r % 1024, kb = q / 64, nb = q % 64; tr_item_f8(F.in[I_WGU] + (size_t)e * DM * 2048, 2048, DM, (unsigned char*)(ws + WS_WGU) + (size_t)e * 2048 * DM, 64 * kb, 32 * nb, scr, F.lane); continue; } r -= IT_GU;
        if (r < IT_DN) { const int e = r / 512, q = r % 512, kb = q / 32, nb = q % 32; tr_item_f8(F.in[I_WDN] + (size_t)e * DFF * DM, DM, DFF, (unsigned char*)(ws + WS_WDN) + (size_t)e * DM * DFF, 64 * kb, 32 * nb, scr, F.lane); continue; } r -= IT_DN;
        if (r < IT_MKV) { const int kb = r / 32, nb = r % 32; tr_item(F.in[I_WMKV], 1024, 1024, (bf16*)(ws + WS_WMKV), 64 * kb, 32 * nb, CmId(), scr, F.lane); continue; } r -= IT_MKV;
        if (r < IT_BR) { const int b = r / 256, q = r % 256, kb = q / 32, nb = q % 32; tr_item(F.in[I_WBRML + b], 1024, 512, (bf16*)(ws + WS_WBR) + (size_t)b * 1024 * 512, 64 * kb, 32 * nb, CmId(), scr, F.lane); continue; } r -= IT_BR;
        if (r < IT_OUT) { const int kb = r / 32, nb = r % 32; tr_item(F.in[I_WOUT], 1024, 1024, (bf16*)(ws + WS_WOUT), 64 * kb, 32 * nb, CmId(), scr, F.lane); continue; } r -= IT_OUT;
        { const int kv = r / 256, q = r % 256, kb = q / 8, nb = q % 8; tr_item(F.in[kv ? I_CW1V : I_CW1K], 256, 2048, (bf16*)(ws + WS_WC1) + (size_t)kv * 256 * 2048, 64 * kb, 32 * nb, CmId(), scr, F.lane); }
    }
    for (int m = gw; m < MT; m += NGW) rms_row_bf16(F.in[I_X] + (size_t)m * DM, F.in[I_GMIX], (bf16*)(ws + WS_R1) + (size_t)m * DM, F.lane);
    for (int m = gw; m < MROWS; m += NGW) rms_row_bf16(F.in[I_MEM] + (size_t)m * DM, F.in[I_GMEM], (bf16*)(ws + WS_MEMN) + (size_t)m * DM, F.lane);
    float* rc = (float*)(ws + WS_SMALL + SM_ROPEC); float* rs = (float*)(ws + WS_SMALL + SM_ROPES);
    for (int i = F.bx * 512 + F.tid; i < SEQ * 32; i += F.G * 512) {
        const int p = i >> 5, k = i & 31;
        const float invf = exp2f(-(float)k * (13.287712379549449f / 32.0f));
        const float ang = (float)p * invf;
        const float kf = rintf(ang * 0.15915494309189535f);
        float r = fmaf(-kf, 6.28125f, ang); r = fmaf(-kf, 1.9353071795864769e-3f, r);
        rc[i] = cosf(r); rs[i] = sinf(r);
    }
    { bf16* wrt = (bf16*)(ws + WS_SMALL + SM_WRT);
      for (int i = F.bx * 512 + F.tid; i < 32 * 1024; i += F.G * 512) { const int e = i >> 10, k = i & 1023; const float w = F.in[I_WR][k * 32 + e]; const unsigned hi = f2bf(w); wrt[i] = (bf16)hi; wrt[32 * 1024 + i] = (bf16)f2bf(w - __uint_as_float(hi << 16)); } }
    if (F.bx == F.G - 1) {
        const int kv = F.tid >> 8, f = F.tid & 255;
        const float* pe = F.in[kv ? I_CPV : I_CPK]; const float* w1 = F.in[kv ? I_CW1V : I_CW1K];
        float a = F.in[kv ? I_CB1V : I_CB1K][f];
        for (int k = 0; k < 2048; ++k) a = fmaf(pe[k], w1[(size_t)k * 256 + f], a);
        ((float*)(ws + WS_SMALL + SM_CBIAS))[kv * 256 + f] = a;
    }
}

DI void unpack8(const v4u& w, float (&f)[8]) {
    f[0] = __uint_as_float(w.x << 16); f[1] = __uint_as_float(w.x & 0xffff0000u); f[2] = __uint_as_float(w.y << 16); f[3] = __uint_as_float(w.y & 0xffff0000u);
    f[4] = __uint_as_float(w.z << 16); f[5] = __uint_as_float(w.z & 0xffff0000u); f[6] = __uint_as_float(w.w << 16); f[7] = __uint_as_float(w.w & 0xffff0000u);
}
DI v4u pack8f(const float (&f)[8]) { v4u o; o.x = pk2(f[0], f[1]); o.y = pk2(f[2], f[3]); o.z = pk2(f[4], f[5]); o.w = pk2(f[6], f[7]); return o; }
DI void load8f(const float* p, float (&f)[8]) { const f32x4 a = *(const f32x4*)p, b = *(const f32x4*)(p + 4); f[0] = a.x; f[1] = a.y; f[2] = a.z; f[3] = a.w; f[4] = b.x; f[5] = b.y; f[6] = b.z; f[7] = b.w; }
DI void norm_rope64(float (&f)[8], const float (&g)[8], const float* rc, const float* rs, int pos, int lane, float scale) {
    float ss = 0.f;
#pragma unroll
    for (int i = 0; i < 8; ++i) ss = fmaf(f[i], f[i], ss);
    ss += __shfl_xor(ss, 1); ss += __shfl_xor(ss, 2); ss += __shfl_xor(ss, 4);
    const float rstd = rsqrtf(ss * (1.f / 64.f) + EPS);
    float c8[8], s8[8]; load8f(rc + pos * 32 + 8 * (lane & 3), c8); load8f(rs + pos * 32 + 8 * (lane & 3), s8);
    const bool hi = (lane & 4) != 0;
#pragma unroll
    for (int i = 0; i < 8; ++i) { const float y = f[i] * rstd * g[i]; const float pt = __shfl_xor(y, 4); f[i] = (hi ? fmaf(pt, s8[i], y * c8[i]) : fmaf(-pt, s8[i], y * c8[i])) * scale; }
}
DI void p2_prep(Frame& F) {
    unsigned char* ws = F.ws;
    const int gw = F.bx * NWAVES + F.wave, NGW = F.G * NWAVES, lane = F.lane;
    const bf16* proj = (const bf16*)(ws + WS_PROJ);
    const float* rc = (const float*)(ws + WS_SMALL + SM_ROPEC); const float* rs = (const float*)(ws + WS_SMALL + SM_ROPES);
    bf16* qn = (bf16*)(ws + WS_QN); bf16* ksn = (bf16*)(ws + WS_KSN); bf16* kwn = (bf16*)(ws + WS_KWN); bf16* mqn = (bf16*)(ws + WS_MQN); bf16* mlqk = (bf16*)(ws + WS_MLQK);
    bf16* acmp = (bf16*)(ws + WS_ACMP);
    {
        float gq8[8], mg8[8]; load8f(F.in[I_NGQ] + 8 * (lane & 7), gq8); load8f(F.in[I_MGQ] + 8 * (lane & 15), mg8);
        for (int t = gw; t < MT; t += NGW) {
            const int tau = t & 2047; const bf16* pr = proj + (size_t)t * NPROJ;
            float f[8]; unpack8(*(const v4u*)(pr + PC_NQ + 8 * lane), f);
            norm_rope64(f, gq8, rc, rs, tau, lane, 0.125f * 1.4426950408889634f);
            *(v4u*)(qn + (size_t)t * 512 + 8 * lane) = pack8f(f);
            unpack8(*(const v4u*)(pr + PC_MQ + 8 * lane), f);
            float ss = 0.f;
#pragma unroll
            for (int i = 0; i < 8; ++i) ss = fmaf(f[i], f[i], ss);
            ss += __shfl_xor(ss, 1); ss += __shfl_xor(ss, 2); ss += __shfl_xor(ss, 4); ss += __shfl_xor(ss, 8);
            const float rstd = rsqrtf(ss * (1.f / 128.f) + EPS) * (0.08838834764831845f * 1.4426950408889634f);
#pragma unroll
            for (int i = 0; i < 8; ++i) f[i] *= rstd * mg8[i];
            *(v4u*)(mqn + (size_t)t * 512 + 8 * lane) = pack8f(f);
            *(v4u*)((bf16*)(ws + WS_MLV) + (size_t)t * 512 + 8 * lane) = *(const v4u*)(pr + PC_MLV + 8 * lane);
        }
    }
    {
        const int L = lane & 31, hd4 = L >> 3, j = L & 7, half = lane >> 5;
        float gk8[8]; load8f(F.in[I_NGK] + (1 + (hd4 >> 1)) * 64 + 8 * j, gk8);
        const int kcol = (hd4 < 2 ? PC_NKS + hd4 * 64 : PC_NKW + (hd4 - 2) * 64) + 8 * j;
        bf16* kdst = (hd4 < 2 ? ksn : kwn) + (hd4 & 1) * 64 + 8 * j;
        const int kv = hd4 >> 1, hh = hd4 & 1;
        for (int tp = gw; tp < MT / 2; tp += NGW) {
            const int t = 2 * tp + half, b = t >> 11, tau = t & 2047; const bf16* pr = proj + (size_t)t * NPROJ;
            float f[8]; unpack8(*(const v4u*)(pr + kcol), f);
            norm_rope64(f, gk8, rc, rs, tau, lane, 1.0f);
            *(v4u*)(kdst + (size_t)t * 128) = pack8f(f);
            { const int wv = L >> 4, jj = L & 15;
              *(v4u*)((bf16*)(ws + (wv ? WS_VWN : WS_VSN)) + (size_t)t * 128 + 8 * jj) = *(const v4u*)(pr + (wv ? PC_NVW : PC_NVS) + 8 * jj); }
            const v4u cv = *(const v4u*)(pr + PC_NKC + hd4 * 64 + 8 * j);
            const int nA = tau >> 4;
#pragma unroll
            for (int dn = 0; dn < 2; ++dn) { const int n = nA - dn; if (n >= 0 && n <= 126) { const int l = tau - 16 * n;
                *(v4u*)(acmp + (size_t)kv * 4096 * 2048 + (size_t)((b * 2 + hh) * 128 + n) * 2048 + l * 64 + 8 * j) = cv; } }
        }
    }
    for (int run = gw; run < MT / 16; run += NGW) {
        const int t0 = run * 16, tau0 = t0 & 2047;
#pragma unroll 1
        for (int sp = 0; sp < 2; ++sp) {
            const int ch = 512 * sp + 8 * lane;
            float w0[8], w1[8], w2[8], w3[8], bb[8];
            load8f(F.in[I_CONVW] + ch, w0); load8f(F.in[I_CONVW] + 1024 + ch, w1); load8f(F.in[I_CONVW] + 2048 + ch, w2); load8f(F.in[I_CONVW] + 3072 + ch, w3); load8f(F.in[I_CONVB] + ch, bb);
            float x0[8], x1[8], x2[8];
            if (tau0 >= 3) { unpack8(*(const v4u*)(proj + (size_t)(t0 - 3) * NPROJ + ch), x0); unpack8(*(const v4u*)(proj + (size_t)(t0 - 2) * NPROJ + ch), x1); unpack8(*(const v4u*)(proj + (size_t)(t0 - 1) * NPROJ + ch), x2); }
            else {
#pragma unroll
                for (int i = 0; i < 8; ++i) { x0[i] = 0.f; x1[i] = 0.f; x2[i] = 0.f; } }
#pragma unroll 4
            for (int k = 0; k < 16; ++k) {
                float x3[8], y[8]; unpack8(*(const v4u*)(proj + (size_t)(t0 + k) * NPROJ + ch), x3);
#pragma unroll
                for (int i = 0; i < 8; ++i) { const float a = fmaf(w3[i], x3[i], fmaf(w2[i], x2[i], fmaf(w1[i], x1[i], fmaf(w0[i], x0[i], bb[i])))); y[i] = a * sigm(a); x0[i] = x1[i]; x1[i] = x2[i]; x2[i] = x3[i]; }
                *(v4u*)(mlqk + (size_t)(t0 + k) * 1024 + ch) = pack8f(y);
            }
        }
    }
    for (int i = F.bx * 512 + F.tid; i < 2 * 32 * 2048; i += F.G * 512) { const int kv = i / (32 * 2048), q = i % (32 * 2048), bh = q / 2048, col = q % 2048;
        acmp[(size_t)kv * 4096 * 2048 + (size_t)(bh * 128 + 127) * 2048 + col] = 0; }
    {
        const bf16* memkv = (const bf16*)(ws + WS_MEMKV); bf16* memkn = (bf16*)(ws + WS_MEMKN);
        float kg8[8]; load8f(F.in[I_MGK] + 8 * (lane & 15), kg8);
        for (int r = gw; r < MROWS; r += NGW) {
            float f[8]; unpack8(*(const v4u*)(memkv + (size_t)r * 1024 + 8 * lane), f);
            float ss = 0.f;
#pragma unroll
            for (int i = 0; i < 8; ++i) ss = fmaf(f[i], f[i], ss);
            ss += __shfl_xor(ss, 1); ss += __shfl_xor(ss, 2); ss += __shfl_xor(ss, 4); ss += __shfl_xor(ss, 8);
            const float rstd = rsqrtf(ss * (1.f / 128.f) + EPS);
#pragma unroll
            for (int i = 0; i < 8; ++i) f[i] *= rstd * kg8[i];
            *(v4u*)(memkn + (size_t)r * 512 + 8 * lane) = pack8f(f);
        }
    }
}

DI void p4_kcvc(Frame& F) {
    unsigned char* ws = F.ws;
    const int gw = F.bx * NWAVES + F.wave, NGW = F.G * NWAVES, lane = F.lane;
    const bf16* hid = (const bf16*)(ws + WS_HID);
    const float* rc = (const float*)(ws + WS_SMALL + SM_ROPEC); const float* rs = (const float*)(ws + WS_SMALL + SM_ROPES);
    const float gk = F.in[I_NGK][lane];
    for (int it = gw; it < 2 * 4096; it += NGW) {
        const int kv = it >> 12, r = it & 4095, n = r & 127;
        bf16* dst = (bf16*)(ws + (kv ? WS_VC : WS_KC)) + (size_t)r * 64 + lane;
        if (n == 127) { *dst = 0; continue; }
        const bf16* hr = hid + (size_t)kv * 4096 * 256 + (size_t)r * 256; const float* w2 = F.in[kv ? I_CW2V : I_CW2K];
        float a = 0.f;
        for (int f = 0; f < 256; ++f) a = fmaf(bf2f(hr[f]), w2[f * 64 + lane], a);
        if (kv == 0) {
            const float y = a * rsqrtf(wave_sum(a * a) * (1.f / 64.f) + EPS) * gk;
            const int pos = 16 * n + 31; const float c = rc[pos * 32 + (lane & 31)], s = rs[pos * 32 + (lane & 31)];
            const float pt = __shfl_xor(y, 32);
            a = lane < 32 ? y * c - pt * s : y * c + pt * s;
        }
        *dst = (bf16)f2bf(a);
    }
}

DI void mlstm_unit(Frame& F, int unit) {
    unsigned char* ws = F.ws;
    const int b = unit >> 2, h = unit & 3, tid = F.tid, kk = tid >> 7, c = tid & 127;
    const bf16* proj = (const bf16*)(ws + WS_PROJ); const bf16* mlqk = (const bf16*)(ws + WS_MLQK); bf16* H0 = (bf16*)(ws + WS_H0);
    LAS float* qs = (LAS float*)F.lds;
    LAS float* ks = qs + 16 * 128;
    LAS float* vs = ks + 16 * 128;
    LAS float* gi = vs + 16 * 128;
    LAS float* gf = gi + 16;
    LAS float* part = gf + 16;
    LAS float* pden = part + 2 * 4 * 128;
    LAS float* hb = pden + 8;
    float C[32], nn[32];
#pragma unroll
    for (int i = 0; i < 32; ++i) { C[i] = 0.f; nn[i] = 0.f; }
    float m = 0.f;
    const float bi = F.in[I_MLBI][h], bfv = F.in[I_MLBF][h];
    const float scale = 0.08838834764831845f;
#pragma unroll 1
    for (int t0 = 0; t0 < SEQ; t0 += 16) {
        __syncthreads();
        for (int i = tid; i < 16 * 128; i += 512) { const int s = i >> 7, d = i & 127; const size_t t = (size_t)b * SEQ + t0 + s;
            qs[i] = bf2f(mlqk[t * 1024 + h * 128 + d]); ks[i] = bf2f(mlqk[t * 1024 + 512 + h * 128 + d]); vs[i] = bf2f(proj[t * NPROJ + PC_MLV + h * 128 + d]); }
        if (tid < 16) { const size_t t = (size_t)b * SEQ + t0 + tid; gi[tid] = bf2f(proj[t * NPROJ + PC_MLI + h]) + bi; gf[tid] = logsig(bf2f(proj[t * NPROJ + PC_MLF + h]) + bfv); }
        __syncthreads();
#pragma unroll 1
        for (int s = 0; s < 16; ++s) {
            const float lf = gf[s], ig = gi[s];
            const float mn = fmaxf(lf + m, ig), a = __expf(lf + m - mn), bb = __expf(ig - mn);
            m = mn;
            const float v = vs[s * 128 + c];
            float pn = 0.f, pd = 0.f;
#pragma unroll
            for (int i = 0; i < 32; ++i) { const float kvv = ks[s * 128 + kk * 32 + i], qv = qs[s * 128 + kk * 32 + i];
                C[i] = a * C[i] + bb * kvv * v; nn[i] = a * nn[i] + bb * kvv; pn = fmaf(qv, C[i], pn); pd = fmaf(qv, nn[i], pd); }
            const int par = s & 1;
            part[(par * 4 + kk) * 128 + c] = pn; if (c == 0) pden[par * 4 + kk] = pd;
            __syncthreads();
            if (kk == 0) {
                const float num = (part[(par * 4 + 0) * 128 + c] + part[(par * 4 + 1) * 128 + c]) + (part[(par * 4 + 2) * 128 + c] + part[(par * 4 + 3) * 128 + c]);
                const float den = (pden[par * 4 + 0] + pden[par * 4 + 1]) + (pden[par * 4 + 2] + pden[par * 4 + 3]);
                hb[s * 128 + c] = num * scale / fmaxf(fabsf(den * scale), __expf(-mn));
            }
        }
        __syncthreads();
#pragma unroll
        for (int rr = 0; rr < 2; ++rr) { const int s = F.wave * 2 + rr; const size_t t = (size_t)b * SEQ + t0 + s;
            const float v0 = hb[s * 128 + F.lane], v1 = hb[s * 128 + 64 + F.lane];
            const float rstd = rsqrtf(wave_sum(v0 * v0 + v1 * v1) * (1.f / 128.f) + EPS);
            const float o0 = bf2f(proj[t * NPROJ + PC_MLO + h * 128 + F.lane]), o1 = bf2f(proj[t * NPROJ + PC_MLO + h * 128 + 64 + F.lane]);
            H0[t * 512 + h * 128 + F.lane] = (bf16)f2bf(v0 * rstd * F.in[I_MLGOUT][h * 128 + F.lane] * sigm(o0));
            H0[t * 512 + h * 128 + 64 + F.lane] = (bf16)f2bf(v1 * rstd * F.in[I_MLGOUT][h * 128 + 64 + F.lane] * sigm(o1)); }
    }
    __syncthreads();
}

DI void nsa_scores(const bf16* krow, bool valid, const LAS float* qs, float (&s)[4]) {
    s[0] = s[1] = s[2] = s[3] = 0.f;
    if (valid) {
#pragma unroll 2
        for (int c8 = 0; c8 < 8; ++c8) { const v4u kk = *(const v4u*)(krow + c8 * 8);
            const unsigned w[4] = {kk.x, kk.y, kk.z, kk.w};
#pragma unroll
            for (int j = 0; j < 4; ++j) { const float k0 = __uint_as_float(w[j] << 16), k1 = __uint_as_float(w[j] & 0xffff0000u); const int d = c8 * 8 + 2 * j;
#pragma unroll
                for (int g = 0; g < 4; ++g) s[g] = fmaf(k1, qs[g * 64 + d + 1], fmaf(k0, qs[g * 64 + d], s[g])); } }
    }
}
DI void nsa_wave(Frame& F, int item, LAS float* wl) {
    unsigned char* ws = F.ws; const int lane = F.lane;
    const int t = item >> 1, hkv = item & 1, b = t >> 11, tau = t & 2047;
    const bf16* proj = (const bf16*)(ws + WS_PROJ);
    const bf16* qn = (const bf16*)(ws + WS_QN); const bf16* ksn = (const bf16*)(ws + WS_KSN); const bf16* kwn = (const bf16*)(ws + WS_KWN);
    const bf16* kc = (const bf16*)(ws + WS_KC); const bf16* vc = (const bf16*)(ws + WS_VC); bf16* H1 = (bf16*)(ws + WS_H1);
    LAS float* qs = wl;
    LAS float* ps = wl + 256;
    LAS float* psum = wl + 768;
#pragma unroll
    for (int g = 0; g < 4; ++g) qs[g * 64 + lane] = bf2f(qn[(size_t)t * 512 + (hkv * 4 + g) * 64 + lane]);
    float ofin[4] = {0.f, 0.f, 0.f, 0.f};
    float gate[4][3];
#pragma unroll
    for (int g = 0; g < 4; ++g)
#pragma unroll
        for (int cidx = 0; cidx < 3; ++cidx) gate[g][cidx] = sigm(bf2f(proj[(size_t)t * NPROJ + PC_NG + (hkv * 4 + g) * 3 + cidx]));
    const int ncmp = tau >= 31 ? ((tau - 31) >> 4) + 1 : 0;
    {
        float l[4] = {0.f, 0.f, 0.f, 0.f}, o[4] = {0.f, 0.f, 0.f, 0.f};
        const size_t rbase = (size_t)(b * 2 + hkv) * 128;
#pragma unroll
        for (int blk = 0; blk < 2; ++blk) { const int n = blk * 64 + lane; const bool valid = n < ncmp; float s[4];
            nsa_scores(kc + (rbase + n) * 64, valid, qs, s);
#pragma unroll
            for (int g = 0; g < 4; ++g) { const float p = valid ? __expf(s[g]) : 0.f; l[g] += p; ps[g * 128 + n] = p; } }
        float inv[4];
#pragma unroll
        for (int g = 0; g < 4; ++g) { const float L = wave_sum(l[g]); inv[g] = L > 0.f ? 1.f / L : 0.f; }
#pragma unroll
        for (int blk = 0; blk < 2; ++blk) { const int n = blk * 64 + lane; psum[n] = (ps[0 * 128 + n] * inv[0] + ps[1 * 128 + n] * inv[1]) + (ps[2 * 128 + n] * inv[2] + ps[3 * 128 + n] * inv[3]); }
#pragma unroll 2
        for (int n = 0; n < ncmp; ++n) { const float vv = bf2f(vc[(rbase + n) * 64 + lane]);
#pragma unroll
            for (int g = 0; g < 4; ++g) o[g] = fmaf(ps[g * 128 + n], vv, o[g]); }
#pragma unroll
        for (int g = 0; g < 4; ++g) ofin[g] += gate[g][0] * o[g] * inv[g];
    }
    const int cur = tau >> 6;
    unsigned selmask = 0u;
    {
        float score = -3.0e38f;
        if (lane < 32) { const int j = lane; float imp = 0.f;
#pragma unroll
            for (int dn = -1; dn <= 3; ++dn) { const int n = 4 * j + dn; if (n >= 0 && n <= 126) imp += psum[n]; }
            const bool forced = (j == 0) || (j == cur) || (j == cur - 1);
            score = j > cur ? NEGF : imp + (forced ? 1.0e4f : 0.f); }
#pragma unroll 1
        for (int r = 0; r < 8; ++r) { const float mx = wave_max(score); const unsigned long long bal = __ballot(score == mx); const int win = __ffsll((long long)bal) - 1;
            selmask |= 1u << win; if (lane == win) score = -3.4e38f; }
    }
    {
        float l[4] = {0.f, 0.f, 0.f, 0.f}, o[4] = {0.f, 0.f, 0.f, 0.f};
#pragma unroll 1
        for (int j = 0; j <= cur; ++j) { if (!((selmask >> j) & 1u)) continue;
            const int kpos = 64 * j + lane; const bool valid = kpos <= tau; float s[4];
            nsa_scores(ksn + ((size_t)b * SEQ + kpos) * 128 + hkv * 64, valid, qs, s);
#pragma unroll
            for (int g = 0; g < 4; ++g) { const float p = valid ? __expf(s[g]) : 0.f; l[g] += p; ps[g * 128 + lane] = p; }
            const int nk = j == cur ? (tau & 63) + 1 : 64;
            const bf16* vb = proj + ((size_t)b * SEQ + 64 * j) * NPROJ + PC_NVS + hkv * 64 + lane;
#pragma unroll 2
            for (int k = 0; k < nk; ++k) { const float vv = bf2f(vb[(size_t)k * NPROJ]);
#pragma unroll
                for (int g = 0; g < 4; ++g) o[g] = fmaf(ps[g * 128 + k], vv, o[g]); } }
#pragma unroll
        for (int g = 0; g < 4; ++g) { const float L = wave_sum(l[g]); ofin[g] += gate[g][1] * o[g] * (L > 0.f ? 1.f / L : 0.f); }
    }
    {
        float l[4] = {0.f, 0.f, 0.f, 0.f}, o[4] = {0.f, 0.f, 0.f, 0.f};
        const int start = tau - 511 > 0 ? tau - 511 : 0;
#pragma unroll 1
        for (int base = start & ~63; base <= tau; base += 64) {
            const int kpos = base + lane; const bool valid = kpos >= start && kpos <= tau; float s[4];
            nsa_scores(kwn + ((size_t)b * SEQ + kpos) * 128 + hkv * 64, valid, qs, s);
#pragma unroll
            for (int g = 0; g < 4; ++g) { const float p = valid ? __expf(s[g]) : 0.f; l[g] += p; ps[g * 128 + lane] = p; }
            const int k0 = start > base ? start - base : 0, k1 = tau - base < 63 ? tau - base : 63;
            const bf16* vb = proj + ((size_t)b * SEQ + base) * NPROJ + PC_NVW + hkv * 64 + lane;
#pragma unroll 2
            for (int k = k0; k <= k1; ++k) { const float vv = bf2f(vb[(size_t)k * NPROJ]);
#pragma unroll
                for (int g = 0; g < 4; ++g) o[g] = fmaf(ps[g * 128 + k], vv, o[g]); } }
#pragma unroll
        for (int g = 0; g < 4; ++g) { const float L = wave_sum(l[g]); ofin[g] += gate[g][2] * o[g] * (L > 0.f ? 1.f / L : 0.f); }
    }
#pragma unroll
    for (int g = 0; g < 4; ++g) H1[(size_t)t * 512 + (hkv * 4 + g) * 64 + lane] = (bf16)f2bf(ofin[g]);
}
DI void mem_wave(Frame& F, int t, LAS float* wl) {
    unsigned char* ws = F.ws; const int lane = F.lane; const int b = t >> 11;
    const bf16* mqn = (const bf16*)(ws + WS_MQN); const bf16* memkn = (const bf16*)(ws + WS_MEMKN); const bf16* memkv = (const bf16*)(ws + WS_MEMKV); bf16* H2 = (bf16*)(ws + WS_H2);
    LAS float* qs = wl;
    LAS float* ps = wl + 128;
#pragma unroll 1
    for (int h = 0; h < 4; ++h) {
        qs[lane] = bf2f(mqn[(size_t)t * 512 + h * 128 + lane]); qs[64 + lane] = bf2f(mqn[(size_t)t * 512 + h * 128 + 64 + lane]);
        float l = 0.f;
#pragma unroll 1
        for (int kq = 0; kq < 4; ++kq) { const int key = kq * 64 + lane; const bf16* kr = memkn + ((size_t)b * MEML + key) * 512 + h * 128; float s = 0.f;
#pragma unroll 2
            for (int c8 = 0; c8 < 16; ++c8) { const v4u kk = *(const v4u*)(kr + c8 * 8); const unsigned w[4] = {kk.x, kk.y, kk.z, kk.w};
#pragma unroll
                for (int j = 0; j < 4; ++j) s = fmaf(__uint_as_float(w[j] & 0xffff0000u), qs[c8 * 8 + 2 * j + 1], fmaf(__uint_as_float(w[j] << 16), qs[c8 * 8 + 2 * j], s)); }
            const float p = __expf(s); l += p; ps[key] = p; }
        const float inv = 1.f / wave_sum(l);
        float o0 = 0.f, o1 = 0.f;
        const bf16* vb = memkv + (size_t)b * MEML * 1024 + 512 + h * 128;
#pragma unroll 4
        for (int key = 0; key < MEML; ++key) { const float p = ps[key]; o0 = fmaf(p, bf2f(vb[(size_t)key * 1024 + lane]), o0); o1 = fmaf(p, bf2f(vb[(size_t)key * 1024 + 64 + lane]), o1); }
        H2[(size_t)t * 512 + h * 128 + lane] = (bf16)f2bf(o0 * inv); H2[(size_t)t * 512 + h * 128 + 64 + lane] = (bf16)f2bf(o1 * inv);
    }
}
typedef float f32x16 __attribute__((ext_vector_type(16)));
typedef float f32x2v __attribute__((ext_vector_type(2)));
typedef __bf16 bf16x2v __attribute__((ext_vector_type(2)));
typedef short s16x4 __attribute__((ext_vector_type(4)));
typedef unsigned u32x2 __attribute__((ext_vector_type(2)));
#define MFMA32(a, b, c) __builtin_amdgcn_mfma_f32_32x32x16_bf16((a), (b), (c), 0, 0, 0)
#define WG_BAR() do { asm volatile("s_waitcnt vmcnt(0) lgkmcnt(0)" ::: "memory"); __builtin_amdgcn_s_barrier(); asm volatile("" ::: "memory"); } while (0)
DI unsigned pkbf(float lo, float hi) { f32x2v v = {lo, hi}; return __builtin_bit_cast(unsigned, __builtin_convertvector(v, bf16x2v)); }
template <int S> DI bf16x8 pack8(const f32x16& x) {
    v4u p; p.x = pkbf(x[8 * S], x[8 * S + 1]); p.y = pkbf(x[8 * S + 2], x[8 * S + 3]); p.z = pkbf(x[8 * S + 4], x[8 * S + 5]); p.w = pkbf(x[8 * S + 6], x[8 * S + 7]);
    return __builtin_bit_cast(bf16x8, p);
}
DI int crow(int i, int h) { return (i & 3) + 8 * (i >> 2) + 4 * h; }
constexpr int AT_K = 0, AT_V = 32768, AT_IMP = 65536, AT_WM = 98304, AT_INV = 98368, AT_SC = 99392;

DI void glds16(const void* gsrc, unsigned lds_dst) { unsigned keep; asm volatile("s_mov_b32 %0, m0\n\ts_mov_b32 m0, %2\n\ts_nop 0\n\tglobal_load_lds_dwordx4 %1, off\n\ts_mov_b32 m0, %0" : "=&s"(keep) : "v"(gsrc), "s"(lds_dst) : "memory"); }
DI void at_load(LAS unsigned char* lds, int par, const void* kb, size_t kpitch, const void* vb, size_t vpitch, int wave, int lane) {
    const int row = 8 * wave + (lane >> 3), pc = lane & 7;
    const int kc = pc ^ ((row >> 1) & 7), vc = pc ^ (((row >> 1) & 1) << 2);
    glds16((const char*)kb + (size_t)row * kpitch + 16 * kc, (unsigned)(size_t)(lds + AT_K + par * 8192 + wave * 1024));
    glds16((const char*)vb + (size_t)row * vpitch + 16 * vc, (unsigned)(size_t)(lds + AT_V + par * 8192 + wave * 1024));
}
#define SB() __builtin_amdgcn_sched_barrier(0)
typedef __attribute__((address_space(3))) s16x4 lds_s16x4;
DI void at_qk(const LAS unsigned char* kbuf, const int (&ka)[4], const bf16x8 (&qf)[4], f32x16 (&s)[2]) {
    bf16x8 kf[2][4];
#pragma unroll
    for (int kb = 0; kb < 2; ++kb)
#pragma unroll
        for (int st = 0; st < 4; ++st) kf[kb][st] = *(const LAS bf16x8*)(kbuf + ka[st] + kb * 4096);
    SB();
#pragma unroll
    for (int kb = 0; kb < 2; ++kb) {
        f32x16 a;
#pragma unroll
        for (int i = 0; i < 16; ++i) a[i] = 0.f;
#pragma unroll
        for (int st = 0; st < 4; ++st) a = MFMA32(kf[kb][st], qf[st], a);
        s[kb] = a;
    }
}
DI void at_vload(const LAS unsigned char* vbuf, const int (&va)[2], bf16x8 (&vf)[2][2][2]) {
#pragma unroll
    for (int kb = 0; kb < 2; ++kb)
#pragma unroll
        for (int s2 = 0; s2 < 2; ++s2)
#pragma unroll
            for (int db = 0; db < 2; ++db) {
                const s16x4 lo = __builtin_amdgcn_ds_read_tr16_b64_v4i16((lds_s16x4*)(vbuf + va[db] + kb * 4096 + s2 * 2048));
                const s16x4 hi = __builtin_amdgcn_ds_read_tr16_b64_v4i16((lds_s16x4*)(vbuf + va[db] + kb * 4096 + s2 * 2048 + 1024));
                vf[kb][s2][db] = __builtin_shufflevector(lo, hi, 0, 1, 2, 3, 4, 5, 6, 7); }
}
DI void at_pv(const bf16x8 (&vf)[2][2][2], const f32x16 (&p)[2], f32x16 (&o)[2]) {
#pragma unroll
    for (int kb = 0; kb < 2; ++kb) {
        const bf16x8 pf0 = pack8<0>(p[kb]), pf1 = pack8<1>(p[kb]);
#pragma unroll
        for (int s2 = 0; s2 < 2; ++s2)
#pragma unroll
            for (int db = 0; db < 2; ++db) o[db] = MFMA32(vf[kb][s2][db], s2 ? pf1 : pf0, o[db]);
    }
}

DI void at_wait(int n) {
    if (n >= 2) asm volatile("s_waitcnt vmcnt(4)" ::: "memory"); else if (n == 1) asm volatile("s_waitcnt vmcnt(2)" ::: "memory"); else asm volatile("s_waitcnt vmcnt(0)" ::: "memory");
    asm volatile("s_waitcnt lgkmcnt(0)" ::: "memory"); __builtin_amdgcn_s_barrier(); asm volatile("" ::: "memory");
}
DI void nsa_unit(Frame& F, int unit) {
    unsigned char* ws = F.ws; LAS unsigned char* lds = F.lds;
    int lane_ = F.lane; asm volatile("" : "+v"(lane_));
    const int lane = lane_, wave = F.wave, r = lane & 31, h = lane >> 5, g = wave >> 1, qh = wave & 1;
    const int bh = unit & 31, qt = 31 - (unit >> 5), b = bh >> 1, hkv = bh & 1;
    const int qloc = 32 * qh + r, tau = 64 * qt + qloc, qq = tau & 63; const size_t t = (size_t)b * SEQ + tau;
    const bf16* proj = (const bf16*)(ws + WS_PROJ);
    const bf16* qn = (const bf16*)(ws + WS_QN); const bf16* ksn = (const bf16*)(ws + WS_KSN); const bf16* kwn = (const bf16*)(ws + WS_KWN);
    const bf16* kc = (const bf16*)(ws + WS_KC); const bf16* vc = (const bf16*)(ws + WS_VC); bf16* H1 = (bf16*)(ws + WS_H1);
    int ka[4], va[2];
    { const int f = (r >> 1) & 7, fs = f >> 1, hb = h ^ (f & 1);
#pragma unroll
      for (int st = 0; st < 4; ++st) ka[st] = r * 128 + 16 * (((st ^ fs) << 1) | hb);
      const int i16 = lane & 15, q = i16 >> 2, p = i16 & 3, g1 = (lane >> 4) & 1;
#pragma unroll
      for (int db = 0; db < 2; ++db) va[db] = (4 * h + q) * 128 + 16 * ((4 * db + 2 * g1 + (p >> 1)) ^ (((q >> 1) & 1) << 2)) + 8 * (p & 1); }
    bf16x8 qf[4];
#pragma unroll
    for (int st = 0; st < 4; ++st) qf[st] = *(const bf16x8*)(qn + t * 512 + (hkv * 4 + g) * 64 + 16 * st + 8 * h);
    float gate[3];
#pragma unroll
    for (int c = 0; c < 3; ++c) gate[c] = sigm(bf2f(proj[t * NPROJ + PC_NG + (hkv * 4 + g) * 3 + c]));
    f32x16 ofin[2];
#pragma unroll
    for (int i = 0; i < 16; ++i) { ofin[0][i] = 0.f; ofin[1][i] = 0.f; }
    WG_BAR();
    {
        const int ncq = tau >= 31 ? ((tau - 31) >> 4) + 1 : 0;
        const int ntc = (((64 * qt + 63 - 31) >> 4) + 1 > 64) ? 2 : 1;
        const char* kb0 = (const char*)(kc + (size_t)(b * 2 + hkv) * 128 * 64); const char* vb0 = (const char*)(vc + (size_t)(b * 2 + hkv) * 128 * 64);
        at_load(lds, 0, kb0, 128, vb0, 128, wave, lane);
        if (ntc == 2) at_load(lds, 1, kb0 + 64 * 128, 128, vb0 + 64 * 128, 128, wave, lane);
        WG_BAR();
        f32x16 o[2]; float l = 0.f, prevEp = 0.f;
#pragma unroll
        for (int i = 0; i < 16; ++i) { o[0][i] = 0.f; o[1][i] = 0.f; }
        LAS float* I = (LAS float*)(lds + AT_IMP) + (g * 64 + qloc) * 32;
#pragma unroll 1
        for (int tile = 0; tile < 2; ++tile) {
            if (tile < ntc) {
                f32x16 s[2];
                at_qk(lds + AT_K + tile * 8192, ka, qf, s);
                bf16x8 vf[2][2][2]; at_vload(lds + AT_V + tile * 8192, va, vf); SB();
#pragma unroll
                for (int kb = 0; kb < 2; ++kb)
#pragma unroll
                    for (int i = 0; i < 16; ++i) { const int n = 64 * tile + 32 * kb + crow(i, h); const float p = n < ncq ? __builtin_amdgcn_exp2f(s[kb][i]) : 0.f; s[kb][i] = p; l += p; }
#pragma unroll
                for (int kb = 0; kb < 2; ++kb)
#pragma unroll
                    for (int a = 0; a < 4; ++a) { const int idx = tile * 8 + kb * 4 + a; const float Gv = (s[kb][4 * a] + s[kb][4 * a + 1]) + (s[kb][4 * a + 2] + s[kb][4 * a + 3]);
                        const float Epv = __shfl_xor(s[kb][4 * a + 3], 32);
                        I[2 * idx + h] = Gv + (h ? Epv : prevEp); prevEp = Epv; }
                at_pv(vf, s, o);
            } else {
#pragma unroll
                for (int idx = 8; idx < 16; ++idx) I[2 * idx + h] = 0.f;
            }
        }
        const float L = l + __shfl_xor(l, 32); const float inv = L > 0.f ? 1.f / L : 0.f;
        const float gi = gate[0] * inv;
#pragma unroll
        for (int i = 0; i < 16; ++i) { ofin[0][i] += gi * o[0][i]; ofin[1][i] += gi * o[1][i]; }
        if (h == 0) ((LAS float*)(lds + AT_INV))[g * 64 + qloc] = inv;
    }
    WG_BAR();
    unsigned sel = 0u, wm, um;
    {
        const LAS float* I = (const LAS float*)(lds + AT_IMP) + qloc * 32;
        const LAS float* IV = (const LAS float*)(lds + AT_INV) + qloc;
        const float iv0 = IV[0], iv1 = IV[64], iv2 = IV[128], iv3 = IV[192];
        LAS float* SC = (LAS float*)(lds + AT_SC) + (qh * 32 + r) * 33;
        if (g == 0 && h == 0) {
#pragma unroll 8
            for (int j = 0; j < 32; ++j) { const float imp = (I[j] * iv0 + I[64 * 32 + j] * iv1) + (I[2 * 64 * 32 + j] * iv2 + I[3 * 64 * 32 + j] * iv3);
                const bool forced = (j == 0) || (j == qt) || (j == qt - 1);
                SC[j] = j > qt ? NEGF : imp + (forced ? 1.0e4f : 0.f); }
        }
        WG_BAR();
#pragma unroll 1
        for (int rd = 0; rd < 8; ++rd) { float best = -3.4e38f; int bi = 0;
#pragma unroll 8
            for (int j = 0; j < 32; ++j) { const float v = ((sel >> j) & 1u) ? -3.4e38f : SC[j]; if (v > best) { best = v; bi = j; } }
            sel |= 1u << bi; }
        sel &= (qt == 31) ? 0xffffffffu : ((1u << (qt + 1)) - 1u);
        wm = sel;
#pragma unroll
        for (int o = 1; o < 32; o <<= 1) wm |= (unsigned)__shfl_xor((int)wm, o);
        wm = (unsigned)__builtin_amdgcn_readfirstlane((int)wm);
        if (lane == 0) ((LAS unsigned*)(lds + AT_WM))[wave] = wm;
        WG_BAR();
        um = 0u;
#pragma unroll
        for (int w = 0; w < 8; ++w) um |= ((const LAS unsigned*)(lds + AT_WM))[w];
        um = (unsigned)__builtin_amdgcn_readfirstlane((int)um);
    }
    {
        f32x16 o[2]; float l = 0.f;
#pragma unroll
        for (int i = 0; i < 16; ++i) { o[0][i] = 0.f; o[1][i] = 0.f; }
        const char* kbase = (const char*)(ksn + (size_t)b * SEQ * 128 + hkv * 64); const char* vbase = (const char*)((const bf16*)(ws + WS_VSN) + (size_t)b * SEQ * 128 + hkv * 64);
        unsigned rem = um, im = um; int k = 0; const int T = __popc(um);
#pragma unroll 1
        for (int i = 0; i < 3 && im; ++i) { const int jn = __ffs((int)im) - 1; im &= im - 1u; at_load(lds, i, kbase + (size_t)jn * 64 * 256, 256, vbase + (size_t)jn * 64 * 256, 256, wave, lane); }
#pragma unroll 1
        while (rem) {
            const int j = __ffs((int)rem) - 1; rem &= rem - 1u;
            at_wait(T - k - 1);
            if (im) { const int jn = __ffs((int)im) - 1; im &= im - 1u; at_load(lds, (k + 3) & 3, kbase + (size_t)jn * 64 * 256, 256, vbase + (size_t)jn * 64 * 256, 256, wave, lane); }
            const int par = k & 3;
            if ((wm >> j) & 1u) {
                f32x16 s[2];
                at_qk(lds + AT_K + par * 8192, ka, qf, s);
                bf16x8 vf[2][2][2]; at_vload(lds + AT_V + par * 8192, va, vf); SB();
                const bool on = (sel >> j) & 1u; const int klim = j == qt ? qq : 63;
#pragma unroll
                for (int kb = 0; kb < 2; ++kb)
#pragma unroll
                    for (int i = 0; i < 16; ++i) { const int key = 32 * kb + crow(i, h); const float p = (on && key <= klim) ? __builtin_amdgcn_exp2f(s[kb][i]) : 0.f; s[kb][i] = p; l += p; }
                at_pv(vf, s, o);
            }
            ++k;
        }
        const float L = l + __shfl_xor(l, 32); const float gi = gate[1] * (L > 0.f ? 1.f / L : 0.f);
#pragma unroll
        for (int i = 0; i < 16; ++i) { ofin[0][i] += gi * o[0][i]; ofin[1][i] += gi * o[1][i]; }
    }
    WG_BAR();
    {
        f32x16 o[2]; float l = 0.f;
#pragma unroll
        for (int i = 0; i < 16; ++i) { o[0][i] = 0.f; o[1][i] = 0.f; }
        const char* kbase = (const char*)(kwn + (size_t)b * SEQ * 128 + hkv * 64); const char* vbase = (const char*)((const bf16*)(ws + WS_VWN) + (size_t)b * SEQ * 128 + hkv * 64);
        const int jlo = qt > 8 ? qt - 8 : 0; const int T = qt - jlo + 1;
#pragma unroll 1
        for (int i = 0; i < 3 && i < T; ++i) at_load(lds, i, kbase + (size_t)(jlo + i) * 64 * 256, 256, vbase + (size_t)(jlo + i) * 64 * 256, 256, wave, lane);
#pragma unroll 1
        for (int k = 0; k < T; ++k) {
            const int j = jlo + k, par = k & 3;
            at_wait(T - k - 1);
            if (k + 3 < T) at_load(lds, (k + 3) & 3, kbase + (size_t)(j + 3) * 64 * 256, 256, vbase + (size_t)(j + 3) * 64 * 256, 256, wave, lane);
            f32x16 s[2];
            at_qk(lds + AT_K + par * 8192, ka, qf, s);
            bf16x8 vf[2][2][2]; at_vload(lds + AT_V + par * 8192, va, vf); SB();
            const int klo = (j == qt - 8) ? qq + 1 : 0, khi = (j == qt) ? qq : 63;
#pragma unroll
            for (int kb = 0; kb < 2; ++kb)
#pragma unroll
                for (int i = 0; i < 16; ++i) { const int key = 32 * kb + crow(i, h); const float p = (key >= klo && key <= khi) ? __builtin_amdgcn_exp2f(s[kb][i]) : 0.f; s[kb][i] = p; l += p; }
            at_pv(vf, s, o);
        }
        const float L = l + __shfl_xor(l, 32); const float gi = gate[2] * (L > 0.f ? 1.f / L : 0.f);
#pragma unroll
        for (int i = 0; i < 16; ++i) { ofin[0][i] += gi * o[0][i]; ofin[1][i] += gi * o[1][i]; }
    }
    bf16* orow = H1 + t * 512 + (hkv * 4 + g) * 64;
#pragma unroll
    for (int db = 0; db < 2; ++db)
#pragma unroll
        for (int a = 0; a < 4; ++a) { u32x2 w; w.x = pkbf(ofin[db][4 * a], ofin[db][4 * a + 1]); w.y = pkbf(ofin[db][4 * a + 2], ofin[db][4 * a + 3]); *(u32x2*)(orow + 32 * db + 8 * a + 4 * h) = w; }
}
constexpr int ML_K = 0, ML_V = 32768, ML_VW = 65536, ML_C = 81920, ML_N = 114688, ML_SS = 115200, ML_WS = 116224, ML_GO = 120320;
DI int ml_fk(int s) { return ((s & 3) << 2) | ((s >> 2) & 3); }
DI void ml_load(LAS unsigned char* lds, int par, const char* kb, const char* vb, int wave, int lane) {
#pragma unroll
    for (int n2 = 0; n2 < 2; ++n2) { const int n = 2 * wave + n2, row = 4 * n + (lane >> 4), pc = lane & 15;
        const int kc = pc ^ ml_fk(row), vc = pc ^ ((row & 3) << 2);
        glds16(kb + (size_t)row * 2048 + 16 * kc, (unsigned)(size_t)(lds + ML_K + par * 16384 + n * 1024));
        glds16(vb + (size_t)row * 1024 + 16 * vc, (unsigned)(size_t)(lds + ML_V + par * 16384 + n * 1024)); }
}
DI bf16x8 ml_tr8(const LAS unsigned char* p) {
    const s16x4 lo = __builtin_amdgcn_ds_read_tr16_b64_v4i16((lds_s16x4*)p); const s16x4 hi = __builtin_amdgcn_ds_read_tr16_b64_v4i16((lds_s16x4*)(p + 1024));
    return __builtin_shufflevector(lo, hi, 0, 1, 2, 3, 4, 5, 6, 7);
}
DI void mlstm_unit2(Frame& F, int unit) {
    unsigned char* ws = F.ws; LAS unsigned char* lds = F.lds;
    int lane_ = F.lane; asm volatile("" : "+v"(lane_));
    const int lane = lane_, wave = F.wave, tid = wave * 64 + lane, r = lane & 31, hh = lane >> 5, tb = wave >> 2, vb = wave & 3;
    const int b = unit >> 2, hd = unit & 3;
    const bf16* proj = (const bf16*)(ws + WS_PROJ); const bf16* mlqk = (const bf16*)(ws + WS_MLQK); bf16* H0 = (bf16*)(ws + WS_H0);
    const size_t tok0 = (size_t)b * SEQ;
    const char* kbase = (const char*)(mlqk + tok0 * 1024 + 512 + hd * 128); const char* vbase = (const char*)((const bf16*)(ws + WS_MLV) + tok0 * 512 + hd * 128);
    const float LOG2E = 1.4426950408889634f;
    const int i16 = lane & 15, q4 = i16 >> 2, p4 = i16 & 3, g1 = (lane >> 4) & 1;
    const int colsw = 16 * ((4 * vb + 2 * g1 + (p4 >> 1)) ^ (q4 << 2)) + 8 * (p4 & 1);
    const int base_c = (8 * hh + q4) * 256 + colsw;
    const int base_v = (4 * hh + q4) * 256 + colsw;
    const int fK = ml_fk(r), rowK = r * 256 + ((hh ^ (fK & 1)) << 4), F16 = (fK & 14) << 4;
    int base_kt[2][2];
#pragma unroll
    for (int blk = 0; blk < 2; ++blk)
#pragma unroll
        for (int hi = 0; hi < 2; ++hi) { const int kbp = 2 * tb + blk; base_kt[blk][hi] = (8 * hh + 4 * hi + q4) * 256 + 16 * ((4 * kbp + 2 * g1 + (p4 >> 1)) ^ ((q4 << 2) | ((2 * hh + hi) & 3))) + 8 * (p4 & 1); }
    LAS float* WS = (LAS float*)(lds + ML_WS) + wave * 128;
    LAS float* NV = (LAS float*)(lds + ML_N); LAS float* SS = (LAS float*)(lds + ML_SS);
    __syncthreads();
    for (int i = tid; i < 32768 / 16; i += 512) ((LAS v4u*)(lds + ML_C))[i] = (v4u){0u, 0u, 0u, 0u};
    if (tid < 128) NV[tid] = 0.f;
    f32x16 Cst[2];
#pragma unroll
    for (int i = 0; i < 16; ++i) { Cst[0][i] = 0.f; Cst[1][i] = 0.f; }
    if (tid < 128) ((LAS float*)(lds + ML_GO))[tid] = F.in[I_MLGOUT][hd * 128 + tid];
    const float bi = F.in[I_MLBI][hd], bfv = F.in[I_MLBF][hd];
    float m_prev = 0.f;
    ml_load(lds, 0, kbase, vbase, wave, lane);
    bf16x8 qf[8];
    { const bf16* qp = mlqk + (tok0 + 32 * tb + r) * 1024 + hd * 128 + 8 * hh;
#pragma unroll
      for (int st = 0; st < 8; ++st) qf[st] = *(const bf16x8*)(qp + 16 * st); }
    float gi_raw = bf2f(proj[(tok0 + lane) * NPROJ + PC_MLI + hd]), gf_raw = bf2f(proj[(tok0 + lane) * NPROJ + PC_MLF + hd]);
    u32x2 outw[4]; bf16* outp = nullptr;
#pragma unroll
    for (int a = 0; a < 4; ++a) outw[a] = (u32x2){0u, 0u};
#pragma unroll 1
    for (int c = 0; c < 32; ++c) {
        const int par = c & 1; const size_t tokc = tok0 + 64 * c;
        WG_BAR();
        if (c > 0) {
#pragma unroll
            for (int a = 0; a < 4; ++a) *(u32x2*)(outp + 8 * a) = outw[a]; }
        if (c < 31) ml_load(lds, par ^ 1, kbase + (size_t)(64 * (c + 1)) * 2048, vbase + (size_t)(64 * (c + 1)) * 1024, wave, lane);
        u32x2 og[4];
        { const bf16* op = proj + (tokc + 32 * tb + r) * NPROJ + PC_MLO + hd * 128 + 32 * vb + 4 * hh;
#pragma unroll
          for (int a = 0; a < 4; ++a) og[a] = *(const u32x2*)(op + 8 * a); }
        const float ig = gi_raw + bi, lf = logsig(gf_raw + bfv);
        float bc = lf;
#pragma unroll
        for (int o = 1; o < 64; o <<= 1) { const float v = __shfl_up(bc, o); if (lane >= o) bc += v; }
        const float rr = ig - bc;
        float cm = rr;
#pragma unroll
        for (int o = 1; o < 64; o <<= 1) { const float v = __shfl_up(cm, o); if (lane >= o) cm = fmaxf(cm, v); }
        const float M63 = fmaxf(m_prev, __shfl(cm, 63)), blast = __shfl(bc, 63);
        const float a_old = __expf(m_prev - M63), m_new = blast + M63;
        const int tl = 32 * tb + r;
        const float Mt = fmaxf(m_prev, __shfl(cm, tl)), bt = __shfl(bc, tl);
        const float inter = __expf(m_prev - Mt), m_t = bt + Mt;
        WS[lane] = rr * LOG2E; WS[64 + lane] = __expf(rr - M63);
        const float MtL = Mt * LOG2E;
        const LAS unsigned char* kbuf = lds + ML_K + par * 16384; const LAS unsigned char* vbuf = lds + ML_V + par * 16384;
        f32x16 wd[2]; float dsum = 0.f;
#pragma unroll
        for (int kb = 0; kb < 2; ++kb) {
#pragma unroll
            for (int i = 0; i < 16; ++i) wd[kb][i] = 0.f;
            if (kb <= tb) {
                f32x16 a = wd[kb]; bf16x8 kfr[8];
#pragma unroll
                for (int st = 0; st < 8; ++st) kfr[st] = *(const LAS bf16x8*)(kbuf + kb * 8192 + rowK + ((32 * st) ^ F16));
                SB();
#pragma unroll
                for (int st = 0; st < 8; ++st) a = MFMA32(kfr[st], qf[st], a);
#pragma unroll
                for (int i = 0; i < 16; ++i) { const int s = 32 * kb + crow(i, hh); const float e = __builtin_amdgcn_exp2f(WS[s] - MtL); const float w = (s <= tl) ? e * a[i] : 0.f; a[i] = w; dsum += w; }
                wd[kb] = a;
            }
        }
        f32x16 acc; bf16x8 cfr[8];
#pragma unroll
        for (int i = 0; i < 16; ++i) acc[i] = 0.f;
#pragma unroll
        for (int st = 0; st < 8; ++st) cfr[st] = ml_tr8(lds + ML_C + base_c + st * 4096);
        SB();
#pragma unroll
        for (int st = 0; st < 8; ++st) acc = MFMA32(cfr[st], qf[st], acc);
#pragma unroll
        for (int i = 0; i < 16; ++i) acc[i] *= inter;
#pragma unroll
        for (int kb = 0; kb < 2; ++kb) {
            if (kb <= tb) {
                const bf16x8 pf0 = pack8<0>(wd[kb]), pf1 = pack8<1>(wd[kb]);
                {
#pragma unroll
                  for (int s2 = 0; s2 < 2; ++s2) { const LAS unsigned char* p = vbuf + base_v + kb * 8192 + s2 * 4096;
                    const s16x4 lo = __builtin_amdgcn_ds_read_tr16_b64_v4i16((lds_s16x4*)p); const s16x4 hi = __builtin_amdgcn_ds_read_tr16_b64_v4i16((lds_s16x4*)(p + 2048));
                    const bf16x8 vf = __builtin_shufflevector(lo, hi, 0, 1, 2, 3, 4, 5, 6, 7);
                    acc = MFMA32(vf, s2 ? pf1 : pf0, acc); } }
            }
        }
        float qn_ = 0.f;
#pragma unroll
        for (int st = 0; st < 8; ++st) { const v4u qw = __builtin_bit_cast(v4u, qf[st]); const LAS float* np = NV + 16 * st + 8 * hh; const f32x4 n0 = *(const LAS f32x4*)np, n1 = *(const LAS f32x4*)(np + 4);
            qn_ = fmaf(__uint_as_float(qw.x << 16), n0[0], qn_); qn_ = fmaf(__uint_as_float(qw.x & 0xffff0000u), n0[1], qn_); qn_ = fmaf(__uint_as_float(qw.y << 16), n0[2], qn_); qn_ = fmaf(__uint_as_float(qw.y & 0xffff0000u), n0[3], qn_);
            qn_ = fmaf(__uint_as_float(qw.z << 16), n1[0], qn_); qn_ = fmaf(__uint_as_float(qw.z & 0xffff0000u), n1[1], qn_); qn_ = fmaf(__uint_as_float(qw.w << 16), n1[2], qn_); qn_ = fmaf(__uint_as_float(qw.w & 0xffff0000u), n1[3], qn_); }
        qn_ += __shfl_xor(qn_, 32); dsum += __shfl_xor(dsum, 32);
        const float den = inter * qn_ + dsum; const float rden = 1.f / fmaxf(fabsf(den), __expf(-m_t));
        float ssq = 0.f;
#pragma unroll
        for (int i = 0; i < 16; ++i) { acc[i] *= rden; ssq = fmaf(acc[i], acc[i], ssq); }
        ssq += __shfl_xor(ssq, 32);
        if (hh == 0) SS[vb * 64 + tl] = ssq;
#pragma unroll
        for (int k2 = 0; k2 < 2; ++k2) { const int ci = tid + 512 * k2, s = ci >> 4; const float w = WS[64 + s];
            const v4u x = *(const LAS v4u*)(vbuf + ci * 16); v4u y; const unsigned xs[4] = {x.x, x.y, x.z, x.w}; unsigned ys[4];
#pragma unroll
            for (int j = 0; j < 4; ++j) ys[j] = pkbf(__uint_as_float(xs[j] << 16) * w, __uint_as_float(xs[j] & 0xffff0000u) * w);
            y.x = ys[0]; y.y = ys[1]; y.z = ys[2]; y.w = ys[3]; *(LAS v4u*)(lds + ML_VW + ci * 16) = y; }
        asm volatile("s_waitcnt lgkmcnt(0)" ::: "memory"); __builtin_amdgcn_s_barrier(); asm volatile("" ::: "memory");
        if (c < 31) {
            const bf16* qp = mlqk + (tokc + 64 + 32 * tb + r) * 1024 + hd * 128 + 8 * hh;
#pragma unroll
            for (int st = 0; st < 8; ++st) qf[st] = *(const bf16x8*)(qp + 16 * st);
            gi_raw = bf2f(proj[(tokc + 64 + lane) * NPROJ + PC_MLI + hd]); gf_raw = bf2f(proj[(tokc + 64 + lane) * NPROJ + PC_MLF + hd]);
        }
        { const LAS float* GO = (const LAS float*)(lds + ML_GO) + 32 * vb + 4 * hh;
          const float rstd = rsqrtf(((SS[tl] + SS[64 + tl]) + (SS[128 + tl] + SS[192 + tl])) * (1.f / 128.f) + EPS);
          bf16* orow = H0 + (tokc + tl) * 512 + hd * 128 + 32 * vb + 4 * hh;
#pragma unroll
          for (int a = 0; a < 4; ++a) { float o4[4]; const unsigned gw[2] = {og[a].x, og[a].y};
#pragma unroll
              for (int j = 0; j < 4; ++j) { const float ov = (j & 1) ? __uint_as_float(gw[j >> 1] & 0xffff0000u) : __uint_as_float(gw[j >> 1] << 16); o4[j] = acc[4 * a + j] * rstd * GO[8 * a + j] * sigm(ov); }
              outw[a].x = pkbf(o4[0], o4[1]); outw[a].y = pkbf(o4[2], o4[3]); }
          outp = orow; }
#pragma unroll
        for (int blk = 0; blk < 2; ++blk) {
            f32x16 cs = Cst[blk];
#pragma unroll
            for (int i = 0; i < 16; ++i) cs[i] *= a_old;
            bf16x8 afr[4], kfr2[4];
#pragma unroll
            for (int st = 0; st < 4; ++st) {
                afr[st] = ml_tr8(lds + ML_VW + base_c + st * 4096);
                const s16x4 lo = __builtin_amdgcn_ds_read_tr16_b64_v4i16((lds_s16x4*)(kbuf + base_kt[blk][0] + st * 4096)); const s16x4 hi = __builtin_amdgcn_ds_read_tr16_b64_v4i16((lds_s16x4*)(kbuf + base_kt[blk][1] + st * 4096));
                kfr2[st] = __builtin_shufflevector(lo, hi, 0, 1, 2, 3, 4, 5, 6, 7);
            }
            SB();
#pragma unroll
            for (int st = 0; st < 4; ++st) cs = MFMA32(afr[st], kfr2[st], cs);
            Cst[blk] = cs;
            const int kk = 32 * (2 * tb + blk) + r;
#pragma unroll
            for (int a = 0; a < 4; ++a) { u32x2 w; w.x = pkbf(cs[4 * a], cs[4 * a + 1]); w.y = pkbf(cs[4 * a + 2], cs[4 * a + 3]);
                *(LAS u32x2*)(lds + ML_C + kk * 256 + 16 * ((4 * vb + a) ^ ((r & 3) << 2)) + 8 * hh) = w; }
        }
        if (tid < 128) { float nv = NV[tid] * a_old;
#pragma unroll 8
            for (int s = 0; s < 64; ++s) { const unsigned short kvs = *(const LAS unsigned short*)(kbuf + s * 256 + 16 * ((tid >> 3) ^ ml_fk(s)) + 2 * (tid & 7)); nv = fmaf(WS[64 + s], bf2f(kvs), nv); }
            NV[tid] = nv; }
        m_prev = m_new;
    }
#pragma unroll
    for (int a = 0; a < 4; ++a) *(u32x2*)(outp + 8 * a) = outw[a];
    __syncthreads();
}
DI void mem_load(LAS unsigned char* lds, int par, const char* kb, const char* vb, int wave, int lane) {
#pragma unroll
    for (int n2 = 0; n2 < 2; ++n2) { const int n = 2 * wave + n2, row = 4 * n + (lane >> 4), pc = lane & 15;
        const int kc = pc ^ ml_fk(row), vc = pc ^ ((row & 3) << 2);
        glds16(kb + (size_t)row * 1024 + 16 * kc, (unsigned)(size_t)(lds + ML_K + par * 16384 + n * 1024));
        glds16(vb + (size_t)row * 2048 + 16 * vc, (unsigned)(size_t)(lds + ML_V + par * 16384 + n * 1024)); }
}
DI void mem_unit(Frame& F, int unit) {
    unsigned char* ws = F.ws; LAS unsigned char* lds = F.lds;
    int lane_ = F.lane; asm volatile("" : "+v"(lane_));
    const int lane = lane_, wave = F.wave, r = lane & 31, hh = lane >> 5;
    const int b = unit >> 5, hd = (unit >> 3) & 3, qt = unit & 7;
    const bf16* mqn = (const bf16*)(ws + WS_MQN); const bf16* memkn = (const bf16*)(ws + WS_MEMKN); const bf16* memkv = (const bf16*)(ws + WS_MEMKV); bf16* H2 = (bf16*)(ws + WS_H2);
    const size_t t = (size_t)b * SEQ + 256 * qt + 32 * wave + r;
    const char* kbase = (const char*)(memkn + (size_t)b * MEML * 512 + hd * 128); const char* vbase = (const char*)(memkv + (size_t)b * MEML * 1024 + 512 + hd * 128);
    const int i16 = lane & 15, q4 = i16 >> 2, p4 = i16 & 3, g1 = (lane >> 4) & 1;
    int base_v[4];
#pragma unroll
    for (int db = 0; db < 4; ++db) base_v[db] = (4 * hh + q4) * 256 + 16 * ((4 * db + 2 * g1 + (p4 >> 1)) ^ (q4 << 2)) + 8 * (p4 & 1);
    const int fK = ml_fk(r), rowK = r * 256 + ((hh ^ (fK & 1)) << 4), F16 = (fK & 14) << 4;
    bf16x8 qf[8];
#pragma unroll
    for (int st = 0; st < 8; ++st) qf[st] = *(const bf16x8*)(mqn + t * 512 + hd * 128 + 16 * st + 8 * hh);
    f32x16 o[4]; float l = 0.f;
#pragma unroll
    for (int db = 0; db < 4; ++db)
#pragma unroll
        for (int i = 0; i < 16; ++i) o[db][i] = 0.f;
    WG_BAR();
    mem_load(lds, 0, kbase, vbase, wave, lane);
#pragma unroll 1
    for (int tile = 0; tile < 4; ++tile) {
        const int par = tile & 1;
        WG_BAR();
        if (tile < 3) mem_load(lds, par ^ 1, kbase + (size_t)(64 * (tile + 1)) * 1024, vbase + (size_t)(64 * (tile + 1)) * 2048, wave, lane);
        const LAS unsigned char* kbuf = lds + ML_K + par * 16384; const LAS unsigned char* vbuf = lds + ML_V + par * 16384;
#pragma unroll
        for (int kb = 0; kb < 2; ++kb) {
            bf16x8 kf[8];
#pragma unroll
            for (int st = 0; st < 8; ++st) kf[st] = *(const LAS bf16x8*)(kbuf + kb * 8192 + rowK + ((32 * st) ^ F16));
            SB();
            f32x16 a;
#pragma unroll
            for (int i = 0; i < 16; ++i) a[i] = 0.f;
#pragma unroll
            for (int st = 0; st < 8; ++st) a = MFMA32(kf[st], qf[st], a);
            bf16x8 vf[2][4];
#pragma unroll
            for (int s2 = 0; s2 < 2; ++s2)
#pragma unroll
                for (int db = 0; db < 4; ++db) { const LAS unsigned char* p = vbuf + base_v[db] + kb * 8192 + s2 * 4096;
                    const s16x4 lo = __builtin_amdgcn_ds_read_tr16_b64_v4i16((lds_s16x4*)p); const s16x4 hi = __builtin_amdgcn_ds_read_tr16_b64_v4i16((lds_s16x4*)(p + 2048));
                    vf[s2][db] = __builtin_shufflevector(lo, hi, 0, 1, 2, 3, 4, 5, 6, 7); }
            SB();
#pragma unroll
            for (int i = 0; i < 16; ++i) { a[i] = __builtin_amdgcn_exp2f(a[i]); l += a[i]; }
            const bf16x8 pf0 = pack8<0>(a), pf1 = pack8<1>(a);
#pragma unroll
            for (int s2 = 0; s2 < 2; ++s2)
#pragma unroll
                for (int db = 0; db < 4; ++db) o[db] = MFMA32(vf[s2][db], s2 ? pf1 : pf0, o[db]);
        }
    }
    const float inv = 1.f / (l + __shfl_xor(l, 32));
    bf16* orow = H2 + t * 512 + hd * 128 + 4 * hh;
#pragma unroll
    for (int db = 0; db < 4; ++db)
#pragma unroll
        for (int a = 0; a < 4; ++a) { u32x2 w; w.x = pkbf(o[db][4 * a] * inv, o[db][4 * a + 1] * inv); w.y = pkbf(o[db][4 * a + 2] * inv, o[db][4 * a + 3] * inv); *(u32x2*)(orow + 32 * db + 8 * a) = w; }
}
DI int q_pop(Frame& F, unsigned* qc) {
    __syncthreads();
    if (F.tid == 0) F.MISC[16] = atomicAdd(qc, 1u);
    __syncthreads();
    return (int)F.MISC[16];
}
template <bool ML, bool NSA, bool MEMA>
DI void p5_queue(Frame& F, int cbase) {
    unsigned* qc = F.ctl + CW_QCTR + cbase;
    if (ML) {
#pragma unroll 1
        for (;;) { const int it = q_pop(F, qc); if (it >= 64) break; mlstm_unit2(F, it); }
    }
    if (NSA) {
#pragma unroll 1
        for (;;) { const int it = q_pop(F, qc + 64); if (it >= 1024) break; nsa_unit(F, it); }
    }
    if (MEMA) {
#pragma unroll 1
        for (;;) { const int it = q_pop(F, qc + 128); if (it >= 512) break; mem_unit(F, it); }
    }
    __syncthreads();
}
DI void p5_mixers(Frame& F) {
    const int nml = F.G >= 128 ? 64 : 0;
#ifndef RPT_ML
#define RPT_ML 1
#endif
#ifndef RPT_NSA
#define RPT_NSA 1
#endif
#ifndef RPT_MEM
#define RPT_MEM 1
#endif
    if (F.bx < nml || nml == 0) { for (int rp = 0; rp < RPT_ML; ++rp) for (int u = F.bx; u < 64; u += (nml ? nml : F.G)) mlstm_unit2(F, u); }
    if (F.bx >= nml) {
        LAS float* wl = (LAS float*)(F.lds + F.wave * 4096);
        const int gw = (F.bx - nml) * NWAVES + F.wave, NGW = (F.G - nml) * NWAVES;
        for (int rp = 0; rp < RPT_NSA; ++rp) for (int u = F.bx - nml; u < 1024; u += F.G - nml) nsa_unit(F, u);
        __syncthreads();
        for (int rp = 0; rp < RPT_MEM; ++rp) for (int t = gw; t < MT; t += NGW) mem_wave(F, t, wl);
    }
}

DI void p8_router(Frame& F, int alt) {
    unsigned char* ws = F.ws + (size_t)alt * 3 * MiB; const int lane = F.lane, tid = F.tid, wave = F.wave, r = lane & 31, hh = lane >> 5;
    unsigned char* xn8 = (unsigned char*)(F.ws + WS_R1);
    int* tok_e = (int*)(ws + WS_ROUTE + RT_TOKE); int* tok_pos = (int*)(ws + WS_ROUTE + RT_TOKPOS); float* tok_w = (float*)(ws + WS_ROUTE + RT_TOKW);
    unsigned* gcnt = F.ctl + CW_ECNT + 64 * alt;
    const bf16* wrt = (const bf16*)(F.ws + WS_SMALL + SM_WRT);
    LAS unsigned char* img = F.lds;
    LAS float* part = (LAS float*)F.lds;
    LAS float* lg = (LAS float*)(F.lds + 4 * 64 * 33 * 4);
    LAS int* lcnt = (LAS int*)(F.lds + RING_BYTES + 1024);
    LAS int* lbase = lcnt + 32;
    LAS int* se = lbase + 32;
    LAS int* sp = se + 256;
    LAS float* sw = (LAS float*)(sp + 256);
    const float* gf = F.in[I_GFFN];
    for (int bt = F.bx; bt < MT / 64; bt += F.G) {
        __syncthreads();
        if (tid < 32) lcnt[tid] = 0;
#pragma unroll 2
        for (int i = 0; i < 8; ++i) {
            const int tl = wave * 8 + i, t = bt * 64 + tl;
            const f32x4* xr = (const f32x4*)(F.out + (size_t)t * DM) + lane; const f32x4* gr = (const f32x4*)gf + lane;
            f32x4 v[4]; float s = 0.f;
#pragma unroll
            for (int j = 0; j < 4; ++j) { v[j] = xr[64 * j]; s += (v[j].x * v[j].x + v[j].y * v[j].y) + (v[j].z * v[j].z + v[j].w * v[j].w); }
            const float rstd = rsqrtf(wave_sum(s) * (1.f / DM) + EPS);
            unsigned* o4 = (unsigned*)(xn8 + (size_t)t * DM) + lane;
#pragma unroll
            for (int j = 0; j < 4; ++j) { const f32x4 gg = gr[64 * j];
                const float y0 = v[j].x * rstd * gg.x, y1 = v[j].y * rstd * gg.y, y2 = v[j].z * rstd * gg.z, y3 = v[j].w * rstd * gg.w;
                const unsigned long long w = (unsigned long long)pk2(y0, y1) | ((unsigned long long)pk2(y2, y3) << 32);
                int q8 = 0; q8 = __builtin_amdgcn_cvt_pk_fp8_f32(y0, y1, q8, false); q8 = __builtin_amdgcn_cvt_pk_fp8_f32(y2, y3, q8, true);
                o4[64 * j] = (unsigned)q8;
                const int d = 4 * lane + 256 * j, ch = d >> 3;
                *(LAS unsigned long long*)(img + tl * 2048 + 16 * (ch ^ (tl & 15)) + 2 * (d & 7)) = w; }
        }
        __syncthreads();
        {
            const int mb = wave & 1, kq = wave >> 1, trow = 32 * mb + r;
            f32x16 acc;
#pragma unroll
            for (int i = 0; i < 16; ++i) acc[i] = 0.f;
#pragma unroll 4
            for (int s2 = 0; s2 < 16; ++s2) { const int st = 16 * kq + s2;
                const bf16x8 xa = *(const LAS bf16x8*)(img + trow * 2048 + 16 * ((2 * st + hh) ^ (trow & 15)));
                const bf16x8 wh = *(const bf16x8*)(wrt + (size_t)r * 1024 + 16 * st + 8 * hh), wl = *(const bf16x8*)(wrt + 32 * 1024 + (size_t)r * 1024 + 16 * st + 8 * hh);
                acc = MFMA32(xa, wh, acc); acc = MFMA32(xa, wl, acc); }
            __syncthreads();
#pragma unroll
            for (int i = 0; i < 16; ++i) part[(kq * 64 + 32 * mb + crow(i, hh)) * 33 + r] = acc[i];
        }
        __syncthreads();
        for (int i = tid; i < 64 * 32; i += 512) { const int tk = i >> 5, e = i & 31; lg[tk * 33 + e] = ((part[(0 * 64 + tk) * 33 + e] + part[(1 * 64 + tk) * 33 + e]) + (part[(2 * 64 + tk) * 33 + e] + part[(3 * 64 + tk) * 33 + e])) + F.in[I_BR][e]; }
        __syncthreads();
        for (int i = 0; i < 8; ++i) {
            const int tl = wave * 8 + i, e = lane & 31;
            float sc = lg[tl * 33 + e]; int ek[4]; float vk[4];
#pragma unroll
            for (int rd = 0; rd < 4; ++rd) { const float mx = wave_max(sc); const unsigned long long bal = __ballot(sc == mx); const int win = (__ffsll((long long)bal) - 1) & 31;
                ek[rd] = win; vk[rd] = mx; if (e == win) sc = -3.4e38f; }
            const float e1 = __expf(vk[1] - vk[0]), e2 = __expf(vk[2] - vk[0]), e3 = __expf(vk[3] - vk[0]); const float inv = 1.f / (1.f + e1 + e2 + e3);
            if (lane == 0) {
                const float wk[4] = {inv, e1 * inv, e2 * inv, e3 * inv};
#pragma unroll
                for (int rd = 0; rd < 4; ++rd) { se[tl * 4 + rd] = ek[rd]; sw[tl * 4 + rd] = wk[rd]; sp[tl * 4 + rd] = atomicAdd((int*)&lcnt[ek[rd]], 1); }
            }
        }
        __syncthreads();
        if (tid < 32) lbase[tid] = (int)atomicAdd(&gcnt[tid], (unsigned)lcnt[tid]);
        __syncthreads();
        if (tid < 256) { const int t = bt * 64 + (tid >> 2), k = tid & 3; const int e = se[tid];
          tok_e[t * 4 + k] = e; tok_pos[t * 4 + k] = lbase[e] + sp[tid]; tok_w[t * 4 + k] = sw[tid]; }
    }
    __syncthreads();
}
DI int moe_tables(Frame& F, LAS int* pstart, LAS unsigned char* blk_e) {
    unsigned* gcnt = F.ctl + CW_ECNT;
    __syncthreads();
    if (F.tid == 0) { int acc = 0; for (int e = 0; e < NEXP; ++e) { const int cnt = (int)__hip_atomic_load(&gcnt[e], __ATOMIC_RELAXED, __HIP_MEMORY_SCOPE_AGENT); pstart[e] = acc; acc += (cnt + MOEB - 1) / MOEB * MOEB; } pstart[NEXP] = acc; }
    __syncthreads();
    const int nblk = pstart[NEXP] / MOEB;
    for (int rb = F.tid; rb < nblk; rb += 512) { int e = 0; while (e < NEXP - 1 && pstart[e + 1] <= rb * MOEB) ++e; blk_e[rb] = (unsigned char)e; }
    __syncthreads();
    return nblk;
}
DI void p9_scatter(Frame& F) {
    unsigned char* ws = F.ws; const int lane = F.lane;
    LAS int* pstart = (LAS int*)(F.lds + 65536); LAS unsigned char* blk_e = (LAS unsigned char*)(F.lds + 65536 + 256);
    moe_tables(F, pstart, blk_e);
    const unsigned char* xn8 = (const unsigned char*)(ws + WS_R1); unsigned char* aperm = (unsigned char*)(ws + WS_APERM);
    const int* tok_e = (const int*)(ws + WS_ROUTE + RT_TOKE); const int* tok_pos = (const int*)(ws + WS_ROUTE + RT_TOKPOS); const float* tok_w = (const float*)(ws + WS_ROUTE + RT_TOKW);
    int* tok_dest = (int*)(ws + WS_ROUTE + RT_TOKDEST); float* roww = (float*)(ws + WS_ROUTE + RT_ROWW);
    unsigned* gcnt = F.ctl + CW_ECNT;
    const int gw = F.bx * NWAVES + F.wave, NGW = F.G * NWAVES;
    for (int t4 = gw; t4 < MT / 4; t4 += NGW) {
        int dest = 0;
        if (lane < 16) { const int it = t4 * 16 + lane; dest = pstart[tok_e[it]] + tok_pos[it]; tok_dest[it] = dest; roww[dest] = tok_w[it]; }
        v4u v0[4];
#pragma unroll
        for (int q = 0; q < 4; ++q) { const v4u* src = (const v4u*)(xn8 + (size_t)(t4 * 4 + q) * DM); v0[q] = src[lane]; }
#pragma unroll
        for (int q = 0; q < 4; ++q)
#pragma unroll
            for (int k = 0; k < 4; ++k) { const int d = __shfl(dest, q * 4 + k); v4u* dst = (v4u*)(aperm + (size_t)d * DM); dst[lane] = v0[q]; }
    }
    for (int it = gw; it < NEXP * MOEB; it += NGW) { const int e = it >> 8, i = it & 255; const int cnt = (int)__hip_atomic_load(&gcnt[e], __ATOMIC_RELAXED, __HIP_MEMORY_SCOPE_AGENT); const int padded = (cnt + MOEB - 1) / MOEB * MOEB;
        if (i < padded - cnt) { const int dest = pstart[e] + cnt + i; v4u* dst = (v4u*)(aperm + (size_t)dest * DM); const v4u z = {0u, 0u, 0u, 0u}; dst[lane] = z; if (lane == 0) roww[dest] = 0.f; } }
}
DI void p12_combine(Frame& F) {
    unsigned char* ws = F.ws; const int lane = F.lane;
    const bf16* ybuf = (const bf16*)(ws + WS_APERM); const int* tok_dest = (const int*)(ws + WS_ROUTE + RT_TOKDEST);
    const int gw = F.bx * NWAVES + F.wave, NGW = F.G * NWAVES;
    for (int t2 = gw; t2 < MT / 2; t2 += NGW) {
        typedef int i32x4 __attribute__((ext_vector_type(4)));
        unsigned long long w[2][4][4]; f32x4 a[2][4];
#pragma unroll
        for (int q = 0; q < 2; ++q) { const int t = 2 * t2 + q; const f32x4* orow = (const f32x4*)(F.out + (size_t)t * DM);
            const i32x4 d = *(const i32x4*)(tok_dest + t * 4);
            const unsigned long long* y0 = (const unsigned long long*)(ybuf + (size_t)d.x * DM) + lane; const unsigned long long* y1 = (const unsigned long long*)(ybuf + (size_t)d.y * DM) + lane;
            const unsigned long long* y2 = (const unsigned long long*)(ybuf + (size_t)d.z * DM) + lane; const unsigned long long* y3 = (const unsigned long long*)(ybuf + (size_t)d.w * DM) + lane;
#pragma unroll
            for (int j = 0; j < 4; ++j) { w[q][0][j] = y0[64 * j]; w[q][1][j] = y1[64 * j]; w[q][2][j] = y2[64 * j]; w[q][3][j] = y3[64 * j]; a[q][j] = orow[lane + 64 * j]; } }
#pragma unroll
        for (int q = 0; q < 2; ++q) { f32x4* orow = (f32x4*)(F.out + (size_t)(2 * t2 + q) * DM);
#pragma unroll
            for (int j = 0; j < 4; ++j) {
#pragma unroll
                for (int k = 0; k < 4; ++k) { const unsigned long long ww = w[q][k][j];
                    a[q][j].x += __uint_as_float((unsigned)ww << 16); a[q][j].y += __uint_as_float((unsigned)ww & 0xffff0000u); a[q][j].z += __uint_as_float((unsigned)(ww >> 32) << 16); a[q][j].w += __uint_as_float((unsigned)(ww >> 32) & 0xffff0000u); }
                orow[lane + 64 * j] = a[q][j]; } }
    }
}

constexpr int N_PHASES = 13;
#ifndef MK_PER_PHASE
#define MK_PER_PHASE 0
#endif
__global__ void __launch_bounds__(NWAVES * 64, 2) fwd_kernel(Args args) {
    extern __shared__ __attribute__((aligned(16))) unsigned char lds_raw[];
    Frame F;
    F.lds = (LAS unsigned char*)lds_raw; F.MISC = (volatile LAS unsigned*)(F.lds + MISC_OFF);
    F.tid = threadIdx.x; F.lane = F.tid & 63; F.wave = __builtin_amdgcn_readfirstlane(F.tid >> 6); F.G = gridDim.x; F.bx = blockIdx.x;
    F.ws = args.ws; F.ctl = (unsigned*)(args.ws + WS_CTL); F.in = args.in; F.out = args.out;
    unsigned char* ws = args.ws;
    for (int u = F.tid; u < (LDS_BYTES - LDSCTL_OFF) / 4; u += NWAVES * 64) ((LAS unsigned*)(F.lds + LDSCTL_OFF))[u] = 0u;
    __syncthreads();
    const int lo = args.ph_lo, hi = args.ph_hi;
    XcdBarrier bar; bar.bar = F.ctl + CW_BAR; bar.x = 0; bar.st = nullptr;
    if (hi - lo > 1) bar = xcd_barrier_post(F.ctl + CW_BAR, F.MISC + 8);
#ifndef PH_MASK
#define PH_MASK 0x1fff
#endif
#define IN(k) (((PH_MASK >> (k)) & 1) && lo <= (k) && (k) < hi)
#define SEAM(k) do { if (IN(k) && IN((k) + 1)) xcd_barrier(bar); } while (0)
    typedef pg8::bf16_t b16;
#ifndef RPT_MASK
#define RPT_MASK 0
#endif
#define RPT(k) _Pragma("unroll") for (int rp_ = 0; rp_ < 1 + ((RPT_MASK >> (k)) & 1); ++rp_)
    if (IN(0)) { RPT(0) p0_prologue(F); } SEAM(0);
    if (IN(1)) RPT(1) {
        { pg8::Gemm g{(const b16*)(ws + WS_R1), (const b16*)(ws + WS_WIN), MT, NPROJ, DM}; pg8::StaticOrder S; S.init(MT, NPROJ, F.G, F.bx);
          pg8::EpiBf16Silu E{(b16*)(ws + WS_PROJ), NPROJ, nullptr, 0};
          pg8::gemm_phase<pg8::EpiBf16Silu, pg8::StaticOrder, true, true>(F.lds, g, S, E); }
        { pg8::Gemm g{(const b16*)(ws + WS_MEMN), (const b16*)(ws + WS_WMKV), MROWS, 1024, DM}; pg8::StaticOrder S; S.init(MROWS, 1024, F.G, (F.bx + 64) % F.G);
          pg8::EpiBf16Silu E{(b16*)(ws + WS_MEMKV), 1024, nullptr, 0};
          pg8::gemm_phase<pg8::EpiBf16Silu, pg8::StaticOrder, true, true>(F.lds, g, S, E); }
    } SEAM(1);
    if (IN(2)) { RPT(2) p2_prep(F); } SEAM(2);
    if (IN(3)) RPT(3) {
#pragma unroll
        for (int kv = 0; kv < 2; ++kv) {
            pg8::Gemm g{(const b16*)(ws + WS_ACMP) + (size_t)kv * 4096 * 2048, (const b16*)(ws + WS_WC1) + (size_t)kv * 256 * 2048, 4096, 256, 2048}; pg8::StaticOrder S; S.init(4096, 256, F.G, (F.bx + F.G - 16 * kv) % F.G);
            pg8::EpiBf16Silu E{(b16*)(ws + WS_HID) + (size_t)kv * 4096 * 256, 256, (const float*)(ws + WS_SMALL + SM_CBIAS) + kv * 256, 1};
            pg8::gemm_phase<pg8::EpiBf16Silu, pg8::StaticOrder, true, true>(F.lds, g, S, E); }
    } SEAM(3);
    if (IN(4)) { RPT(4) p4_kcvc(F); } SEAM(4);
#ifndef RPT5_ML
#define RPT5_ML 0
#endif
#ifndef RPT5_NSA
#define RPT5_NSA 0
#endif
#ifndef RPT5_MEM
#define RPT5_MEM 0
#endif
    if (IN(5)) { p5_queue<true, true, true>(F, 0);
        if (RPT5_ML || RPT5_NSA || RPT5_MEM) { xcd_barrier(bar); p5_queue<RPT5_ML != 0, RPT5_NSA != 0, RPT5_MEM != 0>(F, 256); } } SEAM(5);
    if (IN(6)) RPT(6) {
        pg8::StaticOrder S; S.init(MT, DM, F.G, F.bx);
        { pg8::Gemm g{(const b16*)(ws + WS_H0), (const b16*)(ws + WS_WBR), MT, DM, 512}; pg8::EpiGate<0> E{(const b16*)(ws + WS_PROJ), F.out, (b16*)(ws + WS_R1)};
          pg8::gemm_phase<pg8::EpiGate<0>, pg8::StaticOrder, true, true>(F.lds, g, S, E); }
        { pg8::Gemm g{(const b16*)(ws + WS_H1), (const b16*)(ws + WS_WBR) + 1024 * 512, MT, DM, 512}; pg8::EpiGate<1> E{(const b16*)(ws + WS_PROJ), F.out, (b16*)(ws + WS_R1)};
          pg8::gemm_phase<pg8::EpiGate<1>, pg8::StaticOrder, true, true>(F.lds, g, S, E); }
        { pg8::Gemm g{(const b16*)(ws + WS_H2), (const b16*)(ws + WS_WBR) + 2 * 1024 * 512, MT, DM, 512}; pg8::EpiGate<2> E{(const b16*)(ws + WS_PROJ), F.out, (b16*)(ws + WS_R1)};
          pg8::gemm_phase<pg8::EpiGate<2>, pg8::StaticOrder, true, true>(F.lds, g, S, E); }
    } SEAM(6);
    if (IN(7)) RPT(7) {
        pg8::Gemm g{(const b16*)(ws + WS_R1), (const b16*)(ws + WS_WOUT), MT, DM, DM}; pg8::StaticOrder S; S.init(MT, DM, F.G, F.bx);
        pg8::EpiRes E{F.in[I_X], F.out};
        pg8::gemm_phase<pg8::EpiRes, pg8::StaticOrder, true, true>(F.lds, g, S, E);
    } SEAM(7);
    if (IN(8)) { p8_router(F, 0); if ((RPT_MASK >> 8) & 1) p8_router(F, 1); } SEAM(8);
    if (IN(9)) { RPT(9) p9_scatter(F); } SEAM(9);
    if (IN(10)) RPT(10) {
        LAS int* pstart = (LAS int*)(F.lds + RING_BYTES + 1024); LAS unsigned char* blk_e = (LAS unsigned char*)(F.lds + RING_BYTES + 1024 + 256);
        const int nblk = moe_tables(F, pstart, blk_e);
        pg8::Gemm8 g{(const unsigned char*)(ws + WS_APERM), (const unsigned char*)(ws + WS_WGU), CAP, NEXP * 2048, DM, 0x7f7f7f7f, 0x77777777};
        pg8::MoeOrder<8> S{nblk, F.G, F.bx, (const PG8_LAS unsigned char*)blk_e};
        pg8::EpiSwiglu E{(unsigned char*)(ws + WS_ACT), F.in[I_BGU]};
        pg8::gemm_phase_f8<pg8::EpiSwiglu, pg8::MoeOrder<8>, true, true>(F.lds, g, S, E);
    } SEAM(10);
    if (IN(11)) RPT(11) {
        LAS int* pstart = (LAS int*)(F.lds + RING_BYTES + 1024); LAS unsigned char* blk_e = (LAS unsigned char*)(F.lds + RING_BYTES + 1024 + 256);
        const int nblk = moe_tables(F, pstart, blk_e);
        pg8::Gemm8 g{(const unsigned char*)(ws + WS_ACT), (const unsigned char*)(ws + WS_WDN), CAP, NEXP * DM, DFF, 0x7f7f7f7f, 0x77777777};
        pg8::MoeOrder<4> S{nblk, F.G, F.bx, (const PG8_LAS unsigned char*)blk_e};
        pg8::EpiDown E{(b16*)(ws + WS_APERM), F.in[I_BDN], (const float*)(ws + WS_ROUTE + RT_ROWW)};
        pg8::gemm_phase_f8<pg8::EpiDown, pg8::MoeOrder<4>, true, true>(F.lds, g, S, E);
    } SEAM(11);
    if (IN(12)) { p12_combine(F); }
#undef IN
#undef SEAM
}

extern "C" void kernel_launch(void* const* d_in, const int* in_sizes, int n_in, void* d_out, int out_size, void* d_ws, size_t ws_size, hipStream_t stream) {
    static int grid = 0;
    if (grid == 0) {
        if (n_in != N_IN || out_size != MT * DM || ws_size < WS_END) { fprintf(stderr, "kernel_launch: unexpected shapes (n_in %d, out %d, ws %zu need %zu)\n", n_in, out_size, ws_size, (size_t)WS_END); grid = -1; return; }
        int dev = 0, cus = 0, per_cu = 0;
        if (hipGetDevice(&dev) != hipSuccess || hipDeviceGetAttribute(&cus, hipDeviceAttributeMultiprocessorCount, dev) != hipSuccess) { grid = -1; return; }
        if (hipFuncSetAttribute((const void*)fwd_kernel, hipFuncAttributeMaxDynamicSharedMemorySize, LDS_BYTES) != hipSuccess) { fprintf(stderr, "kernel_launch: hipFuncSetAttribute failed\n"); grid = -1; return; }
        if (hipOccupancyMaxActiveBlocksPerMultiprocessor(&per_cu, (const void*)fwd_kernel, NWAVES * 64, LDS_BYTES) != hipSuccess || per_cu < 1) { fprintf(stderr, "kernel_launch: occupancy query says %d\n", per_cu); }
        (void)hipGetLastError();
        grid = cus;
    }
    if (grid < 0) return;
    if (hipMemsetAsync((char*)d_ws + WS_CTL, 0, CTL_ZERO_BYTES, stream) != hipSuccess) return;
    Args a{};
    for (int i = 0; i < N_IN; ++i) a.in[i] = (const float*)d_in[i];
    a.out = (float*)d_out; a.ws = (unsigned char*)d_ws;
#if MK_PER_PHASE
    for (int p = 0; p < N_PHASES; ++p) { a.ph_lo = p; a.ph_hi = p + 1; a.li = 0; hipLaunchKernelGGL(fwd_kernel, dim3(grid), dim3(NWAVES * 64), LDS_BYTES, stream, a); }
#else
    a.ph_lo = 0; a.ph_hi = N_PHASES; a.li = 0;
    hipLaunchKernelGGL(fwd_kernel, dim3(grid), dim3(NWAVES * 64), LDS_BYTES, stream, a);
#endif
}
```

```cpp
#include <hip/hip_runtime.h>
#include <cstdio>
#include <cstdint>
namespace pg8 {
#define PG8_LAS __attribute__((address_space(3)))
typedef unsigned short bf16_t;
typedef short bf16x8 __attribute__((ext_vector_type(8)));
typedef float f32x4 __attribute__((ext_vector_type(4)));
typedef unsigned u32x4 __attribute__((ext_vector_type(4)));
constexpr int BM = 256, BK = 64, HALF = 128, HTB = HALF * BK * 2  , STAGE_BYTES = 8 * HTB, NXCD = 8, WGM = 8;

__host__ __device__ __forceinline__ int lds_byte(int r, int c) { const int st = (r >> 4) * 2 + (c >> 5), rr = r & 15, cc = c & 31, ob = rr * 64 + cc * 2; return st * 1024 + (ob ^ (((ob >> 9) & 1) << 5)); }
__host__ __device__ __forceinline__ void stage_rc(int b, int& R, int& C) { const int st = b / 1024, sb = b % 1024, swz = sb ^ (((sb >> 9) & 1) << 5); R = (st >> 1) * 16 + swz / 64; C = (st & 1) * 32 + (swz % 64) / 2; }
__host__ __device__ __forceinline__ int perm32(int rho) { const int n = rho >> 4, i = rho & 15; return 8 * (i >> 2) + 4 * n + (i & 3); }

struct Unit { int pm, pn; };
struct Gemm { const bf16_t* A; const bf16_t* Bt; int M, N, K; };

struct StaticOrder {
    int nM, nN, nwg, G, c;
    __host__ __device__ void init(int M, int N, int G_, int c_) { nM = M / BM; nN = N / BM; nwg = nM * nN; G = G_; c = c_; }
    __host__ __device__ bool next(int i, Unit& u) const {
        const long L = (long)i * G + c; if (L >= nwg) return false;
        int wgid = (int)L; { const int q = nwg / NXCD, r = nwg % NXCD, xcd = wgid % NXCD, off = wgid / NXCD; wgid = (xcd < r ? xcd * (q + 1) : r * (q + 1) + (xcd - r) * q) + off; }
        const int nig = WGM * nN, gid = wgid / nig, fm = gid * WGM, gsz = (nM - fm) < WGM ? (nM - fm) : WGM;
        u.pm = fm + ((wgid % nig) % gsz); u.pn = (wgid % nig) / gsz; return true;
    }
    __device__ __forceinline__ void a_ready(const Unit&) const {}
    __device__ __forceinline__ void done(const Unit&) const {}
};

__device__ __forceinline__ unsigned cvt_pk_bf16(float lo, float hi) { unsigned r; asm volatile("v_cvt_pk_bf16_f32 %0, %1, %2" : "=v"(r) : "v"(lo), "v"(hi)); return r; }
typedef float f32x2 __attribute__((ext_vector_type(2)));
__device__ __forceinline__ f32x2 gelu_pk(f32x2 v) {
    const f32x2 av = __builtin_elementwise_abs(v), d = av * 0.2316418882f + 1.0f;
    f32x2 t; t.x = __builtin_amdgcn_rcpf(d.x); t.y = __builtin_amdgcn_rcpf(d.y);
    f32x2 q = t * 0.5307027145f + (-0.7265760135f); q = q * t + 0.7107068705f; q = q * t + (-0.142248368f); q = q * t + 0.127414796f; q = q * t;
    const f32x2 s = (v * v) * (-0.72134752044f);
    f32x2 e; e.x = __builtin_amdgcn_exp2f(s.x); e.y = __builtin_amdgcn_exp2f(s.y);
    const f32x2 m = v * (q * e), r = v - m;
    f32x2 o; o.x = v.x < 0.f ? m.x : r.x; o.y = v.y < 0.f ? m.y : r.y; return o;
}

template <int ACT  > struct EpiBf16 {
    static constexpr bool PERM = true, AFTER_DRAIN = false; static_assert(ACT == 0 || ACT == 1, "EpiBf16: ACT is 0 (none) or 1 (gelu_pk)");
    bf16_t* O; int ldc; const float* bias; int split_cols; size_t split_stride; float scale0;
    __device__ __forceinline__ void operator()(const f32x4 (&acc)[2][2][4][2], const Unit& u, int wr, int wc, int fr, int fq) const {
        const int row0 = u.pm * BM + wr * 64 + fr; int colt = u.pn * BM; bf16_t* base = O;
        float sc = 1.f; if (split_cols) { const int t = colt / split_cols; base += (size_t)t * split_stride; colt -= t * split_cols; if (t == 0) sc = scale0; }
        const int col0 = colt + wc * 32 + 8 * fq, bcol0 = u.pn * BM + wc * 32 + 8 * fq;
        f32x4 bv[2][2];
#pragma unroll
        for (int bj = 0; bj < 2; ++bj)
#pragma unroll
            for (int n = 0; n < 2; ++n) bv[bj][n] = bias ? *(const f32x4*)(bias + bcol0 + bj * HALF + 4 * n) : (f32x4){0.f, 0.f, 0.f, 0.f};
#pragma unroll
        for (int ai = 0; ai < 2; ++ai)
#pragma unroll
            for (int m = 0; m < 4; ++m) { bf16_t* rowp = base + (size_t)(row0 + ai * HALF + m * 16) * ldc + col0;
#pragma unroll
                for (int bj = 0; bj < 2; ++bj) { f32x4 v0 = acc[ai][bj][m][0] + bv[bj][0], v1 = acc[ai][bj][m][1] + bv[bj][1];
                    if (ACT == 1) { f32x2 a = gelu_pk((f32x2){v0[0], v0[1]}), b = gelu_pk((f32x2){v0[2], v0[3]}), c = gelu_pk((f32x2){v1[0], v1[1]}), d = gelu_pk((f32x2){v1[2], v1[3]});
                        v0 = (f32x4){a.x, a.y, b.x, b.y}; v1 = (f32x4){c.x, c.y, d.x, d.y}; }
                    v0 = v0 * sc; v1 = v1 * sc; u32x4 w; w.x = cvt_pk_bf16(v0[0], v0[1]); w.y = cvt_pk_bf16(v0[2], v0[3]); w.z = cvt_pk_bf16(v1[0], v1[1]); w.w = cvt_pk_bf16(v1[2], v1[3]);
                    *(u32x4*)(rowp + bj * HALF) = w; } }
    }
};

struct PanelStats {
    unsigned* xbuf;
    unsigned* cnt;
    unsigned* tmo;
    int ntn; float eps;
    unsigned code;
    __device__ __forceinline__ bool run(const f32x4 (&v)[2][2][4][2], const Unit& u, int wr, int wc, int fr, int fq, PG8_LAS unsigned char* lds, int wid, int lane) const {
        typedef float f32x2v __attribute__((ext_vector_type(2)));
        PG8_LAS f32x2v* P = (PG8_LAS f32x2v*)lds;
        PG8_LAS f32x2v* S = (PG8_LAS f32x2v*)(lds + 8192);
        PG8_LAS unsigned* flag = (PG8_LAS unsigned*)(lds + 8192 + 2048);
#pragma unroll
        for (int ai = 0; ai < 2; ++ai)
#pragma unroll
            for (int m = 0; m < 4; ++m) {
                float s = 0.f;
#pragma unroll
                for (int bj = 0; bj < 2; ++bj)
#pragma unroll
                    for (int n = 0; n < 2; ++n) { const f32x4 x = v[ai][bj][m][n]; s += (x[0] + x[1]) + (x[2] + x[3]); }
                s += __shfl_xor(s, 16); s += __shfl_xor(s, 32);
                const float mw = s * (1.0f / 64.0f); float q = 0.f;
#pragma unroll
                for (int bj = 0; bj < 2; ++bj)
#pragma unroll
                    for (int n = 0; n < 2; ++n) { const f32x4 d = v[ai][bj][m][n] - mw; q += (d[0] * d[0] + d[1] * d[1]) + (d[2] * d[2] + d[3] * d[3]); }
                q += __shfl_xor(q, 16); q += __shfl_xor(q, 32);
                if (fq == 0) P[(ai * HALF + wr * 64 + m * 16 + fr) * 4 + wc] = (f32x2v){mw, q};
            }
        asm volatile("s_waitcnt lgkmcnt(0)" ::: "memory"); __builtin_amdgcn_s_barrier(); asm volatile("" ::: "memory");
#if defined(BROKEN_EXCHANGE_NO_WAIT)
#warning BROKEN CONTROL BUILD: the row-statistics exchange does not wait; results are wrong by design
        if (blockIdx.x >= 64) { const long long t0_ = clock64(); while (clock64() - t0_ < 60000) __builtin_amdgcn_s_sleep(8); }
#endif
        const int row = wid * 32 + (lane & 31);
        if (lane < 32) {
            const f32x2v a = P[row * 4 + 0], b = P[row * 4 + 1], c = P[row * 4 + 2], d = P[row * 4 + 3];
            const float mt = (a.x + b.x + c.x + d.x) * 0.25f;
            const float da = a.x - mt, db = b.x - mt, dc = c.x - mt, dd = d.x - mt;
            const float m2 = (a.y + b.y) + (c.y + d.y) + 64.0f * ((da * da + db * db) + (dc * dc + dd * dd));
            unsigned long long* slot = (unsigned long long*)xbuf + ((size_t)(u.pm * BM + row) * 4 + u.pn);
            __hip_atomic_store(slot, ((unsigned long long)__float_as_uint(m2) << 32) | __float_as_uint(mt), __ATOMIC_RELAXED, __HIP_MEMORY_SCOPE_AGENT);
        }
        asm volatile("s_waitcnt vmcnt(0)" ::: "memory");
        if (lane == 0) __hip_atomic_fetch_add(cnt + 64 * u.pm, 1u, __ATOMIC_RELAXED, __HIP_MEMORY_SCOPE_AGENT);
        if (wid == 0) {
            bool dead = false; const unsigned long long t0 = __builtin_amdgcn_s_memrealtime(); const unsigned want = 8u * (unsigned)ntn;
            for (;;) {
#if defined(BROKEN_EXCHANGE_NO_WAIT)
                break;
#endif
                if ((unsigned)__builtin_amdgcn_readfirstlane(__hip_atomic_load(cnt + 64 * u.pm, __ATOMIC_RELAXED, __HIP_MEMORY_SCOPE_AGENT)) >= want) break;
                if (__builtin_amdgcn_s_memrealtime() - t0 > 2000000ull) {
                    if (lane == 0) { unsigned expect = 0u; __hip_atomic_compare_exchange_strong(tmo + 1, &expect, code | (unsigned)(u.pm & 0xff), __ATOMIC_RELAXED, __ATOMIC_RELAXED, __HIP_MEMORY_SCOPE_AGENT);
                                     __hip_atomic_store(tmo, 1u, __ATOMIC_RELAXED, __HIP_MEMORY_SCOPE_AGENT); }
                    dead = true; break; }
                __builtin_amdgcn_s_sleep(2);
            }
            __builtin_amdgcn_fence(__ATOMIC_ACQUIRE, "agent");
            if (lane == 0) flag[0] = dead ? 1u : 0u;
        }
        asm volatile("s_waitcnt vmcnt(0) lgkmcnt(0)" ::: "memory"); __builtin_amdgcn_s_barrier(); asm volatile("" ::: "memory");
        const bool bad = flag[0] != 0u;
        if (lane < 32) {
            const unsigned long long* slot = (const unsigned long long*)xbuf + (size_t)(u.pm * BM + row) * 4; float mt[4], m2[4]; float ms = 0.f;
#pragma unroll
            for (int t = 0; t < 4; ++t) { if (t < ntn) { const unsigned long long w = __hip_atomic_load(slot + t, __ATOMIC_RELAXED, __HIP_MEMORY_SCOPE_AGENT); mt[t] = __uint_as_float((unsigned)w); m2[t] = __uint_as_float((unsigned)(w >> 32)); } else { mt[t] = 0.f; m2[t] = 0.f; } ms += mt[t]; }
            const float mean = ms / (float)ntn; float q = 0.f;
#pragma unroll
            for (int t = 0; t < 4; ++t) if (t < ntn) { const float dm = mt[t] - mean; q += m2[t] + 256.0f * dm * dm; }
            S[row] = (f32x2v){mean, 1.0f / sqrtf(q / (256.0f * (float)ntn) + eps)};
        }
        asm volatile("s_waitcnt lgkmcnt(0)" ::: "memory"); __builtin_amdgcn_s_barrier(); asm volatile("" ::: "memory");
        return bad;
    }
};
struct EpiLnRes {
    static constexpr bool PERM = false, AFTER_DRAIN = true;
    const float* base; float* out; int ldc; const float* bias; PanelStats st; unsigned poison;
    __device__ __forceinline__ void fused(f32x4 (&acc)[2][2][4][2], const Unit& u, int wr, int wc, int fr, int fq, PG8_LAS unsigned char* lds, int wid, int lane) const {
        typedef float f32x2v __attribute__((ext_vector_type(2)));
        const PG8_LAS f32x2v* S = (const PG8_LAS f32x2v*)(lds + 8192);
        const int col0 = u.pn * BM + wc * 32 + 4 * fq;
#pragma unroll
        for (int bj = 0; bj < 2; ++bj)
#pragma unroll
            for (int n = 0; n < 2; ++n) { const f32x4 bv = bias ? *(const f32x4*)(bias + col0 + bj * HALF + n * 16) : (f32x4){0.f, 0.f, 0.f, 0.f};
#pragma unroll
                for (int ai = 0; ai < 2; ++ai)
#pragma unroll
                    for (int m = 0; m < 4; ++m) acc[ai][bj][m][n] += bv; }
        f32x4 pre[4][2][2];
#pragma unroll
        for (int m = 0; m < 4; ++m) { const size_t off = (size_t)(u.pm * BM + wr * 64 + m * 16 + fr) * ldc + col0;
#pragma unroll
            for (int bj = 0; bj < 2; ++bj)
#pragma unroll
                for (int n = 0; n < 2; ++n) pre[m][bj][n] = *(const f32x4*)(base + off + bj * HALF + n * 16); }
        const bool bad = st.run(acc, u, wr, wc, fr, fq, lds, wid, lane) || poison != 0u;
        const float qnan = __builtin_nanf("");
#pragma unroll
        for (int ai = 0; ai < 2; ++ai)
#pragma unroll
            for (int m = 0; m < 4; ++m) { const int r = ai * HALF + wr * 64 + m * 16 + fr; const f32x2v sr = S[r]; const size_t off = (size_t)(u.pm * BM + r) * ldc + col0;
#pragma unroll
                for (int bj = 0; bj < 2; ++bj)
#pragma unroll
                    for (int n = 0; n < 2; ++n) { const f32x4 bs = ai == 0 ? pre[m][bj][n] : *(const f32x4*)(base + off + bj * HALF + n * 16); f32x4 o = bs + (acc[ai][bj][m][n] - sr.x) * sr.y;
                        if (bad) o = (f32x4){qnan, qnan, qnan, qnan}; *(f32x4*)(out + off + bj * HALF + n * 16) = o; }
                if (m & 1) asm volatile("" ::: "memory"); }
    }
};
struct EpiLnResLn {
    static constexpr bool PERM = false, AFTER_DRAIN = true;
    const float* base; float* out; bf16_t* xn; int ldc; const float* bias; PanelStats st1, st2; unsigned poison;
    __device__ __forceinline__ void fused(f32x4 (&acc)[2][2][4][2], const Unit& u, int wr, int wc, int fr, int fq, PG8_LAS unsigned char* lds, int wid, int lane) const {
        typedef float f32x2v __attribute__((ext_vector_type(2))); typedef unsigned u32x2v __attribute__((ext_vector_type(2)));
        const PG8_LAS f32x2v* S = (const PG8_LAS f32x2v*)(lds + 8192);
        const int col0 = u.pn * BM + wc * 32 + 4 * fq;
#pragma unroll
        for (int bj = 0; bj < 2; ++bj)
#pragma unroll
            for (int n = 0; n < 2; ++n) { const f32x4 bv = bias ? *(const f32x4*)(bias + col0 + bj * HALF + n * 16) : (f32x4){0.f, 0.f, 0.f, 0.f};
#pragma unroll
                for (int ai = 0; ai < 2; ++ai)
#pragma unroll
                    for (int m = 0; m < 4; ++m) acc[ai][bj][m][n] += bv; }
        bool bad = st1.run(acc, u, wr, wc, fr, fq, lds, wid, lane) || poison != 0u;
        const float qnan = __builtin_nanf("");
#pragma unroll
        for (int ai = 0; ai < 2; ++ai)
#pragma unroll
            for (int m = 0; m < 4; ++m) { const int r = ai * HALF + wr * 64 + m * 16 + fr; const f32x2v sr = S[r]; const size_t off = (size_t)(u.pm * BM + r) * ldc + col0;
#pragma unroll
                for (int bj = 0; bj < 2; ++bj)
#pragma unroll
                    for (int n = 0; n < 2; ++n) { const f32x4 bs = *(const f32x4*)(base + off + bj * HALF + n * 16); acc[ai][bj][m][n] = bs + (acc[ai][bj][m][n] - sr.x) * sr.y; }
                asm volatile("" : "+v"(acc[ai][0][m][0]), "+v"(acc[ai][0][m][1]), "+v"(acc[ai][1][m][0]), "+v"(acc[ai][1][m][1]));
                if (m & 1) asm volatile("" ::: "memory"); }
        const bool bad1 = bad;
        bad = st2.run(acc, u, wr, wc, fr, fq, lds, wid, lane) || bad;
#pragma unroll
        for (int ai = 0; ai < 2; ++ai)
#pragma unroll
            for (int m = 0; m < 4; ++m) { const int r = ai * HALF + wr * 64 + m * 16 + fr; const f32x2v sr = S[r]; const size_t off = (size_t)(u.pm * BM + r) * ldc + col0;
#pragma unroll
                for (int bj = 0; bj < 2; ++bj)
#pragma unroll
                    for (int n = 0; n < 2; ++n) { const f32x4 x1 = acc[ai][bj][m][n]; *(f32x4*)(out + off + bj * HALF + n * 16) = bad1 ? (f32x4){qnan, qnan, qnan, qnan} : x1;
                        const f32x4 o = (x1 - sr.x) * sr.y; u32x2v w; w.x = cvt_pk_bf16(o[0], o[1]); w.y = cvt_pk_bf16(o[2], o[3]);
                        if (bad) { w.x = 0x7fc07fc0u; w.y = 0x7fc07fc0u; } *(u32x2v*)(xn + off + bj * HALF + n * 16) = w; }
                asm volatile("" ::: "memory"); }
    }
};

template <class Epi, class Sched, bool ALIGN_EPI = false, bool SP2 = false>
__device__ __forceinline__ void gemm_phase(PG8_LAS unsigned char* lds, const Gemm g, const Sched& S, const Epi& E, int wid_in) {
    int lane_; asm volatile("v_mbcnt_lo_u32_b32 %0, -1, 0\n\tv_mbcnt_hi_u32_b32 %0, -1, %0" : "=v"(lane_));
    const int wid = wid_in, lane = lane_, tid = wid * 64 + lane, wr = wid >> 2, wc = wid & 3, fr = lane & 15, fq = lane >> 4;
    const int K = g.K, nt = K / BK;
    unsigned voffA[2], voffB[2];
#pragma unroll
    for (int i = 0; i < 2; ++i) { int R, C; stage_rc(tid * 16 + i * 8192, R, C); const int Rb = Epi::PERM ? ((R & ~31) + perm32(R & 31)) : R;
        voffA[i] = (unsigned)(R * K + C) * 2u; voffB[i] = (unsigned)(Rb * K + C) * 2u; }
    const size_t kstep = (size_t)(BK * 2);
    const size_t hstep = (size_t)HALF * K * 2;
    const size_t tstep = 2 * hstep;
    const unsigned ldsw = (unsigned)wid * 1024u;
    const int aoff = lds_byte(wr * 64 + fr, fq * 8), boff = lds_byte(wc * 32 + fr, fq * 8);
#define PG8_SA(b, h) (((b) * 2 + (h)) * HTB)
#define PG8_SB(b, h) ((4 + (b) * 2 + (h)) * HTB)
#define PG8_STAGE(bufoff, gbase, voff) do { _Pragma("unroll") for (int _i = 0; _i < 2; ++_i) \
        __builtin_amdgcn_global_load_lds((const unsigned*)((const char*)(gbase) + (voff)[_i]), (PG8_LAS unsigned*)(lds + (bufoff) + ldsw + _i * 8192), 16, 0, 0); } while (0)
#define PG8_LDA(dst, b, h) do { _Pragma("unroll") for (int m = 0; m < 4; ++m) _Pragma("unroll") for (int k = 0; k < 2; ++k) dst[m][k] = *(const PG8_LAS bf16x8*)(lds + PG8_SA(b, h) + aoff + m * 2048 + k * 1024); } while (0)
#define PG8_LDB(dst, b, h) do { _Pragma("unroll") for (int n = 0; n < 2; ++n) _Pragma("unroll") for (int k = 0; k < 2; ++k) dst[n][k] = *(const PG8_LAS bf16x8*)(lds + PG8_SB(b, h) + boff + n * 2048 + k * 1024); } while (0)
#define PG8_MMA(ai, bj, At, Bt) do { __builtin_amdgcn_s_setprio(1); _Pragma("unroll") for (int m = 0; m < 4; ++m) _Pragma("unroll") for (int n = 0; n < 2; ++n) _Pragma("unroll") for (int k = 0; k < 2; ++k) \
        acc[ai][bj][m][n] = __builtin_amdgcn_mfma_f32_16x16x32_bf16(Bt[n][k], At[m][k], acc[ai][bj][m][n], 0, 0, 0); __builtin_amdgcn_s_setprio(0); } while (0)
#define PG8_WAIT_V(n) asm volatile("s_waitcnt vmcnt(" #n ")" ::: "memory")
#define PG8_WAIT_L(n) asm volatile("s_waitcnt lgkmcnt(" #n ")" ::: "memory")
#define PG8_BAR __builtin_amdgcn_s_barrier()
#define PG8_SCHED __builtin_amdgcn_sched_barrier(0)
    Unit cur, nxt; int ui = 0;
    if (!S.next(0, cur)) return;
    f32x4 acc[2][2][4][2];
#pragma unroll
    for (int a = 0; a < 2; ++a)
#pragma unroll
        for (int b = 0; b < 2; ++b)
#pragma unroll
            for (int m = 0; m < 4; ++m)
#pragma unroll
                for (int n = 0; n < 2; ++n) acc[a][b][m][n] = (f32x4){0.f, 0.f, 0.f, 0.f};
    bf16x8 At[4][2], B0[2][2], B1[2][2];
    const char* cA = (const char*)g.A + (size_t)cur.pm * tstep; const char* cB = (const char*)g.Bt + (size_t)cur.pn * tstep;
    S.a_ready(cur);
    if constexpr (SP2) {
        PG8_STAGE(PG8_SB(0, 0), cB, voffB); PG8_STAGE(PG8_SB(0, 1), cB + hstep, voffB); PG8_STAGE(PG8_SA(0, 0), cA, voffA); PG8_STAGE(PG8_SA(0, 1), cA + hstep, voffA);
        if (wr == 1) PG8_BAR;
        PG8_WAIT_V(2); PG8_BAR;
        PG8_STAGE(PG8_SB(1, 0), cB + kstep, voffB); PG8_STAGE(PG8_SA(1, 0), cA + kstep, voffA); PG8_STAGE(PG8_SB(1, 1), cB + hstep + kstep, voffB);
        PG8_WAIT_V(6); PG8_BAR;
    } else {
        PG8_STAGE(PG8_SB(0, 0), cB, voffB); PG8_STAGE(PG8_SA(0, 0), cA, voffA); PG8_STAGE(PG8_SB(0, 1), cB + hstep, voffB); PG8_STAGE(PG8_SA(0, 1), cA + hstep, voffA);
        if (wr == 1) PG8_BAR;
        PG8_WAIT_V(4); PG8_BAR;
        PG8_STAGE(PG8_SB(1, 0), cB + kstep, voffB); PG8_STAGE(PG8_SA(1, 0), cA + kstep, voffA); PG8_STAGE(PG8_SB(1, 1), cB + hstep + kstep, voffB);
        PG8_WAIT_V(6); PG8_BAR;
    }
    for (;;) {
        const bool has_next = S.next(ui + 1, nxt);
        const char* nA = has_next ? (const char*)g.A + (size_t)nxt.pm * tstep : cA; const char* nB = has_next ? (const char*)g.Bt + (size_t)nxt.pn * tstep : cB;
        for (int t = 0; t < nt; t += 2) {
            const bool last = (t == nt - 2);
            const char* a1 = cA + (size_t)(t + 1) * kstep;
            const char* a2 = last ? nA : cA + (size_t)(t + 2) * kstep; const char* b2 = last ? nB : cB + (size_t)(t + 2) * kstep;
            const char* a3 = a2 + kstep; const char* b3 = b2 + kstep;
            if (last && has_next) S.a_ready(nxt);
            if constexpr (SP2) {
            PG8_LDB(B0, 0, 0); PG8_LDB(B1, 0, 1); PG8_SCHED; PG8_LDA(At, 0, 0); PG8_STAGE(PG8_SA(1, 1), a1 + hstep, voffA);
            PG8_WAIT_V(8); PG8_WAIT_L(0); PG8_BAR; PG8_MMA(0, 0, At, B0); PG8_MMA(0, 1, At, B1); PG8_BAR; PG8_SCHED;
            PG8_LDA(At, 0, 1); PG8_STAGE(PG8_SB(0, 0), b2, voffB); PG8_STAGE(PG8_SB(0, 1), b2 + hstep, voffB); PG8_STAGE(PG8_SA(0, 0), a2, voffA);
            PG8_WAIT_V(8); PG8_WAIT_L(0); PG8_BAR; PG8_MMA(1, 0, At, B0); PG8_MMA(1, 1, At, B1); PG8_BAR; PG8_SCHED;
            PG8_LDB(B0, 1, 0); PG8_LDB(B1, 1, 1); PG8_SCHED; PG8_LDA(At, 1, 0); PG8_STAGE(PG8_SA(0, 1), a2 + hstep, voffA);
            PG8_WAIT_V(8); PG8_WAIT_L(0); PG8_BAR; PG8_MMA(0, 0, At, B0); PG8_MMA(0, 1, At, B1); PG8_BAR; PG8_SCHED;
            PG8_LDA(At, 1, 1); PG8_STAGE(PG8_SB(1, 0), b3, voffB); PG8_STAGE(PG8_SB(1, 1), b3 + hstep, voffB); PG8_STAGE(PG8_SA(1, 0), a3, voffA);
            PG8_WAIT_V(8); PG8_WAIT_L(0); PG8_BAR; PG8_MMA(1, 0, At, B0); PG8_MMA(1, 1, At, B1); PG8_BAR; PG8_SCHED;
            } else {
            PG8_LDB(B0, 0, 0); PG8_SCHED; PG8_LDA(At, 0, 0); PG8_STAGE(PG8_SA(1, 1), a1 + hstep, voffA);
            PG8_WAIT_L(8); PG8_BAR; PG8_WAIT_L(0); PG8_MMA(0, 0, At, B0); PG8_BAR; PG8_SCHED;
            PG8_LDB(B1, 0, 1); PG8_STAGE(PG8_SB(0, 0), b2, voffB);
            PG8_BAR; PG8_WAIT_L(0); PG8_MMA(0, 1, At, B1); PG8_BAR;
            PG8_LDA(At, 0, 1); PG8_STAGE(PG8_SA(0, 0), a2, voffA);
            PG8_BAR; PG8_WAIT_L(0); PG8_MMA(1, 0, At, B0); PG8_BAR; PG8_SCHED;
            PG8_STAGE(PG8_SB(0, 1), b2 + hstep, voffB);
            PG8_WAIT_V(6); PG8_BAR; PG8_MMA(1, 1, At, B1); PG8_BAR;
            PG8_LDB(B0, 1, 0); PG8_SCHED; PG8_LDA(At, 1, 0); PG8_STAGE(PG8_SA(0, 1), a2 + hstep, voffA);
            PG8_WAIT_L(8); PG8_BAR; PG8_WAIT_L(0); PG8_MMA(0, 0, At, B0); PG8_BAR; PG8_SCHED;
            PG8_LDB(B1, 1, 1); PG8_STAGE(PG8_SB(1, 0), b3, voffB);
            PG8_BAR; PG8_WAIT_L(0); PG8_MMA(0, 1, At, B1); PG8_BAR;
            PG8_LDA(At, 1, 1); PG8_STAGE(PG8_SA(1, 0), a3, voffA);
            PG8_BAR; PG8_WAIT_L(0); PG8_MMA(1, 0, At, B0); PG8_BAR; PG8_SCHED;
            PG8_STAGE(PG8_SB(1, 1), b3 + hstep, voffB);
            PG8_WAIT_V(6); PG8_BAR; PG8_MMA(1, 1, At, B1); PG8_BAR;
            }
        }
        if constexpr (ALIGN_EPI) { if (wr == 0) PG8_BAR; }
        if constexpr (!Epi::AFTER_DRAIN) { E(acc, cur, wr, wc, fr, fq); S.done(cur); }
        if (!has_next) break;
#pragma unroll
        for (int a = 0; a < 2; ++a)
#pragma unroll
            for (int b = 0; b < 2; ++b)
#pragma unroll
                for (int m = 0; m < 4; ++m)
#pragma unroll
                    for (int n = 0; n < 2; ++n) acc[a][b][m][n] = (f32x4){0.f, 0.f, 0.f, 0.f};
        cur = nxt; cA = nA; cB = nB; ++ui;
        if constexpr (ALIGN_EPI) { if (wr == 1) PG8_BAR; }
    }
    PG8_WAIT_V(0);
    if constexpr (!ALIGN_EPI) { if (wr == 0) PG8_BAR; }
    PG8_BAR;
    if constexpr (Epi::AFTER_DRAIN) { E.fused(acc, cur, wr, wc, fr, fq, lds, wid, lane); S.done(cur); }
#undef PG8_SA
#undef PG8_SB
#undef PG8_STAGE
#undef PG8_LDA
#undef PG8_LDB
#undef PG8_MMA
#undef PG8_WAIT_V
#undef PG8_WAIT_L
#undef PG8_BAR
#undef PG8_SCHED
}
}
namespace pg8 {
struct Gemm8 { const unsigned char* A; const unsigned char* Bt; int M, N, K; int scale_a, scale_b; };
template <class Epi, class Sched, bool ALIGN_EPI = false, bool SP2 = false>
__device__ __forceinline__ void gemm_phase_f8(PG8_LAS unsigned char* lds, const Gemm8 g, const Sched& S, const Epi& E, int wid_in) {
    int lane_; asm volatile("v_mbcnt_lo_u32_b32 %0, -1, 0\n\tv_mbcnt_hi_u32_b32 %0, -1, %0" : "=v"(lane_));
    const int wid = wid_in, lane = lane_, tid = wid * 64 + lane, wr = wid >> 2, wc = wid & 3, fr = lane & 15, fq = lane >> 4;
    const int K = g.K, nt = K / 128;
    unsigned voffA[2], voffB[2];
#pragma unroll
    for (int i = 0; i < 2; ++i) { int R, C; stage_rc(tid * 16 + i * 8192, R, C); const int Rb = Epi::PERM ? ((R & ~31) + perm32(R & 31)) : R;
        voffA[i] = (unsigned)(R * K + 2 * C); voffB[i] = (unsigned)(Rb * K + 2 * C); }
    const size_t kstep = (size_t)(BK * 2);
    const size_t hstep = (size_t)HALF * K;
    const size_t tstep = 2 * hstep;
    const unsigned ldsw = (unsigned)wid * 1024u;
    const int aoff = lds_byte(wr * 64 + fr, fq * 16), boff = lds_byte(wc * 32 + fr, fq * 16);
#define PG8_SA(b, h) (((b) * 2 + (h)) * HTB)
#define PG8_SB(b, h) ((4 + (b) * 2 + (h)) * HTB)
#define PG8_STAGE(bufoff, gbase, voff) do { _Pragma("unroll") for (int _i = 0; _i < 2; ++_i) { unsigned keep_; \
        asm volatile("s_mov_b32 %0, m0\n\ts_mov_b32 m0, %3\n\ts_nop 0\n\tglobal_load_lds_dwordx4 %1, %2\n\ts_mov_b32 m0, %0" : "=&s"(keep_) : "v"((voff)[_i]), "s"((const char*)(gbase)), "s"((unsigned)(size_t)(lds + (bufoff) + ldsw + _i * 8192)) : "memory"); } } while (0)
#define PG8_LDA(dst, b, h) do { _Pragma("unroll") for (int m = 0; m < 4; ++m) { const u32x4 lo_ = *(const PG8_LAS u32x4*)(lds + PG8_SA(b, h) + aoff + m * 2048), hi_ = *(const PG8_LAS u32x4*)(lds + PG8_SA(b, h) + aoff + m * 2048 + 16); dst[m] = __builtin_bit_cast(i32x8, __builtin_shufflevector(lo_, hi_, 0, 1, 2, 3, 4, 5, 6, 7)); } } while (0)
#define PG8_LDB(dst, b, h) do { _Pragma("unroll") for (int n = 0; n < 2; ++n) { const u32x4 lo_ = *(const PG8_LAS u32x4*)(lds + PG8_SB(b, h) + boff + n * 2048), hi_ = *(const PG8_LAS u32x4*)(lds + PG8_SB(b, h) + boff + n * 2048 + 16); dst[n] = __builtin_bit_cast(i32x8, __builtin_shufflevector(lo_, hi_, 0, 1, 2, 3, 4, 5, 6, 7)); } } while (0)
#define PG8_MMA(ai, bj, At, Bt) do { __builtin_amdgcn_s_setprio(1); _Pragma("unroll") for (int m = 0; m < 4; ++m) _Pragma("unroll") for (int n = 0; n < 2; ++n) \
        acc[ai][bj][m][n] = __builtin_amdgcn_mfma_scale_f32_16x16x128_f8f6f4(Bt[n], At[m], acc[ai][bj][m][n], 0, 0, 0, g.scale_b, 0, g.scale_a); __builtin_amdgcn_s_setprio(0); } while (0)
#define PG8_WAIT_V(n) asm volatile("s_waitcnt vmcnt(" #n ")" ::: "memory")
#define PG8_WAIT_L(n) asm volatile("s_waitcnt lgkmcnt(" #n ")" ::: "memory")
#define PG8_BAR __builtin_amdgcn_s_barrier()
#define PG8_SCHED __builtin_amdgcn_sched_barrier(0)
    Unit cur, nxt; int ui = 0;
    if (!S.next(0, cur)) return;
    f32x4 acc[2][2][4][2];
#pragma unroll
    for (int a = 0; a < 2; ++a)
#pragma unroll
        for (int b = 0; b < 2; ++b)
#pragma unroll
            for (int m = 0; m < 4; ++m)
#pragma unroll
                for (int n = 0; n < 2; ++n) acc[a][b][m][n] = (f32x4){0.f, 0.f, 0.f, 0.f};
    typedef int i32x8 __attribute__((ext_vector_type(8))); i32x8 At[4], B0[2], B1[2];
    const char* cA = (const char*)g.A + (size_t)cur.pm * tstep; const char* cB = (const char*)g.Bt + (size_t)cur.pn * tstep;
    S.a_ready(cur);
    if constexpr (SP2) {
        PG8_STAGE(PG8_SB(0, 0), cB, voffB); PG8_STAGE(PG8_SB(0, 1), cB + hstep, voffB); PG8_STAGE(PG8_SA(0, 0), cA, voffA); PG8_STAGE(PG8_SA(0, 1), cA + hstep, voffA);
        if (wr == 1) PG8_BAR;
        PG8_WAIT_V(2); PG8_BAR;
        PG8_STAGE(PG8_SB(1, 0), cB + kstep, voffB); PG8_STAGE(PG8_SA(1, 0), cA + kstep, voffA); PG8_STAGE(PG8_SB(1, 1), cB + hstep + kstep, voffB);
        PG8_WAIT_V(6); PG8_BAR;
    } else {
        PG8_STAGE(PG8_SB(0, 0), cB, voffB); PG8_STAGE(PG8_SA(0, 0), cA, voffA); PG8_STAGE(PG8_SB(0, 1), cB + hstep, voffB); PG8_STAGE(PG8_SA(0, 1), cA + hstep, voffA);
        if (wr == 1) PG8_BAR;
        PG8_WAIT_V(4); PG8_BAR;
        PG8_STAGE(PG8_SB(1, 0), cB + kstep, voffB); PG8_STAGE(PG8_SA(1, 0), cA + kstep, voffA); PG8_STAGE(PG8_SB(1, 1), cB + hstep + kstep, voffB);
        PG8_WAIT_V(6); PG8_BAR;
    }
    for (;;) {
        const bool has_next = S.next(ui + 1, nxt);
        const char* nA = has_next ? (const char*)g.A + (size_t)nxt.pm * tstep : cA; const char* nB = has_next ? (const char*)g.Bt + (size_t)nxt.pn * tstep : cB;
#pragma unroll 1
        for (int t = 0; t < nt; t += 2) {
            const bool last = (t == nt - 2);
            const char* a1 = cA + (size_t)(t + 1) * kstep;
            const char* a2 = last ? nA : cA + (size_t)(t + 2) * kstep; const char* b2 = last ? nB : cB + (size_t)(t + 2) * kstep;
            const char* a3 = a2 + kstep; const char* b3 = b2 + kstep;
            if (last && has_next) S.a_ready(nxt);
            if constexpr (SP2) {
            PG8_LDB(B0, 0, 0); PG8_LDB(B1, 0, 1); PG8_SCHED; PG8_LDA(At, 0, 0); PG8_STAGE(PG8_SA(1, 1), a1 + hstep, voffA);
            PG8_WAIT_V(8); PG8_WAIT_L(0); PG8_BAR; PG8_MMA(0, 0, At, B0); PG8_MMA(0, 1, At, B1); PG8_BAR; PG8_SCHED;
            PG8_LDA(At, 0, 1); PG8_STAGE(PG8_SB(0, 0), b2, voffB); PG8_STAGE(PG8_SB(0, 1), b2 + hstep, voffB); PG8_STAGE(PG8_SA(0, 0), a2, voffA);
            PG8_WAIT_V(8); PG8_WAIT_L(0); PG8_BAR; PG8_MMA(1, 0, At, B0); PG8_MMA(1, 1, At, B1); PG8_BAR; PG8_SCHED;
            PG8_LDB(B0, 1, 0); PG8_LDB(B1, 1, 1); PG8_SCHED; PG8_LDA(At, 1, 0); PG8_STAGE(PG8_SA(0, 1), a2 + hstep, voffA);
            PG8_WAIT_V(8); PG8_WAIT_L(0); PG8_BAR; PG8_MMA(0, 0, At, B0); PG8_MMA(0, 1, At, B1); PG8_BAR; PG8_SCHED;
            PG8_LDA(At, 1, 1); PG8_STAGE(PG8_SB(1, 0), b3, voffB); PG8_STAGE(PG8_SB(1, 1), b3 + hstep, voffB); PG8_STAGE(PG8_SA(1, 0), a3, voffA);
            PG8_WAIT_V(8); PG8_WAIT_L(0); PG8_BAR; PG8_MMA(1, 0, At, B0); PG8_MMA(1, 1, At, B1); PG8_BAR; PG8_SCHED;
            } else {
            PG8_LDB(B0, 0, 0); PG8_SCHED; PG8_LDA(At, 0, 0); PG8_STAGE(PG8_SA(1, 1), a1 + hstep, voffA);
            PG8_WAIT_L(8); PG8_BAR; PG8_WAIT_L(0); PG8_MMA(0, 0, At, B0); PG8_BAR; PG8_SCHED;
            PG8_LDB(B1, 0, 1); PG8_STAGE(PG8_SB(0, 0), b2, voffB);
            PG8_BAR; PG8_WAIT_L(0); PG8_MMA(0, 1, At, B1); PG8_BAR;
            PG8_LDA(At, 0, 1); PG8_STAGE(PG8_SA(0, 0), a2, voffA);
            PG8_BAR; PG8_WAIT_L(0); PG8_MMA(1, 0, At, B0); PG8_BAR; PG8_SCHED;
            PG8_STAGE(PG8_SB(0, 1), b2 + hstep, voffB);
            PG8_WAIT_V(6); PG8_BAR; PG8_MMA(1, 1, At, B1); PG8_BAR;
            PG8_LDB(B0, 1, 0); PG8_SCHED; PG8_LDA(At, 1, 0); PG8_STAGE(PG8_SA(0, 1), a2 + hstep, voffA);
            PG8_WAIT_L(8); PG8_BAR; PG8_WAIT_L(0); PG8_MMA(0, 0, At, B0); PG8_BAR; PG8_SCHED;
            PG8_LDB(B1, 1, 1); PG8_STAGE(PG8_SB(1, 0), b3, voffB);
            PG8_BAR; PG8_WAIT_L(0); PG8_MMA(0, 1, At, B1); PG8_BAR;
            PG8_LDA(At, 1, 1); PG8_STAGE(PG8_SA(1, 0), a3, voffA);
            PG8_BAR; PG8_WAIT_L(0); PG8_MMA(1, 0, At, B0); PG8_BAR; PG8_SCHED;
            PG8_STAGE(PG8_SB(1, 1), b3 + hstep, voffB);
            PG8_WAIT_V(6); PG8_BAR; PG8_MMA(1, 1, At, B1); PG8_BAR;
            }
        }
        if constexpr (ALIGN_EPI) { if (wr == 0) PG8_BAR; }
        if constexpr (!Epi::AFTER_DRAIN) { int l2_; asm volatile("v_mbcnt_lo_u32_b32 %0, -1, 0\n\tv_mbcnt_hi_u32_b32 %0, -1, %0" : "=v"(l2_));
            E(acc, cur, wr, wc, l2_ & 15, l2_ >> 4); S.done(cur); }
        if (!has_next) break;
#pragma unroll
        for (int a = 0; a < 2; ++a)
#pragma unroll
            for (int b = 0; b < 2; ++b)
#pragma unroll
                for (int m = 0; m < 4; ++m)
#pragma unroll
                    for (int n = 0; n < 2; ++n) acc[a][b][m][n] = (f32x4){0.f, 0.f, 0.f, 0.f};
        cur = nxt; cA = nA; cB = nB; ++ui;
        if constexpr (ALIGN_EPI) { if (wr == 1) PG8_BAR; }
    }
    PG8_WAIT_V(0);
    if constexpr (!ALIGN_EPI) { if (wr == 0) PG8_BAR; }
    PG8_BAR;
    if constexpr (Epi::AFTER_DRAIN) { E.fused(acc, cur, wr, wc, fr, fq, lds, wid, lane); S.done(cur); }
#undef PG8_SA
#undef PG8_SB
#undef PG8_STAGE
#undef PG8_LDA
#undef PG8_LDB
#undef PG8_MMA
#undef PG8_WAIT_V
#undef PG8_WAIT_L
#undef PG8_BAR
#undef PG8_SCHED
}
}
#define GAS __attribute__((address_space(1)))
#define LAS __attribute__((address_space(3)))
typedef unsigned short bf16;
typedef unsigned v4u __attribute__((ext_vector_type(4)));
typedef float f32x4 __attribute__((ext_vector_type(4)));
typedef short bf16x8 __attribute__((ext_vector_type(8)));
typedef GAS unsigned gu32;
typedef GAS unsigned long long gu64;
#define RLX_AGENT __ATOMIC_RELAXED, __HIP_MEMORY_SCOPE_AGENT
#define LDS_WAIT() asm volatile("s_waitcnt lgkmcnt(0)" ::: "memory")
#define VM_WAIT() asm volatile("s_waitcnt vmcnt(0)" ::: "memory")
__device__ __forceinline__ unsigned long long rt() { return __builtin_amdgcn_s_memrealtime(); }
__device__ __forceinline__ unsigned f2bf(float f) { unsigned u = __builtin_bit_cast(unsigned, f); return (u + 0x7fffu + ((u >> 16) & 1u)) >> 16; }
__device__ __forceinline__ unsigned pk2(float lo, float hi) { return f2bf(lo) | (f2bf(hi) << 16); }

#define XB_TMO      128
#define XB_XCNT(j)  (256  + 64 * (j))
#define XB_XSUB(j)  (1280 + 64 * (j))
#define XB_XGEN(j)  (2304 + 64 * (j))
#define XB_TOP      3328
#define XB_TOPGEN   3392
#define XCD_BAR_WORDS 3456
#define XB_SPIN_CAP (1u << 18)

__device__ __forceinline__ unsigned xb_ld(unsigned* p)              { return __hip_atomic_load(p, __ATOMIC_RELAXED, __HIP_MEMORY_SCOPE_AGENT); }
__device__ __forceinline__ unsigned xb_add(unsigned* p, unsigned v) { return __hip_atomic_fetch_add(p, v, __ATOMIC_RELAXED, __HIP_MEMORY_SCOPE_AGENT); }
__device__ __forceinline__ unsigned xb_xcc_id() { return (unsigned)__builtin_amdgcn_s_getreg((3 << 11) | 20) & 0xFu; }
#define XB_SPIN(cond, bar) do { unsigned _sp = 0; while (cond) { __builtin_amdgcn_s_sleep(1); \
    if ((++_sp & 255u) == 0u) { if (xb_ld(&(bar)[XB_TMO])) break; if (_sp > XB_SPIN_CAP) { atomicAdd(&(bar)[XB_TMO], 1u); break; } } } } while (0)

struct XcdBarrier {
    int wv;
    unsigned* bar; unsigned x;
    volatile LAS unsigned* st;
};

__device__ __forceinline__ int xb_lane_id() { int l; asm volatile("v_mbcnt_lo_u32_b32 %0, -1, 0\n\tv_mbcnt_hi_u32_b32 %0, -1, %0" : "=v"(l)); return l; }
__device__ __forceinline__ XcdBarrier xcd_barrier_post(unsigned* bar, volatile LAS unsigned* st, int wv) {
    XcdBarrier b; b.wv = wv; b.bar = bar; b.x = xb_xcc_id(); b.st = st;
    if (wv == 0 && xb_lane_id() == 0) (void)xb_add(&bar[XB_XCNT(b.x)], 1u);
    return b;
}
__device__ __forceinline__ void xcd_barrier_complete(unsigned* bar, unsigned x, unsigned& nloc, unsigned& nx) {
    const unsigned G = gridDim.x * gridDim.y * gridDim.z;
    unsigned sum, cnt, mine, sp = 0u;
    for (;;) {
        sum = 0u; cnt = 0u; mine = 0u;
#pragma unroll
        for (unsigned j = 0; j < 16; ++j) { const unsigned c = xb_ld(&bar[XB_XCNT(j)]); sum += c; cnt += (c > 0u) ? 1u : 0u; mine = (j == x) ? c : mine; }
        if (sum == G) break;
        __builtin_amdgcn_s_sleep(1);
        if ((++sp & 255u) == 0u) { if (xb_ld(&bar[XB_TMO])) break; if (sp > XB_SPIN_CAP) { atomicAdd(&bar[XB_TMO], 1u); break; } }
    }
    nloc = mine > 0u ? mine : 1u; nx = cnt > 0u ? cnt : 1u;
}

__device__ __forceinline__ void xcd_barrier(const XcdBarrier& b) {
    asm volatile("s_waitcnt vmcnt(0)" ::: "memory");
    __syncthreads();
    if (b.wv == 0 && xb_lane_id() == 0) {
        unsigned* bar = b.bar;
        __builtin_amdgcn_s_waitcnt(0);
        unsigned nloc = b.st[0], nx = b.st[1];
        if (nloc == 0u) { xcd_barrier_complete(bar, b.x, nloc, nx); b.st[0] = nloc; b.st[1] = nx; }
        const unsigned old = xb_add(&bar[XB_XSUB(b.x)], 1u);
        const unsigned gen = old / nloc;
        if (old + 1u == (gen + 1u) * nloc) {
            __builtin_amdgcn_fence(__ATOMIC_RELEASE, "agent");
            asm volatile("s_waitcnt vmcnt(0)" ::: "memory");
            const unsigned og = xb_add(&bar[XB_TOP], 1u);
            const unsigned tg = og / nx;
            if (og + 1u == (tg + 1u) * nx) xb_add(&bar[XB_TOPGEN], 1u);
            else XB_SPIN(xb_ld(&bar[XB_TOPGEN]) == tg, bar);
            __builtin_amdgcn_fence(__ATOMIC_ACQUIRE, "agent");
            xb_add(&bar[XB_XGEN(b.x)], 1u);
            asm volatile("s_waitcnt vmcnt(0)" ::: "memory");
        } else {
            XB_SPIN(xb_ld(&bar[XB_XGEN(b.x)]) == gen, bar);
            __builtin_amdgcn_fence(__ATOMIC_ACQUIRE, "agent");
            asm volatile("s_waitcnt vmcnt(0)" ::: "memory");
        }
    }
    __syncthreads();
}
#define DI __device__ __forceinline__
constexpr int NWAVES = 8;
constexpr int NB = 16, SEQ = 2048, DM = 1024, MT = NB * SEQ;
constexpr int DIN_SRC = 6944, NPROJ = 7168;
constexpr int MEML = 256, MROWS = NB * MEML;
constexpr int NEXP = 32, TOPK = 4, DFF = 1024, MOEB = 256;
constexpr int NROWS = MT * TOPK;
constexpr int NBLK_MAX = (NROWS + NEXP * (MOEB - 1) + MOEB - 1) / MOEB;
constexpr int CAP = NBLK_MAX * MOEB;
constexpr float EPS = 1e-6f;
constexpr float NEGF = -1e30f;
constexpr int PC_MLQ = 0, PC_MLK = 512, PC_MLV = 1024, PC_MLO = 1536, PC_NQ = 2048, PC_NKC = 2560, PC_NVC = 2688, PC_NKS = 2816, PC_NVS = 2944,
              PC_NKW = 3072, PC_NVW = 3200, PC_MQ = 3328, PC_BRG = 3840, PC_MLI = 6912, PC_MLF = 6916, PC_NG = 6920, PC_END = 6944;
__host__ __device__ constexpr int proj_srccol(int j) {
    return j < 2048 ? j : j < 2560 ? 2056 + (j - 2048) : j < 3328 ? 2568 + (j - 2560) : j < 3840 ? 3360 + (j - 3328) : j < 6912 ? 3872 + (j - 3840)
         : j < 6920 ? 2048 + (j - 6912) : j < 6944 ? 3336 + (j - 6920) : -1;
}

constexpr size_t MiB = 1u << 20;
constexpr size_t WS_CTL = 0, CTL_ZERO_BYTES = 1 * MiB;
constexpr size_t WS_WIN = 1 * MiB, WS_WGU = 15 * MiB, WS_WDN = 143 * MiB, WS_WMKV = 207 * MiB, WS_WBR = 209 * MiB, WS_WOUT = 212 * MiB, WS_WC1 = 214 * MiB;
constexpr size_t WS_SMALL = 216 * MiB;
constexpr size_t WS_R1 = 218 * MiB;
constexpr size_t WS_PROJ = 282 * MiB;
constexpr size_t WS_R3 = 730 * MiB;
constexpr size_t WS_MEMKV = WS_R3, WS_MEMKN = WS_R3 + 8 * MiB, WS_QN = WS_R3 + 12 * MiB, WS_KSN = WS_R3 + 44 * MiB, WS_KWN = WS_R3 + 52 * MiB,
                 WS_MQN = WS_R3 + 60 * MiB, WS_MLQK = WS_R3 + 92 * MiB, WS_HID = WS_R3 + 156 * MiB, WS_KC = WS_R3 + 160 * MiB, WS_VC = WS_KC + MiB / 2,
                 WS_H0 = WS_R3 + 161 * MiB, WS_H1 = WS_H0 + 32 * MiB, WS_H2 = WS_H1 + 32 * MiB, WS_ROUTE = WS_H2 + 32 * MiB, WS_END = WS_ROUTE + 6 * MiB;
constexpr size_t WS_MLV = WS_R1, WS_VSN = WS_R1 + 32 * MiB, WS_VWN = WS_R1 + 40 * MiB;
constexpr size_t WS_MEMN = WS_H0;
constexpr size_t WS_ACMP = WS_H1;
constexpr size_t WS_APERM = WS_PROJ;
constexpr size_t WS_ACT = WS_PROJ + 272 * MiB;
static_assert(WS_ACT + 272 * MiB <= WS_H0 + 96 * MiB && WS_END <= 1024 * MiB, "ws map");
constexpr size_t SM_ROPEC = 0, SM_ROPES = 256 * 1024, SM_CBIAS = 512 * 1024, SM_WRT = 1024 * 1024;
constexpr size_t RT_TOKE = 0, RT_TOKPOS = 512 * 1024, RT_TOKW = 1024 * 1024, RT_TOKDEST = 1536 * 1024, RT_ROWW = 2048 * 1024;
constexpr int CW_BAR = 4096;
constexpr int CW_ECNT = 16384;
constexpr int CW_QCTR = 16384 + 64;

constexpr int RING_BYTES = 131072, LDSCTL_OFF = RING_BYTES, MISC_OFF = LDSCTL_OFF + 320, LDS_BYTES = 155648;

struct Args { const float* in[34]; float* out; unsigned char* ws; int ph_lo, ph_hi, li, pad; };

DI float bf2f(unsigned short h) { return __uint_as_float((unsigned)h << 16); }
DI float wave_sum(float v) {
#pragma unroll
    for (int o = 1; o < 64; o <<= 1) v += __shfl_xor(v, o);
    return v;
}
DI float wave_max(float v) {
#pragma unroll
    for (int o = 1; o < 64; o <<= 1) v = fmaxf(v, __shfl_xor(v, o));
    return v;
}
DI float sigm(float x) { return __builtin_amdgcn_rcpf(1.f + __expf(-x)); }
DI float logsig(float x) { return fminf(x, 0.f) - log1pf(__expf(-fabsf(x))); }

namespace pg8 {
struct EpiBf16Silu {
    static constexpr bool PERM = true, AFTER_DRAIN = false;
    bf16_t* O; int ldc; const float* bias; int silu;
    DI void operator()(const f32x4 (&acc)[2][2][4][2], const Unit& u, int wr, int wc, int fr, int fq) const {
        const int row0 = u.pm * BM + wr * 64 + fr; const int col0 = u.pn * BM + wc * 32 + 8 * fq;
#pragma unroll
        for (int ai = 0; ai < 2; ++ai)
#pragma unroll
            for (int m = 0; m < 4; ++m) { bf16_t* rowp = O + (size_t)(row0 + ai * HALF + m * 16) * ldc + col0;
#pragma unroll
                for (int bj = 0; bj < 2; ++bj) { f32x4 v0 = acc[ai][bj][m][0], v1 = acc[ai][bj][m][1];
                    if (bias) { v0 += *(const f32x4*)(bias + col0 + bj * HALF); v1 += *(const f32x4*)(bias + col0 + bj * HALF + 4); }
                    if (silu) {
#pragma unroll
                        for (int j = 0; j < 4; ++j) { v0[j] = v0[j] * __builtin_amdgcn_rcpf(1.f + __expf(-v0[j])); v1[j] = v1[j] * __builtin_amdgcn_rcpf(1.f + __expf(-v1[j])); } }
                    u32x4 w; w.x = cvt_pk_bf16(v0[0], v0[1]); w.y = cvt_pk_bf16(v0[2], v0[3]); w.z = cvt_pk_bf16(v1[0], v1[1]); w.w = cvt_pk_bf16(v1[2], v1[3]);
                    *(u32x4*)(rowp + bj * HALF) = w; } }
    }
};
template <int B> struct EpiGate {
    static constexpr bool PERM = false, AFTER_DRAIN = false;
    const bf16_t* proj; float* tmp; bf16_t* merged;
    DI void operator()(const f32x4 (&acc)[2][2][4][2], const Unit& u, int wr, int wc, int fr, int fq) const {
        typedef unsigned u32x2v __attribute__((ext_vector_type(2)));
        const int col0 = u.pn * BM + wc * 32 + 4 * fq;
#pragma unroll
        for (int ai = 0; ai < 2; ++ai)
#pragma unroll
            for (int m = 0; m < 4; ++m) { const size_t r = (size_t)(u.pm * BM + ai * HALF + wr * 64 + m * 16 + fr);
#pragma unroll
                for (int bj = 0; bj < 2; ++bj)
#pragma unroll
                    for (int n = 0; n < 2; ++n) { const int c = col0 + bj * HALF + n * 16;
                        const u32x2v gw = *(const u32x2v*)(proj + r * NPROJ + PC_BRG + B * DM + c);
                        f32x4 g; g[0] = __uint_as_float(gw.x << 16); g[1] = __uint_as_float(gw.x & 0xffff0000u); g[2] = __uint_as_float(gw.y << 16); g[3] = __uint_as_float(gw.y & 0xffff0000u);
                        f32x4 v = acc[ai][bj][m][n];
#pragma unroll
                        for (int j = 0; j < 4; ++j) v[j] = v[j] * __builtin_amdgcn_rcpf(1.f + __expf(-g[j]));
                        float* tp = tmp + r * DM + c;
                        if (B == 0) { *(f32x4*)tp = v; }
                        else if (B == 1) { *(f32x4*)tp = *(const f32x4*)tp + v; }
                        else { v = *(const f32x4*)tp + v; u32x2v w; w.x = cvt_pk_bf16(v[0], v[1]); w.y = cvt_pk_bf16(v[2], v[3]); *(u32x2v*)(merged + r * DM + c) = w; } } }
    }
};
struct EpiRes {
    static constexpr bool PERM = false, AFTER_DRAIN = false;
    const float* base; float* out;
    DI void operator()(const f32x4 (&acc)[2][2][4][2], const Unit& u, int wr, int wc, int fr, int fq) const {
        const int col0 = u.pn * BM + wc * 32 + 4 * fq;
#pragma unroll
        for (int ai = 0; ai < 2; ++ai)
#pragma unroll
            for (int m = 0; m < 4; ++m) { const size_t r = (size_t)(u.pm * BM + ai * HALF + wr * 64 + m * 16 + fr);
#pragma unroll
                for (int bj = 0; bj < 2; ++bj)
#pragma unroll
                    for (int n = 0; n < 2; ++n) { const int c = col0 + bj * HALF + n * 16; *(f32x4*)(out + r * DM + c) = *(const f32x4*)(base + r * DM + c) + acc[ai][bj][m][n]; } }
    }
};
struct EpiSwiglu {
    static constexpr bool PERM = true, AFTER_DRAIN = false;
    unsigned char* act; const float* bgu;
    DI void operator()(const f32x4 (&acc)[2][2][4][2], const Unit& u, int wr, int wc, int fr, int fq) const {
        typedef unsigned u32x2v __attribute__((ext_vector_type(2)));
        const int e = u.pn >> 3, pnl = u.pn & 7;
        const int lc0 = pnl * BM + wc * 32 + 8 * fq;
        const unsigned row0 = (unsigned)(u.pm * BM + wr * 64 + fr);
        const float* bp = bgu + e * 2048;
#pragma unroll
        for (int ai = 0; ai < 2; ++ai)
#pragma unroll
            for (int m = 0; m < 4; ++m) { const unsigned rowoff = (row0 + ai * HALF + m * 16) * (unsigned)DFF;
#pragma unroll
                for (int bj = 0; bj < 2; ++bj) {
                    const unsigned lc = (unsigned)(lc0 + bj * HALF);
                    const f32x4 b0 = *(const f32x4*)(bp + lc), b1 = *(const f32x4*)(bp + lc + 4);
                    const f32x4 v0 = acc[ai][bj][m][0] + b0, v1 = acc[ai][bj][m][1] + b1;
                    float o[4];
#pragma unroll
                    for (int q = 0; q < 4; ++q) { const float gt = fminf(q < 2 ? v0[2 * q] : v1[2 * q - 4], 7.0f); float up = q < 2 ? v0[2 * q + 1] : v1[2 * q - 3]; up = fminf(fmaxf(up, -7.0f), 7.0f);
                        o[q] = (up + 1.0f) * (gt * __builtin_amdgcn_rcpf(1.f + __expf(-1.702f * gt))); }
                    int q8 = 0; q8 = __builtin_amdgcn_cvt_pk_fp8_f32(o[0], o[1], q8, false); q8 = __builtin_amdgcn_cvt_pk_fp8_f32(o[2], o[3], q8, true);
                    *(unsigned*)(act + (rowoff + (lc >> 1))) = (unsigned)q8; } }
    }
};
struct EpiDown {
    static constexpr bool PERM = false, AFTER_DRAIN = false;
    bf16_t* y; const float* bdn; const float* roww;
    DI void operator()(const f32x4 (&acc)[2][2][4][2], const Unit& u, int wr, int wc, int fr, int fq) const {
        typedef unsigned u32x2v __attribute__((ext_vector_type(2)));
        const int e = u.pn >> 2, pnl = u.pn & 3;
        const int col0 = pnl * BM + wc * 32 + 4 * fq;
#pragma unroll
        for (int ai = 0; ai < 2; ++ai)
#pragma unroll
            for (int m = 0; m < 4; ++m) { const size_t r = (size_t)(u.pm * BM + ai * HALF + wr * 64 + m * 16 + fr); const float rw = roww[r];
#pragma unroll
                for (int bj = 0; bj < 2; ++bj)
#pragma unroll
                    for (int n = 0; n < 2; ++n) { const int c = col0 + bj * HALF + n * 16; const f32x4 v = (acc[ai][bj][m][n] + *(const f32x4*)(bdn + e * DM + c)) * rw;
                        u32x2v w; w.x = cvt_pk_bf16(v[0], v[1]); w.y = cvt_pk_bf16(v[2], v[3]); *(u32x2v*)(y + r * DM + c) = w; } }
    }
};
template <int NPN> struct MoeOrder {
    int nblk, G, c; const PG8_LAS unsigned char* blk_e;
    DI bool next(int i, Unit& u) const {
        int rb, pn;
        if (G == 256) { const int x = c & 7, j = c >> 3; rb = i * (256 / NPN) + x * (32 / NPN) + j / NPN; pn = j % NPN; }
        else { const int L = i * G + c; rb = L / NPN; pn = L % NPN; }
        if (rb >= nblk) return false;
        u.pm = rb; u.pn = __builtin_amdgcn_readfirstlane((int)blk_e[rb]) * NPN + pn; return true; }
    DI void a_ready(const Unit&) const {}
    DI void done(const Unit&) const {}
};
}

struct Frame {
    LAS unsigned char* lds; volatile LAS unsigned* MISC; unsigned* ctl; unsigned char* ws;
    int wave, G, bx;
    DI int lane_id() const { int l; asm volatile("v_mbcnt_lo_u32_b32 %0, -1, 0\n\tv_mbcnt_hi_u32_b32 %0, -1, %0" : "=v"(l)); return l; }
    DI int tid_id() const { return wave * 64 + lane_id(); }
    const float* const* in; float* out;
};
enum { I_X = 0, I_MEM, I_GMIX, I_WIN, I_CONVW, I_CONVB, I_MLBI, I_MLBF, I_MLGOUT, I_NGQ, I_NGK, I_CPK, I_CW1K, I_CB1K, I_CW2K, I_CPV, I_CW1V, I_CB1V, I_CW2V,
       I_GMEM, I_WMKV, I_MGQ, I_MGK, I_WBRML, I_WBRNSA, I_WBRMEM, I_WOUT, I_GFFN, I_WR, I_BR, I_WGU, I_BGU, I_WDN, I_BDN, N_IN };

template <class CM>
DI void tr_item(const float* W, int ldw, int K, bf16* WT, int k0, int n0, CM cm, LAS float* scr, int lane) {
    const int sc = cm(n0 + (lane & 31));
#pragma unroll 8
    for (int i = 0; i < 32; ++i) { const int kk = 2 * i + (lane >> 5); scr[kk * 33 + (lane & 31)] = sc >= 0 ? W[(size_t)(k0 + kk) * ldw + sc] : 0.f; }
    LDS_WAIT(); asm volatile("" ::: "memory");
    const int c = lane & 7;
#pragma unroll
    for (int j = 0; j < 4; ++j) { const int n = (lane >> 3) + 8 * j; const LAS float* s = scr + (8 * c) * 33 + n;
        v4u o; o.x = pk2(s[0 * 33], s[1 * 33]); o.y = pk2(s[2 * 33], s[3 * 33]); o.z = pk2(s[4 * 33], s[5 * 33]); o.w = pk2(s[6 * 33], s[7 * 33]);
        *(v4u*)(WT + (size_t)(n0 + n) * K + k0 + 8 * c) = o; }
    LDS_WAIT(); asm volatile("" ::: "memory");
}
DI void tr_item_f8(const float* W, int ldw, int K, unsigned char* WT, int k0, int n0, LAS float* scr, int lane) {
#pragma unroll 8
    for (int i = 0; i < 32; ++i) { const int kk = 2 * i + (lane >> 5); scr[kk * 33 + (lane & 31)] = W[(size_t)(k0 + kk) * ldw + n0 + (lane & 31)] * 256.0f; }
    LDS_WAIT(); asm volatile("" ::: "memory");
    const int c = lane & 7;
#pragma unroll
    for (int j = 0; j < 4; ++j) { const int n = (lane >> 3) + 8 * j; const LAS float* sp = scr + (8 * c) * 33 + n;
        int lo = 0, hi = 0;
        lo = __builtin_amdgcn_cvt_pk_fp8_f32(sp[0 * 33], sp[1 * 33], lo, false); lo = __builtin_amdgcn_cvt_pk_fp8_f32(sp[2 * 33], sp[3 * 33], lo, true);
        hi = __builtin_amdgcn_cvt_pk_fp8_f32(sp[4 * 33], sp[5 * 33], hi, false); hi = __builtin_amdgcn_cvt_pk_fp8_f32(sp[6 * 33], sp[7 * 33], hi, true);
        typedef unsigned u32x2t __attribute__((ext_vector_type(2)));
        *(u32x2t*)(WT + (size_t)(n0 + n) * K + k0 + 8 * c) = (u32x2t){(unsigned)lo, (unsigned)hi}; }
    LDS_WAIT(); asm volatile("" ::: "memory");
}
DI void tr_fill_v4(const float* W, int ldw, int k0, int n0, LAS float* scr, int lane, float mul) {
    f32x4 v[8];
#pragma unroll
    for (int i = 0; i < 8; ++i) v[i] = *(const f32x4*)(W + (size_t)(k0 + 8 * i + (lane >> 3)) * ldw + n0 + 4 * (lane & 7));
#pragma unroll
    for (int i = 0; i < 8; ++i) { LAS float* d = scr + (8 * i + (lane >> 3)) * 33 + 4 * (lane & 7); d[0] = v[i].x * mul; d[1] = v[i].y * mul; d[2] = v[i].z * mul; d[3] = v[i].w * mul; }
    LDS_WAIT(); asm volatile("" ::: "memory");
}
DI void tr_emit_bf16(bf16* WT, int K, int k0, int n0, LAS float* scr, int lane) {
    const int c = lane & 7;
#pragma unroll
    for (int j = 0; j < 4; ++j) { const int n = (lane >> 3) + 8 * j; const LAS float* sp = scr + (8 * c) * 33 + n;
        v4u o; o.x = pk2(sp[0 * 33], sp[1 * 33]); o.y = pk2(sp[2 * 33], sp[3 * 33]); o.z = pk2(sp[4 * 33], sp[5 * 33]); o.w = pk2(sp[6 * 33], sp[7 * 33]);
        *(v4u*)(WT + (size_t)(n0 + n) * K + k0 + 8 * c) = o; }
    LDS_WAIT(); asm volatile("" ::: "memory");
}
DI void tr_emit_f8(unsigned char* WT, int K, int k0, int n0, LAS float* scr, int lane) {
    const int c = lane & 7;
#pragma unroll
    for (int j = 0; j < 4; ++j) { const int n = (lane >> 3) + 8 * j; const LAS float* sp = scr + (8 * c) * 33 + n;
        int lo = 0, hi = 0;
        lo = __builtin_amdgcn_cvt_pk_fp8_f32(sp[0 * 33], sp[1 * 33], lo, false); lo = __builtin_amdgcn_cvt_pk_fp8_f32(sp[2 * 33], sp[3 * 33], lo, true);
        hi = __builtin_amdgcn_cvt_pk_fp8_f32(sp[4 * 33], sp[5 * 33], hi, false); hi = __builtin_amdgcn_cvt_pk_fp8_f32(sp[6 * 33], sp[7 * 33], hi, true);
        typedef unsigned u32x2t __attribute__((ext_vector_type(2)));
        *(u32x2t*)(WT + (size_t)(n0 + n) * K + k0 + 8 * c) = (u32x2t){(unsigned)lo, (unsigned)hi}; }
    LDS_WAIT(); asm volatile("" ::: "memory");
}
struct CmId { DI int operator()(int j) const { return j; } };
struct CmProj { DI int operator()(int j) const { return proj_srccol(j); } };

DI void rms_row_bf16(const float* xrow, const float* g, bf16* orow, int lane) {
    const f32x4* xr = (const f32x4*)xrow + lane; const f32x4* gr = (const f32x4*)g + lane;
    f32x4 v[4]; float s = 0.f;
#pragma unroll
    for (int j = 0; j < 4; ++j) { v[j] = xr[64 * j]; s += (v[j].x * v[j].x + v[j].y * v[j].y) + (v[j].z * v[j].z + v[j].w * v[j].w); }
    const float rstd = rsqrtf(wave_sum(s) * (1.f / DM) + EPS);
    unsigned long long* o8 = (unsigned long long*)orow + lane;
#pragma unroll
    for (int j = 0; j < 4; ++j) { const f32x4 gg = gr[64 * j];
        o8[64 * j] = (unsigned long long)pk2(v[j].x * rstd * gg.x, v[j].y * rstd * gg.y) | ((unsigned long long)pk2(v[j].z * rstd * gg.z, v[j].w * rstd * gg.w) << 32); }
}

DI void p0_prologue(Frame& F) {
    LAS float* scr = (LAS float*)(F.lds + F.wave * 16384);
    const int gw = F.bx * NWAVES + F.wave, NGW = F.G * NWAVES;
    unsigned char* ws = F.ws;
    constexpr int IT_IN = 16 * (NPROJ / 32), IT_GU = 32 * 16 * 64, IT_DN = 32 * 16 * 32, IT_MKV = 16 * 32, IT_BR = 3 * 8 * 32, IT_OUT = 16 * 32, IT_C1 = 2 * 32 * 8;
    constexpr int NITEMS = IT_IN + IT_GU + IT_DN + IT_MKV + IT_BR + IT_OUT + IT_C1;
    for (int it = gw; it < NITEMS; it += NGW) {
        int r = it;
        if (r < IT_IN) { const int kb = r / (NPROJ / 32), nb = r % (NPROJ / 32); tr_item(F.in[I_WIN], DIN_SRC, DM, (bf16*)(ws + WS_WIN), 64 * kb, 32 * nb, CmProj(), scr, F.lane_id()); continue; } r -= IT_IN;
        if (r < IT_GU) { const int e = r / 1024, q = r % 1024, kb = q / 64, nb = q % 64; tr_fill_v4(F.in[I_WGU] + (size_t)e * DM * 2048, 2048, 64 * kb, 32 * nb, scr, F.lane_id(), 256.0f); tr_emit_f8((unsigned char*)(ws + WS_WGU) + (size_t)e * 2048 * DM, DM, 64 * kb, 32 * nb, scr, F.lane_id()); continue; } r -= IT_GU;
        if (r < IT_DN) { const int e = r / 512, q = r % 512, kb = q / 32, nb = q % 32; tr_fill_v4(F.in[I_WDN] + (size_t)e * DFF * DM, DM, 64 * kb, 32 * nb, scr, F.lane_id(), 256.0f); tr_emit_f8((unsigned char*)(ws + WS_WDN) + (size_t)e * DM * DFF, DFF, 64 * kb, 32 * nb, scr, F.lane_id()); continue; } r -= IT_DN;
        if (r < IT_MKV) { const int kb = r / 32, nb = r % 32; tr_fill_v4(F.in[I_WMKV], 1024, 64 * kb, 32 * nb, scr, F.lane_id(), 1.0f); tr_emit_bf16((bf16*)(ws + WS_WMKV), 1024, 64 * kb, 32 * nb, scr, F.lane_id()); continue; } r -= IT_MKV;
        if (r < IT_BR) { const int b = r / 256, q = r % 256, kb = q / 32, nb = q % 32; tr_fill_v4(F.in[I_WBRML + b], 1024, 64 * kb, 32 * nb, scr, F.lane_id(), 1.0f); tr_emit_bf16((bf16*)(ws + WS_WBR) + (size_t)b * 1024 * 512, 512, 64 * kb, 32 * nb, scr, F.lane_id()); continue; } r -= IT_BR;
        if (r < IT_OUT) { const int kb = r / 32, nb = r % 32; tr_fill_v4(F.in[I_WOUT], 1024, 64 * kb, 32 * nb, scr, F.lane_id(), 1.0f); tr_emit_bf16((bf16*)(ws + WS_WOUT), 1024, 64 * kb, 32 * nb, scr, F.lane_id()); continue; } r -= IT_OUT;
        { const int kv = r / 256, q = r % 256, kb = q / 8, nb = q % 8; tr_fill_v4(F.in[kv ? I_CW1V : I_CW1K], 256, 64 * kb, 32 * nb, scr, F.lane_id(), 1.0f); tr_emit_bf16((bf16*)(ws + WS_WC1) + (size_t)kv * 256 * 2048, 2048, 64 * kb, 32 * nb, scr, F.lane_id()); }
    }
    for (int m = gw; m < MT; m += NGW) rms_row_bf16(F.in[I_X] + (size_t)m * DM, F.in[I_GMIX], (bf16*)(ws + WS_R1) + (size_t)m * DM, F.lane_id());
    for (int m = gw; m < MROWS; m += NGW) rms_row_bf16(F.in[I_MEM] + (size_t)m * DM, F.in[I_GMEM], (bf16*)(ws + WS_MEMN) + (size_t)m * DM, F.lane_id());
    float* rc = (float*)(ws + WS_SMALL + SM_ROPEC); float* rs = (float*)(ws + WS_SMALL + SM_ROPES);
    for (int i = F.bx * 512 + F.tid_id(); i < SEQ * 32; i += F.G * 512) {
        const int p = i >> 5, k = i & 31;
        const float invf = exp2f(-(float)k * (13.287712379549449f / 32.0f));
        const float ang = (float)p * invf;
        const float kf = rintf(ang * 0.15915494309189535f);
        float r = fmaf(-kf, 6.28125f, ang); r = fmaf(-kf, 1.9353071795864769e-3f, r);
        rc[i] = cosf(r); rs[i] = sinf(r);
    }
    { bf16* wrt = (bf16*)(ws + WS_SMALL + SM_WRT);
      for (int i = F.bx * 512 + F.tid_id(); i < 32 * 1024; i += F.G * 512) { const int e = i >> 10, k = i & 1023; const float w = F.in[I_WR][k * 32 + e]; const unsigned hi = f2bf(w); wrt[i] = (bf16)hi; wrt[32 * 1024 + i] = (bf16)f2bf(w - __uint_as_float(hi << 16)); } }
    if (F.bx == F.G - 1) {
        const int kv = F.tid_id() >> 8, f = F.tid_id() & 255;
        const float* pe = F.in[kv ? I_CPV : I_CPK]; const float* w1 = F.in[kv ? I_CW1V : I_CW1K];
        float a = F.in[kv ? I_CB1V : I_CB1K][f];
        for (int k = 0; k < 2048; ++k) a = fmaf(pe[k], w1[(size_t)k * 256 + f], a);
        ((float*)(ws + WS_SMALL + SM_CBIAS))[kv * 256 + f] = a;
    }
}

DI void unpack8(const v4u& w, float (&f)[8]) {
    f[0] = __uint_as_float(w.x << 16); f[1] = __uint_as_float(w.x & 0xffff0000u); f[2] = __uint_as_float(w.y << 16); f[3] = __uint_as_float(w.y & 0xffff0000u);
    f[4] = __uint_as_float(w.z << 16); f[5] = __uint_as_float(w.z & 0xffff0000u); f[6] = __uint_as_float(w.w << 16); f[7] = __uint_as_float(w.w & 0xffff0000u);
}
DI v4u pack8f(const float (&f)[8]) { v4u o; o.x = pk2(f[0], f[1]); o.y = pk2(f[2], f[3]); o.z = pk2(f[4], f[5]); o.w = pk2(f[6], f[7]); return o; }
DI void load8f(const float* p, float (&f)[8]) { const f32x4 a = *(const f32x4*)p, b = *(const f32x4*)(p + 4); f[0] = a.x; f[1] = a.y; f[2] = a.z; f[3] = a.w; f[4] = b.x; f[5] = b.y; f[6] = b.z; f[7] = b.w; }
DI void norm_rope64(float (&f)[8], const float (&g)[8], const float (&c8)[8], const float (&s8)[8], int lane, float scale) {
    float ss = 0.f;
#pragma unroll
    for (int i = 0; i < 8; ++i) ss = fmaf(f[i], f[i], ss);
    ss += __shfl_xor(ss, 1); ss += __shfl_xor(ss, 2); ss += __shfl_xor(ss, 4);
    const float rstd = rsqrtf(ss * (1.f / 64.f) + EPS);
    const bool hi = (lane & 4) != 0;
#pragma unroll
    for (int i = 0; i < 8; ++i) { const float y = f[i] * rstd * g[i]; const float pt = __shfl_xor(y, 4); f[i] = (hi ? fmaf(pt, s8[i], y * c8[i]) : fmaf(-pt, s8[i], y * c8[i])) * scale; }
}
DI void p2_prep(Frame& F) {
    unsigned char* ws = F.ws;
    const int gw = F.bx * NWAVES + F.wave, NGW = F.G * NWAVES, lane = F.lane_id();
    const bf16* proj = (const bf16*)(ws + WS_PROJ);
    const float* rc = (const float*)(ws + WS_SMALL + SM_ROPEC); const float* rs = (const float*)(ws + WS_SMALL + SM_ROPES);
    bf16* qn = (bf16*)(ws + WS_QN); bf16* ksn = (bf16*)(ws + WS_KSN); bf16* kwn = (bf16*)(ws + WS_KWN); bf16* mqn = (bf16*)(ws + WS_MQN); bf16* mlqk = (bf16*)(ws + WS_MLQK);
    bf16* acmp = (bf16*)(ws + WS_ACMP);
    constexpr int NT = 4;
    {
        float gq8[8], mg8[8]; load8f(F.in[I_NGQ] + 8 * (lane & 7), gq8); load8f(F.in[I_MGQ] + 8 * (lane & 15), mg8);
        for (int t0 = gw * NT; t0 < MT; t0 += NGW * NT) {
            v4u a[NT], bq[NT], cv[NT]; float c8[NT][8], s8[NT][8];
#pragma unroll
            for (int u = 0; u < NT; ++u) { const int t = t0 + u, tau = t & 2047; const bf16* pr = proj + (size_t)t * NPROJ;
                a[u] = *(const v4u*)(pr + PC_NQ + 8 * lane); bq[u] = *(const v4u*)(pr + PC_MQ + 8 * lane); cv[u] = *(const v4u*)(pr + PC_MLV + 8 * lane);
                load8f(rc + tau * 32 + 8 * (lane & 3), c8[u]); load8f(rs + tau * 32 + 8 * (lane & 3), s8[u]); }
#pragma unroll
            for (int u = 0; u < NT; ++u) { const int t = t0 + u;
                float f[8]; unpack8(a[u], f);
                norm_rope64(f, gq8, c8[u], s8[u], lane, 0.125f * 1.4426950408889634f);
                *(v4u*)(qn + (size_t)t * 512 + 8 * lane) = pack8f(f);
                unpack8(bq[u], f);
                float ss = 0.f;
#pragma unroll
                for (int i = 0; i < 8; ++i) ss = fmaf(f[i], f[i], ss);
                ss += __shfl_xor(ss, 1); ss += __shfl_xor(ss, 2); ss += __shfl_xor(ss, 4); ss += __shfl_xor(ss, 8);
                const float rstd = rsqrtf(ss * (1.f / 128.f) + EPS) * (0.08838834764831845f * 1.4426950408889634f);
#pragma unroll
                for (int i = 0; i < 8; ++i) f[i] *= rstd * mg8[i];
                *(v4u*)(mqn + (size_t)t * 512 + 8 * lane) = pack8f(f);
                *(v4u*)((bf16*)(ws + WS_MLV) + (size_t)t * 512 + 8 * lane) = cv[u]; }
        }
    }
    {
        const int L = lane & 31, hd4 = L >> 3, j = L & 7, half = lane >> 5;
        float gk8[8]; load8f(F.in[I_NGK] + (1 + (hd4 >> 1)) * 64 + 8 * j, gk8);
        const int kcol = (hd4 < 2 ? PC_NKS + hd4 * 64 : PC_NKW + (hd4 - 2) * 64) + 8 * j;
        bf16* kdst = (hd4 < 2 ? ksn : kwn) + (hd4 & 1) * 64 + 8 * j;
        const int kv = hd4 >> 1, hh = hd4 & 1, wv = L >> 4, jj = L & 15;
        bf16* vdst = (bf16*)(ws + (wv ? WS_VWN : WS_VSN)) + 8 * jj; const int vcol = (wv ? PC_NVW : PC_NVS) + 8 * jj;
        for (int tp0 = gw * NT; tp0 < MT / 2; tp0 += NGW * NT) {
            v4u a[NT], vv[NT], cv[NT]; float c8[NT][8], s8[NT][8];
#pragma unroll
            for (int u = 0; u < NT; ++u) { const int t = 2 * (tp0 + u) + half, tau = t & 2047; const bf16* pr = proj + (size_t)t * NPROJ;
                a[u] = *(const v4u*)(pr + kcol); vv[u] = *(const v4u*)(pr + vcol); cv[u] = *(const v4u*)(pr + PC_NKC + hd4 * 64 + 8 * j);
                load8f(rc + tau * 32 + 8 * (lane & 3), c8[u]); load8f(rs + tau * 32 + 8 * (lane & 3), s8[u]); }
#pragma unroll
            for (int u = 0; u < NT; ++u) { const int t = 2 * (tp0 + u) + half, b = t >> 11, tau = t & 2047;
                float f[8]; unpack8(a[u], f);
                norm_rope64(f, gk8, c8[u], s8[u], lane, 1.0f);
                *(v4u*)(kdst + (size_t)t * 128) = pack8f(f);
                *(v4u*)(vdst + (size_t)t * 128) = vv[u];
                const int nA = tau >> 4;
#pragma unroll
                for (int dn = 0; dn < 2; ++dn) { const int n = nA - dn; if (n >= 0 && n <= 126) { const int l = tau - 16 * n;
                    *(v4u*)(acmp + (size_t)kv * 4096 * 2048 + (size_t)((b * 2 + hh) * 128 + n) * 2048 + l * 64 + 8 * j) = cv[u]; } } }
        }
    }
    for (int run = gw; run < MT / 16; run += NGW) {
        const int t0 = run * 16, tau0 = t0 & 2047;
#pragma unroll 1
        for (int sp = 0; sp < 2; ++sp) {
            const int ch = 512 * sp + 8 * lane;
            float w0[8], w1[8], w2[8], w3[8], bb[8];
            load8f(F.in[I_CONVW] + ch, w0); load8f(F.in[I_CONVW] + 1024 + ch, w1); load8f(F.in[I_CONVW] + 2048 + ch, w2); load8f(F.in[I_CONVW] + 3072 + ch, w3); load8f(F.in[I_CONVB] + ch, bb);
            float x0[8], x1[8], x2[8];
            if (tau0 >= 3) { unpack8(*(const v4u*)(proj + (size_t)(t0 - 3) * NPROJ + ch), x0); unpack8(*(const v4u*)(proj + (size_t)(t0 - 2) * NPROJ + ch), x1); unpack8(*(const v4u*)(proj + (size_t)(t0 - 1) * NPROJ + ch), x2); }
            else {
#pragma unroll
                for (int i = 0; i < 8; ++i) { x0[i] = 0.f; x1[i] = 0.f; x2[i] = 0.f; } }
#pragma unroll 1
            for (int k0 = 0; k0 < 16; k0 += 4) {
                v4u raw[4];
#pragma unroll
                for (int k = 0; k < 4; ++k) raw[k] = *(const v4u*)(proj + (size_t)(t0 + k0 + k) * NPROJ + ch);
#pragma unroll
                for (int k = 0; k < 4; ++k) { float x3[8], y[8]; unpack8(raw[k], x3);
#pragma unroll
                    for (int i = 0; i < 8; ++i) { const float a = fmaf(w3[i], x3[i], fmaf(w2[i], x2[i], fmaf(w1[i], x1[i], fmaf(w0[i], x0[i], bb[i])))); y[i] = a * sigm(a); x0[i] = x1[i]; x1[i] = x2[i]; x2[i] = x3[i]; }
                    *(v4u*)(mlqk + (size_t)(t0 + k0 + k) * 1024 + ch) = pack8f(y); }
            }
        }
    }
    for (int i = F.bx * 512 + F.tid_id(); i < 2 * 32 * 2048; i += F.G * 512) { const int kv = i / (32 * 2048), q = i % (32 * 2048), bh = q / 2048, col = q % 2048;
        acmp[(size_t)kv * 4096 * 2048 + (size_t)(bh * 128 + 127) * 2048 + col] = 0; }
    {
        const bf16* memkv = (const bf16*)(ws + WS_MEMKV); bf16* memkn = (bf16*)(ws + WS_MEMKN);
        float kg8[8]; load8f(F.in[I_MGK] + 8 * (lane & 15), kg8);
        for (int r = gw; r < MROWS; r += NGW) {
            float f[8]; unpack8(*(const v4u*)(memkv + (size_t)r * 1024 + 8 * lane), f);
            float ss = 0.f;
#pragma unroll
            for (int i = 0; i < 8; ++i) ss = fmaf(f[i], f[i], ss);
            ss += __shfl_xor(ss, 1); ss += __shfl_xor(ss, 2); ss += __shfl_xor(ss, 4); ss += __shfl_xor(ss, 8);
            const float rstd = rsqrtf(ss * (1.f / 128.f) + EPS);
#pragma unroll
            for (int i = 0; i < 8; ++i) f[i] *= rstd * kg8[i];
            *(v4u*)(memkn + (size_t)r * 512 + 8 * lane) = pack8f(f);
        }
    }
}

DI void p4_kcvc(Frame& F) {
    unsigned char* ws = F.ws;
    const int gw = F.bx * NWAVES + F.wave, NGW = F.G * NWAVES, lane = F.lane_id();
    const bf16* hid = (const bf16*)(ws + WS_HID);
    const float* rc = (const float*)(ws + WS_SMALL + SM_ROPEC); const float* rs = (const float*)(ws + WS_SMALL + SM_ROPES);
    const float gk = F.in[I_NGK][lane];
    for (int it = gw; it < 2 * 4096; it += NGW) {
        const int kv = it >> 12, r = it & 4095, n = r & 127;
        bf16* dst = (bf16*)(ws + (kv ? WS_VC : WS_KC)) + (size_t)r * 64 + lane;
        if (n == 127) { *dst = 0; continue; }
        const bf16* hr = hid + (size_t)kv * 4096 * 256 + (size_t)r * 256; const float* w2 = F.in[kv ? I_CW2V : I_CW2K];
        float a = 0.f;
        for (int f = 0; f < 256; ++f) a = fmaf(bf2f(hr[f]), w2[f * 64 + lane], a);
        if (kv == 0) {
            const float y = a * rsqrtf(wave_sum(a * a) * (1.f / 64.f) + EPS) * gk;
            const int pos = 16 * n + 31; const float c = rc[pos * 32 + (lane & 31)], s = rs[pos * 32 + (lane & 31)];
            const float pt = __shfl_xor(y, 32);
            a = lane < 32 ? y * c - pt * s : y * c + pt * s;
        }
        *dst = (bf16)f2bf(a);
    }
}

DI void mlstm_unit(Frame& F, int unit) {
    unsigned char* ws = F.ws;
    const int b = unit >> 2, h = unit & 3, tid = F.tid_id(), kk = tid >> 7, c = tid & 127;
    const bf16* proj = (const bf16*)(ws + WS_PROJ); const bf16* mlqk = (const bf16*)(ws + WS_MLQK); bf16* H0 = (bf16*)(ws + WS_H0);
    LAS float* qs = (LAS float*)F.lds;
    LAS float* ks = qs + 16 * 128;
    LAS float* vs = ks + 16 * 128;
    LAS float* gi = vs + 16 * 128;
    LAS float* gf = gi + 16;
    LAS float* part = gf + 16;
    LAS float* pden = part + 2 * 4 * 128;
    LAS float* hb = pden + 8;
    float C[32], nn[32];
#pragma unroll
    for (int i = 0; i < 32; ++i) { C[i] = 0.f; nn[i] = 0.f; }
    float m = 0.f;
    const float bi = F.in[I_MLBI][h], bfv = F.in[I_MLBF][h];
    const float scale = 0.08838834764831845f;
#pragma unroll 1
    for (int t0 = 0; t0 < SEQ; t0 += 16) {
        __syncthreads();
        for (int i = tid; i < 16 * 128; i += 512) { const int s = i >> 7, d = i & 127; const size_t t = (size_t)b * SEQ + t0 + s;
            qs[i] = bf2f(mlqk[t * 1024 + h * 128 + d]); ks[i] = bf2f(mlqk[t * 1024 + 512 + h * 128 + d]); vs[i] = bf2f(proj[t * NPROJ + PC_MLV + h * 128 + d]); }
        if (tid < 16) { const size_t t = (size_t)b * SEQ + t0 + tid; gi[tid] = bf2f(proj[t * NPROJ + PC_MLI + h]) + bi; gf[tid] = logsig(bf2f(proj[t * NPROJ + PC_MLF + h]) + bfv); }
        __syncthreads();
#pragma unroll 1
        for (int s = 0; s < 16; ++s) {
            const float lf = gf[s], ig = gi[s];
            const float mn = fmaxf(lf + m, ig), a = __expf(lf + m - mn), bb = __expf(ig - mn);
            m = mn;
            const float v = vs[s * 128 + c];
            float pn = 0.f, pd = 0.f;
#pragma unroll
            for (int i = 0; i < 32; ++i) { const float kvv = ks[s * 128 + kk * 32 + i], qv = qs[s * 128 + kk * 32 + i];
                C[i] = a * C[i] + bb * kvv * v; nn[i] = a * nn[i] + bb * kvv; pn = fmaf(qv, C[i], pn); pd = fmaf(qv, nn[i], pd); }
            const int par = s & 1;
            part[(par * 4 + kk) * 128 + c] = pn; if (c == 0) pden[par * 4 + kk] = pd;
            __syncthreads();
            if (kk == 0) {
                const float num = (part[(par * 4 + 0) * 128 + c] + part[(par * 4 + 1) * 128 + c]) + (part[(par * 4 + 2) * 128 + c] + part[(par * 4 + 3) * 128 + c]);
                const float den = (pden[par * 4 + 0] + pden[par * 4 + 1]) + (pden[par * 4 + 2] + pden[par * 4 + 3]);
                hb[s * 128 + c] = num * scale / fmaxf(fabsf(den * scale), __expf(-mn));
            }
        }
        __syncthreads();
#pragma unroll
        for (int rr = 0; rr < 2; ++rr) { const int s = F.wave * 2 + rr; const size_t t = (size_t)b * SEQ + t0 + s;
            const float v0 = hb[s * 128 + F.lane_id()], v1 = hb[s * 128 + 64 + F.lane_id()];
            const float rstd = rsqrtf(wave_sum(v0 * v0 + v1 * v1) * (1.f / 128.f) + EPS);
            const float o0 = bf2f(proj[t * NPROJ + PC_MLO + h * 128 + F.lane_id()]), o1 = bf2f(proj[t * NPROJ + PC_MLO + h * 128 + 64 + F.lane_id()]);
            H0[t * 512 + h * 128 + F.lane_id()] = (bf16)f2bf(v0 * rstd * F.in[I_MLGOUT][h * 128 + F.lane_id()] * sigm(o0));
            H0[t * 512 + h * 128 + 64 + F.lane_id()] = (bf16)f2bf(v1 * rstd * F.in[I_MLGOUT][h * 128 + 64 + F.lane_id()] * sigm(o1)); }
    }
    __syncthreads();
}

DI void nsa_scores(const bf16* krow, bool valid, const LAS float* qs, float (&s)[4]) {
    s[0] = s[1] = s[2] = s[3] = 0.f;
    if (valid) {
#pragma unroll 2
        for (int c8 = 0; c8 < 8; ++c8) { const v4u kk = *(const v4u*)(krow + c8 * 8);
            const unsigned w[4] = {kk.x, kk.y, kk.z, kk.w};
#pragma unroll
            for (int j = 0; j < 4; ++j) { const float k0 = __uint_as_float(w[j] << 16), k1 = __uint_as_float(w[j] & 0xffff0000u); const int d = c8 * 8 + 2 * j;
#pragma unroll
                for (int g = 0; g < 4; ++g) s[g] = fmaf(k1, qs[g * 64 + d + 1], fmaf(k0, qs[g * 64 + d], s[g])); } }
    }
}
DI void nsa_wave(Frame& F, int item, LAS float* wl) {
    unsigned char* ws = F.ws; const int lane = F.lane_id();
    const int t = item >> 1, hkv = item & 1, b = t >> 11, tau = t & 2047;
    const bf16* proj = (const bf16*)(ws + WS_PROJ);
    const bf16* qn = (const bf16*)(ws + WS_QN); const bf16* ksn = (const bf16*)(ws + WS_KSN); const bf16* kwn = (const bf16*)(ws + WS_KWN);
    const bf16* kc = (const bf16*)(ws + WS_KC); const bf16* vc = (const bf16*)(ws + WS_VC); bf16* H1 = (bf16*)(ws + WS_H1);
    LAS float* qs = wl;
    LAS float* ps = wl + 256;
    LAS float* psum = wl + 768;
#pragma unroll
    for (int g = 0; g < 4; ++g) qs[g * 64 + lane] = bf2f(qn[(size_t)t * 512 + (hkv * 4 + g) * 64 + lane]);
    float ofin[4] = {0.f, 0.f, 0.f, 0.f};
    float gate[4][3];
#pragma unroll
    for (int g = 0; g < 4; ++g)
#pragma unroll
        for (int cidx = 0; cidx < 3; ++cidx) gate[g][cidx] = sigm(bf2f(proj[(size_t)t * NPROJ + PC_NG + (hkv * 4 + g) * 3 + cidx]));
    const int ncmp = tau >= 31 ? ((tau - 31) >> 4) + 1 : 0;
    {
        float l[4] = {0.f, 0.f, 0.f, 0.f}, o[4] = {0.f, 0.f, 0.f, 0.f};
        const size_t rbase = (size_t)(b * 2 + hkv) * 128;
#pragma unroll
        for (int blk = 0; blk < 2; ++blk) { const int n = blk * 64 + lane; const bool valid = n < ncmp; float s[4];
            nsa_scores(kc + (rbase + n) * 64, valid, qs, s);
#pragma unroll
            for (int g = 0; g < 4; ++g) { const float p = valid ? __expf(s[g]) : 0.f; l[g] += p; ps[g * 128 + n] = p; } }
        float inv[4];
#pragma unroll
        for (int g = 0; g < 4; ++g) { const float L = wave_sum(l[g]); inv[g] = L > 0.f ? 1.f / L : 0.f; }
#pragma unroll
        for (int blk = 0; blk < 2; ++blk) { const int n = blk * 64 + lane; psum[n] = (ps[0 * 128 + n] * inv[0] + ps[1 * 128 + n] * inv[1]) + (ps[2 * 128 + n] * inv[2] + ps[3 * 128 + n] * inv[3]); }
#pragma unroll 2
        for (int n = 0; n < ncmp; ++n) { const float vv = bf2f(vc[(rbase + n) * 64 + lane]);
#pragma unroll
            for (int g = 0; g < 4; ++g) o[g] = fmaf(ps[g * 128 + n], vv, o[g]); }
#pragma unroll
        for (int g = 0; g < 4; ++g) ofin[g] += gate[g][0] * o[g] * inv[g];
    }
    const int cur = tau >> 6;
    unsigned selmask = 0u;
    {
        float score = -3.0e38f;
        if (lane < 32) { const int j = lane; float imp = 0.f;
#pragma unroll
            for (int dn = -1; dn <= 3; ++dn) { const int n = 4 * j + dn; if (n >= 0 && n <= 126) imp += psum[n]; }
            const bool forced = (j == 0) || (j == cur) || (j == cur - 1);
            score = j > cur ? NEGF : imp + (forced ? 1.0e4f : 0.f); }
#pragma unroll 1
        for (int r = 0; r < 8; ++r) { const float mx = wave_max(score); const unsigned long long bal = __ballot(score == mx); const int win = __ffsll((long long)bal) - 1;
            selmask |= 1u << win; if (lane == win) score = -3.4e38f; }
    }
    {
        float l[4] = {0.f, 0.f, 0.f, 0.f}, o[4] = {0.f, 0.f, 0.f, 0.f};
#pragma unroll 1
        for (int j = 0; j <= cur; ++j) { if (!((selmask >> j) & 1u)) continue;
            const int kpos = 64 * j + lane; const bool valid = kpos <= tau; float s[4];
            nsa_scores(ksn + ((size_t)b * SEQ + kpos) * 128 + hkv * 64, valid, qs, s);
#pragma unroll
            for (int g = 0; g < 4; ++g) { const float p = valid ? __expf(s[g]) : 0.f; l[g] += p; ps[g * 128 + lane] = p; }
            const int nk = j == cur ? (tau & 63) + 1 : 64;
            const bf16* vb = proj + ((size_t)b * SEQ + 64 * j) * NPROJ + PC_NVS + hkv * 64 + lane;
#pragma unroll 2
            for (int k = 0; k < nk; ++k) { const float vv = bf2f(vb[(size_t)k * NPROJ]);
#pragma unroll
                for (int g = 0; g < 4; ++g) o[g] = fmaf(ps[g * 128 + k], vv, o[g]); } }
#pragma unroll
        for (int g = 0; g < 4; ++g) { const float L = wave_sum(l[g]); ofin[g] += gate[g][1] * o[g] * (L > 0.f ? 1.f / L : 0.f); }
    }
    {
        float l[4] = {0.f, 0.f, 0.f, 0.f}, o[4] = {0.f, 0.f, 0.f, 0.f};
        const int start = tau - 511 > 0 ? tau - 511 : 0;
#pragma unroll 1
        for (int base = start & ~63; base <= tau; base += 64) {
            const int kpos = base + lane; const bool valid = kpos >= start && kpos <= tau; float s[4];
            nsa_scores(kwn + ((size_t)b * SEQ + kpos) * 128 + hkv * 64, valid, qs, s);
#pragma unroll
            for (int g = 0; g < 4; ++g) { const float p = valid ? __expf(s[g]) : 0.f; l[g] += p; ps[g * 128 + lane] = p; }
            const int k0 = start > base ? start - base : 0, k1 = tau - base < 63 ? tau - base : 63;
            const bf16* vb = proj + ((size_t)b * SEQ + base) * NPROJ + PC_NVW + hkv * 64 + lane;
#pragma unroll 2
            for (int k = k0; k <= k1; ++k) { const float vv = bf2f(vb[(size_t)k * NPROJ]);
#pragma unroll
                for (int g = 0; g < 4; ++g) o[g] = fmaf(ps[g * 128 + k], vv, o[g]); } }
#pragma unroll
        for (int g = 0; g < 4; ++g) { const float L = wave_sum(l[g]); ofin[g] += gate[g][2] * o[g] * (L > 0.f ? 1.f / L : 0.f); }
    }
#pragma unroll
    for (int g = 0; g < 4; ++g) H1[(size_t)t * 512 + (hkv * 4 + g) * 64 + lane] = (bf16)f2bf(ofin[g]);
}
DI void mem_wave(Frame& F, int t, LAS float* wl) {
    unsigned char* ws = F.ws; const int lane = F.lane_id(); const int b = t >> 11;
    const bf16* mqn = (const bf16*)(ws + WS_MQN); const bf16* memkn = (const bf16*)(ws + WS_MEMKN); const bf16* memkv = (const bf16*)(ws + WS_MEMKV); bf16* H2 = (bf16*)(ws + WS_H2);
    LAS float* qs = wl;
    LAS float* ps = wl + 128;
#pragma unroll 1
    for (int h = 0; h < 4; ++h) {
        qs[lane] = bf2f(mqn[(size_t)t * 512 + h * 128 + lane]); qs[64 + lane] = bf2f(mqn[(size_t)t * 512 + h * 128 + 64 + lane]);
        float l = 0.f;
#pragma unroll 1
        for (int kq = 0; kq < 4; ++kq) { const int key = kq * 64 + lane; const bf16* kr = memkn + ((size_t)b * MEML + key) * 512 + h * 128; float s = 0.f;
#pragma unroll 2
            for (int c8 = 0; c8 < 16; ++c8) { const v4u kk = *(const v4u*)(kr + c8 * 8); const unsigned w[4] = {kk.x, kk.y, kk.z, kk.w};
#pragma unroll
                for (int j = 0; j < 4; ++j) s = fmaf(__uint_as_float(w[j] & 0xffff0000u), qs[c8 * 8 + 2 * j + 1], fmaf(__uint_as_float(w[j] << 16), qs[c8 * 8 + 2 * j], s)); }
            const float p = __expf(s); l += p; ps[key] = p; }
        const float inv = 1.f / wave_sum(l);
        float o0 = 0.f, o1 = 0.f;
        const bf16* vb = memkv + (size_t)b * MEML * 1024 + 512 + h * 128;
#pragma unroll 4
        for (int key = 0; key < MEML; ++key) { const float p = ps[key]; o0 = fmaf(p, bf2f(vb[(size_t)key * 1024 + lane]), o0); o1 = fmaf(p, bf2f(vb[(size_t)key * 1024 + 64 + lane]), o1); }
        H2[(size_t)t * 512 + h * 128 + lane] = (bf16)f2bf(o0 * inv); H2[(size_t)t * 512 + h * 128 + 64 + lane] = (bf16)f2bf(o1 * inv);
    }
}
typedef float f32x16 __attribute__((ext_vector_type(16)));
typedef float f32x2v __attribute__((ext_vector_type(2)));
typedef __bf16 bf16x2v __attribute__((ext_vector_type(2)));
typedef short s16x4 __attribute__((ext_vector_type(4)));
typedef unsigned u32x2 __attribute__((ext_vector_type(2)));
#define MFMA32(a, b, c) __builtin_amdgcn_mfma_f32_32x32x16_bf16((a), (b), (c), 0, 0, 0)
#define WG_BAR() do { asm volatile("s_waitcnt vmcnt(0) lgkmcnt(0)" ::: "memory"); __builtin_amdgcn_s_barrier(); asm volatile("" ::: "memory"); } while (0)
DI unsigned pkbf(float lo, float hi) { f32x2v v = {lo, hi}; return __builtin_bit_cast(unsigned, __builtin_convertvector(v, bf16x2v)); }
template <int S> DI bf16x8 pack8(const f32x16& x) {
    v4u p; p.x = pkbf(x[8 * S], x[8 * S + 1]); p.y = pkbf(x[8 * S + 2], x[8 * S + 3]); p.z = pkbf(x[8 * S + 4], x[8 * S + 5]); p.w = pkbf(x[8 * S + 6], x[8 * S + 7]);
    return __builtin_bit_cast(bf16x8, p);
}
DI int crow(int i, int h) { return (i & 3) + 8 * (i >> 2) + 4 * h; }
constexpr int AT_K = 0, AT_V = 32768, AT_IMP = 65536, AT_WM = 98304, AT_INV = 98368, AT_SC = 99392;

DI void glds16(const void* gsrc, unsigned lds_dst) { unsigned keep; asm volatile("s_mov_b32 %0, m0\n\ts_mov_b32 m0, %2\n\ts_nop 0\n\tglobal_load_lds_dwordx4 %1, off\n\ts_mov_b32 m0, %0" : "=&s"(keep) : "v"(gsrc), "s"(lds_dst) : "memory"); }
DI void at_load(LAS unsigned char* lds, int par, const void* kb, size_t kpitch, const void* vb, size_t vpitch, int wave, int lane) {
    const int row = 8 * wave + (lane >> 3), pc = lane & 7;
    const int kc = pc ^ ((row >> 1) & 7), vc = pc ^ (((row >> 1) & 1) << 2);
    glds16((const char*)kb + (size_t)row * kpitch + 16 * kc, (unsigned)(size_t)(lds + AT_K + par * 8192 + wave * 1024));
    glds16((const char*)vb + (size_t)row * vpitch + 16 * vc, (unsigned)(size_t)(lds + AT_V + par * 8192 + wave * 1024));
}
#define SB() __builtin_amdgcn_sched_barrier(0)
typedef __attribute__((address_space(3))) s16x4 lds_s16x4;
DI void at_qk(const LAS unsigned char* kbuf, const int (&ka)[4], const bf16x8 (&qf)[4], f32x16 (&s)[2]) {
    bf16x8 kf[2][4];
#pragma unroll
    for (int kb = 0; kb < 2; ++kb)
#pragma unroll
        for (int st = 0; st < 4; ++st) kf[kb][st] = *(const LAS bf16x8*)(kbuf + ka[st] + kb * 4096);
    SB();
#pragma unroll
    for (int kb = 0; kb < 2; ++kb) {
        f32x16 a;
#pragma unroll
        for (int i = 0; i < 16; ++i) a[i] = 0.f;
#pragma unroll
        for (int st = 0; st < 4; ++st) a = MFMA32(kf[kb][st], qf[st], a);
        s[kb] = a;
    }
}
DI void at_vload(const LAS unsigned char* vbuf, const int (&va)[2], int kb, bf16x8 (&vf)[2][2]) {
#pragma unroll
    for (int s2 = 0; s2 < 2; ++s2)
#pragma unroll
        for (int db = 0; db < 2; ++db) {
            const s16x4 lo = __builtin_amdgcn_ds_read_tr16_b64_v4i16((lds_s16x4*)(vbuf + va[db] + kb * 4096 + s2 * 2048));
            const s16x4 hi = __builtin_amdgcn_ds_read_tr16_b64_v4i16((lds_s16x4*)(vbuf + va[db] + kb * 4096 + s2 * 2048 + 1024));
            vf[s2][db] = __builtin_shufflevector(lo, hi, 0, 1, 2, 3, 4, 5, 6, 7); }
}
DI void at_pv1(const bf16x8 (&vf)[2][2], const f32x16& p, f32x16 (&o)[2]) {
    const bf16x8 pf0 = pack8<0>(p), pf1 = pack8<1>(p);
#pragma unroll
    for (int s2 = 0; s2 < 2; ++s2)
#pragma unroll
        for (int db = 0; db < 2; ++db) o[db] = MFMA32(vf[s2][db], s2 ? pf1 : pf0, o[db]);
}
DI void at_pv(const LAS unsigned char* vbuf, const int (&va)[2], const bf16x8 (&vf0)[2][2], const f32x16 (&p)[2], f32x16 (&o)[2]) {
    bf16x8 vf1[2][2]; at_vload(vbuf, va, 1, vf1);
    at_pv1(vf0, p[0], o);
    at_pv1(vf1, p[1], o);
}
DI void at_exp_all(f32x16 (&s)[2], float& l) {
#pragma unroll
    for (int kb = 0; kb < 2; ++kb)
#pragma unroll
        for (int i = 0; i < 16; ++i) { const float p = __builtin_amdgcn_exp2f(s[kb][i]); s[kb][i] = p; l += p; }
}
DI void at_wait(int n) {
    if (n >= 2) asm volatile("s_waitcnt vmcnt(4)" ::: "memory"); else if (n == 1) asm volatile("s_waitcnt vmcnt(2)" ::: "memory"); else asm volatile("s_waitcnt vmcnt(0)" ::: "memory");
    asm volatile("s_waitcnt lgkmcnt(0)" ::: "memory"); __builtin_amdgcn_s_barrier(); asm volatile("" ::: "memory");
}
template <bool STORE = true, bool DO_CMP = true, bool DO_SEL = true, bool DO_WIN = true>
DI void nsa_unit(Frame& F, int unit) {
    unsigned char* ws = F.ws; LAS unsigned char* lds = F.lds;
    int lane_ = F.lane_id();
    const int lane = lane_, wave = F.wave, r = lane & 31, h = lane >> 5, g = wave >> 1, qh = wave & 1;
    const int bh = unit & 31, qt = 31 - (unit >> 5), b = bh >> 1, hkv = bh & 1;
    const int qloc = 32 * qh + r, tau = 64 * qt + qloc, qq = tau & 63; const size_t t = (size_t)b * SEQ + tau;
    const bf16* proj = (const bf16*)(ws + WS_PROJ);
    const bf16* qn = (const bf16*)(ws + WS_QN); const bf16* ksn = (const bf16*)(ws + WS_KSN); const bf16* kwn = (const bf16*)(ws + WS_KWN);
    const bf16* kc = (const bf16*)(ws + WS_KC); const bf16* vc = (const bf16*)(ws + WS_VC); bf16* H1 = (bf16*)(ws + WS_H1);
    int ka[4], va[2];
    { const int f = (r >> 1) & 7, fs = f >> 1, hb = h ^ (f & 1);
#pragma unroll
      for (int st = 0; st < 4; ++st) ka[st] = r * 128 + 16 * (((st ^ fs) << 1) | hb);
      const int i16 = lane & 15, q = i16 >> 2, p = i16 & 3, g1 = (lane >> 4) & 1;
#pragma unroll
      for (int db = 0; db < 2; ++db) va[db] = (4 * h + q) * 128 + 16 * ((4 * db + 2 * g1 + (p >> 1)) ^ (((q >> 1) & 1) << 2)) + 8 * (p & 1); }
    bf16x8 qf[4];
#pragma unroll
    for (int st = 0; st < 4; ++st) qf[st] = *(const bf16x8*)(qn + t * 512 + (hkv * 4 + g) * 64 + 16 * st + 8 * h);
    float gate[3];
#pragma unroll
    for (int c = 0; c < 3; ++c) gate[c] = sigm(bf2f(proj[t * NPROJ + PC_NG + (hkv * 4 + g) * 3 + c]));
    f32x16 ofin[2];
#pragma unroll
    for (int i = 0; i < 16; ++i) { ofin[0][i] = 0.f; ofin[1][i] = 0.f; }
    WG_BAR();
    if (DO_CMP) {
        const int ncq = tau >= 31 ? ((tau - 31) >> 4) + 1 : 0;
        const int ntc = (((64 * qt + 63 - 31) >> 4) + 1 > 64) ? 2 : 1;
        const char* kb0 = (const char*)(kc + (size_t)(b * 2 + hkv) * 128 * 64); const char* vb0 = (const char*)(vc + (size_t)(b * 2 + hkv) * 128 * 64);
        at_load(lds, 0, kb0, 128, vb0, 128, wave, lane);
        if (ntc == 2) at_load(lds, 1, kb0 + 64 * 128, 128, vb0 + 64 * 128, 128, wave, lane);
        WG_BAR();
        f32x16 o[2]; float l = 0.f, prevEp = 0.f;
#pragma unroll
        for (int i = 0; i < 16; ++i) { o[0][i] = 0.f; o[1][i] = 0.f; }
        LAS float* I = (LAS float*)(lds + AT_IMP) + (g * 64 + qloc) * 32;
#pragma unroll 1
        for (int tile = 0; tile < 2; ++tile) {
            if (tile < ntc) {
                f32x16 s[2];
                at_qk(lds + AT_K + tile * 8192, ka, qf, s);
                bf16x8 vf[2][2]; at_vload(lds + AT_V + tile * 8192, va, 0, vf); SB();
#pragma unroll
                for (int kb = 0; kb < 2; ++kb)
#pragma unroll
                    for (int i = 0; i < 16; ++i) { const int n = 64 * tile + 32 * kb + crow(i, h); const float p = n < ncq ? __builtin_amdgcn_exp2f(s[kb][i]) : 0.f; s[kb][i] = p; l += p; }
#pragma unroll
                for (int kb = 0; kb < 2; ++kb)
#pragma unroll
                    for (int a = 0; a < 4; ++a) { const int idx = tile * 8 + kb * 4 + a; const float Gv = (s[kb][4 * a] + s[kb][4 * a + 1]) + (s[kb][4 * a + 2] + s[kb][4 * a + 3]);
                        const float Epv = __shfl_xor(s[kb][4 * a + 3], 32);
                        I[2 * idx + h] = Gv + (h ? Epv : prevEp); prevEp = Epv; }
                at_pv(lds + AT_V + tile * 8192, va, vf, s, o);
            } else {
#pragma unroll
                for (int idx = 8; idx < 16; ++idx) I[2 * idx + h] = 0.f;
            }
        }
        const float L = l + __shfl_xor(l, 32); const float inv = L > 0.f ? 1.f / L : 0.f;
        const float gi = gate[0] * inv;
#pragma unroll
        for (int i = 0; i < 16; ++i) { ofin[0][i] += gi * o[0][i]; ofin[1][i] += gi * o[1][i]; }
        if (h == 0) ((LAS float*)(lds + AT_INV))[g * 64 + qloc] = inv;
    }
    WG_BAR();
    unsigned sel = 0u, wm = 0u, um = 0u;
    if (!DO_CMP) { sel = (qt == 31) ? 0xffffffffu : ((1u << (qt + 1)) - 1u); wm = sel; um = sel; }
    else {
        const LAS float* I = (const LAS float*)(lds + AT_IMP) + qloc * 32;
        const LAS float* IV = (const LAS float*)(lds + AT_INV) + qloc;
        const float iv0 = IV[0], iv1 = IV[64], iv2 = IV[128], iv3 = IV[192];
        LAS unsigned* SC = (LAS unsigned*)(lds + AT_SC) + (qh * 32 + r) * 33;
        if (g == 0 && h == 0) {
#pragma unroll 8
            for (int j = 0; j < 32; ++j) { const float imp = (I[j] * iv0 + I[64 * 32 + j] * iv1) + (I[2 * 64 * 32 + j] * iv2 + I[3 * 64 * 32 + j] * iv3);
                const bool cand = (j >= 1) && (j <= qt - 2);
                SC[j] = cand ? ((__float_as_uint(imp) & ~31u) | (unsigned)(31 - j)) + 32u : 0u; }
        }
        WG_BAR();
        if (qt <= 7) sel = (1u << (qt + 1)) - 1u;
        else {
            sel = 1u | (1u << qt) | (1u << (qt - 1));
            unsigned prev = 0xffffffffu;
#pragma unroll 1
            for (int rd = 0; rd < 5; ++rd) { unsigned best = 0u;
#pragma unroll 8
                for (int j = 0; j < 32; ++j) { const unsigned kx = SC[j]; const unsigned cnd = kx < prev ? kx : 0u; best = cnd > best ? cnd : best; }
                prev = best; if (best) sel |= 1u << (31 - (int)(best & 31u)); }
        }
        sel &= (qt == 31) ? 0xffffffffu : ((1u << (qt + 1)) - 1u);
        wm = sel;
#pragma unroll
        for (int o = 1; o < 32; o <<= 1) wm |= (unsigned)__shfl_xor((int)wm, o);
        wm = (unsigned)__builtin_amdgcn_readfirstlane((int)wm);
        if (lane == 0) ((LAS unsigned*)(lds + AT_WM))[wave] = wm;
        WG_BAR();
        um = 0u;
#pragma unroll
        for (int w = 0; w < 8; ++w) um |= ((const LAS unsigned*)(lds + AT_WM))[w];
        um = (unsigned)__builtin_amdgcn_readfirstlane((int)um);
    }
    if (DO_SEL) {
        f32x16 o[2]; float l = 0.f;
#pragma unroll
        for (int i = 0; i < 16; ++i) { o[0][i] = 0.f; o[1][i] = 0.f; }
        const char* kbase = (const char*)(ksn + (size_t)b * SEQ * 128 + hkv * 64); const char* vbase = (const char*)((const bf16*)(ws + WS_VSN) + (size_t)b * SEQ * 128 + hkv * 64);
        unsigned rem = um, im = um; int k = 0; const int T = __popc(um);
#pragma unroll 1
        for (int i = 0; i < 3 && im; ++i) { const int jn = __ffs((int)im) - 1; im &= im - 1u; at_load(lds, i, kbase + (size_t)jn * 64 * 256, 256, vbase + (size_t)jn * 64 * 256, 256, wave, lane); }
#pragma unroll 1
        while (rem) {
            const int j = __ffs((int)rem) - 1; rem &= rem - 1u;
            at_wait(T - k - 1);
#ifdef NSA_E1
            at_wait(T - k - 1);
#endif
            if (im) { const int jn = __ffs((int)im) - 1; im &= im - 1u; at_load(lds, (k + 3) & 3, kbase + (size_t)jn * 64 * 256, 256, vbase + (size_t)jn * 64 * 256, 256, wave, lane); }
            const int par = k & 3;
            if ((wm >> j) & 1u) {
                f32x16 s[2];
                at_qk(lds + AT_K + par * 8192, ka, qf, s);
                bf16x8 vf[2][2]; at_vload(lds + AT_V + par * 8192, va, 0, vf); SB();
                const bool on = (sel >> j) & 1u;
                if (j != qt && __all(on)) at_exp_all(s, l);
                else { const int klim = j == qt ? qq : 63;
#pragma unroll
                    for (int kb = 0; kb < 2; ++kb)
#pragma unroll
                        for (int i = 0; i < 16; ++i) { const int key = 32 * kb + crow(i, h); const float p = (on && key <= klim) ? __builtin_amdgcn_exp2f(s[kb][i]) : 0.f; s[kb][i] = p; l += p; } }
                at_pv(lds + AT_V + par * 8192, va, vf, s, o);
            }
            ++k;
        }
        const float L = l + __shfl_xor(l, 32); const float gi = gate[1] * (L > 0.f ? 1.f / L : 0.f);
#pragma unroll
        for (int i = 0; i < 16; ++i) { ofin[0][i] += gi * o[0][i]; ofin[1][i] += gi * o[1][i]; }
    }
    WG_BAR();
    if (DO_WIN) {
        f32x16 o[2]; float l = 0.f;
#pragma unroll
        for (int i = 0; i < 16; ++i) { o[0][i] = 0.f; o[1][i] = 0.f; }
        const char* kbase = (const char*)(kwn + (size_t)b * SEQ * 128 + hkv * 64); const char* vbase = (const char*)((const bf16*)(ws + WS_VWN) + (size_t)b * SEQ * 128 + hkv * 64);
        const int jlo = qt > 8 ? qt - 8 : 0; const int T = qt - jlo + 1;
#ifdef NSA_E2
        f32x16 o2[2]; float l2 = 0.f;
#pragma unroll
        for (int i = 0; i < 16; ++i) { o2[0][i] = 0.f; o2[1][i] = 0.f; }
#endif
#pragma unroll 1
        for (int i = 0; i < 3 && i < T; ++i) at_load(lds, i, kbase + (size_t)(jlo + i) * 64 * 256, 256, vbase + (size_t)(jlo + i) * 64 * 256, 256, wave, lane);
#pragma unroll 1
        for (int k = 0; k < T; ++k) {
            const int j = jlo + k, par = k & 3;
            at_wait(T - k - 1);
#ifdef NSA_E1
            at_wait(T - k - 1);
#endif
            if (k + 3 < T) at_load(lds, (k + 3) & 3, kbase + (size_t)(j + 3) * 64 * 256, 256, vbase + (size_t)(j + 3) * 64 * 256, 256, wave, lane);
            f32x16 s[2];
            at_qk(lds + AT_K + par * 8192, ka, qf, s);
            bf16x8 vf[2][2]; at_vload(lds + AT_V + par * 8192, va, 0, vf); SB();
#ifdef NSA_E2
            { f32x16 s2[2]; asm volatile("" ::: "memory"); at_qk(lds + AT_K + par * 8192, ka, qf, s2); bf16x8 vf2[2][2]; at_vload(lds + AT_V + par * 8192, va, 0, vf2); SB(); at_exp_all(s2, l2); at_pv(lds + AT_V + par * 8192, va, vf2, s2, o2); }
#endif
            if (j != qt && j != qt - 8) at_exp_all(s, l);
            else { const int klo = (j == qt - 8) ? qq + 1 : 0, khi = (j == qt) ? qq : 63;
#pragma unroll
                for (int kb = 0; kb < 2; ++kb)
#pragma unroll
                    for (int i = 0; i < 16; ++i) { const int key = 32 * kb + crow(i, h); const float p = (key >= klo && key <= khi) ? __builtin_amdgcn_exp2f(s[kb][i]) : 0.f; s[kb][i] = p; l += p; } }
            at_pv(lds + AT_V + par * 8192, va, vf, s, o);
        }
#ifdef NSA_E2
        { const float z = l2 * 0.f;
#pragma unroll
          for (int i = 0; i < 16; ++i) { ofin[0][i] += z * o2[0][i]; ofin[1][i] += z * o2[1][i]; } }
#endif
        const float L = l + __shfl_xor(l, 32); const float gi = gate[2] * (L > 0.f ? 1.f / L : 0.f);
#pragma unroll
        for (int i = 0; i < 16; ++i) { ofin[0][i] += gi * o[0][i]; ofin[1][i] += gi * o[1][i]; }
    }
    if (!STORE) { asm volatile("" :: "v"(ofin[0]), "v"(ofin[1])); return; }
    WG_BAR();
#pragma unroll
    for (int db = 0; db < 2; ++db)
#pragma unroll
        for (int a = 0; a < 4; ++a) { u32x2 w; w.x = pkbf(ofin[db][4 * a], ofin[db][4 * a + 1]); w.y = pkbf(ofin[db][4 * a + 2], ofin[db][4 * a + 3]); *(LAS u32x2*)(lds + qloc * 528 + g * 128 + (32 * db + 8 * a + 4 * h) * 2) = w; }
    WG_BAR();
    { const int tid = wave * 64 + lane; bf16* obase = H1 + ((size_t)b * SEQ + 64 * qt) * 512 + hkv * 256;
#pragma unroll
      for (int i = 0; i < 4; ++i) { const int piece = tid + 512 * i, row = piece >> 5, c = piece & 31; *(v4u*)(obase + (size_t)row * 512 + 8 * c) = *(const LAS v4u*)(lds + row * 528 + 16 * c); } }
}
constexpr int ML_K = 0, ML_V = 32768, ML_VW = 65536, ML_C = 81920, ML_N = 114688, ML_SS = 115200, ML_WS = 116224, ML_GO = 120320, ML_ST = 135424;
DI int ml_fk(int s) { return ((s & 3) << 2) | ((s >> 2) & 3); }
DI void ml_load(LAS unsigned char* lds, int par, const char* kb, const char* vb, int wave, int lane) {
#pragma unroll
    for (int n2 = 0; n2 < 2; ++n2) { const int n = 2 * wave + n2, row = 4 * n + (lane >> 4), pc = lane & 15;
        const int kc = pc ^ ml_fk(row), vc = pc ^ ((row & 3) << 2);
        glds16(kb + (size_t)row * 2048 + 16 * kc, (unsigned)(size_t)(lds + ML_K + par * 16384 + n * 1024));
        glds16(vb + (size_t)row * 1024 + 16 * vc, (unsigned)(size_t)(lds + ML_V + par * 16384 + n * 1024)); }
}
DI bf16x8 ml_tr8(const LAS unsigned char* p) {
    const s16x4 lo = __builtin_amdgcn_ds_read_tr16_b64_v4i16((lds_s16x4*)p); const s16x4 hi = __builtin_amdgcn_ds_read_tr16_b64_v4i16((lds_s16x4*)(p + 1024));
    return __builtin_shufflevector(lo, hi, 0, 1, 2, 3, 4, 5, 6, 7);
}
template <int PM = 0xff>
DI void mlstm_unit2(Frame& F, int unit) {
    unsigned char* ws = F.ws; LAS unsigned char* lds = F.lds;
    int lane_ = F.lane_id();
    const int lane = lane_, wave = F.wave, tid = wave * 64 + lane, r = lane & 31, hh = lane >> 5, tb = wave >> 2, vb = wave & 3;
    const int b = unit >> 2, hd = unit & 3;
    const bf16* proj = (const bf16*)(ws + WS_PROJ); const bf16* mlqk = (const bf16*)(ws + WS_MLQK); bf16* H0 = (bf16*)(ws + WS_H0);
    const size_t tok0 = (size_t)b * SEQ;
    const char* kbase = (const char*)(mlqk + tok0 * 1024 + 512 + hd * 128); const char* vbase = (const char*)((const bf16*)(ws + WS_MLV) + tok0 * 512 + hd * 128);
    const float LOG2E = 1.4426950408889634f;
    const int i16 = lane & 15, q4 = i16 >> 2, p4 = i16 & 3, g1 = (lane >> 4) & 1;
    const int colsw = 16 * ((4 * vb + 2 * g1 + (p4 >> 1)) ^ (q4 << 2)) + 8 * (p4 & 1);
    const int base_c = (8 * hh + q4) * 256 + colsw;
    const int base_v = (4 * hh + q4) * 256 + colsw;
    const int fK = ml_fk(r), rowK = r * 256 + ((hh ^ (fK & 1)) << 4), F16 = (fK & 14) << 4;
    int base_kt[2][2];
#pragma unroll
    for (int blk = 0; blk < 2; ++blk)
#pragma unroll
        for (int hi = 0; hi < 2; ++hi) { const int kbp = 2 * tb + blk; base_kt[blk][hi] = (8 * hh + 4 * hi + q4) * 256 + 16 * ((4 * kbp + 2 * g1 + (p4 >> 1)) ^ ((q4 << 2) | ((2 * hh + hi) & 3))) + 8 * (p4 & 1); }
    LAS float* WS = (LAS float*)(lds + ML_WS) + wave * 128;
    LAS float* NV = (LAS float*)(lds + ML_N); LAS float* SS = (LAS float*)(lds + ML_SS);
    __syncthreads();
    for (int i = tid; i < 32768 / 16; i += 512) ((LAS v4u*)(lds + ML_C))[i] = (v4u){0u, 0u, 0u, 0u};
    if (tid < 128) NV[tid] = 0.f;
    f32x16 Cst[2];
#pragma unroll
    for (int i = 0; i < 16; ++i) { Cst[0][i] = 0.f; Cst[1][i] = 0.f; }
    if (tid < 128) ((LAS float*)(lds + ML_GO))[tid] = F.in[I_MLGOUT][hd * 128 + tid];
    const float bi = F.in[I_MLBI][hd], bfv = F.in[I_MLBF][hd];
    float m_prev = 0.f;
    ml_load(lds, 0, kbase, vbase, wave, lane);
    bf16x8 qf[8];
    { const bf16* qp = mlqk + (tok0 + 32 * tb + r) * 1024 + hd * 128 + 8 * hh;
#pragma unroll
      for (int st = 0; st < 8; ++st) qf[st] = *(const bf16x8*)(qp + 16 * st); }
    float gi_raw = bf2f(proj[(tok0 + lane) * NPROJ + PC_MLI + hd]), gf_raw = bf2f(proj[(tok0 + lane) * NPROJ + PC_MLF + hd]);
#pragma unroll 1
    for (int c = 0; c < 32; ++c) {
        const int par = c & 1; const size_t tokc = tok0 + 64 * c;
        WG_BAR();
        if ((PM & 1) && c > 0) {
            bf16* obase = H0 + (tokc - 64) * 512 + hd * 128;
#pragma unroll
            for (int i = 0; i < 2; ++i) { const int piece = tid + 512 * i, row = piece >> 4, cc = piece & 15; *(v4u*)(obase + (size_t)row * 512 + 8 * cc) = *(const LAS v4u*)(lds + ML_ST + row * 272 + 16 * cc); } }
        if (c < 31) ml_load(lds, par ^ 1, kbase + (size_t)(64 * (c + 1)) * 2048, vbase + (size_t)(64 * (c + 1)) * 1024, wave, lane);
        u32x2 og[4];
        { const bf16* op = proj + (tokc + 32 * tb + r) * NPROJ + PC_MLO + hd * 128 + 32 * vb + 4 * hh;
#pragma unroll
          for (int a = 0; a < 4; ++a) og[a] = *(const u32x2*)(op + 8 * a); }
        const float ig = gi_raw + bi, lf = logsig(gf_raw + bfv);
        float bc = lf;
        if (PM & 2) {
#pragma unroll
        for (int o = 1; o < 64; o <<= 1) { const float v = __shfl_up(bc, o); if (lane >= o) bc += v; } }
        const float rr = ig - bc;
        float cm = rr;
        if (PM & 2) {
#pragma unroll
        for (int o = 1; o < 64; o <<= 1) { const float v = __shfl_up(cm, o); if (lane >= o) cm = fmaxf(cm, v); } }
        const float M63 = fmaxf(m_prev, __shfl(cm, 63)), blast = __shfl(bc, 63);
        const float a_old = __expf(m_prev - M63), m_new = blast + M63;
        const int tl = 32 * tb + r;
        const float Mt = fmaxf(m_prev, __shfl(cm, tl)), bt = __shfl(bc, tl);
        const float inter = __expf(m_prev - Mt), m_t = bt + Mt;
        WS[lane] = rr * LOG2E; WS[64 + lane] = __expf(rr - M63);
        const float MtL = Mt * LOG2E;
        const LAS unsigned char* kbuf = lds + ML_K + par * 16384; const LAS unsigned char* vbuf = lds + ML_V + par * 16384;
        f32x16 wd[2]; float dsum = 0.f;
#pragma unroll
        for (int kb = 0; kb < 2; ++kb) {
#pragma unroll
            for (int i = 0; i < 16; ++i) wd[kb][i] = 0.f;
            if ((PM & 4) && kb <= tb) {
                f32x16 a = wd[kb]; bf16x8 kfr[8];
#pragma unroll
                for (int st = 0; st < 8; ++st) kfr[st] = *(const LAS bf16x8*)(kbuf + kb * 8192 + rowK + ((32 * st) ^ F16));
                SB();
#pragma unroll
                for (int st = 0; st < 8; ++st) a = MFMA32(kfr[st], qf[st], a);
#pragma unroll
                for (int i = 0; i < 16; ++i) { const int s = 32 * kb + crow(i, hh); const float e = __builtin_amdgcn_exp2f(WS[s] - MtL); const float w = (s <= tl) ? e * a[i] : 0.f; a[i] = w; dsum += w; }
                wd[kb] = a;
            }
        }
        f32x16 acc; bf16x8 cfr[8];
#pragma unroll
        for (int i = 0; i < 16; ++i) acc[i] = 0.f;
        if (PM & 8) {
#pragma unroll
        for (int st = 0; st < 8; ++st) cfr[st] = ml_tr8(lds + ML_C + base_c + st * 4096);
        SB();
#pragma unroll
        for (int st = 0; st < 8; ++st) acc = MFMA32(cfr[st], qf[st], acc); }
#pragma unroll
        for (int i = 0; i < 16; ++i) acc[i] *= inter;
#pragma unroll
        for (int kb = 0; kb < 2; ++kb) {
            if ((PM & 16) && kb <= tb) {
                const bf16x8 pf0 = pack8<0>(wd[kb]), pf1 = pack8<1>(wd[kb]);
                {
#pragma unroll
                  for (int s2 = 0; s2 < 2; ++s2) { const LAS unsigned char* p = vbuf + base_v + kb * 8192 + s2 * 4096;
                    const s16x4 lo = __builtin_amdgcn_ds_read_tr16_b64_v4i16((lds_s16x4*)p); const s16x4 hi = __builtin_amdgcn_ds_read_tr16_b64_v4i16((lds_s16x4*)(p + 2048));
                    const bf16x8 vf = __builtin_shufflevector(lo, hi, 0, 1, 2, 3, 4, 5, 6, 7);
                    acc = MFMA32(vf, s2 ? pf1 : pf0, acc); } }
            }
        }
        float qn_ = 0.f;
        if (PM & 32)
#pragma unroll
        for (int st = 0; st < 8; ++st) { const v4u qw = __builtin_bit_cast(v4u, qf[st]); const LAS float* np = NV + 16 * st + 8 * hh; const f32x4 n0 = *(const LAS f32x4*)np, n1 = *(const LAS f32x4*)(np + 4);
            qn_ = fmaf(__uint_as_float(qw.x << 16), n0[0], qn_); qn_ = fmaf(__uint_as_float(qw.x & 0xffff0000u), n0[1], qn_); qn_ = fmaf(__uint_as_float(qw.y << 16), n0[2], qn_); qn_ = fmaf(__uint_as_float(qw.y & 0xffff0000u), n0[3], qn_);
            qn_ = fmaf(__uint_as_float(qw.z << 16), n1[0], qn_); qn_ = fmaf(__uint_as_float(qw.z & 0xffff0000u), n1[1], qn_); qn_ = fmaf(__uint_as_float(qw.w << 16), n1[2], qn_); qn_ = fmaf(__uint_as_float(qw.w & 0xffff0000u), n1[3], qn_); }
        qn_ += __shfl_xor(qn_, 32); dsum += __shfl_xor(dsum, 32);
        const float den = inter * qn_ + dsum; const float rden = 1.f / fmaxf(fabsf(den), __expf(-m_t));
        float ssq = 0.f;
#pragma unroll
        for (int i = 0; i < 16; ++i) { acc[i] *= rden; ssq = fmaf(acc[i], acc[i], ssq); }
        ssq += __shfl_xor(ssq, 32);
        if (hh == 0) SS[vb * 64 + tl] = ssq;
        if (PM & 64)
#pragma unroll
        for (int k2 = 0; k2 < 2; ++k2) { const int ci = tid + 512 * k2, s = ci >> 4; const float w = WS[64 + s];
            const v4u x = *(const LAS v4u*)(vbuf + ci * 16); v4u y; const unsigned xs[4] = {x.x, x.y, x.z, x.w}; unsigned ys[4];
#pragma unroll
            for (int j = 0; j < 4; ++j) ys[j] = pkbf(__uint_as_float(xs[j] << 16) * w, __uint_as_float(xs[j] & 0xffff0000u) * w);
            y.x = ys[0]; y.y = ys[1]; y.z = ys[2]; y.w = ys[3]; *(LAS v4u*)(lds + ML_VW + ci * 16) = y; }
        asm volatile("s_waitcnt lgkmcnt(0)" ::: "memory"); __builtin_amdgcn_s_barrier(); asm volatile("" ::: "memory");
        if (c < 31) {
            const bf16* qp = mlqk + (tokc + 64 + 32 * tb + r) * 1024 + hd * 128 + 8 * hh;
#pragma unroll
            for (int st = 0; st < 8; ++st) qf[st] = *(const bf16x8*)(qp + 16 * st);
            gi_raw = bf2f(proj[(tokc + 64 + lane) * NPROJ + PC_MLI + hd]); gf_raw = bf2f(proj[(tokc + 64 + lane) * NPROJ + PC_MLF + hd]);
        }
        { const LAS float* GO = (const LAS float*)(lds + ML_GO) + 32 * vb + 4 * hh;
          const float rstd = rsqrtf(((SS[tl] + SS[64 + tl]) + (SS[128 + tl] + SS[192 + tl])) * (1.f / 128.f) + EPS);
#pragma unroll
          for (int a = 0; a < 4; ++a) { float o4[4]; const unsigned gw[2] = {og[a].x, og[a].y};
#pragma unroll
              for (int j = 0; j < 4; ++j) { const float ov = (j & 1) ? __uint_as_float(gw[j >> 1] & 0xffff0000u) : __uint_as_float(gw[j >> 1] << 16); o4[j] = acc[4 * a + j] * rstd * GO[8 * a + j] * sigm(ov); }
              u32x2 w; w.x = pkbf(o4[0], o4[1]); w.y = pkbf(o4[2], o4[3]); *(LAS u32x2*)(lds + ML_ST + tl * 272 + (32 * vb + 8 * a + 4 * hh) * 2) = w; } }
        if (PM & 128)
#pragma unroll
        for (int blk = 0; blk < 2; ++blk) {
            f32x16 cs = Cst[blk];
#pragma unroll
            for (int i = 0; i < 16; ++i) cs[i] *= a_old;
            bf16x8 afr[4], kfr2[4];
#pragma unroll
            for (int st = 0; st < 4; ++st) {
                afr[st] = ml_tr8(lds + ML_VW + base_c + st * 4096);
                const s16x4 lo = __builtin_amdgcn_ds_read_tr16_b64_v4i16((lds_s16x4*)(kbuf + base_kt[blk][0] + st * 4096)); const s16x4 hi = __builtin_amdgcn_ds_read_tr16_b64_v4i16((lds_s16x4*)(kbuf + base_kt[blk][1] + st * 4096));
                kfr2[st] = __builtin_shufflevector(lo, hi, 0, 1, 2, 3, 4, 5, 6, 7);
            }
            SB();
#pragma unroll
            for (int st = 0; st < 4; ++st) cs = MFMA32(afr[st], kfr2[st], cs);
            Cst[blk] = cs;
            const int kk = 32 * (2 * tb + blk) + r;
#pragma unroll
            for (int a = 0; a < 4; ++a) { u32x2 w; w.x = pkbf(cs[4 * a], cs[4 * a + 1]); w.y = pkbf(cs[4 * a + 2], cs[4 * a + 3]);
                *(LAS u32x2*)(lds + ML_C + kk * 256 + 16 * ((4 * vb + a) ^ ((r & 3) << 2)) + 8 * hh) = w; }
        }
        if ((PM & 64) && tid < 128) { float nv = NV[tid] * a_old;
#pragma unroll 8
            for (int s = 0; s < 64; ++s) { const unsigned short kvs = *(const LAS unsigned short*)(kbuf + s * 256 + 16 * ((tid >> 3) ^ ml_fk(s)) + 2 * (tid & 7)); nv = fmaf(WS[64 + s], bf2f(kvs), nv); }
            NV[tid] = nv; }
        m_prev = m_new;
    }
    __syncthreads();
    if (PM & 1) { bf16* obase = H0 + (tok0 + 64 * 31) * 512 + hd * 128;
#pragma unroll
        for (int i = 0; i < 2; ++i) { const int piece = tid + 512 * i, row = piece >> 4, cc = piece & 15; *(v4u*)(obase + (size_t)row * 512 + 8 * cc) = *(const LAS v4u*)(lds + ML_ST + row * 272 + 16 * cc); } }
    __syncthreads();
}
DI void mem_load(LAS unsigned char* lds, int par, const char* kb, const char* vb, int wave, int lane) {
#pragma unroll
    for (int n2 = 0; n2 < 2; ++n2) { const int n = 2 * wave + n2, row = 4 * n + (lane >> 4), pc = lane & 15;
        const int kc = pc ^ ml_fk(row), vc = pc ^ ((row & 3) << 2);
        glds16(kb + (size_t)row * 1024 + 16 * kc, (unsigned)(size_t)(lds + ML_K + par * 16384 + n * 1024));
        glds16(vb + (size_t)row * 2048 + 16 * vc, (unsigned)(size_t)(lds + ML_V + par * 16384 + n * 1024)); }
}
template <bool STORE = true, bool DMA = true, bool COMP = true>
DI void mem_unit(Frame& F, int unit) {
    unsigned char* ws = F.ws; LAS unsigned char* lds = F.lds;
    int lane_ = F.lane_id();
    const int lane = lane_, wave = F.wave, r = lane & 31, hh = lane >> 5;
    const int b = unit >> 5, hd = (unit >> 3) & 3, qt = unit & 7;
    const bf16* mqn = (const bf16*)(ws + WS_MQN); const bf16* memkn = (const bf16*)(ws + WS_MEMKN); const bf16* memkv = (const bf16*)(ws + WS_MEMKV); bf16* H2 = (bf16*)(ws + WS_H2);
    const size_t t = (size_t)b * SEQ + 256 * qt + 32 * wave + r;
    const char* kbase = (const char*)(memkn + (size_t)b * MEML * 512 + hd * 128); const char* vbase = (const char*)(memkv + (size_t)b * MEML * 1024 + 512 + hd * 128);
    const int i16 = lane & 15, q4 = i16 >> 2, p4 = i16 & 3, g1 = (lane >> 4) & 1;
    int base_v[4];
#pragma unroll
    for (int db = 0; db < 4; ++db) base_v[db] = (4 * hh + q4) * 256 + 16 * ((4 * db + 2 * g1 + (p4 >> 1)) ^ (q4 << 2)) + 8 * (p4 & 1);
    const int fK = ml_fk(r), rowK = r * 256 + ((hh ^ (fK & 1)) << 4), F16 = (fK & 14) << 4;
    bf16x8 qf[8];
#pragma unroll
    for (int st = 0; st < 8; ++st) qf[st] = *(const bf16x8*)(mqn + t * 512 + hd * 128 + 16 * st + 8 * hh);
    f32x16 o[4]; float l = 0.f;
#pragma unroll
    for (int db = 0; db < 4; ++db)
#pragma unroll
        for (int i = 0; i < 16; ++i) o[db][i] = 0.f;
    WG_BAR();
    if (DMA) mem_load(lds, 0, kbase, vbase, wave, lane);
#pragma unroll 1
    for (int tile = 0; tile < 4; ++tile) {
        const int par = tile & 1;
        WG_BAR();
        if (DMA && tile < 3) mem_load(lds, par ^ 1, kbase + (size_t)(64 * (tile + 1)) * 1024, vbase + (size_t)(64 * (tile + 1)) * 2048, wave, lane);
        const LAS unsigned char* kbuf = lds + ML_K + par * 16384; const LAS unsigned char* vbuf = lds + ML_V + par * 16384;
        if (COMP)
#pragma unroll
        for (int kb = 0; kb < 2; ++kb) {
            bf16x8 kf[8];
#pragma unroll
            for (int st = 0; st < 8; ++st) kf[st] = *(const LAS bf16x8*)(kbuf + kb * 8192 + rowK + ((32 * st) ^ F16));
            SB();
            f32x16 a;
#pragma unroll
            for (int i = 0; i < 16; ++i) a[i] = 0.f;
#pragma unroll
            for (int st = 0; st < 8; ++st) a = MFMA32(kf[st], qf[st], a);
            bf16x8 vf[2][4];
#pragma unroll
            for (int s2 = 0; s2 < 2; ++s2)
#pragma unroll
                for (int db = 0; db < 4; ++db) { const LAS unsigned char* p = vbuf + base_v[db] + kb * 8192 + s2 * 4096;
                    const s16x4 lo = __builtin_amdgcn_ds_read_tr16_b64_v4i16((lds_s16x4*)p); const s16x4 hi = __builtin_amdgcn_ds_read_tr16_b64_v4i16((lds_s16x4*)(p + 2048));
                    vf[s2][db] = __builtin_shufflevector(lo, hi, 0, 1, 2, 3, 4, 5, 6, 7); }
            SB();
#pragma unroll
            for (int i = 0; i < 16; ++i) { a[i] = __builtin_amdgcn_exp2f(a[i]); l += a[i]; }
            const bf16x8 pf0 = pack8<0>(a), pf1 = pack8<1>(a);
#pragma unroll
            for (int s2 = 0; s2 < 2; ++s2)
#pragma unroll
                for (int db = 0; db < 4; ++db) o[db] = MFMA32(vf[s2][db], s2 ? pf1 : pf0, o[db]);
        }
    }
    const float inv = 1.f / (l + __shfl_xor(l, 32));
    if (!STORE) {
#pragma unroll
        for (int db = 0; db < 4; ++db) asm volatile("" :: "v"(o[db]), "v"(inv));
        return; }
    WG_BAR();
#pragma unroll
    for (int db = 0; db < 4; ++db)
#pragma unroll
        for (int a = 0; a < 4; ++a) { u32x2 w; w.x = pkbf(o[db][4 * a] * inv, o[db][4 * a + 1] * inv); w.y = pkbf(o[db][4 * a + 2] * inv, o[db][4 * a + 3] * inv);
            *(LAS u32x2*)(lds + (32 * wave + r) * 272 + (32 * db + 8 * a + 4 * hh) * 2) = w; }
    WG_BAR();
    { const int tid = wave * 64 + lane; bf16* obase = H2 + ((size_t)b * SEQ + 256 * qt) * 512 + hd * 128;
#pragma unroll
      for (int i = 0; i < 8; ++i) { const int piece = tid + 512 * i, row = piece >> 4, c = piece & 15; *(v4u*)(obase + (size_t)row * 512 + 8 * c) = *(const LAS v4u*)(lds + row * 272 + 16 * c); } }
}
DI int q_pop(Frame& F, unsigned* qc) {
    __syncthreads();
    if (F.tid_id() == 0) F.MISC[16] = atomicAdd(qc, 1u);
    __syncthreads();
    return (int)F.MISC[16];
}
template <bool ML, bool NSA, bool MEMA, bool MST = true, bool MDMA = true, bool MCOMP = true, bool NST = true, bool NCMP = true, bool NSEL = true, bool NWIN = true, int MLPM = 0xff>
DI void p5_queue(Frame& F, int cbase) {
    unsigned* qc = F.ctl + CW_QCTR + cbase;
    if (ML) {
#pragma unroll 1
        for (;;) { const int it = q_pop(F, qc); if (it >= 64) break; mlstm_unit2<MLPM>(F, it); }
    }
    if (NSA) {
#pragma unroll 1
        for (;;) { const int it = q_pop(F, qc + 64); if (it >= 1024) break; nsa_unit<NST, NCMP, NSEL, NWIN>(F, it); }
    }
    if (MEMA) {
#pragma unroll 1
        for (;;) { const int it = q_pop(F, qc + 128); if (it >= 512) break; mem_unit<MST, MDMA, MCOMP>(F, it); }
    }
    __syncthreads();
}
DI void p5_mixers(Frame& F) {
    const int nml = F.G >= 128 ? 64 : 0;
#ifndef RPT_ML
#define RPT_ML 1
#endif
#ifndef RPT_NSA
#define RPT_NSA 1
#endif
#ifndef RPT_MEM
#define RPT_MEM 1
#endif
    if (F.bx < nml || nml == 0) { for (int rp = 0; rp < RPT_ML; ++rp) for (int u = F.bx; u < 64; u += (nml ? nml : F.G)) mlstm_unit2(F, u); }
    if (F.bx >= nml) {
        LAS float* wl = (LAS float*)(F.lds + F.wave * 4096);
        const int gw = (F.bx - nml) * NWAVES + F.wave, NGW = (F.G - nml) * NWAVES;
        for (int rp = 0; rp < RPT_NSA; ++rp) for (int u = F.bx - nml; u < 1024; u += F.G - nml) nsa_unit(F, u);
        __syncthreads();
        for (int rp = 0; rp < RPT_MEM; ++rp) for (int t = gw; t < MT; t += NGW) mem_wave(F, t, wl);
    }
}

DI void p8_router(Frame& F, int alt) {
    unsigned char* ws = F.ws + (size_t)alt * 3 * MiB; const int lane = F.lane_id(), tid = F.tid_id(), wave = F.wave, r = lane & 31, hh = lane >> 5;
    unsigned char* xn8 = (unsigned char*)(F.ws + WS_R1);
    int* tok_e = (int*)(ws + WS_ROUTE + RT_TOKE); int* tok_pos = (int*)(ws + WS_ROUTE + RT_TOKPOS); float* tok_w = (float*)(ws + WS_ROUTE + RT_TOKW);
    unsigned* gcnt = F.ctl + CW_ECNT + 64 * alt;
    const bf16* wrt = (const bf16*)(F.ws + WS_SMALL + SM_WRT);
    LAS unsigned char* img = F.lds;
    LAS float* part = (LAS float*)F.lds;
    LAS float* lg = (LAS float*)(F.lds + 4 * 64 * 33 * 4);
    LAS int* lcnt = (LAS int*)(F.lds + RING_BYTES + 1024);
    LAS int* lbase = lcnt + 32;
    LAS int* se = lbase + 32;
    LAS int* sp = se + 256;
    LAS float* sw = (LAS float*)(sp + 256);
    const float* gf = F.in[I_GFFN];
    for (int bt = F.bx; bt < MT / 64; bt += F.G) {
        __syncthreads();
        if (tid < 32) lcnt[tid] = 0;
#pragma unroll 2
        for (int i = 0; i < 8; ++i) {
            const int tl = wave * 8 + i, t = bt * 64 + tl;
            const f32x4* xr = (const f32x4*)(F.out + (size_t)t * DM) + lane; const f32x4* gr = (const f32x4*)gf + lane;
            f32x4 v[4]; float s = 0.f;
#pragma unroll
            for (int j = 0; j < 4; ++j) { v[j] = xr[64 * j]; s += (v[j].x * v[j].x + v[j].y * v[j].y) + (v[j].z * v[j].z + v[j].w * v[j].w); }
            const float rstd = rsqrtf(wave_sum(s) * (1.f / DM) + EPS);
            unsigned* o4 = (unsigned*)(xn8 + (size_t)t * DM) + lane;
#pragma unroll
            for (int j = 0; j < 4; ++j) { const f32x4 gg = gr[64 * j];
                const float y0 = v[j].x * rstd * gg.x, y1 = v[j].y * rstd * gg.y, y2 = v[j].z * rstd * gg.z, y3 = v[j].w * rstd * gg.w;
                const unsigned long long w = (unsigned long long)pk2(y0, y1) | ((unsigned long long)pk2(y2, y3) << 32);
                int q8 = 0; q8 = __builtin_amdgcn_cvt_pk_fp8_f32(y0, y1, q8, false); q8 = __builtin_amdgcn_cvt_pk_fp8_f32(y2, y3, q8, true);
                o4[64 * j] = (unsigned)q8;
                const int d = 4 * lane + 256 * j, ch = d >> 3;
                *(LAS unsigned long long*)(img + tl * 2048 + 16 * (ch ^ (tl & 15)) + 2 * (d & 7)) = w; }
        }
        __syncthreads();
        {
            const int mb = wave & 1, kq = wave >> 1, trow = 32 * mb + r;
            f32x16 acc;
#pragma unroll
            for (int i = 0; i < 16; ++i) acc[i] = 0.f;
#pragma unroll 4
            for (int s2 = 0; s2 < 16; ++s2) { const int st = 16 * kq + s2;
                const bf16x8 xa = *(const LAS bf16x8*)(img + trow * 2048 + 16 * ((2 * st + hh) ^ (trow & 15)));
                const bf16x8 wh = *(const bf16x8*)(wrt + (size_t)r * 1024 + 16 * st + 8 * hh), wl = *(const bf16x8*)(wrt + 32 * 1024 + (size_t)r * 1024 + 16 * st + 8 * hh);
                acc = MFMA32(xa, wh, acc); acc = MFMA32(xa, wl, acc); }
            __syncthreads();
#pragma unroll
            for (int i = 0; i < 16; ++i) part[(kq * 64 + 32 * mb + crow(i, hh)) * 33 + r] = acc[i];
        }
        __syncthreads();
        for (int i = tid; i < 64 * 32; i += 512) { const int tk = i >> 5, e = i & 31; lg[tk * 33 + e] = ((part[(0 * 64 + tk) * 33 + e] + part[(1 * 64 + tk) * 33 + e]) + (part[(2 * 64 + tk) * 33 + e] + part[(3 * 64 + tk) * 33 + e])) + F.in[I_BR][e]; }
        __syncthreads();
        for (int i = 0; i < 8; ++i) {
            const int tl = wave * 8 + i, e = lane & 31;
            float sc = lg[tl * 33 + e]; int ek[4]; float vk[4];
#pragma unroll
            for (int rd = 0; rd < 4; ++rd) { const float mx = wave_max(sc); const unsigned long long bal = __ballot(sc == mx); const int win = (__ffsll((long long)bal) - 1) & 31;
                ek[rd] = win; vk[rd] = mx; if (e == win) sc = -3.4e38f; }
            const float e1 = __expf(vk[1] - vk[0]), e2 = __expf(vk[2] - vk[0]), e3 = __expf(vk[3] - vk[0]); const float inv = 1.f / (1.f + e1 + e2 + e3);
            if (lane == 0) {
                const float wk[4] = {inv, e1 * inv, e2 * inv, e3 * inv};
#pragma unroll
                for (int rd = 0; rd < 4; ++rd) { se[tl * 4 + rd] = ek[rd]; sw[tl * 4 + rd] = wk[rd]; sp[tl * 4 + rd] = atomicAdd((int*)&lcnt[ek[rd]], 1); }
            }
        }
        __syncthreads();
        if (tid < 32) lbase[tid] = (int)atomicAdd(&gcnt[tid], (unsigned)lcnt[tid]);
        __syncthreads();
        if (tid < 256) { const int t = bt * 64 + (tid >> 2), k = tid & 3; const int e = se[tid];
          tok_e[t * 4 + k] = e; tok_pos[t * 4 + k] = lbase[e] + sp[tid]; tok_w[t * 4 + k] = sw[tid]; }
    }
    __syncthreads();
}
DI int moe_tables(Frame& F, LAS int* pstart, LAS unsigned char* blk_e) {
    unsigned* gcnt = F.ctl + CW_ECNT;
    __syncthreads();
    if (F.tid_id() == 0) { int acc = 0; for (int e = 0; e < NEXP; ++e) { const int cnt = (int)__hip_atomic_load(&gcnt[e], __ATOMIC_RELAXED, __HIP_MEMORY_SCOPE_AGENT); pstart[e] = acc; acc += (cnt + MOEB - 1) / MOEB * MOEB; } pstart[NEXP] = acc; }
    __syncthreads();
    const int nblk = pstart[NEXP] / MOEB;
    for (int rb = F.tid_id(); rb < nblk; rb += 512) { int e = 0; while (e < NEXP - 1 && pstart[e + 1] <= rb * MOEB) ++e; blk_e[rb] = (unsigned char)e; }
    __syncthreads();
    return nblk;
}
DI void p9_scatter(Frame& F) {
    unsigned char* ws = F.ws; const int lane = F.lane_id();
    LAS int* pstart = (LAS int*)(F.lds + 65536); LAS unsigned char* blk_e = (LAS unsigned char*)(F.lds + 65536 + 256);
    moe_tables(F, pstart, blk_e);
    const unsigned char* xn8 = (const unsigned char*)(ws + WS_R1); unsigned char* aperm = (unsigned char*)(ws + WS_APERM);
    const int* tok_e = (const int*)(ws + WS_ROUTE + RT_TOKE); const int* tok_pos = (const int*)(ws + WS_ROUTE + RT_TOKPOS); const float* tok_w = (const float*)(ws + WS_ROUTE + RT_TOKW);
    int* tok_dest = (int*)(ws + WS_ROUTE + RT_TOKDEST); float* roww = (float*)(ws + WS_ROUTE + RT_ROWW);
    unsigned* gcnt = F.ctl + CW_ECNT;
    const int gw = F.bx * NWAVES + F.wave, NGW = F.G * NWAVES;
    for (int t4 = gw; t4 < MT / 4; t4 += NGW) {
        int dest = 0;
        if (lane < 16) { const int it = t4 * 16 + lane; dest = pstart[tok_e[it]] + tok_pos[it]; tok_dest[it] = dest; roww[dest] = tok_w[it]; }
        v4u v0[4];
#pragma unroll
        for (int q = 0; q < 4; ++q) { const v4u* src = (const v4u*)(xn8 + (size_t)(t4 * 4 + q) * DM); v0[q] = src[lane]; }
#pragma unroll
        for (int q = 0; q < 4; ++q)
#pragma unroll
            for (int k = 0; k < 4; ++k) { const int d = __shfl(dest, q * 4 + k); v4u* dst = (v4u*)(aperm + (size_t)d * DM); dst[lane] = v0[q]; }
    }
    for (int it = gw; it < NEXP * MOEB; it += NGW) { const int e = it >> 8, i = it & 255; const int cnt = (int)__hip_atomic_load(&gcnt[e], __ATOMIC_RELAXED, __HIP_MEMORY_SCOPE_AGENT); const int padded = (cnt + MOEB - 1) / MOEB * MOEB;
        if (i < padded - cnt) { const int dest = pstart[e] + cnt + i; v4u* dst = (v4u*)(aperm + (size_t)dest * DM); const v4u z = {0u, 0u, 0u, 0u}; dst[lane] = z; if (lane == 0) roww[dest] = 0.f; } }
}
DI void p12_combine(Frame& F) {
    unsigned char* ws = F.ws; const int lane = F.lane_id();
    const bf16* ybuf = (const bf16*)(ws + WS_APERM); const int* tok_dest = (const int*)(ws + WS_ROUTE + RT_TOKDEST);
    const int gw = F.bx * NWAVES + F.wave, NGW = F.G * NWAVES;
    for (int t2 = gw; t2 < MT / 2; t2 += NGW) {
        typedef int i32x4 __attribute__((ext_vector_type(4)));
        unsigned long long w[2][4][4]; f32x4 a[2][4];
#pragma unroll
        for (int q = 0; q < 2; ++q) { const int t = 2 * t2 + q; const f32x4* orow = (const f32x4*)(F.out + (size_t)t * DM);
            const i32x4 d = *(const i32x4*)(tok_dest + t * 4);
            const unsigned long long* y0 = (const unsigned long long*)(ybuf + (size_t)d.x * DM) + lane; const unsigned long long* y1 = (const unsigned long long*)(ybuf + (size_t)d.y * DM) + lane;
            const unsigned long long* y2 = (const unsigned long long*)(ybuf + (size_t)d.z * DM) + lane; const unsigned long long* y3 = (const unsigned long long*)(ybuf + (size_t)d.w * DM) + lane;
#pragma unroll
            for (int j = 0; j < 4; ++j) { w[q][0][j] = y0[64 * j]; w[q][1][j] = y1[64 * j]; w[q][2][j] = y2[64 * j]; w[q][3][j] = y3[64 * j]; a[q][j] = orow[lane + 64 * j]; } }
#pragma unroll
        for (int q = 0; q < 2; ++q) { f32x4* orow = (f32x4*)(F.out + (size_t)(2 * t2 + q) * DM);
#pragma unroll
            for (int j = 0; j < 4; ++j) {
#pragma unroll
                for (int k = 0; k < 4; ++k) { const unsigned long long ww = w[q][k][j];
                    a[q][j].x += __uint_as_float((unsigned)ww << 16); a[q][j].y += __uint_as_float((unsigned)ww & 0xffff0000u); a[q][j].z += __uint_as_float((unsigned)(ww >> 32) << 16); a[q][j].w += __uint_as_float((unsigned)(ww >> 32) & 0xffff0000u); }
                orow[lane + 64 * j] = a[q][j]; } }
    }
}

constexpr int N_PHASES = 13;
#ifndef MK_PER_PHASE
#define MK_PER_PHASE 0
#endif
__global__ void __launch_bounds__(NWAVES * 64, 2) fwd_kernel(Args args) {
    extern __shared__ __attribute__((aligned(16))) unsigned char lds_raw[];
    Frame F;
    F.lds = (LAS unsigned char*)lds_raw; F.MISC = (volatile LAS unsigned*)(F.lds + MISC_OFF);
    F.wave = __builtin_amdgcn_readfirstlane((int)(threadIdx.x >> 6)); F.G = gridDim.x; F.bx = blockIdx.x;
    F.ws = args.ws; F.ctl = (unsigned*)(args.ws + WS_CTL); F.in = args.in; F.out = args.out;
    unsigned char* ws = args.ws;
    for (int u = threadIdx.x; u < (LDS_BYTES - LDSCTL_OFF) / 4; u += NWAVES * 64) ((LAS unsigned*)(F.lds + LDSCTL_OFF))[u] = 0u;
    __syncthreads();
    const int lo = args.ph_lo, hi = args.ph_hi;
    XcdBarrier bar; bar.wv = F.wave; bar.bar = F.ctl + CW_BAR; bar.x = 0; bar.st = nullptr;
    if (hi - lo > 1) bar = xcd_barrier_post(F.ctl + CW_BAR, F.MISC + 8, F.wave);
#ifndef PH_MASK
#define PH_MASK 0x1fff
#endif
#define IN(k) (((PH_MASK >> (k)) & 1) && lo <= (k) && (k) < hi)
#define SEAM(k) do { if (IN(k) && IN((k) + 1)) xcd_barrier(bar); } while (0)
    typedef pg8::bf16_t b16;
#ifndef RPT_MASK
#define RPT_MASK 0
#endif
#define RPT(k) _Pragma("unroll") for (int rp_ = 0; rp_ < 1 + ((RPT_MASK >> (k)) & 1); ++rp_)
    if (IN(0)) { RPT(0) p0_prologue(F); } SEAM(0);
    if (IN(1)) RPT(1) {
        { pg8::Gemm g{(const b16*)(ws + WS_R1), (const b16*)(ws + WS_WIN), MT, NPROJ, DM}; pg8::StaticOrder S; S.init(MT, NPROJ, F.G, F.bx);
          pg8::EpiBf16Silu E{(b16*)(ws + WS_PROJ), NPROJ, nullptr, 0};
          pg8::gemm_phase<pg8::EpiBf16Silu, pg8::StaticOrder, true, true>(F.lds, g, S, E, F.wave); }
        { pg8::Gemm g{(const b16*)(ws + WS_MEMN), (const b16*)(ws + WS_WMKV), MROWS, 1024, DM}; pg8::StaticOrder S; S.init(MROWS, 1024, F.G, (F.bx + 64) % F.G);
          pg8::EpiBf16Silu E{(b16*)(ws + WS_MEMKV), 1024, nullptr, 0};
          pg8::gemm_phase<pg8::EpiBf16Silu, pg8::StaticOrder, true, true>(F.lds, g, S, E, F.wave); }
    } SEAM(1);
    if (IN(2)) { RPT(2) p2_prep(F); } SEAM(2);
    if (IN(3)) RPT(3) {
#pragma unroll
        for (int kv = 0; kv < 2; ++kv) {
            pg8::Gemm g{(const b16*)(ws + WS_ACMP) + (size_t)kv * 4096 * 2048, (const b16*)(ws + WS_WC1) + (size_t)kv * 256 * 2048, 4096, 256, 2048}; pg8::StaticOrder S; S.init(4096, 256, F.G, (F.bx + F.G - 16 * kv) % F.G);
            pg8::EpiBf16Silu E{(b16*)(ws + WS_HID) + (size_t)kv * 4096 * 256, 256, (const float*)(ws + WS_SMALL + SM_CBIAS) + kv * 256, 1};
            pg8::gemm_phase<pg8::EpiBf16Silu, pg8::StaticOrder, true, true>(F.lds, g, S, E, F.wave); }
    } SEAM(3);
    if (IN(4)) { RPT(4) p4_kcvc(F); } SEAM(4);
#ifndef RPT5_ML
#define RPT5_ML 0
#endif
#ifndef MLPROBE
#define MLPROBE 0xff
#endif
#ifndef NPROBE_ST
#define NPROBE_ST true
#endif
#ifndef NPROBE_CMP
#define NPROBE_CMP true
#endif
#ifndef NPROBE_SEL
#define NPROBE_SEL true
#endif
#ifndef NPROBE_WIN
#define NPROBE_WIN true
#endif
#ifndef MPROBE_ST
#define MPROBE_ST true
#endif
#ifndef MPROBE_DMA
#define MPROBE_DMA true
#endif
#ifndef MPROBE_COMP
#define MPROBE_COMP true
#endif
#ifndef RPT5_NSA
#define RPT5_NSA 0
#endif
#ifndef RPT5_MEM
#define RPT5_MEM 0
#endif
    if (IN(5)) { p5_queue<true, true, true>(F, 0);
        if (RPT5_ML || RPT5_NSA || RPT5_MEM) { xcd_barrier(bar); p5_queue<RPT5_ML != 0, RPT5_NSA != 0, RPT5_MEM != 0, MPROBE_ST, MPROBE_DMA, MPROBE_COMP, NPROBE_ST, NPROBE_CMP, NPROBE_SEL, NPROBE_WIN, MLPROBE>(F, 256); } } SEAM(5);
    if (IN(6)) RPT(6) {
        pg8::StaticOrder S; S.init(MT, DM, F.G, F.bx);
        { pg8::Gemm g{(const b16*)(ws + WS_H0), (const b16*)(ws + WS_WBR), MT, DM, 512}; pg8::EpiGate<0> E{(const b16*)(ws + WS_PROJ), F.out, (b16*)(ws + WS_R1)};
          pg8::gemm_phase<pg8::EpiGate<0>, pg8::StaticOrder, true, true>(F.lds, g, S, E, F.wave); }
        { pg8::Gemm g{(const b16*)(ws + WS_H1), (const b16*)(ws + WS_WBR) + 1024 * 512, MT, DM, 512}; pg8::EpiGate<1> E{(const b16*)(ws + WS_PROJ), F.out, (b16*)(ws + WS_R1)};
          pg8::gemm_phase<pg8::EpiGate<1>, pg8::StaticOrder, true, true>(F.lds, g, S, E, F.wave); }
        { pg8::Gemm g{(const b16*)(ws + WS_H2), (const b16*)(ws + WS_WBR) + 2 * 1024 * 512, MT, DM, 512}; pg8::EpiGate<2> E{(const b16*)(ws + WS_PROJ), F.out, (b16*)(ws + WS_R1)};
          pg8::gemm_phase<pg8::EpiGate<2>, pg8::StaticOrder, true, true>(F.lds, g, S, E, F.wave); }
    } SEAM(6);
    if (IN(7)) RPT(7) {
        pg8::Gemm g{(const b16*)(ws + WS_R1), (const b16*)(ws + WS_WOUT), MT, DM, DM}; pg8::StaticOrder S; S.init(MT, DM, F.G, F.bx);
        pg8::EpiRes E{F.in[I_X], F.out};
        pg8::gemm_phase<pg8::EpiRes, pg8::StaticOrder, true, true>(F.lds, g, S, E, F.wave);
    } SEAM(7);
    if (IN(8)) { p8_router(F, 0); if ((RPT_MASK >> 8) & 1) p8_router(F, 1); } SEAM(8);
    if (IN(9)) { RPT(9) p9_scatter(F); } SEAM(9);
    if (IN(10)) RPT(10) {
        LAS int* pstart = (LAS int*)(F.lds + RING_BYTES + 1024); LAS unsigned char* blk_e = (LAS unsigned char*)(F.lds + RING_BYTES + 1024 + 256);
        const int nblk = moe_tables(F, pstart, blk_e);
        pg8::Gemm8 g{(const unsigned char*)(ws + WS_APERM), (const unsigned char*)(ws + WS_WGU), CAP, NEXP * 2048, DM, 0x7f7f7f7f, 0x77777777};
        pg8::MoeOrder<8> S{nblk, F.G, F.bx, (const PG8_LAS unsigned char*)blk_e};
        pg8::EpiSwiglu E{(unsigned char*)(ws + WS_ACT), F.in[I_BGU]};
        pg8::gemm_phase_f8<pg8::EpiSwiglu, pg8::MoeOrder<8>, true, true>(F.lds, g, S, E, F.wave);
    } SEAM(10);
    if (IN(11)) RPT(11) {
        LAS int* pstart = (LAS int*)(F.lds + RING_BYTES + 1024); LAS unsigned char* blk_e = (LAS unsigned char*)(F.lds + RING_BYTES + 1024 + 256);
        const int nblk = moe_tables(F, pstart, blk_e);
        pg8::Gemm8 g{(const unsigned char*)(ws + WS_ACT), (const unsigned char*)(ws + WS_WDN), CAP, NEXP * DM, DFF, 0x7f7f7f7f, 0x77777777};
        pg8::MoeOrder<4> S{nblk, F.G, F.bx, (const PG8_LAS unsigned char*)blk_e};
        pg8::EpiDown E{(b16*)(ws + WS_APERM), F.in[I_BDN], (const float*)(ws + WS_ROUTE + RT_ROWW)};
        pg8::gemm_phase_f8<pg8::EpiDown, pg8::MoeOrder<4>, true, true>(F.lds, g, S, E, F.wave);
    } SEAM(11);
    if (IN(12)) { p12_combine(F); }
#undef IN
#undef SEAM
}

extern "C" void kernel_launch(void* const* d_in, const int* in_sizes, int n_in, void* d_out, int out_size, void* d_ws, size_t ws_size, hipStream_t stream) {
    static int grid = 0;
    if (grid == 0) {
        if (n_in != N_IN || out_size != MT * DM || ws_size < WS_END) { fprintf(stderr, "kernel_launch: unexpected shapes (n_in %d, out %d, ws %zu need %zu)\n", n_in, out_size, ws_size, (size_t)WS_END); grid = -1; return; }
        int dev = 0, cus = 0, per_cu = 0;
        if (hipGetDevice(&dev) != hipSuccess || hipDeviceGetAttribute(&cus, hipDeviceAttributeMultiprocessorCount, dev) != hipSuccess) { grid = -1; return; }
        if (hipFuncSetAttribute((const void*)fwd_kernel, hipFuncAttributeMaxDynamicSharedMemorySize, LDS_BYTES) != hipSuccess) { fprintf(stderr, "kernel_launch: hipFuncSetAttribute failed\n"); grid = -1; return; }
        if (hipOccupancyMaxActiveBlocksPerMultiprocessor(&per_cu, (const void*)fwd_kernel, NWAVES * 64, LDS_BYTES) != hipSuccess || per_cu < 1) { fprintf(stderr, "kernel_launch: occupancy query says %d\n", per_cu); }
        (void)hipGetLastError();
        grid = cus;
    }
    if (grid < 0) return;
    if (hipMemsetAsync((char*)d_ws + WS_CTL, 0, CTL_ZERO_BYTES, stream) != hipSuccess) return;
    Args a{};
    for (int i = 0; i < N_IN; ++i) a.in[i] = (const float*)d_in[i];
    a.out = (float*)d_out; a.ws = (unsigned char*)d_ws;
#if MK_PER_PHASE
    for (int p = 0; p < N_PHASES; ++p) { a.ph_lo = p; a.ph_hi = p + 1; a.li = 0; hipLaunchKernelGGL(fwd_kernel, dim3(grid), dim3(NWAVES * 64), LDS_BYTES, stream, a); }
#else
    a.ph_lo = 0; a.ph_hi = N_PHASES; a.li = 0;
    hipLaunchKernelGGL(fwd_kernel, dim3(grid), dim3(NWAVES * 64), LDS_BYTES, stream, a);
#endif
}
```

```cpp
#include <hip/hip_runtime.h>
#include <cstdio>
#include <cstdint>
namespace pg8 {
#define PG8_LAS __attribute__((address_space(3)))
typedef unsigned short bf16_t;
typedef short bf16x8 __attribute__((ext_vector_type(8)));
typedef float f32x4 __attribute__((ext_vector_type(4)));
typedef unsigned u32x4 __attribute__((ext_vector_type(4)));
constexpr int BM = 256, BK = 64, HALF = 128, HTB = HALF * BK * 2  , STAGE_BYTES = 8 * HTB, NXCD = 8, WGM = 8;

__host__ __device__ __forceinline__ int lds_byte(int r, int c) { const int st = (r >> 4) * 2 + (c >> 5), rr = r & 15, cc = c & 31, ob = rr * 64 + cc * 2; return st * 1024 + (ob ^ (((ob >> 9) & 1) << 5)); }
__host__ __device__ __forceinline__ void stage_rc(int b, int& R, int& C) { const int st = b / 1024, sb = b % 1024, swz = sb ^ (((sb >> 9) & 1) << 5); R = (st >> 1) * 16 + swz / 64; C = (st & 1) * 32 + (swz % 64) / 2; }
__host__ __device__ __forceinline__ int perm32(int rho) { const int n = rho >> 4, i = rho & 15; return 8 * (i >> 2) + 4 * n + (i & 3); }

struct Unit { int pm, pn; };
struct Gemm { const bf16_t* A; const bf16_t* Bt; int M, N, K; };

struct StaticOrder {
    int nM, nN, nwg, G, c;
    __host__ __device__ void init(int M, int N, int G_, int c_) { nM = M / BM; nN = N / BM; nwg = nM * nN; G = G_; c = c_; }
    __host__ __device__ bool next(int i, Unit& u) const {
        const long L = (long)i * G + c; if (L >= nwg) return false;
        int wgid = (int)L; { const int q = nwg / NXCD, r = nwg % NXCD, xcd = wgid % NXCD, off = wgid / NXCD; wgid = (xcd < r ? xcd * (q + 1) : r * (q + 1) + (xcd - r) * q) + off; }
        const int nig = WGM * nN, gid = wgid / nig, fm = gid * WGM, gsz = (nM - fm) < WGM ? (nM - fm) : WGM;
        u.pm = fm + ((wgid % nig) % gsz); u.pn = (wgid % nig) / gsz; return true;
    }
    __device__ __forceinline__ void a_ready(const Unit&) const {}
    __device__ __forceinline__ void done(const Unit&) const {}
};

__device__ __forceinline__ unsigned cvt_pk_bf16(float lo, float hi) { unsigned r; asm volatile("v_cvt_pk_bf16_f32 %0, %1, %2" : "=v"(r) : "v"(lo), "v"(hi)); return r; }
typedef float f32x2 __attribute__((ext_vector_type(2)));
__device__ __forceinline__ f32x2 gelu_pk(f32x2 v) {
    const f32x2 av = __builtin_elementwise_abs(v), d = av * 0.2316418882f + 1.0f;
    f32x2 t; t.x = __builtin_amdgcn_rcpf(d.x); t.y = __builtin_amdgcn_rcpf(d.y);
    f32x2 q = t * 0.5307027145f + (-0.7265760135f); q = q * t + 0.7107068705f; q = q * t + (-0.142248368f); q = q * t + 0.127414796f; q = q * t;
    const f32x2 s = (v * v) * (-0.72134752044f);
    f32x2 e; e.x = __builtin_amdgcn_exp2f(s.x); e.y = __builtin_amdgcn_exp2f(s.y);
    const f32x2 m = v * (q * e), r = v - m;
    f32x2 o; o.x = v.x < 0.f ? m.x : r.x; o.y = v.y < 0.f ? m.y : r.y; return o;
}

template <int ACT  > struct EpiBf16 {
    static constexpr bool PERM = true, AFTER_DRAIN = false; static_assert(ACT == 0 || ACT == 1, "EpiBf16: ACT is 0 (none) or 1 (gelu_pk)");
    bf16_t* O; int ldc; const float* bias; int split_cols; size_t split_stride; float scale0;
    __device__ __forceinline__ void operator()(const f32x4 (&acc)[2][2][4][2], const Unit& u, int wr, int wc, int fr, int fq) const {
        const int row0 = u.pm * BM + wr * 64 + fr; int colt = u.pn * BM; bf16_t* base = O;
        float sc = 1.f; if (split_cols) { const int t = colt / split_cols; base += (size_t)t * split_stride; colt -= t * split_cols; if (t == 0) sc = scale0; }
        const int col0 = colt + wc * 32 + 8 * fq, bcol0 = u.pn * BM + wc * 32 + 8 * fq;
        f32x4 bv[2][2];
#pragma unroll
        for (int bj = 0; bj < 2; ++bj)
#pragma unroll
            for (int n = 0; n < 2; ++n) bv[bj][n] = bias ? *(const f32x4*)(bias + bcol0 + bj * HALF + 4 * n) : (f32x4){0.f, 0.f, 0.f, 0.f};
#pragma unroll
        for (int ai = 0; ai < 2; ++ai)
#pragma unroll
            for (int m = 0; m < 4; ++m) { bf16_t* rowp = base + (size_t)(row0 + ai * HALF + m * 16) * ldc + col0;
#pragma unroll
                for (int bj = 0; bj < 2; ++bj) { f32x4 v0 = acc[ai][bj][m][0] + bv[bj][0], v1 = acc[ai][bj][m][1] + bv[bj][1];
                    if (ACT == 1) { f32x2 a = gelu_pk((f32x2){v0[0], v0[1]}), b = gelu_pk((f32x2){v0[2], v0[3]}), c = gelu_pk((f32x2){v1[0], v1[1]}), d = gelu_pk((f32x2){v1[2], v1[3]});
                        v0 = (f32x4){a.x, a.y, b.x, b.y}; v1 = (f32x4){c.x, c.y, d.x, d.y}; }
                    v0 = v0 * sc; v1 = v1 * sc; u32x4 w; w.x = cvt_pk_bf16(v0[0], v0[1]); w.y = cvt_pk_bf16(v0[2], v0[3]); w.z = cvt_pk_bf16(v1[0], v1[1]); w.w = cvt_pk_bf16(v1[2], v1[3]);
                    *(u32x4*)(rowp + bj * HALF) = w; } }
    }
};

struct PanelStats {
    unsigned* xbuf;
    unsigned* cnt;
    unsigned* tmo;
    int ntn; float eps;
    unsigned code;
    __device__ __forceinline__ bool run(const f32x4 (&v)[2][2][4][2], const Unit& u, int wr, int wc, int fr, int fq, PG8_LAS unsigned char* lds, int wid, int lane) const {
        typedef float f32x2v __attribute__((ext_vector_type(2)));
        PG8_LAS f32x2v* P = (PG8_LAS f32x2v*)lds;
        PG8_LAS f32x2v* S = (PG8_LAS f32x2v*)(lds + 8192);
        PG8_LAS unsigned* flag = (PG8_LAS unsigned*)(lds + 8192 + 2048);
#pragma unroll
        for (int ai = 0; ai < 2; ++ai)
#pragma unroll
            for (int m = 0; m < 4; ++m) {
                float s = 0.f;
#pragma unroll
                for (int bj = 0; bj < 2; ++bj)
#pragma unroll
                    for (int n = 0; n < 2; ++n) { const f32x4 x = v[ai][bj][m][n]; s += (x[0] + x[1]) + (x[2] + x[3]); }
                s += __shfl_xor(s, 16); s += __shfl_xor(s, 32);
                const float mw = s * (1.0f / 64.0f); float q = 0.f;
#pragma unroll
                for (int bj = 0; bj < 2; ++bj)
#pragma unroll
                    for (int n = 0; n < 2; ++n) { const f32x4 d = v[ai][bj][m][n] - mw; q += (d[0] * d[0] + d[1] * d[1]) + (d[2] * d[2] + d[3] * d[3]); }
                q += __shfl_xor(q, 16); q += __shfl_xor(q, 32);
                if (fq == 0) P[(ai * HALF + wr * 64 + m * 16 + fr) * 4 + wc] = (f32x2v){mw, q};
            }
        asm volatile("s_waitcnt lgkmcnt(0)" ::: "memory"); __builtin_amdgcn_s_barrier(); asm volatile("" ::: "memory");
#if defined(BROKEN_EXCHANGE_NO_WAIT)
#warning BROKEN CONTROL BUILD: the row-statistics exchange does not wait; results are wrong by design
        if (blockIdx.x >= 64) { const long long t0_ = clock64(); while (clock64() - t0_ < 60000) __builtin_amdgcn_s_sleep(8); }
#endif
        const int row = wid * 32 + (lane & 31);
        if (lane < 32) {
            const f32x2v a = P[row * 4 + 0], b = P[row * 4 + 1], c = P[row * 4 + 2], d = P[row * 4 + 3];
            const float mt = (a.x + b.x + c.x + d.x) * 0.25f;
            const float da = a.x - mt, db = b.x - mt, dc = c.x - mt, dd = d.x - mt;
            const float m2 = (a.y + b.y) + (c.y + d.y) + 64.0f * ((da * da + db * db) + (dc * dc + dd * dd));
            unsigned long long* slot = (unsigned long long*)xbuf + ((size_t)(u.pm * BM + row) * 4 + u.pn);
            __hip_atomic_store(slot, ((unsigned long long)__float_as_uint(m2) << 32) | __float_as_uint(mt), __ATOMIC_RELAXED, __HIP_MEMORY_SCOPE_AGENT);
        }
        asm volatile("s_waitcnt vmcnt(0)" ::: "memory");
        if (lane == 0) __hip_atomic_fetch_add(cnt + 64 * u.pm, 1u, __ATOMIC_RELAXED, __HIP_MEMORY_SCOPE_AGENT);
        if (wid == 0) {
            bool dead = false; const unsigned long long t0 = __builtin_amdgcn_s_memrealtime(); const unsigned want = 8u * (unsigned)ntn;
            for (;;) {
#if defined(BROKEN_EXCHANGE_NO_WAIT)
                break;
#endif
                if ((unsigned)__builtin_amdgcn_readfirstlane(__hip_atomic_load(cnt + 64 * u.pm, __ATOMIC_RELAXED, __HIP_MEMORY_SCOPE_AGENT)) >= want) break;
                if (__builtin_amdgcn_s_memrealtime() - t0 > 2000000ull) {
                    if (lane == 0) { unsigned expect = 0u; __hip_atomic_compare_exchange_strong(tmo + 1, &expect, code | (unsigned)(u.pm & 0xff), __ATOMIC_RELAXED, __ATOMIC_RELAXED, __HIP_MEMORY_SCOPE_AGENT);
                                     __hip_atomic_store(tmo, 1u, __ATOMIC_RELAXED, __HIP_MEMORY_SCOPE_AGENT); }
                    dead = true; break; }
                __builtin_amdgcn_s_sleep(2);
            }
            __builtin_amdgcn_fence(__ATOMIC_ACQUIRE, "agent");
            if (lane == 0) flag[0] = dead ? 1u : 0u;
        }
        asm volatile("s_waitcnt vmcnt(0) lgkmcnt(0)" ::: "memory"); __builtin_amdgcn_s_barrier(); asm volatile("" ::: "memory");
        const bool bad = flag[0] != 0u;
        if (lane < 32) {
            const unsigned long long* slot = (const unsigned long long*)xbuf + (size_t)(u.pm * BM + row) * 4; float mt[4], m2[4]; float ms = 0.f;
#pragma unroll
            for (int t = 0; t < 4; ++t) { if (t < ntn) { const unsigned long long w = __hip_atomic_load(slot + t, __ATOMIC_RELAXED, __HIP_MEMORY_SCOPE_AGENT); mt[t] = __uint_as_float((unsigned)w); m2[t] = __uint_as_float((unsigned)(w >> 32)); } else { mt[t] = 0.f; m2[t] = 0.f; } ms += mt[t]; }
            const float mean = ms / (float)ntn; float q = 0.f;
#pragma unroll
            for (int t = 0; t < 4; ++t) if (t < ntn) { const float dm = mt[t] - mean; q += m2[t] + 256.0f * dm * dm; }
            S[row] = (f32x2v){mean, 1.0f / sqrtf(q / (256.0f * (float)ntn) + eps)};
        }
        asm volatile("s_waitcnt lgkmcnt(0)" ::: "memory"); __builtin_amdgcn_s_barrier(); asm volatile("" ::: "memory");
        return bad;
    }
};
struct EpiLnRes {
    static constexpr bool PERM = false, AFTER_DRAIN = true;
    const float* base; float* out; int ldc; const float* bias; PanelStats st; unsigned poison;
    __device__ __forceinline__ void fused(f32x4 (&acc)[2][2][4][2], const Unit& u, int wr, int wc, int fr, int fq, PG8_LAS unsigned char* lds, int wid, int lane) const {
        typedef float f32x2v __attribute__((ext_vector_type(2)));
        const PG8_LAS f32x2v* S = (const PG8_LAS f32x2v*)(lds + 8192);
        const int col0 = u.pn * BM + wc * 32 + 4 * fq;
#pragma unroll
        for (int bj = 0; bj < 2; ++bj)
#pragma unroll
            for (int n = 0; n < 2; ++n) { const f32x4 bv = bias ? *(const f32x4*)(bias + col0 + bj * HALF + n * 16) : (f32x4){0.f, 0.f, 0.f, 0.f};
#pragma unroll
                for (int ai = 0; ai < 2; ++ai)
#pragma unroll
                    for (int m = 0; m < 4; ++m) acc[ai][bj][m][n] += bv; }
        f32x4 pre[4][2][2];
#pragma unroll
        for (int m = 0; m < 4; ++m) { const size_t off = (size_t)(u.pm * BM + wr * 64 + m * 16 + fr) * ldc + col0;
#pragma unroll
            for (int bj = 0; bj < 2; ++bj)
#pragma unroll
                for (int n = 0; n < 2; ++n) pre[m][bj][n] = *(const f32x4*)(base + off + bj * HALF + n * 16); }
        const bool bad = st.run(acc, u, wr, wc, fr, fq, lds, wid, lane) || poison != 0u;
        const float qnan = __builtin_nanf("");
#pragma unroll
        for (int ai = 0; ai < 2; ++ai)
#pragma unroll
            for (int m = 0; m < 4; ++m) { const int r = ai * HALF + wr * 64 + m * 16 + fr; const f32x2v sr = S[r]; const size_t off = (size_t)(u.pm * BM + r) * ldc + col0;
#pragma unroll
                for (int bj = 0; bj < 2; ++bj)
#pragma unroll
                    for (int n = 0; n < 2; ++n) { const f32x4 bs = ai == 0 ? pre[m][bj][n] : *(const f32x4*)(base + off + bj * HALF + n * 16); f32x4 o = bs + (acc[ai][bj][m][n] - sr.x) * sr.y;
                        if (bad) o = (f32x4){qnan, qnan, qnan, qnan}; *(f32x4*)(out + off + bj * HALF + n * 16) = o; }
                if (m & 1) asm volatile("" ::: "memory"); }
    }
};
struct EpiLnResLn {
    static constexpr bool PERM = false, AFTER_DRAIN = true;
    const float* base; float* out; bf16_t* xn; int ldc; const float* bias; PanelStats st1, st2; unsigned poison;
    __device__ __forceinline__ void fused(f32x4 (&acc)[2][2][4][2], const Unit& u, int wr, int wc, int fr, int fq, PG8_LAS unsigned char* lds, int wid, int lane) const {
        typedef float f32x2v __attribute__((ext_vector_type(2))); typedef unsigned u32x2v __attribute__((ext_vector_type(2)));
        const PG8_LAS f32x2v* S = (const PG8_LAS f32x2v*)(lds + 8192);
        const int col0 = u.pn * BM + wc * 32 + 4 * fq;
#pragma unroll
        for (int bj = 0; bj < 2; ++bj)
#pragma unroll
            for (int n = 0; n < 2; ++n) { const f32x4 bv = bias ? *(const f32x4*)(bias + col0 + bj * HALF + n * 16) : (f32x4){0.f, 0.f, 0.f, 0.f};
#pragma unroll
                for (int ai = 0; ai < 2; ++ai)
#pragma unroll
                    for (int m = 0; m < 4; ++m) acc[ai][bj][m][n] += bv; }
        bool bad = st1.run(acc, u, wr, wc, fr, fq, lds, wid, lane) || poison != 0u;
        const float qnan = __builtin_nanf("");
#pragma unroll
        for (int ai = 0; ai < 2; ++ai)
#pragma unroll
            for (int m = 0; m < 4; ++m) { const int r = ai * HALF + wr * 64 + m * 16 + fr; const f32x2v sr = S[r]; const size_t off = (size_t)(u.pm * BM + r) * ldc + col0;
#pragma unroll
                for (int bj = 0; bj < 2; ++bj)
#pragma unroll
                    for (int n = 0; n < 2; ++n) { const f32x4 bs = *(const f32x4*)(base + off + bj * HALF + n * 16); acc[ai][bj][m][n] = bs + (acc[ai][bj][m][n] - sr.x) * sr.y; }
                asm volatile("" : "+v"(acc[ai][0][m][0]), "+v"(acc[ai][0][m][1]), "+v"(acc[ai][1][m][0]), "+v"(acc[ai][1][m][1]));
                if (m & 1) asm volatile("" ::: "memory"); }
        const bool bad1 = bad;
        bad = st2.run(acc, u, wr, wc, fr, fq, lds, wid, lane) || bad;
#pragma unroll
        for (int ai = 0; ai < 2; ++ai)
#pragma unroll
            for (int m = 0; m < 4; ++m) { const int r = ai * HALF + wr * 64 + m * 16 + fr; const f32x2v sr = S[r]; const size_t off = (size_t)(u.pm * BM + r) * ldc + col0;
#pragma unroll
                for (int bj = 0; bj < 2; ++bj)
#pragma unroll
                    for (int n = 0; n < 2; ++n) { const f32x4 x1 = acc[ai][bj][m][n]; *(f32x4*)(out + off + bj * HALF + n * 16) = bad1 ? (f32x4){qnan, qnan, qnan, qnan} : x1;
                        const f32x4 o = (x1 - sr.x) * sr.y; u32x2v w; w.x = cvt_pk_bf16(o[0], o[1]); w.y = cvt_pk_bf16(o[2], o[3]);
                        if (bad) { w.x = 0x7fc07fc0u; w.y = 0x7fc07fc0u; } *(u32x2v*)(xn + off + bj * HALF + n * 16) = w; }
                asm volatile("" ::: "memory"); }
    }
};

template <class Epi, class Sched, bool ALIGN_EPI = false, bool SP2 = false>
__device__ __forceinline__ void gemm_phase(PG8_LAS unsigned char* lds, const Gemm g, const Sched& S, const Epi& E, int wid_in) {
    int lane_; asm volatile("v_mbcnt_lo_u32_b32 %0, -1, 0\n\tv_mbcnt_hi_u32_b32 %0, -1, %0" : "=v"(lane_));
    const int wid = wid_in, lane = lane_, tid = wid * 64 + lane, wr = wid >> 2, wc = wid & 3, fr = lane & 15, fq = lane >> 4;
    const int K = g.K, nt = K / BK;
    unsigned voffA[2], voffB[2];
#pragma unroll
    for (int i = 0; i < 2; ++i) { int R, C; stage_rc(tid * 16 + i * 8192, R, C); const int Rb = Epi::PERM ? ((R & ~31) + perm32(R & 31)) : R;
        voffA[i] = (unsigned)(R * K + C) * 2u; voffB[i] = (unsigned)(Rb * K + C) * 2u; }
    const size_t kstep = (size_t)(BK * 2);
    const size_t hstep = (size_t)HALF * K * 2;
    const size_t tstep = 2 * hstep;
    const unsigned ldsw = (unsigned)wid * 1024u;
    const int aoff = lds_byte(wr * 64 + fr, fq * 8), boff = lds_byte(wc * 32 + fr, fq * 8);
#define PG8_SA(b, h) (((b) * 2 + (h)) * HTB)
#define PG8_SB(b, h) ((4 + (b) * 2 + (h)) * HTB)
#define PG8_STAGE(bufoff, gbase, voff) do { _Pragma("unroll") for (int _i = 0; _i < 2; ++_i) \
        __builtin_amdgcn_global_load_lds((const unsigned*)((const char*)(gbase) + (voff)[_i]), (PG8_LAS unsigned*)(lds + (bufoff) + ldsw + _i * 8192), 16, 0, 0); } while (0)
#define PG8_LDA(dst, b, h) do { _Pragma("unroll") for (int m = 0; m < 4; ++m) _Pragma("unroll") for (int k = 0; k < 2; ++k) dst[m][k] = *(const PG8_LAS bf16x8*)(lds + PG8_SA(b, h) + aoff + m * 2048 + k * 1024); } while (0)
#define PG8_LDB(dst, b, h) do { _Pragma("unroll") for (int n = 0; n < 2; ++n) _Pragma("unroll") for (int k = 0; k < 2; ++k) dst[n][k] = *(const PG8_LAS bf16x8*)(lds + PG8_SB(b, h) + boff + n * 2048 + k * 1024); } while (0)
#define PG8_MMA(ai, bj, At, Bt) do { __builtin_amdgcn_s_setprio(1); _Pragma("unroll") for (int m = 0; m < 4; ++m) _Pragma("unroll") for (int n = 0; n < 2; ++n) _Pragma("unroll") for (int k = 0; k < 2; ++k) \
        acc[ai][bj][m][n] = __builtin_amdgcn_mfma_f32_16x16x32_bf16(Bt[n][k], At[m][k], acc[ai][bj][m][n], 0, 0, 0); __builtin_amdgcn_s_setprio(0); } while (0)
#define PG8_WAIT_V(n) asm volatile("s_waitcnt vmcnt(" #n ")" ::: "memory")
#define PG8_WAIT_L(n) asm volatile("s_waitcnt lgkmcnt(" #n ")" ::: "memory")
#define PG8_BAR __builtin_amdgcn_s_barrier()
#define PG8_SCHED __builtin_amdgcn_sched_barrier(0)
    Unit cur, nxt; int ui = 0;
    if (!S.next(0, cur)) return;
    f32x4 acc[2][2][4][2];
#pragma unroll
    for (int a = 0; a < 2; ++a)
#pragma unroll
        for (int b = 0; b < 2; ++b)
#pragma unroll
            for (int m = 0; m < 4; ++m)
#pragma unroll
                for (int n = 0; n < 2; ++n) acc[a][b][m][n] = (f32x4){0.f, 0.f, 0.f, 0.f};
    bf16x8 At[4][2], B0[2][2], B1[2][2];
    const char* cA = (const char*)g.A + (size_t)cur.pm * tstep; const char* cB = (const char*)g.Bt + (size_t)cur.pn * tstep;
    S.a_ready(cur);
    if constexpr (SP2) {
        PG8_STAGE(PG8_SB(0, 0), cB, voffB); PG8_STAGE(PG8_SB(0, 1), cB + hstep, voffB); PG8_STAGE(PG8_SA(0, 0), cA, voffA); PG8_STAGE(PG8_SA(0, 1), cA + hstep, voffA);
        if (wr == 1) PG8_BAR;
        PG8_WAIT_V(2); PG8_BAR;
        PG8_STAGE(PG8_SB(1, 0), cB + kstep, voffB); PG8_STAGE(PG8_SA(1, 0), cA + kstep, voffA); PG8_STAGE(PG8_SB(1, 1), cB + hstep + kstep, voffB);
        PG8_WAIT_V(6); PG8_BAR;
    } else {
        PG8_STAGE(PG8_SB(0, 0), cB, voffB); PG8_STAGE(PG8_SA(0, 0), cA, voffA); PG8_STAGE(PG8_SB(0, 1), cB + hstep, voffB); PG8_STAGE(PG8_SA(0, 1), cA + hstep, voffA);
        if (wr == 1) PG8_BAR;
        PG8_WAIT_V(4); PG8_BAR;
        PG8_STAGE(PG8_SB(1, 0), cB + kstep, voffB); PG8_STAGE(PG8_SA(1, 0), cA + kstep, voffA); PG8_STAGE(PG8_SB(1, 1), cB + hstep + kstep, voffB);
        PG8_WAIT_V(6); PG8_BAR;
    }
    for (;;) {
        const bool has_next = S.next(ui + 1, nxt);
        const char* nA = has_next ? (const char*)g.A + (size_t)nxt.pm * tstep : cA; const char* nB = has_next ? (const char*)g.Bt + (size_t)nxt.pn * tstep : cB;
        for (int t = 0; t < nt; t += 2) {
            const bool last = (t == nt - 2);
            const char* a1 = cA + (size_t)(t + 1) * kstep;
            const char* a2 = last ? nA : cA + (size_t)(t + 2) * kstep; const char* b2 = last ? nB : cB + (size_t)(t + 2) * kstep;
            const char* a3 = a2 + kstep; const char* b3 = b2 + kstep;
            if (last && has_next) S.a_ready(nxt);
            if constexpr (SP2) {
            PG8_LDB(B0, 0, 0); PG8_LDB(B1, 0, 1); PG8_SCHED; PG8_LDA(At, 0, 0); PG8_STAGE(PG8_SA(1, 1), a1 + hstep, voffA);
            PG8_WAIT_V(8); PG8_WAIT_L(0); PG8_BAR; PG8_MMA(0, 0, At, B0); PG8_MMA(0, 1, At, B1); PG8_BAR; PG8_SCHED;
            PG8_LDA(At, 0, 1); PG8_STAGE(PG8_SB(0, 0), b2, voffB); PG8_STAGE(PG8_SB(0, 1), b2 + hstep, voffB); PG8_STAGE(PG8_SA(0, 0), a2, voffA);
            PG8_WAIT_V(8); PG8_WAIT_L(0); PG8_BAR; PG8_MMA(1, 0, At, B0); PG8_MMA(1, 1, At, B1); PG8_BAR; PG8_SCHED;
            PG8_LDB(B0, 1, 0); PG8_LDB(B1, 1, 1); PG8_SCHED; PG8_LDA(At, 1, 0); PG8_STAGE(PG8_SA(0, 1), a2 + hstep, voffA);
            PG8_WAIT_V(8); PG8_WAIT_L(0); PG8_BAR; PG8_MMA(0, 0, At, B0); PG8_MMA(0, 1, At, B1); PG8_BAR; PG8_SCHED;
            PG8_LDA(At, 1, 1); PG8_STAGE(PG8_SB(1, 0), b3, voffB); PG8_STAGE(PG8_SB(1, 1), b3 + hstep, voffB); PG8_STAGE(PG8_SA(1, 0), a3, voffA);
            PG8_WAIT_V(8); PG8_WAIT_L(0); PG8_BAR; PG8_MMA(1, 0, At, B0); PG8_MMA(1, 1, At, B1); PG8_BAR; PG8_SCHED;
            } else {
            PG8_LDB(B0, 0, 0); PG8_SCHED; PG8_LDA(At, 0, 0); PG8_STAGE(PG8_SA(1, 1), a1 + hstep, voffA);
            PG8_WAIT_L(8); PG8_BAR; PG8_WAIT_L(0); PG8_MMA(0, 0, At, B0); PG8_BAR; PG8_SCHED;
            PG8_LDB(B1, 0, 1); PG8_STAGE(PG8_SB(0, 0), b2, voffB);
            PG8_BAR; PG8_WAIT_L(0); PG8_MMA(0, 1, At, B1); PG8_BAR;
            PG8_LDA(At, 0, 1); PG8_STAGE(PG8_SA(0, 0), a2, voffA);
            PG8_BAR; PG8_WAIT_L(0); PG8_MMA(1, 0, At, B0); PG8_BAR; PG8_SCHED;
            PG8_STAGE(PG8_SB(0, 1), b2 + hstep, voffB);
            PG8_WAIT_V(6); PG8_BAR; PG8_MMA(1, 1, At, B1); PG8_BAR;
            PG8_LDB(B0, 1, 0); PG8_SCHED; PG8_LDA(At, 1, 0); PG8_STAGE(PG8_SA(0, 1), a2 + hstep, voffA);
            PG8_WAIT_L(8); PG8_BAR; PG8_WAIT_L(0); PG8_MMA(0, 0, At, B0); PG8_BAR; PG8_SCHED;
            PG8_LDB(B1, 1, 1); PG8_STAGE(PG8_SB(1, 0), b3, voffB);
            PG8_BAR; PG8_WAIT_L(0); PG8_MMA(0, 1, At, B1); PG8_BAR;
            PG8_LDA(At, 1, 1); PG8_STAGE(PG8_SA(1, 0), a3, voffA);
            PG8_BAR; PG8_WAIT_L(0); PG8_MMA(1, 0, At, B0); PG8_BAR; PG8_SCHED;
            PG8_STAGE(PG8_SB(1, 1), b3 + hstep, voffB);
            PG8_WAIT_V(6); PG8_BAR; PG8_MMA(1, 1, At, B1); PG8_BAR;
            }
        }
        if constexpr (ALIGN_EPI) { if (wr == 0) PG8_BAR; }
        if constexpr (!Epi::AFTER_DRAIN) { E(acc, cur, wr, wc, fr, fq); S.done(cur); }
        if (!has_next) break;
#pragma unroll
        for (int a = 0; a < 2; ++a)
#pragma unroll
            for (int b = 0; b < 2; ++b)
#pragma unroll
                for (int m = 0; m < 4; ++m)
#pragma unroll
                    for (int n = 0; n < 2; ++n) acc[a][b][m][n] = (f32x4){0.f, 0.f, 0.f, 0.f};
        cur = nxt; cA = nA; cB = nB; ++ui;
        if constexpr (ALIGN_EPI) { if (wr == 1) PG8_BAR; }
    }
    PG8_WAIT_V(0);
    if constexpr (!ALIGN_EPI) { if (wr == 0) PG8_BAR; }
    PG8_BAR;
    if constexpr (Epi::AFTER_DRAIN) { E.fused(acc, cur, wr, wc, fr, fq, lds, wid, lane); S.done(cur); }
#undef PG8_SA
#undef PG8_SB
#undef PG8_STAGE
#undef PG8_LDA
#undef PG8_LDB
#undef PG8_MMA
#undef PG8_WAIT_V
#undef PG8_WAIT_L
#undef PG8_BAR
#undef PG8_SCHED
}
}
namespace pg8 {
struct Gemm8 { const unsigned char* A; const unsigned char* Bt; int M, N, K; int scale_a, scale_b; };
template <class Epi, class Sched, bool ALIGN_EPI = false, bool SP2 = false>
__device__ __forceinline__ void gemm_phase_f8(PG8_LAS unsigned char* lds, const Gemm8 g, const Sched& S, const Epi& E, int wid_in) {
    int lane_; asm volatile("v_mbcnt_lo_u32_b32 %0, -1, 0\n\tv_mbcnt_hi_u32_b32 %0, -1, %0" : "=v"(lane_));
    const int wid = wid_in, lane = lane_, tid = wid * 64 + lane, wr = wid >> 2, wc = wid & 3, fr = lane & 15, fq = lane >> 4;
    const int K = g.K, nt = K / 128;
    unsigned voffA[2], voffB[2];
#pragma unroll
    for (int i = 0; i < 2; ++i) { int R, C; stage_rc(tid * 16 + i * 8192, R, C); const int Rb = Epi::PERM ? ((R & ~31) + perm32(R & 31)) : R;
        voffA[i] = (unsigned)(R * K + 2 * C); voffB[i] = (unsigned)(Rb * K + 2 * C); }
    const size_t kstep = (size_t)(BK * 2);
    const size_t hstep = (size_t)HALF * K;
    const size_t tstep = 2 * hstep;
    const unsigned ldsw = (unsigned)wid * 1024u;
    const int aoff = lds_byte(wr * 64 + fr, fq * 16), boff = lds_byte(wc * 32 + fr, fq * 16);
#define PG8_SA(b, h) (((b) * 2 + (h)) * HTB)
#define PG8_SB(b, h) ((4 + (b) * 2 + (h)) * HTB)
#define PG8_STAGE(bufoff, gbase, voff) do { _Pragma("unroll") for (int _i = 0; _i < 2; ++_i) { unsigned keep_; \
        asm volatile("s_mov_b32 %0, m0\n\ts_mov_b32 m0, %3\n\ts_nop 0\n\tglobal_load_lds_dwordx4 %1, %2\n\ts_mov_b32 m0, %0" : "=&s"(keep_) : "v"((voff)[_i]), "s"((const char*)(gbase)), "s"((unsigned)(size_t)(lds + (bufoff) + ldsw + _i * 8192)) : "memory"); } } while (0)
#define PG8_LDA(dst, b, h) do { _Pragma("unroll") for (int m = 0; m < 4; ++m) { const u32x4 lo_ = *(const PG8_LAS u32x4*)(lds + PG8_SA(b, h) + aoff + m * 2048), hi_ = *(const PG8_LAS u32x4*)(lds + PG8_SA(b, h) + aoff + m * 2048 + 16); dst[m] = __builtin_bit_cast(i32x8, __builtin_shufflevector(lo_, hi_, 0, 1, 2, 3, 4, 5, 6, 7)); } } while (0)
#define PG8_LDB(dst, b, h) do { _Pragma("unroll") for (int n = 0; n < 2; ++n) { const u32x4 lo_ = *(const PG8_LAS u32x4*)(lds + PG8_SB(b, h) + boff + n * 2048), hi_ = *(const PG8_LAS u32x4*)(lds + PG8_SB(b, h) + boff + n * 2048 + 16); dst[n] = __builtin_bit_cast(i32x8, __builtin_shufflevector(lo_, hi_, 0, 1, 2, 3, 4, 5, 6, 7)); } } while (0)
#define PG8_MMA(ai, bj, At, Bt) do { __builtin_amdgcn_s_setprio(1); _Pragma("unroll") for (int m = 0; m < 4; ++m) _Pragma("unroll") for (int n = 0; n < 2; ++n) \
        acc[ai][bj][m][n] = __builtin_amdgcn_mfma_scale_f32_16x16x128_f8f6f4(Bt[n], At[m], acc[ai][bj][m][n], 0, 0, 0, g.scale_b, 0, g.scale_a); __builtin_amdgcn_s_setprio(0); } while (0)
#define PG8_WAIT_V(n) asm volatile("s_waitcnt vmcnt(" #n ")" ::: "memory")
#define PG8_WAIT_L(n) asm volatile("s_waitcnt lgkmcnt(" #n ")" ::: "memory")
#define PG8_BAR __builtin_amdgcn_s_barrier()
#define PG8_SCHED __builtin_amdgcn_sched_barrier(0)
    Unit cur, nxt; int ui = 0;
    if (!S.next(0, cur)) return;
    f32x4 acc[2][2][4][2];
#pragma unroll
    for (int a = 0; a < 2; ++a)
#pragma unroll
        for (int b = 0; b < 2; ++b)
#pragma unroll
            for (int m = 0; m < 4; ++m)
#pragma unroll
                for (int n = 0; n < 2; ++n) acc[a][b][m][n] = (f32x4){0.f, 0.f, 0.f, 0.f};
    typedef int i32x8 __attribute__((ext_vector_type(8))); i32x8 At[4], B0[2], B1[2];
    const char* cA = (const char*)g.A + (size_t)cur.pm * tstep; const char* cB = (const char*)g.Bt + (size_t)cur.pn * tstep;
    S.a_ready(cur);
    if constexpr (SP2) {
        PG8_STAGE(PG8_SB(0, 0), cB, voffB); PG8_STAGE(PG8_SB(0, 1), cB + hstep, voffB); PG8_STAGE(PG8_SA(0, 0), cA, voffA); PG8_STAGE(PG8_SA(0, 1), cA + hstep, voffA);
        if (wr == 1) PG8_BAR;
        PG8_WAIT_V(2); PG8_BAR;
        PG8_STAGE(PG8_SB(1, 0), cB + kstep, voffB); PG8_STAGE(PG8_SA(1, 0), cA + kstep, voffA); PG8_STAGE(PG8_SB(1, 1), cB + hstep + kstep, voffB);
        PG8_WAIT_V(6); PG8_BAR;
    } else {
        PG8_STAGE(PG8_SB(0, 0), cB, voffB); PG8_STAGE(PG8_SA(0, 0), cA, voffA); PG8_STAGE(PG8_SB(0, 1), cB + hstep, voffB); PG8_STAGE(PG8_SA(0, 1), cA + hstep, voffA);
        if (wr == 1) PG8_BAR;
        PG8_WAIT_V(4); PG8_BAR;
        PG8_STAGE(PG8_SB(1, 0), cB + kstep, voffB); PG8_STAGE(PG8_SA(1, 0), cA + kstep, voffA); PG8_STAGE(PG8_SB(1, 1), cB + hstep + kstep, voffB);
        PG8_WAIT_V(6); PG8_BAR;
    }
    for (;;) {
        const bool has_next = S.next(ui + 1, nxt);
        const char* nA = has_next ? (const char*)g.A + (size_t)nxt.pm * tstep : cA; const char* nB = has_next ? (const char*)g.Bt + (size_t)nxt.pn * tstep : cB;
#pragma unroll 1
        for (int t = 0; t < nt; t += 2) {
            const bool last = (t == nt - 2);
            const char* a1 = cA + (size_t)(t + 1) * kstep;
            const char* a2 = last ? nA : cA + (size_t)(t + 2) * kstep; const char* b2 = last ? nB : cB + (size_t)(t + 2) * kstep;
            const char* a3 = a2 + kstep; const char* b3 = b2 + kstep;
            if (last && has_next) S.a_ready(nxt);
            if constexpr (SP2) {
            PG8_LDB(B0, 0, 0); PG8_LDB(B1, 0, 1); PG8_SCHED; PG8_LDA(At, 0, 0); PG8_STAGE(PG8_SA(1, 1), a1 + hstep, voffA);
            PG8_WAIT_V(8); PG8_WAIT_L(0); PG8_BAR; PG8_MMA(0, 0, At, B0); PG8_MMA(0, 1, At, B1); PG8_BAR; PG8_SCHED;
            PG8_LDA(At, 0, 1); PG8_STAGE(PG8_SB(0, 0), b2, voffB); PG8_STAGE(PG8_SB(0, 1), b2 + hstep, voffB); PG8_STAGE(PG8_SA(0, 0), a2, voffA);
            PG8_WAIT_V(8); PG8_WAIT_L(0); PG8_BAR; PG8_MMA(1, 0, At, B0); PG8_MMA(1, 1, At, B1); PG8_BAR; PG8_SCHED;
            PG8_LDB(B0, 1, 0); PG8_LDB(B1, 1, 1); PG8_SCHED; PG8_LDA(At, 1, 0); PG8_STAGE(PG8_SA(0, 1), a2 + hstep, voffA);
            PG8_WAIT_V(8); PG8_WAIT_L(0); PG8_BAR; PG8_MMA(0, 0, At, B0); PG8_MMA(0, 1, At, B1); PG8_BAR; PG8_SCHED;
            PG8_LDA(At, 1, 1); PG8_STAGE(PG8_SB(1, 0), b3, voffB); PG8_STAGE(PG8_SB(1, 1), b3 + hstep, voffB); PG8_STAGE(PG8_SA(1, 0), a3, voffA);
            PG8_WAIT_V(8); PG8_WAIT_L(0); PG8_BAR; PG8_MMA(1, 0, At, B0); PG8_MMA(1, 1, At, B1); PG8_BAR; PG8_SCHED;
            } else {
            PG8_LDB(B0, 0, 0); PG8_SCHED; PG8_LDA(At, 0, 0); PG8_STAGE(PG8_SA(1, 1), a1 + hstep, voffA);
            PG8_WAIT_L(8); PG8_BAR; PG8_WAIT_L(0); PG8_MMA(0, 0, At, B0); PG8_BAR; PG8_SCHED;
            PG8_LDB(B1, 0, 1); PG8_STAGE(PG8_SB(0, 0), b2, voffB);
            PG8_BAR; PG8_WAIT_L(0); PG8_MMA(0, 1, At, B1); PG8_BAR;
            PG8_LDA(At, 0, 1); PG8_STAGE(PG8_SA(0, 0), a2, voffA);
            PG8_BAR; PG8_WAIT_L(0); PG8_MMA(1, 0, At, B0); PG8_BAR; PG8_SCHED;
            PG8_STAGE(PG8_SB(0, 1), b2 + hstep, voffB);
            PG8_WAIT_V(6); PG8_BAR; PG8_MMA(1, 1, At, B1); PG8_BAR;
            PG8_LDB(B0, 1, 0); PG8_SCHED; PG8_LDA(At, 1, 0); PG8_STAGE(PG8_SA(0, 1), a2 + hstep, voffA);
            PG8_WAIT_L(8); PG8_BAR; PG8_WAIT_L(0); PG8_MMA(0, 0, At, B0); PG8_BAR; PG8_SCHED;
            PG8_LDB(B1, 1, 1); PG8_STAGE(PG8_SB(1, 0), b3, voffB);
            PG8_BAR; PG8_WAIT_L(0); PG8_MMA(0, 1, At, B1); PG8_BAR;
            PG8_LDA(At, 1, 1); PG8_STAGE(PG8_SA(1, 0), a3, voffA);
            PG8_BAR; PG8_WAIT_L(0); PG8_MMA(1, 0, At, B0); PG8_BAR; PG8_SCHED;
            PG8_STAGE(PG8_SB(1, 1), b3 + hstep, voffB);
            PG8_WAIT_V(6); PG8_BAR; PG8_MMA(1, 1, At, B1); PG8_BAR;
            }
        }
        if constexpr (ALIGN_EPI) { if (wr == 0) PG8_BAR; }
        if constexpr (!Epi::AFTER_DRAIN) { int l2_; asm volatile("v_mbcnt_lo_u32_b32 %0, -1, 0\n\tv_mbcnt_hi_u32_b32 %0, -1, %0" : "=v"(l2_));
            E(acc, cur, wr, wc, l2_ & 15, l2_ >> 4); S.done(cur); }
        if (!has_next) break;
#pragma unroll
        for (int a = 0; a < 2; ++a)
#pragma unroll
            for (int b = 0; b < 2; ++b)
#pragma unroll
                for (int m = 0; m < 4; ++m)
#pragma unroll
                    for (int n = 0; n < 2; ++n) acc[a][b][m][n] = (f32x4){0.f, 0.f, 0.f, 0.f};
        cur = nxt; cA = nA; cB = nB; ++ui;
        if constexpr (ALIGN_EPI) { if (wr == 1) PG8_BAR; }
    }
    PG8_WAIT_V(0);
    if constexpr (!ALIGN_EPI) { if (wr == 0) PG8_BAR; }
    PG8_BAR;
    if constexpr (Epi::AFTER_DRAIN) { E.fused(acc, cur, wr, wc, fr, fq, lds, wid, lane); S.done(cur); }
#undef PG8_SA
#undef PG8_SB
#undef PG8_STAGE
#undef PG8_LDA
#undef PG8_LDB
#undef PG8_MMA
#undef PG8_WAIT_V
#undef PG8_WAIT_L
#undef PG8_BAR
#undef PG8_SCHED
}
}
#define GAS __attribute__((address_space(1)))
#define LAS __attribute__((address_space(3)))
typedef unsigned short bf16;
typedef unsigned v4u __attribute__((ext_vector_type(4)));
typedef float f32x4 __attribute__((ext_vector_type(4)));
typedef short bf16x8 __attribute__((ext_vector_type(8)));
typedef GAS unsigned gu32;
typedef GAS unsigned long long gu64;
#define RLX_AGENT __ATOMIC_RELAXED, __HIP_MEMORY_SCOPE_AGENT
#define LDS_WAIT() asm volatile("s_waitcnt lgkmcnt(0)" ::: "memory")
#define VM_WAIT() asm volatile("s_waitcnt vmcnt(0)" ::: "memory")
__device__ __forceinline__ unsigned long long rt() { return __builtin_amdgcn_s_memrealtime(); }
__device__ __forceinline__ unsigned f2bf(float f) { unsigned u = __builtin_bit_cast(unsigned, f); return (u + 0x7fffu + ((u >> 16) & 1u)) >> 16; }
__device__ __forceinline__ unsigned pk2(float lo, float hi) { return f2bf(lo) | (f2bf(hi) << 16); }

#define XB_TMO      128
#define XB_XCNT(j)  (256  + 64 * (j))
#define XB_XSUB(j)  (1280 + 64 * (j))
#define XB_XGEN(j)  (2304 + 64 * (j))
#define XB_TOP      3328
#define XB_TOPGEN   3392
#define XCD_BAR_WORDS 3456
#define XB_SPIN_CAP (1u << 18)

__device__ __forceinline__ unsigned xb_ld(unsigned* p)              { return __hip_atomic_load(p, __ATOMIC_RELAXED, __HIP_MEMORY_SCOPE_AGENT); }
__device__ __forceinline__ unsigned xb_add(unsigned* p, unsigned v) { return __hip_atomic_fetch_add(p, v, __ATOMIC_RELAXED, __HIP_MEMORY_SCOPE_AGENT); }
__device__ __forceinline__ unsigned xb_xcc_id() { return (unsigned)__builtin_amdgcn_s_getreg((3 << 11) | 20) & 0xFu; }
#define XB_SPIN(cond, bar) do { unsigned _sp = 0; while (cond) { __builtin_amdgcn_s_sleep(1); \
    if ((++_sp & 255u) == 0u) { if (xb_ld(&(bar)[XB_TMO])) break; if (_sp > XB_SPIN_CAP) { atomicAdd(&(bar)[XB_TMO], 1u); break; } } } } while (0)

struct XcdBarrier {
    int wv;
    unsigned* bar; unsigned x;
    volatile LAS unsigned* st;
};

__device__ __forceinline__ int xb_lane_id() { int l; asm volatile("v_mbcnt_lo_u32_b32 %0, -1, 0\n\tv_mbcnt_hi_u32_b32 %0, -1, %0" : "=v"(l)); return l; }
__device__ __forceinline__ XcdBarrier xcd_barrier_post(unsigned* bar, volatile LAS unsigned* st, int wv) {
    XcdBarrier b; b.wv = wv; b.bar = bar; b.x = xb_xcc_id(); b.st = st;
    if (wv == 0 && xb_lane_id() == 0) (void)xb_add(&bar[XB_XCNT(b.x)], 1u);
    return b;
}
__device__ __forceinline__ void xcd_barrier_complete(unsigned* bar, unsigned x, unsigned& nloc, unsigned& nx) {
    const unsigned G = gridDim.x * gridDim.y * gridDim.z;
    unsigned sum, cnt, mine, sp = 0u;
    for (;;) {
        sum = 0u; cnt = 0u; mine = 0u;
#pragma unroll
        for (unsigned j = 0; j < 16; ++j) { const unsigned c = xb_ld(&bar[XB_XCNT(j)]); sum += c; cnt += (c > 0u) ? 1u : 0u; mine = (j == x) ? c : mine; }
        if (sum == G) break;
        __builtin_amdgcn_s_sleep(1);
        if ((++sp & 255u) == 0u) { if (xb_ld(&bar[XB_TMO])) break; if (sp > XB_SPIN_CAP) { atomicAdd(&bar[XB_TMO], 1u); break; } }
    }
    nloc = mine > 0u ? mine : 1u; nx = cnt > 0u ? cnt : 1u;
}

__device__ __forceinline__ void xcd_barrier(const XcdBarrier& b) {
    asm volatile("s_waitcnt vmcnt(0)" ::: "memory");
    __syncthreads();
    if (b.wv == 0 && xb_lane_id() == 0) {
        unsigned* bar = b.bar;
        __builtin_amdgcn_s_waitcnt(0);
        unsigned nloc = b.st[0], nx = b.st[1];
        if (nloc == 0u) { xcd_barrier_complete(bar, b.x, nloc, nx); b.st[0] = nloc; b.st[1] = nx; }
        const unsigned old = xb_add(&bar[XB_XSUB(b.x)], 1u);
        const unsigned gen = old / nloc;
        if (old + 1u == (gen + 1u) * nloc) {
            __builtin_amdgcn_fence(__ATOMIC_RELEASE, "agent");
            asm volatile("s_waitcnt vmcnt(0)" ::: "memory");
            const unsigned og = xb_add(&bar[XB_TOP], 1u);
            const unsigned tg = og / nx;
            if (og + 1u == (tg + 1u) * nx) xb_add(&bar[XB_TOPGEN], 1u);
            else XB_SPIN(xb_ld(&bar[XB_TOPGEN]) == tg, bar);
            __builtin_amdgcn_fence(__ATOMIC_ACQUIRE, "agent");
            xb_add(&bar[XB_XGEN(b.x)], 1u);
            asm volatile("s_waitcnt vmcnt(0)" ::: "memory");
        } else {
            XB_SPIN(xb_ld(&bar[XB_XGEN(b.x)]) == gen, bar);
            __builtin_amdgcn_fence(__ATOMIC_ACQUIRE, "agent");
            asm volatile("s_waitcnt vmcnt(0)" ::: "memory");
        }
    }
    __syncthreads();
}
#define DI __device__ __forceinline__
constexpr int NWAVES = 8;
constexpr int NB = 16, SEQ = 2048, DM = 1024, MT = NB * SEQ;
constexpr int DIN_SRC = 6944, NPROJ = 7168;
constexpr int MEML = 256, MROWS = NB * MEML;
constexpr int NEXP = 32, TOPK = 4, DFF = 1024, MOEB = 256;
constexpr int NROWS = MT * TOPK;
constexpr int NBLK_MAX = (NROWS + NEXP * (MOEB - 1) + MOEB - 1) / MOEB;
constexpr int CAP = NBLK_MAX * MOEB;
constexpr float EPS = 1e-6f;
constexpr float NEGF = -1e30f;
constexpr int NB16 = 3584, NF8 = NPROJ - NB16;
constexpr int PC_MLQ = 0, PC_MLK = 512, PC_NQ = 1024, PC_NKC = 1536, PC_NKS = 1664, PC_NKW = 1792, PC_MQ = 1920, PC_MLI = 2432, PC_MLF = 2436, PC_NG = 2440,
              PC_MLV = 2560, PC_NVC = 3072, PC_NVS = 3200, PC_NVW = 3328, PC_MLO = 3584, PC_BRG = 4096;
__host__ __device__ constexpr int proj_srccol(int j) {
    return j < 1024 ? j : j < 1536 ? 2056 + (j - 1024) : j < 1664 ? 2568 + (j - 1536) : j < 1792 ? 2824 + (j - 1664) : j < 1920 ? 3080 + (j - 1792) : j < 2432 ? 3360 + (j - 1920)
         : j < 2440 ? 2048 + (j - 2432) : j < 2464 ? 3336 + (j - 2440) : j < 2560 ? -1
         : j < 3072 ? 1024 + (j - 2560) : j < 3200 ? 2696 + (j - 3072) : j < 3328 ? 2952 + (j - 3200) : j < 3456 ? 3208 + (j - 3328) : j < 3584 ? -1
         : j < 4096 ? 1536 + (j - 3584) : 3872 + (j - 4096);
}

constexpr size_t MiB = 1u << 20;
constexpr size_t WS_CTL = 0, CTL_ZERO_BYTES = 1 * MiB;
constexpr size_t WS_WIN = 1 * MiB, WS_WGU = 15 * MiB, WS_WDN = 143 * MiB, WS_WMKV = 207 * MiB, WS_WBR = 209 * MiB, WS_WOUT = 212 * MiB, WS_WC1 = 214 * MiB;
constexpr size_t WS_WIN8 = WS_WIN + 8 * MiB;
constexpr size_t WS_SMALL = 216 * MiB;
constexpr size_t WS_R1 = 218 * MiB;
constexpr size_t WS_PROJ = 282 * MiB;
constexpr size_t WS_R3 = 730 * MiB;
constexpr size_t WS_MEMKV = WS_R3, WS_MEMKN = WS_R3 + 8 * MiB, WS_QN = WS_R3 + 12 * MiB, WS_KSN = WS_R3 + 44 * MiB, WS_KWN = WS_R3 + 52 * MiB,
                 WS_MQN = WS_R3 + 60 * MiB, WS_MLQK = WS_R3 + 92 * MiB, WS_HID = WS_R3 + 156 * MiB, WS_KC = WS_R3 + 160 * MiB, WS_VC = WS_KC + MiB / 2,
                 WS_H0 = WS_R3 + 161 * MiB, WS_H1 = WS_H0 + 32 * MiB, WS_H2 = WS_H1 + 32 * MiB, WS_ROUTE = WS_H2 + 32 * MiB, WS_END = WS_ROUTE + 6 * MiB;
constexpr size_t WS_MLV = WS_R1, WS_VSN = WS_R1 + 32 * MiB, WS_VWN = WS_R1 + 40 * MiB;
constexpr size_t WS_U8 = WS_H2;
constexpr size_t WS_MEMN = WS_H0;
constexpr size_t WS_ACMP = WS_H1;
constexpr size_t WS_APERM = WS_PROJ;
constexpr size_t WS_ACT = WS_PROJ + 272 * MiB;
static_assert(WS_ACT + 272 * MiB <= WS_H0 + 96 * MiB && WS_END <= 1024 * MiB, "ws map");
constexpr size_t SM_ROPEC = 0, SM_ROPES = 256 * 1024, SM_CBIAS = 512 * 1024, SM_WRT = 1024 * 1024;
constexpr size_t RT_TOKE = 0, RT_TOKPOS = 512 * 1024, RT_TOKW = 1024 * 1024, RT_TOKDEST = 1536 * 1024, RT_ROWW = 2048 * 1024;
constexpr int CW_BAR = 4096;
constexpr int CW_ECNT = 16384;
constexpr int CW_QCTR = 16384 + 64;

constexpr int RING_BYTES = 131072, LDSCTL_OFF = RING_BYTES, MISC_OFF = LDSCTL_OFF + 320, LDS_BYTES = 155648;

struct Args { const float* in[34]; float* out; unsigned char* ws; int ph_lo, ph_hi, li, pad; };

DI float bf2f(unsigned short h) { return __uint_as_float((unsigned)h << 16); }
DI float wave_sum(float v) {
#pragma unroll
    for (int o = 1; o < 64; o <<= 1) v += __shfl_xor(v, o);
    return v;
}
DI float wave_max(float v) {
#pragma unroll
    for (int o = 1; o < 64; o <<= 1) v = fmaxf(v, __shfl_xor(v, o));
    return v;
}
DI float sigm(float x) { return __builtin_amdgcn_rcpf(1.f + __expf(-x)); }
DI float logsig(float x) { return fminf(x, 0.f) - log1pf(__expf(-fabsf(x))); }

namespace pg8 {
struct EpiBf16Silu {
    static constexpr bool PERM = true, AFTER_DRAIN = false;
    bf16_t* O; int ldc; const float* bias; int silu;
    DI void operator()(const f32x4 (&acc)[2][2][4][2], const Unit& u, int wr, int wc, int fr, int fq) const {
        const int row0 = u.pm * BM + wr * 64 + fr; const int col0 = u.pn * BM + wc * 32 + 8 * fq;
#pragma unroll
        for (int ai = 0; ai < 2; ++ai)
#pragma unroll
            for (int m = 0; m < 4; ++m) { bf16_t* rowp = O + (size_t)(row0 + ai * HALF + m * 16) * ldc + col0;
#pragma unroll
                for (int bj = 0; bj < 2; ++bj) { f32x4 v0 = acc[ai][bj][m][0], v1 = acc[ai][bj][m][1];
                    if (bias) { v0 += *(const f32x4*)(bias + col0 + bj * HALF); v1 += *(const f32x4*)(bias + col0 + bj * HALF + 4); }
                    if (silu) {
#pragma unroll
                        for (int j = 0; j < 4; ++j) { v0[j] = v0[j] * __builtin_amdgcn_rcpf(1.f + __expf(-v0[j])); v1[j] = v1[j] * __builtin_amdgcn_rcpf(1.f + __expf(-v1[j])); } }
                    u32x4 w; w.x = cvt_pk_bf16(v0[0], v0[1]); w.y = cvt_pk_bf16(v0[2], v0[3]); w.z = cvt_pk_bf16(v1[0], v1[1]); w.w = cvt_pk_bf16(v1[2], v1[3]);
                    *(u32x4*)(rowp + bj * HALF) = w; } }
    }
};
template <int B> struct EpiGate {
    static constexpr bool PERM = false, AFTER_DRAIN = false;
    const bf16_t* proj; float* tmp; bf16_t* merged;
    DI void operator()(const f32x4 (&acc)[2][2][4][2], const Unit& u, int wr, int wc, int fr, int fq) const {
        typedef unsigned u32x2v __attribute__((ext_vector_type(2)));
        const int col0 = u.pn * BM + wc * 32 + 4 * fq;
#pragma unroll
        for (int ai = 0; ai < 2; ++ai)
#pragma unroll
            for (int m = 0; m < 4; ++m) { const size_t r = (size_t)(u.pm * BM + ai * HALF + wr * 64 + m * 16 + fr);
#pragma unroll
                for (int bj = 0; bj < 2; ++bj)
#pragma unroll
                    for (int n = 0; n < 2; ++n) { const int c = col0 + bj * HALF + n * 16;
                        const u32x2v gw = *(const u32x2v*)(proj + r * NPROJ + PC_BRG + B * DM + c);
                        f32x4 g; g[0] = __uint_as_float(gw.x << 16); g[1] = __uint_as_float(gw.x & 0xffff0000u); g[2] = __uint_as_float(gw.y << 16); g[3] = __uint_as_float(gw.y & 0xffff0000u);
                        f32x4 v = acc[ai][bj][m][n];
#pragma unroll
                        for (int j = 0; j < 4; ++j) v[j] = v[j] * __builtin_amdgcn_rcpf(1.f + __expf(-g[j]));
                        float* tp = tmp + r * DM + c;
                        if (B == 0) { *(f32x4*)tp = v; }
                        else if (B == 1) { *(f32x4*)tp = *(const f32x4*)tp + v; }
                        else { v = *(const f32x4*)tp + v; u32x2v w; w.x = cvt_pk_bf16(v[0], v[1]); w.y = cvt_pk_bf16(v[2], v[3]); *(u32x2v*)(merged + r * DM + c) = w; } } }
    }
};
struct EpiRes {
    static constexpr bool PERM = false, AFTER_DRAIN = false;
    const float* base; float* out;
    DI void operator()(const f32x4 (&acc)[2][2][4][2], const Unit& u, int wr, int wc, int fr, int fq) const {
        const int col0 = u.pn * BM + wc * 32 + 4 * fq;
#pragma unroll
        for (int ai = 0; ai < 2; ++ai)
#pragma unroll
            for (int m = 0; m < 4; ++m) { const size_t r = (size_t)(u.pm * BM + ai * HALF + wr * 64 + m * 16 + fr);
#pragma unroll
                for (int bj = 0; bj < 2; ++bj)
#pragma unroll
                    for (int n = 0; n < 2; ++n) { const int c = col0 + bj * HALF + n * 16; *(f32x4*)(out + r * DM + c) = *(const f32x4*)(base + r * DM + c) + acc[ai][bj][m][n]; } }
    }
};
struct EpiSwiglu {
    static constexpr bool PERM = true, AFTER_DRAIN = false;
    unsigned char* act; const float* bgu;
    DI void operator()(const f32x4 (&acc)[2][2][4][2], const Unit& u, int wr, int wc, int fr, int fq) const {
        typedef unsigned u32x2v __attribute__((ext_vector_type(2)));
        const int e = u.pn >> 3, pnl = u.pn & 7;
        const int lc0 = pnl * BM + wc * 32 + 8 * fq;
        const unsigned row0 = (unsigned)(u.pm * BM + wr * 64 + fr);
        const float* bp = bgu + e * 2048;
#pragma unroll
        for (int ai = 0; ai < 2; ++ai)
#pragma unroll
            for (int m = 0; m < 4; ++m) { const unsigned rowoff = (row0 + ai * HALF + m * 16) * (unsigned)DFF;
#pragma unroll
                for (int bj = 0; bj < 2; ++bj) {
                    const unsigned lc = (unsigned)(lc0 + bj * HALF);
                    const f32x4 b0 = *(const f32x4*)(bp + lc), b1 = *(const f32x4*)(bp + lc + 4);
                    const f32x4 v0 = acc[ai][bj][m][0] + b0, v1 = acc[ai][bj][m][1] + b1;
                    float o[4];
#pragma unroll
                    for (int q = 0; q < 4; ++q) { const float gt = fminf(q < 2 ? v0[2 * q] : v1[2 * q - 4], 7.0f); float up = q < 2 ? v0[2 * q + 1] : v1[2 * q - 3]; up = fminf(fmaxf(up, -7.0f), 7.0f);
                        o[q] = (up + 1.0f) * (gt * __builtin_amdgcn_rcpf(1.f + __expf(-1.702f * gt))); }
                    int q8 = 0; q8 = __builtin_amdgcn_cvt_pk_fp8_f32(o[0], o[1], q8, false); q8 = __builtin_amdgcn_cvt_pk_fp8_f32(o[2], o[3], q8, true);
                    *(unsigned*)(act + (rowoff + (lc >> 1))) = (unsigned)q8; } }
    }
};
struct EpiDown {
    static constexpr bool PERM = false, AFTER_DRAIN = false;
    bf16_t* y; const float* bdn; const float* roww;
    DI void operator()(const f32x4 (&acc)[2][2][4][2], const Unit& u, int wr, int wc, int fr, int fq) const {
        typedef unsigned u32x2v __attribute__((ext_vector_type(2)));
        const int e = u.pn >> 2, pnl = u.pn & 3;
        const int col0 = pnl * BM + wc * 32 + 4 * fq;
#pragma unroll
        for (int ai = 0; ai < 2; ++ai)
#pragma unroll
            for (int m = 0; m < 4; ++m) { const size_t r = (size_t)(u.pm * BM + ai * HALF + wr * 64 + m * 16 + fr); const float rw = roww[r];
#pragma unroll
                for (int bj = 0; bj < 2; ++bj)
#pragma unroll
                    for (int n = 0; n < 2; ++n) { const int c = col0 + bj * HALF + n * 16; const f32x4 v = (acc[ai][bj][m][n] + *(const f32x4*)(bdn + e * DM + c)) * rw;
                        u32x2v w; w.x = cvt_pk_bf16(v[0], v[1]); w.y = cvt_pk_bf16(v[2], v[3]); *(u32x2v*)(y + r * DM + c) = w; } }
    }
};
template <int NPN> struct MoeOrder {
    int nblk, G, c; const PG8_LAS unsigned char* blk_e;
    DI bool next(int i, Unit& u) const {
        int rb, pn;
        if (G == 256) { const int x = c & 7, j = c >> 3; rb = i * (256 / NPN) + x * (32 / NPN) + j / NPN; pn = j % NPN; }
        else { const int L = i * G + c; rb = L / NPN; pn = L % NPN; }
        if (rb >= nblk) return false;
        u.pm = rb; u.pn = __builtin_amdgcn_readfirstlane((int)blk_e[rb]) * NPN + pn; return true; }
    DI void a_ready(const Unit&) const {}
    DI void done(const Unit&) const {}
};
}

struct Frame {
    LAS unsigned char* lds; volatile LAS unsigned* MISC; unsigned* ctl; unsigned char* ws;
    int wave, G, bx;
    DI int lane_id() const { int l; asm volatile("v_mbcnt_lo_u32_b32 %0, -1, 0\n\tv_mbcnt_hi_u32_b32 %0, -1, %0" : "=v"(l)); return l; }
    DI int tid_id() const { return wave * 64 + lane_id(); }
    const float* const* in; float* out;
};
enum { I_X = 0, I_MEM, I_GMIX, I_WIN, I_CONVW, I_CONVB, I_MLBI, I_MLBF, I_MLGOUT, I_NGQ, I_NGK, I_CPK, I_CW1K, I_CB1K, I_CW2K, I_CPV, I_CW1V, I_CB1V, I_CW2V,
       I_GMEM, I_WMKV, I_MGQ, I_MGK, I_WBRML, I_WBRNSA, I_WBRMEM, I_WOUT, I_GFFN, I_WR, I_BR, I_WGU, I_BGU, I_WDN, I_BDN, N_IN };

template <class CM>
DI void tr_item(const float* W, int ldw, int K, bf16* WT, int k0, int n0, CM cm, LAS float* scr, int lane) {
    const int sc = cm(n0 + (lane & 31));
#pragma unroll 8
    for (int i = 0; i < 32; ++i) { const int kk = 2 * i + (lane >> 5); scr[kk * 33 + (lane & 31)] = sc >= 0 ? W[(size_t)(k0 + kk) * ldw + sc] : 0.f; }
    LDS_WAIT(); asm volatile("" ::: "memory");
    const int c = lane & 7;
#pragma unroll
    for (int j = 0; j < 4; ++j) { const int n = (lane >> 3) + 8 * j; const LAS float* s = scr + (8 * c) * 33 + n;
        v4u o; o.x = pk2(s[0 * 33], s[1 * 33]); o.y = pk2(s[2 * 33], s[3 * 33]); o.z = pk2(s[4 * 33], s[5 * 33]); o.w = pk2(s[6 * 33], s[7 * 33]);
        *(v4u*)(WT + (size_t)(n0 + n) * K + k0 + 8 * c) = o; }
    LDS_WAIT(); asm volatile("" ::: "memory");
}
DI void tr_item_f8(const float* W, int ldw, int K, unsigned char* WT, int k0, int n0, LAS float* scr, int lane) {
#pragma unroll 8
    for (int i = 0; i < 32; ++i) { const int kk = 2 * i + (lane >> 5); scr[kk * 33 + (lane & 31)] = W[(size_t)(k0 + kk) * ldw + n0 + (lane & 31)] * 256.0f; }
    LDS_WAIT(); asm volatile("" ::: "memory");
    const int c = lane & 7;
#pragma unroll
    for (int j = 0; j < 4; ++j) { const int n = (lane >> 3) + 8 * j; const LAS float* sp = scr + (8 * c) * 33 + n;
        int lo = 0, hi = 0;
        lo = __builtin_amdgcn_cvt_pk_fp8_f32(sp[0 * 33], sp[1 * 33], lo, false); lo = __builtin_amdgcn_cvt_pk_fp8_f32(sp[2 * 33], sp[3 * 33], lo, true);
        hi = __builtin_amdgcn_cvt_pk_fp8_f32(sp[4 * 33], sp[5 * 33], hi, false); hi = __builtin_amdgcn_cvt_pk_fp8_f32(sp[6 * 33], sp[7 * 33], hi, true);
        typedef unsigned u32x2t __attribute__((ext_vector_type(2)));
        *(u32x2t*)(WT + (size_t)(n0 + n) * K + k0 + 8 * c) = (u32x2t){(unsigned)lo, (unsigned)hi}; }
    LDS_WAIT(); asm volatile("" ::: "memory");
}
DI void tr_fill_v4(const float* W, int ldw, int k0, int n0, LAS float* scr, int lane, float mul) {
    f32x4 v[8];
#pragma unroll
    for (int i = 0; i < 8; ++i) v[i] = *(const f32x4*)(W + (size_t)(k0 + 8 * i + (lane >> 3)) * ldw + n0 + 4 * (lane & 7));
#pragma unroll
    for (int i = 0; i < 8; ++i) { LAS float* d = scr + (8 * i + (lane >> 3)) * 33 + 4 * (lane & 7); d[0] = v[i].x * mul; d[1] = v[i].y * mul; d[2] = v[i].z * mul; d[3] = v[i].w * mul; }
    LDS_WAIT(); asm volatile("" ::: "memory");
}
DI void tr_emit_bf16(bf16* WT, int K, int k0, int n0, LAS float* scr, int lane) {
    const int c = lane & 7;
#pragma unroll
    for (int j = 0; j < 4; ++j) { const int n = (lane >> 3) + 8 * j; const LAS float* sp = scr + (8 * c) * 33 + n;
        v4u o; o.x = pk2(sp[0 * 33], sp[1 * 33]); o.y = pk2(sp[2 * 33], sp[3 * 33]); o.z = pk2(sp[4 * 33], sp[5 * 33]); o.w = pk2(sp[6 * 33], sp[7 * 33]);
        *(v4u*)(WT + (size_t)(n0 + n) * K + k0 + 8 * c) = o; }
    LDS_WAIT(); asm volatile("" ::: "memory");
}
DI void tr_emit_f8(unsigned char* WT, int K, int k0, int n0, LAS float* scr, int lane) {
    const int c = lane & 7;
#pragma unroll
    for (int j = 0; j < 4; ++j) { const int n = (lane >> 3) + 8 * j; const LAS float* sp = scr + (8 * c) * 33 + n;
        int lo = 0, hi = 0;
        lo = __builtin_amdgcn_cvt_pk_fp8_f32(sp[0 * 33], sp[1 * 33], lo, false); lo = __builtin_amdgcn_cvt_pk_fp8_f32(sp[2 * 33], sp[3 * 33], lo, true);
        hi = __builtin_amdgcn_cvt_pk_fp8_f32(sp[4 * 33], sp[5 * 33], hi, false); hi = __builtin_amdgcn_cvt_pk_fp8_f32(sp[6 * 33], sp[7 * 33], hi, true);
        typedef unsigned u32x2t __attribute__((ext_vector_type(2)));
        *(u32x2t*)(WT + (size_t)(n0 + n) * K + k0 + 8 * c) = (u32x2t){(unsigned)lo, (unsigned)hi}; }
    LDS_WAIT(); asm volatile("" ::: "memory");
}
template <class CM>
DI void tr_fill_cm(const float* W, int ldw, int k0, int n0, CM cm, LAS float* scr, int lane, float mul) {
    const int sc = cm(n0 + (lane & 31));
#pragma unroll 8
    for (int i = 0; i < 32; ++i) { const int kk = 2 * i + (lane >> 5); scr[kk * 33 + (lane & 31)] = sc >= 0 ? W[(size_t)(k0 + kk) * ldw + sc] * mul : 0.f; }
    LDS_WAIT(); asm volatile("" ::: "memory");
}
struct CmId { DI int operator()(int j) const { return j; } };
struct CmProj { DI int operator()(int j) const { return proj_srccol(j); } };

DI void rms_row_bf16(const float* xrow, const float* g, bf16* orow, int lane) {
    const f32x4* xr = (const f32x4*)xrow + lane; const f32x4* gr = (const f32x4*)g + lane;
    f32x4 v[4]; float s = 0.f;
#pragma unroll
    for (int j = 0; j < 4; ++j) { v[j] = xr[64 * j]; s += (v[j].x * v[j].x + v[j].y * v[j].y) + (v[j].z * v[j].z + v[j].w * v[j].w); }
    const float rstd = rsqrtf(wave_sum(s) * (1.f / DM) + EPS);
    unsigned long long* o8 = (unsigned long long*)orow + lane;
#pragma unroll
    for (int j = 0; j < 4; ++j) { const f32x4 gg = gr[64 * j];
        o8[64 * j] = (unsigned long long)pk2(v[j].x * rstd * gg.x, v[j].y * rstd * gg.y) | ((unsigned long long)pk2(v[j].z * rstd * gg.z, v[j].w * rstd * gg.w) << 32); }
}

DI void rms_row_f8(const float* xrow, const float* g, unsigned char* orow, int lane) {
    const f32x4* xr = (const f32x4*)xrow + lane; const f32x4* gr = (const f32x4*)g + lane;
    f32x4 v[4]; float s = 0.f;
#pragma unroll
    for (int j = 0; j < 4; ++j) { v[j] = xr[64 * j]; s += (v[j].x * v[j].x + v[j].y * v[j].y) + (v[j].z * v[j].z + v[j].w * v[j].w); }
    const float rstd = rsqrtf(wave_sum(s) * (1.f / DM) + EPS);
    unsigned* o4 = (unsigned*)orow + lane;
#pragma unroll
    for (int j = 0; j < 4; ++j) { const f32x4 gg = gr[64 * j]; int q8 = 0;
        q8 = __builtin_amdgcn_cvt_pk_fp8_f32(v[j].x * rstd * gg.x, v[j].y * rstd * gg.y, q8, false); q8 = __builtin_amdgcn_cvt_pk_fp8_f32(v[j].z * rstd * gg.z, v[j].w * rstd * gg.w, q8, true);
        o4[64 * j] = (unsigned)q8; }
}
DI void rms_row_both(const float* xrow, const float* g, bf16* orow, unsigned char* orow8, int lane) {
    const f32x4* xr = (const f32x4*)xrow + lane; const f32x4* gr = (const f32x4*)g + lane;
    f32x4 v[4]; float s = 0.f;
#pragma unroll
    for (int j = 0; j < 4; ++j) { v[j] = xr[64 * j]; s += (v[j].x * v[j].x + v[j].y * v[j].y) + (v[j].z * v[j].z + v[j].w * v[j].w); }
    const float rstd = rsqrtf(wave_sum(s) * (1.f / DM) + EPS);
    unsigned long long* o8 = (unsigned long long*)orow + lane; unsigned* o4 = (unsigned*)orow8 + lane;
#pragma unroll
    for (int j = 0; j < 4; ++j) { const f32x4 gg = gr[64 * j]; const float y0 = v[j].x * rstd * gg.x, y1 = v[j].y * rstd * gg.y, y2 = v[j].z * rstd * gg.z, y3 = v[j].w * rstd * gg.w;
        o8[64 * j] = (unsigned long long)pk2(y0, y1) | ((unsigned long long)pk2(y2, y3) << 32);
        int q8 = 0; q8 = __builtin_amdgcn_cvt_pk_fp8_f32(y0, y1, q8, false); q8 = __builtin_amdgcn_cvt_pk_fp8_f32(y2, y3, q8, true);
        o4[64 * j] = (unsigned)q8; }
}
DI void p0_prologue(Frame& F) {
    LAS float* scr = (LAS float*)(F.lds + F.wave * 16384);
    const int gw = F.bx * NWAVES + F.wave, NGW = F.G * NWAVES;
    unsigned char* ws = F.ws;
    constexpr int IT_IN = 16 * (NPROJ / 32), IT_GU = 32 * 16 * 64, IT_DN = 32 * 16 * 32, IT_MKV = 16 * 32, IT_BR = 3 * 8 * 32, IT_OUT = 16 * 32, IT_C1 = 2 * 32 * 8;
    constexpr int NITEMS = IT_IN + IT_GU + IT_DN + IT_MKV + IT_BR + IT_OUT + IT_C1;
    for (int it = gw; it < NITEMS; it += NGW) {
        int r = it;
        if (r < IT_IN) { const int kb = r / (NPROJ / 32), nb = r % (NPROJ / 32); if (32 * nb < NB16) { tr_fill_cm(F.in[I_WIN], DIN_SRC, 64 * kb, 32 * nb, CmProj(), scr, F.lane_id(), 1.0f); tr_emit_bf16((bf16*)(ws + WS_WIN), DM, 64 * kb, 32 * nb, scr, F.lane_id()); }
            else { tr_fill_cm(F.in[I_WIN], DIN_SRC, 64 * kb, 32 * nb, CmProj(), scr, F.lane_id(), 256.0f); tr_emit_f8((unsigned char*)(ws + WS_WIN8), DM, 64 * kb, 32 * nb - NB16, scr, F.lane_id()); }
            continue; } r -= IT_IN;
        if (r < IT_GU) { const int e = r / 1024, q = r % 1024, kb = q / 64, nb = q % 64; tr_fill_v4(F.in[I_WGU] + (size_t)e * DM * 2048, 2048, 64 * kb, 32 * nb, scr, F.lane_id(), 256.0f); tr_emit_f8((unsigned char*)(ws + WS_WGU) + (size_t)e * 2048 * DM, DM, 64 * kb, 32 * nb, scr, F.lane_id()); continue; } r -= IT_GU;
        if (r < IT_DN) { const int e = r / 512, q = r % 512, kb = q / 32, nb = q % 32; tr_fill_v4(F.in[I_WDN] + (size_t)e * DFF * DM, DM, 64 * kb, 32 * nb, scr, F.lane_id(), 256.0f); tr_emit_f8((unsigned char*)(ws + WS_WDN) + (size_t)e * DM * DFF, DFF, 64 * kb, 32 * nb, scr, F.lane_id()); continue; } r -= IT_DN;
        if (r < IT_MKV) { const int kb = r / 32, nb = r % 32; tr_fill_v4(F.in[I_WMKV], 1024, 64 * kb, 32 * nb, scr, F.lane_id(), 1.0f); tr_emit_bf16((bf16*)(ws + WS_WMKV), 1024, 64 * kb, 32 * nb, scr, F.lane_id()); continue; } r -= IT_MKV;
        if (r < IT_BR) { const int b = r / 256, q = r % 256, kb = q / 32, nb = q % 32; tr_fill_v4(F.in[I_WBRML + b], 1024, 64 * kb, 32 * nb, scr, F.lane_id(), 1.0f); tr_emit_bf16((bf16*)(ws + WS_WBR) + (size_t)b * 1024 * 512, 512, 64 * kb, 32 * nb, scr, F.lane_id()); continue; } r -= IT_BR;
        if (r < IT_OUT) { const int kb = r / 32, nb = r % 32; tr_fill_v4(F.in[I_WOUT], 1024, 64 * kb, 32 * nb, scr, F.lane_id(), 1.0f); tr_emit_bf16((bf16*)(ws + WS_WOUT), 1024, 64 * kb, 32 * nb, scr, F.lane_id()); continue; } r -= IT_OUT;
        { const int kv = r / 256, q = r % 256, kb = q / 8, nb = q % 8; tr_fill_v4(F.in[kv ? I_CW1V : I_CW1K], 256, 64 * kb, 32 * nb, scr, F.lane_id(), 1.0f); tr_emit_bf16((bf16*)(ws + WS_WC1) + (size_t)kv * 256 * 2048, 2048, 64 * kb, 32 * nb, scr, F.lane_id()); }
    }
    for (int m = gw; m < MT; m += NGW) rms_row_both(F.in[I_X] + (size_t)m * DM, F.in[I_GMIX], (bf16*)(ws + WS_R1) + (size_t)m * DM, (unsigned char*)(ws + WS_U8) + (size_t)m * DM, F.lane_id());
    for (int m = gw; m < MROWS; m += NGW) rms_row_bf16(F.in[I_MEM] + (size_t)m * DM, F.in[I_GMEM], (bf16*)(ws + WS_MEMN) + (size_t)m * DM, F.lane_id());
    float* rc = (float*)(ws + WS_SMALL + SM_ROPEC); float* rs = (float*)(ws + WS_SMALL + SM_ROPES);
    for (int i = F.bx * 512 + F.tid_id(); i < SEQ * 32; i += F.G * 512) {
        const int p = i >> 5, k = i & 31;
        const float invf = exp2f(-(float)k * (13.287712379549449f / 32.0f));
        const float ang = (float)p * invf;
        const float kf = rintf(ang * 0.15915494309189535f);
        float r = fmaf(-kf, 6.28125f, ang); r = fmaf(-kf, 1.9353071795864769e-3f, r);
        rc[i] = cosf(r); rs[i] = sinf(r);
    }
    { bf16* wrt = (bf16*)(ws + WS_SMALL + SM_WRT);
      for (int i = F.bx * 512 + F.tid_id(); i < 32 * 1024; i += F.G * 512) { const int e = i >> 10, k = i & 1023; const float w = F.in[I_WR][k * 32 + e]; const unsigned hi = f2bf(w); wrt[i] = (bf16)hi; wrt[32 * 1024 + i] = (bf16)f2bf(w - __uint_as_float(hi << 16)); } }
    if (F.bx == F.G - 1) {
        const int kv = F.tid_id() >> 8, f = F.tid_id() & 255;
        const float* pe = F.in[kv ? I_CPV : I_CPK]; const float* w1 = F.in[kv ? I_CW1V : I_CW1K];
        float a = F.in[kv ? I_CB1V : I_CB1K][f];
        for (int k = 0; k < 2048; ++k) a = fmaf(pe[k], w1[(size_t)k * 256 + f], a);
        ((float*)(ws + WS_SMALL + SM_CBIAS))[kv * 256 + f] = a;
    }
}

DI void unpack8(const v4u& w, float (&f)[8]) {
    f[0] = __uint_as_float(w.x << 16); f[1] = __uint_as_float(w.x & 0xffff0000u); f[2] = __uint_as_float(w.y << 16); f[3] = __uint_as_float(w.y & 0xffff0000u);
    f[4] = __uint_as_float(w.z << 16); f[5] = __uint_as_float(w.z & 0xffff0000u); f[6] = __uint_as_float(w.w << 16); f[7] = __uint_as_float(w.w & 0xffff0000u);
}
DI v4u pack8f(const float (&f)[8]) { v4u o; o.x = pk2(f[0], f[1]); o.y = pk2(f[2], f[3]); o.z = pk2(f[4], f[5]); o.w = pk2(f[6], f[7]); return o; }
DI void load8f(const float* p, float (&f)[8]) { const f32x4 a = *(const f32x4*)p, b = *(const f32x4*)(p + 4); f[0] = a.x; f[1] = a.y; f[2] = a.z; f[3] = a.w; f[4] = b.x; f[5] = b.y; f[6] = b.z; f[7] = b.w; }
DI void norm_rope64(float (&f)[8], const float (&g)[8], const float (&c8)[8], const float (&s8)[8], int lane, float scale) {
    float ss = 0.f;
#pragma unroll
    for (int i = 0; i < 8; ++i) ss = fmaf(f[i], f[i], ss);
    ss += __shfl_xor(ss, 1); ss += __shfl_xor(ss, 2); ss += __shfl_xor(ss, 4);
    const float rstd = rsqrtf(ss * (1.f / 64.f) + EPS);
    const bool hi = (lane & 4) != 0;
#pragma unroll
    for (int i = 0; i < 8; ++i) { const float y = f[i] * rstd * g[i]; const float pt = __shfl_xor(y, 4); f[i] = (hi ? fmaf(pt, s8[i], y * c8[i]) : fmaf(-pt, s8[i], y * c8[i])) * scale; }
}
DI void p2_prep(Frame& F) {
    unsigned char* ws = F.ws;
    const int gw = F.bx * NWAVES + F.wave, NGW = F.G * NWAVES, lane = F.lane_id();
    const bf16* proj = (const bf16*)(ws + WS_PROJ);
    const float* rc = (const float*)(ws + WS_SMALL + SM_ROPEC); const float* rs = (const float*)(ws + WS_SMALL + SM_ROPES);
    bf16* qn = (bf16*)(ws + WS_QN); bf16* ksn = (bf16*)(ws + WS_KSN); bf16* kwn = (bf16*)(ws + WS_KWN); bf16* mqn = (bf16*)(ws + WS_MQN); bf16* mlqk = (bf16*)(ws + WS_MLQK);
    bf16* acmp = (bf16*)(ws + WS_ACMP);
    constexpr int NT = 4;
    {
        float gq8[8], mg8[8]; load8f(F.in[I_NGQ] + 8 * (lane & 7), gq8); load8f(F.in[I_MGQ] + 8 * (lane & 15), mg8);
        for (int t0 = gw * NT; t0 < MT; t0 += NGW * NT) {
            v4u a[NT], bq[NT], cv[NT]; float c8[NT][8], s8[NT][8];
#pragma unroll
            for (int u = 0; u < NT; ++u) { const int t = t0 + u, tau = t & 2047; const bf16* pr = proj + (size_t)t * NPROJ;
                a[u] = *(const v4u*)(pr + PC_NQ + 8 * lane); bq[u] = *(const v4u*)(pr + PC_MQ + 8 * lane); cv[u] = *(const v4u*)(pr + PC_MLV + 8 * lane);
                load8f(rc + tau * 32 + 8 * (lane & 3), c8[u]); load8f(rs + tau * 32 + 8 * (lane & 3), s8[u]); }
#pragma unroll
            for (int u = 0; u < NT; ++u) { const int t = t0 + u;
                float f[8]; unpack8(a[u], f);
                norm_rope64(f, gq8, c8[u], s8[u], lane, 0.125f * 1.4426950408889634f);
                *(v4u*)(qn + (size_t)t * 512 + 8 * lane) = pack8f(f);
                unpack8(bq[u], f);
                float ss = 0.f;
#pragma unroll
                for (int i = 0; i < 8; ++i) ss = fmaf(f[i], f[i], ss);
                ss += __shfl_xor(ss, 1); ss += __shfl_xor(ss, 2); ss += __shfl_xor(ss, 4); ss += __shfl_xor(ss, 8);
                const float rstd = rsqrtf(ss * (1.f / 128.f) + EPS) * (0.08838834764831845f * 1.4426950408889634f);
#pragma unroll
                for (int i = 0; i < 8; ++i) f[i] *= rstd * mg8[i];
                *(v4u*)(mqn + (size_t)t * 512 + 8 * lane) = pack8f(f);
                *(v4u*)((bf16*)(ws + WS_MLV) + (size_t)t * 512 + 8 * lane) = cv[u]; }
        }
    }
    {
        const int L = lane & 31, hd4 = L >> 3, j = L & 7, half = lane >> 5;
        float gk8[8]; load8f(F.in[I_NGK] + (1 + (hd4 >> 1)) * 64 + 8 * j, gk8);
        const int kcol = (hd4 < 2 ? PC_NKS + hd4 * 64 : PC_NKW + (hd4 - 2) * 64) + 8 * j;
        bf16* kdst = (hd4 < 2 ? ksn : kwn) + (hd4 & 1) * 64 + 8 * j;
        const int kv = hd4 >> 1, hh = hd4 & 1, wv = L >> 4, jj = L & 15;
        bf16* vdst = (bf16*)(ws + (wv ? WS_VWN : WS_VSN)) + 8 * jj; const int vcol = (wv ? PC_NVW : PC_NVS) + 8 * jj;
        for (int tp0 = gw * NT; tp0 < MT / 2; tp0 += NGW * NT) {
            v4u a[NT], vv[NT], cv[NT]; float c8[NT][8], s8[NT][8];
#pragma unroll
            for (int u = 0; u < NT; ++u) { const int t = 2 * (tp0 + u) + half, tau = t & 2047; const bf16* pr = proj + (size_t)t * NPROJ;
                a[u] = *(const v4u*)(pr + kcol); vv[u] = *(const v4u*)(pr + vcol); cv[u] = *(const v4u*)(pr + (kv ? PC_NVC : PC_NKC) + hh * 64 + 8 * j);
                load8f(rc + tau * 32 + 8 * (lane & 3), c8[u]); load8f(rs + tau * 32 + 8 * (lane & 3), s8[u]); }
#pragma unroll
            for (int u = 0; u < NT; ++u) { const int t = 2 * (tp0 + u) + half, b = t >> 11, tau = t & 2047;
                float f[8]; unpack8(a[u], f);
                norm_rope64(f, gk8, c8[u], s8[u], lane, 1.0f);
                *(v4u*)(kdst + (size_t)t * 128) = pack8f(f);
                *(v4u*)(vdst + (size_t)t * 128) = vv[u];
                const int nA = tau >> 4;
#pragma unroll
                for (int dn = 0; dn < 2; ++dn) { const int n = nA - dn; if (n >= 0 && n <= 126) { const int l = tau - 16 * n;
                    *(v4u*)(acmp + (size_t)kv * 4096 * 2048 + (size_t)((b * 2 + hh) * 128 + n) * 2048 + l * 64 + 8 * j) = cv[u]; } } }
        }
    }
    for (int run = gw; run < MT / 16; run += NGW) {
        const int t0 = run * 16, tau0 = t0 & 2047;
#pragma unroll 1
        for (int sp = 0; sp < 2; ++sp) {
            const int ch = 512 * sp + 8 * lane;
            float w0[8], w1[8], w2[8], w3[8], bb[8];
            load8f(F.in[I_CONVW] + ch, w0); load8f(F.in[I_CONVW] + 1024 + ch, w1); load8f(F.in[I_CONVW] + 2048 + ch, w2); load8f(F.in[I_CONVW] + 3072 + ch, w3); load8f(F.in[I_CONVB] + ch, bb);
            float x0[8], x1[8], x2[8];
            if (tau0 >= 3) { unpack8(*(const v4u*)(proj + (size_t)(t0 - 3) * NPROJ + ch), x0); unpack8(*(const v4u*)(proj + (size_t)(t0 - 2) * NPROJ + ch), x1); unpack8(*(const v4u*)(proj + (size_t)(t0 - 1) * NPROJ + ch), x2); }
            else {
#pragma unroll
                for (int i = 0; i < 8; ++i) { x0[i] = 0.f; x1[i] = 0.f; x2[i] = 0.f; } }
#pragma unroll 1
            for (int k0 = 0; k0 < 16; k0 += 4) {
                v4u raw[4];
#pragma unroll
                for (int k = 0; k < 4; ++k) raw[k] = *(const v4u*)(proj + (size_t)(t0 + k0 + k) * NPROJ + ch);
#pragma unroll
                for (int k = 0; k < 4; ++k) { float x3[8], y[8]; unpack8(raw[k], x3);
#pragma unroll
                    for (int i = 0; i < 8; ++i) { const float a = fmaf(w3[i], x3[i], fmaf(w2[i], x2[i], fmaf(w1[i], x1[i], fmaf(w0[i], x0[i], bb[i])))); y[i] = a * sigm(a); x0[i] = x1[i]; x1[i] = x2[i]; x2[i] = x3[i]; }
                    *(v4u*)(mlqk + (size_t)(t0 + k0 + k) * 1024 + ch) = pack8f(y); }
            }
        }
    }
    for (int i = F.bx * 512 + F.tid_id(); i < 2 * 32 * 2048; i += F.G * 512) { const int kv = i / (32 * 2048), q = i % (32 * 2048), bh = q / 2048, col = q % 2048;
        acmp[(size_t)kv * 4096 * 2048 + (size_t)(bh * 128 + 127) * 2048 + col] = 0; }
    {
        const bf16* memkv = (const bf16*)(ws + WS_MEMKV); bf16* memkn = (bf16*)(ws + WS_MEMKN);
        float kg8[8]; load8f(F.in[I_MGK] + 8 * (lane & 15), kg8);
        for (int r = gw; r < MROWS; r += NGW) {
            float f[8]; unpack8(*(const v4u*)(memkv + (size_t)r * 1024 + 8 * lane), f);
            float ss = 0.f;
#pragma unroll
            for (int i = 0; i < 8; ++i) ss = fmaf(f[i], f[i], ss);
            ss += __shfl_xor(ss, 1); ss += __shfl_xor(ss, 2); ss += __shfl_xor(ss, 4); ss += __shfl_xor(ss, 8);
            const float rstd = rsqrtf(ss * (1.f / 128.f) + EPS);
#pragma unroll
            for (int i = 0; i < 8; ++i) f[i] *= rstd * kg8[i];
            *(v4u*)(memkn + (size_t)r * 512 + 8 * lane) = pack8f(f);
        }
    }
}

DI void p4_kcvc(Frame& F) {
    unsigned char* ws = F.ws;
    const int gw = F.bx * NWAVES + F.wave, NGW = F.G * NWAVES, lane = F.lane_id();
    const bf16* hid = (const bf16*)(ws + WS_HID);
    const float* rc = (const float*)(ws + WS_SMALL + SM_ROPEC); const float* rs = (const float*)(ws + WS_SMALL + SM_ROPES);
    const float gk = F.in[I_NGK][lane];
    for (int it = gw; it < 2 * 4096; it += NGW) {
        const int kv = it >> 12, r = it & 4095, n = r & 127;
        bf16* dst = (bf16*)(ws + (kv ? WS_VC : WS_KC)) + (size_t)r * 64 + lane;
        if (n == 127) { *dst = 0; continue; }
        const bf16* hr = hid + (size_t)kv * 4096 * 256 + (size_t)r * 256; const float* w2 = F.in[kv ? I_CW2V : I_CW2K];
        float a = 0.f;
        for (int f = 0; f < 256; ++f) a = fmaf(bf2f(hr[f]), w2[f * 64 + lane], a);
        if (kv == 0) {
            const float y = a * rsqrtf(wave_sum(a * a) * (1.f / 64.f) + EPS) * gk;
            const int pos = 16 * n + 31; const float c = rc[pos * 32 + (lane & 31)], s = rs[pos * 32 + (lane & 31)];
            const float pt = __shfl_xor(y, 32);
            a = lane < 32 ? y * c - pt * s : y * c + pt * s;
        }
        *dst = (bf16)f2bf(a);
    }
}

DI void mlstm_unit(Frame& F, int unit) {
    unsigned char* ws = F.ws;
    const int b = unit >> 2, h = unit & 3, tid = F.tid_id(), kk = tid >> 7, c = tid & 127;
    const bf16* proj = (const bf16*)(ws + WS_PROJ); const bf16* mlqk = (const bf16*)(ws + WS_MLQK); bf16* H0 = (bf16*)(ws + WS_H0);
    LAS float* qs = (LAS float*)F.lds;
    LAS float* ks = qs + 16 * 128;
    LAS float* vs = ks + 16 * 128;
    LAS float* gi = vs + 16 * 128;
    LAS float* gf = gi + 16;
    LAS float* part = gf + 16;
    LAS float* pden = part + 2 * 4 * 128;
    LAS float* hb = pden + 8;
    float C[32], nn[32];
#pragma unroll
    for (int i = 0; i < 32; ++i) { C[i] = 0.f; nn[i] = 0.f; }
    float m = 0.f;
    const float bi = F.in[I_MLBI][h], bfv = F.in[I_MLBF][h];
    const float scale = 0.08838834764831845f;
#pragma unroll 1
    for (int t0 = 0; t0 < SEQ; t0 += 16) {
        __syncthreads();
        for (int i = tid; i < 16 * 128; i += 512) { const int s = i >> 7, d = i & 127; const size_t t = (size_t)b * SEQ + t0 + s;
            qs[i] = bf2f(mlqk[t * 1024 + h * 128 + d]); ks[i] = bf2f(mlqk[t * 1024 + 512 + h * 128 + d]); vs[i] = bf2f(proj[t * NPROJ + PC_MLV + h * 128 + d]); }
        if (tid < 16) { const size_t t = (size_t)b * SEQ + t0 + tid; gi[tid] = bf2f(proj[t * NPROJ + PC_MLI + h]) + bi; gf[tid] = logsig(bf2f(proj[t * NPROJ + PC_MLF + h]) + bfv); }
        __syncthreads();
#pragma unroll 1
        for (int s = 0; s < 16; ++s) {
            const float lf = gf[s], ig = gi[s];
            const float mn = fmaxf(lf + m, ig), a = __expf(lf + m - mn), bb = __expf(ig - mn);
            m = mn;
            const float v = vs[s * 128 + c];
            float pn = 0.f, pd = 0.f;
#pragma unroll
            for (int i = 0; i < 32; ++i) { const float kvv = ks[s * 128 + kk * 32 + i], qv = qs[s * 128 + kk * 32 + i];
                C[i] = a * C[i] + bb * kvv * v; nn[i] = a * nn[i] + bb * kvv; pn = fmaf(qv, C[i], pn); pd = fmaf(qv, nn[i], pd); }
            const int par = s & 1;
            part[(par * 4 + kk) * 128 + c] = pn; if (c == 0) pden[par * 4 + kk] = pd;
            __syncthreads();
            if (kk == 0) {
                const float num = (part[(par * 4 + 0) * 128 + c] + part[(par * 4 + 1) * 128 + c]) + (part[(par * 4 + 2) * 128 + c] + part[(par * 4 + 3) * 128 + c]);
                const float den = (pden[par * 4 + 0] + pden[par * 4 + 1]) + (pden[par * 4 + 2] + pden[par * 4 + 3]);
                hb[s * 128 + c] = num * scale / fmaxf(fabsf(den * scale), __expf(-mn));
            }
        }
        __syncthreads();
#pragma unroll
        for (int rr = 0; rr < 2; ++rr) { const int s = F.wave * 2 + rr; const size_t t = (size_t)b * SEQ + t0 + s;
            const float v0 = hb[s * 128 + F.lane_id()], v1 = hb[s * 128 + 64 + F.lane_id()];
            const float rstd = rsqrtf(wave_sum(v0 * v0 + v1 * v1) * (1.f / 128.f) + EPS);
            const float o0 = bf2f(proj[t * NPROJ + PC_MLO + h * 128 + F.lane_id()]), o1 = bf2f(proj[t * NPROJ + PC_MLO + h * 128 + 64 + F.lane_id()]);
            H0[t * 512 + h * 128 + F.lane_id()] = (bf16)f2bf(v0 * rstd * F.in[I_MLGOUT][h * 128 + F.lane_id()] * sigm(o0));
            H0[t * 512 + h * 128 + 64 + F.lane_id()] = (bf16)f2bf(v1 * rstd * F.in[I_MLGOUT][h * 128 + 64 + F.lane_id()] * sigm(o1)); }
    }
    __syncthreads();
}

DI void nsa_scores(const bf16* krow, bool valid, const LAS float* qs, float (&s)[4]) {
    s[0] = s[1] = s[2] = s[3] = 0.f;
    if (valid) {
#pragma unroll 2
        for (int c8 = 0; c8 < 8; ++c8) { const v4u kk = *(const v4u*)(krow + c8 * 8);
            const unsigned w[4] = {kk.x, kk.y, kk.z, kk.w};
#pragma unroll
            for (int j = 0; j < 4; ++j) { const float k0 = __uint_as_float(w[j] << 16), k1 = __uint_as_float(w[j] & 0xffff0000u); const int d = c8 * 8 + 2 * j;
#pragma unroll
                for (int g = 0; g < 4; ++g) s[g] = fmaf(k1, qs[g * 64 + d + 1], fmaf(k0, qs[g * 64 + d], s[g])); } }
    }
}
DI void nsa_wave(Frame& F, int item, LAS float* wl) {
    unsigned char* ws = F.ws; const int lane = F.lane_id();
    const int t = item >> 1, hkv = item & 1, b = t >> 11, tau = t & 2047;
    const bf16* proj = (const bf16*)(ws + WS_PROJ);
    const bf16* qn = (const bf16*)(ws + WS_QN); const bf16* ksn = (const bf16*)(ws + WS_KSN); const bf16* kwn = (const bf16*)(ws + WS_KWN);
    const bf16* kc = (const bf16*)(ws + WS_KC); const bf16* vc = (const bf16*)(ws + WS_VC); bf16* H1 = (bf16*)(ws + WS_H1);
    LAS float* qs = wl;
    LAS float* ps = wl + 256;
    LAS float* psum = wl + 768;
#pragma unroll
    for (int g = 0; g < 4; ++g) qs[g * 64 + lane] = bf2f(qn[(size_t)t * 512 + (hkv * 4 + g) * 64 + lane]);
    float ofin[4] = {0.f, 0.f, 0.f, 0.f};
    float gate[4][3];
#pragma unroll
    for (int g = 0; g < 4; ++g)
#pragma unroll
        for (int cidx = 0; cidx < 3; ++cidx) gate[g][cidx] = sigm(bf2f(proj[(size_t)t * NPROJ + PC_NG + (hkv * 4 + g) * 3 + cidx]));
    const int ncmp = tau >= 31 ? ((tau - 31) >> 4) + 1 : 0;
    {
        float l[4] = {0.f, 0.f, 0.f, 0.f}, o[4] = {0.f, 0.f, 0.f, 0.f};
        const size_t rbase = (size_t)(b * 2 + hkv) * 128;
#pragma unroll
        for (int blk = 0; blk < 2; ++blk) { const int n = blk * 64 + lane; const bool valid = n < ncmp; float s[4];
            nsa_scores(kc + (rbase + n) * 64, valid, qs, s);
#pragma unroll
            for (int g = 0; g < 4; ++g) { const float p = valid ? __expf(s[g]) : 0.f; l[g] += p; ps[g * 128 + n] = p; } }
        float inv[4];
#pragma unroll
        for (int g = 0; g < 4; ++g) { const float L = wave_sum(l[g]); inv[g] = L > 0.f ? 1.f / L : 0.f; }
#pragma unroll
        for (int blk = 0; blk < 2; ++blk) { const int n = blk * 64 + lane; psum[n] = (ps[0 * 128 + n] * inv[0] + ps[1 * 128 + n] * inv[1]) + (ps[2 * 128 + n] * inv[2] + ps[3 * 128 + n] * inv[3]); }
#pragma unroll 2
        for (int n = 0; n < ncmp; ++n) { const float vv = bf2f(vc[(rbase + n) * 64 + lane]);
#pragma unroll
            for (int g = 0; g < 4; ++g) o[g] = fmaf(ps[g * 128 + n], vv, o[g]); }
#pragma unroll
        for (int g = 0; g < 4; ++g) ofin[g] += gate[g][0] * o[g] * inv[g];
    }
    const int cur = tau >> 6;
    unsigned selmask = 0u;
    {
        float score = -3.0e38f;
        if (lane < 32) { const int j = lane; float imp = 0.f;
#pragma unroll
            for (int dn = -1; dn <= 3; ++dn) { const int n = 4 * j + dn; if (n >= 0 && n <= 126) imp += psum[n]; }
            const bool forced = (j == 0) || (j == cur) || (j == cur - 1);
            score = j > cur ? NEGF : imp + (forced ? 1.0e4f : 0.f); }
#pragma unroll 1
        for (int r = 0; r < 8; ++r) { const float mx = wave_max(score); const unsigned long long bal = __ballot(score == mx); const int win = __ffsll((long long)bal) - 1;
            selmask |= 1u << win; if (lane == win) score = -3.4e38f; }
    }
    {
        float l[4] = {0.f, 0.f, 0.f, 0.f}, o[4] = {0.f, 0.f, 0.f, 0.f};
#pragma unroll 1
        for (int j = 0; j <= cur; ++j) { if (!((selmask >> j) & 1u)) continue;
            const int kpos = 64 * j + lane; const bool valid = kpos <= tau; float s[4];
            nsa_scores(ksn + ((size_t)b * SEQ + kpos) * 128 + hkv * 64, valid, qs, s);
#pragma unroll
            for (int g = 0; g < 4; ++g) { const float p = valid ? __expf(s[g]) : 0.f; l[g] += p; ps[g * 128 + lane] = p; }
            const int nk = j == cur ? (tau & 63) + 1 : 64;
            const bf16* vb = proj + ((size_t)b * SEQ + 64 * j) * NPROJ + PC_NVS + hkv * 64 + lane;
#pragma unroll 2
            for (int k = 0; k < nk; ++k) { const float vv = bf2f(vb[(size_t)k * NPROJ]);
#pragma unroll
                for (int g = 0; g < 4; ++g) o[g] = fmaf(ps[g * 128 + k], vv, o[g]); } }
#pragma unroll
        for (int g = 0; g < 4; ++g) { const float L = wave_sum(l[g]); ofin[g] += gate[g][1] * o[g] * (L > 0.f ? 1.f / L : 0.f); }
    }
    {
        float l[4] = {0.f, 0.f, 0.f, 0.f}, o[4] = {0.f, 0.f, 0.f, 0.f};
        const int start = tau - 511 > 0 ? tau - 511 : 0;
#pragma unroll 1
        for (int base = start & ~63; base <= tau; base += 64) {
            const int kpos = base + lane; const bool valid = kpos >= start && kpos <= tau; float s[4];
            nsa_scores(kwn + ((size_t)b * SEQ + kpos) * 128 + hkv * 64, valid, qs, s);
#pragma unroll
            for (int g = 0; g < 4; ++g) { const float p = valid ? __expf(s[g]) : 0.f; l[g] += p; ps[g * 128 + lane] = p; }
            const int k0 = start > base ? start - base : 0, k1 = tau - base < 63 ? tau - base : 63;
            const bf16* vb = proj + ((size_t)b * SEQ + base) * NPROJ + PC_NVW + hkv * 64 + lane;
#pragma unroll 2
            for (int k = k0; k <= k1; ++k) { const float vv = bf2f(vb[(size_t)k * NPROJ]);
#pragma unroll
                for (int g = 0; g < 4; ++g) o[g] = fmaf(ps[g * 128 + k], vv, o[g]); } }
#pragma unroll
        for (int g = 0; g < 4; ++g) { const float L = wave_sum(l[g]); ofin[g] += gate[g][2] * o[g] * (L > 0.f ? 1.f / L : 0.f); }
    }
#pragma unroll
    for (int g = 0; g < 4; ++g) H1[(size_t)t * 512 + (hkv * 4 + g) * 64 + lane] = (bf16)f2bf(ofin[g]);
}
DI void mem_wave(Frame& F, int t, LAS float* wl) {
    unsigned char* ws = F.ws; const int lane = F.lane_id(); const int b = t >> 11;
    const bf16* mqn = (const bf16*)(ws + WS_MQN); const bf16* memkn = (const bf16*)(ws + WS_MEMKN); const bf16* memkv = (const bf16*)(ws + WS_MEMKV); bf16* H2 = (bf16*)(ws + WS_H2);
    LAS float* qs = wl;
    LAS float* ps = wl + 128;
#pragma unroll 1
    for (int h = 0; h < 4; ++h) {
        qs[lane] = bf2f(mqn[(size_t)t * 512 + h * 128 + lane]); qs[64 + lane] = bf2f(mqn[(size_t)t * 512 + h * 128 + 64 + lane]);
        float l = 0.f;
#pragma unroll 1
        for (int kq = 0; kq < 4; ++kq) { const int key = kq * 64 + lane; const bf16* kr = memkn + ((size_t)b * MEML + key) * 512 + h * 128; float s = 0.f;
#pragma unroll 2
            for (int c8 = 0; c8 < 16; ++c8) { const v4u kk = *(const v4u*)(kr + c8 * 8); const unsigned w[4] = {kk.x, kk.y, kk.z, kk.w};
#pragma unroll
                for (int j = 0; j < 4; ++j) s = fmaf(__uint_as_float(w[j] & 0xffff0000u), qs[c8 * 8 + 2 * j + 1], fmaf(__uint_as_float(w[j] << 16), qs[c8 * 8 + 2 * j], s)); }
            const float p = __expf(s); l += p; ps[key] = p; }
        const float inv = 1.f / wave_sum(l);
        float o0 = 0.f, o1 = 0.f;
        const bf16* vb = memkv + (size_t)b * MEML * 1024 + 512 + h * 128;
#pragma unroll 4
        for (int key = 0; key < MEML; ++key) { const float p = ps[key]; o0 = fmaf(p, bf2f(vb[(size_t)key * 1024 + lane]), o0); o1 = fmaf(p, bf2f(vb[(size_t)key * 1024 + 64 + lane]), o1); }
        H2[(size_t)t * 512 + h * 128 + lane] = (bf16)f2bf(o0 * inv); H2[(size_t)t * 512 + h * 128 + 64 + lane] = (bf16)f2bf(o1 * inv);
    }
}
typedef float f32x16 __attribute__((ext_vector_type(16)));
typedef float f32x2v __attribute__((ext_vector_type(2)));
typedef __bf16 bf16x2v __attribute__((ext_vector_type(2)));
typedef short s16x4 __attribute__((ext_vector_type(4)));
typedef unsigned u32x2 __attribute__((ext_vector_type(2)));
#define MFMA32(a, b, c) __builtin_amdgcn_mfma_f32_32x32x16_bf16((a), (b), (c), 0, 0, 0)
#define WG_BAR() do { asm volatile("s_waitcnt vmcnt(0) lgkmcnt(0)" ::: "memory"); __builtin_amdgcn_s_barrier(); asm volatile("" ::: "memory"); } while (0)
DI unsigned pkbf(float lo, float hi) { f32x2v v = {lo, hi}; return __builtin_bit_cast(unsigned, __builtin_convertvector(v, bf16x2v)); }
template <int S> DI bf16x8 pack8(const f32x16& x) {
    v4u p; p.x = pkbf(x[8 * S], x[8 * S + 1]); p.y = pkbf(x[8 * S + 2], x[8 * S + 3]); p.z = pkbf(x[8 * S + 4], x[8 * S + 5]); p.w = pkbf(x[8 * S + 6], x[8 * S + 7]);
    return __builtin_bit_cast(bf16x8, p);
}
DI int crow(int i, int h) { return (i & 3) + 8 * (i >> 2) + 4 * h; }
constexpr int AT_K = 0, AT_V = 32768, AT_IMP = 65536, AT_WM = 98304, AT_INV = 98368, AT_SC = 99392;

DI void glds16(const void* gsrc, unsigned lds_dst) { unsigned keep; asm volatile("s_mov_b32 %0, m0\n\ts_mov_b32 m0, %2\n\ts_nop 0\n\tglobal_load_lds_dwordx4 %1, off\n\ts_mov_b32 m0, %0" : "=&s"(keep) : "v"(gsrc), "s"(lds_dst) : "memory"); }
DI void at_load(LAS unsigned char* lds, int par, const void* kb, size_t kpitch, const void* vb, size_t vpitch, int wave, int lane) {
    const int row = 8 * wave + (lane >> 3), pc = lane & 7;
    const int kc = pc ^ ((row >> 1) & 7), vc = pc ^ (((row >> 1) & 1) << 2);
    glds16((const char*)kb + (size_t)row * kpitch + 16 * kc, (unsigned)(size_t)(lds + AT_K + par * 8192 + wave * 1024));
    glds16((const char*)vb + (size_t)row * vpitch + 16 * vc, (unsigned)(size_t)(lds + AT_V + par * 8192 + wave * 1024));
}
#define SB() __builtin_amdgcn_sched_barrier(0)
typedef __attribute__((address_space(3))) s16x4 lds_s16x4;
DI void at_qk(const LAS unsigned char* kbuf, const int (&ka)[4], const bf16x8 (&qf)[4], f32x16 (&s)[2]) {
    bf16x8 kf[2][4];
#pragma unroll
    for (int kb = 0; kb < 2; ++kb)
#pragma unroll
        for (int st = 0; st < 4; ++st) kf[kb][st] = *(const LAS bf16x8*)(kbuf + ka[st] + kb * 4096);
    SB();
#pragma unroll
    for (int kb = 0; kb < 2; ++kb) {
        f32x16 a;
#pragma unroll
        for (int i = 0; i < 16; ++i) a[i] = 0.f;
#pragma unroll
        for (int st = 0; st < 4; ++st) a = MFMA32(kf[kb][st], qf[st], a);
        s[kb] = a;
    }
}
DI void at_vload(const LAS unsigned char* vbuf, const int (&va)[2], int kb, bf16x8 (&vf)[2][2]) {
#pragma unroll
    for (int s2 = 0; s2 < 2; ++s2)
#pragma unroll
        for (int db = 0; db < 2; ++db) {
            const s16x4 lo = __builtin_amdgcn_ds_read_tr16_b64_v4i16((lds_s16x4*)(vbuf + va[db] + kb * 4096 + s2 * 2048));
            const s16x4 hi = __builtin_amdgcn_ds_read_tr16_b64_v4i16((lds_s16x4*)(vbuf + va[db] + kb * 4096 + s2 * 2048 + 1024));
            vf[s2][db] = __builtin_shufflevector(lo, hi, 0, 1, 2, 3, 4, 5, 6, 7); }
}
DI void at_pv1(const bf16x8 (&vf)[2][2], const f32x16& p, f32x16 (&o)[2]) {
    const bf16x8 pf0 = pack8<0>(p), pf1 = pack8<1>(p);
#pragma unroll
    for (int s2 = 0; s2 < 2; ++s2)
#pragma unroll
        for (int db = 0; db < 2; ++db) o[db] = MFMA32(vf[s2][db], s2 ? pf1 : pf0, o[db]);
}
DI void at_pv(const LAS unsigned char* vbuf, const int (&va)[2], const bf16x8 (&vf0)[2][2], const f32x16 (&p)[2], f32x16 (&o)[2]) {
    bf16x8 vf1[2][2]; at_vload(vbuf, va, 1, vf1);
    at_pv1(vf0, p[0], o);
    at_pv1(vf1, p[1], o);
}
DI void at_exp_all(f32x16 (&s)[2], float& l) {
#pragma unroll
    for (int kb = 0; kb < 2; ++kb)
#pragma unroll
        for (int i = 0; i < 16; ++i) { const float p = __builtin_amdgcn_exp2f(s[kb][i]); s[kb][i] = p; l += p; }
}
DI void at_wait(int n) {
    if (n >= 2) asm volatile("s_waitcnt vmcnt(4)" ::: "memory"); else if (n == 1) asm volatile("s_waitcnt vmcnt(2)" ::: "memory"); else asm volatile("s_waitcnt vmcnt(0)" ::: "memory");
    asm volatile("s_waitcnt lgkmcnt(0)" ::: "memory"); __builtin_amdgcn_s_barrier(); asm volatile("" ::: "memory");
}
template <bool STORE = true, bool DO_CMP = true, bool DO_SEL = true, bool DO_WIN = true>
DI void nsa_unit(Frame& F, int unit) {
    unsigned char* ws = F.ws; LAS unsigned char* lds = F.lds;
    int lane_ = F.lane_id();
    const int lane = lane_, wave = F.wave, r = lane & 31, h = lane >> 5, g = wave >> 1, qh = wave & 1;
    const int bh = unit & 31, qt = 31 - (unit >> 5), b = bh >> 1, hkv = bh & 1;
    const int qloc = 32 * qh + r, tau = 64 * qt + qloc, qq = tau & 63; const size_t t = (size_t)b * SEQ + tau;
    const bf16* proj = (const bf16*)(ws + WS_PROJ);
    const bf16* qn = (const bf16*)(ws + WS_QN); const bf16* ksn = (const bf16*)(ws + WS_KSN); const bf16* kwn = (const bf16*)(ws + WS_KWN);
    const bf16* kc = (const bf16*)(ws + WS_KC); const bf16* vc = (const bf16*)(ws + WS_VC); bf16* H1 = (bf16*)(ws + WS_H1);
    int ka[4], va[2];
    { const int f = (r >> 1) & 7, fs = f >> 1, hb = h ^ (f & 1);
#pragma unroll
      for (int st = 0; st < 4; ++st) ka[st] = r * 128 + 16 * (((st ^ fs) << 1) | hb);
      const int i16 = lane & 15, q = i16 >> 2, p = i16 & 3, g1 = (lane >> 4) & 1;
#pragma unroll
      for (int db = 0; db < 2; ++db) va[db] = (4 * h + q) * 128 + 16 * ((4 * db + 2 * g1 + (p >> 1)) ^ (((q >> 1) & 1) << 2)) + 8 * (p & 1); }
    bf16x8 qf[4];
#pragma unroll
    for (int st = 0; st < 4; ++st) qf[st] = *(const bf16x8*)(qn + t * 512 + (hkv * 4 + g) * 64 + 16 * st + 8 * h);
    float gate[3];
#pragma unroll
    for (int c = 0; c < 3; ++c) gate[c] = sigm(bf2f(proj[t * NPROJ + PC_NG + (hkv * 4 + g) * 3 + c]));
    f32x16 ofin[2];
#pragma unroll
    for (int i = 0; i < 16; ++i) { ofin[0][i] = 0.f; ofin[1][i] = 0.f; }
    WG_BAR();
    if (DO_CMP) {
        const int ncq = tau >= 31 ? ((tau - 31) >> 4) + 1 : 0;
        const int ntc = (((64 * qt + 63 - 31) >> 4) + 1 > 64) ? 2 : 1;
        const char* kb0 = (const char*)(kc + (size_t)(b * 2 + hkv) * 128 * 64); const char* vb0 = (const char*)(vc + (size_t)(b * 2 + hkv) * 128 * 64);
        at_load(lds, 0, kb0, 128, vb0, 128, wave, lane);
        if (ntc == 2) at_load(lds, 1, kb0 + 64 * 128, 128, vb0 + 64 * 128, 128, wave, lane);
        WG_BAR();
        f32x16 o[2]; float l = 0.f, prevEp = 0.f;
#pragma unroll
        for (int i = 0; i < 16; ++i) { o[0][i] = 0.f; o[1][i] = 0.f; }
        LAS float* I = (LAS float*)(lds + AT_IMP) + (g * 64 + qloc) * 32;
#pragma unroll 1
        for (int tile = 0; tile < 2; ++tile) {
            if (tile < ntc) {
                f32x16 s[2];
                at_qk(lds + AT_K + tile * 8192, ka, qf, s);
                bf16x8 vf[2][2]; at_vload(lds + AT_V + tile * 8192, va, 0, vf); SB();
#pragma unroll
                for (int kb = 0; kb < 2; ++kb)
#pragma unroll
                    for (int i = 0; i < 16; ++i) { const int n = 64 * tile + 32 * kb + crow(i, h); const float p = n < ncq ? __builtin_amdgcn_exp2f(s[kb][i]) : 0.f; s[kb][i] = p; l += p; }
#pragma unroll
                for (int kb = 0; kb < 2; ++kb)
#pragma unroll
                    for (int a = 0; a < 4; ++a) { const int idx = tile * 8 + kb * 4 + a; const float Gv = (s[kb][4 * a] + s[kb][4 * a + 1]) + (s[kb][4 * a + 2] + s[kb][4 * a + 3]);
                        const float Epv = __shfl_xor(s[kb][4 * a + 3], 32);
                        I[2 * idx + h] = Gv + (h ? Epv : prevEp); prevEp = Epv; }
                at_pv(lds + AT_V + tile * 8192, va, vf, s, o);
            } else {
#pragma unroll
                for (int idx = 8; idx < 16; ++idx) I[2 * idx + h] = 0.f;
            }
        }
        const float L = l + __shfl_xor(l, 32); const float inv = L > 0.f ? 1.f / L : 0.f;
        const float gi = gate[0] * inv;
#pragma unroll
        for (int i = 0; i < 16; ++i) { ofin[0][i] += gi * o[0][i]; ofin[1][i] += gi * o[1][i]; }
        if (h == 0) ((LAS float*)(lds + AT_INV))[g * 64 + qloc] = inv;
    }
    WG_BAR();
    unsigned sel = 0u, wm = 0u, um = 0u;
    if (!DO_CMP) { sel = (qt == 31) ? 0xffffffffu : ((1u << (qt + 1)) - 1u); wm = sel; um = sel; }
    else {
        const LAS float* I = (const LAS float*)(lds + AT_IMP) + qloc * 32;
        const LAS float* IV = (const LAS float*)(lds + AT_INV) + qloc;
        const float iv0 = IV[0], iv1 = IV[64], iv2 = IV[128], iv3 = IV[192];
        LAS unsigned* SC = (LAS unsigned*)(lds + AT_SC) + (qh * 32 + r) * 33;
        if (g == 0 && h == 0) {
#pragma unroll 8
            for (int j = 0; j < 32; ++j) { const float imp = (I[j] * iv0 + I[64 * 32 + j] * iv1) + (I[2 * 64 * 32 + j] * iv2 + I[3 * 64 * 32 + j] * iv3);
                const bool cand = (j >= 1) && (j <= qt - 2);
                SC[j] = cand ? ((__float_as_uint(imp) & ~31u) | (unsigned)(31 - j)) + 32u : 0u; }
        }
        WG_BAR();
        if (qt <= 7) sel = (1u << (qt + 1)) - 1u;
        else {
            sel = 1u | (1u << qt) | (1u << (qt - 1));
            unsigned prev = 0xffffffffu;
#pragma unroll 1
            for (int rd = 0; rd < 5; ++rd) { unsigned best = 0u;
#pragma unroll 8
                for (int j = 0; j < 32; ++j) { const unsigned kx = SC[j]; const unsigned cnd = kx < prev ? kx : 0u; best = cnd > best ? cnd : best; }
                prev = best; if (best) sel |= 1u << (31 - (int)(best & 31u)); }
        }
        sel &= (qt == 31) ? 0xffffffffu : ((1u << (qt + 1)) - 1u);
        wm = sel;
#pragma unroll
        for (int o = 1; o < 32; o <<= 1) wm |= (unsigned)__shfl_xor((int)wm, o);
        wm = (unsigned)__builtin_amdgcn_readfirstlane((int)wm);
        if (lane == 0) ((LAS unsigned*)(lds + AT_WM))[wave] = wm;
        WG_BAR();
        um = 0u;
#pragma unroll
        for (int w = 0; w < 8; ++w) um |= ((const LAS unsigned*)(lds + AT_WM))[w];
        um = (unsigned)__builtin_amdgcn_readfirstlane((int)um);
    }
    if (DO_SEL) {
        f32x16 o[2]; float l = 0.f;
#pragma unroll
        for (int i = 0; i < 16; ++i) { o[0][i] = 0.f; o[1][i] = 0.f; }
        const char* kbase = (const char*)(ksn + (size_t)b * SEQ * 128 + hkv * 64); const char* vbase = (const char*)((const bf16*)(ws + WS_VSN) + (size_t)b * SEQ * 128 + hkv * 64);
        unsigned rem = um, im = um; int k = 0; const int T = __popc(um);
#pragma unroll 1
        for (int i = 0; i < 3 && im; ++i) { const int jn = __ffs((int)im) - 1; im &= im - 1u; at_load(lds, i, kbase + (size_t)jn * 64 * 256, 256, vbase + (size_t)jn * 64 * 256, 256, wave, lane); }
#pragma unroll 1
        while (rem) {
            const int j = __ffs((int)rem) - 1; rem &= rem - 1u;
            at_wait(T - k - 1);
#ifdef NSA_E1
            at_wait(T - k - 1);
#endif
            if (im) { const int jn = __ffs((int)im) - 1; im &= im - 1u; at_load(lds, (k + 3) & 3, kbase + (size_t)jn * 64 * 256, 256, vbase + (size_t)jn * 64 * 256, 256, wave, lane); }
            const int par = k & 3;
            if ((wm >> j) & 1u) {
                f32x16 s[2];
                at_qk(lds + AT_K + par * 8192, ka, qf, s);
                bf16x8 vf[2][2]; at_vload(lds + AT_V + par * 8192, va, 0, vf); SB();
                const bool on = (sel >> j) & 1u;
                if (j != qt && __all(on)) at_exp_all(s, l);
                else { const int klim = j == qt ? qq : 63;
#pragma unroll
                    for (int kb = 0; kb < 2; ++kb)
#pragma unroll
                        for (int i = 0; i < 16; ++i) { const int key = 32 * kb + crow(i, h); const float p = (on && key <= klim) ? __builtin_amdgcn_exp2f(s[kb][i]) : 0.f; s[kb][i] = p; l += p; } }
                at_pv(lds + AT_V + par * 8192, va, vf, s, o);
            }
            ++k;
        }
        const float L = l + __shfl_xor(l, 32); const float gi = gate[1] * (L > 0.f ? 1.f / L : 0.f);
#pragma unroll
        for (int i = 0; i < 16; ++i) { ofin[0][i] += gi * o[0][i]; ofin[1][i] += gi * o[1][i]; }
    }
    WG_BAR();
    if (DO_WIN) {
        f32x16 o[2]; float l = 0.f;
#pragma unroll
        for (int i = 0; i < 16; ++i) { o[0][i] = 0.f; o[1][i] = 0.f; }
        const char* kbase = (const char*)(kwn + (size_t)b * SEQ * 128 + hkv * 64); const char* vbase = (const char*)((const bf16*)(ws + WS_VWN) + (size_t)b * SEQ * 128 + hkv * 64);
        const int jlo = qt > 8 ? qt - 8 : 0; const int T = qt - jlo + 1;
#ifdef NSA_E2
        f32x16 o2[2]; float l2 = 0.f;
#pragma unroll
        for (int i = 0; i < 16; ++i) { o2[0][i] = 0.f; o2[1][i] = 0.f; }
#endif
#pragma unroll 1
        for (int i = 0; i < 3 && i < T; ++i) at_load(lds, i, kbase + (size_t)(jlo + i) * 64 * 256, 256, vbase + (size_t)(jlo + i) * 64 * 256, 256, wave, lane);
#pragma unroll 1
        for (int k = 0; k < T; ++k) {
            const int j = jlo + k, par = k & 3;
            at_wait(T - k - 1);
#ifdef NSA_E1
            at_wait(T - k - 1);
#endif
            if (k + 3 < T) at_load(lds, (k + 3) & 3, kbase + (size_t)(j + 3) * 64 * 256, 256, vbase + (size_t)(j + 3) * 64 * 256, 256, wave, lane);
            f32x16 s[2];
            at_qk(lds + AT_K + par * 8192, ka, qf, s);
            bf16x8 vf[2][2]; at_vload(lds + AT_V + par * 8192, va, 0, vf); SB();
#ifdef NSA_E2
            { f32x16 s2[2]; asm volatile("" ::: "memory"); at_qk(lds + AT_K + par * 8192, ka, qf, s2); bf16x8 vf2[2][2]; at_vload(lds + AT_V + par * 8192, va, 0, vf2); SB(); at_exp_all(s2, l2); at_pv(lds + AT_V + par * 8192, va, vf2, s2, o2); }
#endif
            if (j != qt && j != qt - 8) at_exp_all(s, l);
            else { const int klo = (j == qt - 8) ? qq + 1 : 0, khi = (j == qt) ? qq : 63;
#pragma unroll
                for (int kb = 0; kb < 2; ++kb)
#pragma unroll
                    for (int i = 0; i < 16; ++i) { const int key = 32 * kb + crow(i, h); const float p = (key >= klo && key <= khi) ? __builtin_amdgcn_exp2f(s[kb][i]) : 0.f; s[kb][i] = p; l += p; } }
            at_pv(lds + AT_V + par * 8192, va, vf, s, o);
        }
#ifdef NSA_E2
        { const float z = l2 * 0.f;
#pragma unroll
          for (int i = 0; i < 16; ++i) { ofin[0][i] += z * o2[0][i]; ofin[1][i] += z * o2[1][i]; } }
#endif
        const float L = l + __shfl_xor(l, 32); const float gi = gate[2] * (L > 0.f ? 1.f / L : 0.f);
#pragma unroll
        for (int i = 0; i < 16; ++i) { ofin[0][i] += gi * o[0][i]; ofin[1][i] += gi * o[1][i]; }
    }
    if (!STORE) { asm volatile("" :: "v"(ofin[0]), "v"(ofin[1])); return; }
    WG_BAR();
#pragma unroll
    for (int db = 0; db < 2; ++db)
#pragma unroll
        for (int a = 0; a < 4; ++a) { u32x2 w; w.x = pkbf(ofin[db][4 * a], ofin[db][4 * a + 1]); w.y = pkbf(ofin[db][4 * a + 2], ofin[db][4 * a + 3]); *(LAS u32x2*)(lds + qloc * 528 + g * 128 + (32 * db + 8 * a + 4 * h) * 2) = w; }
    WG_BAR();
    { const int tid = wave * 64 + lane; bf16* obase = H1 + ((size_t)b * SEQ + 64 * qt) * 512 + hkv * 256;
#pragma unroll
      for (int i = 0; i < 4; ++i) { const int piece = tid + 512 * i, row = piece >> 5, c = piece & 31; *(v4u*)(obase + (size_t)row * 512 + 8 * c) = *(const LAS v4u*)(lds + row * 528 + 16 * c); } }
}
constexpr int ML_K = 0, ML_V = 32768, ML_VW = 65536, ML_C = 81920, ML_N = 114688, ML_SS = 115200, ML_WS = 116224, ML_GO = 120320, ML_ST = 135424;
DI int ml_fk(int s) { return ((s & 3) << 2) | ((s >> 2) & 3); }
DI void ml_load(LAS unsigned char* lds, int par, const char* kb, const char* vb, int wave, int lane) {
#pragma unroll
    for (int n2 = 0; n2 < 2; ++n2) { const int n = 2 * wave + n2, row = 4 * n + (lane >> 4), pc = lane & 15;
        const int kc = pc ^ ml_fk(row), vc = pc ^ ((row & 3) << 2);
        glds16(kb + (size_t)row * 2048 + 16 * kc, (unsigned)(size_t)(lds + ML_K + par * 16384 + n * 1024));
        glds16(vb + (size_t)row * 1024 + 16 * vc, (unsigned)(size_t)(lds + ML_V + par * 16384 + n * 1024)); }
}
DI bf16x8 ml_tr8(const LAS unsigned char* p) {
    const s16x4 lo = __builtin_amdgcn_ds_read_tr16_b64_v4i16((lds_s16x4*)p); const s16x4 hi = __builtin_amdgcn_ds_read_tr16_b64_v4i16((lds_s16x4*)(p + 1024));
    return __builtin_shufflevector(lo, hi, 0, 1, 2, 3, 4, 5, 6, 7);
}
template <int PM = 0xff>
DI void mlstm_unit2(Frame& F, int unit) {
    unsigned char* ws = F.ws; LAS unsigned char* lds = F.lds;
    int lane_ = F.lane_id();
    const int lane = lane_, wave = F.wave, tid = wave * 64 + lane, r = lane & 31, hh = lane >> 5, tb = wave >> 2, vb = wave & 3;
    const int b = unit >> 2, hd = unit & 3;
    const bf16* proj = (const bf16*)(ws + WS_PROJ); const bf16* mlqk = (const bf16*)(ws + WS_MLQK); bf16* H0 = (bf16*)(ws + WS_H0);
    const size_t tok0 = (size_t)b * SEQ;
    const char* kbase = (const char*)(mlqk + tok0 * 1024 + 512 + hd * 128); const char* vbase = (const char*)((const bf16*)(ws + WS_MLV) + tok0 * 512 + hd * 128);
    const float LOG2E = 1.4426950408889634f;
    const int i16 = lane & 15, q4 = i16 >> 2, p4 = i16 & 3, g1 = (lane >> 4) & 1;
    const int colsw = 16 * ((4 * vb + 2 * g1 + (p4 >> 1)) ^ (q4 << 2)) + 8 * (p4 & 1);
    const int base_c = (8 * hh + q4) * 256 + colsw;
    const int base_v = (4 * hh + q4) * 256 + colsw;
    const int fK = ml_fk(r), rowK = r * 256 + ((hh ^ (fK & 1)) << 4), F16 = (fK & 14) << 4;
    int base_kt[2][2];
#pragma unroll
    for (int blk = 0; blk < 2; ++blk)
#pragma unroll
        for (int hi = 0; hi < 2; ++hi) { const int kbp = 2 * tb + blk; base_kt[blk][hi] = (8 * hh + 4 * hi + q4) * 256 + 16 * ((4 * kbp + 2 * g1 + (p4 >> 1)) ^ ((q4 << 2) | ((2 * hh + hi) & 3))) + 8 * (p4 & 1); }
    LAS float* WS = (LAS float*)(lds + ML_WS) + wave * 128;
    LAS float* NV = (LAS float*)(lds + ML_N); LAS float* SS = (LAS float*)(lds + ML_SS);
    __syncthreads();
    for (int i = tid; i < 32768 / 16; i += 512) ((LAS v4u*)(lds + ML_C))[i] = (v4u){0u, 0u, 0u, 0u};
    if (tid < 128) NV[tid] = 0.f;
    f32x16 Cst[2];
#pragma unroll
    for (int i = 0; i < 16; ++i) { Cst[0][i] = 0.f; Cst[1][i] = 0.f; }
    if (tid < 128) ((LAS float*)(lds + ML_GO))[tid] = F.in[I_MLGOUT][hd * 128 + tid];
    const float bi = F.in[I_MLBI][hd], bfv = F.in[I_MLBF][hd];
    float m_prev = 0.f;
    ml_load(lds, 0, kbase, vbase, wave, lane);
    bf16x8 qf[8];
    { const bf16* qp = mlqk + (tok0 + 32 * tb + r) * 1024 + hd * 128 + 8 * hh;
#pragma unroll
      for (int st = 0; st < 8; ++st) qf[st] = *(const bf16x8*)(qp + 16 * st); }
    float gi_raw = bf2f(proj[(tok0 + lane) * NPROJ + PC_MLI + hd]), gf_raw = bf2f(proj[(tok0 + lane) * NPROJ + PC_MLF + hd]);
#pragma unroll 1
    for (int c = 0; c < 32; ++c) {
        const int par = c & 1; const size_t tokc = tok0 + 64 * c;
        WG_BAR();
        if ((PM & 1) && c > 0) {
            bf16* obase = H0 + (tokc - 64) * 512 + hd * 128;
#pragma unroll
            for (int i = 0; i < 2; ++i) { const int piece = tid + 512 * i, row = piece >> 4, cc = piece & 15; *(v4u*)(obase + (size_t)row * 512 + 8 * cc) = *(const LAS v4u*)(lds + ML_ST + row * 272 + 16 * cc); } }
        if (c < 31) ml_load(lds, par ^ 1, kbase + (size_t)(64 * (c + 1)) * 2048, vbase + (size_t)(64 * (c + 1)) * 1024, wave, lane);
        u32x2 og[4];
        { const bf16* op = proj + (tokc + 32 * tb + r) * NPROJ + PC_MLO + hd * 128 + 32 * vb + 4 * hh;
#pragma unroll
          for (int a = 0; a < 4; ++a) og[a] = *(const u32x2*)(op + 8 * a); }
        const float ig = gi_raw + bi, lf = logsig(gf_raw + bfv);
        float bc = lf;
        if (PM & 2) {
#pragma unroll
        for (int o = 1; o < 64; o <<= 1) { const float v = __shfl_up(bc, o); if (lane >= o) bc += v; } }
        const float rr = ig - bc;
        float cm = rr;
        if (PM & 2) {
#pragma unroll
        for (int o = 1; o < 64; o <<= 1) { const float v = __shfl_up(cm, o); if (lane >= o) cm = fmaxf(cm, v); } }
        const float M63 = fmaxf(m_prev, __shfl(cm, 63)), blast = __shfl(bc, 63);
        const float a_old = __expf(m_prev - M63), m_new = blast + M63;
        const int tl = 32 * tb + r;
        const float Mt = fmaxf(m_prev, __shfl(cm, tl)), bt = __shfl(bc, tl);
        const float inter = __expf(m_prev - Mt), m_t = bt + Mt;
        WS[lane] = rr * LOG2E; WS[64 + lane] = __expf(rr - M63);
        const float MtL = Mt * LOG2E;
        const LAS unsigned char* kbuf = lds + ML_K + par * 16384; const LAS unsigned char* vbuf = lds + ML_V + par * 16384;
        f32x16 wd[2]; float dsum = 0.f;
#pragma unroll
        for (int kb = 0; kb < 2; ++kb) {
#pragma unroll
            for (int i = 0; i < 16; ++i) wd[kb][i] = 0.f;
            if ((PM & 4) && kb <= tb) {
                f32x16 a = wd[kb]; bf16x8 kfr[8];
#pragma unroll
                for (int st = 0; st < 8; ++st) kfr[st] = *(const LAS bf16x8*)(kbuf + kb * 8192 + rowK + ((32 * st) ^ F16));
                SB();
#pragma unroll
                for (int st = 0; st < 8; ++st) a = MFMA32(kfr[st], qf[st], a);
#pragma unroll
                for (int i = 0; i < 16; ++i) { const int s = 32 * kb + crow(i, hh); const float e = __builtin_amdgcn_exp2f(WS[s] - MtL); const float w = (s <= tl) ? e * a[i] : 0.f; a[i] = w; dsum += w; }
                wd[kb] = a;
            }
        }
        f32x16 acc; bf16x8 cfr[8];
#pragma unroll
        for (int i = 0; i < 16; ++i) acc[i] = 0.f;
        if (PM & 8) {
#pragma unroll
        for (int st = 0; st < 8; ++st) cfr[st] = ml_tr8(lds + ML_C + base_c + st * 4096);
        SB();
#pragma unroll
        for (int st = 0; st < 8; ++st) acc = MFMA32(cfr[st], qf[st], acc); }
#pragma unroll
        for (int i = 0; i < 16; ++i) acc[i] *= inter;
#pragma unroll
        for (int kb = 0; kb < 2; ++kb) {
            if ((PM & 16) && kb <= tb) {
                const bf16x8 pf0 = pack8<0>(wd[kb]), pf1 = pack8<1>(wd[kb]);
                {
#pragma unroll
                  for (int s2 = 0; s2 < 2; ++s2) { const LAS unsigned char* p = vbuf + base_v + kb * 8192 + s2 * 4096;
                    const s16x4 lo = __builtin_amdgcn_ds_read_tr16_b64_v4i16((lds_s16x4*)p); const s16x4 hi = __builtin_amdgcn_ds_read_tr16_b64_v4i16((lds_s16x4*)(p + 2048));
                    const bf16x8 vf = __builtin_shufflevector(lo, hi, 0, 1, 2, 3, 4, 5, 6, 7);
                    acc = MFMA32(vf, s2 ? pf1 : pf0, acc); } }
            }
        }
        float qn_ = 0.f;
        if (PM & 32)
#pragma unroll
        for (int st = 0; st < 8; ++st) { const v4u qw = __builtin_bit_cast(v4u, qf[st]); const LAS float* np = NV + 16 * st + 8 * hh; const f32x4 n0 = *(const LAS f32x4*)np, n1 = *(const LAS f32x4*)(np + 4);
            qn_ = fmaf(__uint_as_float(qw.x << 16), n0[0], qn_); qn_ = fmaf(__uint_as_float(qw.x & 0xffff0000u), n0[1], qn_); qn_ = fmaf(__uint_as_float(qw.y << 16), n0[2], qn_); qn_ = fmaf(__uint_as_float(qw.y & 0xffff0000u), n0[3], qn_);
            qn_ = fmaf(__uint_as_float(qw.z << 16), n1[0], qn_); qn_ = fmaf(__uint_as_float(qw.z & 0xffff0000u), n1[1], qn_); qn_ = fmaf(__uint_as_float(qw.w << 16), n1[2], qn_); qn_ = fmaf(__uint_as_float(qw.w & 0xffff0000u), n1[3], qn_); }
        qn_ += __shfl_xor(qn_, 32); dsum += __shfl_xor(dsum, 32);
        const float den = inter * qn_ + dsum; const float rden = 1.f / fmaxf(fabsf(den), __expf(-m_t));
        float ssq = 0.f;
#pragma unroll
        for (int i = 0; i < 16; ++i) { acc[i] *= rden; ssq = fmaf(acc[i], acc[i], ssq); }
        ssq += __shfl_xor(ssq, 32);
        if (hh == 0) SS[vb * 64 + tl] = ssq;
        if (PM & 64)
#pragma unroll
        for (int k2 = 0; k2 < 2; ++k2) { const int ci = tid + 512 * k2, s = ci >> 4; const float w = WS[64 + s];
            const v4u x = *(const LAS v4u*)(vbuf + ci * 16); v4u y; const unsigned xs[4] = {x.x, x.y, x.z, x.w}; unsigned ys[4];
#pragma unroll
            for (int j = 0; j < 4; ++j) ys[j] = pkbf(__uint_as_float(xs[j] << 16) * w, __uint_as_float(xs[j] & 0xffff0000u) * w);
            y.x = ys[0]; y.y = ys[1]; y.z = ys[2]; y.w = ys[3]; *(LAS v4u*)(lds + ML_VW + ci * 16) = y; }
        asm volatile("s_waitcnt lgkmcnt(0)" ::: "memory"); __builtin_amdgcn_s_barrier(); asm volatile("" ::: "memory");
        if (c < 31) {
            const bf16* qp = mlqk + (tokc + 64 + 32 * tb + r) * 1024 + hd * 128 + 8 * hh;
#pragma unroll
            for (int st = 0; st < 8; ++st) qf[st] = *(const bf16x8*)(qp + 16 * st);
            gi_raw = bf2f(proj[(tokc + 64 + lane) * NPROJ + PC_MLI + hd]); gf_raw = bf2f(proj[(tokc + 64 + lane) * NPROJ + PC_MLF + hd]);
        }
        { const LAS float* GO = (const LAS float*)(lds + ML_GO) + 32 * vb + 4 * hh;
          const float rstd = rsqrtf(((SS[tl] + SS[64 + tl]) + (SS[128 + tl] + SS[192 + tl])) * (1.f / 128.f) + EPS);
#pragma unroll
          for (int a = 0; a < 4; ++a) { float o4[4]; const unsigned gw[2] = {og[a].x, og[a].y};
#pragma unroll
              for (int j = 0; j < 4; ++j) { const float ov = (j & 1) ? __uint_as_float(gw[j >> 1] & 0xffff0000u) : __uint_as_float(gw[j >> 1] << 16); o4[j] = acc[4 * a + j] * rstd * GO[8 * a + j] * sigm(ov); }
              u32x2 w; w.x = pkbf(o4[0], o4[1]); w.y = pkbf(o4[2], o4[3]); *(LAS u32x2*)(lds + ML_ST + tl * 272 + (32 * vb + 8 * a + 4 * hh) * 2) = w; } }
        if (PM & 128)
#pragma unroll
        for (int blk = 0; blk < 2; ++blk) {
            f32x16 cs = Cst[blk];
#pragma unroll
            for (int i = 0; i < 16; ++i) cs[i] *= a_old;
            bf16x8 afr[4], kfr2[4];
#pragma unroll
            for (int st = 0; st < 4; ++st) {
                afr[st] = ml_tr8(lds + ML_VW + base_c + st * 4096);
                const s16x4 lo = __builtin_amdgcn_ds_read_tr16_b64_v4i16((lds_s16x4*)(kbuf + base_kt[blk][0] + st * 4096)); const s16x4 hi = __builtin_amdgcn_ds_read_tr16_b64_v4i16((lds_s16x4*)(kbuf + base_kt[blk][1] + st * 4096));
                kfr2[st] = __builtin_shufflevector(lo, hi, 0, 1, 2, 3, 4, 5, 6, 7);
            }
            SB();
#pragma unroll
            for (int st = 0; st < 4; ++st) cs = MFMA32(afr[st], kfr2[st], cs);
            Cst[blk] = cs;
            const int kk = 32 * (2 * tb + blk) + r;
#pragma unroll
            for (int a = 0; a < 4; ++a) { u32x2 w; w.x = pkbf(cs[4 * a], cs[4 * a + 1]); w.y = pkbf(cs[4 * a + 2], cs[4 * a + 3]);
                *(LAS u32x2*)(lds + ML_C + kk * 256 + 16 * ((4 * vb + a) ^ ((r & 3) << 2)) + 8 * hh) = w; }
        }
        if ((PM & 64) && tid < 128) { float nv = NV[tid] * a_old;
#pragma unroll 8
            for (int s = 0; s < 64; ++s) { const unsigned short kvs = *(const LAS unsigned short*)(kbuf + s * 256 + 16 * ((tid >> 3) ^ ml_fk(s)) + 2 * (tid & 7)); nv = fmaf(WS[64 + s], bf2f(kvs), nv); }
            NV[tid] = nv; }
        m_prev = m_new;
    }
    __syncthreads();
    if (PM & 1) { bf16* obase = H0 + (tok0 + 64 * 31) * 512 + hd * 128;
#pragma unroll
        for (int i = 0; i < 2; ++i) { const int piece = tid + 512 * i, row = piece >> 4, cc = piece & 15; *(v4u*)(obase + (size_t)row * 512 + 8 * cc) = *(const LAS v4u*)(lds + ML_ST + row * 272 + 16 * cc); } }
    __syncthreads();
}
DI void mem_load(LAS unsigned char* lds, int par, const char* kb, const char* vb, int wave, int lane) {
#pragma unroll
    for (int n2 = 0; n2 < 2; ++n2) { const int n = 2 * wave + n2, row = 4 * n + (lane >> 4), pc = lane & 15;
        const int kc = pc ^ ml_fk(row), vc = pc ^ ((row & 3) << 2);
        glds16(kb + (size_t)row * 1024 + 16 * kc, (unsigned)(size_t)(lds + ML_K + par * 16384 + n * 1024));
        glds16(vb + (size_t)row * 2048 + 16 * vc, (unsigned)(size_t)(lds + ML_V + par * 16384 + n * 1024)); }
}
template <bool STORE = true, bool DMA = true, bool COMP = true>
DI void mem_unit(Frame& F, int unit) {
    unsigned char* ws = F.ws; LAS unsigned char* lds = F.lds;
    int lane_ = F.lane_id();
    const int lane = lane_, wave = F.wave, r = lane & 31, hh = lane >> 5;
    const int b = unit >> 5, hd = (unit >> 3) & 3, qt = unit & 7;
    const bf16* mqn = (const bf16*)(ws + WS_MQN); const bf16* memkn = (const bf16*)(ws + WS_MEMKN); const bf16* memkv = (const bf16*)(ws + WS_MEMKV); bf16* H2 = (bf16*)(ws + WS_H2);
    const size_t t = (size_t)b * SEQ + 256 * qt + 32 * wave + r;
    const char* kbase = (const char*)(memkn + (size_t)b * MEML * 512 + hd * 128); const char* vbase = (const char*)(memkv + (size_t)b * MEML * 1024 + 512 + hd * 128);
    const int i16 = lane & 15, q4 = i16 >> 2, p4 = i16 & 3, g1 = (lane >> 4) & 1;
    int base_v[4];
#pragma unroll
    for (int db = 0; db < 4; ++db) base_v[db] = (4 * hh + q4) * 256 + 16 * ((4 * db + 2 * g1 + (p4 >> 1)) ^ (q4 << 2)) + 8 * (p4 & 1);
    const int fK = ml_fk(r), rowK = r * 256 + ((hh ^ (fK & 1)) << 4), F16 = (fK & 14) << 4;
    bf16x8 qf[8];
#pragma unroll
    for (int st = 0; st < 8; ++st) qf[st] = *(const bf16x8*)(mqn + t * 512 + hd * 128 + 16 * st + 8 * hh);
    f32x16 o[4]; float l = 0.f;
#pragma unroll
    for (int db = 0; db < 4; ++db)
#pragma unroll
        for (int i = 0; i < 16; ++i) o[db][i] = 0.f;
    WG_BAR();
    if (DMA) mem_load(lds, 0, kbase, vbase, wave, lane);
#pragma unroll 1
    for (int tile = 0; tile < 4; ++tile) {
        const int par = tile & 1;
        WG_BAR();
        if (DMA && tile < 3) mem_load(lds, par ^ 1, kbase + (size_t)(64 * (tile + 1)) * 1024, vbase + (size_t)(64 * (tile + 1)) * 2048, wave, lane);
        const LAS unsigned char* kbuf = lds + ML_K + par * 16384; const LAS unsigned char* vbuf = lds + ML_V + par * 16384;
        if (COMP)
#pragma unroll
        for (int kb = 0; kb < 2; ++kb) {
            bf16x8 kf[8];
#pragma unroll
            for (int st = 0; st < 8; ++st) kf[st] = *(const LAS bf16x8*)(kbuf + kb * 8192 + rowK + ((32 * st) ^ F16));
            SB();
            f32x16 a;
#pragma unroll
            for (int i = 0; i < 16; ++i) a[i] = 0.f;
#pragma unroll
            for (int st = 0; st < 8; ++st) a = MFMA32(kf[st], qf[st], a);
            bf16x8 vf[2][4];
#pragma unroll
            for (int s2 = 0; s2 < 2; ++s2)
#pragma unroll
                for (int db = 0; db < 4; ++db) { const LAS unsigned char* p = vbuf + base_v[db] + kb * 8192 + s2 * 4096;
                    const s16x4 lo = __builtin_amdgcn_ds_read_tr16_b64_v4i16((lds_s16x4*)p); const s16x4 hi = __builtin_amdgcn_ds_read_tr16_b64_v4i16((lds_s16x4*)(p + 2048));
                    vf[s2][db] = __builtin_shufflevector(lo, hi, 0, 1, 2, 3, 4, 5, 6, 7); }
            SB();
#pragma unroll
            for (int i = 0; i < 16; ++i) { a[i] = __builtin_amdgcn_exp2f(a[i]); l += a[i]; }
            const bf16x8 pf0 = pack8<0>(a), pf1 = pack8<1>(a);
#pragma unroll
            for (int s2 = 0; s2 < 2; ++s2)
#pragma unroll
                for (int db = 0; db < 4; ++db) o[db] = MFMA32(vf[s2][db], s2 ? pf1 : pf0, o[db]);
        }
    }
    const float inv = 1.f / (l + __shfl_xor(l, 32));
    if (!STORE) {
#pragma unroll
        for (int db = 0; db < 4; ++db) asm volatile("" :: "v"(o[db]), "v"(inv));
        return; }
    WG_BAR();
#pragma unroll
    for (int db = 0; db < 4; ++db)
#pragma unroll
        for (int a = 0; a < 4; ++a) { u32x2 w; w.x = pkbf(o[db][4 * a] * inv, o[db][4 * a + 1] * inv); w.y = pkbf(o[db][4 * a + 2] * inv, o[db][4 * a + 3] * inv);
            *(LAS u32x2*)(lds + (32 * wave + r) * 272 + (32 * db + 8 * a + 4 * hh) * 2) = w; }
    WG_BAR();
    { const int tid = wave * 64 + lane; bf16* obase = H2 + ((size_t)b * SEQ + 256 * qt) * 512 + hd * 128;
#pragma unroll
      for (int i = 0; i < 8; ++i) { const int piece = tid + 512 * i, row = piece >> 4, c = piece & 15; *(v4u*)(obase + (size_t)row * 512 + 8 * c) = *(const LAS v4u*)(lds + row * 272 + 16 * c); } }
}
DI int q_pop(Frame& F, unsigned* qc) {
    __syncthreads();
    if (F.tid_id() == 0) F.MISC[16] = atomicAdd(qc, 1u);
    __syncthreads();
    return (int)F.MISC[16];
}
template <bool ML, bool NSA, bool MEMA, bool MST = true, bool MDMA = true, bool MCOMP = true, bool NST = true, bool NCMP = true, bool NSEL = true, bool NWIN = true, int MLPM = 0xff>
DI void p5_queue(Frame& F, int cbase) {
    unsigned* qc = F.ctl + CW_QCTR + cbase;
    if (ML) {
#pragma unroll 1
        for (;;) { const int it = q_pop(F, qc); if (it >= 64) break; mlstm_unit2<MLPM>(F, it); }
    }
    if (NSA) {
#pragma unroll 1
        for (;;) { const int it = q_pop(F, qc + 64); if (it >= 1024) break; nsa_unit<NST, NCMP, NSEL, NWIN>(F, it); }
    }
    if (MEMA) {
#pragma unroll 1
        for (;;) { const int it = q_pop(F, qc + 128); if (it >= 512) break; mem_unit<MST, MDMA, MCOMP>(F, it); }
    }
    __syncthreads();
}
DI void p5_mixers(Frame& F) {
    const int nml = F.G >= 128 ? 64 : 0;
#ifndef RPT_ML
#define RPT_ML 1
#endif
#ifndef RPT_NSA
#define RPT_NSA 1
#endif
#ifndef RPT_MEM
#define RPT_MEM 1
#endif
    if (F.bx < nml || nml == 0) { for (int rp = 0; rp < RPT_ML; ++rp) for (int u = F.bx; u < 64; u += (nml ? nml : F.G)) mlstm_unit2(F, u); }
    if (F.bx >= nml) {
        LAS float* wl = (LAS float*)(F.lds + F.wave * 4096);
        const int gw = (F.bx - nml) * NWAVES + F.wave, NGW = (F.G - nml) * NWAVES;
        for (int rp = 0; rp < RPT_NSA; ++rp) for (int u = F.bx - nml; u < 1024; u += F.G - nml) nsa_unit(F, u);
        __syncthreads();
        for (int rp = 0; rp < RPT_MEM; ++rp) for (int t = gw; t < MT; t += NGW) mem_wave(F, t, wl);
    }
}

DI void p8_router(Frame& F, int alt) {
    unsigned char* ws = F.ws + (size_t)alt * 3 * MiB; const int lane = F.lane_id(), tid = F.tid_id(), wave = F.wave, r = lane & 31, hh = lane >> 5;
    unsigned char* xn8 = (unsigned char*)(F.ws + WS_R1);
    int* tok_e = (int*)(ws + WS_ROUTE + RT_TOKE); int* tok_pos = (int*)(ws + WS_ROUTE + RT_TOKPOS); float* tok_w = (float*)(ws + WS_ROUTE + RT_TOKW);
    unsigned* gcnt = F.ctl + CW_ECNT + 64 * alt;
    const bf16* wrt = (const bf16*)(F.ws + WS_SMALL + SM_WRT);
    LAS unsigned char* img = F.lds;
    LAS float* part = (LAS float*)F.lds;
    LAS float* lg = (LAS float*)(F.lds + 4 * 64 * 33 * 4);
    LAS int* lcnt = (LAS int*)(F.lds + RING_BYTES + 1024);
    LAS int* lbase = lcnt + 32;
    LAS int* se = lbase + 32;
    LAS int* sp = se + 256;
    LAS float* sw = (LAS float*)(sp + 256);
    const float* gf = F.in[I_GFFN];
    for (int bt = F.bx; bt < MT / 64; bt += F.G) {
        __syncthreads();
        if (tid < 32) lcnt[tid] = 0;
#pragma unroll 2
        for (int i = 0; i < 8; ++i) {
            const int tl = wave * 8 + i, t = bt * 64 + tl;
            const f32x4* xr = (const f32x4*)(F.out + (size_t)t * DM) + lane; const f32x4* gr = (const f32x4*)gf + lane;
            f32x4 v[4]; float s = 0.f;
#pragma unroll
            for (int j = 0; j < 4; ++j) { v[j] = xr[64 * j]; s += (v[j].x * v[j].x + v[j].y * v[j].y) + (v[j].z * v[j].z + v[j].w * v[j].w); }
            const float rstd = rsqrtf(wave_sum(s) * (1.f / DM) + EPS);
            unsigned* o4 = (unsigned*)(xn8 + (size_t)t * DM) + lane;
#pragma unroll
            for (int j = 0; j < 4; ++j) { const f32x4 gg = gr[64 * j];
                const float y0 = v[j].x * rstd * gg.x, y1 = v[j].y * rstd * gg.y, y2 = v[j].z * rstd * gg.z, y3 = v[j].w * rstd * gg.w;
                const unsigned long long w = (unsigned long long)pk2(y0, y1) | ((unsigned long long)pk2(y2, y3) << 32);
                int q8 = 0; q8 = __builtin_amdgcn_cvt_pk_fp8_f32(y0, y1, q8, false); q8 = __builtin_amdgcn_cvt_pk_fp8_f32(y2, y3, q8, true);
                o4[64 * j] = (unsigned)q8;
                const int d = 4 * lane + 256 * j, ch = d >> 3;
                *(LAS unsigned long long*)(img + tl * 2048 + 16 * (ch ^ (tl & 15)) + 2 * (d & 7)) = w; }
        }
        __syncthreads();
        {
            const int mb = wave & 1, kq = wave >> 1, trow = 32 * mb + r;
            f32x16 acc;
#pragma unroll
            for (int i = 0; i < 16; ++i) acc[i] = 0.f;
#pragma unroll 4
            for (int s2 = 0; s2 < 16; ++s2) { const int st = 16 * kq + s2;
                const bf16x8 xa = *(const LAS bf16x8*)(img + trow * 2048 + 16 * ((2 * st + hh) ^ (trow & 15)));
                const bf16x8 wh = *(const bf16x8*)(wrt + (size_t)r * 1024 + 16 * st + 8 * hh), wl = *(const bf16x8*)(wrt + 32 * 1024 + (size_t)r * 1024 + 16 * st + 8 * hh);
                acc = MFMA32(xa, wh, acc); acc = MFMA32(xa, wl, acc); }
            __syncthreads();
#pragma unroll
            for (int i = 0; i < 16; ++i) part[(kq * 64 + 32 * mb + crow(i, hh)) * 33 + r] = acc[i];
        }
        __syncthreads();
        for (int i = tid; i < 64 * 32; i += 512) { const int tk = i >> 5, e = i & 31; lg[tk * 33 + e] = ((part[(0 * 64 + tk) * 33 + e] + part[(1 * 64 + tk) * 33 + e]) + (part[(2 * 64 + tk) * 33 + e] + part[(3 * 64 + tk) * 33 + e])) + F.in[I_BR][e]; }
        __syncthreads();
        for (int i = 0; i < 8; ++i) {
            const int tl = wave * 8 + i, e = lane & 31;
            float sc = lg[tl * 33 + e]; int ek[4]; float vk[4];
#pragma unroll
            for (int rd = 0; rd < 4; ++rd) { const float mx = wave_max(sc); const unsigned long long bal = __ballot(sc == mx); const int win = (__ffsll((long long)bal) - 1) & 31;
                ek[rd] = win; vk[rd] = mx; if (e == win) sc = -3.4e38f; }
            const float e1 = __expf(vk[1] - vk[0]), e2 = __expf(vk[2] - vk[0]), e3 = __expf(vk[3] - vk[0]); const float inv = 1.f / (1.f + e1 + e2 + e3);
            if (lane == 0) {
                const float wk[4] = {inv, e1 * inv, e2 * inv, e3 * inv};
#pragma unroll
                for (int rd = 0; rd < 4; ++rd) { se[tl * 4 + rd] = ek[rd]; sw[tl * 4 + rd] = wk[rd]; sp[tl * 4 + rd] = atomicAdd((int*)&lcnt[ek[rd]], 1); }
            }
        }
        __syncthreads();
        if (tid < 32) lbase[tid] = (int)atomicAdd(&gcnt[tid], (unsigned)lcnt[tid]);
        __syncthreads();
        if (tid < 256) { const int t = bt * 64 + (tid >> 2), k = tid & 3; const int e = se[tid];
          tok_e[t * 4 + k] = e; tok_pos[t * 4 + k] = lbase[e] + sp[tid]; tok_w[t * 4 + k] = sw[tid]; }
    }
    __syncthreads();
}
DI int moe_tables(Frame& F, LAS int* pstart, LAS unsigned char* blk_e) {
    unsigned* gcnt = F.ctl + CW_ECNT;
    __syncthreads();
    if (F.tid_id() == 0) { int acc = 0; for (int e = 0; e < NEXP; ++e) { const int cnt = (int)__hip_atomic_load(&gcnt[e], __ATOMIC_RELAXED, __HIP_MEMORY_SCOPE_AGENT); pstart[e] = acc; acc += (cnt + MOEB - 1) / MOEB * MOEB; } pstart[NEXP] = acc; }
    __syncthreads();
    const int nblk = pstart[NEXP] / MOEB;
    for (int rb = F.tid_id(); rb < nblk; rb += 512) { int e = 0; while (e < NEXP - 1 && pstart[e + 1] <= rb * MOEB) ++e; blk_e[rb] = (unsigned char)e; }
    __syncthreads();
    return nblk;
}
DI void p9_scatter(Frame& F) {
    unsigned char* ws = F.ws; const int lane = F.lane_id();
    LAS int* pstart = (LAS int*)(F.lds + 65536); LAS unsigned char* blk_e = (LAS unsigned char*)(F.lds + 65536 + 256);
    moe_tables(F, pstart, blk_e);
    const unsigned char* xn8 = (const unsigned char*)(ws + WS_R1); unsigned char* aperm = (unsigned char*)(ws + WS_APERM);
    const int* tok_e = (const int*)(ws + WS_ROUTE + RT_TOKE); const int* tok_pos = (const int*)(ws + WS_ROUTE + RT_TOKPOS); const float* tok_w = (const float*)(ws + WS_ROUTE + RT_TOKW);
    int* tok_dest = (int*)(ws + WS_ROUTE + RT_TOKDEST); float* roww = (float*)(ws + WS_ROUTE + RT_ROWW);
    unsigned* gcnt = F.ctl + CW_ECNT;
    const int gw = F.bx * NWAVES + F.wave, NGW = F.G * NWAVES;
    for (int t4 = gw; t4 < MT / 4; t4 += NGW) {
        int dest = 0;
        if (lane < 16) { const int it = t4 * 16 + lane; dest = pstart[tok_e[it]] + tok_pos[it]; tok_dest[it] = dest; roww[dest] = tok_w[it]; }
        v4u v0[4];
#pragma unroll
        for (int q = 0; q < 4; ++q) { const v4u* src = (const v4u*)(xn8 + (size_t)(t4 * 4 + q) * DM); v0[q] = src[lane]; }
#pragma unroll
        for (int q = 0; q < 4; ++q)
#pragma unroll
            for (int k = 0; k < 4; ++k) { const int d = __shfl(dest, q * 4 + k); v4u* dst = (v4u*)(aperm + (size_t)d * DM); dst[lane] = v0[q]; }
    }
    for (int it = gw; it < NEXP * MOEB; it += NGW) { const int e = it >> 8, i = it & 255; const int cnt = (int)__hip_atomic_load(&gcnt[e], __ATOMIC_RELAXED, __HIP_MEMORY_SCOPE_AGENT); const int padded = (cnt + MOEB - 1) / MOEB * MOEB;
        if (i < padded - cnt) { const int dest = pstart[e] + cnt + i; v4u* dst = (v4u*)(aperm + (size_t)dest * DM); const v4u z = {0u, 0u, 0u, 0u}; dst[lane] = z; if (lane == 0) roww[dest] = 0.f; } }
}
DI void p12_combine(Frame& F) {
    unsigned char* ws = F.ws; const int lane = F.lane_id();
    const bf16* ybuf = (const bf16*)(ws + WS_APERM); const int* tok_dest = (const int*)(ws + WS_ROUTE + RT_TOKDEST);
    const int gw = F.bx * NWAVES + F.wave, NGW = F.G * NWAVES;
    for (int t2 = gw; t2 < MT / 2; t2 += NGW) {
        typedef int i32x4 __attribute__((ext_vector_type(4)));
        unsigned long long w[2][4][4]; f32x4 a[2][4];
#pragma unroll
        for (int q = 0; q < 2; ++q) { const int t = 2 * t2 + q; const f32x4* orow = (const f32x4*)(F.out + (size_t)t * DM);
            const i32x4 d = *(const i32x4*)(tok_dest + t * 4);
            const unsigned long long* y0 = (const unsigned long long*)(ybuf + (size_t)d.x * DM) + lane; const unsigned long long* y1 = (const unsigned long long*)(ybuf + (size_t)d.y * DM) + lane;
            const unsigned long long* y2 = (const unsigned long long*)(ybuf + (size_t)d.z * DM) + lane; const unsigned long long* y3 = (const unsigned long long*)(ybuf + (size_t)d.w * DM) + lane;
#pragma unroll
            for (int j = 0; j < 4; ++j) { w[q][0][j] = y0[64 * j]; w[q][1][j] = y1[64 * j]; w[q][2][j] = y2[64 * j]; w[q][3][j] = y3[64 * j]; a[q][j] = orow[lane + 64 * j]; } }
#pragma unroll
        for (int q = 0; q < 2; ++q) { f32x4* orow = (f32x4*)(F.out + (size_t)(2 * t2 + q) * DM);
#pragma unroll
            for (int j = 0; j < 4; ++j) {
#pragma unroll
                for (int k = 0; k < 4; ++k) { const unsigned long long ww = w[q][k][j];
                    a[q][j].x += __uint_as_float((unsigned)ww << 16); a[q][j].y += __uint_as_float((unsigned)ww & 0xffff0000u); a[q][j].z += __uint_as_float((unsigned)(ww >> 32) << 16); a[q][j].w += __uint_as_float((unsigned)(ww >> 32) & 0xffff0000u); }
                orow[lane + 64 * j] = a[q][j]; } }
    }
}

constexpr int N_PHASES = 13;
#ifndef MK_PER_PHASE
#define MK_PER_PHASE 0
#endif
__global__ void __launch_bounds__(NWAVES * 64, 2) fwd_kernel(Args args) {
    extern __shared__ __attribute__((aligned(16))) unsigned char lds_raw[];
    Frame F;
    F.lds = (LAS unsigned char*)lds_raw; F.MISC = (volatile LAS unsigned*)(F.lds + MISC_OFF);
    F.wave = __builtin_amdgcn_readfirstlane((int)(threadIdx.x >> 6)); F.G = gridDim.x; F.bx = blockIdx.x;
    F.ws = args.ws; F.ctl = (unsigned*)(args.ws + WS_CTL); F.in = args.in; F.out = args.out;
    unsigned char* ws = args.ws;
    for (int u = threadIdx.x; u < (LDS_BYTES - LDSCTL_OFF) / 4; u += NWAVES * 64) ((LAS unsigned*)(F.lds + LDSCTL_OFF))[u] = 0u;
    __syncthreads();
    const int lo = args.ph_lo, hi = args.ph_hi;
    XcdBarrier bar; bar.wv = F.wave; bar.bar = F.ctl + CW_BAR; bar.x = 0; bar.st = nullptr;
    if (hi - lo > 1) bar = xcd_barrier_post(F.ctl + CW_BAR, F.MISC + 8, F.wave);
#ifndef PH_MASK
#define PH_MASK 0x1fff
#endif
#define IN(k) (((PH_MASK >> (k)) & 1) && lo <= (k) && (k) < hi)
#define SEAM(k) do { if (IN(k) && IN((k) + 1)) xcd_barrier(bar); } while (0)
    typedef pg8::bf16_t b16;
#ifndef RPT_MASK
#define RPT_MASK 0
#endif
#define RPT(k) _Pragma("unroll") for (int rp_ = 0; rp_ < 1 + ((RPT_MASK >> (k)) & 1); ++rp_)
    if (IN(0)) { RPT(0) p0_prologue(F); } SEAM(0);
    if (IN(1)) RPT(1) {
        { pg8::Gemm8 g{(const unsigned char*)(ws + WS_U8), (const unsigned char*)(ws + WS_WIN8), MT, NF8, DM, 0x7f7f7f7f, 0x77777777}; pg8::StaticOrder S; S.init(MT, NF8, F.G, F.bx);
          pg8::EpiBf16Silu E{(b16*)(ws + WS_PROJ) + NB16, NPROJ, nullptr, 0};
          pg8::gemm_phase_f8<pg8::EpiBf16Silu, pg8::StaticOrder, true, true>(F.lds, g, S, E, F.wave); }
        { pg8::Gemm g{(const b16*)(ws + WS_R1), (const b16*)(ws + WS_WIN), MT, NB16, DM}; pg8::StaticOrder S; S.init(MT, NB16, F.G, F.bx);
          pg8::EpiBf16Silu E{(b16*)(ws + WS_PROJ), NPROJ, nullptr, 0};
          pg8::gemm_phase<pg8::EpiBf16Silu, pg8::StaticOrder, true, true>(F.lds, g, S, E, F.wave); }
        { pg8::Gemm g{(const b16*)(ws + WS_MEMN), (const b16*)(ws + WS_WMKV), MROWS, 1024, DM}; pg8::StaticOrder S; S.init(MROWS, 1024, F.G, (F.bx + 64) % F.G);
          pg8::EpiBf16Silu E{(b16*)(ws + WS_MEMKV), 1024, nullptr, 0};
          pg8::gemm_phase<pg8::EpiBf16Silu, pg8::StaticOrder, true, true>(F.lds, g, S, E, F.wave); }
    } SEAM(1);
    if (IN(2)) { RPT(2) p2_prep(F); } SEAM(2);
    if (IN(3)) RPT(3) {
#pragma unroll
        for (int kv = 0; kv < 2; ++kv) {
            pg8::Gemm g{(const b16*)(ws + WS_ACMP) + (size_t)kv * 4096 * 2048, (const b16*)(ws + WS_WC1) + (size_t)kv * 256 * 2048, 4096, 256, 2048}; pg8::StaticOrder S; S.init(4096, 256, F.G, (F.bx + F.G - 16 * kv) % F.G);
            pg8::EpiBf16Silu E{(b16*)(ws + WS_HID) + (size_t)kv * 4096 * 256, 256, (const float*)(ws + WS_SMALL + SM_CBIAS) + kv * 256, 1};
            pg8::gemm_phase<pg8::EpiBf16Silu, pg8::StaticOrder, true, true>(F.lds, g, S, E, F.wave); }
    } SEAM(3);
    if (IN(4)) { RPT(4) p4_kcvc(F); } SEAM(4);
#ifndef RPT5_ML
#define RPT5_ML 0
#endif
#ifndef MLPROBE
#define MLPROBE 0xff
#endif
#ifndef NPROBE_ST
#define NPROBE_ST true
#endif
#ifndef NPROBE_CMP
#define NPROBE_CMP true
#endif
#ifndef NPROBE_SEL
#define NPROBE_SEL true
#endif
#ifndef NPROBE_WIN
#define NPROBE_WIN true
#endif
#ifndef MPROBE_ST
#define MPROBE_ST true
#endif
#ifndef MPROBE_DMA
#define MPROBE_DMA true
#endif
#ifndef MPROBE_COMP
#define MPROBE_COMP true
#endif
#ifndef RPT5_NSA
#define RPT5_NSA 0
#endif
#ifndef RPT5_MEM
#define RPT5_MEM 0
#endif
    if (IN(5)) { p5_queue<true, true, true>(F, 0);
        if (RPT5_ML || RPT5_NSA || RPT5_MEM) { xcd_barrier(bar); p5_queue<RPT5_ML != 0, RPT5_NSA != 0, RPT5_MEM != 0, MPROBE_ST, MPROBE_DMA, MPROBE_COMP, NPROBE_ST, NPROBE_CMP, NPROBE_SEL, NPROBE_WIN, MLPROBE>(F, 256); } } SEAM(5);
    if (IN(6)) RPT(6) {
        pg8::StaticOrder S; S.init(MT, DM, F.G, F.bx);
        { pg8::Gemm g{(const b16*)(ws + WS_H0), (const b16*)(ws + WS_WBR), MT, DM, 512}; pg8::EpiGate<0> E{(const b16*)(ws + WS_PROJ), F.out, (b16*)(ws + WS_R1)};
          pg8::gemm_phase<pg8::EpiGate<0>, pg8::StaticOrder, true, true>(F.lds, g, S, E, F.wave); }
        { pg8::Gemm g{(const b16*)(ws + WS_H1), (const b16*)(ws + WS_WBR) + 1024 * 512, MT, DM, 512}; pg8::EpiGate<1> E{(const b16*)(ws + WS_PROJ), F.out, (b16*)(ws + WS_R1)};
          pg8::gemm_phase<pg8::EpiGate<1>, pg8::StaticOrder, true, true>(F.lds, g, S, E, F.wave); }
        { pg8::Gemm g{(const b16*)(ws + WS_H2), (const b16*)(ws + WS_WBR) + 2 * 1024 * 512, MT, DM, 512}; pg8::EpiGate<2> E{(const b16*)(ws + WS_PROJ), F.out, (b16*)(ws + WS_R1)};
          pg8::gemm_phase<pg8::EpiGate<2>, pg8::StaticOrder, true, true>(F.lds, g, S, E, F.wave); }
    } SEAM(6);
    if (IN(7)) RPT(7) {
        pg8::Gemm g{(const b16*)(ws + WS_R1), (const b16*)(ws + WS_WOUT), MT, DM, DM}; pg8::StaticOrder S; S.init(MT, DM, F.G, F.bx);
        pg8::EpiRes E{F.in[I_X], F.out};
        pg8::gemm_phase<pg8::EpiRes, pg8::StaticOrder, true, true>(F.lds, g, S, E, F.wave);
    } SEAM(7);
    if (IN(8)) { p8_router(F, 0); if ((RPT_MASK >> 8) & 1) p8_router(F, 1); } SEAM(8);
    if (IN(9)) { RPT(9) p9_scatter(F); } SEAM(9);
    if (IN(10)) RPT(10) {
        LAS int* pstart = (LAS int*)(F.lds + RING_BYTES + 1024); LAS unsigned char* blk_e = (LAS unsigned char*)(F.lds + RING_BYTES + 1024 + 256);
        const int nblk = moe_tables(F, pstart, blk_e);
        pg8::Gemm8 g{(const unsigned char*)(ws + WS_APERM), (const unsigned char*)(ws + WS_WGU), CAP, NEXP * 2048, DM, 0x7f7f7f7f, 0x77777777};
        pg8::MoeOrder<8> S{nblk, F.G, F.bx, (const PG8_LAS unsigned char*)blk_e};
        pg8::EpiSwiglu E{(unsigned char*)(ws + WS_ACT), F.in[I_BGU]};
        pg8::gemm_phase_f8<pg8::EpiSwiglu, pg8::MoeOrder<8>, true, true>(F.lds, g, S, E, F.wave);
    } SEAM(10);
    if (IN(11)) RPT(11) {
        LAS int* pstart = (LAS int*)(F.lds + RING_BYTES + 1024); LAS unsigned char* blk_e = (LAS unsigned char*)(F.lds + RING_BYTES + 1024 + 256);
        const int nblk = moe_tables(F, pstart, blk_e);
        pg8::Gemm8 g{(const unsigned char*)(ws + WS_ACT), (const unsigned char*)(ws + WS_WDN), CAP, NEXP * DM, DFF, 0x7f7f7f7f, 0x77777777};
        pg8::MoeOrder<4> S{nblk, F.G, F.bx, (const PG8_LAS unsigned char*)blk_e};
        pg8::EpiDown E{(b16*)(ws + WS_APERM), F.in[I_BDN], (const float*)(ws + WS_ROUTE + RT_ROWW)};
        pg8::gemm_phase_f8<pg8::EpiDown, pg8::MoeOrder<4>, true, true>(F.lds, g, S, E, F.wave);
    } SEAM(11);
    if (IN(12)) { p12_combine(F); }
#undef IN
#undef SEAM
}

extern "C" void kernel_launch(void* const* d_in, const int* in_sizes, int n_in, void* d_out, int out_size, void* d_ws, size_t ws_size, hipStream_t stream) {
    static int grid = 0;
    if (grid == 0) {
        if (n_in != N_IN || out_size != MT * DM || ws_size < WS_END) { fprintf(stderr, "kernel_launch: unexpected shapes (n_in %d, out %d, ws %zu need %zu)\n", n_in, out_size, ws_size, (size_t)WS_END); grid = -1; return; }
        int dev = 0, cus = 0, per_cu = 0;
        if (hipGetDevice(&dev) != hipSuccess || hipDeviceGetAttribute(&cus, hipDeviceAttributeMultiprocessorCount, dev) != hipSuccess) { grid = -1; return; }
        if (hipFuncSetAttribute((const void*)fwd_kernel, hipFuncAttributeMaxDynamicSharedMemorySize, LDS_BYTES) != hipSuccess) { fprintf(stderr, "kernel_launch: hipFuncSetAttribute failed\n"); grid = -1; return; }
        if (hipOccupancyMaxActiveBlocksPerMultiprocessor(&per_cu, (const void*)fwd_kernel, NWAVES * 64, LDS_BYTES) != hipSuccess || per_cu < 1) { fprintf(stderr, "kernel_launch: occupancy query says %d\n", per_cu); }
        (void)hipGetLastError();
        grid = cus;
    }
    if (grid < 0) return;
    if (hipMemsetAsync((char*)d_ws + WS_CTL, 0, CTL_ZERO_BYTES, stream) != hipSuccess) return;
    Args a{};
    for (int i = 0; i < N_IN; ++i) a.in[i] = (const float*)d_in[i];
    a.out = (float*)d_out; a.ws = (unsigned char*)d_ws;
#if MK_PER_PHASE
    for (int p = 0; p < N_PHASES; ++p) { a.ph_lo = p; a.ph_hi = p + 1; a.li = 0; hipLaunchKernelGGL(fwd_kernel, dim3(grid), dim3(NWAVES * 64), LDS_BYTES, stream, a); }
#else
    a.ph_lo = 0; a.ph_hi = N_PHASES; a.li = 0;
    hipLaunchKernelGGL(fwd_kernel, dim3(grid), dim3(NWAVES * 64), LDS_BYTES, stream, a);
#endif
}
```

```cpp
#include <hip/hip_runtime.h>
#include <cstdio>
#include <cstdint>
namespace pg8 {
#define PG8_LAS __attribute__((address_space(3)))
typedef unsigned short bf16_t;
typedef short bf16x8 __attribute__((ext_vector_type(8)));
typedef float f32x4 __attribute__((ext_vector_type(4)));
typedef unsigned u32x4 __attribute__((ext_vector_type(4)));
constexpr int BM = 256, BK = 64, HALF = 128, HTB = HALF * BK * 2  , STAGE_BYTES = 8 * HTB, NXCD = 8, WGM = 8;

__host__ __device__ __forceinline__ int lds_byte(int r, int c) { const int st = (r >> 4) * 2 + (c >> 5), rr = r & 15, cc = c & 31, ob = rr * 64 + cc * 2; return st * 1024 + (ob ^ (((ob >> 9) & 1) << 5)); }
__host__ __device__ __forceinline__ void stage_rc(int b, int& R, int& C) { const int st = b / 1024, sb = b % 1024, swz = sb ^ (((sb >> 9) & 1) << 5); R = (st >> 1) * 16 + swz / 64; C = (st & 1) * 32 + (swz % 64) / 2; }
__host__ __device__ __forceinline__ int perm32(int rho) { const int n = rho >> 4, i = rho & 15; return 8 * (i >> 2) + 4 * n + (i & 3); }

struct Unit { int pm, pn; };
struct Gemm { const bf16_t* A; const bf16_t* Bt; int M, N, K; };

struct StaticOrder {
    int nM, nN, nwg, G, c;
    __host__ __device__ void init(int M, int N, int G_, int c_) { nM = M / BM; nN = N / BM; nwg = nM * nN; G = G_; c = c_; }
    __host__ __device__ bool next(int i, Unit& u) const {
        const long L = (long)i * G + c; if (L >= nwg) return false;
        int wgid = (int)L; { const int q = nwg / NXCD, r = nwg % NXCD, xcd = wgid % NXCD, off = wgid / NXCD; wgid = (xcd < r ? xcd * (q + 1) : r * (q + 1) + (xcd - r) * q) + off; }
        const int nig = WGM * nN, gid = wgid / nig, fm = gid * WGM, gsz = (nM - fm) < WGM ? (nM - fm) : WGM;
        u.pm = fm + ((wgid % nig) % gsz); u.pn = (wgid % nig) / gsz; return true;
    }
    __device__ __forceinline__ void a_ready(const Unit&) const {}
    __device__ __forceinline__ void done(const Unit&) const {}
};

__device__ __forceinline__ unsigned cvt_pk_bf16(float lo, float hi) { unsigned r; asm volatile("v_cvt_pk_bf16_f32 %0, %1, %2" : "=v"(r) : "v"(lo), "v"(hi)); return r; }
typedef float f32x2 __attribute__((ext_vector_type(2)));
__device__ __forceinline__ f32x2 gelu_pk(f32x2 v) {
    const f32x2 av = __builtin_elementwise_abs(v), d = av * 0.2316418882f + 1.0f;
    f32x2 t; t.x = __builtin_amdgcn_rcpf(d.x); t.y = __builtin_amdgcn_rcpf(d.y);
    f32x2 q = t * 0.5307027145f + (-0.7265760135f); q = q * t + 0.7107068705f; q = q * t + (-0.142248368f); q = q * t + 0.127414796f; q = q * t;
    const f32x2 s = (v * v) * (-0.72134752044f);
    f32x2 e; e.x = __builtin_amdgcn_exp2f(s.x); e.y = __builtin_amdgcn_exp2f(s.y);
    const f32x2 m = v * (q * e), r = v - m;
    f32x2 o; o.x = v.x < 0.f ? m.x : r.x; o.y = v.y < 0.f ? m.y : r.y; return o;
}

template <int ACT  > struct EpiBf16 {
    static constexpr bool PERM = true, AFTER_DRAIN = false; static_assert(ACT == 0 || ACT == 1, "EpiBf16: ACT is 0 (none) or 1 (gelu_pk)");
    bf16_t* O; int ldc; const float* bias; int split_cols; size_t split_stride; float scale0;
    __device__ __forceinline__ void operator()(const f32x4 (&acc)[2][2][4][2], const Unit& u, int wr, int wc, int fr, int fq) const {
        const int row0 = u.pm * BM + wr * 64 + fr; int colt = u.pn * BM; bf16_t* base = O;
        float sc = 1.f; if (split_cols) { const int t = colt / split_cols; base += (size_t)t * split_stride; colt -= t * split_cols; if (t == 0) sc = scale0; }
        const int col0 = colt + wc * 32 + 8 * fq, bcol0 = u.pn * BM + wc * 32 + 8 * fq;
        f32x4 bv[2][2];
#pragma unroll
        for (int bj = 0; bj < 2; ++bj)
#pragma unroll
            for (int n = 0; n < 2; ++n) bv[bj][n] = bias ? *(const f32x4*)(bias + bcol0 + bj * HALF + 4 * n) : (f32x4){0.f, 0.f, 0.f, 0.f};
#pragma unroll
        for (int ai = 0; ai < 2; ++ai)
#pragma unroll
            for (int m = 0; m < 4; ++m) { bf16_t* rowp = base + (size_t)(row0 + ai * HALF + m * 16) * ldc + col0;
#pragma unroll
                for (int bj = 0; bj < 2; ++bj) { f32x4 v0 = acc[ai][bj][m][0] + bv[bj][0], v1 = acc[ai][bj][m][1] + bv[bj][1];
                    if (ACT == 1) { f32x2 a = gelu_pk((f32x2){v0[0], v0[1]}), b = gelu_pk((f32x2){v0[2], v0[3]}), c = gelu_pk((f32x2){v1[0], v1[1]}), d = gelu_pk((f32x2){v1[2], v1[3]});
                        v0 = (f32x4){a.x, a.y, b.x, b.y}; v1 = (f32x4){c.x, c.y, d.x, d.y}; }
                    v0 = v0 * sc; v1 = v1 * sc; u32x4 w; w.x = cvt_pk_bf16(v0[0], v0[1]); w.y = cvt_pk_bf16(v0[2], v0[3]); w.z = cvt_pk_bf16(v1[0], v1[1]); w.w = cvt_pk_bf16(v1[2], v1[3]);
                    *(u32x4*)(rowp + bj * HALF) = w; } }
    }
};

struct PanelStats {
    unsigned* xbuf;
    unsigned* cnt;
    unsigned* tmo;
    int ntn; float eps;
    unsigned code;
    __device__ __forceinline__ bool run(const f32x4 (&v)[2][2][4][2], const Unit& u, int wr, int wc, int fr, int fq, PG8_LAS unsigned char* lds, int wid, int lane) const {
        typedef float f32x2v __attribute__((ext_vector_type(2)));
        PG8_LAS f32x2v* P = (PG8_LAS f32x2v*)lds;
        PG8_LAS f32x2v* S = (PG8_LAS f32x2v*)(lds + 8192);
        PG8_LAS unsigned* flag = (PG8_LAS unsigned*)(lds + 8192 + 2048);
#pragma unroll
        for (int ai = 0; ai < 2; ++ai)
#pragma unroll
            for (int m = 0; m < 4; ++m) {
                float s = 0.f;
#pragma unroll
                for (int bj = 0; bj < 2; ++bj)
#pragma unroll
                    for (int n = 0; n < 2; ++n) { const f32x4 x = v[ai][bj][m][n]; s += (x[0] + x[1]) + (x[2] + x[3]); }
                s += __shfl_xor(s, 16); s += __shfl_xor(s, 32);
                const float mw = s * (1.0f / 64.0f); float q = 0.f;
#pragma unroll
                for (int bj = 0; bj < 2; ++bj)
#pragma unroll
                    for (int n = 0; n < 2; ++n) { const f32x4 d = v[ai][bj][m][n] - mw; q += (d[0] * d[0] + d[1] * d[1]) + (d[2] * d[2] + d[3] * d[3]); }
                q += __shfl_xor(q, 16); q += __shfl_xor(q, 32);
                if (fq == 0) P[(ai * HALF + wr * 64 + m * 16 + fr) * 4 + wc] = (f32x2v){mw, q};
            }
        asm volatile("s_waitcnt lgkmcnt(0)" ::: "memory"); __builtin_amdgcn_s_barrier(); asm volatile("" ::: "memory");
#if defined(BROKEN_EXCHANGE_NO_WAIT)
#warning BROKEN CONTROL BUILD: the row-statistics exchange does not wait; results are wrong by design
        if (blockIdx.x >= 64) { const long long t0_ = clock64(); while (clock64() - t0_ < 60000) __builtin_amdgcn_s_sleep(8); }
#endif
        const int row = wid * 32 + (lane & 31);
        if (lane < 32) {
            const f32x2v a = P[row * 4 + 0], b = P[row * 4 + 1], c = P[row * 4 + 2], d = P[row * 4 + 3];
            const float mt = (a.x + b.x + c.x + d.x) * 0.25f;
            const float da = a.x - mt, db = b.x - mt, dc = c.x - mt, dd = d.x - mt;
            const float m2 = (a.y + b.y) + (c.y + d.y) + 64.0f * ((da * da + db * db) + (dc * dc + dd * dd));
            unsigned long long* slot = (unsigned long long*)xbuf + ((size_t)(u.pm * BM + row) * 4 + u.pn);
            __hip_atomic_store(slot, ((unsigned long long)__float_as_uint(m2) << 32) | __float_as_uint(mt), __ATOMIC_RELAXED, __HIP_MEMORY_SCOPE_AGENT);
        }
        asm volatile("s_waitcnt vmcnt(0)" ::: "memory");
        if (lane == 0) __hip_atomic_fetch_add(cnt + 64 * u.pm, 1u, __ATOMIC_RELAXED, __HIP_MEMORY_SCOPE_AGENT);
        if (wid == 0) {
            bool dead = false; const unsigned long long t0 = __builtin_amdgcn_s_memrealtime(); const unsigned want = 8u * (unsigned)ntn;
            for (;;) {
#if defined(BROKEN_EXCHANGE_NO_WAIT)
                break;
#endif
                if ((unsigned)__builtin_amdgcn_readfirstlane(__hip_atomic_load(cnt + 64 * u.pm, __ATOMIC_RELAXED, __HIP_MEMORY_SCOPE_AGENT)) >= want) break;
                if (__builtin_amdgcn_s_memrealtime() - t0 > 2000000ull) {
                    if (lane == 0) { unsigned expect = 0u; __hip_atomic_compare_exchange_strong(tmo + 1, &expect, code | (unsigned)(u.pm & 0xff), __ATOMIC_RELAXED, __ATOMIC_RELAXED, __HIP_MEMORY_SCOPE_AGENT);
                                     __hip_atomic_store(tmo, 1u, __ATOMIC_RELAXED, __HIP_MEMORY_SCOPE_AGENT); }
                    dead = true; break; }
                __builtin_amdgcn_s_sleep(2);
            }
            __builtin_amdgcn_fence(__ATOMIC_ACQUIRE, "agent");
            if (lane == 0) flag[0] = dead ? 1u : 0u;
        }
        asm volatile("s_waitcnt vmcnt(0) lgkmcnt(0)" ::: "memory"); __builtin_amdgcn_s_barrier(); asm volatile("" ::: "memory");
        const bool bad = flag[0] != 0u;
        if (lane < 32) {
            const unsigned long long* slot = (const unsigned long long*)xbuf + (size_t)(u.pm * BM + row) * 4; float mt[4], m2[4]; float ms = 0.f;
#pragma unroll
            for (int t = 0; t < 4; ++t) { if (t < ntn) { const unsigned long long w = __hip_atomic_load(slot + t, __ATOMIC_RELAXED, __HIP_MEMORY_SCOPE_AGENT); mt[t] = __uint_as_float((unsigned)w); m2[t] = __uint_as_float((unsigned)(w >> 32)); } else { mt[t] = 0.f; m2[t] = 0.f; } ms += mt[t]; }
            const float mean = ms / (float)ntn; float q = 0.f;
#pragma unroll
            for (int t = 0; t < 4; ++t) if (t < ntn) { const float dm = mt[t] - mean; q += m2[t] + 256.0f * dm * dm; }
            S[row] = (f32x2v){mean, 1.0f / sqrtf(q / (256.0f * (float)ntn) + eps)};
        }
        asm volatile("s_waitcnt lgkmcnt(0)" ::: "memory"); __builtin_amdgcn_s_barrier(); asm volatile("" ::: "memory");
        return bad;
    }
};
struct EpiLnRes {
    static constexpr bool PERM = false, AFTER_DRAIN = true;
    const float* base; float* out; int ldc; const float* bias; PanelStats st; unsigned poison;
    __device__ __forceinline__ void fused(f32x4 (&acc)[2][2][4][2], const Unit& u, int wr, int wc, int fr, int fq, PG8_LAS unsigned char* lds, int wid, int lane) const {
        typedef float f32x2v __attribute__((ext_vector_type(2)));
        const PG8_LAS f32x2v* S = (const PG8_LAS f32x2v*)(lds + 8192);
        const int col0 = u.pn * BM + wc * 32 + 4 * fq;
#pragma unroll
        for (int bj = 0; bj < 2; ++bj)
#pragma unroll
            for (int n = 0; n < 2; ++n) { const f32x4 bv = bias ? *(const f32x4*)(bias + col0 + bj * HALF + n * 16) : (f32x4){0.f, 0.f, 0.f, 0.f};
#pragma unroll
                for (int ai = 0; ai < 2; ++ai)
#pragma unroll
                    for (int m = 0; m < 4; ++m) acc[ai][bj][m][n] += bv; }
        f32x4 pre[4][2][2];
#pragma unroll
        for (int m = 0; m < 4; ++m) { const size_t off = (size_t)(u.pm * BM + wr * 64 + m * 16 + fr) * ldc + col0;
#pragma unroll
            for (int bj = 0; bj < 2; ++bj)
#pragma unroll
                for (int n = 0; n < 2; ++n) pre[m][bj][n] = *(const f32x4*)(base + off + bj * HALF + n * 16); }
        const bool bad = st.run(acc, u, wr, wc, fr, fq, lds, wid, lane) || poison != 0u;
        const float qnan = __builtin_nanf("");
#pragma unroll
        for (int ai = 0; ai < 2; ++ai)
#pragma unroll
            for (int m = 0; m < 4; ++m) { const int r = ai * HALF + wr * 64 + m * 16 + fr; const f32x2v sr = S[r]; const size_t off = (size_t)(u.pm * BM + r) * ldc + col0;
#pragma unroll
                for (int bj = 0; bj < 2; ++bj)
#pragma unroll
                    for (int n = 0; n < 2; ++n) { const f32x4 bs = ai == 0 ? pre[m][bj][n] : *(const f32x4*)(base + off + bj * HALF + n * 16); f32x4 o = bs + (acc[ai][bj][m][n] - sr.x) * sr.y;
                        if (bad) o = (f32x4){qnan, qnan, qnan, qnan}; *(f32x4*)(out + off + bj * HALF + n * 16) = o; }
                if (m & 1) asm volatile("" ::: "memory"); }
    }
};
struct EpiLnResLn {
    static constexpr bool PERM = false, AFTER_DRAIN = true;
    const float* base; float* out; bf16_t* xn; int ldc; const float* bias; PanelStats st1, st2; unsigned poison;
    __device__ __forceinline__ void fused(f32x4 (&acc)[2][2][4][2], const Unit& u, int wr, int wc, int fr, int fq, PG8_LAS unsigned char* lds, int wid, int lane) const {
        typedef float f32x2v __attribute__((ext_vector_type(2))); typedef unsigned u32x2v __attribute__((ext_vector_type(2)));
        const PG8_LAS f32x2v* S = (const PG8_LAS f32x2v*)(lds + 8192);
        const int col0 = u.pn * BM + wc * 32 + 4 * fq;
#pragma unroll
        for (int bj = 0; bj < 2; ++bj)
#pragma unroll
            for (int n = 0; n < 2; ++n) { const f32x4 bv = bias ? *(const f32x4*)(bias + col0 + bj * HALF + n * 16) : (f32x4){0.f, 0.f, 0.f, 0.f};
#pragma unroll
                for (int ai = 0; ai < 2; ++ai)
#pragma unroll
                    for (int m = 0; m < 4; ++m) acc[ai][bj][m][n] += bv; }
        bool bad = st1.run(acc, u, wr, wc, fr, fq, lds, wid, lane) || poison != 0u;
        const float qnan = __builtin_nanf("");
#pragma unroll
        for (int ai = 0; ai < 2; ++ai)
#pragma unroll
            for (int m = 0; m < 4; ++m) { const int r = ai * HALF + wr * 64 + m * 16 + fr; const f32x2v sr = S[r]; const size_t off = (size_t)(u.pm * BM + r) * ldc + col0;
#pragma unroll
                for (int bj = 0; bj < 2; ++bj)
#pragma unroll
                    for (int n = 0; n < 2; ++n) { const f32x4 bs = *(const f32x4*)(base + off + bj * HALF + n * 16); acc[ai][bj][m][n] = bs + (acc[ai][bj][m][n] - sr.x) * sr.y; }
                asm volatile("" : "+v"(acc[ai][0][m][0]), "+v"(acc[ai][0][m][1]), "+v"(acc[ai][1][m][0]), "+v"(acc[ai][1][m][1]));
                if (m & 1) asm volatile("" ::: "memory"); }
        const bool bad1 = bad;
        bad = st2.run(acc, u, wr, wc, fr, fq, lds, wid, lane) || bad;
#pragma unroll
        for (int ai = 0; ai < 2; ++ai)
#pragma unroll
            for (int m = 0; m < 4; ++m) { const int r = ai * HALF + wr * 64 + m * 16 + fr; const f32x2v sr = S[r]; const size_t off = (size_t)(u.pm * BM + r) * ldc + col0;
#pragma unroll
                for (int bj = 0; bj < 2; ++bj)
#pragma unroll
                    for (int n = 0; n < 2; ++n) { const f32x4 x1 = acc[ai][bj][m][n]; *(f32x4*)(out + off + bj * HALF + n * 16) = bad1 ? (f32x4){qnan, qnan, qnan, qnan} : x1;
                        const f32x4 o = (x1 - sr.x) * sr.y; u32x2v w; w.x = cvt_pk_bf16(o[0], o[1]); w.y = cvt_pk_bf16(o[2], o[3]);
                        if (bad) { w.x = 0x7fc07fc0u; w.y = 0x7fc07fc0u; } *(u32x2v*)(xn + off + bj * HALF + n * 16) = w; }
                asm volatile("" ::: "memory"); }
    }
};

template <class E, class = void> struct MidSeg { static constexpr int v = 0; };
template <class E> struct MidSeg<E, decltype((void)E::MIDSEG)> { static constexpr int v = E::MIDSEG; };
template <class Epi, class Sched, bool ALIGN_EPI = false, bool SP2 = false>
__device__ __forceinline__ void gemm_phase(PG8_LAS unsigned char* lds, const Gemm g, const Sched& S, const Epi& E, int wid_in) {
    int lane_; asm volatile("v_mbcnt_lo_u32_b32 %0, -1, 0\n\tv_mbcnt_hi_u32_b32 %0, -1, %0" : "=v"(lane_));
    const int wid = wid_in, lane = lane_, tid = wid * 64 + lane, wr = wid >> 2, wc = wid & 3, fr = lane & 15, fq = lane >> 4;
    const int K = g.K, nt = K / BK;
    unsigned voffA[2], voffB[2];
#pragma unroll
    for (int i = 0; i < 2; ++i) { int R, C; stage_rc(tid * 16 + i * 8192, R, C); const int Rb = Epi::PERM ? ((R & ~31) + perm32(R & 31)) : R;
        voffA[i] = (unsigned)(R * K + C) * 2u; voffB[i] = (unsigned)(Rb * K + C) * 2u; }
    const size_t kstep = (size_t)(BK * 2);
    const size_t hstep = (size_t)HALF * K * 2;
    const size_t tstep = 2 * hstep;
    const unsigned ldsw = (unsigned)wid * 1024u;
    const int aoff = lds_byte(wr * 64 + fr, fq * 8), boff = lds_byte(wc * 32 + fr, fq * 8);
#define PG8_SA(b, h) (((b) * 2 + (h)) * HTB)
#define PG8_SB(b, h) ((4 + (b) * 2 + (h)) * HTB)
#define PG8_STAGE(bufoff, gbase, voff) do { _Pragma("unroll") for (int _i = 0; _i < 2; ++_i) \
        __builtin_amdgcn_global_load_lds((const unsigned*)((const char*)(gbase) + (voff)[_i]), (PG8_LAS unsigned*)(lds + (bufoff) + ldsw + _i * 8192), 16, 0, 0); } while (0)
#define PG8_LDA(dst, b, h) do { _Pragma("unroll") for (int m = 0; m < 4; ++m) _Pragma("unroll") for (int k = 0; k < 2; ++k) dst[m][k] = *(const PG8_LAS bf16x8*)(lds + PG8_SA(b, h) + aoff + m * 2048 + k * 1024); } while (0)
#define PG8_LDB(dst, b, h) do { _Pragma("unroll") for (int n = 0; n < 2; ++n) _Pragma("unroll") for (int k = 0; k < 2; ++k) dst[n][k] = *(const PG8_LAS bf16x8*)(lds + PG8_SB(b, h) + boff + n * 2048 + k * 1024); } while (0)
#define PG8_MMA(ai, bj, At, Bt) do { __builtin_amdgcn_s_setprio(1); _Pragma("unroll") for (int m = 0; m < 4; ++m) _Pragma("unroll") for (int n = 0; n < 2; ++n) _Pragma("unroll") for (int k = 0; k < 2; ++k) \
        acc[ai][bj][m][n] = __builtin_amdgcn_mfma_f32_16x16x32_bf16(Bt[n][k], At[m][k], acc[ai][bj][m][n], 0, 0, 0); __builtin_amdgcn_s_setprio(0); } while (0)
#define PG8_WAIT_V(n) asm volatile("s_waitcnt vmcnt(" #n ")" ::: "memory")
#define PG8_WAIT_L(n) asm volatile("s_waitcnt lgkmcnt(" #n ")" ::: "memory")
#define PG8_BAR __builtin_amdgcn_s_barrier()
#define PG8_SCHED __builtin_amdgcn_sched_barrier(0)
    Unit cur, nxt; int ui = 0;
    if (!S.next(0, cur)) return;
    f32x4 acc[2][2][4][2];
#pragma unroll
    for (int a = 0; a < 2; ++a)
#pragma unroll
        for (int b = 0; b < 2; ++b)
#pragma unroll
            for (int m = 0; m < 4; ++m)
#pragma unroll
                for (int n = 0; n < 2; ++n) acc[a][b][m][n] = (f32x4){0.f, 0.f, 0.f, 0.f};
    bf16x8 At[4][2], B0[2][2], B1[2][2];
    const char* cA = (const char*)g.A + (size_t)cur.pm * tstep; const char* cB = (const char*)g.Bt + (size_t)cur.pn * tstep;
    S.a_ready(cur);
    if constexpr (SP2) {
        PG8_STAGE(PG8_SB(0, 0), cB, voffB); PG8_STAGE(PG8_SB(0, 1), cB + hstep, voffB); PG8_STAGE(PG8_SA(0, 0), cA, voffA); PG8_STAGE(PG8_SA(0, 1), cA + hstep, voffA);
        if (wr == 1) PG8_BAR;
        PG8_WAIT_V(2); PG8_BAR;
        PG8_STAGE(PG8_SB(1, 0), cB + kstep, voffB); PG8_STAGE(PG8_SA(1, 0), cA + kstep, voffA); PG8_STAGE(PG8_SB(1, 1), cB + hstep + kstep, voffB);
        PG8_WAIT_V(6); PG8_BAR;
    } else {
        PG8_STAGE(PG8_SB(0, 0), cB, voffB); PG8_STAGE(PG8_SA(0, 0), cA, voffA); PG8_STAGE(PG8_SB(0, 1), cB + hstep, voffB); PG8_STAGE(PG8_SA(0, 1), cA + hstep, voffA);
        if (wr == 1) PG8_BAR;
        PG8_WAIT_V(4); PG8_BAR;
        PG8_STAGE(PG8_SB(1, 0), cB + kstep, voffB); PG8_STAGE(PG8_SA(1, 0), cA + kstep, voffA); PG8_STAGE(PG8_SB(1, 1), cB + hstep + kstep, voffB);
        PG8_WAIT_V(6); PG8_BAR;
    }
    for (;;) {
        const bool has_next = S.next(ui + 1, nxt);
        const char* nA = has_next ? (const char*)g.A + (size_t)nxt.pm * tstep : cA; const char* nB = has_next ? (const char*)g.Bt + (size_t)nxt.pn * tstep : cB;
        for (int t = 0; t < nt; t += 2) {
            if constexpr (MidSeg<Epi>::v > 0) { if (t > 0 && t % MidSeg<Epi>::v == 0) E.mid(acc, cur, t / MidSeg<Epi>::v, wr, wc, fr, fq); }
            const bool last = (t == nt - 2);
            const char* a1 = cA + (size_t)(t + 1) * kstep;
            const char* a2 = last ? nA : cA + (size_t)(t + 2) * kstep; const char* b2 = last ? nB : cB + (size_t)(t + 2) * kstep;
            const char* a3 = a2 + kstep; const char* b3 = b2 + kstep;
            if (last && has_next) S.a_ready(nxt);
            if constexpr (SP2) {
            PG8_LDB(B0, 0, 0); PG8_LDB(B1, 0, 1); PG8_SCHED; PG8_LDA(At, 0, 0); PG8_STAGE(PG8_SA(1, 1), a1 + hstep, voffA);
            PG8_WAIT_V(8); PG8_WAIT_L(0); PG8_BAR; PG8_MMA(0, 0, At, B0); PG8_MMA(0, 1, At, B1); PG8_BAR; PG8_SCHED;
            PG8_LDA(At, 0, 1); PG8_STAGE(PG8_SB(0, 0), b2, voffB); PG8_STAGE(PG8_SB(0, 1), b2 + hstep, voffB); PG8_STAGE(PG8_SA(0, 0), a2, voffA);
            PG8_WAIT_V(8); PG8_WAIT_L(0); PG8_BAR; PG8_MMA(1, 0, At, B0); PG8_MMA(1, 1, At, B1); PG8_BAR; PG8_SCHED;
            PG8_LDB(B0, 1, 0); PG8_LDB(B1, 1, 1); PG8_SCHED; PG8_LDA(At, 1, 0); PG8_STAGE(PG8_SA(0, 1), a2 + hstep, voffA);
            PG8_WAIT_V(8); PG8_WAIT_L(0); PG8_BAR; PG8_MMA(0, 0, At, B0); PG8_MMA(0, 1, At, B1); PG8_BAR; PG8_SCHED;
            PG8_LDA(At, 1, 1); PG8_STAGE(PG8_SB(1, 0), b3, voffB); PG8_STAGE(PG8_SB(1, 1), b3 + hstep, voffB); PG8_STAGE(PG8_SA(1, 0), a3, voffA);
            PG8_WAIT_V(8); PG8_WAIT_L(0); PG8_BAR; PG8_MMA(1, 0, At, B0); PG8_MMA(1, 1, At, B1); PG8_BAR; PG8_SCHED;
            } else {
            PG8_LDB(B0, 0, 0); PG8_SCHED; PG8_LDA(At, 0, 0); PG8_STAGE(PG8_SA(1, 1), a1 + hstep, voffA);
            PG8_WAIT_L(8); PG8_BAR; PG8_WAIT_L(0); PG8_MMA(0, 0, At, B0); PG8_BAR; PG8_SCHED;
            PG8_LDB(B1, 0, 1); PG8_STAGE(PG8_SB(0, 0), b2, voffB);
            PG8_BAR; PG8_WAIT_L(0); PG8_MMA(0, 1, At, B1); PG8_BAR;
            PG8_LDA(At, 0, 1); PG8_STAGE(PG8_SA(0, 0), a2, voffA);
            PG8_BAR; PG8_WAIT_L(0); PG8_MMA(1, 0, At, B0); PG8_BAR; PG8_SCHED;
            PG8_STAGE(PG8_SB(0, 1), b2 + hstep, voffB);
            PG8_WAIT_V(6); PG8_BAR; PG8_MMA(1, 1, At, B1); PG8_BAR;
            PG8_LDB(B0, 1, 0); PG8_SCHED; PG8_LDA(At, 1, 0); PG8_STAGE(PG8_SA(0, 1), a2 + hstep, voffA);
            PG8_WAIT_L(8); PG8_BAR; PG8_WAIT_L(0); PG8_MMA(0, 0, At, B0); PG8_BAR; PG8_SCHED;
            PG8_LDB(B1, 1, 1); PG8_STAGE(PG8_SB(1, 0), b3, voffB);
            PG8_BAR; PG8_WAIT_L(0); PG8_MMA(0, 1, At, B1); PG8_BAR;
            PG8_LDA(At, 1, 1); PG8_STAGE(PG8_SA(1, 0), a3, voffA);
            PG8_BAR; PG8_WAIT_L(0); PG8_MMA(1, 0, At, B0); PG8_BAR; PG8_SCHED;
            PG8_STAGE(PG8_SB(1, 1), b3 + hstep, voffB);
            PG8_WAIT_V(6); PG8_BAR; PG8_MMA(1, 1, At, B1); PG8_BAR;
            }
        }
        if constexpr (ALIGN_EPI) { if (wr == 0) PG8_BAR; }
        if constexpr (!Epi::AFTER_DRAIN) { E(acc, cur, wr, wc, fr, fq); S.done(cur); }
        if (!has_next) break;
#pragma unroll
        for (int a = 0; a < 2; ++a)
#pragma unroll
            for (int b = 0; b < 2; ++b)
#pragma unroll
                for (int m = 0; m < 4; ++m)
#pragma unroll
                    for (int n = 0; n < 2; ++n) acc[a][b][m][n] = (f32x4){0.f, 0.f, 0.f, 0.f};
        cur = nxt; cA = nA; cB = nB; ++ui;
        if constexpr (ALIGN_EPI) { if (wr == 1) PG8_BAR; }
    }
    PG8_WAIT_V(0);
    if constexpr (!ALIGN_EPI) { if (wr == 0) PG8_BAR; }
    PG8_BAR;
    if constexpr (Epi::AFTER_DRAIN) { E.fused(acc, cur, wr, wc, fr, fq, lds, wid, lane); S.done(cur); }
#undef PG8_SA
#undef PG8_SB
#undef PG8_STAGE
#undef PG8_LDA
#undef PG8_LDB
#undef PG8_MMA
#undef PG8_WAIT_V
#undef PG8_WAIT_L
#undef PG8_BAR
#undef PG8_SCHED
}
}
namespace pg8 {
struct Gemm8 { const unsigned char* A; const unsigned char* Bt; int M, N, K; int scale_a, scale_b; };
template <class Epi, class Sched, bool ALIGN_EPI = false, bool SP2 = false>
__device__ __forceinline__ void gemm_phase_f8(PG8_LAS unsigned char* lds, const Gemm8 g, const Sched& S, const Epi& E, int wid_in) {
    int lane_; asm volatile("v_mbcnt_lo_u32_b32 %0, -1, 0\n\tv_mbcnt_hi_u32_b32 %0, -1, %0" : "=v"(lane_));
    const int wid = wid_in, lane = lane_, tid = wid * 64 + lane, wr = wid >> 2, wc = wid & 3, fr = lane & 15, fq = lane >> 4;
    const int K = g.K, nt = K / 128;
    unsigned voffA[2], voffB[2];
#pragma unroll
    for (int i = 0; i < 2; ++i) { int R, C; stage_rc(tid * 16 + i * 8192, R, C); const int Rb = Epi::PERM ? ((R & ~31) + perm32(R & 31)) : R;
        voffA[i] = (unsigned)(R * K + 2 * C); voffB[i] = (unsigned)(Rb * K + 2 * C); }
    const size_t kstep = (size_t)(BK * 2);
    const size_t hstep = (size_t)HALF * K;
    const size_t tstep = 2 * hstep;
    const unsigned ldsw = (unsigned)wid * 1024u;
    const int aoff = lds_byte(wr * 64 + fr, fq * 16), boff = lds_byte(wc * 32 + fr, fq * 16);
#define PG8_SA(b, h) (((b) * 2 + (h)) * HTB)
#define PG8_SB(b, h) ((4 + (b) * 2 + (h)) * HTB)
#define PG8_STAGE(bufoff, gbase, voff) do { _Pragma("unroll") for (int _i = 0; _i < 2; ++_i) { unsigned keep_; \
        asm volatile("s_mov_b32 %0, m0\n\ts_mov_b32 m0, %3\n\ts_nop 0\n\tglobal_load_lds_dwordx4 %1, %2\n\ts_mov_b32 m0, %0" : "=&s"(keep_) : "v"((voff)[_i]), "s"((const char*)(gbase)), "s"((unsigned)(size_t)(lds + (bufoff) + ldsw + _i * 8192)) : "memory"); } } while (0)
#define PG8_LDA(dst, b, h) do { _Pragma("unroll") for (int m = 0; m < 4; ++m) { const u32x4 lo_ = *(const PG8_LAS u32x4*)(lds + PG8_SA(b, h) + aoff + m * 2048), hi_ = *(const PG8_LAS u32x4*)(lds + PG8_SA(b, h) + aoff + m * 2048 + 16); dst[m] = __builtin_bit_cast(i32x8, __builtin_shufflevector(lo_, hi_, 0, 1, 2, 3, 4, 5, 6, 7)); } } while (0)
#define PG8_LDB(dst, b, h) do { _Pragma("unroll") for (int n = 0; n < 2; ++n) { const u32x4 lo_ = *(const PG8_LAS u32x4*)(lds + PG8_SB(b, h) + boff + n * 2048), hi_ = *(const PG8_LAS u32x4*)(lds + PG8_SB(b, h) + boff + n * 2048 + 16); dst[n] = __builtin_bit_cast(i32x8, __builtin_shufflevector(lo_, hi_, 0, 1, 2, 3, 4, 5, 6, 7)); } } while (0)
#define PG8_MMA(ai, bj, At, Bt) do { __builtin_amdgcn_s_setprio(1); _Pragma("unroll") for (int m = 0; m < 4; ++m) _Pragma("unroll") for (int n = 0; n < 2; ++n) \
        acc[ai][bj][m][n] = __builtin_amdgcn_mfma_scale_f32_16x16x128_f8f6f4(Bt[n], At[m], acc[ai][bj][m][n], 0, 0, 0, g.scale_b, 0, g.scale_a); __builtin_amdgcn_s_setprio(0); } while (0)
#define PG8_WAIT_V(n) asm volatile("s_waitcnt vmcnt(" #n ")" ::: "memory")
#define PG8_WAIT_L(n) asm volatile("s_waitcnt lgkmcnt(" #n ")" ::: "memory")
#define PG8_BAR __builtin_amdgcn_s_barrier()
#define PG8_SCHED __builtin_amdgcn_sched_barrier(0)
    Unit cur, nxt; int ui = 0;
    if (!S.next(0, cur)) return;
    f32x4 acc[2][2][4][2];
#pragma unroll
    for (int a = 0; a < 2; ++a)
#pragma unroll
        for (int b = 0; b < 2; ++b)
#pragma unroll
            for (int m = 0; m < 4; ++m)
#pragma unroll
                for (int n = 0; n < 2; ++n) acc[a][b][m][n] = (f32x4){0.f, 0.f, 0.f, 0.f};
    typedef int i32x8 __attribute__((ext_vector_type(8))); i32x8 At[4], B0[2], B1[2];
    const char* cA = (const char*)g.A + (size_t)cur.pm * tstep; const char* cB = (const char*)g.Bt + (size_t)cur.pn * tstep;
    S.a_ready(cur);
    if constexpr (SP2) {
        PG8_STAGE(PG8_SB(0, 0), cB, voffB); PG8_STAGE(PG8_SB(0, 1), cB + hstep, voffB); PG8_STAGE(PG8_SA(0, 0), cA, voffA); PG8_STAGE(PG8_SA(0, 1), cA + hstep, voffA);
        if (wr == 1) PG8_BAR;
        PG8_WAIT_V(2); PG8_BAR;
        PG8_STAGE(PG8_SB(1, 0), cB + kstep, voffB); PG8_STAGE(PG8_SA(1, 0), cA + kstep, voffA); PG8_STAGE(PG8_SB(1, 1), cB + hstep + kstep, voffB);
        PG8_WAIT_V(6); PG8_BAR;
    } else {
        PG8_STAGE(PG8_SB(0, 0), cB, voffB); PG8_STAGE(PG8_SA(0, 0), cA, voffA); PG8_STAGE(PG8_SB(0, 1), cB + hstep, voffB); PG8_STAGE(PG8_SA(0, 1), cA + hstep, voffA);
        if (wr == 1) PG8_BAR;
        PG8_WAIT_V(4); PG8_BAR;
        PG8_STAGE(PG8_SB(1, 0), cB + kstep, voffB); PG8_STAGE(PG8_SA(1, 0), cA + kstep, voffA); PG8_STAGE(PG8_SB(1, 1), cB + hstep + kstep, voffB);
        PG8_WAIT_V(6); PG8_BAR;
    }
    for (;;) {
        const bool has_next = S.next(ui + 1, nxt);
        const char* nA = has_next ? (const char*)g.A + (size_t)nxt.pm * tstep : cA; const char* nB = has_next ? (const char*)g.Bt + (size_t)nxt.pn * tstep : cB;
#pragma unroll 1
        for (int t = 0; t < nt; t += 2) {
            const bool last = (t == nt - 2);
            const char* a1 = cA + (size_t)(t + 1) * kstep;
            const char* a2 = last ? nA : cA + (size_t)(t + 2) * kstep; const char* b2 = last ? nB : cB + (size_t)(t + 2) * kstep;
            const char* a3 = a2 + kstep; const char* b3 = b2 + kstep;
            if (last && has_next) S.a_ready(nxt);
            if constexpr (SP2) {
            PG8_LDB(B0, 0, 0); PG8_LDB(B1, 0, 1); PG8_SCHED; PG8_LDA(At, 0, 0); PG8_STAGE(PG8_SA(1, 1), a1 + hstep, voffA);
            PG8_WAIT_V(8); PG8_WAIT_L(0); PG8_BAR; PG8_MMA(0, 0, At, B0); PG8_MMA(0, 1, At, B1); PG8_BAR; PG8_SCHED;
            PG8_LDA(At, 0, 1); PG8_STAGE(PG8_SB(0, 0), b2, voffB); PG8_STAGE(PG8_SB(0, 1), b2 + hstep, voffB); PG8_STAGE(PG8_SA(0, 0), a2, voffA);
            PG8_WAIT_V(8); PG8_WAIT_L(0); PG8_BAR; PG8_MMA(1, 0, At, B0); PG8_MMA(1, 1, At, B1); PG8_BAR; PG8_SCHED;
            PG8_LDB(B0, 1, 0); PG8_LDB(B1, 1, 1); PG8_SCHED; PG8_LDA(At, 1, 0); PG8_STAGE(PG8_SA(0, 1), a2 + hstep, voffA);
            PG8_WAIT_V(8); PG8_WAIT_L(0); PG8_BAR; PG8_MMA(0, 0, At, B0); PG8_MMA(0, 1, At, B1); PG8_BAR; PG8_SCHED;
            PG8_LDA(At, 1, 1); PG8_STAGE(PG8_SB(1, 0), b3, voffB); PG8_STAGE(PG8_SB(1, 1), b3 + hstep, voffB); PG8_STAGE(PG8_SA(1, 0), a3, voffA);
            PG8_WAIT_V(8); PG8_WAIT_L(0); PG8_BAR; PG8_MMA(1, 0, At, B0); PG8_MMA(1, 1, At, B1); PG8_BAR; PG8_SCHED;
            } else {
            PG8_LDB(B0, 0, 0); PG8_SCHED; PG8_LDA(At, 0, 0); PG8_STAGE(PG8_SA(1, 1), a1 + hstep, voffA);
            PG8_WAIT_L(8); PG8_BAR; PG8_WAIT_L(0); PG8_MMA(0, 0, At, B0); PG8_BAR; PG8_SCHED;
            PG8_LDB(B1, 0, 1); PG8_STAGE(PG8_SB(0, 0), b2, voffB);
            PG8_BAR; PG8_WAIT_L(0); PG8_MMA(0, 1, At, B1); PG8_BAR;
            PG8_LDA(At, 0, 1); PG8_STAGE(PG8_SA(0, 0), a2, voffA);
            PG8_BAR; PG8_WAIT_L(0); PG8_MMA(1, 0, At, B0); PG8_BAR; PG8_SCHED;
            PG8_STAGE(PG8_SB(0, 1), b2 + hstep, voffB);
            PG8_WAIT_V(6); PG8_BAR; PG8_MMA(1, 1, At, B1); PG8_BAR;
            PG8_LDB(B0, 1, 0); PG8_SCHED; PG8_LDA(At, 1, 0); PG8_STAGE(PG8_SA(0, 1), a2 + hstep, voffA);
            PG8_WAIT_L(8); PG8_BAR; PG8_WAIT_L(0); PG8_MMA(0, 0, At, B0); PG8_BAR; PG8_SCHED;
            PG8_LDB(B1, 1, 1); PG8_STAGE(PG8_SB(1, 0), b3, voffB);
            PG8_BAR; PG8_WAIT_L(0); PG8_MMA(0, 1, At, B1); PG8_BAR;
            PG8_LDA(At, 1, 1); PG8_STAGE(PG8_SA(1, 0), a3, voffA);
            PG8_BAR; PG8_WAIT_L(0); PG8_MMA(1, 0, At, B0); PG8_BAR; PG8_SCHED;
            PG8_STAGE(PG8_SB(1, 1), b3 + hstep, voffB);
            PG8_WAIT_V(6); PG8_BAR; PG8_MMA(1, 1, At, B1); PG8_BAR;
            }
        }
        if constexpr (ALIGN_EPI) { if (wr == 0) PG8_BAR; }
        if constexpr (!Epi::AFTER_DRAIN) { int l2_; asm volatile("v_mbcnt_lo_u32_b32 %0, -1, 0\n\tv_mbcnt_hi_u32_b32 %0, -1, %0" : "=v"(l2_));
            E(acc, cur, wr, wc, l2_ & 15, l2_ >> 4); S.done(cur); }
        if (!has_next) break;
#pragma unroll
        for (int a = 0; a < 2; ++a)
#pragma unroll
            for (int b = 0; b < 2; ++b)
#pragma unroll
                for (int m = 0; m < 4; ++m)
#pragma unroll
                    for (int n = 0; n < 2; ++n) acc[a][b][m][n] = (f32x4){0.f, 0.f, 0.f, 0.f};
        cur = nxt; cA = nA; cB = nB; ++ui;
        if constexpr (ALIGN_EPI) { if (wr == 1) PG8_BAR; }
    }
    PG8_WAIT_V(0);
    if constexpr (!ALIGN_EPI) { if (wr == 0) PG8_BAR; }
    PG8_BAR;
    if constexpr (Epi::AFTER_DRAIN) { E.fused(acc, cur, wr, wc, fr, fq, lds, wid, lane); S.done(cur); }
#undef PG8_SA
#undef PG8_SB
#undef PG8_STAGE
#undef PG8_LDA
#undef PG8_LDB
#undef PG8_MMA
#undef PG8_WAIT_V
#undef PG8_WAIT_L
#undef PG8_BAR
#undef PG8_SCHED
}
}
#define GAS __attribute__((address_space(1)))
#define LAS __attribute__((address_space(3)))
typedef unsigned short bf16;
typedef unsigned v4u __attribute__((ext_vector_type(4)));
typedef float f32x4 __attribute__((ext_vector_type(4)));
typedef short bf16x8 __attribute__((ext_vector_type(8)));
typedef GAS unsigned gu32;
typedef GAS unsigned long long gu64;
#define RLX_AGENT __ATOMIC_RELAXED, __HIP_MEMORY_SCOPE_AGENT
#define LDS_WAIT() asm volatile("s_waitcnt lgkmcnt(0)" ::: "memory")
#define VM_WAIT() asm volatile("s_waitcnt vmcnt(0)" ::: "memory")
__device__ __forceinline__ unsigned long long rt() { return __builtin_amdgcn_s_memrealtime(); }
__device__ __forceinline__ unsigned f2bf(float f) { unsigned u = __builtin_bit_cast(unsigned, f); return (u + 0x7fffu + ((u >> 16) & 1u)) >> 16; }
__device__ __forceinline__ unsigned pk2(float lo, float hi) { return f2bf(lo) | (f2bf(hi) << 16); }

#define XB_TMO      128
#define XB_XCNT(j)  (256  + 64 * (j))
#define XB_XSUB(j)  (1280 + 64 * (j))
#define XB_XGEN(j)  (2304 + 64 * (j))
#define XB_TOP      3328
#define XB_TOPGEN   3392
#define XCD_BAR_WORDS 3456
#define XB_SPIN_CAP (1u << 18)

__device__ __forceinline__ unsigned xb_ld(unsigned* p)              { return __hip_atomic_load(p, __ATOMIC_RELAXED, __HIP_MEMORY_SCOPE_AGENT); }
__device__ __forceinline__ unsigned xb_add(unsigned* p, unsigned v) { return __hip_atomic_fetch_add(p, v, __ATOMIC_RELAXED, __HIP_MEMORY_SCOPE_AGENT); }
__device__ __forceinline__ unsigned xb_xcc_id() { return (unsigned)__builtin_amdgcn_s_getreg((3 << 11) | 20) & 0xFu; }
#define XB_SPIN(cond, bar) do { unsigned _sp = 0; while (cond) { __builtin_amdgcn_s_sleep(1); \
    if ((++_sp & 255u) == 0u) { if (xb_ld(&(bar)[XB_TMO])) break; if (_sp > XB_SPIN_CAP) { atomicAdd(&(bar)[XB_TMO], 1u); break; } } } } while (0)

struct XcdBarrier {
    int wv;
    unsigned* bar; unsigned x;
    volatile LAS unsigned* st;
};

__device__ __forceinline__ int xb_lane_id() { int l; asm volatile("v_mbcnt_lo_u32_b32 %0, -1, 0\n\tv_mbcnt_hi_u32_b32 %0, -1, %0" : "=v"(l)); return l; }
__device__ __forceinline__ XcdBarrier xcd_barrier_post(unsigned* bar, volatile LAS unsigned* st, int wv) {
    XcdBarrier b; b.wv = wv; b.bar = bar; b.x = xb_xcc_id(); b.st = st;
    if (wv == 0 && xb_lane_id() == 0) (void)xb_add(&bar[XB_XCNT(b.x)], 1u);
    return b;
}
__device__ __forceinline__ void xcd_barrier_complete(unsigned* bar, unsigned x, unsigned& nloc, unsigned& nx) {
    const unsigned G = gridDim.x * gridDim.y * gridDim.z;
    unsigned sum, cnt, mine, sp = 0u;
    for (;;) {
        sum = 0u; cnt = 0u; mine = 0u;
#pragma unroll
        for (unsigned j = 0; j < 16; ++j) { const unsigned c = xb_ld(&bar[XB_XCNT(j)]); sum += c; cnt += (c > 0u) ? 1u : 0u; mine = (j == x) ? c : mine; }
        if (sum == G) break;
        __builtin_amdgcn_s_sleep(1);
        if ((++sp & 255u) == 0u) { if (xb_ld(&bar[XB_TMO])) break; if (sp > XB_SPIN_CAP) { atomicAdd(&bar[XB_TMO], 1u); break; } }
    }
    nloc = mine > 0u ? mine : 1u; nx = cnt > 0u ? cnt : 1u;
}

__device__ __forceinline__ void xcd_barrier(const XcdBarrier& b) {
    asm volatile("s_waitcnt vmcnt(0)" ::: "memory");
    __syncthreads();
    if (b.wv == 0 && xb_lane_id() == 0) {
        unsigned* bar = b.bar;
        __builtin_amdgcn_s_waitcnt(0);
        unsigned nloc = b.st[0], nx = b.st[1];
        if (nloc == 0u) { xcd_barrier_complete(bar, b.x, nloc, nx); b.st[0] = nloc; b.st[1] = nx; }
        const unsigned old = xb_add(&bar[XB_XSUB(b.x)], 1u);
        const unsigned gen = old / nloc;
        if (old + 1u == (gen + 1u) * nloc) {
            __builtin_amdgcn_fence(__ATOMIC_RELEASE, "agent");
            asm volatile("s_waitcnt vmcnt(0)" ::: "memory");
            const unsigned og = xb_add(&bar[XB_TOP], 1u);
            const unsigned tg = og / nx;
            if (og + 1u == (tg + 1u) * nx) xb_add(&bar[XB_TOPGEN], 1u);
            else XB_SPIN(xb_ld(&bar[XB_TOPGEN]) == tg, bar);
            __builtin_amdgcn_fence(__ATOMIC_ACQUIRE, "agent");
            xb_add(&bar[XB_XGEN(b.x)], 1u);
            asm volatile("s_waitcnt vmcnt(0)" ::: "memory");
        } else {
            XB_SPIN(xb_ld(&bar[XB_XGEN(b.x)]) == gen, bar);
            __builtin_amdgcn_fence(__ATOMIC_ACQUIRE, "agent");
            asm volatile("s_waitcnt vmcnt(0)" ::: "memory");
        }
    }
    __syncthreads();
}
#define DI __device__ __forceinline__
constexpr int NWAVES = 8;
constexpr int NB = 16, SEQ = 2048, DM = 1024, MT = NB * SEQ;
constexpr int DIN_SRC = 6944, NPROJ = 7168;
constexpr int MEML = 256, MROWS = NB * MEML;
constexpr int NEXP = 32, TOPK = 4, DFF = 1024, MOEB = 256;
constexpr int NROWS = MT * TOPK;
constexpr int NBLK_MAX = (NROWS + NEXP * (MOEB - 1) + MOEB - 1) / MOEB;
constexpr int CAP = NBLK_MAX * MOEB;
constexpr float EPS = 1e-6f;
constexpr float NEGF = -1e30f;
constexpr int NB16 = 3584, NF8 = NPROJ - NB16;
constexpr int PC_MLQ = 0, PC_MLK = 512, PC_NQ = 1024, PC_NKC = 1536, PC_NKS = 1664, PC_NKW = 1792, PC_MQ = 1920, PC_MLI = 2432, PC_MLF = 2436, PC_NG = 2440,
              PC_MLV = 2560, PC_NVC = 3072, PC_NVS = 3200, PC_NVW = 3328, PC_MLO = 3584, PC_BRG = 4096;
__host__ __device__ constexpr int proj_srccol(int j) {
    return j < 1024 ? j : j < 1536 ? 2056 + (j - 1024) : j < 1664 ? 2568 + (j - 1536) : j < 1792 ? 2824 + (j - 1664) : j < 1920 ? 3080 + (j - 1792) : j < 2432 ? 3360 + (j - 1920)
         : j < 2440 ? 2048 + (j - 2432) : j < 2464 ? 3336 + (j - 2440) : j < 2560 ? -1
         : j < 3072 ? 1024 + (j - 2560) : j < 3200 ? 2696 + (j - 3072) : j < 3328 ? 2952 + (j - 3200) : j < 3456 ? 3208 + (j - 3328) : j < 3584 ? -1
         : j < 4096 ? 1536 + (j - 3584) : 3872 + (j - 4096);
}

constexpr size_t MiB = 1u << 20;
constexpr size_t WS_CTL = 0, CTL_ZERO_BYTES = 1 * MiB;
constexpr size_t WS_WIN = 1 * MiB, WS_WGU = 15 * MiB, WS_WDN = 143 * MiB, WS_WMKV = 207 * MiB, WS_WBR = 209 * MiB, WS_WOUT = 212 * MiB, WS_WC1 = 214 * MiB;
constexpr size_t WS_WIN8 = WS_WIN + 8 * MiB;
constexpr size_t WS_SMALL = 216 * MiB;
constexpr size_t WS_R1 = 218 * MiB;
constexpr size_t WS_PROJ = 282 * MiB;
constexpr size_t WS_R3 = 730 * MiB;
constexpr size_t WS_MEMKV = WS_R3, WS_MEMKN = WS_R3 + 8 * MiB, WS_QN = WS_R3 + 12 * MiB, WS_KSN = WS_R3 + 44 * MiB, WS_KWN = WS_R3 + 52 * MiB,
                 WS_MQN = WS_R3 + 60 * MiB, WS_MLQK = WS_R3 + 92 * MiB, WS_HID = WS_R3 + 156 * MiB, WS_KC = WS_R3 + 160 * MiB, WS_VC = WS_KC + MiB / 2,
                 WS_H0 = WS_R3 + 161 * MiB, WS_H1 = WS_H0 + 32 * MiB, WS_H2 = WS_H1 + 32 * MiB, WS_ROUTE = WS_H2 + 32 * MiB, WS_END = WS_ROUTE + 6 * MiB;
constexpr size_t WS_MLV = WS_R1, WS_VSN = WS_R1 + 32 * MiB, WS_VWN = WS_R1 + 40 * MiB;
constexpr size_t WS_U8 = WS_H2;
constexpr size_t WS_MEMN = WS_H0;
constexpr size_t WS_ACMP = WS_H1;
constexpr size_t WS_APERM = WS_PROJ;
constexpr size_t WS_ACT = WS_PROJ + 272 * MiB;
static_assert(WS_ACT + 272 * MiB <= WS_H0 + 96 * MiB && WS_END <= 1024 * MiB, "ws map");
constexpr size_t SM_ROPEC = 0, SM_ROPES = 256 * 1024, SM_CBIAS = 512 * 1024, SM_WRT = 1024 * 1024;
constexpr size_t RT_TOKE = 0, RT_TOKPOS = 512 * 1024, RT_TOKW = 1024 * 1024, RT_TOKDEST = 1536 * 1024, RT_ROWW = 2048 * 1024;
constexpr int CW_BAR = 4096;
constexpr int CW_ECNT = 16384;
constexpr int CW_QCTR = 16384 + 64;

constexpr int RING_BYTES = 131072, LDSCTL_OFF = RING_BYTES, MISC_OFF = LDSCTL_OFF + 320, LDS_BYTES = 155648;

struct Args { const float* in[34]; float* out; unsigned char* ws; int ph_lo, ph_hi, li, pad; };

DI float bf2f(unsigned short h) { return __uint_as_float((unsigned)h << 16); }
DI float wave_sum(float v) {
#pragma unroll
    for (int o = 1; o < 64; o <<= 1) v += __shfl_xor(v, o);
    return v;
}
DI float wave_max(float v) {
#pragma unroll
    for (int o = 1; o < 64; o <<= 1) v = fmaxf(v, __shfl_xor(v, o));
    return v;
}
DI float sigm(float x) { return __builtin_amdgcn_rcpf(1.f + __expf(-x)); }
DI float logsig(float x) { return fminf(x, 0.f) - log1pf(__expf(-fabsf(x))); }

namespace pg8 {
struct EpiBf16Silu {
    static constexpr bool PERM = true, AFTER_DRAIN = false;
    bf16_t* O; int ldc; const float* bias; int silu;
    DI void operator()(const f32x4 (&acc)[2][2][4][2], const Unit& u, int wr, int wc, int fr, int fq) const {
        const int row0 = u.pm * BM + wr * 64 + fr; const int col0 = u.pn * BM + wc * 32 + 8 * fq;
#pragma unroll
        for (int ai = 0; ai < 2; ++ai)
#pragma unroll
            for (int m = 0; m < 4; ++m) { bf16_t* rowp = O + (size_t)(row0 + ai * HALF + m * 16) * ldc + col0;
#pragma unroll
                for (int bj = 0; bj < 2; ++bj) { f32x4 v0 = acc[ai][bj][m][0], v1 = acc[ai][bj][m][1];
                    if (bias) { v0 += *(const f32x4*)(bias + col0 + bj * HALF); v1 += *(const f32x4*)(bias + col0 + bj * HALF + 4); }
                    if (silu) {
#pragma unroll
                        for (int j = 0; j < 4; ++j) { v0[j] = v0[j] * __builtin_amdgcn_rcpf(1.f + __expf(-v0[j])); v1[j] = v1[j] * __builtin_amdgcn_rcpf(1.f + __expf(-v1[j])); } }
                    u32x4 w; w.x = cvt_pk_bf16(v0[0], v0[1]); w.y = cvt_pk_bf16(v0[2], v0[3]); w.z = cvt_pk_bf16(v1[0], v1[1]); w.w = cvt_pk_bf16(v1[2], v1[3]);
                    *(u32x4*)(rowp + bj * HALF) = w; } }
    }
};
template <int B> struct EpiGate {
    static constexpr bool PERM = false, AFTER_DRAIN = false;
    const bf16_t* proj; float* tmp; bf16_t* merged;
    DI void operator()(const f32x4 (&acc)[2][2][4][2], const Unit& u, int wr, int wc, int fr, int fq) const {
        typedef unsigned u32x2v __attribute__((ext_vector_type(2)));
        const int col0 = u.pn * BM + wc * 32 + 4 * fq;
#pragma unroll
        for (int ai = 0; ai < 2; ++ai)
#pragma unroll
            for (int m = 0; m < 4; ++m) { const size_t r = (size_t)(u.pm * BM + ai * HALF + wr * 64 + m * 16 + fr);
#pragma unroll
                for (int bj = 0; bj < 2; ++bj)
#pragma unroll
                    for (int n = 0; n < 2; ++n) { const int c = col0 + bj * HALF + n * 16;
                        const u32x2v gw = *(const u32x2v*)(proj + r * NPROJ + PC_BRG + B * DM + c);
                        f32x4 g; g[0] = __uint_as_float(gw.x << 16); g[1] = __uint_as_float(gw.x & 0xffff0000u); g[2] = __uint_as_float(gw.y << 16); g[3] = __uint_as_float(gw.y & 0xffff0000u);
                        f32x4 v = acc[ai][bj][m][n];
#pragma unroll
                        for (int j = 0; j < 4; ++j) v[j] = v[j] * __builtin_amdgcn_rcpf(1.f + __expf(-g[j]));
                        float* tp = tmp + r * DM + c;
                        if (B == 0) { *(f32x4*)tp = v; }
                        else if (B == 1) { *(f32x4*)tp = *(const f32x4*)tp + v; }
                        else { v = *(const f32x4*)tp + v; u32x2v w; w.x = cvt_pk_bf16(v[0], v[1]); w.y = cvt_pk_bf16(v[2], v[3]); *(u32x2v*)(merged + r * DM + c) = w; } } }
    }
};
struct EpiMerge {
    static constexpr bool PERM = false, AFTER_DRAIN = false;
    const bf16_t* proj; float* tmp; bf16_t* merged;
    DI void operator()(const f32x4 (&acc)[2][2][4][2], const Unit& u, int wr, int wc, int fr, int fq) const {
        typedef unsigned u32x2v __attribute__((ext_vector_type(2)));
        const int b = u.pn >> 2, pn = u.pn & 3, pm = u.pm & 127;
        const int col0 = pn * BM + wc * 32 + 4 * fq;
#pragma unroll
        for (int ai = 0; ai < 2; ++ai)
#pragma unroll
            for (int m = 0; m < 4; ++m) { const size_t r = (size_t)(pm * BM + ai * HALF + wr * 64 + m * 16 + fr);
#pragma unroll
                for (int bj = 0; bj < 2; ++bj)
#pragma unroll
                    for (int n = 0; n < 2; ++n) { const int c = col0 + bj * HALF + n * 16;
                        const u32x2v gw = *(const u32x2v*)(proj + r * NPROJ + PC_BRG + b * DM + c);
                        f32x4 g; g[0] = __uint_as_float(gw.x << 16); g[1] = __uint_as_float(gw.x & 0xffff0000u); g[2] = __uint_as_float(gw.y << 16); g[3] = __uint_as_float(gw.y & 0xffff0000u);
                        f32x4 v = acc[ai][bj][m][n];
#pragma unroll
                        for (int j = 0; j < 4; ++j) v[j] = v[j] * __builtin_amdgcn_rcpf(1.f + __expf(-g[j]));
                        float* tp = tmp + r * DM + c;
                        if (b == 0) { *(f32x4*)tp = v; }
                        else if (b == 1) { *(f32x4*)tp = *(const f32x4*)tp + v; }
                        else { v = *(const f32x4*)tp + v; u32x2v w; w.x = cvt_pk_bf16(v[0], v[1]); w.y = cvt_pk_bf16(v[2], v[3]); *(u32x2v*)(merged + r * DM + c) = w; } } }
    }
};
struct EpiMergeK {
    static constexpr bool PERM = false, AFTER_DRAIN = false; static constexpr int MIDSEG = 8;
    const bf16_t* proj; bf16_t* merged;
    DI static f32x4 ldg(const bf16_t* p) { typedef unsigned u32x2v __attribute__((ext_vector_type(2))); const u32x2v gw = *(const u32x2v*)p; f32x4 g;
        g[0] = __uint_as_float(gw.x << 16); g[1] = __uint_as_float(gw.x & 0xffff0000u); g[2] = __uint_as_float(gw.y << 16); g[3] = __uint_as_float(gw.y & 0xffff0000u); return g; }
    DI void mid(f32x4 (&acc)[2][2][4][2], const Unit& u, int seg, int wr, int wc, int fr, int fq) const {
        const int col0 = u.pn * BM + wc * 32 + 4 * fq;
#pragma unroll
        for (int ai = 0; ai < 2; ++ai)
#pragma unroll
            for (int m = 0; m < 4; ++m) { const size_t r = (size_t)(u.pm * BM + ai * HALF + wr * 64 + m * 16 + fr);
#pragma unroll
                for (int bj = 0; bj < 2; ++bj)
#pragma unroll
                    for (int n = 0; n < 2; ++n) { const int c = col0 + bj * HALF + n * 16; const bf16_t* gp = proj + r * NPROJ + PC_BRG + (seg - 1) * DM + c;
                        const f32x4 ga = ldg(gp), gb = ldg(gp + DM);
#pragma unroll
                        for (int j = 0; j < 4; ++j) acc[ai][bj][m][n][j] *= (1.f + __expf(-gb[j])) * __builtin_amdgcn_rcpf(1.f + __expf(-ga[j])); } }
    }
    DI void operator()(const f32x4 (&acc)[2][2][4][2], const Unit& u, int wr, int wc, int fr, int fq) const {
        typedef unsigned u32x2v __attribute__((ext_vector_type(2)));
        const int col0 = u.pn * BM + wc * 32 + 4 * fq;
#pragma unroll
        for (int ai = 0; ai < 2; ++ai)
#pragma unroll
            for (int m = 0; m < 4; ++m) { const size_t r = (size_t)(u.pm * BM + ai * HALF + wr * 64 + m * 16 + fr);
#pragma unroll
                for (int bj = 0; bj < 2; ++bj)
#pragma unroll
                    for (int n = 0; n < 2; ++n) { const int c = col0 + bj * HALF + n * 16; const f32x4 g = ldg(proj + r * NPROJ + PC_BRG + 2 * DM + c); f32x4 v = acc[ai][bj][m][n];
#pragma unroll
                        for (int j = 0; j < 4; ++j) v[j] = v[j] * __builtin_amdgcn_rcpf(1.f + __expf(-g[j]));
                        u32x2v w; w.x = cvt_pk_bf16(v[0], v[1]); w.y = cvt_pk_bf16(v[2], v[3]); *(u32x2v*)(merged + r * DM + c) = w; } }
    }
};
struct MergeOrder {
    StaticOrder so;
    DI bool next(int i, Unit& u) const { const int tl = i / 3, b = i - 3 * tl; Unit t; if (!so.next(tl, t)) return false; u.pm = b * 128 + t.pm; u.pn = b * 4 + t.pn; return true; }
    DI void a_ready(const Unit&) const {}
    DI void done(const Unit&) const {}
};
struct EpiRes {
    static constexpr bool PERM = false, AFTER_DRAIN = false;
    const float* base; float* out;
    DI void operator()(const f32x4 (&acc)[2][2][4][2], const Unit& u, int wr, int wc, int fr, int fq) const {
        const int col0 = u.pn * BM + wc * 32 + 4 * fq;
#pragma unroll
        for (int ai = 0; ai < 2; ++ai)
#pragma unroll
            for (int m = 0; m < 4; ++m) { const size_t r = (size_t)(u.pm * BM + ai * HALF + wr * 64 + m * 16 + fr);
#pragma unroll
                for (int bj = 0; bj < 2; ++bj)
#pragma unroll
                    for (int n = 0; n < 2; ++n) { const int c = col0 + bj * HALF + n * 16; *(f32x4*)(out + r * DM + c) = *(const f32x4*)(base + r * DM + c) + acc[ai][bj][m][n]; } }
    }
};
struct EpiSwiglu {
    static constexpr bool PERM = true, AFTER_DRAIN = false;
    unsigned char* act; const float* bgu;
    DI void operator()(const f32x4 (&acc)[2][2][4][2], const Unit& u, int wr, int wc, int fr, int fq) const {
        typedef unsigned u32x2v __attribute__((ext_vector_type(2)));
        const int e = u.pn >> 3, pnl = u.pn & 7;
        const int lc0 = pnl * BM + wc * 32 + 8 * fq;
        const unsigned row0 = (unsigned)(u.pm * BM + wr * 64 + fr);
        const float* bp = bgu + e * 2048;
#pragma unroll
        for (int ai = 0; ai < 2; ++ai)
#pragma unroll
            for (int m = 0; m < 4; ++m) { const unsigned rowoff = (row0 + ai * HALF + m * 16) * (unsigned)DFF;
#pragma unroll
                for (int bj = 0; bj < 2; ++bj) {
                    const unsigned lc = (unsigned)(lc0 + bj * HALF);
                    const f32x4 b0 = *(const f32x4*)(bp + lc), b1 = *(const f32x4*)(bp + lc + 4);
                    const f32x4 v0 = acc[ai][bj][m][0] + b0, v1 = acc[ai][bj][m][1] + b1;
                    float o[4];
#pragma unroll
                    for (int q = 0; q < 4; ++q) { const float gt = fminf(q < 2 ? v0[2 * q] : v1[2 * q - 4], 7.0f); float up = q < 2 ? v0[2 * q + 1] : v1[2 * q - 3]; up = fminf(fmaxf(up, -7.0f), 7.0f);
                        o[q] = (up + 1.0f) * (gt * __builtin_amdgcn_rcpf(1.f + __expf(-1.702f * gt))); }
                    int q8 = 0; q8 = __builtin_amdgcn_cvt_pk_fp8_f32(o[0], o[1], q8, false); q8 = __builtin_amdgcn_cvt_pk_fp8_f32(o[2], o[3], q8, true);
                    *(unsigned*)(act + (rowoff + (lc >> 1))) = (unsigned)q8; } }
    }
};
struct EpiDown {
    static constexpr bool PERM = false, AFTER_DRAIN = false;
    bf16_t* y; const float* bdn; const float* roww;
    DI void operator()(const f32x4 (&acc)[2][2][4][2], const Unit& u, int wr, int wc, int fr, int fq) const {
        typedef unsigned u32x2v __attribute__((ext_vector_type(2)));
        const int e = u.pn >> 2, pnl = u.pn & 3;
        const int col0 = pnl * BM + wc * 32 + 4 * fq;
#pragma unroll
        for (int ai = 0; ai < 2; ++ai)
#pragma unroll
            for (int m = 0; m < 4; ++m) { const size_t r = (size_t)(u.pm * BM + ai * HALF + wr * 64 + m * 16 + fr); const float rw = roww[r];
#pragma unroll
                for (int bj = 0; bj < 2; ++bj)
#pragma unroll
                    for (int n = 0; n < 2; ++n) { const int c = col0 + bj * HALF + n * 16; const f32x4 v = (acc[ai][bj][m][n] + *(const f32x4*)(bdn + e * DM + c)) * rw;
                        u32x2v w; w.x = cvt_pk_bf16(v[0], v[1]); w.y = cvt_pk_bf16(v[2], v[3]); *(u32x2v*)(y + r * DM + c) = w; } }
    }
};
template <int NPN> struct MoeOrder {
    int nblk, G, c; const PG8_LAS unsigned char* blk_e;
    DI bool next(int i, Unit& u) const {
        int rb, pn;
        if (G == 256) { const int x = c & 7, j = c >> 3; rb = i * (256 / NPN) + x * (32 / NPN) + j / NPN; pn = j % NPN; }
        else { const int L = i * G + c; rb = L / NPN; pn = L % NPN; }
        if (rb >= nblk) return false;
        u.pm = rb; u.pn = __builtin_amdgcn_readfirstlane((int)blk_e[rb]) * NPN + pn; return true; }
    DI void a_ready(const Unit&) const {}
    DI void done(const Unit&) const {}
};
}

struct Frame {
    LAS unsigned char* lds; volatile LAS unsigned* MISC; unsigned* ctl; unsigned char* ws;
    int wave, G, bx;
    DI int lane_id() const { int l; asm volatile("v_mbcnt_lo_u32_b32 %0, -1, 0\n\tv_mbcnt_hi_u32_b32 %0, -1, %0" : "=v"(l)); return l; }
    DI int tid_id() const { return wave * 64 + lane_id(); }
    const float* const* in; float* out;
};
enum { I_X = 0, I_MEM, I_GMIX, I_WIN, I_CONVW, I_CONVB, I_MLBI, I_MLBF, I_MLGOUT, I_NGQ, I_NGK, I_CPK, I_CW1K, I_CB1K, I_CW2K, I_CPV, I_CW1V, I_CB1V, I_CW2V,
       I_GMEM, I_WMKV, I_MGQ, I_MGK, I_WBRML, I_WBRNSA, I_WBRMEM, I_WOUT, I_GFFN, I_WR, I_BR, I_WGU, I_BGU, I_WDN, I_BDN, N_IN };

template <class CM>
DI void tr_item(const float* W, int ldw, int K, bf16* WT, int k0, int n0, CM cm, LAS float* scr, int lane) {
    const int sc = cm(n0 + (lane & 31));
#pragma unroll 8
    for (int i = 0; i < 32; ++i) { const int kk = 2 * i + (lane >> 5); scr[kk * 33 + (lane & 31)] = sc >= 0 ? W[(size_t)(k0 + kk) * ldw + sc] : 0.f; }
    LDS_WAIT(); asm volatile("" ::: "memory");
    const int c = lane & 7;
#pragma unroll
    for (int j = 0; j < 4; ++j) { const int n = (lane >> 3) + 8 * j; const LAS float* s = scr + (8 * c) * 33 + n;
        v4u o; o.x = pk2(s[0 * 33], s[1 * 33]); o.y = pk2(s[2 * 33], s[3 * 33]); o.z = pk2(s[4 * 33], s[5 * 33]); o.w = pk2(s[6 * 33], s[7 * 33]);
        *(v4u*)(WT + (size_t)(n0 + n) * K + k0 + 8 * c) = o; }
    LDS_WAIT(); asm volatile("" ::: "memory");
}
DI void tr_item_f8(const float* W, int ldw, int K, unsigned char* WT, int k0, int n0, LAS float* scr, int lane) {
#pragma unroll 8
    for (int i = 0; i < 32; ++i) { const int kk = 2 * i + (lane >> 5); scr[kk * 33 + (lane & 31)] = W[(size_t)(k0 + kk) * ldw + n0 + (lane & 31)] * 256.0f; }
    LDS_WAIT(); asm volatile("" ::: "memory");
    const int c = lane & 7;
#pragma unroll
    for (int j = 0; j < 4; ++j) { const int n = (lane >> 3) + 8 * j; const LAS float* sp = scr + (8 * c) * 33 + n;
        int lo = 0, hi = 0;
        lo = __builtin_amdgcn_cvt_pk_fp8_f32(sp[0 * 33], sp[1 * 33], lo, false); lo = __builtin_amdgcn_cvt_pk_fp8_f32(sp[2 * 33], sp[3 * 33], lo, true);
        hi = __builtin_amdgcn_cvt_pk_fp8_f32(sp[4 * 33], sp[5 * 33], hi, false); hi = __builtin_amdgcn_cvt_pk_fp8_f32(sp[6 * 33], sp[7 * 33], hi, true);
        typedef unsigned u32x2t __attribute__((ext_vector_type(2)));
        *(u32x2t*)(WT + (size_t)(n0 + n) * K + k0 + 8 * c) = (u32x2t){(unsigned)lo, (unsigned)hi}; }
    LDS_WAIT(); asm volatile("" ::: "memory");
}
DI void tr_fill_v4(const float* W, int ldw, int k0, int n0, LAS float* scr, int lane, float mul) {
    f32x4 v[8];
#pragma unroll
    for (int i = 0; i < 8; ++i) v[i] = *(const f32x4*)(W + (size_t)(k0 + 8 * i + (lane >> 3)) * ldw + n0 + 4 * (lane & 7));
#pragma unroll
    for (int i = 0; i < 8; ++i) { LAS float* d = scr + (8 * i + (lane >> 3)) * 33 + 4 * (lane & 7); d[0] = v[i].x * mul; d[1] = v[i].y * mul; d[2] = v[i].z * mul; d[3] = v[i].w * mul; }
    LDS_WAIT(); asm volatile("" ::: "memory");
}
DI void tr_emit_bf16(bf16* WT, int K, int k0, int n0, LAS float* scr, int lane) {
    const int c = lane & 7;
#pragma unroll
    for (int j = 0; j < 4; ++j) { const int n = (lane >> 3) + 8 * j; const LAS float* sp = scr + (8 * c) * 33 + n;
        v4u o; o.x = pk2(sp[0 * 33], sp[1 * 33]); o.y = pk2(sp[2 * 33], sp[3 * 33]); o.z = pk2(sp[4 * 33], sp[5 * 33]); o.w = pk2(sp[6 * 33], sp[7 * 33]);
        *(v4u*)(WT + (size_t)(n0 + n) * K + k0 + 8 * c) = o; }
    LDS_WAIT(); asm volatile("" ::: "memory");
}
DI void tr_emit_f8(unsigned char* WT, int K, int k0, int n0, LAS float* scr, int lane) {
    const int c = lane & 7;
#pragma unroll
    for (int j = 0; j < 4; ++j) { const int n = (lane >> 3) + 8 * j; const LAS float* sp = scr + (8 * c) * 33 + n;
        int lo = 0, hi = 0;
        lo = __builtin_amdgcn_cvt_pk_fp8_f32(sp[0 * 33], sp[1 * 33], lo, false); lo = __builtin_amdgcn_cvt_pk_fp8_f32(sp[2 * 33], sp[3 * 33], lo, true);
        hi = __builtin_amdgcn_cvt_pk_fp8_f32(sp[4 * 33], sp[5 * 33], hi, false); hi = __builtin_amdgcn_cvt_pk_fp8_f32(sp[6 * 33], sp[7 * 33], hi, true);
        typedef unsigned u32x2t __attribute__((ext_vector_type(2)));
        *(u32x2t*)(WT + (size_t)(n0 + n) * K + k0 + 8 * c) = (u32x2t){(unsigned)lo, (unsigned)hi}; }
    LDS_WAIT(); asm volatile("" ::: "memory");
}
template <class CM>
DI void tr_fill_cm(const float* W, int ldw, int k0, int n0, CM cm, LAS float* scr, int lane, float mul) {
    const int sc = cm(n0 + (lane & 31));
#pragma unroll 8
    for (int i = 0; i < 32; ++i) { const int kk = 2 * i + (lane >> 5); scr[kk * 33 + (lane & 31)] = sc >= 0 ? W[(size_t)(k0 + kk) * ldw + sc] * mul : 0.f; }
    LDS_WAIT(); asm volatile("" ::: "memory");
}
struct CmId { DI int operator()(int j) const { return j; } };
struct CmProj { DI int operator()(int j) const { return proj_srccol(j); } };

DI void rms_row_bf16(const float* xrow, const float* g, bf16* orow, int lane) {
    const f32x4* xr = (const f32x4*)xrow + lane; const f32x4* gr = (const f32x4*)g + lane;
    f32x4 v[4]; float s = 0.f;
#pragma unroll
    for (int j = 0; j < 4; ++j) { v[j] = xr[64 * j]; s += (v[j].x * v[j].x + v[j].y * v[j].y) + (v[j].z * v[j].z + v[j].w * v[j].w); }
    const float rstd = rsqrtf(wave_sum(s) * (1.f / DM) + EPS);
    unsigned long long* o8 = (unsigned long long*)orow + lane;
#pragma unroll
    for (int j = 0; j < 4; ++j) { const f32x4 gg = gr[64 * j];
        o8[64 * j] = (unsigned long long)pk2(v[j].x * rstd * gg.x, v[j].y * rstd * gg.y) | ((unsigned long long)pk2(v[j].z * rstd * gg.z, v[j].w * rstd * gg.w) << 32); }
}

DI void rms_row_f8(const float* xrow, const float* g, unsigned char* orow, int lane) {
    const f32x4* xr = (const f32x4*)xrow + lane; const f32x4* gr = (const f32x4*)g + lane;
    f32x4 v[4]; float s = 0.f;
#pragma unroll
    for (int j = 0; j < 4; ++j) { v[j] = xr[64 * j]; s += (v[j].x * v[j].x + v[j].y * v[j].y) + (v[j].z * v[j].z + v[j].w * v[j].w); }
    const float rstd = rsqrtf(wave_sum(s) * (1.f / DM) + EPS);
    unsigned* o4 = (unsigned*)orow + lane;
#pragma unroll
    for (int j = 0; j < 4; ++j) { const f32x4 gg = gr[64 * j]; int q8 = 0;
        q8 = __builtin_amdgcn_cvt_pk_fp8_f32(v[j].x * rstd * gg.x, v[j].y * rstd * gg.y, q8, false); q8 = __builtin_amdgcn_cvt_pk_fp8_f32(v[j].z * rstd * gg.z, v[j].w * rstd * gg.w, q8, true);
        o4[64 * j] = (unsigned)q8; }
}
DI void rms_row_both(const float* xrow, const float* g, bf16* orow, unsigned char* orow8, int lane) {
    const f32x4* xr = (const f32x4*)xrow + lane; const f32x4* gr = (const f32x4*)g + lane;
    f32x4 v[4]; float s = 0.f;
#pragma unroll
    for (int j = 0; j < 4; ++j) { v[j] = xr[64 * j]; s += (v[j].x * v[j].x + v[j].y * v[j].y) + (v[j].z * v[j].z + v[j].w * v[j].w); }
    const float rstd = rsqrtf(wave_sum(s) * (1.f / DM) + EPS);
    unsigned long long* o8 = (unsigned long long*)orow + lane; unsigned* o4 = (unsigned*)orow8 + lane;
#pragma unroll
    for (int j = 0; j < 4; ++j) { const f32x4 gg = gr[64 * j]; const float y0 = v[j].x * rstd * gg.x, y1 = v[j].y * rstd * gg.y, y2 = v[j].z * rstd * gg.z, y3 = v[j].w * rstd * gg.w;
        o8[64 * j] = (unsigned long long)pk2(y0, y1) | ((unsigned long long)pk2(y2, y3) << 32);
        int q8 = 0; q8 = __builtin_amdgcn_cvt_pk_fp8_f32(y0, y1, q8, false); q8 = __builtin_amdgcn_cvt_pk_fp8_f32(y2, y3, q8, true);
        o4[64 * j] = (unsigned)q8; }
}
DI void p0_prologue(Frame& F) {
    LAS float* scr = (LAS float*)(F.lds + F.wave * 16384);
    const int gw = F.bx * NWAVES + F.wave, NGW = F.G * NWAVES;
    unsigned char* ws = F.ws;
    constexpr int IT_IN = 16 * (NPROJ / 32), IT_GU = 32 * 16 * 64, IT_DN = 32 * 16 * 32, IT_MKV = 16 * 32, IT_BR = 3 * 8 * 32, IT_OUT = 16 * 32, IT_C1 = 2 * 32 * 8;
    constexpr int NITEMS = IT_IN + IT_GU + IT_DN + IT_MKV + IT_BR + IT_OUT + IT_C1;
    for (int it = gw; it < NITEMS; it += NGW) {
        int r = it;
        if (r < IT_IN) { const int kb = r / (NPROJ / 32), nb = r % (NPROJ / 32); if (32 * nb < NB16) { tr_fill_cm(F.in[I_WIN], DIN_SRC, 64 * kb, 32 * nb, CmProj(), scr, F.lane_id(), 1.0f); tr_emit_bf16((bf16*)(ws + WS_WIN), DM, 64 * kb, 32 * nb, scr, F.lane_id()); }
            else { tr_fill_cm(F.in[I_WIN], DIN_SRC, 64 * kb, 32 * nb, CmProj(), scr, F.lane_id(), 256.0f); tr_emit_f8((unsigned char*)(ws + WS_WIN8), DM, 64 * kb, 32 * nb - NB16, scr, F.lane_id()); }
            continue; } r -= IT_IN;
        if (r < IT_GU) { const int e = r / 1024, q = r % 1024, kb = q / 64, nb = q % 64; tr_fill_v4(F.in[I_WGU] + (size_t)e * DM * 2048, 2048, 64 * kb, 32 * nb, scr, F.lane_id(), 256.0f); tr_emit_f8((unsigned char*)(ws + WS_WGU) + (size_t)e * 2048 * DM, DM, 64 * kb, 32 * nb, scr, F.lane_id()); continue; } r -= IT_GU;
        if (r < IT_DN) { const int e = r / 512, q = r % 512, kb = q / 32, nb = q % 32; tr_fill_v4(F.in[I_WDN] + (size_t)e * DFF * DM, DM, 64 * kb, 32 * nb, scr, F.lane_id(), 256.0f); tr_emit_f8((unsigned char*)(ws + WS_WDN) + (size_t)e * DM * DFF, DFF, 64 * kb, 32 * nb, scr, F.lane_id()); continue; } r -= IT_DN;
        if (r < IT_MKV) { const int kb = r / 32, nb = r % 32; tr_fill_v4(F.in[I_WMKV], 1024, 64 * kb, 32 * nb, scr, F.lane_id(), 1.0f); tr_emit_bf16((bf16*)(ws + WS_WMKV), 1024, 64 * kb, 32 * nb, scr, F.lane_id()); continue; } r -= IT_MKV;
        if (r < IT_BR) { const int b = r / 256, q = r % 256, kb = q / 32, nb = q % 32; tr_fill_v4(F.in[I_WBRML + b], 1024, 64 * kb, 32 * nb, scr, F.lane_id(), 1.0f); tr_emit_bf16((bf16*)(ws + WS_WBR), 1536, 512 * b + 64 * kb, 32 * nb, scr, F.lane_id()); continue; } r -= IT_BR;
        if (r < IT_OUT) { const int kb = r / 32, nb = r % 32; tr_fill_v4(F.in[I_WOUT], 1024, 64 * kb, 32 * nb, scr, F.lane_id(), 1.0f); tr_emit_bf16((bf16*)(ws + WS_WOUT), 1024, 64 * kb, 32 * nb, scr, F.lane_id()); continue; } r -= IT_OUT;
        { const int kv = r / 256, q = r % 256, kb = q / 8, nb = q % 8; tr_fill_v4(F.in[kv ? I_CW1V : I_CW1K], 256, 64 * kb, 32 * nb, scr, F.lane_id(), 1.0f); tr_emit_bf16((bf16*)(ws + WS_WC1) + (size_t)kv * 256 * 2048, 2048, 64 * kb, 32 * nb, scr, F.lane_id()); }
    }
    for (int m = gw; m < MT; m += NGW) rms_row_both(F.in[I_X] + (size_t)m * DM, F.in[I_GMIX], (bf16*)(ws + WS_R1) + (size_t)m * DM, (unsigned char*)(ws + WS_U8) + (size_t)m * DM, F.lane_id());
    for (int m = gw; m < MROWS; m += NGW) rms_row_bf16(F.in[I_MEM] + (size_t)m * DM, F.in[I_GMEM], (bf16*)(ws + WS_MEMN) + (size_t)m * DM, F.lane_id());
    float* rc = (float*)(ws + WS_SMALL + SM_ROPEC); float* rs = (float*)(ws + WS_SMALL + SM_ROPES);
    for (int i = F.bx * 512 + F.tid_id(); i < SEQ * 32; i += F.G * 512) {
        const int p = i >> 5, k = i & 31;
        const float invf = exp2f(-(float)k * (13.287712379549449f / 32.0f));
        const float ang = (float)p * invf;
        const float kf = rintf(ang * 0.15915494309189535f);
        float r = fmaf(-kf, 6.28125f, ang); r = fmaf(-kf, 1.9353071795864769e-3f, r);
        rc[i] = cosf(r); rs[i] = sinf(r);
    }
    { bf16* wrt = (bf16*)(ws + WS_SMALL + SM_WRT);
      for (int i = F.bx * 512 + F.tid_id(); i < 32 * 1024; i += F.G * 512) { const int e = i >> 10, k = i & 1023; const float w = F.in[I_WR][k * 32 + e]; const unsigned hi = f2bf(w); wrt[i] = (bf16)hi; wrt[32 * 1024 + i] = (bf16)f2bf(w - __uint_as_float(hi << 16)); } }
    if (F.bx == F.G - 1) {
        const int kv = F.tid_id() >> 8, f = F.tid_id() & 255;
        const float* pe = F.in[kv ? I_CPV : I_CPK]; const float* w1 = F.in[kv ? I_CW1V : I_CW1K];
        float a = F.in[kv ? I_CB1V : I_CB1K][f];
        for (int k = 0; k < 2048; ++k) a = fmaf(pe[k], w1[(size_t)k * 256 + f], a);
        ((float*)(ws + WS_SMALL + SM_CBIAS))[kv * 256 + f] = a;
    }
}

DI void unpack8(const v4u& w, float (&f)[8]) {
    f[0] = __uint_as_float(w.x << 16); f[1] = __uint_as_float(w.x & 0xffff0000u); f[2] = __uint_as_float(w.y << 16); f[3] = __uint_as_float(w.y & 0xffff0000u);
    f[4] = __uint_as_float(w.z << 16); f[5] = __uint_as_float(w.z & 0xffff0000u); f[6] = __uint_as_float(w.w << 16); f[7] = __uint_as_float(w.w & 0xffff0000u);
}
DI v4u pack8f(const float (&f)[8]) { v4u o; o.x = pk2(f[0], f[1]); o.y = pk2(f[2], f[3]); o.z = pk2(f[4], f[5]); o.w = pk2(f[6], f[7]); return o; }
DI void load8f(const float* p, float (&f)[8]) { const f32x4 a = *(const f32x4*)p, b = *(const f32x4*)(p + 4); f[0] = a.x; f[1] = a.y; f[2] = a.z; f[3] = a.w; f[4] = b.x; f[5] = b.y; f[6] = b.z; f[7] = b.w; }
DI void norm_rope64(float (&f)[8], const float (&g)[8], const float (&c8)[8], const float (&s8)[8], int lane, float scale) {
    float ss = 0.f;
#pragma unroll
    for (int i = 0; i < 8; ++i) ss = fmaf(f[i], f[i], ss);
    ss += __shfl_xor(ss, 1); ss += __shfl_xor(ss, 2); ss += __shfl_xor(ss, 4);
    const float rstd = rsqrtf(ss * (1.f / 64.f) + EPS);
    const bool hi = (lane & 4) != 0;
#pragma unroll
    for (int i = 0; i < 8; ++i) { const float y = f[i] * rstd * g[i]; const float pt = __shfl_xor(y, 4); f[i] = (hi ? fmaf(pt, s8[i], y * c8[i]) : fmaf(-pt, s8[i], y * c8[i])) * scale; }
}
DI void p2_prep(Frame& F) {
    unsigned char* ws = F.ws;
    const int gw = F.bx * NWAVES + F.wave, NGW = F.G * NWAVES, lane = F.lane_id();
    const bf16* proj = (const bf16*)(ws + WS_PROJ);
    const float* rc = (const float*)(ws + WS_SMALL + SM_ROPEC); const float* rs = (const float*)(ws + WS_SMALL + SM_ROPES);
    bf16* qn = (bf16*)(ws + WS_QN); bf16* ksn = (bf16*)(ws + WS_KSN); bf16* kwn = (bf16*)(ws + WS_KWN); bf16* mqn = (bf16*)(ws + WS_MQN); bf16* mlqk = (bf16*)(ws + WS_MLQK);
    bf16* acmp = (bf16*)(ws + WS_ACMP);
    constexpr int NT = 4;
    {
        float gq8[8], mg8[8]; load8f(F.in[I_NGQ] + 8 * (lane & 7), gq8); load8f(F.in[I_MGQ] + 8 * (lane & 15), mg8);
        for (int t0 = gw * NT; t0 < MT; t0 += NGW * NT) {
            v4u a[NT], bq[NT], cv[NT]; float c8[NT][8], s8[NT][8];
#pragma unroll
            for (int u = 0; u < NT; ++u) { const int t = t0 + u, tau = t & 2047; const bf16* pr = proj + (size_t)t * NPROJ;
                a[u] = *(const v4u*)(pr + PC_NQ + 8 * lane); bq[u] = *(const v4u*)(pr + PC_MQ + 8 * lane); cv[u] = *(const v4u*)(pr + PC_MLV + 8 * lane);
                load8f(rc + tau * 32 + 8 * (lane & 3), c8[u]); load8f(rs + tau * 32 + 8 * (lane & 3), s8[u]); }
#pragma unroll
            for (int u = 0; u < NT; ++u) { const int t = t0 + u;
                float f[8]; unpack8(a[u], f);
                norm_rope64(f, gq8, c8[u], s8[u], lane, 0.125f * 1.4426950408889634f);
                *(v4u*)(qn + (size_t)t * 512 + 8 * lane) = pack8f(f);
                unpack8(bq[u], f);
                float ss = 0.f;
#pragma unroll
                for (int i = 0; i < 8; ++i) ss = fmaf(f[i], f[i], ss);
                ss += __shfl_xor(ss, 1); ss += __shfl_xor(ss, 2); ss += __shfl_xor(ss, 4); ss += __shfl_xor(ss, 8);
                const float rstd = rsqrtf(ss * (1.f / 128.f) + EPS) * (0.08838834764831845f * 1.4426950408889634f);
#pragma unroll
                for (int i = 0; i < 8; ++i) f[i] *= rstd * mg8[i];
                *(v4u*)(mqn + (size_t)t * 512 + 8 * lane) = pack8f(f);
                *(v4u*)((bf16*)(ws + WS_MLV) + (size_t)t * 512 + 8 * lane) = cv[u]; }
        }
    }
    {
        const int L = lane & 31, hd4 = L >> 3, j = L & 7, half = lane >> 5;
        float gk8[8]; load8f(F.in[I_NGK] + (1 + (hd4 >> 1)) * 64 + 8 * j, gk8);
        const int kcol = (hd4 < 2 ? PC_NKS + hd4 * 64 : PC_NKW + (hd4 - 2) * 64) + 8 * j;
        bf16* kdst = (hd4 < 2 ? ksn : kwn) + (hd4 & 1) * 64 + 8 * j;
        const int kv = hd4 >> 1, hh = hd4 & 1, wv = L >> 4, jj = L & 15;
        bf16* vdst = (bf16*)(ws + (wv ? WS_VWN : WS_VSN)) + 8 * jj; const int vcol = (wv ? PC_NVW : PC_NVS) + 8 * jj;
        for (int tp0 = gw * NT; tp0 < MT / 2; tp0 += NGW * NT) {
            v4u a[NT], vv[NT], cv[NT]; float c8[NT][8], s8[NT][8];
#pragma unroll
            for (int u = 0; u < NT; ++u) { const int t = 2 * (tp0 + u) + half, tau = t & 2047; const bf16* pr = proj + (size_t)t * NPROJ;
                a[u] = *(const v4u*)(pr + kcol); vv[u] = *(const v4u*)(pr + vcol); cv[u] = *(const v4u*)(pr + (kv ? PC_NVC : PC_NKC) + hh * 64 + 8 * j);
                load8f(rc + tau * 32 + 8 * (lane & 3), c8[u]); load8f(rs + tau * 32 + 8 * (lane & 3), s8[u]); }
#pragma unroll
            for (int u = 0; u < NT; ++u) { const int t = 2 * (tp0 + u) + half, b = t >> 11, tau = t & 2047;
                float f[8]; unpack8(a[u], f);
                norm_rope64(f, gk8, c8[u], s8[u], lane, 1.0f);
                *(v4u*)(kdst + (size_t)t * 128) = pack8f(f);
                *(v4u*)(vdst + (size_t)t * 128) = vv[u];
                const int nA = tau >> 4;
#pragma unroll
                for (int dn = 0; dn < 2; ++dn) { const int n = nA - dn; if (n >= 0 && n <= 126) { const int l = tau - 16 * n;
                    *(v4u*)(acmp + (size_t)kv * 4096 * 2048 + (size_t)((b * 2 + hh) * 128 + n) * 2048 + l * 64 + 8 * j) = cv[u]; } } }
        }
    }
    for (int run = gw; run < MT / 16; run += NGW) {
        const int t0 = run * 16, tau0 = t0 & 2047;
#pragma unroll 1
        for (int sp = 0; sp < 2; ++sp) {
            const int ch = 512 * sp + 8 * lane;
            float w0[8], w1[8], w2[8], w3[8], bb[8];
            load8f(F.in[I_CONVW] + ch, w0); load8f(F.in[I_CONVW] + 1024 + ch, w1); load8f(F.in[I_CONVW] + 2048 + ch, w2); load8f(F.in[I_CONVW] + 3072 + ch, w3); load8f(F.in[I_CONVB] + ch, bb);
            float x0[8], x1[8], x2[8];
            if (tau0 >= 3) { unpack8(*(const v4u*)(proj + (size_t)(t0 - 3) * NPROJ + ch), x0); unpack8(*(const v4u*)(proj + (size_t)(t0 - 2) * NPROJ + ch), x1); unpack8(*(const v4u*)(proj + (size_t)(t0 - 1) * NPROJ + ch), x2); }
            else {
#pragma unroll
                for (int i = 0; i < 8; ++i) { x0[i] = 0.f; x1[i] = 0.f; x2[i] = 0.f; } }
#pragma unroll 1
            for (int k0 = 0; k0 < 16; k0 += 4) {
                v4u raw[4];
#pragma unroll
                for (int k = 0; k < 4; ++k) raw[k] = *(const v4u*)(proj + (size_t)(t0 + k0 + k) * NPROJ + ch);
#pragma unroll
                for (int k = 0; k < 4; ++k) { float x3[8], y[8]; unpack8(raw[k], x3);
#pragma unroll
                    for (int i = 0; i < 8; ++i) { const float a = fmaf(w3[i], x3[i], fmaf(w2[i], x2[i], fmaf(w1[i], x1[i], fmaf(w0[i], x0[i], bb[i])))); y[i] = a * sigm(a); x0[i] = x1[i]; x1[i] = x2[i]; x2[i] = x3[i]; }
                    *(v4u*)(mlqk + (size_t)(t0 + k0 + k) * 1024 + ch) = pack8f(y); }
            }
        }
    }
    for (int i = F.bx * 512 + F.tid_id(); i < 2 * 32 * 2048; i += F.G * 512) { const int kv = i / (32 * 2048), q = i % (32 * 2048), bh = q / 2048, col = q % 2048;
        acmp[(size_t)kv * 4096 * 2048 + (size_t)(bh * 128 + 127) * 2048 + col] = 0; }
    {
        const bf16* memkv = (const bf16*)(ws + WS_MEMKV); bf16* memkn = (bf16*)(ws + WS_MEMKN);
        float kg8[8]; load8f(F.in[I_MGK] + 8 * (lane & 15), kg8);
        for (int r = gw; r < MROWS; r += NGW) {
            float f[8]; unpack8(*(const v4u*)(memkv + (size_t)r * 1024 + 8 * lane), f);
            float ss = 0.f;
#pragma unroll
            for (int i = 0; i < 8; ++i) ss = fmaf(f[i], f[i], ss);
            ss += __shfl_xor(ss, 1); ss += __shfl_xor(ss, 2); ss += __shfl_xor(ss, 4); ss += __shfl_xor(ss, 8);
            const float rstd = rsqrtf(ss * (1.f / 128.f) + EPS);
#pragma unroll
            for (int i = 0; i < 8; ++i) f[i] *= rstd * kg8[i];
            *(v4u*)(memkn + (size_t)r * 512 + 8 * lane) = pack8f(f);
        }
    }
}

DI void p4_kcvc(Frame& F) {
    unsigned char* ws = F.ws;
    const int gw = F.bx * NWAVES + F.wave, NGW = F.G * NWAVES, lane = F.lane_id();
    const bf16* hid = (const bf16*)(ws + WS_HID);
    const float* rc = (const float*)(ws + WS_SMALL + SM_ROPEC); const float* rs = (const float*)(ws + WS_SMALL + SM_ROPES);
    const float gk = F.in[I_NGK][lane];
    for (int it = gw; it < 2 * 4096; it += NGW) {
        const int kv = it >> 12, r = it & 4095, n = r & 127;
        bf16* dst = (bf16*)(ws + (kv ? WS_VC : WS_KC)) + (size_t)r * 64 + lane;
        if (n == 127) { *dst = 0; continue; }
        const bf16* hr = hid + (size_t)kv * 4096 * 256 + (size_t)r * 256; const float* w2 = F.in[kv ? I_CW2V : I_CW2K];
        float a = 0.f;
        for (int f = 0; f < 256; ++f) a = fmaf(bf2f(hr[f]), w2[f * 64 + lane], a);
        if (kv == 0) {
            const float y = a * rsqrtf(wave_sum(a * a) * (1.f / 64.f) + EPS) * gk;
            const int pos = 16 * n + 31; const float c = rc[pos * 32 + (lane & 31)], s = rs[pos * 32 + (lane & 31)];
            const float pt = __shfl_xor(y, 32);
            a = lane < 32 ? y * c - pt * s : y * c + pt * s;
        }
        *dst = (bf16)f2bf(a);
    }
}

DI void mlstm_unit(Frame& F, int unit) {
    unsigned char* ws = F.ws;
    const int b = unit >> 2, h = unit & 3, tid = F.tid_id(), kk = tid >> 7, c = tid & 127;
    const bf16* proj = (const bf16*)(ws + WS_PROJ); const bf16* mlqk = (const bf16*)(ws + WS_MLQK); bf16* H0 = (bf16*)(ws + WS_H0);
    LAS float* qs = (LAS float*)F.lds;
    LAS float* ks = qs + 16 * 128;
    LAS float* vs = ks + 16 * 128;
    LAS float* gi = vs + 16 * 128;
    LAS float* gf = gi + 16;
    LAS float* part = gf + 16;
    LAS float* pden = part + 2 * 4 * 128;
    LAS float* hb = pden + 8;
    float C[32], nn[32];
#pragma unroll
    for (int i = 0; i < 32; ++i) { C[i] = 0.f; nn[i] = 0.f; }
    float m = 0.f;
    const float bi = F.in[I_MLBI][h], bfv = F.in[I_MLBF][h];
    const float scale = 0.08838834764831845f;
#pragma unroll 1
    for (int t0 = 0; t0 < SEQ; t0 += 16) {
        __syncthreads();
        for (int i = tid; i < 16 * 128; i += 512) { const int s = i >> 7, d = i & 127; const size_t t = (size_t)b * SEQ + t0 + s;
            qs[i] = bf2f(mlqk[t * 1024 + h * 128 + d]); ks[i] = bf2f(mlqk[t * 1024 + 512 + h * 128 + d]); vs[i] = bf2f(proj[t * NPROJ + PC_MLV + h * 128 + d]); }
        if (tid < 16) { const size_t t = (size_t)b * SEQ + t0 + tid; gi[tid] = bf2f(proj[t * NPROJ + PC_MLI + h]) + bi; gf[tid] = logsig(bf2f(proj[t * NPROJ + PC_MLF + h]) + bfv); }
        __syncthreads();
#pragma unroll 1
        for (int s = 0; s < 16; ++s) {
            const float lf = gf[s], ig = gi[s];
            const float mn = fmaxf(lf + m, ig), a = __expf(lf + m - mn), bb = __expf(ig - mn);
            m = mn;
            const float v = vs[s * 128 + c];
            float pn = 0.f, pd = 0.f;
#pragma unroll
            for (int i = 0; i < 32; ++i) { const float kvv = ks[s * 128 + kk * 32 + i], qv = qs[s * 128 + kk * 32 + i];
                C[i] = a * C[i] + bb * kvv * v; nn[i] = a * nn[i] + bb * kvv; pn = fmaf(qv, C[i], pn); pd = fmaf(qv, nn[i], pd); }
            const int par = s & 1;
            part[(par * 4 + kk) * 128 + c] = pn; if (c == 0) pden[par * 4 + kk] = pd;
            __syncthreads();
            if (kk == 0) {
                const float num = (part[(par * 4 + 0) * 128 + c] + part[(par * 4 + 1) * 128 + c]) + (part[(par * 4 + 2) * 128 + c] + part[(par * 4 + 3) * 128 + c]);
                const float den = (pden[par * 4 + 0] + pden[par * 4 + 1]) + (pden[par * 4 + 2] + pden[par * 4 + 3]);
                hb[s * 128 + c] = num * scale / fmaxf(fabsf(den * scale), __expf(-mn));
            }
        }
        __syncthreads();
#pragma unroll
        for (int rr = 0; rr < 2; ++rr) { const int s = F.wave * 2 + rr; const size_t t = (size_t)b * SEQ + t0 + s;
            const float v0 = hb[s * 128 + F.lane_id()], v1 = hb[s * 128 + 64 + F.lane_id()];
            const float rstd = rsqrtf(wave_sum(v0 * v0 + v1 * v1) * (1.f / 128.f) + EPS);
            const float o0 = bf2f(proj[t * NPROJ + PC_MLO + h * 128 + F.lane_id()]), o1 = bf2f(proj[t * NPROJ + PC_MLO + h * 128 + 64 + F.lane_id()]);
            H0[t * 512 + h * 128 + F.lane_id()] = (bf16)f2bf(v0 * rstd * F.in[I_MLGOUT][h * 128 + F.lane_id()] * sigm(o0));
            H0[t * 512 + h * 128 + 64 + F.lane_id()] = (bf16)f2bf(v1 * rstd * F.in[I_MLGOUT][h * 128 + 64 + F.lane_id()] * sigm(o1)); }
    }
    __syncthreads();
}

DI void nsa_scores(const bf16* krow, bool valid, const LAS float* qs, float (&s)[4]) {
    s[0] = s[1] = s[2] = s[3] = 0.f;
    if (valid) {
#pragma unroll 2
        for (int c8 = 0; c8 < 8; ++c8) { const v4u kk = *(const v4u*)(krow + c8 * 8);
            const unsigned w[4] = {kk.x, kk.y, kk.z, kk.w};
#pragma unroll
            for (int j = 0; j < 4; ++j) { const float k0 = __uint_as_float(w[j] << 16), k1 = __uint_as_float(w[j] & 0xffff0000u); const int d = c8 * 8 + 2 * j;
#pragma unroll
                for (int g = 0; g < 4; ++g) s[g] = fmaf(k1, qs[g * 64 + d + 1], fmaf(k0, qs[g * 64 + d], s[g])); } }
    }
}
DI void nsa_wave(Frame& F, int item, LAS float* wl) {
    unsigned char* ws = F.ws; const int lane = F.lane_id();
    const int t = item >> 1, hkv = item & 1, b = t >> 11, tau = t & 2047;
    const bf16* proj = (const bf16*)(ws + WS_PROJ);
    const bf16* qn = (const bf16*)(ws + WS_QN); const bf16* ksn = (const bf16*)(ws + WS_KSN); const bf16* kwn = (const bf16*)(ws + WS_KWN);
    const bf16* kc = (const bf16*)(ws + WS_KC); const bf16* vc = (const bf16*)(ws + WS_VC); bf16* H1 = (bf16*)(ws + WS_H1);
    LAS float* qs = wl;
    LAS float* ps = wl + 256;
    LAS float* psum = wl + 768;
#pragma unroll
    for (int g = 0; g < 4; ++g) qs[g * 64 + lane] = bf2f(qn[(size_t)t * 512 + (hkv * 4 + g) * 64 + lane]);
    float ofin[4] = {0.f, 0.f, 0.f, 0.f};
    float gate[4][3];
#pragma unroll
    for (int g = 0; g < 4; ++g)
#pragma unroll
        for (int cidx = 0; cidx < 3; ++cidx) gate[g][cidx] = sigm(bf2f(proj[(size_t)t * NPROJ + PC_NG + (hkv * 4 + g) * 3 + cidx]));
    const int ncmp = tau >= 31 ? ((tau - 31) >> 4) + 1 : 0;
    {
        float l[4] = {0.f, 0.f, 0.f, 0.f}, o[4] = {0.f, 0.f, 0.f, 0.f};
        const size_t rbase = (size_t)(b * 2 + hkv) * 128;
#pragma unroll
        for (int blk = 0; blk < 2; ++blk) { const int n = blk * 64 + lane; const bool valid = n < ncmp; float s[4];
            nsa_scores(kc + (rbase + n) * 64, valid, qs, s);
#pragma unroll
            for (int g = 0; g < 4; ++g) { const float p = valid ? __expf(s[g]) : 0.f; l[g] += p; ps[g * 128 + n] = p; } }
        float inv[4];
#pragma unroll
        for (int g = 0; g < 4; ++g) { const float L = wave_sum(l[g]); inv[g] = L > 0.f ? 1.f / L : 0.f; }
#pragma unroll
        for (int blk = 0; blk < 2; ++blk) { const int n = blk * 64 + lane; psum[n] = (ps[0 * 128 + n] * inv[0] + ps[1 * 128 + n] * inv[1]) + (ps[2 * 128 + n] * inv[2] + ps[3 * 128 + n] * inv[3]); }
#pragma unroll 2
        for (int n = 0; n < ncmp; ++n) { const float vv = bf2f(vc[(rbase + n) * 64 + lane]);
#pragma unroll
            for (int g = 0; g < 4; ++g) o[g] = fmaf(ps[g * 128 + n], vv, o[g]); }
#pragma unroll
        for (int g = 0; g < 4; ++g) ofin[g] += gate[g][0] * o[g] * inv[g];
    }
    const int cur = tau >> 6;
    unsigned selmask = 0u;
    {
        float score = -3.0e38f;
        if (lane < 32) { const int j = lane; float imp = 0.f;
#pragma unroll
            for (int dn = -1; dn <= 3; ++dn) { const int n = 4 * j + dn; if (n >= 0 && n <= 126) imp += psum[n]; }
            const bool forced = (j == 0) || (j == cur) || (j == cur - 1);
            score = j > cur ? NEGF : imp + (forced ? 1.0e4f : 0.f); }
#pragma unroll 1
        for (int r = 0; r < 8; ++r) { const float mx = wave_max(score); const unsigned long long bal = __ballot(score == mx); const int win = __ffsll((long long)bal) - 1;
            selmask |= 1u << win; if (lane == win) score = -3.4e38f; }
    }
    {
        float l[4] = {0.f, 0.f, 0.f, 0.f}, o[4] = {0.f, 0.f, 0.f, 0.f};
#pragma unroll 1
        for (int j = 0; j <= cur; ++j) { if (!((selmask >> j) & 1u)) continue;
            const int kpos = 64 * j + lane; const bool valid = kpos <= tau; float s[4];
            nsa_scores(ksn + ((size_t)b * SEQ + kpos) * 128 + hkv * 64, valid, qs, s);
#pragma unroll
            for (int g = 0; g < 4; ++g) { const float p = valid ? __expf(s[g]) : 0.f; l[g] += p; ps[g * 128 + lane] = p; }
            const int nk = j == cur ? (tau & 63) + 1 : 64;
            const bf16* vb = proj + ((size_t)b * SEQ + 64 * j) * NPROJ + PC_NVS + hkv * 64 + lane;
#pragma unroll 2
            for (int k = 0; k < nk; ++k) { const float vv = bf2f(vb[(size_t)k * NPROJ]);
#pragma unroll
                for (int g = 0; g < 4; ++g) o[g] = fmaf(ps[g * 128 + k], vv, o[g]); } }
#pragma unroll
        for (int g = 0; g < 4; ++g) { const float L = wave_sum(l[g]); ofin[g] += gate[g][1] * o[g] * (L > 0.f ? 1.f / L : 0.f); }
    }
    {
        float l[4] = {0.f, 0.f, 0.f, 0.f}, o[4] = {0.f, 0.f, 0.f, 0.f};
        const int start = tau - 511 > 0 ? tau - 511 : 0;
#pragma unroll 1
        for (int base = start & ~63; base <= tau; base += 64) {
            const int kpos = base + lane; const bool valid = kpos >= start && kpos <= tau; float s[4];
            nsa_scores(kwn + ((size_t)b * SEQ + kpos) * 128 + hkv * 64, valid, qs, s);
#pragma unroll
            for (int g = 0; g < 4; ++g) { const float p = valid ? __expf(s[g]) : 0.f; l[g] += p; ps[g * 128 + lane] = p; }
            const int k0 = start > base ? start - base : 0, k1 = tau - base < 63 ? tau - base : 63;
            const bf16* vb = proj + ((size_t)b * SEQ + base) * NPROJ + PC_NVW + hkv * 64 + lane;
#pragma unroll 2
            for (int k = k0; k <= k1; ++k) { const float vv = bf2f(vb[(size_t)k * NPROJ]);
#pragma unroll
                for (int g = 0; g < 4; ++g) o[g] = fmaf(ps[g * 128 + k], vv, o[g]); } }
#pragma unroll
        for (int g = 0; g < 4; ++g) { const float L = wave_sum(l[g]); ofin[g] += gate[g][2] * o[g] * (L > 0.f ? 1.f / L : 0.f); }
    }
#pragma unroll
    for (int g = 0; g < 4; ++g) H1[(size_t)t * 512 + (hkv * 4 + g) * 64 + lane] = (bf16)f2bf(ofin[g]);
}
DI void mem_wave(Frame& F, int t, LAS float* wl) {
    unsigned char* ws = F.ws; const int lane = F.lane_id(); const int b = t >> 11;
    const bf16* mqn = (const bf16*)(ws + WS_MQN); const bf16* memkn = (const bf16*)(ws + WS_MEMKN); const bf16* memkv = (const bf16*)(ws + WS_MEMKV); bf16* H2 = (bf16*)(ws + WS_H2);
    LAS float* qs = wl;
    LAS float* ps = wl + 128;
#pragma unroll 1
    for (int h = 0; h < 4; ++h) {
        qs[lane] = bf2f(mqn[(size_t)t * 512 + h * 128 + lane]); qs[64 + lane] = bf2f(mqn[(size_t)t * 512 + h * 128 + 64 + lane]);
        float l = 0.f;
#pragma unroll 1
        for (int kq = 0; kq < 4; ++kq) { const int key = kq * 64 + lane; const bf16* kr = memkn + ((size_t)b * MEML + key) * 512 + h * 128; float s = 0.f;
#pragma unroll 2
            for (int c8 = 0; c8 < 16; ++c8) { const v4u kk = *(const v4u*)(kr + c8 * 8); const unsigned w[4] = {kk.x, kk.y, kk.z, kk.w};
#pragma unroll
                for (int j = 0; j < 4; ++j) s = fmaf(__uint_as_float(w[j] & 0xffff0000u), qs[c8 * 8 + 2 * j + 1], fmaf(__uint_as_float(w[j] << 16), qs[c8 * 8 + 2 * j], s)); }
            const float p = __expf(s); l += p; ps[key] = p; }
        const float inv = 1.f / wave_sum(l);
        float o0 = 0.f, o1 = 0.f;
        const bf16* vb = memkv + (size_t)b * MEML * 1024 + 512 + h * 128;
#pragma unroll 4
        for (int key = 0; key < MEML; ++key) { const float p = ps[key]; o0 = fmaf(p, bf2f(vb[(size_t)key * 1024 + lane]), o0); o1 = fmaf(p, bf2f(vb[(size_t)key * 1024 + 64 + lane]), o1); }
        H2[(size_t)t * 512 + h * 128 + lane] = (bf16)f2bf(o0 * inv); H2[(size_t)t * 512 + h * 128 + 64 + lane] = (bf16)f2bf(o1 * inv);
    }
}
typedef float f32x16 __attribute__((ext_vector_type(16)));
typedef float f32x2v __attribute__((ext_vector_type(2)));
typedef __bf16 bf16x2v __attribute__((ext_vector_type(2)));
typedef short s16x4 __attribute__((ext_vector_type(4)));
typedef unsigned u32x2 __attribute__((ext_vector_type(2)));
#define MFMA32(a, b, c) __builtin_amdgcn_mfma_f32_32x32x16_bf16((a), (b), (c), 0, 0, 0)
#define WG_BAR() do { asm volatile("s_waitcnt vmcnt(0) lgkmcnt(0)" ::: "memory"); __builtin_amdgcn_s_barrier(); asm volatile("" ::: "memory"); } while (0)
DI unsigned pkbf(float lo, float hi) { f32x2v v = {lo, hi}; return __builtin_bit_cast(unsigned, __builtin_convertvector(v, bf16x2v)); }
template <int S> DI bf16x8 pack8(const f32x16& x) {
    v4u p; p.x = pkbf(x[8 * S], x[8 * S + 1]); p.y = pkbf(x[8 * S + 2], x[8 * S + 3]); p.z = pkbf(x[8 * S + 4], x[8 * S + 5]); p.w = pkbf(x[8 * S + 6], x[8 * S + 7]);
    return __builtin_bit_cast(bf16x8, p);
}
DI int crow(int i, int h) { return (i & 3) + 8 * (i >> 2) + 4 * h; }
constexpr int AT_K = 0, AT_V = 32768, AT_IMP = 65536, AT_WM = 98304, AT_INV = 98368, AT_SC = 99392;

DI void glds16(const void* gsrc, unsigned lds_dst) { unsigned keep; asm volatile("s_mov_b32 %0, m0\n\ts_mov_b32 m0, %2\n\ts_nop 0\n\tglobal_load_lds_dwordx4 %1, off\n\ts_mov_b32 m0, %0" : "=&s"(keep) : "v"(gsrc), "s"(lds_dst) : "memory"); }
DI void at_load(LAS unsigned char* lds, int par, const void* kb, size_t kpitch, const void* vb, size_t vpitch, int wave, int lane) {
    const int row = 8 * wave + (lane >> 3), pc = lane & 7;
    const int kc = pc ^ ((row >> 1) & 7), vc = pc ^ (((row >> 1) & 1) << 2);
    glds16((const char*)kb + (size_t)row * kpitch + 16 * kc, (unsigned)(size_t)(lds + AT_K + par * 8192 + wave * 1024));
    glds16((const char*)vb + (size_t)row * vpitch + 16 * vc, (unsigned)(size_t)(lds + AT_V + par * 8192 + wave * 1024));
}
#define SB() __builtin_amdgcn_sched_barrier(0)
typedef __attribute__((address_space(3))) s16x4 lds_s16x4;
DI void at_qk(const LAS unsigned char* kbuf, const int (&ka)[4], const bf16x8 (&qf)[4], f32x16 (&s)[2]) {
    bf16x8 kf[2][4];
#pragma unroll
    for (int kb = 0; kb < 2; ++kb)
#pragma unroll
        for (int st = 0; st < 4; ++st) kf[kb][st] = *(const LAS bf16x8*)(kbuf + ka[st] + kb * 4096);
    SB();
#pragma unroll
    for (int kb = 0; kb < 2; ++kb) {
        f32x16 a;
#pragma unroll
        for (int i = 0; i < 16; ++i) a[i] = 0.f;
#pragma unroll
        for (int st = 0; st < 4; ++st) a = MFMA32(kf[kb][st], qf[st], a);
        s[kb] = a;
    }
}
DI void at_vload(const LAS unsigned char* vbuf, const int (&va)[2], int kb, bf16x8 (&vf)[2][2]) {
#pragma unroll
    for (int s2 = 0; s2 < 2; ++s2)
#pragma unroll
        for (int db = 0; db < 2; ++db) {
            const s16x4 lo = __builtin_amdgcn_ds_read_tr16_b64_v4i16((lds_s16x4*)(vbuf + va[db] + kb * 4096 + s2 * 2048));
            const s16x4 hi = __builtin_amdgcn_ds_read_tr16_b64_v4i16((lds_s16x4*)(vbuf + va[db] + kb * 4096 + s2 * 2048 + 1024));
            vf[s2][db] = __builtin_shufflevector(lo, hi, 0, 1, 2, 3, 4, 5, 6, 7); }
}
DI void at_pv1(const bf16x8 (&vf)[2][2], const f32x16& p, f32x16 (&o)[2]) {
    const bf16x8 pf0 = pack8<0>(p), pf1 = pack8<1>(p);
#pragma unroll
    for (int s2 = 0; s2 < 2; ++s2)
#pragma unroll
        for (int db = 0; db < 2; ++db) o[db] = MFMA32(vf[s2][db], s2 ? pf1 : pf0, o[db]);
}
DI void at_pv(const LAS unsigned char* vbuf, const int (&va)[2], const bf16x8 (&vf0)[2][2], const f32x16 (&p)[2], f32x16 (&o)[2]) {
    bf16x8 vf1[2][2]; at_vload(vbuf, va, 1, vf1);
    at_pv1(vf0, p[0], o);
    at_pv1(vf1, p[1], o);
}
DI void at_exp_all(f32x16 (&s)[2], float& l) {
#pragma unroll
    for (int kb = 0; kb < 2; ++kb)
#pragma unroll
        for (int i = 0; i < 16; ++i) { const float p = __builtin_amdgcn_exp2f(s[kb][i]); s[kb][i] = p; l += p; }
}
DI void at_wait(int n) {
    if (n >= 2) asm volatile("s_waitcnt vmcnt(4)" ::: "memory"); else if (n == 1) asm volatile("s_waitcnt vmcnt(2)" ::: "memory"); else asm volatile("s_waitcnt vmcnt(0)" ::: "memory");
    asm volatile("s_waitcnt lgkmcnt(0)" ::: "memory"); __builtin_amdgcn_s_barrier(); asm volatile("" ::: "memory");
}
template <bool STORE = true, bool DO_CMP = true, bool DO_SEL = true, bool DO_WIN = true>
DI void nsa_unit(Frame& F, int unit) {
    unsigned char* ws = F.ws; LAS unsigned char* lds = F.lds;
    int lane_ = F.lane_id();
    const int lane = lane_, wave = F.wave, r = lane & 31, h = lane >> 5, g = wave >> 1, qh = wave & 1;
    const int bh = unit & 31, qt = 31 - (unit >> 5), b = bh >> 1, hkv = bh & 1;
    const int qloc = 32 * qh + r, tau = 64 * qt + qloc, qq = tau & 63; const size_t t = (size_t)b * SEQ + tau;
    const bf16* proj = (const bf16*)(ws + WS_PROJ);
    const bf16* qn = (const bf16*)(ws + WS_QN); const bf16* ksn = (const bf16*)(ws + WS_KSN); const bf16* kwn = (const bf16*)(ws + WS_KWN);
    const bf16* kc = (const bf16*)(ws + WS_KC); const bf16* vc = (const bf16*)(ws + WS_VC); bf16* H1 = (bf16*)(ws + WS_H0);
    int ka[4], va[2];
    { const int f = (r >> 1) & 7, fs = f >> 1, hb = h ^ (f & 1);
#pragma unroll
      for (int st = 0; st < 4; ++st) ka[st] = r * 128 + 16 * (((st ^ fs) << 1) | hb);
      const int i16 = lane & 15, q = i16 >> 2, p = i16 & 3, g1 = (lane >> 4) & 1;
#pragma unroll
      for (int db = 0; db < 2; ++db) va[db] = (4 * h + q) * 128 + 16 * ((4 * db + 2 * g1 + (p >> 1)) ^ (((q >> 1) & 1) << 2)) + 8 * (p & 1); }
    bf16x8 qf[4];
#pragma unroll
    for (int st = 0; st < 4; ++st) qf[st] = *(const bf16x8*)(qn + t * 512 + (hkv * 4 + g) * 64 + 16 * st + 8 * h);
    float gate[3];
#pragma unroll
    for (int c = 0; c < 3; ++c) gate[c] = sigm(bf2f(proj[t * NPROJ + PC_NG + (hkv * 4 + g) * 3 + c]));
    f32x16 ofin[2];
#pragma unroll
    for (int i = 0; i < 16; ++i) { ofin[0][i] = 0.f; ofin[1][i] = 0.f; }
    WG_BAR();
    if (DO_CMP) {
        const int ncq = tau >= 31 ? ((tau - 31) >> 4) + 1 : 0;
        const int ntc = (((64 * qt + 63 - 31) >> 4) + 1 > 64) ? 2 : 1;
        const char* kb0 = (const char*)(kc + (size_t)(b * 2 + hkv) * 128 * 64); const char* vb0 = (const char*)(vc + (size_t)(b * 2 + hkv) * 128 * 64);
        at_load(lds, 0, kb0, 128, vb0, 128, wave, lane);
        if (ntc == 2) at_load(lds, 1, kb0 + 64 * 128, 128, vb0 + 64 * 128, 128, wave, lane);
        WG_BAR();
        f32x16 o[2]; float l = 0.f, prevEp = 0.f;
#pragma unroll
        for (int i = 0; i < 16; ++i) { o[0][i] = 0.f; o[1][i] = 0.f; }
        LAS float* I = (LAS float*)(lds + AT_IMP) + (g * 64 + qloc) * 32;
#pragma unroll 1
        for (int tile = 0; tile < 2; ++tile) {
            if (tile < ntc) {
                f32x16 s[2];
                at_qk(lds + AT_K + tile * 8192, ka, qf, s);
                bf16x8 vf[2][2]; at_vload(lds + AT_V + tile * 8192, va, 0, vf); SB();
#pragma unroll
                for (int kb = 0; kb < 2; ++kb)
#pragma unroll
                    for (int i = 0; i < 16; ++i) { const int n = 64 * tile + 32 * kb + crow(i, h); const float p = n < ncq ? __builtin_amdgcn_exp2f(s[kb][i]) : 0.f; s[kb][i] = p; l += p; }
#pragma unroll
                for (int kb = 0; kb < 2; ++kb)
#pragma unroll
                    for (int a = 0; a < 4; ++a) { const int idx = tile * 8 + kb * 4 + a; const float Gv = (s[kb][4 * a] + s[kb][4 * a + 1]) + (s[kb][4 * a + 2] + s[kb][4 * a + 3]);
                        const float Epv = __shfl_xor(s[kb][4 * a + 3], 32);
                        I[2 * idx + h] = Gv + (h ? Epv : prevEp); prevEp = Epv; }
                at_pv(lds + AT_V + tile * 8192, va, vf, s, o);
            } else {
#pragma unroll
                for (int idx = 8; idx < 16; ++idx) I[2 * idx + h] = 0.f;
            }
        }
        const float L = l + __shfl_xor(l, 32); const float inv = L > 0.f ? 1.f / L : 0.f;
        const float gi = gate[0] * inv;
#pragma unroll
        for (int i = 0; i < 16; ++i) { ofin[0][i] += gi * o[0][i]; ofin[1][i] += gi * o[1][i]; }
        if (h == 0) ((LAS float*)(lds + AT_INV))[g * 64 + qloc] = inv;
    }
    WG_BAR();
    unsigned sel = 0u, wm = 0u, um = 0u;
    if (!DO_CMP) { sel = (qt == 31) ? 0xffffffffu : ((1u << (qt + 1)) - 1u); wm = sel; um = sel; }
    else {
        const LAS float* I = (const LAS float*)(lds + AT_IMP) + qloc * 32;
        const LAS float* IV = (const LAS float*)(lds + AT_INV) + qloc;
        const float iv0 = IV[0], iv1 = IV[64], iv2 = IV[128], iv3 = IV[192];
        LAS unsigned* SC = (LAS unsigned*)(lds + AT_SC) + (qh * 32 + r) * 33;
        if (g == 0 && h == 0) {
#pragma unroll 8
            for (int j = 0; j < 32; ++j) { const float imp = (I[j] * iv0 + I[64 * 32 + j] * iv1) + (I[2 * 64 * 32 + j] * iv2 + I[3 * 64 * 32 + j] * iv3);
                const bool cand = (j >= 1) && (j <= qt - 2);
                SC[j] = cand ? ((__float_as_uint(imp) & ~31u) | (unsigned)(31 - j)) + 32u : 0u; }
        }
        WG_BAR();
        if (qt <= 7) sel = (1u << (qt + 1)) - 1u;
        else {
            sel = 1u | (1u << qt) | (1u << (qt - 1));
            unsigned prev = 0xffffffffu;
#pragma unroll 1
            for (int rd = 0; rd < 5; ++rd) { unsigned best = 0u;
#pragma unroll 8
                for (int j = 0; j < 32; ++j) { const unsigned kx = SC[j]; const unsigned cnd = kx < prev ? kx : 0u; best = cnd > best ? cnd : best; }
                prev = best; if (best) sel |= 1u << (31 - (int)(best & 31u)); }
        }
        sel &= (qt == 31) ? 0xffffffffu : ((1u << (qt + 1)) - 1u);
        wm = sel;
#pragma unroll
        for (int o = 1; o < 32; o <<= 1) wm |= (unsigned)__shfl_xor((int)wm, o);
        wm = (unsigned)__builtin_amdgcn_readfirstlane((int)wm);
        if (lane == 0) ((LAS unsigned*)(lds + AT_WM))[wave] = wm;
        WG_BAR();
        um = 0u;
#pragma unroll
        for (int w = 0; w < 8; ++w) um |= ((const LAS unsigned*)(lds + AT_WM))[w];
        um = (unsigned)__builtin_amdgcn_readfirstlane((int)um);
    }
    if (DO_SEL) {
        f32x16 o[2]; float l = 0.f;
#pragma unroll
        for (int i = 0; i < 16; ++i) { o[0][i] = 0.f; o[1][i] = 0.f; }
        const char* kbase = (const char*)(ksn + (size_t)b * SEQ * 128 + hkv * 64); const char* vbase = (const char*)((const bf16*)(ws + WS_VSN) + (size_t)b * SEQ * 128 + hkv * 64);
        unsigned rem = um, im = um; int k = 0; const int T = __popc(um);
#pragma unroll 1
        for (int i = 0; i < 3 && im; ++i) { const int jn = __ffs((int)im) - 1; im &= im - 1u; at_load(lds, i, kbase + (size_t)jn * 64 * 256, 256, vbase + (size_t)jn * 64 * 256, 256, wave, lane); }
#pragma unroll 1
        while (rem) {
            const int j = __ffs((int)rem) - 1; rem &= rem - 1u;
            at_wait(T - k - 1);
#ifdef NSA_E1
            at_wait(T - k - 1);
#endif
            if (im) { const int jn = __ffs((int)im) - 1; im &= im - 1u; at_load(lds, (k + 3) & 3, kbase + (size_t)jn * 64 * 256, 256, vbase + (size_t)jn * 64 * 256, 256, wave, lane); }
            const int par = k & 3;
            if ((wm >> j) & 1u) {
                f32x16 s[2];
                at_qk(lds + AT_K + par * 8192, ka, qf, s);
                bf16x8 vf[2][2]; at_vload(lds + AT_V + par * 8192, va, 0, vf); SB();
                const bool on = (sel >> j) & 1u;
                if (j != qt && __all(on)) at_exp_all(s, l);
                else { const int klim = j == qt ? qq : 63;
#pragma unroll
                    for (int kb = 0; kb < 2; ++kb)
#pragma unroll
                        for (int i = 0; i < 16; ++i) { const int key = 32 * kb + crow(i, h); const float p = (on && key <= klim) ? __builtin_amdgcn_exp2f(s[kb][i]) : 0.f; s[kb][i] = p; l += p; } }
                at_pv(lds + AT_V + par * 8192, va, vf, s, o);
            }
            ++k;
        }
        const float L = l + __shfl_xor(l, 32); const float gi = gate[1] * (L > 0.f ? 1.f / L : 0.f);
#pragma unroll
        for (int i = 0; i < 16; ++i) { ofin[0][i] += gi * o[0][i]; ofin[1][i] += gi * o[1][i]; }
    }
    WG_BAR();
    if (DO_WIN) {
        f32x16 o[2]; float l = 0.f;
#pragma unroll
        for (int i = 0; i < 16; ++i) { o[0][i] = 0.f; o[1][i] = 0.f; }
        const char* kbase = (const char*)(kwn + (size_t)b * SEQ * 128 + hkv * 64); const char* vbase = (const char*)((const bf16*)(ws + WS_VWN) + (size_t)b * SEQ * 128 + hkv * 64);
        const int jlo = qt > 8 ? qt - 8 : 0; const int T = qt - jlo + 1;
#ifdef NSA_E2
        f32x16 o2[2]; float l2 = 0.f;
#pragma unroll
        for (int i = 0; i < 16; ++i) { o2[0][i] = 0.f; o2[1][i] = 0.f; }
#endif
#pragma unroll 1
        for (int i = 0; i < 3 && i < T; ++i) at_load(lds, i, kbase + (size_t)(jlo + i) * 64 * 256, 256, vbase + (size_t)(jlo + i) * 64 * 256, 256, wave, lane);
#pragma unroll 1
        for (int k = 0; k < T; ++k) {
            const int j = jlo + k, par = k & 3;
            at_wait(T - k - 1);
#ifdef NSA_E1
            at_wait(T - k - 1);
#endif
            if (k + 3 < T) at_load(lds, (k + 3) & 3, kbase + (size_t)(j + 3) * 64 * 256, 256, vbase + (size_t)(j + 3) * 64 * 256, 256, wave, lane);
            f32x16 s[2];
            at_qk(lds + AT_K + par * 8192, ka, qf, s);
            bf16x8 vf[2][2]; at_vload(lds + AT_V + par * 8192, va, 0, vf); SB();
#ifdef NSA_E2
            { f32x16 s2[2]; asm volatile("" ::: "memory"); at_qk(lds + AT_K + par * 8192, ka, qf, s2); bf16x8 vf2[2][2]; at_vload(lds + AT_V + par * 8192, va, 0, vf2); SB(); at_exp_all(s2, l2); at_pv(lds + AT_V + par * 8192, va, vf2, s2, o2); }
#endif
            if (j != qt && j != qt - 8) at_exp_all(s, l);
            else { const int klo = (j == qt - 8) ? qq + 1 : 0, khi = (j == qt) ? qq : 63;
#pragma unroll
                for (int kb = 0; kb < 2; ++kb)
#pragma unroll
                    for (int i = 0; i < 16; ++i) { const int key = 32 * kb + crow(i, h); const float p = (key >= klo && key <= khi) ? __builtin_amdgcn_exp2f(s[kb][i]) : 0.f; s[kb][i] = p; l += p; } }
            at_pv(lds + AT_V + par * 8192, va, vf, s, o);
        }
#ifdef NSA_E2
        { const float z = l2 * 0.f;
#pragma unroll
          for (int i = 0; i < 16; ++i) { ofin[0][i] += z * o2[0][i]; ofin[1][i] += z * o2[1][i]; } }
#endif
        const float L = l + __shfl_xor(l, 32); const float gi = gate[2] * (L > 0.f ? 1.f / L : 0.f);
#pragma unroll
        for (int i = 0; i < 16; ++i) { ofin[0][i] += gi * o[0][i]; ofin[1][i] += gi * o[1][i]; }
    }
    if (!STORE) { asm volatile("" :: "v"(ofin[0]), "v"(ofin[1])); return; }
    WG_BAR();
#pragma unroll
    for (int db = 0; db < 2; ++db)
#pragma unroll
        for (int a = 0; a < 4; ++a) { u32x2 w; w.x = pkbf(ofin[db][4 * a], ofin[db][4 * a + 1]); w.y = pkbf(ofin[db][4 * a + 2], ofin[db][4 * a + 3]); *(LAS u32x2*)(lds + qloc * 528 + g * 128 + (32 * db + 8 * a + 4 * h) * 2) = w; }
    WG_BAR();
    { const int tid = wave * 64 + lane; bf16* obase = H1 + ((size_t)b * SEQ + 64 * qt) * 1536 + 512 + hkv * 256;
#pragma unroll
      for (int i = 0; i < 4; ++i) { const int piece = tid + 512 * i, row = piece >> 5, c = piece & 31; *(v4u*)(obase + (size_t)row * 1536 + 8 * c) = *(const LAS v4u*)(lds + row * 528 + 16 * c); } }
}
constexpr int ML_K = 0, ML_V = 32768, ML_VW = 65536, ML_C = 81920, ML_N = 114688, ML_SS = 115200, ML_WS = 116224, ML_GO = 120320, ML_ST = 135424;
DI int ml_fk(int s) { return ((s & 3) << 2) | ((s >> 2) & 3); }
DI void ml_load(LAS unsigned char* lds, int par, const char* kb, const char* vb, int wave, int lane) {
#pragma unroll
    for (int n2 = 0; n2 < 2; ++n2) { const int n = 2 * wave + n2, row = 4 * n + (lane >> 4), pc = lane & 15;
        const int kc = pc ^ ml_fk(row), vc = pc ^ ((row & 3) << 2);
        glds16(kb + (size_t)row * 2048 + 16 * kc, (unsigned)(size_t)(lds + ML_K + par * 16384 + n * 1024));
        glds16(vb + (size_t)row * 1024 + 16 * vc, (unsigned)(size_t)(lds + ML_V + par * 16384 + n * 1024)); }
}
DI bf16x8 ml_tr8(const LAS unsigned char* p) {
    const s16x4 lo = __builtin_amdgcn_ds_read_tr16_b64_v4i16((lds_s16x4*)p); const s16x4 hi = __builtin_amdgcn_ds_read_tr16_b64_v4i16((lds_s16x4*)(p + 1024));
    return __builtin_shufflevector(lo, hi, 0, 1, 2, 3, 4, 5, 6, 7);
}
template <int PM = 0xff>
DI void mlstm_unit2(Frame& F, int unit) {
    unsigned char* ws = F.ws; LAS unsigned char* lds = F.lds;
    int lane_ = F.lane_id();
    const int lane = lane_, wave = F.wave, tid = wave * 64 + lane, r = lane & 31, hh = lane >> 5, tb = wave >> 2, vb = wave & 3;
    const int b = unit >> 2, hd = unit & 3;
    const bf16* proj = (const bf16*)(ws + WS_PROJ); const bf16* mlqk = (const bf16*)(ws + WS_MLQK); bf16* H0 = (bf16*)(ws + WS_H0);
    const size_t tok0 = (size_t)b * SEQ;
    const char* kbase = (const char*)(mlqk + tok0 * 1024 + 512 + hd * 128); const char* vbase = (const char*)((const bf16*)(ws + WS_MLV) + tok0 * 512 + hd * 128);
    const float LOG2E = 1.4426950408889634f;
    const int i16 = lane & 15, q4 = i16 >> 2, p4 = i16 & 3, g1 = (lane >> 4) & 1;
    const int colsw = 16 * ((4 * vb + 2 * g1 + (p4 >> 1)) ^ (q4 << 2)) + 8 * (p4 & 1);
    const int base_c = (8 * hh + q4) * 256 + colsw;
    const int base_v = (4 * hh + q4) * 256 + colsw;
    const int fK = ml_fk(r), rowK = r * 256 + ((hh ^ (fK & 1)) << 4), F16 = (fK & 14) << 4;
    int base_kt[2][2];
#pragma unroll
    for (int blk = 0; blk < 2; ++blk)
#pragma unroll
        for (int hi = 0; hi < 2; ++hi) { const int kbp = 2 * tb + blk; base_kt[blk][hi] = (8 * hh + 4 * hi + q4) * 256 + 16 * ((4 * kbp + 2 * g1 + (p4 >> 1)) ^ ((q4 << 2) | ((2 * hh + hi) & 3))) + 8 * (p4 & 1); }
    LAS float* WS = (LAS float*)(lds + ML_WS) + wave * 128;
    LAS float* NV = (LAS float*)(lds + ML_N); LAS float* SS = (LAS float*)(lds + ML_SS);
    __syncthreads();
    for (int i = tid; i < 32768 / 16; i += 512) ((LAS v4u*)(lds + ML_C))[i] = (v4u){0u, 0u, 0u, 0u};
    if (tid < 128) NV[tid] = 0.f;
    f32x16 Cst[2];
#pragma unroll
    for (int i = 0; i < 16; ++i) { Cst[0][i] = 0.f; Cst[1][i] = 0.f; }
    if (tid < 128) ((LAS float*)(lds + ML_GO))[tid] = F.in[I_MLGOUT][hd * 128 + tid];
    const float bi = F.in[I_MLBI][hd], bfv = F.in[I_MLBF][hd];
    float m_prev = 0.f;
    ml_load(lds, 0, kbase, vbase, wave, lane);
    bf16x8 qf[8];
    { const bf16* qp = mlqk + (tok0 + 32 * tb + r) * 1024 + hd * 128 + 8 * hh;
#pragma unroll
      for (int st = 0; st < 8; ++st) qf[st] = *(const bf16x8*)(qp + 16 * st); }
    float gi_raw = bf2f(proj[(tok0 + lane) * NPROJ + PC_MLI + hd]), gf_raw = bf2f(proj[(tok0 + lane) * NPROJ + PC_MLF + hd]);
#pragma unroll 1
    for (int c = 0; c < 32; ++c) {
        const int par = c & 1; const size_t tokc = tok0 + 64 * c;
        WG_BAR();
        if ((PM & 1) && c > 0) {
            bf16* obase = H0 + (tokc - 64) * 1536 + hd * 128;
#pragma unroll
            for (int i = 0; i < 2; ++i) { const int piece = tid + 512 * i, row = piece >> 4, cc = piece & 15; *(v4u*)(obase + (size_t)row * 1536 + 8 * cc) = *(const LAS v4u*)(lds + ML_ST + row * 272 + 16 * cc); } }
        if (c < 31) ml_load(lds, par ^ 1, kbase + (size_t)(64 * (c + 1)) * 2048, vbase + (size_t)(64 * (c + 1)) * 1024, wave, lane);
        u32x2 og[4];
        { const bf16* op = proj + (tokc + 32 * tb + r) * NPROJ + PC_MLO + hd * 128 + 32 * vb + 4 * hh;
#pragma unroll
          for (int a = 0; a < 4; ++a) og[a] = *(const u32x2*)(op + 8 * a); }
        const float ig = gi_raw + bi, lf = logsig(gf_raw + bfv);
        float bc = lf;
        if (PM & 2) {
#pragma unroll
        for (int o = 1; o < 64; o <<= 1) { const float v = __shfl_up(bc, o); if (lane >= o) bc += v; } }
        const float rr = ig - bc;
        float cm = rr;
        if (PM & 2) {
#pragma unroll
        for (int o = 1; o < 64; o <<= 1) { const float v = __shfl_up(cm, o); if (lane >= o) cm = fmaxf(cm, v); } }
        const float M63 = fmaxf(m_prev, __shfl(cm, 63)), blast = __shfl(bc, 63);
        const float a_old = __expf(m_prev - M63), m_new = blast + M63;
        const int tl = 32 * tb + r;
        const float Mt = fmaxf(m_prev, __shfl(cm, tl)), bt = __shfl(bc, tl);
        const float inter = __expf(m_prev - Mt), m_t = bt + Mt;
        WS[lane] = rr * LOG2E; WS[64 + lane] = __expf(rr - M63);
        const float MtL = Mt * LOG2E;
        const LAS unsigned char* kbuf = lds + ML_K + par * 16384; const LAS unsigned char* vbuf = lds + ML_V + par * 16384;
        f32x16 wd[2]; float dsum = 0.f;
#pragma unroll
        for (int kb = 0; kb < 2; ++kb) {
#pragma unroll
            for (int i = 0; i < 16; ++i) wd[kb][i] = 0.f;
            if ((PM & 4) && kb <= tb) {
                f32x16 a = wd[kb]; bf16x8 kfr[8];
#pragma unroll
                for (int st = 0; st < 8; ++st) kfr[st] = *(const LAS bf16x8*)(kbuf + kb * 8192 + rowK + ((32 * st) ^ F16));
                SB();
#pragma unroll
                for (int st = 0; st < 8; ++st) a = MFMA32(kfr[st], qf[st], a);
#pragma unroll
                for (int i = 0; i < 16; ++i) { const int s = 32 * kb + crow(i, hh); const float e = __builtin_amdgcn_exp2f(WS[s] - MtL); const float w = (s <= tl) ? e * a[i] : 0.f; a[i] = w; dsum += w; }
                wd[kb] = a;
            }
        }
        f32x16 acc; bf16x8 cfr[8];
#pragma unroll
        for (int i = 0; i < 16; ++i) acc[i] = 0.f;
        if (PM & 8) {
#pragma unroll
        for (int st = 0; st < 8; ++st) cfr[st] = ml_tr8(lds + ML_C + base_c + st * 4096);
        SB();
#pragma unroll
        for (int st = 0; st < 8; ++st) acc = MFMA32(cfr[st], qf[st], acc); }
#pragma unroll
        for (int i = 0; i < 16; ++i) acc[i] *= inter;
#pragma unroll
        for (int kb = 0; kb < 2; ++kb) {
            if ((PM & 16) && kb <= tb) {
                const bf16x8 pf0 = pack8<0>(wd[kb]), pf1 = pack8<1>(wd[kb]);
                {
#pragma unroll
                  for (int s2 = 0; s2 < 2; ++s2) { const LAS unsigned char* p = vbuf + base_v + kb * 8192 + s2 * 4096;
                    const s16x4 lo = __builtin_amdgcn_ds_read_tr16_b64_v4i16((lds_s16x4*)p); const s16x4 hi = __builtin_amdgcn_ds_read_tr16_b64_v4i16((lds_s16x4*)(p + 2048));
                    const bf16x8 vf = __builtin_shufflevector(lo, hi, 0, 1, 2, 3, 4, 5, 6, 7);
                    acc = MFMA32(vf, s2 ? pf1 : pf0, acc); } }
            }
        }
        float qn_ = 0.f;
        if (PM & 32)
#pragma unroll
        for (int st = 0; st < 8; ++st) { const v4u qw = __builtin_bit_cast(v4u, qf[st]); const LAS float* np = NV + 16 * st + 8 * hh; const f32x4 n0 = *(const LAS f32x4*)np, n1 = *(const LAS f32x4*)(np + 4);
            qn_ = fmaf(__uint_as_float(qw.x << 16), n0[0], qn_); qn_ = fmaf(__uint_as_float(qw.x & 0xffff0000u), n0[1], qn_); qn_ = fmaf(__uint_as_float(qw.y << 16), n0[2], qn_); qn_ = fmaf(__uint_as_float(qw.y & 0xffff0000u), n0[3], qn_);
            qn_ = fmaf(__uint_as_float(qw.z << 16), n1[0], qn_); qn_ = fmaf(__uint_as_float(qw.z & 0xffff0000u), n1[1], qn_); qn_ = fmaf(__uint_as_float(qw.w << 16), n1[2], qn_); qn_ = fmaf(__uint_as_float(qw.w & 0xffff0000u), n1[3], qn_); }
        qn_ += __shfl_xor(qn_, 32); dsum += __shfl_xor(dsum, 32);
        const float den = inter * qn_ + dsum; const float rden = 1.f / fmaxf(fabsf(den), __expf(-m_t));
        float ssq = 0.f;
#pragma unroll
        for (int i = 0; i < 16; ++i) { acc[i] *= rden; ssq = fmaf(acc[i], acc[i], ssq); }
        ssq += __shfl_xor(ssq, 32);
        if (hh == 0) SS[vb * 64 + tl] = ssq;
        if (PM & 64)
#pragma unroll
        for (int k2 = 0; k2 < 2; ++k2) { const int ci = tid + 512 * k2, s = ci >> 4; const float w = WS[64 + s];
            const v4u x = *(const LAS v4u*)(vbuf + ci * 16); v4u y; const unsigned xs[4] = {x.x, x.y, x.z, x.w}; unsigned ys[4];
#pragma unroll
            for (int j = 0; j < 4; ++j) ys[j] = pkbf(__uint_as_float(xs[j] << 16) * w, __uint_as_float(xs[j] & 0xffff0000u) * w);
            y.x = ys[0]; y.y = ys[1]; y.z = ys[2]; y.w = ys[3]; *(LAS v4u*)(lds + ML_VW + ci * 16) = y; }
        asm volatile("s_waitcnt lgkmcnt(0)" ::: "memory"); __builtin_amdgcn_s_barrier(); asm volatile("" ::: "memory");
        if (c < 31) {
            const bf16* qp = mlqk + (tokc + 64 + 32 * tb + r) * 1024 + hd * 128 + 8 * hh;
#pragma unroll
            for (int st = 0; st < 8; ++st) qf[st] = *(const bf16x8*)(qp + 16 * st);
            gi_raw = bf2f(proj[(tokc + 64 + lane) * NPROJ + PC_MLI + hd]); gf_raw = bf2f(proj[(tokc + 64 + lane) * NPROJ + PC_MLF + hd]);
        }
        { const LAS float* GO = (const LAS float*)(lds + ML_GO) + 32 * vb + 4 * hh;
          const float rstd = rsqrtf(((SS[tl] + SS[64 + tl]) + (SS[128 + tl] + SS[192 + tl])) * (1.f / 128.f) + EPS);
#pragma unroll
          for (int a = 0; a < 4; ++a) { float o4[4]; const unsigned gw[2] = {og[a].x, og[a].y};
#pragma unroll
              for (int j = 0; j < 4; ++j) { const float ov = (j & 1) ? __uint_as_float(gw[j >> 1] & 0xffff0000u) : __uint_as_float(gw[j >> 1] << 16); o4[j] = acc[4 * a + j] * rstd * GO[8 * a + j] * sigm(ov); }
              u32x2 w; w.x = pkbf(o4[0], o4[1]); w.y = pkbf(o4[2], o4[3]); *(LAS u32x2*)(lds + ML_ST + tl * 272 + (32 * vb + 8 * a + 4 * hh) * 2) = w; } }
        if (PM & 128)
#pragma unroll
        for (int blk = 0; blk < 2; ++blk) {
            f32x16 cs = Cst[blk];
#pragma unroll
            for (int i = 0; i < 16; ++i) cs[i] *= a_old;
            bf16x8 afr[4], kfr2[4];
#pragma unroll
            for (int st = 0; st < 4; ++st) {
                afr[st] = ml_tr8(lds + ML_VW + base_c + st * 4096);
                const s16x4 lo = __builtin_amdgcn_ds_read_tr16_b64_v4i16((lds_s16x4*)(kbuf + base_kt[blk][0] + st * 4096)); const s16x4 hi = __builtin_amdgcn_ds_read_tr16_b64_v4i16((lds_s16x4*)(kbuf + base_kt[blk][1] + st * 4096));
                kfr2[st] = __builtin_shufflevector(lo, hi, 0, 1, 2, 3, 4, 5, 6, 7);
            }
            SB();
#pragma unroll
            for (int st = 0; st < 4; ++st) cs = MFMA32(afr[st], kfr2[st], cs);
            Cst[blk] = cs;
            const int kk = 32 * (2 * tb + blk) + r;
#pragma unroll
            for (int a = 0; a < 4; ++a) { u32x2 w; w.x = pkbf(cs[4 * a], cs[4 * a + 1]); w.y = pkbf(cs[4 * a + 2], cs[4 * a + 3]);
                *(LAS u32x2*)(lds + ML_C + kk * 256 + 16 * ((4 * vb + a) ^ ((r & 3) << 2)) + 8 * hh) = w; }
        }
        if ((PM & 64) && tid < 128) { float nv = NV[tid] * a_old;
#pragma unroll 8
            for (int s = 0; s < 64; ++s) { const unsigned short kvs = *(const LAS unsigned short*)(kbuf + s * 256 + 16 * ((tid >> 3) ^ ml_fk(s)) + 2 * (tid & 7)); nv = fmaf(WS[64 + s], bf2f(kvs), nv); }
            NV[tid] = nv; }
        m_prev = m_new;
    }
    __syncthreads();
    if (PM & 1) { bf16* obase = H0 + (tok0 + 64 * 31) * 1536 + hd * 128;
#pragma unroll
        for (int i = 0; i < 2; ++i) { const int piece = tid + 512 * i, row = piece >> 4, cc = piece & 15; *(v4u*)(obase + (size_t)row * 1536 + 8 * cc) = *(const LAS v4u*)(lds + ML_ST + row * 272 + 16 * cc); } }
    __syncthreads();
}
DI void mem_load(LAS unsigned char* lds, int par, const char* kb, const char* vb, int wave, int lane) {
#pragma unroll
    for (int n2 = 0; n2 < 2; ++n2) { const int n = 2 * wave + n2, row = 4 * n + (lane >> 4), pc = lane & 15;
        const int kc = pc ^ ml_fk(row), vc = pc ^ ((row & 3) << 2);
        glds16(kb + (size_t)row * 1024 + 16 * kc, (unsigned)(size_t)(lds + ML_K + par * 16384 + n * 1024));
        glds16(vb + (size_t)row * 2048 + 16 * vc, (unsigned)(size_t)(lds + ML_V + par * 16384 + n * 1024)); }
}
template <bool STORE = true, bool DMA = true, bool COMP = true>
DI void mem_unit(Frame& F, int unit) {
    unsigned char* ws = F.ws; LAS unsigned char* lds = F.lds;
    int lane_ = F.lane_id();
    const int lane = lane_, wave = F.wave, r = lane & 31, hh = lane >> 5;
    const int b = unit >> 5, hd = (unit >> 3) & 3, qt = unit & 7;
    const bf16* mqn = (const bf16*)(ws + WS_MQN); const bf16* memkn = (const bf16*)(ws + WS_MEMKN); const bf16* memkv = (const bf16*)(ws + WS_MEMKV); bf16* H2 = (bf16*)(ws + WS_H0);
    const size_t t = (size_t)b * SEQ + 256 * qt + 32 * wave + r;
    const char* kbase = (const char*)(memkn + (size_t)b * MEML * 512 + hd * 128); const char* vbase = (const char*)(memkv + (size_t)b * MEML * 1024 + 512 + hd * 128);
    const int i16 = lane & 15, q4 = i16 >> 2, p4 = i16 & 3, g1 = (lane >> 4) & 1;
    int base_v[4];
#pragma unroll
    for (int db = 0; db < 4; ++db) base_v[db] = (4 * hh + q4) * 256 + 16 * ((4 * db + 2 * g1 + (p4 >> 1)) ^ (q4 << 2)) + 8 * (p4 & 1);
    const int fK = ml_fk(r), rowK = r * 256 + ((hh ^ (fK & 1)) << 4), F16 = (fK & 14) << 4;
    bf16x8 qf[8];
#pragma unroll
    for (int st = 0; st < 8; ++st) qf[st] = *(const bf16x8*)(mqn + t * 512 + hd * 128 + 16 * st + 8 * hh);
    f32x16 o[4]; float l = 0.f;
#pragma unroll
    for (int db = 0; db < 4; ++db)
#pragma unroll
        for (int i = 0; i < 16; ++i) o[db][i] = 0.f;
    WG_BAR();
    if (DMA) mem_load(lds, 0, kbase, vbase, wave, lane);
#pragma unroll 1
    for (int tile = 0; tile < 4; ++tile) {
        const int par = tile & 1;
        WG_BAR();
        if (DMA && tile < 3) mem_load(lds, par ^ 1, kbase + (size_t)(64 * (tile + 1)) * 1024, vbase + (size_t)(64 * (tile + 1)) * 2048, wave, lane);
        const LAS unsigned char* kbuf = lds + ML_K + par * 16384; const LAS unsigned char* vbuf = lds + ML_V + par * 16384;
        if (COMP)
#pragma unroll
        for (int kb = 0; kb < 2; ++kb) {
            bf16x8 kf[8];
#pragma unroll
            for (int st = 0; st < 8; ++st) kf[st] = *(const LAS bf16x8*)(kbuf + kb * 8192 + rowK + ((32 * st) ^ F16));
            SB();
            f32x16 a;
#pragma unroll
            for (int i = 0; i < 16; ++i) a[i] = 0.f;
#pragma unroll
            for (int st = 0; st < 8; ++st) a = MFMA32(kf[st], qf[st], a);
            bf16x8 vf[2][4];
#pragma unroll
            for (int s2 = 0; s2 < 2; ++s2)
#pragma unroll
                for (int db = 0; db < 4; ++db) { const LAS unsigned char* p = vbuf + base_v[db] + kb * 8192 + s2 * 4096;
                    const s16x4 lo = __builtin_amdgcn_ds_read_tr16_b64_v4i16((lds_s16x4*)p); const s16x4 hi = __builtin_amdgcn_ds_read_tr16_b64_v4i16((lds_s16x4*)(p + 2048));
                    vf[s2][db] = __builtin_shufflevector(lo, hi, 0, 1, 2, 3, 4, 5, 6, 7); }
            SB();
#pragma unroll
            for (int i = 0; i < 16; ++i) { a[i] = __builtin_amdgcn_exp2f(a[i]); l += a[i]; }
            const bf16x8 pf0 = pack8<0>(a), pf1 = pack8<1>(a);
#pragma unroll
            for (int s2 = 0; s2 < 2; ++s2)
#pragma unroll
                for (int db = 0; db < 4; ++db) o[db] = MFMA32(vf[s2][db], s2 ? pf1 : pf0, o[db]);
        }
    }
    const float inv = 1.f / (l + __shfl_xor(l, 32));
    if (!STORE) {
#pragma unroll
        for (int db = 0; db < 4; ++db) asm volatile("" :: "v"(o[db]), "v"(inv));
        return; }
    WG_BAR();
#pragma unroll
    for (int db = 0; db < 4; ++db)
#pragma unroll
        for (int a = 0; a < 4; ++a) { u32x2 w; w.x = pkbf(o[db][4 * a] * inv, o[db][4 * a + 1] * inv); w.y = pkbf(o[db][4 * a + 2] * inv, o[db][4 * a + 3] * inv);
            *(LAS u32x2*)(lds + (32 * wave + r) * 272 + (32 * db + 8 * a + 4 * hh) * 2) = w; }
    WG_BAR();
    { const int tid = wave * 64 + lane; bf16* obase = H2 + ((size_t)b * SEQ + 256 * qt) * 1536 + 1024 + hd * 128;
#pragma unroll
      for (int i = 0; i < 8; ++i) { const int piece = tid + 512 * i, row = piece >> 4, c = piece & 15; *(v4u*)(obase + (size_t)row * 1536 + 8 * c) = *(const LAS v4u*)(lds + row * 272 + 16 * c); } }
}
DI int q_pop(Frame& F, unsigned* qc) {
    __syncthreads();
    if (F.tid_id() == 0) F.MISC[16] = atomicAdd(qc, 1u);
    __syncthreads();
    return (int)F.MISC[16];
}
template <bool ML, bool NSA, bool MEMA, bool MST = true, bool MDMA = true, bool MCOMP = true, bool NST = true, bool NCMP = true, bool NSEL = true, bool NWIN = true, int MLPM = 0xff>
DI void p5_queue(Frame& F, int cbase) {
    unsigned* qc = F.ctl + CW_QCTR + cbase;
    if (ML) {
#pragma unroll 1
        for (;;) { const int it = q_pop(F, qc); if (it >= 64) break; mlstm_unit2<MLPM>(F, it); }
    }
    if (NSA) {
#pragma unroll 1
        for (;;) { const int it = q_pop(F, qc + 64); if (it >= 1024) break; nsa_unit<NST, NCMP, NSEL, NWIN>(F, it); }
    }
    if (MEMA) {
#pragma unroll 1
        for (;;) { const int it = q_pop(F, qc + 128); if (it >= 512) break; mem_unit<MST, MDMA, MCOMP>(F, it); }
    }
    __syncthreads();
}
DI void p5_mixers(Frame& F) {
    const int nml = F.G >= 128 ? 64 : 0;
#ifndef RPT_ML
#define RPT_ML 1
#endif
#ifndef RPT_NSA
#define RPT_NSA 1
#endif
#ifndef RPT_MEM
#define RPT_MEM 1
#endif
    if (F.bx < nml || nml == 0) { for (int rp = 0; rp < RPT_ML; ++rp) for (int u = F.bx; u < 64; u += (nml ? nml : F.G)) mlstm_unit2(F, u); }
    if (F.bx >= nml) {
        LAS float* wl = (LAS float*)(F.lds + F.wave * 4096);
        const int gw = (F.bx - nml) * NWAVES + F.wave, NGW = (F.G - nml) * NWAVES;
        for (int rp = 0; rp < RPT_NSA; ++rp) for (int u = F.bx - nml; u < 1024; u += F.G - nml) nsa_unit(F, u);
        __syncthreads();
        for (int rp = 0; rp < RPT_MEM; ++rp) for (int t = gw; t < MT; t += NGW) mem_wave(F, t, wl);
    }
}

DI void p8_router(Frame& F, int alt) {
    unsigned char* ws = F.ws + (size_t)alt * 3 * MiB; const int lane = F.lane_id(), tid = F.tid_id(), wave = F.wave, r = lane & 31, hh = lane >> 5;
    unsigned char* xn8 = (unsigned char*)(F.ws + WS_R1);
    int* tok_e = (int*)(ws + WS_ROUTE + RT_TOKE); int* tok_pos = (int*)(ws + WS_ROUTE + RT_TOKPOS); float* tok_w = (float*)(ws + WS_ROUTE + RT_TOKW);
    unsigned* gcnt = F.ctl + CW_ECNT + 64 * alt;
    const bf16* wrt = (const bf16*)(F.ws + WS_SMALL + SM_WRT);
    LAS unsigned char* img = F.lds;
    LAS float* part = (LAS float*)F.lds;
    LAS float* lg = (LAS float*)(F.lds + 4 * 64 * 33 * 4);
    LAS int* lcnt = (LAS int*)(F.lds + RING_BYTES + 1024);
    LAS int* lbase = lcnt + 32;
    LAS int* se = lbase + 32;
    LAS int* sp = se + 256;
    LAS float* sw = (LAS float*)(sp + 256);
    const float* gf = F.in[I_GFFN];
    for (int bt = F.bx; bt < MT / 64; bt += F.G) {
        __syncthreads();
        if (tid < 32) lcnt[tid] = 0;
#pragma unroll 2
        for (int i = 0; i < 8; ++i) {
            const int tl = wave * 8 + i, t = bt * 64 + tl;
            const f32x4* xr = (const f32x4*)(F.out + (size_t)t * DM) + lane; const f32x4* gr = (const f32x4*)gf + lane;
            f32x4 v[4]; float s = 0.f;
#pragma unroll
            for (int j = 0; j < 4; ++j) { v[j] = xr[64 * j]; s += (v[j].x * v[j].x + v[j].y * v[j].y) + (v[j].z * v[j].z + v[j].w * v[j].w); }
            const float rstd = rsqrtf(wave_sum(s) * (1.f / DM) + EPS);
            unsigned* o4 = (unsigned*)(xn8 + (size_t)t * DM) + lane;
#pragma unroll
            for (int j = 0; j < 4; ++j) { const f32x4 gg = gr[64 * j];
                const float y0 = v[j].x * rstd * gg.x, y1 = v[j].y * rstd * gg.y, y2 = v[j].z * rstd * gg.z, y3 = v[j].w * rstd * gg.w;
                const unsigned long long w = (unsigned long long)pk2(y0, y1) | ((unsigned long long)pk2(y2, y3) << 32);
                int q8 = 0; q8 = __builtin_amdgcn_cvt_pk_fp8_f32(y0, y1, q8, false); q8 = __builtin_amdgcn_cvt_pk_fp8_f32(y2, y3, q8, true);
                o4[64 * j] = (unsigned)q8;
                const int d = 4 * lane + 256 * j, ch = d >> 3;
                *(LAS unsigned long long*)(img + tl * 2048 + 16 * (ch ^ (tl & 15)) + 2 * (d & 7)) = w; }
        }
        __syncthreads();
        {
            const int mb = wave & 1, kq = wave >> 1, trow = 32 * mb + r;
            f32x16 acc;
#pragma unroll
            for (int i = 0; i < 16; ++i) acc[i] = 0.f;
#pragma unroll 4
            for (int s2 = 0; s2 < 16; ++s2) { const int st = 16 * kq + s2;
                const bf16x8 xa = *(const LAS bf16x8*)(img + trow * 2048 + 16 * ((2 * st + hh) ^ (trow & 15)));
                const bf16x8 wh = *(const bf16x8*)(wrt + (size_t)r * 1024 + 16 * st + 8 * hh), wl = *(const bf16x8*)(wrt + 32 * 1024 + (size_t)r * 1024 + 16 * st + 8 * hh);
                acc = MFMA32(xa, wh, acc); acc = MFMA32(xa, wl, acc); }
            __syncthreads();
#pragma unroll
            for (int i = 0; i < 16; ++i) part[(kq * 64 + 32 * mb + crow(i, hh)) * 33 + r] = acc[i];
        }
        __syncthreads();
        for (int i = tid; i < 64 * 32; i += 512) { const int tk = i >> 5, e = i & 31; lg[tk * 33 + e] = ((part[(0 * 64 + tk) * 33 + e] + part[(1 * 64 + tk) * 33 + e]) + (part[(2 * 64 + tk) * 33 + e] + part[(3 * 64 + tk) * 33 + e])) + F.in[I_BR][e]; }
        __syncthreads();
        for (int i = 0; i < 8; ++i) {
            const int tl = wave * 8 + i, e = lane & 31;
            float sc = lg[tl * 33 + e]; int ek[4]; float vk[4];
#pragma unroll
            for (int rd = 0; rd < 4; ++rd) { const float mx = wave_max(sc); const unsigned long long bal = __ballot(sc == mx); const int win = (__ffsll((long long)bal) - 1) & 31;
                ek[rd] = win; vk[rd] = mx; if (e == win) sc = -3.4e38f; }
            const float e1 = __expf(vk[1] - vk[0]), e2 = __expf(vk[2] - vk[0]), e3 = __expf(vk[3] - vk[0]); const float inv = 1.f / (1.f + e1 + e2 + e3);
            if (lane == 0) {
                const float wk[4] = {inv, e1 * inv, e2 * inv, e3 * inv};
#pragma unroll
                for (int rd = 0; rd < 4; ++rd) { se[tl * 4 + rd] = ek[rd]; sw[tl * 4 + rd] = wk[rd]; sp[tl * 4 + rd] = atomicAdd((int*)&lcnt[ek[rd]], 1); }
            }
        }
        __syncthreads();
        if (tid < 32) lbase[tid] = (int)atomicAdd(&gcnt[tid], (unsigned)lcnt[tid]);
        __syncthreads();
        if (tid < 256) { const int t = bt * 64 + (tid >> 2), k = tid & 3; const int e = se[tid];
          tok_e[t * 4 + k] = e; tok_pos[t * 4 + k] = lbase[e] + sp[tid]; tok_w[t * 4 + k] = sw[tid]; }
    }
    __syncthreads();
}
DI int moe_tables(Frame& F, LAS int* pstart, LAS unsigned char* blk_e) {
    unsigned* gcnt = F.ctl + CW_ECNT;
    __syncthreads();
    if (F.tid_id() == 0) { int acc = 0; for (int e = 0; e < NEXP; ++e) { const int cnt = (int)__hip_atomic_load(&gcnt[e], __ATOMIC_RELAXED, __HIP_MEMORY_SCOPE_AGENT); pstart[e] = acc; acc += (cnt + MOEB - 1) / MOEB * MOEB; } pstart[NEXP] = acc; }
    __syncthreads();
    const int nblk = pstart[NEXP] / MOEB;
    for (int rb = F.tid_id(); rb < nblk; rb += 512) { int e = 0; while (e < NEXP - 1 && pstart[e + 1] <= rb * MOEB) ++e; blk_e[rb] = (unsigned char)e; }
    __syncthreads();
    return nblk;
}
DI void p9_scatter(Frame& F) {
    unsigned char* ws = F.ws; const int lane = F.lane_id();
    LAS int* pstart = (LAS int*)(F.lds + 65536); LAS unsigned char* blk_e = (LAS unsigned char*)(F.lds + 65536 + 256);
    moe_tables(F, pstart, blk_e);
    const unsigned char* xn8 = (const unsigned char*)(ws + WS_R1); unsigned char* aperm = (unsigned char*)(ws + WS_APERM);
    const int* tok_e = (const int*)(ws + WS_ROUTE + RT_TOKE); const int* tok_pos = (const int*)(ws + WS_ROUTE + RT_TOKPOS); const float* tok_w = (const float*)(ws + WS_ROUTE + RT_TOKW);
    int* tok_dest = (int*)(ws + WS_ROUTE + RT_TOKDEST); float* roww = (float*)(ws + WS_ROUTE + RT_ROWW);
    unsigned* gcnt = F.ctl + CW_ECNT;
    const int gw = F.bx * NWAVES + F.wave, NGW = F.G * NWAVES;
    for (int t4 = gw; t4 < MT / 4; t4 += NGW) {
        int dest = 0;
        if (lane < 16) { const int it = t4 * 16 + lane; dest = pstart[tok_e[it]] + tok_pos[it]; tok_dest[it] = dest; roww[dest] = tok_w[it]; }
        v4u v0[4];
#pragma unroll
        for (int q = 0; q < 4; ++q) { const v4u* src = (const v4u*)(xn8 + (size_t)(t4 * 4 + q) * DM); v0[q] = src[lane]; }
#pragma unroll
        for (int q = 0; q < 4; ++q)
#pragma unroll
            for (int k = 0; k < 4; ++k) { const int d = __shfl(dest, q * 4 + k); v4u* dst = (v4u*)(aperm + (size_t)d * DM); dst[lane] = v0[q]; }
    }
    for (int it = gw; it < NEXP * MOEB; it += NGW) { const int e = it >> 8, i = it & 255; const int cnt = (int)__hip_atomic_load(&gcnt[e], __ATOMIC_RELAXED, __HIP_MEMORY_SCOPE_AGENT); const int padded = (cnt + MOEB - 1) / MOEB * MOEB;
        if (i < padded - cnt) { const int dest = pstart[e] + cnt + i; v4u* dst = (v4u*)(aperm + (size_t)dest * DM); const v4u z = {0u, 0u, 0u, 0u}; dst[lane] = z; if (lane == 0) roww[dest] = 0.f; } }
}
DI void p12_combine(Frame& F) {
    unsigned char* ws = F.ws; const int lane = F.lane_id();
    const bf16* ybuf = (const bf16*)(ws + WS_APERM); const int* tok_dest = (const int*)(ws + WS_ROUTE + RT_TOKDEST);
    const int gw = F.bx * NWAVES + F.wave, NGW = F.G * NWAVES;
    for (int t2 = gw; t2 < MT / 2; t2 += NGW) {
        typedef int i32x4 __attribute__((ext_vector_type(4)));
        unsigned long long w[2][4][4]; f32x4 a[2][4];
#pragma unroll
        for (int q = 0; q < 2; ++q) { const int t = 2 * t2 + q; const f32x4* orow = (const f32x4*)(F.out + (size_t)t * DM);
            const i32x4 d = *(const i32x4*)(tok_dest + t * 4);
            const unsigned long long* y0 = (const unsigned long long*)(ybuf + (size_t)d.x * DM) + lane; const unsigned long long* y1 = (const unsigned long long*)(ybuf + (size_t)d.y * DM) + lane;
            const unsigned long long* y2 = (const unsigned long long*)(ybuf + (size_t)d.z * DM) + lane; const unsigned long long* y3 = (const unsigned long long*)(ybuf + (size_t)d.w * DM) + lane;
#pragma unroll
            for (int j = 0; j < 4; ++j) { w[q][0][j] = y0[64 * j]; w[q][1][j] = y1[64 * j]; w[q][2][j] = y2[64 * j]; w[q][3][j] = y3[64 * j]; a[q][j] = orow[lane + 64 * j]; } }
#pragma unroll
        for (int q = 0; q < 2; ++q) { f32x4* orow = (f32x4*)(F.out + (size_t)(2 * t2 + q) * DM);
#pragma unroll
            for (int j = 0; j < 4; ++j) {
#pragma unroll
                for (int k = 0; k < 4; ++k) { const unsigned long long ww = w[q][k][j];
                    a[q][j].x += __uint_as_float((unsigned)ww << 16); a[q][j].y += __uint_as_float((unsigned)ww & 0xffff0000u); a[q][j].z += __uint_as_float((unsigned)(ww >> 32) << 16); a[q][j].w += __uint_as_float((unsigned)(ww >> 32) & 0xffff0000u); }
                orow[lane + 64 * j] = a[q][j]; } }
    }
}

constexpr int N_PHASES = 13;
#ifndef MK_PER_PHASE
#define MK_PER_PHASE 0
#endif
__global__ void __launch_bounds__(NWAVES * 64, 2) fwd_kernel(Args args) {
    extern __shared__ __attribute__((aligned(16))) unsigned char lds_raw[];
    Frame F;
    F.lds = (LAS unsigned char*)lds_raw; F.MISC = (volatile LAS unsigned*)(F.lds + MISC_OFF);
    F.wave = __builtin_amdgcn_readfirstlane((int)(threadIdx.x >> 6)); F.G = gridDim.x; F.bx = blockIdx.x;
    F.ws = args.ws; F.ctl = (unsigned*)(args.ws + WS_CTL); F.in = args.in; F.out = args.out;
    unsigned char* ws = args.ws;
    for (int u = threadIdx.x; u < (LDS_BYTES - LDSCTL_OFF) / 4; u += NWAVES * 64) ((LAS unsigned*)(F.lds + LDSCTL_OFF))[u] = 0u;
    __syncthreads();
    const int lo = args.ph_lo, hi = args.ph_hi;
    XcdBarrier bar; bar.wv = F.wave; bar.bar = F.ctl + CW_BAR; bar.x = 0; bar.st = nullptr;
    if (hi - lo > 1) bar = xcd_barrier_post(F.ctl + CW_BAR, F.MISC + 8, F.wave);
#ifndef PH_MASK
#define PH_MASK 0x1fff
#endif
#define IN(k) (((PH_MASK >> (k)) & 1) && lo <= (k) && (k) < hi)
#define SEAM(k) do { if (IN(k) && IN((k) + 1)) xcd_barrier(bar); } while (0)
    typedef pg8::bf16_t b16;
#ifndef RPT_MASK
#define RPT_MASK 0
#endif
#define RPT(k) _Pragma("unroll") for (int rp_ = 0; rp_ < 1 + ((RPT_MASK >> (k)) & 1); ++rp_)
    if (IN(0)) { RPT(0) p0_prologue(F); } SEAM(0);
    if (IN(1)) RPT(1) {
        { pg8::Gemm8 g{(const unsigned char*)(ws + WS_U8), (const unsigned char*)(ws + WS_WIN8), MT, NF8, DM, 0x7f7f7f7f, 0x77777777}; pg8::StaticOrder S; S.init(MT, NF8, F.G, F.bx);
          pg8::EpiBf16Silu E{(b16*)(ws + WS_PROJ) + NB16, NPROJ, nullptr, 0};
          pg8::gemm_phase_f8<pg8::EpiBf16Silu, pg8::StaticOrder, true, true>(F.lds, g, S, E, F.wave); }
        { pg8::Gemm g{(const b16*)(ws + WS_R1), (const b16*)(ws + WS_WIN), MT, NB16, DM}; pg8::StaticOrder S; S.init(MT, NB16, F.G, F.bx);
          pg8::EpiBf16Silu E{(b16*)(ws + WS_PROJ), NPROJ, nullptr, 0};
          pg8::gemm_phase<pg8::EpiBf16Silu, pg8::StaticOrder, true, true>(F.lds, g, S, E, F.wave); }
        { pg8::Gemm g{(const b16*)(ws + WS_MEMN), (const b16*)(ws + WS_WMKV), MROWS, 1024, DM}; pg8::StaticOrder S; S.init(MROWS, 1024, F.G, (F.bx + 64) % F.G);
          pg8::EpiBf16Silu E{(b16*)(ws + WS_MEMKV), 1024, nullptr, 0};
          pg8::gemm_phase<pg8::EpiBf16Silu, pg8::StaticOrder, true, true>(F.lds, g, S, E, F.wave); }
    } SEAM(1);
    if (IN(2)) { RPT(2) p2_prep(F); } SEAM(2);
    if (IN(3)) RPT(3) {
#pragma unroll
        for (int kv = 0; kv < 2; ++kv) {
            pg8::Gemm g{(const b16*)(ws + WS_ACMP) + (size_t)kv * 4096 * 2048, (const b16*)(ws + WS_WC1) + (size_t)kv * 256 * 2048, 4096, 256, 2048}; pg8::StaticOrder S; S.init(4096, 256, F.G, (F.bx + F.G - 16 * kv) % F.G);
            pg8::EpiBf16Silu E{(b16*)(ws + WS_HID) + (size_t)kv * 4096 * 256, 256, (const float*)(ws + WS_SMALL + SM_CBIAS) + kv * 256, 1};
            pg8::gemm_phase<pg8::EpiBf16Silu, pg8::StaticOrder, true, true>(F.lds, g, S, E, F.wave); }
    } SEAM(3);
    if (IN(4)) { RPT(4) p4_kcvc(F); } SEAM(4);
#ifndef RPT5_ML
#define RPT5_ML 0
#endif
#ifndef MLPROBE
#define MLPROBE 0xff
#endif
#ifndef NPROBE_ST
#define NPROBE_ST true
#endif
#ifndef NPROBE_CMP
#define NPROBE_CMP true
#endif
#ifndef NPROBE_SEL
#define NPROBE_SEL true
#endif
#ifndef NPROBE_WIN
#define NPROBE_WIN true
#endif
#ifndef MPROBE_ST
#define MPROBE_ST true
#endif
#ifndef MPROBE_DMA
#define MPROBE_DMA true
#endif
#ifndef MPROBE_COMP
#define MPROBE_COMP true
#endif
#ifndef RPT5_NSA
#define RPT5_NSA 0
#endif
#ifndef RPT5_MEM
#define RPT5_MEM 0
#endif
    if (IN(5)) { p5_queue<true, true, true>(F, 0);
        if (RPT5_ML || RPT5_NSA || RPT5_MEM) { xcd_barrier(bar); p5_queue<RPT5_ML != 0, RPT5_NSA != 0, RPT5_MEM != 0, MPROBE_ST, MPROBE_DMA, MPROBE_COMP, NPROBE_ST, NPROBE_CMP, NPROBE_SEL, NPROBE_WIN, MLPROBE>(F, 256); } } SEAM(5);
    if (IN(6)) RPT(6) {
        pg8::StaticOrder S; S.init(MT, DM, F.G, F.bx);
        pg8::Gemm g{(const b16*)(ws + WS_H0), (const b16*)(ws + WS_WBR), MT, DM, 1536};
        pg8::EpiMergeK E{(const b16*)(ws + WS_PROJ), (b16*)(ws + WS_R1)};
        pg8::gemm_phase<pg8::EpiMergeK, pg8::StaticOrder, true, true>(F.lds, g, S, E, F.wave);
    } SEAM(6);
    if (IN(7)) RPT(7) {
        pg8::Gemm g{(const b16*)(ws + WS_R1), (const b16*)(ws + WS_WOUT), MT, DM, DM}; pg8::StaticOrder S; S.init(MT, DM, F.G, F.bx);
        pg8::EpiRes E{F.in[I_X], F.out};
        pg8::gemm_phase<pg8::EpiRes, pg8::StaticOrder, true, true>(F.lds, g, S, E, F.wave);
    } SEAM(7);
    if (IN(8)) { p8_router(F, 0); if ((RPT_MASK >> 8) & 1) p8_router(F, 1); } SEAM(8);
    if (IN(9)) { RPT(9) p9_scatter(F); } SEAM(9);
    if (IN(10)) RPT(10) {
        LAS int* pstart = (LAS int*)(F.lds + RING_BYTES + 1024); LAS unsigned char* blk_e = (LAS unsigned char*)(F.lds + RING_BYTES + 1024 + 256);
        const int nblk = moe_tables(F, pstart, blk_e);
        pg8::Gemm8 g{(const unsigned char*)(ws + WS_APERM), (const unsigned char*)(ws + WS_WGU), CAP, NEXP * 2048, DM, 0x7f7f7f7f, 0x77777777};
        pg8::MoeOrder<8> S{nblk, F.G, F.bx, (const PG8_LAS unsigned char*)blk_e};
        pg8::EpiSwiglu E{(unsigned char*)(ws + WS_ACT), F.in[I_BGU]};
        pg8::gemm_phase_f8<pg8::EpiSwiglu, pg8::MoeOrder<8>, true, true>(F.lds, g, S, E, F.wave);
    } SEAM(10);
    if (IN(11)) RPT(11) {
        LAS int* pstart = (LAS int*)(F.lds + RING_BYTES + 1024); LAS unsigned char* blk_e = (LAS unsigned char*)(F.lds + RING_BYTES + 1024 + 256);
        const int nblk = moe_tables(F, pstart, blk_e);
        pg8::Gemm8 g{(const unsigned char*)(ws + WS_ACT), (const unsigned char*)(ws + WS_WDN), CAP, NEXP * DM, DFF, 0x7f7f7f7f, 0x77777777};
        pg8::MoeOrder<4> S{nblk, F.G, F.bx, (const PG8_LAS unsigned char*)blk_e};
        pg8::EpiDown E{(b16*)(ws + WS_APERM), F.in[I_BDN], (const float*)(ws + WS_ROUTE + RT_ROWW)};
        pg8::gemm_phase_f8<pg8::EpiDown, pg8::MoeOrder<4>, true, true>(F.lds, g, S, E, F.wave);
    } SEAM(11);
    if (IN(12)) { p12_combine(F); }
#undef IN
#undef SEAM
}

extern "C" void kernel_launch(void* const* d_in, const int* in_sizes, int n_in, void* d_out, int out_size, void* d_ws, size_t ws_size, hipStream_t stream) {
    static int grid = 0;
    if (grid == 0) {
        if (n_in != N_IN || out_size != MT * DM || ws_size < WS_END) { fprintf(stderr, "kernel_launch: unexpected shapes (n_in %d, out %d, ws %zu need %zu)\n", n_in, out_size, ws_size, (size_t)WS_END); grid = -1; return; }
        int dev = 0, cus = 0, per_cu = 0;
        if (hipGetDevice(&dev) != hipSuccess || hipDeviceGetAttribute(&cus, hipDeviceAttributeMultiprocessorCount, dev) != hipSuccess) { grid = -1; return; }
        if (hipFuncSetAttribute((const void*)fwd_kernel, hipFuncAttributeMaxDynamicSharedMemorySize, LDS_BYTES) != hipSuccess) { fprintf(stderr, "kernel_launch: hipFuncSetAttribute failed\n"); grid = -1; return; }
        if (hipOccupancyMaxActiveBlocksPerMultiprocessor(&per_cu, (const void*)fwd_kernel, NWAVES * 64, LDS_BYTES) != hipSuccess || per_cu < 1) { fprintf(stderr, "kernel_launch: occupancy query says %d\n", per_cu); }
        (void)hipGetLastError();
        grid = cus;
    }
    if (grid < 0) return;
    if (hipMemsetAsync((char*)d_ws + WS_CTL, 0, CTL_ZERO_BYTES, stream) != hipSuccess) return;
    Args a{};
    for (int i = 0; i < N_IN; ++i) a.in[i] = (const float*)d_in[i];
    a.out = (float*)d_out; a.ws = (unsigned char*)d_ws;
#if MK_PER_PHASE
    for (int p = 0; p < N_PHASES; ++p) { a.ph_lo = p; a.ph_hi = p + 1; a.li = 0; hipLaunchKernelGGL(fwd_kernel, dim3(grid), dim3(NWAVES * 64), LDS_BYTES, stream, a); }
#else
    a.ph_lo = 0; a.ph_hi = N_PHASES; a.li = 0;
    hipLaunchKernelGGL(fwd_kernel, dim3(grid), dim3(NWAVES * 64), LDS_BYTES, stream, a);
#endif
}
```

```cpp
#include <hip/hip_runtime.h>
#include <cstdio>
#include <cstdint>
namespace pg8 {
#define PG8_LAS __attribute__((address_space(3)))
typedef unsigned short bf16_t;
typedef short bf16x8 __attribute__((ext_vector_type(8)));
typedef float f32x4 __attribute__((ext_vector_type(4)));
typedef unsigned u32x4 __attribute__((ext_vector_type(4)));
constexpr int BM = 256, BK = 64, HALF = 128, HTB = HALF * BK * 2  , STAGE_BYTES = 8 * HTB, NXCD = 8, WGM = 8;

__host__ __device__ __forceinline__ int lds_byte(int r, int c) { const int st = (r >> 4) * 2 + (c >> 5), rr = r & 15, cc = c & 31, ob = rr * 64 + cc * 2; return st * 1024 + (ob ^ (((ob >> 9) & 1) << 5)); }
__host__ __device__ __forceinline__ void stage_rc(int b, int& R, int& C) { const int st = b / 1024, sb = b % 1024, swz = sb ^ (((sb >> 9) & 1) << 5); R = (st >> 1) * 16 + swz / 64; C = (st & 1) * 32 + (swz % 64) / 2; }
__host__ __device__ __forceinline__ int perm32(int rho) { const int n = rho >> 4, i = rho & 15; return 8 * (i >> 2) + 4 * n + (i & 3); }

struct Unit { int pm, pn; };
struct Gemm { const bf16_t* A; const bf16_t* Bt; int M, N, K; };

struct StaticOrder {
    int nM, nN, nwg, G, c;
    __host__ __device__ void init(int M, int N, int G_, int c_) { nM = M / BM; nN = N / BM; nwg = nM * nN; G = G_; c = c_; }
    __host__ __device__ bool next(int i, Unit& u) const {
        const long L = (long)i * G + c; if (L >= nwg) return false;
        int wgid = (int)L; { const int q = nwg / NXCD, r = nwg % NXCD, xcd = wgid % NXCD, off = wgid / NXCD; wgid = (xcd < r ? xcd * (q + 1) : r * (q + 1) + (xcd - r) * q) + off; }
        const int nig = WGM * nN, gid = wgid / nig, fm = gid * WGM, gsz = (nM - fm) < WGM ? (nM - fm) : WGM;
        u.pm = fm + ((wgid % nig) % gsz); u.pn = (wgid % nig) / gsz; return true;
    }
    __device__ __forceinline__ void a_ready(const Unit&) const {}
    __device__ __forceinline__ void done(const Unit&) const {}
};

__device__ __forceinline__ unsigned cvt_pk_bf16(float lo, float hi) { unsigned r; asm volatile("v_cvt_pk_bf16_f32 %0, %1, %2" : "=v"(r) : "v"(lo), "v"(hi)); return r; }
typedef float f32x2 __attribute__((ext_vector_type(2)));
__device__ __forceinline__ f32x2 gelu_pk(f32x2 v) {
    const f32x2 av = __builtin_elementwise_abs(v), d = av * 0.2316418882f + 1.0f;
    f32x2 t; t.x = __builtin_amdgcn_rcpf(d.x); t.y = __builtin_amdgcn_rcpf(d.y);
    f32x2 q = t * 0.5307027145f + (-0.7265760135f); q = q * t + 0.7107068705f; q = q * t + (-0.142248368f); q = q * t + 0.127414796f; q = q * t;
    const f32x2 s = (v * v) * (-0.72134752044f);
    f32x2 e; e.x = __builtin_amdgcn_exp2f(s.x); e.y = __builtin_amdgcn_exp2f(s.y);
    const f32x2 m = v * (q * e), r = v - m;
    f32x2 o; o.x = v.x < 0.f ? m.x : r.x; o.y = v.y < 0.f ? m.y : r.y; return o;
}

template <int ACT  > struct EpiBf16 {
    static constexpr bool PERM = true, AFTER_DRAIN = false; static_assert(ACT == 0 || ACT == 1, "EpiBf16: ACT is 0 (none) or 1 (gelu_pk)");
    bf16_t* O; int ldc; const float* bias; int split_cols; size_t split_stride; float scale0;
    __device__ __forceinline__ void operator()(const f32x4 (&acc)[2][2][4][2], const Unit& u, int wr, int wc, int fr, int fq) const {
        const int row0 = u.pm * BM + wr * 64 + fr; int colt = u.pn * BM; bf16_t* base = O;
        float sc = 1.f; if (split_cols) { const int t = colt / split_cols; base += (size_t)t * split_stride; colt -= t * split_cols; if (t == 0) sc = scale0; }
        const int col0 = colt + wc * 32 + 8 * fq, bcol0 = u.pn * BM + wc * 32 + 8 * fq;
        f32x4 bv[2][2];
#pragma unroll
        for (int bj = 0; bj < 2; ++bj)
#pragma unroll
            for (int n = 0; n < 2; ++n) bv[bj][n] = bias ? *(const f32x4*)(bias + bcol0 + bj * HALF + 4 * n) : (f32x4){0.f, 0.f, 0.f, 0.f};
#pragma unroll
        for (int ai = 0; ai < 2; ++ai)
#pragma unroll
            for (int m = 0; m < 4; ++m) { bf16_t* rowp = base + (size_t)(row0 + ai * HALF + m * 16) * ldc + col0;
#pragma unroll
                for (int bj = 0; bj < 2; ++bj) { f32x4 v0 = acc[ai][bj][m][0] + bv[bj][0], v1 = acc[ai][bj][m][1] + bv[bj][1];
                    if (ACT == 1) { f32x2 a = gelu_pk((f32x2){v0[0], v0[1]}), b = gelu_pk((f32x2){v0[2], v0[3]}), c = gelu_pk((f32x2){v1[0], v1[1]}), d = gelu_pk((f32x2){v1[2], v1[3]});
                        v0 = (f32x4){a.x, a.y, b.x, b.y}; v1 = (f32x4){c.x, c.y, d.x, d.y}; }
                    v0 = v0 * sc; v1 = v1 * sc; u32x4 w; w.x = cvt_pk_bf16(v0[0], v0[1]); w.y = cvt_pk_bf16(v0[2], v0[3]); w.z = cvt_pk_bf16(v1[0], v1[1]); w.w = cvt_pk_bf16(v1[2], v1[3]);
                    *(u32x4*)(rowp + bj * HALF) = w; } }
    }
};

struct PanelStats {
    unsigned* xbuf;
    unsigned* cnt;
    unsigned* tmo;
    int ntn; float eps;
    unsigned code;
    __device__ __forceinline__ bool run(const f32x4 (&v)[2][2][4][2], const Unit& u, int wr, int wc, int fr, int fq, PG8_LAS unsigned char* lds, int wid, int lane) const {
        typedef float f32x2v __attribute__((ext_vector_type(2)));
        PG8_LAS f32x2v* P = (PG8_LAS f32x2v*)lds;
        PG8_LAS f32x2v* S = (PG8_LAS f32x2v*)(lds + 8192);
        PG8_LAS unsigned* flag = (PG8_LAS unsigned*)(lds + 8192 + 2048);
#pragma unroll
        for (int ai = 0; ai < 2; ++ai)
#pragma unroll
            for (int m = 0; m < 4; ++m) {
                float s = 0.f;
#pragma unroll
                for (int bj = 0; bj < 2; ++bj)
#pragma unroll
                    for (int n = 0; n < 2; ++n) { const f32x4 x = v[ai][bj][m][n]; s += (x[0] + x[1]) + (x[2] + x[3]); }
                s += __shfl_xor(s, 16); s += __shfl_xor(s, 32);
                const float mw = s * (1.0f / 64.0f); float q = 0.f;
#pragma unroll
                for (int bj = 0; bj < 2; ++bj)
#pragma unroll
                    for (int n = 0; n < 2; ++n) { const f32x4 d = v[ai][bj][m][n] - mw; q += (d[0] * d[0] + d[1] * d[1]) + (d[2] * d[2] + d[3] * d[3]); }
                q += __shfl_xor(q, 16); q += __shfl_xor(q, 32);
                if (fq == 0) P[(ai * HALF + wr * 64 + m * 16 + fr) * 4 + wc] = (f32x2v){mw, q};
            }
        asm volatile("s_waitcnt lgkmcnt(0)" ::: "memory"); __builtin_amdgcn_s_barrier(); asm volatile("" ::: "memory");
#if defined(BROKEN_EXCHANGE_NO_WAIT)
#warning BROKEN CONTROL BUILD: the row-statistics exchange does not wait; results are wrong by design
        if (blockIdx.x >= 64) { const long long t0_ = clock64(); while (clock64() - t0_ < 60000) __builtin_amdgcn_s_sleep(8); }
#endif
        const int row = wid * 32 + (lane & 31);
        if (lane < 32) {
            const f32x2v a = P[row * 4 + 0], b = P[row * 4 + 1], c = P[row * 4 + 2], d = P[row * 4 + 3];
            const float mt = (a.x + b.x + c.x + d.x) * 0.25f;
            const float da = a.x - mt, db = b.x - mt, dc = c.x - mt, dd = d.x - mt;
            const float m2 = (a.y + b.y) + (c.y + d.y) + 64.0f * ((da * da + db * db) + (dc * dc + dd * dd));
            unsigned long long* slot = (unsigned long long*)xbuf + ((size_t)(u.pm * BM + row) * 4 + u.pn);
            __hip_atomic_store(slot, ((unsigned long long)__float_as_uint(m2) << 32) | __float_as_uint(mt), __ATOMIC_RELAXED, __HIP_MEMORY_SCOPE_AGENT);
        }
        asm volatile("s_waitcnt vmcnt(0)" ::: "memory");
        if (lane == 0) __hip_atomic_fetch_add(cnt + 64 * u.pm, 1u, __ATOMIC_RELAXED, __HIP_MEMORY_SCOPE_AGENT);
        if (wid == 0) {
            bool dead = false; const unsigned long long t0 = __builtin_amdgcn_s_memrealtime(); const unsigned want = 8u * (unsigned)ntn;
            for (;;) {
#if defined(BROKEN_EXCHANGE_NO_WAIT)
                break;
#endif
                if ((unsigned)__builtin_amdgcn_readfirstlane(__hip_atomic_load(cnt + 64 * u.pm, __ATOMIC_RELAXED, __HIP_MEMORY_SCOPE_AGENT)) >= want) break;
                if (__builtin_amdgcn_s_memrealtime() - t0 > 2000000ull) {
                    if (lane == 0) { unsigned expect = 0u; __hip_atomic_compare_exchange_strong(tmo + 1, &expect, code | (unsigned)(u.pm & 0xff), __ATOMIC_RELAXED, __ATOMIC_RELAXED, __HIP_MEMORY_SCOPE_AGENT);
                                     __hip_atomic_store(tmo, 1u, __ATOMIC_RELAXED, __HIP_MEMORY_SCOPE_AGENT); }
                    dead = true; break; }
                __builtin_amdgcn_s_sleep(2);
            }
            __builtin_amdgcn_fence(__ATOMIC_ACQUIRE, "agent");
            if (lane == 0) flag[0] = dead ? 1u : 0u;
        }
        asm volatile("s_waitcnt vmcnt(0) lgkmcnt(0)" ::: "memory"); __builtin_amdgcn_s_barrier(); asm volatile("" ::: "memory");
        const bool bad = flag[0] != 0u;
        if (lane < 32) {
            const unsigned long long* slot = (const unsigned long long*)xbuf + (size_t)(u.pm * BM + row) * 4; float mt[4], m2[4]; float ms = 0.f;
#pragma unroll
            for (int t = 0; t < 4; ++t) { if (t < ntn) { const unsigned long long w = __hip_atomic_load(slot + t, __ATOMIC_RELAXED, __HIP_MEMORY_SCOPE_AGENT); mt[t] = __uint_as_float((unsigned)w); m2[t] = __uint_as_float((unsigned)(w >> 32)); } else { mt[t] = 0.f; m2[t] = 0.f; } ms += mt[t]; }
            const float mean = ms / (float)ntn; float q = 0.f;
#pragma unroll
            for (int t = 0; t < 4; ++t) if (t < ntn) { const float dm = mt[t] - mean; q += m2[t] + 256.0f * dm * dm; }
            S[row] = (f32x2v){mean, 1.0f / sqrtf(q / (256.0f * (float)ntn) + eps)};
        }
        asm volatile("s_waitcnt lgkmcnt(0)" ::: "memory"); __builtin_amdgcn_s_barrier(); asm volatile("" ::: "memory");
        return bad;
    }
};
struct EpiLnRes {
    static constexpr bool PERM = false, AFTER_DRAIN = true;
    const float* base; float* out; int ldc; const float* bias; PanelStats st; unsigned poison;
    __device__ __forceinline__ void fused(f32x4 (&acc)[2][2][4][2], const Unit& u, int wr, int wc, int fr, int fq, PG8_LAS unsigned char* lds, int wid, int lane) const {
        typedef float f32x2v __attribute__((ext_vector_type(2)));
        const PG8_LAS f32x2v* S = (const PG8_LAS f32x2v*)(lds + 8192);
        const int col0 = u.pn * BM + wc * 32 + 4 * fq;
#pragma unroll
        for (int bj = 0; bj < 2; ++bj)
#pragma unroll
            for (int n = 0; n < 2; ++n) { const f32x4 bv = bias ? *(const f32x4*)(bias + col0 + bj * HALF + n * 16) : (f32x4){0.f, 0.f, 0.f, 0.f};
#pragma unroll
                for (int ai = 0; ai < 2; ++ai)
#pragma unroll
                    for (int m = 0; m < 4; ++m) acc[ai][bj][m][n] += bv; }
        f32x4 pre[4][2][2];
#pragma unroll
        for (int m = 0; m < 4; ++m) { const size_t off = (size_t)(u.pm * BM + wr * 64 + m * 16 + fr) * ldc + col0;
#pragma unroll
            for (int bj = 0; bj < 2; ++bj)
#pragma unroll
                for (int n = 0; n < 2; ++n) pre[m][bj][n] = *(const f32x4*)(base + off + bj * HALF + n * 16); }
        const bool bad = st.run(acc, u, wr, wc, fr, fq, lds, wid, lane) || poison != 0u;
        const float qnan = __builtin_nanf("");
#pragma unroll
        for (int ai = 0; ai < 2; ++ai)
#pragma unroll
            for (int m = 0; m < 4; ++m) { const int r = ai * HALF + wr * 64 + m * 16 + fr; const f32x2v sr = S[r]; const size_t off = (size_t)(u.pm * BM + r) * ldc + col0;
#pragma unroll
                for (int bj = 0; bj < 2; ++bj)
#pragma unroll
                    for (int n = 0; n < 2; ++n) { const f32x4 bs = ai == 0 ? pre[m][bj][n] : *(const f32x4*)(base + off + bj * HALF + n * 16); f32x4 o = bs + (acc[ai][bj][m][n] - sr.x) * sr.y;
                        if (bad) o = (f32x4){qnan, qnan, qnan, qnan}; *(f32x4*)(out + off + bj * HALF + n * 16) = o; }
                if (m & 1) asm volatile("" ::: "memory"); }
    }
};
struct EpiLnResLn {
    static constexpr bool PERM = false, AFTER_DRAIN = true;
    const float* base; float* out; bf16_t* xn; int ldc; const float* bias; PanelStats st1, st2; unsigned poison;
    __device__ __forceinline__ void fused(f32x4 (&acc)[2][2][4][2], const Unit& u, int wr, int wc, int fr, int fq, PG8_LAS unsigned char* lds, int wid, int lane) const {
        typedef float f32x2v __attribute__((ext_vector_type(2))); typedef unsigned u32x2v __attribute__((ext_vector_type(2)));
        const PG8_LAS f32x2v* S = (const PG8_LAS f32x2v*)(lds + 8192);
        const int col0 = u.pn * BM + wc * 32 + 4 * fq;
#pragma unroll
        for (int bj = 0; bj < 2; ++bj)
#pragma unroll
            for (int n = 0; n < 2; ++n) { const f32x4 bv = bias ? *(const f32x4*)(bias + col0 + bj * HALF + n * 16) : (f32x4){0.f, 0.f, 0.f, 0.f};
#pragma unroll
                for (int ai = 0; ai < 2; ++ai)
#pragma unroll
                    for (int m = 0; m < 4; ++m) acc[ai][bj][m][n] += bv; }
        bool bad = st1.run(acc, u, wr, wc, fr, fq, lds, wid, lane) || poison != 0u;
        const float qnan = __builtin_nanf("");
#pragma unroll
        for (int ai = 0; ai < 2; ++ai)
#pragma unroll
            for (int m = 0; m < 4; ++m) { const int r = ai * HALF + wr * 64 + m * 16 + fr; const f32x2v sr = S[r]; const size_t off = (size_t)(u.pm * BM + r) * ldc + col0;
#pragma unroll
                for (int bj = 0; bj < 2; ++bj)
#pragma unroll
                    for (int n = 0; n < 2; ++n) { const f32x4 bs = *(const f32x4*)(base + off + bj * HALF + n * 16); acc[ai][bj][m][n] = bs + (acc[ai][bj][m][n] - sr.x) * sr.y; }
                asm volatile("" : "+v"(acc[ai][0][m][0]), "+v"(acc[ai][0][m][1]), "+v"(acc[ai][1][m][0]), "+v"(acc[ai][1][m][1]));
                if (m & 1) asm volatile("" ::: "memory"); }
        const bool bad1 = bad;
        bad = st2.run(acc, u, wr, wc, fr, fq, lds, wid, lane) || bad;
#pragma unroll
        for (int ai = 0; ai < 2; ++ai)
#pragma unroll
            for (int m = 0; m < 4; ++m) { const int r = ai * HALF + wr * 64 + m * 16 + fr; const f32x2v sr = S[r]; const size_t off = (size_t)(u.pm * BM + r) * ldc + col0;
#pragma unroll
                for (int bj = 0; bj < 2; ++bj)
#pragma unroll
                    for (int n = 0; n < 2; ++n) { const f32x4 x1 = acc[ai][bj][m][n]; *(f32x4*)(out + off + bj * HALF + n * 16) = bad1 ? (f32x4){qnan, qnan, qnan, qnan} : x1;
                        const f32x4 o = (x1 - sr.x) * sr.y; u32x2v w; w.x = cvt_pk_bf16(o[0], o[1]); w.y = cvt_pk_bf16(o[2], o[3]);
                        if (bad) { w.x = 0x7fc07fc0u; w.y = 0x7fc07fc0u; } *(u32x2v*)(xn + off + bj * HALF + n * 16) = w; }
                asm volatile("" ::: "memory"); }
    }
};

template <class E, class = void> struct MidSeg { static constexpr int v = 0; };
template <class E> struct MidSeg<E, decltype((void)E::MIDSEG)> { static constexpr int v = E::MIDSEG; };
template <class Epi, class Sched, bool ALIGN_EPI = false, bool SP2 = false>
__device__ __forceinline__ void gemm_phase(PG8_LAS unsigned char* lds, const Gemm g, const Sched& S, const Epi& E, int wid_in) {
    int lane_; asm volatile("v_mbcnt_lo_u32_b32 %0, -1, 0\n\tv_mbcnt_hi_u32_b32 %0, -1, %0" : "=v"(lane_));
    const int wid = wid_in, lane = lane_, tid = wid * 64 + lane, wr = wid >> 2, wc = wid & 3, fr = lane & 15, fq = lane >> 4;
    const int K = g.K, nt = K / BK;
    unsigned voffA[2], voffB[2];
#pragma unroll
    for (int i = 0; i < 2; ++i) { int R, C; stage_rc(tid * 16 + i * 8192, R, C); const int Rb = Epi::PERM ? ((R & ~31) + perm32(R & 31)) : R;
        voffA[i] = (unsigned)(R * K + C) * 2u; voffB[i] = (unsigned)(Rb * K + C) * 2u; }
    const size_t kstep = (size_t)(BK * 2);
    const size_t hstep = (size_t)HALF * K * 2;
    const size_t tstep = 2 * hstep;
    const unsigned ldsw = (unsigned)wid * 1024u;
    const int aoff = lds_byte(wr * 64 + fr, fq * 8), boff = lds_byte(wc * 32 + fr, fq * 8);
#define PG8_SA(b, h) (((b) * 2 + (h)) * HTB)
#define PG8_SB(b, h) ((4 + (b) * 2 + (h)) * HTB)
#define PG8_STAGE(bufoff, gbase, voff) do { _Pragma("unroll") for (int _i = 0; _i < 2; ++_i) \
        __builtin_amdgcn_global_load_lds((const unsigned*)((const char*)(gbase) + (voff)[_i]), (PG8_LAS unsigned*)(lds + (bufoff) + ldsw + _i * 8192), 16, 0, 0); } while (0)
#define PG8_LDA(dst, b, h) do { _Pragma("unroll") for (int m = 0; m < 4; ++m) _Pragma("unroll") for (int k = 0; k < 2; ++k) dst[m][k] = *(const PG8_LAS bf16x8*)(lds + PG8_SA(b, h) + aoff + m * 2048 + k * 1024); } while (0)
#define PG8_LDB(dst, b, h) do { _Pragma("unroll") for (int n = 0; n < 2; ++n) _Pragma("unroll") for (int k = 0; k < 2; ++k) dst[n][k] = *(const PG8_LAS bf16x8*)(lds + PG8_SB(b, h) + boff + n * 2048 + k * 1024); } while (0)
#define PG8_MMA(ai, bj, At, Bt) do { __builtin_amdgcn_s_setprio(1); _Pragma("unroll") for (int m = 0; m < 4; ++m) _Pragma("unroll") for (int n = 0; n < 2; ++n) _Pragma("unroll") for (int k = 0; k < 2; ++k) \
        acc[ai][bj][m][n] = __builtin_amdgcn_mfma_f32_16x16x32_bf16(Bt[n][k], At[m][k], acc[ai][bj][m][n], 0, 0, 0); __builtin_amdgcn_s_setprio(0); } while (0)
#define PG8_WAIT_V(n) asm volatile("s_waitcnt vmcnt(" #n ")" ::: "memory")
#define PG8_WAIT_L(n) asm volatile("s_waitcnt lgkmcnt(" #n ")" ::: "memory")
#define PG8_BAR __builtin_amdgcn_s_barrier()
#define PG8_SCHED __builtin_amdgcn_sched_barrier(0)
    Unit cur, nxt; int ui = 0;
    if (!S.next(0, cur)) return;
    f32x4 acc[2][2][4][2];
#pragma unroll
    for (int a = 0; a < 2; ++a)
#pragma unroll
        for (int b = 0; b < 2; ++b)
#pragma unroll
            for (int m = 0; m < 4; ++m)
#pragma unroll
                for (int n = 0; n < 2; ++n) acc[a][b][m][n] = (f32x4){0.f, 0.f, 0.f, 0.f};
    bf16x8 At[4][2], B0[2][2], B1[2][2];
    const char* cA = (const char*)g.A + (size_t)cur.pm * tstep; const char* cB = (const char*)g.Bt + (size_t)cur.pn * tstep;
    S.a_ready(cur);
    if constexpr (SP2) {
        PG8_STAGE(PG8_SB(0, 0), cB, voffB); PG8_STAGE(PG8_SB(0, 1), cB + hstep, voffB); PG8_STAGE(PG8_SA(0, 0), cA, voffA); PG8_STAGE(PG8_SA(0, 1), cA + hstep, voffA);
        if (wr == 1) PG8_BAR;
        PG8_WAIT_V(2); PG8_BAR;
        PG8_STAGE(PG8_SB(1, 0), cB + kstep, voffB); PG8_STAGE(PG8_SA(1, 0), cA + kstep, voffA); PG8_STAGE(PG8_SB(1, 1), cB + hstep + kstep, voffB);
        PG8_WAIT_V(6); PG8_BAR;
    } else {
        PG8_STAGE(PG8_SB(0, 0), cB, voffB); PG8_STAGE(PG8_SA(0, 0), cA, voffA); PG8_STAGE(PG8_SB(0, 1), cB + hstep, voffB); PG8_STAGE(PG8_SA(0, 1), cA + hstep, voffA);
        if (wr == 1) PG8_BAR;
        PG8_WAIT_V(4); PG8_BAR;
        PG8_STAGE(PG8_SB(1, 0), cB + kstep, voffB); PG8_STAGE(PG8_SA(1, 0), cA + kstep, voffA); PG8_STAGE(PG8_SB(1, 1), cB + hstep + kstep, voffB);
        PG8_WAIT_V(6); PG8_BAR;
    }
    for (;;) {
        const bool has_next = S.next(ui + 1, nxt);
        const char* nA = has_next ? (const char*)g.A + (size_t)nxt.pm * tstep : cA; const char* nB = has_next ? (const char*)g.Bt + (size_t)nxt.pn * tstep : cB;
        for (int t = 0; t < nt; t += 2) {
            if constexpr (MidSeg<Epi>::v > 0) { if (t > 0 && t % MidSeg<Epi>::v == 0) E.mid(acc, cur, t / MidSeg<Epi>::v, wr, wc, fr, fq); }
            const bool last = (t == nt - 2);
            const char* a1 = cA + (size_t)(t + 1) * kstep;
            const char* a2 = last ? nA : cA + (size_t)(t + 2) * kstep; const char* b2 = last ? nB : cB + (size_t)(t + 2) * kstep;
            const char* a3 = a2 + kstep; const char* b3 = b2 + kstep;
            if (last && has_next) S.a_ready(nxt);
            if constexpr (SP2) {
            PG8_LDB(B0, 0, 0); PG8_LDB(B1, 0, 1); PG8_SCHED; PG8_LDA(At, 0, 0); PG8_STAGE(PG8_SA(1, 1), a1 + hstep, voffA);
            PG8_WAIT_V(8); PG8_WAIT_L(0); PG8_BAR; PG8_MMA(0, 0, At, B0); PG8_MMA(0, 1, At, B1); PG8_BAR; PG8_SCHED;
            PG8_LDA(At, 0, 1); PG8_STAGE(PG8_SB(0, 0), b2, voffB); PG8_STAGE(PG8_SB(0, 1), b2 + hstep, voffB); PG8_STAGE(PG8_SA(0, 0), a2, voffA);
            PG8_WAIT_V(8); PG8_WAIT_L(0); PG8_BAR; PG8_MMA(1, 0, At, B0); PG8_MMA(1, 1, At, B1); PG8_BAR; PG8_SCHED;
            PG8_LDB(B0, 1, 0); PG8_LDB(B1, 1, 1); PG8_SCHED; PG8_LDA(At, 1, 0); PG8_STAGE(PG8_SA(0, 1), a2 + hstep, voffA);
            PG8_WAIT_V(8); PG8_WAIT_L(0); PG8_BAR; PG8_MMA(0, 0, At, B0); PG8_MMA(0, 1, At, B1); PG8_BAR; PG8_SCHED;
            PG8_LDA(At, 1, 1); PG8_STAGE(PG8_SB(1, 0), b3, voffB); PG8_STAGE(PG8_SB(1, 1), b3 + hstep, voffB); PG8_STAGE(PG8_SA(1, 0), a3, voffA);
            PG8_WAIT_V(8); PG8_WAIT_L(0); PG8_BAR; PG8_MMA(1, 0, At, B0); PG8_MMA(1, 1, At, B1); PG8_BAR; PG8_SCHED;
            } else {
            PG8_LDB(B0, 0, 0); PG8_SCHED; PG8_LDA(At, 0, 0); PG8_STAGE(PG8_SA(1, 1), a1 + hstep, voffA);
            PG8_WAIT_L(8); PG8_BAR; PG8_WAIT_L(0); PG8_MMA(0, 0, At, B0); PG8_BAR; PG8_SCHED;
            PG8_LDB(B1, 0, 1); PG8_STAGE(PG8_SB(0, 0), b2, voffB);
            PG8_BAR; PG8_WAIT_L(0); PG8_MMA(0, 1, At, B1); PG8_BAR;
            PG8_LDA(At, 0, 1); PG8_STAGE(PG8_SA(0, 0), a2, voffA);
            PG8_BAR; PG8_WAIT_L(0); PG8_MMA(1, 0, At, B0); PG8_BAR; PG8_SCHED;
            PG8_STAGE(PG8_SB(0, 1), b2 + hstep, voffB);
            PG8_WAIT_V(6); PG8_BAR; PG8_MMA(1, 1, At, B1); PG8_BAR;
            PG8_LDB(B0, 1, 0); PG8_SCHED; PG8_LDA(At, 1, 0); PG8_STAGE(PG8_SA(0, 1), a2 + hstep, voffA);
            PG8_WAIT_L(8); PG8_BAR; PG8_WAIT_L(0); PG8_MMA(0, 0, At, B0); PG8_BAR; PG8_SCHED;
            PG8_LDB(B1, 1, 1); PG8_STAGE(PG8_SB(1, 0), b3, voffB);
            PG8_BAR; PG8_WAIT_L(0); PG8_MMA(0, 1, At, B1); PG8_BAR;
            PG8_LDA(At, 1, 1); PG8_STAGE(PG8_SA(1, 0), a3, voffA);
            PG8_BAR; PG8_WAIT_L(0); PG8_MMA(1, 0, At, B0); PG8_BAR; PG8_SCHED;
            PG8_STAGE(PG8_SB(1, 1), b3 + hstep, voffB);
            PG8_WAIT_V(6); PG8_BAR; PG8_MMA(1, 1, At, B1); PG8_BAR;
            }
        }
        if constexpr (ALIGN_EPI) { if (wr == 0) PG8_BAR; }
        if constexpr (!Epi::AFTER_DRAIN) { E(acc, cur, wr, wc, fr, fq); S.done(cur); }
        if (!has_next) break;
#pragma unroll
        for (int a = 0; a < 2; ++a)
#pragma unroll
            for (int b = 0; b < 2; ++b)
#pragma unroll
                for (int m = 0; m < 4; ++m)
#pragma unroll
                    for (int n = 0; n < 2; ++n) acc[a][b][m][n] = (f32x4){0.f, 0.f, 0.f, 0.f};
        cur = nxt; cA = nA; cB = nB; ++ui;
        if constexpr (ALIGN_EPI) { if (wr == 1) PG8_BAR; }
    }
    PG8_WAIT_V(0);
    if constexpr (!ALIGN_EPI) { if (wr == 0) PG8_BAR; }
    PG8_BAR;
    if constexpr (Epi::AFTER_DRAIN) { E.fused(acc, cur, wr, wc, fr, fq, lds, wid, lane); S.done(cur); }
#undef PG8_SA
#undef PG8_SB
#undef PG8_STAGE
#undef PG8_LDA
#undef PG8_LDB
#undef PG8_MMA
#undef PG8_WAIT_V
#undef PG8_WAIT_L
#undef PG8_BAR
#undef PG8_SCHED
}
}
namespace pg8 {
struct Gemm8 { const unsigned char* A; const unsigned char* Bt; int M, N, K; int scale_a, scale_b; };
template <class Epi, class Sched, bool ALIGN_EPI = false, bool SP2 = false>
__device__ __forceinline__ void gemm_phase_f8(PG8_LAS unsigned char* lds, const Gemm8 g, const Sched& S, const Epi& E, int wid_in) {
    int lane_; asm volatile("v_mbcnt_lo_u32_b32 %0, -1, 0\n\tv_mbcnt_hi_u32_b32 %0, -1, %0" : "=v"(lane_));
    const int wid = wid_in, lane = lane_, tid = wid * 64 + lane, wr = wid >> 2, wc = wid & 3, fr = lane & 15, fq = lane >> 4;
    const int K = g.K, nt = K / 128;
    unsigned voffA[2], voffB[2];
#pragma unroll
    for (int i = 0; i < 2; ++i) { int R, C; stage_rc(tid * 16 + i * 8192, R, C); const int Rb = Epi::PERM ? ((R & ~31) + perm32(R & 31)) : R;
        voffA[i] = (unsigned)(R * K + 2 * C); voffB[i] = (unsigned)(Rb * K + 2 * C); }
    const size_t kstep = (size_t)(BK * 2);
    const size_t hstep = (size_t)HALF * K;
    const size_t tstep = 2 * hstep;
    const unsigned ldsw = (unsigned)wid * 1024u;
    const int aoff = lds_byte(wr * 64 + fr, fq * 16), boff = lds_byte(wc * 32 + fr, fq * 16);
#define PG8_SA(b, h) (((b) * 2 + (h)) * HTB)
#define PG8_SB(b, h) ((4 + (b) * 2 + (h)) * HTB)
#define PG8_STAGE(bufoff, gbase, voff) do { _Pragma("unroll") for (int _i = 0; _i < 2; ++_i) { unsigned keep_; \
        asm volatile("s_mov_b32 %0, m0\n\ts_mov_b32 m0, %3\n\ts_nop 0\n\tglobal_load_lds_dwordx4 %1, %2\n\ts_mov_b32 m0, %0" : "=&s"(keep_) : "v"((voff)[_i]), "s"((const char*)(gbase)), "s"((unsigned)(size_t)(lds + (bufoff) + ldsw + _i * 8192)) : "memory"); } } while (0)
#define PG8_LDA(dst, b, h) do { _Pragma("unroll") for (int m = 0; m < 4; ++m) { const u32x4 lo_ = *(const PG8_LAS u32x4*)(lds + PG8_SA(b, h) + aoff + m * 2048), hi_ = *(const PG8_LAS u32x4*)(lds + PG8_SA(b, h) + aoff + m * 2048 + 16); dst[m] = __builtin_bit_cast(i32x8, __builtin_shufflevector(lo_, hi_, 0, 1, 2, 3, 4, 5, 6, 7)); } } while (0)
#define PG8_LDB(dst, b, h) do { _Pragma("unroll") for (int n = 0; n < 2; ++n) { const u32x4 lo_ = *(const PG8_LAS u32x4*)(lds + PG8_SB(b, h) + boff + n * 2048), hi_ = *(const PG8_LAS u32x4*)(lds + PG8_SB(b, h) + boff + n * 2048 + 16); dst[n] = __builtin_bit_cast(i32x8, __builtin_shufflevector(lo_, hi_, 0, 1, 2, 3, 4, 5, 6, 7)); } } while (0)
#define PG8_MMA(ai, bj, At, Bt) do { __builtin_amdgcn_s_setprio(1); _Pragma("unroll") for (int m = 0; m < 4; ++m) _Pragma("unroll") for (int n = 0; n < 2; ++n) \
        acc[ai][bj][m][n] = __builtin_amdgcn_mfma_scale_f32_16x16x128_f8f6f4(Bt[n], At[m], acc[ai][bj][m][n], 0, 0, 0, g.scale_b, 0, g.scale_a); __builtin_amdgcn_s_setprio(0); } while (0)
#define PG8_WAIT_V(n) asm volatile("s_waitcnt vmcnt(" #n ")" ::: "memory")
#define PG8_WAIT_L(n) asm volatile("s_waitcnt lgkmcnt(" #n ")" ::: "memory")
#define PG8_BAR __builtin_amdgcn_s_barrier()
#define PG8_SCHED __builtin_amdgcn_sched_barrier(0)
    Unit cur, nxt; int ui = 0;
    if (!S.next(0, cur)) return;
    f32x4 acc[2][2][4][2];
#pragma unroll
    for (int a = 0; a < 2; ++a)
#pragma unroll
        for (int b = 0; b < 2; ++b)
#pragma unroll
            for (int m = 0; m < 4; ++m)
#pragma unroll
                for (int n = 0; n < 2; ++n) acc[a][b][m][n] = (f32x4){0.f, 0.f, 0.f, 0.f};
    typedef int i32x8 __attribute__((ext_vector_type(8))); i32x8 At[4], B0[2], B1[2];
    const char* cA = (const char*)g.A + (size_t)cur.pm * tstep; const char* cB = (const char*)g.Bt + (size_t)cur.pn * tstep;
    S.a_ready(cur);
    if constexpr (SP2) {
        PG8_STAGE(PG8_SB(0, 0), cB, voffB); PG8_STAGE(PG8_SB(0, 1), cB + hstep, voffB); PG8_STAGE(PG8_SA(0, 0), cA, voffA); PG8_STAGE(PG8_SA(0, 1), cA + hstep, voffA);
        if (wr == 1) PG8_BAR;
        PG8_WAIT_V(2); PG8_BAR;
        PG8_STAGE(PG8_SB(1, 0), cB + kstep, voffB); PG8_STAGE(PG8_SA(1, 0), cA + kstep, voffA); PG8_STAGE(PG8_SB(1, 1), cB + hstep + kstep, voffB);
        PG8_WAIT_V(6); PG8_BAR;
    } else {
        PG8_STAGE(PG8_SB(0, 0), cB, voffB); PG8_STAGE(PG8_SA(0, 0), cA, voffA); PG8_STAGE(PG8_SB(0, 1), cB + hstep, voffB); PG8_STAGE(PG8_SA(0, 1), cA + hstep, voffA);
        if (wr == 1) PG8_BAR;
        PG8_WAIT_V(4); PG8_BAR;
        PG8_STAGE(PG8_SB(1, 0), cB + kstep, voffB); PG8_STAGE(PG8_SA(1, 0), cA + kstep, voffA); PG8_STAGE(PG8_SB(1, 1), cB + hstep + kstep, voffB);
        PG8_WAIT_V(6); PG8_BAR;
    }
    for (;;) {
        const bool has_next = S.next(ui + 1, nxt);
        const char* nA = has_next ? (const char*)g.A + (size_t)nxt.pm * tstep : cA; const char* nB = has_next ? (const char*)g.Bt + (size_t)nxt.pn * tstep : cB;
#pragma unroll 1
        for (int t = 0; t < nt; t += 2) {
            const bool last = (t == nt - 2);
            const char* a1 = cA + (size_t)(t + 1) * kstep;
            const char* a2 = last ? nA : cA + (size_t)(t + 2) * kstep; const char* b2 = last ? nB : cB + (size_t)(t + 2) * kstep;
            const char* a3 = a2 + kstep; const char* b3 = b2 + kstep;
            if (last && has_next) S.a_ready(nxt);
            if constexpr (SP2) {
            PG8_LDB(B0, 0, 0); PG8_LDB(B1, 0, 1); PG8_SCHED; PG8_LDA(At, 0, 0); PG8_STAGE(PG8_SA(1, 1), a1 + hstep, voffA);
            PG8_WAIT_V(8); PG8_WAIT_L(0); PG8_BAR; PG8_MMA(0, 0, At, B0); PG8_MMA(0, 1, At, B1); PG8_BAR; PG8_SCHED;
            PG8_LDA(At, 0, 1); PG8_STAGE(PG8_SB(0, 0), b2, voffB); PG8_STAGE(PG8_SB(0, 1), b2 + hstep, voffB); PG8_STAGE(PG8_SA(0, 0), a2, voffA);
            PG8_WAIT_V(8); PG8_WAIT_L(0); PG8_BAR; PG8_MMA(1, 0, At, B0); PG8_MMA(1, 1, At, B1); PG8_BAR; PG8_SCHED;
            PG8_LDB(B0, 1, 0); PG8_LDB(B1, 1, 1); PG8_SCHED; PG8_LDA(At, 1, 0); PG8_STAGE(PG8_SA(0, 1), a2 + hstep, voffA);
            PG8_WAIT_V(8); PG8_WAIT_L(0); PG8_BAR; PG8_MMA(0, 0, At, B0); PG8_MMA(0, 1, At, B1); PG8_BAR; PG8_SCHED;
            PG8_LDA(At, 1, 1); PG8_STAGE(PG8_SB(1, 0), b3, voffB); PG8_STAGE(PG8_SB(1, 1), b3 + hstep, voffB); PG8_STAGE(PG8_SA(1, 0), a3, voffA);
            PG8_WAIT_V(8); PG8_WAIT_L(0); PG8_BAR; PG8_MMA(1, 0, At, B0); PG8_MMA(1, 1, At, B1); PG8_BAR; PG8_SCHED;
            } else {
            PG8_LDB(B0, 0, 0); PG8_SCHED; PG8_LDA(At, 0, 0); PG8_STAGE(PG8_SA(1, 1), a1 + hstep, voffA);
            PG8_WAIT_L(8); PG8_BAR; PG8_WAIT_L(0); PG8_MMA(0, 0, At, B0); PG8_BAR; PG8_SCHED;
            PG8_LDB(B1, 0, 1); PG8_STAGE(PG8_SB(0, 0), b2, voffB);
            PG8_BAR; PG8_WAIT_L(0); PG8_MMA(0, 1, At, B1); PG8_BAR;
            PG8_LDA(At, 0, 1); PG8_STAGE(PG8_SA(0, 0), a2, voffA);
            PG8_BAR; PG8_WAIT_L(0); PG8_MMA(1, 0, At, B0); PG8_BAR; PG8_SCHED;
            PG8_STAGE(PG8_SB(0, 1), b2 + hstep, voffB);
            PG8_WAIT_V(6); PG8_BAR; PG8_MMA(1, 1, At, B1); PG8_BAR;
            PG8_LDB(B0, 1, 0); PG8_SCHED; PG8_LDA(At, 1, 0); PG8_STAGE(PG8_SA(0, 1), a2 + hstep, voffA);
            PG8_WAIT_L(8); PG8_BAR; PG8_WAIT_L(0); PG8_MMA(0, 0, At, B0); PG8_BAR; PG8_SCHED;
            PG8_LDB(B1, 1, 1); PG8_STAGE(PG8_SB(1, 0), b3, voffB);
            PG8_BAR; PG8_WAIT_L(0); PG8_MMA(0, 1, At, B1); PG8_BAR;
            PG8_LDA(At, 1, 1); PG8_STAGE(PG8_SA(1, 0), a3, voffA);
            PG8_BAR; PG8_WAIT_L(0); PG8_MMA(1, 0, At, B0); PG8_BAR; PG8_SCHED;
            PG8_STAGE(PG8_SB(1, 1), b3 + hstep, voffB);
            PG8_WAIT_V(6); PG8_BAR; PG8_MMA(1, 1, At, B1); PG8_BAR;
            }
        }
        if constexpr (ALIGN_EPI) { if (wr == 0) PG8_BAR; }
        if constexpr (!Epi::AFTER_DRAIN) { int l2_; asm volatile("v_mbcnt_lo_u32_b32 %0, -1, 0\n\tv_mbcnt_hi_u32_b32 %0, -1, %0" : "=v"(l2_));
            E(acc, cur, wr, wc, l2_ & 15, l2_ >> 4); S.done(cur); }
        if (!has_next) break;
#pragma unroll
        for (int a = 0; a < 2; ++a)
#pragma unroll
            for (int b = 0; b < 2; ++b)
#pragma unroll
                for (int m = 0; m < 4; ++m)
#pragma unroll
                    for (int n = 0; n < 2; ++n) acc[a][b][m][n] = (f32x4){0.f, 0.f, 0.f, 0.f};
        cur = nxt; cA = nA; cB = nB; ++ui;
        if constexpr (ALIGN_EPI) { if (wr == 1) PG8_BAR; }
    }
    PG8_WAIT_V(0);
    if constexpr (!ALIGN_EPI) { if (wr == 0) PG8_BAR; }
    PG8_BAR;
    if constexpr (Epi::AFTER_DRAIN) { E.fused(acc, cur, wr, wc, fr, fq, lds, wid, lane); S.done(cur); }
#undef PG8_SA
#undef PG8_SB
#undef PG8_STAGE
#undef PG8_LDA
#undef PG8_LDB
#undef PG8_MMA
#undef PG8_WAIT_V
#undef PG8_WAIT_L
#undef PG8_BAR
#undef PG8_SCHED
}
}
namespace pg8 {
struct GemmA { const bf16_t* A; const bf16_t* Bt; int K; int rowA; size_t kstepA, hstepA, tstepA; };
template <class Epi, class Sched, bool ALIGN_EPI = false, bool SP2 = false>
__device__ __forceinline__ void gemm_phase_ga(PG8_LAS unsigned char* lds, const GemmA g, const Sched& S, const Epi& E, int wid_in) {
    int lane_; asm volatile("v_mbcnt_lo_u32_b32 %0, -1, 0\n\tv_mbcnt_hi_u32_b32 %0, -1, %0" : "=v"(lane_));
    const int wid = wid_in, lane = lane_, tid = wid * 64 + lane, wr = wid >> 2, wc = wid & 3, fr = lane & 15, fq = lane >> 4;
    const int K = g.K, nt = K / BK;
    unsigned voffA[2], voffB[2];
#pragma unroll
    for (int i = 0; i < 2; ++i) { int R, C; stage_rc(tid * 16 + i * 8192, R, C); const int Rb = Epi::PERM ? ((R & ~31) + perm32(R & 31)) : R;
        voffA[i] = (unsigned)(R * g.rowA + C * 2); voffB[i] = (unsigned)(Rb * K + C) * 2u; }
    const size_t kstep = (size_t)(BK * 2);
    const size_t hstep = (size_t)HALF * K * 2;
    const size_t kstepA = g.kstepA, hstepA = g.hstepA, tstepA = g.tstepA;
    const size_t tstep = 2 * hstep;
    const unsigned ldsw = (unsigned)wid * 1024u;
    const int aoff = lds_byte(wr * 64 + fr, fq * 8), boff = lds_byte(wc * 32 + fr, fq * 8);
#define PG8_SA(b, h) (((b) * 2 + (h)) * HTB)
#define PG8_SB(b, h) ((4 + (b) * 2 + (h)) * HTB)
#define PG8_STAGE(bufoff, gbase, voff) do { _Pragma("unroll") for (int _i = 0; _i < 2; ++_i) \
        __builtin_amdgcn_global_load_lds((const unsigned*)((const char*)(gbase) + (voff)[_i]), (PG8_LAS unsigned*)(lds + (bufoff) + ldsw + _i * 8192), 16, 0, 0); } while (0)
#define PG8_LDA(dst, b, h) do { _Pragma("unroll") for (int m = 0; m < 4; ++m) _Pragma("unroll") for (int k = 0; k < 2; ++k) dst[m][k] = *(const PG8_LAS bf16x8*)(lds + PG8_SA(b, h) + aoff + m * 2048 + k * 1024); } while (0)
#define PG8_LDB(dst, b, h) do { _Pragma("unroll") for (int n = 0; n < 2; ++n) _Pragma("unroll") for (int k = 0; k < 2; ++k) dst[n][k] = *(const PG8_LAS bf16x8*)(lds + PG8_SB(b, h) + boff + n * 2048 + k * 1024); } while (0)
#define PG8_MMA(ai, bj, At, Bt) do { __builtin_amdgcn_s_setprio(1); _Pragma("unroll") for (int m = 0; m < 4; ++m) _Pragma("unroll") for (int n = 0; n < 2; ++n) _Pragma("unroll") for (int k = 0; k < 2; ++k) \
        acc[ai][bj][m][n] = __builtin_amdgcn_mfma_f32_16x16x32_bf16(Bt[n][k], At[m][k], acc[ai][bj][m][n], 0, 0, 0); __builtin_amdgcn_s_setprio(0); } while (0)
#define PG8_WAIT_V(n) asm volatile("s_waitcnt vmcnt(" #n ")" ::: "memory")
#define PG8_WAIT_L(n) asm volatile("s_waitcnt lgkmcnt(" #n ")" ::: "memory")
#define PG8_BAR __builtin_amdgcn_s_barrier()
#define PG8_SCHED __builtin_amdgcn_sched_barrier(0)
    Unit cur, nxt; int ui = 0;
    if (!S.next(0, cur)) return;
    f32x4 acc[2][2][4][2];
#pragma unroll
    for (int a = 0; a < 2; ++a)
#pragma unroll
        for (int b = 0; b < 2; ++b)
#pragma unroll
            for (int m = 0; m < 4; ++m)
#pragma unroll
                for (int n = 0; n < 2; ++n) acc[a][b][m][n] = (f32x4){0.f, 0.f, 0.f, 0.f};
    bf16x8 At[4][2], B0[2][2], B1[2][2];
    const char* cA = (const char*)g.A + (size_t)cur.pm * tstepA; const char* cB = (const char*)g.Bt + (size_t)cur.pn * tstep;
    S.a_ready(cur);
    if constexpr (SP2) {
        PG8_STAGE(PG8_SB(0, 0), cB, voffB); PG8_STAGE(PG8_SB(0, 1), cB + hstep, voffB); PG8_STAGE(PG8_SA(0, 0), cA, voffA); PG8_STAGE(PG8_SA(0, 1), cA + hstepA, voffA);
        if (wr == 1) PG8_BAR;
        PG8_WAIT_V(2); PG8_BAR;
        PG8_STAGE(PG8_SB(1, 0), cB + kstep, voffB); PG8_STAGE(PG8_SA(1, 0), cA + kstepA, voffA); PG8_STAGE(PG8_SB(1, 1), cB + hstep + kstep, voffB);
        PG8_WAIT_V(6); PG8_BAR;
    } else {
        PG8_STAGE(PG8_SB(0, 0), cB, voffB); PG8_STAGE(PG8_SA(0, 0), cA, voffA); PG8_STAGE(PG8_SB(0, 1), cB + hstep, voffB); PG8_STAGE(PG8_SA(0, 1), cA + hstepA, voffA);
        if (wr == 1) PG8_BAR;
        PG8_WAIT_V(4); PG8_BAR;
        PG8_STAGE(PG8_SB(1, 0), cB + kstep, voffB); PG8_STAGE(PG8_SA(1, 0), cA + kstepA, voffA); PG8_STAGE(PG8_SB(1, 1), cB + hstep + kstep, voffB);
        PG8_WAIT_V(6); PG8_BAR;
    }
    for (;;) {
        const bool has_next = S.next(ui + 1, nxt);
        const char* nA = has_next ? (const char*)g.A + (size_t)nxt.pm * tstepA : cA; const char* nB = has_next ? (const char*)g.Bt + (size_t)nxt.pn * tstep : cB;
        for (int t = 0; t < nt; t += 2) {
            if constexpr (MidSeg<Epi>::v > 0) { if (t > 0 && t % MidSeg<Epi>::v == 0) E.mid(acc, cur, t / MidSeg<Epi>::v, wr, wc, fr, fq); }
            const bool last = (t == nt - 2);
            const char* a1 = cA + (size_t)(t + 1) * kstepA;
            const char* a2 = last ? nA : cA + (size_t)(t + 2) * kstepA; const char* b2 = last ? nB : cB + (size_t)(t + 2) * kstep;
            const char* a3 = a2 + kstepA; const char* b3 = b2 + kstep;
            if (last && has_next) S.a_ready(nxt);
            if constexpr (SP2) {
            PG8_LDB(B0, 0, 0); PG8_LDB(B1, 0, 1); PG8_SCHED; PG8_LDA(At, 0, 0); PG8_STAGE(PG8_SA(1, 1), a1 + hstepA, voffA);
            PG8_WAIT_V(8); PG8_WAIT_L(0); PG8_BAR; PG8_MMA(0, 0, At, B0); PG8_MMA(0, 1, At, B1); PG8_BAR; PG8_SCHED;
            PG8_LDA(At, 0, 1); PG8_STAGE(PG8_SB(0, 0), b2, voffB); PG8_STAGE(PG8_SB(0, 1), b2 + hstep, voffB); PG8_STAGE(PG8_SA(0, 0), a2, voffA);
            PG8_WAIT_V(8); PG8_WAIT_L(0); PG8_BAR; PG8_MMA(1, 0, At, B0); PG8_MMA(1, 1, At, B1); PG8_BAR; PG8_SCHED;
            PG8_LDB(B0, 1, 0); PG8_LDB(B1, 1, 1); PG8_SCHED; PG8_LDA(At, 1, 0); PG8_STAGE(PG8_SA(0, 1), a2 + hstepA, voffA);
            PG8_WAIT_V(8); PG8_WAIT_L(0); PG8_BAR; PG8_MMA(0, 0, At, B0); PG8_MMA(0, 1, At, B1); PG8_BAR; PG8_SCHED;
            PG8_LDA(At, 1, 1); PG8_STAGE(PG8_SB(1, 0), b3, voffB); PG8_STAGE(PG8_SB(1, 1), b3 + hstep, voffB); PG8_STAGE(PG8_SA(1, 0), a3, voffA);
            PG8_WAIT_V(8); PG8_WAIT_L(0); PG8_BAR; PG8_MMA(1, 0, At, B0); PG8_MMA(1, 1, At, B1); PG8_BAR; PG8_SCHED;
            } else {
            PG8_LDB(B0, 0, 0); PG8_SCHED; PG8_LDA(At, 0, 0); PG8_STAGE(PG8_SA(1, 1), a1 + hstepA, voffA);
            PG8_WAIT_L(8); PG8_BAR; PG8_WAIT_L(0); PG8_MMA(0, 0, At, B0); PG8_BAR; PG8_SCHED;
            PG8_LDB(B1, 0, 1); PG8_STAGE(PG8_SB(0, 0), b2, voffB);
            PG8_BAR; PG8_WAIT_L(0); PG8_MMA(0, 1, At, B1); PG8_BAR;
            PG8_LDA(At, 0, 1); PG8_STAGE(PG8_SA(0, 0), a2, voffA);
            PG8_BAR; PG8_WAIT_L(0); PG8_MMA(1, 0, At, B0); PG8_BAR; PG8_SCHED;
            PG8_STAGE(PG8_SB(0, 1), b2 + hstep, voffB);
            PG8_WAIT_V(6); PG8_BAR; PG8_MMA(1, 1, At, B1); PG8_BAR;
            PG8_LDB(B0, 1, 0); PG8_SCHED; PG8_LDA(At, 1, 0); PG8_STAGE(PG8_SA(0, 1), a2 + hstepA, voffA);
            PG8_WAIT_L(8); PG8_BAR; PG8_WAIT_L(0); PG8_MMA(0, 0, At, B0); PG8_BAR; PG8_SCHED;
            PG8_LDB(B1, 1, 1); PG8_STAGE(PG8_SB(1, 0), b3, voffB);
            PG8_BAR; PG8_WAIT_L(0); PG8_MMA(0, 1, At, B1); PG8_BAR;
            PG8_LDA(At, 1, 1); PG8_STAGE(PG8_SA(1, 0), a3, voffA);
            PG8_BAR; PG8_WAIT_L(0); PG8_MMA(1, 0, At, B0); PG8_BAR; PG8_SCHED;
            PG8_STAGE(PG8_SB(1, 1), b3 + hstep, voffB);
            PG8_WAIT_V(6); PG8_BAR; PG8_MMA(1, 1, At, B1); PG8_BAR;
            }
        }
        if constexpr (ALIGN_EPI) { if (wr == 0) PG8_BAR; }
        if constexpr (!Epi::AFTER_DRAIN) { E(acc, cur, wr, wc, fr, fq); S.done(cur); }
        if (!has_next) break;
#pragma unroll
        for (int a = 0; a < 2; ++a)
#pragma unroll
            for (int b = 0; b < 2; ++b)
#pragma unroll
                for (int m = 0; m < 4; ++m)
#pragma unroll
                    for (int n = 0; n < 2; ++n) acc[a][b][m][n] = (f32x4){0.f, 0.f, 0.f, 0.f};
        cur = nxt; cA = nA; cB = nB; ++ui;
        if constexpr (ALIGN_EPI) { if (wr == 1) PG8_BAR; }
    }
    PG8_WAIT_V(0);
    if constexpr (!ALIGN_EPI) { if (wr == 0) PG8_BAR; }
    PG8_BAR;
    if constexpr (Epi::AFTER_DRAIN) { E.fused(acc, cur, wr, wc, fr, fq, lds, wid, lane); S.done(cur); }
#undef PG8_SA
#undef PG8_SB
#undef PG8_STAGE
#undef PG8_LDA
#undef PG8_LDB
#undef PG8_MMA
#undef PG8_WAIT_V
#undef PG8_WAIT_L
#undef PG8_BAR
#undef PG8_SCHED
}
}
#define GAS __attribute__((address_space(1)))
#define LAS __attribute__((address_space(3)))
typedef unsigned short bf16;
typedef unsigned v4u __attribute__((ext_vector_type(4)));
typedef float f32x4 __attribute__((ext_vector_type(4)));
typedef short bf16x8 __attribute__((ext_vector_type(8)));
typedef GAS unsigned gu32;
typedef GAS unsigned long long gu64;
#define RLX_AGENT __ATOMIC_RELAXED, __HIP_MEMORY_SCOPE_AGENT
#define LDS_WAIT() asm volatile("s_waitcnt lgkmcnt(0)" ::: "memory")
#define VM_WAIT() asm volatile("s_waitcnt vmcnt(0)" ::: "memory")
__device__ __forceinline__ unsigned long long rt() { return __builtin_amdgcn_s_memrealtime(); }
__device__ __forceinline__ unsigned f2bf(float f) { unsigned u = __builtin_bit_cast(unsigned, f); return (u + 0x7fffu + ((u >> 16) & 1u)) >> 16; }
__device__ __forceinline__ unsigned pk2(float lo, float hi) { return f2bf(lo) | (f2bf(hi) << 16); }

#define XB_TMO      128
#define XB_XCNT(j)  (256  + 64 * (j))
#define XB_XSUB(j)  (1280 + 64 * (j))
#define XB_XGEN(j)  (2304 + 64 * (j))
#define XB_TOP      3328
#define XB_TOPGEN   3392
#define XCD_BAR_WORDS 3456
#define XB_SPIN_CAP (1u << 18)

__device__ __forceinline__ unsigned xb_ld(unsigned* p)              { return __hip_atomic_load(p, __ATOMIC_RELAXED, __HIP_MEMORY_SCOPE_AGENT); }
__device__ __forceinline__ unsigned xb_add(unsigned* p, unsigned v) { return __hip_atomic_fetch_add(p, v, __ATOMIC_RELAXED, __HIP_MEMORY_SCOPE_AGENT); }
__device__ __forceinline__ unsigned xb_xcc_id() { return (unsigned)__builtin_amdgcn_s_getreg((3 << 11) | 20) & 0xFu; }
#define XB_SPIN(cond, bar) do { unsigned _sp = 0; while (cond) { __builtin_amdgcn_s_sleep(1); \
    if ((++_sp & 255u) == 0u) { if (xb_ld(&(bar)[XB_TMO])) break; if (_sp > XB_SPIN_CAP) { atomicAdd(&(bar)[XB_TMO], 1u); break; } } } } while (0)

struct XcdBarrier {
    int wv;
    unsigned* bar; unsigned x;
    volatile LAS unsigned* st;
};

__device__ __forceinline__ int xb_lane_id() { int l; asm volatile("v_mbcnt_lo_u32_b32 %0, -1, 0\n\tv_mbcnt_hi_u32_b32 %0, -1, %0" : "=v"(l)); return l; }
__device__ __forceinline__ XcdBarrier xcd_barrier_post(unsigned* bar, volatile LAS unsigned* st, int wv) {
    XcdBarrier b; b.wv = wv; b.bar = bar; b.x = xb_xcc_id(); b.st = st;
    if (wv == 0 && xb_lane_id() == 0) (void)xb_add(&bar[XB_XCNT(b.x)], 1u);
    return b;
}
__device__ __forceinline__ void xcd_barrier_complete(unsigned* bar, unsigned x, unsigned& nloc, unsigned& nx) {
    const unsigned G = gridDim.x * gridDim.y * gridDim.z;
    unsigned sum, cnt, mine, sp = 0u;
    for (;;) {
        sum = 0u; cnt = 0u; mine = 0u;
#pragma unroll
        for (unsigned j = 0; j < 16; ++j) { const unsigned c = xb_ld(&bar[XB_XCNT(j)]); sum += c; cnt += (c > 0u) ? 1u : 0u; mine = (j == x) ? c : mine; }
        if (sum == G) break;
        __builtin_amdgcn_s_sleep(1);
        if ((++sp & 255u) == 0u) { if (xb_ld(&bar[XB_TMO])) break; if (sp > XB_SPIN_CAP) { atomicAdd(&bar[XB_TMO], 1u); break; } }
    }
    nloc = mine > 0u ? mine : 1u; nx = cnt > 0u ? cnt : 1u;
}

__device__ __forceinline__ void xcd_barrier(const XcdBarrier& b) {
    asm volatile("s_waitcnt vmcnt(0)" ::: "memory");
    __syncthreads();
    if (b.wv == 0 && xb_lane_id() == 0) {
        unsigned* bar = b.bar;
        __builtin_amdgcn_s_waitcnt(0);
        unsigned nloc = b.st[0], nx = b.st[1];
        if (nloc == 0u) { xcd_barrier_complete(bar, b.x, nloc, nx); b.st[0] = nloc; b.st[1] = nx; }
        const unsigned old = xb_add(&bar[XB_XSUB(b.x)], 1u);
        const unsigned gen = old / nloc;
        if (old + 1u == (gen + 1u) * nloc) {
            __builtin_amdgcn_fence(__ATOMIC_RELEASE, "agent");
            asm volatile("s_waitcnt vmcnt(0)" ::: "memory");
            const unsigned og = xb_add(&bar[XB_TOP], 1u);
            const unsigned tg = og / nx;
            if (og + 1u == (tg + 1u) * nx) xb_add(&bar[XB_TOPGEN], 1u);
            else XB_SPIN(xb_ld(&bar[XB_TOPGEN]) == tg, bar);
            __builtin_amdgcn_fence(__ATOMIC_ACQUIRE, "agent");
            xb_add(&bar[XB_XGEN(b.x)], 1u);
            asm volatile("s_waitcnt vmcnt(0)" ::: "memory");
        } else {
            XB_SPIN(xb_ld(&bar[XB_XGEN(b.x)]) == gen, bar);
            __builtin_amdgcn_fence(__ATOMIC_ACQUIRE, "agent");
            asm volatile("s_waitcnt vmcnt(0)" ::: "memory");
        }
    }
    __syncthreads();
}
#define DI __device__ __forceinline__
constexpr int NWAVES = 8;
constexpr int NB = 16, SEQ = 2048, DM = 1024, MT = NB * SEQ;
constexpr int DIN_SRC = 6944, NPROJ = 7168;
constexpr int MEML = 256, MROWS = NB * MEML;
constexpr int NEXP = 32, TOPK = 4, DFF = 1024, MOEB = 256;
constexpr int NROWS = MT * TOPK;
constexpr int NBLK_MAX = (NROWS + NEXP * (MOEB - 1) + MOEB - 1) / MOEB;
constexpr int CAP = NBLK_MAX * MOEB;
constexpr float EPS = 1e-6f;
constexpr float NEGF = -1e30f;
constexpr int NB16 = 3584, NF8 = NPROJ - NB16;
constexpr int PC_MLQ = 0, PC_MLK = 512, PC_NQ = 1024, PC_NKC = 1536, PC_NKS = 1664, PC_NKW = 1792, PC_MQ = 1920, PC_MLI = 2432, PC_MLF = 2436, PC_NG = 2440,
              PC_MLV = 2560, PC_NVC = 3072, PC_NVS = 3200, PC_NVW = 3328, PC_MLO = 3584, PC_BRG = 4096;
__host__ __device__ constexpr int proj_srccol(int j) {
    return j < 1024 ? j : j < 1536 ? 2056 + (j - 1024) : j < 1664 ? 2568 + (j - 1536) : j < 1792 ? 2824 + (j - 1664) : j < 1920 ? 3080 + (j - 1792) : j < 2432 ? 3360 + (j - 1920)
         : j < 2440 ? 2048 + (j - 2432) : j < 2464 ? 3336 + (j - 2440) : j < 2560 ? -1
         : j < 3072 ? 1024 + (j - 2560) : j < 3200 ? 2696 + (j - 3072) : j < 3328 ? 2952 + (j - 3200) : j < 3456 ? 3208 + (j - 3328) : j < 3584 ? -1
         : j < 4096 ? 1536 + (j - 3584) : 3872 + (j - 4096);
}

constexpr size_t MiB = 1u << 20;
constexpr size_t WS_CTL = 0, CTL_ZERO_BYTES = 1 * MiB;
constexpr size_t WS_WIN = 1 * MiB, WS_WGU = 15 * MiB, WS_WDN = 143 * MiB, WS_WMKV = 207 * MiB, WS_WBR = 209 * MiB, WS_WOUT = 212 * MiB, WS_WC1 = 214 * MiB;
constexpr size_t WS_WIN8 = WS_WIN + 8 * MiB;
constexpr size_t WS_SMALL = 216 * MiB;
constexpr size_t WS_R1 = 218 * MiB;
constexpr size_t WS_PROJ = 282 * MiB;
constexpr size_t WS_R3 = 730 * MiB;
constexpr size_t WS_MEMKV = WS_R3, WS_MEMKN = WS_R3 + 8 * MiB, WS_QN = WS_R3 + 12 * MiB, WS_KSN = WS_R3 + 44 * MiB, WS_KWN = WS_R3 + 52 * MiB,
                 WS_MQN = WS_R3 + 60 * MiB, WS_MLQK = WS_R3 + 92 * MiB, WS_HID = WS_R3 + 156 * MiB, WS_KC = WS_R3 + 160 * MiB, WS_VC = WS_KC + MiB / 2,
                 WS_H0 = WS_R3 + 161 * MiB, WS_H1 = WS_H0 + 32 * MiB, WS_H2 = WS_H1 + 32 * MiB, WS_ROUTE = WS_H2 + 32 * MiB, WS_END = WS_ROUTE + 6 * MiB;
constexpr size_t WS_MLV = WS_R1, WS_VSN = WS_R1 + 32 * MiB, WS_VWN = WS_R1 + 40 * MiB;
constexpr size_t WS_U8 = WS_H2;
constexpr size_t WS_MEMN = WS_H0;
constexpr size_t WS_ACMP = WS_H1;
constexpr size_t WS_APERM = WS_PROJ;
constexpr size_t WS_ACT = WS_PROJ + 272 * MiB;
static_assert(WS_ACT + 272 * MiB <= WS_H0 + 96 * MiB && WS_END <= 1024 * MiB, "ws map");
constexpr size_t SM_ROPEC = 0, SM_ROPES = 256 * 1024, SM_CBIAS = 512 * 1024, SM_WRT = 1024 * 1024, SM_W2T = 1024 * 1024 + 256 * 1024;
constexpr size_t RT_TOKE = 0, RT_TOKPOS = 512 * 1024, RT_TOKW = 1024 * 1024, RT_TOKDEST = 1536 * 1024, RT_ROWW = 2048 * 1024;
constexpr int CW_BAR = 4096;
constexpr int CW_ECNT = 16384;
constexpr int CW_QCTR = 16384 + 64;

constexpr int RING_BYTES = 131072, LDSCTL_OFF = RING_BYTES, MISC_OFF = LDSCTL_OFF + 320, LDS_BYTES = 155648;

struct Args { const float* in[34]; float* out; unsigned char* ws; int ph_lo, ph_hi, li, pad; };

DI float bf2f(unsigned short h) { return __uint_as_float((unsigned)h << 16); }
DI float wave_sum(float v) {
#pragma unroll
    for (int o = 1; o < 64; o <<= 1) v += __shfl_xor(v, o);
    return v;
}
DI float wave_max(float v) {
#pragma unroll
    for (int o = 1; o < 64; o <<= 1) v = fmaxf(v, __shfl_xor(v, o));
    return v;
}
DI float sigm(float x) { return __builtin_amdgcn_rcpf(1.f + __expf(-x)); }
DI float logsig(float x) { return fminf(x, 0.f) - log1pf(__expf(-fabsf(x))); }

namespace pg8 {
struct EpiBf16Silu {
    static constexpr bool PERM = true, AFTER_DRAIN = false;
    bf16_t* O; int ldc; const float* bias; int silu;
    DI void operator()(const f32x4 (&acc)[2][2][4][2], const Unit& u, int wr, int wc, int fr, int fq) const {
        const int row0 = u.pm * BM + wr * 64 + fr; const int col0 = u.pn * BM + wc * 32 + 8 * fq;
#pragma unroll
        for (int ai = 0; ai < 2; ++ai)
#pragma unroll
            for (int m = 0; m < 4; ++m) { bf16_t* rowp = O + (size_t)(row0 + ai * HALF + m * 16) * ldc + col0;
#pragma unroll
                for (int bj = 0; bj < 2; ++bj) { f32x4 v0 = acc[ai][bj][m][0], v1 = acc[ai][bj][m][1];
                    if (bias) { v0 += *(const f32x4*)(bias + col0 + bj * HALF); v1 += *(const f32x4*)(bias + col0 + bj * HALF + 4); }
                    if (silu) {
#pragma unroll
                        for (int j = 0; j < 4; ++j) { v0[j] = v0[j] * __builtin_amdgcn_rcpf(1.f + __expf(-v0[j])); v1[j] = v1[j] * __builtin_amdgcn_rcpf(1.f + __expf(-v1[j])); } }
                    u32x4 w; w.x = cvt_pk_bf16(v0[0], v0[1]); w.y = cvt_pk_bf16(v0[2], v0[3]); w.z = cvt_pk_bf16(v1[0], v1[1]); w.w = cvt_pk_bf16(v1[2], v1[3]);
                    *(u32x4*)(rowp + bj * HALF) = w; } }
    }
};
template <int B> struct EpiGate {
    static constexpr bool PERM = false, AFTER_DRAIN = false;
    const bf16_t* proj; float* tmp; bf16_t* merged;
    DI void operator()(const f32x4 (&acc)[2][2][4][2], const Unit& u, int wr, int wc, int fr, int fq) const {
        typedef unsigned u32x2v __attribute__((ext_vector_type(2)));
        const int col0 = u.pn * BM + wc * 32 + 4 * fq;
#pragma unroll
        for (int ai = 0; ai < 2; ++ai)
#pragma unroll
            for (int m = 0; m < 4; ++m) { const size_t r = (size_t)(u.pm * BM + ai * HALF + wr * 64 + m * 16 + fr);
#pragma unroll
                for (int bj = 0; bj < 2; ++bj)
#pragma unroll
                    for (int n = 0; n < 2; ++n) { const int c = col0 + bj * HALF + n * 16;
                        const u32x2v gw = *(const u32x2v*)(proj + r * NPROJ + PC_BRG + B * DM + c);
                        f32x4 g; g[0] = __uint_as_float(gw.x << 16); g[1] = __uint_as_float(gw.x & 0xffff0000u); g[2] = __uint_as_float(gw.y << 16); g[3] = __uint_as_float(gw.y & 0xffff0000u);
                        f32x4 v = acc[ai][bj][m][n];
#pragma unroll
                        for (int j = 0; j < 4; ++j) v[j] = v[j] * __builtin_amdgcn_rcpf(1.f + __expf(-g[j]));
                        float* tp = tmp + r * DM + c;
                        if (B == 0) { *(f32x4*)tp = v; }
                        else if (B == 1) { *(f32x4*)tp = *(const f32x4*)tp + v; }
                        else { v = *(const f32x4*)tp + v; u32x2v w; w.x = cvt_pk_bf16(v[0], v[1]); w.y = cvt_pk_bf16(v[2], v[3]); *(u32x2v*)(merged + r * DM + c) = w; } } }
    }
};
struct EpiMerge {
    static constexpr bool PERM = false, AFTER_DRAIN = false;
    const bf16_t* proj; float* tmp; bf16_t* merged;
    DI void operator()(const f32x4 (&acc)[2][2][4][2], const Unit& u, int wr, int wc, int fr, int fq) const {
        typedef unsigned u32x2v __attribute__((ext_vector_type(2)));
        const int b = u.pn >> 2, pn = u.pn & 3, pm = u.pm & 127;
        const int col0 = pn * BM + wc * 32 + 4 * fq;
#pragma unroll
        for (int ai = 0; ai < 2; ++ai)
#pragma unroll
            for (int m = 0; m < 4; ++m) { const size_t r = (size_t)(pm * BM + ai * HALF + wr * 64 + m * 16 + fr);
#pragma unroll
                for (int bj = 0; bj < 2; ++bj)
#pragma unroll
                    for (int n = 0; n < 2; ++n) { const int c = col0 + bj * HALF + n * 16;
                        const u32x2v gw = *(const u32x2v*)(proj + r * NPROJ + PC_BRG + b * DM + c);
                        f32x4 g; g[0] = __uint_as_float(gw.x << 16); g[1] = __uint_as_float(gw.x & 0xffff0000u); g[2] = __uint_as_float(gw.y << 16); g[3] = __uint_as_float(gw.y & 0xffff0000u);
                        f32x4 v = acc[ai][bj][m][n];
#pragma unroll
                        for (int j = 0; j < 4; ++j) v[j] = v[j] * __builtin_amdgcn_rcpf(1.f + __expf(-g[j]));
                        float* tp = tmp + r * DM + c;
                        if (b == 0) { *(f32x4*)tp = v; }
                        else if (b == 1) { *(f32x4*)tp = *(const f32x4*)tp + v; }
                        else { v = *(const f32x4*)tp + v; u32x2v w; w.x = cvt_pk_bf16(v[0], v[1]); w.y = cvt_pk_bf16(v[2], v[3]); *(u32x2v*)(merged + r * DM + c) = w; } } }
    }
};
struct EpiMergeK {
    static constexpr bool PERM = false, AFTER_DRAIN = false; static constexpr int MIDSEG = 8;
    const bf16_t* proj; bf16_t* merged;
    DI static f32x4 ldg(const bf16_t* p) { typedef unsigned u32x2v __attribute__((ext_vector_type(2))); const u32x2v gw = *(const u32x2v*)p; f32x4 g;
        g[0] = __uint_as_float(gw.x << 16); g[1] = __uint_as_float(gw.x & 0xffff0000u); g[2] = __uint_as_float(gw.y << 16); g[3] = __uint_as_float(gw.y & 0xffff0000u); return g; }
    DI void mid(f32x4 (&acc)[2][2][4][2], const Unit& u, int seg, int wr, int wc, int fr, int fq) const {
        const int col0 = u.pn * BM + wc * 32 + 4 * fq;
#pragma unroll
        for (int ai = 0; ai < 2; ++ai)
#pragma unroll
            for (int m = 0; m < 4; ++m) { const size_t r = (size_t)(u.pm * BM + ai * HALF + wr * 64 + m * 16 + fr);
#pragma unroll
                for (int bj = 0; bj < 2; ++bj)
#pragma unroll
                    for (int n = 0; n < 2; ++n) { const int c = col0 + bj * HALF + n * 16; const bf16_t* gp = proj + r * NPROJ + PC_BRG + (seg - 1) * DM + c;
                        const f32x4 ga = ldg(gp), gb = ldg(gp + DM);
#pragma unroll
                        for (int j = 0; j < 4; ++j) acc[ai][bj][m][n][j] *= (1.f + __expf(-gb[j])) * __builtin_amdgcn_rcpf(1.f + __expf(-ga[j])); } }
    }
    DI void operator()(const f32x4 (&acc)[2][2][4][2], const Unit& u, int wr, int wc, int fr, int fq) const {
        typedef unsigned u32x2v __attribute__((ext_vector_type(2)));
        const int col0 = u.pn * BM + wc * 32 + 4 * fq;
#pragma unroll
        for (int ai = 0; ai < 2; ++ai)
#pragma unroll
            for (int m = 0; m < 4; ++m) { const size_t r = (size_t)(u.pm * BM + ai * HALF + wr * 64 + m * 16 + fr);
#pragma unroll
                for (int bj = 0; bj < 2; ++bj)
#pragma unroll
                    for (int n = 0; n < 2; ++n) { const int c = col0 + bj * HALF + n * 16; const f32x4 g = ldg(proj + r * NPROJ + PC_BRG + 2 * DM + c); f32x4 v = acc[ai][bj][m][n];
#pragma unroll
                        for (int j = 0; j < 4; ++j) v[j] = v[j] * __builtin_amdgcn_rcpf(1.f + __expf(-g[j]));
                        u32x2v w; w.x = cvt_pk_bf16(v[0], v[1]); w.y = cvt_pk_bf16(v[2], v[3]); *(u32x2v*)(merged + r * DM + c) = w; } }
    }
};
struct MergeOrder {
    StaticOrder so;
    DI bool next(int i, Unit& u) const { const int tl = i / 3, b = i - 3 * tl; Unit t; if (!so.next(tl, t)) return false; u.pm = b * 128 + t.pm; u.pn = b * 4 + t.pn; return true; }
    DI void a_ready(const Unit&) const {}
    DI void done(const Unit&) const {}
};
struct EpiRes {
    static constexpr bool PERM = false, AFTER_DRAIN = false;
    const float* base; float* out;
    DI void operator()(const f32x4 (&acc)[2][2][4][2], const Unit& u, int wr, int wc, int fr, int fq) const {
        const int col0 = u.pn * BM + wc * 32 + 4 * fq;
#pragma unroll
        for (int ai = 0; ai < 2; ++ai)
#pragma unroll
            for (int m = 0; m < 4; ++m) { const size_t r = (size_t)(u.pm * BM + ai * HALF + wr * 64 + m * 16 + fr);
#pragma unroll
                for (int bj = 0; bj < 2; ++bj)
#pragma unroll
                    for (int n = 0; n < 2; ++n) { const int c = col0 + bj * HALF + n * 16; *(f32x4*)(out + r * DM + c) = *(const f32x4*)(base + r * DM + c) + acc[ai][bj][m][n]; } }
    }
};
struct EpiSwiglu {
    static constexpr bool PERM = true, AFTER_DRAIN = false;
    unsigned char* act; const float* bgu;
    DI void operator()(const f32x4 (&acc)[2][2][4][2], const Unit& u, int wr, int wc, int fr, int fq) const {
        typedef unsigned u32x2v __attribute__((ext_vector_type(2)));
        const int e = u.pn >> 3, pnl = u.pn & 7;
        const int lc0 = pnl * BM + wc * 32 + 8 * fq;
        const unsigned row0 = (unsigned)(u.pm * BM + wr * 64 + fr);
        const float* bp = bgu + e * 2048;
#pragma unroll
        for (int ai = 0; ai < 2; ++ai)
#pragma unroll
            for (int m = 0; m < 4; ++m) { const unsigned rowoff = (row0 + ai * HALF + m * 16) * (unsigned)DFF;
#pragma unroll
                for (int bj = 0; bj < 2; ++bj) {
                    const unsigned lc = (unsigned)(lc0 + bj * HALF);
                    const f32x4 b0 = *(const f32x4*)(bp + lc), b1 = *(const f32x4*)(bp + lc + 4);
                    const f32x4 v0 = acc[ai][bj][m][0] + b0, v1 = acc[ai][bj][m][1] + b1;
                    float o[4];
#pragma unroll
                    for (int q = 0; q < 4; ++q) { const float gt = fminf(q < 2 ? v0[2 * q] : v1[2 * q - 4], 7.0f); float up = q < 2 ? v0[2 * q + 1] : v1[2 * q - 3]; up = fminf(fmaxf(up, -7.0f), 7.0f);
                        o[q] = (up + 1.0f) * (gt * __builtin_amdgcn_rcpf(1.f + __expf(-1.702f * gt))); }
                    int q8 = 0; q8 = __builtin_amdgcn_cvt_pk_fp8_f32(o[0], o[1], q8, false); q8 = __builtin_amdgcn_cvt_pk_fp8_f32(o[2], o[3], q8, true);
                    *(unsigned*)(act + (rowoff + (lc >> 1))) = (unsigned)q8; } }
    }
};
struct EpiDown {
    static constexpr bool PERM = false, AFTER_DRAIN = false;
    bf16_t* y; const float* bdn; const float* roww;
    DI void operator()(const f32x4 (&acc)[2][2][4][2], const Unit& u, int wr, int wc, int fr, int fq) const {
        typedef unsigned u32x2v __attribute__((ext_vector_type(2)));
        const int e = u.pn >> 2, pnl = u.pn & 3;
        const int col0 = pnl * BM + wc * 32 + 4 * fq;
#pragma unroll
        for (int ai = 0; ai < 2; ++ai)
#pragma unroll
            for (int m = 0; m < 4; ++m) { const size_t r = (size_t)(u.pm * BM + ai * HALF + wr * 64 + m * 16 + fr); const float rw = roww[r];
#pragma unroll
                for (int bj = 0; bj < 2; ++bj)
#pragma unroll
                    for (int n = 0; n < 2; ++n) { const int c = col0 + bj * HALF + n * 16; const f32x4 v = (acc[ai][bj][m][n] + *(const f32x4*)(bdn + e * DM + c)) * rw;
                        u32x2v w; w.x = cvt_pk_bf16(v[0], v[1]); w.y = cvt_pk_bf16(v[2], v[3]); *(u32x2v*)(y + r * DM + c) = w; } }
    }
};
template <int NPN> struct MoeOrder {
    int nblk, G, c; const PG8_LAS unsigned char* blk_e;
    DI bool next(int i, Unit& u) const {
        int rb, pn;
        if (G == 256) { const int x = c & 7, j = c >> 3; rb = i * (256 / NPN) + x * (32 / NPN) + j / NPN; pn = j % NPN; }
        else { const int L = i * G + c; rb = L / NPN; pn = L % NPN; }
        if (rb >= nblk) return false;
        u.pm = rb; u.pn = __builtin_amdgcn_readfirstlane((int)blk_e[rb]) * NPN + pn; return true; }
    DI void a_ready(const Unit&) const {}
    DI void done(const Unit&) const {}
};
}

struct Frame {
    LAS unsigned char* lds; volatile LAS unsigned* MISC; unsigned* ctl; unsigned char* ws;
    int wave, G, bx;
    DI int lane_id() const { int l; asm volatile("v_mbcnt_lo_u32_b32 %0, -1, 0\n\tv_mbcnt_hi_u32_b32 %0, -1, %0" : "=v"(l)); return l; }
    DI int tid_id() const { return wave * 64 + lane_id(); }
    const float* const* in; float* out;
};
enum { I_X = 0, I_MEM, I_GMIX, I_WIN, I_CONVW, I_CONVB, I_MLBI, I_MLBF, I_MLGOUT, I_NGQ, I_NGK, I_CPK, I_CW1K, I_CB1K, I_CW2K, I_CPV, I_CW1V, I_CB1V, I_CW2V,
       I_GMEM, I_WMKV, I_MGQ, I_MGK, I_WBRML, I_WBRNSA, I_WBRMEM, I_WOUT, I_GFFN, I_WR, I_BR, I_WGU, I_BGU, I_WDN, I_BDN, N_IN };

template <class CM>
DI void tr_item(const float* W, int ldw, int K, bf16* WT, int k0, int n0, CM cm, LAS float* scr, int lane) {
    const int sc = cm(n0 + (lane & 31));
#pragma unroll 8
    for (int i = 0; i < 32; ++i) { const int kk = 2 * i + (lane >> 5); scr[kk * 33 + (lane & 31)] = sc >= 0 ? W[(size_t)(k0 + kk) * ldw + sc] : 0.f; }
    LDS_WAIT(); asm volatile("" ::: "memory");
    const int c = lane & 7;
#pragma unroll
    for (int j = 0; j < 4; ++j) { const int n = (lane >> 3) + 8 * j; const LAS float* s = scr + (8 * c) * 33 + n;
        v4u o; o.x = pk2(s[0 * 33], s[1 * 33]); o.y = pk2(s[2 * 33], s[3 * 33]); o.z = pk2(s[4 * 33], s[5 * 33]); o.w = pk2(s[6 * 33], s[7 * 33]);
        *(v4u*)(WT + (size_t)(n0 + n) * K + k0 + 8 * c) = o; }
    LDS_WAIT(); asm volatile("" ::: "memory");
}
DI void tr_item_f8(const float* W, int ldw, int K, unsigned char* WT, int k0, int n0, LAS float* scr, int lane) {
#pragma unroll 8
    for (int i = 0; i < 32; ++i) { const int kk = 2 * i + (lane >> 5); scr[kk * 33 + (lane & 31)] = W[(size_t)(k0 + kk) * ldw + n0 + (lane & 31)] * 256.0f; }
    LDS_WAIT(); asm volatile("" ::: "memory");
    const int c = lane & 7;
#pragma unroll
    for (int j = 0; j < 4; ++j) { const int n = (lane >> 3) + 8 * j; const LAS float* sp = scr + (8 * c) * 33 + n;
        int lo = 0, hi = 0;
        lo = __builtin_amdgcn_cvt_pk_fp8_f32(sp[0 * 33], sp[1 * 33], lo, false); lo = __builtin_amdgcn_cvt_pk_fp8_f32(sp[2 * 33], sp[3 * 33], lo, true);
        hi = __builtin_amdgcn_cvt_pk_fp8_f32(sp[4 * 33], sp[5 * 33], hi, false); hi = __builtin_amdgcn_cvt_pk_fp8_f32(sp[6 * 33], sp[7 * 33], hi, true);
        typedef unsigned u32x2t __attribute__((ext_vector_type(2)));
        *(u32x2t*)(WT + (size_t)(n0 + n) * K + k0 + 8 * c) = (u32x2t){(unsigned)lo, (unsigned)hi}; }
    LDS_WAIT(); asm volatile("" ::: "memory");
}
DI void tr_load_v4(const float* W, int ldw, int k0, int n0, int lane, f32x4 (&v)[8]) {
#pragma unroll
    for (int i = 0; i < 8; ++i) v[i] = *(const f32x4*)(W + (size_t)(k0 + 8 * i + (lane >> 3)) * ldw + n0 + 4 * (lane & 7));
}
DI void tr_put_v4(const f32x4 (&v)[8], LAS float* scr, int lane, float mul) {
#pragma unroll
    for (int i = 0; i < 8; ++i) { LAS float* d = scr + (8 * i + (lane >> 3)) * 33 + 4 * (lane & 7); d[0] = v[i].x * mul; d[1] = v[i].y * mul; d[2] = v[i].z * mul; d[3] = v[i].w * mul; }
    LDS_WAIT(); asm volatile("" ::: "memory");
}
DI void tr_fill_v4(const float* W, int ldw, int k0, int n0, LAS float* scr, int lane, float mul) { f32x4 v[8]; tr_load_v4(W, ldw, k0, n0, lane, v); tr_put_v4(v, scr, lane, mul); }
DI void tr_emit_bf16(bf16* WT, int K, int k0, int n0, LAS float* scr, int lane) {
    const int c = lane & 7;
#pragma unroll
    for (int j = 0; j < 4; ++j) { const int n = (lane >> 3) + 8 * j; const LAS float* sp = scr + (8 * c) * 33 + n;
        v4u o; o.x = pk2(sp[0 * 33], sp[1 * 33]); o.y = pk2(sp[2 * 33], sp[3 * 33]); o.z = pk2(sp[4 * 33], sp[5 * 33]); o.w = pk2(sp[6 * 33], sp[7 * 33]);
        *(v4u*)(WT + (size_t)(n0 + n) * K + k0 + 8 * c) = o; }
    LDS_WAIT(); asm volatile("" ::: "memory");
}
DI void tr_emit_f8(unsigned char* WT, int K, int k0, int n0, LAS float* scr, int lane) {
    const int c = lane & 7;
#pragma unroll
    for (int j = 0; j < 4; ++j) { const int n = (lane >> 3) + 8 * j; const LAS float* sp = scr + (8 * c) * 33 + n;
        int lo = 0, hi = 0;
        lo = __builtin_amdgcn_cvt_pk_fp8_f32(sp[0 * 33], sp[1 * 33], lo, false); lo = __builtin_amdgcn_cvt_pk_fp8_f32(sp[2 * 33], sp[3 * 33], lo, true);
        hi = __builtin_amdgcn_cvt_pk_fp8_f32(sp[4 * 33], sp[5 * 33], hi, false); hi = __builtin_amdgcn_cvt_pk_fp8_f32(sp[6 * 33], sp[7 * 33], hi, true);
        typedef unsigned u32x2t __attribute__((ext_vector_type(2)));
        *(u32x2t*)(WT + (size_t)(n0 + n) * K + k0 + 8 * c) = (u32x2t){(unsigned)lo, (unsigned)hi}; }
    LDS_WAIT(); asm volatile("" ::: "memory");
}
template <class CM>
DI void tr_fill_cm(const float* W, int ldw, int k0, int n0, CM cm, LAS float* scr, int lane, float mul) {
    const int sc = cm(n0 + (lane & 31));
#pragma unroll 8
    for (int i = 0; i < 32; ++i) { const int kk = 2 * i + (lane >> 5); scr[kk * 33 + (lane & 31)] = sc >= 0 ? W[(size_t)(k0 + kk) * ldw + sc] * mul : 0.f; }
    LDS_WAIT(); asm volatile("" ::: "memory");
}
struct CmId { DI int operator()(int j) const { return j; } };
struct CmProj { DI int operator()(int j) const { return proj_srccol(j); } };

DI void rms_row_bf16(const float* xrow, const float* g, bf16* orow, int lane) {
    const f32x4* xr = (const f32x4*)xrow + lane; const f32x4* gr = (const f32x4*)g + lane;
    f32x4 v[4]; float s = 0.f;
#pragma unroll
    for (int j = 0; j < 4; ++j) { v[j] = xr[64 * j]; s += (v[j].x * v[j].x + v[j].y * v[j].y) + (v[j].z * v[j].z + v[j].w * v[j].w); }
    const float rstd = rsqrtf(wave_sum(s) * (1.f / DM) + EPS);
    unsigned long long* o8 = (unsigned long long*)orow + lane;
#pragma unroll
    for (int j = 0; j < 4; ++j) { const f32x4 gg = gr[64 * j];
        o8[64 * j] = (unsigned long long)pk2(v[j].x * rstd * gg.x, v[j].y * rstd * gg.y) | ((unsigned long long)pk2(v[j].z * rstd * gg.z, v[j].w * rstd * gg.w) << 32); }
}

DI void rms_row_f8(const float* xrow, const float* g, unsigned char* orow, int lane) {
    const f32x4* xr = (const f32x4*)xrow + lane; const f32x4* gr = (const f32x4*)g + lane;
    f32x4 v[4]; float s = 0.f;
#pragma unroll
    for (int j = 0; j < 4; ++j) { v[j] = xr[64 * j]; s += (v[j].x * v[j].x + v[j].y * v[j].y) + (v[j].z * v[j].z + v[j].w * v[j].w); }
    const float rstd = rsqrtf(wave_sum(s) * (1.f / DM) + EPS);
    unsigned* o4 = (unsigned*)orow + lane;
#pragma unroll
    for (int j = 0; j < 4; ++j) { const f32x4 gg = gr[64 * j]; int q8 = 0;
        q8 = __builtin_amdgcn_cvt_pk_fp8_f32(v[j].x * rstd * gg.x, v[j].y * rstd * gg.y, q8, false); q8 = __builtin_amdgcn_cvt_pk_fp8_f32(v[j].z * rstd * gg.z, v[j].w * rstd * gg.w, q8, true);
        o4[64 * j] = (unsigned)q8; }
}
template <int NR>
DI void rms_rows_both(const float* x0, const float* g, bf16* o0, unsigned char* o80, size_t step, int lane) {
    const f32x4* gr = (const f32x4*)g + lane;
    f32x4 v[NR][4];
#pragma unroll
    for (int q = 0; q < NR; ++q) { const f32x4* xr = (const f32x4*)(x0 + q * step * DM) + lane;
#pragma unroll
        for (int j = 0; j < 4; ++j) v[q][j] = xr[64 * j]; }
#pragma unroll
    for (int q = 0; q < NR; ++q) { float s = 0.f;
#pragma unroll
        for (int j = 0; j < 4; ++j) s += (v[q][j].x * v[q][j].x + v[q][j].y * v[q][j].y) + (v[q][j].z * v[q][j].z + v[q][j].w * v[q][j].w);
        const float rstd = rsqrtf(wave_sum(s) * (1.f / DM) + EPS);
        unsigned long long* o8 = (unsigned long long*)(o0 + q * step * DM) + lane; unsigned* o4 = (unsigned*)(o80 + q * step * DM) + lane;
#pragma unroll
        for (int j = 0; j < 4; ++j) { const f32x4 gg = gr[64 * j]; const float y0 = v[q][j].x * rstd * gg.x, y1 = v[q][j].y * rstd * gg.y, y2 = v[q][j].z * rstd * gg.z, y3 = v[q][j].w * rstd * gg.w;
            o8[64 * j] = (unsigned long long)pk2(y0, y1) | ((unsigned long long)pk2(y2, y3) << 32);
            int q8 = 0; q8 = __builtin_amdgcn_cvt_pk_fp8_f32(y0, y1, q8, false); q8 = __builtin_amdgcn_cvt_pk_fp8_f32(y2, y3, q8, true);
            o4[64 * j] = (unsigned)q8; } }
}
DI void p0_prologue(Frame& F) {
    LAS float* scr = (LAS float*)(F.lds + F.wave * 16384);
    const int gw = F.bx * NWAVES + F.wave, NGW = F.G * NWAVES;
    unsigned char* ws = F.ws;
    constexpr int IT_IN = 16 * (NPROJ / 32), IT_GU = 32 * 16 * 64, IT_DN = 32 * 16 * 32, IT_MKV = 16 * 32, IT_BR = 3 * 8 * 32, IT_OUT = 16 * 32, IT_C1 = 2 * 32 * 8;
    constexpr int NITEMS = IT_IN + IT_GU + IT_DN + IT_MKV + IT_BR + IT_OUT + IT_C1;
    {
        struct D { const float* src; unsigned char* dst; int ldw, k0, n0; };
        auto dec = [&](int j) { D d; if (j < IT_GU) { const int e = j / 1024, q = j % 1024; d.src = F.in[I_WGU] + (size_t)e * DM * 2048; d.dst = (unsigned char*)(ws + WS_WGU) + (size_t)e * 2048 * DM; d.ldw = 2048; d.k0 = 64 * (q / 64); d.n0 = 32 * (q % 64); }
                                     else { const int jj = j - IT_GU, e = jj / 512, q = jj % 512; d.src = F.in[I_WDN] + (size_t)e * DFF * DM; d.dst = (unsigned char*)(ws + WS_WDN) + (size_t)e * DM * DFF; d.ldw = DM; d.k0 = 64 * (q / 32); d.n0 = 32 * (q % 32); } return d; };
        const int lane = F.lane_id();
        int j = gw; f32x4 va[8]; D da{};
        if (j < IT_GU + IT_DN) { da = dec(j); tr_load_v4(da.src, da.ldw, da.k0, da.n0, lane, va); }
#pragma unroll 1
        while (j < IT_GU + IT_DN) {
            const int jn = j + NGW; f32x4 vb[8]; D db{};
            if (jn < IT_GU + IT_DN) { db = dec(jn); tr_load_v4(db.src, db.ldw, db.k0, db.n0, lane, vb); }
            else {
#pragma unroll
                for (int i = 0; i < 8; ++i) vb[i] = va[i]; }
            tr_put_v4(va, scr, lane, 256.0f); tr_emit_f8(da.dst, 1024, da.k0, da.n0, scr, lane);
#pragma unroll
            for (int i = 0; i < 8; ++i) va[i] = vb[i];
            da = db; j = jn;
        }
    }
    for (int it = gw; it < NITEMS; it += NGW) {
        int r = it;
        if (r < IT_IN) { const int kb = r / (NPROJ / 32), nb = r % (NPROJ / 32); if (32 * nb < NB16) { tr_fill_cm(F.in[I_WIN], DIN_SRC, 64 * kb, 32 * nb, CmProj(), scr, F.lane_id(), 1.0f); tr_emit_bf16((bf16*)(ws + WS_WIN), DM, 64 * kb, 32 * nb, scr, F.lane_id()); }
            else { tr_fill_cm(F.in[I_WIN], DIN_SRC, 64 * kb, 32 * nb, CmProj(), scr, F.lane_id(), 256.0f); tr_emit_f8((unsigned char*)(ws + WS_WIN8), DM, 64 * kb, 32 * nb - NB16, scr, F.lane_id()); }
            continue; } r -= IT_IN;
        if (r < IT_GU + IT_DN) continue; r -= IT_GU + IT_DN;
        if (r < IT_MKV) { const int kb = r / 32, nb = r % 32; tr_fill_v4(F.in[I_WMKV], 1024, 64 * kb, 32 * nb, scr, F.lane_id(), 1.0f); tr_emit_bf16((bf16*)(ws + WS_WMKV), 1024, 64 * kb, 32 * nb, scr, F.lane_id()); continue; } r -= IT_MKV;
        if (r < IT_BR) { const int b = r / 256, q = r % 256, kb = q / 32, nb = q % 32; tr_fill_v4(F.in[I_WBRML + b], 1024, 64 * kb, 32 * nb, scr, F.lane_id(), 1.0f); tr_emit_bf16((bf16*)(ws + WS_WBR), 1536, 512 * b + 64 * kb, 32 * nb, scr, F.lane_id()); continue; } r -= IT_BR;
        if (r < IT_OUT) { const int kb = r / 32, nb = r % 32; tr_fill_v4(F.in[I_WOUT], 1024, 64 * kb, 32 * nb, scr, F.lane_id(), 1.0f); tr_emit_bf16((bf16*)(ws + WS_WOUT), 1024, 64 * kb, 32 * nb, scr, F.lane_id()); continue; } r -= IT_OUT;
        { const int kv = r / 256, q = r % 256, kb = q / 8, nb = q % 8; tr_fill_v4(F.in[kv ? I_CW1V : I_CW1K], 256, 64 * kb, 32 * nb, scr, F.lane_id(), 1.0f); tr_emit_bf16((bf16*)(ws + WS_WC1) + (size_t)kv * 256 * 2048, 2048, 64 * kb, 32 * nb, scr, F.lane_id()); }
    }
    { int m = gw;
      for (; m + 3 * NGW < MT; m += 4 * NGW) rms_rows_both<4>(F.in[I_X] + (size_t)m * DM, F.in[I_GMIX], (bf16*)(ws + WS_R1) + (size_t)m * DM, (unsigned char*)(ws + WS_U8) + (size_t)m * DM, (size_t)NGW, F.lane_id());
      for (; m < MT; m += NGW) rms_rows_both<1>(F.in[I_X] + (size_t)m * DM, F.in[I_GMIX], (bf16*)(ws + WS_R1) + (size_t)m * DM, (unsigned char*)(ws + WS_U8) + (size_t)m * DM, (size_t)NGW, F.lane_id()); }
    for (int m = gw; m < MROWS; m += NGW) rms_row_bf16(F.in[I_MEM] + (size_t)m * DM, F.in[I_GMEM], (bf16*)(ws + WS_MEMN) + (size_t)m * DM, F.lane_id());
    float* rc = (float*)(ws + WS_SMALL + SM_ROPEC); float* rs = (float*)(ws + WS_SMALL + SM_ROPES);
    for (int i = F.bx * 512 + F.tid_id(); i < SEQ * 32; i += F.G * 512) {
        const int p = i >> 5, k = i & 31;
        const float invf = exp2f(-(float)k * (13.287712379549449f / 32.0f));
        const float ang = (float)p * invf;
        const float kf = rintf(ang * 0.15915494309189535f);
        float r = fmaf(-kf, 6.28125f, ang); r = fmaf(-kf, 1.9353071795864769e-3f, r);
        rc[i] = cosf(r); rs[i] = sinf(r);
    }
    { bf16* wrt = (bf16*)(ws + WS_SMALL + SM_WRT);
      for (int i = F.bx * 512 + F.tid_id(); i < 32 * 1024; i += F.G * 512) { const int e = i >> 10, k = i & 1023; const float w = F.in[I_WR][k * 32 + e]; const unsigned hi = f2bf(w); wrt[i] = (bf16)hi; wrt[32 * 1024 + i] = (bf16)f2bf(w - __uint_as_float(hi << 16)); } }
    { bf16* w2t = (bf16*)(ws + WS_SMALL + SM_W2T);
      for (int i = F.bx * 512 + F.tid_id(); i < 2 * 64 * 256; i += F.G * 512) { const int kv = i >> 14, d = (i >> 8) & 63, f = i & 255; w2t[i] = (bf16)f2bf(F.in[kv ? I_CW2V : I_CW2K][f * 64 + d]); } }
    if (F.bx == F.G - 1) {
        const int kv = F.tid_id() >> 8, f = F.tid_id() & 255;
        const float* pe = F.in[kv ? I_CPV : I_CPK]; const float* w1 = F.in[kv ? I_CW1V : I_CW1K];
        float a = F.in[kv ? I_CB1V : I_CB1K][f];
        for (int k = 0; k < 2048; ++k) a = fmaf(pe[k], w1[(size_t)k * 256 + f], a);
        ((float*)(ws + WS_SMALL + SM_CBIAS))[kv * 256 + f] = a;
    }
}

DI void unpack8(const v4u& w, float (&f)[8]) {
    f[0] = __uint_as_float(w.x << 16); f[1] = __uint_as_float(w.x & 0xffff0000u); f[2] = __uint_as_float(w.y << 16); f[3] = __uint_as_float(w.y & 0xffff0000u);
    f[4] = __uint_as_float(w.z << 16); f[5] = __uint_as_float(w.z & 0xffff0000u); f[6] = __uint_as_float(w.w << 16); f[7] = __uint_as_float(w.w & 0xffff0000u);
}
DI v4u pack8f(const float (&f)[8]) { v4u o; o.x = pk2(f[0], f[1]); o.y = pk2(f[2], f[3]); o.z = pk2(f[4], f[5]); o.w = pk2(f[6], f[7]); return o; }
DI void load8f(const float* p, float (&f)[8]) { const f32x4 a = *(const f32x4*)p, b = *(const f32x4*)(p + 4); f[0] = a.x; f[1] = a.y; f[2] = a.z; f[3] = a.w; f[4] = b.x; f[5] = b.y; f[6] = b.z; f[7] = b.w; }
DI void norm_rope64(float (&f)[8], const float (&g)[8], const float (&c8)[8], const float (&s8)[8], int lane, float scale) {
    float ss = 0.f;
#pragma unroll
    for (int i = 0; i < 8; ++i) ss = fmaf(f[i], f[i], ss);
    ss += __shfl_xor(ss, 1); ss += __shfl_xor(ss, 2); ss += __shfl_xor(ss, 4);
    const float rstd = rsqrtf(ss * (1.f / 64.f) + EPS);
    const bool hi = (lane & 4) != 0;
#pragma unroll
    for (int i = 0; i < 8; ++i) { const float y = f[i] * rstd * g[i]; const float pt = __shfl_xor(y, 4); f[i] = (hi ? fmaf(pt, s8[i], y * c8[i]) : fmaf(-pt, s8[i], y * c8[i])) * scale; }
}
DI void p2_prep(Frame& F) {
    unsigned char* ws = F.ws;
    const int ncg = F.G >= 64 ? 32 : 0;
    if (F.bx < ncg) return;
    const int gw = (F.bx - ncg) * NWAVES + F.wave, NGW = (F.G - ncg) * NWAVES, lane = F.lane_id();
    const bf16* proj = (const bf16*)(ws + WS_PROJ);
    const float* rc = (const float*)(ws + WS_SMALL + SM_ROPEC); const float* rs = (const float*)(ws + WS_SMALL + SM_ROPES);
    bf16* qn = (bf16*)(ws + WS_QN); bf16* ksn = (bf16*)(ws + WS_KSN); bf16* kwn = (bf16*)(ws + WS_KWN); bf16* mqn = (bf16*)(ws + WS_MQN); bf16* mlqk = (bf16*)(ws + WS_MLQK);
    constexpr int NT = 4;
    {
        float gq8[8], mg8[8]; load8f(F.in[I_NGQ] + 8 * (lane & 7), gq8); load8f(F.in[I_MGQ] + 8 * (lane & 15), mg8);
        for (int t0 = gw * NT; t0 < MT; t0 += NGW * NT) {
            v4u a[NT], bq[NT], cv[NT]; float c8[NT][8], s8[NT][8];
#pragma unroll
            for (int u = 0; u < NT; ++u) { const int t = t0 + u, tau = t & 2047; const bf16* pr = proj + (size_t)t * NPROJ;
                a[u] = *(const v4u*)(pr + PC_NQ + 8 * lane); bq[u] = *(const v4u*)(pr + PC_MQ + 8 * lane); cv[u] = *(const v4u*)(pr + PC_MLV + 8 * lane);
                load8f(rc + tau * 32 + 8 * (lane & 3), c8[u]); load8f(rs + tau * 32 + 8 * (lane & 3), s8[u]); }
#pragma unroll
            for (int u = 0; u < NT; ++u) { const int t = t0 + u;
                float f[8]; unpack8(a[u], f);
                norm_rope64(f, gq8, c8[u], s8[u], lane, 0.125f * 1.4426950408889634f);
                *(v4u*)(qn + (size_t)t * 512 + 8 * lane) = pack8f(f);
                unpack8(bq[u], f);
                float ss = 0.f;
#pragma unroll
                for (int i = 0; i < 8; ++i) ss = fmaf(f[i], f[i], ss);
                ss += __shfl_xor(ss, 1); ss += __shfl_xor(ss, 2); ss += __shfl_xor(ss, 4); ss += __shfl_xor(ss, 8);
                const float rstd = rsqrtf(ss * (1.f / 128.f) + EPS) * (0.08838834764831845f * 1.4426950408889634f);
#pragma unroll
                for (int i = 0; i < 8; ++i) f[i] *= rstd * mg8[i];
                *(v4u*)(mqn + (size_t)t * 512 + 8 * lane) = pack8f(f);
                *(v4u*)((bf16*)(ws + WS_MLV) + (size_t)t * 512 + 8 * lane) = cv[u]; }
        }
    }
    {
        const int L = lane & 31, hd4 = L >> 3, j = L & 7, half = lane >> 5;
        float gk8[8]; load8f(F.in[I_NGK] + (1 + (hd4 >> 1)) * 64 + 8 * j, gk8);
        const int kcol = (hd4 < 2 ? PC_NKS + hd4 * 64 : PC_NKW + (hd4 - 2) * 64) + 8 * j;
        bf16* kdst = (hd4 < 2 ? ksn : kwn) + (hd4 & 1) * 64 + 8 * j;
        const int wv = L >> 4, jj = L & 15;
        bf16* vdst = (bf16*)(ws + (wv ? WS_VWN : WS_VSN)) + 8 * jj; const int vcol = (wv ? PC_NVW : PC_NVS) + 8 * jj;
        for (int tp0 = gw * NT; tp0 < MT / 2; tp0 += NGW * NT) {
            v4u a[NT], vv[NT]; float c8[NT][8], s8[NT][8];
#pragma unroll
            for (int u = 0; u < NT; ++u) { const int t = 2 * (tp0 + u) + half, tau = t & 2047; const bf16* pr = proj + (size_t)t * NPROJ;
                a[u] = *(const v4u*)(pr + kcol); vv[u] = *(const v4u*)(pr + vcol);
                load8f(rc + tau * 32 + 8 * (lane & 3), c8[u]); load8f(rs + tau * 32 + 8 * (lane & 3), s8[u]); }
#pragma unroll
            for (int u = 0; u < NT; ++u) { const int t = 2 * (tp0 + u) + half;
                float f[8]; unpack8(a[u], f);
                norm_rope64(f, gk8, c8[u], s8[u], lane, 1.0f);
                *(v4u*)(kdst + (size_t)t * 128) = pack8f(f);
                *(v4u*)(vdst + (size_t)t * 128) = vv[u]; }
        }
    }
    for (int run = gw; run < MT / 16; run += NGW) {
        const int t0 = run * 16, tau0 = t0 & 2047;
#pragma unroll 1
        for (int sp = 0; sp < 2; ++sp) {
            const int ch = 512 * sp + 8 * lane;
            float w0[8], w1[8], w2[8], w3[8], bb[8];
            load8f(F.in[I_CONVW] + ch, w0); load8f(F.in[I_CONVW] + 1024 + ch, w1); load8f(F.in[I_CONVW] + 2048 + ch, w2); load8f(F.in[I_CONVW] + 3072 + ch, w3); load8f(F.in[I_CONVB] + ch, bb);
            float x0[8], x1[8], x2[8];
            if (tau0 >= 3) { unpack8(*(const v4u*)(proj + (size_t)(t0 - 3) * NPROJ + ch), x0); unpack8(*(const v4u*)(proj + (size_t)(t0 - 2) * NPROJ + ch), x1); unpack8(*(const v4u*)(proj + (size_t)(t0 - 1) * NPROJ + ch), x2); }
            else {
#pragma unroll
                for (int i = 0; i < 8; ++i) { x0[i] = 0.f; x1[i] = 0.f; x2[i] = 0.f; } }
#pragma unroll 1
            for (int k0 = 0; k0 < 16; k0 += 4) {
                v4u raw[4];
#pragma unroll
                for (int k = 0; k < 4; ++k) raw[k] = *(const v4u*)(proj + (size_t)(t0 + k0 + k) * NPROJ + ch);
#pragma unroll
                for (int k = 0; k < 4; ++k) { float x3[8], y[8]; unpack8(raw[k], x3);
#pragma unroll
                    for (int i = 0; i < 8; ++i) { const float a = fmaf(w3[i], x3[i], fmaf(w2[i], x2[i], fmaf(w1[i], x1[i], fmaf(w0[i], x0[i], bb[i])))); y[i] = a * sigm(a); x0[i] = x1[i]; x1[i] = x2[i]; x2[i] = x3[i]; }
                    *(v4u*)(mlqk + (size_t)(t0 + k0 + k) * 1024 + ch) = pack8f(y); }
            }
        }
    }
    {
        const bf16* memkv = (const bf16*)(ws + WS_MEMKV); bf16* memkn = (bf16*)(ws + WS_MEMKN);
        float kg8[8]; load8f(F.in[I_MGK] + 8 * (lane & 15), kg8);
        for (int r = gw; r < MROWS; r += NGW) {
            float f[8]; unpack8(*(const v4u*)(memkv + (size_t)r * 1024 + 8 * lane), f);
            float ss = 0.f;
#pragma unroll
            for (int i = 0; i < 8; ++i) ss = fmaf(f[i], f[i], ss);
            ss += __shfl_xor(ss, 1); ss += __shfl_xor(ss, 2); ss += __shfl_xor(ss, 4); ss += __shfl_xor(ss, 8);
            const float rstd = rsqrtf(ss * (1.f / 128.f) + EPS);
#pragma unroll
            for (int i = 0; i < 8; ++i) f[i] *= rstd * kg8[i];
            *(v4u*)(memkn + (size_t)r * 512 + 8 * lane) = pack8f(f);
        }
    }
}

DI void p4_kcvc(Frame& F) {
    unsigned char* ws = F.ws;
    const int gw = F.bx * NWAVES + F.wave, NGW = F.G * NWAVES, lane = F.lane_id();
    const bf16* hid = (const bf16*)(ws + WS_HID);
    const float* rc = (const float*)(ws + WS_SMALL + SM_ROPEC); const float* rs = (const float*)(ws + WS_SMALL + SM_ROPES);
    const float gk = F.in[I_NGK][lane];
    for (int it = gw; it < 2 * 4096; it += NGW) {
        const int kv = it >> 12, r = it & 4095, n = r & 127;
        bf16* dst = (bf16*)(ws + (kv ? WS_VC : WS_KC)) + (size_t)r * 64 + lane;
        if (n == 127) { *dst = 0; continue; }
        const bf16* hr = hid + (size_t)kv * 4096 * 256 + (size_t)r * 256; const float* w2 = F.in[kv ? I_CW2V : I_CW2K];
        float a = 0.f;
        for (int f = 0; f < 256; ++f) a = fmaf(bf2f(hr[f]), w2[f * 64 + lane], a);
        if (kv == 0) {
            const float y = a * rsqrtf(wave_sum(a * a) * (1.f / 64.f) + EPS) * gk;
            const int pos = 16 * n + 31; const float c = rc[pos * 32 + (lane & 31)], s = rs[pos * 32 + (lane & 31)];
            const float pt = __shfl_xor(y, 32);
            a = lane < 32 ? y * c - pt * s : y * c + pt * s;
        }
        *dst = (bf16)f2bf(a);
    }
}

typedef float f32x16 __attribute__((ext_vector_type(16)));
typedef float f32x2v __attribute__((ext_vector_type(2)));
typedef __bf16 bf16x2v __attribute__((ext_vector_type(2)));
typedef short s16x4 __attribute__((ext_vector_type(4)));
typedef unsigned u32x2 __attribute__((ext_vector_type(2)));
#define MFMA32(a, b, c) __builtin_amdgcn_mfma_f32_32x32x16_bf16((a), (b), (c), 0, 0, 0)
#define WG_BAR() do { asm volatile("s_waitcnt vmcnt(0) lgkmcnt(0)" ::: "memory"); __builtin_amdgcn_s_barrier(); asm volatile("" ::: "memory"); } while (0)
DI unsigned pkbf(float lo, float hi) { f32x2v v = {lo, hi}; return __builtin_bit_cast(unsigned, __builtin_convertvector(v, bf16x2v)); }
template <int S> DI bf16x8 pack8(const f32x16& x) {
    v4u p; p.x = pkbf(x[8 * S], x[8 * S + 1]); p.y = pkbf(x[8 * S + 2], x[8 * S + 3]); p.z = pkbf(x[8 * S + 4], x[8 * S + 5]); p.w = pkbf(x[8 * S + 6], x[8 * S + 7]);
    return __builtin_bit_cast(bf16x8, p);
}
DI int crow(int i, int h) { return (i & 3) + 8 * (i >> 2) + 4 * h; }
constexpr int AT_K = 0, AT_V = 32768, AT_IMP = 65536, AT_WM = 98304, AT_INV = 98368, AT_SC = 99392;

DI void glds16(const void* gsrc, unsigned lds_dst) { unsigned keep; asm volatile("s_mov_b32 %0, m0\n\ts_mov_b32 m0, %2\n\ts_nop 0\n\tglobal_load_lds_dwordx4 %1, off\n\ts_mov_b32 m0, %0" : "=&s"(keep) : "v"(gsrc), "s"(lds_dst) : "memory"); }
DI void at_load(LAS unsigned char* lds, int par, const void* kb, size_t kpitch, const void* vb, size_t vpitch, int wave, int lane) {
    const int row = 8 * wave + (lane >> 3), pc = lane & 7;
    const int kc = pc ^ ((row >> 1) & 7), vc = pc ^ (((row >> 1) & 1) << 2);
    glds16((const char*)kb + (size_t)row * kpitch + 16 * kc, (unsigned)(size_t)(lds + AT_K + par * 8192 + wave * 1024));
    glds16((const char*)vb + (size_t)row * vpitch + 16 * vc, (unsigned)(size_t)(lds + AT_V + par * 8192 + wave * 1024));
}
#define SB() __builtin_amdgcn_sched_barrier(0)
typedef __attribute__((address_space(3))) s16x4 lds_s16x4;
DI void at_qk(const LAS unsigned char* kbuf, const int (&ka)[4], const bf16x8 (&qf)[4], f32x16 (&s)[2]) {
    bf16x8 kf[2][4];
#pragma unroll
    for (int kb = 0; kb < 2; ++kb)
#pragma unroll
        for (int st = 0; st < 4; ++st) kf[kb][st] = *(const LAS bf16x8*)(kbuf + ka[st] + kb * 4096);
    SB();
#pragma unroll
    for (int kb = 0; kb < 2; ++kb) {
        f32x16 a;
#pragma unroll
        for (int i = 0; i < 16; ++i) a[i] = 0.f;
#pragma unroll
        for (int st = 0; st < 4; ++st) a = MFMA32(kf[kb][st], qf[st], a);
        s[kb] = a;
    }
}
DI void at_vload(const LAS unsigned char* vbuf, const int (&va)[2], int kb, bf16x8 (&vf)[2][2]) {
#pragma unroll
    for (int s2 = 0; s2 < 2; ++s2)
#pragma unroll
        for (int db = 0; db < 2; ++db) {
            const s16x4 lo = __builtin_amdgcn_ds_read_tr16_b64_v4i16((lds_s16x4*)(vbuf + va[db] + kb * 4096 + s2 * 2048));
            const s16x4 hi = __builtin_amdgcn_ds_read_tr16_b64_v4i16((lds_s16x4*)(vbuf + va[db] + kb * 4096 + s2 * 2048 + 1024));
            vf[s2][db] = __builtin_shufflevector(lo, hi, 0, 1, 2, 3, 4, 5, 6, 7); }
}
DI void at_pv1(const bf16x8 (&vf)[2][2], const f32x16& p, f32x16 (&o)[2]) {
    const bf16x8 pf0 = pack8<0>(p), pf1 = pack8<1>(p);
#pragma unroll
    for (int s2 = 0; s2 < 2; ++s2)
#pragma unroll
        for (int db = 0; db < 2; ++db) o[db] = MFMA32(vf[s2][db], s2 ? pf1 : pf0, o[db]);
}
DI void at_pv(const LAS unsigned char* vbuf, const int (&va)[2], const bf16x8 (&vf0)[2][2], const f32x16 (&p)[2], f32x16 (&o)[2]) {
    bf16x8 vf1[2][2]; at_vload(vbuf, va, 1, vf1);
    at_pv1(vf0, p[0], o);
    at_pv1(vf1, p[1], o);
}
DI void at_exp_all(f32x16 (&s)[2], float& l) {
#pragma unroll
    for (int kb = 0; kb < 2; ++kb)
#pragma unroll
        for (int i = 0; i < 16; ++i) { const float p = __builtin_amdgcn_exp2f(s[kb][i]); s[kb][i] = p; l += p; }
}
DI void at_wait(int n) {
    if (n >= 2) asm volatile("s_waitcnt vmcnt(4)" ::: "memory"); else if (n == 1) asm volatile("s_waitcnt vmcnt(2)" ::: "memory"); else asm volatile("s_waitcnt vmcnt(0)" ::: "memory");
    asm volatile("s_waitcnt lgkmcnt(0)" ::: "memory"); __builtin_amdgcn_s_barrier(); asm volatile("" ::: "memory");
}
template <bool STORE = true, bool DO_CMP = true, bool DO_SEL = true, bool DO_WIN = true>
DI void nsa_unit(Frame& F, int unit) {
    unsigned char* ws = F.ws; LAS unsigned char* lds = F.lds;
    int lane_ = F.lane_id();
    const int lane = lane_, wave = F.wave, r = lane & 31, h = lane >> 5, g = wave >> 1, qh = wave & 1;
    const int bh = unit & 31, qt = 31 - (unit >> 5), b = bh >> 1, hkv = bh & 1;
    const int qloc = 32 * qh + r, tau = 64 * qt + qloc, qq = tau & 63; const size_t t = (size_t)b * SEQ + tau;
    const bf16* proj = (const bf16*)(ws + WS_PROJ);
    const bf16* qn = (const bf16*)(ws + WS_QN); const bf16* ksn = (const bf16*)(ws + WS_KSN); const bf16* kwn = (const bf16*)(ws + WS_KWN);
    const bf16* kc = (const bf16*)(ws + WS_KC); const bf16* vc = (const bf16*)(ws + WS_VC); bf16* H1 = (bf16*)(ws + WS_H0);
    int ka[4], va[2];
    { const int f = (r >> 1) & 7, fs = f >> 1, hb = h ^ (f & 1);
#pragma unroll
      for (int st = 0; st < 4; ++st) ka[st] = r * 128 + 16 * (((st ^ fs) << 1) | hb);
      const int i16 = lane & 15, q = i16 >> 2, p = i16 & 3, g1 = (lane >> 4) & 1;
#pragma unroll
      for (int db = 0; db < 2; ++db) va[db] = (4 * h + q) * 128 + 16 * ((4 * db + 2 * g1 + (p >> 1)) ^ (((q >> 1) & 1) << 2)) + 8 * (p & 1); }
    bf16x8 qf[4];
#pragma unroll
    for (int st = 0; st < 4; ++st) qf[st] = *(const bf16x8*)(qn + t * 512 + (hkv * 4 + g) * 64 + 16 * st + 8 * h);
    float gate[3];
#pragma unroll
    for (int c = 0; c < 3; ++c) gate[c] = sigm(bf2f(proj[t * NPROJ + PC_NG + (hkv * 4 + g) * 3 + c]));
    f32x16 ofin[2];
#pragma unroll
    for (int i = 0; i < 16; ++i) { ofin[0][i] = 0.f; ofin[1][i] = 0.f; }
    WG_BAR();
    if (DO_CMP) {
        const int ncq = tau >= 31 ? ((tau - 31) >> 4) + 1 : 0;
        const int ntc = (((64 * qt + 63 - 31) >> 4) + 1 > 64) ? 2 : 1;
        const char* kb0 = (const char*)(kc + (size_t)(b * 2 + hkv) * 128 * 64); const char* vb0 = (const char*)(vc + (size_t)(b * 2 + hkv) * 128 * 64);
        at_load(lds, 0, kb0, 128, vb0, 128, wave, lane);
        if (ntc == 2) at_load(lds, 1, kb0 + 64 * 128, 128, vb0 + 64 * 128, 128, wave, lane);
        WG_BAR();
        f32x16 o[2]; float l = 0.f, prevEp = 0.f;
#pragma unroll
        for (int i = 0; i < 16; ++i) { o[0][i] = 0.f; o[1][i] = 0.f; }
        LAS float* I = (LAS float*)(lds + AT_IMP) + (g * 64 + qloc) * 32;
#pragma unroll 1
        for (int tile = 0; tile < 2; ++tile) {
            if (tile < ntc) {
                f32x16 s[2];
                at_qk(lds + AT_K + tile * 8192, ka, qf, s);
                bf16x8 vf[2][2]; at_vload(lds + AT_V + tile * 8192, va, 0, vf); SB();
#pragma unroll
                for (int kb = 0; kb < 2; ++kb)
#pragma unroll
                    for (int i = 0; i < 16; ++i) { const int n = 64 * tile + 32 * kb + crow(i, h); const float p = n < ncq ? __builtin_amdgcn_exp2f(s[kb][i]) : 0.f; s[kb][i] = p; l += p; }
#pragma unroll
                for (int kb = 0; kb < 2; ++kb)
#pragma unroll
                    for (int a = 0; a < 4; ++a) { const int idx = tile * 8 + kb * 4 + a; const float Gv = (s[kb][4 * a] + s[kb][4 * a + 1]) + (s[kb][4 * a + 2] + s[kb][4 * a + 3]);
                        const float Epv = __shfl_xor(s[kb][4 * a + 3], 32);
                        I[2 * idx + h] = Gv + (h ? Epv : prevEp); prevEp = Epv; }
                at_pv(lds + AT_V + tile * 8192, va, vf, s, o);
            } else {
#pragma unroll
                for (int idx = 8; idx < 16; ++idx) I[2 * idx + h] = 0.f;
            }
        }
        const float L = l + __shfl_xor(l, 32); const float inv = L > 0.f ? 1.f / L : 0.f;
        const float gi = gate[0] * inv;
#pragma unroll
        for (int i = 0; i < 16; ++i) { ofin[0][i] += gi * o[0][i]; ofin[1][i] += gi * o[1][i]; }
        if (h == 0) ((LAS float*)(lds + AT_INV))[g * 64 + qloc] = inv;
    }
    WG_BAR();
    unsigned sel = 0u, wm = 0u, um = 0u;
    if (!DO_CMP) { sel = (qt == 31) ? 0xffffffffu : ((1u << (qt + 1)) - 1u); wm = sel; um = sel; }
    else {
        const LAS float* I = (const LAS float*)(lds + AT_IMP) + qloc * 32;
        const LAS float* IV = (const LAS float*)(lds + AT_INV) + qloc;
        const float iv0 = IV[0], iv1 = IV[64], iv2 = IV[128], iv3 = IV[192];
        LAS unsigned* SC = (LAS unsigned*)(lds + AT_SC) + (qh * 32 + r) * 33;
        if (g == 0 && h == 0) {
#pragma unroll 8
            for (int j = 0; j < 32; ++j) { const float imp = (I[j] * iv0 + I[64 * 32 + j] * iv1) + (I[2 * 64 * 32 + j] * iv2 + I[3 * 64 * 32 + j] * iv3);
                const bool cand = (j >= 1) && (j <= qt - 2);
                SC[j] = cand ? ((__float_as_uint(imp) & ~31u) | (unsigned)(31 - j)) + 32u : 0u; }
        }
        WG_BAR();
        if (qt <= 7) sel = (1u << (qt + 1)) - 1u;
        else {
            sel = 1u | (1u << qt) | (1u << (qt - 1));
            unsigned prev = 0xffffffffu;
#pragma unroll 1
            for (int rd = 0; rd < 5; ++rd) { unsigned best = 0u;
#pragma unroll 8
                for (int j = 0; j < 32; ++j) { const unsigned kx = SC[j]; const unsigned cnd = kx < prev ? kx : 0u; best = cnd > best ? cnd : best; }
                prev = best; if (best) sel |= 1u << (31 - (int)(best & 31u)); }
        }
        sel &= (qt == 31) ? 0xffffffffu : ((1u << (qt + 1)) - 1u);
        wm = sel;
#pragma unroll
        for (int o = 1; o < 32; o <<= 1) wm |= (unsigned)__shfl_xor((int)wm, o);
        wm = (unsigned)__builtin_amdgcn_readfirstlane((int)wm);
        if (lane == 0) ((LAS unsigned*)(lds + AT_WM))[wave] = wm;
        WG_BAR();
        um = 0u;
#pragma unroll
        for (int w = 0; w < 8; ++w) um |= ((const LAS unsigned*)(lds + AT_WM))[w];
        um = (unsigned)__builtin_amdgcn_readfirstlane((int)um);
    }
    if (DO_SEL) {
        f32x16 o[2]; float l = 0.f;
#pragma unroll
        for (int i = 0; i < 16; ++i) { o[0][i] = 0.f; o[1][i] = 0.f; }
        const char* kbase = (const char*)(ksn + (size_t)b * SEQ * 128 + hkv * 64); const char* vbase = (const char*)((const bf16*)(ws + WS_VSN) + (size_t)b * SEQ * 128 + hkv * 64);
        unsigned rem = um, im = um; int k = 0; const int T = __popc(um);
#pragma unroll 1
        for (int i = 0; i < 3 && im; ++i) { const int jn = __ffs((int)im) - 1; im &= im - 1u; at_load(lds, i, kbase + (size_t)jn * 64 * 256, 256, vbase + (size_t)jn * 64 * 256, 256, wave, lane); }
#pragma unroll 1
        while (rem) {
            const int j = __ffs((int)rem) - 1; rem &= rem - 1u;
            at_wait(T - k - 1);
#ifdef NSA_E1
            at_wait(T - k - 1);
#endif
            if (im) { const int jn = __ffs((int)im) - 1; im &= im - 1u; at_load(lds, (k + 3) & 3, kbase + (size_t)jn * 64 * 256, 256, vbase + (size_t)jn * 64 * 256, 256, wave, lane); }
            const int par = k & 3;
            if ((wm >> j) & 1u) {
                f32x16 s[2];
                at_qk(lds + AT_K + par * 8192, ka, qf, s);
                bf16x8 vf[2][2]; at_vload(lds + AT_V + par * 8192, va, 0, vf); SB();
                const bool on = (sel >> j) & 1u;
                if (j != qt && __all(on)) at_exp_all(s, l);
                else { const int klim = j == qt ? qq : 63;
#pragma unroll
                    for (int kb = 0; kb < 2; ++kb)
#pragma unroll
                        for (int i = 0; i < 16; ++i) { const int key = 32 * kb + crow(i, h); const float p = (on && key <= klim) ? __builtin_amdgcn_exp2f(s[kb][i]) : 0.f; s[kb][i] = p; l += p; } }
                at_pv(lds + AT_V + par * 8192, va, vf, s, o);
            }
            ++k;
        }
        const float L = l + __shfl_xor(l, 32); const float gi = gate[1] * (L > 0.f ? 1.f / L : 0.f);
#pragma unroll
        for (int i = 0; i < 16; ++i) { ofin[0][i] += gi * o[0][i]; ofin[1][i] += gi * o[1][i]; }
    }
    WG_BAR();
    if (DO_WIN) {
        f32x16 o[2]; float l = 0.f;
#pragma unroll
        for (int i = 0; i < 16; ++i) { o[0][i] = 0.f; o[1][i] = 0.f; }
        const char* kbase = (const char*)(kwn + (size_t)b * SEQ * 128 + hkv * 64); const char* vbase = (const char*)((const bf16*)(ws + WS_VWN) + (size_t)b * SEQ * 128 + hkv * 64);
        const int jlo = qt > 8 ? qt - 8 : 0; const int T = qt - jlo + 1;
#ifdef NSA_E2
        f32x16 o2[2]; float l2 = 0.f;
#pragma unroll
        for (int i = 0; i < 16; ++i) { o2[0][i] = 0.f; o2[1][i] = 0.f; }
#endif
#pragma unroll 1
        for (int i = 0; i < 3 && i < T; ++i) at_load(lds, i, kbase + (size_t)(jlo + i) * 64 * 256, 256, vbase + (size_t)(jlo + i) * 64 * 256, 256, wave, lane);
#pragma unroll 1
        for (int k = 0; k < T; ++k) {
            const int j = jlo + k, par = k & 3;
            at_wait(T - k - 1);
#ifdef NSA_E1
            at_wait(T - k - 1);
#endif
            if (k + 3 < T) at_load(lds, (k + 3) & 3, kbase + (size_t)(j + 3) * 64 * 256, 256, vbase + (size_t)(j + 3) * 64 * 256, 256, wave, lane);
            f32x16 s[2];
            at_qk(lds + AT_K + par * 8192, ka, qf, s);
            bf16x8 vf[2][2]; at_vload(lds + AT_V + par * 8192, va, 0, vf); SB();
#ifdef NSA_E2
            { f32x16 s2[2]; asm volatile("" ::: "memory"); at_qk(lds + AT_K + par * 8192, ka, qf, s2); bf16x8 vf2[2][2]; at_vload(lds + AT_V + par * 8192, va, 0, vf2); SB(); at_exp_all(s2, l2); at_pv(lds + AT_V + par * 8192, va, vf2, s2, o2); }
#endif
            if (j != qt && j != qt - 8) at_exp_all(s, l);
            else { const int klo = (j == qt - 8) ? qq + 1 : 0, khi = (j == qt) ? qq : 63;
#pragma unroll
                for (int kb = 0; kb < 2; ++kb)
#pragma unroll
                    for (int i = 0; i < 16; ++i) { const int key = 32 * kb + crow(i, h); const float p = (key >= klo && key <= khi) ? __builtin_amdgcn_exp2f(s[kb][i]) : 0.f; s[kb][i] = p; l += p; } }
            at_pv(lds + AT_V + par * 8192, va, vf, s, o);
        }
#ifdef NSA_E2
        { const float z = l2 * 0.f;
#pragma unroll
          for (int i = 0; i < 16; ++i) { ofin[0][i] += z * o2[0][i]; ofin[1][i] += z * o2[1][i]; } }
#endif
        const float L = l + __shfl_xor(l, 32); const float gi = gate[2] * (L > 0.f ? 1.f / L : 0.f);
#pragma unroll
        for (int i = 0; i < 16; ++i) { ofin[0][i] += gi * o[0][i]; ofin[1][i] += gi * o[1][i]; }
    }
    if (!STORE) { asm volatile("" :: "v"(ofin[0]), "v"(ofin[1])); return; }
    WG_BAR();
#pragma unroll
    for (int db = 0; db < 2; ++db)
#pragma unroll
        for (int a = 0; a < 4; ++a) { u32x2 w; w.x = pkbf(ofin[db][4 * a], ofin[db][4 * a + 1]); w.y = pkbf(ofin[db][4 * a + 2], ofin[db][4 * a + 3]); *(LAS u32x2*)(lds + qloc * 528 + g * 128 + (32 * db + 8 * a + 4 * h) * 2) = w; }
    WG_BAR();
    { const int tid = wave * 64 + lane; bf16* obase = H1 + ((size_t)b * SEQ + 64 * qt) * 1536 + 512 + hkv * 256;
#pragma unroll
      for (int i = 0; i < 4; ++i) { const int piece = tid + 512 * i, row = piece >> 5, c = piece & 31; *(v4u*)(obase + (size_t)row * 1536 + 8 * c) = *(const LAS v4u*)(lds + row * 528 + 16 * c); } }
}
constexpr int ML_K = 0, ML_V = 32768, ML_VW = 65536, ML_C = 81920, ML_N = 114688, ML_SS = 115200, ML_WS = 116224, ML_GO = 120320, ML_ST = 135424;
DI int ml_fk(int s) { return ((s & 3) << 2) | ((s >> 2) & 3); }
DI void ml_load(LAS unsigned char* lds, int par, const char* kb, const char* vb, int wave, int lane) {
#pragma unroll
    for (int n2 = 0; n2 < 2; ++n2) { const int n = 2 * wave + n2, row = 4 * n + (lane >> 4), pc = lane & 15;
        const int kc = pc ^ ml_fk(row), vc = pc ^ ((row & 3) << 2);
        glds16(kb + (size_t)row * 2048 + 16 * kc, (unsigned)(size_t)(lds + ML_K + par * 16384 + n * 1024));
        glds16(vb + (size_t)row * 1024 + 16 * vc, (unsigned)(size_t)(lds + ML_V + par * 16384 + n * 1024)); }
}
DI bf16x8 ml_tr8(const LAS unsigned char* p) {
    const s16x4 lo = __builtin_amdgcn_ds_read_tr16_b64_v4i16((lds_s16x4*)p); const s16x4 hi = __builtin_amdgcn_ds_read_tr16_b64_v4i16((lds_s16x4*)(p + 1024));
    return __builtin_shufflevector(lo, hi, 0, 1, 2, 3, 4, 5, 6, 7);
}
template <int PM = 0xff>
DI void mlstm_unit2(Frame& F, int unit) {
    unsigned char* ws = F.ws; LAS unsigned char* lds = F.lds;
    int lane_ = F.lane_id();
    const int lane = lane_, wave = F.wave, tid = wave * 64 + lane, r = lane & 31, hh = lane >> 5, tb = wave >> 2, vb = wave & 3;
    const int b = unit >> 2, hd = unit & 3;
    const bf16* proj = (const bf16*)(ws + WS_PROJ); const bf16* mlqk = (const bf16*)(ws + WS_MLQK); bf16* H0 = (bf16*)(ws + WS_H0);
    const size_t tok0 = (size_t)b * SEQ;
    const char* kbase = (const char*)(mlqk + tok0 * 1024 + 512 + hd * 128); const char* vbase = (const char*)((const bf16*)(ws + WS_MLV) + tok0 * 512 + hd * 128);
    const float LOG2E = 1.4426950408889634f;
    const int i16 = lane & 15, q4 = i16 >> 2, p4 = i16 & 3, g1 = (lane >> 4) & 1;
    const int colsw = 16 * ((4 * vb + 2 * g1 + (p4 >> 1)) ^ (q4 << 2)) + 8 * (p4 & 1);
    const int base_c = (8 * hh + q4) * 256 + colsw;
    const int base_v = (4 * hh + q4) * 256 + colsw;
    const int fK = ml_fk(r), rowK = r * 256 + ((hh ^ (fK & 1)) << 4), F16 = (fK & 14) << 4;
    int base_kt[2][2];
#pragma unroll
    for (int blk = 0; blk < 2; ++blk)
#pragma unroll
        for (int hi = 0; hi < 2; ++hi) { const int kbp = 2 * tb + blk; base_kt[blk][hi] = (8 * hh + 4 * hi + q4) * 256 + 16 * ((4 * kbp + 2 * g1 + (p4 >> 1)) ^ ((q4 << 2) | ((2 * hh + hi) & 3))) + 8 * (p4 & 1); }
    LAS float* WS = (LAS float*)(lds + ML_WS) + wave * 128;
    LAS float* NV = (LAS float*)(lds + ML_N); LAS float* SS = (LAS float*)(lds + ML_SS);
    __syncthreads();
    for (int i = tid; i < 32768 / 16; i += 512) ((LAS v4u*)(lds + ML_C))[i] = (v4u){0u, 0u, 0u, 0u};
    if (tid < 128) NV[tid] = 0.f;
    f32x16 Cst[2];
#pragma unroll
    for (int i = 0; i < 16; ++i) { Cst[0][i] = 0.f; Cst[1][i] = 0.f; }
    if (tid < 128) ((LAS float*)(lds + ML_GO))[tid] = F.in[I_MLGOUT][hd * 128 + tid];
    const float bi = F.in[I_MLBI][hd], bfv = F.in[I_MLBF][hd];
    float m_prev = 0.f;
    ml_load(lds, 0, kbase, vbase, wave, lane);
    bf16x8 qf[8];
    { const bf16* qp = mlqk + (tok0 + 32 * tb + r) * 1024 + hd * 128 + 8 * hh;
#pragma unroll
      for (int st = 0; st < 8; ++st) qf[st] = *(const bf16x8*)(qp + 16 * st); }
    float gi_raw = bf2f(proj[(tok0 + lane) * NPROJ + PC_MLI + hd]), gf_raw = bf2f(proj[(tok0 + lane) * NPROJ + PC_MLF + hd]);
#pragma unroll 1
    for (int c = 0; c < 32; ++c) {
        const int par = c & 1; const size_t tokc = tok0 + 64 * c;
        WG_BAR();
        if ((PM & 1) && c > 0) {
            bf16* obase = H0 + (tokc - 64) * 1536 + hd * 128;
#pragma unroll
            for (int i = 0; i < 2; ++i) { const int piece = tid + 512 * i, row = piece >> 4, cc = piece & 15; *(v4u*)(obase + (size_t)row * 1536 + 8 * cc) = *(const LAS v4u*)(lds + ML_ST + row * 272 + 16 * cc); } }
        if (c < 31) ml_load(lds, par ^ 1, kbase + (size_t)(64 * (c + 1)) * 2048, vbase + (size_t)(64 * (c + 1)) * 1024, wave, lane);
        u32x2 og[4];
        { const bf16* op = proj + (tokc + 32 * tb + r) * NPROJ + PC_MLO + hd * 128 + 32 * vb + 4 * hh;
#pragma unroll
          for (int a = 0; a < 4; ++a) og[a] = *(const u32x2*)(op + 8 * a); }
        const float ig = gi_raw + bi, lf = logsig(gf_raw + bfv);
        float bc = lf;
        if (PM & 2) {
#pragma unroll
        for (int o = 1; o < 64; o <<= 1) { const float v = __shfl_up(bc, o); if (lane >= o) bc += v; } }
        const float rr = ig - bc;
        float cm = rr;
        if (PM & 2) {
#pragma unroll
        for (int o = 1; o < 64; o <<= 1) { const float v = __shfl_up(cm, o); if (lane >= o) cm = fmaxf(cm, v); } }
        const float M63 = fmaxf(m_prev, __shfl(cm, 63)), blast = __shfl(bc, 63);
        const float a_old = __expf(m_prev - M63), m_new = blast + M63;
        const int tl = 32 * tb + r;
        const float Mt = fmaxf(m_prev, __shfl(cm, tl)), bt = __shfl(bc, tl);
        const float inter = __expf(m_prev - Mt), m_t = bt + Mt;
        WS[lane] = rr * LOG2E; WS[64 + lane] = __expf(rr - M63);
        const float MtL = Mt * LOG2E;
        const LAS unsigned char* kbuf = lds + ML_K + par * 16384; const LAS unsigned char* vbuf = lds + ML_V + par * 16384;
        f32x16 wd[2]; float dsum = 0.f;
#pragma unroll
        for (int kb = 0; kb < 2; ++kb) {
#pragma unroll
            for (int i = 0; i < 16; ++i) wd[kb][i] = 0.f;
            if ((PM & 4) && kb <= tb) {
                f32x16 a = wd[kb]; bf16x8 kfr[8];
#pragma unroll
                for (int st = 0; st < 8; ++st) kfr[st] = *(const LAS bf16x8*)(kbuf + kb * 8192 + rowK + ((32 * st) ^ F16));
                SB();
#pragma unroll
                for (int st = 0; st < 8; ++st) a = MFMA32(kfr[st], qf[st], a);
#pragma unroll
                for (int i = 0; i < 16; ++i) { const int s = 32 * kb + crow(i, hh); const float e = __builtin_amdgcn_exp2f(WS[s] - MtL); const float w = (s <= tl) ? e * a[i] : 0.f; a[i] = w; dsum += w; }
                wd[kb] = a;
            }
        }
        f32x16 acc; bf16x8 cfr[8];
#pragma unroll
        for (int i = 0; i < 16; ++i) acc[i] = 0.f;
        if (PM & 8) {
#pragma unroll
        for (int st = 0; st < 8; ++st) cfr[st] = ml_tr8(lds + ML_C + base_c + st * 4096);
        SB();
#pragma unroll
        for (int st = 0; st < 8; ++st) acc = MFMA32(cfr[st], qf[st], acc); }
#pragma unroll
        for (int i = 0; i < 16; ++i) acc[i] *= inter;
#pragma unroll
        for (int kb = 0; kb < 2; ++kb) {
            if ((PM & 16) && kb <= tb) {
                const bf16x8 pf0 = pack8<0>(wd[kb]), pf1 = pack8<1>(wd[kb]);
                {
#pragma unroll
                  for (int s2 = 0; s2 < 2; ++s2) { const LAS unsigned char* p = vbuf + base_v + kb * 8192 + s2 * 4096;
                    const s16x4 lo = __builtin_amdgcn_ds_read_tr16_b64_v4i16((lds_s16x4*)p); const s16x4 hi = __builtin_amdgcn_ds_read_tr16_b64_v4i16((lds_s16x4*)(p + 2048));
                    const bf16x8 vf = __builtin_shufflevector(lo, hi, 0, 1, 2, 3, 4, 5, 6, 7);
                    acc = MFMA32(vf, s2 ? pf1 : pf0, acc); } }
            }
        }
        float qn_ = 0.f;
        if (PM & 32)
#pragma unroll
        for (int st = 0; st < 8; ++st) { const v4u qw = __builtin_bit_cast(v4u, qf[st]); const LAS float* np = NV + 16 * st + 8 * hh; const f32x4 n0 = *(const LAS f32x4*)np, n1 = *(const LAS f32x4*)(np + 4);
            qn_ = fmaf(__uint_as_float(qw.x << 16), n0[0], qn_); qn_ = fmaf(__uint_as_float(qw.x & 0xffff0000u), n0[1], qn_); qn_ = fmaf(__uint_as_float(qw.y << 16), n0[2], qn_); qn_ = fmaf(__uint_as_float(qw.y & 0xffff0000u), n0[3], qn_);
            qn_ = fmaf(__uint_as_float(qw.z << 16), n1[0], qn_); qn_ = fmaf(__uint_as_float(qw.z & 0xffff0000u), n1[1], qn_); qn_ = fmaf(__uint_as_float(qw.w << 16), n1[2], qn_); qn_ = fmaf(__uint_as_float(qw.w & 0xffff0000u), n1[3], qn_); }
        qn_ += __shfl_xor(qn_, 32); dsum += __shfl_xor(dsum, 32);
        const float den = inter * qn_ + dsum; const float rden = 1.f / fmaxf(fabsf(den), __expf(-m_t));
        float ssq = 0.f;
#pragma unroll
        for (int i = 0; i < 16; ++i) { acc[i] *= rden; ssq = fmaf(acc[i], acc[i], ssq); }
        ssq += __shfl_xor(ssq, 32);
        if (hh == 0) SS[vb * 64 + tl] = ssq;
        if (PM & 64)
#pragma unroll
        for (int k2 = 0; k2 < 2; ++k2) { const int ci = tid + 512 * k2, s = ci >> 4; const float w = WS[64 + s];
            const v4u x = *(const LAS v4u*)(vbuf + ci * 16); v4u y; const unsigned xs[4] = {x.x, x.y, x.z, x.w}; unsigned ys[4];
#pragma unroll
            for (int j = 0; j < 4; ++j) ys[j] = pkbf(__uint_as_float(xs[j] << 16) * w, __uint_as_float(xs[j] & 0xffff0000u) * w);
            y.x = ys[0]; y.y = ys[1]; y.z = ys[2]; y.w = ys[3]; *(LAS v4u*)(lds + ML_VW + ci * 16) = y; }
        asm volatile("s_waitcnt lgkmcnt(0)" ::: "memory"); __builtin_amdgcn_s_barrier(); asm volatile("" ::: "memory");
        if (c < 31) {
            const bf16* qp = mlqk + (tokc + 64 + 32 * tb + r) * 1024 + hd * 128 + 8 * hh;
#pragma unroll
            for (int st = 0; st < 8; ++st) qf[st] = *(const bf16x8*)(qp + 16 * st);
            gi_raw = bf2f(proj[(tokc + 64 + lane) * NPROJ + PC_MLI + hd]); gf_raw = bf2f(proj[(tokc + 64 + lane) * NPROJ + PC_MLF + hd]);
        }
        { const LAS float* GO = (const LAS float*)(lds + ML_GO) + 32 * vb + 4 * hh;
          const float rstd = rsqrtf(((SS[tl] + SS[64 + tl]) + (SS[128 + tl] + SS[192 + tl])) * (1.f / 128.f) + EPS);
#pragma unroll
          for (int a = 0; a < 4; ++a) { float o4[4]; const unsigned gw[2] = {og[a].x, og[a].y};
#pragma unroll
              for (int j = 0; j < 4; ++j) { const float ov = (j & 1) ? __uint_as_float(gw[j >> 1] & 0xffff0000u) : __uint_as_float(gw[j >> 1] << 16); o4[j] = acc[4 * a + j] * rstd * GO[8 * a + j] * sigm(ov); }
              u32x2 w; w.x = pkbf(o4[0], o4[1]); w.y = pkbf(o4[2], o4[3]); *(LAS u32x2*)(lds + ML_ST + tl * 272 + (32 * vb + 8 * a + 4 * hh) * 2) = w; } }
        if (PM & 128)
#pragma unroll
        for (int blk = 0; blk < 2; ++blk) {
            f32x16 cs = Cst[blk];
#pragma unroll
            for (int i = 0; i < 16; ++i) cs[i] *= a_old;
            bf16x8 afr[4], kfr2[4];
#pragma unroll
            for (int st = 0; st < 4; ++st) {
                afr[st] = ml_tr8(lds + ML_VW + base_c + st * 4096);
                const s16x4 lo = __builtin_amdgcn_ds_read_tr16_b64_v4i16((lds_s16x4*)(kbuf + base_kt[blk][0] + st * 4096)); const s16x4 hi = __builtin_amdgcn_ds_read_tr16_b64_v4i16((lds_s16x4*)(kbuf + base_kt[blk][1] + st * 4096));
                kfr2[st] = __builtin_shufflevector(lo, hi, 0, 1, 2, 3, 4, 5, 6, 7);
            }
            SB();
#pragma unroll
            for (int st = 0; st < 4; ++st) cs = MFMA32(afr[st], kfr2[st], cs);
            Cst[blk] = cs;
            const int kk = 32 * (2 * tb + blk) + r;
#pragma unroll
            for (int a = 0; a < 4; ++a) { u32x2 w; w.x = pkbf(cs[4 * a], cs[4 * a + 1]); w.y = pkbf(cs[4 * a + 2], cs[4 * a + 3]);
                *(LAS u32x2*)(lds + ML_C + kk * 256 + 16 * ((4 * vb + a) ^ ((r & 3) << 2)) + 8 * hh) = w; }
        }
        if ((PM & 64) && tid < 128) { float nv = NV[tid] * a_old;
#pragma unroll 8
            for (int s = 0; s < 64; ++s) { const unsigned short kvs = *(const LAS unsigned short*)(kbuf + s * 256 + 16 * ((tid >> 3) ^ ml_fk(s)) + 2 * (tid & 7)); nv = fmaf(WS[64 + s], bf2f(kvs), nv); }
            NV[tid] = nv; }
        m_prev = m_new;
    }
    __syncthreads();
    if (PM & 1) { bf16* obase = H0 + (tok0 + 64 * 31) * 1536 + hd * 128;
#pragma unroll
        for (int i = 0; i < 2; ++i) { const int piece = tid + 512 * i, row = piece >> 4, cc = piece & 15; *(v4u*)(obase + (size_t)row * 1536 + 8 * cc) = *(const LAS v4u*)(lds + ML_ST + row * 272 + 16 * cc); } }
    __syncthreads();
}
DI void mem_load(LAS unsigned char* lds, int par, const char* kb, const char* vb, int wave, int lane) {
#pragma unroll
    for (int n2 = 0; n2 < 2; ++n2) { const int n = 2 * wave + n2, row = 4 * n + (lane >> 4), pc = lane & 15;
        const int kc = pc ^ ml_fk(row), vc = pc ^ ((row & 3) << 2);
        glds16(kb + (size_t)row * 1024 + 16 * kc, (unsigned)(size_t)(lds + ML_K + par * 16384 + n * 1024));
        glds16(vb + (size_t)row * 2048 + 16 * vc, (unsigned)(size_t)(lds + ML_V + par * 16384 + n * 1024)); }
}
template <bool STORE = true, bool DMA = true, bool COMP = true>
DI void mem_unit(Frame& F, int unit) {
    unsigned char* ws = F.ws; LAS unsigned char* lds = F.lds;
    int lane_ = F.lane_id();
    const int lane = lane_, wave = F.wave, r = lane & 31, hh = lane >> 5;
    const int b = unit >> 5, hd = (unit >> 3) & 3, qt = unit & 7;
    const bf16* mqn = (const bf16*)(ws + WS_MQN); const bf16* memkn = (const bf16*)(ws + WS_MEMKN); const bf16* memkv = (const bf16*)(ws + WS_MEMKV); bf16* H2 = (bf16*)(ws + WS_H0);
    const size_t t = (size_t)b * SEQ + 256 * qt + 32 * wave + r;
    const char* kbase = (const char*)(memkn + (size_t)b * MEML * 512 + hd * 128); const char* vbase = (const char*)(memkv + (size_t)b * MEML * 1024 + 512 + hd * 128);
    const int i16 = lane & 15, q4 = i16 >> 2, p4 = i16 & 3, g1 = (lane >> 4) & 1;
    int base_v[4];
#pragma unroll
    for (int db = 0; db < 4; ++db) base_v[db] = (4 * hh + q4) * 256 + 16 * ((4 * db + 2 * g1 + (p4 >> 1)) ^ (q4 << 2)) + 8 * (p4 & 1);
    const int fK = ml_fk(r), rowK = r * 256 + ((hh ^ (fK & 1)) << 4), F16 = (fK & 14) << 4;
    bf16x8 qf[8];
#pragma unroll
    for (int st = 0; st < 8; ++st) qf[st] = *(const bf16x8*)(mqn + t * 512 + hd * 128 + 16 * st + 8 * hh);
    f32x16 o[4]; float l = 0.f;
#pragma unroll
    for (int db = 0; db < 4; ++db)
#pragma unroll
        for (int i = 0; i < 16; ++i) o[db][i] = 0.f;
    WG_BAR();
    if (DMA) mem_load(lds, 0, kbase, vbase, wave, lane);
#pragma unroll 1
    for (int tile = 0; tile < 4; ++tile) {
        const int par = tile & 1;
        WG_BAR();
        if (DMA && tile < 3) mem_load(lds, par ^ 1, kbase + (size_t)(64 * (tile + 1)) * 1024, vbase + (size_t)(64 * (tile + 1)) * 2048, wave, lane);
        const LAS unsigned char* kbuf = lds + ML_K + par * 16384; const LAS unsigned char* vbuf = lds + ML_V + par * 16384;
        if (COMP)
#pragma unroll
        for (int kb = 0; kb < 2; ++kb) {
            bf16x8 kf[8];
#pragma unroll
            for (int st = 0; st < 8; ++st) kf[st] = *(const LAS bf16x8*)(kbuf + kb * 8192 + rowK + ((32 * st) ^ F16));
            SB();
            f32x16 a;
#pragma unroll
            for (int i = 0; i < 16; ++i) a[i] = 0.f;
#pragma unroll
            for (int st = 0; st < 8; ++st) a = MFMA32(kf[st], qf[st], a);
            bf16x8 vf[2][4];
#pragma unroll
            for (int s2 = 0; s2 < 2; ++s2)
#pragma unroll
                for (int db = 0; db < 4; ++db) { const LAS unsigned char* p = vbuf + base_v[db] + kb * 8192 + s2 * 4096;
                    const s16x4 lo = __builtin_amdgcn_ds_read_tr16_b64_v4i16((lds_s16x4*)p); const s16x4 hi = __builtin_amdgcn_ds_read_tr16_b64_v4i16((lds_s16x4*)(p + 2048));
                    vf[s2][db] = __builtin_shufflevector(lo, hi, 0, 1, 2, 3, 4, 5, 6, 7); }
            SB();
#pragma unroll
            for (int i = 0; i < 16; ++i) { a[i] = __builtin_amdgcn_exp2f(a[i]); l += a[i]; }
            const bf16x8 pf0 = pack8<0>(a), pf1 = pack8<1>(a);
#pragma unroll
            for (int s2 = 0; s2 < 2; ++s2)
#pragma unroll
                for (int db = 0; db < 4; ++db) o[db] = MFMA32(vf[s2][db], s2 ? pf1 : pf0, o[db]);
        }
    }
    const float inv = 1.f / (l + __shfl_xor(l, 32));
    if (!STORE) {
#pragma unroll
        for (int db = 0; db < 4; ++db) asm volatile("" :: "v"(o[db]), "v"(inv));
        return; }
    WG_BAR();
#pragma unroll
    for (int db = 0; db < 4; ++db)
#pragma unroll
        for (int a = 0; a < 4; ++a) { u32x2 w; w.x = pkbf(o[db][4 * a] * inv, o[db][4 * a + 1] * inv); w.y = pkbf(o[db][4 * a + 2] * inv, o[db][4 * a + 3] * inv);
            *(LAS u32x2*)(lds + (32 * wave + r) * 272 + (32 * db + 8 * a + 4 * hh) * 2) = w; }
    WG_BAR();
    { const int tid = wave * 64 + lane; bf16* obase = H2 + ((size_t)b * SEQ + 256 * qt) * 1536 + 1024 + hd * 128;
#pragma unroll
      for (int i = 0; i < 8; ++i) { const int piece = tid + 512 * i, row = piece >> 4, c = piece & 15; *(v4u*)(obase + (size_t)row * 1536 + 8 * c) = *(const LAS v4u*)(lds + row * 272 + 16 * c); } }
}
DI int q_pop(Frame& F, unsigned* qc) {
    __syncthreads();
    if (F.tid_id() == 0) F.MISC[16] = atomicAdd(qc, 1u);
    __syncthreads();
    return (int)F.MISC[16];
}
template <bool ML, bool NSA, bool MEMA, bool MST = true, bool MDMA = true, bool MCOMP = true, bool NST = true, bool NCMP = true, bool NSEL = true, bool NWIN = true, int MLPM = 0xff>
DI void p5_queue(Frame& F, int cbase) {
    unsigned* qc = F.ctl + CW_QCTR + cbase;
    if (ML) {
#pragma unroll 1
        for (;;) { const int it = q_pop(F, qc); if (it >= 64) break; mlstm_unit2<MLPM>(F, it); }
    }
    if (NSA) {
#pragma unroll 1
        for (;;) { const int it = q_pop(F, qc + 64); if (it >= 1024) break; nsa_unit<NST, NCMP, NSEL, NWIN>(F, it); }
    }
    if (MEMA) {
#pragma unroll 1
        for (;;) { const int it = q_pop(F, qc + 128); if (it >= 512) break; mem_unit<MST, MDMA, MCOMP>(F, it); }
    }
    __syncthreads();
}
struct OneUnit { int pm; DI bool next(int i, pg8::Unit& u) const { if (i) return false; u.pm = pm; u.pn = 0; return true; } DI void a_ready(const pg8::Unit&) const {} DI void done(const pg8::Unit&) const {} };
DI void p2_compress(Frame& F) {
    unsigned char* ws = F.ws;
    if (F.G < 64 || F.bx >= 32) return;
    const int kv = F.bx >> 4, pm = F.bx & 15;
    typedef pg8::bf16_t b16;
    { pg8::GemmA g{(const b16*)(ws + WS_PROJ) + (kv ? PC_NVC : PC_NKC), (const b16*)(ws + WS_WC1) + (size_t)kv * 256 * 2048, 2048, 16 * NPROJ * 2, (size_t)NPROJ * 2, (size_t)128, (size_t)SEQ * NPROJ * 2};
      OneUnit S{pm};
      pg8::EpiBf16Silu E{(b16*)(ws + WS_HID) + (size_t)kv * 4096 * 256, 256, (const float*)(ws + WS_SMALL + SM_CBIAS) + kv * 256, 1};
      pg8::gemm_phase_ga<pg8::EpiBf16Silu, OneUnit, false, true>(F.lds, g, S, E, F.wave); }
    asm volatile("s_waitcnt vmcnt(0)" ::: "memory"); __syncthreads();
    const int lane = F.lane_id(), r = lane & 31, hh = lane >> 5;
    const int row = pm * 256 + F.wave * 32 + r, n = row & 127;
    const bf16* hid = (const bf16*)(ws + WS_HID) + (size_t)kv * 4096 * 256 + (size_t)row * 256 + 8 * hh;
    const bf16* w2t = (const bf16*)(ws + WS_SMALL + SM_W2T) + (size_t)kv * 64 * 256 + 8 * hh;
    f32x16 acc[2];
#pragma unroll
    for (int i = 0; i < 16; ++i) { acc[0][i] = 0.f; acc[1][i] = 0.f; }
#pragma unroll 4
    for (int st = 0; st < 16; ++st) { const bf16x8 hb = *(const bf16x8*)(hid + 16 * st);
        const bf16x8 w0 = *(const bf16x8*)(w2t + (size_t)r * 256 + 16 * st), w1 = *(const bf16x8*)(w2t + (size_t)(32 + r) * 256 + 16 * st);
        acc[0] = MFMA32(w0, hb, acc[0]); acc[1] = MFMA32(w1, hb, acc[1]); }
    if (kv == 0) {
        float ss = 0.f;
#pragma unroll
        for (int i = 0; i < 16; ++i) ss += acc[0][i] * acc[0][i] + acc[1][i] * acc[1][i];
        ss += __shfl_xor(ss, 32);
        const float rstd = rsqrtf(ss * (1.f / 64.f) + EPS);
        const float* rc = (const float*)(ws + WS_SMALL + SM_ROPEC); const float* rs = (const float*)(ws + WS_SMALL + SM_ROPES);
        const int pos = 16 * n + 31 < SEQ ? 16 * n + 31 : SEQ - 1;
#pragma unroll
        for (int i = 0; i < 16; ++i) { const int d = crow(i, hh); const float c = rc[pos * 32 + d], sn = rs[pos * 32 + d];
            const float y0 = acc[0][i] * rstd * F.in[I_NGK][d], y1 = acc[1][i] * rstd * F.in[I_NGK][32 + d];
            acc[0][i] = y0 * c - y1 * sn; acc[1][i] = y1 * c + y0 * sn; }
    }
    bf16* dst = (bf16*)(ws + (kv ? WS_VC : WS_KC)) + (size_t)row * 64 + 4 * hh;
#pragma unroll
    for (int db = 0; db < 2; ++db)
#pragma unroll
        for (int a = 0; a < 4; ++a) { u32x2 w; w.x = pkbf(acc[db][4 * a], acc[db][4 * a + 1]); w.y = pkbf(acc[db][4 * a + 2], acc[db][4 * a + 3]); if (n == 127) { w.x = 0u; w.y = 0u; }
            *(u32x2*)(dst + 32 * db + 8 * a) = w; }
}
DI void mlstm_unit(Frame& F, int unit) {
    unsigned char* ws = F.ws;
    const int b = unit >> 2, h = unit & 3, tid = F.tid_id(), kk = tid >> 7, c = tid & 127;
    const bf16* proj = (const bf16*)(ws + WS_PROJ); const bf16* mlqk = (const bf16*)(ws + WS_MLQK); bf16* H0 = (bf16*)(ws + WS_H0);
    LAS float* qs = (LAS float*)F.lds;
    LAS float* ks = qs + 16 * 128;
    LAS float* vs = ks + 16 * 128;
    LAS float* gi = vs + 16 * 128;
    LAS float* gf = gi + 16;
    LAS float* part = gf + 16;
    LAS float* pden = part + 2 * 4 * 128;
    LAS float* hb = pden + 8;
    float C[32], nn[32];
#pragma unroll
    for (int i = 0; i < 32; ++i) { C[i] = 0.f; nn[i] = 0.f; }
    float m = 0.f;
    const float bi = F.in[I_MLBI][h], bfv = F.in[I_MLBF][h];
    const float scale = 0.08838834764831845f;
#pragma unroll 1
    for (int t0 = 0; t0 < SEQ; t0 += 16) {
        __syncthreads();
        for (int i = tid; i < 16 * 128; i += 512) { const int s = i >> 7, d = i & 127; const size_t t = (size_t)b * SEQ + t0 + s;
            qs[i] = bf2f(mlqk[t * 1024 + h * 128 + d]); ks[i] = bf2f(mlqk[t * 1024 + 512 + h * 128 + d]); vs[i] = bf2f(proj[t * NPROJ + PC_MLV + h * 128 + d]); }
        if (tid < 16) { const size_t t = (size_t)b * SEQ + t0 + tid; gi[tid] = bf2f(proj[t * NPROJ + PC_MLI + h]) + bi; gf[tid] = logsig(bf2f(proj[t * NPROJ + PC_MLF + h]) + bfv); }
        __syncthreads();
#pragma unroll 1
        for (int s = 0; s < 16; ++s) {
            const float lf = gf[s], ig = gi[s];
            const float mn = fmaxf(lf + m, ig), a = __expf(lf + m - mn), bb = __expf(ig - mn);
            m = mn;
            const float v = vs[s * 128 + c];
            float pn = 0.f, pd = 0.f;
#pragma unroll
            for (int i = 0; i < 32; ++i) { const float kvv = ks[s * 128 + kk * 32 + i], qv = qs[s * 128 + kk * 32 + i];
                C[i] = a * C[i] + bb * kvv * v; nn[i] = a * nn[i] + bb * kvv; pn = fmaf(qv, C[i], pn); pd = fmaf(qv, nn[i], pd); }
            const int par = s & 1;
            part[(par * 4 + kk) * 128 + c] = pn; if (c == 0) pden[par * 4 + kk] = pd;
            __syncthreads();
            if (kk == 0) {
                const float num = (part[(par * 4 + 0) * 128 + c] + part[(par * 4 + 1) * 128 + c]) + (part[(par * 4 + 2) * 128 + c] + part[(par * 4 + 3) * 128 + c]);
                const float den = (pden[par * 4 + 0] + pden[par * 4 + 1]) + (pden[par * 4 + 2] + pden[par * 4 + 3]);
                hb[s * 128 + c] = num * scale / fmaxf(fabsf(den * scale), __expf(-mn));
            }
        }
        __syncthreads();
#pragma unroll
        for (int rr = 0; rr < 2; ++rr) { const int s = F.wave * 2 + rr; const size_t t = (size_t)b * SEQ + t0 + s;
            const float v0 = hb[s * 128 + F.lane_id()], v1 = hb[s * 128 + 64 + F.lane_id()];
            const float rstd = rsqrtf(wave_sum(v0 * v0 + v1 * v1) * (1.f / 128.f) + EPS);
            const float o0 = bf2f(proj[t * NPROJ + PC_MLO + h * 128 + F.lane_id()]), o1 = bf2f(proj[t * NPROJ + PC_MLO + h * 128 + 64 + F.lane_id()]);
            H0[t * 512 + h * 128 + F.lane_id()] = (bf16)f2bf(v0 * rstd * F.in[I_MLGOUT][h * 128 + F.lane_id()] * sigm(o0));
            H0[t * 512 + h * 128 + 64 + F.lane_id()] = (bf16)f2bf(v1 * rstd * F.in[I_MLGOUT][h * 128 + 64 + F.lane_id()] * sigm(o1)); }
    }
    __syncthreads();
}

DI void nsa_scores(const bf16* krow, bool valid, const LAS float* qs, float (&s)[4]) {
    s[0] = s[1] = s[2] = s[3] = 0.f;
    if (valid) {
#pragma unroll 2
        for (int c8 = 0; c8 < 8; ++c8) { const v4u kk = *(const v4u*)(krow + c8 * 8);
            const unsigned w[4] = {kk.x, kk.y, kk.z, kk.w};
#pragma unroll
            for (int j = 0; j < 4; ++j) { const float k0 = __uint_as_float(w[j] << 16), k1 = __uint_as_float(w[j] & 0xffff0000u); const int d = c8 * 8 + 2 * j;
#pragma unroll
                for (int g = 0; g < 4; ++g) s[g] = fmaf(k1, qs[g * 64 + d + 1], fmaf(k0, qs[g * 64 + d], s[g])); } }
    }
}
DI void nsa_wave(Frame& F, int item, LAS float* wl) {
    unsigned char* ws = F.ws; const int lane = F.lane_id();
    const int t = item >> 1, hkv = item & 1, b = t >> 11, tau = t & 2047;
    const bf16* proj = (const bf16*)(ws + WS_PROJ);
    const bf16* qn = (const bf16*)(ws + WS_QN); const bf16* ksn = (const bf16*)(ws + WS_KSN); const bf16* kwn = (const bf16*)(ws + WS_KWN);
    const bf16* kc = (const bf16*)(ws + WS_KC); const bf16* vc = (const bf16*)(ws + WS_VC); bf16* H1 = (bf16*)(ws + WS_H1);
    LAS float* qs = wl;
    LAS float* ps = wl + 256;
    LAS float* psum = wl + 768;
#pragma unroll
    for (int g = 0; g < 4; ++g) qs[g * 64 + lane] = bf2f(qn[(size_t)t * 512 + (hkv * 4 + g) * 64 + lane]);
    float ofin[4] = {0.f, 0.f, 0.f, 0.f};
    float gate[4][3];
#pragma unroll
    for (int g = 0; g < 4; ++g)
#pragma unroll
        for (int cidx = 0; cidx < 3; ++cidx) gate[g][cidx] = sigm(bf2f(proj[(size_t)t * NPROJ + PC_NG + (hkv * 4 + g) * 3 + cidx]));
    const int ncmp = tau >= 31 ? ((tau - 31) >> 4) + 1 : 0;
    {
        float l[4] = {0.f, 0.f, 0.f, 0.f}, o[4] = {0.f, 0.f, 0.f, 0.f};
        const size_t rbase = (size_t)(b * 2 + hkv) * 128;
#pragma unroll
        for (int blk = 0; blk < 2; ++blk) { const int n = blk * 64 + lane; const bool valid = n < ncmp; float s[4];
            nsa_scores(kc + (rbase + n) * 64, valid, qs, s);
#pragma unroll
            for (int g = 0; g < 4; ++g) { const float p = valid ? __expf(s[g]) : 0.f; l[g] += p; ps[g * 128 + n] = p; } }
        float inv[4];
#pragma unroll
        for (int g = 0; g < 4; ++g) { const float L = wave_sum(l[g]); inv[g] = L > 0.f ? 1.f / L : 0.f; }
#pragma unroll
        for (int blk = 0; blk < 2; ++blk) { const int n = blk * 64 + lane; psum[n] = (ps[0 * 128 + n] * inv[0] + ps[1 * 128 + n] * inv[1]) + (ps[2 * 128 + n] * inv[2] + ps[3 * 128 + n] * inv[3]); }
#pragma unroll 2
        for (int n = 0; n < ncmp; ++n) { const float vv = bf2f(vc[(rbase + n) * 64 + lane]);
#pragma unroll
            for (int g = 0; g < 4; ++g) o[g] = fmaf(ps[g * 128 + n], vv, o[g]); }
#pragma unroll
        for (int g = 0; g < 4; ++g) ofin[g] += gate[g][0] * o[g] * inv[g];
    }
    const int cur = tau >> 6;
    unsigned selmask = 0u;
    {
        float score = -3.0e38f;
        if (lane < 32) { const int j = lane; float imp = 0.f;
#pragma unroll
            for (int dn = -1; dn <= 3; ++dn) { const int n = 4 * j + dn; if (n >= 0 && n <= 126) imp += psum[n]; }
            const bool forced = (j == 0) || (j == cur) || (j == cur - 1);
            score = j > cur ? NEGF : imp + (forced ? 1.0e4f : 0.f); }
#pragma unroll 1
        for (int r = 0; r < 8; ++r) { const float mx = wave_max(score); const unsigned long long bal = __ballot(score == mx); const int win = __ffsll((long long)bal) - 1;
            selmask |= 1u << win; if (lane == win) score = -3.4e38f; }
    }
    {
        float l[4] = {0.f, 0.f, 0.f, 0.f}, o[4] = {0.f, 0.f, 0.f, 0.f};
#pragma unroll 1
        for (int j = 0; j <= cur; ++j) { if (!((selmask >> j) & 1u)) continue;
            const int kpos = 64 * j + lane; const bool valid = kpos <= tau; float s[4];
            nsa_scores(ksn + ((size_t)b * SEQ + kpos) * 128 + hkv * 64, valid, qs, s);
#pragma unroll
            for (int g = 0; g < 4; ++g) { const float p = valid ? __expf(s[g]) : 0.f; l[g] += p; ps[g * 128 + lane] = p; }
            const int nk = j == cur ? (tau & 63) + 1 : 64;
            const bf16* vb = proj + ((size_t)b * SEQ + 64 * j) * NPROJ + PC_NVS + hkv * 64 + lane;
#pragma unroll 2
            for (int k = 0; k < nk; ++k) { const float vv = bf2f(vb[(size_t)k * NPROJ]);
#pragma unroll
                for (int g = 0; g < 4; ++g) o[g] = fmaf(ps[g * 128 + k], vv, o[g]); } }
#pragma unroll
        for (int g = 0; g < 4; ++g) { const float L = wave_sum(l[g]); ofin[g] += gate[g][1] * o[g] * (L > 0.f ? 1.f / L : 0.f); }
    }
    {
        float l[4] = {0.f, 0.f, 0.f, 0.f}, o[4] = {0.f, 0.f, 0.f, 0.f};
        const int start = tau - 511 > 0 ? tau - 511 : 0;
#pragma unroll 1
        for (int base = start & ~63; base <= tau; base += 64) {
            const int kpos = base + lane; const bool valid = kpos >= start && kpos <= tau; float s[4];
            nsa_scores(kwn + ((size_t)b * SEQ + kpos) * 128 + hkv * 64, valid, qs, s);
#pragma unroll
            for (int g = 0; g < 4; ++g) { const float p = valid ? __expf(s[g]) : 0.f; l[g] += p; ps[g * 128 + lane] = p; }
            const int k0 = start > base ? start - base : 0, k1 = tau - base < 63 ? tau - base : 63;
            const bf16* vb = proj + ((size_t)b * SEQ + base) * NPROJ + PC_NVW + hkv * 64 + lane;
#pragma unroll 2
            for (int k = k0; k <= k1; ++k) { const float vv = bf2f(vb[(size_t)k * NPROJ]);
#pragma unroll
                for (int g = 0; g < 4; ++g) o[g] = fmaf(ps[g * 128 + k], vv, o[g]); } }
#pragma unroll
        for (int g = 0; g < 4; ++g) { const float L = wave_sum(l[g]); ofin[g] += gate[g][2] * o[g] * (L > 0.f ? 1.f / L : 0.f); }
    }
#pragma unroll
    for (int g = 0; g < 4; ++g) H1[(size_t)t * 512 + (hkv * 4 + g) * 64 + lane] = (bf16)f2bf(ofin[g]);
}
DI void mem_wave(Frame& F, int t, LAS float* wl) {
    unsigned char* ws = F.ws; const int lane = F.lane_id(); const int b = t >> 11;
    const bf16* mqn = (const bf16*)(ws + WS_MQN); const bf16* memkn = (const bf16*)(ws + WS_MEMKN); const bf16* memkv = (const bf16*)(ws + WS_MEMKV); bf16* H2 = (bf16*)(ws + WS_H2);
    LAS float* qs = wl;
    LAS float* ps = wl + 128;
#pragma unroll 1
    for (int h = 0; h < 4; ++h) {
        qs[lane] = bf2f(mqn[(size_t)t * 512 + h * 128 + lane]); qs[64 + lane] = bf2f(mqn[(size_t)t * 512 + h * 128 + 64 + lane]);
        float l = 0.f;
#pragma unroll 1
        for (int kq = 0; kq < 4; ++kq) { const int key = kq * 64 + lane; const bf16* kr = memkn + ((size_t)b * MEML + key) * 512 + h * 128; float s = 0.f;
#pragma unroll 2
            for (int c8 = 0; c8 < 16; ++c8) { const v4u kk = *(const v4u*)(kr + c8 * 8); const unsigned w[4] = {kk.x, kk.y, kk.z, kk.w};
#pragma unroll
                for (int j = 0; j < 4; ++j) s = fmaf(__uint_as_float(w[j] & 0xffff0000u), qs[c8 * 8 + 2 * j + 1], fmaf(__uint_as_float(w[j] << 16), qs[c8 * 8 + 2 * j], s)); }
            const float p = __expf(s); l += p; ps[key] = p; }
        const float inv = 1.f / wave_sum(l);
        float o0 = 0.f, o1 = 0.f;
        const bf16* vb = memkv + (size_t)b * MEML * 1024 + 512 + h * 128;
#pragma unroll 4
        for (int key = 0; key < MEML; ++key) { const float p = ps[key]; o0 = fmaf(p, bf2f(vb[(size_t)key * 1024 + lane]), o0); o1 = fmaf(p, bf2f(vb[(size_t)key * 1024 + 64 + lane]), o1); }
        H2[(size_t)t * 512 + h * 128 + lane] = (bf16)f2bf(o0 * inv); H2[(size_t)t * 512 + h * 128 + 64 + lane] = (bf16)f2bf(o1 * inv);
    }
}
DI void p5_mixers(Frame& F) {
    const int nml = F.G >= 128 ? 64 : 0;
#ifndef RPT_ML
#define RPT_ML 1
#endif
#ifndef RPT_NSA
#define RPT_NSA 1
#endif
#ifndef RPT_MEM
#define RPT_MEM 1
#endif
    if (F.bx < nml || nml == 0) { for (int rp = 0; rp < RPT_ML; ++rp) for (int u = F.bx; u < 64; u += (nml ? nml : F.G)) mlstm_unit2(F, u); }
    if (F.bx >= nml) {
        LAS float* wl = (LAS float*)(F.lds + F.wave * 4096);
        const int gw = (F.bx - nml) * NWAVES + F.wave, NGW = (F.G - nml) * NWAVES;
        for (int rp = 0; rp < RPT_NSA; ++rp) for (int u = F.bx - nml; u < 1024; u += F.G - nml) nsa_unit(F, u);
        __syncthreads();
        for (int rp = 0; rp < RPT_MEM; ++rp) for (int t = gw; t < MT; t += NGW) mem_wave(F, t, wl);
    }
}

DI void p8_router(Frame& F, int alt) {
    unsigned char* ws = F.ws + (size_t)alt * 3 * MiB; const int lane = F.lane_id(), tid = F.tid_id(), wave = F.wave, r = lane & 31, hh = lane >> 5;
    unsigned char* xn8 = (unsigned char*)(F.ws + WS_R1);
    int* tok_e = (int*)(ws + WS_ROUTE + RT_TOKE); int* tok_pos = (int*)(ws + WS_ROUTE + RT_TOKPOS); float* tok_w = (float*)(ws + WS_ROUTE + RT_TOKW);
    unsigned* gcnt = F.ctl + CW_ECNT + 64 * alt;
    const bf16* wrt = (const bf16*)(F.ws + WS_SMALL + SM_WRT);
    LAS unsigned char* img = F.lds;
    LAS float* part = (LAS float*)F.lds;
    LAS float* lg = (LAS float*)(F.lds + 4 * 64 * 33 * 4);
    LAS int* lcnt = (LAS int*)(F.lds + RING_BYTES + 1024);
    LAS int* lbase = lcnt + 32;
    LAS int* se = lbase + 32;
    LAS int* sp = se + 256;
    LAS float* sw = (LAS float*)(sp + 256);
    const float* gf = F.in[I_GFFN];
    for (int bt = F.bx; bt < MT / 64; bt += F.G) {
        __syncthreads();
        if (tid < 32) lcnt[tid] = 0;
#pragma unroll 2
        for (int i = 0; i < 8; ++i) {
            const int tl = wave * 8 + i, t = bt * 64 + tl;
            const f32x4* xr = (const f32x4*)(F.out + (size_t)t * DM) + lane; const f32x4* gr = (const f32x4*)gf + lane;
            f32x4 v[4]; float s = 0.f;
#pragma unroll
            for (int j = 0; j < 4; ++j) { v[j] = xr[64 * j]; s += (v[j].x * v[j].x + v[j].y * v[j].y) + (v[j].z * v[j].z + v[j].w * v[j].w); }
            const float rstd = rsqrtf(wave_sum(s) * (1.f / DM) + EPS);
            unsigned* o4 = (unsigned*)(xn8 + (size_t)t * DM) + lane;
#pragma unroll
            for (int j = 0; j < 4; ++j) { const f32x4 gg = gr[64 * j];
                const float y0 = v[j].x * rstd * gg.x, y1 = v[j].y * rstd * gg.y, y2 = v[j].z * rstd * gg.z, y3 = v[j].w * rstd * gg.w;
                const unsigned long long w = (unsigned long long)pk2(y0, y1) | ((unsigned long long)pk2(y2, y3) << 32);
                int q8 = 0; q8 = __builtin_amdgcn_cvt_pk_fp8_f32(y0, y1, q8, false); q8 = __builtin_amdgcn_cvt_pk_fp8_f32(y2, y3, q8, true);
                o4[64 * j] = (unsigned)q8;
                const int d = 4 * lane + 256 * j, ch = d >> 3;
                *(LAS unsigned long long*)(img + tl * 2048 + 16 * (ch ^ (tl & 15)) + 2 * (d & 7)) = w; }
        }
        __syncthreads();
        {
            const int mb = wave & 1, kq = wave >> 1, trow = 32 * mb + r;
            f32x16 acc;
#pragma unroll
            for (int i = 0; i < 16; ++i) acc[i] = 0.f;
#pragma unroll 4
            for (int s2 = 0; s2 < 16; ++s2) { const int st = 16 * kq + s2;
                const bf16x8 xa = *(const LAS bf16x8*)(img + trow * 2048 + 16 * ((2 * st + hh) ^ (trow & 15)));
                const bf16x8 wh = *(const bf16x8*)(wrt + (size_t)r * 1024 + 16 * st + 8 * hh), wl = *(const bf16x8*)(wrt + 32 * 1024 + (size_t)r * 1024 + 16 * st + 8 * hh);
                acc = MFMA32(xa, wh, acc); acc = MFMA32(xa, wl, acc); }
            __syncthreads();
#pragma unroll
            for (int i = 0; i < 16; ++i) part[(kq * 64 + 32 * mb + crow(i, hh)) * 33 + r] = acc[i];
        }
        __syncthreads();
        for (int i = tid; i < 64 * 32; i += 512) { const int tk = i >> 5, e = i & 31; lg[tk * 33 + e] = ((part[(0 * 64 + tk) * 33 + e] + part[(1 * 64 + tk) * 33 + e]) + (part[(2 * 64 + tk) * 33 + e] + part[(3 * 64 + tk) * 33 + e])) + F.in[I_BR][e]; }
        __syncthreads();
        for (int i = 0; i < 8; ++i) {
            const int tl = wave * 8 + i, e = lane & 31;
            float sc = lg[tl * 33 + e]; int ek[4]; float vk[4];
#pragma unroll
            for (int rd = 0; rd < 4; ++rd) { const float mx = wave_max(sc); const unsigned long long bal = __ballot(sc == mx); const int win = (__ffsll((long long)bal) - 1) & 31;
                ek[rd] = win; vk[rd] = mx; if (e == win) sc = -3.4e38f; }
            const float e1 = __expf(vk[1] - vk[0]), e2 = __expf(vk[2] - vk[0]), e3 = __expf(vk[3] - vk[0]); const float inv = 1.f / (1.f + e1 + e2 + e3);
            if (lane == 0) {
                const float wk[4] = {inv, e1 * inv, e2 * inv, e3 * inv};
#pragma unroll
                for (int rd = 0; rd < 4; ++rd) { se[tl * 4 + rd] = ek[rd]; sw[tl * 4 + rd] = wk[rd]; sp[tl * 4 + rd] = atomicAdd((int*)&lcnt[ek[rd]], 1); }
            }
        }
        __syncthreads();
        if (tid < 32) lbase[tid] = (int)atomicAdd(&gcnt[tid], (unsigned)lcnt[tid]);
        __syncthreads();
        if (tid < 256) { const int t = bt * 64 + (tid >> 2), k = tid & 3; const int e = se[tid];
          tok_e[t * 4 + k] = e; tok_pos[t * 4 + k] = lbase[e] + sp[tid]; tok_w[t * 4 + k] = sw[tid]; }
    }
    __syncthreads();
}
DI int moe_tables(Frame& F, LAS int* pstart, LAS unsigned char* blk_e) {
    unsigned* gcnt = F.ctl + CW_ECNT;
    __syncthreads();
    if (F.tid_id() == 0) { int acc = 0; for (int e = 0; e < NEXP; ++e) { const int cnt = (int)__hip_atomic_load(&gcnt[e], __ATOMIC_RELAXED, __HIP_MEMORY_SCOPE_AGENT); pstart[e] = acc; acc += (cnt + MOEB - 1) / MOEB * MOEB; } pstart[NEXP] = acc; }
    __syncthreads();
    const int nblk = pstart[NEXP] / MOEB;
    for (int rb = F.tid_id(); rb < nblk; rb += 512) { int e = 0; while (e < NEXP - 1 && pstart[e + 1] <= rb * MOEB) ++e; blk_e[rb] = (unsigned char)e; }
    __syncthreads();
    return nblk;
}
DI void p9_scatter(Frame& F) {
    unsigned char* ws = F.ws; const int lane = F.lane_id();
    LAS int* pstart = (LAS int*)(F.lds + 65536); LAS unsigned char* blk_e = (LAS unsigned char*)(F.lds + 65536 + 256);
    moe_tables(F, pstart, blk_e);
    const unsigned char* xn8 = (const unsigned char*)(ws + WS_R1); unsigned char* aperm = (unsigned char*)(ws + WS_APERM);
    const int* tok_e = (const int*)(ws + WS_ROUTE + RT_TOKE); const int* tok_pos = (const int*)(ws + WS_ROUTE + RT_TOKPOS); const float* tok_w = (const float*)(ws + WS_ROUTE + RT_TOKW);
    int* tok_dest = (int*)(ws + WS_ROUTE + RT_TOKDEST); float* roww = (float*)(ws + WS_ROUTE + RT_ROWW);
    unsigned* gcnt = F.ctl + CW_ECNT;
    const int gw = F.bx * NWAVES + F.wave, NGW = F.G * NWAVES;
    for (int t4 = gw; t4 < MT / 4; t4 += NGW) {
        int dest = 0;
        if (lane < 16) { const int it = t4 * 16 + lane; dest = pstart[tok_e[it]] + tok_pos[it]; tok_dest[it] = dest; roww[dest] = tok_w[it]; }
        v4u v0[4];
#pragma unroll
        for (int q = 0; q < 4; ++q) { const v4u* src = (const v4u*)(xn8 + (size_t)(t4 * 4 + q) * DM); v0[q] = src[lane]; }
#pragma unroll
        for (int q = 0; q < 4; ++q)
#pragma unroll
            for (int k = 0; k < 4; ++k) { const int d = __shfl(dest, q * 4 + k); v4u* dst = (v4u*)(aperm + (size_t)d * DM); dst[lane] = v0[q]; }
    }
    for (int it = gw; it < NEXP * MOEB; it += NGW) { const int e = it >> 8, i = it & 255; const int cnt = (int)__hip_atomic_load(&gcnt[e], __ATOMIC_RELAXED, __HIP_MEMORY_SCOPE_AGENT); const int padded = (cnt + MOEB - 1) / MOEB * MOEB;
        if (i < padded - cnt) { const int dest = pstart[e] + cnt + i; v4u* dst = (v4u*)(aperm + (size_t)dest * DM); const v4u z = {0u, 0u, 0u, 0u}; dst[lane] = z; if (lane == 0) roww[dest] = 0.f; } }
}
DI void p12_combine(Frame& F) {
    unsigned char* ws = F.ws; const int lane = F.lane_id();
    const bf16* ybuf = (const bf16*)(ws + WS_APERM); const int* tok_dest = (const int*)(ws + WS_ROUTE + RT_TOKDEST);
    const int gw = F.bx * NWAVES + F.wave, NGW = F.G * NWAVES;
    for (int t2 = gw; t2 < MT / 2; t2 += NGW) {
        typedef int i32x4 __attribute__((ext_vector_type(4)));
        unsigned long long w[2][4][4]; f32x4 a[2][4];
#pragma unroll
        for (int q = 0; q < 2; ++q) { const int t = 2 * t2 + q; const f32x4* orow = (const f32x4*)(F.out + (size_t)t * DM);
            const i32x4 d = *(const i32x4*)(tok_dest + t * 4);
            const unsigned long long* y0 = (const unsigned long long*)(ybuf + (size_t)d.x * DM) + lane; const unsigned long long* y1 = (const unsigned long long*)(ybuf + (size_t)d.y * DM) + lane;
            const unsigned long long* y2 = (const unsigned long long*)(ybuf + (size_t)d.z * DM) + lane; const unsigned long long* y3 = (const unsigned long long*)(ybuf + (size_t)d.w * DM) + lane;
#pragma unroll
            for (int j = 0; j < 4; ++j) { w[q][0][j] = y0[64 * j]; w[q][1][j] = y1[64 * j]; w[q][2][j] = y2[64 * j]; w[q][3][j] = y3[64 * j]; a[q][j] = orow[lane + 64 * j]; } }
#pragma unroll
        for (int q = 0; q < 2; ++q) { f32x4* orow = (f32x4*)(F.out + (size_t)(2 * t2 + q) * DM);
#pragma unroll
            for (int j = 0; j < 4; ++j) {
#pragma unroll
                for (int k = 0; k < 4; ++k) { const unsigned long long ww = w[q][k][j];
                    a[q][j].x += __uint_as_float((unsigned)ww << 16); a[q][j].y += __uint_as_float((unsigned)ww & 0xffff0000u); a[q][j].z += __uint_as_float((unsigned)(ww >> 32) << 16); a[q][j].w += __uint_as_float((unsigned)(ww >> 32) & 0xffff0000u); }
                orow[lane + 64 * j] = a[q][j]; } }
    }
}

constexpr int N_PHASES = 13;
#ifndef MK_PER_PHASE
#define MK_PER_PHASE 0
#endif
__global__ void __launch_bounds__(NWAVES * 64, 2) fwd_kernel(Args args) {
    extern __shared__ __attribute__((aligned(16))) unsigned char lds_raw[];
    Frame F;
    F.lds = (LAS unsigned char*)lds_raw; F.MISC = (volatile LAS unsigned*)(F.lds + MISC_OFF);
    F.wave = __builtin_amdgcn_readfirstlane((int)(threadIdx.x >> 6)); F.G = gridDim.x; F.bx = blockIdx.x;
    F.ws = args.ws; F.ctl = (unsigned*)(args.ws + WS_CTL); F.in = args.in; F.out = args.out;
    unsigned char* ws = args.ws;
    for (int u = threadIdx.x; u < (LDS_BYTES - LDSCTL_OFF) / 4; u += NWAVES * 64) ((LAS unsigned*)(F.lds + LDSCTL_OFF))[u] = 0u;
    __syncthreads();
    const int lo = args.ph_lo, hi = args.ph_hi;
    XcdBarrier bar; bar.wv = F.wave; bar.bar = F.ctl + CW_BAR; bar.x = 0; bar.st = nullptr;
    if (hi - lo > 1) bar = xcd_barrier_post(F.ctl + CW_BAR, F.MISC + 8, F.wave);
#ifndef PH_MASK
#define PH_MASK 0x1fff
#endif
#define IN(k) (((PH_MASK >> (k)) & 1) && lo <= (k) && (k) < hi)
#define SEAM(k) do { if (IN(k) && IN((k) + 1)) xcd_barrier(bar); } while (0)
    typedef pg8::bf16_t b16;
#ifndef RPT_MASK
#define RPT_MASK 0
#endif
#define RPT(k) _Pragma("unroll") for (int rp_ = 0; rp_ < 1 + ((RPT_MASK >> (k)) & 1); ++rp_)
    if (IN(0)) { RPT(0) p0_prologue(F); } SEAM(0);
    if (IN(1)) RPT(1) {
        { pg8::Gemm8 g{(const unsigned char*)(ws + WS_U8), (const unsigned char*)(ws + WS_WIN8), MT, NF8, DM, 0x7f7f7f7f, 0x77777777}; pg8::StaticOrder S; S.init(MT, NF8, F.G, F.bx);
          pg8::EpiBf16Silu E{(b16*)(ws + WS_PROJ) + NB16, NPROJ, nullptr, 0};
          pg8::gemm_phase_f8<pg8::EpiBf16Silu, pg8::StaticOrder, true, true>(F.lds, g, S, E, F.wave); }
        { pg8::Gemm g{(const b16*)(ws + WS_R1), (const b16*)(ws + WS_WIN), MT, NB16, DM}; pg8::StaticOrder S; S.init(MT, NB16, F.G, F.bx);
          pg8::EpiBf16Silu E{(b16*)(ws + WS_PROJ), NPROJ, nullptr, 0};
          pg8::gemm_phase<pg8::EpiBf16Silu, pg8::StaticOrder, true, true>(F.lds, g, S, E, F.wave); }
        { pg8::Gemm g{(const b16*)(ws + WS_MEMN), (const b16*)(ws + WS_WMKV), MROWS, 1024, DM}; pg8::StaticOrder S; S.init(MROWS, 1024, F.G, (F.bx + 64) % F.G);
          pg8::EpiBf16Silu E{(b16*)(ws + WS_MEMKV), 1024, nullptr, 0};
          pg8::gemm_phase<pg8::EpiBf16Silu, pg8::StaticOrder, true, true>(F.lds, g, S, E, F.wave); }
    } SEAM(1);
    if (IN(2)) { RPT(2) { p2_compress(F); p2_prep(F); } }
    if (IN(2) && IN(5)) xcd_barrier(bar);
#ifndef RPT5_ML
#define RPT5_ML 0
#endif
#ifndef MLPROBE
#define MLPROBE 0xff
#endif
#ifndef NPROBE_ST
#define NPROBE_ST true
#endif
#ifndef NPROBE_CMP
#define NPROBE_CMP true
#endif
#ifndef NPROBE_SEL
#define NPROBE_SEL true
#endif
#ifndef NPROBE_WIN
#define NPROBE_WIN true
#endif
#ifndef MPROBE_ST
#define MPROBE_ST true
#endif
#ifndef MPROBE_DMA
#define MPROBE_DMA true
#endif
#ifndef MPROBE_COMP
#define MPROBE_COMP true
#endif
#ifndef RPT5_NSA
#define RPT5_NSA 0
#endif
#ifndef RPT5_MEM
#define RPT5_MEM 0
#endif
    if (IN(5)) { p5_queue<true, true, true>(F, 0);
        if (RPT5_ML || RPT5_NSA || RPT5_MEM) { xcd_barrier(bar); p5_queue<RPT5_ML != 0, RPT5_NSA != 0, RPT5_MEM != 0, MPROBE_ST, MPROBE_DMA, MPROBE_COMP, NPROBE_ST, NPROBE_CMP, NPROBE_SEL, NPROBE_WIN, MLPROBE>(F, 256); } } SEAM(5);
    if (IN(6)) RPT(6) {
        pg8::StaticOrder S; S.init(MT, DM, F.G, F.bx);
        pg8::Gemm g{(const b16*)(ws + WS_H0), (const b16*)(ws + WS_WBR), MT, DM, 1536};
        pg8::EpiMergeK E{(const b16*)(ws + WS_PROJ), (b16*)(ws + WS_R1)};
        pg8::gemm_phase<pg8::EpiMergeK, pg8::StaticOrder, true, true>(F.lds, g, S, E, F.wave);
    } SEAM(6);
    if (IN(7)) RPT(7) {
        pg8::Gemm g{(const b16*)(ws + WS_R1), (const b16*)(ws + WS_WOUT), MT, DM, DM}; pg8::StaticOrder S; S.init(MT, DM, F.G, F.bx);
        pg8::EpiRes E{F.in[I_X], F.out};
        pg8::gemm_phase<pg8::EpiRes, pg8::StaticOrder, true, true>(F.lds, g, S, E, F.wave);
    } SEAM(7);
    if (IN(8)) { p8_router(F, 0); if ((RPT_MASK >> 8) & 1) p8_router(F, 1); } SEAM(8);
    if (IN(9)) { RPT(9) p9_scatter(F); } SEAM(9);
    if (IN(10)) RPT(10) {
        LAS int* pstart = (LAS int*)(F.lds + RING_BYTES + 1024); LAS unsigned char* blk_e = (LAS unsigned char*)(F.lds + RING_BYTES + 1024 + 256);
        const int nblk = moe_tables(F, pstart, blk_e);
        pg8::Gemm8 g{(const unsigned char*)(ws + WS_APERM), (const unsigned char*)(ws + WS_WGU), CAP, NEXP * 2048, DM, 0x7f7f7f7f, 0x77777777};
        pg8::MoeOrder<8> S{nblk, F.G, F.bx, (const PG8_LAS unsigned char*)blk_e};
        pg8::EpiSwiglu E{(unsigned char*)(ws + WS_ACT), F.in[I_BGU]};
        pg8::gemm_phase_f8<pg8::EpiSwiglu, pg8::MoeOrder<8>, true, true>(F.lds, g, S, E, F.wave);
    } SEAM(10);
    if (IN(11)) RPT(11) {
        LAS int* pstart = (LAS int*)(F.lds + RING_BYTES + 1024); LAS unsigned char* blk_e = (LAS unsigned char*)(F.lds + RING_BYTES + 1024 + 256);
        const int nblk = moe_tables(F, pstart, blk_e);
        pg8::Gemm8 g{(const unsigned char*)(ws + WS_ACT), (const unsigned char*)(ws + WS_WDN), CAP, NEXP * DM, DFF, 0x7f7f7f7f, 0x77777777};
        pg8::MoeOrder<4> S{nblk, F.G, F.bx, (const PG8_LAS unsigned char*)blk_e};
        pg8::EpiDown E{(b16*)(ws + WS_APERM), F.in[I_BDN], (const float*)(ws + WS_ROUTE + RT_ROWW)};
        pg8::gemm_phase_f8<pg8::EpiDown, pg8::MoeOrder<4>, true, true>(F.lds, g, S, E, F.wave);
    } SEAM(11);
    if (IN(12)) { p12_combine(F); }
#undef IN
#undef SEAM
}

extern "C" void kernel_launch(void* const* d_in, const int* in_sizes, int n_in, void* d_out, int out_size, void* d_ws, size_t ws_size, hipStream_t stream) {
    static int grid = 0;
    if (grid == 0) {
        if (n_in != N_IN || out_size != MT * DM || ws_size < WS_END) { fprintf(stderr, "kernel_launch: unexpected shapes (n_in %d, out %d, ws %zu need %zu)\n", n_in, out_size, ws_size, (size_t)WS_END); grid = -1; return; }
        int dev = 0, cus = 0, per_cu = 0;
        if (hipGetDevice(&dev) != hipSuccess || hipDeviceGetAttribute(&cus, hipDeviceAttributeMultiprocessorCount, dev) != hipSuccess) { grid = -1; return; }
        if (hipFuncSetAttribute((const void*)fwd_kernel, hipFuncAttributeMaxDynamicSharedMemorySize, LDS_BYTES) != hipSuccess) { fprintf(stderr, "kernel_launch: hipFuncSetAttribute failed\n"); grid = -1; return; }
        if (hipOccupancyMaxActiveBlocksPerMultiprocessor(&per_cu, (const void*)fwd_kernel, NWAVES * 64, LDS_BYTES) != hipSuccess || per_cu < 1) { fprintf(stderr, "kernel_launch: occupancy query says %d\n", per_cu); }
        (void)hipGetLastError();
        grid = cus;
    }
    if (grid < 0) return;
    if (hipMemsetAsync((char*)d_ws + WS_CTL, 0, CTL_ZERO_BYTES, stream) != hipSuccess) return;
    Args a{};
    for (int i = 0; i < N_IN; ++i) a.in[i] = (const float*)d_in[i];
    a.out = (float*)d_out; a.ws = (unsigned char*)d_ws;
#if MK_PER_PHASE
    for (int p = 0; p < N_PHASES; ++p) { a.ph_lo = p; a.ph_hi = p + 1; a.li = 0; hipLaunchKernelGGL(fwd_kernel, dim3(grid), dim3(NWAVES * 64), LDS_BYTES, stream, a); }
#else
    a.ph_lo = 0; a.ph_hi = N_PHASES; a.li = 0;
    hipLaunchKernelGGL(fwd_kernel, dim3(grid), dim3(NWAVES * 64), LDS_BYTES, stream, a);
#endif
}
```

```cpp
#include <hip/hip_runtime.h>
#include <cstdio>
#include <cstdint>
namespace pg8 {
#define PG8_LAS __attribute__((address_space(3)))
typedef unsigned short bf16_t;
typedef short bf16x8 __attribute__((ext_vector_type(8)));
typedef float f32x4 __attribute__((ext_vector_type(4)));
typedef unsigned u32x4 __attribute__((ext_vector_type(4)));
constexpr int BM = 256, BK = 64, HALF = 128, HTB = HALF * BK * 2  , STAGE_BYTES = 8 * HTB, NXCD = 8, WGM = 8;

__host__ __device__ __forceinline__ int lds_byte(int r, int c) { const int st = (r >> 4) * 2 + (c >> 5), rr = r & 15, cc = c & 31, ob = rr * 64 + cc * 2; return st * 1024 + (ob ^ (((ob >> 9) & 1) << 5)); }
__host__ __device__ __forceinline__ void stage_rc(int b, int& R, int& C) { const int st = b / 1024, sb = b % 1024, swz = sb ^ (((sb >> 9) & 1) << 5); R = (st >> 1) * 16 + swz / 64; C = (st & 1) * 32 + (swz % 64) / 2; }
__host__ __device__ __forceinline__ int perm32(int rho) { const int n = rho >> 4, i = rho & 15; return 8 * (i >> 2) + 4 * n + (i & 3); }

struct Unit { int pm, pn; };
struct Gemm { const bf16_t* A; const bf16_t* Bt; int M, N, K; };

struct StaticOrder {
    int nM, nN, nwg, G, c;
    __host__ __device__ void init(int M, int N, int G_, int c_) { nM = M / BM; nN = N / BM; nwg = nM * nN; G = G_; c = c_; }
    __host__ __device__ bool next(int i, Unit& u) const {
        const long L = (long)i * G + c; if (L >= nwg) return false;
        int wgid = (int)L; { const int q = nwg / NXCD, r = nwg % NXCD, xcd = wgid % NXCD, off = wgid / NXCD; wgid = (xcd < r ? xcd * (q + 1) : r * (q + 1) + (xcd - r) * q) + off; }
        const int nig = WGM * nN, gid = wgid / nig, fm = gid * WGM, gsz = (nM - fm) < WGM ? (nM - fm) : WGM;
        u.pm = fm + ((wgid % nig) % gsz); u.pn = (wgid % nig) / gsz; return true;
    }
    __device__ __forceinline__ void a_ready(const Unit&) const {}
    __device__ __forceinline__ void done(const Unit&) const {}
};

__device__ __forceinline__ unsigned cvt_pk_bf16(float lo, float hi) { unsigned r; asm volatile("v_cvt_pk_bf16_f32 %0, %1, %2" : "=v"(r) : "v"(lo), "v"(hi)); return r; }
typedef float f32x2 __attribute__((ext_vector_type(2)));
__device__ __forceinline__ f32x2 gelu_pk(f32x2 v) {
    const f32x2 av = __builtin_elementwise_abs(v), d = av * 0.2316418882f + 1.0f;
    f32x2 t; t.x = __builtin_amdgcn_rcpf(d.x); t.y = __builtin_amdgcn_rcpf(d.y);
    f32x2 q = t * 0.5307027145f + (-0.7265760135f); q = q * t + 0.7107068705f; q = q * t + (-0.142248368f); q = q * t + 0.127414796f; q = q * t;
    const f32x2 s = (v * v) * (-0.72134752044f);
    f32x2 e; e.x = __builtin_amdgcn_exp2f(s.x); e.y = __builtin_amdgcn_exp2f(s.y);
    const f32x2 m = v * (q * e), r = v - m;
    f32x2 o; o.x = v.x < 0.f ? m.x : r.x; o.y = v.y < 0.f ? m.y : r.y; return o;
}

template <int ACT  > struct EpiBf16 {
    static constexpr bool PERM = true, AFTER_DRAIN = false; static_assert(ACT == 0 || ACT == 1, "EpiBf16: ACT is 0 (none) or 1 (gelu_pk)");
    bf16_t* O; int ldc; const float* bias; int split_cols; size_t split_stride; float scale0;
    __device__ __forceinline__ void operator()(const f32x4 (&acc)[2][2][4][2], const Unit& u, int wr, int wc, int fr, int fq) const {
        const int row0 = u.pm * BM + wr * 64 + fr; int colt = u.pn * BM; bf16_t* base = O;
        float sc = 1.f; if (split_cols) { const int t = colt / split_cols; base += (size_t)t * split_stride; colt -= t * split_cols; if (t == 0) sc = scale0; }
        const int col0 = colt + wc * 32 + 8 * fq, bcol0 = u.pn * BM + wc * 32 + 8 * fq;
        f32x4 bv[2][2];
#pragma unroll
        for (int bj = 0; bj < 2; ++bj)
#pragma unroll
            for (int n = 0; n < 2; ++n) bv[bj][n] = bias ? *(const f32x4*)(bias + bcol0 + bj * HALF + 4 * n) : (f32x4){0.f, 0.f, 0.f, 0.f};
#pragma unroll
        for (int ai = 0; ai < 2; ++ai)
#pragma unroll
            for (int m = 0; m < 4; ++m) { bf16_t* rowp = base + (size_t)(row0 + ai * HALF + m * 16) * ldc + col0;
#pragma unroll
                for (int bj = 0; bj < 2; ++bj) { f32x4 v0 = acc[ai][bj][m][0] + bv[bj][0], v1 = acc[ai][bj][m][1] + bv[bj][1];
                    if (ACT == 1) { f32x2 a = gelu_pk((f32x2){v0[0], v0[1]}), b = gelu_pk((f32x2){v0[2], v0[3]}), c = gelu_pk((f32x2){v1[0], v1[1]}), d = gelu_pk((f32x2){v1[2], v1[3]});
                        v0 = (f32x4){a.x, a.y, b.x, b.y}; v1 = (f32x4){c.x, c.y, d.x, d.y}; }
                    v0 = v0 * sc; v1 = v1 * sc; u32x4 w; w.x = cvt_pk_bf16(v0[0], v0[1]); w.y = cvt_pk_bf16(v0[2], v0[3]); w.z = cvt_pk_bf16(v1[0], v1[1]); w.w = cvt_pk_bf16(v1[2], v1[3]);
                    *(u32x4*)(rowp + bj * HALF) = w; } }
    }
};

struct PanelStats {
    unsigned* xbuf;
    unsigned* cnt;
    unsigned* tmo;
    int ntn; float eps;
    unsigned code;
    __device__ __forceinline__ bool run(const f32x4 (&v)[2][2][4][2], const Unit& u, int wr, int wc, int fr, int fq, PG8_LAS unsigned char* lds, int wid, int lane) const {
        typedef float f32x2v __attribute__((ext_vector_type(2)));
        PG8_LAS f32x2v* P = (PG8_LAS f32x2v*)lds;
        PG8_LAS f32x2v* S = (PG8_LAS f32x2v*)(lds + 8192);
        PG8_LAS unsigned* flag = (PG8_LAS unsigned*)(lds + 8192 + 2048);
#pragma unroll
        for (int ai = 0; ai < 2; ++ai)
#pragma unroll
            for (int m = 0; m < 4; ++m) {
                float s = 0.f;
#pragma unroll
                for (int bj = 0; bj < 2; ++bj)
#pragma unroll
                    for (int n = 0; n < 2; ++n) { const f32x4 x = v[ai][bj][m][n]; s += (x[0] + x[1]) + (x[2] + x[3]); }
                s += __shfl_xor(s, 16); s += __shfl_xor(s, 32);
                const float mw = s * (1.0f / 64.0f); float q = 0.f;
#pragma unroll
                for (int bj = 0; bj < 2; ++bj)
#pragma unroll
                    for (int n = 0; n < 2; ++n) { const f32x4 d = v[ai][bj][m][n] - mw; q += (d[0] * d[0] + d[1] * d[1]) + (d[2] * d[2] + d[3] * d[3]); }
                q += __shfl_xor(q, 16); q += __shfl_xor(q, 32);
                if (fq == 0) P[(ai * HALF + wr * 64 + m * 16 + fr) * 4 + wc] = (f32x2v){mw, q};
            }
        asm volatile("s_waitcnt lgkmcnt(0)" ::: "memory"); __builtin_amdgcn_s_barrier(); asm volatile("" ::: "memory");
#if defined(BROKEN_EXCHANGE_NO_WAIT)
#warning BROKEN CONTROL BUILD: the row-statistics exchange does not wait; results are wrong by design
        if (blockIdx.x >= 64) { const long long t0_ = clock64(); while (clock64() - t0_ < 60000) __builtin_amdgcn_s_sleep(8); }
#endif
        const int row = wid * 32 + (lane & 31);
        if (lane < 32) {
            const f32x2v a = P[row * 4 + 0], b = P[row * 4 + 1], c = P[row * 4 + 2], d = P[row * 4 + 3];
            const float mt = (a.x + b.x + c.x + d.x) * 0.25f;
            const float da = a.x - mt, db = b.x - mt, dc = c.x - mt, dd = d.x - mt;
            const float m2 = (a.y + b.y) + (c.y + d.y) + 64.0f * ((da * da + db * db) + (dc * dc + dd * dd));
            unsigned long long* slot = (unsigned long long*)xbuf + ((size_t)(u.pm * BM + row) * 4 + u.pn);
            __hip_atomic_store(slot, ((unsigned long long)__float_as_uint(m2) << 32) | __float_as_uint(mt), __ATOMIC_RELAXED, __HIP_MEMORY_SCOPE_AGENT);
        }
        asm volatile("s_waitcnt vmcnt(0)" ::: "memory");
        if (lane == 0) __hip_atomic_fetch_add(cnt + 64 * u.pm, 1u, __ATOMIC_RELAXED, __HIP_MEMORY_SCOPE_AGENT);
        if (wid == 0) {
            bool dead = false; const unsigned long long t0 = __builtin_amdgcn_s_memrealtime(); const unsigned want = 8u * (unsigned)ntn;
            for (;;) {
#if defined(BROKEN_EXCHANGE_NO_WAIT)
                break;
#endif
                if ((unsigned)__builtin_amdgcn_readfirstlane(__hip_atomic_load(cnt + 64 * u.pm, __ATOMIC_RELAXED, __HIP_MEMORY_SCOPE_AGENT)) >= want) break;
                if (__builtin_amdgcn_s_memrealtime() - t0 > 2000000ull) {
                    if (lane == 0) { unsigned expect = 0u; __hip_atomic_compare_exchange_strong(tmo + 1, &expect, code | (unsigned)(u.pm & 0xff), __ATOMIC_RELAXED, __ATOMIC_RELAXED, __HIP_MEMORY_SCOPE_AGENT);
                                     __hip_atomic_store(tmo, 1u, __ATOMIC_RELAXED, __HIP_MEMORY_SCOPE_AGENT); }
                    dead = true; break; }
                __builtin_amdgcn_s_sleep(2);
            }
            __builtin_amdgcn_fence(__ATOMIC_ACQUIRE, "agent");
            if (lane == 0) flag[0] = dead ? 1u : 0u;
        }
        asm volatile("s_waitcnt vmcnt(0) lgkmcnt(0)" ::: "memory"); __builtin_amdgcn_s_barrier(); asm volatile("" ::: "memory");
        const bool bad = flag[0] != 0u;
        if (lane < 32) {
            const unsigned long long* slot = (const unsigned long long*)xbuf + (size_t)(u.pm * BM + row) * 4; float mt[4], m2[4]; float ms = 0.f;
#pragma unroll
            for (int t = 0; t < 4; ++t) { if (t < ntn) { const unsigned long long w = __hip_atomic_load(slot + t, __ATOMIC_RELAXED, __HIP_MEMORY_SCOPE_AGENT); mt[t] = __uint_as_float((unsigned)w); m2[t] = __uint_as_float((unsigned)(w >> 32)); } else { mt[t] = 0.f; m2[t] = 0.f; } ms += mt[t]; }
            const float mean = ms / (float)ntn; float q = 0.f;
#pragma unroll
            for (int t = 0; t < 4; ++t) if (t < ntn) { const float dm = mt[t] - mean; q += m2[t] + 256.0f * dm * dm; }
            S[row] = (f32x2v){mean, 1.0f / sqrtf(q / (256.0f * (float)ntn) + eps)};
        }
        asm volatile("s_waitcnt lgkmcnt(0)" ::: "memory"); __builtin_amdgcn_s_barrier(); asm volatile("" ::: "memory");
        return bad;
    }
};
struct EpiLnRes {
    static constexpr bool PERM = false, AFTER_DRAIN = true;
    const float* base; float* out; int ldc; const float* bias; PanelStats st; unsigned poison;
    __device__ __forceinline__ void fused(f32x4 (&acc)[2][2][4][2], const Unit& u, int wr, int wc, int fr, int fq, PG8_LAS unsigned char* lds, int wid, int lane) const {
        typedef float f32x2v __attribute__((ext_vector_type(2)));
        const PG8_LAS f32x2v* S = (const PG8_LAS f32x2v*)(lds + 8192);
        const int col0 = u.pn * BM + wc * 32 + 4 * fq;
#pragma unroll
        for (int bj = 0; bj < 2; ++bj)
#pragma unroll
            for (int n = 0; n < 2; ++n) { const f32x4 bv = bias ? *(const f32x4*)(bias + col0 + bj * HALF + n * 16) : (f32x4){0.f, 0.f, 0.f, 0.f};
#pragma unroll
                for (int ai = 0; ai < 2; ++ai)
#pragma unroll
                    for (int m = 0; m < 4; ++m) acc[ai][bj][m][n] += bv; }
        f32x4 pre[4][2][2];
#pragma unroll
        for (int m = 0; m < 4; ++m) { const size_t off = (size_t)(u.pm * BM + wr * 64 + m * 16 + fr) * ldc + col0;
#pragma unroll
            for (int bj = 0; bj < 2; ++bj)
#pragma unroll
                for (int n = 0; n < 2; ++n) pre[m][bj][n] = *(const f32x4*)(base + off + bj * HALF + n * 16); }
        const bool bad = st.run(acc, u, wr, wc, fr, fq, lds, wid, lane) || poison != 0u;
        const float qnan = __builtin_nanf("");
#pragma unroll
        for (int ai = 0; ai < 2; ++ai)
#pragma unroll
            for (int m = 0; m < 4; ++m) { const int r = ai * HALF + wr * 64 + m * 16 + fr; const f32x2v sr = S[r]; const size_t off = (size_t)(u.pm * BM + r) * ldc + col0;
#pragma unroll
                for (int bj = 0; bj < 2; ++bj)
#pragma unroll
                    for (int n = 0; n < 2; ++n) { const f32x4 bs = ai == 0 ? pre[m][bj][n] : *(const f32x4*)(base + off + bj * HALF + n * 16); f32x4 o = bs + (acc[ai][bj][m][n] - sr.x) * sr.y;
                        if (bad) o = (f32x4){qnan, qnan, qnan, qnan}; *(f32x4*)(out + off + bj * HALF + n * 16) = o; }
                if (m & 1) asm volatile("" ::: "memory"); }
    }
};
struct EpiLnResLn {
    static constexpr bool PERM = false, AFTER_DRAIN = true;
    const float* base; float* out; bf16_t* xn; int ldc; const float* bias; PanelStats st1, st2; unsigned poison;
    __device__ __forceinline__ void fused(f32x4 (&acc)[2][2][4][2], const Unit& u, int wr, int wc, int fr, int fq, PG8_LAS unsigned char* lds, int wid, int lane) const {
        typedef float f32x2v __attribute__((ext_vector_type(2))); typedef unsigned u32x2v __attribute__((ext_vector_type(2)));
        const PG8_LAS f32x2v* S = (const PG8_LAS f32x2v*)(lds + 8192);
        const int col0 = u.pn * BM + wc * 32 + 4 * fq;
#pragma unroll
        for (int bj = 0; bj < 2; ++bj)
#pragma unroll
            for (int n = 0; n < 2; ++n) { const f32x4 bv = bias ? *(const f32x4*)(bias + col0 + bj * HALF + n * 16) : (f32x4){0.f, 0.f, 0.f, 0.f};
#pragma unroll
                for (int ai = 0; ai < 2; ++ai)
#pragma unroll
                    for (int m = 0; m < 4; ++m) acc[ai][bj][m][n] += bv; }
        bool bad = st1.run(acc, u, wr, wc, fr, fq, lds, wid, lane) || poison != 0u;
        const float qnan = __builtin_nanf("");
#pragma unroll
        for (int ai = 0; ai < 2; ++ai)
#pragma unroll
            for (int m = 0; m < 4; ++m) { const int r = ai * HALF + wr * 64 + m * 16 + fr; const f32x2v sr = S[r]; const size_t off = (size_t)(u.pm * BM + r) * ldc + col0;
#pragma unroll
                for (int bj = 0; bj < 2; ++bj)
#pragma unroll
                    for (int n = 0; n < 2; ++n) { const f32x4 bs = *(const f32x4*)(base + off + bj * HALF + n * 16); acc[ai][bj][m][n] = bs + (acc[ai][bj][m][n] - sr.x) * sr.y; }
                asm volatile("" : "+v"(acc[ai][0][m][0]), "+v"(acc[ai][0][m][1]), "+v"(acc[ai][1][m][0]), "+v"(acc[ai][1][m][1]));
                if (m & 1) asm volatile("" ::: "memory"); }
        const bool bad1 = bad;
        bad = st2.run(acc, u, wr, wc, fr, fq, lds, wid, lane) || bad;
#pragma unroll
        for (int ai = 0; ai < 2; ++ai)
#pragma unroll
            for (int m = 0; m < 4; ++m) { const int r = ai * HALF + wr * 64 + m * 16 + fr; const f32x2v sr = S[r]; const size_t off = (size_t)(u.pm * BM + r) * ldc + col0;
#pragma unroll
                for (int bj = 0; bj < 2; ++bj)
#pragma unroll
                    for (int n = 0; n < 2; ++n) { const f32x4 x1 = acc[ai][bj][m][n]; *(f32x4*)(out + off + bj * HALF + n * 16) = bad1 ? (f32x4){qnan, qnan, qnan, qnan} : x1;
                        const f32x4 o = (x1 - sr.x) * sr.y; u32x2v w; w.x = cvt_pk_bf16(o[0], o[1]); w.y = cvt_pk_bf16(o[2], o[3]);
                        if (bad) { w.x = 0x7fc07fc0u; w.y = 0x7fc07fc0u; } *(u32x2v*)(xn + off + bj * HALF + n * 16) = w; }
                asm volatile("" ::: "memory"); }
    }
};

template <class E, class = void> struct MidSeg { static constexpr int v = 0; };
template <class E> struct MidSeg<E, decltype((void)E::MIDSEG)> { static constexpr int v = E::MIDSEG; };
template <class Epi, class Sched, bool ALIGN_EPI = false, bool SP2 = false>
__device__ __forceinline__ void gemm_phase(PG8_LAS unsigned char* lds, const Gemm g, const Sched& S, const Epi& E, int wid_in) {
    int lane_; asm volatile("v_mbcnt_lo_u32_b32 %0, -1, 0\n\tv_mbcnt_hi_u32_b32 %0, -1, %0" : "=v"(lane_));
    const int wid = wid_in, lane = lane_, tid = wid * 64 + lane, wr = wid >> 2, wc = wid & 3, fr = lane & 15, fq = lane >> 4;
    const int K = g.K, nt = K / BK;
    unsigned voffA[2], voffB[2];
#pragma unroll
    for (int i = 0; i < 2; ++i) { int R, C; stage_rc(tid * 16 + i * 8192, R, C); const int Rb = Epi::PERM ? ((R & ~31) + perm32(R & 31)) : R;
        voffA[i] = (unsigned)(R * K + C) * 2u; voffB[i] = (unsigned)(Rb * K + C) * 2u; }
    const size_t kstep = (size_t)(BK * 2);
    const size_t hstep = (size_t)HALF * K * 2;
    const size_t tstep = 2 * hstep;
    const unsigned ldsw = (unsigned)wid * 1024u;
    const int aoff = lds_byte(wr * 64 + fr, fq * 8), boff = lds_byte(wc * 32 + fr, fq * 8);
#define PG8_SA(b, h) (((b) * 2 + (h)) * HTB)
#define PG8_SB(b, h) ((4 + (b) * 2 + (h)) * HTB)
#define PG8_STAGE(bufoff, gbase, voff) do { _Pragma("unroll") for (int _i = 0; _i < 2; ++_i) \
        __builtin_amdgcn_global_load_lds((const unsigned*)((const char*)(gbase) + (voff)[_i]), (PG8_LAS unsigned*)(lds + (bufoff) + ldsw + _i * 8192), 16, 0, 0); } while (0)
#define PG8_LDA(dst, b, h) do { _Pragma("unroll") for (int m = 0; m < 4; ++m) _Pragma("unroll") for (int k = 0; k < 2; ++k) dst[m][k] = *(const PG8_LAS bf16x8*)(lds + PG8_SA(b, h) + aoff + m * 2048 + k * 1024); } while (0)
#define PG8_LDB(dst, b, h) do { _Pragma("unroll") for (int n = 0; n < 2; ++n) _Pragma("unroll") for (int k = 0; k < 2; ++k) dst[n][k] = *(const PG8_LAS bf16x8*)(lds + PG8_SB(b, h) + boff + n * 2048 + k * 1024); } while (0)
#define PG8_MMA(ai, bj, At, Bt) do { __builtin_amdgcn_s_setprio(1); _Pragma("unroll") for (int m = 0; m < 4; ++m) _Pragma("unroll") for (int n = 0; n < 2; ++n) _Pragma("unroll") for (int k = 0; k < 2; ++k) \
        acc[ai][bj][m][n] = __builtin_amdgcn_mfma_f32_16x16x32_bf16(Bt[n][k], At[m][k], acc[ai][bj][m][n], 0, 0, 0); __builtin_amdgcn_s_setprio(0); } while (0)
#define PG8_WAIT_V(n) asm volatile("s_waitcnt vmcnt(" #n ")" ::: "memory")
#define PG8_WAIT_L(n) asm volatile("s_waitcnt lgkmcnt(" #n ")" ::: "memory")
#define PG8_BAR __builtin_amdgcn_s_barrier()
#define PG8_SCHED __builtin_amdgcn_sched_barrier(0)
    Unit cur, nxt; int ui = 0;
    if (!S.next(0, cur)) return;
    f32x4 acc[2][2][4][2];
#pragma unroll
    for (int a = 0; a < 2; ++a)
#pragma unroll
        for (int b = 0; b < 2; ++b)
#pragma unroll
            for (int m = 0; m < 4; ++m)
#pragma unroll
                for (int n = 0; n < 2; ++n) acc[a][b][m][n] = (f32x4){0.f, 0.f, 0.f, 0.f};
    bf16x8 At[4][2], B0[2][2], B1[2][2];
    const char* cA = (const char*)g.A + (size_t)cur.pm * tstep; const char* cB = (const char*)g.Bt + (size_t)cur.pn * tstep;
    S.a_ready(cur);
    if constexpr (SP2) {
        PG8_STAGE(PG8_SB(0, 0), cB, voffB); PG8_STAGE(PG8_SB(0, 1), cB + hstep, voffB); PG8_STAGE(PG8_SA(0, 0), cA, voffA); PG8_STAGE(PG8_SA(0, 1), cA + hstep, voffA);
        if (wr == 1) PG8_BAR;
        PG8_WAIT_V(2); PG8_BAR;
        PG8_STAGE(PG8_SB(1, 0), cB + kstep, voffB); PG8_STAGE(PG8_SA(1, 0), cA + kstep, voffA); PG8_STAGE(PG8_SB(1, 1), cB + hstep + kstep, voffB);
        PG8_WAIT_V(6); PG8_BAR;
    } else {
        PG8_STAGE(PG8_SB(0, 0), cB, voffB); PG8_STAGE(PG8_SA(0, 0), cA, voffA); PG8_STAGE(PG8_SB(0, 1), cB + hstep, voffB); PG8_STAGE(PG8_SA(0, 1), cA + hstep, voffA);
        if (wr == 1) PG8_BAR;
        PG8_WAIT_V(4); PG8_BAR;
        PG8_STAGE(PG8_SB(1, 0), cB + kstep, voffB); PG8_STAGE(PG8_SA(1, 0), cA + kstep, voffA); PG8_STAGE(PG8_SB(1, 1), cB + hstep + kstep, voffB);
        PG8_WAIT_V(6); PG8_BAR;
    }
    for (;;) {
        const bool has_next = S.next(ui + 1, nxt);
        const char* nA = has_next ? (const char*)g.A + (size_t)nxt.pm * tstep : cA; const char* nB = has_next ? (const char*)g.Bt + (size_t)nxt.pn * tstep : cB;
        for (int t = 0; t < nt; t += 2) {
            if constexpr (MidSeg<Epi>::v > 0) { if (t > 0 && t % MidSeg<Epi>::v == 0) E.mid(acc, cur, t / MidSeg<Epi>::v, wr, wc, fr, fq); }
            const bool last = (t == nt - 2);
            const char* a1 = cA + (size_t)(t + 1) * kstep;
            const char* a2 = last ? nA : cA + (size_t)(t + 2) * kstep; const char* b2 = last ? nB : cB + (size_t)(t + 2) * kstep;
            const char* a3 = a2 + kstep; const char* b3 = b2 + kstep;
            if (last && has_next) S.a_ready(nxt);
            if constexpr (SP2) {
            PG8_LDB(B0, 0, 0); PG8_LDB(B1, 0, 1); PG8_SCHED; PG8_LDA(At, 0, 0); PG8_STAGE(PG8_SA(1, 1), a1 + hstep, voffA);
            PG8_WAIT_V(8); PG8_WAIT_L(0); PG8_BAR; PG8_MMA(0, 0, At, B0); PG8_MMA(0, 1, At, B1); PG8_BAR; PG8_SCHED;
            PG8_LDA(At, 0, 1); PG8_STAGE(PG8_SB(0, 0), b2, voffB); PG8_STAGE(PG8_SB(0, 1), b2 + hstep, voffB); PG8_STAGE(PG8_SA(0, 0), a2, voffA);
            PG8_WAIT_V(8); PG8_WAIT_L(0); PG8_BAR; PG8_MMA(1, 0, At, B0); PG8_MMA(1, 1, At, B1); PG8_BAR; PG8_SCHED;
            PG8_LDB(B0, 1, 0); PG8_LDB(B1, 1, 1); PG8_SCHED; PG8_LDA(At, 1, 0); PG8_STAGE(PG8_SA(0, 1), a2 + hstep, voffA);
            PG8_WAIT_V(8); PG8_WAIT_L(0); PG8_BAR; PG8_MMA(0, 0, At, B0); PG8_MMA(0, 1, At, B1); PG8_BAR; PG8_SCHED;
            PG8_LDA(At, 1, 1); PG8_STAGE(PG8_SB(1, 0), b3, voffB); PG8_STAGE(PG8_SB(1, 1), b3 + hstep, voffB); PG8_STAGE(PG8_SA(1, 0), a3, voffA);
            PG8_WAIT_V(8); PG8_WAIT_L(0); PG8_BAR; PG8_MMA(1, 0, At, B0); PG8_MMA(1, 1, At, B1); PG8_BAR; PG8_SCHED;
            } else {
            PG8_LDB(B0, 0, 0); PG8_SCHED; PG8_LDA(At, 0, 0); PG8_STAGE(PG8_SA(1, 1), a1 + hstep, voffA);
            PG8_WAIT_L(8); PG8_BAR; PG8_WAIT_L(0); PG8_MMA(0, 0, At, B0); PG8_BAR; PG8_SCHED;
            PG8_LDB(B1, 0, 1); PG8_STAGE(PG8_SB(0, 0), b2, voffB);
            PG8_BAR; PG8_WAIT_L(0); PG8_MMA(0, 1, At, B1); PG8_BAR;
            PG8_LDA(At, 0, 1); PG8_STAGE(PG8_SA(0, 0), a2, voffA);
            PG8_BAR; PG8_WAIT_L(0); PG8_MMA(1, 0, At, B0); PG8_BAR; PG8_SCHED;
            PG8_STAGE(PG8_SB(0, 1), b2 + hstep, voffB);
            PG8_WAIT_V(6); PG8_BAR; PG8_MMA(1, 1, At, B1); PG8_BAR;
            PG8_LDB(B0, 1, 0); PG8_SCHED; PG8_LDA(At, 1, 0); PG8_STAGE(PG8_SA(0, 1), a2 + hstep, voffA);
            PG8_WAIT_L(8); PG8_BAR; PG8_WAIT_L(0); PG8_MMA(0, 0, At, B0); PG8_BAR; PG8_SCHED;
            PG8_LDB(B1, 1, 1); PG8_STAGE(PG8_SB(1, 0), b3, voffB);
            PG8_BAR; PG8_WAIT_L(0); PG8_MMA(0, 1, At, B1); PG8_BAR;
            PG8_LDA(At, 1, 1); PG8_STAGE(PG8_SA(1, 0), a3, voffA);
            PG8_BAR; PG8_WAIT_L(0); PG8_MMA(1, 0, At, B0); PG8_BAR; PG8_SCHED;
            PG8_STAGE(PG8_SB(1, 1), b3 + hstep, voffB);
            PG8_WAIT_V(6); PG8_BAR; PG8_MMA(1, 1, At, B1); PG8_BAR;
            }
        }
        if constexpr (ALIGN_EPI) { if (wr == 0) PG8_BAR; }
        if constexpr (!Epi::AFTER_DRAIN) { E(acc, cur, wr, wc, fr, fq); S.done(cur); }
        if (!has_next) break;
#pragma unroll
        for (int a = 0; a < 2; ++a)
#pragma unroll
            for (int b = 0; b < 2; ++b)
#pragma unroll
                for (int m = 0; m < 4; ++m)
#pragma unroll
                    for (int n = 0; n < 2; ++n) acc[a][b][m][n] = (f32x4){0.f, 0.f, 0.f, 0.f};
        cur = nxt; cA = nA; cB = nB; ++ui;
        if constexpr (ALIGN_EPI) { if (wr == 1) PG8_BAR; }
    }
    PG8_WAIT_V(0);
    if constexpr (!ALIGN_EPI) { if (wr == 0) PG8_BAR; }
    PG8_BAR;
    if constexpr (Epi::AFTER_DRAIN) { E.fused(acc, cur, wr, wc, fr, fq, lds, wid, lane); S.done(cur); }
#undef PG8_SA
#undef PG8_SB
#undef PG8_STAGE
#undef PG8_LDA
#undef PG8_LDB
#undef PG8_MMA
#undef PG8_WAIT_V
#undef PG8_WAIT_L
#undef PG8_BAR
#undef PG8_SCHED
}
}
namespace pg8 {
struct Gemm8 { const unsigned char* A; const unsigned char* Bt; int M, N, K; int scale_a, scale_b; };
template <class Epi, class Sched, bool ALIGN_EPI = false, bool SP2 = false>
__device__ __forceinline__ void gemm_phase_f8(PG8_LAS unsigned char* lds, const Gemm8 g, const Sched& S, const Epi& E, int wid_in) {
    int lane_; asm volatile("v_mbcnt_lo_u32_b32 %0, -1, 0\n\tv_mbcnt_hi_u32_b32 %0, -1, %0" : "=v"(lane_));
    const int wid = wid_in, lane = lane_, tid = wid * 64 + lane, wr = wid >> 2, wc = wid & 3, fr = lane & 15, fq = lane >> 4;
    const int K = g.K, nt = K / 128;
    unsigned voffA[2], voffB[2];
#pragma unroll
    for (int i = 0; i < 2; ++i) { int R, C; stage_rc(tid * 16 + i * 8192, R, C); const int Rb = Epi::PERM ? ((R & ~31) + perm32(R & 31)) : R;
        voffA[i] = (unsigned)(R * K + 2 * C); voffB[i] = (unsigned)(Rb * K + 2 * C); }
    const size_t kstep = (size_t)(BK * 2);
    const size_t hstep = (size_t)HALF * K;
    const size_t tstep = 2 * hstep;
    const unsigned ldsw = (unsigned)wid * 1024u;
    const int aoff = lds_byte(wr * 64 + fr, fq * 16), boff = lds_byte(wc * 32 + fr, fq * 16);
#define PG8_SA(b, h) (((b) * 2 + (h)) * HTB)
#define PG8_SB(b, h) ((4 + (b) * 2 + (h)) * HTB)
#define PG8_STAGE(bufoff, gbase, voff) do { _Pragma("unroll") for (int _i = 0; _i < 2; ++_i) { unsigned keep_; \
        asm volatile("s_mov_b32 %0, m0\n\ts_mov_b32 m0, %3\n\ts_nop 0\n\tglobal_load_lds_dwordx4 %1, %2\n\ts_mov_b32 m0, %0" : "=&s"(keep_) : "v"((voff)[_i]), "s"((const char*)(gbase)), "s"((unsigned)(size_t)(lds + (bufoff) + ldsw + _i * 8192)) : "memory"); } } while (0)
#define PG8_LDA(dst, b, h) do { _Pragma("unroll") for (int m = 0; m < 4; ++m) { const u32x4 lo_ = *(const PG8_LAS u32x4*)(lds + PG8_SA(b, h) + aoff + m * 2048), hi_ = *(const PG8_LAS u32x4*)(lds + PG8_SA(b, h) + aoff + m * 2048 + 16); dst[m] = __builtin_bit_cast(i32x8, __builtin_shufflevector(lo_, hi_, 0, 1, 2, 3, 4, 5, 6, 7)); } } while (0)
#define PG8_LDB(dst, b, h) do { _Pragma("unroll") for (int n = 0; n < 2; ++n) { const u32x4 lo_ = *(const PG8_LAS u32x4*)(lds + PG8_SB(b, h) + boff + n * 2048), hi_ = *(const PG8_LAS u32x4*)(lds + PG8_SB(b, h) + boff + n * 2048 + 16); dst[n] = __builtin_bit_cast(i32x8, __builtin_shufflevector(lo_, hi_, 0, 1, 2, 3, 4, 5, 6, 7)); } } while (0)
#define PG8_MMA(ai, bj, At, Bt) do { __builtin_amdgcn_s_setprio(1); _Pragma("unroll") for (int m = 0; m < 4; ++m) _Pragma("unroll") for (int n = 0; n < 2; ++n) \
        acc[ai][bj][m][n] = __builtin_amdgcn_mfma_scale_f32_16x16x128_f8f6f4(Bt[n], At[m], acc[ai][bj][m][n], 0, 0, 0, g.scale_b, 0, g.scale_a); __builtin_amdgcn_s_setprio(0); } while (0)
#define PG8_WAIT_V(n) asm volatile("s_waitcnt vmcnt(" #n ")" ::: "memory")
#define PG8_WAIT_L(n) asm volatile("s_waitcnt lgkmcnt(" #n ")" ::: "memory")
#define PG8_BAR __builtin_amdgcn_s_barrier()
#define PG8_SCHED __builtin_amdgcn_sched_barrier(0)
    Unit cur, nxt; int ui = 0;
    if (!S.next(0, cur)) return;
    f32x4 acc[2][2][4][2];
#pragma unroll
    for (int a = 0; a < 2; ++a)
#pragma unroll
        for (int b = 0; b < 2; ++b)
#pragma unroll
            for (int m = 0; m < 4; ++m)
#pragma unroll
                for (int n = 0; n < 2; ++n) acc[a][b][m][n] = (f32x4){0.f, 0.f, 0.f, 0.f};
    typedef int i32x8 __attribute__((ext_vector_type(8))); i32x8 At[4], B0[2], B1[2];
    const char* cA = (const char*)g.A + (size_t)cur.pm * tstep; const char* cB = (const char*)g.Bt + (size_t)cur.pn * tstep;
    S.a_ready(cur);
    if constexpr (SP2) {
        PG8_STAGE(PG8_SB(0, 0), cB, voffB); PG8_STAGE(PG8_SB(0, 1), cB + hstep, voffB); PG8_STAGE(PG8_SA(0, 0), cA, voffA); PG8_STAGE(PG8_SA(0, 1), cA + hstep, voffA);
        if (wr == 1) PG8_BAR;
        PG8_WAIT_V(2); PG8_BAR;
        PG8_STAGE(PG8_SB(1, 0), cB + kstep, voffB); PG8_STAGE(PG8_SA(1, 0), cA + kstep, voffA); PG8_STAGE(PG8_SB(1, 1), cB + hstep + kstep, voffB);
        PG8_WAIT_V(6); PG8_BAR;
    } else {
        PG8_STAGE(PG8_SB(0, 0), cB, voffB); PG8_STAGE(PG8_SA(0, 0), cA, voffA); PG8_STAGE(PG8_SB(0, 1), cB + hstep, voffB); PG8_STAGE(PG8_SA(0, 1), cA + hstep, voffA);
        if (wr == 1) PG8_BAR;
        PG8_WAIT_V(4); PG8_BAR;
        PG8_STAGE(PG8_SB(1, 0), cB + kstep, voffB); PG8_STAGE(PG8_SA(1, 0), cA + kstep, voffA); PG8_STAGE(PG8_SB(1, 1), cB + hstep + kstep, voffB);
        PG8_WAIT_V(6); PG8_BAR;
    }
    for (;;) {
        const bool has_next = S.next(ui + 1, nxt);
        const char* nA = has_next ? (const char*)g.A + (size_t)nxt.pm * tstep : cA; const char* nB = has_next ? (const char*)g.Bt + (size_t)nxt.pn * tstep : cB;
#pragma unroll 1
        for (int t = 0; t < nt; t += 2) {
            const bool last = (t == nt - 2);
            const char* a1 = cA + (size_t)(t + 1) * kstep;
            const char* a2 = last ? nA : cA + (size_t)(t + 2) * kstep; const char* b2 = last ? nB : cB + (size_t)(t + 2) * kstep;
            const char* a3 = a2 + kstep; const char* b3 = b2 + kstep;
            if (last && has_next) S.a_ready(nxt);
            if constexpr (SP2) {
            PG8_LDB(B0, 0, 0); PG8_LDB(B1, 0, 1); PG8_SCHED; PG8_LDA(At, 0, 0); PG8_STAGE(PG8_SA(1, 1), a1 + hstep, voffA);
            PG8_WAIT_V(8); PG8_WAIT_L(0); PG8_BAR; PG8_MMA(0, 0, At, B0); PG8_MMA(0, 1, At, B1); PG8_BAR; PG8_SCHED;
            PG8_LDA(At, 0, 1); PG8_STAGE(PG8_SB(0, 0), b2, voffB); PG8_STAGE(PG8_SB(0, 1), b2 + hstep, voffB); PG8_STAGE(PG8_SA(0, 0), a2, voffA);
            PG8_WAIT_V(8); PG8_WAIT_L(0); PG8_BAR; PG8_MMA(1, 0, At, B0); PG8_MMA(1, 1, At, B1); PG8_BAR; PG8_SCHED;
            PG8_LDB(B0, 1, 0); PG8_LDB(B1, 1, 1); PG8_SCHED; PG8_LDA(At, 1, 0); PG8_STAGE(PG8_SA(0, 1), a2 + hstep, voffA);
            PG8_WAIT_V(8); PG8_WAIT_L(0); PG8_BAR; PG8_MMA(0, 0, At, B0); PG8_MMA(0, 1, At, B1); PG8_BAR; PG8_SCHED;
            PG8_LDA(At, 1, 1); PG8_STAGE(PG8_SB(1, 0), b3, voffB); PG8_STAGE(PG8_SB(1, 1), b3 + hstep, voffB); PG8_STAGE(PG8_SA(1, 0), a3, voffA);
            PG8_WAIT_V(8); PG8_WAIT_L(0); PG8_BAR; PG8_MMA(1, 0, At, B0); PG8_MMA(1, 1, At, B1); PG8_BAR; PG8_SCHED;
            } else {
            PG8_LDB(B0, 0, 0); PG8_SCHED; PG8_LDA(At, 0, 0); PG8_STAGE(PG8_SA(1, 1), a1 + hstep, voffA);
            PG8_WAIT_L(8); PG8_BAR; PG8_WAIT_L(0); PG8_MMA(0, 0, At, B0); PG8_BAR; PG8_SCHED;
            PG8_LDB(B1, 0, 1); PG8_STAGE(PG8_SB(0, 0), b2, voffB);
            PG8_BAR; PG8_WAIT_L(0); PG8_MMA(0, 1, At, B1); PG8_BAR;
            PG8_LDA(At, 0, 1); PG8_STAGE(PG8_SA(0, 0), a2, voffA);
            PG8_BAR; PG8_WAIT_L(0); PG8_MMA(1, 0, At, B0); PG8_BAR; PG8_SCHED;
            PG8_STAGE(PG8_SB(0, 1), b2 + hstep, voffB);
            PG8_WAIT_V(6); PG8_BAR; PG8_MMA(1, 1, At, B1); PG8_BAR;
            PG8_LDB(B0, 1, 0); PG8_SCHED; PG8_LDA(At, 1, 0); PG8_STAGE(PG8_SA(0, 1), a2 + hstep, voffA);
            PG8_WAIT_L(8); PG8_BAR; PG8_WAIT_L(0); PG8_MMA(0, 0, At, B0); PG8_BAR; PG8_SCHED;
            PG8_LDB(B1, 1, 1); PG8_STAGE(PG8_SB(1, 0), b3, voffB);
            PG8_BAR; PG8_WAIT_L(0); PG8_MMA(0, 1, At, B1); PG8_BAR;
            PG8_LDA(At, 1, 1); PG8_STAGE(PG8_SA(1, 0), a3, voffA);
            PG8_BAR; PG8_WAIT_L(0); PG8_MMA(1, 0, At, B0); PG8_BAR; PG8_SCHED;
            PG8_STAGE(PG8_SB(1, 1), b3 + hstep, voffB);
            PG8_WAIT_V(6); PG8_BAR; PG8_MMA(1, 1, At, B1); PG8_BAR;
            }
        }
        if constexpr (ALIGN_EPI) { if (wr == 0) PG8_BAR; }
        if constexpr (!Epi::AFTER_DRAIN) { int l2_; asm volatile("v_mbcnt_lo_u32_b32 %0, -1, 0\n\tv_mbcnt_hi_u32_b32 %0, -1, %0" : "=v"(l2_));
            E(acc, cur, wr, wc, l2_ & 15, l2_ >> 4); S.done(cur); }
        if (!has_next) break;
#pragma unroll
        for (int a = 0; a < 2; ++a)
#pragma unroll
            for (int b = 0; b < 2; ++b)
#pragma unroll
                for (int m = 0; m < 4; ++m)
#pragma unroll
                    for (int n = 0; n < 2; ++n) acc[a][b][m][n] = (f32x4){0.f, 0.f, 0.f, 0.f};
        cur = nxt; cA = nA; cB = nB; ++ui;
        if constexpr (ALIGN_EPI) { if (wr == 1) PG8_BAR; }
    }
    PG8_WAIT_V(0);
    if constexpr (!ALIGN_EPI) { if (wr == 0) PG8_BAR; }
    PG8_BAR;
    if constexpr (Epi::AFTER_DRAIN) { E.fused(acc, cur, wr, wc, fr, fq, lds, wid, lane); S.done(cur); }
#undef PG8_SA
#undef PG8_SB
#undef PG8_STAGE
#undef PG8_LDA
#undef PG8_LDB
#undef PG8_MMA
#undef PG8_WAIT_V
#undef PG8_WAIT_L
#undef PG8_BAR
#undef PG8_SCHED
}
}
namespace pg8 {
struct GemmA { const bf16_t* A; const bf16_t* Bt; int K; int rowA; size_t kstepA, hstepA, tstepA; };
template <class Epi, class Sched, bool ALIGN_EPI = false, bool SP2 = false>
__device__ __forceinline__ void gemm_phase_ga(PG8_LAS unsigned char* lds, const GemmA g, const Sched& S, const Epi& E, int wid_in) {
    int lane_; asm volatile("v_mbcnt_lo_u32_b32 %0, -1, 0\n\tv_mbcnt_hi_u32_b32 %0, -1, %0" : "=v"(lane_));
    const int wid = wid_in, lane = lane_, tid = wid * 64 + lane, wr = wid >> 2, wc = wid & 3, fr = lane & 15, fq = lane >> 4;
    const int K = g.K, nt = K / BK;
    unsigned voffA[2], voffB[2];
#pragma unroll
    for (int i = 0; i < 2; ++i) { int R, C; stage_rc(tid * 16 + i * 8192, R, C); const int Rb = Epi::PERM ? ((R & ~31) + perm32(R & 31)) : R;
        voffA[i] = (unsigned)(R * g.rowA + C * 2); voffB[i] = (unsigned)(Rb * K + C) * 2u; }
    const size_t kstep = (size_t)(BK * 2);
    const size_t hstep = (size_t)HALF * K * 2;
    const size_t kstepA = g.kstepA, hstepA = g.hstepA, tstepA = g.tstepA;
    const size_t tstep = 2 * hstep;
    const unsigned ldsw = (unsigned)wid * 1024u;
    const int aoff = lds_byte(wr * 64 + fr, fq * 8), boff = lds_byte(wc * 32 + fr, fq * 8);
#define PG8_SA(b, h) (((b) * 2 + (h)) * HTB)
#define PG8_SB(b, h) ((4 + (b) * 2 + (h)) * HTB)
#define PG8_STAGE(bufoff, gbase, voff) do { _Pragma("unroll") for (int _i = 0; _i < 2; ++_i) \
        __builtin_amdgcn_global_load_lds((const unsigned*)((const char*)(gbase) + (voff)[_i]), (PG8_LAS unsigned*)(lds + (bufoff) + ldsw + _i * 8192), 16, 0, 0); } while (0)
#define PG8_LDA(dst, b, h) do { _Pragma("unroll") for (int m = 0; m < 4; ++m) _Pragma("unroll") for (int k = 0; k < 2; ++k) dst[m][k] = *(const PG8_LAS bf16x8*)(lds + PG8_SA(b, h) + aoff + m * 2048 + k * 1024); } while (0)
#define PG8_LDB(dst, b, h) do { _Pragma("unroll") for (int n = 0; n < 2; ++n) _Pragma("unroll") for (int k = 0; k < 2; ++k) dst[n][k] = *(const PG8_LAS bf16x8*)(lds + PG8_SB(b, h) + boff + n * 2048 + k * 1024); } while (0)
#define PG8_MMA(ai, bj, At, Bt) do { __builtin_amdgcn_s_setprio(1); _Pragma("unroll") for (int m = 0; m < 4; ++m) _Pragma("unroll") for (int n = 0; n < 2; ++n) _Pragma("unroll") for (int k = 0; k < 2; ++k) \
        acc[ai][bj][m][n] = __builtin_amdgcn_mfma_f32_16x16x32_bf16(Bt[n][k], At[m][k], acc[ai][bj][m][n], 0, 0, 0); __builtin_amdgcn_s_setprio(0); } while (0)
#define PG8_WAIT_V(n) asm volatile("s_waitcnt vmcnt(" #n ")" ::: "memory")
#define PG8_WAIT_L(n) asm volatile("s_waitcnt lgkmcnt(" #n ")" ::: "memory")
#define PG8_BAR __builtin_amdgcn_s_barrier()
#define PG8_SCHED __builtin_amdgcn_sched_barrier(0)
    Unit cur, nxt; int ui = 0;
    if (!S.next(0, cur)) return;
    f32x4 acc[2][2][4][2];
#pragma unroll
    for (int a = 0; a < 2; ++a)
#pragma unroll
        for (int b = 0; b < 2; ++b)
#pragma unroll
            for (int m = 0; m < 4; ++m)
#pragma unroll
                for (int n = 0; n < 2; ++n) acc[a][b][m][n] = (f32x4){0.f, 0.f, 0.f, 0.f};
    bf16x8 At[4][2], B0[2][2], B1[2][2];
    const char* cA = (const char*)g.A + (size_t)cur.pm * tstepA; const char* cB = (const char*)g.Bt + (size_t)cur.pn * tstep;
    S.a_ready(cur);
    if constexpr (SP2) {
        PG8_STAGE(PG8_SB(0, 0), cB, voffB); PG8_STAGE(PG8_SB(0, 1), cB + hstep, voffB); PG8_STAGE(PG8_SA(0, 0), cA, voffA); PG8_STAGE(PG8_SA(0, 1), cA + hstepA, voffA);
        if (wr == 1) PG8_BAR;
        PG8_WAIT_V(2); PG8_BAR;
        PG8_STAGE(PG8_SB(1, 0), cB + kstep, voffB); PG8_STAGE(PG8_SA(1, 0), cA + kstepA, voffA); PG8_STAGE(PG8_SB(1, 1), cB + hstep + kstep, voffB);
        PG8_WAIT_V(6); PG8_BAR;
    } else {
        PG8_STAGE(PG8_SB(0, 0), cB, voffB); PG8_STAGE(PG8_SA(0, 0), cA, voffA); PG8_STAGE(PG8_SB(0, 1), cB + hstep, voffB); PG8_STAGE(PG8_SA(0, 1), cA + hstepA, voffA);
        if (wr == 1) PG8_BAR;
        PG8_WAIT_V(4); PG8_BAR;
        PG8_STAGE(PG8_SB(1, 0), cB + kstep, voffB); PG8_STAGE(PG8_SA(1, 0), cA + kstepA, voffA); PG8_STAGE(PG8_SB(1, 1), cB + hstep + kstep, voffB);
        PG8_WAIT_V(6); PG8_BAR;
    }
    for (;;) {
        const bool has_next = S.next(ui + 1, nxt);
        const char* nA = has_next ? (const char*)g.A + (size_t)nxt.pm * tstepA : cA; const char* nB = has_next ? (const char*)g.Bt + (size_t)nxt.pn * tstep : cB;
        for (int t = 0; t < nt; t += 2) {
            if constexpr (MidSeg<Epi>::v > 0) { if (t > 0 && t % MidSeg<Epi>::v == 0) E.mid(acc, cur, t / MidSeg<Epi>::v, wr, wc, fr, fq); }
            const bool last = (t == nt - 2);
            const char* a1 = cA + (size_t)(t + 1) * kstepA;
            const char* a2 = last ? nA : cA + (size_t)(t + 2) * kstepA; const char* b2 = last ? nB : cB + (size_t)(t + 2) * kstep;
            const char* a3 = a2 + kstepA; const char* b3 = b2 + kstep;
            if (last && has_next) S.a_ready(nxt);
            if constexpr (SP2) {
            PG8_LDB(B0, 0, 0); PG8_LDB(B1, 0, 1); PG8_SCHED; PG8_LDA(At, 0, 0); PG8_STAGE(PG8_SA(1, 1), a1 + hstepA, voffA);
            PG8_WAIT_V(8); PG8_WAIT_L(0); PG8_BAR; PG8_MMA(0, 0, At, B0); PG8_MMA(0, 1, At, B1); PG8_BAR; PG8_SCHED;
            PG8_LDA(At, 0, 1); PG8_STAGE(PG8_SB(0, 0), b2, voffB); PG8_STAGE(PG8_SB(0, 1), b2 + hstep, voffB); PG8_STAGE(PG8_SA(0, 0), a2, voffA);
            PG8_WAIT_V(8); PG8_WAIT_L(0); PG8_BAR; PG8_MMA(1, 0, At, B0); PG8_MMA(1, 1, At, B1); PG8_BAR; PG8_SCHED;
            PG8_LDB(B0, 1, 0); PG8_LDB(B1, 1, 1); PG8_SCHED; PG8_LDA(At, 1, 0); PG8_STAGE(PG8_SA(0, 1), a2 + hstepA, voffA);
            PG8_WAIT_V(8); PG8_WAIT_L(0); PG8_BAR; PG8_MMA(0, 0, At, B0); PG8_MMA(0, 1, At, B1); PG8_BAR; PG8_SCHED;
            PG8_LDA(At, 1, 1); PG8_STAGE(PG8_SB(1, 0), b3, voffB); PG8_STAGE(PG8_SB(1, 1), b3 + hstep, voffB); PG8_STAGE(PG8_SA(1, 0), a3, voffA);
            PG8_WAIT_V(8); PG8_WAIT_L(0); PG8_BAR; PG8_MMA(1, 0, At, B0); PG8_MMA(1, 1, At, B1); PG8_BAR; PG8_SCHED;
            } else {
            PG8_LDB(B0, 0, 0); PG8_SCHED; PG8_LDA(At, 0, 0); PG8_STAGE(PG8_SA(1, 1), a1 + hstepA, voffA);
            PG8_WAIT_L(8); PG8_BAR; PG8_WAIT_L(0); PG8_MMA(0, 0, At, B0); PG8_BAR; PG8_SCHED;
            PG8_LDB(B1, 0, 1); PG8_STAGE(PG8_SB(0, 0), b2, voffB);
            PG8_BAR; PG8_WAIT_L(0); PG8_MMA(0, 1, At, B1); PG8_BAR;
            PG8_LDA(At, 0, 1); PG8_STAGE(PG8_SA(0, 0), a2, voffA);
            PG8_BAR; PG8_WAIT_L(0); PG8_MMA(1, 0, At, B0); PG8_BAR; PG8_SCHED;
            PG8_STAGE(PG8_SB(0, 1), b2 + hstep, voffB);
            PG8_WAIT_V(6); PG8_BAR; PG8_MMA(1, 1, At, B1); PG8_BAR;
            PG8_LDB(B0, 1, 0); PG8_SCHED; PG8_LDA(At, 1, 0); PG8_STAGE(PG8_SA(0, 1), a2 + hstepA, voffA);
            PG8_WAIT_L(8); PG8_BAR; PG8_WAIT_L(0); PG8_MMA(0, 0, At, B0); PG8_BAR; PG8_SCHED;
            PG8_LDB(B1, 1, 1); PG8_STAGE(PG8_SB(1, 0), b3, voffB);
            PG8_BAR; PG8_WAIT_L(0); PG8_MMA(0, 1, At, B1); PG8_BAR;
            PG8_LDA(At, 1, 1); PG8_STAGE(PG8_SA(1, 0), a3, voffA);
            PG8_BAR; PG8_WAIT_L(0); PG8_MMA(1, 0, At, B0); PG8_BAR; PG8_SCHED;
            PG8_STAGE(PG8_SB(1, 1), b3 + hstep, voffB);
            PG8_WAIT_V(6); PG8_BAR; PG8_MMA(1, 1, At, B1); PG8_BAR;
            }
        }
        if constexpr (ALIGN_EPI) { if (wr == 0) PG8_BAR; }
        if constexpr (!Epi::AFTER_DRAIN) { E(acc, cur, wr, wc, fr, fq); S.done(cur); }
        if (!has_next) break;
#pragma unroll
        for (int a = 0; a < 2; ++a)
#pragma unroll
            for (int b = 0; b < 2; ++b)
#pragma unroll
                for (int m = 0; m < 4; ++m)
#pragma unroll
                    for (int n = 0; n < 2; ++n) acc[a][b][m][n] = (f32x4){0.f, 0.f, 0.f, 0.f};
        cur = nxt; cA = nA; cB = nB; ++ui;
        if constexpr (ALIGN_EPI) { if (wr == 1) PG8_BAR; }
    }
    PG8_WAIT_V(0);
    if constexpr (!ALIGN_EPI) { if (wr == 0) PG8_BAR; }
    PG8_BAR;
    if constexpr (Epi::AFTER_DRAIN) { E.fused(acc, cur, wr, wc, fr, fq, lds, wid, lane); S.done(cur); }
#undef PG8_SA
#undef PG8_SB
#undef PG8_STAGE
#undef PG8_LDA
#undef PG8_LDB
#undef PG8_MMA
#undef PG8_WAIT_V
#undef PG8_WAIT_L
#undef PG8_BAR
#undef PG8_SCHED
}
}
#define GAS __attribute__((address_space(1)))
#define LAS __attribute__((address_space(3)))
typedef unsigned short bf16;
typedef unsigned v4u __attribute__((ext_vector_type(4)));
typedef float f32x4 __attribute__((ext_vector_type(4)));
typedef short bf16x8 __attribute__((ext_vector_type(8)));
typedef GAS unsigned gu32;
typedef GAS unsigned long long gu64;
#define RLX_AGENT __ATOMIC_RELAXED, __HIP_MEMORY_SCOPE_AGENT
#define LDS_WAIT() asm volatile("s_waitcnt lgkmcnt(0)" ::: "memory")
#define VM_WAIT() asm volatile("s_waitcnt vmcnt(0)" ::: "memory")
__device__ __forceinline__ unsigned long long rt() { return __builtin_amdgcn_s_memrealtime(); }
__device__ __forceinline__ unsigned f2bf(float f) { unsigned u = __builtin_bit_cast(unsigned, f); return (u + 0x7fffu + ((u >> 16) & 1u)) >> 16; }
__device__ __forceinline__ unsigned pk2(float lo, float hi) { return f2bf(lo) | (f2bf(hi) << 16); }

#define XB_TMO      128
#define XB_XCNT(j)  (256  + 64 * (j))
#define XB_XSUB(j)  (1280 + 64 * (j))
#define XB_XGEN(j)  (2304 + 64 * (j))
#define XB_TOP      3328
#define XB_TOPGEN   3392
#define XCD_BAR_WORDS 3456
#define XB_SPIN_CAP (1u << 18)

__device__ __forceinline__ unsigned xb_ld(unsigned* p)              { return __hip_atomic_load(p, __ATOMIC_RELAXED, __HIP_MEMORY_SCOPE_AGENT); }
__device__ __forceinline__ unsigned xb_add(unsigned* p, unsigned v) { return __hip_atomic_fetch_add(p, v, __ATOMIC_RELAXED, __HIP_MEMORY_SCOPE_AGENT); }
__device__ __forceinline__ unsigned xb_xcc_id() { return (unsigned)__builtin_amdgcn_s_getreg((3 << 11) | 20) & 0xFu; }
#define XB_SPIN(cond, bar) do { unsigned _sp = 0; while (cond) { __builtin_amdgcn_s_sleep(1); \
    if ((++_sp & 255u) == 0u) { if (xb_ld(&(bar)[XB_TMO])) break; if (_sp > XB_SPIN_CAP) { atomicAdd(&(bar)[XB_TMO], 1u); break; } } } } while (0)

struct XcdBarrier {
    int wv;
    unsigned* bar; unsigned x;
    volatile LAS unsigned* st;
};

__device__ __forceinline__ int xb_lane_id() { int l; asm volatile("v_mbcnt_lo_u32_b32 %0, -1, 0\n\tv_mbcnt_hi_u32_b32 %0, -1, %0" : "=v"(l)); return l; }
__device__ __forceinline__ XcdBarrier xcd_barrier_post(unsigned* bar, volatile LAS unsigned* st, int wv) {
    XcdBarrier b; b.wv = wv; b.bar = bar; b.x = xb_xcc_id(); b.st = st;
    if (wv == 0 && xb_lane_id() == 0) (void)xb_add(&bar[XB_XCNT(b.x)], 1u);
    return b;
}
__device__ __forceinline__ void xcd_barrier_complete(unsigned* bar, unsigned x, unsigned& nloc, unsigned& nx) {
    const unsigned G = gridDim.x * gridDim.y * gridDim.z;
    unsigned sum, cnt, mine, sp = 0u;
    for (;;) {
        sum = 0u; cnt = 0u; mine = 0u;
#pragma unroll
        for (unsigned j = 0; j < 16; ++j) { const unsigned c = xb_ld(&bar[XB_XCNT(j)]); sum += c; cnt += (c > 0u) ? 1u : 0u; mine = (j == x) ? c : mine; }
        if (sum == G) break;
        __builtin_amdgcn_s_sleep(1);
        if ((++sp & 255u) == 0u) { if (xb_ld(&bar[XB_TMO])) break; if (sp > XB_SPIN_CAP) { atomicAdd(&bar[XB_TMO], 1u); break; } }
    }
    nloc = mine > 0u ? mine : 1u; nx = cnt > 0u ? cnt : 1u;
}

__device__ __forceinline__ void xcd_barrier(const XcdBarrier& b) {
    asm volatile("s_waitcnt vmcnt(0)" ::: "memory");
    __syncthreads();
    if (b.wv == 0 && xb_lane_id() == 0) {
        unsigned* bar = b.bar;
        __builtin_amdgcn_s_waitcnt(0);
        unsigned nloc = b.st[0], nx = b.st[1];
        if (nloc == 0u) { xcd_barrier_complete(bar, b.x, nloc, nx); b.st[0] = nloc; b.st[1] = nx; }
        const unsigned old = xb_add(&bar[XB_XSUB(b.x)], 1u);
        const unsigned gen = old / nloc;
        if (old + 1u == (gen + 1u) * nloc) {
            __builtin_amdgcn_fence(__ATOMIC_RELEASE, "agent");
            asm volatile("s_waitcnt vmcnt(0)" ::: "memory");
            const unsigned og = xb_add(&bar[XB_TOP], 1u);
            const unsigned tg = og / nx;
            if (og + 1u == (tg + 1u) * nx) xb_add(&bar[XB_TOPGEN], 1u);
            else XB_SPIN(xb_ld(&bar[XB_TOPGEN]) == tg, bar);
            __builtin_amdgcn_fence(__ATOMIC_ACQUIRE, "agent");
            xb_add(&bar[XB_XGEN(b.x)], 1u);
            asm volatile("s_waitcnt vmcnt(0)" ::: "memory");
        } else {
            XB_SPIN(xb_ld(&bar[XB_XGEN(b.x)]) == gen, bar);
            __builtin_amdgcn_fence(__ATOMIC_ACQUIRE, "agent");
            asm volatile("s_waitcnt vmcnt(0)" ::: "memory");
        }
    }
    __syncthreads();
}
#define DI __device__ __forceinline__
constexpr int NWAVES = 8;
constexpr int NB = 16, SEQ = 2048, DM = 1024, MT = NB * SEQ;
constexpr int DIN_SRC = 6944, NPROJ = 7168;
constexpr int MEML = 256, MROWS = NB * MEML;
constexpr int NEXP = 32, TOPK = 4, DFF = 1024, MOEB = 256;
constexpr int NROWS = MT * TOPK;
constexpr int NBLK_MAX = (NROWS + NEXP * (MOEB - 1) + MOEB - 1) / MOEB;
constexpr int CAP = NBLK_MAX * MOEB;
constexpr float EPS = 1e-6f;
constexpr float NEGF = -1e30f;
constexpr int NB16 = 3584, NF8 = NPROJ - NB16;
constexpr int PC_MLQ = 0, PC_MLK = 512, PC_NQ = 1024, PC_NKC = 1536, PC_NKS = 1664, PC_NKW = 1792, PC_MQ = 1920, PC_MLI = 2432, PC_MLF = 2436, PC_NG = 2440,
              PC_MLV = 2560, PC_NVC = 3072, PC_NVS = 3200, PC_NVW = 3328, PC_MLO = 3584, PC_BRG = 4096;
__host__ __device__ constexpr int proj_srccol(int j) {
    return j < 1024 ? j : j < 1536 ? 2056 + (j - 1024) : j < 1664 ? 2568 + (j - 1536) : j < 1792 ? 2824 + (j - 1664) : j < 1920 ? 3080 + (j - 1792) : j < 2432 ? 3360 + (j - 1920)
         : j < 2440 ? 2048 + (j - 2432) : j < 2464 ? 3336 + (j - 2440) : j < 2560 ? -1
         : j < 3072 ? 1024 + (j - 2560) : j < 3200 ? 2696 + (j - 3072) : j < 3328 ? 2952 + (j - 3200) : j < 3456 ? 3208 + (j - 3328) : j < 3584 ? -1
         : j < 4096 ? 1536 + (j - 3584) : 3872 + (j - 4096);
}

constexpr size_t MiB = 1u << 20;
constexpr size_t WS_CTL = 0, CTL_ZERO_BYTES = 1 * MiB;
constexpr size_t WS_WIN = 1 * MiB, WS_WGU = 15 * MiB, WS_WDN = 143 * MiB, WS_WMKV = 207 * MiB, WS_WBR = 209 * MiB, WS_WOUT = 212 * MiB, WS_WC1 = 214 * MiB;
constexpr size_t WS_WIN8 = WS_WIN + 8 * MiB;
constexpr size_t WS_SMALL = 216 * MiB;
constexpr size_t WS_R1 = 218 * MiB;
constexpr size_t WS_PROJ = 282 * MiB;
constexpr size_t WS_R3 = 730 * MiB;
constexpr size_t WS_MEMKV = WS_R3, WS_MEMKN = WS_R3 + 8 * MiB, WS_QN = WS_R3 + 12 * MiB, WS_KSN = WS_R3 + 44 * MiB, WS_KWN = WS_R3 + 52 * MiB,
                 WS_MQN = WS_R3 + 60 * MiB, WS_MLQK = WS_R3 + 92 * MiB, WS_HID = WS_R3 + 156 * MiB, WS_KC = WS_R3 + 160 * MiB, WS_VC = WS_KC + MiB / 2,
                 WS_H0 = WS_R3 + 161 * MiB, WS_H1 = WS_H0 + 32 * MiB, WS_H2 = WS_H1 + 32 * MiB, WS_ROUTE = WS_H2 + 32 * MiB, WS_END = WS_ROUTE + 6 * MiB;
constexpr size_t WS_MLV = WS_R1, WS_VSN = WS_R1 + 32 * MiB, WS_VWN = WS_R1 + 40 * MiB;
constexpr size_t WS_U8 = WS_H2;
constexpr size_t WS_MEMN = WS_H0;
constexpr size_t WS_ACMP = WS_H1;
constexpr size_t WS_APERM = WS_PROJ;
constexpr size_t WS_ACT = WS_PROJ + 272 * MiB;
static_assert(WS_ACT + 272 * MiB <= WS_H0 + 96 * MiB && WS_END <= 1024 * MiB, "ws map");
constexpr size_t SM_ROPEC = 0, SM_ROPES = 256 * 1024, SM_CBIAS = 512 * 1024, SM_WRT = 1024 * 1024, SM_W2T = 1024 * 1024 + 256 * 1024;
constexpr size_t RT_TOKE = 0, RT_TOKPOS = 512 * 1024, RT_TOKW = 1024 * 1024, RT_TOKDEST = 1536 * 1024, RT_ROWW = 2048 * 1024;
constexpr int CW_BAR = 4096;
constexpr int CW_ECNT = 16384;
constexpr int CW_QCTR = 16384 + 64;

constexpr int RING_BYTES = 131072, LDSCTL_OFF = RING_BYTES, MISC_OFF = LDSCTL_OFF + 320, LDS_BYTES = 155648;

struct Args { const float* in[34]; float* out; unsigned char* ws; int ph_lo, ph_hi, li, pad; };

DI float bf2f(unsigned short h) { return __uint_as_float((unsigned)h << 16); }
DI float wave_sum(float v) {
#pragma unroll
    for (int o = 1; o < 64; o <<= 1) v += __shfl_xor(v, o);
    return v;
}
DI float wave_max(float v) {
#pragma unroll
    for (int o = 1; o < 64; o <<= 1) v = fmaxf(v, __shfl_xor(v, o));
    return v;
}
DI float sigm(float x) { return __builtin_amdgcn_rcpf(1.f + __expf(-x)); }
DI float logsig(float x) { return fminf(x, 0.f) - log1pf(__expf(-fabsf(x))); }

namespace pg8 {
struct EpiBf16Silu {
    static constexpr bool PERM = true, AFTER_DRAIN = false;
    bf16_t* O; int ldc; const float* bias; int silu;
    DI void operator()(const f32x4 (&acc)[2][2][4][2], const Unit& u, int wr, int wc, int fr, int fq) const {
        const int row0 = u.pm * BM + wr * 64 + fr; const int col0 = u.pn * BM + wc * 32 + 8 * fq;
#pragma unroll
        for (int ai = 0; ai < 2; ++ai)
#pragma unroll
            for (int m = 0; m < 4; ++m) { bf16_t* rowp = O + (size_t)(row0 + ai * HALF + m * 16) * ldc + col0;
#pragma unroll
                for (int bj = 0; bj < 2; ++bj) { f32x4 v0 = acc[ai][bj][m][0], v1 = acc[ai][bj][m][1];
                    if (bias) { v0 += *(const f32x4*)(bias + col0 + bj * HALF); v1 += *(const f32x4*)(bias + col0 + bj * HALF + 4); }
                    if (silu) {
#pragma unroll
                        for (int j = 0; j < 4; ++j) { v0[j] = v0[j] * __builtin_amdgcn_rcpf(1.f + __expf(-v0[j])); v1[j] = v1[j] * __builtin_amdgcn_rcpf(1.f + __expf(-v1[j])); } }
                    u32x4 w; w.x = cvt_pk_bf16(v0[0], v0[1]); w.y = cvt_pk_bf16(v0[2], v0[3]); w.z = cvt_pk_bf16(v1[0], v1[1]); w.w = cvt_pk_bf16(v1[2], v1[3]);
                    *(u32x4*)(rowp + bj * HALF) = w; } }
    }
};
template <int B> struct EpiGate {
    static constexpr bool PERM = false, AFTER_DRAIN = false;
    const bf16_t* proj; float* tmp; bf16_t* merged;
    DI void operator()(const f32x4 (&acc)[2][2][4][2], const Unit& u, int wr, int wc, int fr, int fq) const {
        typedef unsigned u32x2v __attribute__((ext_vector_type(2)));
        const int col0 = u.pn * BM + wc * 32 + 4 * fq;
#pragma unroll
        for (int ai = 0; ai < 2; ++ai)
#pragma unroll
            for (int m = 0; m < 4; ++m) { const size_t r = (size_t)(u.pm * BM + ai * HALF + wr * 64 + m * 16 + fr);
#pragma unroll
                for (int bj = 0; bj < 2; ++bj)
#pragma unroll
                    for (int n = 0; n < 2; ++n) { const int c = col0 + bj * HALF + n * 16;
                        const u32x2v gw = *(const u32x2v*)(proj + r * NPROJ + PC_BRG + B * DM + c);
                        f32x4 g; g[0] = __uint_as_float(gw.x << 16); g[1] = __uint_as_float(gw.x & 0xffff0000u); g[2] = __uint_as_float(gw.y << 16); g[3] = __uint_as_float(gw.y & 0xffff0000u);
                        f32x4 v = acc[ai][bj][m][n];
#pragma unroll
                        for (int j = 0; j < 4; ++j) v[j] = v[j] * __builtin_amdgcn_rcpf(1.f + __expf(-g[j]));
                        float* tp = tmp + r * DM + c;
                        if (B == 0) { *(f32x4*)tp = v; }
                        else if (B == 1) { *(f32x4*)tp = *(const f32x4*)tp + v; }
                        else { v = *(const f32x4*)tp + v; u32x2v w; w.x = cvt_pk_bf16(v[0], v[1]); w.y = cvt_pk_bf16(v[2], v[3]); *(u32x2v*)(merged + r * DM + c) = w; } } }
    }
};
struct EpiMerge {
    static constexpr bool PERM = false, AFTER_DRAIN = false;
    const bf16_t* proj; float* tmp; bf16_t* merged;
    DI void operator()(const f32x4 (&acc)[2][2][4][2], const Unit& u, int wr, int wc, int fr, int fq) const {
        typedef unsigned u32x2v __attribute__((ext_vector_type(2)));
        const int b = u.pn >> 2, pn = u.pn & 3, pm = u.pm & 127;
        const int col0 = pn * BM + wc * 32 + 4 * fq;
#pragma unroll
        for (int ai = 0; ai < 2; ++ai)
#pragma unroll
            for (int m = 0; m < 4; ++m) { const size_t r = (size_t)(pm * BM + ai * HALF + wr * 64 + m * 16 + fr);
#pragma unroll
                for (int bj = 0; bj < 2; ++bj)
#pragma unroll
                    for (int n = 0; n < 2; ++n) { const int c = col0 + bj * HALF + n * 16;
                        const u32x2v gw = *(const u32x2v*)(proj + r * NPROJ + PC_BRG + b * DM + c);
                        f32x4 g; g[0] = __uint_as_float(gw.x << 16); g[1] = __uint_as_float(gw.x & 0xffff0000u); g[2] = __uint_as_float(gw.y << 16); g[3] = __uint_as_float(gw.y & 0xffff0000u);
                        f32x4 v = acc[ai][bj][m][n];
#pragma unroll
                        for (int j = 0; j < 4; ++j) v[j] = v[j] * __builtin_amdgcn_rcpf(1.f + __expf(-g[j]));
                        float* tp = tmp + r * DM + c;
                        if (b == 0) { *(f32x4*)tp = v; }
                        else if (b == 1) { *(f32x4*)tp = *(const f32x4*)tp + v; }
                        else { v = *(const f32x4*)tp + v; u32x2v w; w.x = cvt_pk_bf16(v[0], v[1]); w.y = cvt_pk_bf16(v[2], v[3]); *(u32x2v*)(merged + r * DM + c) = w; } } }
    }
};
struct EpiMergeK {
    static constexpr bool PERM = false, AFTER_DRAIN = false; static constexpr int MIDSEG = 8;
    const bf16_t* proj; bf16_t* merged;
    DI static f32x4 ldg(const bf16_t* p) { typedef unsigned u32x2v __attribute__((ext_vector_type(2))); const u32x2v gw = *(const u32x2v*)p; f32x4 g;
        g[0] = __uint_as_float(gw.x << 16); g[1] = __uint_as_float(gw.x & 0xffff0000u); g[2] = __uint_as_float(gw.y << 16); g[3] = __uint_as_float(gw.y & 0xffff0000u); return g; }
    DI void mid(f32x4 (&acc)[2][2][4][2], const Unit& u, int seg, int wr, int wc, int fr, int fq) const {
        const int col0 = u.pn * BM + wc * 32 + 4 * fq;
#pragma unroll
        for (int ai = 0; ai < 2; ++ai)
#pragma unroll
            for (int m = 0; m < 4; ++m) { const size_t r = (size_t)(u.pm * BM + ai * HALF + wr * 64 + m * 16 + fr);
#pragma unroll
                for (int bj = 0; bj < 2; ++bj)
#pragma unroll
                    for (int n = 0; n < 2; ++n) { const int c = col0 + bj * HALF + n * 16; const bf16_t* gp = proj + r * NPROJ + PC_BRG + (seg - 1) * DM + c;
                        const f32x4 ga = ldg(gp), gb = ldg(gp + DM);
#pragma unroll
                        for (int j = 0; j < 4; ++j) acc[ai][bj][m][n][j] *= (1.f + __expf(-gb[j])) * __builtin_amdgcn_rcpf(1.f + __expf(-ga[j])); } }
    }
    DI void operator()(const f32x4 (&acc)[2][2][4][2], const Unit& u, int wr, int wc, int fr, int fq) const {
        typedef unsigned u32x2v __attribute__((ext_vector_type(2)));
        const int col0 = u.pn * BM + wc * 32 + 4 * fq;
#pragma unroll
        for (int ai = 0; ai < 2; ++ai)
#pragma unroll
            for (int m = 0; m < 4; ++m) { const size_t r = (size_t)(u.pm * BM + ai * HALF + wr * 64 + m * 16 + fr);
#pragma unroll
                for (int bj = 0; bj < 2; ++bj)
#pragma unroll
                    for (int n = 0; n < 2; ++n) { const int c = col0 + bj * HALF + n * 16; const f32x4 g = ldg(proj + r * NPROJ + PC_BRG + 2 * DM + c); f32x4 v = acc[ai][bj][m][n];
#pragma unroll
                        for (int j = 0; j < 4; ++j) v[j] = v[j] * __builtin_amdgcn_rcpf(1.f + __expf(-g[j]));
                        u32x2v w; w.x = cvt_pk_bf16(v[0], v[1]); w.y = cvt_pk_bf16(v[2], v[3]); *(u32x2v*)(merged + r * DM + c) = w; } }
    }
};
struct MergeOrder {
    StaticOrder so;
    DI bool next(int i, Unit& u) const { const int tl = i / 3, b = i - 3 * tl; Unit t; if (!so.next(tl, t)) return false; u.pm = b * 128 + t.pm; u.pn = b * 4 + t.pn; return true; }
    DI void a_ready(const Unit&) const {}
    DI void done(const Unit&) const {}
};
struct EpiRes {
    static constexpr bool PERM = false, AFTER_DRAIN = false;
    const float* base; float* out;
    DI void operator()(const f32x4 (&acc)[2][2][4][2], const Unit& u, int wr, int wc, int fr, int fq) const {
        const int col0 = u.pn * BM + wc * 32 + 4 * fq;
#pragma unroll
        for (int ai = 0; ai < 2; ++ai)
#pragma unroll
            for (int m = 0; m < 4; ++m) { const size_t r = (size_t)(u.pm * BM + ai * HALF + wr * 64 + m * 16 + fr);
#pragma unroll
                for (int bj = 0; bj < 2; ++bj)
#pragma unroll
                    for (int n = 0; n < 2; ++n) { const int c = col0 + bj * HALF + n * 16; *(f32x4*)(out + r * DM + c) = *(const f32x4*)(base + r * DM + c) + acc[ai][bj][m][n]; } }
    }
};
struct EpiSwiglu {
    static constexpr bool PERM = true, AFTER_DRAIN = false;
    unsigned char* act; const float* bgu;
    DI void operator()(const f32x4 (&acc)[2][2][4][2], const Unit& u, int wr, int wc, int fr, int fq) const {
        typedef unsigned u32x2v __attribute__((ext_vector_type(2)));
        const int e = u.pn >> 3, pnl = u.pn & 7;
        const int lc0 = pnl * BM + wc * 32 + 8 * fq;
        const unsigned row0 = (unsigned)(u.pm * BM + wr * 64 + fr);
        const float* bp = bgu + e * 2048;
#pragma unroll
        for (int ai = 0; ai < 2; ++ai)
#pragma unroll
            for (int m = 0; m < 4; ++m) { const unsigned rowoff = (row0 + ai * HALF + m * 16) * (unsigned)DFF;
#pragma unroll
                for (int bj = 0; bj < 2; ++bj) {
                    const unsigned lc = (unsigned)(lc0 + bj * HALF);
                    const f32x4 b0 = *(const f32x4*)(bp + lc), b1 = *(const f32x4*)(bp + lc + 4);
                    const f32x4 v0 = acc[ai][bj][m][0] + b0, v1 = acc[ai][bj][m][1] + b1;
                    float o[4];
#pragma unroll
                    for (int q = 0; q < 4; ++q) { const float gt = fminf(q < 2 ? v0[2 * q] : v1[2 * q - 4], 7.0f); float up = q < 2 ? v0[2 * q + 1] : v1[2 * q - 3]; up = fminf(fmaxf(up, -7.0f), 7.0f);
                        o[q] = (up + 1.0f) * (gt * __builtin_amdgcn_rcpf(1.f + __expf(-1.702f * gt))); }
                    int q8 = 0; q8 = __builtin_amdgcn_cvt_pk_fp8_f32(o[0], o[1], q8, false); q8 = __builtin_amdgcn_cvt_pk_fp8_f32(o[2], o[3], q8, true);
                    *(unsigned*)(act + (rowoff + (lc >> 1))) = (unsigned)q8; } }
    }
};
struct EpiDown {
    static constexpr bool PERM = true, AFTER_DRAIN = false;
    bf16_t* y; const float* bdn; const float* roww;
    DI void operator()(const f32x4 (&acc)[2][2][4][2], const Unit& u, int wr, int wc, int fr, int fq) const {
        const int e = u.pn >> 2, pnl = u.pn & 3;
        const int col0 = pnl * BM + wc * 32 + 8 * fq;
        const float* bp = bdn + e * DM + col0;
        f32x4 bv[2][2];
#pragma unroll
        for (int bj = 0; bj < 2; ++bj) { bv[bj][0] = *(const f32x4*)(bp + bj * HALF); bv[bj][1] = *(const f32x4*)(bp + bj * HALF + 4); }
        const unsigned row0 = (unsigned)(u.pm * BM + wr * 64 + fr);
#pragma unroll
        for (int ai = 0; ai < 2; ++ai)
#pragma unroll
            for (int m = 0; m < 4; ++m) { const unsigned r = row0 + ai * HALF + m * 16; const float rw = roww[r]; const unsigned off = r * (unsigned)DM + (unsigned)col0;
#pragma unroll
                for (int bj = 0; bj < 2; ++bj) { const f32x4 v0 = (acc[ai][bj][m][0] + bv[bj][0]) * rw, v1 = (acc[ai][bj][m][1] + bv[bj][1]) * rw;
                    u32x4 w; w.x = cvt_pk_bf16(v0[0], v0[1]); w.y = cvt_pk_bf16(v0[2], v0[3]); w.z = cvt_pk_bf16(v1[0], v1[1]); w.w = cvt_pk_bf16(v1[2], v1[3]);
                    *(u32x4*)(y + (off + bj * HALF)) = w; } }
    }
};
template <int NPN> struct MoeOrder {
    int nblk, G, c; const PG8_LAS unsigned char* blk_e;
    DI bool next(int i, Unit& u) const {
        int rb, pn;
        if (G == 256) { const int x = c & 7, j = c >> 3; rb = i * (256 / NPN) + x * (32 / NPN) + j / NPN; pn = j % NPN; }
        else { const int L = i * G + c; rb = L / NPN; pn = L % NPN; }
        if (rb >= nblk) return false;
        u.pm = rb; u.pn = __builtin_amdgcn_readfirstlane((int)blk_e[rb]) * NPN + pn; return true; }
    DI void a_ready(const Unit&) const {}
    DI void done(const Unit&) const {}
};
}

struct Frame {
    LAS unsigned char* lds; volatile LAS unsigned* MISC; unsigned* ctl; unsigned char* ws;
    int wave, G, bx;
    DI int lane_id() const { int l; asm volatile("v_mbcnt_lo_u32_b32 %0, -1, 0\n\tv_mbcnt_hi_u32_b32 %0, -1, %0" : "=v"(l)); return l; }
    DI int tid_id() const { return wave * 64 + lane_id(); }
    const float* const* in; float* out;
};
enum { I_X = 0, I_MEM, I_GMIX, I_WIN, I_CONVW, I_CONVB, I_MLBI, I_MLBF, I_MLGOUT, I_NGQ, I_NGK, I_CPK, I_CW1K, I_CB1K, I_CW2K, I_CPV, I_CW1V, I_CB1V, I_CW2V,
       I_GMEM, I_WMKV, I_MGQ, I_MGK, I_WBRML, I_WBRNSA, I_WBRMEM, I_WOUT, I_GFFN, I_WR, I_BR, I_WGU, I_BGU, I_WDN, I_BDN, N_IN };

template <class CM>
DI void tr_item(const float* W, int ldw, int K, bf16* WT, int k0, int n0, CM cm, LAS float* scr, int lane) {
    const int sc = cm(n0 + (lane & 31));
#pragma unroll 8
    for (int i = 0; i < 32; ++i) { const int kk = 2 * i + (lane >> 5); scr[kk * 33 + (lane & 31)] = sc >= 0 ? W[(size_t)(k0 + kk) * ldw + sc] : 0.f; }
    LDS_WAIT(); asm volatile("" ::: "memory");
    const int c = lane & 7;
#pragma unroll
    for (int j = 0; j < 4; ++j) { const int n = (lane >> 3) + 8 * j; const LAS float* s = scr + (8 * c) * 33 + n;
        v4u o; o.x = pk2(s[0 * 33], s[1 * 33]); o.y = pk2(s[2 * 33], s[3 * 33]); o.z = pk2(s[4 * 33], s[5 * 33]); o.w = pk2(s[6 * 33], s[7 * 33]);
        *(v4u*)(WT + (size_t)(n0 + n) * K + k0 + 8 * c) = o; }
    LDS_WAIT(); asm volatile("" ::: "memory");
}
DI void tr_item_f8(const float* W, int ldw, int K, unsigned char* WT, int k0, int n0, LAS float* scr, int lane) {
#pragma unroll 8
    for (int i = 0; i < 32; ++i) { const int kk = 2 * i + (lane >> 5); scr[kk * 33 + (lane & 31)] = W[(size_t)(k0 + kk) * ldw + n0 + (lane & 31)] * 256.0f; }
    LDS_WAIT(); asm volatile("" ::: "memory");
    const int c = lane & 7;
#pragma unroll
    for (int j = 0; j < 4; ++j) { const int n = (lane >> 3) + 8 * j; const LAS float* sp = scr + (8 * c) * 33 + n;
        int lo = 0, hi = 0;
        lo = __builtin_amdgcn_cvt_pk_fp8_f32(sp[0 * 33], sp[1 * 33], lo, false); lo = __builtin_amdgcn_cvt_pk_fp8_f32(sp[2 * 33], sp[3 * 33], lo, true);
        hi = __builtin_amdgcn_cvt_pk_fp8_f32(sp[4 * 33], sp[5 * 33], hi, false); hi = __builtin_amdgcn_cvt_pk_fp8_f32(sp[6 * 33], sp[7 * 33], hi, true);
        typedef unsigned u32x2t __attribute__((ext_vector_type(2)));
        *(u32x2t*)(WT + (size_t)(n0 + n) * K + k0 + 8 * c) = (u32x2t){(unsigned)lo, (unsigned)hi}; }
    LDS_WAIT(); asm volatile("" ::: "memory");
}
DI void tr_load_v4(const float* W, int ldw, int k0, int n0, int lane, f32x4 (&v)[8]) {
#pragma unroll
    for (int i = 0; i < 8; ++i) v[i] = *(const f32x4*)(W + (size_t)(k0 + 8 * i + (lane >> 3)) * ldw + n0 + 4 * (lane & 7));
}
DI void tr_put_v4(const f32x4 (&v)[8], LAS float* scr, int lane, float mul) {
#pragma unroll
    for (int i = 0; i < 8; ++i) { LAS float* d = scr + (8 * i + (lane >> 3)) * 33 + 4 * (lane & 7); d[0] = v[i].x * mul; d[1] = v[i].y * mul; d[2] = v[i].z * mul; d[3] = v[i].w * mul; }
    LDS_WAIT(); asm volatile("" ::: "memory");
}
DI void tr_fill_v4(const float* W, int ldw, int k0, int n0, LAS float* scr, int lane, float mul) { f32x4 v[8]; tr_load_v4(W, ldw, k0, n0, lane, v); tr_put_v4(v, scr, lane, mul); }
DI void tr_emit_bf16(bf16* WT, int K, int k0, int n0, LAS float* scr, int lane) {
    const int c = lane & 7;
#pragma unroll
    for (int j = 0; j < 4; ++j) { const int n = (lane >> 3) + 8 * j; const LAS float* sp = scr + (8 * c) * 33 + n;
        v4u o; o.x = pk2(sp[0 * 33], sp[1 * 33]); o.y = pk2(sp[2 * 33], sp[3 * 33]); o.z = pk2(sp[4 * 33], sp[5 * 33]); o.w = pk2(sp[6 * 33], sp[7 * 33]);
        *(v4u*)(WT + (size_t)(n0 + n) * K + k0 + 8 * c) = o; }
    LDS_WAIT(); asm volatile("" ::: "memory");
}
DI void tr_emit_f8(unsigned char* WT, int K, int k0, int n0, LAS float* scr, int lane) {
    const int c = lane & 7;
#pragma unroll
    for (int j = 0; j < 4; ++j) { const int n = (lane >> 3) + 8 * j; const LAS float* sp = scr + (8 * c) * 33 + n;
        int lo = 0, hi = 0;
        lo = __builtin_amdgcn_cvt_pk_fp8_f32(sp[0 * 33], sp[1 * 33], lo, false); lo = __builtin_amdgcn_cvt_pk_fp8_f32(sp[2 * 33], sp[3 * 33], lo, true);
        hi = __builtin_amdgcn_cvt_pk_fp8_f32(sp[4 * 33], sp[5 * 33], hi, false); hi = __builtin_amdgcn_cvt_pk_fp8_f32(sp[6 * 33], sp[7 * 33], hi, true);
        typedef unsigned u32x2t __attribute__((ext_vector_type(2)));
        *(u32x2t*)(WT + (size_t)(n0 + n) * K + k0 + 8 * c) = (u32x2t){(unsigned)lo, (unsigned)hi}; }
    LDS_WAIT(); asm volatile("" ::: "memory");
}
template <class CM>
DI void tr_fill_cm(const float* W, int ldw, int k0, int n0, CM cm, LAS float* scr, int lane, float mul) {
    const int sc = cm(n0 + (lane & 31));
#pragma unroll 8
    for (int i = 0; i < 32; ++i) { const int kk = 2 * i + (lane >> 5); scr[kk * 33 + (lane & 31)] = sc >= 0 ? W[(size_t)(k0 + kk) * ldw + sc] * mul : 0.f; }
    LDS_WAIT(); asm volatile("" ::: "memory");
}
struct CmId { DI int operator()(int j) const { return j; } };
struct CmProj { DI int operator()(int j) const { return proj_srccol(j); } };

DI void rms_row_bf16(const float* xrow, const float* g, bf16* orow, int lane) {
    const f32x4* xr = (const f32x4*)xrow + lane; const f32x4* gr = (const f32x4*)g + lane;
    f32x4 v[4]; float s = 0.f;
#pragma unroll
    for (int j = 0; j < 4; ++j) { v[j] = xr[64 * j]; s += (v[j].x * v[j].x + v[j].y * v[j].y) + (v[j].z * v[j].z + v[j].w * v[j].w); }
    const float rstd = rsqrtf(wave_sum(s) * (1.f / DM) + EPS);
    unsigned long long* o8 = (unsigned long long*)orow + lane;
#pragma unroll
    for (int j = 0; j < 4; ++j) { const f32x4 gg = gr[64 * j];
        o8[64 * j] = (unsigned long long)pk2(v[j].x * rstd * gg.x, v[j].y * rstd * gg.y) | ((unsigned long long)pk2(v[j].z * rstd * gg.z, v[j].w * rstd * gg.w) << 32); }
}

DI void rms_row_f8(const float* xrow, const float* g, unsigned char* orow, int lane) {
    const f32x4* xr = (const f32x4*)xrow + lane; const f32x4* gr = (const f32x4*)g + lane;
    f32x4 v[4]; float s = 0.f;
#pragma unroll
    for (int j = 0; j < 4; ++j) { v[j] = xr[64 * j]; s += (v[j].x * v[j].x + v[j].y * v[j].y) + (v[j].z * v[j].z + v[j].w * v[j].w); }
    const float rstd = rsqrtf(wave_sum(s) * (1.f / DM) + EPS);
    unsigned* o4 = (unsigned*)orow + lane;
#pragma unroll
    for (int j = 0; j < 4; ++j) { const f32x4 gg = gr[64 * j]; int q8 = 0;
        q8 = __builtin_amdgcn_cvt_pk_fp8_f32(v[j].x * rstd * gg.x, v[j].y * rstd * gg.y, q8, false); q8 = __builtin_amdgcn_cvt_pk_fp8_f32(v[j].z * rstd * gg.z, v[j].w * rstd * gg.w, q8, true);
        o4[64 * j] = (unsigned)q8; }
}
template <int NR>
DI void rms_rows_both(const float* x0, const float* g, bf16* o0, unsigned char* o80, size_t step, int lane) {
    const f32x4* gr = (const f32x4*)g + lane;
    f32x4 v[NR][4];
#pragma unroll
    for (int q = 0; q < NR; ++q) { const f32x4* xr = (const f32x4*)(x0 + q * step * DM) + lane;
#pragma unroll
        for (int j = 0; j < 4; ++j) v[q][j] = xr[64 * j]; }
#pragma unroll
    for (int q = 0; q < NR; ++q) { float s = 0.f;
#pragma unroll
        for (int j = 0; j < 4; ++j) s += (v[q][j].x * v[q][j].x + v[q][j].y * v[q][j].y) + (v[q][j].z * v[q][j].z + v[q][j].w * v[q][j].w);
        const float rstd = rsqrtf(wave_sum(s) * (1.f / DM) + EPS);
        unsigned long long* o8 = (unsigned long long*)(o0 + q * step * DM) + lane; unsigned* o4 = (unsigned*)(o80 + q * step * DM) + lane;
#pragma unroll
        for (int j = 0; j < 4; ++j) { const f32x4 gg = gr[64 * j]; const float y0 = v[q][j].x * rstd * gg.x, y1 = v[q][j].y * rstd * gg.y, y2 = v[q][j].z * rstd * gg.z, y3 = v[q][j].w * rstd * gg.w;
            o8[64 * j] = (unsigned long long)pk2(y0, y1) | ((unsigned long long)pk2(y2, y3) << 32);
            int q8 = 0; q8 = __builtin_amdgcn_cvt_pk_fp8_f32(y0, y1, q8, false); q8 = __builtin_amdgcn_cvt_pk_fp8_f32(y2, y3, q8, true);
            o4[64 * j] = (unsigned)q8; } }
}
DI void p0_prologue(Frame& F) {
    LAS float* scr = (LAS float*)(F.lds + F.wave * 16384);
    const int gw = F.bx * NWAVES + F.wave, NGW = F.G * NWAVES;
    unsigned char* ws = F.ws;
    constexpr int IT_IN = 16 * (NPROJ / 32), IT_GU = 32 * 16 * 64, IT_DN = 32 * 16 * 32, IT_MKV = 16 * 32, IT_BR = 3 * 8 * 32, IT_OUT = 16 * 32, IT_C1 = 2 * 32 * 8;
    constexpr int NITEMS = IT_IN + IT_GU + IT_DN + IT_MKV + IT_BR + IT_OUT + IT_C1;
    {
        struct D { const float* src; unsigned char* dst; int ldw, k0, n0; };
        auto dec = [&](int j) { D d; if (j < IT_GU) { const int e = j / 1024, q = j % 1024; d.src = F.in[I_WGU] + (size_t)e * DM * 2048; d.dst = (unsigned char*)(ws + WS_WGU) + (size_t)e * 2048 * DM; d.ldw = 2048; d.k0 = 64 * (q / 64); d.n0 = 32 * (q % 64); }
                                     else { const int jj = j - IT_GU, e = jj / 512, q = jj % 512; d.src = F.in[I_WDN] + (size_t)e * DFF * DM; d.dst = (unsigned char*)(ws + WS_WDN) + (size_t)e * DM * DFF; d.ldw = DM; d.k0 = 64 * (q / 32); d.n0 = 32 * (q % 32); } return d; };
        const int lane = F.lane_id();
        int j = gw; f32x4 va[8]; D da{};
        if (j < IT_GU + IT_DN) { da = dec(j); tr_load_v4(da.src, da.ldw, da.k0, da.n0, lane, va); }
#pragma unroll 1
        while (j < IT_GU + IT_DN) {
            const int jn = j + NGW; f32x4 vb[8]; D db{};
            if (jn < IT_GU + IT_DN) { db = dec(jn); tr_load_v4(db.src, db.ldw, db.k0, db.n0, lane, vb); }
            else {
#pragma unroll
                for (int i = 0; i < 8; ++i) vb[i] = va[i]; }
            tr_put_v4(va, scr, lane, 256.0f); tr_emit_f8(da.dst, 1024, da.k0, da.n0, scr, lane);
#pragma unroll
            for (int i = 0; i < 8; ++i) va[i] = vb[i];
            da = db; j = jn;
        }
    }
    for (int it = gw; it < NITEMS; it += NGW) {
        int r = it;
        if (r < IT_IN) { const int kb = r / (NPROJ / 32), nb = r % (NPROJ / 32); if (32 * nb < NB16) { tr_fill_cm(F.in[I_WIN], DIN_SRC, 64 * kb, 32 * nb, CmProj(), scr, F.lane_id(), 1.0f); tr_emit_bf16((bf16*)(ws + WS_WIN), DM, 64 * kb, 32 * nb, scr, F.lane_id()); }
            else { tr_fill_cm(F.in[I_WIN], DIN_SRC, 64 * kb, 32 * nb, CmProj(), scr, F.lane_id(), 256.0f); tr_emit_f8((unsigned char*)(ws + WS_WIN8), DM, 64 * kb, 32 * nb - NB16, scr, F.lane_id()); }
            continue; } r -= IT_IN;
        if (r < IT_GU + IT_DN) continue; r -= IT_GU + IT_DN;
        if (r < IT_MKV) { const int kb = r / 32, nb = r % 32; tr_fill_v4(F.in[I_WMKV], 1024, 64 * kb, 32 * nb, scr, F.lane_id(), 1.0f); tr_emit_bf16((bf16*)(ws + WS_WMKV), 1024, 64 * kb, 32 * nb, scr, F.lane_id()); continue; } r -= IT_MKV;
        if (r < IT_BR) { const int b = r / 256, q = r % 256, kb = q / 32, nb = q % 32; tr_fill_v4(F.in[I_WBRML + b], 1024, 64 * kb, 32 * nb, scr, F.lane_id(), 1.0f); tr_emit_bf16((bf16*)(ws + WS_WBR), 1536, 512 * b + 64 * kb, 32 * nb, scr, F.lane_id()); continue; } r -= IT_BR;
        if (r < IT_OUT) { const int kb = r / 32, nb = r % 32; tr_fill_v4(F.in[I_WOUT], 1024, 64 * kb, 32 * nb, scr, F.lane_id(), 1.0f); tr_emit_bf16((bf16*)(ws + WS_WOUT), 1024, 64 * kb, 32 * nb, scr, F.lane_id()); continue; } r -= IT_OUT;
        { const int kv = r / 256, q = r % 256, kb = q / 8, nb = q % 8; tr_fill_v4(F.in[kv ? I_CW1V : I_CW1K], 256, 64 * kb, 32 * nb, scr, F.lane_id(), 1.0f); tr_emit_bf16((bf16*)(ws + WS_WC1) + (size_t)kv * 256 * 2048, 2048, 64 * kb, 32 * nb, scr, F.lane_id()); }
    }
    { int m = gw;
      for (; m + 3 * NGW < MT; m += 4 * NGW) rms_rows_both<4>(F.in[I_X] + (size_t)m * DM, F.in[I_GMIX], (bf16*)(ws + WS_R1) + (size_t)m * DM, (unsigned char*)(ws + WS_U8) + (size_t)m * DM, (size_t)NGW, F.lane_id());
      for (; m < MT; m += NGW) rms_rows_both<1>(F.in[I_X] + (size_t)m * DM, F.in[I_GMIX], (bf16*)(ws + WS_R1) + (size_t)m * DM, (unsigned char*)(ws + WS_U8) + (size_t)m * DM, (size_t)NGW, F.lane_id()); }
    for (int m = gw; m < MROWS; m += NGW) rms_row_bf16(F.in[I_MEM] + (size_t)m * DM, F.in[I_GMEM], (bf16*)(ws + WS_MEMN) + (size_t)m * DM, F.lane_id());
    float* rc = (float*)(ws + WS_SMALL + SM_ROPEC); float* rs = (float*)(ws + WS_SMALL + SM_ROPES);
    for (int i = F.bx * 512 + F.tid_id(); i < SEQ * 32; i += F.G * 512) {
        const int p = i >> 5, k = i & 31;
        const float invf = exp2f(-(float)k * (13.287712379549449f / 32.0f));
        const float ang = (float)p * invf;
        const float kf = rintf(ang * 0.15915494309189535f);
        float r = fmaf(-kf, 6.28125f, ang); r = fmaf(-kf, 1.9353071795864769e-3f, r);
        rc[i] = cosf(r); rs[i] = sinf(r);
    }
    { bf16* wrt = (bf16*)(ws + WS_SMALL + SM_WRT);
      for (int i = F.bx * 512 + F.tid_id(); i < 32 * 1024; i += F.G * 512) { const int e = i >> 10, k = i & 1023; const float w = F.in[I_WR][k * 32 + e]; const unsigned hi = f2bf(w); wrt[i] = (bf16)hi; wrt[32 * 1024 + i] = (bf16)f2bf(w - __uint_as_float(hi << 16)); } }
    { bf16* w2t = (bf16*)(ws + WS_SMALL + SM_W2T);
      for (int i = F.bx * 512 + F.tid_id(); i < 2 * 64 * 256; i += F.G * 512) { const int kv = i >> 14, d = (i >> 8) & 63, f = i & 255; w2t[i] = (bf16)f2bf(F.in[kv ? I_CW2V : I_CW2K][f * 64 + d]); } }
    if (F.bx == F.G - 1) {
        const int kv = F.tid_id() >> 8, f = F.tid_id() & 255;
        const float* pe = F.in[kv ? I_CPV : I_CPK]; const float* w1 = F.in[kv ? I_CW1V : I_CW1K];
        float a = F.in[kv ? I_CB1V : I_CB1K][f];
        for (int k = 0; k < 2048; ++k) a = fmaf(pe[k], w1[(size_t)k * 256 + f], a);
        ((float*)(ws + WS_SMALL + SM_CBIAS))[kv * 256 + f] = a;
    }
}

DI void unpack8(const v4u& w, float (&f)[8]) {
    f[0] = __uint_as_float(w.x << 16); f[1] = __uint_as_float(w.x & 0xffff0000u); f[2] = __uint_as_float(w.y << 16); f[3] = __uint_as_float(w.y & 0xffff0000u);
    f[4] = __uint_as_float(w.z << 16); f[5] = __uint_as_float(w.z & 0xffff0000u); f[6] = __uint_as_float(w.w << 16); f[7] = __uint_as_float(w.w & 0xffff0000u);
}
DI v4u pack8f(const float (&f)[8]) { v4u o; o.x = pk2(f[0], f[1]); o.y = pk2(f[2], f[3]); o.z = pk2(f[4], f[5]); o.w = pk2(f[6], f[7]); return o; }
DI void load8f(const float* p, float (&f)[8]) { const f32x4 a = *(const f32x4*)p, b = *(const f32x4*)(p + 4); f[0] = a.x; f[1] = a.y; f[2] = a.z; f[3] = a.w; f[4] = b.x; f[5] = b.y; f[6] = b.z; f[7] = b.w; }
DI void norm_rope64(float (&f)[8], const float (&g)[8], const float (&c8)[8], const float (&s8)[8], int lane, float scale) {
    float ss = 0.f;
#pragma unroll
    for (int i = 0; i < 8; ++i) ss = fmaf(f[i], f[i], ss);
    ss += __shfl_xor(ss, 1); ss += __shfl_xor(ss, 2); ss += __shfl_xor(ss, 4);
    const float rstd = rsqrtf(ss * (1.f / 64.f) + EPS);
    const bool hi = (lane & 4) != 0;
#pragma unroll
    for (int i = 0; i < 8; ++i) { const float y = f[i] * rstd * g[i]; const float pt = __shfl_xor(y, 4); f[i] = (hi ? fmaf(pt, s8[i], y * c8[i]) : fmaf(-pt, s8[i], y * c8[i])) * scale; }
}
DI void p2_prep(Frame& F) {
    unsigned char* ws = F.ws;
    const int ncg = F.G >= 64 ? 32 : 0;
    if (F.bx < ncg) return;
    const int gw = (F.bx - ncg) * NWAVES + F.wave, NGW = (F.G - ncg) * NWAVES, lane = F.lane_id();
    const bf16* proj = (const bf16*)(ws + WS_PROJ);
    const float* rc = (const float*)(ws + WS_SMALL + SM_ROPEC); const float* rs = (const float*)(ws + WS_SMALL + SM_ROPES);
    bf16* qn = (bf16*)(ws + WS_QN); bf16* ksn = (bf16*)(ws + WS_KSN); bf16* kwn = (bf16*)(ws + WS_KWN); bf16* mqn = (bf16*)(ws + WS_MQN); bf16* mlqk = (bf16*)(ws + WS_MLQK);
    constexpr int NT = 4;
    {
        float gq8[8], mg8[8]; load8f(F.in[I_NGQ] + 8 * (lane & 7), gq8); load8f(F.in[I_MGQ] + 8 * (lane & 15), mg8);
        for (int t0 = gw * NT; t0 < MT; t0 += NGW * NT) {
            v4u a[NT], bq[NT], cv[NT]; float c8[NT][8], s8[NT][8];
#pragma unroll
            for (int u = 0; u < NT; ++u) { const int t = t0 + u, tau = t & 2047; const bf16* pr = proj + (size_t)t * NPROJ;
                a[u] = *(const v4u*)(pr + PC_NQ + 8 * lane); bq[u] = *(const v4u*)(pr + PC_MQ + 8 * lane); cv[u] = *(const v4u*)(pr + PC_MLV + 8 * lane);
                load8f(rc + tau * 32 + 8 * (lane & 3), c8[u]); load8f(rs + tau * 32 + 8 * (lane & 3), s8[u]); }
#pragma unroll
            for (int u = 0; u < NT; ++u) { const int t = t0 + u;
                float f[8]; unpack8(a[u], f);
                norm_rope64(f, gq8, c8[u], s8[u], lane, 0.125f * 1.4426950408889634f);
                *(v4u*)(qn + (size_t)t * 512 + 8 * lane) = pack8f(f);
                unpack8(bq[u], f);
                float ss = 0.f;
#pragma unroll
                for (int i = 0; i < 8; ++i) ss = fmaf(f[i], f[i], ss);
                ss += __shfl_xor(ss, 1); ss += __shfl_xor(ss, 2); ss += __shfl_xor(ss, 4); ss += __shfl_xor(ss, 8);
                const float rstd = rsqrtf(ss * (1.f / 128.f) + EPS) * (0.08838834764831845f * 1.4426950408889634f);
#pragma unroll
                for (int i = 0; i < 8; ++i) f[i] *= rstd * mg8[i];
                *(v4u*)(mqn + (size_t)t * 512 + 8 * lane) = pack8f(f);
                *(v4u*)((bf16*)(ws + WS_MLV) + (size_t)t * 512 + 8 * lane) = cv[u]; }
        }
    }
    {
        const int L = lane & 31, hd4 = L >> 3, j = L & 7, half = lane >> 5;
        float gk8[8]; load8f(F.in[I_NGK] + (1 + (hd4 >> 1)) * 64 + 8 * j, gk8);
        const int kcol = (hd4 < 2 ? PC_NKS + hd4 * 64 : PC_NKW + (hd4 - 2) * 64) + 8 * j;
        bf16* kdst = (hd4 < 2 ? ksn : kwn) + (hd4 & 1) * 64 + 8 * j;
        const int wv = L >> 4, jj = L & 15;
        bf16* vdst = (bf16*)(ws + (wv ? WS_VWN : WS_VSN)) + 8 * jj; const int vcol = (wv ? PC_NVW : PC_NVS) + 8 * jj;
        for (int tp0 = gw * NT; tp0 < MT / 2; tp0 += NGW * NT) {
            v4u a[NT], vv[NT]; float c8[NT][8], s8[NT][8];
#pragma unroll
            for (int u = 0; u < NT; ++u) { const int t = 2 * (tp0 + u) + half, tau = t & 2047; const bf16* pr = proj + (size_t)t * NPROJ;
                a[u] = *(const v4u*)(pr + kcol); vv[u] = *(const v4u*)(pr + vcol);
                load8f(rc + tau * 32 + 8 * (lane & 3), c8[u]); load8f(rs + tau * 32 + 8 * (lane & 3), s8[u]); }
#pragma unroll
            for (int u = 0; u < NT; ++u) { const int t = 2 * (tp0 + u) + half;
                float f[8]; unpack8(a[u], f);
                norm_rope64(f, gk8, c8[u], s8[u], lane, 1.0f);
                *(v4u*)(kdst + (size_t)t * 128) = pack8f(f);
                *(v4u*)(vdst + (size_t)t * 128) = vv[u]; }
        }
    }
    for (int run = gw; run < MT / 16; run += NGW) {
        const int t0 = run * 16, tau0 = t0 & 2047;
#pragma unroll 1
        for (int sp = 0; sp < 2; ++sp) {
            const int ch = 512 * sp + 8 * lane;
            float w0[8], w1[8], w2[8], w3[8], bb[8];
            load8f(F.in[I_CONVW] + ch, w0); load8f(F.in[I_CONVW] + 1024 + ch, w1); load8f(F.in[I_CONVW] + 2048 + ch, w2); load8f(F.in[I_CONVW] + 3072 + ch, w3); load8f(F.in[I_CONVB] + ch, bb);
            float x0[8], x1[8], x2[8];
            if (tau0 >= 3) { unpack8(*(const v4u*)(proj + (size_t)(t0 - 3) * NPROJ + ch), x0); unpack8(*(const v4u*)(proj + (size_t)(t0 - 2) * NPROJ + ch), x1); unpack8(*(const v4u*)(proj + (size_t)(t0 - 1) * NPROJ + ch), x2); }
            else {
#pragma unroll
                for (int i = 0; i < 8; ++i) { x0[i] = 0.f; x1[i] = 0.f; x2[i] = 0.f; } }
#pragma unroll 1
            for (int k0 = 0; k0 < 16; k0 += 4) {
                v4u raw[4];
#pragma unroll
                for (int k = 0; k < 4; ++k) raw[k] = *(const v4u*)(proj + (size_t)(t0 + k0 + k) * NPROJ + ch);
#pragma unroll
                for (int k = 0; k < 4; ++k) { float x3[8], y[8]; unpack8(raw[k], x3);
#pragma unroll
                    for (int i = 0; i < 8; ++i) { const float a = fmaf(w3[i], x3[i], fmaf(w2[i], x2[i], fmaf(w1[i], x1[i], fmaf(w0[i], x0[i], bb[i])))); y[i] = a * sigm(a); x0[i] = x1[i]; x1[i] = x2[i]; x2[i] = x3[i]; }
                    *(v4u*)(mlqk + (size_t)(t0 + k0 + k) * 1024 + ch) = pack8f(y); }
            }
        }
    }
    {
        const bf16* memkv = (const bf16*)(ws + WS_MEMKV); bf16* memkn = (bf16*)(ws + WS_MEMKN);
        float kg8[8]; load8f(F.in[I_MGK] + 8 * (lane & 15), kg8);
        for (int r = gw; r < MROWS; r += NGW) {
            float f[8]; unpack8(*(const v4u*)(memkv + (size_t)r * 1024 + 8 * lane), f);
            float ss = 0.f;
#pragma unroll
            for (int i = 0; i < 8; ++i) ss = fmaf(f[i], f[i], ss);
            ss += __shfl_xor(ss, 1); ss += __shfl_xor(ss, 2); ss += __shfl_xor(ss, 4); ss += __shfl_xor(ss, 8);
            const float rstd = rsqrtf(ss * (1.f / 128.f) + EPS);
#pragma unroll
            for (int i = 0; i < 8; ++i) f[i] *= rstd * kg8[i];
            *(v4u*)(memkn + (size_t)r * 512 + 8 * lane) = pack8f(f);
        }
    }
}

DI void p4_kcvc(Frame& F) {
    unsigned char* ws = F.ws;
    const int gw = F.bx * NWAVES + F.wave, NGW = F.G * NWAVES, lane = F.lane_id();
    const bf16* hid = (const bf16*)(ws + WS_HID);
    const float* rc = (const float*)(ws + WS_SMALL + SM_ROPEC); const float* rs = (const float*)(ws + WS_SMALL + SM_ROPES);
    const float gk = F.in[I_NGK][lane];
    for (int it = gw; it < 2 * 4096; it += NGW) {
        const int kv = it >> 12, r = it & 4095, n = r & 127;
        bf16* dst = (bf16*)(ws + (kv ? WS_VC : WS_KC)) + (size_t)r * 64 + lane;
        if (n == 127) { *dst = 0; continue; }
        const bf16* hr = hid + (size_t)kv * 4096 * 256 + (size_t)r * 256; const float* w2 = F.in[kv ? I_CW2V : I_CW2K];
        float a = 0.f;
        for (int f = 0; f < 256; ++f) a = fmaf(bf2f(hr[f]), w2[f * 64 + lane], a);
        if (kv == 0) {
            const float y = a * rsqrtf(wave_sum(a * a) * (1.f / 64.f) + EPS) * gk;
            const int pos = 16 * n + 31; const float c = rc[pos * 32 + (lane & 31)], s = rs[pos * 32 + (lane & 31)];
            const float pt = __shfl_xor(y, 32);
            a = lane < 32 ? y * c - pt * s : y * c + pt * s;
        }
        *dst = (bf16)f2bf(a);
    }
}

typedef float f32x16 __attribute__((ext_vector_type(16)));
typedef float f32x2v __attribute__((ext_vector_type(2)));
typedef __bf16 bf16x2v __attribute__((ext_vector_type(2)));
typedef short s16x4 __attribute__((ext_vector_type(4)));
typedef unsigned u32x2 __attribute__((ext_vector_type(2)));
#define MFMA32(a, b, c) __builtin_amdgcn_mfma_f32_32x32x16_bf16((a), (b), (c), 0, 0, 0)
#define WG_BAR() do { asm volatile("s_waitcnt vmcnt(0) lgkmcnt(0)" ::: "memory"); __builtin_amdgcn_s_barrier(); asm volatile("" ::: "memory"); } while (0)
DI unsigned pkbf(float lo, float hi) { f32x2v v = {lo, hi}; return __builtin_bit_cast(unsigned, __builtin_convertvector(v, bf16x2v)); }
template <int S> DI bf16x8 pack8(const f32x16& x) {
    v4u p; p.x = pkbf(x[8 * S], x[8 * S + 1]); p.y = pkbf(x[8 * S + 2], x[8 * S + 3]); p.z = pkbf(x[8 * S + 4], x[8 * S + 5]); p.w = pkbf(x[8 * S + 6], x[8 * S + 7]);
    return __builtin_bit_cast(bf16x8, p);
}
DI int crow(int i, int h) { return (i & 3) + 8 * (i >> 2) + 4 * h; }
constexpr int AT_K = 0, AT_V = 32768, AT_IMP = 65536, AT_WM = 98304, AT_INV = 98368, AT_SC = 99392;

DI void glds16(const void* gsrc, unsigned lds_dst) { unsigned keep; asm volatile("s_mov_b32 %0, m0\n\ts_mov_b32 m0, %2\n\ts_nop 0\n\tglobal_load_lds_dwordx4 %1, off\n\ts_mov_b32 m0, %0" : "=&s"(keep) : "v"(gsrc), "s"(lds_dst) : "memory"); }
DI void at_load(LAS unsigned char* lds, int par, const void* kb, size_t kpitch, const void* vb, size_t vpitch, int wave, int lane) {
    const int row = 8 * wave + (lane >> 3), pc = lane & 7;
    const int kc = pc ^ ((row >> 1) & 7), vc = pc ^ (((row >> 1) & 1) << 2);
    glds16((const char*)kb + (size_t)row * kpitch + 16 * kc, (unsigned)(size_t)(lds + AT_K + par * 8192 + wave * 1024));
    glds16((const char*)vb + (size_t)row * vpitch + 16 * vc, (unsigned)(size_t)(lds + AT_V + par * 8192 + wave * 1024));
}
#define SB() __builtin_amdgcn_sched_barrier(0)
typedef __attribute__((address_space(3))) s16x4 lds_s16x4;
DI void at_qk(const LAS unsigned char* kbuf, const int (&ka)[4], const bf16x8 (&qf)[4], f32x16 (&s)[2]) {
    bf16x8 kf[2][4];
#pragma unroll
    for (int kb = 0; kb < 2; ++kb)
#pragma unroll
        for (int st = 0; st < 4; ++st) kf[kb][st] = *(const LAS bf16x8*)(kbuf + ka[st] + kb * 4096);
    SB();
#pragma unroll
    for (int kb = 0; kb < 2; ++kb) {
        f32x16 a;
#pragma unroll
        for (int i = 0; i < 16; ++i) a[i] = 0.f;
#pragma unroll
        for (int st = 0; st < 4; ++st) a = MFMA32(kf[kb][st], qf[st], a);
        s[kb] = a;
    }
}
DI void at_vload(const LAS unsigned char* vbuf, const int (&va)[2], int kb, bf16x8 (&vf)[2][2]) {
#pragma unroll
    for (int s2 = 0; s2 < 2; ++s2)
#pragma unroll
        for (int db = 0; db < 2; ++db) {
            const s16x4 lo = __builtin_amdgcn_ds_read_tr16_b64_v4i16((lds_s16x4*)(vbuf + va[db] + kb * 4096 + s2 * 2048));
            const s16x4 hi = __builtin_amdgcn_ds_read_tr16_b64_v4i16((lds_s16x4*)(vbuf + va[db] + kb * 4096 + s2 * 2048 + 1024));
            vf[s2][db] = __builtin_shufflevector(lo, hi, 0, 1, 2, 3, 4, 5, 6, 7); }
}
DI void at_pv1(const bf16x8 (&vf)[2][2], const f32x16& p, f32x16 (&o)[2]) {
    const bf16x8 pf0 = pack8<0>(p), pf1 = pack8<1>(p);
#pragma unroll
    for (int s2 = 0; s2 < 2; ++s2)
#pragma unroll
        for (int db = 0; db < 2; ++db) o[db] = MFMA32(vf[s2][db], s2 ? pf1 : pf0, o[db]);
}
DI void at_pv(const LAS unsigned char* vbuf, const int (&va)[2], const bf16x8 (&vf0)[2][2], const f32x16 (&p)[2], f32x16 (&o)[2]) {
    bf16x8 vf1[2][2]; at_vload(vbuf, va, 1, vf1);
    at_pv1(vf0, p[0], o);
    at_pv1(vf1, p[1], o);
}
DI void at_exp_all(f32x16 (&s)[2], float& l) {
#pragma unroll
    for (int kb = 0; kb < 2; ++kb)
#pragma unroll
        for (int i = 0; i < 16; ++i) { const float p = __builtin_amdgcn_exp2f(s[kb][i]); s[kb][i] = p; l += p; }
}
DI void at_wait(int n) {
    if (n >= 2) asm volatile("s_waitcnt vmcnt(4)" ::: "memory"); else if (n == 1) asm volatile("s_waitcnt vmcnt(2)" ::: "memory"); else asm volatile("s_waitcnt vmcnt(0)" ::: "memory");
    asm volatile("s_waitcnt lgkmcnt(0)" ::: "memory"); __builtin_amdgcn_s_barrier(); asm volatile("" ::: "memory");
}
template <bool STORE = true, bool DO_CMP = true, bool DO_SEL = true, bool DO_WIN = true>
DI void nsa_unit(Frame& F, int unit) {
    unsigned char* ws = F.ws; LAS unsigned char* lds = F.lds;
    int lane_ = F.lane_id();
    const int lane = lane_, wave = F.wave, r = lane & 31, h = lane >> 5, g = wave >> 1, qh = wave & 1;
    const int bh = unit & 31, qt = 31 - (unit >> 5), b = bh >> 1, hkv = bh & 1;
    const int qloc = 32 * qh + r, tau = 64 * qt + qloc, qq = tau & 63; const size_t t = (size_t)b * SEQ + tau;
    const bf16* proj = (const bf16*)(ws + WS_PROJ);
    const bf16* qn = (const bf16*)(ws + WS_QN); const bf16* ksn = (const bf16*)(ws + WS_KSN); const bf16* kwn = (const bf16*)(ws + WS_KWN);
    const bf16* kc = (const bf16*)(ws + WS_KC); const bf16* vc = (const bf16*)(ws + WS_VC); bf16* H1 = (bf16*)(ws + WS_H0);
    int ka[4], va[2];
    { const int f = (r >> 1) & 7, fs = f >> 1, hb = h ^ (f & 1);
#pragma unroll
      for (int st = 0; st < 4; ++st) ka[st] = r * 128 + 16 * (((st ^ fs) << 1) | hb);
      const int i16 = lane & 15, q = i16 >> 2, p = i16 & 3, g1 = (lane >> 4) & 1;
#pragma unroll
      for (int db = 0; db < 2; ++db) va[db] = (4 * h + q) * 128 + 16 * ((4 * db + 2 * g1 + (p >> 1)) ^ (((q >> 1) & 1) << 2)) + 8 * (p & 1); }
    bf16x8 qf[4];
#pragma unroll
    for (int st = 0; st < 4; ++st) qf[st] = *(const bf16x8*)(qn + t * 512 + (hkv * 4 + g) * 64 + 16 * st + 8 * h);
    float gate[3];
#pragma unroll
    for (int c = 0; c < 3; ++c) gate[c] = sigm(bf2f(proj[t * NPROJ + PC_NG + (hkv * 4 + g) * 3 + c]));
    f32x16 ofin[2];
#pragma unroll
    for (int i = 0; i < 16; ++i) { ofin[0][i] = 0.f; ofin[1][i] = 0.f; }
    WG_BAR();
    if (DO_CMP) {
        const int ncq = tau >= 31 ? ((tau - 31) >> 4) + 1 : 0;
        const int ntc = (((64 * qt + 63 - 31) >> 4) + 1 > 64) ? 2 : 1;
        const char* kb0 = (const char*)(kc + (size_t)(b * 2 + hkv) * 128 * 64); const char* vb0 = (const char*)(vc + (size_t)(b * 2 + hkv) * 128 * 64);
        at_load(lds, 0, kb0, 128, vb0, 128, wave, lane);
        if (ntc == 2) at_load(lds, 1, kb0 + 64 * 128, 128, vb0 + 64 * 128, 128, wave, lane);
        WG_BAR();
        f32x16 o[2]; float l = 0.f, prevEp = 0.f;
#pragma unroll
        for (int i = 0; i < 16; ++i) { o[0][i] = 0.f; o[1][i] = 0.f; }
        LAS float* I = (LAS float*)(lds + AT_IMP) + (g * 64 + qloc) * 32;
#pragma unroll 1
        for (int tile = 0; tile < 2; ++tile) {
            if (tile < ntc) {
                f32x16 s[2];
                at_qk(lds + AT_K + tile * 8192, ka, qf, s);
                bf16x8 vf[2][2]; at_vload(lds + AT_V + tile * 8192, va, 0, vf); SB();
#pragma unroll
                for (int kb = 0; kb < 2; ++kb)
#pragma unroll
                    for (int i = 0; i < 16; ++i) { const int n = 64 * tile + 32 * kb + crow(i, h); const float p = n < ncq ? __builtin_amdgcn_exp2f(s[kb][i]) : 0.f; s[kb][i] = p; l += p; }
#pragma unroll
                for (int kb = 0; kb < 2; ++kb)
#pragma unroll
                    for (int a = 0; a < 4; ++a) { const int idx = tile * 8 + kb * 4 + a; const float Gv = (s[kb][4 * a] + s[kb][4 * a + 1]) + (s[kb][4 * a + 2] + s[kb][4 * a + 3]);
                        const float Epv = __shfl_xor(s[kb][4 * a + 3], 32);
                        I[2 * idx + h] = Gv + (h ? Epv : prevEp); prevEp = Epv; }
                at_pv(lds + AT_V + tile * 8192, va, vf, s, o);
            } else {
#pragma unroll
                for (int idx = 8; idx < 16; ++idx) I[2 * idx + h] = 0.f;
            }
        }
        const float L = l + __shfl_xor(l, 32); const float inv = L > 0.f ? 1.f / L : 0.f;
        const float gi = gate[0] * inv;
#pragma unroll
        for (int i = 0; i < 16; ++i) { ofin[0][i] += gi * o[0][i]; ofin[1][i] += gi * o[1][i]; }
        if (h == 0) ((LAS float*)(lds + AT_INV))[g * 64 + qloc] = inv;
    }
    WG_BAR();
    unsigned sel = 0u, wm = 0u, um = 0u;
    if (!DO_CMP) { sel = (qt == 31) ? 0xffffffffu : ((1u << (qt + 1)) - 1u); wm = sel; um = sel; }
    else {
        const LAS float* I = (const LAS float*)(lds + AT_IMP) + qloc * 32;
        const LAS float* IV = (const LAS float*)(lds + AT_INV) + qloc;
        const float iv0 = IV[0], iv1 = IV[64], iv2 = IV[128], iv3 = IV[192];
        LAS unsigned* SC = (LAS unsigned*)(lds + AT_SC) + (qh * 32 + r) * 33;
        if (g == 0 && h == 0) {
#pragma unroll 8
            for (int j = 0; j < 32; ++j) { const float imp = (I[j] * iv0 + I[64 * 32 + j] * iv1) + (I[2 * 64 * 32 + j] * iv2 + I[3 * 64 * 32 + j] * iv3);
                const bool cand = (j >= 1) && (j <= qt - 2);
                SC[j] = cand ? ((__float_as_uint(imp) & ~31u) | (unsigned)(31 - j)) + 32u : 0u; }
        }
        WG_BAR();
        if (qt <= 7) sel = (1u << (qt + 1)) - 1u;
        else {
            sel = 1u | (1u << qt) | (1u << (qt - 1));
            unsigned prev = 0xffffffffu;
#pragma unroll 1
            for (int rd = 0; rd < 5; ++rd) { unsigned best = 0u;
#pragma unroll 8
                for (int j = 0; j < 32; ++j) { const unsigned kx = SC[j]; const unsigned cnd = kx < prev ? kx : 0u; best = cnd > best ? cnd : best; }
                prev = best; if (best) sel |= 1u << (31 - (int)(best & 31u)); }
        }
        sel &= (qt == 31) ? 0xffffffffu : ((1u << (qt + 1)) - 1u);
        wm = sel;
#pragma unroll
        for (int o = 1; o < 32; o <<= 1) wm |= (unsigned)__shfl_xor((int)wm, o);
        wm = (unsigned)__builtin_amdgcn_readfirstlane((int)wm);
        if (lane == 0) ((LAS unsigned*)(lds + AT_WM))[wave] = wm;
        WG_BAR();
        um = 0u;
#pragma unroll
        for (int w = 0; w < 8; ++w) um |= ((const LAS unsigned*)(lds + AT_WM))[w];
        um = (unsigned)__builtin_amdgcn_readfirstlane((int)um);
    }
    if (DO_SEL) {
        f32x16 o[2]; float l = 0.f;
#pragma unroll
        for (int i = 0; i < 16; ++i) { o[0][i] = 0.f; o[1][i] = 0.f; }
        const char* kbase = (const char*)(ksn + (size_t)b * SEQ * 128 + hkv * 64); const char* vbase = (const char*)((const bf16*)(ws + WS_VSN) + (size_t)b * SEQ * 128 + hkv * 64);
        unsigned rem = um, im = um; int k = 0; const int T = __popc(um);
#pragma unroll 1
        for (int i = 0; i < 3 && im; ++i) { const int jn = __ffs((int)im) - 1; im &= im - 1u; at_load(lds, i, kbase + (size_t)jn * 64 * 256, 256, vbase + (size_t)jn * 64 * 256, 256, wave, lane); }
#pragma unroll 1
        while (rem) {
            const int j = __ffs((int)rem) - 1; rem &= rem - 1u;
            at_wait(T - k - 1);
#ifdef NSA_E1
            at_wait(T - k - 1);
#endif
            if (im) { const int jn = __ffs((int)im) - 1; im &= im - 1u; at_load(lds, (k + 3) & 3, kbase + (size_t)jn * 64 * 256, 256, vbase + (size_t)jn * 64 * 256, 256, wave, lane); }
            const int par = k & 3;
            if ((wm >> j) & 1u) {
                f32x16 s[2];
                at_qk(lds + AT_K + par * 8192, ka, qf, s);
                bf16x8 vf[2][2]; at_vload(lds + AT_V + par * 8192, va, 0, vf); SB();
                const bool on = (sel >> j) & 1u;
                if (j != qt && __all(on)) at_exp_all(s, l);
                else { const int klim = j == qt ? qq : 63;
#pragma unroll
                    for (int kb = 0; kb < 2; ++kb)
#pragma unroll
                        for (int i = 0; i < 16; ++i) { const int key = 32 * kb + crow(i, h); const float p = (on && key <= klim) ? __builtin_amdgcn_exp2f(s[kb][i]) : 0.f; s[kb][i] = p; l += p; } }
                at_pv(lds + AT_V + par * 8192, va, vf, s, o);
            }
            ++k;
        }
        const float L = l + __shfl_xor(l, 32); const float gi = gate[1] * (L > 0.f ? 1.f / L : 0.f);
#pragma unroll
        for (int i = 0; i < 16; ++i) { ofin[0][i] += gi * o[0][i]; ofin[1][i] += gi * o[1][i]; }
    }
    WG_BAR();
    if (DO_WIN) {
        f32x16 o[2]; float l = 0.f;
#pragma unroll
        for (int i = 0; i < 16; ++i) { o[0][i] = 0.f; o[1][i] = 0.f; }
        const char* kbase = (const char*)(kwn + (size_t)b * SEQ * 128 + hkv * 64); const char* vbase = (const char*)((const bf16*)(ws + WS_VWN) + (size_t)b * SEQ * 128 + hkv * 64);
        const int jlo = qt > 8 ? qt - 8 : 0; const int T = qt - jlo + 1;
#ifdef NSA_E2
        f32x16 o2[2]; float l2 = 0.f;
#pragma unroll
        for (int i = 0; i < 16; ++i) { o2[0][i] = 0.f; o2[1][i] = 0.f; }
#endif
#pragma unroll 1
        for (int i = 0; i < 3 && i < T; ++i) at_load(lds, i, kbase + (size_t)(jlo + i) * 64 * 256, 256, vbase + (size_t)(jlo + i) * 64 * 256, 256, wave, lane);
#pragma unroll 1
        for (int k = 0; k < T; ++k) {
            const int j = jlo + k, par = k & 3;
            at_wait(T - k - 1);
#ifdef NSA_E1
            at_wait(T - k - 1);
#endif
            if (k + 3 < T) at_load(lds, (k + 3) & 3, kbase + (size_t)(j + 3) * 64 * 256, 256, vbase + (size_t)(j + 3) * 64 * 256, 256, wave, lane);
            f32x16 s[2];
            at_qk(lds + AT_K + par * 8192, ka, qf, s);
            bf16x8 vf[2][2]; at_vload(lds + AT_V + par * 8192, va, 0, vf); SB();
#ifdef NSA_E2
            { f32x16 s2[2]; asm volatile("" ::: "memory"); at_qk(lds + AT_K + par * 8192, ka, qf, s2); bf16x8 vf2[2][2]; at_vload(lds + AT_V + par * 8192, va, 0, vf2); SB(); at_exp_all(s2, l2); at_pv(lds + AT_V + par * 8192, va, vf2, s2, o2); }
#endif
            if (j != qt && j != qt - 8) at_exp_all(s, l);
            else { const int klo = (j == qt - 8) ? qq + 1 : 0, khi = (j == qt) ? qq : 63;
#pragma unroll
                for (int kb = 0; kb < 2; ++kb)
#pragma unroll
                    for (int i = 0; i < 16; ++i) { const int key = 32 * kb + crow(i, h); const float p = (key >= klo && key <= khi) ? __builtin_amdgcn_exp2f(s[kb][i]) : 0.f; s[kb][i] = p; l += p; } }
            at_pv(lds + AT_V + par * 8192, va, vf, s, o);
        }
#ifdef NSA_E2
        { const float z = l2 * 0.f;
#pragma unroll
          for (int i = 0; i < 16; ++i) { ofin[0][i] += z * o2[0][i]; ofin[1][i] += z * o2[1][i]; } }
#endif
        const float L = l + __shfl_xor(l, 32); const float gi = gate[2] * (L > 0.f ? 1.f / L : 0.f);
#pragma unroll
        for (int i = 0; i < 16; ++i) { ofin[0][i] += gi * o[0][i]; ofin[1][i] += gi * o[1][i]; }
    }
    if (!STORE) { asm volatile("" :: "v"(ofin[0]), "v"(ofin[1])); return; }
    WG_BAR();
#pragma unroll
    for (int db = 0; db < 2; ++db)
#pragma unroll
        for (int a = 0; a < 4; ++a) { u32x2 w; w.x = pkbf(ofin[db][4 * a], ofin[db][4 * a + 1]); w.y = pkbf(ofin[db][4 * a + 2], ofin[db][4 * a + 3]); *(LAS u32x2*)(lds + qloc * 528 + g * 128 + (32 * db + 8 * a + 4 * h) * 2) = w; }
    WG_BAR();
    { const int tid = wave * 64 + lane; bf16* obase = H1 + ((size_t)b * SEQ + 64 * qt) * 1536 + 512 + hkv * 256;
#pragma unroll
      for (int i = 0; i < 4; ++i) { const int piece = tid + 512 * i, row = piece >> 5, c = piece & 31; *(v4u*)(obase + (size_t)row * 1536 + 8 * c) = *(const LAS v4u*)(lds + row * 528 + 16 * c); } }
}
constexpr int ML_K = 0, ML_V = 32768, ML_VW = 65536, ML_C = 81920, ML_N = 114688, ML_SS = 115200, ML_WS = 116224, ML_GO = 120320, ML_ST = 135424;
DI int ml_fk(int s) { return ((s & 3) << 2) | ((s >> 2) & 3); }
DI void ml_load(LAS unsigned char* lds, int par, const char* kb, const char* vb, int wave, int lane) {
#pragma unroll
    for (int n2 = 0; n2 < 2; ++n2) { const int n = 2 * wave + n2, row = 4 * n + (lane >> 4), pc = lane & 15;
        const int kc = pc ^ ml_fk(row), vc = pc ^ ((row & 3) << 2);
        glds16(kb + (size_t)row * 2048 + 16 * kc, (unsigned)(size_t)(lds + ML_K + par * 16384 + n * 1024));
        glds16(vb + (size_t)row * 1024 + 16 * vc, (unsigned)(size_t)(lds + ML_V + par * 16384 + n * 1024)); }
}
DI bf16x8 ml_tr8(const LAS unsigned char* p) {
    const s16x4 lo = __builtin_amdgcn_ds_read_tr16_b64_v4i16((lds_s16x4*)p); const s16x4 hi = __builtin_amdgcn_ds_read_tr16_b64_v4i16((lds_s16x4*)(p + 1024));
    return __builtin_shufflevector(lo, hi, 0, 1, 2, 3, 4, 5, 6, 7);
}
template <int PM = 0xff>
DI void mlstm_unit2(Frame& F, int unit) {
    unsigned char* ws = F.ws; LAS unsigned char* lds = F.lds;
    int lane_ = F.lane_id();
    const int lane = lane_, wave = F.wave, tid = wave * 64 + lane, r = lane & 31, hh = lane >> 5, tb = wave >> 2, vb = wave & 3;
    const int b = unit >> 2, hd = unit & 3;
    const bf16* proj = (const bf16*)(ws + WS_PROJ); const bf16* mlqk = (const bf16*)(ws + WS_MLQK); bf16* H0 = (bf16*)(ws + WS_H0);
    const size_t tok0 = (size_t)b * SEQ;
    const char* kbase = (const char*)(mlqk + tok0 * 1024 + 512 + hd * 128); const char* vbase = (const char*)((const bf16*)(ws + WS_MLV) + tok0 * 512 + hd * 128);
    const float LOG2E = 1.4426950408889634f;
    const int i16 = lane & 15, q4 = i16 >> 2, p4 = i16 & 3, g1 = (lane >> 4) & 1;
    const int colsw = 16 * ((4 * vb + 2 * g1 + (p4 >> 1)) ^ (q4 << 2)) + 8 * (p4 & 1);
    const int base_c = (8 * hh + q4) * 256 + colsw;
    const int base_v = (4 * hh + q4) * 256 + colsw;
    const int fK = ml_fk(r), rowK = r * 256 + ((hh ^ (fK & 1)) << 4), F16 = (fK & 14) << 4;
    int base_kt[2][2];
#pragma unroll
    for (int blk = 0; blk < 2; ++blk)
#pragma unroll
        for (int hi = 0; hi < 2; ++hi) { const int kbp = 2 * tb + blk; base_kt[blk][hi] = (8 * hh + 4 * hi + q4) * 256 + 16 * ((4 * kbp + 2 * g1 + (p4 >> 1)) ^ ((q4 << 2) | ((2 * hh + hi) & 3))) + 8 * (p4 & 1); }
    LAS float* WS = (LAS float*)(lds + ML_WS) + wave * 128;
    LAS float* NV = (LAS float*)(lds + ML_N); LAS float* SS = (LAS float*)(lds + ML_SS);
    __syncthreads();
    for (int i = tid; i < 32768 / 16; i += 512) ((LAS v4u*)(lds + ML_C))[i] = (v4u){0u, 0u, 0u, 0u};
    if (tid < 128) NV[tid] = 0.f;
    f32x16 Cst[2];
#pragma unroll
    for (int i = 0; i < 16; ++i) { Cst[0][i] = 0.f; Cst[1][i] = 0.f; }
    if (tid < 128) ((LAS float*)(lds + ML_GO))[tid] = F.in[I_MLGOUT][hd * 128 + tid];
    const float bi = F.in[I_MLBI][hd], bfv = F.in[I_MLBF][hd];
    float m_prev = 0.f;
    ml_load(lds, 0, kbase, vbase, wave, lane);
    bf16x8 qf[8];
    { const bf16* qp = mlqk + (tok0 + 32 * tb + r) * 1024 + hd * 128 + 8 * hh;
#pragma unroll
      for (int st = 0; st < 8; ++st) qf[st] = *(const bf16x8*)(qp + 16 * st); }
    float gi_raw = bf2f(proj[(tok0 + lane) * NPROJ + PC_MLI + hd]), gf_raw = bf2f(proj[(tok0 + lane) * NPROJ + PC_MLF + hd]);
#pragma unroll 1
    for (int c = 0; c < 32; ++c) {
        const int par = c & 1; const size_t tokc = tok0 + 64 * c;
        WG_BAR();
        if ((PM & 1) && c > 0) {
            bf16* obase = H0 + (tokc - 64) * 1536 + hd * 128;
#pragma unroll
            for (int i = 0; i < 2; ++i) { const int piece = tid + 512 * i, row = piece >> 4, cc = piece & 15; *(v4u*)(obase + (size_t)row * 1536 + 8 * cc) = *(const LAS v4u*)(lds + ML_ST + row * 272 + 16 * cc); } }
        if (c < 31) ml_load(lds, par ^ 1, kbase + (size_t)(64 * (c + 1)) * 2048, vbase + (size_t)(64 * (c + 1)) * 1024, wave, lane);
        u32x2 og[4];
        { const bf16* op = proj + (tokc + 32 * tb + r) * NPROJ + PC_MLO + hd * 128 + 32 * vb + 4 * hh;
#pragma unroll
          for (int a = 0; a < 4; ++a) og[a] = *(const u32x2*)(op + 8 * a); }
        const float ig = gi_raw + bi, lf = logsig(gf_raw + bfv);
        float bc = lf;
        if (PM & 2) {
#pragma unroll
        for (int o = 1; o < 64; o <<= 1) { const float v = __shfl_up(bc, o); if (lane >= o) bc += v; } }
        const float rr = ig - bc;
        float cm = rr;
        if (PM & 2) {
#pragma unroll
        for (int o = 1; o < 64; o <<= 1) { const float v = __shfl_up(cm, o); if (lane >= o) cm = fmaxf(cm, v); } }
        const float M63 = fmaxf(m_prev, __shfl(cm, 63)), blast = __shfl(bc, 63);
        const float a_old = __expf(m_prev - M63), m_new = blast + M63;
        const int tl = 32 * tb + r;
        const float Mt = fmaxf(m_prev, __shfl(cm, tl)), bt = __shfl(bc, tl);
        const float inter = __expf(m_prev - Mt), m_t = bt + Mt;
        WS[lane] = rr * LOG2E; WS[64 + lane] = __expf(rr - M63);
        const float MtL = Mt * LOG2E;
        const LAS unsigned char* kbuf = lds + ML_K + par * 16384; const LAS unsigned char* vbuf = lds + ML_V + par * 16384;
        f32x16 wd[2]; float dsum = 0.f;
#pragma unroll
        for (int kb = 0; kb < 2; ++kb) {
#pragma unroll
            for (int i = 0; i < 16; ++i) wd[kb][i] = 0.f;
            if ((PM & 4) && kb <= tb) {
                f32x16 a = wd[kb]; bf16x8 kfr[8];
#pragma unroll
                for (int st = 0; st < 8; ++st) kfr[st] = *(const LAS bf16x8*)(kbuf + kb * 8192 + rowK + ((32 * st) ^ F16));
                SB();
#pragma unroll
                for (int st = 0; st < 8; ++st) a = MFMA32(kfr[st], qf[st], a);
#pragma unroll
                for (int i = 0; i < 16; ++i) { const int s = 32 * kb + crow(i, hh); const float e = __builtin_amdgcn_exp2f(WS[s] - MtL); const float w = (s <= tl) ? e * a[i] : 0.f; a[i] = w; dsum += w; }
                wd[kb] = a;
            }
        }
        f32x16 acc; bf16x8 cfr[8];
#pragma unroll
        for (int i = 0; i < 16; ++i) acc[i] = 0.f;
        if (PM & 8) {
#pragma unroll
        for (int st = 0; st < 8; ++st) cfr[st] = ml_tr8(lds + ML_C + base_c + st * 4096);
        SB();
#pragma unroll
        for (int st = 0; st < 8; ++st) acc = MFMA32(cfr[st], qf[st], acc); }
#pragma unroll
        for (int i = 0; i < 16; ++i) acc[i] *= inter;
#pragma unroll
        for (int kb = 0; kb < 2; ++kb) {
            if ((PM & 16) && kb <= tb) {
                const bf16x8 pf0 = pack8<0>(wd[kb]), pf1 = pack8<1>(wd[kb]);
                {
#pragma unroll
                  for (int s2 = 0; s2 < 2; ++s2) { const LAS unsigned char* p = vbuf + base_v + kb * 8192 + s2 * 4096;
                    const s16x4 lo = __builtin_amdgcn_ds_read_tr16_b64_v4i16((lds_s16x4*)p); const s16x4 hi = __builtin_amdgcn_ds_read_tr16_b64_v4i16((lds_s16x4*)(p + 2048));
                    const bf16x8 vf = __builtin_shufflevector(lo, hi, 0, 1, 2, 3, 4, 5, 6, 7);
                    acc = MFMA32(vf, s2 ? pf1 : pf0, acc); } }
            }
        }
        float qn_ = 0.f;
        if (PM & 32)
#pragma unroll
        for (int st = 0; st < 8; ++st) { const v4u qw = __builtin_bit_cast(v4u, qf[st]); const LAS float* np = NV + 16 * st + 8 * hh; const f32x4 n0 = *(const LAS f32x4*)np, n1 = *(const LAS f32x4*)(np + 4);
            qn_ = fmaf(__uint_as_float(qw.x << 16), n0[0], qn_); qn_ = fmaf(__uint_as_float(qw.x & 0xffff0000u), n0[1], qn_); qn_ = fmaf(__uint_as_float(qw.y << 16), n0[2], qn_); qn_ = fmaf(__uint_as_float(qw.y & 0xffff0000u), n0[3], qn_);
            qn_ = fmaf(__uint_as_float(qw.z << 16), n1[0], qn_); qn_ = fmaf(__uint_as_float(qw.z & 0xffff0000u), n1[1], qn_); qn_ = fmaf(__uint_as_float(qw.w << 16), n1[2], qn_); qn_ = fmaf(__uint_as_float(qw.w & 0xffff0000u), n1[3], qn_); }
        qn_ += __shfl_xor(qn_, 32); dsum += __shfl_xor(dsum, 32);
        const float den = inter * qn_ + dsum; const float rden = 1.f / fmaxf(fabsf(den), __expf(-m_t));
        float ssq = 0.f;
#pragma unroll
        for (int i = 0; i < 16; ++i) { acc[i] *= rden; ssq = fmaf(acc[i], acc[i], ssq); }
        ssq += __shfl_xor(ssq, 32);
        if (hh == 0) SS[vb * 64 + tl] = ssq;
        if (PM & 64)
#pragma unroll
        for (int k2 = 0; k2 < 2; ++k2) { const int ci = tid + 512 * k2, s = ci >> 4; const float w = WS[64 + s];
            const v4u x = *(const LAS v4u*)(vbuf + ci * 16); v4u y; const unsigned xs[4] = {x.x, x.y, x.z, x.w}; unsigned ys[4];
#pragma unroll
            for (int j = 0; j < 4; ++j) ys[j] = pkbf(__uint_as_float(xs[j] << 16) * w, __uint_as_float(xs[j] & 0xffff0000u) * w);
            y.x = ys[0]; y.y = ys[1]; y.z = ys[2]; y.w = ys[3]; *(LAS v4u*)(lds + ML_VW + ci * 16) = y; }
        asm volatile("s_waitcnt lgkmcnt(0)" ::: "memory"); __builtin_amdgcn_s_barrier(); asm volatile("" ::: "memory");
        if (c < 31) {
            const bf16* qp = mlqk + (tokc + 64 + 32 * tb + r) * 1024 + hd * 128 + 8 * hh;
#pragma unroll
            for (int st = 0; st < 8; ++st) qf[st] = *(const bf16x8*)(qp + 16 * st);
            gi_raw = bf2f(proj[(tokc + 64 + lane) * NPROJ + PC_MLI + hd]); gf_raw = bf2f(proj[(tokc + 64 + lane) * NPROJ + PC_MLF + hd]);
        }
        { const LAS float* GO = (const LAS float*)(lds + ML_GO) + 32 * vb + 4 * hh;
          const float rstd = rsqrtf(((SS[tl] + SS[64 + tl]) + (SS[128 + tl] + SS[192 + tl])) * (1.f / 128.f) + EPS);
#pragma unroll
          for (int a = 0; a < 4; ++a) { float o4[4]; const unsigned gw[2] = {og[a].x, og[a].y};
#pragma unroll
              for (int j = 0; j < 4; ++j) { const float ov = (j & 1) ? __uint_as_float(gw[j >> 1] & 0xffff0000u) : __uint_as_float(gw[j >> 1] << 16); o4[j] = acc[4 * a + j] * rstd * GO[8 * a + j] * sigm(ov); }
              u32x2 w; w.x = pkbf(o4[0], o4[1]); w.y = pkbf(o4[2], o4[3]); *(LAS u32x2*)(lds + ML_ST + tl * 272 + (32 * vb + 8 * a + 4 * hh) * 2) = w; } }
        if (PM & 128)
#pragma unroll
        for (int blk = 0; blk < 2; ++blk) {
            f32x16 cs = Cst[blk];
#pragma unroll
            for (int i = 0; i < 16; ++i) cs[i] *= a_old;
            bf16x8 afr[4], kfr2[4];
#pragma unroll
            for (int st = 0; st < 4; ++st) {
                afr[st] = ml_tr8(lds + ML_VW + base_c + st * 4096);
                const s16x4 lo = __builtin_amdgcn_ds_read_tr16_b64_v4i16((lds_s16x4*)(kbuf + base_kt[blk][0] + st * 4096)); const s16x4 hi = __builtin_amdgcn_ds_read_tr16_b64_v4i16((lds_s16x4*)(kbuf + base_kt[blk][1] + st * 4096));
                kfr2[st] = __builtin_shufflevector(lo, hi, 0, 1, 2, 3, 4, 5, 6, 7);
            }
            SB();
#pragma unroll
            for (int st = 0; st < 4; ++st) cs = MFMA32(afr[st], kfr2[st], cs);
            Cst[blk] = cs;
            const int kk = 32 * (2 * tb + blk) + r;
#pragma unroll
            for (int a = 0; a < 4; ++a) { u32x2 w; w.x = pkbf(cs[4 * a], cs[4 * a + 1]); w.y = pkbf(cs[4 * a + 2], cs[4 * a + 3]);
                *(LAS u32x2*)(lds + ML_C + kk * 256 + 16 * ((4 * vb + a) ^ ((r & 3) << 2)) + 8 * hh) = w; }
        }
        if ((PM & 64) && tid < 128) { float nv = NV[tid] * a_old;
#pragma unroll 8
            for (int s = 0; s < 64; ++s) { const unsigned short kvs = *(const LAS unsigned short*)(kbuf + s * 256 + 16 * ((tid >> 3) ^ ml_fk(s)) + 2 * (tid & 7)); nv = fmaf(WS[64 + s], bf2f(kvs), nv); }
            NV[tid] = nv; }
        m_prev = m_new;
    }
    __syncthreads();
    if (PM & 1) { bf16* obase = H0 + (tok0 + 64 * 31) * 1536 + hd * 128;
#pragma unroll
        for (int i = 0; i < 2; ++i) { const int piece = tid + 512 * i, row = piece >> 4, cc = piece & 15; *(v4u*)(obase + (size_t)row * 1536 + 8 * cc) = *(const LAS v4u*)(lds + ML_ST + row * 272 + 16 * cc); } }
    __syncthreads();
}
DI void mem_load(LAS unsigned char* lds, int par, const char* kb, const char* vb, int wave, int lane) {
#pragma unroll
    for (int n2 = 0; n2 < 2; ++n2) { const int n = 2 * wave + n2, row = 4 * n + (lane >> 4), pc = lane & 15;
        const int kc = pc ^ ml_fk(row), vc = pc ^ ((row & 3) << 2);
        glds16(kb + (size_t)row * 1024 + 16 * kc, (unsigned)(size_t)(lds + ML_K + par * 16384 + n * 1024));
        glds16(vb + (size_t)row * 2048 + 16 * vc, (unsigned)(size_t)(lds + ML_V + par * 16384 + n * 1024)); }
}
template <bool STORE = true, bool DMA = true, bool COMP = true>
DI void mem_unit(Frame& F, int unit) {
    unsigned char* ws = F.ws; LAS unsigned char* lds = F.lds;
    int lane_ = F.lane_id();
    const int lane = lane_, wave = F.wave, r = lane & 31, hh = lane >> 5;
    const int b = unit >> 5, hd = (unit >> 3) & 3, qt = unit & 7;
    const bf16* mqn = (const bf16*)(ws + WS_MQN); const bf16* memkn = (const bf16*)(ws + WS_MEMKN); const bf16* memkv = (const bf16*)(ws + WS_MEMKV); bf16* H2 = (bf16*)(ws + WS_H0);
    const size_t t = (size_t)b * SEQ + 256 * qt + 32 * wave + r;
    const char* kbase = (const char*)(memkn + (size_t)b * MEML * 512 + hd * 128); const char* vbase = (const char*)(memkv + (size_t)b * MEML * 1024 + 512 + hd * 128);
    const int i16 = lane & 15, q4 = i16 >> 2, p4 = i16 & 3, g1 = (lane >> 4) & 1;
    int base_v[4];
#pragma unroll
    for (int db = 0; db < 4; ++db) base_v[db] = (4 * hh + q4) * 256 + 16 * ((4 * db + 2 * g1 + (p4 >> 1)) ^ (q4 << 2)) + 8 * (p4 & 1);
    const int fK = ml_fk(r), rowK = r * 256 + ((hh ^ (fK & 1)) << 4), F16 = (fK & 14) << 4;
    bf16x8 qf[8];
#pragma unroll
    for (int st = 0; st < 8; ++st) qf[st] = *(const bf16x8*)(mqn + t * 512 + hd * 128 + 16 * st + 8 * hh);
    f32x16 o[4]; float l = 0.f;
#pragma unroll
    for (int db = 0; db < 4; ++db)
#pragma unroll
        for (int i = 0; i < 16; ++i) o[db][i] = 0.f;
    WG_BAR();
    if (DMA) mem_load(lds, 0, kbase, vbase, wave, lane);
#pragma unroll 1
    for (int tile = 0; tile < 4; ++tile) {
        const int par = tile & 1;
        WG_BAR();
        if (DMA && tile < 3) mem_load(lds, par ^ 1, kbase + (size_t)(64 * (tile + 1)) * 1024, vbase + (size_t)(64 * (tile + 1)) * 2048, wave, lane);
        const LAS unsigned char* kbuf = lds + ML_K + par * 16384; const LAS unsigned char* vbuf = lds + ML_V + par * 16384;
        if (COMP)
#pragma unroll
        for (int kb = 0; kb < 2; ++kb) {
            bf16x8 kf[8];
#pragma unroll
            for (int st = 0; st < 8; ++st) kf[st] = *(const LAS bf16x8*)(kbuf + kb * 8192 + rowK + ((32 * st) ^ F16));
            SB();
            f32x16 a;
#pragma unroll
            for (int i = 0; i < 16; ++i) a[i] = 0.f;
#pragma unroll
            for (int st = 0; st < 8; ++st) a = MFMA32(kf[st], qf[st], a);
            bf16x8 vf[2][4];
#pragma unroll
            for (int s2 = 0; s2 < 2; ++s2)
#pragma unroll
                for (int db = 0; db < 4; ++db) { const LAS unsigned char* p = vbuf + base_v[db] + kb * 8192 + s2 * 4096;
                    const s16x4 lo = __builtin_amdgcn_ds_read_tr16_b64_v4i16((lds_s16x4*)p); const s16x4 hi = __builtin_amdgcn_ds_read_tr16_b64_v4i16((lds_s16x4*)(p + 2048));
                    vf[s2][db] = __builtin_shufflevector(lo, hi, 0, 1, 2, 3, 4, 5, 6, 7); }
            SB();
#pragma unroll
            for (int i = 0; i < 16; ++i) { a[i] = __builtin_amdgcn_exp2f(a[i]); l += a[i]; }
            const bf16x8 pf0 = pack8<0>(a), pf1 = pack8<1>(a);
#pragma unroll
            for (int s2 = 0; s2 < 2; ++s2)
#pragma unroll
                for (int db = 0; db < 4; ++db) o[db] = MFMA32(vf[s2][db], s2 ? pf1 : pf0, o[db]);
        }
    }
    const float inv = 1.f / (l + __shfl_xor(l, 32));
    if (!STORE) {
#pragma unroll
        for (int db = 0; db < 4; ++db) asm volatile("" :: "v"(o[db]), "v"(inv));
        return; }
    WG_BAR();
#pragma unroll
    for (int db = 0; db < 4; ++db)
#pragma unroll
        for (int a = 0; a < 4; ++a) { u32x2 w; w.x = pkbf(o[db][4 * a] * inv, o[db][4 * a + 1] * inv); w.y = pkbf(o[db][4 * a + 2] * inv, o[db][4 * a + 3] * inv);
            *(LAS u32x2*)(lds + (32 * wave + r) * 272 + (32 * db + 8 * a + 4 * hh) * 2) = w; }
    WG_BAR();
    { const int tid = wave * 64 + lane; bf16* obase = H2 + ((size_t)b * SEQ + 256 * qt) * 1536 + 1024 + hd * 128;
#pragma unroll
      for (int i = 0; i < 8; ++i) { const int piece = tid + 512 * i, row = piece >> 4, c = piece & 15; *(v4u*)(obase + (size_t)row * 1536 + 8 * c) = *(const LAS v4u*)(lds + row * 272 + 16 * c); } }
}
DI int q_pop(Frame& F, unsigned* qc) {
    __syncthreads();
    if (F.tid_id() == 0) F.MISC[16] = atomicAdd(qc, 1u);
    __syncthreads();
    return (int)F.MISC[16];
}
template <bool ML, bool NSA, bool MEMA, bool MST = true, bool MDMA = true, bool MCOMP = true, bool NST = true, bool NCMP = true, bool NSEL = true, bool NWIN = true, int MLPM = 0xff>
DI void p5_queue(Frame& F, int cbase) {
    unsigned* qc = F.ctl + CW_QCTR + cbase;
    if (ML) {
#pragma unroll 1
        for (;;) { const int it = q_pop(F, qc); if (it >= 64) break; mlstm_unit2<MLPM>(F, it); }
    }
    if (NSA) {
#pragma unroll 1
        for (;;) { const int it = q_pop(F, qc + 64); if (it >= 1024) break; nsa_unit<NST, NCMP, NSEL, NWIN>(F, it); }
    }
    if (MEMA) {
#pragma unroll 1
        for (;;) { const int it = q_pop(F, qc + 128); if (it >= 512) break; mem_unit<MST, MDMA, MCOMP>(F, it); }
    }
    __syncthreads();
}
struct OneUnit { int pm; DI bool next(int i, pg8::Unit& u) const { if (i) return false; u.pm = pm; u.pn = 0; return true; } DI void a_ready(const pg8::Unit&) const {} DI void done(const pg8::Unit&) const {} };
DI void p2_compress(Frame& F) {
    unsigned char* ws = F.ws;
    if (F.G < 64 || F.bx >= 32) return;
    const int kv = F.bx >> 4, pm = F.bx & 15;
    typedef pg8::bf16_t b16;
    { pg8::GemmA g{(const b16*)(ws + WS_PROJ) + (kv ? PC_NVC : PC_NKC), (const b16*)(ws + WS_WC1) + (size_t)kv * 256 * 2048, 2048, 16 * NPROJ * 2, (size_t)NPROJ * 2, (size_t)128, (size_t)SEQ * NPROJ * 2};
      OneUnit S{pm};
      pg8::EpiBf16Silu E{(b16*)(ws + WS_HID) + (size_t)kv * 4096 * 256, 256, (const float*)(ws + WS_SMALL + SM_CBIAS) + kv * 256, 1};
      pg8::gemm_phase_ga<pg8::EpiBf16Silu, OneUnit, false, true>(F.lds, g, S, E, F.wave); }
    asm volatile("s_waitcnt vmcnt(0)" ::: "memory"); __syncthreads();
    const int lane = F.lane_id(), r = lane & 31, hh = lane >> 5;
    const int row = pm * 256 + F.wave * 32 + r, n = row & 127;
    const bf16* hid = (const bf16*)(ws + WS_HID) + (size_t)kv * 4096 * 256 + (size_t)row * 256 + 8 * hh;
    const bf16* w2t = (const bf16*)(ws + WS_SMALL + SM_W2T) + (size_t)kv * 64 * 256 + 8 * hh;
    f32x16 acc[2];
#pragma unroll
    for (int i = 0; i < 16; ++i) { acc[0][i] = 0.f; acc[1][i] = 0.f; }
#pragma unroll 4
    for (int st = 0; st < 16; ++st) { const bf16x8 hb = *(const bf16x8*)(hid + 16 * st);
        const bf16x8 w0 = *(const bf16x8*)(w2t + (size_t)r * 256 + 16 * st), w1 = *(const bf16x8*)(w2t + (size_t)(32 + r) * 256 + 16 * st);
        acc[0] = MFMA32(w0, hb, acc[0]); acc[1] = MFMA32(w1, hb, acc[1]); }
    if (kv == 0) {
        float ss = 0.f;
#pragma unroll
        for (int i = 0; i < 16; ++i) ss += acc[0][i] * acc[0][i] + acc[1][i] * acc[1][i];
        ss += __shfl_xor(ss, 32);
        const float rstd = rsqrtf(ss * (1.f / 64.f) + EPS);
        const float* rc = (const float*)(ws + WS_SMALL + SM_ROPEC); const float* rs = (const float*)(ws + WS_SMALL + SM_ROPES);
        const int pos = 16 * n + 31 < SEQ ? 16 * n + 31 : SEQ - 1;
#pragma unroll
        for (int i = 0; i < 16; ++i) { const int d = crow(i, hh); const float c = rc[pos * 32 + d], sn = rs[pos * 32 + d];
            const float y0 = acc[0][i] * rstd * F.in[I_NGK][d], y1 = acc[1][i] * rstd * F.in[I_NGK][32 + d];
            acc[0][i] = y0 * c - y1 * sn; acc[1][i] = y1 * c + y0 * sn; }
    }
    bf16* dst = (bf16*)(ws + (kv ? WS_VC : WS_KC)) + (size_t)row * 64 + 4 * hh;
#pragma unroll
    for (int db = 0; db < 2; ++db)
#pragma unroll
        for (int a = 0; a < 4; ++a) { u32x2 w; w.x = pkbf(acc[db][4 * a], acc[db][4 * a + 1]); w.y = pkbf(acc[db][4 * a + 2], acc[db][4 * a + 3]); if (n == 127) { w.x = 0u; w.y = 0u; }
            *(u32x2*)(dst + 32 * db + 8 * a) = w; }
}
DI void mlstm_unit(Frame& F, int unit) {
    unsigned char* ws = F.ws;
    const int b = unit >> 2, h = unit & 3, tid = F.tid_id(), kk = tid >> 7, c = tid & 127;
    const bf16* proj = (const bf16*)(ws + WS_PROJ); const bf16* mlqk = (const bf16*)(ws + WS_MLQK); bf16* H0 = (bf16*)(ws + WS_H0);
    LAS float* qs = (LAS float*)F.lds;
    LAS float* ks = qs + 16 * 128;
    LAS float* vs = ks + 16 * 128;
    LAS float* gi = vs + 16 * 128;
    LAS float* gf = gi + 16;
    LAS float* part = gf + 16;
    LAS float* pden = part + 2 * 4 * 128;
    LAS float* hb = pden + 8;
    float C[32], nn[32];
#pragma unroll
    for (int i = 0; i < 32; ++i) { C[i] = 0.f; nn[i] = 0.f; }
    float m = 0.f;
    const float bi = F.in[I_MLBI][h], bfv = F.in[I_MLBF][h];
    const float scale = 0.08838834764831845f;
#pragma unroll 1
    for (int t0 = 0; t0 < SEQ; t0 += 16) {
        __syncthreads();
        for (int i = tid; i < 16 * 128; i += 512) { const int s = i >> 7, d = i & 127; const size_t t = (size_t)b * SEQ + t0 + s;
            qs[i] = bf2f(mlqk[t * 1024 + h * 128 + d]); ks[i] = bf2f(mlqk[t * 1024 + 512 + h * 128 + d]); vs[i] = bf2f(proj[t * NPROJ + PC_MLV + h * 128 + d]); }
        if (tid < 16) { const size_t t = (size_t)b * SEQ + t0 + tid; gi[tid] = bf2f(proj[t * NPROJ + PC_MLI + h]) + bi; gf[tid] = logsig(bf2f(proj[t * NPROJ + PC_MLF + h]) + bfv); }
        __syncthreads();
#pragma unroll 1
        for (int s = 0; s < 16; ++s) {
            const float lf = gf[s], ig = gi[s];
            const float mn = fmaxf(lf + m, ig), a = __expf(lf + m - mn), bb = __expf(ig - mn);
            m = mn;
            const float v = vs[s * 128 + c];
            float pn = 0.f, pd = 0.f;
#pragma unroll
            for (int i = 0; i < 32; ++i) { const float kvv = ks[s * 128 + kk * 32 + i], qv = qs[s * 128 + kk * 32 + i];
                C[i] = a * C[i] + bb * kvv * v; nn[i] = a * nn[i] + bb * kvv; pn = fmaf(qv, C[i], pn); pd = fmaf(qv, nn[i], pd); }
            const int par = s & 1;
            part[(par * 4 + kk) * 128 + c] = pn; if (c == 0) pden[par * 4 + kk] = pd;
            __syncthreads();
            if (kk == 0) {
                const float num = (part[(par * 4 + 0) * 128 + c] + part[(par * 4 + 1) * 128 + c]) + (part[(par * 4 + 2) * 128 + c] + part[(par * 4 + 3) * 128 + c]);
                const float den = (pden[par * 4 + 0] + pden[par * 4 + 1]) + (pden[par * 4 + 2] + pden[par * 4 + 3]);
                hb[s * 128 + c] = num * scale / fmaxf(fabsf(den * scale), __expf(-mn));
            }
        }
        __syncthreads();
#pragma unroll
        for (int rr = 0; rr < 2; ++rr) { const int s = F.wave * 2 + rr; const size_t t = (size_t)b * SEQ + t0 + s;
            const float v0 = hb[s * 128 + F.lane_id()], v1 = hb[s * 128 + 64 + F.lane_id()];
            const float rstd = rsqrtf(wave_sum(v0 * v0 + v1 * v1) * (1.f / 128.f) + EPS);
            const float o0 = bf2f(proj[t * NPROJ + PC_MLO + h * 128 + F.lane_id()]), o1 = bf2f(proj[t * NPROJ + PC_MLO + h * 128 + 64 + F.lane_id()]);
            H0[t * 512 + h * 128 + F.lane_id()] = (bf16)f2bf(v0 * rstd * F.in[I_MLGOUT][h * 128 + F.lane_id()] * sigm(o0));
            H0[t * 512 + h * 128 + 64 + F.lane_id()] = (bf16)f2bf(v1 * rstd * F.in[I_MLGOUT][h * 128 + 64 + F.lane_id()] * sigm(o1)); }
    }
    __syncthreads();
}

DI void nsa_scores(const bf16* krow, bool valid, const LAS float* qs, float (&s)[4]) {
    s[0] = s[1] = s[2] = s[3] = 0.f;
    if (valid) {
#pragma unroll 2
        for (int c8 = 0; c8 < 8; ++c8) { const v4u kk = *(const v4u*)(krow + c8 * 8);
            const unsigned w[4] = {kk.x, kk.y, kk.z, kk.w};
#pragma unroll
            for (int j = 0; j < 4; ++j) { const float k0 = __uint_as_float(w[j] << 16), k1 = __uint_as_float(w[j] & 0xffff0000u); const int d = c8 * 8 + 2 * j;
#pragma unroll
                for (int g = 0; g < 4; ++g) s[g] = fmaf(k1, qs[g * 64 + d + 1], fmaf(k0, qs[g * 64 + d], s[g])); } }
    }
}
DI void nsa_wave(Frame& F, int item, LAS float* wl) {
    unsigned char* ws = F.ws; const int lane = F.lane_id();
    const int t = item >> 1, hkv = item & 1, b = t >> 11, tau = t & 2047;
    const bf16* proj = (const bf16*)(ws + WS_PROJ);
    const bf16* qn = (const bf16*)(ws + WS_QN); const bf16* ksn = (const bf16*)(ws + WS_KSN); const bf16* kwn = (const bf16*)(ws + WS_KWN);
    const bf16* kc = (const bf16*)(ws + WS_KC); const bf16* vc = (const bf16*)(ws + WS_VC); bf16* H1 = (bf16*)(ws + WS_H1);
    LAS float* qs = wl;
    LAS float* ps = wl + 256;
    LAS float* psum = wl + 768;
#pragma unroll
    for (int g = 0; g < 4; ++g) qs[g * 64 + lane] = bf2f(qn[(size_t)t * 512 + (hkv * 4 + g) * 64 + lane]);
    float ofin[4] = {0.f, 0.f, 0.f, 0.f};
    float gate[4][3];
#pragma unroll
    for (int g = 0; g < 4; ++g)
#pragma unroll
        for (int cidx = 0; cidx < 3; ++cidx) gate[g][cidx] = sigm(bf2f(proj[(size_t)t * NPROJ + PC_NG + (hkv * 4 + g) * 3 + cidx]));
    const int ncmp = tau >= 31 ? ((tau - 31) >> 4) + 1 : 0;
    {
        float l[4] = {0.f, 0.f, 0.f, 0.f}, o[4] = {0.f, 0.f, 0.f, 0.f};
        const size_t rbase = (size_t)(b * 2 + hkv) * 128;
#pragma unroll
        for (int blk = 0; blk < 2; ++blk) { const int n = blk * 64 + lane; const bool valid = n < ncmp; float s[4];
            nsa_scores(kc + (rbase + n) * 64, valid, qs, s);
#pragma unroll
            for (int g = 0; g < 4; ++g) { const float p = valid ? __expf(s[g]) : 0.f; l[g] += p; ps[g * 128 + n] = p; } }
        float inv[4];
#pragma unroll
        for (int g = 0; g < 4; ++g) { const float L = wave_sum(l[g]); inv[g] = L > 0.f ? 1.f / L : 0.f; }
#pragma unroll
        for (int blk = 0; blk < 2; ++blk) { const int n = blk * 64 + lane; psum[n] = (ps[0 * 128 + n] * inv[0] + ps[1 * 128 + n] * inv[1]) + (ps[2 * 128 + n] * inv[2] + ps[3 * 128 + n] * inv[3]); }
#pragma unroll 2
        for (int n = 0; n < ncmp; ++n) { const float vv = bf2f(vc[(rbase + n) * 64 + lane]);
#pragma unroll
            for (int g = 0; g < 4; ++g) o[g] = fmaf(ps[g * 128 + n], vv, o[g]); }
#pragma unroll
        for (int g = 0; g < 4; ++g) ofin[g] += gate[g][0] * o[g] * inv[g];
    }
    const int cur = tau >> 6;
    unsigned selmask = 0u;
    {
        float score = -3.0e38f;
        if (lane < 32) { const int j = lane; float imp = 0.f;
#pragma unroll
            for (int dn = -1; dn <= 3; ++dn) { const int n = 4 * j + dn; if (n >= 0 && n <= 126) imp += psum[n]; }
            const bool forced = (j == 0) || (j == cur) || (j == cur - 1);
            score = j > cur ? NEGF : imp + (forced ? 1.0e4f : 0.f); }
#pragma unroll 1
        for (int r = 0; r < 8; ++r) { const float mx = wave_max(score); const unsigned long long bal = __ballot(score == mx); const int win = __ffsll((long long)bal) - 1;
            selmask |= 1u << win; if (lane == win) score = -3.4e38f; }
    }
    {
        float l[4] = {0.f, 0.f, 0.f, 0.f}, o[4] = {0.f, 0.f, 0.f, 0.f};
#pragma unroll 1
        for (int j = 0; j <= cur; ++j) { if (!((selmask >> j) & 1u)) continue;
            const int kpos = 64 * j + lane; const bool valid = kpos <= tau; float s[4];
            nsa_scores(ksn + ((size_t)b * SEQ + kpos) * 128 + hkv * 64, valid, qs, s);
#pragma unroll
            for (int g = 0; g < 4; ++g) { const float p = valid ? __expf(s[g]) : 0.f; l[g] += p; ps[g * 128 + lane] = p; }
            const int nk = j == cur ? (tau & 63) + 1 : 64;
            const bf16* vb = proj + ((size_t)b * SEQ + 64 * j) * NPROJ + PC_NVS + hkv * 64 + lane;
#pragma unroll 2
            for (int k = 0; k < nk; ++k) { const float vv = bf2f(vb[(size_t)k * NPROJ]);
#pragma unroll
                for (int g = 0; g < 4; ++g) o[g] = fmaf(ps[g * 128 + k], vv, o[g]); } }
#pragma unroll
        for (int g = 0; g < 4; ++g) { const float L = wave_sum(l[g]); ofin[g] += gate[g][1] * o[g] * (L > 0.f ? 1.f / L : 0.f); }
    }
    {
        float l[4] = {0.f, 0.f, 0.f, 0.f}, o[4] = {0.f, 0.f, 0.f, 0.f};
        const int start = tau - 511 > 0 ? tau - 511 : 0;
#pragma unroll 1
        for (int base = start & ~63; base <= tau; base += 64) {
            const int kpos = base + lane; const bool valid = kpos >= start && kpos <= tau; float s[4];
            nsa_scores(kwn + ((size_t)b * SEQ + kpos) * 128 + hkv * 64, valid, qs, s);
#pragma unroll
            for (int g = 0; g < 4; ++g) { const float p = valid ? __expf(s[g]) : 0.f; l[g] += p; ps[g * 128 + lane] = p; }
            const int k0 = start > base ? start - base : 0, k1 = tau - base < 63 ? tau - base : 63;
            const bf16* vb = proj + ((size_t)b * SEQ + base) * NPROJ + PC_NVW + hkv * 64 + lane;
#pragma unroll 2
            for (int k = k0; k <= k1; ++k) { const float vv = bf2f(vb[(size_t)k * NPROJ]);
#pragma unroll
                for (int g = 0; g < 4; ++g) o[g] = fmaf(ps[g * 128 + k], vv, o[g]); } }
#pragma unroll
        for (int g = 0; g < 4; ++g) { const float L = wave_sum(l[g]); ofin[g] += gate[g][2] * o[g] * (L > 0.f ? 1.f / L : 0.f); }
    }
#pragma unroll
    for (int g = 0; g < 4; ++g) H1[(size_t)t * 512 + (hkv * 4 + g) * 64 + lane] = (bf16)f2bf(ofin[g]);
}
DI void mem_wave(Frame& F, int t, LAS float* wl) {
    unsigned char* ws = F.ws; const int lane = F.lane_id(); const int b = t >> 11;
    const bf16* mqn = (const bf16*)(ws + WS_MQN); const bf16* memkn = (const bf16*)(ws + WS_MEMKN); const bf16* memkv = (const bf16*)(ws + WS_MEMKV); bf16* H2 = (bf16*)(ws + WS_H2);
    LAS float* qs = wl;
    LAS float* ps = wl + 128;
#pragma unroll 1
    for (int h = 0; h < 4; ++h) {
        qs[lane] = bf2f(mqn[(size_t)t * 512 + h * 128 + lane]); qs[64 + lane] = bf2f(mqn[(size_t)t * 512 + h * 128 + 64 + lane]);
        float l = 0.f;
#pragma unroll 1
        for (int kq = 0; kq < 4; ++kq) { const int key = kq * 64 + lane; const bf16* kr = memkn + ((size_t)b * MEML + key) * 512 + h * 128; float s = 0.f;
#pragma unroll 2
            for (int c8 = 0; c8 < 16; ++c8) { const v4u kk = *(const v4u*)(kr + c8 * 8); const unsigned w[4] = {kk.x, kk.y, kk.z, kk.w};
#pragma unroll
                for (int j = 0; j < 4; ++j) s = fmaf(__uint_as_float(w[j] & 0xffff0000u), qs[c8 * 8 + 2 * j + 1], fmaf(__uint_as_float(w[j] << 16), qs[c8 * 8 + 2 * j], s)); }
            const float p = __expf(s); l += p; ps[key] = p; }
        const float inv = 1.f / wave_sum(l);
        float o0 = 0.f, o1 = 0.f;
        const bf16* vb = memkv + (size_t)b * MEML * 1024 + 512 + h * 128;
#pragma unroll 4
        for (int key = 0; key < MEML; ++key) { const float p = ps[key]; o0 = fmaf(p, bf2f(vb[(size_t)key * 1024 + lane]), o0); o1 = fmaf(p, bf2f(vb[(size_t)key * 1024 + 64 + lane]), o1); }
        H2[(size_t)t * 512 + h * 128 + lane] = (bf16)f2bf(o0 * inv); H2[(size_t)t * 512 + h * 128 + 64 + lane] = (bf16)f2bf(o1 * inv);
    }
}
DI void p5_mixers(Frame& F) {
    const int nml = F.G >= 128 ? 64 : 0;
#ifndef RPT_ML
#define RPT_ML 1
#endif
#ifndef RPT_NSA
#define RPT_NSA 1
#endif
#ifndef RPT_MEM
#define RPT_MEM 1
#endif
    if (F.bx < nml || nml == 0) { for (int rp = 0; rp < RPT_ML; ++rp) for (int u = F.bx; u < 64; u += (nml ? nml : F.G)) mlstm_unit2(F, u); }
    if (F.bx >= nml) {
        LAS float* wl = (LAS float*)(F.lds + F.wave * 4096);
        const int gw = (F.bx - nml) * NWAVES + F.wave, NGW = (F.G - nml) * NWAVES;
        for (int rp = 0; rp < RPT_NSA; ++rp) for (int u = F.bx - nml; u < 1024; u += F.G - nml) nsa_unit(F, u);
        __syncthreads();
        for (int rp = 0; rp < RPT_MEM; ++rp) for (int t = gw; t < MT; t += NGW) mem_wave(F, t, wl);
    }
}

DI void p8_router(Frame& F, int alt) {
    unsigned char* ws = F.ws + (size_t)alt * 3 * MiB; const int lane = F.lane_id(), tid = F.tid_id(), wave = F.wave, r = lane & 31, hh = lane >> 5;
    unsigned char* xn8 = (unsigned char*)(F.ws + WS_R1);
    int* tok_e = (int*)(ws + WS_ROUTE + RT_TOKE); int* tok_pos = (int*)(ws + WS_ROUTE + RT_TOKPOS); float* tok_w = (float*)(ws + WS_ROUTE + RT_TOKW);
    unsigned* gcnt = F.ctl + CW_ECNT + 64 * alt;
    const bf16* wrt = (const bf16*)(F.ws + WS_SMALL + SM_WRT);
    LAS unsigned char* img = F.lds;
    LAS float* part = (LAS float*)F.lds;
    LAS float* lg = (LAS float*)(F.lds + 4 * 64 * 33 * 4);
    LAS int* lcnt = (LAS int*)(F.lds + RING_BYTES + 1024);
    LAS int* lbase = lcnt + 32;
    LAS int* se = lbase + 32;
    LAS int* sp = se + 256;
    LAS float* sw = (LAS float*)(sp + 256);
    const float* gf = F.in[I_GFFN];
    for (int bt = F.bx; bt < MT / 64; bt += F.G) {
        __syncthreads();
        if (tid < 32) lcnt[tid] = 0;
#pragma unroll 2
        for (int i = 0; i < 8; ++i) {
            const int tl = wave * 8 + i, t = bt * 64 + tl;
            const f32x4* xr = (const f32x4*)(F.out + (size_t)t * DM) + lane; const f32x4* gr = (const f32x4*)gf + lane;
            f32x4 v[4]; float s = 0.f;
#pragma unroll
            for (int j = 0; j < 4; ++j) { v[j] = xr[64 * j]; s += (v[j].x * v[j].x + v[j].y * v[j].y) + (v[j].z * v[j].z + v[j].w * v[j].w); }
            const float rstd = rsqrtf(wave_sum(s) * (1.f / DM) + EPS);
            unsigned* o4 = (unsigned*)(xn8 + (size_t)t * DM) + lane;
#pragma unroll
            for (int j = 0; j < 4; ++j) { const f32x4 gg = gr[64 * j];
                const float y0 = v[j].x * rstd * gg.x, y1 = v[j].y * rstd * gg.y, y2 = v[j].z * rstd * gg.z, y3 = v[j].w * rstd * gg.w;
                const unsigned long long w = (unsigned long long)pk2(y0, y1) | ((unsigned long long)pk2(y2, y3) << 32);
                int q8 = 0; q8 = __builtin_amdgcn_cvt_pk_fp8_f32(y0, y1, q8, false); q8 = __builtin_amdgcn_cvt_pk_fp8_f32(y2, y3, q8, true);
                o4[64 * j] = (unsigned)q8;
                const int d = 4 * lane + 256 * j, ch = d >> 3;
                *(LAS unsigned long long*)(img + tl * 2048 + 16 * (ch ^ (tl & 15)) + 2 * (d & 7)) = w; }
        }
        __syncthreads();
        {
            const int mb = wave & 1, kq = wave >> 1, trow = 32 * mb + r;
            f32x16 acc;
#pragma unroll
            for (int i = 0; i < 16; ++i) acc[i] = 0.f;
#pragma unroll 4
            for (int s2 = 0; s2 < 16; ++s2) { const int st = 16 * kq + s2;
                const bf16x8 xa = *(const LAS bf16x8*)(img + trow * 2048 + 16 * ((2 * st + hh) ^ (trow & 15)));
                const bf16x8 wh = *(const bf16x8*)(wrt + (size_t)r * 1024 + 16 * st + 8 * hh), wl = *(const bf16x8*)(wrt + 32 * 1024 + (size_t)r * 1024 + 16 * st + 8 * hh);
                acc = MFMA32(xa, wh, acc); acc = MFMA32(xa, wl, acc); }
            __syncthreads();
#pragma unroll
            for (int i = 0; i < 16; ++i) part[(kq * 64 + 32 * mb + crow(i, hh)) * 33 + r] = acc[i];
        }
        __syncthreads();
        for (int i = tid; i < 64 * 32; i += 512) { const int tk = i >> 5, e = i & 31; lg[tk * 33 + e] = ((part[(0 * 64 + tk) * 33 + e] + part[(1 * 64 + tk) * 33 + e]) + (part[(2 * 64 + tk) * 33 + e] + part[(3 * 64 + tk) * 33 + e])) + F.in[I_BR][e]; }
        __syncthreads();
        for (int i = 0; i < 8; ++i) {
            const int tl = wave * 8 + i, e = lane & 31;
            float sc = lg[tl * 33 + e]; int ek[4]; float vk[4];
#pragma unroll
            for (int rd = 0; rd < 4; ++rd) { const float mx = wave_max(sc); const unsigned long long bal = __ballot(sc == mx); const int win = (__ffsll((long long)bal) - 1) & 31;
                ek[rd] = win; vk[rd] = mx; if (e == win) sc = -3.4e38f; }
            const float e1 = __expf(vk[1] - vk[0]), e2 = __expf(vk[2] - vk[0]), e3 = __expf(vk[3] - vk[0]); const float inv = 1.f / (1.f + e1 + e2 + e3);
            if (lane == 0) {
                const float wk[4] = {inv, e1 * inv, e2 * inv, e3 * inv};
#pragma unroll
                for (int rd = 0; rd < 4; ++rd) { se[tl * 4 + rd] = ek[rd]; sw[tl * 4 + rd] = wk[rd]; sp[tl * 4 + rd] = atomicAdd((int*)&lcnt[ek[rd]], 1); }
            }
        }
        __syncthreads();
        if (tid < 32) lbase[tid] = (int)atomicAdd(&gcnt[tid], (unsigned)lcnt[tid]);
        __syncthreads();
        if (tid < 256) { const int t = bt * 64 + (tid >> 2), k = tid & 3; const int e = se[tid];
          tok_e[t * 4 + k] = e; tok_pos[t * 4 + k] = lbase[e] + sp[tid]; tok_w[t * 4 + k] = sw[tid]; }
    }
    __syncthreads();
}
DI int moe_tables(Frame& F, LAS int* pstart, LAS unsigned char* blk_e) {
    unsigned* gcnt = F.ctl + CW_ECNT;
    __syncthreads();
    if (F.wave == 0) {
        const int l = F.lane_id(); int pad = 0;
        if (l < NEXP) { const int cnt = (int)__hip_atomic_load(&gcnt[l], __ATOMIC_RELAXED, __HIP_MEMORY_SCOPE_AGENT); pad = (cnt + MOEB - 1) / MOEB * MOEB; }
        int inc = pad;
#pragma unroll
        for (int o = 1; o < 32; o <<= 1) { const int v = __shfl_up(inc, o); if (l >= o) inc += v; }
        if (l < NEXP) pstart[l] = inc - pad;
        if (l == NEXP - 1) pstart[NEXP] = inc;
    }
    __syncthreads();
    const int nblk = pstart[NEXP] / MOEB;
    for (int rb = F.tid_id(); rb < nblk; rb += 512) { int e = 0; while (e < NEXP - 1 && pstart[e + 1] <= rb * MOEB) ++e; blk_e[rb] = (unsigned char)e; }
    __syncthreads();
    return nblk;
}
DI void p9_scatter(Frame& F) {
    unsigned char* ws = F.ws; const int lane = F.lane_id();
    LAS int* pstart = (LAS int*)(F.lds + 65536); LAS unsigned char* blk_e = (LAS unsigned char*)(F.lds + 65536 + 256);
    moe_tables(F, pstart, blk_e);
    const unsigned char* xn8 = (const unsigned char*)(ws + WS_R1); unsigned char* aperm = (unsigned char*)(ws + WS_APERM);
    const int* tok_e = (const int*)(ws + WS_ROUTE + RT_TOKE); const int* tok_pos = (const int*)(ws + WS_ROUTE + RT_TOKPOS); const float* tok_w = (const float*)(ws + WS_ROUTE + RT_TOKW);
    int* tok_dest = (int*)(ws + WS_ROUTE + RT_TOKDEST); float* roww = (float*)(ws + WS_ROUTE + RT_ROWW);
    unsigned* gcnt = F.ctl + CW_ECNT;
    const int gw = F.bx * NWAVES + F.wave, NGW = F.G * NWAVES;
    for (int t4 = gw; t4 < MT / 4; t4 += NGW) {
        int dest = 0;
        if (lane < 16) { const int it = t4 * 16 + lane; dest = pstart[tok_e[it]] + tok_pos[it]; tok_dest[it] = dest; roww[dest] = tok_w[it]; }
        v4u v0[4];
#pragma unroll
        for (int q = 0; q < 4; ++q) { const v4u* src = (const v4u*)(xn8 + (size_t)(t4 * 4 + q) * DM); v0[q] = src[lane]; }
#pragma unroll
        for (int q = 0; q < 4; ++q)
#pragma unroll
            for (int k = 0; k < 4; ++k) { const int d = __shfl(dest, q * 4 + k); v4u* dst = (v4u*)(aperm + (size_t)d * DM); dst[lane] = v0[q]; }
    }
    for (int it = gw; it < NEXP * MOEB; it += NGW) { const int e = it >> 8, i = it & 255; const int cnt = (int)__hip_atomic_load(&gcnt[e], __ATOMIC_RELAXED, __HIP_MEMORY_SCOPE_AGENT); const int padded = (cnt + MOEB - 1) / MOEB * MOEB;
        if (i < padded - cnt) { const int dest = pstart[e] + cnt + i; v4u* dst = (v4u*)(aperm + (size_t)dest * DM); const v4u z = {0u, 0u, 0u, 0u}; dst[lane] = z; if (lane == 0) roww[dest] = 0.f; } }
}
DI void p12_combine(Frame& F) {
    unsigned char* ws = F.ws; const int lane = F.lane_id();
    const bf16* ybuf = (const bf16*)(ws + WS_APERM); const int* tok_dest = (const int*)(ws + WS_ROUTE + RT_TOKDEST);
    const int gw = F.bx * NWAVES + F.wave, NGW = F.G * NWAVES;
    for (int t2 = gw; t2 < MT / 2; t2 += NGW) {
        typedef int i32x4 __attribute__((ext_vector_type(4)));
        unsigned long long w[2][4][4]; f32x4 a[2][4];
#pragma unroll
        for (int q = 0; q < 2; ++q) { const int t = 2 * t2 + q; const f32x4* orow = (const f32x4*)(F.out + (size_t)t * DM);
            const i32x4 d = *(const i32x4*)(tok_dest + t * 4);
            const unsigned long long* y0 = (const unsigned long long*)(ybuf + (size_t)d.x * DM) + lane; const unsigned long long* y1 = (const unsigned long long*)(ybuf + (size_t)d.y * DM) + lane;
            const unsigned long long* y2 = (const unsigned long long*)(ybuf + (size_t)d.z * DM) + lane; const unsigned long long* y3 = (const unsigned long long*)(ybuf + (size_t)d.w * DM) + lane;
#pragma unroll
            for (int j = 0; j < 4; ++j) { w[q][0][j] = y0[64 * j]; w[q][1][j] = y1[64 * j]; w[q][2][j] = y2[64 * j]; w[q][3][j] = y3[64 * j]; a[q][j] = orow[lane + 64 * j]; } }
#pragma unroll
        for (int q = 0; q < 2; ++q) { f32x4* orow = (f32x4*)(F.out + (size_t)(2 * t2 + q) * DM);
#pragma unroll
            for (int j = 0; j < 4; ++j) {
#pragma unroll
                for (int k = 0; k < 4; ++k) { const unsigned long long ww = w[q][k][j];
                    a[q][j].x += __uint_as_float((unsigned)ww << 16); a[q][j].y += __uint_as_float((unsigned)ww & 0xffff0000u); a[q][j].z += __uint_as_float((unsigned)(ww >> 32) << 16); a[q][j].w += __uint_as_float((unsigned)(ww >> 32) & 0xffff0000u); }
                orow[lane + 64 * j] = a[q][j]; } }
    }
}

constexpr int N_PHASES = 13;
#ifndef MK_PER_PHASE
#define MK_PER_PHASE 0
#endif
__global__ void __launch_bounds__(NWAVES * 64, 2) fwd_kernel(Args args) {
    extern __shared__ __attribute__((aligned(16))) unsigned char lds_raw[];
    Frame F;
    F.lds = (LAS unsigned char*)lds_raw; F.MISC = (volatile LAS unsigned*)(F.lds + MISC_OFF);
    F.wave = __builtin_amdgcn_readfirstlane((int)(threadIdx.x >> 6)); F.G = gridDim.x; F.bx = blockIdx.x;
    F.ws = args.ws; F.ctl = (unsigned*)(args.ws + WS_CTL); F.in = args.in; F.out = args.out;
    unsigned char* ws = args.ws;
    for (int u = threadIdx.x; u < (LDS_BYTES - LDSCTL_OFF) / 4; u += NWAVES * 64) ((LAS unsigned*)(F.lds + LDSCTL_OFF))[u] = 0u;
    __syncthreads();
    const int lo = args.ph_lo, hi = args.ph_hi;
    XcdBarrier bar; bar.wv = F.wave; bar.bar = F.ctl + CW_BAR; bar.x = 0; bar.st = nullptr;
    if (hi - lo > 1) bar = xcd_barrier_post(F.ctl + CW_BAR, F.MISC + 8, F.wave);
#ifndef PH_MASK
#define PH_MASK 0x1fff
#endif
#define IN(k) (((PH_MASK >> (k)) & 1) && lo <= (k) && (k) < hi)
#define SEAM(k) do { if (IN(k) && IN((k) + 1)) xcd_barrier(bar); } while (0)
    typedef pg8::bf16_t b16;
#ifndef RPT_MASK
#define RPT_MASK 0
#endif
#define RPT(k) _Pragma("unroll") for (int rp_ = 0; rp_ < 1 + ((RPT_MASK >> (k)) & 1); ++rp_)
    if (IN(0)) { RPT(0) p0_prologue(F); } SEAM(0);
    if (IN(1)) RPT(1) {
        { pg8::Gemm8 g{(const unsigned char*)(ws + WS_U8), (const unsigned char*)(ws + WS_WIN8), MT, NF8, DM, 0x7f7f7f7f, 0x77777777}; pg8::StaticOrder S; S.init(MT, NF8, F.G, F.bx);
          pg8::EpiBf16Silu E{(b16*)(ws + WS_PROJ) + NB16, NPROJ, nullptr, 0};
          pg8::gemm_phase_f8<pg8::EpiBf16Silu, pg8::StaticOrder, true, true>(F.lds, g, S, E, F.wave); }
        { pg8::Gemm g{(const b16*)(ws + WS_R1), (const b16*)(ws + WS_WIN), MT, NB16, DM}; pg8::StaticOrder S; S.init(MT, NB16, F.G, F.bx);
          pg8::EpiBf16Silu E{(b16*)(ws + WS_PROJ), NPROJ, nullptr, 0};
          pg8::gemm_phase<pg8::EpiBf16Silu, pg8::StaticOrder, true, true>(F.lds, g, S, E, F.wave); }
        { pg8::Gemm g{(const b16*)(ws + WS_MEMN), (const b16*)(ws + WS_WMKV), MROWS, 1024, DM}; pg8::StaticOrder S; S.init(MROWS, 1024, F.G, (F.bx + 64) % F.G);
          pg8::EpiBf16Silu E{(b16*)(ws + WS_MEMKV), 1024, nullptr, 0};
          pg8::gemm_phase<pg8::EpiBf16Silu, pg8::StaticOrder, true, true>(F.lds, g, S, E, F.wave); }
    } SEAM(1);
    if (IN(2)) { RPT(2) { p2_compress(F); p2_prep(F); } }
    if (IN(2) && IN(5)) xcd_barrier(bar);
#ifndef RPT5_ML
#define RPT5_ML 0
#endif
#ifndef MLPROBE
#define MLPROBE 0xff
#endif
#ifndef NPROBE_ST
#define NPROBE_ST true
#endif
#ifndef NPROBE_CMP
#define NPROBE_CMP true
#endif
#ifndef NPROBE_SEL
#define NPROBE_SEL true
#endif
#ifndef NPROBE_WIN
#define NPROBE_WIN true
#endif
#ifndef MPROBE_ST
#define MPROBE_ST true
#endif
#ifndef MPROBE_DMA
#define MPROBE_DMA true
#endif
#ifndef MPROBE_COMP
#define MPROBE_COMP true
#endif
#ifndef RPT5_NSA
#define RPT5_NSA 0
#endif
#ifndef RPT5_MEM
#define RPT5_MEM 0
#endif
    if (IN(5)) { p5_queue<true, true, true>(F, 0);
        if (RPT5_ML || RPT5_NSA || RPT5_MEM) { xcd_barrier(bar); p5_queue<RPT5_ML != 0, RPT5_NSA != 0, RPT5_MEM != 0, MPROBE_ST, MPROBE_DMA, MPROBE_COMP, NPROBE_ST, NPROBE_CMP, NPROBE_SEL, NPROBE_WIN, MLPROBE>(F, 256); } } SEAM(5);
    if (IN(6)) RPT(6) {
        pg8::StaticOrder S; S.init(MT, DM, F.G, F.bx);
        pg8::Gemm g{(const b16*)(ws + WS_H0), (const b16*)(ws + WS_WBR), MT, DM, 1536};
        pg8::EpiMergeK E{(const b16*)(ws + WS_PROJ), (b16*)(ws + WS_R1)};
        pg8::gemm_phase<pg8::EpiMergeK, pg8::StaticOrder, true, true>(F.lds, g, S, E, F.wave);
    } SEAM(6);
    if (IN(7)) RPT(7) {
        pg8::Gemm g{(const b16*)(ws + WS_R1), (const b16*)(ws + WS_WOUT), MT, DM, DM}; pg8::StaticOrder S; S.init(MT, DM, F.G, F.bx);
        pg8::EpiRes E{F.in[I_X], F.out};
        pg8::gemm_phase<pg8::EpiRes, pg8::StaticOrder, true, true>(F.lds, g, S, E, F.wave);
    } SEAM(7);
    if (IN(8)) { p8_router(F, 0); if ((RPT_MASK >> 8) & 1) p8_router(F, 1); } SEAM(8);
    if (IN(9)) { RPT(9) p9_scatter(F); } SEAM(9);
    if (IN(10)) RPT(10) {
        LAS int* pstart = (LAS int*)(F.lds + RING_BYTES + 1024); LAS unsigned char* blk_e = (LAS unsigned char*)(F.lds + RING_BYTES + 1024 + 256);
        const int nblk = moe_tables(F, pstart, blk_e);
        pg8::Gemm8 g{(const unsigned char*)(ws + WS_APERM), (const unsigned char*)(ws + WS_WGU), CAP, NEXP * 2048, DM, 0x7f7f7f7f, 0x77777777};
        pg8::MoeOrder<8> S{nblk, F.G, F.bx, (const PG8_LAS unsigned char*)blk_e};
        pg8::EpiSwiglu E{(unsigned char*)(ws + WS_ACT), F.in[I_BGU]};
        pg8::gemm_phase_f8<pg8::EpiSwiglu, pg8::MoeOrder<8>, true, true>(F.lds, g, S, E, F.wave);
    } SEAM(10);
    if (IN(11)) RPT(11) {
        LAS int* pstart = (LAS int*)(F.lds + RING_BYTES + 1024); LAS unsigned char* blk_e = (LAS unsigned char*)(F.lds + RING_BYTES + 1024 + 256);
        const int nblk = moe_tables(F, pstart, blk_e);
        pg8::Gemm8 g{(const unsigned char*)(ws + WS_ACT), (const unsigned char*)(ws + WS_WDN), CAP, NEXP * DM, DFF, 0x7f7f7f7f, 0x77777777};
        pg8::MoeOrder<4> S{nblk, F.G, F.bx, (const PG8_LAS unsigned char*)blk_e};
        pg8::EpiDown E{(b16*)(ws + WS_APERM), F.in[I_BDN], (const float*)(ws + WS_ROUTE + RT_ROWW)};
        pg8::gemm_phase_f8<pg8::EpiDown, pg8::MoeOrder<4>, true, true>(F.lds, g, S, E, F.wave);
    } SEAM(11);
    if (IN(12)) { p12_combine(F); }
#undef IN
#undef SEAM
}

extern "C" void kernel_launch(void* const* d_in, const int* in_sizes, int n_in, void* d_out, int out_size, void* d_ws, size_t ws_size, hipStream_t stream) {
    static int grid = 0;
    if (grid == 0) {
        if (n_in != N_IN || out_size != MT * DM || ws_size < WS_END) { fprintf(stderr, "kernel_launch: unexpected shapes (n_in %d, out %d, ws %zu need %zu)\n", n_in, out_size, ws_size, (size_t)WS_END); grid = -1; return; }
        int dev = 0, cus = 0, per_cu = 0;
        if (hipGetDevice(&dev) != hipSuccess || hipDeviceGetAttribute(&cus, hipDeviceAttributeMultiprocessorCount, dev) != hipSuccess) { grid = -1; return; }
        if (hipFuncSetAttribute((const void*)fwd_kernel, hipFuncAttributeMaxDynamicSharedMemorySize, LDS_BYTES) != hipSuccess) { fprintf(stderr, "kernel_launch: hipFuncSetAttribute failed\n"); grid = -1; return; }
        if (hipOccupancyMaxActiveBlocksPerMultiprocessor(&per_cu, (const void*)fwd_kernel, NWAVES * 64, LDS_BYTES) != hipSuccess || per_cu < 1) { fprintf(stderr, "kernel_launch: occupancy query says %d\n", per_cu); }
        (void)hipGetLastError();
        grid = cus;
    }
    if (grid < 0) return;
    if (hipMemsetAsync((char*)d_ws + WS_CTL, 0, CTL_ZERO_BYTES, stream) != hipSuccess) return;
    Args a{};
    for (int i = 0; i < N_IN; ++i) a.in[i] = (const float*)d_in[i];
    a.out = (float*)d_out; a.ws = (unsigned char*)d_ws;
#if MK_PER_PHASE
    for (int p = 0; p < N_PHASES; ++p) { a.ph_lo = p; a.ph_hi = p + 1; a.li = 0; hipLaunchKernelGGL(fwd_kernel, dim3(grid), dim3(NWAVES * 64), LDS_BYTES, stream, a); }
#else
    a.ph_lo = 0; a.ph_hi = N_PHASES; a.li = 0;
    hipLaunchKernelGGL(fwd_kernel, dim3(grid), dim3(NWAVES * 64), LDS_BYTES, stream, a);
#endif
}
```

```cpp
#include <hip/hip_runtime.h>
#include <cstdio>
#include <cstdint>
namespace pg8 {
#define PG8_LAS __attribute__((address_space(3)))
typedef unsigned short bf16_t;
typedef short bf16x8 __attribute__((ext_vector_type(8)));
typedef float f32x4 __attribute__((ext_vector_type(4)));
typedef unsigned u32x4 __attribute__((ext_vector_type(4)));
constexpr int BM = 256, BK = 64, HALF = 128, HTB = HALF * BK * 2  , STAGE_BYTES = 8 * HTB, NXCD = 8, WGM = 8;

__host__ __device__ __forceinline__ int lds_byte(int r, int c) { const int st = (r >> 4) * 2 + (c >> 5), rr = r & 15, cc = c & 31, ob = rr * 64 + cc * 2; return st * 1024 + (ob ^ (((ob >> 9) & 1) << 5)); }
__host__ __device__ __forceinline__ void stage_rc(int b, int& R, int& C) { const int st = b / 1024, sb = b % 1024, swz = sb ^ (((sb >> 9) & 1) << 5); R = (st >> 1) * 16 + swz / 64; C = (st & 1) * 32 + (swz % 64) / 2; }
__host__ __device__ __forceinline__ int perm32(int rho) { const int n = rho >> 4, i = rho & 15; return 8 * (i >> 2) + 4 * n + (i & 3); }

struct Unit { int pm, pn; };
struct Gemm { const bf16_t* A; const bf16_t* Bt; int M, N, K; };

struct StaticOrder {
    int nM, nN, nwg, G, c;
    __host__ __device__ void init(int M, int N, int G_, int c_) { nM = M / BM; nN = N / BM; nwg = nM * nN; G = G_; c = c_; }
    __host__ __device__ bool next(int i, Unit& u) const {
        const long L = (long)i * G + c; if (L >= nwg) return false;
        int wgid = (int)L; { const int q = nwg / NXCD, r = nwg % NXCD, xcd = wgid % NXCD, off = wgid / NXCD; wgid = (xcd < r ? xcd * (q + 1) : r * (q + 1) + (xcd - r) * q) + off; }
        const int nig = WGM * nN, gid = wgid / nig, fm = gid * WGM, gsz = (nM - fm) < WGM ? (nM - fm) : WGM;
        u.pm = fm + ((wgid % nig) % gsz); u.pn = (wgid % nig) / gsz; return true;
    }
    __device__ __forceinline__ void a_ready(const Unit&) const {}
    __device__ __forceinline__ void done(const Unit&) const {}
};

__device__ __forceinline__ unsigned cvt_pk_bf16(float lo, float hi) { unsigned r; asm volatile("v_cvt_pk_bf16_f32 %0, %1, %2" : "=v"(r) : "v"(lo), "v"(hi)); return r; }
typedef float f32x2 __attribute__((ext_vector_type(2)));
__device__ __forceinline__ f32x2 gelu_pk(f32x2 v) {
    const f32x2 av = __builtin_elementwise_abs(v), d = av * 0.2316418882f + 1.0f;
    f32x2 t; t.x = __builtin_amdgcn_rcpf(d.x); t.y = __builtin_amdgcn_rcpf(d.y);
    f32x2 q = t * 0.5307027145f + (-0.7265760135f); q = q * t + 0.7107068705f; q = q * t + (-0.142248368f); q = q * t + 0.127414796f; q = q * t;
    const f32x2 s = (v * v) * (-0.72134752044f);
    f32x2 e; e.x = __builtin_amdgcn_exp2f(s.x); e.y = __builtin_amdgcn_exp2f(s.y);
    const f32x2 m = v * (q * e), r = v - m;
    f32x2 o; o.x = v.x < 0.f ? m.x : r.x; o.y = v.y < 0.f ? m.y : r.y; return o;
}

template <int ACT  > struct EpiBf16 {
    static constexpr bool PERM = true, AFTER_DRAIN = false; static_assert(ACT == 0 || ACT == 1, "EpiBf16: ACT is 0 (none) or 1 (gelu_pk)");
    bf16_t* O; int ldc; const float* bias; int split_cols; size_t split_stride; float scale0;
    __device__ __forceinline__ void operator()(const f32x4 (&acc)[2][2][4][2], const Unit& u, int wr, int wc, int fr, int fq) const {
        const int row0 = u.pm * BM + wr * 64 + fr; int colt = u.pn * BM; bf16_t* base = O;
        float sc = 1.f; if (split_cols) { const int t = colt / split_cols; base += (size_t)t * split_stride; colt -= t * split_cols; if (t == 0) sc = scale0; }
        const int col0 = colt + wc * 32 + 8 * fq, bcol0 = u.pn * BM + wc * 32 + 8 * fq;
        f32x4 bv[2][2];
#pragma unroll
        for (int bj = 0; bj < 2; ++bj)
#pragma unroll
            for (int n = 0; n < 2; ++n) bv[bj][n] = bias ? *(const f32x4*)(bias + bcol0 + bj * HALF + 4 * n) : (f32x4){0.f, 0.f, 0.f, 0.f};
#pragma unroll
        for (int ai = 0; ai < 2; ++ai)
#pragma unroll
            for (int m = 0; m < 4; ++m) { bf16_t* rowp = base + (size_t)(row0 + ai * HALF + m * 16) * ldc + col0;
#pragma unroll
                for (int bj = 0; bj < 2; ++bj) { f32x4 v0 = acc[ai][bj][m][0] + bv[bj][0], v1 = acc[ai][bj][m][1] + bv[bj][1];
                    if (ACT == 1) { f32x2 a = gelu_pk((f32x2){v0[0], v0[1]}), b = gelu_pk((f32x2){v0[2], v0[3]}), c = gelu_pk((f32x2){v1[0], v1[1]}), d = gelu_pk((f32x2){v1[2], v1[3]});
                        v0 = (f32x4){a.x, a.y, b.x, b.y}; v1 = (f32x4){c.x, c.y, d.x, d.y}; }
                    v0 = v0 * sc; v1 = v1 * sc; u32x4 w; w.x = cvt_pk_bf16(v0[0], v0[1]); w.y = cvt_pk_bf16(v0[2], v0[3]); w.z = cvt_pk_bf16(v1[0], v1[1]); w.w = cvt_pk_bf16(v1[2], v1[3]);
                    *(u32x4*)(rowp + bj * HALF) = w; } }
    }
};

struct PanelStats {
    unsigned* xbuf;
    unsigned* cnt;
    unsigned* tmo;
    int ntn; float eps;
    unsigned code;
    __device__ __forceinline__ bool run(const f32x4 (&v)[2][2][4][2], const Unit& u, int wr, int wc, int fr, int fq, PG8_LAS unsigned char* lds, int wid, int lane) const {
        typedef float f32x2v __attribute__((ext_vector_type(2)));
        PG8_LAS f32x2v* P = (PG8_LAS f32x2v*)lds;
        PG8_LAS f32x2v* S = (PG8_LAS f32x2v*)(lds + 8192);
        PG8_LAS unsigned* flag = (PG8_LAS unsigned*)(lds + 8192 + 2048);
#pragma unroll
        for (int ai = 0; ai < 2; ++ai)
#pragma unroll
            for (int m = 0; m < 4; ++m) {
                float s = 0.f;
#pragma unroll
                for (int bj = 0; bj < 2; ++bj)
#pragma unroll
                    for (int n = 0; n < 2; ++n) { const f32x4 x = v[ai][bj][m][n]; s += (x[0] + x[1]) + (x[2] + x[3]); }
                s += __shfl_xor(s, 16); s += __shfl_xor(s, 32);
                const float mw = s * (1.0f / 64.0f); float q = 0.f;
#pragma unroll
                for (int bj = 0; bj < 2; ++bj)
#pragma unroll
                    for (int n = 0; n < 2; ++n) { const f32x4 d = v[ai][bj][m][n] - mw; q += (d[0] * d[0] + d[1] * d[1]) + (d[2] * d[2] + d[3] * d[3]); }
                q += __shfl_xor(q, 16); q += __shfl_xor(q, 32);
                if (fq == 0) P[(ai * HALF + wr * 64 + m * 16 + fr) * 4 + wc] = (f32x2v){mw, q};
            }
        asm volatile("s_waitcnt lgkmcnt(0)" ::: "memory"); __builtin_amdgcn_s_barrier(); asm volatile("" ::: "memory");
#if defined(BROKEN_EXCHANGE_NO_WAIT)
#warning BROKEN CONTROL BUILD: the row-statistics exchange does not wait; results are wrong by design
        if (blockIdx.x >= 64) { const long long t0_ = clock64(); while (clock64() - t0_ < 60000) __builtin_amdgcn_s_sleep(8); }
#endif
        const int row = wid * 32 + (lane & 31);
        if (lane < 32) {
            const f32x2v a = P[row * 4 + 0], b = P[row * 4 + 1], c = P[row * 4 + 2], d = P[row * 4 + 3];
            const float mt = (a.x + b.x + c.x + d.x) * 0.25f;
            const float da = a.x - mt, db = b.x - mt, dc = c.x - mt, dd = d.x - mt;
            const float m2 = (a.y + b.y) + (c.y + d.y) + 64.0f * ((da * da + db * db) + (dc * dc + dd * dd));
            unsigned long long* slot = (unsigned long long*)xbuf + ((size_t)(u.pm * BM + row) * 4 + u.pn);
            __hip_atomic_store(slot, ((unsigned long long)__float_as_uint(m2) << 32) | __float_as_uint(mt), __ATOMIC_RELAXED, __HIP_MEMORY_SCOPE_AGENT);
        }
        asm volatile("s_waitcnt vmcnt(0)" ::: "memory");
        if (lane == 0) __hip_atomic_fetch_add(cnt + 64 * u.pm, 1u, __ATOMIC_RELAXED, __HIP_MEMORY_SCOPE_AGENT);
        if (wid == 0) {
            bool dead = false; const unsigned long long t0 = __builtin_amdgcn_s_memrealtime(); const unsigned want = 8u * (unsigned)ntn;
            for (;;) {
#if defined(BROKEN_EXCHANGE_NO_WAIT)
                break;
#endif
                if ((unsigned)__builtin_amdgcn_readfirstlane(__hip_atomic_load(cnt + 64 * u.pm, __ATOMIC_RELAXED, __HIP_MEMORY_SCOPE_AGENT)) >= want) break;
                if (__builtin_amdgcn_s_memrealtime() - t0 > 2000000ull) {
                    if (lane == 0) { unsigned expect = 0u; __hip_atomic_compare_exchange_strong(tmo + 1, &expect, code | (unsigned)(u.pm & 0xff), __ATOMIC_RELAXED, __ATOMIC_RELAXED, __HIP_MEMORY_SCOPE_AGENT);
                                     __hip_atomic_store(tmo, 1u, __ATOMIC_RELAXED, __HIP_MEMORY_SCOPE_AGENT); }
                    dead = true; break; }
                __builtin_amdgcn_s_sleep(2);
            }
            __builtin_amdgcn_fence(__ATOMIC_ACQUIRE, "agent");
            if (lane == 0) flag[0] = dead ? 1u : 0u;
        }
        asm volatile("s_waitcnt vmcnt(0) lgkmcnt(0)" ::: "memory"); __builtin_amdgcn_s_barrier(); asm volatile("" ::: "memory");
        const bool bad = flag[0] != 0u;
        if (lane < 32) {
            const unsigned long long* slot = (const unsigned long long*)xbuf + (size_t)(u.pm * BM + row) * 4; float mt[4], m2[4]; float ms = 0.f;
#pragma unroll
            for (int t = 0; t < 4; ++t) { if (t < ntn) { const unsigned long long w = __hip_atomic_load(slot + t, __ATOMIC_RELAXED, __HIP_MEMORY_SCOPE_AGENT); mt[t] = __uint_as_float((unsigned)w); m2[t] = __uint_as_float((unsigned)(w >> 32)); } else { mt[t] = 0.f; m2[t] = 0.f; } ms += mt[t]; }
            const float mean = ms / (float)ntn; float q = 0.f;
#pragma unroll
            for (int t = 0; t < 4; ++t) if (t < ntn) { const float dm = mt[t] - mean; q += m2[t] + 256.0f * dm * dm; }
            S[row] = (f32x2v){mean, 1.0f / sqrtf(q / (256.0f * (float)ntn) + eps)};
        }
        asm volatile("s_waitcnt lgkmcnt(0)" ::: "memory"); __builtin_amdgcn_s_barrier(); asm volatile("" ::: "memory");
        return bad;
    }
};
struct EpiLnRes {
    static constexpr bool PERM = false, AFTER_DRAIN = true;
    const float* base; float* out; int ldc; const float* bias; PanelStats st; unsigned poison;
    __device__ __forceinline__ void fused(f32x4 (&acc)[2][2][4][2], const Unit& u, int wr, int wc, int fr, int fq, PG8_LAS unsigned char* lds, int wid, int lane) const {
        typedef float f32x2v __attribute__((ext_vector_type(2)));
        const PG8_LAS f32x2v* S = (const PG8_LAS f32x2v*)(lds + 8192);
        const int col0 = u.pn * BM + wc * 32 + 4 * fq;
#pragma unroll
        for (int bj = 0; bj < 2; ++bj)
#pragma unroll
            for (int n = 0; n < 2; ++n) { const f32x4 bv = bias ? *(const f32x4*)(bias + col0 + bj * HALF + n * 16) : (f32x4){0.f, 0.f, 0.f, 0.f};
#pragma unroll
                for (int ai = 0; ai < 2; ++ai)
#pragma unroll
                    for (int m = 0; m < 4; ++m) acc[ai][bj][m][n] += bv; }
        f32x4 pre[4][2][2];
#pragma unroll
        for (int m = 0; m < 4; ++m) { const size_t off = (size_t)(u.pm * BM + wr * 64 + m * 16 + fr) * ldc + col0;
#pragma unroll
            for (int bj = 0; bj < 2; ++bj)
#pragma unroll
                for (int n = 0; n < 2; ++n) pre[m][bj][n] = *(const f32x4*)(base + off + bj * HALF + n * 16); }
        const bool bad = st.run(acc, u, wr, wc, fr, fq, lds, wid, lane) || poison != 0u;
        const float qnan = __builtin_nanf("");
#pragma unroll
        for (int ai = 0; ai < 2; ++ai)
#pragma unroll
            for (int m = 0; m < 4; ++m) { const int r = ai * HALF + wr * 64 + m * 16 + fr; const f32x2v sr = S[r]; const size_t off = (size_t)(u.pm * BM + r) * ldc + col0;
#pragma unroll
                for (int bj = 0; bj < 2; ++bj)
#pragma unroll
                    for (int n = 0; n < 2; ++n) { const f32x4 bs = ai == 0 ? pre[m][bj][n] : *(const f32x4*)(base + off + bj * HALF + n * 16); f32x4 o = bs + (acc[ai][bj][m][n] - sr.x) * sr.y;
                        if (bad) o = (f32x4){qnan, qnan, qnan, qnan}; *(f32x4*)(out + off + bj * HALF + n * 16) = o; }
                if (m & 1) asm volatile("" ::: "memory"); }
    }
};
struct EpiLnResLn {
    static constexpr bool PERM = false, AFTER_DRAIN = true;
    const float* base; float* out; bf16_t* xn; int ldc; const float* bias; PanelStats st1, st2; unsigned poison;
    __device__ __forceinline__ void fused(f32x4 (&acc)[2][2][4][2], const Unit& u, int wr, int wc, int fr, int fq, PG8_LAS unsigned char* lds, int wid, int lane) const {
        typedef float f32x2v __attribute__((ext_vector_type(2))); typedef unsigned u32x2v __attribute__((ext_vector_type(2)));
        const PG8_LAS f32x2v* S = (const PG8_LAS f32x2v*)(lds + 8192);
        const int col0 = u.pn * BM + wc * 32 + 4 * fq;
#pragma unroll
        for (int bj = 0; bj < 2; ++bj)
#pragma unroll
            for (int n = 0; n < 2; ++n) { const f32x4 bv = bias ? *(const f32x4*)(bias + col0 + bj * HALF + n * 16) : (f32x4){0.f, 0.f, 0.f, 0.f};
#pragma unroll
                for (int ai = 0; ai < 2; ++ai)
#pragma unroll
                    for (int m = 0; m < 4; ++m) acc[ai][bj][m][n] += bv; }
        bool bad = st1.run(acc, u, wr, wc, fr, fq, lds, wid, lane) || poison != 0u;
        const float qnan = __builtin_nanf("");
#pragma unroll
        for (int ai = 0; ai < 2; ++ai)
#pragma unroll
            for (int m = 0; m < 4; ++m) { const int r = ai * HALF + wr * 64 + m * 16 + fr; const f32x2v sr = S[r]; const size_t off = (size_t)(u.pm * BM + r) * ldc + col0;
#pragma unroll
                for (int bj = 0; bj < 2; ++bj)
#pragma unroll
                    for (int n = 0; n < 2; ++n) { const f32x4 bs = *(const f32x4*)(base + off + bj * HALF + n * 16); acc[ai][bj][m][n] = bs + (acc[ai][bj][m][n] - sr.x) * sr.y; }
                asm volatile("" : "+v"(acc[ai][0][m][0]), "+v"(acc[ai][0][m][1]), "+v"(acc[ai][1][m][0]), "+v"(acc[ai][1][m][1]));
                if (m & 1) asm volatile("" ::: "memory"); }
        const bool bad1 = bad;
        bad = st2.run(acc, u, wr, wc, fr, fq, lds, wid, lane) || bad;
#pragma unroll
        for (int ai = 0; ai < 2; ++ai)
#pragma unroll
            for (int m = 0; m < 4; ++m) { const int r = ai * HALF + wr * 64 + m * 16 + fr; const f32x2v sr = S[r]; const size_t off = (size_t)(u.pm * BM + r) * ldc + col0;
#pragma unroll
                for (int bj = 0; bj < 2; ++bj)
#pragma unroll
                    for (int n = 0; n < 2; ++n) { const f32x4 x1 = acc[ai][bj][m][n]; *(f32x4*)(out + off + bj * HALF + n * 16) = bad1 ? (f32x4){qnan, qnan, qnan, qnan} : x1;
                        const f32x4 o = (x1 - sr.x) * sr.y; u32x2v w; w.x = cvt_pk_bf16(o[0], o[1]); w.y = cvt_pk_bf16(o[2], o[3]);
                        if (bad) { w.x = 0x7fc07fc0u; w.y = 0x7fc07fc0u; } *(u32x2v*)(xn + off + bj * HALF + n * 16) = w; }
                asm volatile("" ::: "memory"); }
    }
};

template <class E, class = void> struct MidSeg { static constexpr int v = 0; };
template <class E> struct MidSeg<E, decltype((void)E::MIDSEG)> { static constexpr int v = E::MIDSEG; };
template <class Epi, class Sched, bool ALIGN_EPI = false, bool SP2 = false>
__device__ __forceinline__ void gemm_phase(PG8_LAS unsigned char* lds, const Gemm g, const Sched& S, const Epi& E, int wid_in) {
    int lane_; asm volatile("v_mbcnt_lo_u32_b32 %0, -1, 0\n\tv_mbcnt_hi_u32_b32 %0, -1, %0" : "=v"(lane_));
    const int wid = wid_in, lane = lane_, tid = wid * 64 + lane, wr = wid >> 2, wc = wid & 3, fr = lane & 15, fq = lane >> 4;
    const int K = g.K, nt = K / BK;
    unsigned voffA[2], voffB[2];
#pragma unroll
    for (int i = 0; i < 2; ++i) { int R, C; stage_rc(tid * 16 + i * 8192, R, C); const int Rb = Epi::PERM ? ((R & ~31) + perm32(R & 31)) : R;
        voffA[i] = (unsigned)(R * K + C) * 2u; voffB[i] = (unsigned)(Rb * K + C) * 2u; }
    const size_t kstep = (size_t)(BK * 2);
    const size_t hstep = (size_t)HALF * K * 2;
    const size_t tstep = 2 * hstep;
    const unsigned ldsw = (unsigned)wid * 1024u;
    const int aoff = lds_byte(wr * 64 + fr, fq * 8), boff = lds_byte(wc * 32 + fr, fq * 8);
#define PG8_SA(b, h) (((b) * 2 + (h)) * HTB)
#define PG8_SB(b, h) ((4 + (b) * 2 + (h)) * HTB)
#define PG8_STAGE(bufoff, gbase, voff) do { _Pragma("unroll") for (int _i = 0; _i < 2; ++_i) \
        __builtin_amdgcn_global_load_lds((const unsigned*)((const char*)(gbase) + (voff)[_i]), (PG8_LAS unsigned*)(lds + (bufoff) + ldsw + _i * 8192), 16, 0, 0); } while (0)
#define PG8_LDA(dst, b, h) do { _Pragma("unroll") for (int m = 0; m < 4; ++m) _Pragma("unroll") for (int k = 0; k < 2; ++k) dst[m][k] = *(const PG8_LAS bf16x8*)(lds + PG8_SA(b, h) + aoff + m * 2048 + k * 1024); } while (0)
#define PG8_LDB(dst, b, h) do { _Pragma("unroll") for (int n = 0; n < 2; ++n) _Pragma("unroll") for (int k = 0; k < 2; ++k) dst[n][k] = *(const PG8_LAS bf16x8*)(lds + PG8_SB(b, h) + boff + n * 2048 + k * 1024); } while (0)
#define PG8_MMA(ai, bj, At, Bt) do { __builtin_amdgcn_s_setprio(1); _Pragma("unroll") for (int m = 0; m < 4; ++m) _Pragma("unroll") for (int n = 0; n < 2; ++n) _Pragma("unroll") for (int k = 0; k < 2; ++k) \
        acc[ai][bj][m][n] = __builtin_amdgcn_mfma_f32_16x16x32_bf16(Bt[n][k], At[m][k], acc[ai][bj][m][n], 0, 0, 0); __builtin_amdgcn_s_setprio(0); } while (0)
#define PG8_WAIT_V(n) asm volatile("s_waitcnt vmcnt(" #n ")" ::: "memory")
#define PG8_WAIT_L(n) asm volatile("s_waitcnt lgkmcnt(" #n ")" ::: "memory")
#define PG8_BAR __builtin_amdgcn_s_barrier()
#define PG8_SCHED __builtin_amdgcn_sched_barrier(0)
    Unit cur, nxt; int ui = 0;
    if (!S.next(0, cur)) return;
    f32x4 acc[2][2][4][2];
#pragma unroll
    for (int a = 0; a < 2; ++a)
#pragma unroll
        for (int b = 0; b < 2; ++b)
#pragma unroll
            for (int m = 0; m < 4; ++m)
#pragma unroll
                for (int n = 0; n < 2; ++n) acc[a][b][m][n] = (f32x4){0.f, 0.f, 0.f, 0.f};
    bf16x8 At[4][2], B0[2][2], B1[2][2];
    const char* cA = (const char*)g.A + (size_t)cur.pm * tstep; const char* cB = (const char*)g.Bt + (size_t)cur.pn * tstep;
    S.a_ready(cur);
    if constexpr (SP2) {
        PG8_STAGE(PG8_SB(0, 0), cB, voffB); PG8_STAGE(PG8_SB(0, 1), cB + hstep, voffB); PG8_STAGE(PG8_SA(0, 0), cA, voffA); PG8_STAGE(PG8_SA(0, 1), cA + hstep, voffA);
        if (wr == 1) PG8_BAR;
        PG8_WAIT_V(2); PG8_BAR;
        PG8_STAGE(PG8_SB(1, 0), cB + kstep, voffB); PG8_STAGE(PG8_SA(1, 0), cA + kstep, voffA); PG8_STAGE(PG8_SB(1, 1), cB + hstep + kstep, voffB);
        PG8_WAIT_V(6); PG8_BAR;
    } else {
        PG8_STAGE(PG8_SB(0, 0), cB, voffB); PG8_STAGE(PG8_SA(0, 0), cA, voffA); PG8_STAGE(PG8_SB(0, 1), cB + hstep, voffB); PG8_STAGE(PG8_SA(0, 1), cA + hstep, voffA);
        if (wr == 1) PG8_BAR;
        PG8_WAIT_V(4); PG8_BAR;
        PG8_STAGE(PG8_SB(1, 0), cB + kstep, voffB); PG8_STAGE(PG8_SA(1, 0), cA + kstep, voffA); PG8_STAGE(PG8_SB(1, 1), cB + hstep + kstep, voffB);
        PG8_WAIT_V(6); PG8_BAR;
    }
    for (;;) {
        const bool has_next = S.next(ui + 1, nxt);
        const char* nA = has_next ? (const char*)g.A + (size_t)nxt.pm * tstep : cA; const char* nB = has_next ? (const char*)g.Bt + (size_t)nxt.pn * tstep : cB;
        for (int t = 0; t < nt; t += 2) {
            if constexpr (MidSeg<Epi>::v > 0) { if (t > 0 && t % MidSeg<Epi>::v == 0) E.mid(acc, cur, t / MidSeg<Epi>::v, wr, wc, fr, fq); }
            const bool last = (t == nt - 2);
            const char* a1 = cA + (size_t)(t + 1) * kstep;
            const char* a2 = last ? nA : cA + (size_t)(t + 2) * kstep; const char* b2 = last ? nB : cB + (size_t)(t + 2) * kstep;
            const char* a3 = a2 + kstep; const char* b3 = b2 + kstep;
            if (last && has_next) S.a_ready(nxt);
            if constexpr (SP2) {
            PG8_LDB(B0, 0, 0); PG8_LDB(B1, 0, 1); PG8_SCHED; PG8_LDA(At, 0, 0); PG8_STAGE(PG8_SA(1, 1), a1 + hstep, voffA);
            PG8_WAIT_V(8); PG8_WAIT_L(0); PG8_BAR; PG8_MMA(0, 0, At, B0); PG8_MMA(0, 1, At, B1); PG8_BAR; PG8_SCHED;
            PG8_LDA(At, 0, 1); PG8_STAGE(PG8_SB(0, 0), b2, voffB); PG8_STAGE(PG8_SB(0, 1), b2 + hstep, voffB); PG8_STAGE(PG8_SA(0, 0), a2, voffA);
            PG8_WAIT_V(8); PG8_WAIT_L(0); PG8_BAR; PG8_MMA(1, 0, At, B0); PG8_MMA(1, 1, At, B1); PG8_BAR; PG8_SCHED;
            PG8_LDB(B0, 1, 0); PG8_LDB(B1, 1, 1); PG8_SCHED; PG8_LDA(At, 1, 0); PG8_STAGE(PG8_SA(0, 1), a2 + hstep, voffA);
            PG8_WAIT_V(8); PG8_WAIT_L(0); PG8_BAR; PG8_MMA(0, 0, At, B0); PG8_MMA(0, 1, At, B1); PG8_BAR; PG8_SCHED;
            PG8_LDA(At, 1, 1); PG8_STAGE(PG8_SB(1, 0), b3, voffB); PG8_STAGE(PG8_SB(1, 1), b3 + hstep, voffB); PG8_STAGE(PG8_SA(1, 0), a3, voffA);
            PG8_WAIT_V(8); PG8_WAIT_L(0); PG8_BAR; PG8_MMA(1, 0, At, B0); PG8_MMA(1, 1, At, B1); PG8_BAR; PG8_SCHED;
            } else {
            PG8_LDB(B0, 0, 0); PG8_SCHED; PG8_LDA(At, 0, 0); PG8_STAGE(PG8_SA(1, 1), a1 + hstep, voffA);
            PG8_WAIT_L(8); PG8_BAR; PG8_WAIT_L(0); PG8_MMA(0, 0, At, B0); PG8_BAR; PG8_SCHED;
            PG8_LDB(B1, 0, 1); PG8_STAGE(PG8_SB(0, 0), b2, voffB);
            PG8_BAR; PG8_WAIT_L(0); PG8_MMA(0, 1, At, B1); PG8_BAR;
            PG8_LDA(At, 0, 1); PG8_STAGE(PG8_SA(0, 0), a2, voffA);
            PG8_BAR; PG8_WAIT_L(0); PG8_MMA(1, 0, At, B0); PG8_BAR; PG8_SCHED;
            PG8_STAGE(PG8_SB(0, 1), b2 + hstep, voffB);
            PG8_WAIT_V(6); PG8_BAR; PG8_MMA(1, 1, At, B1); PG8_BAR;
            PG8_LDB(B0, 1, 0); PG8_SCHED; PG8_LDA(At, 1, 0); PG8_STAGE(PG8_SA(0, 1), a2 + hstep, voffA);
            PG8_WAIT_L(8); PG8_BAR; PG8_WAIT_L(0); PG8_MMA(0, 0, At, B0); PG8_BAR; PG8_SCHED;
            PG8_LDB(B1, 1, 1); PG8_STAGE(PG8_SB(1, 0), b3, voffB);
            PG8_BAR; PG8_WAIT_L(0); PG8_MMA(0, 1, At, B1); PG8_BAR;
            PG8_LDA(At, 1, 1); PG8_STAGE(PG8_SA(1, 0), a3, voffA);
            PG8_BAR; PG8_WAIT_L(0); PG8_MMA(1, 0, At, B0); PG8_BAR; PG8_SCHED;
            PG8_STAGE(PG8_SB(1, 1), b3 + hstep, voffB);
            PG8_WAIT_V(6); PG8_BAR; PG8_MMA(1, 1, At, B1); PG8_BAR;
            }
        }
        if constexpr (ALIGN_EPI) { if (wr == 0) PG8_BAR; }
        if constexpr (!Epi::AFTER_DRAIN) { E(acc, cur, wr, wc, fr, fq); S.done(cur); }
        if (!has_next) break;
#pragma unroll
        for (int a = 0; a < 2; ++a)
#pragma unroll
            for (int b = 0; b < 2; ++b)
#pragma unroll
                for (int m = 0; m < 4; ++m)
#pragma unroll
                    for (int n = 0; n < 2; ++n) acc[a][b][m][n] = (f32x4){0.f, 0.f, 0.f, 0.f};
        cur = nxt; cA = nA; cB = nB; ++ui;
        if constexpr (ALIGN_EPI) { if (wr == 1) PG8_BAR; }
    }
    PG8_WAIT_V(0);
    if constexpr (!ALIGN_EPI) { if (wr == 0) PG8_BAR; }
    PG8_BAR;
    if constexpr (Epi::AFTER_DRAIN) { E.fused(acc, cur, wr, wc, fr, fq, lds, wid, lane); S.done(cur); }
#undef PG8_SA
#undef PG8_SB
#undef PG8_STAGE
#undef PG8_LDA
#undef PG8_LDB
#undef PG8_MMA
#undef PG8_WAIT_V
#undef PG8_WAIT_L
#undef PG8_BAR
#undef PG8_SCHED
}
}
namespace pg8 {
template <class E, class = void> struct Perm2 { static constexpr bool v = false; };
template <class E> struct Perm2<E, decltype((void)E::PERM2)> { static constexpr bool v = E::PERM2; };
struct Gemm8 { const unsigned char* A; const unsigned char* Bt; int M, N, K; int scale_a, scale_b; };
template <class Epi, class Sched, bool ALIGN_EPI = false, bool SP2 = false>
__device__ __forceinline__ void gemm_phase_f8(PG8_LAS unsigned char* lds, const Gemm8 g, const Sched& S, const Epi& E, int wid_in) {
    int lane_; asm volatile("v_mbcnt_lo_u32_b32 %0, -1, 0\n\tv_mbcnt_hi_u32_b32 %0, -1, %0" : "=v"(lane_));
    const int wid = wid_in, lane = lane_, tid = wid * 64 + lane, wr = wid >> 2, wc = wid & 3, fr = lane & 15, fq = lane >> 4;
    const int K = g.K, nt = K / 128;
    unsigned voffA[2], voffB[2];
#pragma unroll
    for (int i = 0; i < 2; ++i) { int R, C; stage_rc(tid * 16 + i * 8192, R, C); const int Rb = Perm2<Epi>::v ? (64 * (R >> 5) + 16 * ((R >> 2) & 3) + 4 * ((R >> 4) & 1) + (R & 3)) : Epi::PERM ? ((R & ~31) + perm32(R & 31)) : R;
        voffA[i] = (unsigned)(R * K + 2 * C); voffB[i] = (unsigned)(Rb * K + 2 * C); }
    const size_t kstep = (size_t)(BK * 2);
    const size_t hstep = (size_t)HALF * K;
    const size_t hstepB = Perm2<Epi>::v ? (size_t)8 * K : hstep;
    const size_t tstep = 2 * hstep;
    const unsigned ldsw = (unsigned)wid * 1024u;
    const int aoff = lds_byte(wr * 64 + fr, fq * 16), boff = lds_byte(wc * 32 + fr, fq * 16);
#define PG8_SA(b, h) (((b) * 2 + (h)) * HTB)
#define PG8_SB(b, h) ((4 + (b) * 2 + (h)) * HTB)
#define PG8_STAGE(bufoff, gbase, voff) do { _Pragma("unroll") for (int _i = 0; _i < 2; ++_i) { unsigned keep_; \
        asm volatile("s_mov_b32 %0, m0\n\ts_mov_b32 m0, %3\n\ts_nop 0\n\tglobal_load_lds_dwordx4 %1, %2\n\ts_mov_b32 m0, %0" : "=&s"(keep_) : "v"((voff)[_i]), "s"((const char*)(gbase)), "s"((unsigned)(size_t)(lds + (bufoff) + ldsw + _i * 8192)) : "memory"); } } while (0)
#define PG8_LDA(dst, b, h) do { _Pragma("unroll") for (int m = 0; m < 4; ++m) { const u32x4 lo_ = *(const PG8_LAS u32x4*)(lds + PG8_SA(b, h) + aoff + m * 2048), hi_ = *(const PG8_LAS u32x4*)(lds + PG8_SA(b, h) + aoff + m * 2048 + 16); dst[m] = __builtin_bit_cast(i32x8, __builtin_shufflevector(lo_, hi_, 0, 1, 2, 3, 4, 5, 6, 7)); } } while (0)
#define PG8_LDB(dst, b, h) do { _Pragma("unroll") for (int n = 0; n < 2; ++n) { const u32x4 lo_ = *(const PG8_LAS u32x4*)(lds + PG8_SB(b, h) + boff + n * 2048), hi_ = *(const PG8_LAS u32x4*)(lds + PG8_SB(b, h) + boff + n * 2048 + 16); dst[n] = __builtin_bit_cast(i32x8, __builtin_shufflevector(lo_, hi_, 0, 1, 2, 3, 4, 5, 6, 7)); } } while (0)
#define PG8_MMA(ai, bj, At, Bt) do { __builtin_amdgcn_s_setprio(1); _Pragma("unroll") for (int m = 0; m < 4; ++m) _Pragma("unroll") for (int n = 0; n < 2; ++n) \
        acc[ai][bj][m][n] = __builtin_amdgcn_mfma_scale_f32_16x16x128_f8f6f4(Bt[n], At[m], acc[ai][bj][m][n], 0, 0, 0, g.scale_b, 0, g.scale_a); __builtin_amdgcn_s_setprio(0); } while (0)
#define PG8_WAIT_V(n) asm volatile("s_waitcnt vmcnt(" #n ")" ::: "memory")
#define PG8_WAIT_L(n) asm volatile("s_waitcnt lgkmcnt(" #n ")" ::: "memory")
#define PG8_BAR __builtin_amdgcn_s_barrier()
#define PG8_SCHED __builtin_amdgcn_sched_barrier(0)
    Unit cur, nxt; int ui = 0;
    if (!S.next(0, cur)) return;
    f32x4 acc[2][2][4][2];
#pragma unroll
    for (int a = 0; a < 2; ++a)
#pragma unroll
        for (int b = 0; b < 2; ++b)
#pragma unroll
            for (int m = 0; m < 4; ++m)
#pragma unroll
                for (int n = 0; n < 2; ++n) acc[a][b][m][n] = (f32x4){0.f, 0.f, 0.f, 0.f};
    typedef int i32x8 __attribute__((ext_vector_type(8))); i32x8 At[4], B0[2], B1[2];
    const char* cA = (const char*)g.A + (size_t)cur.pm * tstep; const char* cB = (const char*)g.Bt + (size_t)cur.pn * tstep;
    S.a_ready(cur);
    if constexpr (SP2) {
        PG8_STAGE(PG8_SB(0, 0), cB, voffB); PG8_STAGE(PG8_SB(0, 1), cB + hstepB, voffB); PG8_STAGE(PG8_SA(0, 0), cA, voffA); PG8_STAGE(PG8_SA(0, 1), cA + hstep, voffA);
        if (wr == 1) PG8_BAR;
        PG8_WAIT_V(2); PG8_BAR;
        PG8_STAGE(PG8_SB(1, 0), cB + kstep, voffB); PG8_STAGE(PG8_SA(1, 0), cA + kstep, voffA); PG8_STAGE(PG8_SB(1, 1), cB + hstepB + kstep, voffB);
        PG8_WAIT_V(6); PG8_BAR;
    } else {
        PG8_STAGE(PG8_SB(0, 0), cB, voffB); PG8_STAGE(PG8_SA(0, 0), cA, voffA); PG8_STAGE(PG8_SB(0, 1), cB + hstepB, voffB); PG8_STAGE(PG8_SA(0, 1), cA + hstep, voffA);
        if (wr == 1) PG8_BAR;
        PG8_WAIT_V(4); PG8_BAR;
        PG8_STAGE(PG8_SB(1, 0), cB + kstep, voffB); PG8_STAGE(PG8_SA(1, 0), cA + kstep, voffA); PG8_STAGE(PG8_SB(1, 1), cB + hstepB + kstep, voffB);
        PG8_WAIT_V(6); PG8_BAR;
    }
    for (;;) {
        const bool has_next = S.next(ui + 1, nxt);
        const char* nA = has_next ? (const char*)g.A + (size_t)nxt.pm * tstep : cA; const char* nB = has_next ? (const char*)g.Bt + (size_t)nxt.pn * tstep : cB;
#pragma unroll 1
        for (int t = 0; t < nt; t += 2) {
            const bool last = (t == nt - 2);
            const char* a1 = cA + (size_t)(t + 1) * kstep;
            const char* a2 = last ? nA : cA + (size_t)(t + 2) * kstep; const char* b2 = last ? nB : cB + (size_t)(t + 2) * kstep;
            const char* a3 = a2 + kstep; const char* b3 = b2 + kstep;
            if (last && has_next) S.a_ready(nxt);
            if constexpr (SP2) {
            PG8_LDB(B0, 0, 0); PG8_LDB(B1, 0, 1); PG8_SCHED; PG8_LDA(At, 0, 0); PG8_STAGE(PG8_SA(1, 1), a1 + hstep, voffA);
            PG8_WAIT_V(8); PG8_WAIT_L(0); PG8_BAR; PG8_MMA(0, 0, At, B0); PG8_MMA(0, 1, At, B1); PG8_BAR; PG8_SCHED;
            PG8_LDA(At, 0, 1); PG8_STAGE(PG8_SB(0, 0), b2, voffB); PG8_STAGE(PG8_SB(0, 1), b2 + hstepB, voffB); PG8_STAGE(PG8_SA(0, 0), a2, voffA);
            PG8_WAIT_V(8); PG8_WAIT_L(0); PG8_BAR; PG8_MMA(1, 0, At, B0); PG8_MMA(1, 1, At, B1); PG8_BAR; PG8_SCHED;
            PG8_LDB(B0, 1, 0); PG8_LDB(B1, 1, 1); PG8_SCHED; PG8_LDA(At, 1, 0); PG8_STAGE(PG8_SA(0, 1), a2 + hstep, voffA);
            PG8_WAIT_V(8); PG8_WAIT_L(0); PG8_BAR; PG8_MMA(0, 0, At, B0); PG8_MMA(0, 1, At, B1); PG8_BAR; PG8_SCHED;
            PG8_LDA(At, 1, 1); PG8_STAGE(PG8_SB(1, 0), b3, voffB); PG8_STAGE(PG8_SB(1, 1), b3 + hstepB, voffB); PG8_STAGE(PG8_SA(1, 0), a3, voffA);
            PG8_WAIT_V(8); PG8_WAIT_L(0); PG8_BAR; PG8_MMA(1, 0, At, B0); PG8_MMA(1, 1, At, B1); PG8_BAR; PG8_SCHED;
            } else {
            PG8_LDB(B0, 0, 0); PG8_SCHED; PG8_LDA(At, 0, 0); PG8_STAGE(PG8_SA(1, 1), a1 + hstep, voffA);
            PG8_WAIT_L(8); PG8_BAR; PG8_WAIT_L(0); PG8_MMA(0, 0, At, B0); PG8_BAR; PG8_SCHED;
            PG8_LDB(B1, 0, 1); PG8_STAGE(PG8_SB(0, 0), b2, voffB);
            PG8_BAR; PG8_WAIT_L(0); PG8_MMA(0, 1, At, B1); PG8_BAR;
            PG8_LDA(At, 0, 1); PG8_STAGE(PG8_SA(0, 0), a2, voffA);
            PG8_BAR; PG8_WAIT_L(0); PG8_MMA(1, 0, At, B0); PG8_BAR; PG8_SCHED;
            PG8_STAGE(PG8_SB(0, 1), b2 + hstepB, voffB);
            PG8_WAIT_V(6); PG8_BAR; PG8_MMA(1, 1, At, B1); PG8_BAR;
            PG8_LDB(B0, 1, 0); PG8_SCHED; PG8_LDA(At, 1, 0); PG8_STAGE(PG8_SA(0, 1), a2 + hstep, voffA);
            PG8_WAIT_L(8); PG8_BAR; PG8_WAIT_L(0); PG8_MMA(0, 0, At, B0); PG8_BAR; PG8_SCHED;
            PG8_LDB(B1, 1, 1); PG8_STAGE(PG8_SB(1, 0), b3, voffB);
            PG8_BAR; PG8_WAIT_L(0); PG8_MMA(0, 1, At, B1); PG8_BAR;
            PG8_LDA(At, 1, 1); PG8_STAGE(PG8_SA(1, 0), a3, voffA);
            PG8_BAR; PG8_WAIT_L(0); PG8_MMA(1, 0, At, B0); PG8_BAR; PG8_SCHED;
            PG8_STAGE(PG8_SB(1, 1), b3 + hstepB, voffB);
            PG8_WAIT_V(6); PG8_BAR; PG8_MMA(1, 1, At, B1); PG8_BAR;
            }
        }
        if constexpr (ALIGN_EPI) { if (wr == 0) PG8_BAR; }
        if constexpr (!Epi::AFTER_DRAIN) { int l2_; asm volatile("v_mbcnt_lo_u32_b32 %0, -1, 0\n\tv_mbcnt_hi_u32_b32 %0, -1, %0" : "=v"(l2_));
            E(acc, cur, wr, wc, l2_ & 15, l2_ >> 4); S.done(cur); }
        if (!has_next) break;
#pragma unroll
        for (int a = 0; a < 2; ++a)
#pragma unroll
            for (int b = 0; b < 2; ++b)
#pragma unroll
                for (int m = 0; m < 4; ++m)
#pragma unroll
                    for (int n = 0; n < 2; ++n) acc[a][b][m][n] = (f32x4){0.f, 0.f, 0.f, 0.f};
        cur = nxt; cA = nA; cB = nB; ++ui;
        if constexpr (ALIGN_EPI) { if (wr == 1) PG8_BAR; }
    }
    PG8_WAIT_V(0);
    if constexpr (!ALIGN_EPI) { if (wr == 0) PG8_BAR; }
    PG8_BAR;
    if constexpr (Epi::AFTER_DRAIN) { E.fused(acc, cur, wr, wc, fr, fq, lds, wid, lane); S.done(cur); }
#undef PG8_SA
#undef PG8_SB
#undef PG8_STAGE
#undef PG8_LDA
#undef PG8_LDB
#undef PG8_MMA
#undef PG8_WAIT_V
#undef PG8_WAIT_L
#undef PG8_BAR
#undef PG8_SCHED
}
}
namespace pg8 {
struct GemmA { const bf16_t* A; const bf16_t* Bt; int K; int rowA; size_t kstepA, hstepA, tstepA; };
template <class Epi, class Sched, bool ALIGN_EPI = false, bool SP2 = false>
__device__ __forceinline__ void gemm_phase_ga(PG8_LAS unsigned char* lds, const GemmA g, const Sched& S, const Epi& E, int wid_in) {
    int lane_; asm volatile("v_mbcnt_lo_u32_b32 %0, -1, 0\n\tv_mbcnt_hi_u32_b32 %0, -1, %0" : "=v"(lane_));
    const int wid = wid_in, lane = lane_, tid = wid * 64 + lane, wr = wid >> 2, wc = wid & 3, fr = lane & 15, fq = lane >> 4;
    const int K = g.K, nt = K / BK;
    unsigned voffA[2], voffB[2];
#pragma unroll
    for (int i = 0; i < 2; ++i) { int R, C; stage_rc(tid * 16 + i * 8192, R, C); const int Rb = Epi::PERM ? ((R & ~31) + perm32(R & 31)) : R;
        voffA[i] = (unsigned)(R * g.rowA + C * 2); voffB[i] = (unsigned)(Rb * K + C) * 2u; }
    const size_t kstep = (size_t)(BK * 2);
    const size_t hstep = (size_t)HALF * K * 2;
    const size_t kstepA = g.kstepA, hstepA = g.hstepA, tstepA = g.tstepA;
    const size_t tstep = 2 * hstep;
    const unsigned ldsw = (unsigned)wid * 1024u;
    const int aoff = lds_byte(wr * 64 + fr, fq * 8), boff = lds_byte(wc * 32 + fr, fq * 8);
#define PG8_SA(b, h) (((b) * 2 + (h)) * HTB)
#define PG8_SB(b, h) ((4 + (b) * 2 + (h)) * HTB)
#define PG8_STAGE(bufoff, gbase, voff) do { _Pragma("unroll") for (int _i = 0; _i < 2; ++_i) \
        __builtin_amdgcn_global_load_lds((const unsigned*)((const char*)(gbase) + (voff)[_i]), (PG8_LAS unsigned*)(lds + (bufoff) + ldsw + _i * 8192), 16, 0, 0); } while (0)
#define PG8_LDA(dst, b, h) do { _Pragma("unroll") for (int m = 0; m < 4; ++m) _Pragma("unroll") for (int k = 0; k < 2; ++k) dst[m][k] = *(const PG8_LAS bf16x8*)(lds + PG8_SA(b, h) + aoff + m * 2048 + k * 1024); } while (0)
#define PG8_LDB(dst, b, h) do { _Pragma("unroll") for (int n = 0; n < 2; ++n) _Pragma("unroll") for (int k = 0; k < 2; ++k) dst[n][k] = *(const PG8_LAS bf16x8*)(lds + PG8_SB(b, h) + boff + n * 2048 + k * 1024); } while (0)
#define PG8_MMA(ai, bj, At, Bt) do { __builtin_amdgcn_s_setprio(1); _Pragma("unroll") for (int m = 0; m < 4; ++m) _Pragma("unroll") for (int n = 0; n < 2; ++n) _Pragma("unroll") for (int k = 0; k < 2; ++k) \
        acc[ai][bj][m][n] = __builtin_amdgcn_mfma_f32_16x16x32_bf16(Bt[n][k], At[m][k], acc[ai][bj][m][n], 0, 0, 0); __builtin_amdgcn_s_setprio(0); } while (0)
#define PG8_WAIT_V(n) asm volatile("s_waitcnt vmcnt(" #n ")" ::: "memory")
#define PG8_WAIT_L(n) asm volatile("s_waitcnt lgkmcnt(" #n ")" ::: "memory")
#define PG8_BAR __builtin_amdgcn_s_barrier()
#define PG8_SCHED __builtin_amdgcn_sched_barrier(0)
    Unit cur, nxt; int ui = 0;
    if (!S.next(0, cur)) return;
    f32x4 acc[2][2][4][2];
#pragma unroll
    for (int a = 0; a < 2; ++a)
#pragma unroll
        for (int b = 0; b < 2; ++b)
#pragma unroll
            for (int m = 0; m < 4; ++m)
#pragma unroll
                for (int n = 0; n < 2; ++n) acc[a][b][m][n] = (f32x4){0.f, 0.f, 0.f, 0.f};
    bf16x8 At[4][2], B0[2][2], B1[2][2];
    const char* cA = (const char*)g.A + (size_t)cur.pm * tstepA; const char* cB = (const char*)g.Bt + (size_t)cur.pn * tstep;
    S.a_ready(cur);
    if constexpr (SP2) {
        PG8_STAGE(PG8_SB(0, 0), cB, voffB); PG8_STAGE(PG8_SB(0, 1), cB + hstep, voffB); PG8_STAGE(PG8_SA(0, 0), cA, voffA); PG8_STAGE(PG8_SA(0, 1), cA + hstepA, voffA);
        if (wr == 1) PG8_BAR;
        PG8_WAIT_V(2); PG8_BAR;
        PG8_STAGE(PG8_SB(1, 0), cB + kstep, voffB); PG8_STAGE(PG8_SA(1, 0), cA + kstepA, voffA); PG8_STAGE(PG8_SB(1, 1), cB + hstep + kstep, voffB);
        PG8_WAIT_V(6); PG8_BAR;
    } else {
        PG8_STAGE(PG8_SB(0, 0), cB, voffB); PG8_STAGE(PG8_SA(0, 0), cA, voffA); PG8_STAGE(PG8_SB(0, 1), cB + hstep, voffB); PG8_STAGE(PG8_SA(0, 1), cA + hstepA, voffA);
        if (wr == 1) PG8_BAR;
        PG8_WAIT_V(4); PG8_BAR;
        PG8_STAGE(PG8_SB(1, 0), cB + kstep, voffB); PG8_STAGE(PG8_SA(1, 0), cA + kstepA, voffA); PG8_STAGE(PG8_SB(1, 1), cB + hstep + kstep, voffB);
        PG8_WAIT_V(6); PG8_BAR;
    }
    for (;;) {
        const bool has_next = S.next(ui + 1, nxt);
        const char* nA = has_next ? (const char*)g.A + (size_t)nxt.pm * tstepA : cA; const char* nB = has_next ? (const char*)g.Bt + (size_t)nxt.pn * tstep : cB;
        for (int t = 0; t < nt; t += 2) {
            if constexpr (MidSeg<Epi>::v > 0) { if (t > 0 && t % MidSeg<Epi>::v == 0) E.mid(acc, cur, t / MidSeg<Epi>::v, wr, wc, fr, fq); }
            const bool last = (t == nt - 2);
            const char* a1 = cA + (size_t)(t + 1) * kstepA;
            const char* a2 = last ? nA : cA + (size_t)(t + 2) * kstepA; const char* b2 = last ? nB : cB + (size_t)(t + 2) * kstep;
            const char* a3 = a2 + kstepA; const char* b3 = b2 + kstep;
            if (last && has_next) S.a_ready(nxt);
            if constexpr (SP2) {
            PG8_LDB(B0, 0, 0); PG8_LDB(B1, 0, 1); PG8_SCHED; PG8_LDA(At, 0, 0); PG8_STAGE(PG8_SA(1, 1), a1 + hstepA, voffA);
            PG8_WAIT_V(8); PG8_WAIT_L(0); PG8_BAR; PG8_MMA(0, 0, At, B0); PG8_MMA(0, 1, At, B1); PG8_BAR; PG8_SCHED;
            PG8_LDA(At, 0, 1); PG8_STAGE(PG8_SB(0, 0), b2, voffB); PG8_STAGE(PG8_SB(0, 1), b2 + hstep, voffB); PG8_STAGE(PG8_SA(0, 0), a2, voffA);
            PG8_WAIT_V(8); PG8_WAIT_L(0); PG8_BAR; PG8_MMA(1, 0, At, B0); PG8_MMA(1, 1, At, B1); PG8_BAR; PG8_SCHED;
            PG8_LDB(B0, 1, 0); PG8_LDB(B1, 1, 1); PG8_SCHED; PG8_LDA(At, 1, 0); PG8_STAGE(PG8_SA(0, 1), a2 + hstepA, voffA);
            PG8_WAIT_V(8); PG8_WAIT_L(0); PG8_BAR; PG8_MMA(0, 0, At, B0); PG8_MMA(0, 1, At, B1); PG8_BAR; PG8_SCHED;
            PG8_LDA(At, 1, 1); PG8_STAGE(PG8_SB(1, 0), b3, voffB); PG8_STAGE(PG8_SB(1, 1), b3 + hstep, voffB); PG8_STAGE(PG8_SA(1, 0), a3, voffA);
            PG8_WAIT_V(8); PG8_WAIT_L(0); PG8_BAR; PG8_MMA(1, 0, At, B0); PG8_MMA(1, 1, At, B1); PG8_BAR; PG8_SCHED;
            } else {
            PG8_LDB(B0, 0, 0); PG8_SCHED; PG8_LDA(At, 0, 0); PG8_STAGE(PG8_SA(1, 1), a1 + hstepA, voffA);
            PG8_WAIT_L(8); PG8_BAR; PG8_WAIT_L(0); PG8_MMA(0, 0, At, B0); PG8_BAR; PG8_SCHED;
            PG8_LDB(B1, 0, 1); PG8_STAGE(PG8_SB(0, 0), b2, voffB);
            PG8_BAR; PG8_WAIT_L(0); PG8_MMA(0, 1, At, B1); PG8_BAR;
            PG8_LDA(At, 0, 1); PG8_STAGE(PG8_SA(0, 0), a2, voffA);
            PG8_BAR; PG8_WAIT_L(0); PG8_MMA(1, 0, At, B0); PG8_BAR; PG8_SCHED;
            PG8_STAGE(PG8_SB(0, 1), b2 + hstep, voffB);
            PG8_WAIT_V(6); PG8_BAR; PG8_MMA(1, 1, At, B1); PG8_BAR;
            PG8_LDB(B0, 1, 0); PG8_SCHED; PG8_LDA(At, 1, 0); PG8_STAGE(PG8_SA(0, 1), a2 + hstepA, voffA);
            PG8_WAIT_L(8); PG8_BAR; PG8_WAIT_L(0); PG8_MMA(0, 0, At, B0); PG8_BAR; PG8_SCHED;
            PG8_LDB(B1, 1, 1); PG8_STAGE(PG8_SB(1, 0), b3, voffB);
            PG8_BAR; PG8_WAIT_L(0); PG8_MMA(0, 1, At, B1); PG8_BAR;
            PG8_LDA(At, 1, 1); PG8_STAGE(PG8_SA(1, 0), a3, voffA);
            PG8_BAR; PG8_WAIT_L(0); PG8_MMA(1, 0, At, B0); PG8_BAR; PG8_SCHED;
            PG8_STAGE(PG8_SB(1, 1), b3 + hstep, voffB);
            PG8_WAIT_V(6); PG8_BAR; PG8_MMA(1, 1, At, B1); PG8_BAR;
            }
        }
        if constexpr (ALIGN_EPI) { if (wr == 0) PG8_BAR; }
        if constexpr (!Epi::AFTER_DRAIN) { E(acc, cur, wr, wc, fr, fq); S.done(cur); }
        if (!has_next) break;
#pragma unroll
        for (int a = 0; a < 2; ++a)
#pragma unroll
            for (int b = 0; b < 2; ++b)
#pragma unroll
                for (int m = 0; m < 4; ++m)
#pragma unroll
                    for (int n = 0; n < 2; ++n) acc[a][b][m][n] = (f32x4){0.f, 0.f, 0.f, 0.f};
        cur = nxt; cA = nA; cB = nB; ++ui;
        if constexpr (ALIGN_EPI) { if (wr == 1) PG8_BAR; }
    }
    PG8_WAIT_V(0);
    if constexpr (!ALIGN_EPI) { if (wr == 0) PG8_BAR; }
    PG8_BAR;
    if constexpr (Epi::AFTER_DRAIN) { E.fused(acc, cur, wr, wc, fr, fq, lds, wid, lane); S.done(cur); }
#undef PG8_SA
#undef PG8_SB
#undef PG8_STAGE
#undef PG8_LDA
#undef PG8_LDB
#undef PG8_MMA
#undef PG8_WAIT_V
#undef PG8_WAIT_L
#undef PG8_BAR
#undef PG8_SCHED
}
}
#define GAS __attribute__((address_space(1)))
#define LAS __attribute__((address_space(3)))
typedef unsigned short bf16;
typedef unsigned v4u __attribute__((ext_vector_type(4)));
typedef float f32x4 __attribute__((ext_vector_type(4)));
typedef short bf16x8 __attribute__((ext_vector_type(8)));
typedef GAS unsigned gu32;
typedef GAS unsigned long long gu64;
#define RLX_AGENT __ATOMIC_RELAXED, __HIP_MEMORY_SCOPE_AGENT
#define LDS_WAIT() asm volatile("s_waitcnt lgkmcnt(0)" ::: "memory")
#define VM_WAIT() asm volatile("s_waitcnt vmcnt(0)" ::: "memory")
__device__ __forceinline__ unsigned long long rt() { return __builtin_amdgcn_s_memrealtime(); }
__device__ __forceinline__ unsigned f2bf(float f) { unsigned u = __builtin_bit_cast(unsigned, f); return (u + 0x7fffu + ((u >> 16) & 1u)) >> 16; }
__device__ __forceinline__ unsigned pk2(float lo, float hi) { return f2bf(lo) | (f2bf(hi) << 16); }

#define XB_TMO      128
#define XB_XCNT(j)  (256  + 64 * (j))
#define XB_XSUB(j)  (1280 + 64 * (j))
#define XB_XGEN(j)  (2304 + 64 * (j))
#define XB_TOP      3328
#define XB_TOPGEN   3392
#define XCD_BAR_WORDS 3456
#define XB_SPIN_CAP (1u << 18)

__device__ __forceinline__ unsigned xb_ld(unsigned* p)              { return __hip_atomic_load(p, __ATOMIC_RELAXED, __HIP_MEMORY_SCOPE_AGENT); }
__device__ __forceinline__ unsigned xb_add(unsigned* p, unsigned v) { return __hip_atomic_fetch_add(p, v, __ATOMIC_RELAXED, __HIP_MEMORY_SCOPE_AGENT); }
__device__ __forceinline__ unsigned xb_xcc_id() { return (unsigned)__builtin_amdgcn_s_getreg((3 << 11) | 20) & 0xFu; }
#define XB_SPIN(cond, bar) do { unsigned _sp = 0; while (cond) { __builtin_amdgcn_s_sleep(1); \
    if ((++_sp & 255u) == 0u) { if (xb_ld(&(bar)[XB_TMO])) break; if (_sp > XB_SPIN_CAP) { atomicAdd(&(bar)[XB_TMO], 1u); break; } } } } while (0)

struct XcdBarrier {
    int wv;
    unsigned* bar; unsigned x;
    volatile LAS unsigned* st;
};

__device__ __forceinline__ int xb_lane_id() { int l; asm volatile("v_mbcnt_lo_u32_b32 %0, -1, 0\n\tv_mbcnt_hi_u32_b32 %0, -1, %0" : "=v"(l)); return l; }
__device__ __forceinline__ XcdBarrier xcd_barrier_post(unsigned* bar, volatile LAS unsigned* st, int wv) {
    XcdBarrier b; b.wv = wv; b.bar = bar; b.x = xb_xcc_id(); b.st = st;
    if (wv == 0 && xb_lane_id() == 0) (void)xb_add(&bar[XB_XCNT(b.x)], 1u);
    return b;
}
__device__ __forceinline__ void xcd_barrier_complete(unsigned* bar, unsigned x, unsigned& nloc, unsigned& nx) {
    const unsigned G = gridDim.x * gridDim.y * gridDim.z;
    unsigned sum, cnt, mine, sp = 0u;
    for (;;) {
        sum = 0u; cnt = 0u; mine = 0u;
#pragma unroll
        for (unsigned j = 0; j < 16; ++j) { const unsigned c = xb_ld(&bar[XB_XCNT(j)]); sum += c; cnt += (c > 0u) ? 1u : 0u; mine = (j == x) ? c : mine; }
        if (sum == G) break;
        __builtin_amdgcn_s_sleep(1);
        if ((++sp & 255u) == 0u) { if (xb_ld(&bar[XB_TMO])) break; if (sp > XB_SPIN_CAP) { atomicAdd(&bar[XB_TMO], 1u); break; } }
    }
    nloc = mine > 0u ? mine : 1u; nx = cnt > 0u ? cnt : 1u;
}

__device__ __forceinline__ void xcd_barrier(const XcdBarrier& b) {
    asm volatile("s_waitcnt vmcnt(0)" ::: "memory");
    __syncthreads();
    if (b.wv == 0 && xb_lane_id() == 0) {
        unsigned* bar = b.bar;
        __builtin_amdgcn_s_waitcnt(0);
        unsigned nloc = b.st[0], nx = b.st[1];
        if (nloc == 0u) { xcd_barrier_complete(bar, b.x, nloc, nx); b.st[0] = nloc; b.st[1] = nx; }
        const unsigned old = xb_add(&bar[XB_XSUB(b.x)], 1u);
        const unsigned gen = old / nloc;
        if (old + 1u == (gen + 1u) * nloc) {
            __builtin_amdgcn_fence(__ATOMIC_RELEASE, "agent");
            asm volatile("s_waitcnt vmcnt(0)" ::: "memory");
            const unsigned og = xb_add(&bar[XB_TOP], 1u);
            const unsigned tg = og / nx;
            if (og + 1u == (tg + 1u) * nx) xb_add(&bar[XB_TOPGEN], 1u);
            else XB_SPIN(xb_ld(&bar[XB_TOPGEN]) == tg, bar);
            __builtin_amdgcn_fence(__ATOMIC_ACQUIRE, "agent");
            xb_add(&bar[XB_XGEN(b.x)], 1u);
            asm volatile("s_waitcnt vmcnt(0)" ::: "memory");
        } else {
            XB_SPIN(xb_ld(&bar[XB_XGEN(b.x)]) == gen, bar);
            __builtin_amdgcn_fence(__ATOMIC_ACQUIRE, "agent");
            asm volatile("s_waitcnt vmcnt(0)" ::: "memory");
        }
    }
    __syncthreads();
}
#define DI __device__ __forceinline__
constexpr int NWAVES = 8;
constexpr int NB = 16, SEQ = 2048, DM = 1024, MT = NB * SEQ;
constexpr int DIN_SRC = 6944, NPROJ = 7168;
constexpr int MEML = 256, MROWS = NB * MEML;
constexpr int NEXP = 32, TOPK = 4, DFF = 1024, MOEB = 256;
constexpr int NROWS = MT * TOPK;
constexpr int NBLK_MAX = (NROWS + NEXP * (MOEB - 1) + MOEB - 1) / MOEB;
constexpr int CAP = NBLK_MAX * MOEB;
constexpr float EPS = 1e-6f;
constexpr float NEGF = -1e30f;
constexpr int NB16 = 3584, NF8 = NPROJ - NB16;
constexpr int PC_MLQ = 0, PC_MLK = 512, PC_NQ = 1024, PC_NKC = 1536, PC_NKS = 1664, PC_NKW = 1792, PC_MQ = 1920, PC_MLI = 2432, PC_MLF = 2436, PC_NG = 2440,
              PC_MLV = 2560, PC_NVC = 3072, PC_NVS = 3200, PC_NVW = 3328, PC_MLO = 3584, PC_BRG = 4096;
__host__ __device__ constexpr int proj_srccol(int j) {
    return j < 1024 ? j : j < 1536 ? 2056 + (j - 1024) : j < 1664 ? 2568 + (j - 1536) : j < 1792 ? 2824 + (j - 1664) : j < 1920 ? 3080 + (j - 1792) : j < 2432 ? 3360 + (j - 1920)
         : j < 2440 ? 2048 + (j - 2432) : j < 2464 ? 3336 + (j - 2440) : j < 2560 ? -1
         : j < 3072 ? 1024 + (j - 2560) : j < 3200 ? 2696 + (j - 3072) : j < 3328 ? 2952 + (j - 3200) : j < 3456 ? 3208 + (j - 3328) : j < 3584 ? -1
         : j < 4096 ? 1536 + (j - 3584) : 3872 + (j - 4096);
}

constexpr size_t MiB = 1u << 20;
constexpr size_t WS_CTL = 0, CTL_ZERO_BYTES = 1 * MiB;
constexpr size_t WS_WIN = 1 * MiB, WS_WGU = 15 * MiB, WS_WDN = 143 * MiB, WS_WMKV = 207 * MiB, WS_WBR = 209 * MiB, WS_WOUT = 212 * MiB, WS_WC1 = 214 * MiB;
constexpr size_t WS_WIN8 = WS_WIN + 8 * MiB;
constexpr size_t WS_SMALL = 216 * MiB;
constexpr size_t WS_R1 = 218 * MiB;
constexpr size_t WS_PROJ = 282 * MiB;
constexpr size_t WS_R3 = 730 * MiB;
constexpr size_t WS_MEMKV = WS_R3, WS_MEMKN = WS_R3 + 8 * MiB, WS_QN = WS_R3 + 12 * MiB, WS_KSN = WS_R3 + 44 * MiB, WS_KWN = WS_R3 + 52 * MiB,
                 WS_MQN = WS_R3 + 60 * MiB, WS_MLQK = WS_R3 + 92 * MiB, WS_HID = WS_R3 + 156 * MiB, WS_KC = WS_R3 + 160 * MiB, WS_VC = WS_KC + MiB / 2,
                 WS_H0 = WS_R3 + 161 * MiB, WS_H1 = WS_H0 + 32 * MiB, WS_H2 = WS_H1 + 32 * MiB, WS_ROUTE = WS_H2 + 32 * MiB, WS_END = WS_ROUTE + 6 * MiB;
constexpr size_t WS_MLV = WS_R1, WS_VSN = WS_R1 + 32 * MiB, WS_VWN = WS_R1 + 40 * MiB;
constexpr size_t WS_U8 = WS_H2;
constexpr size_t WS_MEMN = WS_H0;
constexpr size_t WS_ACMP = WS_H1;
constexpr size_t WS_APERM = WS_PROJ;
constexpr size_t WS_ACT = WS_PROJ + 272 * MiB;
static_assert(WS_ACT + 272 * MiB <= WS_H0 + 96 * MiB && WS_END <= 1024 * MiB, "ws map");
constexpr size_t SM_ROPEC = 0, SM_ROPES = 256 * 1024, SM_CBIAS = 512 * 1024, SM_WRT = 1024 * 1024, SM_W2T = 1024 * 1024 + 256 * 1024;
constexpr size_t RT_TOKE = 0, RT_TOKPOS = 512 * 1024, RT_TOKW = 1024 * 1024, RT_TOKDEST = 1536 * 1024, RT_ROWW = 2048 * 1024;
constexpr int CW_BAR = 4096;
constexpr int CW_ECNT = 16384;
constexpr int CW_QCTR = 16384 + 64;

constexpr int RING_BYTES = 131072, LDSCTL_OFF = RING_BYTES, MISC_OFF = LDSCTL_OFF + 320, LDS_BYTES = 155648;

struct Args { const float* in[34]; float* out; unsigned char* ws; int ph_lo, ph_hi, li, pad; };

DI float bf2f(unsigned short h) { return __uint_as_float((unsigned)h << 16); }
DI float wave_sum(float v) {
#pragma unroll
    for (int o = 1; o < 64; o <<= 1) v += __shfl_xor(v, o);
    return v;
}
DI float wave_max(float v) {
#pragma unroll
    for (int o = 1; o < 64; o <<= 1) v = fmaxf(v, __shfl_xor(v, o));
    return v;
}
DI float sigm(float x) { return __builtin_amdgcn_rcpf(1.f + __expf(-x)); }
DI float logsig(float x) { return fminf(x, 0.f) - log1pf(__expf(-fabsf(x))); }

namespace pg8 {
struct EpiBf16Silu {
    static constexpr bool PERM = true, AFTER_DRAIN = false;
    bf16_t* O; int ldc; const float* bias; int silu;
    DI void operator()(const f32x4 (&acc)[2][2][4][2], const Unit& u, int wr, int wc, int fr, int fq) const {
        const int row0 = u.pm * BM + wr * 64 + fr; const int col0 = u.pn * BM + wc * 32 + 8 * fq;
#pragma unroll
        for (int ai = 0; ai < 2; ++ai)
#pragma unroll
            for (int m = 0; m < 4; ++m) { bf16_t* rowp = O + (size_t)(row0 + ai * HALF + m * 16) * ldc + col0;
#pragma unroll
                for (int bj = 0; bj < 2; ++bj) { f32x4 v0 = acc[ai][bj][m][0], v1 = acc[ai][bj][m][1];
                    if (bias) { v0 += *(const f32x4*)(bias + col0 + bj * HALF); v1 += *(const f32x4*)(bias + col0 + bj * HALF + 4); }
                    if (silu) {
#pragma unroll
                        for (int j = 0; j < 4; ++j) { v0[j] = v0[j] * __builtin_amdgcn_rcpf(1.f + __expf(-v0[j])); v1[j] = v1[j] * __builtin_amdgcn_rcpf(1.f + __expf(-v1[j])); } }
                    u32x4 w; w.x = cvt_pk_bf16(v0[0], v0[1]); w.y = cvt_pk_bf16(v0[2], v0[3]); w.z = cvt_pk_bf16(v1[0], v1[1]); w.w = cvt_pk_bf16(v1[2], v1[3]);
                    *(u32x4*)(rowp + bj * HALF) = w; } }
    }
};
template <int B> struct EpiGate {
    static constexpr bool PERM = false, AFTER_DRAIN = false;
    const bf16_t* proj; float* tmp; bf16_t* merged;
    DI void operator()(const f32x4 (&acc)[2][2][4][2], const Unit& u, int wr, int wc, int fr, int fq) const {
        typedef unsigned u32x2v __attribute__((ext_vector_type(2)));
        const int col0 = u.pn * BM + wc * 32 + 4 * fq;
#pragma unroll
        for (int ai = 0; ai < 2; ++ai)
#pragma unroll
            for (int m = 0; m < 4; ++m) { const size_t r = (size_t)(u.pm * BM + ai * HALF + wr * 64 + m * 16 + fr);
#pragma unroll
                for (int bj = 0; bj < 2; ++bj)
#pragma unroll
                    for (int n = 0; n < 2; ++n) { const int c = col0 + bj * HALF + n * 16;
                        const u32x2v gw = *(const u32x2v*)(proj + r * NPROJ + PC_BRG + B * DM + c);
                        f32x4 g; g[0] = __uint_as_float(gw.x << 16); g[1] = __uint_as_float(gw.x & 0xffff0000u); g[2] = __uint_as_float(gw.y << 16); g[3] = __uint_as_float(gw.y & 0xffff0000u);
                        f32x4 v = acc[ai][bj][m][n];
#pragma unroll
                        for (int j = 0; j < 4; ++j) v[j] = v[j] * __builtin_amdgcn_rcpf(1.f + __expf(-g[j]));
                        float* tp = tmp + r * DM + c;
                        if (B == 0) { *(f32x4*)tp = v; }
                        else if (B == 1) { *(f32x4*)tp = *(const f32x4*)tp + v; }
                        else { v = *(const f32x4*)tp + v; u32x2v w; w.x = cvt_pk_bf16(v[0], v[1]); w.y = cvt_pk_bf16(v[2], v[3]); *(u32x2v*)(merged + r * DM + c) = w; } } }
    }
};
struct EpiMerge {
    static constexpr bool PERM = false, AFTER_DRAIN = false;
    const bf16_t* proj; float* tmp; bf16_t* merged;
    DI void operator()(const f32x4 (&acc)[2][2][4][2], const Unit& u, int wr, int wc, int fr, int fq) const {
        typedef unsigned u32x2v __attribute__((ext_vector_type(2)));
        const int b = u.pn >> 2, pn = u.pn & 3, pm = u.pm & 127;
        const int col0 = pn * BM + wc * 32 + 4 * fq;
#pragma unroll
        for (int ai = 0; ai < 2; ++ai)
#pragma unroll
            for (int m = 0; m < 4; ++m) { const size_t r = (size_t)(pm * BM + ai * HALF + wr * 64 + m * 16 + fr);
#pragma unroll
                for (int bj = 0; bj < 2; ++bj)
#pragma unroll
                    for (int n = 0; n < 2; ++n) { const int c = col0 + bj * HALF + n * 16;
                        const u32x2v gw = *(const u32x2v*)(proj + r * NPROJ + PC_BRG + b * DM + c);
                        f32x4 g; g[0] = __uint_as_float(gw.x << 16); g[1] = __uint_as_float(gw.x & 0xffff0000u); g[2] = __uint_as_float(gw.y << 16); g[3] = __uint_as_float(gw.y & 0xffff0000u);
                        f32x4 v = acc[ai][bj][m][n];
#pragma unroll
                        for (int j = 0; j < 4; ++j) v[j] = v[j] * __builtin_amdgcn_rcpf(1.f + __expf(-g[j]));
                        float* tp = tmp + r * DM + c;
                        if (b == 0) { *(f32x4*)tp = v; }
                        else if (b == 1) { *(f32x4*)tp = *(const f32x4*)tp + v; }
                        else { v = *(const f32x4*)tp + v; u32x2v w; w.x = cvt_pk_bf16(v[0], v[1]); w.y = cvt_pk_bf16(v[2], v[3]); *(u32x2v*)(merged + r * DM + c) = w; } } }
    }
};
struct EpiMergeK {
    static constexpr bool PERM = true, AFTER_DRAIN = false; static constexpr int MIDSEG = 8;
    const bf16_t* proj; bf16_t* merged;
    DI static void ldg8(const bf16_t* p, float (&g)[8]) { const u32x4 w = *(const u32x4*)p; const unsigned ws_[4] = {w.x, w.y, w.z, w.w};
#pragma unroll
        for (int j = 0; j < 4; ++j) { g[2 * j] = __uint_as_float(ws_[j] << 16); g[2 * j + 1] = __uint_as_float(ws_[j] & 0xffff0000u); } }
    DI void mid(f32x4 (&acc)[2][2][4][2], const Unit& u, int seg, int wr, int wc, int fr, int fq) const {
        const int col0 = u.pn * BM + wc * 32 + 8 * fq;
#pragma unroll
        for (int ai = 0; ai < 2; ++ai)
#pragma unroll
            for (int m = 0; m < 4; ++m) { const size_t r = (size_t)(u.pm * BM + ai * HALF + wr * 64 + m * 16 + fr);
#pragma unroll
                for (int bj = 0; bj < 2; ++bj) { const bf16_t* gp = proj + r * NPROJ + PC_BRG + (seg - 1) * DM + col0 + bj * HALF;
                    float ga[8], gb[8]; ldg8(gp, ga); ldg8(gp + DM, gb);
#pragma unroll
                    for (int n = 0; n < 2; ++n)
#pragma unroll
                        for (int j = 0; j < 4; ++j) acc[ai][bj][m][n][j] *= (1.f + __expf(-gb[4 * n + j])) * __builtin_amdgcn_rcpf(1.f + __expf(-ga[4 * n + j])); } }
    }
    DI void operator()(const f32x4 (&acc)[2][2][4][2], const Unit& u, int wr, int wc, int fr, int fq) const {
        const int col0 = u.pn * BM + wc * 32 + 8 * fq;
#pragma unroll
        for (int ai = 0; ai < 2; ++ai)
#pragma unroll
            for (int m = 0; m < 4; ++m) { const size_t r = (size_t)(u.pm * BM + ai * HALF + wr * 64 + m * 16 + fr);
#pragma unroll
                for (int bj = 0; bj < 2; ++bj) { float g[8]; ldg8(proj + r * NPROJ + PC_BRG + 2 * DM + col0 + bj * HALF, g); float v[8];
#pragma unroll
                    for (int n = 0; n < 2; ++n)
#pragma unroll
                        for (int j = 0; j < 4; ++j) v[4 * n + j] = acc[ai][bj][m][n][j] * __builtin_amdgcn_rcpf(1.f + __expf(-g[4 * n + j]));
                    u32x4 w; w.x = cvt_pk_bf16(v[0], v[1]); w.y = cvt_pk_bf16(v[2], v[3]); w.z = cvt_pk_bf16(v[4], v[5]); w.w = cvt_pk_bf16(v[6], v[7]);
                    *(u32x4*)(merged + r * DM + col0 + bj * HALF) = w; } }
    }
};
struct MergeOrder {
    StaticOrder so;
    DI bool next(int i, Unit& u) const { const int tl = i / 3, b = i - 3 * tl; Unit t; if (!so.next(tl, t)) return false; u.pm = b * 128 + t.pm; u.pn = b * 4 + t.pn; return true; }
    DI void a_ready(const Unit&) const {}
    DI void done(const Unit&) const {}
};
struct EpiRes {
    static constexpr bool PERM = false, AFTER_DRAIN = false;
    const float* base; float* out;
    DI void operator()(const f32x4 (&acc)[2][2][4][2], const Unit& u, int wr, int wc, int fr, int fq) const {
        const int col0 = u.pn * BM + wc * 32 + 4 * fq;
#pragma unroll
        for (int ai = 0; ai < 2; ++ai)
#pragma unroll
            for (int m = 0; m < 4; ++m) { const size_t r = (size_t)(u.pm * BM + ai * HALF + wr * 64 + m * 16 + fr);
#pragma unroll
                for (int bj = 0; bj < 2; ++bj)
#pragma unroll
                    for (int n = 0; n < 2; ++n) { const int c = col0 + bj * HALF + n * 16; *(f32x4*)(out + r * DM + c) = *(const f32x4*)(base + r * DM + c) + acc[ai][bj][m][n]; } }
    }
};
struct EpiSwiglu {
    static constexpr bool PERM = true, AFTER_DRAIN = false, PERM2 = true;
    unsigned char* act; const float* bgu;
    DI void operator()(const f32x4 (&acc)[2][2][4][2], const Unit& u, int wr, int wc, int fr, int fq) const {
        typedef unsigned u32x2v __attribute__((ext_vector_type(2)));
        const int e = u.pn >> 3, pnl = u.pn & 7;
        const unsigned lc0 = (unsigned)(pnl * BM + wc * 64 + 16 * fq);
        const unsigned row0 = (unsigned)(u.pm * BM + wr * 64 + fr);
        const float* bp = bgu + e * 2048 + lc0;
        f32x4 bv[2][2];
#pragma unroll
        for (int bj = 0; bj < 2; ++bj)
#pragma unroll
            for (int n = 0; n < 2; ++n) bv[bj][n] = *(const f32x4*)(bp + 8 * bj + 4 * n);
#pragma unroll
        for (int ai = 0; ai < 2; ++ai)
#pragma unroll
            for (int m = 0; m < 4; ++m) { const unsigned rowoff = (row0 + ai * HALF + m * 16) * (unsigned)DFF;
                int q8[2] = {0, 0};
#pragma unroll
                for (int bj = 0; bj < 2; ++bj) { float o[4];
#pragma unroll
                    for (int n = 0; n < 2; ++n) { const f32x4 v = acc[ai][bj][m][n] + bv[bj][n];
#pragma unroll
                        for (int q = 0; q < 2; ++q) { const float gt = fminf(v[2 * q], 7.0f); const float up = fminf(fmaxf(v[2 * q + 1], -7.0f), 7.0f);
                            o[2 * n + q] = (up + 1.0f) * (gt * __builtin_amdgcn_rcpf(1.f + __expf(-1.702f * gt))); } }
                    q8[bj] = __builtin_amdgcn_cvt_pk_fp8_f32(o[0], o[1], q8[bj], false); q8[bj] = __builtin_amdgcn_cvt_pk_fp8_f32(o[2], o[3], q8[bj], true); }
                *(u32x2v*)(act + (rowoff + (lc0 >> 1))) = (u32x2v){(unsigned)q8[0], (unsigned)q8[1]}; }
    }
};
struct EpiDown {
    static constexpr bool PERM = true, AFTER_DRAIN = false;
    bf16_t* y; const float* bdn; const float* roww;
    DI void operator()(const f32x4 (&acc)[2][2][4][2], const Unit& u, int wr, int wc, int fr, int fq) const {
        const int e = u.pn >> 2, pnl = u.pn & 3;
        const int col0 = pnl * BM + wc * 32 + 8 * fq;
        const float* bp = bdn + e * DM + col0;
        f32x4 bv[2][2];
#pragma unroll
        for (int bj = 0; bj < 2; ++bj) { bv[bj][0] = *(const f32x4*)(bp + bj * HALF); bv[bj][1] = *(const f32x4*)(bp + bj * HALF + 4); }
        const unsigned row0 = (unsigned)(u.pm * BM + wr * 64 + fr);
#pragma unroll
        for (int ai = 0; ai < 2; ++ai)
#pragma unroll
            for (int m = 0; m < 4; ++m) { const unsigned r = row0 + ai * HALF + m * 16; const float rw = roww[r]; const unsigned off = r * (unsigned)DM + (unsigned)col0;
#pragma unroll
                for (int bj = 0; bj < 2; ++bj) { const f32x4 v0 = (acc[ai][bj][m][0] + bv[bj][0]) * rw, v1 = (acc[ai][bj][m][1] + bv[bj][1]) * rw;
                    u32x4 w; w.x = cvt_pk_bf16(v0[0], v0[1]); w.y = cvt_pk_bf16(v0[2], v0[3]); w.z = cvt_pk_bf16(v1[0], v1[1]); w.w = cvt_pk_bf16(v1[2], v1[3]);
                    *(u32x4*)(y + (off + bj * HALF)) = w; } }
    }
};
template <int NPN> struct MoeOrder {
    int nblk, G, c; const PG8_LAS unsigned char* blk_e;
    DI bool next(int i, Unit& u) const {
        int rb, pn;
        if (G == 256) { const int x = c & 7, j = c >> 3; rb = i * (256 / NPN) + x * (32 / NPN) + j / NPN; pn = j % NPN; }
        else { const int L = i * G + c; rb = L / NPN; pn = L % NPN; }
        if (rb >= nblk) return false;
        u.pm = rb; u.pn = __builtin_amdgcn_readfirstlane((int)blk_e[rb]) * NPN + pn; return true; }
    DI void a_ready(const Unit&) const {}
    DI void done(const Unit&) const {}
};
}

struct Frame {
    LAS unsigned char* lds; volatile LAS unsigned* MISC; unsigned* ctl; unsigned char* ws;
    int wave, G, bx;
    DI int lane_id() const { int l; asm volatile("v_mbcnt_lo_u32_b32 %0, -1, 0\n\tv_mbcnt_hi_u32_b32 %0, -1, %0" : "=v"(l)); return l; }
    DI int tid_id() const { return wave * 64 + lane_id(); }
    const float* const* in; float* out;
};
enum { I_X = 0, I_MEM, I_GMIX, I_WIN, I_CONVW, I_CONVB, I_MLBI, I_MLBF, I_MLGOUT, I_NGQ, I_NGK, I_CPK, I_CW1K, I_CB1K, I_CW2K, I_CPV, I_CW1V, I_CB1V, I_CW2V,
       I_GMEM, I_WMKV, I_MGQ, I_MGK, I_WBRML, I_WBRNSA, I_WBRMEM, I_WOUT, I_GFFN, I_WR, I_BR, I_WGU, I_BGU, I_WDN, I_BDN, N_IN };

template <class CM>
DI void tr_item(const float* W, int ldw, int K, bf16* WT, int k0, int n0, CM cm, LAS float* scr, int lane) {
    const int sc = cm(n0 + (lane & 31));
#pragma unroll 8
    for (int i = 0; i < 32; ++i) { const int kk = 2 * i + (lane >> 5); scr[kk * 33 + (lane & 31)] = sc >= 0 ? W[(size_t)(k0 + kk) * ldw + sc] : 0.f; }
    LDS_WAIT(); asm volatile("" ::: "memory");
    const int c = lane & 7;
#pragma unroll
    for (int j = 0; j < 4; ++j) { const int n = (lane >> 3) + 8 * j; const LAS float* s = scr + (8 * c) * 33 + n;
        v4u o; o.x = pk2(s[0 * 33], s[1 * 33]); o.y = pk2(s[2 * 33], s[3 * 33]); o.z = pk2(s[4 * 33], s[5 * 33]); o.w = pk2(s[6 * 33], s[7 * 33]);
        *(v4u*)(WT + (size_t)(n0 + n) * K + k0 + 8 * c) = o; }
    LDS_WAIT(); asm volatile("" ::: "memory");
}
DI void tr_item_f8(const float* W, int ldw, int K, unsigned char* WT, int k0, int n0, LAS float* scr, int lane) {
#pragma unroll 8
    for (int i = 0; i < 32; ++i) { const int kk = 2 * i + (lane >> 5); scr[kk * 33 + (lane & 31)] = W[(size_t)(k0 + kk) * ldw + n0 + (lane & 31)] * 256.0f; }
    LDS_WAIT(); asm volatile("" ::: "memory");
    const int c = lane & 7;
#pragma unroll
    for (int j = 0; j < 4; ++j) { const int n = (lane >> 3) + 8 * j; const LAS float* sp = scr + (8 * c) * 33 + n;
        int lo = 0, hi = 0;
        lo = __builtin_amdgcn_cvt_pk_fp8_f32(sp[0 * 33], sp[1 * 33], lo, false); lo = __builtin_amdgcn_cvt_pk_fp8_f32(sp[2 * 33], sp[3 * 33], lo, true);
        hi = __builtin_amdgcn_cvt_pk_fp8_f32(sp[4 * 33], sp[5 * 33], hi, false); hi = __builtin_amdgcn_cvt_pk_fp8_f32(sp[6 * 33], sp[7 * 33], hi, true);
        typedef unsigned u32x2t __attribute__((ext_vector_type(2)));
        *(u32x2t*)(WT + (size_t)(n0 + n) * K + k0 + 8 * c) = (u32x2t){(unsigned)lo, (unsigned)hi}; }
    LDS_WAIT(); asm volatile("" ::: "memory");
}
DI void tr_load_v4(const float* W, int ldw, int k0, int n0, int lane, f32x4 (&v)[8]) {
#pragma unroll
    for (int i = 0; i < 8; ++i) v[i] = *(const f32x4*)(W + (size_t)(k0 + 8 * i + (lane >> 3)) * ldw + n0 + 4 * (lane & 7));
}
DI void tr_put_v4(const f32x4 (&v)[8], LAS float* scr, int lane, float mul) {
#pragma unroll
    for (int i = 0; i < 8; ++i) { LAS float* d = scr + (8 * i + (lane >> 3)) * 33 + 4 * (lane & 7); d[0] = v[i].x * mul; d[1] = v[i].y * mul; d[2] = v[i].z * mul; d[3] = v[i].w * mul; }
    LDS_WAIT(); asm volatile("" ::: "memory");
}
DI void tr_fill_v4(const float* W, int ldw, int k0, int n0, LAS float* scr, int lane, float mul) { f32x4 v[8]; tr_load_v4(W, ldw, k0, n0, lane, v); tr_put_v4(v, scr, lane, mul); }
DI void tr_emit_bf16(bf16* WT, int K, int k0, int n0, LAS float* scr, int lane) {
    const int c = lane & 7;
#pragma unroll
    for (int j = 0; j < 4; ++j) { const int n = (lane >> 3) + 8 * j; const LAS float* sp = scr + (8 * c) * 33 + n;
        v4u o; o.x = pk2(sp[0 * 33], sp[1 * 33]); o.y = pk2(sp[2 * 33], sp[3 * 33]); o.z = pk2(sp[4 * 33], sp[5 * 33]); o.w = pk2(sp[6 * 33], sp[7 * 33]);
        *(v4u*)(WT + (size_t)(n0 + n) * K + k0 + 8 * c) = o; }
    LDS_WAIT(); asm volatile("" ::: "memory");
}
DI void tr_emit_f8(unsigned char* WT, int K, int k0, int n0, LAS float* scr, int lane) {
    const int c = lane & 7;
#pragma unroll
    for (int j = 0; j < 4; ++j) { const int n = (lane >> 3) + 8 * j; const LAS float* sp = scr + (8 * c) * 33 + n;
        int lo = 0, hi = 0;
        lo = __builtin_amdgcn_cvt_pk_fp8_f32(sp[0 * 33], sp[1 * 33], lo, false); lo = __builtin_amdgcn_cvt_pk_fp8_f32(sp[2 * 33], sp[3 * 33], lo, true);
        hi = __builtin_amdgcn_cvt_pk_fp8_f32(sp[4 * 33], sp[5 * 33], hi, false); hi = __builtin_amdgcn_cvt_pk_fp8_f32(sp[6 * 33], sp[7 * 33], hi, true);
        typedef unsigned u32x2t __attribute__((ext_vector_type(2)));
        *(u32x2t*)(WT + (size_t)(n0 + n) * K + k0 + 8 * c) = (u32x2t){(unsigned)lo, (unsigned)hi}; }
    LDS_WAIT(); asm volatile("" ::: "memory");
}
template <class CM>
DI void tr_fill_cm(const float* W, int ldw, int k0, int n0, CM cm, LAS float* scr, int lane, float mul) {
    const int sc = cm(n0 + (lane & 31));
#pragma unroll 8
    for (int i = 0; i < 32; ++i) { const int kk = 2 * i + (lane >> 5); scr[kk * 33 + (lane & 31)] = sc >= 0 ? W[(size_t)(k0 + kk) * ldw + sc] * mul : 0.f; }
    LDS_WAIT(); asm volatile("" ::: "memory");
}
struct CmId { DI int operator()(int j) const { return j; } };
struct CmProj { DI int operator()(int j) const { return proj_srccol(j); } };

DI void rms_row_bf16(const float* xrow, const float* g, bf16* orow, int lane) {
    const f32x4* xr = (const f32x4*)xrow + lane; const f32x4* gr = (const f32x4*)g + lane;
    f32x4 v[4]; float s = 0.f;
#pragma unroll
    for (int j = 0; j < 4; ++j) { v[j] = xr[64 * j]; s += (v[j].x * v[j].x + v[j].y * v[j].y) + (v[j].z * v[j].z + v[j].w * v[j].w); }
    const float rstd = rsqrtf(wave_sum(s) * (1.f / DM) + EPS);
    unsigned long long* o8 = (unsigned long long*)orow + lane;
#pragma unroll
    for (int j = 0; j < 4; ++j) { const f32x4 gg = gr[64 * j];
        o8[64 * j] = (unsigned long long)pk2(v[j].x * rstd * gg.x, v[j].y * rstd * gg.y) | ((unsigned long long)pk2(v[j].z * rstd * gg.z, v[j].w * rstd * gg.w) << 32); }
}

DI void rms_row_f8(const float* xrow, const float* g, unsigned char* orow, int lane) {
    const f32x4* xr = (const f32x4*)xrow + lane; const f32x4* gr = (const f32x4*)g + lane;
    f32x4 v[4]; float s = 0.f;
#pragma unroll
    for (int j = 0; j < 4; ++j) { v[j] = xr[64 * j]; s += (v[j].x * v[j].x + v[j].y * v[j].y) + (v[j].z * v[j].z + v[j].w * v[j].w); }
    const float rstd = rsqrtf(wave_sum(s) * (1.f / DM) + EPS);
    unsigned* o4 = (unsigned*)orow + lane;
#pragma unroll
    for (int j = 0; j < 4; ++j) { const f32x4 gg = gr[64 * j]; int q8 = 0;
        q8 = __builtin_amdgcn_cvt_pk_fp8_f32(v[j].x * rstd * gg.x, v[j].y * rstd * gg.y, q8, false); q8 = __builtin_amdgcn_cvt_pk_fp8_f32(v[j].z * rstd * gg.z, v[j].w * rstd * gg.w, q8, true);
        o4[64 * j] = (unsigned)q8; }
}
template <int NR>
DI void rms_rows_both(const float* x0, const float* g, bf16* o0, unsigned char* o80, size_t step, int lane) {
    const f32x4* gr = (const f32x4*)g + lane;
    f32x4 v[NR][4];
#pragma unroll
    for (int q = 0; q < NR; ++q) { const f32x4* xr = (const f32x4*)(x0 + q * step * DM) + lane;
#pragma unroll
        for (int j = 0; j < 4; ++j) v[q][j] = xr[64 * j]; }
#pragma unroll
    for (int q = 0; q < NR; ++q) { float s = 0.f;
#pragma unroll
        for (int j = 0; j < 4; ++j) s += (v[q][j].x * v[q][j].x + v[q][j].y * v[q][j].y) + (v[q][j].z * v[q][j].z + v[q][j].w * v[q][j].w);
        const float rstd = rsqrtf(wave_sum(s) * (1.f / DM) + EPS);
        unsigned long long* o8 = (unsigned long long*)(o0 + q * step * DM) + lane; unsigned* o4 = (unsigned*)(o80 + q * step * DM) + lane;
#pragma unroll
        for (int j = 0; j < 4; ++j) { const f32x4 gg = gr[64 * j]; const float y0 = v[q][j].x * rstd * gg.x, y1 = v[q][j].y * rstd * gg.y, y2 = v[q][j].z * rstd * gg.z, y3 = v[q][j].w * rstd * gg.w;
            o8[64 * j] = (unsigned long long)pk2(y0, y1) | ((unsigned long long)pk2(y2, y3) << 32);
            int q8 = 0; q8 = __builtin_amdgcn_cvt_pk_fp8_f32(y0, y1, q8, false); q8 = __builtin_amdgcn_cvt_pk_fp8_f32(y2, y3, q8, true);
            o4[64 * j] = (unsigned)q8; } }
}
DI void p0_prologue(Frame& F) {
    LAS float* scr = (LAS float*)(F.lds + F.wave * 16384);
    const int gw = F.bx * NWAVES + F.wave, NGW = F.G * NWAVES;
    unsigned char* ws = F.ws;
    constexpr int IT_IN = 16 * (NPROJ / 32), IT_GU = 32 * 16 * 64, IT_DN = 32 * 16 * 32, IT_MKV = 16 * 32, IT_BR = 3 * 8 * 32, IT_OUT = 16 * 32, IT_C1 = 2 * 32 * 8;
    constexpr int NITEMS = IT_IN + IT_GU + IT_DN + IT_MKV + IT_BR + IT_OUT + IT_C1;
    {
        struct D { const float* src; unsigned char* dst; int ldw, k0, n0; };
        auto dec = [&](int j) { D d; if (j < IT_GU) { const int e = j / 1024, q = j % 1024; d.src = F.in[I_WGU] + (size_t)e * DM * 2048; d.dst = (unsigned char*)(ws + WS_WGU) + (size_t)e * 2048 * DM; d.ldw = 2048; d.k0 = 64 * (q / 64); d.n0 = 32 * (q % 64); }
                                     else { const int jj = j - IT_GU, e = jj / 512, q = jj % 512; d.src = F.in[I_WDN] + (size_t)e * DFF * DM; d.dst = (unsigned char*)(ws + WS_WDN) + (size_t)e * DM * DFF; d.ldw = DM; d.k0 = 64 * (q / 32); d.n0 = 32 * (q % 32); } return d; };
        const int lane = F.lane_id();
        int j = gw; f32x4 va[8]; D da{};
        if (j < IT_GU + IT_DN) { da = dec(j); tr_load_v4(da.src, da.ldw, da.k0, da.n0, lane, va); }
#pragma unroll 1
        while (j < IT_GU + IT_DN) {
            const int jn = j + NGW; f32x4 vb[8]; D db{};
            if (jn < IT_GU + IT_DN) { db = dec(jn); tr_load_v4(db.src, db.ldw, db.k0, db.n0, lane, vb); }
            else {
#pragma unroll
                for (int i = 0; i < 8; ++i) vb[i] = va[i]; }
            tr_put_v4(va, scr, lane, 256.0f); tr_emit_f8(da.dst, 1024, da.k0, da.n0, scr, lane);
#pragma unroll
            for (int i = 0; i < 8; ++i) va[i] = vb[i];
            da = db; j = jn;
        }
    }
    for (int it = gw; it < NITEMS; it += NGW) {
        int r = it;
        if (r < IT_IN) { const int kb = r / (NPROJ / 32), nb = r % (NPROJ / 32); if (32 * nb < NB16) { tr_fill_cm(F.in[I_WIN], DIN_SRC, 64 * kb, 32 * nb, CmProj(), scr, F.lane_id(), 1.0f); tr_emit_bf16((bf16*)(ws + WS_WIN), DM, 64 * kb, 32 * nb, scr, F.lane_id()); }
            else { tr_fill_cm(F.in[I_WIN], DIN_SRC, 64 * kb, 32 * nb, CmProj(), scr, F.lane_id(), 256.0f); tr_emit_f8((unsigned char*)(ws + WS_WIN8), DM, 64 * kb, 32 * nb - NB16, scr, F.lane_id()); }
            continue; } r -= IT_IN;
        if (r < IT_GU + IT_DN) continue; r -= IT_GU + IT_DN;
        if (r < IT_MKV) { const int kb = r / 32, nb = r % 32; tr_fill_v4(F.in[I_WMKV], 1024, 64 * kb, 32 * nb, scr, F.lane_id(), 1.0f); tr_emit_bf16((bf16*)(ws + WS_WMKV), 1024, 64 * kb, 32 * nb, scr, F.lane_id()); continue; } r -= IT_MKV;
        if (r < IT_BR) { const int b = r / 256, q = r % 256, kb = q / 32, nb = q % 32; tr_fill_v4(F.in[I_WBRML + b], 1024, 64 * kb, 32 * nb, scr, F.lane_id(), 1.0f); tr_emit_bf16((bf16*)(ws + WS_WBR), 1536, 512 * b + 64 * kb, 32 * nb, scr, F.lane_id()); continue; } r -= IT_BR;
        if (r < IT_OUT) { const int kb = r / 32, nb = r % 32; tr_fill_v4(F.in[I_WOUT], 1024, 64 * kb, 32 * nb, scr, F.lane_id(), 1.0f); tr_emit_bf16((bf16*)(ws + WS_WOUT), 1024, 64 * kb, 32 * nb, scr, F.lane_id()); continue; } r -= IT_OUT;
        { const int kv = r / 256, q = r % 256, kb = q / 8, nb = q % 8; tr_fill_v4(F.in[kv ? I_CW1V : I_CW1K], 256, 64 * kb, 32 * nb, scr, F.lane_id(), 1.0f); tr_emit_bf16((bf16*)(ws + WS_WC1) + (size_t)kv * 256 * 2048, 2048, 64 * kb, 32 * nb, scr, F.lane_id()); }
    }
    { int m = gw;
      for (; m + 3 * NGW < MT; m += 4 * NGW) rms_rows_both<4>(F.in[I_X] + (size_t)m * DM, F.in[I_GMIX], (bf16*)(ws + WS_R1) + (size_t)m * DM, (unsigned char*)(ws + WS_U8) + (size_t)m * DM, (size_t)NGW, F.lane_id());
      for (; m < MT; m += NGW) rms_rows_both<1>(F.in[I_X] + (size_t)m * DM, F.in[I_GMIX], (bf16*)(ws + WS_R1) + (size_t)m * DM, (unsigned char*)(ws + WS_U8) + (size_t)m * DM, (size_t)NGW, F.lane_id()); }
    for (int m = gw; m < MROWS; m += NGW) rms_row_bf16(F.in[I_MEM] + (size_t)m * DM, F.in[I_GMEM], (bf16*)(ws + WS_MEMN) + (size_t)m * DM, F.lane_id());
    float* rc = (float*)(ws + WS_SMALL + SM_ROPEC); float* rs = (float*)(ws + WS_SMALL + SM_ROPES);
    for (int i = F.bx * 512 + F.tid_id(); i < SEQ * 32; i += F.G * 512) {
        const int p = i >> 5, k = i & 31;
        const float invf = exp2f(-(float)k * (13.287712379549449f / 32.0f));
        const float ang = (float)p * invf;
        const float kf = rintf(ang * 0.15915494309189535f);
        float r = fmaf(-kf, 6.28125f, ang); r = fmaf(-kf, 1.9353071795864769e-3f, r);
        rc[i] = cosf(r); rs[i] = sinf(r);
    }
    { bf16* wrt = (bf16*)(ws + WS_SMALL + SM_WRT);
      for (int i = F.bx * 512 + F.tid_id(); i < 32 * 1024; i += F.G * 512) { const int e = i >> 10, k = i & 1023; const float w = F.in[I_WR][k * 32 + e]; const unsigned hi = f2bf(w); wrt[i] = (bf16)hi; wrt[32 * 1024 + i] = (bf16)f2bf(w - __uint_as_float(hi << 16)); } }
    { bf16* w2t = (bf16*)(ws + WS_SMALL + SM_W2T);
      for (int i = F.bx * 512 + F.tid_id(); i < 2 * 64 * 256; i += F.G * 512) { const int kv = i >> 14, d = (i >> 8) & 63, f = i & 255; w2t[i] = (bf16)f2bf(F.in[kv ? I_CW2V : I_CW2K][f * 64 + d]); } }
    if (F.bx == F.G - 1) {
        const int kv = F.tid_id() >> 8, f = F.tid_id() & 255;
        const float* pe = F.in[kv ? I_CPV : I_CPK]; const float* w1 = F.in[kv ? I_CW1V : I_CW1K];
        float a = F.in[kv ? I_CB1V : I_CB1K][f];
        for (int k = 0; k < 2048; ++k) a = fmaf(pe[k], w1[(size_t)k * 256 + f], a);
        ((float*)(ws + WS_SMALL + SM_CBIAS))[kv * 256 + f] = a;
    }
}

DI void unpack8(const v4u& w, float (&f)[8]) {
    f[0] = __uint_as_float(w.x << 16); f[1] = __uint_as_float(w.x & 0xffff0000u); f[2] = __uint_as_float(w.y << 16); f[3] = __uint_as_float(w.y & 0xffff0000u);
    f[4] = __uint_as_float(w.z << 16); f[5] = __uint_as_float(w.z & 0xffff0000u); f[6] = __uint_as_float(w.w << 16); f[7] = __uint_as_float(w.w & 0xffff0000u);
}
DI v4u pack8f(const float (&f)[8]) { v4u o; o.x = pk2(f[0], f[1]); o.y = pk2(f[2], f[3]); o.z = pk2(f[4], f[5]); o.w = pk2(f[6], f[7]); return o; }
DI void load8f(const float* p, float (&f)[8]) { const f32x4 a = *(const f32x4*)p, b = *(const f32x4*)(p + 4); f[0] = a.x; f[1] = a.y; f[2] = a.z; f[3] = a.w; f[4] = b.x; f[5] = b.y; f[6] = b.z; f[7] = b.w; }
DI void norm_rope64(float (&f)[8], const float (&g)[8], const float (&c8)[8], const float (&s8)[8], int lane, float scale) {
    float ss = 0.f;
#pragma unroll
    for (int i = 0; i < 8; ++i) ss = fmaf(f[i], f[i], ss);
    ss += __shfl_xor(ss, 1); ss += __shfl_xor(ss, 2); ss += __shfl_xor(ss, 4);
    const float rstd = rsqrtf(ss * (1.f / 64.f) + EPS);
    const bool hi = (lane & 4) != 0;
#pragma unroll
    for (int i = 0; i < 8; ++i) { const float y = f[i] * rstd * g[i]; const float pt = __shfl_xor(y, 4); f[i] = (hi ? fmaf(pt, s8[i], y * c8[i]) : fmaf(-pt, s8[i], y * c8[i])) * scale; }
}
DI void p2_prep(Frame& F) {
    unsigned char* ws = F.ws;
    const int ncg = F.G >= 64 ? 32 : 0;
    if (F.bx < ncg) return;
    const int gw = (F.bx - ncg) * NWAVES + F.wave, NGW = (F.G - ncg) * NWAVES, lane = F.lane_id();
    const bf16* proj = (const bf16*)(ws + WS_PROJ);
    const float* rc = (const float*)(ws + WS_SMALL + SM_ROPEC); const float* rs = (const float*)(ws + WS_SMALL + SM_ROPES);
    bf16* qn = (bf16*)(ws + WS_QN); bf16* ksn = (bf16*)(ws + WS_KSN); bf16* kwn = (bf16*)(ws + WS_KWN); bf16* mqn = (bf16*)(ws + WS_MQN); bf16* mlqk = (bf16*)(ws + WS_MLQK);
    constexpr int NT = 4;
    {
        float gq8[8], mg8[8]; load8f(F.in[I_NGQ] + 8 * (lane & 7), gq8); load8f(F.in[I_MGQ] + 8 * (lane & 15), mg8);
        for (int t0 = gw * NT; t0 < MT; t0 += NGW * NT) {
            v4u a[NT], bq[NT], cv[NT]; float c8[NT][8], s8[NT][8];
#pragma unroll
            for (int u = 0; u < NT; ++u) { const int t = t0 + u, tau = t & 2047; const bf16* pr = proj + (size_t)t * NPROJ;
                a[u] = *(const v4u*)(pr + PC_NQ + 8 * lane); bq[u] = *(const v4u*)(pr + PC_MQ + 8 * lane); cv[u] = *(const v4u*)(pr + PC_MLV + 8 * lane);
                load8f(rc + tau * 32 + 8 * (lane & 3), c8[u]); load8f(rs + tau * 32 + 8 * (lane & 3), s8[u]); }
#pragma unroll
            for (int u = 0; u < NT; ++u) { const int t = t0 + u;
                float f[8]; unpack8(a[u], f);
                norm_rope64(f, gq8, c8[u], s8[u], lane, 0.125f * 1.4426950408889634f);
                *(v4u*)(qn + (size_t)t * 512 + 8 * lane) = pack8f(f);
                unpack8(bq[u], f);
                float ss = 0.f;
#pragma unroll
                for (int i = 0; i < 8; ++i) ss = fmaf(f[i], f[i], ss);
                ss += __shfl_xor(ss, 1); ss += __shfl_xor(ss, 2); ss += __shfl_xor(ss, 4); ss += __shfl_xor(ss, 8);
                const float rstd = rsqrtf(ss * (1.f / 128.f) + EPS) * (0.08838834764831845f * 1.4426950408889634f);
#pragma unroll
                for (int i = 0; i < 8; ++i) f[i] *= rstd * mg8[i];
                *(v4u*)(mqn + (size_t)t * 512 + 8 * lane) = pack8f(f);
                *(v4u*)((bf16*)(ws + WS_MLV) + (size_t)t * 512 + 8 * lane) = cv[u]; }
        }
    }
    {
        const int L = lane & 31, hd4 = L >> 3, j = L & 7, half = lane >> 5;
        float gk8[8]; load8f(F.in[I_NGK] + (1 + (hd4 >> 1)) * 64 + 8 * j, gk8);
        const int kcol = (hd4 < 2 ? PC_NKS + hd4 * 64 : PC_NKW + (hd4 - 2) * 64) + 8 * j;
        bf16* kdst = (hd4 < 2 ? ksn : kwn) + (hd4 & 1) * 64 + 8 * j;
        const int wv = L >> 4, jj = L & 15;
        bf16* vdst = (bf16*)(ws + (wv ? WS_VWN : WS_VSN)) + 8 * jj; const int vcol = (wv ? PC_NVW : PC_NVS) + 8 * jj;
        for (int tp0 = gw * NT; tp0 < MT / 2; tp0 += NGW * NT) {
            v4u a[NT], vv[NT]; float c8[NT][8], s8[NT][8];
#pragma unroll
            for (int u = 0; u < NT; ++u) { const int t = 2 * (tp0 + u) + half, tau = t & 2047; const bf16* pr = proj + (size_t)t * NPROJ;
                a[u] = *(const v4u*)(pr + kcol); vv[u] = *(const v4u*)(pr + vcol);
                load8f(rc + tau * 32 + 8 * (lane & 3), c8[u]); load8f(rs + tau * 32 + 8 * (lane & 3), s8[u]); }
#pragma unroll
            for (int u = 0; u < NT; ++u) { const int t = 2 * (tp0 + u) + half;
                float f[8]; unpack8(a[u], f);
                norm_rope64(f, gk8, c8[u], s8[u], lane, 1.0f);
                *(v4u*)(kdst + (size_t)t * 128) = pack8f(f);
                *(v4u*)(vdst + (size_t)t * 128) = vv[u]; }
        }
    }
    for (int run = gw; run < MT / 16; run += NGW) {
        const int t0 = run * 16, tau0 = t0 & 2047;
#pragma unroll 1
        for (int sp = 0; sp < 2; ++sp) {
            const int ch = 512 * sp + 8 * lane;
            float w0[8], w1[8], w2[8], w3[8], bb[8];
            load8f(F.in[I_CONVW] + ch, w0); load8f(F.in[I_CONVW] + 1024 + ch, w1); load8f(F.in[I_CONVW] + 2048 + ch, w2); load8f(F.in[I_CONVW] + 3072 + ch, w3); load8f(F.in[I_CONVB] + ch, bb);
            float x0[8], x1[8], x2[8];
            if (tau0 >= 3) { unpack8(*(const v4u*)(proj + (size_t)(t0 - 3) * NPROJ + ch), x0); unpack8(*(const v4u*)(proj + (size_t)(t0 - 2) * NPROJ + ch), x1); unpack8(*(const v4u*)(proj + (size_t)(t0 - 1) * NPROJ + ch), x2); }
            else {
#pragma unroll
                for (int i = 0; i < 8; ++i) { x0[i] = 0.f; x1[i] = 0.f; x2[i] = 0.f; } }
#pragma unroll 1
            for (int k0 = 0; k0 < 16; k0 += 4) {
                v4u raw[4];
#pragma unroll
                for (int k = 0; k < 4; ++k) raw[k] = *(const v4u*)(proj + (size_t)(t0 + k0 + k) * NPROJ + ch);
#pragma unroll
                for (int k = 0; k < 4; ++k) { float x3[8], y[8]; unpack8(raw[k], x3);
#pragma unroll
                    for (int i = 0; i < 8; ++i) { const float a = fmaf(w3[i], x3[i], fmaf(w2[i], x2[i], fmaf(w1[i], x1[i], fmaf(w0[i], x0[i], bb[i])))); y[i] = a * sigm(a); x0[i] = x1[i]; x1[i] = x2[i]; x2[i] = x3[i]; }
                    *(v4u*)(mlqk + (size_t)(t0 + k0 + k) * 1024 + ch) = pack8f(y); }
            }
        }
    }
    {
        const bf16* memkv = (const bf16*)(ws + WS_MEMKV); bf16* memkn = (bf16*)(ws + WS_MEMKN);
        float kg8[8]; load8f(F.in[I_MGK] + 8 * (lane & 15), kg8);
        for (int r = gw; r < MROWS; r += NGW) {
            float f[8]; unpack8(*(const v4u*)(memkv + (size_t)r * 1024 + 8 * lane), f);
            float ss = 0.f;
#pragma unroll
            for (int i = 0; i < 8; ++i) ss = fmaf(f[i], f[i], ss);
            ss += __shfl_xor(ss, 1); ss += __shfl_xor(ss, 2); ss += __shfl_xor(ss, 4); ss += __shfl_xor(ss, 8);
            const float rstd = rsqrtf(ss * (1.f / 128.f) + EPS);
#pragma unroll
            for (int i = 0; i < 8; ++i) f[i] *= rstd * kg8[i];
            *(v4u*)(memkn + (size_t)r * 512 + 8 * lane) = pack8f(f);
        }
    }
}

DI void p4_kcvc(Frame& F) {
    unsigned char* ws = F.ws;
    const int gw = F.bx * NWAVES + F.wave, NGW = F.G * NWAVES, lane = F.lane_id();
    const bf16* hid = (const bf16*)(ws + WS_HID);
    const float* rc = (const float*)(ws + WS_SMALL + SM_ROPEC); const float* rs = (const float*)(ws + WS_SMALL + SM_ROPES);
    const float gk = F.in[I_NGK][lane];
    for (int it = gw; it < 2 * 4096; it += NGW) {
        const int kv = it >> 12, r = it & 4095, n = r & 127;
        bf16* dst = (bf16*)(ws + (kv ? WS_VC : WS_KC)) + (size_t)r * 64 + lane;
        if (n == 127) { *dst = 0; continue; }
        const bf16* hr = hid + (size_t)kv * 4096 * 256 + (size_t)r * 256; const float* w2 = F.in[kv ? I_CW2V : I_CW2K];
        float a = 0.f;
        for (int f = 0; f < 256; ++f) a = fmaf(bf2f(hr[f]), w2[f * 64 + lane], a);
        if (kv == 0) {
            const float y = a * rsqrtf(wave_sum(a * a) * (1.f / 64.f) + EPS) * gk;
            const int pos = 16 * n + 31; const float c = rc[pos * 32 + (lane & 31)], s = rs[pos * 32 + (lane & 31)];
            const float pt = __shfl_xor(y, 32);
            a = lane < 32 ? y * c - pt * s : y * c + pt * s;
        }
        *dst = (bf16)f2bf(a);
    }
}

typedef float f32x16 __attribute__((ext_vector_type(16)));
typedef float f32x2v __attribute__((ext_vector_type(2)));
typedef __bf16 bf16x2v __attribute__((ext_vector_type(2)));
typedef short s16x4 __attribute__((ext_vector_type(4)));
typedef unsigned u32x2 __attribute__((ext_vector_type(2)));
#define MFMA32(a, b, c) __builtin_amdgcn_mfma_f32_32x32x16_bf16((a), (b), (c), 0, 0, 0)
#define WG_BAR() do { asm volatile("s_waitcnt vmcnt(0) lgkmcnt(0)" ::: "memory"); __builtin_amdgcn_s_barrier(); asm volatile("" ::: "memory"); } while (0)
DI unsigned pkbf(float lo, float hi) { f32x2v v = {lo, hi}; return __builtin_bit_cast(unsigned, __builtin_convertvector(v, bf16x2v)); }
template <int S> DI bf16x8 pack8(const f32x16& x) {
    v4u p; p.x = pkbf(x[8 * S], x[8 * S + 1]); p.y = pkbf(x[8 * S + 2], x[8 * S + 3]); p.z = pkbf(x[8 * S + 4], x[8 * S + 5]); p.w = pkbf(x[8 * S + 6], x[8 * S + 7]);
    return __builtin_bit_cast(bf16x8, p);
}
DI int crow(int i, int h) { return (i & 3) + 8 * (i >> 2) + 4 * h; }
constexpr int AT_K = 0, AT_V = 32768, AT_IMP = 65536, AT_WM = 98304, AT_INV = 98368, AT_SC = 99392;

DI void glds16(const void* gsrc, unsigned lds_dst) { unsigned keep; asm volatile("s_mov_b32 %0, m0\n\ts_mov_b32 m0, %2\n\ts_nop 0\n\tglobal_load_lds_dwordx4 %1, off\n\ts_mov_b32 m0, %0" : "=&s"(keep) : "v"(gsrc), "s"(lds_dst) : "memory"); }
DI void at_load(LAS unsigned char* lds, int par, const void* kb, size_t kpitch, const void* vb, size_t vpitch, int wave, int lane) {
    const int row = 8 * wave + (lane >> 3), pc = lane & 7;
    const int kc = pc ^ ((row >> 1) & 7), vc = pc ^ (((row >> 1) & 1) << 2);
    glds16((const char*)kb + (size_t)row * kpitch + 16 * kc, (unsigned)(size_t)(lds + AT_K + par * 8192 + wave * 1024));
    glds16((const char*)vb + (size_t)row * vpitch + 16 * vc, (unsigned)(size_t)(lds + AT_V + par * 8192 + wave * 1024));
}
#define SB() __builtin_amdgcn_sched_barrier(0)
typedef __attribute__((address_space(3))) s16x4 lds_s16x4;
DI void at_qk(const LAS unsigned char* kbuf, const int (&ka)[4], const bf16x8 (&qf)[4], f32x16 (&s)[2]) {
    bf16x8 kf[2][4];
#pragma unroll
    for (int kb = 0; kb < 2; ++kb)
#pragma unroll
        for (int st = 0; st < 4; ++st) kf[kb][st] = *(const LAS bf16x8*)(kbuf + ka[st] + kb * 4096);
    SB();
#pragma unroll
    for (int kb = 0; kb < 2; ++kb) {
        f32x16 a;
#pragma unroll
        for (int i = 0; i < 16; ++i) a[i] = 0.f;
#pragma unroll
        for (int st = 0; st < 4; ++st) a = MFMA32(kf[kb][st], qf[st], a);
        s[kb] = a;
    }
}
DI void at_vload(const LAS unsigned char* vbuf, const int (&va)[2], int kb, bf16x8 (&vf)[2][2]) {
#pragma unroll
    for (int s2 = 0; s2 < 2; ++s2)
#pragma unroll
        for (int db = 0; db < 2; ++db) {
            const s16x4 lo = __builtin_amdgcn_ds_read_tr16_b64_v4i16((lds_s16x4*)(vbuf + va[db] + kb * 4096 + s2 * 2048));
            const s16x4 hi = __builtin_amdgcn_ds_read_tr16_b64_v4i16((lds_s16x4*)(vbuf + va[db] + kb * 4096 + s2 * 2048 + 1024));
            vf[s2][db] = __builtin_shufflevector(lo, hi, 0, 1, 2, 3, 4, 5, 6, 7); }
}
DI void at_pv1(const bf16x8 (&vf)[2][2], const f32x16& p, f32x16 (&o)[2]) {
    const bf16x8 pf0 = pack8<0>(p), pf1 = pack8<1>(p);
#pragma unroll
    for (int s2 = 0; s2 < 2; ++s2)
#pragma unroll
        for (int db = 0; db < 2; ++db) o[db] = MFMA32(vf[s2][db], s2 ? pf1 : pf0, o[db]);
}
DI void at_pv(const LAS unsigned char* vbuf, const int (&va)[2], const bf16x8 (&vf0)[2][2], const f32x16 (&p)[2], f32x16 (&o)[2]) {
    bf16x8 vf1[2][2]; at_vload(vbuf, va, 1, vf1);
    at_pv1(vf0, p[0], o);
    at_pv1(vf1, p[1], o);
}
DI void at_exp_all(f32x16 (&s)[2], float& l) {
#pragma unroll
    for (int kb = 0; kb < 2; ++kb)
#pragma unroll
        for (int i = 0; i < 16; ++i) { const float p = __builtin_amdgcn_exp2f(s[kb][i]); s[kb][i] = p; l += p; }
}
DI void at_wait(int n) {
    if (n >= 2) asm volatile("s_waitcnt vmcnt(4)" ::: "memory"); else if (n == 1) asm volatile("s_waitcnt vmcnt(2)" ::: "memory"); else asm volatile("s_waitcnt vmcnt(0)" ::: "memory");
    asm volatile("s_waitcnt lgkmcnt(0)" ::: "memory"); __builtin_amdgcn_s_barrier(); asm volatile("" ::: "memory");
}
template <bool STORE = true, bool DO_CMP = true, bool DO_SEL = true, bool DO_WIN = true>
DI void nsa_unit(Frame& F, int unit) {
    unsigned char* ws = F.ws; LAS unsigned char* lds = F.lds;
    int lane_ = F.lane_id();
    const int lane = lane_, wave = F.wave, r = lane & 31, h = lane >> 5, g = wave >> 1, qh = wave & 1;
    const int bh = unit & 31, qt = 31 - (unit >> 5), b = bh >> 1, hkv = bh & 1;
    const int qloc = 32 * qh + r, tau = 64 * qt + qloc, qq = tau & 63; const size_t t = (size_t)b * SEQ + tau;
    const bf16* proj = (const bf16*)(ws + WS_PROJ);
    const bf16* qn = (const bf16*)(ws + WS_QN); const bf16* ksn = (const bf16*)(ws + WS_KSN); const bf16* kwn = (const bf16*)(ws + WS_KWN);
    const bf16* kc = (const bf16*)(ws + WS_KC); const bf16* vc = (const bf16*)(ws + WS_VC); bf16* H1 = (bf16*)(ws + WS_H0);
    int ka[4], va[2];
    { const int f = (r >> 1) & 7, fs = f >> 1, hb = h ^ (f & 1);
#pragma unroll
      for (int st = 0; st < 4; ++st) ka[st] = r * 128 + 16 * (((st ^ fs) << 1) | hb);
      const int i16 = lane & 15, q = i16 >> 2, p = i16 & 3, g1 = (lane >> 4) & 1;
#pragma unroll
      for (int db = 0; db < 2; ++db) va[db] = (4 * h + q) * 128 + 16 * ((4 * db + 2 * g1 + (p >> 1)) ^ (((q >> 1) & 1) << 2)) + 8 * (p & 1); }
    bf16x8 qf[4];
#pragma unroll
    for (int st = 0; st < 4; ++st) qf[st] = *(const bf16x8*)(qn + t * 512 + (hkv * 4 + g) * 64 + 16 * st + 8 * h);
    float gate[3];
#pragma unroll
    for (int c = 0; c < 3; ++c) gate[c] = sigm(bf2f(proj[t * NPROJ + PC_NG + (hkv * 4 + g) * 3 + c]));
    f32x16 ofin[2];
#pragma unroll
    for (int i = 0; i < 16; ++i) { ofin[0][i] = 0.f; ofin[1][i] = 0.f; }
    WG_BAR();
    if (DO_CMP) {
        const int ncq = tau >= 31 ? ((tau - 31) >> 4) + 1 : 0;
        const int ntc = (((64 * qt + 63 - 31) >> 4) + 1 > 64) ? 2 : 1;
        const char* kb0 = (const char*)(kc + (size_t)(b * 2 + hkv) * 128 * 64); const char* vb0 = (const char*)(vc + (size_t)(b * 2 + hkv) * 128 * 64);
        at_load(lds, 0, kb0, 128, vb0, 128, wave, lane);
        if (ntc == 2) at_load(lds, 1, kb0 + 64 * 128, 128, vb0 + 64 * 128, 128, wave, lane);
        WG_BAR();
        f32x16 o[2]; float l = 0.f, prevEp = 0.f;
#pragma unroll
        for (int i = 0; i < 16; ++i) { o[0][i] = 0.f; o[1][i] = 0.f; }
        LAS float* I = (LAS float*)(lds + AT_IMP) + (g * 64 + qloc) * 32;
#pragma unroll 1
        for (int tile = 0; tile < 2; ++tile) {
            if (tile < ntc) {
                f32x16 s[2];
                at_qk(lds + AT_K + tile * 8192, ka, qf, s);
                bf16x8 vf[2][2]; at_vload(lds + AT_V + tile * 8192, va, 0, vf); SB();
#pragma unroll
                for (int kb = 0; kb < 2; ++kb)
#pragma unroll
                    for (int i = 0; i < 16; ++i) { const int n = 64 * tile + 32 * kb + crow(i, h); const float p = n < ncq ? __builtin_amdgcn_exp2f(s[kb][i]) : 0.f; s[kb][i] = p; l += p; }
#pragma unroll
                for (int kb = 0; kb < 2; ++kb)
#pragma unroll
                    for (int a = 0; a < 4; ++a) { const int idx = tile * 8 + kb * 4 + a; const float Gv = (s[kb][4 * a] + s[kb][4 * a + 1]) + (s[kb][4 * a + 2] + s[kb][4 * a + 3]);
                        const float Epv = __shfl_xor(s[kb][4 * a + 3], 32);
                        I[2 * idx + h] = Gv + (h ? Epv : prevEp); prevEp = Epv; }
                at_pv(lds + AT_V + tile * 8192, va, vf, s, o);
            } else {
#pragma unroll
                for (int idx = 8; idx < 16; ++idx) I[2 * idx + h] = 0.f;
            }
        }
        const float L = l + __shfl_xor(l, 32); const float inv = L > 0.f ? 1.f / L : 0.f;
        const float gi = gate[0] * inv;
#pragma unroll
        for (int i = 0; i < 16; ++i) { ofin[0][i] += gi * o[0][i]; ofin[1][i] += gi * o[1][i]; }
        if (h == 0) ((LAS float*)(lds + AT_INV))[g * 64 + qloc] = inv;
    }
    WG_BAR();
    unsigned sel = 0u, wm = 0u, um = 0u;
    if (!DO_CMP) { sel = (qt == 31) ? 0xffffffffu : ((1u << (qt + 1)) - 1u); wm = sel; um = sel; }
    else {
        const LAS float* I = (const LAS float*)(lds + AT_IMP) + qloc * 32;
        const LAS float* IV = (const LAS float*)(lds + AT_INV) + qloc;
        const float iv0 = IV[0], iv1 = IV[64], iv2 = IV[128], iv3 = IV[192];
        LAS unsigned* SC = (LAS unsigned*)(lds + AT_SC) + (qh * 32 + r) * 33;
        if (g == 0 && h == 0) {
#pragma unroll 8
            for (int j = 0; j < 32; ++j) { const float imp = (I[j] * iv0 + I[64 * 32 + j] * iv1) + (I[2 * 64 * 32 + j] * iv2 + I[3 * 64 * 32 + j] * iv3);
                const bool cand = (j >= 1) && (j <= qt - 2);
                SC[j] = cand ? ((__float_as_uint(imp) & ~31u) | (unsigned)(31 - j)) + 32u : 0u; }
        }
        WG_BAR();
        if (qt <= 7) sel = (1u << (qt + 1)) - 1u;
        else {
            sel = 1u | (1u << qt) | (1u << (qt - 1));
            unsigned prev = 0xffffffffu;
#pragma unroll 1
            for (int rd = 0; rd < 5; ++rd) { unsigned best = 0u;
#pragma unroll 8
                for (int j = 0; j < 32; ++j) { const unsigned kx = SC[j]; const unsigned cnd = kx < prev ? kx : 0u; best = cnd > best ? cnd : best; }
                prev = best; if (best) sel |= 1u << (31 - (int)(best & 31u)); }
        }
        sel &= (qt == 31) ? 0xffffffffu : ((1u << (qt + 1)) - 1u);
        wm = sel;
#pragma unroll
        for (int o = 1; o < 32; o <<= 1) wm |= (unsigned)__shfl_xor((int)wm, o);
        wm = (unsigned)__builtin_amdgcn_readfirstlane((int)wm);
        if (lane == 0) ((LAS unsigned*)(lds + AT_WM))[wave] = wm;
        WG_BAR();
        um = 0u;
#pragma unroll
        for (int w = 0; w < 8; ++w) um |= ((const LAS unsigned*)(lds + AT_WM))[w];
        um = (unsigned)__builtin_amdgcn_readfirstlane((int)um);
    }
    if (DO_SEL) {
        f32x16 o[2]; float l = 0.f;
#pragma unroll
        for (int i = 0; i < 16; ++i) { o[0][i] = 0.f; o[1][i] = 0.f; }
        const char* kbase = (const char*)(ksn + (size_t)b * SEQ * 128 + hkv * 64); const char* vbase = (const char*)((const bf16*)(ws + WS_VSN) + (size_t)b * SEQ * 128 + hkv * 64);
        unsigned rem = um, im = um; int k = 0; const int T = __popc(um);
#pragma unroll 1
        for (int i = 0; i < 3 && im; ++i) { const int jn = __ffs((int)im) - 1; im &= im - 1u; at_load(lds, i, kbase + (size_t)jn * 64 * 256, 256, vbase + (size_t)jn * 64 * 256, 256, wave, lane); }
#pragma unroll 1
        while (rem) {
            const int j = __ffs((int)rem) - 1; rem &= rem - 1u;
            at_wait(T - k - 1);
#ifdef NSA_E1
            at_wait(T - k - 1);
#endif
            if (im) { const int jn = __ffs((int)im) - 1; im &= im - 1u; at_load(lds, (k + 3) & 3, kbase + (size_t)jn * 64 * 256, 256, vbase + (size_t)jn * 64 * 256, 256, wave, lane); }
            const int par = k & 3;
            if ((wm >> j) & 1u) {
                f32x16 s[2];
                at_qk(lds + AT_K + par * 8192, ka, qf, s);
                bf16x8 vf[2][2]; at_vload(lds + AT_V + par * 8192, va, 0, vf); SB();
                const bool on = (sel >> j) & 1u;
                if (j != qt && __all(on)) at_exp_all(s, l);
                else { const int klim = j == qt ? qq : 63;
#pragma unroll
                    for (int kb = 0; kb < 2; ++kb)
#pragma unroll
                        for (int i = 0; i < 16; ++i) { const int key = 32 * kb + crow(i, h); const float p = (on && key <= klim) ? __builtin_amdgcn_exp2f(s[kb][i]) : 0.f; s[kb][i] = p; l += p; } }
                at_pv(lds + AT_V + par * 8192, va, vf, s, o);
            }
            ++k;
        }
        const float L = l + __shfl_xor(l, 32); const float gi = gate[1] * (L > 0.f ? 1.f / L : 0.f);
#pragma unroll
        for (int i = 0; i < 16; ++i) { ofin[0][i] += gi * o[0][i]; ofin[1][i] += gi * o[1][i]; }
    }
    WG_BAR();
    if (DO_WIN) {
        f32x16 o[2]; float l = 0.f;
#pragma unroll
        for (int i = 0; i < 16; ++i) { o[0][i] = 0.f; o[1][i] = 0.f; }
        const char* kbase = (const char*)(kwn + (size_t)b * SEQ * 128 + hkv * 64); const char* vbase = (const char*)((const bf16*)(ws + WS_VWN) + (size_t)b * SEQ * 128 + hkv * 64);
        const int jlo = qt > 8 ? qt - 8 : 0; const int T = qt - jlo + 1;
#ifdef NSA_E2
        f32x16 o2[2]; float l2 = 0.f;
#pragma unroll
        for (int i = 0; i < 16; ++i) { o2[0][i] = 0.f; o2[1][i] = 0.f; }
#endif
#pragma unroll 1
        for (int i = 0; i < 3 && i < T; ++i) at_load(lds, i, kbase + (size_t)(jlo + i) * 64 * 256, 256, vbase + (size_t)(jlo + i) * 64 * 256, 256, wave, lane);
#pragma unroll 1
        for (int k = 0; k < T; ++k) {
            const int j = jlo + k, par = k & 3;
            at_wait(T - k - 1);
#ifdef NSA_E1
            at_wait(T - k - 1);
#endif
            if (k + 3 < T) at_load(lds, (k + 3) & 3, kbase + (size_t)(j + 3) * 64 * 256, 256, vbase + (size_t)(j + 3) * 64 * 256, 256, wave, lane);
            f32x16 s[2];
            at_qk(lds + AT_K + par * 8192, ka, qf, s);
            bf16x8 vf[2][2]; at_vload(lds + AT_V + par * 8192, va, 0, vf); SB();
#ifdef NSA_E2
            { f32x16 s2[2]; asm volatile("" ::: "memory"); at_qk(lds + AT_K + par * 8192, ka, qf, s2); bf16x8 vf2[2][2]; at_vload(lds + AT_V + par * 8192, va, 0, vf2); SB(); at_exp_all(s2, l2); at_pv(lds + AT_V + par * 8192, va, vf2, s2, o2); }
#endif
            if (j != qt && j != qt - 8) at_exp_all(s, l);
            else { const int klo = (j == qt - 8) ? qq + 1 : 0, khi = (j == qt) ? qq : 63;
#pragma unroll
                for (int kb = 0; kb < 2; ++kb)
#pragma unroll
                    for (int i = 0; i < 16; ++i) { const int key = 32 * kb + crow(i, h); const float p = (key >= klo && key <= khi) ? __builtin_amdgcn_exp2f(s[kb][i]) : 0.f; s[kb][i] = p; l += p; } }
            at_pv(lds + AT_V + par * 8192, va, vf, s, o);
        }
#ifdef NSA_E2
        { const float z = l2 * 0.f;
#pragma unroll
          for (int i = 0; i < 16; ++i) { ofin[0][i] += z * o2[0][i]; ofin[1][i] += z * o2[1][i]; } }
#endif
        const float L = l + __shfl_xor(l, 32); const float gi = gate[2] * (L > 0.f ? 1.f / L : 0.f);
#pragma unroll
        for (int i = 0; i < 16; ++i) { ofin[0][i] += gi * o[0][i]; ofin[1][i] += gi * o[1][i]; }
    }
    if (!STORE) { asm volatile("" :: "v"(ofin[0]), "v"(ofin[1])); return; }
    WG_BAR();
#pragma unroll
    for (int db = 0; db < 2; ++db)
#pragma unroll
        for (int a = 0; a < 4; ++a) { u32x2 w; w.x = pkbf(ofin[db][4 * a], ofin[db][4 * a + 1]); w.y = pkbf(ofin[db][4 * a + 2], ofin[db][4 * a + 3]); *(LAS u32x2*)(lds + qloc * 528 + g * 128 + (32 * db + 8 * a + 4 * h) * 2) = w; }
    WG_BAR();
    { const int tid = wave * 64 + lane; bf16* obase = H1 + ((size_t)b * SEQ + 64 * qt) * 1536 + 512 + hkv * 256;
#pragma unroll
      for (int i = 0; i < 4; ++i) { const int piece = tid + 512 * i, row = piece >> 5, c = piece & 31; *(v4u*)(obase + (size_t)row * 1536 + 8 * c) = *(const LAS v4u*)(lds + row * 528 + 16 * c); } }
}
constexpr int ML_K = 0, ML_V = 32768, ML_VW = 65536, ML_C = 81920, ML_N = 114688, ML_SS = 115200, ML_WS = 116224, ML_GO = 120320, ML_ST = 135424;
DI int ml_fk(int s) { return ((s & 3) << 2) | ((s >> 2) & 3); }
DI void ml_load(LAS unsigned char* lds, int par, const char* kb, const char* vb, int wave, int lane) {
#pragma unroll
    for (int n2 = 0; n2 < 2; ++n2) { const int n = 2 * wave + n2, row = 4 * n + (lane >> 4), pc = lane & 15;
        const int kc = pc ^ ml_fk(row), vc = pc ^ ((row & 3) << 2);
        glds16(kb + (size_t)row * 2048 + 16 * kc, (unsigned)(size_t)(lds + ML_K + par * 16384 + n * 1024));
        glds16(vb + (size_t)row * 1024 + 16 * vc, (unsigned)(size_t)(lds + ML_V + par * 16384 + n * 1024)); }
}
DI bf16x8 ml_tr8(const LAS unsigned char* p) {
    const s16x4 lo = __builtin_amdgcn_ds_read_tr16_b64_v4i16((lds_s16x4*)p); const s16x4 hi = __builtin_amdgcn_ds_read_tr16_b64_v4i16((lds_s16x4*)(p + 1024));
    return __builtin_shufflevector(lo, hi, 0, 1, 2, 3, 4, 5, 6, 7);
}
template <int PM = 0xff>
DI void mlstm_unit2(Frame& F, int unit) {
    unsigned char* ws = F.ws; LAS unsigned char* lds = F.lds;
    int lane_ = F.lane_id();
    const int lane = lane_, wave = F.wave, tid = wave * 64 + lane, r = lane & 31, hh = lane >> 5, tb = wave >> 2, vb = wave & 3;
    const int b = unit >> 2, hd = unit & 3;
    const bf16* proj = (const bf16*)(ws + WS_PROJ); const bf16* mlqk = (const bf16*)(ws + WS_MLQK); bf16* H0 = (bf16*)(ws + WS_H0);
    const size_t tok0 = (size_t)b * SEQ;
    const char* kbase = (const char*)(mlqk + tok0 * 1024 + 512 + hd * 128); const char* vbase = (const char*)((const bf16*)(ws + WS_MLV) + tok0 * 512 + hd * 128);
    const float LOG2E = 1.4426950408889634f;
    const int i16 = lane & 15, q4 = i16 >> 2, p4 = i16 & 3, g1 = (lane >> 4) & 1;
    const int colsw = 16 * ((4 * vb + 2 * g1 + (p4 >> 1)) ^ (q4 << 2)) + 8 * (p4 & 1);
    const int base_c = (8 * hh + q4) * 256 + colsw;
    const int base_v = (4 * hh + q4) * 256 + colsw;
    const int fK = ml_fk(r), rowK = r * 256 + ((hh ^ (fK & 1)) << 4), F16 = (fK & 14) << 4;
    int base_kt[2][2];
#pragma unroll
    for (int blk = 0; blk < 2; ++blk)
#pragma unroll
        for (int hi = 0; hi < 2; ++hi) { const int kbp = 2 * tb + blk; base_kt[blk][hi] = (8 * hh + 4 * hi + q4) * 256 + 16 * ((4 * kbp + 2 * g1 + (p4 >> 1)) ^ ((q4 << 2) | ((2 * hh + hi) & 3))) + 8 * (p4 & 1); }
    LAS float* WS = (LAS float*)(lds + ML_WS) + wave * 128;
    LAS float* NV = (LAS float*)(lds + ML_N); LAS float* SS = (LAS float*)(lds + ML_SS);
    __syncthreads();
    for (int i = tid; i < 32768 / 16; i += 512) ((LAS v4u*)(lds + ML_C))[i] = (v4u){0u, 0u, 0u, 0u};
    if (tid < 128) NV[tid] = 0.f;
    f32x16 Cst[2];
#pragma unroll
    for (int i = 0; i < 16; ++i) { Cst[0][i] = 0.f; Cst[1][i] = 0.f; }
    if (tid < 128) ((LAS float*)(lds + ML_GO))[tid] = F.in[I_MLGOUT][hd * 128 + tid];
    const float bi = F.in[I_MLBI][hd], bfv = F.in[I_MLBF][hd];
    float m_prev = 0.f;
    ml_load(lds, 0, kbase, vbase, wave, lane);
    bf16x8 qf[8];
    { const bf16* qp = mlqk + (tok0 + 32 * tb + r) * 1024 + hd * 128 + 8 * hh;
#pragma unroll
      for (int st = 0; st < 8; ++st) qf[st] = *(const bf16x8*)(qp + 16 * st); }
    float gi_raw = bf2f(proj[(tok0 + lane) * NPROJ + PC_MLI + hd]), gf_raw = bf2f(proj[(tok0 + lane) * NPROJ + PC_MLF + hd]);
#pragma unroll 1
    for (int c = 0; c < 32; ++c) {
        const int par = c & 1; const size_t tokc = tok0 + 64 * c;
        WG_BAR();
        if ((PM & 1) && c > 0) {
            bf16* obase = H0 + (tokc - 64) * 1536 + hd * 128;
#pragma unroll
            for (int i = 0; i < 2; ++i) { const int piece = tid + 512 * i, row = piece >> 4, cc = piece & 15; *(v4u*)(obase + (size_t)row * 1536 + 8 * cc) = *(const LAS v4u*)(lds + ML_ST + row * 272 + 16 * cc); } }
        if (c < 31) ml_load(lds, par ^ 1, kbase + (size_t)(64 * (c + 1)) * 2048, vbase + (size_t)(64 * (c + 1)) * 1024, wave, lane);
        u32x2 og[4];
        { const bf16* op = proj + (tokc + 32 * tb + r) * NPROJ + PC_MLO + hd * 128 + 32 * vb + 4 * hh;
#pragma unroll
          for (int a = 0; a < 4; ++a) og[a] = *(const u32x2*)(op + 8 * a); }
        const float ig = gi_raw + bi, lf = logsig(gf_raw + bfv);
        float bc = lf;
        if (PM & 2) {
#pragma unroll
        for (int o = 1; o < 64; o <<= 1) { const float v = __shfl_up(bc, o); if (lane >= o) bc += v; } }
        const float rr = ig - bc;
        float cm = rr;
        if (PM & 2) {
#pragma unroll
        for (int o = 1; o < 64; o <<= 1) { const float v = __shfl_up(cm, o); if (lane >= o) cm = fmaxf(cm, v); } }
        const float M63 = fmaxf(m_prev, __shfl(cm, 63)), blast = __shfl(bc, 63);
        const float a_old = __expf(m_prev - M63), m_new = blast + M63;
        const int tl = 32 * tb + r;
        const float Mt = fmaxf(m_prev, __shfl(cm, tl)), bt = __shfl(bc, tl);
        const float inter = __expf(m_prev - Mt), m_t = bt + Mt;
        WS[lane] = rr * LOG2E; WS[64 + lane] = __expf(rr - M63);
        const float MtL = Mt * LOG2E;
        const LAS unsigned char* kbuf = lds + ML_K + par * 16384; const LAS unsigned char* vbuf = lds + ML_V + par * 16384;
        f32x16 wd[2]; float dsum = 0.f;
#pragma unroll
        for (int kb = 0; kb < 2; ++kb) {
#pragma unroll
            for (int i = 0; i < 16; ++i) wd[kb][i] = 0.f;
            if ((PM & 4) && kb <= tb) {
                f32x16 a = wd[kb]; bf16x8 kfr[8];
#pragma unroll
                for (int st = 0; st < 8; ++st) kfr[st] = *(const LAS bf16x8*)(kbuf + kb * 8192 + rowK + ((32 * st) ^ F16));
                SB();
#pragma unroll
                for (int st = 0; st < 8; ++st) a = MFMA32(kfr[st], qf[st], a);
#pragma unroll
                for (int i = 0; i < 16; ++i) { const int s = 32 * kb + crow(i, hh); const float e = __builtin_amdgcn_exp2f(WS[s] - MtL); const float w = (s <= tl) ? e * a[i] : 0.f; a[i] = w; dsum += w; }
                wd[kb] = a;
            }
        }
        f32x16 acc; bf16x8 cfr[8];
#pragma unroll
        for (int i = 0; i < 16; ++i) acc[i] = 0.f;
        if (PM & 8) {
#pragma unroll
        for (int st = 0; st < 8; ++st) cfr[st] = ml_tr8(lds + ML_C + base_c + st * 4096);
        SB();
#pragma unroll
        for (int st = 0; st < 8; ++st) acc = MFMA32(cfr[st], qf[st], acc); }
#pragma unroll
        for (int i = 0; i < 16; ++i) acc[i] *= inter;
#pragma unroll
        for (int kb = 0; kb < 2; ++kb) {
            if ((PM & 16) && kb <= tb) {
                const bf16x8 pf0 = pack8<0>(wd[kb]), pf1 = pack8<1>(wd[kb]);
                {
#pragma unroll
                  for (int s2 = 0; s2 < 2; ++s2) { const LAS unsigned char* p = vbuf + base_v + kb * 8192 + s2 * 4096;
                    const s16x4 lo = __builtin_amdgcn_ds_read_tr16_b64_v4i16((lds_s16x4*)p); const s16x4 hi = __builtin_amdgcn_ds_read_tr16_b64_v4i16((lds_s16x4*)(p + 2048));
                    const bf16x8 vf = __builtin_shufflevector(lo, hi, 0, 1, 2, 3, 4, 5, 6, 7);
                    acc = MFMA32(vf, s2 ? pf1 : pf0, acc); } }
            }
        }
        float qn_ = 0.f;
        if (PM & 32)
#pragma unroll
        for (int st = 0; st < 8; ++st) { const v4u qw = __builtin_bit_cast(v4u, qf[st]); const LAS float* np = NV + 16 * st + 8 * hh; const f32x4 n0 = *(const LAS f32x4*)np, n1 = *(const LAS f32x4*)(np + 4);
            qn_ = fmaf(__uint_as_float(qw.x << 16), n0[0], qn_); qn_ = fmaf(__uint_as_float(qw.x & 0xffff0000u), n0[1], qn_); qn_ = fmaf(__uint_as_float(qw.y << 16), n0[2], qn_); qn_ = fmaf(__uint_as_float(qw.y & 0xffff0000u), n0[3], qn_);
            qn_ = fmaf(__uint_as_float(qw.z << 16), n1[0], qn_); qn_ = fmaf(__uint_as_float(qw.z & 0xffff0000u), n1[1], qn_); qn_ = fmaf(__uint_as_float(qw.w << 16), n1[2], qn_); qn_ = fmaf(__uint_as_float(qw.w & 0xffff0000u), n1[3], qn_); }
        qn_ += __shfl_xor(qn_, 32); dsum += __shfl_xor(dsum, 32);
        const float den = inter * qn_ + dsum; const float rden = 1.f / fmaxf(fabsf(den), __expf(-m_t));
        float ssq = 0.f;
#pragma unroll
        for (int i = 0; i < 16; ++i) { acc[i] *= rden; ssq = fmaf(acc[i], acc[i], ssq); }
        ssq += __shfl_xor(ssq, 32);
        if (hh == 0) SS[vb * 64 + tl] = ssq;
        if (PM & 64)
#pragma unroll
        for (int k2 = 0; k2 < 2; ++k2) { const int ci = tid + 512 * k2, s = ci >> 4; const float w = WS[64 + s];
            const v4u x = *(const LAS v4u*)(vbuf + ci * 16); v4u y; const unsigned xs[4] = {x.x, x.y, x.z, x.w}; unsigned ys[4];
#pragma unroll
            for (int j = 0; j < 4; ++j) ys[j] = pkbf(__uint_as_float(xs[j] << 16) * w, __uint_as_float(xs[j] & 0xffff0000u) * w);
            y.x = ys[0]; y.y = ys[1]; y.z = ys[2]; y.w = ys[3]; *(LAS v4u*)(lds + ML_VW + ci * 16) = y; }
        asm volatile("s_waitcnt lgkmcnt(0)" ::: "memory"); __builtin_amdgcn_s_barrier(); asm volatile("" ::: "memory");
        if (c < 31) {
            const bf16* qp = mlqk + (tokc + 64 + 32 * tb + r) * 1024 + hd * 128 + 8 * hh;
#pragma unroll
            for (int st = 0; st < 8; ++st) qf[st] = *(const bf16x8*)(qp + 16 * st);
            gi_raw = bf2f(proj[(tokc + 64 + lane) * NPROJ + PC_MLI + hd]); gf_raw = bf2f(proj[(tokc + 64 + lane) * NPROJ + PC_MLF + hd]);
        }
        { const LAS float* GO = (const LAS float*)(lds + ML_GO) + 32 * vb + 4 * hh;
          const float rstd = rsqrtf(((SS[tl] + SS[64 + tl]) + (SS[128 + tl] + SS[192 + tl])) * (1.f / 128.f) + EPS);
#pragma unroll
          for (int a = 0; a < 4; ++a) { float o4[4]; const unsigned gw[2] = {og[a].x, og[a].y};
#pragma unroll
              for (int j = 0; j < 4; ++j) { const float ov = (j & 1) ? __uint_as_float(gw[j >> 1] & 0xffff0000u) : __uint_as_float(gw[j >> 1] << 16); o4[j] = acc[4 * a + j] * rstd * GO[8 * a + j] * sigm(ov); }
              u32x2 w; w.x = pkbf(o4[0], o4[1]); w.y = pkbf(o4[2], o4[3]); *(LAS u32x2*)(lds + ML_ST + tl * 272 + (32 * vb + 8 * a + 4 * hh) * 2) = w; } }
        if (PM & 128)
#pragma unroll
        for (int blk = 0; blk < 2; ++blk) {
            f32x16 cs = Cst[blk];
#pragma unroll
            for (int i = 0; i < 16; ++i) cs[i] *= a_old;
            bf16x8 afr[4], kfr2[4];
#pragma unroll
            for (int st = 0; st < 4; ++st) {
                afr[st] = ml_tr8(lds + ML_VW + base_c + st * 4096);
                const s16x4 lo = __builtin_amdgcn_ds_read_tr16_b64_v4i16((lds_s16x4*)(kbuf + base_kt[blk][0] + st * 4096)); const s16x4 hi = __builtin_amdgcn_ds_read_tr16_b64_v4i16((lds_s16x4*)(kbuf + base_kt[blk][1] + st * 4096));
                kfr2[st] = __builtin_shufflevector(lo, hi, 0, 1, 2, 3, 4, 5, 6, 7);
            }
            SB();
#pragma unroll
            for (int st = 0; st < 4; ++st) cs = MFMA32(afr[st], kfr2[st], cs);
            Cst[blk] = cs;
            const int kk = 32 * (2 * tb + blk) + r;
#pragma unroll
            for (int a = 0; a < 4; ++a) { u32x2 w; w.x = pkbf(cs[4 * a], cs[4 * a + 1]); w.y = pkbf(cs[4 * a + 2], cs[4 * a + 3]);
                *(LAS u32x2*)(lds + ML_C + kk * 256 + 16 * ((4 * vb + a) ^ ((r & 3) << 2)) + 8 * hh) = w; }
        }
        if ((PM & 64) && tid < 128) { float nv = NV[tid] * a_old;
#pragma unroll 8
            for (int s = 0; s < 64; ++s) { const unsigned short kvs = *(const LAS unsigned short*)(kbuf + s * 256 + 16 * ((tid >> 3) ^ ml_fk(s)) + 2 * (tid & 7)); nv = fmaf(WS[64 + s], bf2f(kvs), nv); }
            NV[tid] = nv; }
        m_prev = m_new;
    }
    __syncthreads();
    if (PM & 1) { bf16* obase = H0 + (tok0 + 64 * 31) * 1536 + hd * 128;
#pragma unroll
        for (int i = 0; i < 2; ++i) { const int piece = tid + 512 * i, row = piece >> 4, cc = piece & 15; *(v4u*)(obase + (size_t)row * 1536 + 8 * cc) = *(const LAS v4u*)(lds + ML_ST + row * 272 + 16 * cc); } }
    __syncthreads();
}
DI void mem_load(LAS unsigned char* lds, int par, const char* kb, const char* vb, int wave, int lane) {
#pragma unroll
    for (int n2 = 0; n2 < 2; ++n2) { const int n = 2 * wave + n2, row = 4 * n + (lane >> 4), pc = lane & 15;
        const int kc = pc ^ ml_fk(row), vc = pc ^ ((row & 3) << 2);
        glds16(kb + (size_t)row * 1024 + 16 * kc, (unsigned)(size_t)(lds + ML_K + par * 16384 + n * 1024));
        glds16(vb + (size_t)row * 2048 + 16 * vc, (unsigned)(size_t)(lds + ML_V + par * 16384 + n * 1024)); }
}
template <bool STORE = true, bool DMA = true, bool COMP = true>
DI void mem_unit(Frame& F, int unit) {
    unsigned char* ws = F.ws; LAS unsigned char* lds = F.lds;
    int lane_ = F.lane_id();
    const int lane = lane_, wave = F.wave, r = lane & 31, hh = lane >> 5;
    const int b = unit >> 5, hd = (unit >> 3) & 3, qt = unit & 7;
    const bf16* mqn = (const bf16*)(ws + WS_MQN); const bf16* memkn = (const bf16*)(ws + WS_MEMKN); const bf16* memkv = (const bf16*)(ws + WS_MEMKV); bf16* H2 = (bf16*)(ws + WS_H0);
    const size_t t = (size_t)b * SEQ + 256 * qt + 32 * wave + r;
    const char* kbase = (const char*)(memkn + (size_t)b * MEML * 512 + hd * 128); const char* vbase = (const char*)(memkv + (size_t)b * MEML * 1024 + 512 + hd * 128);
    const int i16 = lane & 15, q4 = i16 >> 2, p4 = i16 & 3, g1 = (lane >> 4) & 1;
    int base_v[4];
#pragma unroll
    for (int db = 0; db < 4; ++db) base_v[db] = (4 * hh + q4) * 256 + 16 * ((4 * db + 2 * g1 + (p4 >> 1)) ^ (q4 << 2)) + 8 * (p4 & 1);
    const int fK = ml_fk(r), rowK = r * 256 + ((hh ^ (fK & 1)) << 4), F16 = (fK & 14) << 4;
    bf16x8 qf[8];
#pragma unroll
    for (int st = 0; st < 8; ++st) qf[st] = *(const bf16x8*)(mqn + t * 512 + hd * 128 + 16 * st + 8 * hh);
    f32x16 o[4]; float l = 0.f;
#pragma unroll
    for (int db = 0; db < 4; ++db)
#pragma unroll
        for (int i = 0; i < 16; ++i) o[db][i] = 0.f;
    WG_BAR();
    if (DMA) mem_load(lds, 0, kbase, vbase, wave, lane);
#pragma unroll 1
    for (int tile = 0; tile < 4; ++tile) {
        const int par = tile & 1;
        WG_BAR();
        if (DMA && tile < 3) mem_load(lds, par ^ 1, kbase + (size_t)(64 * (tile + 1)) * 1024, vbase + (size_t)(64 * (tile + 1)) * 2048, wave, lane);
        const LAS unsigned char* kbuf = lds + ML_K + par * 16384; const LAS unsigned char* vbuf = lds + ML_V + par * 16384;
        if (COMP)
#pragma unroll
        for (int kb = 0; kb < 2; ++kb) {
            bf16x8 kf[8];
#pragma unroll
            for (int st = 0; st < 8; ++st) kf[st] = *(const LAS bf16x8*)(kbuf + kb * 8192 + rowK + ((32 * st) ^ F16));
            SB();
            f32x16 a;
#pragma unroll
            for (int i = 0; i < 16; ++i) a[i] = 0.f;
#pragma unroll
            for (int st = 0; st < 8; ++st) a = MFMA32(kf[st], qf[st], a);
            bf16x8 vf[2][4];
#pragma unroll
            for (int s2 = 0; s2 < 2; ++s2)
#pragma unroll
                for (int db = 0; db < 4; ++db) { const LAS unsigned char* p = vbuf + base_v[db] + kb * 8192 + s2 * 4096;
                    const s16x4 lo = __builtin_amdgcn_ds_read_tr16_b64_v4i16((lds_s16x4*)p); const s16x4 hi = __builtin_amdgcn_ds_read_tr16_b64_v4i16((lds_s16x4*)(p + 2048));
                    vf[s2][db] = __builtin_shufflevector(lo, hi, 0, 1, 2, 3, 4, 5, 6, 7); }
            SB();
#pragma unroll
            for (int i = 0; i < 16; ++i) { a[i] = __builtin_amdgcn_exp2f(a[i]); l += a[i]; }
            const bf16x8 pf0 = pack8<0>(a), pf1 = pack8<1>(a);
#pragma unroll
            for (int s2 = 0; s2 < 2; ++s2)
#pragma unroll
                for (int db = 0; db < 4; ++db) o[db] = MFMA32(vf[s2][db], s2 ? pf1 : pf0, o[db]);
        }
    }
    const float inv = 1.f / (l + __shfl_xor(l, 32));
    if (!STORE) {
#pragma unroll
        for (int db = 0; db < 4; ++db) asm volatile("" :: "v"(o[db]), "v"(inv));
        return; }
    WG_BAR();
#pragma unroll
    for (int db = 0; db < 4; ++db)
#pragma unroll
        for (int a = 0; a < 4; ++a) { u32x2 w; w.x = pkbf(o[db][4 * a] * inv, o[db][4 * a + 1] * inv); w.y = pkbf(o[db][4 * a + 2] * inv, o[db][4 * a + 3] * inv);
            *(LAS u32x2*)(lds + (32 * wave + r) * 272 + (32 * db + 8 * a + 4 * hh) * 2) = w; }
    WG_BAR();
    { const int tid = wave * 64 + lane; bf16* obase = H2 + ((size_t)b * SEQ + 256 * qt) * 1536 + 1024 + hd * 128;
#pragma unroll
      for (int i = 0; i < 8; ++i) { const int piece = tid + 512 * i, row = piece >> 4, c = piece & 15; *(v4u*)(obase + (size_t)row * 1536 + 8 * c) = *(const LAS v4u*)(lds + row * 272 + 16 * c); } }
}
DI int q_pop(Frame& F, unsigned* qc) {
    __syncthreads();
    if (F.tid_id() == 0) F.MISC[16] = atomicAdd(qc, 1u);
    __syncthreads();
    return (int)F.MISC[16];
}
template <bool ML, bool NSA, bool MEMA, bool MST = true, bool MDMA = true, bool MCOMP = true, bool NST = true, bool NCMP = true, bool NSEL = true, bool NWIN = true, int MLPM = 0xff>
DI void p5_queue(Frame& F, int cbase) {
    unsigned* qc = F.ctl + CW_QCTR + cbase;
    if (ML) {
#pragma unroll 1
        for (;;) { const int it = q_pop(F, qc); if (it >= 64) break; mlstm_unit2<MLPM>(F, it); }
    }
    if (NSA) {
#pragma unroll 1
        for (;;) { const int it = q_pop(F, qc + 64); if (it >= 1024) break; nsa_unit<NST, NCMP, NSEL, NWIN>(F, it); }
    }
    if (MEMA) {
#pragma unroll 1
        for (;;) { const int it = q_pop(F, qc + 128); if (it >= 512) break; mem_unit<MST, MDMA, MCOMP>(F, it); }
    }
    __syncthreads();
}
struct OneUnit { int pm; DI bool next(int i, pg8::Unit& u) const { if (i) return false; u.pm = pm; u.pn = 0; return true; } DI void a_ready(const pg8::Unit&) const {} DI void done(const pg8::Unit&) const {} };
DI void p2_compress(Frame& F) {
    unsigned char* ws = F.ws;
    if (F.G < 64 || F.bx >= 32) return;
    const int kv = F.bx >> 4, pm = F.bx & 15;
    typedef pg8::bf16_t b16;
    { pg8::GemmA g{(const b16*)(ws + WS_PROJ) + (kv ? PC_NVC : PC_NKC), (const b16*)(ws + WS_WC1) + (size_t)kv * 256 * 2048, 2048, 16 * NPROJ * 2, (size_t)NPROJ * 2, (size_t)128, (size_t)SEQ * NPROJ * 2};
      OneUnit S{pm};
      pg8::EpiBf16Silu E{(b16*)(ws + WS_HID) + (size_t)kv * 4096 * 256, 256, (const float*)(ws + WS_SMALL + SM_CBIAS) + kv * 256, 1};
      pg8::gemm_phase_ga<pg8::EpiBf16Silu, OneUnit, false, true>(F.lds, g, S, E, F.wave); }
    asm volatile("s_waitcnt vmcnt(0)" ::: "memory"); __syncthreads();
    const int lane = F.lane_id(), r = lane & 31, hh = lane >> 5;
    const int row = pm * 256 + F.wave * 32 + r, n = row & 127;
    const bf16* hid = (const bf16*)(ws + WS_HID) + (size_t)kv * 4096 * 256 + (size_t)row * 256 + 8 * hh;
    const bf16* w2t = (const bf16*)(ws + WS_SMALL + SM_W2T) + (size_t)kv * 64 * 256 + 8 * hh;
    f32x16 acc[2];
#pragma unroll
    for (int i = 0; i < 16; ++i) { acc[0][i] = 0.f; acc[1][i] = 0.f; }
#pragma unroll 4
    for (int st = 0; st < 16; ++st) { const bf16x8 hb = *(const bf16x8*)(hid + 16 * st);
        const bf16x8 w0 = *(const bf16x8*)(w2t + (size_t)r * 256 + 16 * st), w1 = *(const bf16x8*)(w2t + (size_t)(32 + r) * 256 + 16 * st);
        acc[0] = MFMA32(w0, hb, acc[0]); acc[1] = MFMA32(w1, hb, acc[1]); }
    if (kv == 0) {
        float ss = 0.f;
#pragma unroll
        for (int i = 0; i < 16; ++i) ss += acc[0][i] * acc[0][i] + acc[1][i] * acc[1][i];
        ss += __shfl_xor(ss, 32);
        const float rstd = rsqrtf(ss * (1.f / 64.f) + EPS);
        const float* rc = (const float*)(ws + WS_SMALL + SM_ROPEC); const float* rs = (const float*)(ws + WS_SMALL + SM_ROPES);
        const int pos = 16 * n + 31 < SEQ ? 16 * n + 31 : SEQ - 1;
#pragma unroll
        for (int i = 0; i < 16; ++i) { const int d = crow(i, hh); const float c = rc[pos * 32 + d], sn = rs[pos * 32 + d];
            const float y0 = acc[0][i] * rstd * F.in[I_NGK][d], y1 = acc[1][i] * rstd * F.in[I_NGK][32 + d];
            acc[0][i] = y0 * c - y1 * sn; acc[1][i] = y1 * c + y0 * sn; }
    }
    bf16* dst = (bf16*)(ws + (kv ? WS_VC : WS_KC)) + (size_t)row * 64 + 4 * hh;
#pragma unroll
    for (int db = 0; db < 2; ++db)
#pragma unroll
        for (int a = 0; a < 4; ++a) { u32x2 w; w.x = pkbf(acc[db][4 * a], acc[db][4 * a + 1]); w.y = pkbf(acc[db][4 * a + 2], acc[db][4 * a + 3]); if (n == 127) { w.x = 0u; w.y = 0u; }
            *(u32x2*)(dst + 32 * db + 8 * a) = w; }
}
DI void mlstm_unit(Frame& F, int unit) {
    unsigned char* ws = F.ws;
    const int b = unit >> 2, h = unit & 3, tid = F.tid_id(), kk = tid >> 7, c = tid & 127;
    const bf16* proj = (const bf16*)(ws + WS_PROJ); const bf16* mlqk = (const bf16*)(ws + WS_MLQK); bf16* H0 = (bf16*)(ws + WS_H0);
    LAS float* qs = (LAS float*)F.lds;
    LAS float* ks = qs + 16 * 128;
    LAS float* vs = ks + 16 * 128;
    LAS float* gi = vs + 16 * 128;
    LAS float* gf = gi + 16;
    LAS float* part = gf + 16;
    LAS float* pden = part + 2 * 4 * 128;
    LAS float* hb = pden + 8;
    float C[32], nn[32];
#pragma unroll
    for (int i = 0; i < 32; ++i) { C[i] = 0.f; nn[i] = 0.f; }
    float m = 0.f;
    const float bi = F.in[I_MLBI][h], bfv = F.in[I_MLBF][h];
    const float scale = 0.08838834764831845f;
#pragma unroll 1
    for (int t0 = 0; t0 < SEQ; t0 += 16) {
        __syncthreads();
        for (int i = tid; i < 16 * 128; i += 512) { const int s = i >> 7, d = i & 127; const size_t t = (size_t)b * SEQ + t0 + s;
            qs[i] = bf2f(mlqk[t * 1024 + h * 128 + d]); ks[i] = bf2f(mlqk[t * 1024 + 512 + h * 128 + d]); vs[i] = bf2f(proj[t * NPROJ + PC_MLV + h * 128 + d]); }
        if (tid < 16) { const size_t t = (size_t)b * SEQ + t0 + tid; gi[tid] = bf2f(proj[t * NPROJ + PC_MLI + h]) + bi; gf[tid] = logsig(bf2f(proj[t * NPROJ + PC_MLF + h]) + bfv); }
        __syncthreads();
#pragma unroll 1
        for (int s = 0; s < 16; ++s) {
            const float lf = gf[s], ig = gi[s];
            const float mn = fmaxf(lf + m, ig), a = __expf(lf + m - mn), bb = __expf(ig - mn);
            m = mn;
            const float v = vs[s * 128 + c];
            float pn = 0.f, pd = 0.f;
#pragma unroll
            for (int i = 0; i < 32; ++i) { const float kvv = ks[s * 128 + kk * 32 + i], qv = qs[s * 128 + kk * 32 + i];
                C[i] = a * C[i] + bb * kvv * v; nn[i] = a * nn[i] + bb * kvv; pn = fmaf(qv, C[i], pn); pd = fmaf(qv, nn[i], pd); }
            const int par = s & 1;
            part[(par * 4 + kk) * 128 + c] = pn; if (c == 0) pden[par * 4 + kk] = pd;
            __syncthreads();
            if (kk == 0) {
                const float num = (part[(par * 4 + 0) * 128 + c] + part[(par * 4 + 1) * 128 + c]) + (part[(par * 4 + 2) * 128 + c] + part[(par * 4 + 3) * 128 + c]);
                const float den = (pden[par * 4 + 0] + pden[par * 4 + 1]) + (pden[par * 4 + 2] + pden[par * 4 + 3]);
                hb[s * 128 + c] = num * scale / fmaxf(fabsf(den * scale), __expf(-mn));
            }
        }
        __syncthreads();
#pragma unroll
        for (int rr = 0; rr < 2; ++rr) { const int s = F.wave * 2 + rr; const size_t t = (size_t)b * SEQ + t0 + s;
            const float v0 = hb[s * 128 + F.lane_id()], v1 = hb[s * 128 + 64 + F.lane_id()];
            const float rstd = rsqrtf(wave_sum(v0 * v0 + v1 * v1) * (1.f / 128.f) + EPS);
            const float o0 = bf2f(proj[t * NPROJ + PC_MLO + h * 128 + F.lane_id()]), o1 = bf2f(proj[t * NPROJ + PC_MLO + h * 128 + 64 + F.lane_id()]);
            H0[t * 512 + h * 128 + F.lane_id()] = (bf16)f2bf(v0 * rstd * F.in[I_MLGOUT][h * 128 + F.lane_id()] * sigm(o0));
            H0[t * 512 + h * 128 + 64 + F.lane_id()] = (bf16)f2bf(v1 * rstd * F.in[I_MLGOUT][h * 128 + 64 + F.lane_id()] * sigm(o1)); }
    }
    __syncthreads();
}

DI void nsa_scores(const bf16* krow, bool valid, const LAS float* qs, float (&s)[4]) {
    s[0] = s[1] = s[2] = s[3] = 0.f;
    if (valid) {
#pragma unroll 2
        for (int c8 = 0; c8 < 8; ++c8) { const v4u kk = *(const v4u*)(krow + c8 * 8);
            const unsigned w[4] = {kk.x, kk.y, kk.z, kk.w};
#pragma unroll
            for (int j = 0; j < 4; ++j) { const float k0 = __uint_as_float(w[j] << 16), k1 = __uint_as_float(w[j] & 0xffff0000u); const int d = c8 * 8 + 2 * j;
#pragma unroll
                for (int g = 0; g < 4; ++g) s[g] = fmaf(k1, qs[g * 64 + d + 1], fmaf(k0, qs[g * 64 + d], s[g])); } }
    }
}
DI void nsa_wave(Frame& F, int item, LAS float* wl) {
    unsigned char* ws = F.ws; const int lane = F.lane_id();
    const int t = item >> 1, hkv = item & 1, b = t >> 11, tau = t & 2047;
    const bf16* proj = (const bf16*)(ws + WS_PROJ);
    const bf16* qn = (const bf16*)(ws + WS_QN); const bf16* ksn = (const bf16*)(ws + WS_KSN); const bf16* kwn = (const bf16*)(ws + WS_KWN);
    const bf16* kc = (const bf16*)(ws + WS_KC); const bf16* vc = (const bf16*)(ws + WS_VC); bf16* H1 = (bf16*)(ws + WS_H1);
    LAS float* qs = wl;
    LAS float* ps = wl + 256;
    LAS float* psum = wl + 768;
#pragma unroll
    for (int g = 0; g < 4; ++g) qs[g * 64 + lane] = bf2f(qn[(size_t)t * 512 + (hkv * 4 + g) * 64 + lane]);
    float ofin[4] = {0.f, 0.f, 0.f, 0.f};
    float gate[4][3];
#pragma unroll
    for (int g = 0; g < 4; ++g)
#pragma unroll
        for (int cidx = 0; cidx < 3; ++cidx) gate[g][cidx] = sigm(bf2f(proj[(size_t)t * NPROJ + PC_NG + (hkv * 4 + g) * 3 + cidx]));
    const int ncmp = tau >= 31 ? ((tau - 31) >> 4) + 1 : 0;
    {
        float l[4] = {0.f, 0.f, 0.f, 0.f}, o[4] = {0.f, 0.f, 0.f, 0.f};
        const size_t rbase = (size_t)(b * 2 + hkv) * 128;
#pragma unroll
        for (int blk = 0; blk < 2; ++blk) { const int n = blk * 64 + lane; const bool valid = n < ncmp; float s[4];
            nsa_scores(kc + (rbase + n) * 64, valid, qs, s);
#pragma unroll
            for (int g = 0; g < 4; ++g) { const float p = valid ? __expf(s[g]) : 0.f; l[g] += p; ps[g * 128 + n] = p; } }
        float inv[4];
#pragma unroll
        for (int g = 0; g < 4; ++g) { const float L = wave_sum(l[g]); inv[g] = L > 0.f ? 1.f / L : 0.f; }
#pragma unroll
        for (int blk = 0; blk < 2; ++blk) { const int n = blk * 64 + lane; psum[n] = (ps[0 * 128 + n] * inv[0] + ps[1 * 128 + n] * inv[1]) + (ps[2 * 128 + n] * inv[2] + ps[3 * 128 + n] * inv[3]); }
#pragma unroll 2
        for (int n = 0; n < ncmp; ++n) { const float vv = bf2f(vc[(rbase + n) * 64 + lane]);
#pragma unroll
            for (int g = 0; g < 4; ++g) o[g] = fmaf(ps[g * 128 + n], vv, o[g]); }
#pragma unroll
        for (int g = 0; g < 4; ++g) ofin[g] += gate[g][0] * o[g] * inv[g];
    }
    const int cur = tau >> 6;
    unsigned selmask = 0u;
    {
        float score = -3.0e38f;
        if (lane < 32) { const int j = lane; float imp = 0.f;
#pragma unroll
            for (int dn = -1; dn <= 3; ++dn) { const int n = 4 * j + dn; if (n >= 0 && n <= 126) imp += psum[n]; }
            const bool forced = (j == 0) || (j == cur) || (j == cur - 1);
            score = j > cur ? NEGF : imp + (forced ? 1.0e4f : 0.f); }
#pragma unroll 1
        for (int r = 0; r < 8; ++r) { const float mx = wave_max(score); const unsigned long long bal = __ballot(score == mx); const int win = __ffsll((long long)bal) - 1;
            selmask |= 1u << win; if (lane == win) score = -3.4e38f; }
    }
    {
        float l[4] = {0.f, 0.f, 0.f, 0.f}, o[4] = {0.f, 0.f, 0.f, 0.f};
#pragma unroll 1
        for (int j = 0; j <= cur; ++j) { if (!((selmask >> j) & 1u)) continue;
            const int kpos = 64 * j + lane; const bool valid = kpos <= tau; float s[4];
            nsa_scores(ksn + ((size_t)b * SEQ + kpos) * 128 + hkv * 64, valid, qs, s);
#pragma unroll
            for (int g = 0; g < 4; ++g) { const float p = valid ? __expf(s[g]) : 0.f; l[g] += p; ps[g * 128 + lane] = p; }
            const int nk = j == cur ? (tau & 63) + 1 : 64;
            const bf16* vb = proj + ((size_t)b * SEQ + 64 * j) * NPROJ + PC_NVS + hkv * 64 + lane;
#pragma unroll 2
            for (int k = 0; k < nk; ++k) { const float vv = bf2f(vb[(size_t)k * NPROJ]);
#pragma unroll
                for (int g = 0; g < 4; ++g) o[g] = fmaf(ps[g * 128 + k], vv, o[g]); } }
#pragma unroll
        for (int g = 0; g < 4; ++g) { const float L = wave_sum(l[g]); ofin[g] += gate[g][1] * o[g] * (L > 0.f ? 1.f / L : 0.f); }
    }
    {
        float l[4] = {0.f, 0.f, 0.f, 0.f}, o[4] = {0.f, 0.f, 0.f, 0.f};
        const int start = tau - 511 > 0 ? tau - 511 : 0;
#pragma unroll 1
        for (int base = start & ~63; base <= tau; base += 64) {
            const int kpos = base + lane; const bool valid = kpos >= start && kpos <= tau; float s[4];
            nsa_scores(kwn + ((size_t)b * SEQ + kpos) * 128 + hkv * 64, valid, qs, s);
#pragma unroll
            for (int g = 0; g < 4; ++g) { const float p = valid ? __expf(s[g]) : 0.f; l[g] += p; ps[g * 128 + lane] = p; }
            const int k0 = start > base ? start - base : 0, k1 = tau - base < 63 ? tau - base : 63;
            const bf16* vb = proj + ((size_t)b * SEQ + base) * NPROJ + PC_NVW + hkv * 64 + lane;
#pragma unroll 2
            for (int k = k0; k <= k1; ++k) { const float vv = bf2f(vb[(size_t)k * NPROJ]);
#pragma unroll
                for (int g = 0; g < 4; ++g) o[g] = fmaf(ps[g * 128 + k], vv, o[g]); } }
#pragma unroll
        for (int g = 0; g < 4; ++g) { const float L = wave_sum(l[g]); ofin[g] += gate[g][2] * o[g] * (L > 0.f ? 1.f / L : 0.f); }
    }
#pragma unroll
    for (int g = 0; g < 4; ++g) H1[(size_t)t * 512 + (hkv * 4 + g) * 64 + lane] = (bf16)f2bf(ofin[g]);
}
DI void mem_wave(Frame& F, int t, LAS float* wl) {
    unsigned char* ws = F.ws; const int lane = F.lane_id(); const int b = t >> 11;
    const bf16* mqn = (const bf16*)(ws + WS_MQN); const bf16* memkn = (const bf16*)(ws + WS_MEMKN); const bf16* memkv = (const bf16*)(ws + WS_MEMKV); bf16* H2 = (bf16*)(ws + WS_H2);
    LAS float* qs = wl;
    LAS float* ps = wl + 128;
#pragma unroll 1
    for (int h = 0; h < 4; ++h) {
        qs[lane] = bf2f(mqn[(size_t)t * 512 + h * 128 + lane]); qs[64 + lane] = bf2f(mqn[(size_t)t * 512 + h * 128 + 64 + lane]);
        float l = 0.f;
#pragma unroll 1
        for (int kq = 0; kq < 4; ++kq) { const int key = kq * 64 + lane; const bf16* kr = memkn + ((size_t)b * MEML + key) * 512 + h * 128; float s = 0.f;
#pragma unroll 2
            for (int c8 = 0; c8 < 16; ++c8) { const v4u kk = *(const v4u*)(kr + c8 * 8); const unsigned w[4] = {kk.x, kk.y, kk.z, kk.w};
#pragma unroll
                for (int j = 0; j < 4; ++j) s = fmaf(__uint_as_float(w[j] & 0xffff0000u), qs[c8 * 8 + 2 * j + 1], fmaf(__uint_as_float(w[j] << 16), qs[c8 * 8 + 2 * j], s)); }
            const float p = __expf(s); l += p; ps[key] = p; }
        const float inv = 1.f / wave_sum(l);
        float o0 = 0.f, o1 = 0.f;
        const bf16* vb = memkv + (size_t)b * MEML * 1024 + 512 + h * 128;
#pragma unroll 4
        for (int key = 0; key < MEML; ++key) { const float p = ps[key]; o0 = fmaf(p, bf2f(vb[(size_t)key * 1024 + lane]), o0); o1 = fmaf(p, bf2f(vb[(size_t)key * 1024 + 64 + lane]), o1); }
        H2[(size_t)t * 512 + h * 128 + lane] = (bf16)f2bf(o0 * inv); H2[(size_t)t * 512 + h * 128 + 64 + lane] = (bf16)f2bf(o1 * inv);
    }
}
DI void p5_mixers(Frame& F) {
    const int nml = F.G >= 128 ? 64 : 0;
#ifndef RPT_ML
#define RPT_ML 1
#endif
#ifndef RPT_NSA
#define RPT_NSA 1
#endif
#ifndef RPT_MEM
#define RPT_MEM 1
#endif
    if (F.bx < nml || nml == 0) { for (int rp = 0; rp < RPT_ML; ++rp) for (int u = F.bx; u < 64; u += (nml ? nml : F.G)) mlstm_unit2(F, u); }
    if (F.bx >= nml) {
        LAS float* wl = (LAS float*)(F.lds + F.wave * 4096);
        const int gw = (F.bx - nml) * NWAVES + F.wave, NGW = (F.G - nml) * NWAVES;
        for (int rp = 0; rp < RPT_NSA; ++rp) for (int u = F.bx - nml; u < 1024; u += F.G - nml) nsa_unit(F, u);
        __syncthreads();
        for (int rp = 0; rp < RPT_MEM; ++rp) for (int t = gw; t < MT; t += NGW) mem_wave(F, t, wl);
    }
}

DI void p8_router(Frame& F, int alt) {
    unsigned char* ws = F.ws + (size_t)alt * 3 * MiB; const int lane = F.lane_id(), tid = F.tid_id(), wave = F.wave, r = lane & 31, hh = lane >> 5;
    unsigned char* xn8 = (unsigned char*)(F.ws + WS_R1);
    int* tok_e = (int*)(ws + WS_ROUTE + RT_TOKE); int* tok_pos = (int*)(ws + WS_ROUTE + RT_TOKPOS); float* tok_w = (float*)(ws + WS_ROUTE + RT_TOKW);
    unsigned* gcnt = F.ctl + CW_ECNT + 64 * alt;
    const bf16* wrt = (const bf16*)(F.ws + WS_SMALL + SM_WRT);
    LAS unsigned char* img = F.lds;
    LAS float* part = (LAS float*)F.lds;
    LAS float* lg = (LAS float*)(F.lds + 4 * 64 * 33 * 4);
    LAS int* lcnt = (LAS int*)(F.lds + RING_BYTES + 1024);
    LAS int* lbase = lcnt + 32;
    LAS int* se = lbase + 32;
    LAS int* sp = se + 256;
    LAS float* sw = (LAS float*)(sp + 256);
    const float* gf = F.in[I_GFFN];
    for (int bt = F.bx; bt < MT / 64; bt += F.G) {
        __syncthreads();
        if (tid < 32) lcnt[tid] = 0;
#pragma unroll 2
        for (int i = 0; i < 8; ++i) {
            const int tl = wave * 8 + i, t = bt * 64 + tl;
            const f32x4* xr = (const f32x4*)(F.out + (size_t)t * DM) + lane; const f32x4* gr = (const f32x4*)gf + lane;
            f32x4 v[4]; float s = 0.f;
#pragma unroll
            for (int j = 0; j < 4; ++j) { v[j] = xr[64 * j]; s += (v[j].x * v[j].x + v[j].y * v[j].y) + (v[j].z * v[j].z + v[j].w * v[j].w); }
            const float rstd = rsqrtf(wave_sum(s) * (1.f / DM) + EPS);
            unsigned* o4 = (unsigned*)(xn8 + (size_t)t * DM) + lane;
#pragma unroll
            for (int j = 0; j < 4; ++j) { const f32x4 gg = gr[64 * j];
                const float y0 = v[j].x * rstd * gg.x, y1 = v[j].y * rstd * gg.y, y2 = v[j].z * rstd * gg.z, y3 = v[j].w * rstd * gg.w;
                const unsigned long long w = (unsigned long long)pk2(y0, y1) | ((unsigned long long)pk2(y2, y3) << 32);
                int q8 = 0; q8 = __builtin_amdgcn_cvt_pk_fp8_f32(y0, y1, q8, false); q8 = __builtin_amdgcn_cvt_pk_fp8_f32(y2, y3, q8, true);
                o4[64 * j] = (unsigned)q8;
                const int d = 4 * lane + 256 * j, ch = d >> 3;
                *(LAS unsigned long long*)(img + tl * 2048 + 16 * (ch ^ (tl & 15)) + 2 * (d & 7)) = w; }
        }
        __syncthreads();
        {
            const int mb = wave & 1, kq = wave >> 1, trow = 32 * mb + r;
            f32x16 acc;
#pragma unroll
            for (int i = 0; i < 16; ++i) acc[i] = 0.f;
#pragma unroll 4
            for (int s2 = 0; s2 < 16; ++s2) { const int st = 16 * kq + s2;
                const bf16x8 xa = *(const LAS bf16x8*)(img + trow * 2048 + 16 * ((2 * st + hh) ^ (trow & 15)));
                const bf16x8 wh = *(const bf16x8*)(wrt + (size_t)r * 1024 + 16 * st + 8 * hh), wl = *(const bf16x8*)(wrt + 32 * 1024 + (size_t)r * 1024 + 16 * st + 8 * hh);
                acc = MFMA32(xa, wh, acc); acc = MFMA32(xa, wl, acc); }
            __syncthreads();
#pragma unroll
            for (int i = 0; i < 16; ++i) part[(kq * 64 + 32 * mb + crow(i, hh)) * 33 + r] = acc[i];
        }
        __syncthreads();
        for (int i = tid; i < 64 * 32; i += 512) { const int tk = i >> 5, e = i & 31; lg[tk * 33 + e] = ((part[(0 * 64 + tk) * 33 + e] + part[(1 * 64 + tk) * 33 + e]) + (part[(2 * 64 + tk) * 33 + e] + part[(3 * 64 + tk) * 33 + e])) + F.in[I_BR][e]; }
        __syncthreads();
        for (int i = 0; i < 8; ++i) {
            const int tl = wave * 8 + i, e = lane & 31;
            float sc = lg[tl * 33 + e]; int ek[4]; float vk[4];
#pragma unroll
            for (int rd = 0; rd < 4; ++rd) { const float mx = wave_max(sc); const unsigned long long bal = __ballot(sc == mx); const int win = (__ffsll((long long)bal) - 1) & 31;
                ek[rd] = win; vk[rd] = mx; if (e == win) sc = -3.4e38f; }
            const float e1 = __expf(vk[1] - vk[0]), e2 = __expf(vk[2] - vk[0]), e3 = __expf(vk[3] - vk[0]); const float inv = 1.f / (1.f + e1 + e2 + e3);
            if (lane == 0) {
                const float wk[4] = {inv, e1 * inv, e2 * inv, e3 * inv};
#pragma unroll
                for (int rd = 0; rd < 4; ++rd) { se[tl * 4 + rd] = ek[rd]; sw[tl * 4 + rd] = wk[rd]; sp[tl * 4 + rd] = atomicAdd((int*)&lcnt[ek[rd]], 1); }
            }
        }
        __syncthreads();
        if (tid < 32) lbase[tid] = (int)atomicAdd(&gcnt[tid], (unsigned)lcnt[tid]);
        __syncthreads();
        if (tid < 256) { const int t = bt * 64 + (tid >> 2), k = tid & 3; const int e = se[tid];
          tok_e[t * 4 + k] = e; tok_pos[t * 4 + k] = lbase[e] + sp[tid]; tok_w[t * 4 + k] = sw[tid]; }
    }
    __syncthreads();
}
DI int moe_tables(Frame& F, LAS int* pstart, LAS unsigned char* blk_e) {
    unsigned* gcnt = F.ctl + CW_ECNT;
    __syncthreads();
    if (F.wave == 0) {
        const int l = F.lane_id(); int pad = 0;
        if (l < NEXP) { const int cnt = (int)__hip_atomic_load(&gcnt[l], __ATOMIC_RELAXED, __HIP_MEMORY_SCOPE_AGENT); pad = (cnt + MOEB - 1) / MOEB * MOEB; }
        int inc = pad;
#pragma unroll
        for (int o = 1; o < 32; o <<= 1) { const int v = __shfl_up(inc, o); if (l >= o) inc += v; }
        if (l < NEXP) pstart[l] = inc - pad;
        if (l == NEXP - 1) pstart[NEXP] = inc;
    }
    __syncthreads();
    const int nblk = pstart[NEXP] / MOEB;
    for (int rb = F.tid_id(); rb < nblk; rb += 512) { int e = 0; while (e < NEXP - 1 && pstart[e + 1] <= rb * MOEB) ++e; blk_e[rb] = (unsigned char)e; }
    __syncthreads();
    return nblk;
}
DI void p9_scatter(Frame& F) {
    unsigned char* ws = F.ws; const int lane = F.lane_id();
    LAS int* pstart = (LAS int*)(F.lds + 65536); LAS unsigned char* blk_e = (LAS unsigned char*)(F.lds + 65536 + 256);
    moe_tables(F, pstart, blk_e);
    const unsigned char* xn8 = (const unsigned char*)(ws + WS_R1); unsigned char* aperm = (unsigned char*)(ws + WS_APERM);
    const int* tok_e = (const int*)(ws + WS_ROUTE + RT_TOKE); const int* tok_pos = (const int*)(ws + WS_ROUTE + RT_TOKPOS); const float* tok_w = (const float*)(ws + WS_ROUTE + RT_TOKW);
    int* tok_dest = (int*)(ws + WS_ROUTE + RT_TOKDEST); float* roww = (float*)(ws + WS_ROUTE + RT_ROWW);
    unsigned* gcnt = F.ctl + CW_ECNT;
    const int gw = F.bx * NWAVES + F.wave, NGW = F.G * NWAVES;
    for (int t4 = gw; t4 < MT / 4; t4 += NGW) {
        int dest = 0;
        if (lane < 16) { const int it = t4 * 16 + lane; dest = pstart[tok_e[it]] + tok_pos[it]; tok_dest[it] = dest; roww[dest] = tok_w[it]; }
        v4u v0[4];
#pragma unroll
        for (int q = 0; q < 4; ++q) { const v4u* src = (const v4u*)(xn8 + (size_t)(t4 * 4 + q) * DM); v0[q] = src[lane]; }
#pragma unroll
        for (int q = 0; q < 4; ++q)
#pragma unroll
            for (int k = 0; k < 4; ++k) { const int d = __shfl(dest, q * 4 + k); v4u* dst = (v4u*)(aperm + (size_t)d * DM); dst[lane] = v0[q]; }
    }
    for (int it = gw; it < NEXP * MOEB; it += NGW) { const int e = it >> 8, i = it & 255; const int cnt = (int)__hip_atomic_load(&gcnt[e], __ATOMIC_RELAXED, __HIP_MEMORY_SCOPE_AGENT); const int padded = (cnt + MOEB - 1) / MOEB * MOEB;
        if (i < padded - cnt) { const int dest = pstart[e] + cnt + i; v4u* dst = (v4u*)(aperm + (size_t)dest * DM); const v4u z = {0u, 0u, 0u, 0u}; dst[lane] = z; if (lane == 0) roww[dest] = 0.f; } }
}
DI void p12_combine(Frame& F) {
    unsigned char* ws = F.ws; const int lane = F.lane_id();
    const bf16* ybuf = (const bf16*)(ws + WS_APERM); const int* tok_dest = (const int*)(ws + WS_ROUTE + RT_TOKDEST);
    const int gw = F.bx * NWAVES + F.wave, NGW = F.G * NWAVES;
    for (int t2 = gw; t2 < MT / 2; t2 += NGW) {
        typedef int i32x4 __attribute__((ext_vector_type(4)));
        v4u w[2][4][2]; f32x4 a[2][2][2];
#pragma unroll
        for (int q = 0; q < 2; ++q) { const int t = 2 * t2 + q; const f32x4* orow = (const f32x4*)(F.out + (size_t)t * DM);
            const i32x4 d = *(const i32x4*)(tok_dest + t * 4); const int dd[4] = {d.x, d.y, d.z, d.w};
#pragma unroll
            for (int j = 0; j < 2; ++j) {
#pragma unroll
                for (int k = 0; k < 4; ++k) w[q][k][j] = *((const v4u*)(ybuf + (size_t)dd[k] * DM) + lane + 64 * j);
                a[q][j][0] = orow[2 * (lane + 64 * j)]; a[q][j][1] = orow[2 * (lane + 64 * j) + 1]; } }
#pragma unroll
        for (int q = 0; q < 2; ++q) { f32x4* orow = (f32x4*)(F.out + (size_t)(2 * t2 + q) * DM);
#pragma unroll
            for (int j = 0; j < 2; ++j) {
#pragma unroll
                for (int k = 0; k < 4; ++k) { const v4u ww = w[q][k][j];
                    a[q][j][0].x += __uint_as_float(ww.x << 16); a[q][j][0].y += __uint_as_float(ww.x & 0xffff0000u); a[q][j][0].z += __uint_as_float(ww.y << 16); a[q][j][0].w += __uint_as_float(ww.y & 0xffff0000u);
                    a[q][j][1].x += __uint_as_float(ww.z << 16); a[q][j][1].y += __uint_as_float(ww.z & 0xffff0000u); a[q][j][1].z += __uint_as_float(ww.w << 16); a[q][j][1].w += __uint_as_float(ww.w & 0xffff0000u); }
                orow[2 * (lane + 64 * j)] = a[q][j][0]; orow[2 * (lane + 64 * j) + 1] = a[q][j][1]; } }
    }
}

constexpr int N_PHASES = 13;
#ifndef MK_PER_PHASE
#define MK_PER_PHASE 0
#endif
__global__ void __launch_bounds__(NWAVES * 64, 2) fwd_kernel(Args args) {
    extern __shared__ __attribute__((aligned(16))) unsigned char lds_raw[];
    Frame F;
    F.lds = (LAS unsigned char*)lds_raw; F.MISC = (volatile LAS unsigned*)(F.lds + MISC_OFF);
    F.wave = __builtin_amdgcn_readfirstlane((int)(threadIdx.x >> 6)); F.G = gridDim.x; F.bx = blockIdx.x;
    F.ws = args.ws; F.ctl = (unsigned*)(args.ws + WS_CTL); F.in = args.in; F.out = args.out;
    unsigned char* ws = args.ws;
    for (int u = threadIdx.x; u < (LDS_BYTES - LDSCTL_OFF) / 4; u += NWAVES * 64) ((LAS unsigned*)(F.lds + LDSCTL_OFF))[u] = 0u;
    __syncthreads();
    const int lo = args.ph_lo, hi = args.ph_hi;
    XcdBarrier bar; bar.wv = F.wave; bar.bar = F.ctl + CW_BAR; bar.x = 0; bar.st = nullptr;
    if (hi - lo > 1) bar = xcd_barrier_post(F.ctl + CW_BAR, F.MISC + 8, F.wave);
#ifndef PH_MASK
#define PH_MASK 0x1fff
#endif
#define IN(k) (((PH_MASK >> (k)) & 1) && lo <= (k) && (k) < hi)
#define SEAM(k) do { if (IN(k) && IN((k) + 1)) xcd_barrier(bar); } while (0)
    typedef pg8::bf16_t b16;
#ifndef RPT_MASK
#define RPT_MASK 0
#endif
#define RPT(k) _Pragma("unroll") for (int rp_ = 0; rp_ < 1 + ((RPT_MASK >> (k)) & 1); ++rp_)
    if (IN(0)) { RPT(0) p0_prologue(F); } SEAM(0);
    if (IN(1)) RPT(1) {
        { pg8::Gemm8 g{(const unsigned char*)(ws + WS_U8), (const unsigned char*)(ws + WS_WIN8), MT, NF8, DM, 0x7f7f7f7f, 0x77777777}; pg8::StaticOrder S; S.init(MT, NF8, F.G, F.bx);
          pg8::EpiBf16Silu E{(b16*)(ws + WS_PROJ) + NB16, NPROJ, nullptr, 0};
          pg8::gemm_phase_f8<pg8::EpiBf16Silu, pg8::StaticOrder, true, true>(F.lds, g, S, E, F.wave); }
        { pg8::Gemm g{(const b16*)(ws + WS_R1), (const b16*)(ws + WS_WIN), MT, NB16, DM}; pg8::StaticOrder S; S.init(MT, NB16, F.G, F.bx);
          pg8::EpiBf16Silu E{(b16*)(ws + WS_PROJ), NPROJ, nullptr, 0};
          pg8::gemm_phase<pg8::EpiBf16Silu, pg8::StaticOrder, true, true>(F.lds, g, S, E, F.wave); }
        { pg8::Gemm g{(const b16*)(ws + WS_MEMN), (const b16*)(ws + WS_WMKV), MROWS, 1024, DM}; pg8::StaticOrder S; S.init(MROWS, 1024, F.G, (F.bx + 64) % F.G);
          pg8::EpiBf16Silu E{(b16*)(ws + WS_MEMKV), 1024, nullptr, 0};
          pg8::gemm_phase<pg8::EpiBf16Silu, pg8::StaticOrder, true, true>(F.lds, g, S, E, F.wave); }
    } SEAM(1);
    if (IN(2)) { RPT(2) { p2_compress(F); p2_prep(F); } }
    if (IN(2) && IN(5)) xcd_barrier(bar);
#ifndef RPT5_ML
#define RPT5_ML 0
#endif
#ifndef MLPROBE
#define MLPROBE 0xff
#endif
#ifndef NPROBE_ST
#define NPROBE_ST true
#endif
#ifndef NPROBE_CMP
#define NPROBE_CMP true
#endif
#ifndef NPROBE_SEL
#define NPROBE_SEL true
#endif
#ifndef NPROBE_WIN
#define NPROBE_WIN true
#endif
#ifndef MPROBE_ST
#define MPROBE_ST true
#endif
#ifndef MPROBE_DMA
#define MPROBE_DMA true
#endif
#ifndef MPROBE_COMP
#define MPROBE_COMP true
#endif
#ifndef RPT5_NSA
#define RPT5_NSA 0
#endif
#ifndef RPT5_MEM
#define RPT5_MEM 0
#endif
    if (IN(5)) { p5_queue<true, true, true>(F, 0);
        if (RPT5_ML || RPT5_NSA || RPT5_MEM) { xcd_barrier(bar); p5_queue<RPT5_ML != 0, RPT5_NSA != 0, RPT5_MEM != 0, MPROBE_ST, MPROBE_DMA, MPROBE_COMP, NPROBE_ST, NPROBE_CMP, NPROBE_SEL, NPROBE_WIN, MLPROBE>(F, 256); } } SEAM(5);
    if (IN(6)) RPT(6) {
        pg8::StaticOrder S; S.init(MT, DM, F.G, F.bx);
        pg8::Gemm g{(const b16*)(ws + WS_H0), (const b16*)(ws + WS_WBR), MT, DM, 1536};
        pg8::EpiMergeK E{(const b16*)(ws + WS_PROJ), (b16*)(ws + WS_R1)};
        pg8::gemm_phase<pg8::EpiMergeK, pg8::StaticOrder, true, true>(F.lds, g, S, E, F.wave);
    } SEAM(6);
    if (IN(7)) RPT(7) {
        pg8::Gemm g{(const b16*)(ws + WS_R1), (const b16*)(ws + WS_WOUT), MT, DM, DM}; pg8::StaticOrder S; S.init(MT, DM, F.G, F.bx);
        pg8::EpiRes E{F.in[I_X], F.out};
        pg8::gemm_phase<pg8::EpiRes, pg8::StaticOrder, true, true>(F.lds, g, S, E, F.wave);
    } SEAM(7);
    if (IN(8)) { p8_router(F, 0); if ((RPT_MASK >> 8) & 1) p8_router(F, 1); } SEAM(8);
    if (IN(9)) { RPT(9) p9_scatter(F); } SEAM(9);
    if (IN(10)) RPT(10) {
        LAS int* pstart = (LAS int*)(F.lds + RING_BYTES + 1024); LAS unsigned char* blk_e = (LAS unsigned char*)(F.lds + RING_BYTES + 1024 + 256);
        const int nblk = moe_tables(F, pstart, blk_e);
        pg8::Gemm8 g{(const unsigned char*)(ws + WS_APERM), (const unsigned char*)(ws + WS_WGU), CAP, NEXP * 2048, DM, 0x7f7f7f7f, 0x77777777};
        pg8::MoeOrder<8> S{nblk, F.G, F.bx, (const PG8_LAS unsigned char*)blk_e};
        pg8::EpiSwiglu E{(unsigned char*)(ws + WS_ACT), F.in[I_BGU]};
        pg8::gemm_phase_f8<pg8::EpiSwiglu, pg8::MoeOrder<8>, true, true>(F.lds, g, S, E, F.wave);
    } SEAM(10);
    if (IN(11)) RPT(11) {
        LAS int* pstart = (LAS int*)(F.lds + RING_BYTES + 1024); LAS unsigned char* blk_e = (LAS unsigned char*)(F.lds + RING_BYTES + 1024 + 256);
        const int nblk = moe_tables(F, pstart, blk_e);
        pg8::Gemm8 g{(const unsigned char*)(ws + WS_ACT), (const unsigned char*)(ws + WS_WDN), CAP, NEXP * DM, DFF, 0x7f7f7f7f, 0x77777777};
        pg8::MoeOrder<4> S{nblk, F.G, F.bx, (const PG8_LAS unsigned char*)blk_e};
        pg8::EpiDown E{(b16*)(ws + WS_APERM), F.in[I_BDN], (const float*)(ws + WS_ROUTE + RT_ROWW)};
        pg8::gemm_phase_f8<pg8::EpiDown, pg8::MoeOrder<4>, true, true>(F.lds, g, S, E, F.wave);
    } SEAM(11);
    if (IN(12)) { p12_combine(F); }
#undef IN
#undef SEAM
}

extern "C" void kernel_launch(void* const* d_in, const int* in_sizes, int n_in, void* d_out, int out_size, void* d_ws, size_t ws_size, hipStream_t stream) {
    static int grid = 0;
    if (grid == 0) {
        if (n_in != N_IN || out_size != MT * DM || ws_size < WS_END) { fprintf(stderr, "kernel_launch: unexpected shapes (n_in %d, out %d, ws %zu need %zu)\n", n_in, out_size, ws_size, (size_t)WS_END); grid = -1; return; }
        int dev = 0, cus = 0, per_cu = 0;
        if (hipGetDevice(&dev) != hipSuccess || hipDeviceGetAttribute(&cus, hipDeviceAttributeMultiprocessorCount, dev) != hipSuccess) { grid = -1; return; }
        if (hipFuncSetAttribute((const void*)fwd_kernel, hipFuncAttributeMaxDynamicSharedMemorySize, LDS_BYTES) != hipSuccess) { fprintf(stderr, "kernel_launch: hipFuncSetAttribute failed\n"); grid = -1; return; }
        if (hipOccupancyMaxActiveBlocksPerMultiprocessor(&per_cu, (const void*)fwd_kernel, NWAVES * 64, LDS_BYTES) != hipSuccess || per_cu < 1) { fprintf(stderr, "kernel_launch: occupancy query says %d\n", per_cu); }
        (void)hipGetLastError();
        grid = cus;
    }
    if (grid < 0) return;
    if (hipMemsetAsync((char*)d_ws + WS_CTL, 0, CTL_ZERO_BYTES, stream) != hipSuccess) return;
    Args a{};
    for (int i = 0; i < N_IN; ++i) a.in[i] = (const float*)d_in[i];
    a.out = (float*)d_out; a.ws = (unsigned char*)d_ws;
#if MK_PER_PHASE
    for (int p = 0; p < N_PHASES; ++p) { a.ph_lo = p; a.ph_hi = p + 1; a.li = 0; hipLaunchKernelGGL(fwd_kernel, dim3(grid), dim3(NWAVES * 64), LDS_BYTES, stream, a); }
#else
    a.ph_lo = 0; a.ph_hi = N_PHASES; a.li = 0;
    hipLaunchKernelGGL(fwd_kernel, dim3(grid), dim3(NWAVES * 64), LDS_BYTES, stream, a);
#endif
}
```

```cpp
#include <hip/hip_runtime.h>
#include <cstdio>
#include <cstdint>
namespace pg8 {
#define PG8_LAS __attribute__((address_space(3)))
typedef unsigned short bf16_t;
typedef short bf16x8 __attribute__((ext_vector_type(8)));
typedef float f32x4 __attribute__((ext_vector_type(4)));
typedef unsigned u32x4 __attribute__((ext_vector_type(4)));
constexpr int BM = 256, BK = 64, HALF = 128, HTB = HALF * BK * 2  , STAGE_BYTES = 8 * HTB, NXCD = 8, WGM = 8;

__host__ __device__ __forceinline__ int lds_byte(int r, int c) { const int st = (r >> 4) * 2 + (c >> 5), rr = r & 15, cc = c & 31, ob = rr * 64 + cc * 2; return st * 1024 + (ob ^ (((ob >> 9) & 1) << 5)); }
__host__ __device__ __forceinline__ void stage_rc(int b, int& R, int& C) { const int st = b / 1024, sb = b % 1024, swz = sb ^ (((sb >> 9) & 1) << 5); R = (st >> 1) * 16 + swz / 64; C = (st & 1) * 32 + (swz % 64) / 2; }
__host__ __device__ __forceinline__ int perm32(int rho) { const int n = rho >> 4, i = rho & 15; return 8 * (i >> 2) + 4 * n + (i & 3); }

struct Unit { int pm, pn; };
struct Gemm { const bf16_t* A; const bf16_t* Bt; int M, N, K; };

struct StaticOrder {
    int nM, nN, nwg, G, c;
    __host__ __device__ void init(int M, int N, int G_, int c_) { nM = M / BM; nN = N / BM; nwg = nM * nN; G = G_; c = c_; }
    __host__ __device__ bool next(int i, Unit& u) const {
        const long L = (long)i * G + c; if (L >= nwg) return false;
        int wgid = (int)L; { const int q = nwg / NXCD, r = nwg % NXCD, xcd = wgid % NXCD, off = wgid / NXCD; wgid = (xcd < r ? xcd * (q + 1) : r * (q + 1) + (xcd - r) * q) + off; }
        const int nig = WGM * nN, gid = wgid / nig, fm = gid * WGM, gsz = (nM - fm) < WGM ? (nM - fm) : WGM;
        u.pm = fm + ((wgid % nig) % gsz); u.pn = (wgid % nig) / gsz; return true;
    }
    __device__ __forceinline__ void a_ready(const Unit&) const {}
    __device__ __forceinline__ void done(const Unit&) const {}
};

__device__ __forceinline__ unsigned cvt_pk_bf16(float lo, float hi) { unsigned r; asm volatile("v_cvt_pk_bf16_f32 %0, %1, %2" : "=v"(r) : "v"(lo), "v"(hi)); return r; }
typedef float f32x2 __attribute__((ext_vector_type(2)));
__device__ __forceinline__ f32x2 gelu_pk(f32x2 v) {
    const f32x2 av = __builtin_elementwise_abs(v), d = av * 0.2316418882f + 1.0f;
    f32x2 t; t.x = __builtin_amdgcn_rcpf(d.x); t.y = __builtin_amdgcn_rcpf(d.y);
    f32x2 q = t * 0.5307027145f + (-0.7265760135f); q = q * t + 0.7107068705f; q = q * t + (-0.142248368f); q = q * t + 0.127414796f; q = q * t;
    const f32x2 s = (v * v) * (-0.72134752044f);
    f32x2 e; e.x = __builtin_amdgcn_exp2f(s.x); e.y = __builtin_amdgcn_exp2f(s.y);
    const f32x2 m = v * (q * e), r = v - m;
    f32x2 o; o.x = v.x < 0.f ? m.x : r.x; o.y = v.y < 0.f ? m.y : r.y; return o;
}

template <int ACT  > struct EpiBf16 {
    static constexpr bool PERM = true, AFTER_DRAIN = false; static_assert(ACT == 0 || ACT == 1, "EpiBf16: ACT is 0 (none) or 1 (gelu_pk)");
    bf16_t* O; int ldc; const float* bias; int split_cols; size_t split_stride; float scale0;
    __device__ __forceinline__ void operator()(const f32x4 (&acc)[2][2][4][2], const Unit& u, int wr, int wc, int fr, int fq) const {
        const int row0 = u.pm * BM + wr * 64 + fr; int colt = u.pn * BM; bf16_t* base = O;
        float sc = 1.f; if (split_cols) { const int t = colt / split_cols; base += (size_t)t * split_stride; colt -= t * split_cols; if (t == 0) sc = scale0; }
        const int col0 = colt + wc * 32 + 8 * fq, bcol0 = u.pn * BM + wc * 32 + 8 * fq;
        f32x4 bv[2][2];
#pragma unroll
        for (int bj = 0; bj < 2; ++bj)
#pragma unroll
            for (int n = 0; n < 2; ++n) bv[bj][n] = bias ? *(const f32x4*)(bias + bcol0 + bj * HALF + 4 * n) : (f32x4){0.f, 0.f, 0.f, 0.f};
#pragma unroll
        for (int ai = 0; ai < 2; ++ai)
#pragma unroll
            for (int m = 0; m < 4; ++m) { bf16_t* rowp = base + (size_t)(row0 + ai * HALF + m * 16) * ldc + col0;
#pragma unroll
                for (int bj = 0; bj < 2; ++bj) { f32x4 v0 = acc[ai][bj][m][0] + bv[bj][0], v1 = acc[ai][bj][m][1] + bv[bj][1];
                    if (ACT == 1) { f32x2 a = gelu_pk((f32x2){v0[0], v0[1]}), b = gelu_pk((f32x2){v0[2], v0[3]}), c = gelu_pk((f32x2){v1[0], v1[1]}), d = gelu_pk((f32x2){v1[2], v1[3]});
                        v0 = (f32x4){a.x, a.y, b.x, b.y}; v1 = (f32x4){c.x, c.y, d.x, d.y}; }
                    v0 = v0 * sc; v1 = v1 * sc; u32x4 w; w.x = cvt_pk_bf16(v0[0], v0[1]); w.y = cvt_pk_bf16(v0[2], v0[3]); w.z = cvt_pk_bf16(v1[0], v1[1]); w.w = cvt_pk_bf16(v1[2], v1[3]);
                    *(u32x4*)(rowp + bj * HALF) = w; } }
    }
};

struct PanelStats {
    unsigned* xbuf;
    unsigned* cnt;
    unsigned* tmo;
    int ntn; float eps;
    unsigned code;
    __device__ __forceinline__ bool run(const f32x4 (&v)[2][2][4][2], const Unit& u, int wr, int wc, int fr, int fq, PG8_LAS unsigned char* lds, int wid, int lane) const {
        typedef float f32x2v __attribute__((ext_vector_type(2)));
        PG8_LAS f32x2v* P = (PG8_LAS f32x2v*)lds;
        PG8_LAS f32x2v* S = (PG8_LAS f32x2v*)(lds + 8192);
        PG8_LAS unsigned* flag = (PG8_LAS unsigned*)(lds + 8192 + 2048);
#pragma unroll
        for (int ai = 0; ai < 2; ++ai)
#pragma unroll
            for (int m = 0; m < 4; ++m) {
                float s = 0.f;
#pragma unroll
                for (int bj = 0; bj < 2; ++bj)
#pragma unroll
                    for (int n = 0; n < 2; ++n) { const f32x4 x = v[ai][bj][m][n]; s += (x[0] + x[1]) + (x[2] + x[3]); }
                s += __shfl_xor(s, 16); s += __shfl_xor(s, 32);
                const float mw = s * (1.0f / 64.0f); float q = 0.f;
#pragma unroll
                for (int bj = 0; bj < 2; ++bj)
#pragma unroll
                    for (int n = 0; n < 2; ++n) { const f32x4 d = v[ai][bj][m][n] - mw; q += (d[0] * d[0] + d[1] * d[1]) + (d[2] * d[2] + d[3] * d[3]); }
                q += __shfl_xor(q, 16); q += __shfl_xor(q, 32);
                if (fq == 0) P[(ai * HALF + wr * 64 + m * 16 + fr) * 4 + wc] = (f32x2v){mw, q};
            }
        asm volatile("s_waitcnt lgkmcnt(0)" ::: "memory"); __builtin_amdgcn_s_barrier(); asm volatile("" ::: "memory");
#if defined(BROKEN_EXCHANGE_NO_WAIT)
#warning BROKEN CONTROL BUILD: the row-statistics exchange does not wait; results are wrong by design
        if (blockIdx.x >= 64) { const long long t0_ = clock64(); while (clock64() - t0_ < 60000) __builtin_amdgcn_s_sleep(8); }
#endif
        const int row = wid * 32 + (lane & 31);
        if (lane < 32) {
            const f32x2v a = P[row * 4 + 0], b = P[row * 4 + 1], c = P[row * 4 + 2], d = P[row * 4 + 3];
            const float mt = (a.x + b.x + c.x + d.x) * 0.25f;
            const float da = a.x - mt, db = b.x - mt, dc = c.x - mt, dd = d.x - mt;
            const float m2 = (a.y + b.y) + (c.y + d.y) + 64.0f * ((da * da + db * db) + (dc * dc + dd * dd));
            unsigned long long* slot = (unsigned long long*)xbuf + ((size_t)(u.pm * BM + row) * 4 + u.pn);
            __hip_atomic_store(slot, ((unsigned long long)__float_as_uint(m2) << 32) | __float_as_uint(mt), __ATOMIC_RELAXED, __HIP_MEMORY_SCOPE_AGENT);
        }
        asm volatile("s_waitcnt vmcnt(0)" ::: "memory");
        if (lane == 0) __hip_atomic_fetch_add(cnt + 64 * u.pm, 1u, __ATOMIC_RELAXED, __HIP_MEMORY_SCOPE_AGENT);
        if (wid == 0) {
            bool dead = false; const unsigned long long t0 = __builtin_amdgcn_s_memrealtime(); const unsigned want = 8u * (unsigned)ntn;
            for (;;) {
#if defined(BROKEN_EXCHANGE_NO_WAIT)
                break;
#endif
                if ((unsigned)__builtin_amdgcn_readfirstlane(__hip_atomic_load(cnt + 64 * u.pm, __ATOMIC_RELAXED, __HIP_MEMORY_SCOPE_AGENT)) >= want) break;
                if (__builtin_amdgcn_s_memrealtime() - t0 > 2000000ull) {
                    if (lane == 0) { unsigned expect = 0u; __hip_atomic_compare_exchange_strong(tmo + 1, &expect, code | (unsigned)(u.pm & 0xff), __ATOMIC_RELAXED, __ATOMIC_RELAXED, __HIP_MEMORY_SCOPE_AGENT);
                                     __hip_atomic_store(tmo, 1u, __ATOMIC_RELAXED, __HIP_MEMORY_SCOPE_AGENT); }
                    dead = true; break; }
                __builtin_amdgcn_s_sleep(2);
            }
            __builtin_amdgcn_fence(__ATOMIC_ACQUIRE, "agent");
            if (lane == 0) flag[0] = dead ? 1u : 0u;
        }
        asm volatile("s_waitcnt vmcnt(0) lgkmcnt(0)" ::: "memory"); __builtin_amdgcn_s_barrier(); asm volatile("" ::: "memory");
        const bool bad = flag[0] != 0u;
        if (lane < 32) {
            const unsigned long long* slot = (const unsigned long long*)xbuf + (size_t)(u.pm * BM + row) * 4; float mt[4], m2[4]; float ms = 0.f;
#pragma unroll
            for (int t = 0; t < 4; ++t) { if (t < ntn) { const unsigned long long w = __hip_atomic_load(slot + t, __ATOMIC_RELAXED, __HIP_MEMORY_SCOPE_AGENT); mt[t] = __uint_as_float((unsigned)w); m2[t] = __uint_as_float((unsigned)(w >> 32)); } else { mt[t] = 0.f; m2[t] = 0.f; } ms += mt[t]; }
            const float mean = ms / (float)ntn; float q = 0.f;
#pragma unroll
            for (int t = 0; t < 4; ++t) if (t < ntn) { const float dm = mt[t] - mean; q += m2[t] + 256.0f * dm * dm; }
            S[row] = (f32x2v){mean, 1.0f / sqrtf(q / (256.0f * (float)ntn) + eps)};
        }
        asm volatile("s_waitcnt lgkmcnt(0)" ::: "memory"); __builtin_amdgcn_s_barrier(); asm volatile("" ::: "memory");
        return bad;
    }
};
struct EpiLnRes {
    static constexpr bool PERM = false, AFTER_DRAIN = true;
    const float* base; float* out; int ldc; const float* bias; PanelStats st; unsigned poison;
    __device__ __forceinline__ void fused(f32x4 (&acc)[2][2][4][2], const Unit& u, int wr, int wc, int fr, int fq, PG8_LAS unsigned char* lds, int wid, int lane) const {
        typedef float f32x2v __attribute__((ext_vector_type(2)));
        const PG8_LAS f32x2v* S = (const PG8_LAS f32x2v*)(lds + 8192);
        const int col0 = u.pn * BM + wc * 32 + 4 * fq;
#pragma unroll
        for (int bj = 0; bj < 2; ++bj)
#pragma unroll
            for (int n = 0; n < 2; ++n) { const f32x4 bv = bias ? *(const f32x4*)(bias + col0 + bj * HALF + n * 16) : (f32x4){0.f, 0.f, 0.f, 0.f};
#pragma unroll
                for (int ai = 0; ai < 2; ++ai)
#pragma unroll
                    for (int m = 0; m < 4; ++m) acc[ai][bj][m][n] += bv; }
        f32x4 pre[4][2][2];
#pragma unroll
        for (int m = 0; m < 4; ++m) { const size_t off = (size_t)(u.pm * BM + wr * 64 + m * 16 + fr) * ldc + col0;
#pragma unroll
            for (int bj = 0; bj < 2; ++bj)
#pragma unroll
                for (int n = 0; n < 2; ++n) pre[m][bj][n] = *(const f32x4*)(base + off + bj * HALF + n * 16); }
        const bool bad = st.run(acc, u, wr, wc, fr, fq, lds, wid, lane) || poison != 0u;
        const float qnan = __builtin_nanf("");
#pragma unroll
        for (int ai = 0; ai < 2; ++ai)
#pragma unroll
            for (int m = 0; m < 4; ++m) { const int r = ai * HALF + wr * 64 + m * 16 + fr; const f32x2v sr = S[r]; const size_t off = (size_t)(u.pm * BM + r) * ldc + col0;
#pragma unroll
                for (int bj = 0; bj < 2; ++bj)
#pragma unroll
                    for (int n = 0; n < 2; ++n) { const f32x4 bs = ai == 0 ? pre[m][bj][n] : *(const f32x4*)(base + off + bj * HALF + n * 16); f32x4 o = bs + (acc[ai][bj][m][n] - sr.x) * sr.y;
                        if (bad) o = (f32x4){qnan, qnan, qnan, qnan}; *(f32x4*)(out + off + bj * HALF + n * 16) = o; }
                if (m & 1) asm volatile("" ::: "memory"); }
    }
};
struct EpiLnResLn {
    static constexpr bool PERM = false, AFTER_DRAIN = true;
    const float* base; float* out; bf16_t* xn; int ldc; const float* bias; PanelStats st1, st2; unsigned poison;
    __device__ __forceinline__ void fused(f32x4 (&acc)[2][2][4][2], const Unit& u, int wr, int wc, int fr, int fq, PG8_LAS unsigned char* lds, int wid, int lane) const {
        typedef float f32x2v __attribute__((ext_vector_type(2))); typedef unsigned u32x2v __attribute__((ext_vector_type(2)));
        const PG8_LAS f32x2v* S = (const PG8_LAS f32x2v*)(lds + 8192);
        const int col0 = u.pn * BM + wc * 32 + 4 * fq;
#pragma unroll
        for (int bj = 0; bj < 2; ++bj)
#pragma unroll
            for (int n = 0; n < 2; ++n) { const f32x4 bv = bias ? *(const f32x4*)(bias + col0 + bj * HALF + n * 16) : (f32x4){0.f, 0.f, 0.f, 0.f};
#pragma unroll
                for (int ai = 0; ai < 2; ++ai)
#pragma unroll
                    for (int m = 0; m < 4; ++m) acc[ai][bj][m][n] += bv; }
        bool bad = st1.run(acc, u, wr, wc, fr, fq, lds, wid, lane) || poison != 0u;
        const float qnan = __builtin_nanf("");
#pragma unroll
        for (int ai = 0; ai < 2; ++ai)
#pragma unroll
            for (int m = 0; m < 4; ++m) { const int r = ai * HALF + wr * 64 + m * 16 + fr; const f32x2v sr = S[r]; const size_t off = (size_t)(u.pm * BM + r) * ldc + col0;
#pragma unroll
                for (int bj = 0; bj < 2; ++bj)
#pragma unroll
                    for (int n = 0; n < 2; ++n) { const f32x4 bs = *(const f32x4*)(base + off + bj * HALF + n * 16); acc[ai][bj][m][n] = bs + (acc[ai][bj][m][n] - sr.x) * sr.y; }
                asm volatile("" : "+v"(acc[ai][0][m][0]), "+v"(acc[ai][0][m][1]), "+v"(acc[ai][1][m][0]), "+v"(acc[ai][1][m][1]));
                if (m & 1) asm volatile("" ::: "memory"); }
        const bool bad1 = bad;
        bad = st2.run(acc, u, wr, wc, fr, fq, lds, wid, lane) || bad;
#pragma unroll
        for (int ai = 0; ai < 2; ++ai)
#pragma unroll
            for (int m = 0; m < 4; ++m) { const int r = ai * HALF + wr * 64 + m * 16 + fr; const f32x2v sr = S[r]; const size_t off = (size_t)(u.pm * BM + r) * ldc + col0;
#pragma unroll
                for (int bj = 0; bj < 2; ++bj)
#pragma unroll
                    for (int n = 0; n < 2; ++n) { const f32x4 x1 = acc[ai][bj][m][n]; *(f32x4*)(out + off + bj * HALF + n * 16) = bad1 ? (f32x4){qnan, qnan, qnan, qnan} : x1;
                        const f32x4 o = (x1 - sr.x) * sr.y; u32x2v w; w.x = cvt_pk_bf16(o[0], o[1]); w.y = cvt_pk_bf16(o[2], o[3]);
                        if (bad) { w.x = 0x7fc07fc0u; w.y = 0x7fc07fc0u; } *(u32x2v*)(xn + off + bj * HALF + n * 16) = w; }
                asm volatile("" ::: "memory"); }
    }
};

template <class E, class = void> struct MidSeg { static constexpr int v = 0; };
template <class E> struct MidSeg<E, decltype((void)E::MIDSEG)> { static constexpr int v = E::MIDSEG; };
template <class Epi, class Sched, bool ALIGN_EPI = false, bool SP2 = false>
__device__ __forceinline__ void gemm_phase(PG8_LAS unsigned char* lds, const Gemm g, const Sched& S, const Epi& E, int wid_in) {
    int lane_; asm volatile("v_mbcnt_lo_u32_b32 %0, -1, 0\n\tv_mbcnt_hi_u32_b32 %0, -1, %0" : "=v"(lane_));
    const int wid = wid_in, lane = lane_, tid = wid * 64 + lane, wr = wid >> 2, wc = wid & 3, fr = lane & 15, fq = lane >> 4;
    const int K = g.K, nt = K / BK;
    unsigned voffA[2], voffB[2];
#pragma unroll
    for (int i = 0; i < 2; ++i) { int R, C; stage_rc(tid * 16 + i * 8192, R, C); const int Rb = Epi::PERM ? ((R & ~31) + perm32(R & 31)) : R;
        voffA[i] = (unsigned)(R * K + C) * 2u; voffB[i] = (unsigned)(Rb * K + C) * 2u; }
    const size_t kstep = (size_t)(BK * 2);
    const size_t hstep = (size_t)HALF * K * 2;
    const size_t tstep = 2 * hstep;
    const unsigned ldsw = (unsigned)wid * 1024u;
    const int aoff = lds_byte(wr * 64 + fr, fq * 8), boff = lds_byte(wc * 32 + fr, fq * 8);
#define PG8_SA(b, h) (((b) * 2 + (h)) * HTB)
#define PG8_SB(b, h) ((4 + (b) * 2 + (h)) * HTB)
#define PG8_STAGE(bufoff, gbase, voff) do { _Pragma("unroll") for (int _i = 0; _i < 2; ++_i) \
        __builtin_amdgcn_global_load_lds((const unsigned*)((const char*)(gbase) + (voff)[_i]), (PG8_LAS unsigned*)(lds + (bufoff) + ldsw + _i * 8192), 16, 0, 0); } while (0)
#define PG8_LDA(dst, b, h) do { _Pragma("unroll") for (int m = 0; m < 4; ++m) _Pragma("unroll") for (int k = 0; k < 2; ++k) dst[m][k] = *(const PG8_LAS bf16x8*)(lds + PG8_SA(b, h) + aoff + m * 2048 + k * 1024); } while (0)
#define PG8_LDB(dst, b, h) do { _Pragma("unroll") for (int n = 0; n < 2; ++n) _Pragma("unroll") for (int k = 0; k < 2; ++k) dst[n][k] = *(const PG8_LAS bf16x8*)(lds + PG8_SB(b, h) + boff + n * 2048 + k * 1024); } while (0)
#define PG8_MMA(ai, bj, At, Bt) do { __builtin_amdgcn_s_setprio(1); _Pragma("unroll") for (int m = 0; m < 4; ++m) _Pragma("unroll") for (int n = 0; n < 2; ++n) _Pragma("unroll") for (int k = 0; k < 2; ++k) \
        acc[ai][bj][m][n] = __builtin_amdgcn_mfma_f32_16x16x32_bf16(Bt[n][k], At[m][k], acc[ai][bj][m][n], 0, 0, 0); __builtin_amdgcn_s_setprio(0); } while (0)
#define PG8_WAIT_V(n) asm volatile("s_waitcnt vmcnt(" #n ")" ::: "memory")
#define PG8_WAIT_L(n) asm volatile("s_waitcnt lgkmcnt(" #n ")" ::: "memory")
#define PG8_BAR __builtin_amdgcn_s_barrier()
#define PG8_SCHED __builtin_amdgcn_sched_barrier(0)
    Unit cur, nxt; int ui = 0;
    if (!S.next(0, cur)) return;
    f32x4 acc[2][2][4][2];
#pragma unroll
    for (int a = 0; a < 2; ++a)
#pragma unroll
        for (int b = 0; b < 2; ++b)
#pragma unroll
            for (int m = 0; m < 4; ++m)
#pragma unroll
                for (int n = 0; n < 2; ++n) acc[a][b][m][n] = (f32x4){0.f, 0.f, 0.f, 0.f};
    bf16x8 At[4][2], B0[2][2], B1[2][2];
    const char* cA = (const char*)g.A + (size_t)cur.pm * tstep; const char* cB = (const char*)g.Bt + (size_t)cur.pn * tstep;
    S.a_ready(cur);
    if constexpr (SP2) {
        PG8_STAGE(PG8_SB(0, 0), cB, voffB); PG8_STAGE(PG8_SB(0, 1), cB + hstep, voffB); PG8_STAGE(PG8_SA(0, 0), cA, voffA); PG8_STAGE(PG8_SA(0, 1), cA + hstep, voffA);
        if (wr == 1) PG8_BAR;
        PG8_WAIT_V(2); PG8_BAR;
        PG8_STAGE(PG8_SB(1, 0), cB + kstep, voffB); PG8_STAGE(PG8_SA(1, 0), cA + kstep, voffA); PG8_STAGE(PG8_SB(1, 1), cB + hstep + kstep, voffB);
        PG8_WAIT_V(6); PG8_BAR;
    } else {
        PG8_STAGE(PG8_SB(0, 0), cB, voffB); PG8_STAGE(PG8_SA(0, 0), cA, voffA); PG8_STAGE(PG8_SB(0, 1), cB + hstep, voffB); PG8_STAGE(PG8_SA(0, 1), cA + hstep, voffA);
        if (wr == 1) PG8_BAR;
        PG8_WAIT_V(4); PG8_BAR;
        PG8_STAGE(PG8_SB(1, 0), cB + kstep, voffB); PG8_STAGE(PG8_SA(1, 0), cA + kstep, voffA); PG8_STAGE(PG8_SB(1, 1), cB + hstep + kstep, voffB);
        PG8_WAIT_V(6); PG8_BAR;
    }
    for (;;) {
        const bool has_next = S.next(ui + 1, nxt);
        const char* nA = has_next ? (const char*)g.A + (size_t)nxt.pm * tstep : cA; const char* nB = has_next ? (const char*)g.Bt + (size_t)nxt.pn * tstep : cB;
        for (int t = 0; t < nt; t += 2) {
            if constexpr (MidSeg<Epi>::v > 0) { if (t > 0 && t % MidSeg<Epi>::v == 0) E.mid(acc, cur, t / MidSeg<Epi>::v, wr, wc, fr, fq); }
            const bool last = (t == nt - 2);
            const char* a1 = cA + (size_t)(t + 1) * kstep;
            const char* a2 = last ? nA : cA + (size_t)(t + 2) * kstep; const char* b2 = last ? nB : cB + (size_t)(t + 2) * kstep;
            const char* a3 = a2 + kstep; const char* b3 = b2 + kstep;
            if (last && has_next) S.a_ready(nxt);
            if constexpr (SP2) {
            PG8_LDB(B0, 0, 0); PG8_LDB(B1, 0, 1); PG8_SCHED; PG8_LDA(At, 0, 0); PG8_STAGE(PG8_SA(1, 1), a1 + hstep, voffA);
            PG8_WAIT_V(8); PG8_WAIT_L(0); PG8_BAR; PG8_MMA(0, 0, At, B0); PG8_MMA(0, 1, At, B1); PG8_BAR; PG8_SCHED;
            PG8_LDA(At, 0, 1); PG8_STAGE(PG8_SB(0, 0), b2, voffB); PG8_STAGE(PG8_SB(0, 1), b2 + hstep, voffB); PG8_STAGE(PG8_SA(0, 0), a2, voffA);
            PG8_WAIT_V(8); PG8_WAIT_L(0); PG8_BAR; PG8_MMA(1, 0, At, B0); PG8_MMA(1, 1, At, B1); PG8_BAR; PG8_SCHED;
            PG8_LDB(B0, 1, 0); PG8_LDB(B1, 1, 1); PG8_SCHED; PG8_LDA(At, 1, 0); PG8_STAGE(PG8_SA(0, 1), a2 + hstep, voffA);
            PG8_WAIT_V(8); PG8_WAIT_L(0); PG8_BAR; PG8_MMA(0, 0, At, B0); PG8_MMA(0, 1, At, B1); PG8_BAR; PG8_SCHED;
            PG8_LDA(At, 1, 1); PG8_STAGE(PG8_SB(1, 0), b3, voffB); PG8_STAGE(PG8_SB(1, 1), b3 + hstep, voffB); PG8_STAGE(PG8_SA(1, 0), a3, voffA);
            PG8_WAIT_V(8); PG8_WAIT_L(0); PG8_BAR; PG8_MMA(1, 0, At, B0); PG8_MMA(1, 1, At, B1); PG8_BAR; PG8_SCHED;
            } else {
            PG8_LDB(B0, 0, 0); PG8_SCHED; PG8_LDA(At, 0, 0); PG8_STAGE(PG8_SA(1, 1), a1 + hstep, voffA);
            PG8_WAIT_L(8); PG8_BAR; PG8_WAIT_L(0); PG8_MMA(0, 0, At, B0); PG8_BAR; PG8_SCHED;
            PG8_LDB(B1, 0, 1); PG8_STAGE(PG8_SB(0, 0), b2, voffB);
            PG8_BAR; PG8_WAIT_L(0); PG8_MMA(0, 1, At, B1); PG8_BAR;
            PG8_LDA(At, 0, 1); PG8_STAGE(PG8_SA(0, 0), a2, voffA);
            PG8_BAR; PG8_WAIT_L(0); PG8_MMA(1, 0, At, B0); PG8_BAR; PG8_SCHED;
            PG8_STAGE(PG8_SB(0, 1), b2 + hstep, voffB);
            PG8_WAIT_V(6); PG8_BAR; PG8_MMA(1, 1, At, B1); PG8_BAR;
            PG8_LDB(B0, 1, 0); PG8_SCHED; PG8_LDA(At, 1, 0); PG8_STAGE(PG8_SA(0, 1), a2 + hstep, voffA);
            PG8_WAIT_L(8); PG8_BAR; PG8_WAIT_L(0); PG8_MMA(0, 0, At, B0); PG8_BAR; PG8_SCHED;
            PG8_LDB(B1, 1, 1); PG8_STAGE(PG8_SB(1, 0), b3, voffB);
            PG8_BAR; PG8_WAIT_L(0); PG8_MMA(0, 1, At, B1); PG8_BAR;
            PG8_LDA(At, 1, 1); PG8_STAGE(PG8_SA(1, 0), a3, voffA);
            PG8_BAR; PG8_WAIT_L(0); PG8_MMA(1, 0, At, B0); PG8_BAR; PG8_SCHED;
            PG8_STAGE(PG8_SB(1, 1), b3 + hstep, voffB);
            PG8_WAIT_V(6); PG8_BAR; PG8_MMA(1, 1, At, B1); PG8_BAR;
            }
        }
        if constexpr (ALIGN_EPI) { if (wr == 0) PG8_BAR; }
        if constexpr (!Epi::AFTER_DRAIN) { E(acc, cur, wr, wc, fr, fq); S.done(cur); }
        if (!has_next) break;
#pragma unroll
        for (int a = 0; a < 2; ++a)
#pragma unroll
            for (int b = 0; b < 2; ++b)
#pragma unroll
                for (int m = 0; m < 4; ++m)
#pragma unroll
                    for (int n = 0; n < 2; ++n) acc[a][b][m][n] = (f32x4){0.f, 0.f, 0.f, 0.f};
        cur = nxt; cA = nA; cB = nB; ++ui;
        if constexpr (ALIGN_EPI) { if (wr == 1) PG8_BAR; }
    }
    PG8_WAIT_V(0);
    if constexpr (!ALIGN_EPI) { if (wr == 0) PG8_BAR; }
    PG8_BAR;
    if constexpr (Epi::AFTER_DRAIN) { E.fused(acc, cur, wr, wc, fr, fq, lds, wid, lane); S.done(cur); }
#undef PG8_SA
#undef PG8_SB
#undef PG8_STAGE
#undef PG8_LDA
#undef PG8_LDB
#undef PG8_MMA
#undef PG8_WAIT_V
#undef PG8_WAIT_L
#undef PG8_BAR
#undef PG8_SCHED
}
}
namespace pg8 {
template <class E, class = void> struct Perm2 { static constexpr bool v = false; };
template <class E> struct Perm2<E, decltype((void)E::PERM2)> { static constexpr bool v = E::PERM2; };
struct Gemm8 { const unsigned char* A; const unsigned char* Bt; int M, N, K; int scale_a, scale_b; };
template <class Epi, class Sched, bool ALIGN_EPI = false, bool SP2 = false>
__device__ __forceinline__ void gemm_phase_f8(PG8_LAS unsigned char* lds, const Gemm8 g, const Sched& S, const Epi& E, int wid_in) {
    int lane_; asm volatile("v_mbcnt_lo_u32_b32 %0, -1, 0\n\tv_mbcnt_hi_u32_b32 %0, -1, %0" : "=v"(lane_));
    const int wid = wid_in, lane = lane_, tid = wid * 64 + lane, wr = wid >> 2, wc = wid & 3, fr = lane & 15, fq = lane >> 4;
    const int K = g.K, nt = K / 128;
    unsigned voffA[2], voffB[2];
#pragma unroll
    for (int i = 0; i < 2; ++i) { int R, C; stage_rc(tid * 16 + i * 8192, R, C); const int Rb = Perm2<Epi>::v ? (64 * (R >> 5) + 16 * ((R >> 2) & 3) + 4 * ((R >> 4) & 1) + (R & 3)) : Epi::PERM ? ((R & ~31) + perm32(R & 31)) : R;
        voffA[i] = (unsigned)(R * K + 2 * C); voffB[i] = (unsigned)(Rb * K + 2 * C); }
    const size_t kstep = (size_t)(BK * 2);
    const size_t hstep = (size_t)HALF * K;
    const size_t hstepB = Perm2<Epi>::v ? (size_t)8 * K : hstep;
    const size_t tstep = 2 * hstep;
    const unsigned ldsw = (unsigned)wid * 1024u;
    const int aoff = lds_byte(wr * 64 + fr, fq * 16), boff = lds_byte(wc * 32 + fr, fq * 16);
#define PG8_SA(b, h) (((b) * 2 + (h)) * HTB)
#define PG8_SB(b, h) ((4 + (b) * 2 + (h)) * HTB)
#define PG8_STAGE(bufoff, gbase, voff) do { _Pragma("unroll") for (int _i = 0; _i < 2; ++_i) { unsigned keep_; \
        asm volatile("s_mov_b32 %0, m0\n\ts_mov_b32 m0, %3\n\ts_nop 0\n\tglobal_load_lds_dwordx4 %1, %2\n\ts_mov_b32 m0, %0" : "=&s"(keep_) : "v"((voff)[_i]), "s"((const char*)(gbase)), "s"((unsigned)(size_t)(lds + (bufoff) + ldsw + _i * 8192)) : "memory"); } } while (0)
#define PG8_LDA(dst, b, h) do { _Pragma("unroll") for (int m = 0; m < 4; ++m) { const u32x4 lo_ = *(const PG8_LAS u32x4*)(lds + PG8_SA(b, h) + aoff + m * 2048), hi_ = *(const PG8_LAS u32x4*)(lds + PG8_SA(b, h) + aoff + m * 2048 + 16); dst[m] = __builtin_bit_cast(i32x8, __builtin_shufflevector(lo_, hi_, 0, 1, 2, 3, 4, 5, 6, 7)); } } while (0)
#define PG8_LDB(dst, b, h) do { _Pragma("unroll") for (int n = 0; n < 2; ++n) { const u32x4 lo_ = *(const PG8_LAS u32x4*)(lds + PG8_SB(b, h) + boff + n * 2048), hi_ = *(const PG8_LAS u32x4*)(lds + PG8_SB(b, h) + boff + n * 2048 + 16); dst[n] = __builtin_bit_cast(i32x8, __builtin_shufflevector(lo_, hi_, 0, 1, 2, 3, 4, 5, 6, 7)); } } while (0)
#define PG8_MMA(ai, bj, At, Bt) do { __builtin_amdgcn_s_setprio(1); _Pragma("unroll") for (int m = 0; m < 4; ++m) _Pragma("unroll") for (int n = 0; n < 2; ++n) \
        acc[ai][bj][m][n] = __builtin_amdgcn_mfma_scale_f32_16x16x128_f8f6f4(Bt[n], At[m], acc[ai][bj][m][n], 0, 0, 0, g.scale_b, 0, g.scale_a); __builtin_amdgcn_s_setprio(0); } while (0)
#define PG8_WAIT_V(n) asm volatile("s_waitcnt vmcnt(" #n ")" ::: "memory")
#define PG8_WAIT_L(n) asm volatile("s_waitcnt lgkmcnt(" #n ")" ::: "memory")
#define PG8_BAR __builtin_amdgcn_s_barrier()
#define PG8_SCHED __builtin_amdgcn_sched_barrier(0)
    Unit cur, nxt; int ui = 0;
    if (!S.next(0, cur)) return;
    f32x4 acc[2][2][4][2];
#pragma unroll
    for (int a = 0; a < 2; ++a)
#pragma unroll
        for (int b = 0; b < 2; ++b)
#pragma unroll
            for (int m = 0; m < 4; ++m)
#pragma unroll
                for (int n = 0; n < 2; ++n) acc[a][b][m][n] = (f32x4){0.f, 0.f, 0.f, 0.f};
    typedef int i32x8 __attribute__((ext_vector_type(8))); i32x8 At[4], B0[2], B1[2];
    const char* cA = (const char*)g.A + (size_t)cur.pm * tstep; const char* cB = (const char*)g.Bt + (size_t)cur.pn * tstep;
    S.a_ready(cur);
    if constexpr (SP2) {
        PG8_STAGE(PG8_SB(0, 0), cB, voffB); PG8_STAGE(PG8_SB(0, 1), cB + hstepB, voffB); PG8_STAGE(PG8_SA(0, 0), cA, voffA); PG8_STAGE(PG8_SA(0, 1), cA + hstep, voffA);
        if (wr == 1) PG8_BAR;
        PG8_WAIT_V(2); PG8_BAR;
        PG8_STAGE(PG8_SB(1, 0), cB + kstep, voffB); PG8_STAGE(PG8_SA(1, 0), cA + kstep, voffA); PG8_STAGE(PG8_SB(1, 1), cB + hstepB + kstep, voffB);
        PG8_WAIT_V(6); PG8_BAR;
    } else {
        PG8_STAGE(PG8_SB(0, 0), cB, voffB); PG8_STAGE(PG8_SA(0, 0), cA, voffA); PG8_STAGE(PG8_SB(0, 1), cB + hstepB, voffB); PG8_STAGE(PG8_SA(0, 1), cA + hstep, voffA);
        if (wr == 1) PG8_BAR;
        PG8_WAIT_V(4); PG8_BAR;
        PG8_STAGE(PG8_SB(1, 0), cB + kstep, voffB); PG8_STAGE(PG8_SA(1, 0), cA + kstep, voffA); PG8_STAGE(PG8_SB(1, 1), cB + hstepB + kstep, voffB);
        PG8_WAIT_V(6); PG8_BAR;
    }
    for (;;) {
        const bool has_next = S.next(ui + 1, nxt);
        const char* nA = has_next ? (const char*)g.A + (size_t)nxt.pm * tstep : cA; const char* nB = has_next ? (const char*)g.Bt + (size_t)nxt.pn * tstep : cB;
#pragma unroll 1
        for (int t = 0; t < nt; t += 2) {
            const bool last = (t == nt - 2);
            const char* a1 = cA + (size_t)(t + 1) * kstep;
            const char* a2 = last ? nA : cA + (size_t)(t + 2) * kstep; const char* b2 = last ? nB : cB + (size_t)(t + 2) * kstep;
            const char* a3 = a2 + kstep; const char* b3 = b2 + kstep;
            if (last && has_next) S.a_ready(nxt);
            if constexpr (SP2) {
            PG8_LDB(B0, 0, 0); PG8_LDB(B1, 0, 1); PG8_SCHED; PG8_LDA(At, 0, 0); PG8_STAGE(PG8_SA(1, 1), a1 + hstep, voffA);
            PG8_WAIT_V(8); PG8_WAIT_L(0); PG8_BAR; PG8_MMA(0, 0, At, B0); PG8_MMA(0, 1, At, B1); PG8_BAR; PG8_SCHED;
            PG8_LDA(At, 0, 1); PG8_STAGE(PG8_SB(0, 0), b2, voffB); PG8_STAGE(PG8_SB(0, 1), b2 + hstepB, voffB); PG8_STAGE(PG8_SA(0, 0), a2, voffA);
            PG8_WAIT_V(8); PG8_WAIT_L(0); PG8_BAR; PG8_MMA(1, 0, At, B0); PG8_MMA(1, 1, At, B1); PG8_BAR; PG8_SCHED;
            PG8_LDB(B0, 1, 0); PG8_LDB(B1, 1, 1); PG8_SCHED; PG8_LDA(At, 1, 0); PG8_STAGE(PG8_SA(0, 1), a2 + hstep, voffA);
            PG8_WAIT_V(8); PG8_WAIT_L(0); PG8_BAR; PG8_MMA(0, 0, At, B0); PG8_MMA(0, 1, At, B1); PG8_BAR; PG8_SCHED;
            PG8_LDA(At, 1, 1); PG8_STAGE(PG8_SB(1, 0), b3, voffB); PG8_STAGE(PG8_SB(1, 1), b3 + hstepB, voffB); PG8_STAGE(PG8_SA(1, 0), a3, voffA);
            PG8_WAIT_V(8); PG8_WAIT_L(0); PG8_BAR; PG8_MMA(1, 0, At, B0); PG8_MMA(1, 1, At, B1); PG8_BAR; PG8_SCHED;
            } else {
            PG8_LDB(B0, 0, 0); PG8_SCHED; PG8_LDA(At, 0, 0); PG8_STAGE(PG8_SA(1, 1), a1 + hstep, voffA);
            PG8_WAIT_L(8); PG8_BAR; PG8_WAIT_L(0); PG8_MMA(0, 0, At, B0); PG8_BAR; PG8_SCHED;
            PG8_LDB(B1, 0, 1); PG8_STAGE(PG8_SB(0, 0), b2, voffB);
            PG8_BAR; PG8_WAIT_L(0); PG8_MMA(0, 1, At, B1); PG8_BAR;
            PG8_LDA(At, 0, 1); PG8_STAGE(PG8_SA(0, 0), a2, voffA);
            PG8_BAR; PG8_WAIT_L(0); PG8_MMA(1, 0, At, B0); PG8_BAR; PG8_SCHED;
            PG8_STAGE(PG8_SB(0, 1), b2 + hstepB, voffB);
            PG8_WAIT_V(6); PG8_BAR; PG8_MMA(1, 1, At, B1); PG8_BAR;
            PG8_LDB(B0, 1, 0); PG8_SCHED; PG8_LDA(At, 1, 0); PG8_STAGE(PG8_SA(0, 1), a2 + hstep, voffA);
            PG8_WAIT_L(8); PG8_BAR; PG8_WAIT_L(0); PG8_MMA(0, 0, At, B0); PG8_BAR; PG8_SCHED;
            PG8_LDB(B1, 1, 1); PG8_STAGE(PG8_SB(1, 0), b3, voffB);
            PG8_BAR; PG8_WAIT_L(0); PG8_MMA(0, 1, At, B1); PG8_BAR;
            PG8_LDA(At, 1, 1); PG8_STAGE(PG8_SA(1, 0), a3, voffA);
            PG8_BAR; PG8_WAIT_L(0); PG8_MMA(1, 0, At, B0); PG8_BAR; PG8_SCHED;
            PG8_STAGE(PG8_SB(1, 1), b3 + hstepB, voffB);
            PG8_WAIT_V(6); PG8_BAR; PG8_MMA(1, 1, At, B1); PG8_BAR;
            }
        }
        if constexpr (ALIGN_EPI) { if (wr == 0) PG8_BAR; }
        if constexpr (!Epi::AFTER_DRAIN) { int l2_; asm volatile("v_mbcnt_lo_u32_b32 %0, -1, 0\n\tv_mbcnt_hi_u32_b32 %0, -1, %0" : "=v"(l2_));
            E(acc, cur, wr, wc, l2_ & 15, l2_ >> 4); S.done(cur); }
        if (!has_next) break;
#pragma unroll
        for (int a = 0; a < 2; ++a)
#pragma unroll
            for (int b = 0; b < 2; ++b)
#pragma unroll
                for (int m = 0; m < 4; ++m)
#pragma unroll
                    for (int n = 0; n < 2; ++n) acc[a][b][m][n] = (f32x4){0.f, 0.f, 0.f, 0.f};
        cur = nxt; cA = nA; cB = nB; ++ui;
        if constexpr (ALIGN_EPI) { if (wr == 1) PG8_BAR; }
    }
    PG8_WAIT_V(0);
    if constexpr (!ALIGN_EPI) { if (wr == 0) PG8_BAR; }
    PG8_BAR;
    if constexpr (Epi::AFTER_DRAIN) { E.fused(acc, cur, wr, wc, fr, fq, lds, wid, lane); S.done(cur); }
#undef PG8_SA
#undef PG8_SB
#undef PG8_STAGE
#undef PG8_LDA
#undef PG8_LDB
#undef PG8_MMA
#undef PG8_WAIT_V
#undef PG8_WAIT_L
#undef PG8_BAR
#undef PG8_SCHED
}
}
namespace pg8 {
struct GemmA { const bf16_t* A; const bf16_t* Bt; int K; int rowA; size_t kstepA, hstepA, tstepA; };
template <class Epi, class Sched, bool ALIGN_EPI = false, bool SP2 = false>
__device__ __forceinline__ void gemm_phase_ga(PG8_LAS unsigned char* lds, const GemmA g, const Sched& S, const Epi& E, int wid_in) {
    int lane_; asm volatile("v_mbcnt_lo_u32_b32 %0, -1, 0\n\tv_mbcnt_hi_u32_b32 %0, -1, %0" : "=v"(lane_));
    const int wid = wid_in, lane = lane_, tid = wid * 64 + lane, wr = wid >> 2, wc = wid & 3, fr = lane & 15, fq = lane >> 4;
    const int K = g.K, nt = K / BK;
    unsigned voffA[2], voffB[2];
#pragma unroll
    for (int i = 0; i < 2; ++i) { int R, C; stage_rc(tid * 16 + i * 8192, R, C); const int Rb = Epi::PERM ? ((R & ~31) + perm32(R & 31)) : R;
        voffA[i] = (unsigned)(R * g.rowA + C * 2); voffB[i] = (unsigned)(Rb * K + C) * 2u; }
    const size_t kstep = (size_t)(BK * 2);
    const size_t hstep = (size_t)HALF * K * 2;
    const size_t kstepA = g.kstepA, hstepA = g.hstepA, tstepA = g.tstepA;
    const size_t tstep = 2 * hstep;
    const unsigned ldsw = (unsigned)wid * 1024u;
    const int aoff = lds_byte(wr * 64 + fr, fq * 8), boff = lds_byte(wc * 32 + fr, fq * 8);
#define PG8_SA(b, h) (((b) * 2 + (h)) * HTB)
#define PG8_SB(b, h) ((4 + (b) * 2 + (h)) * HTB)
#define PG8_STAGE(bufoff, gbase, voff) do { _Pragma("unroll") for (int _i = 0; _i < 2; ++_i) \
        __builtin_amdgcn_global_load_lds((const unsigned*)((const char*)(gbase) + (voff)[_i]), (PG8_LAS unsigned*)(lds + (bufoff) + ldsw + _i * 8192), 16, 0, 0); } while (0)
#define PG8_LDA(dst, b, h) do { _Pragma("unroll") for (int m = 0; m < 4; ++m) _Pragma("unroll") for (int k = 0; k < 2; ++k) dst[m][k] = *(const PG8_LAS bf16x8*)(lds + PG8_SA(b, h) + aoff + m * 2048 + k * 1024); } while (0)
#define PG8_LDB(dst, b, h) do { _Pragma("unroll") for (int n = 0; n < 2; ++n) _Pragma("unroll") for (int k = 0; k < 2; ++k) dst[n][k] = *(const PG8_LAS bf16x8*)(lds + PG8_SB(b, h) + boff + n * 2048 + k * 1024); } while (0)
#define PG8_MMA(ai, bj, At, Bt) do { __builtin_amdgcn_s_setprio(1); _Pragma("unroll") for (int m = 0; m < 4; ++m) _Pragma("unroll") for (int n = 0; n < 2; ++n) _Pragma("unroll") for (int k = 0; k < 2; ++k) \
        acc[ai][bj][m][n] = __builtin_amdgcn_mfma_f32_16x16x32_bf16(Bt[n][k], At[m][k], acc[ai][bj][m][n], 0, 0, 0); __builtin_amdgcn_s_setprio(0); } while (0)
#define PG8_WAIT_V(n) asm volatile("s_waitcnt vmcnt(" #n ")" ::: "memory")
#define PG8_WAIT_L(n) asm volatile("s_waitcnt lgkmcnt(" #n ")" ::: "memory")
#define PG8_BAR __builtin_amdgcn_s_barrier()
#define PG8_SCHED __builtin_amdgcn_sched_barrier(0)
    Unit cur, nxt; int ui = 0;
    if (!S.next(0, cur)) return;
    f32x4 acc[2][2][4][2];
#pragma unroll
    for (int a = 0; a < 2; ++a)
#pragma unroll
        for (int b = 0; b < 2; ++b)
#pragma unroll
            for (int m = 0; m < 4; ++m)
#pragma unroll
                for (int n = 0; n < 2; ++n) acc[a][b][m][n] = (f32x4){0.f, 0.f, 0.f, 0.f};
    bf16x8 At[4][2], B0[2][2], B1[2][2];
    const char* cA = (const char*)g.A + (size_t)cur.pm * tstepA; const char* cB = (const char*)g.Bt + (size_t)cur.pn * tstep;
    S.a_ready(cur);
    if constexpr (SP2) {
        PG8_STAGE(PG8_SB(0, 0), cB, voffB); PG8_STAGE(PG8_SB(0, 1), cB + hstep, voffB); PG8_STAGE(PG8_SA(0, 0), cA, voffA); PG8_STAGE(PG8_SA(0, 1), cA + hstepA, voffA);
        if (wr == 1) PG8_BAR;
        PG8_WAIT_V(2); PG8_BAR;
        PG8_STAGE(PG8_SB(1, 0), cB + kstep, voffB); PG8_STAGE(PG8_SA(1, 0), cA + kstepA, voffA); PG8_STAGE(PG8_SB(1, 1), cB + hstep + kstep, voffB);
        PG8_WAIT_V(6); PG8_BAR;
    } else {
        PG8_STAGE(PG8_SB(0, 0), cB, voffB); PG8_STAGE(PG8_SA(0, 0), cA, voffA); PG8_STAGE(PG8_SB(0, 1), cB + hstep, voffB); PG8_STAGE(PG8_SA(0, 1), cA + hstepA, voffA);
        if (wr == 1) PG8_BAR;
        PG8_WAIT_V(4); PG8_BAR;
        PG8_STAGE(PG8_SB(1, 0), cB + kstep, voffB); PG8_STAGE(PG8_SA(1, 0), cA + kstepA, voffA); PG8_STAGE(PG8_SB(1, 1), cB + hstep + kstep, voffB);
        PG8_WAIT_V(6); PG8_BAR;
    }
    for (;;) {
        const bool has_next = S.next(ui + 1, nxt);
        const char* nA = has_next ? (const char*)g.A + (size_t)nxt.pm * tstepA : cA; const char* nB = has_next ? (const char*)g.Bt + (size_t)nxt.pn * tstep : cB;
        for (int t = 0; t < nt; t += 2) {
            if constexpr (MidSeg<Epi>::v > 0) { if (t > 0 && t % MidSeg<Epi>::v == 0) E.mid(acc, cur, t / MidSeg<Epi>::v, wr, wc, fr, fq); }
            const bool last = (t == nt - 2);
            const char* a1 = cA + (size_t)(t + 1) * kstepA;
            const char* a2 = last ? nA : cA + (size_t)(t + 2) * kstepA; const char* b2 = last ? nB : cB + (size_t)(t + 2) * kstep;
            const char* a3 = a2 + kstepA; const char* b3 = b2 + kstep;
            if (last && has_next) S.a_ready(nxt);
            if constexpr (SP2) {
            PG8_LDB(B0, 0, 0); PG8_LDB(B1, 0, 1); PG8_SCHED; PG8_LDA(At, 0, 0); PG8_STAGE(PG8_SA(1, 1), a1 + hstepA, voffA);
            PG8_WAIT_V(8); PG8_WAIT_L(0); PG8_BAR; PG8_MMA(0, 0, At, B0); PG8_MMA(0, 1, At, B1); PG8_BAR; PG8_SCHED;
            PG8_LDA(At, 0, 1); PG8_STAGE(PG8_SB(0, 0), b2, voffB); PG8_STAGE(PG8_SB(0, 1), b2 + hstep, voffB); PG8_STAGE(PG8_SA(0, 0), a2, voffA);
            PG8_WAIT_V(8); PG8_WAIT_L(0); PG8_BAR; PG8_MMA(1, 0, At, B0); PG8_MMA(1, 1, At, B1); PG8_BAR; PG8_SCHED;
            PG8_LDB(B0, 1, 0); PG8_LDB(B1, 1, 1); PG8_SCHED; PG8_LDA(At, 1, 0); PG8_STAGE(PG8_SA(0, 1), a2 + hstepA, voffA);
            PG8_WAIT_V(8); PG8_WAIT_L(0); PG8_BAR; PG8_MMA(0, 0, At, B0); PG8_MMA(0, 1, At, B1); PG8_BAR; PG8_SCHED;
            PG8_LDA(At, 1, 1); PG8_STAGE(PG8_SB(1, 0), b3, voffB); PG8_STAGE(PG8_SB(1, 1), b3 + hstep, voffB); PG8_STAGE(PG8_SA(1, 0), a3, voffA);
            PG8_WAIT_V(8); PG8_WAIT_L(0); PG8_BAR; PG8_MMA(1, 0, At, B0); PG8_MMA(1, 1, At, B1); PG8_BAR; PG8_SCHED;
            } else {
            PG8_LDB(B0, 0, 0); PG8_SCHED; PG8_LDA(At, 0, 0); PG8_STAGE(PG8_SA(1, 1), a1 + hstepA, voffA);
            PG8_WAIT_L(8); PG8_BAR; PG8_WAIT_L(0); PG8_MMA(0, 0, At, B0); PG8_BAR; PG8_SCHED;
            PG8_LDB(B1, 0, 1); PG8_STAGE(PG8_SB(0, 0), b2, voffB);
            PG8_BAR; PG8_WAIT_L(0); PG8_MMA(0, 1, At, B1); PG8_BAR;
            PG8_LDA(At, 0, 1); PG8_STAGE(PG8_SA(0, 0), a2, voffA);
            PG8_BAR; PG8_WAIT_L(0); PG8_MMA(1, 0, At, B0); PG8_BAR; PG8_SCHED;
            PG8_STAGE(PG8_SB(0, 1), b2 + hstep, voffB);
            PG8_WAIT_V(6); PG8_BAR; PG8_MMA(1, 1, At, B1); PG8_BAR;
            PG8_LDB(B0, 1, 0); PG8_SCHED; PG8_LDA(At, 1, 0); PG8_STAGE(PG8_SA(0, 1), a2 + hstepA, voffA);
            PG8_WAIT_L(8); PG8_BAR; PG8_WAIT_L(0); PG8_MMA(0, 0, At, B0); PG8_BAR; PG8_SCHED;
            PG8_LDB(B1, 1, 1); PG8_STAGE(PG8_SB(1, 0), b3, voffB);
            PG8_BAR; PG8_WAIT_L(0); PG8_MMA(0, 1, At, B1); PG8_BAR;
            PG8_LDA(At, 1, 1); PG8_STAGE(PG8_SA(1, 0), a3, voffA);
            PG8_BAR; PG8_WAIT_L(0); PG8_MMA(1, 0, At, B0); PG8_BAR; PG8_SCHED;
            PG8_STAGE(PG8_SB(1, 1), b3 + hstep, voffB);
            PG8_WAIT_V(6); PG8_BAR; PG8_MMA(1, 1, At, B1); PG8_BAR;
            }
        }
        if constexpr (ALIGN_EPI) { if (wr == 0) PG8_BAR; }
        if constexpr (!Epi::AFTER_DRAIN) { E(acc, cur, wr, wc, fr, fq); S.done(cur); }
        if (!has_next) break;
#pragma unroll
        for (int a = 0; a < 2; ++a)
#pragma unroll
            for (int b = 0; b < 2; ++b)
#pragma unroll
                for (int m = 0; m < 4; ++m)
#pragma unroll
                    for (int n = 0; n < 2; ++n) acc[a][b][m][n] = (f32x4){0.f, 0.f, 0.f, 0.f};
        cur = nxt; cA = nA; cB = nB; ++ui;
        if constexpr (ALIGN_EPI) { if (wr == 1) PG8_BAR; }
    }
    PG8_WAIT_V(0);
    if constexpr (!ALIGN_EPI) { if (wr == 0) PG8_BAR; }
    PG8_BAR;
    if constexpr (Epi::AFTER_DRAIN) { E.fused(acc, cur, wr, wc, fr, fq, lds, wid, lane); S.done(cur); }
#undef PG8_SA
#undef PG8_SB
#undef PG8_STAGE
#undef PG8_LDA
#undef PG8_LDB
#undef PG8_MMA
#undef PG8_WAIT_V
#undef PG8_WAIT_L
#undef PG8_BAR
#undef PG8_SCHED
}
}
#define GAS __attribute__((address_space(1)))
#define LAS __attribute__((address_space(3)))
typedef unsigned short bf16;
typedef unsigned v4u __attribute__((ext_vector_type(4)));
typedef float f32x4 __attribute__((ext_vector_type(4)));
typedef short bf16x8 __attribute__((ext_vector_type(8)));
typedef GAS unsigned gu32;
typedef GAS unsigned long long gu64;
#define RLX_AGENT __ATOMIC_RELAXED, __HIP_MEMORY_SCOPE_AGENT
#define LDS_WAIT() asm volatile("s_waitcnt lgkmcnt(0)" ::: "memory")
#define VM_WAIT() asm volatile("s_waitcnt vmcnt(0)" ::: "memory")
__device__ __forceinline__ unsigned long long rt() { return __builtin_amdgcn_s_memrealtime(); }
__device__ __forceinline__ unsigned f2bf(float f) { unsigned u = __builtin_bit_cast(unsigned, f); return (u + 0x7fffu + ((u >> 16) & 1u)) >> 16; }
__device__ __forceinline__ unsigned pk2(float lo, float hi) { return f2bf(lo) | (f2bf(hi) << 16); }

#define XB_TMO      128
#define XB_XCNT(j)  (256  + 64 * (j))
#define XB_XSUB(j)  (1280 + 64 * (j))
#define XB_XGEN(j)  (2304 + 64 * (j))
#define XB_TOP      3328
#define XB_TOPGEN   3392
#define XCD_BAR_WORDS 3456
#define XB_SPIN_CAP (1u << 18)

__device__ __forceinline__ unsigned xb_ld(unsigned* p)              { return __hip_atomic_load(p, __ATOMIC_RELAXED, __HIP_MEMORY_SCOPE_AGENT); }
__device__ __forceinline__ unsigned xb_add(unsigned* p, unsigned v) { return __hip_atomic_fetch_add(p, v, __ATOMIC_RELAXED, __HIP_MEMORY_SCOPE_AGENT); }
__device__ __forceinline__ unsigned xb_xcc_id() { return (unsigned)__builtin_amdgcn_s_getreg((3 << 11) | 20) & 0xFu; }
#define XB_SPIN(cond, bar) do { unsigned _sp = 0; while (cond) { __builtin_amdgcn_s_sleep(1); \
    if ((++_sp & 255u) == 0u) { if (xb_ld(&(bar)[XB_TMO])) break; if (_sp > XB_SPIN_CAP) { atomicAdd(&(bar)[XB_TMO], 1u); break; } } } } while (0)

struct XcdBarrier {
    int wv;
    unsigned* bar; unsigned x;
    volatile LAS unsigned* st;
};

__device__ __forceinline__ int xb_lane_id() { int l; asm volatile("v_mbcnt_lo_u32_b32 %0, -1, 0\n\tv_mbcnt_hi_u32_b32 %0, -1, %0" : "=v"(l)); return l; }
__device__ __forceinline__ XcdBarrier xcd_barrier_post(unsigned* bar, volatile LAS unsigned* st, int wv) {
    XcdBarrier b; b.wv = wv; b.bar = bar; b.x = xb_xcc_id(); b.st = st;
    if (wv == 0 && xb_lane_id() == 0) (void)xb_add(&bar[XB_XCNT(b.x)], 1u);
    return b;
}
__device__ __forceinline__ void xcd_barrier_complete(unsigned* bar, unsigned x, unsigned& nloc, unsigned& nx) {
    const unsigned G = gridDim.x * gridDim.y * gridDim.z;
    unsigned sum, cnt, mine, sp = 0u;
    for (;;) {
        sum = 0u; cnt = 0u; mine = 0u;
#pragma unroll
        for (unsigned j = 0; j < 16; ++j) { const unsigned c = xb_ld(&bar[XB_XCNT(j)]); sum += c; cnt += (c > 0u) ? 1u : 0u; mine = (j == x) ? c : mine; }
        if (sum == G) break;
        __builtin_amdgcn_s_sleep(1);
        if ((++sp & 255u) == 0u) { if (xb_ld(&bar[XB_TMO])) break; if (sp > XB_SPIN_CAP) { atomicAdd(&bar[XB_TMO], 1u); break; } }
    }
    nloc = mine > 0u ? mine : 1u; nx = cnt > 0u ? cnt : 1u;
}

__device__ __forceinline__ void xcd_barrier(const XcdBarrier& b) {
    asm volatile("s_waitcnt vmcnt(0)" ::: "memory");
    __syncthreads();
    if (b.wv == 0 && xb_lane_id() == 0) {
        unsigned* bar = b.bar;
        __builtin_amdgcn_s_waitcnt(0);
        unsigned nloc = b.st[0], nx = b.st[1];
        if (nloc == 0u) { xcd_barrier_complete(bar, b.x, nloc, nx); b.st[0] = nloc; b.st[1] = nx; }
        const unsigned old = xb_add(&bar[XB_XSUB(b.x)], 1u);
        const unsigned gen = old / nloc;
        if (old + 1u == (gen + 1u) * nloc) {
            __builtin_amdgcn_fence(__ATOMIC_RELEASE, "agent");
            asm volatile("s_waitcnt vmcnt(0)" ::: "memory");
            const unsigned og = xb_add(&bar[XB_TOP], 1u);
            const unsigned tg = og / nx;
            if (og + 1u == (tg + 1u) * nx) xb_add(&bar[XB_TOPGEN], 1u);
            else XB_SPIN(xb_ld(&bar[XB_TOPGEN]) == tg, bar);
            __builtin_amdgcn_fence(__ATOMIC_ACQUIRE, "agent");
            xb_add(&bar[XB_XGEN(b.x)], 1u);
            asm volatile("s_waitcnt vmcnt(0)" ::: "memory");
        } else {
            XB_SPIN(xb_ld(&bar[XB_XGEN(b.x)]) == gen, bar);
            __builtin_amdgcn_fence(__ATOMIC_ACQUIRE, "agent");
            asm volatile("s_waitcnt vmcnt(0)" ::: "memory");
        }
    }
    __syncthreads();
}
#define DI __device__ __forceinline__
constexpr int NWAVES = 8;
constexpr int NB = 16, SEQ = 2048, DM = 1024, MT = NB * SEQ;
constexpr int DIN_SRC = 6944, NPROJ = 7168;
constexpr int MEML = 256, MROWS = NB * MEML;
constexpr int NEXP = 32, TOPK = 4, DFF = 1024, MOEB = 256;
constexpr int NROWS = MT * TOPK;
constexpr int NBLK_MAX = (NROWS + NEXP * (MOEB - 1) + MOEB - 1) / MOEB;
constexpr int CAP = NBLK_MAX * MOEB;
constexpr float EPS = 1e-6f;
constexpr float NEGF = -1e30f;
constexpr int NB16 = 3584, NF8 = NPROJ - NB16;
constexpr int PC_MLQ = 0, PC_MLK = 512, PC_NQ = 1024, PC_NKC = 1536, PC_NKS = 1664, PC_NKW = 1792, PC_MQ = 1920, PC_MLI = 2432, PC_MLF = 2436, PC_NG = 2440,
              PC_MLV = 2560, PC_NVC = 3072, PC_NVS = 3200, PC_NVW = 3328, PC_MLO = 3584, PC_BRG = 4096;
__host__ __device__ constexpr int proj_srccol(int j) {
    return j < 1024 ? j : j < 1536 ? 2056 + (j - 1024) : j < 1664 ? 2568 + (j - 1536) : j < 1792 ? 2824 + (j - 1664) : j < 1920 ? 3080 + (j - 1792) : j < 2432 ? 3360 + (j - 1920)
         : j < 2440 ? 2048 + (j - 2432) : j < 2464 ? 3336 + (j - 2440) : j < 2560 ? -1
         : j < 3072 ? 1024 + (j - 2560) : j < 3200 ? 2696 + (j - 3072) : j < 3328 ? 2952 + (j - 3200) : j < 3456 ? 3208 + (j - 3328) : j < 3584 ? -1
         : j < 4096 ? 1536 + (j - 3584) : 3872 + (j - 4096);
}

constexpr size_t MiB = 1u << 20;
constexpr size_t WS_CTL = 0, CTL_ZERO_BYTES = 1 * MiB;
constexpr size_t WS_WIN = 1 * MiB, WS_WGU = 15 * MiB, WS_WDN = 143 * MiB, WS_WMKV = 207 * MiB, WS_WBR = 209 * MiB, WS_WOUT = 212 * MiB, WS_WC1 = 214 * MiB;
constexpr size_t WS_WIN8 = WS_WIN + 8 * MiB;
constexpr size_t WS_SMALL = 216 * MiB;
constexpr size_t WS_R1 = 218 * MiB;
constexpr size_t WS_PROJ = 282 * MiB;
constexpr size_t WS_R3 = 730 * MiB;
constexpr size_t WS_MEMKV = WS_R3, WS_MEMKN = WS_R3 + 8 * MiB, WS_QN = WS_R3 + 12 * MiB, WS_KSN = WS_R3 + 44 * MiB, WS_KWN = WS_R3 + 52 * MiB,
                 WS_MQN = WS_R3 + 60 * MiB, WS_MLQK = WS_R3 + 92 * MiB, WS_HID = WS_R3 + 156 * MiB, WS_KC = WS_R3 + 160 * MiB, WS_VC = WS_KC + MiB / 2,
                 WS_H0 = WS_R3 + 161 * MiB, WS_H1 = WS_H0 + 32 * MiB, WS_H2 = WS_H1 + 32 * MiB, WS_ROUTE = WS_H2 + 32 * MiB, WS_END = WS_ROUTE + 6 * MiB;
constexpr size_t WS_MLV = WS_R1, WS_VSN = WS_R1 + 32 * MiB, WS_VWN = WS_R1 + 40 * MiB;
constexpr size_t WS_U8 = WS_H2;
constexpr size_t WS_MEMN = WS_H0;
constexpr size_t WS_ACMP = WS_H1;
constexpr size_t WS_APERM = WS_PROJ;
constexpr size_t WS_ACT = WS_PROJ + 272 * MiB;
static_assert(WS_ACT + 272 * MiB <= WS_H0 + 96 * MiB && WS_END <= 1024 * MiB, "ws map");
constexpr size_t SM_ROPEC = 0, SM_ROPES = 256 * 1024, SM_CBIAS = 512 * 1024, SM_WRT = 1024 * 1024, SM_W2T = 1024 * 1024 + 256 * 1024;
constexpr size_t RT_TOKE = 0, RT_TOKPOS = 512 * 1024, RT_TOKW = 1024 * 1024, RT_TOKDEST = 1536 * 1024, RT_ROWW = 2048 * 1024;
constexpr int CW_BAR = 4096;
constexpr int CW_ECNT = 16384;
constexpr int CW_QCTR = 16384 + 64;

constexpr int RING_BYTES = 131072, LDSCTL_OFF = RING_BYTES, MISC_OFF = LDSCTL_OFF + 320, LDS_BYTES = 155648;

struct Args { const float* in[34]; float* out; unsigned char* ws; int ph_lo, ph_hi, li, pad; };

DI float bf2f(unsigned short h) { return __uint_as_float((unsigned)h << 16); }
DI float wave_sum(float v) {
#pragma unroll
    for (int o = 1; o < 64; o <<= 1) v += __shfl_xor(v, o);
    return v;
}
DI float wave_max(float v) {
#pragma unroll
    for (int o = 1; o < 64; o <<= 1) v = fmaxf(v, __shfl_xor(v, o));
    return v;
}
DI float sigm(float x) { return __builtin_amdgcn_rcpf(1.f + __expf(-x)); }
DI float logsig(float x) { return fminf(x, 0.f) - log1pf(__expf(-fabsf(x))); }

namespace pg8 {
struct EpiBf16Silu {
    static constexpr bool PERM = true, AFTER_DRAIN = false;
    bf16_t* O; int ldc; const float* bias; int silu;
    DI void operator()(const f32x4 (&acc)[2][2][4][2], const Unit& u, int wr, int wc, int fr, int fq) const {
        const int row0 = u.pm * BM + wr * 64 + fr; const int col0 = u.pn * BM + wc * 32 + 8 * fq;
#pragma unroll
        for (int ai = 0; ai < 2; ++ai)
#pragma unroll
            for (int m = 0; m < 4; ++m) { bf16_t* rowp = O + (size_t)(row0 + ai * HALF + m * 16) * ldc + col0;
#pragma unroll
                for (int bj = 0; bj < 2; ++bj) { f32x4 v0 = acc[ai][bj][m][0], v1 = acc[ai][bj][m][1];
                    if (bias) { v0 += *(const f32x4*)(bias + col0 + bj * HALF); v1 += *(const f32x4*)(bias + col0 + bj * HALF + 4); }
                    if (silu) {
#pragma unroll
                        for (int j = 0; j < 4; ++j) { v0[j] = v0[j] * __builtin_amdgcn_rcpf(1.f + __expf(-v0[j])); v1[j] = v1[j] * __builtin_amdgcn_rcpf(1.f + __expf(-v1[j])); } }
                    u32x4 w; w.x = cvt_pk_bf16(v0[0], v0[1]); w.y = cvt_pk_bf16(v0[2], v0[3]); w.z = cvt_pk_bf16(v1[0], v1[1]); w.w = cvt_pk_bf16(v1[2], v1[3]);
                    *(u32x4*)(rowp + bj * HALF) = w; } }
    }
};
template <int B> struct EpiGate {
    static constexpr bool PERM = false, AFTER_DRAIN = false;
    const bf16_t* proj; float* tmp; bf16_t* merged;
    DI void operator()(const f32x4 (&acc)[2][2][4][2], const Unit& u, int wr, int wc, int fr, int fq) const {
        typedef unsigned u32x2v __attribute__((ext_vector_type(2)));
        const int col0 = u.pn * BM + wc * 32 + 4 * fq;
#pragma unroll
        for (int ai = 0; ai < 2; ++ai)
#pragma unroll
            for (int m = 0; m < 4; ++m) { const size_t r = (size_t)(u.pm * BM + ai * HALF + wr * 64 + m * 16 + fr);
#pragma unroll
                for (int bj = 0; bj < 2; ++bj)
#pragma unroll
                    for (int n = 0; n < 2; ++n) { const int c = col0 + bj * HALF + n * 16;
                        const u32x2v gw = *(const u32x2v*)(proj + r * NPROJ + PC_BRG + B * DM + c);
                        f32x4 g; g[0] = __uint_as_float(gw.x << 16); g[1] = __uint_as_float(gw.x & 0xffff0000u); g[2] = __uint_as_float(gw.y << 16); g[3] = __uint_as_float(gw.y & 0xffff0000u);
                        f32x4 v = acc[ai][bj][m][n];
#pragma unroll
                        for (int j = 0; j < 4; ++j) v[j] = v[j] * __builtin_amdgcn_rcpf(1.f + __expf(-g[j]));
                        float* tp = tmp + r * DM + c;
                        if (B == 0) { *(f32x4*)tp = v; }
                        else if (B == 1) { *(f32x4*)tp = *(const f32x4*)tp + v; }
                        else { v = *(const f32x4*)tp + v; u32x2v w; w.x = cvt_pk_bf16(v[0], v[1]); w.y = cvt_pk_bf16(v[2], v[3]); *(u32x2v*)(merged + r * DM + c) = w; } } }
    }
};
struct EpiMerge {
    static constexpr bool PERM = false, AFTER_DRAIN = false;
    const bf16_t* proj; float* tmp; bf16_t* merged;
    DI void operator()(const f32x4 (&acc)[2][2][4][2], const Unit& u, int wr, int wc, int fr, int fq) const {
        typedef unsigned u32x2v __attribute__((ext_vector_type(2)));
        const int b = u.pn >> 2, pn = u.pn & 3, pm = u.pm & 127;
        const int col0 = pn * BM + wc * 32 + 4 * fq;
#pragma unroll
        for (int ai = 0; ai < 2; ++ai)
#pragma unroll
            for (int m = 0; m < 4; ++m) { const size_t r = (size_t)(pm * BM + ai * HALF + wr * 64 + m * 16 + fr);
#pragma unroll
                for (int bj = 0; bj < 2; ++bj)
#pragma unroll
                    for (int n = 0; n < 2; ++n) { const int c = col0 + bj * HALF + n * 16;
                        const u32x2v gw = *(const u32x2v*)(proj + r * NPROJ + PC_BRG + b * DM + c);
                        f32x4 g; g[0] = __uint_as_float(gw.x << 16); g[1] = __uint_as_float(gw.x & 0xffff0000u); g[2] = __uint_as_float(gw.y << 16); g[3] = __uint_as_float(gw.y & 0xffff0000u);
                        f32x4 v = acc[ai][bj][m][n];
#pragma unroll
                        for (int j = 0; j < 4; ++j) v[j] = v[j] * __builtin_amdgcn_rcpf(1.f + __expf(-g[j]));
                        float* tp = tmp + r * DM + c;
                        if (b == 0) { *(f32x4*)tp = v; }
                        else if (b == 1) { *(f32x4*)tp = *(const f32x4*)tp + v; }
                        else { v = *(const f32x4*)tp + v; u32x2v w; w.x = cvt_pk_bf16(v[0], v[1]); w.y = cvt_pk_bf16(v[2], v[3]); *(u32x2v*)(merged + r * DM + c) = w; } } }
    }
};
struct EpiMergeK {
    static constexpr bool PERM = true, AFTER_DRAIN = false; static constexpr int MIDSEG = 8;
    const bf16_t* proj; bf16_t* merged;
    DI static void ldg8(const bf16_t* p, float (&g)[8]) { const u32x4 w = *(const u32x4*)p; const unsigned ws_[4] = {w.x, w.y, w.z, w.w};
#pragma unroll
        for (int j = 0; j < 4; ++j) { g[2 * j] = __uint_as_float(ws_[j] << 16); g[2 * j + 1] = __uint_as_float(ws_[j] & 0xffff0000u); } }
    DI void mid(f32x4 (&acc)[2][2][4][2], const Unit& u, int seg, int wr, int wc, int fr, int fq) const {
        const int col0 = u.pn * BM + wc * 32 + 8 * fq;
#pragma unroll
        for (int ai = 0; ai < 2; ++ai)
#pragma unroll
            for (int m = 0; m < 4; ++m) { const size_t r = (size_t)(u.pm * BM + ai * HALF + wr * 64 + m * 16 + fr);
#pragma unroll
                for (int bj = 0; bj < 2; ++bj) { const bf16_t* gp = proj + r * NPROJ + PC_BRG + (seg - 1) * DM + col0 + bj * HALF;
                    float ga[8], gb[8]; ldg8(gp, ga); ldg8(gp + DM, gb);
#pragma unroll
                    for (int n = 0; n < 2; ++n)
#pragma unroll
                        for (int j = 0; j < 4; ++j) acc[ai][bj][m][n][j] *= (1.f + __expf(-gb[4 * n + j])) * __builtin_amdgcn_rcpf(1.f + __expf(-ga[4 * n + j])); } }
    }
    DI void operator()(const f32x4 (&acc)[2][2][4][2], const Unit& u, int wr, int wc, int fr, int fq) const {
        const int col0 = u.pn * BM + wc * 32 + 8 * fq;
#pragma unroll
        for (int ai = 0; ai < 2; ++ai)
#pragma unroll
            for (int m = 0; m < 4; ++m) { const size_t r = (size_t)(u.pm * BM + ai * HALF + wr * 64 + m * 16 + fr);
#pragma unroll
                for (int bj = 0; bj < 2; ++bj) { float g[8]; ldg8(proj + r * NPROJ + PC_BRG + 2 * DM + col0 + bj * HALF, g); float v[8];
#pragma unroll
                    for (int n = 0; n < 2; ++n)
#pragma unroll
                        for (int j = 0; j < 4; ++j) v[4 * n + j] = acc[ai][bj][m][n][j] * __builtin_amdgcn_rcpf(1.f + __expf(-g[4 * n + j]));
                    u32x4 w; w.x = cvt_pk_bf16(v[0], v[1]); w.y = cvt_pk_bf16(v[2], v[3]); w.z = cvt_pk_bf16(v[4], v[5]); w.w = cvt_pk_bf16(v[6], v[7]);
                    *(u32x4*)(merged + r * DM + col0 + bj * HALF) = w; } }
    }
};
struct MergeOrder {
    StaticOrder so;
    DI bool next(int i, Unit& u) const { const int tl = i / 3, b = i - 3 * tl; Unit t; if (!so.next(tl, t)) return false; u.pm = b * 128 + t.pm; u.pn = b * 4 + t.pn; return true; }
    DI void a_ready(const Unit&) const {}
    DI void done(const Unit&) const {}
};
struct EpiRes {
    static constexpr bool PERM = false, AFTER_DRAIN = false;
    const float* base; float* out;
    DI void operator()(const f32x4 (&acc)[2][2][4][2], const Unit& u, int wr, int wc, int fr, int fq) const {
        const int col0 = u.pn * BM + wc * 32 + 4 * fq;
#pragma unroll
        for (int ai = 0; ai < 2; ++ai)
#pragma unroll
            for (int m = 0; m < 4; ++m) { const size_t r = (size_t)(u.pm * BM + ai * HALF + wr * 64 + m * 16 + fr);
#pragma unroll
                for (int bj = 0; bj < 2; ++bj)
#pragma unroll
                    for (int n = 0; n < 2; ++n) { const int c = col0 + bj * HALF + n * 16; *(f32x4*)(out + r * DM + c) = *(const f32x4*)(base + r * DM + c) + acc[ai][bj][m][n]; } }
    }
};
struct EpiSwiglu {
    static constexpr bool PERM = true, AFTER_DRAIN = false, PERM2 = true;
    unsigned char* act; const float* bgu;
    DI void operator()(const f32x4 (&acc)[2][2][4][2], const Unit& u, int wr, int wc, int fr, int fq) const {
        typedef unsigned u32x2v __attribute__((ext_vector_type(2)));
        const int e = u.pn >> 3, pnl = u.pn & 7;
        const unsigned lc0 = (unsigned)(pnl * BM + wc * 64 + 16 * fq);
        const unsigned row0 = (unsigned)(u.pm * BM + wr * 64 + fr);
        const float* bp = bgu + e * 2048 + lc0;
        f32x4 bv[2][2];
#pragma unroll
        for (int bj = 0; bj < 2; ++bj)
#pragma unroll
            for (int n = 0; n < 2; ++n) bv[bj][n] = *(const f32x4*)(bp + 8 * bj + 4 * n);
#pragma unroll
        for (int ai = 0; ai < 2; ++ai)
#pragma unroll
            for (int m = 0; m < 4; ++m) { const unsigned rowoff = (row0 + ai * HALF + m * 16) * (unsigned)DFF;
                int q8[2] = {0, 0};
#pragma unroll
                for (int bj = 0; bj < 2; ++bj) { float o[4];
#pragma unroll
                    for (int n = 0; n < 2; ++n) { const f32x4 v = acc[ai][bj][m][n] + bv[bj][n];
#pragma unroll
                        for (int q = 0; q < 2; ++q) { const float gt = fminf(v[2 * q], 7.0f); const float up = fminf(fmaxf(v[2 * q + 1], -7.0f), 7.0f);
                            o[2 * n + q] = (up + 1.0f) * (gt * __builtin_amdgcn_rcpf(1.f + __expf(-1.702f * gt))); } }
                    q8[bj] = __builtin_amdgcn_cvt_pk_fp8_f32(o[0], o[1], q8[bj], false); q8[bj] = __builtin_amdgcn_cvt_pk_fp8_f32(o[2], o[3], q8[bj], true); }
                *(u32x2v*)(act + (rowoff + (lc0 >> 1))) = (u32x2v){(unsigned)q8[0], (unsigned)q8[1]}; }
    }
};
struct EpiDown {
    static constexpr bool PERM = true, AFTER_DRAIN = false;
    bf16_t* y; const float* bdn; const float* roww;
    DI void operator()(const f32x4 (&acc)[2][2][4][2], const Unit& u, int wr, int wc, int fr, int fq) const {
        const int e = u.pn >> 2, pnl = u.pn & 3;
        const int col0 = pnl * BM + wc * 32 + 8 * fq;
        const float* bp = bdn + e * DM + col0;
        f32x4 bv[2][2];
#pragma unroll
        for (int bj = 0; bj < 2; ++bj) { bv[bj][0] = *(const f32x4*)(bp + bj * HALF); bv[bj][1] = *(const f32x4*)(bp + bj * HALF + 4); }
        const unsigned row0 = (unsigned)(u.pm * BM + wr * 64 + fr);
#pragma unroll
        for (int ai = 0; ai < 2; ++ai)
#pragma unroll
            for (int m = 0; m < 4; ++m) { const unsigned r = row0 + ai * HALF + m * 16; const float rw = roww[r]; const unsigned off = r * (unsigned)DM + (unsigned)col0;
#pragma unroll
                for (int bj = 0; bj < 2; ++bj) { const f32x4 v0 = (acc[ai][bj][m][0] + bv[bj][0]) * rw, v1 = (acc[ai][bj][m][1] + bv[bj][1]) * rw;
                    u32x4 w; w.x = cvt_pk_bf16(v0[0], v0[1]); w.y = cvt_pk_bf16(v0[2], v0[3]); w.z = cvt_pk_bf16(v1[0], v1[1]); w.w = cvt_pk_bf16(v1[2], v1[3]);
                    *(u32x4*)(y + (off + bj * HALF)) = w; } }
    }
};
template <int NPN> struct MoeOrder {
    int nblk, G, c; const PG8_LAS unsigned char* blk_e;
    DI bool next(int i, Unit& u) const {
        int rb, pn;
        if (G == 256) { const int x = c & 7, j = c >> 3; rb = i * (256 / NPN) + x * (32 / NPN) + j / NPN; pn = j % NPN; }
        else { const int L = i * G + c; rb = L / NPN; pn = L % NPN; }
        if (rb >= nblk) return false;
        u.pm = rb; u.pn = __builtin_amdgcn_readfirstlane((int)blk_e[rb]) * NPN + pn; return true; }
    DI void a_ready(const Unit&) const {}
    DI void done(const Unit&) const {}
};
}

struct Frame {
    LAS unsigned char* lds; volatile LAS unsigned* MISC; unsigned* ctl; unsigned char* ws;
    int wave, G, bx;
    DI int lane_id() const { int l; asm volatile("v_mbcnt_lo_u32_b32 %0, -1, 0\n\tv_mbcnt_hi_u32_b32 %0, -1, %0" : "=v"(l)); return l; }
    DI int tid_id() const { return wave * 64 + lane_id(); }
    const float* const* in; float* out;
};
enum { I_X = 0, I_MEM, I_GMIX, I_WIN, I_CONVW, I_CONVB, I_MLBI, I_MLBF, I_MLGOUT, I_NGQ, I_NGK, I_CPK, I_CW1K, I_CB1K, I_CW2K, I_CPV, I_CW1V, I_CB1V, I_CW2V,
       I_GMEM, I_WMKV, I_MGQ, I_MGK, I_WBRML, I_WBRNSA, I_WBRMEM, I_WOUT, I_GFFN, I_WR, I_BR, I_WGU, I_BGU, I_WDN, I_BDN, N_IN };

template <class CM>
DI void tr_item(const float* W, int ldw, int K, bf16* WT, int k0, int n0, CM cm, LAS float* scr, int lane) {
    const int sc = cm(n0 + (lane & 31));
#pragma unroll 8
    for (int i = 0; i < 32; ++i) { const int kk = 2 * i + (lane >> 5); scr[kk * 33 + (lane & 31)] = sc >= 0 ? W[(size_t)(k0 + kk) * ldw + sc] : 0.f; }
    LDS_WAIT(); asm volatile("" ::: "memory");
    const int c = lane & 7;
#pragma unroll
    for (int j = 0; j < 4; ++j) { const int n = (lane >> 3) + 8 * j; const LAS float* s = scr + (8 * c) * 33 + n;
        v4u o; o.x = pk2(s[0 * 33], s[1 * 33]); o.y = pk2(s[2 * 33], s[3 * 33]); o.z = pk2(s[4 * 33], s[5 * 33]); o.w = pk2(s[6 * 33], s[7 * 33]);
        *(v4u*)(WT + (size_t)(n0 + n) * K + k0 + 8 * c) = o; }
    LDS_WAIT(); asm volatile("" ::: "memory");
}
DI void tr_item_f8(const float* W, int ldw, int K, unsigned char* WT, int k0, int n0, LAS float* scr, int lane) {
#pragma unroll 8
    for (int i = 0; i < 32; ++i) { const int kk = 2 * i + (lane >> 5); scr[kk * 33 + (lane & 31)] = W[(size_t)(k0 + kk) * ldw + n0 + (lane & 31)] * 256.0f; }
    LDS_WAIT(); asm volatile("" ::: "memory");
    const int c = lane & 7;
#pragma unroll
    for (int j = 0; j < 4; ++j) { const int n = (lane >> 3) + 8 * j; const LAS float* sp = scr + (8 * c) * 33 + n;
        int lo = 0, hi = 0;
        lo = __builtin_amdgcn_cvt_pk_fp8_f32(sp[0 * 33], sp[1 * 33], lo, false); lo = __builtin_amdgcn_cvt_pk_fp8_f32(sp[2 * 33], sp[3 * 33], lo, true);
        hi = __builtin_amdgcn_cvt_pk_fp8_f32(sp[4 * 33], sp[5 * 33], hi, false); hi = __builtin_amdgcn_cvt_pk_fp8_f32(sp[6 * 33], sp[7 * 33], hi, true);
        typedef unsigned u32x2t __attribute__((ext_vector_type(2)));
        *(u32x2t*)(WT + (size_t)(n0 + n) * K + k0 + 8 * c) = (u32x2t){(unsigned)lo, (unsigned)hi}; }
    LDS_WAIT(); asm volatile("" ::: "memory");
}
DI void tr_load_v4(const float* W, int ldw, int k0, int n0, int lane, f32x4 (&v)[8]) {
#pragma unroll
    for (int i = 0; i < 8; ++i) v[i] = *(const f32x4*)(W + (size_t)(k0 + 8 * i + (lane >> 3)) * ldw + n0 + 4 * (lane & 7));
}
DI void tr_put_v4(const f32x4 (&v)[8], LAS float* scr, int lane, float mul) {
#pragma unroll
    for (int i = 0; i < 8; ++i) { LAS float* d = scr + (8 * i + (lane >> 3)) * 33 + 4 * (lane & 7); d[0] = v[i].x * mul; d[1] = v[i].y * mul; d[2] = v[i].z * mul; d[3] = v[i].w * mul; }
    LDS_WAIT(); asm volatile("" ::: "memory");
}
DI void tr_fill_v4(const float* W, int ldw, int k0, int n0, LAS float* scr, int lane, float mul) { f32x4 v[8]; tr_load_v4(W, ldw, k0, n0, lane, v); tr_put_v4(v, scr, lane, mul); }
DI void tr_emit_bf16(bf16* WT, int K, int k0, int n0, LAS float* scr, int lane) {
    const int c = lane & 7;
#pragma unroll
    for (int j = 0; j < 4; ++j) { const int n = (lane >> 3) + 8 * j; const LAS float* sp = scr + (8 * c) * 33 + n;
        v4u o; o.x = pk2(sp[0 * 33], sp[1 * 33]); o.y = pk2(sp[2 * 33], sp[3 * 33]); o.z = pk2(sp[4 * 33], sp[5 * 33]); o.w = pk2(sp[6 * 33], sp[7 * 33]);
        *(v4u*)(WT + (size_t)(n0 + n) * K + k0 + 8 * c) = o; }
    LDS_WAIT(); asm volatile("" ::: "memory");
}
DI void tr_emit_f8(unsigned char* WT, int K, int k0, int n0, LAS float* scr, int lane) {
    const int c = lane & 7;
#pragma unroll
    for (int j = 0; j < 4; ++j) { const int n = (lane >> 3) + 8 * j; const LAS float* sp = scr + (8 * c) * 33 + n;
        int lo = 0, hi = 0;
        lo = __builtin_amdgcn_cvt_pk_fp8_f32(sp[0 * 33], sp[1 * 33], lo, false); lo = __builtin_amdgcn_cvt_pk_fp8_f32(sp[2 * 33], sp[3 * 33], lo, true);
        hi = __builtin_amdgcn_cvt_pk_fp8_f32(sp[4 * 33], sp[5 * 33], hi, false); hi = __builtin_amdgcn_cvt_pk_fp8_f32(sp[6 * 33], sp[7 * 33], hi, true);
        typedef unsigned u32x2t __attribute__((ext_vector_type(2)));
        *(u32x2t*)(WT + (size_t)(n0 + n) * K + k0 + 8 * c) = (u32x2t){(unsigned)lo, (unsigned)hi}; }
    LDS_WAIT(); asm volatile("" ::: "memory");
}
template <class CM>
DI void tr_fill_cm(const float* W, int ldw, int k0, int n0, CM cm, LAS float* scr, int lane, float mul) {
    const int sc = cm(n0 + (lane & 31));
#pragma unroll 8
    for (int i = 0; i < 32; ++i) { const int kk = 2 * i + (lane >> 5); scr[kk * 33 + (lane & 31)] = sc >= 0 ? W[(size_t)(k0 + kk) * ldw + sc] * mul : 0.f; }
    LDS_WAIT(); asm volatile("" ::: "memory");
}
struct CmId { DI int operator()(int j) const { return j; } };
struct CmProj { DI int operator()(int j) const { return proj_srccol(j); } };

DI void rms_row_bf16(const float* xrow, const float* g, bf16* orow, int lane) {
    const f32x4* xr = (const f32x4*)xrow + lane; const f32x4* gr = (const f32x4*)g + lane;
    f32x4 v[4]; float s = 0.f;
#pragma unroll
    for (int j = 0; j < 4; ++j) { v[j] = xr[64 * j]; s += (v[j].x * v[j].x + v[j].y * v[j].y) + (v[j].z * v[j].z + v[j].w * v[j].w); }
    const float rstd = rsqrtf(wave_sum(s) * (1.f / DM) + EPS);
    unsigned long long* o8 = (unsigned long long*)orow + lane;
#pragma unroll
    for (int j = 0; j < 4; ++j) { const f32x4 gg = gr[64 * j];
        o8[64 * j] = (unsigned long long)pk2(v[j].x * rstd * gg.x, v[j].y * rstd * gg.y) | ((unsigned long long)pk2(v[j].z * rstd * gg.z, v[j].w * rstd * gg.w) << 32); }
}

DI void rms_row_f8(const float* xrow, const float* g, unsigned char* orow, int lane) {
    const f32x4* xr = (const f32x4*)xrow + lane; const f32x4* gr = (const f32x4*)g + lane;
    f32x4 v[4]; float s = 0.f;
#pragma unroll
    for (int j = 0; j < 4; ++j) { v[j] = xr[64 * j]; s += (v[j].x * v[j].x + v[j].y * v[j].y) + (v[j].z * v[j].z + v[j].w * v[j].w); }
    const float rstd = rsqrtf(wave_sum(s) * (1.f / DM) + EPS);
    unsigned* o4 = (unsigned*)orow + lane;
#pragma unroll
    for (int j = 0; j < 4; ++j) { const f32x4 gg = gr[64 * j]; int q8 = 0;
        q8 = __builtin_amdgcn_cvt_pk_fp8_f32(v[j].x * rstd * gg.x, v[j].y * rstd * gg.y, q8, false); q8 = __builtin_amdgcn_cvt_pk_fp8_f32(v[j].z * rstd * gg.z, v[j].w * rstd * gg.w, q8, true);
        o4[64 * j] = (unsigned)q8; }
}
template <int NR>
DI void rms_rows_both(const float* x0, const float* g, bf16* o0, unsigned char* o80, size_t step, int lane) {
    const f32x4* gr = (const f32x4*)g + lane;
    f32x4 v[NR][4];
#pragma unroll
    for (int q = 0; q < NR; ++q) { const f32x4* xr = (const f32x4*)(x0 + q * step * DM) + lane;
#pragma unroll
        for (int j = 0; j < 4; ++j) v[q][j] = xr[64 * j]; }
#pragma unroll
    for (int q = 0; q < NR; ++q) { float s = 0.f;
#pragma unroll
        for (int j = 0; j < 4; ++j) s += (v[q][j].x * v[q][j].x + v[q][j].y * v[q][j].y) + (v[q][j].z * v[q][j].z + v[q][j].w * v[q][j].w);
        const float rstd = rsqrtf(wave_sum(s) * (1.f / DM) + EPS);
        unsigned long long* o8 = (unsigned long long*)(o0 + q * step * DM) + lane; unsigned* o4 = (unsigned*)(o80 + q * step * DM) + lane;
#pragma unroll
        for (int j = 0; j < 4; ++j) { const f32x4 gg = gr[64 * j]; const float y0 = v[q][j].x * rstd * gg.x, y1 = v[q][j].y * rstd * gg.y, y2 = v[q][j].z * rstd * gg.z, y3 = v[q][j].w * rstd * gg.w;
            o8[64 * j] = (unsigned long long)pk2(y0, y1) | ((unsigned long long)pk2(y2, y3) << 32);
            int q8 = 0; q8 = __builtin_amdgcn_cvt_pk_fp8_f32(y0, y1, q8, false); q8 = __builtin_amdgcn_cvt_pk_fp8_f32(y2, y3, q8, true);
            o4[64 * j] = (unsigned)q8; } }
}
DI void p0_prologue(Frame& F) {
    LAS float* scr = (LAS float*)(F.lds + F.wave * 16384);
    const int gw = F.bx * NWAVES + F.wave, NGW = F.G * NWAVES;
    unsigned char* ws = F.ws;
    constexpr int IT_IN = 16 * (NPROJ / 32), IT_GU = 32 * 16 * 64, IT_DN = 32 * 16 * 32, IT_MKV = 16 * 32, IT_BR = 3 * 8 * 32, IT_OUT = 16 * 32, IT_C1 = 2 * 32 * 8;
    constexpr int NITEMS = IT_IN + IT_GU + IT_DN + IT_MKV + IT_BR + IT_OUT + IT_C1;
    {
        struct D { const float* src; unsigned char* dst; int ldw, k0, n0; };
        auto dec = [&](int j) { D d; if (j < IT_GU) { const int e = j / 1024, q = j % 1024; d.src = F.in[I_WGU] + (size_t)e * DM * 2048; d.dst = (unsigned char*)(ws + WS_WGU) + (size_t)e * 2048 * DM; d.ldw = 2048; d.k0 = 64 * (q / 64); d.n0 = 32 * (q % 64); }
                                     else { const int jj = j - IT_GU, e = jj / 512, q = jj % 512; d.src = F.in[I_WDN] + (size_t)e * DFF * DM; d.dst = (unsigned char*)(ws + WS_WDN) + (size_t)e * DM * DFF; d.ldw = DM; d.k0 = 64 * (q / 32); d.n0 = 32 * (q % 32); } return d; };
        const int lane = F.lane_id();
        int j = gw; f32x4 va[8]; D da{};
        if (j < IT_GU + IT_DN) { da = dec(j); tr_load_v4(da.src, da.ldw, da.k0, da.n0, lane, va); }
#pragma unroll 1
        while (j < IT_GU + IT_DN) {
            const int jn = j + NGW; f32x4 vb[8]; D db{};
            if (jn < IT_GU + IT_DN) { db = dec(jn); tr_load_v4(db.src, db.ldw, db.k0, db.n0, lane, vb); }
            else {
#pragma unroll
                for (int i = 0; i < 8; ++i) vb[i] = va[i]; }
            tr_put_v4(va, scr, lane, 256.0f); tr_emit_f8(da.dst, 1024, da.k0, da.n0, scr, lane);
#pragma unroll
            for (int i = 0; i < 8; ++i) va[i] = vb[i];
            da = db; j = jn;
        }
    }
    for (int it = gw; it < NITEMS; it += NGW) {
        int r = it;
        if (r < IT_IN) { const int kb = r / (NPROJ / 32), nb = r % (NPROJ / 32); if (32 * nb < NB16) { tr_fill_cm(F.in[I_WIN], DIN_SRC, 64 * kb, 32 * nb, CmProj(), scr, F.lane_id(), 1.0f); tr_emit_bf16((bf16*)(ws + WS_WIN), DM, 64 * kb, 32 * nb, scr, F.lane_id()); }
            else { tr_fill_cm(F.in[I_WIN], DIN_SRC, 64 * kb, 32 * nb, CmProj(), scr, F.lane_id(), 256.0f); tr_emit_f8((unsigned char*)(ws + WS_WIN8), DM, 64 * kb, 32 * nb - NB16, scr, F.lane_id()); }
            continue; } r -= IT_IN;
        if (r < IT_GU + IT_DN) continue; r -= IT_GU + IT_DN;
        if (r < IT_MKV) { const int kb = r / 32, nb = r % 32; tr_fill_v4(F.in[I_WMKV], 1024, 64 * kb, 32 * nb, scr, F.lane_id(), 1.0f); tr_emit_bf16((bf16*)(ws + WS_WMKV), 1024, 64 * kb, 32 * nb, scr, F.lane_id()); continue; } r -= IT_MKV;
        if (r < IT_BR) { const int b = r / 256, q = r % 256, kb = q / 32, nb = q % 32; tr_fill_v4(F.in[I_WBRML + b], 1024, 64 * kb, 32 * nb, scr, F.lane_id(), 1.0f); tr_emit_bf16((bf16*)(ws + WS_WBR), 1536, 512 * b + 64 * kb, 32 * nb, scr, F.lane_id()); continue; } r -= IT_BR;
        if (r < IT_OUT) { const int kb = r / 32, nb = r % 32; tr_fill_v4(F.in[I_WOUT], 1024, 64 * kb, 32 * nb, scr, F.lane_id(), 1.0f); tr_emit_bf16((bf16*)(ws + WS_WOUT), 1024, 64 * kb, 32 * nb, scr, F.lane_id()); continue; } r -= IT_OUT;
        { const int kv = r / 256, q = r % 256, kb = q / 8, nb = q % 8; tr_fill_v4(F.in[kv ? I_CW1V : I_CW1K], 256, 64 * kb, 32 * nb, scr, F.lane_id(), 1.0f); tr_emit_bf16((bf16*)(ws + WS_WC1) + (size_t)kv * 256 * 2048, 2048, 64 * kb, 32 * nb, scr, F.lane_id()); }
    }
    { int m = gw;
      for (; m + 3 * NGW < MT; m += 4 * NGW) rms_rows_both<4>(F.in[I_X] + (size_t)m * DM, F.in[I_GMIX], (bf16*)(ws + WS_R1) + (size_t)m * DM, (unsigned char*)(ws + WS_U8) + (size_t)m * DM, (size_t)NGW, F.lane_id());
      for (; m < MT; m += NGW) rms_rows_both<1>(F.in[I_X] + (size_t)m * DM, F.in[I_GMIX], (bf16*)(ws + WS_R1) + (size_t)m * DM, (unsigned char*)(ws + WS_U8) + (size_t)m * DM, (size_t)NGW, F.lane_id()); }
    for (int m = gw; m < MROWS; m += NGW) rms_row_bf16(F.in[I_MEM] + (size_t)m * DM, F.in[I_GMEM], (bf16*)(ws + WS_MEMN) + (size_t)m * DM, F.lane_id());
    float* rc = (float*)(ws + WS_SMALL + SM_ROPEC); float* rs = (float*)(ws + WS_SMALL + SM_ROPES);
    for (int i = F.bx * 512 + F.tid_id(); i < SEQ * 32; i += F.G * 512) {
        const int p = i >> 5, k = i & 31;
        const float invf = exp2f(-(float)k * (13.287712379549449f / 32.0f));
        const float ang = (float)p * invf;
        const float kf = rintf(ang * 0.15915494309189535f);
        float r = fmaf(-kf, 6.28125f, ang); r = fmaf(-kf, 1.9353071795864769e-3f, r);
        rc[i] = cosf(r); rs[i] = sinf(r);
    }
    { bf16* wrt = (bf16*)(ws + WS_SMALL + SM_WRT);
      for (int i = F.bx * 512 + F.tid_id(); i < 32 * 1024; i += F.G * 512) { const int e = i >> 10, k = i & 1023; const float w = F.in[I_WR][k * 32 + e]; const unsigned hi = f2bf(w); wrt[i] = (bf16)hi; wrt[32 * 1024 + i] = (bf16)f2bf(w - __uint_as_float(hi << 16)); } }
    { bf16* w2t = (bf16*)(ws + WS_SMALL + SM_W2T);
      for (int i = F.bx * 512 + F.tid_id(); i < 2 * 64 * 256; i += F.G * 512) { const int kv = i >> 14, d = (i >> 8) & 63, f = i & 255; w2t[i] = (bf16)f2bf(F.in[kv ? I_CW2V : I_CW2K][f * 64 + d]); } }
    for (int o = gw; o < 512; o += NGW) {
        const int kv = o >> 8, f = o & 255, lane = F.lane_id();
        const float* pe = F.in[kv ? I_CPV : I_CPK]; const float* w1 = F.in[kv ? I_CW1V : I_CW1K];
        float wv[32], pv[32];
#pragma unroll
        for (int i = 0; i < 32; ++i) { const int k = lane + 64 * i; wv[i] = w1[(size_t)k * 256 + f]; pv[i] = pe[k]; }
        float a = 0.f;
#pragma unroll
        for (int i = 0; i < 32; ++i) a = fmaf(pv[i], wv[i], a);
        a = wave_sum(a);
        if (lane == 0) ((float*)(ws + WS_SMALL + SM_CBIAS))[o] = a + F.in[kv ? I_CB1V : I_CB1K][f];
    }
}

DI void unpack8(const v4u& w, float (&f)[8]) {
    f[0] = __uint_as_float(w.x << 16); f[1] = __uint_as_float(w.x & 0xffff0000u); f[2] = __uint_as_float(w.y << 16); f[3] = __uint_as_float(w.y & 0xffff0000u);
    f[4] = __uint_as_float(w.z << 16); f[5] = __uint_as_float(w.z & 0xffff0000u); f[6] = __uint_as_float(w.w << 16); f[7] = __uint_as_float(w.w & 0xffff0000u);
}
DI v4u pack8f(const float (&f)[8]) { v4u o; o.x = pk2(f[0], f[1]); o.y = pk2(f[2], f[3]); o.z = pk2(f[4], f[5]); o.w = pk2(f[6], f[7]); return o; }
DI void load8f(const float* p, float (&f)[8]) { const f32x4 a = *(const f32x4*)p, b = *(const f32x4*)(p + 4); f[0] = a.x; f[1] = a.y; f[2] = a.z; f[3] = a.w; f[4] = b.x; f[5] = b.y; f[6] = b.z; f[7] = b.w; }
DI void norm_rope64(float (&f)[8], const float (&g)[8], const float (&c8)[8], const float (&s8)[8], int lane, float scale) {
    float ss = 0.f;
#pragma unroll
    for (int i = 0; i < 8; ++i) ss = fmaf(f[i], f[i], ss);
    ss += __shfl_xor(ss, 1); ss += __shfl_xor(ss, 2); ss += __shfl_xor(ss, 4);
    const float rstd = rsqrtf(ss * (1.f / 64.f) + EPS);
    const bool hi = (lane & 4) != 0;
#pragma unroll
    for (int i = 0; i < 8; ++i) { const float y = f[i] * rstd * g[i]; const float pt = __shfl_xor(y, 4); f[i] = (hi ? fmaf(pt, s8[i], y * c8[i]) : fmaf(-pt, s8[i], y * c8[i])) * scale; }
}
DI void p2_prep(Frame& F) {
    unsigned char* ws = F.ws;
    const int ncg = F.G >= 64 ? 32 : 0;
    if (F.bx < ncg) return;
    const int gw = (F.bx - ncg) * NWAVES + F.wave, NGW = (F.G - ncg) * NWAVES, lane = F.lane_id();
    const bf16* proj = (const bf16*)(ws + WS_PROJ);
    const float* rc = (const float*)(ws + WS_SMALL + SM_ROPEC); const float* rs = (const float*)(ws + WS_SMALL + SM_ROPES);
    bf16* qn = (bf16*)(ws + WS_QN); bf16* ksn = (bf16*)(ws + WS_KSN); bf16* kwn = (bf16*)(ws + WS_KWN); bf16* mqn = (bf16*)(ws + WS_MQN); bf16* mlqk = (bf16*)(ws + WS_MLQK);
    constexpr int NT = 4;
    {
        float gq8[8], mg8[8]; load8f(F.in[I_NGQ] + 8 * (lane & 7), gq8); load8f(F.in[I_MGQ] + 8 * (lane & 15), mg8);
        for (int t0 = gw * NT; t0 < MT; t0 += NGW * NT) {
            v4u a[NT], bq[NT], cv[NT]; float c8[NT][8], s8[NT][8];
#pragma unroll
            for (int u = 0; u < NT; ++u) { const int t = t0 + u, tau = t & 2047; const bf16* pr = proj + (size_t)t * NPROJ;
                a[u] = *(const v4u*)(pr + PC_NQ + 8 * lane); bq[u] = *(const v4u*)(pr + PC_MQ + 8 * lane); cv[u] = *(const v4u*)(pr + PC_MLV + 8 * lane);
                load8f(rc + tau * 32 + 8 * (lane & 3), c8[u]); load8f(rs + tau * 32 + 8 * (lane & 3), s8[u]); }
#pragma unroll
            for (int u = 0; u < NT; ++u) { const int t = t0 + u;
                float f[8]; unpack8(a[u], f);
                norm_rope64(f, gq8, c8[u], s8[u], lane, 0.125f * 1.4426950408889634f);
                *(v4u*)(qn + (size_t)t * 512 + 8 * lane) = pack8f(f);
                unpack8(bq[u], f);
                float ss = 0.f;
#pragma unroll
                for (int i = 0; i < 8; ++i) ss = fmaf(f[i], f[i], ss);
                ss += __shfl_xor(ss, 1); ss += __shfl_xor(ss, 2); ss += __shfl_xor(ss, 4); ss += __shfl_xor(ss, 8);
                const float rstd = rsqrtf(ss * (1.f / 128.f) + EPS) * (0.08838834764831845f * 1.4426950408889634f);
#pragma unroll
                for (int i = 0; i < 8; ++i) f[i] *= rstd * mg8[i];
                *(v4u*)(mqn + (size_t)t * 512 + 8 * lane) = pack8f(f);
                *(v4u*)((bf16*)(ws + WS_MLV) + (size_t)t * 512 + 8 * lane) = cv[u]; }
        }
    }
    {
        const int L = lane & 31, hd4 = L >> 3, j = L & 7, half = lane >> 5;
        float gk8[8]; load8f(F.in[I_NGK] + (1 + (hd4 >> 1)) * 64 + 8 * j, gk8);
        const int kcol = (hd4 < 2 ? PC_NKS + hd4 * 64 : PC_NKW + (hd4 - 2) * 64) + 8 * j;
        bf16* kdst = (hd4 < 2 ? ksn : kwn) + (hd4 & 1) * 64 + 8 * j;
        const int wv = L >> 4, jj = L & 15;
        bf16* vdst = (bf16*)(ws + (wv ? WS_VWN : WS_VSN)) + 8 * jj; const int vcol = (wv ? PC_NVW : PC_NVS) + 8 * jj;
        for (int tp0 = gw * NT; tp0 < MT / 2; tp0 += NGW * NT) {
            v4u a[NT], vv[NT]; float c8[NT][8], s8[NT][8];
#pragma unroll
            for (int u = 0; u < NT; ++u) { const int t = 2 * (tp0 + u) + half, tau = t & 2047; const bf16* pr = proj + (size_t)t * NPROJ;
                a[u] = *(const v4u*)(pr + kcol); vv[u] = *(const v4u*)(pr + vcol);
                load8f(rc + tau * 32 + 8 * (lane & 3), c8[u]); load8f(rs + tau * 32 + 8 * (lane & 3), s8[u]); }
#pragma unroll
            for (int u = 0; u < NT; ++u) { const int t = 2 * (tp0 + u) + half;
                float f[8]; unpack8(a[u], f);
                norm_rope64(f, gk8, c8[u], s8[u], lane, 1.0f);
                *(v4u*)(kdst + (size_t)t * 128) = pack8f(f);
                *(v4u*)(vdst + (size_t)t * 128) = vv[u]; }
        }
    }
    for (int run = gw; run < MT / 16; run += NGW) {
        const int t0 = run * 16, tau0 = t0 & 2047;
#pragma unroll 1
        for (int sp = 0; sp < 2; ++sp) {
            const int ch = 512 * sp + 8 * lane;
            float w0[8], w1[8], w2[8], w3[8], bb[8];
            load8f(F.in[I_CONVW] + ch, w0); load8f(F.in[I_CONVW] + 1024 + ch, w1); load8f(F.in[I_CONVW] + 2048 + ch, w2); load8f(F.in[I_CONVW] + 3072 + ch, w3); load8f(F.in[I_CONVB] + ch, bb);
            float x0[8], x1[8], x2[8];
            if (tau0 >= 3) { unpack8(*(const v4u*)(proj + (size_t)(t0 - 3) * NPROJ + ch), x0); unpack8(*(const v4u*)(proj + (size_t)(t0 - 2) * NPROJ + ch), x1); unpack8(*(const v4u*)(proj + (size_t)(t0 - 1) * NPROJ + ch), x2); }
            else {
#pragma unroll
                for (int i = 0; i < 8; ++i) { x0[i] = 0.f; x1[i] = 0.f; x2[i] = 0.f; } }
#pragma unroll 1
            for (int k0 = 0; k0 < 16; k0 += 4) {
                v4u raw[4];
#pragma unroll
                for (int k = 0; k < 4; ++k) raw[k] = *(const v4u*)(proj + (size_t)(t0 + k0 + k) * NPROJ + ch);
#pragma unroll
                for (int k = 0; k < 4; ++k) { float x3[8], y[8]; unpack8(raw[k], x3);
#pragma unroll
                    for (int i = 0; i < 8; ++i) { const float a = fmaf(w3[i], x3[i], fmaf(w2[i], x2[i], fmaf(w1[i], x1[i], fmaf(w0[i], x0[i], bb[i])))); y[i] = a * sigm(a); x0[i] = x1[i]; x1[i] = x2[i]; x2[i] = x3[i]; }
                    *(v4u*)(mlqk + (size_t)(t0 + k0 + k) * 1024 + ch) = pack8f(y); }
            }
        }
    }
    {
        const bf16* memkv = (const bf16*)(ws + WS_MEMKV); bf16* memkn = (bf16*)(ws + WS_MEMKN);
        float kg8[8]; load8f(F.in[I_MGK] + 8 * (lane & 15), kg8);
        for (int r = gw; r < MROWS; r += NGW) {
            float f[8]; unpack8(*(const v4u*)(memkv + (size_t)r * 1024 + 8 * lane), f);
            float ss = 0.f;
#pragma unroll
            for (int i = 0; i < 8; ++i) ss = fmaf(f[i], f[i], ss);
            ss += __shfl_xor(ss, 1); ss += __shfl_xor(ss, 2); ss += __shfl_xor(ss, 4); ss += __shfl_xor(ss, 8);
            const float rstd = rsqrtf(ss * (1.f / 128.f) + EPS);
#pragma unroll
            for (int i = 0; i < 8; ++i) f[i] *= rstd * kg8[i];
            *(v4u*)(memkn + (size_t)r * 512 + 8 * lane) = pack8f(f);
        }
    }
}

DI void p4_kcvc(Frame& F) {
    unsigned char* ws = F.ws;
    const int gw = F.bx * NWAVES + F.wave, NGW = F.G * NWAVES, lane = F.lane_id();
    const bf16* hid = (const bf16*)(ws + WS_HID);
    const float* rc = (const float*)(ws + WS_SMALL + SM_ROPEC); const float* rs = (const float*)(ws + WS_SMALL + SM_ROPES);
    const float gk = F.in[I_NGK][lane];
    for (int it = gw; it < 2 * 4096; it += NGW) {
        const int kv = it >> 12, r = it & 4095, n = r & 127;
        bf16* dst = (bf16*)(ws + (kv ? WS_VC : WS_KC)) + (size_t)r * 64 + lane;
        if (n == 127) { *dst = 0; continue; }
        const bf16* hr = hid + (size_t)kv * 4096 * 256 + (size_t)r * 256; const float* w2 = F.in[kv ? I_CW2V : I_CW2K];
        float a = 0.f;
        for (int f = 0; f < 256; ++f) a = fmaf(bf2f(hr[f]), w2[f * 64 + lane], a);
        if (kv == 0) {
            const float y = a * rsqrtf(wave_sum(a * a) * (1.f / 64.f) + EPS) * gk;
            const int pos = 16 * n + 31; const float c = rc[pos * 32 + (lane & 31)], s = rs[pos * 32 + (lane & 31)];
            const float pt = __shfl_xor(y, 32);
            a = lane < 32 ? y * c - pt * s : y * c + pt * s;
        }
        *dst = (bf16)f2bf(a);
    }
}

typedef float f32x16 __attribute__((ext_vector_type(16)));
typedef float f32x2v __attribute__((ext_vector_type(2)));
typedef __bf16 bf16x2v __attribute__((ext_vector_type(2)));
typedef short s16x4 __attribute__((ext_vector_type(4)));
typedef unsigned u32x2 __attribute__((ext_vector_type(2)));
#define MFMA32(a, b, c) __builtin_amdgcn_mfma_f32_32x32x16_bf16((a), (b), (c), 0, 0, 0)
#define WG_BAR() do { asm volatile("s_waitcnt vmcnt(0) lgkmcnt(0)" ::: "memory"); __builtin_amdgcn_s_barrier(); asm volatile("" ::: "memory"); } while (0)
DI unsigned pkbf(float lo, float hi) { f32x2v v = {lo, hi}; return __builtin_bit_cast(unsigned, __builtin_convertvector(v, bf16x2v)); }
template <int S> DI bf16x8 pack8(const f32x16& x) {
    v4u p; p.x = pkbf(x[8 * S], x[8 * S + 1]); p.y = pkbf(x[8 * S + 2], x[8 * S + 3]); p.z = pkbf(x[8 * S + 4], x[8 * S + 5]); p.w = pkbf(x[8 * S + 6], x[8 * S + 7]);
    return __builtin_bit_cast(bf16x8, p);
}
DI int crow(int i, int h) { return (i & 3) + 8 * (i >> 2) + 4 * h; }
constexpr int AT_K = 0, AT_V = 32768, AT_IMP = 65536, AT_WM = 98304, AT_INV = 98368, AT_SC = 99392;

DI void glds16(const void* gsrc, unsigned lds_dst) { unsigned keep; asm volatile("s_mov_b32 %0, m0\n\ts_mov_b32 m0, %2\n\ts_nop 0\n\tglobal_load_lds_dwordx4 %1, off\n\ts_mov_b32 m0, %0" : "=&s"(keep) : "v"(gsrc), "s"(lds_dst) : "memory"); }
DI void at_load(LAS unsigned char* lds, int par, const void* kb, size_t kpitch, const void* vb, size_t vpitch, int wave, int lane) {
    const int row = 8 * wave + (lane >> 3), pc = lane & 7;
    const int kc = pc ^ ((row >> 1) & 7), vc = pc ^ (((row >> 1) & 1) << 2);
    glds16((const char*)kb + (size_t)row * kpitch + 16 * kc, (unsigned)(size_t)(lds + AT_K + par * 8192 + wave * 1024));
    glds16((const char*)vb + (size_t)row * vpitch + 16 * vc, (unsigned)(size_t)(lds + AT_V + par * 8192 + wave * 1024));
}
#define SB() __builtin_amdgcn_sched_barrier(0)
typedef __attribute__((address_space(3))) s16x4 lds_s16x4;
DI void at_qk(const LAS unsigned char* kbuf, const int (&ka)[4], const bf16x8 (&qf)[4], f32x16 (&s)[2]) {
    bf16x8 kf[2][4];
#pragma unroll
    for (int kb = 0; kb < 2; ++kb)
#pragma unroll
        for (int st = 0; st < 4; ++st) kf[kb][st] = *(const LAS bf16x8*)(kbuf + ka[st] + kb * 4096);
    SB();
#pragma unroll
    for (int kb = 0; kb < 2; ++kb) {
        f32x16 a;
#pragma unroll
        for (int i = 0; i < 16; ++i) a[i] = 0.f;
#pragma unroll
        for (int st = 0; st < 4; ++st) a = MFMA32(kf[kb][st], qf[st], a);
        s[kb] = a;
    }
}
DI void at_vload(const LAS unsigned char* vbuf, const int (&va)[2], int kb, bf16x8 (&vf)[2][2]) {
#pragma unroll
    for (int s2 = 0; s2 < 2; ++s2)
#pragma unroll
        for (int db = 0; db < 2; ++db) {
            const s16x4 lo = __builtin_amdgcn_ds_read_tr16_b64_v4i16((lds_s16x4*)(vbuf + va[db] + kb * 4096 + s2 * 2048));
            const s16x4 hi = __builtin_amdgcn_ds_read_tr16_b64_v4i16((lds_s16x4*)(vbuf + va[db] + kb * 4096 + s2 * 2048 + 1024));
            vf[s2][db] = __builtin_shufflevector(lo, hi, 0, 1, 2, 3, 4, 5, 6, 7); }
}
DI void at_pv1(const bf16x8 (&vf)[2][2], const f32x16& p, f32x16 (&o)[2]) {
    const bf16x8 pf0 = pack8<0>(p), pf1 = pack8<1>(p);
#pragma unroll
    for (int s2 = 0; s2 < 2; ++s2)
#pragma unroll
        for (int db = 0; db < 2; ++db) o[db] = MFMA32(vf[s2][db], s2 ? pf1 : pf0, o[db]);
}
DI void at_pv(const LAS unsigned char* vbuf, const int (&va)[2], const bf16x8 (&vf0)[2][2], const f32x16 (&p)[2], f32x16 (&o)[2]) {
    bf16x8 vf1[2][2]; at_vload(vbuf, va, 1, vf1);
    at_pv1(vf0, p[0], o);
    at_pv1(vf1, p[1], o);
}
DI void at_exp_all(f32x16 (&s)[2], float& l) {
#pragma unroll
    for (int kb = 0; kb < 2; ++kb)
#pragma unroll
        for (int i = 0; i < 16; ++i) { const float p = __builtin_amdgcn_exp2f(s[kb][i]); s[kb][i] = p; l += p; }
}
DI void at_wait(int n) {
    if (n >= 2) asm volatile("s_waitcnt vmcnt(4)" ::: "memory"); else if (n == 1) asm volatile("s_waitcnt vmcnt(2)" ::: "memory"); else asm volatile("s_waitcnt vmcnt(0)" ::: "memory");
    asm volatile("s_waitcnt lgkmcnt(0)" ::: "memory"); __builtin_amdgcn_s_barrier(); asm volatile("" ::: "memory");
}
template <bool STORE = true, bool DO_CMP = true, bool DO_SEL = true, bool DO_WIN = true>
DI void nsa_unit(Frame& F, int unit) {
    unsigned char* ws = F.ws; LAS unsigned char* lds = F.lds;
    int lane_ = F.lane_id();
    const int lane = lane_, wave = F.wave, r = lane & 31, h = lane >> 5, g = wave >> 1, qh = wave & 1;
    const int bh = unit & 31, qt = 31 - (unit >> 5), b = bh >> 1, hkv = bh & 1;
    const int qloc = 32 * qh + r, tau = 64 * qt + qloc, qq = tau & 63; const size_t t = (size_t)b * SEQ + tau;
    const bf16* proj = (const bf16*)(ws + WS_PROJ);
    const bf16* qn = (const bf16*)(ws + WS_QN); const bf16* ksn = (const bf16*)(ws + WS_KSN); const bf16* kwn = (const bf16*)(ws + WS_KWN);
    const bf16* kc = (const bf16*)(ws + WS_KC); const bf16* vc = (const bf16*)(ws + WS_VC); bf16* H1 = (bf16*)(ws + WS_H0);
    int ka[4], va[2];
    { const int f = (r >> 1) & 7, fs = f >> 1, hb = h ^ (f & 1);
#pragma unroll
      for (int st = 0; st < 4; ++st) ka[st] = r * 128 + 16 * (((st ^ fs) << 1) | hb);
      const int i16 = lane & 15, q = i16 >> 2, p = i16 & 3, g1 = (lane >> 4) & 1;
#pragma unroll
      for (int db = 0; db < 2; ++db) va[db] = (4 * h + q) * 128 + 16 * ((4 * db + 2 * g1 + (p >> 1)) ^ (((q >> 1) & 1) << 2)) + 8 * (p & 1); }
    bf16x8 qf[4];
#pragma unroll
    for (int st = 0; st < 4; ++st) qf[st] = *(const bf16x8*)(qn + t * 512 + (hkv * 4 + g) * 64 + 16 * st + 8 * h);
    float gate[3];
#pragma unroll
    for (int c = 0; c < 3; ++c) gate[c] = sigm(bf2f(proj[t * NPROJ + PC_NG + (hkv * 4 + g) * 3 + c]));
    f32x16 ofin[2];
#pragma unroll
    for (int i = 0; i < 16; ++i) { ofin[0][i] = 0.f; ofin[1][i] = 0.f; }
    WG_BAR();
    if (DO_CMP) {
        const int ncq = tau >= 31 ? ((tau - 31) >> 4) + 1 : 0;
        const int ntc = (((64 * qt + 63 - 31) >> 4) + 1 > 64) ? 2 : 1;
        const char* kb0 = (const char*)(kc + (size_t)(b * 2 + hkv) * 128 * 64); const char* vb0 = (const char*)(vc + (size_t)(b * 2 + hkv) * 128 * 64);
        at_load(lds, 0, kb0, 128, vb0, 128, wave, lane);
        if (ntc == 2) at_load(lds, 1, kb0 + 64 * 128, 128, vb0 + 64 * 128, 128, wave, lane);
        WG_BAR();
        f32x16 o[2]; float l = 0.f, prevEp = 0.f;
#pragma unroll
        for (int i = 0; i < 16; ++i) { o[0][i] = 0.f; o[1][i] = 0.f; }
        LAS float* I = (LAS float*)(lds + AT_IMP) + (g * 64 + qloc) * 32;
#pragma unroll 1
        for (int tile = 0; tile < 2; ++tile) {
            if (tile < ntc) {
                f32x16 s[2];
                at_qk(lds + AT_K + tile * 8192, ka, qf, s);
                bf16x8 vf[2][2]; at_vload(lds + AT_V + tile * 8192, va, 0, vf); SB();
#pragma unroll
                for (int kb = 0; kb < 2; ++kb)
#pragma unroll
                    for (int i = 0; i < 16; ++i) { const int n = 64 * tile + 32 * kb + crow(i, h); const float p = n < ncq ? __builtin_amdgcn_exp2f(s[kb][i]) : 0.f; s[kb][i] = p; l += p; }
#pragma unroll
                for (int kb = 0; kb < 2; ++kb)
#pragma unroll
                    for (int a = 0; a < 4; ++a) { const int idx = tile * 8 + kb * 4 + a; const float Gv = (s[kb][4 * a] + s[kb][4 * a + 1]) + (s[kb][4 * a + 2] + s[kb][4 * a + 3]);
                        const float Epv = __shfl_xor(s[kb][4 * a + 3], 32);
                        I[2 * idx + h] = Gv + (h ? Epv : prevEp); prevEp = Epv; }
                at_pv(lds + AT_V + tile * 8192, va, vf, s, o);
            } else {
#pragma unroll
                for (int idx = 8; idx < 16; ++idx) I[2 * idx + h] = 0.f;
            }
        }
        const float L = l + __shfl_xor(l, 32); const float inv = L > 0.f ? 1.f / L : 0.f;
        const float gi = gate[0] * inv;
#pragma unroll
        for (int i = 0; i < 16; ++i) { ofin[0][i] += gi * o[0][i]; ofin[1][i] += gi * o[1][i]; }
        if (h == 0) ((LAS float*)(lds + AT_INV))[g * 64 + qloc] = inv;
    }
    WG_BAR();
    unsigned sel = 0u, wm = 0u, um = 0u;
    if (!DO_CMP) { sel = (qt == 31) ? 0xffffffffu : ((1u << (qt + 1)) - 1u); wm = sel; um = sel; }
    else {
        const LAS float* I = (const LAS float*)(lds + AT_IMP) + qloc * 32;
        const LAS float* IV = (const LAS float*)(lds + AT_INV) + qloc;
        const float iv0 = IV[0], iv1 = IV[64], iv2 = IV[128], iv3 = IV[192];
        LAS unsigned* SC = (LAS unsigned*)(lds + AT_SC) + (qh * 32 + r) * 33;
        if (g == 0 && h == 0) {
#pragma unroll 8
            for (int j = 0; j < 32; ++j) { const float imp = (I[j] * iv0 + I[64 * 32 + j] * iv1) + (I[2 * 64 * 32 + j] * iv2 + I[3 * 64 * 32 + j] * iv3);
                const bool cand = (j >= 1) && (j <= qt - 2);
                SC[j] = cand ? ((__float_as_uint(imp) & ~31u) | (unsigned)(31 - j)) + 32u : 0u; }
        }
        WG_BAR();
        if (qt <= 7) sel = (1u << (qt + 1)) - 1u;
        else {
            sel = 1u | (1u << qt) | (1u << (qt - 1));
            unsigned prev = 0xffffffffu;
#pragma unroll 1
            for (int rd = 0; rd < 5; ++rd) { unsigned best = 0u;
#pragma unroll 8
                for (int j = 0; j < 32; ++j) { const unsigned kx = SC[j]; const unsigned cnd = kx < prev ? kx : 0u; best = cnd > best ? cnd : best; }
                prev = best; if (best) sel |= 1u << (31 - (int)(best & 31u)); }
        }
        sel &= (qt == 31) ? 0xffffffffu : ((1u << (qt + 1)) - 1u);
        wm = sel;
#pragma unroll
        for (int o = 1; o < 32; o <<= 1) wm |= (unsigned)__shfl_xor((int)wm, o);
        wm = (unsigned)__builtin_amdgcn_readfirstlane((int)wm);
        if (lane == 0) ((LAS unsigned*)(lds + AT_WM))[wave] = wm;
        WG_BAR();
        um = 0u;
#pragma unroll
        for (int w = 0; w < 8; ++w) um |= ((const LAS unsigned*)(lds + AT_WM))[w];
        um = (unsigned)__builtin_amdgcn_readfirstlane((int)um);
    }
    if (DO_SEL) {
        f32x16 o[2]; float l = 0.f;
#pragma unroll
        for (int i = 0; i < 16; ++i) { o[0][i] = 0.f; o[1][i] = 0.f; }
        const char* kbase = (const char*)(ksn + (size_t)b * SEQ * 128 + hkv * 64); const char* vbase = (const char*)((const bf16*)(ws + WS_VSN) + (size_t)b * SEQ * 128 + hkv * 64);
        unsigned rem = um, im = um; int k = 0; const int T = __popc(um);
#pragma unroll 1
        for (int i = 0; i < 3 && im; ++i) { const int jn = __ffs((int)im) - 1; im &= im - 1u; at_load(lds, i, kbase + (size_t)jn * 64 * 256, 256, vbase + (size_t)jn * 64 * 256, 256, wave, lane); }
#pragma unroll 1
        while (rem) {
            const int j = __ffs((int)rem) - 1; rem &= rem - 1u;
            at_wait(T - k - 1);
#ifdef NSA_E1
            at_wait(T - k - 1);
#endif
            if (im) { const int jn = __ffs((int)im) - 1; im &= im - 1u; at_load(lds, (k + 3) & 3, kbase + (size_t)jn * 64 * 256, 256, vbase + (size_t)jn * 64 * 256, 256, wave, lane); }
            const int par = k & 3;
            if ((wm >> j) & 1u) {
                f32x16 s[2];
                at_qk(lds + AT_K + par * 8192, ka, qf, s);
                bf16x8 vf[2][2]; at_vload(lds + AT_V + par * 8192, va, 0, vf); SB();
                const bool on = (sel >> j) & 1u;
                if (j != qt && __all(on)) at_exp_all(s, l);
                else { const int klim = j == qt ? qq : 63;
#pragma unroll
                    for (int kb = 0; kb < 2; ++kb)
#pragma unroll
                        for (int i = 0; i < 16; ++i) { const int key = 32 * kb + crow(i, h); const float p = (on && key <= klim) ? __builtin_amdgcn_exp2f(s[kb][i]) : 0.f; s[kb][i] = p; l += p; } }
                at_pv(lds + AT_V + par * 8192, va, vf, s, o);
            }
            ++k;
        }
        const float L = l + __shfl_xor(l, 32); const float gi = gate[1] * (L > 0.f ? 1.f / L : 0.f);
#pragma unroll
        for (int i = 0; i < 16; ++i) { ofin[0][i] += gi * o[0][i]; ofin[1][i] += gi * o[1][i]; }
    }
    WG_BAR();
    if (DO_WIN) {
        f32x16 o[2]; float l = 0.f;
#pragma unroll
        for (int i = 0; i < 16; ++i) { o[0][i] = 0.f; o[1][i] = 0.f; }
        const char* kbase = (const char*)(kwn + (size_t)b * SEQ * 128 + hkv * 64); const char* vbase = (const char*)((const bf16*)(ws + WS_VWN) + (size_t)b * SEQ * 128 + hkv * 64);
        const int jlo = qt > 8 ? qt - 8 : 0; const int T = qt - jlo + 1;
#ifdef NSA_E2
        f32x16 o2[2]; float l2 = 0.f;
#pragma unroll
        for (int i = 0; i < 16; ++i) { o2[0][i] = 0.f; o2[1][i] = 0.f; }
#endif
#pragma unroll 1
        for (int i = 0; i < 3 && i < T; ++i) at_load(lds, i, kbase + (size_t)(jlo + i) * 64 * 256, 256, vbase + (size_t)(jlo + i) * 64 * 256, 256, wave, lane);
#pragma unroll 1
        for (int k = 0; k < T; ++k) {
            const int j = jlo + k, par = k & 3;
            at_wait(T - k - 1);
#ifdef NSA_E1
            at_wait(T - k - 1);
#endif
            if (k + 3 < T) at_load(lds, (k + 3) & 3, kbase + (size_t)(j + 3) * 64 * 256, 256, vbase + (size_t)(j + 3) * 64 * 256, 256, wave, lane);
            f32x16 s[2];
            at_qk(lds + AT_K + par * 8192, ka, qf, s);
            bf16x8 vf[2][2]; at_vload(lds + AT_V + par * 8192, va, 0, vf); SB();
#ifdef NSA_E2
            { f32x16 s2[2]; asm volatile("" ::: "memory"); at_qk(lds + AT_K + par * 8192, ka, qf, s2); bf16x8 vf2[2][2]; at_vload(lds + AT_V + par * 8192, va, 0, vf2); SB(); at_exp_all(s2, l2); at_pv(lds + AT_V + par * 8192, va, vf2, s2, o2); }
#endif
            if (j != qt && j != qt - 8) at_exp_all(s, l);
            else { const int klo = (j == qt - 8) ? qq + 1 : 0, khi = (j == qt) ? qq : 63;
#pragma unroll
                for (int kb = 0; kb < 2; ++kb)
#pragma unroll
                    for (int i = 0; i < 16; ++i) { const int key = 32 * kb + crow(i, h); const float p = (key >= klo && key <= khi) ? __builtin_amdgcn_exp2f(s[kb][i]) : 0.f; s[kb][i] = p; l += p; } }
            at_pv(lds + AT_V + par * 8192, va, vf, s, o);
        }
#ifdef NSA_E2
        { const float z = l2 * 0.f;
#pragma unroll
          for (int i = 0; i < 16; ++i) { ofin[0][i] += z * o2[0][i]; ofin[1][i] += z * o2[1][i]; } }
#endif
        const float L = l + __shfl_xor(l, 32); const float gi = gate[2] * (L > 0.f ? 1.f / L : 0.f);
#pragma unroll
        for (int i = 0; i < 16; ++i) { ofin[0][i] += gi * o[0][i]; ofin[1][i] += gi * o[1][i]; }
    }
    if (!STORE) { asm volatile("" :: "v"(ofin[0]), "v"(ofin[1])); return; }
    WG_BAR();
#pragma unroll
    for (int db = 0; db < 2; ++db)
#pragma unroll
        for (int a = 0; a < 4; ++a) { u32x2 w; w.x = pkbf(ofin[db][4 * a], ofin[db][4 * a + 1]); w.y = pkbf(ofin[db][4 * a + 2], ofin[db][4 * a + 3]); *(LAS u32x2*)(lds + qloc * 528 + g * 128 + (32 * db + 8 * a + 4 * h) * 2) = w; }
    WG_BAR();
    { const int tid = wave * 64 + lane; bf16* obase = H1 + ((size_t)b * SEQ + 64 * qt) * 1536 + 512 + hkv * 256;
#pragma unroll
      for (int i = 0; i < 4; ++i) { const int piece = tid + 512 * i, row = piece >> 5, c = piece & 31; *(v4u*)(obase + (size_t)row * 1536 + 8 * c) = *(const LAS v4u*)(lds + row * 528 + 16 * c); } }
}
constexpr int ML_K = 0, ML_V = 32768, ML_VW = 65536, ML_C = 81920, ML_N = 114688, ML_SS = 115200, ML_WS = 116224, ML_GO = 120320, ML_ST = 135424;
DI int ml_fk(int s) { return ((s & 3) << 2) | ((s >> 2) & 3); }
DI void ml_load(LAS unsigned char* lds, int par, const char* kb, const char* vb, int wave, int lane) {
#pragma unroll
    for (int n2 = 0; n2 < 2; ++n2) { const int n = 2 * wave + n2, row = 4 * n + (lane >> 4), pc = lane & 15;
        const int kc = pc ^ ml_fk(row), vc = pc ^ ((row & 3) << 2);
        glds16(kb + (size_t)row * 2048 + 16 * kc, (unsigned)(size_t)(lds + ML_K + par * 16384 + n * 1024));
        glds16(vb + (size_t)row * 1024 + 16 * vc, (unsigned)(size_t)(lds + ML_V + par * 16384 + n * 1024)); }
}
DI bf16x8 ml_tr8(const LAS unsigned char* p) {
    const s16x4 lo = __builtin_amdgcn_ds_read_tr16_b64_v4i16((lds_s16x4*)p); const s16x4 hi = __builtin_amdgcn_ds_read_tr16_b64_v4i16((lds_s16x4*)(p + 1024));
    return __builtin_shufflevector(lo, hi, 0, 1, 2, 3, 4, 5, 6, 7);
}
template <int PM = 0xff>
DI void mlstm_unit2(Frame& F, int unit) {
    unsigned char* ws = F.ws; LAS unsigned char* lds = F.lds;
    int lane_ = F.lane_id();
    const int lane = lane_, wave = F.wave, tid = wave * 64 + lane, r = lane & 31, hh = lane >> 5, tb = wave >> 2, vb = wave & 3;
    const int b = unit >> 2, hd = unit & 3;
    const bf16* proj = (const bf16*)(ws + WS_PROJ); const bf16* mlqk = (const bf16*)(ws + WS_MLQK); bf16* H0 = (bf16*)(ws + WS_H0);
    const size_t tok0 = (size_t)b * SEQ;
    const char* kbase = (const char*)(mlqk + tok0 * 1024 + 512 + hd * 128); const char* vbase = (const char*)((const bf16*)(ws + WS_MLV) + tok0 * 512 + hd * 128);
    const float LOG2E = 1.4426950408889634f;
    const int i16 = lane & 15, q4 = i16 >> 2, p4 = i16 & 3, g1 = (lane >> 4) & 1;
    const int colsw = 16 * ((4 * vb + 2 * g1 + (p4 >> 1)) ^ (q4 << 2)) + 8 * (p4 & 1);
    const int base_c = (8 * hh + q4) * 256 + colsw;
    const int base_v = (4 * hh + q4) * 256 + colsw;
    const int fK = ml_fk(r), rowK = r * 256 + ((hh ^ (fK & 1)) << 4), F16 = (fK & 14) << 4;
    int base_kt[2][2];
#pragma unroll
    for (int blk = 0; blk < 2; ++blk)
#pragma unroll
        for (int hi = 0; hi < 2; ++hi) { const int kbp = 2 * tb + blk; base_kt[blk][hi] = (8 * hh + 4 * hi + q4) * 256 + 16 * ((4 * kbp + 2 * g1 + (p4 >> 1)) ^ ((q4 << 2) | ((2 * hh + hi) & 3))) + 8 * (p4 & 1); }
    LAS float* WS = (LAS float*)(lds + ML_WS) + wave * 128;
    LAS float* NV = (LAS float*)(lds + ML_N); LAS float* SS = (LAS float*)(lds + ML_SS);
    __syncthreads();
    for (int i = tid; i < 32768 / 16; i += 512) ((LAS v4u*)(lds + ML_C))[i] = (v4u){0u, 0u, 0u, 0u};
    if (tid < 128) NV[tid] = 0.f;
    f32x16 Cst[2];
#pragma unroll
    for (int i = 0; i < 16; ++i) { Cst[0][i] = 0.f; Cst[1][i] = 0.f; }
    if (tid < 128) ((LAS float*)(lds + ML_GO))[tid] = F.in[I_MLGOUT][hd * 128 + tid];
    const float bi = F.in[I_MLBI][hd], bfv = F.in[I_MLBF][hd];
    float m_prev = 0.f;
    ml_load(lds, 0, kbase, vbase, wave, lane);
    bf16x8 qf[8];
    { const bf16* qp = mlqk + (tok0 + 32 * tb + r) * 1024 + hd * 128 + 8 * hh;
#pragma unroll
      for (int st = 0; st < 8; ++st) qf[st] = *(const bf16x8*)(qp + 16 * st); }
    float gi_raw = bf2f(proj[(tok0 + lane) * NPROJ + PC_MLI + hd]), gf_raw = bf2f(proj[(tok0 + lane) * NPROJ + PC_MLF + hd]);
#pragma unroll 1
    for (int c = 0; c < 32; ++c) {
        const int par = c & 1; const size_t tokc = tok0 + 64 * c;
        WG_BAR();
        if ((PM & 1) && c > 0) {
            bf16* obase = H0 + (tokc - 64) * 1536 + hd * 128;
#pragma unroll
            for (int i = 0; i < 2; ++i) { const int piece = tid + 512 * i, row = piece >> 4, cc = piece & 15; *(v4u*)(obase + (size_t)row * 1536 + 8 * cc) = *(const LAS v4u*)(lds + ML_ST + row * 272 + 16 * cc); } }
        if (c < 31) ml_load(lds, par ^ 1, kbase + (size_t)(64 * (c + 1)) * 2048, vbase + (size_t)(64 * (c + 1)) * 1024, wave, lane);
        u32x2 og[4];
        { const bf16* op = proj + (tokc + 32 * tb + r) * NPROJ + PC_MLO + hd * 128 + 32 * vb + 4 * hh;
#pragma unroll
          for (int a = 0; a < 4; ++a) og[a] = *(const u32x2*)(op + 8 * a); }
        const float ig = gi_raw + bi, lf = logsig(gf_raw + bfv);
        float bc = lf;
        if (PM & 2) {
#pragma unroll
        for (int o = 1; o < 64; o <<= 1) { const float v = __shfl_up(bc, o); if (lane >= o) bc += v; } }
        const float rr = ig - bc;
        float cm = rr;
        if (PM & 2) {
#pragma unroll
        for (int o = 1; o < 64; o <<= 1) { const float v = __shfl_up(cm, o); if (lane >= o) cm = fmaxf(cm, v); } }
        const float M63 = fmaxf(m_prev, __shfl(cm, 63)), blast = __shfl(bc, 63);
        const float a_old = __expf(m_prev - M63), m_new = blast + M63;
        const int tl = 32 * tb + r;
        const float Mt = fmaxf(m_prev, __shfl(cm, tl)), bt = __shfl(bc, tl);
        const float inter = __expf(m_prev - Mt), m_t = bt + Mt;
        WS[lane] = rr * LOG2E; WS[64 + lane] = __expf(rr - M63);
        const float MtL = Mt * LOG2E;
        const LAS unsigned char* kbuf = lds + ML_K + par * 16384; const LAS unsigned char* vbuf = lds + ML_V + par * 16384;
        f32x16 wd[2]; float dsum = 0.f;
#pragma unroll
        for (int kb = 0; kb < 2; ++kb) {
#pragma unroll
            for (int i = 0; i < 16; ++i) wd[kb][i] = 0.f;
            if ((PM & 4) && kb <= tb) {
                f32x16 a = wd[kb]; bf16x8 kfr[8];
#pragma unroll
                for (int st = 0; st < 8; ++st) kfr[st] = *(const LAS bf16x8*)(kbuf + kb * 8192 + rowK + ((32 * st) ^ F16));
                SB();
#pragma unroll
                for (int st = 0; st < 8; ++st) a = MFMA32(kfr[st], qf[st], a);
#pragma unroll
                for (int i = 0; i < 16; ++i) { const int s = 32 * kb + crow(i, hh); const float e = __builtin_amdgcn_exp2f(WS[s] - MtL); const float w = (s <= tl) ? e * a[i] : 0.f; a[i] = w; dsum += w; }
                wd[kb] = a;
            }
        }
        f32x16 acc; bf16x8 cfr[8];
#pragma unroll
        for (int i = 0; i < 16; ++i) acc[i] = 0.f;
        if (PM & 8) {
#pragma unroll
        for (int st = 0; st < 8; ++st) cfr[st] = ml_tr8(lds + ML_C + base_c + st * 4096);
        SB();
#pragma unroll
        for (int st = 0; st < 8; ++st) acc = MFMA32(cfr[st], qf[st], acc); }
#pragma unroll
        for (int i = 0; i < 16; ++i) acc[i] *= inter;
#pragma unroll
        for (int kb = 0; kb < 2; ++kb) {
            if ((PM & 16) && kb <= tb) {
                const bf16x8 pf0 = pack8<0>(wd[kb]), pf1 = pack8<1>(wd[kb]);
                {
#pragma unroll
                  for (int s2 = 0; s2 < 2; ++s2) { const LAS unsigned char* p = vbuf + base_v + kb * 8192 + s2 * 4096;
                    const s16x4 lo = __builtin_amdgcn_ds_read_tr16_b64_v4i16((lds_s16x4*)p); const s16x4 hi = __builtin_amdgcn_ds_read_tr16_b64_v4i16((lds_s16x4*)(p + 2048));
                    const bf16x8 vf = __builtin_shufflevector(lo, hi, 0, 1, 2, 3, 4, 5, 6, 7);
                    acc = MFMA32(vf, s2 ? pf1 : pf0, acc); } }
            }
        }
        float qn_ = 0.f;
        if (PM & 32)
#pragma unroll
        for (int st = 0; st < 8; ++st) { const v4u qw = __builtin_bit_cast(v4u, qf[st]); const LAS float* np = NV + 16 * st + 8 * hh; const f32x4 n0 = *(const LAS f32x4*)np, n1 = *(const LAS f32x4*)(np + 4);
            qn_ = fmaf(__uint_as_float(qw.x << 16), n0[0], qn_); qn_ = fmaf(__uint_as_float(qw.x & 0xffff0000u), n0[1], qn_); qn_ = fmaf(__uint_as_float(qw.y << 16), n0[2], qn_); qn_ = fmaf(__uint_as_float(qw.y & 0xffff0000u), n0[3], qn_);
            qn_ = fmaf(__uint_as_float(qw.z << 16), n1[0], qn_); qn_ = fmaf(__uint_as_float(qw.z & 0xffff0000u), n1[1], qn_); qn_ = fmaf(__uint_as_float(qw.w << 16), n1[2], qn_); qn_ = fmaf(__uint_as_float(qw.w & 0xffff0000u), n1[3], qn_); }
        qn_ += __shfl_xor(qn_, 32); dsum += __shfl_xor(dsum, 32);
        const float den = inter * qn_ + dsum; const float rden = 1.f / fmaxf(fabsf(den), __expf(-m_t));
        float ssq = 0.f;
#pragma unroll
        for (int i = 0; i < 16; ++i) { acc[i] *= rden; ssq = fmaf(acc[i], acc[i], ssq); }
        ssq += __shfl_xor(ssq, 32);
        if (hh == 0) SS[vb * 64 + tl] = ssq;
        if (PM & 64)
#pragma unroll
        for (int k2 = 0; k2 < 2; ++k2) { const int ci = tid + 512 * k2, s = ci >> 4; const float w = WS[64 + s];
            const v4u x = *(const LAS v4u*)(vbuf + ci * 16); v4u y; const unsigned xs[4] = {x.x, x.y, x.z, x.w}; unsigned ys[4];
#pragma unroll
            for (int j = 0; j < 4; ++j) ys[j] = pkbf(__uint_as_float(xs[j] << 16) * w, __uint_as_float(xs[j] & 0xffff0000u) * w);
            y.x = ys[0]; y.y = ys[1]; y.z = ys[2]; y.w = ys[3]; *(LAS v4u*)(lds + ML_VW + ci * 16) = y; }
        asm volatile("s_waitcnt lgkmcnt(0)" ::: "memory"); __builtin_amdgcn_s_barrier(); asm volatile("" ::: "memory");
        if (c < 31) {
            const bf16* qp = mlqk + (tokc + 64 + 32 * tb + r) * 1024 + hd * 128 + 8 * hh;
#pragma unroll
            for (int st = 0; st < 8; ++st) qf[st] = *(const bf16x8*)(qp + 16 * st);
            gi_raw = bf2f(proj[(tokc + 64 + lane) * NPROJ + PC_MLI + hd]); gf_raw = bf2f(proj[(tokc + 64 + lane) * NPROJ + PC_MLF + hd]);
        }
        { const LAS float* GO = (const LAS float*)(lds + ML_GO) + 32 * vb + 4 * hh;
          const float rstd = rsqrtf(((SS[tl] + SS[64 + tl]) + (SS[128 + tl] + SS[192 + tl])) * (1.f / 128.f) + EPS);
#pragma unroll
          for (int a = 0; a < 4; ++a) { float o4[4]; const unsigned gw[2] = {og[a].x, og[a].y};
#pragma unroll
              for (int j = 0; j < 4; ++j) { const float ov = (j & 1) ? __uint_as_float(gw[j >> 1] & 0xffff0000u) : __uint_as_float(gw[j >> 1] << 16); o4[j] = acc[4 * a + j] * rstd * GO[8 * a + j] * sigm(ov); }
              u32x2 w; w.x = pkbf(o4[0], o4[1]); w.y = pkbf(o4[2], o4[3]); *(LAS u32x2*)(lds + ML_ST + tl * 272 + (32 * vb + 8 * a + 4 * hh) * 2) = w; } }
        if (PM & 128)
#pragma unroll
        for (int blk = 0; blk < 2; ++blk) {
            f32x16 cs = Cst[blk];
#pragma unroll
            for (int i = 0; i < 16; ++i) cs[i] *= a_old;
            bf16x8 afr[4], kfr2[4];
#pragma unroll
            for (int st = 0; st < 4; ++st) {
                afr[st] = ml_tr8(lds + ML_VW + base_c + st * 4096);
                const s16x4 lo = __builtin_amdgcn_ds_read_tr16_b64_v4i16((lds_s16x4*)(kbuf + base_kt[blk][0] + st * 4096)); const s16x4 hi = __builtin_amdgcn_ds_read_tr16_b64_v4i16((lds_s16x4*)(kbuf + base_kt[blk][1] + st * 4096));
                kfr2[st] = __builtin_shufflevector(lo, hi, 0, 1, 2, 3, 4, 5, 6, 7);
            }
            SB();
#pragma unroll
            for (int st = 0; st < 4; ++st) cs = MFMA32(afr[st], kfr2[st], cs);
            Cst[blk] = cs;
            const int kk = 32 * (2 * tb + blk) + r;
#pragma unroll
            for (int a = 0; a < 4; ++a) { u32x2 w; w.x = pkbf(cs[4 * a], cs[4 * a + 1]); w.y = pkbf(cs[4 * a + 2], cs[4 * a + 3]);
                *(LAS u32x2*)(lds + ML_C + kk * 256 + 16 * ((4 * vb + a) ^ ((r & 3) << 2)) + 8 * hh) = w; }
        }
        if ((PM & 64) && tid < 128) { float nv = NV[tid] * a_old;
#pragma unroll 8
            for (int s = 0; s < 64; ++s) { const unsigned short kvs = *(const LAS unsigned short*)(kbuf + s * 256 + 16 * ((tid >> 3) ^ ml_fk(s)) + 2 * (tid & 7)); nv = fmaf(WS[64 + s], bf2f(kvs), nv); }
            NV[tid] = nv; }
        m_prev = m_new;
    }
    __syncthreads();
    if (PM & 1) { bf16* obase = H0 + (tok0 + 64 * 31) * 1536 + hd * 128;
#pragma unroll
        for (int i = 0; i < 2; ++i) { const int piece = tid + 512 * i, row = piece >> 4, cc = piece & 15; *(v4u*)(obase + (size_t)row * 1536 + 8 * cc) = *(const LAS v4u*)(lds + ML_ST + row * 272 + 16 * cc); } }
    __syncthreads();
}
DI void mem_load(LAS unsigned char* lds, int par, const char* kb, const char* vb, int wave, int lane) {
#pragma unroll
    for (int n2 = 0; n2 < 2; ++n2) { const int n = 2 * wave + n2, row = 4 * n + (lane >> 4), pc = lane & 15;
        const int kc = pc ^ ml_fk(row), vc = pc ^ ((row & 3) << 2);
        glds16(kb + (size_t)row * 1024 + 16 * kc, (unsigned)(size_t)(lds + ML_K + par * 16384 + n * 1024));
        glds16(vb + (size_t)row * 2048 + 16 * vc, (unsigned)(size_t)(lds + ML_V + par * 16384 + n * 1024)); }
}
template <bool STORE = true, bool DMA = true, bool COMP = true>
DI void mem_unit(Frame& F, int unit) {
    unsigned char* ws = F.ws; LAS unsigned char* lds = F.lds;
    int lane_ = F.lane_id();
    const int lane = lane_, wave = F.wave, r = lane & 31, hh = lane >> 5;
    const int b = unit >> 5, hd = (unit >> 3) & 3, qt = unit & 7;
    const bf16* mqn = (const bf16*)(ws + WS_MQN); const bf16* memkn = (const bf16*)(ws + WS_MEMKN); const bf16* memkv = (const bf16*)(ws + WS_MEMKV); bf16* H2 = (bf16*)(ws + WS_H0);
    const size_t t = (size_t)b * SEQ + 256 * qt + 32 * wave + r;
    const char* kbase = (const char*)(memkn + (size_t)b * MEML * 512 + hd * 128); const char* vbase = (const char*)(memkv + (size_t)b * MEML * 1024 + 512 + hd * 128);
    const int i16 = lane & 15, q4 = i16 >> 2, p4 = i16 & 3, g1 = (lane >> 4) & 1;
    int base_v[4];
#pragma unroll
    for (int db = 0; db < 4; ++db) base_v[db] = (4 * hh + q4) * 256 + 16 * ((4 * db + 2 * g1 + (p4 >> 1)) ^ (q4 << 2)) + 8 * (p4 & 1);
    const int fK = ml_fk(r), rowK = r * 256 + ((hh ^ (fK & 1)) << 4), F16 = (fK & 14) << 4;
    bf16x8 qf[8];
#pragma unroll
    for (int st = 0; st < 8; ++st) qf[st] = *(const bf16x8*)(mqn + t * 512 + hd * 128 + 16 * st + 8 * hh);
    f32x16 o[4]; float l = 0.f;
#pragma unroll
    for (int db = 0; db < 4; ++db)
#pragma unroll
        for (int i = 0; i < 16; ++i) o[db][i] = 0.f;
    WG_BAR();
    if (DMA) mem_load(lds, 0, kbase, vbase, wave, lane);
#pragma unroll 1
    for (int tile = 0; tile < 4; ++tile) {
        const int par = tile & 1;
        WG_BAR();
        if (DMA && tile < 3) mem_load(lds, par ^ 1, kbase + (size_t)(64 * (tile + 1)) * 1024, vbase + (size_t)(64 * (tile + 1)) * 2048, wave, lane);
        const LAS unsigned char* kbuf = lds + ML_K + par * 16384; const LAS unsigned char* vbuf = lds + ML_V + par * 16384;
        if (COMP)
#pragma unroll
        for (int kb = 0; kb < 2; ++kb) {
            bf16x8 kf[8];
#pragma unroll
            for (int st = 0; st < 8; ++st) kf[st] = *(const LAS bf16x8*)(kbuf + kb * 8192 + rowK + ((32 * st) ^ F16));
            SB();
            f32x16 a;
#pragma unroll
            for (int i = 0; i < 16; ++i) a[i] = 0.f;
#pragma unroll
            for (int st = 0; st < 8; ++st) a = MFMA32(kf[st], qf[st], a);
            bf16x8 vf[2][4];
#pragma unroll
            for (int s2 = 0; s2 < 2; ++s2)
#pragma unroll
                for (int db = 0; db < 4; ++db) { const LAS unsigned char* p = vbuf + base_v[db] + kb * 8192 + s2 * 4096;
                    const s16x4 lo = __builtin_amdgcn_ds_read_tr16_b64_v4i16((lds_s16x4*)p); const s16x4 hi = __builtin_amdgcn_ds_read_tr16_b64_v4i16((lds_s16x4*)(p + 2048));
                    vf[s2][db] = __builtin_shufflevector(lo, hi, 0, 1, 2, 3, 4, 5, 6, 7); }
            SB();
#pragma unroll
            for (int i = 0; i < 16; ++i) { a[i] = __builtin_amdgcn_exp2f(a[i]); l += a[i]; }
            const bf16x8 pf0 = pack8<0>(a), pf1 = pack8<1>(a);
#pragma unroll
            for (int s2 = 0; s2 < 2; ++s2)
#pragma unroll
                for (int db = 0; db < 4; ++db) o[db] = MFMA32(vf[s2][db], s2 ? pf1 : pf0, o[db]);
        }
    }
    const float inv = 1.f / (l + __shfl_xor(l, 32));
    if (!STORE) {
#pragma unroll
        for (int db = 0; db < 4; ++db) asm volatile("" :: "v"(o[db]), "v"(inv));
        return; }
    WG_BAR();
#pragma unroll
    for (int db = 0; db < 4; ++db)
#pragma unroll
        for (int a = 0; a < 4; ++a) { u32x2 w; w.x = pkbf(o[db][4 * a] * inv, o[db][4 * a + 1] * inv); w.y = pkbf(o[db][4 * a + 2] * inv, o[db][4 * a + 3] * inv);
            *(LAS u32x2*)(lds + (32 * wave + r) * 272 + (32 * db + 8 * a + 4 * hh) * 2) = w; }
    WG_BAR();
    { const int tid = wave * 64 + lane; bf16* obase = H2 + ((size_t)b * SEQ + 256 * qt) * 1536 + 1024 + hd * 128;
#pragma unroll
      for (int i = 0; i < 8; ++i) { const int piece = tid + 512 * i, row = piece >> 4, c = piece & 15; *(v4u*)(obase + (size_t)row * 1536 + 8 * c) = *(const LAS v4u*)(lds + row * 272 + 16 * c); } }
}
DI int q_pop(Frame& F, unsigned* qc) {
    __syncthreads();
    if (F.tid_id() == 0) F.MISC[16] = atomicAdd(qc, 1u);
    __syncthreads();
    return (int)F.MISC[16];
}
template <bool ML, bool NSA, bool MEMA, bool MST = true, bool MDMA = true, bool MCOMP = true, bool NST = true, bool NCMP = true, bool NSEL = true, bool NWIN = true, int MLPM = 0xff>
DI void p5_queue(Frame& F, int cbase) {
    unsigned* qc = F.ctl + CW_QCTR + cbase;
    if (ML) {
#pragma unroll 1
        for (;;) { const int it = q_pop(F, qc); if (it >= 64) break; mlstm_unit2<MLPM>(F, it); }
    }
    if (NSA) {
#pragma unroll 1
        for (;;) { const int it = q_pop(F, qc + 64); if (it >= 1024) break; nsa_unit<NST, NCMP, NSEL, NWIN>(F, it); }
    }
    if (MEMA) {
#pragma unroll 1
        for (;;) { const int it = q_pop(F, qc + 128); if (it >= 512) break; mem_unit<MST, MDMA, MCOMP>(F, it); }
    }
    __syncthreads();
}
struct OneUnit { int pm; DI bool next(int i, pg8::Unit& u) const { if (i) return false; u.pm = pm; u.pn = 0; return true; } DI void a_ready(const pg8::Unit&) const {} DI void done(const pg8::Unit&) const {} };
DI void p2_compress(Frame& F) {
    unsigned char* ws = F.ws;
    if (F.G < 64 || F.bx >= 32) return;
    const int kv = F.bx >> 4, pm = F.bx & 15;
    typedef pg8::bf16_t b16;
    { pg8::GemmA g{(const b16*)(ws + WS_PROJ) + (kv ? PC_NVC : PC_NKC), (const b16*)(ws + WS_WC1) + (size_t)kv * 256 * 2048, 2048, 16 * NPROJ * 2, (size_t)NPROJ * 2, (size_t)128, (size_t)SEQ * NPROJ * 2};
      OneUnit S{pm};
      pg8::EpiBf16Silu E{(b16*)(ws + WS_HID) + (size_t)kv * 4096 * 256, 256, (const float*)(ws + WS_SMALL + SM_CBIAS) + kv * 256, 1};
      pg8::gemm_phase_ga<pg8::EpiBf16Silu, OneUnit, false, true>(F.lds, g, S, E, F.wave); }
    asm volatile("s_waitcnt vmcnt(0)" ::: "memory"); __syncthreads();
    const int lane = F.lane_id(), r = lane & 31, hh = lane >> 5;
    const int row = pm * 256 + F.wave * 32 + r, n = row & 127;
    const bf16* hid = (const bf16*)(ws + WS_HID) + (size_t)kv * 4096 * 256 + (size_t)row * 256 + 8 * hh;
    const bf16* w2t = (const bf16*)(ws + WS_SMALL + SM_W2T) + (size_t)kv * 64 * 256 + 8 * hh;
    f32x16 acc[2];
#pragma unroll
    for (int i = 0; i < 16; ++i) { acc[0][i] = 0.f; acc[1][i] = 0.f; }
#pragma unroll 4
    for (int st = 0; st < 16; ++st) { const bf16x8 hb = *(const bf16x8*)(hid + 16 * st);
        const bf16x8 w0 = *(const bf16x8*)(w2t + (size_t)r * 256 + 16 * st), w1 = *(const bf16x8*)(w2t + (size_t)(32 + r) * 256 + 16 * st);
        acc[0] = MFMA32(w0, hb, acc[0]); acc[1] = MFMA32(w1, hb, acc[1]); }
    if (kv == 0) {
        float ss = 0.f;
#pragma unroll
        for (int i = 0; i < 16; ++i) ss += acc[0][i] * acc[0][i] + acc[1][i] * acc[1][i];
        ss += __shfl_xor(ss, 32);
        const float rstd = rsqrtf(ss * (1.f / 64.f) + EPS);
        const float* rc = (const float*)(ws + WS_SMALL + SM_ROPEC); const float* rs = (const float*)(ws + WS_SMALL + SM_ROPES);
        const int pos = 16 * n + 31 < SEQ ? 16 * n + 31 : SEQ - 1;
#pragma unroll
        for (int i = 0; i < 16; ++i) { const int d = crow(i, hh); const float c = rc[pos * 32 + d], sn = rs[pos * 32 + d];
            const float y0 = acc[0][i] * rstd * F.in[I_NGK][d], y1 = acc[1][i] * rstd * F.in[I_NGK][32 + d];
            acc[0][i] = y0 * c - y1 * sn; acc[1][i] = y1 * c + y0 * sn; }
    }
    bf16* dst = (bf16*)(ws + (kv ? WS_VC : WS_KC)) + (size_t)row * 64 + 4 * hh;
#pragma unroll
    for (int db = 0; db < 2; ++db)
#pragma unroll
        for (int a = 0; a < 4; ++a) { u32x2 w; w.x = pkbf(acc[db][4 * a], acc[db][4 * a + 1]); w.y = pkbf(acc[db][4 * a + 2], acc[db][4 * a + 3]); if (n == 127) { w.x = 0u; w.y = 0u; }
            *(u32x2*)(dst + 32 * db + 8 * a) = w; }
}
DI void mlstm_unit(Frame& F, int unit) {
    unsigned char* ws = F.ws;
    const int b = unit >> 2, h = unit & 3, tid = F.tid_id(), kk = tid >> 7, c = tid & 127;
    const bf16* proj = (const bf16*)(ws + WS_PROJ); const bf16* mlqk = (const bf16*)(ws + WS_MLQK); bf16* H0 = (bf16*)(ws + WS_H0);
    LAS float* qs = (LAS float*)F.lds;
    LAS float* ks = qs + 16 * 128;
    LAS float* vs = ks + 16 * 128;
    LAS float* gi = vs + 16 * 128;
    LAS float* gf = gi + 16;
    LAS float* part = gf + 16;
    LAS float* pden = part + 2 * 4 * 128;
    LAS float* hb = pden + 8;
    float C[32], nn[32];
#pragma unroll
    for (int i = 0; i < 32; ++i) { C[i] = 0.f; nn[i] = 0.f; }
    float m = 0.f;
    const float bi = F.in[I_MLBI][h], bfv = F.in[I_MLBF][h];
    const float scale = 0.08838834764831845f;
#pragma unroll 1
    for (int t0 = 0; t0 < SEQ; t0 += 16) {
        __syncthreads();
        for (int i = tid; i < 16 * 128; i += 512) { const int s = i >> 7, d = i & 127; const size_t t = (size_t)b * SEQ + t0 + s;
            qs[i] = bf2f(mlqk[t * 1024 + h * 128 + d]); ks[i] = bf2f(mlqk[t * 1024 + 512 + h * 128 + d]); vs[i] = bf2f(proj[t * NPROJ + PC_MLV + h * 128 + d]); }
        if (tid < 16) { const size_t t = (size_t)b * SEQ + t0 + tid; gi[tid] = bf2f(proj[t * NPROJ + PC_MLI + h]) + bi; gf[tid] = logsig(bf2f(proj[t * NPROJ + PC_MLF + h]) + bfv); }
        __syncthreads();
#pragma unroll 1
        for (int s = 0; s < 16; ++s) {
            const float lf = gf[s], ig = gi[s];
            const float mn = fmaxf(lf + m, ig), a = __expf(lf + m - mn), bb = __expf(ig - mn);
            m = mn;
            const float v = vs[s * 128 + c];
            float pn = 0.f, pd = 0.f;
#pragma unroll
            for (int i = 0; i < 32; ++i) { const float kvv = ks[s * 128 + kk * 32 + i], qv = qs[s * 128 + kk * 32 + i];
                C[i] = a * C[i] + bb * kvv * v; nn[i] = a * nn[i] + bb * kvv; pn = fmaf(qv, C[i], pn); pd = fmaf(qv, nn[i], pd); }
            const int par = s & 1;
            part[(par * 4 + kk) * 128 + c] = pn; if (c == 0) pden[par * 4 + kk] = pd;
            __syncthreads();
            if (kk == 0) {
                const float num = (part[(par * 4 + 0) * 128 + c] + part[(par * 4 + 1) * 128 + c]) + (part[(par * 4 + 2) * 128 + c] + part[(par * 4 + 3) * 128 + c]);
                const float den = (pden[par * 4 + 0] + pden[par * 4 + 1]) + (pden[par * 4 + 2] + pden[par * 4 + 3]);
                hb[s * 128 + c] = num * scale / fmaxf(fabsf(den * scale), __expf(-mn));
            }
        }
        __syncthreads();
#pragma unroll
        for (int rr = 0; rr < 2; ++rr) { const int s = F.wave * 2 + rr; const size_t t = (size_t)b * SEQ + t0 + s;
            const float v0 = hb[s * 128 + F.lane_id()], v1 = hb[s * 128 + 64 + F.lane_id()];
            const float rstd = rsqrtf(wave_sum(v0 * v0 + v1 * v1) * (1.f / 128.f) + EPS);
            const float o0 = bf2f(proj[t * NPROJ + PC_MLO + h * 128 + F.lane_id()]), o1 = bf2f(proj[t * NPROJ + PC_MLO + h * 128 + 64 + F.lane_id()]);
            H0[t * 512 + h * 128 + F.lane_id()] = (bf16)f2bf(v0 * rstd * F.in[I_MLGOUT][h * 128 + F.lane_id()] * sigm(o0));
            H0[t * 512 + h * 128 + 64 + F.lane_id()] = (bf16)f2bf(v1 * rstd * F.in[I_MLGOUT][h * 128 + 64 + F.lane_id()] * sigm(o1)); }
    }
    __syncthreads();
}

DI void nsa_scores(const bf16* krow, bool valid, const LAS float* qs, float (&s)[4]) {
    s[0] = s[1] = s[2] = s[3] = 0.f;
    if (valid) {
#pragma unroll 2
        for (int c8 = 0; c8 < 8; ++c8) { const v4u kk = *(const v4u*)(krow + c8 * 8);
            const unsigned w[4] = {kk.x, kk.y, kk.z, kk.w};
#pragma unroll
            for (int j = 0; j < 4; ++j) { const float k0 = __uint_as_float(w[j] << 16), k1 = __uint_as_float(w[j] & 0xffff0000u); const int d = c8 * 8 + 2 * j;
#pragma unroll
                for (int g = 0; g < 4; ++g) s[g] = fmaf(k1, qs[g * 64 + d + 1], fmaf(k0, qs[g * 64 + d], s[g])); } }
    }
}
DI void nsa_wave(Frame& F, int item, LAS float* wl) {
    unsigned char* ws = F.ws; const int lane = F.lane_id();
    const int t = item >> 1, hkv = item & 1, b = t >> 11, tau = t & 2047;
    const bf16* proj = (const bf16*)(ws + WS_PROJ);
    const bf16* qn = (const bf16*)(ws + WS_QN); const bf16* ksn = (const bf16*)(ws + WS_KSN); const bf16* kwn = (const bf16*)(ws + WS_KWN);
    const bf16* kc = (const bf16*)(ws + WS_KC); const bf16* vc = (const bf16*)(ws + WS_VC); bf16* H1 = (bf16*)(ws + WS_H1);
    LAS float* qs = wl;
    LAS float* ps = wl + 256;
    LAS float* psum = wl + 768;
#pragma unroll
    for (int g = 0; g < 4; ++g) qs[g * 64 + lane] = bf2f(qn[(size_t)t * 512 + (hkv * 4 + g) * 64 + lane]);
    float ofin[4] = {0.f, 0.f, 0.f, 0.f};
    float gate[4][3];
#pragma unroll
    for (int g = 0; g < 4; ++g)
#pragma unroll
        for (int cidx = 0; cidx < 3; ++cidx) gate[g][cidx] = sigm(bf2f(proj[(size_t)t * NPROJ + PC_NG + (hkv * 4 + g) * 3 + cidx]));
    const int ncmp = tau >= 31 ? ((tau - 31) >> 4) + 1 : 0;
    {
        float l[4] = {0.f, 0.f, 0.f, 0.f}, o[4] = {0.f, 0.f, 0.f, 0.f};
        const size_t rbase = (size_t)(b * 2 + hkv) * 128;
#pragma unroll
        for (int blk = 0; blk < 2; ++blk) { const int n = blk * 64 + lane; const bool valid = n < ncmp; float s[4];
            nsa_scores(kc + (rbase + n) * 64, valid, qs, s);
#pragma unroll
            for (int g = 0; g < 4; ++g) { const float p = valid ? __expf(s[g]) : 0.f; l[g] += p; ps[g * 128 + n] = p; } }
        float inv[4];
#pragma unroll
        for (int g = 0; g < 4; ++g) { const float L = wave_sum(l[g]); inv[g] = L > 0.f ? 1.f / L : 0.f; }
#pragma unroll
        for (int blk = 0; blk < 2; ++blk) { const int n = blk * 64 + lane; psum[n] = (ps[0 * 128 + n] * inv[0] + ps[1 * 128 + n] * inv[1]) + (ps[2 * 128 + n] * inv[2] + ps[3 * 128 + n] * inv[3]); }
#pragma unroll 2
        for (int n = 0; n < ncmp; ++n) { const float vv = bf2f(vc[(rbase + n) * 64 + lane]);
#pragma unroll
            for (int g = 0; g < 4; ++g) o[g] = fmaf(ps[g * 128 + n], vv, o[g]); }
#pragma unroll
        for (int g = 0; g < 4; ++g) ofin[g] += gate[g][0] * o[g] * inv[g];
    }
    const int cur = tau >> 6;
    unsigned selmask = 0u;
    {
        float score = -3.0e38f;
        if (lane < 32) { const int j = lane; float imp = 0.f;
#pragma unroll
            for (int dn = -1; dn <= 3; ++dn) { const int n = 4 * j + dn; if (n >= 0 && n <= 126) imp += psum[n]; }
            const bool forced = (j == 0) || (j == cur) || (j == cur - 1);
            score = j > cur ? NEGF : imp + (forced ? 1.0e4f : 0.f); }
#pragma unroll 1
        for (int r = 0; r < 8; ++r) { const float mx = wave_max(score); const unsigned long long bal = __ballot(score == mx); const int win = __ffsll((long long)bal) - 1;
            selmask |= 1u << win; if (lane == win) score = -3.4e38f; }
    }
    {
        float l[4] = {0.f, 0.f, 0.f, 0.f}, o[4] = {0.f, 0.f, 0.f, 0.f};
#pragma unroll 1
        for (int j = 0; j <= cur; ++j) { if (!((selmask >> j) & 1u)) continue;
            const int kpos = 64 * j + lane; const bool valid = kpos <= tau; float s[4];
            nsa_scores(ksn + ((size_t)b * SEQ + kpos) * 128 + hkv * 64, valid, qs, s);
#pragma unroll
            for (int g = 0; g < 4; ++g) { const float p = valid ? __expf(s[g]) : 0.f; l[g] += p; ps[g * 128 + lane] = p; }
            const int nk = j == cur ? (tau & 63) + 1 : 64;
            const bf16* vb = proj + ((size_t)b * SEQ + 64 * j) * NPROJ + PC_NVS + hkv * 64 + lane;
#pragma unroll 2
            for (int k = 0; k < nk; ++k) { const float vv = bf2f(vb[(size_t)k * NPROJ]);
#pragma unroll
                for (int g = 0; g < 4; ++g) o[g] = fmaf(ps[g * 128 + k], vv, o[g]); } }
#pragma unroll
        for (int g = 0; g < 4; ++g) { const float L = wave_sum(l[g]); ofin[g] += gate[g][1] * o[g] * (L > 0.f ? 1.f / L : 0.f); }
    }
    {
        float l[4] = {0.f, 0.f, 0.f, 0.f}, o[4] = {0.f, 0.f, 0.f, 0.f};
        const int start = tau - 511 > 0 ? tau - 511 : 0;
#pragma unroll 1
        for (int base = start & ~63; base <= tau; base += 64) {
            const int kpos = base + lane; const bool valid = kpos >= start && kpos <= tau; float s[4];
            nsa_scores(kwn + ((size_t)b * SEQ + kpos) * 128 + hkv * 64, valid, qs, s);
#pragma unroll
            for (int g = 0; g < 4; ++g) { const float p = valid ? __expf(s[g]) : 0.f; l[g] += p; ps[g * 128 + lane] = p; }
            const int k0 = start > base ? start - base : 0, k1 = tau - base < 63 ? tau - base : 63;
            const bf16* vb = proj + ((size_t)b * SEQ + base) * NPROJ + PC_NVW + hkv * 64 + lane;
#pragma unroll 2
            for (int k = k0; k <= k1; ++k) { const float vv = bf2f(vb[(size_t)k * NPROJ]);
#pragma unroll
                for (int g = 0; g < 4; ++g) o[g] = fmaf(ps[g * 128 + k], vv, o[g]); } }
#pragma unroll
        for (int g = 0; g < 4; ++g) { const float L = wave_sum(l[g]); ofin[g] += gate[g][2] * o[g] * (L > 0.f ? 1.f / L : 0.f); }
    }
#pragma unroll
    for (int g = 0; g < 4; ++g) H1[(size_t)t * 512 + (hkv * 4 + g) * 64 + lane] = (bf16)f2bf(ofin[g]);
}
DI void mem_wave(Frame& F, int t, LAS float* wl) {
    unsigned char* ws = F.ws; const int lane = F.lane_id(); const int b = t >> 11;
    const bf16* mqn = (const bf16*)(ws + WS_MQN); const bf16* memkn = (const bf16*)(ws + WS_MEMKN); const bf16* memkv = (const bf16*)(ws + WS_MEMKV); bf16* H2 = (bf16*)(ws + WS_H2);
    LAS float* qs = wl;
    LAS float* ps = wl + 128;
#pragma unroll 1
    for (int h = 0; h < 4; ++h) {
        qs[lane] = bf2f(mqn[(size_t)t * 512 + h * 128 + lane]); qs[64 + lane] = bf2f(mqn[(size_t)t * 512 + h * 128 + 64 + lane]);
        float l = 0.f;
#pragma unroll 1
        for (int kq = 0; kq < 4; ++kq) { const int key = kq * 64 + lane; const bf16* kr = memkn + ((size_t)b * MEML + key) * 512 + h * 128; float s = 0.f;
#pragma unroll 2
            for (int c8 = 0; c8 < 16; ++c8) { const v4u kk = *(const v4u*)(kr + c8 * 8); const unsigned w[4] = {kk.x, kk.y, kk.z, kk.w};
#pragma unroll
                for (int j = 0; j < 4; ++j) s = fmaf(__uint_as_float(w[j] & 0xffff0000u), qs[c8 * 8 + 2 * j + 1], fmaf(__uint_as_float(w[j] << 16), qs[c8 * 8 + 2 * j], s)); }
            const float p = __expf(s); l += p; ps[key] = p; }
        const float inv = 1.f / wave_sum(l);
        float o0 = 0.f, o1 = 0.f;
        const bf16* vb = memkv + (size_t)b * MEML * 1024 + 512 + h * 128;
#pragma unroll 4
        for (int key = 0; key < MEML; ++key) { const float p = ps[key]; o0 = fmaf(p, bf2f(vb[(size_t)key * 1024 + lane]), o0); o1 = fmaf(p, bf2f(vb[(size_t)key * 1024 + 64 + lane]), o1); }
        H2[(size_t)t * 512 + h * 128 + lane] = (bf16)f2bf(o0 * inv); H2[(size_t)t * 512 + h * 128 + 64 + lane] = (bf16)f2bf(o1 * inv);
    }
}
DI void p5_mixers(Frame& F) {
    const int nml = F.G >= 128 ? 64 : 0;
#ifndef RPT_ML
#define RPT_ML 1
#endif
#ifndef RPT_NSA
#define RPT_NSA 1
#endif
#ifndef RPT_MEM
#define RPT_MEM 1
#endif
    if (F.bx < nml || nml == 0) { for (int rp = 0; rp < RPT_ML; ++rp) for (int u = F.bx; u < 64; u += (nml ? nml : F.G)) mlstm_unit2(F, u); }
    if (F.bx >= nml) {
        LAS float* wl = (LAS float*)(F.lds + F.wave * 4096);
        const int gw = (F.bx - nml) * NWAVES + F.wave, NGW = (F.G - nml) * NWAVES;
        for (int rp = 0; rp < RPT_NSA; ++rp) for (int u = F.bx - nml; u < 1024; u += F.G - nml) nsa_unit(F, u);
        __syncthreads();
        for (int rp = 0; rp < RPT_MEM; ++rp) for (int t = gw; t < MT; t += NGW) mem_wave(F, t, wl);
    }
}

DI void p8_router(Frame& F, int alt) {
    unsigned char* ws = F.ws + (size_t)alt * 3 * MiB; const int lane = F.lane_id(), tid = F.tid_id(), wave = F.wave, r = lane & 31, hh = lane >> 5;
    unsigned char* xn8 = (unsigned char*)(F.ws + WS_R1);
    int* tok_e = (int*)(ws + WS_ROUTE + RT_TOKE); int* tok_pos = (int*)(ws + WS_ROUTE + RT_TOKPOS); float* tok_w = (float*)(ws + WS_ROUTE + RT_TOKW);
    unsigned* gcnt = F.ctl + CW_ECNT + 64 * alt;
    const bf16* wrt = (const bf16*)(F.ws + WS_SMALL + SM_WRT);
    LAS unsigned char* img = F.lds;
    LAS float* part = (LAS float*)F.lds;
    LAS float* lg = (LAS float*)(F.lds + 4 * 64 * 33 * 4);
    LAS int* lcnt = (LAS int*)(F.lds + RING_BYTES + 1024);
    LAS int* lbase = lcnt + 32;
    LAS int* se = lbase + 32;
    LAS int* sp = se + 256;
    LAS float* sw = (LAS float*)(sp + 256);
    const float* gf = F.in[I_GFFN];
    for (int bt = F.bx; bt < MT / 64; bt += F.G) {
        __syncthreads();
        if (tid < 32) lcnt[tid] = 0;
        const f32x4* gr = (const f32x4*)gf + 4 * lane; const f32x4 g0 = gr[0], g1 = gr[1], g2 = gr[2], g3 = gr[3];
#pragma unroll 1
        for (int i0 = 0; i0 < 8; i0 += 4) {
            f32x4 v[4][4];
#pragma unroll
            for (int u = 0; u < 4; ++u) { const int t = bt * 64 + wave * 8 + i0 + u; const f32x4* xr = (const f32x4*)(F.out + (size_t)t * DM) + 4 * lane;
#pragma unroll
                for (int j = 0; j < 4; ++j) v[u][j] = xr[j]; }
#pragma unroll
            for (int u = 0; u < 4; ++u) { const int tl = wave * 8 + i0 + u, t = bt * 64 + tl; float sq = 0.f;
#pragma unroll
                for (int j = 0; j < 4; ++j) sq += (v[u][j].x * v[u][j].x + v[u][j].y * v[u][j].y) + (v[u][j].z * v[u][j].z + v[u][j].w * v[u][j].w);
                const float rstd = rsqrtf(wave_sum(sq) * (1.f / DM) + EPS);
                const f32x4 gg[4] = {g0, g1, g2, g3}; unsigned q[4]; unsigned bw[8];
#pragma unroll
                for (int j = 0; j < 4; ++j) { const float y0 = v[u][j].x * rstd * gg[j].x, y1 = v[u][j].y * rstd * gg[j].y, y2 = v[u][j].z * rstd * gg[j].z, y3 = v[u][j].w * rstd * gg[j].w;
                    bw[2 * j] = pk2(y0, y1); bw[2 * j + 1] = pk2(y2, y3);
                    int q8 = 0; q8 = __builtin_amdgcn_cvt_pk_fp8_f32(y0, y1, q8, false); q8 = __builtin_amdgcn_cvt_pk_fp8_f32(y2, y3, q8, true); q[j] = (unsigned)q8; }
                *((v4u*)(xn8 + (size_t)t * DM) + lane) = (v4u){q[0], q[1], q[2], q[3]};
                *(LAS v4u*)(img + tl * 2048 + 16 * ((2 * lane) ^ (tl & 15))) = (v4u){bw[0], bw[1], bw[2], bw[3]};
                *(LAS v4u*)(img + tl * 2048 + 16 * ((2 * lane + 1) ^ (tl & 15))) = (v4u){bw[4], bw[5], bw[6], bw[7]}; }
        }
        __syncthreads();
        {
            const int mb = wave & 1, kq = wave >> 1, trow = 32 * mb + r;
            f32x16 acc;
#pragma unroll
            for (int i = 0; i < 16; ++i) acc[i] = 0.f;
#pragma unroll 4
            for (int s2 = 0; s2 < 16; ++s2) { const int st = 16 * kq + s2;
                const bf16x8 xa = *(const LAS bf16x8*)(img + trow * 2048 + 16 * ((2 * st + hh) ^ (trow & 15)));
                const bf16x8 wh = *(const bf16x8*)(wrt + (size_t)r * 1024 + 16 * st + 8 * hh), wl = *(const bf16x8*)(wrt + 32 * 1024 + (size_t)r * 1024 + 16 * st + 8 * hh);
                acc = MFMA32(xa, wh, acc); acc = MFMA32(xa, wl, acc); }
            __syncthreads();
#pragma unroll
            for (int i = 0; i < 16; ++i) part[(kq * 64 + 32 * mb + crow(i, hh)) * 33 + r] = acc[i];
        }
        __syncthreads();
        for (int i = tid; i < 64 * 32; i += 512) { const int tk = i >> 5, e = i & 31; lg[tk * 33 + e] = ((part[(0 * 64 + tk) * 33 + e] + part[(1 * 64 + tk) * 33 + e]) + (part[(2 * 64 + tk) * 33 + e] + part[(3 * 64 + tk) * 33 + e])) + F.in[I_BR][e]; }
        __syncthreads();
        for (int i = 0; i < 8; ++i) {
            const int tl = wave * 8 + i, e = lane & 31;
            float sc = lg[tl * 33 + e]; int ek[4]; float vk[4];
#pragma unroll
            for (int rd = 0; rd < 4; ++rd) { const float mx = wave_max(sc); const unsigned long long bal = __ballot(sc == mx); const int win = (__ffsll((long long)bal) - 1) & 31;
                ek[rd] = win; vk[rd] = mx; if (e == win) sc = -3.4e38f; }
            const float e1 = __expf(vk[1] - vk[0]), e2 = __expf(vk[2] - vk[0]), e3 = __expf(vk[3] - vk[0]); const float inv = 1.f / (1.f + e1 + e2 + e3);
            if (lane == 0) {
                const float wk[4] = {inv, e1 * inv, e2 * inv, e3 * inv};
#pragma unroll
                for (int rd = 0; rd < 4; ++rd) { se[tl * 4 + rd] = ek[rd]; sw[tl * 4 + rd] = wk[rd]; sp[tl * 4 + rd] = atomicAdd((int*)&lcnt[ek[rd]], 1); }
            }
        }
        __syncthreads();
        if (tid < 32) lbase[tid] = (int)atomicAdd(&gcnt[tid], (unsigned)lcnt[tid]);
        __syncthreads();
        if (tid < 256) { const int t = bt * 64 + (tid >> 2), k = tid & 3; const int e = se[tid];
          tok_e[t * 4 + k] = e; tok_pos[t * 4 + k] = lbase[e] + sp[tid]; tok_w[t * 4 + k] = sw[tid]; }
    }
    __syncthreads();
}
DI int moe_tables(Frame& F, LAS int* pstart, LAS unsigned char* blk_e) {
    unsigned* gcnt = F.ctl + CW_ECNT;
    __syncthreads();
    if (F.wave == 0) {
        const int l = F.lane_id(); int pad = 0;
        if (l < NEXP) { const int cnt = (int)__hip_atomic_load(&gcnt[l], __ATOMIC_RELAXED, __HIP_MEMORY_SCOPE_AGENT); pad = (cnt + MOEB - 1) / MOEB * MOEB; }
        int inc = pad;
#pragma unroll
        for (int o = 1; o < 32; o <<= 1) { const int v = __shfl_up(inc, o); if (l >= o) inc += v; }
        if (l < NEXP) pstart[l] = inc - pad;
        if (l == NEXP - 1) pstart[NEXP] = inc;
    }
    __syncthreads();
    const int nblk = pstart[NEXP] / MOEB;
    for (int rb = F.tid_id(); rb < nblk; rb += 512) { int e = 0; while (e < NEXP - 1 && pstart[e + 1] <= rb * MOEB) ++e; blk_e[rb] = (unsigned char)e; }
    __syncthreads();
    return nblk;
}
DI void p9_scatter(Frame& F) {
    unsigned char* ws = F.ws; const int lane = F.lane_id();
    LAS int* pstart = (LAS int*)(F.lds + 65536); LAS unsigned char* blk_e = (LAS unsigned char*)(F.lds + 65536 + 256);
    moe_tables(F, pstart, blk_e);
    const unsigned char* xn8 = (const unsigned char*)(ws + WS_R1); unsigned char* aperm = (unsigned char*)(ws + WS_APERM);
    const int* tok_e = (const int*)(ws + WS_ROUTE + RT_TOKE); const int* tok_pos = (const int*)(ws + WS_ROUTE + RT_TOKPOS); const float* tok_w = (const float*)(ws + WS_ROUTE + RT_TOKW);
    int* tok_dest = (int*)(ws + WS_ROUTE + RT_TOKDEST); float* roww = (float*)(ws + WS_ROUTE + RT_ROWW);
    unsigned* gcnt = F.ctl + CW_ECNT;
    const int gw = F.bx * NWAVES + F.wave, NGW = F.G * NWAVES;
    for (int t4 = gw; t4 < MT / 4; t4 += NGW) {
        int dest = 0;
        if (lane < 16) { const int it = t4 * 16 + lane; dest = pstart[tok_e[it]] + tok_pos[it]; tok_dest[it] = dest; roww[dest] = tok_w[it]; }
        v4u v0[4];
#pragma unroll
        for (int q = 0; q < 4; ++q) { const v4u* src = (const v4u*)(xn8 + (size_t)(t4 * 4 + q) * DM); v0[q] = src[lane]; }
#pragma unroll
        for (int q = 0; q < 4; ++q)
#pragma unroll
            for (int k = 0; k < 4; ++k) { const int d = __shfl(dest, q * 4 + k); v4u* dst = (v4u*)(aperm + (size_t)d * DM); dst[lane] = v0[q]; }
    }
    for (int it = gw; it < NEXP * MOEB; it += NGW) { const int e = it >> 8, i = it & 255; const int cnt = (int)__hip_atomic_load(&gcnt[e], __ATOMIC_RELAXED, __HIP_MEMORY_SCOPE_AGENT); const int padded = (cnt + MOEB - 1) / MOEB * MOEB;
        if (i < padded - cnt) { const int dest = pstart[e] + cnt + i; v4u* dst = (v4u*)(aperm + (size_t)dest * DM); const v4u z = {0u, 0u, 0u, 0u}; dst[lane] = z; if (lane == 0) roww[dest] = 0.f; } }
}
DI void p12_combine(Frame& F) {
    unsigned char* ws = F.ws; const int lane = F.lane_id();
    const bf16* ybuf = (const bf16*)(ws + WS_APERM); const int* tok_dest = (const int*)(ws + WS_ROUTE + RT_TOKDEST);
    const int gw = F.bx * NWAVES + F.wave, NGW = F.G * NWAVES;
    for (int t2 = gw; t2 < MT / 2; t2 += NGW) {
        typedef int i32x4 __attribute__((ext_vector_type(4)));
        v4u w[2][4][2]; f32x4 a[2][2][2];
#pragma unroll
        for (int q = 0; q < 2; ++q) { const int t = 2 * t2 + q; const f32x4* orow = (const f32x4*)(F.out + (size_t)t * DM);
            const i32x4 d = *(const i32x4*)(tok_dest + t * 4); const int dd[4] = {d.x, d.y, d.z, d.w};
#pragma unroll
            for (int j = 0; j < 2; ++j) {
#pragma unroll
                for (int k = 0; k < 4; ++k) w[q][k][j] = *((const v4u*)(ybuf + (size_t)dd[k] * DM) + lane + 64 * j);
                a[q][j][0] = orow[2 * (lane + 64 * j)]; a[q][j][1] = orow[2 * (lane + 64 * j) + 1]; } }
#pragma unroll
        for (int q = 0; q < 2; ++q) { f32x4* orow = (f32x4*)(F.out + (size_t)(2 * t2 + q) * DM);
#pragma unroll
            for (int j = 0; j < 2; ++j) {
#pragma unroll
                for (int k = 0; k < 4; ++k) { const v4u ww = w[q][k][j];
                    a[q][j][0].x += __uint_as_float(ww.x << 16); a[q][j][0].y += __uint_as_float(ww.x & 0xffff0000u); a[q][j][0].z += __uint_as_float(ww.y << 16); a[q][j][0].w += __uint_as_float(ww.y & 0xffff0000u);
                    a[q][j][1].x += __uint_as_float(ww.z << 16); a[q][j][1].y += __uint_as_float(ww.z & 0xffff0000u); a[q][j][1].z += __uint_as_float(ww.w << 16); a[q][j][1].w += __uint_as_float(ww.w & 0xffff0000u); }
                orow[2 * (lane + 64 * j)] = a[q][j][0]; orow[2 * (lane + 64 * j) + 1] = a[q][j][1]; } }
    }
}

constexpr int N_PHASES = 13;
#ifndef MK_PER_PHASE
#define MK_PER_PHASE 0
#endif
__global__ void __launch_bounds__(NWAVES * 64, 2) fwd_kernel(Args args) {
    extern __shared__ __attribute__((aligned(16))) unsigned char lds_raw[];
    Frame F;
    F.lds = (LAS unsigned char*)lds_raw; F.MISC = (volatile LAS unsigned*)(F.lds + MISC_OFF);
    F.wave = __builtin_amdgcn_readfirstlane((int)(threadIdx.x >> 6)); F.G = gridDim.x; F.bx = blockIdx.x;
    F.ws = args.ws; F.ctl = (unsigned*)(args.ws + WS_CTL); F.in = args.in; F.out = args.out;
    unsigned char* ws = args.ws;
    for (int u = threadIdx.x; u < (LDS_BYTES - LDSCTL_OFF) / 4; u += NWAVES * 64) ((LAS unsigned*)(F.lds + LDSCTL_OFF))[u] = 0u;
    __syncthreads();
    const int lo = args.ph_lo, hi = args.ph_hi;
    XcdBarrier bar; bar.wv = F.wave; bar.bar = F.ctl + CW_BAR; bar.x = 0; bar.st = nullptr;
    if (hi - lo > 1) bar = xcd_barrier_post(F.ctl + CW_BAR, F.MISC + 8, F.wave);
#ifndef PH_MASK
#define PH_MASK 0x1fff
#endif
#define IN(k) (((PH_MASK >> (k)) & 1) && lo <= (k) && (k) < hi)
#define SEAM(k) do { if (IN(k) && IN((k) + 1)) xcd_barrier(bar); } while (0)
    typedef pg8::bf16_t b16;
#ifndef RPT_MASK
#define RPT_MASK 0
#endif
#define RPT(k) _Pragma("unroll") for (int rp_ = 0; rp_ < 1 + ((RPT_MASK >> (k)) & 1); ++rp_)
    if (IN(0)) { RPT(0) p0_prologue(F); } SEAM(0);
    if (IN(1)) RPT(1) {
        { pg8::Gemm8 g{(const unsigned char*)(ws + WS_U8), (const unsigned char*)(ws + WS_WIN8), MT, NF8, DM, 0x7f7f7f7f, 0x77777777}; pg8::StaticOrder S; S.init(MT, NF8, F.G, F.bx);
          pg8::EpiBf16Silu E{(b16*)(ws + WS_PROJ) + NB16, NPROJ, nullptr, 0};
          pg8::gemm_phase_f8<pg8::EpiBf16Silu, pg8::StaticOrder, true, true>(F.lds, g, S, E, F.wave); }
        { pg8::Gemm g{(const b16*)(ws + WS_R1), (const b16*)(ws + WS_WIN), MT, NB16, DM}; pg8::StaticOrder S; S.init(MT, NB16, F.G, F.bx);
          pg8::EpiBf16Silu E{(b16*)(ws + WS_PROJ), NPROJ, nullptr, 0};
          pg8::gemm_phase<pg8::EpiBf16Silu, pg8::StaticOrder, true, true>(F.lds, g, S, E, F.wave); }
        { pg8::Gemm g{(const b16*)(ws + WS_MEMN), (const b16*)(ws + WS_WMKV), MROWS, 1024, DM}; pg8::StaticOrder S; S.init(MROWS, 1024, F.G, (F.bx + 64) % F.G);
          pg8::EpiBf16Silu E{(b16*)(ws + WS_MEMKV), 1024, nullptr, 0};
          pg8::gemm_phase<pg8::EpiBf16Silu, pg8::StaticOrder, true, true>(F.lds, g, S, E, F.wave); }
    } SEAM(1);
    if (IN(2)) { RPT(2) { p2_compress(F); p2_prep(F); } }
    if (IN(2) && IN(5)) xcd_barrier(bar);
#ifndef RPT5_ML
#define RPT5_ML 0
#endif
#ifndef MLPROBE
#define MLPROBE 0xff
#endif
#ifndef NPROBE_ST
#define NPROBE_ST true
#endif
#ifndef NPROBE_CMP
#define NPROBE_CMP true
#endif
#ifndef NPROBE_SEL
#define NPROBE_SEL true
#endif
#ifndef NPROBE_WIN
#define NPROBE_WIN true
#endif
#ifndef MPROBE_ST
#define MPROBE_ST true
#endif
#ifndef MPROBE_DMA
#define MPROBE_DMA true
#endif
#ifndef MPROBE_COMP
#define MPROBE_COMP true
#endif
#ifndef RPT5_NSA
#define RPT5_NSA 0
#endif
#ifndef RPT5_MEM
#define RPT5_MEM 0
#endif
    if (IN(5)) { p5_queue<true, true, true>(F, 0);
        if (RPT5_ML || RPT5_NSA || RPT5_MEM) { xcd_barrier(bar); p5_queue<RPT5_ML != 0, RPT5_NSA != 0, RPT5_MEM != 0, MPROBE_ST, MPROBE_DMA, MPROBE_COMP, NPROBE_ST, NPROBE_CMP, NPROBE_SEL, NPROBE_WIN, MLPROBE>(F, 256); } } SEAM(5);
    if (IN(6)) RPT(6) {
        pg8::StaticOrder S; S.init(MT, DM, F.G, F.bx);
        pg8::Gemm g{(const b16*)(ws + WS_H0), (const b16*)(ws + WS_WBR), MT, DM, 1536};
        pg8::EpiMergeK E{(const b16*)(ws + WS_PROJ), (b16*)(ws + WS_R1)};
        pg8::gemm_phase<pg8::EpiMergeK, pg8::StaticOrder, true, true>(F.lds, g, S, E, F.wave);
    } SEAM(6);
    if (IN(7)) RPT(7) {
        pg8::Gemm g{(const b16*)(ws + WS_R1), (const b16*)(ws + WS_WOUT), MT, DM, DM}; pg8::StaticOrder S; S.init(MT, DM, F.G, F.bx);
        pg8::EpiRes E{F.in[I_X], F.out};
        pg8::gemm_phase<pg8::EpiRes, pg8::StaticOrder, true, true>(F.lds, g, S, E, F.wave);
    } SEAM(7);
    if (IN(8)) { p8_router(F, 0); if ((RPT_MASK >> 8) & 1) p8_router(F, 1); } SEAM(8);
    if (IN(9)) { RPT(9) p9_scatter(F); } SEAM(9);
    if (IN(10)) RPT(10) {
        LAS int* pstart = (LAS int*)(F.lds + RING_BYTES + 1024); LAS unsigned char* blk_e = (LAS unsigned char*)(F.lds + RING_BYTES + 1024 + 256);
        const int nblk = moe_tables(F, pstart, blk_e);
        pg8::Gemm8 g{(const unsigned char*)(ws + WS_APERM), (const unsigned char*)(ws + WS_WGU), CAP, NEXP * 2048, DM, 0x7f7f7f7f, 0x77777777};
        pg8::MoeOrder<8> S{nblk, F.G, F.bx, (const PG8_LAS unsigned char*)blk_e};
        pg8::EpiSwiglu E{(unsigned char*)(ws + WS_ACT), F.in[I_BGU]};
        pg8::gemm_phase_f8<pg8::EpiSwiglu, pg8::MoeOrder<8>, true, true>(F.lds, g, S, E, F.wave);
    } SEAM(10);
    if (IN(11)) RPT(11) {
        LAS int* pstart = (LAS int*)(F.lds + RING_BYTES + 1024); LAS unsigned char* blk_e = (LAS unsigned char*)(F.lds + RING_BYTES + 1024 + 256);
        const int nblk = moe_tables(F, pstart, blk_e);
        pg8::Gemm8 g{(const unsigned char*)(ws + WS_ACT), (const unsigned char*)(ws + WS_WDN), CAP, NEXP * DM, DFF, 0x7f7f7f7f, 0x77777777};
        pg8::MoeOrder<4> S{nblk, F.G, F.bx, (const PG8_LAS unsigned char*)blk_e};
        pg8::EpiDown E{(b16*)(ws + WS_APERM), F.in[I_BDN], (const float*)(ws + WS_ROUTE + RT_ROWW)};
        pg8::gemm_phase_f8<pg8::EpiDown, pg8::MoeOrder<4>, true, true>(F.lds, g, S, E, F.wave);
    } SEAM(11);
    if (IN(12)) { p12_combine(F); }
#undef IN
#undef SEAM
}

extern "C" void kernel_launch(void* const* d_in, const int* in_sizes, int n_in, void* d_out, int out_size, void* d_ws, size_t ws_size, hipStream_t stream) {
    static int grid = 0;
    if (grid == 0) {
        if (n_in != N_IN || out_size != MT * DM || ws_size < WS_END) { fprintf(stderr, "kernel_launch: unexpected shapes (n_in %d, out %d, ws %zu need %zu)\n", n_in, out_size, ws_size, (size_t)WS_END); grid = -1; return; }
        int dev = 0, cus = 0, per_cu = 0;
        if (hipGetDevice(&dev) != hipSuccess || hipDeviceGetAttribute(&cus, hipDeviceAttributeMultiprocessorCount, dev) != hipSuccess) { grid = -1; return; }
        if (hipFuncSetAttribute((const void*)fwd_kernel, hipFuncAttributeMaxDynamicSharedMemorySize, LDS_BYTES) != hipSuccess) { fprintf(stderr, "kernel_launch: hipFuncSetAttribute failed\n"); grid = -1; return; }
        if (hipOccupancyMaxActiveBlocksPerMultiprocessor(&per_cu, (const void*)fwd_kernel, NWAVES * 64, LDS_BYTES) != hipSuccess || per_cu < 1) { fprintf(stderr, "kernel_launch: occupancy query says %d\n", per_cu); }
        (void)hipGetLastError();
        grid = cus;
    }
    if (grid < 0) return;
    if (hipMemsetAsync((char*)d_ws + WS_CTL, 0, CTL_ZERO_BYTES, stream) != hipSuccess) return;
    Args a{};
    for (int i = 0; i < N_IN; ++i) a.in[i] = (const float*)d_in[i];
    a.out = (float*)d_out; a.ws = (unsigned char*)d_ws;
#if MK_PER_PHASE
    for (int p = 0; p < N_PHASES; ++p) { a.ph_lo = p; a.ph_hi = p + 1; a.li = 0; hipLaunchKernelGGL(fwd_kernel, dim3(grid), dim3(NWAVES * 64), LDS_BYTES, stream, a); }
#else
    a.ph_lo = 0; a.ph_hi = N_PHASES; a.li = 0;
    hipLaunchKernelGGL(fwd_kernel, dim3(grid), dim3(NWAVES * 64), LDS_BYTES, stream, a);
#endif
}
```

```cpp
#include <hip/hip_runtime.h>
#include <cstdio>
#include <cstdint>
namespace pg8 {
#define PG8_LAS __attribute__((address_space(3)))
typedef unsigned short bf16_t;
typedef short bf16x8 __attribute__((ext_vector_type(8)));
typedef float f32x4 __attribute__((ext_vector_type(4)));
typedef unsigned u32x4 __attribute__((ext_vector_type(4)));
constexpr int BM = 256, BK = 64, HALF = 128, HTB = HALF * BK * 2  , STAGE_BYTES = 8 * HTB, NXCD = 8, WGM = 8;

__host__ __device__ __forceinline__ int lds_byte(int r, int c) { const int st = (r >> 4) * 2 + (c >> 5), rr = r & 15, cc = c & 31, ob = rr * 64 + cc * 2; return st * 1024 + (ob ^ (((ob >> 9) & 1) << 5)); }
__host__ __device__ __forceinline__ void stage_rc(int b, int& R, int& C) { const int st = b / 1024, sb = b % 1024, swz = sb ^ (((sb >> 9) & 1) << 5); R = (st >> 1) * 16 + swz / 64; C = (st & 1) * 32 + (swz % 64) / 2; }
__host__ __device__ __forceinline__ int perm32(int rho) { const int n = rho >> 4, i = rho & 15; return 8 * (i >> 2) + 4 * n + (i & 3); }

struct Unit { int pm, pn; };
struct Gemm { const bf16_t* A; const bf16_t* Bt; int M, N, K; };

struct StaticOrder {
    int nM, nN, nwg, G, c;
    __host__ __device__ void init(int M, int N, int G_, int c_) { nM = M / BM; nN = N / BM; nwg = nM * nN; G = G_; c = c_; }
    __host__ __device__ bool next(int i, Unit& u) const {
        const long L = (long)i * G + c; if (L >= nwg) return false;
        int wgid = (int)L; { const int q = nwg / NXCD, r = nwg % NXCD, xcd = wgid % NXCD, off = wgid / NXCD; wgid = (xcd < r ? xcd * (q + 1) : r * (q + 1) + (xcd - r) * q) + off; }
        const int nig = WGM * nN, gid = wgid / nig, fm = gid * WGM, gsz = (nM - fm) < WGM ? (nM - fm) : WGM;
        u.pm = fm + ((wgid % nig) % gsz); u.pn = (wgid % nig) / gsz; return true;
    }
    __device__ __forceinline__ void a_ready(const Unit&) const {}
    __device__ __forceinline__ void done(const Unit&) const {}
};

__device__ __forceinline__ unsigned cvt_pk_bf16(float lo, float hi) { unsigned r; asm volatile("v_cvt_pk_bf16_f32 %0, %1, %2" : "=v"(r) : "v"(lo), "v"(hi)); return r; }
typedef float f32x2 __attribute__((ext_vector_type(2)));
__device__ __forceinline__ f32x2 gelu_pk(f32x2 v) {
    const f32x2 av = __builtin_elementwise_abs(v), d = av * 0.2316418882f + 1.0f;
    f32x2 t; t.x = __builtin_amdgcn_rcpf(d.x); t.y = __builtin_amdgcn_rcpf(d.y);
    f32x2 q = t * 0.5307027145f + (-0.7265760135f); q = q * t + 0.7107068705f; q = q * t + (-0.142248368f); q = q * t + 0.127414796f; q = q * t;
    const f32x2 s = (v * v) * (-0.72134752044f);
    f32x2 e; e.x = __builtin_amdgcn_exp2f(s.x); e.y = __builtin_amdgcn_exp2f(s.y);
    const f32x2 m = v * (q * e), r = v - m;
    f32x2 o; o.x = v.x < 0.f ? m.x : r.x; o.y = v.y < 0.f ? m.y : r.y; return o;
}

template <int ACT  > struct EpiBf16 {
    static constexpr bool PERM = true, AFTER_DRAIN = false; static_assert(ACT == 0 || ACT == 1, "EpiBf16: ACT is 0 (none) or 1 (gelu_pk)");
    bf16_t* O; int ldc; const float* bias; int split_cols; size_t split_stride; float scale0;
    __device__ __forceinline__ void operator()(const f32x4 (&acc)[2][2][4][2], const Unit& u, int wr, int wc, int fr, int fq) const {
        const int row0 = u.pm * BM + wr * 64 + fr; int colt = u.pn * BM; bf16_t* base = O;
        float sc = 1.f; if (split_cols) { const int t = colt / split_cols; base += (size_t)t * split_stride; colt -= t * split_cols; if (t == 0) sc = scale0; }
        const int col0 = colt + wc * 32 + 8 * fq, bcol0 = u.pn * BM + wc * 32 + 8 * fq;
        f32x4 bv[2][2];
#pragma unroll
        for (int bj = 0; bj < 2; ++bj)
#pragma unroll
            for (int n = 0; n < 2; ++n) bv[bj][n] = bias ? *(const f32x4*)(bias + bcol0 + bj * HALF + 4 * n) : (f32x4){0.f, 0.f, 0.f, 0.f};
#pragma unroll
        for (int ai = 0; ai < 2; ++ai)
#pragma unroll
            for (int m = 0; m < 4; ++m) { bf16_t* rowp = base + (size_t)(row0 + ai * HALF + m * 16) * ldc + col0;
#pragma unroll
                for (int bj = 0; bj < 2; ++bj) { f32x4 v0 = acc[ai][bj][m][0] + bv[bj][0], v1 = acc[ai][bj][m][1] + bv[bj][1];
                    if (ACT == 1) { f32x2 a = gelu_pk((f32x2){v0[0], v0[1]}), b = gelu_pk((f32x2){v0[2], v0[3]}), c = gelu_pk((f32x2){v1[0], v1[1]}), d = gelu_pk((f32x2){v1[2], v1[3]});
                        v0 = (f32x4){a.x, a.y, b.x, b.y}; v1 = (f32x4){c.x, c.y, d.x, d.y}; }
                    v0 = v0 * sc; v1 = v1 * sc; u32x4 w; w.x = cvt_pk_bf16(v0[0], v0[1]); w.y = cvt_pk_bf16(v0[2], v0[3]); w.z = cvt_pk_bf16(v1[0], v1[1]); w.w = cvt_pk_bf16(v1[2], v1[3]);
                    *(u32x4*)(rowp + bj * HALF) = w; } }
    }
};

struct PanelStats {
    unsigned* xbuf;
    unsigned* cnt;
    unsigned* tmo;
    int ntn; float eps;
    unsigned code;
    __device__ __forceinline__ bool run(const f32x4 (&v)[2][2][4][2], const Unit& u, int wr, int wc, int fr, int fq, PG8_LAS unsigned char* lds, int wid, int lane) const {
        typedef float f32x2v __attribute__((ext_vector_type(2)));
        PG8_LAS f32x2v* P = (PG8_LAS f32x2v*)lds;
        PG8_LAS f32x2v* S = (PG8_LAS f32x2v*)(lds + 8192);
        PG8_LAS unsigned* flag = (PG8_LAS unsigned*)(lds + 8192 + 2048);
#pragma unroll
        for (int ai = 0; ai < 2; ++ai)
#pragma unroll
            for (int m = 0; m < 4; ++m) {
                float s = 0.f;
#pragma unroll
                for (int bj = 0; bj < 2; ++bj)
#pragma unroll
                    for (int n = 0; n < 2; ++n) { const f32x4 x = v[ai][bj][m][n]; s += (x[0] + x[1]) + (x[2] + x[3]); }
                s += __shfl_xor(s, 16); s += __shfl_xor(s, 32);
                const float mw = s * (1.0f / 64.0f); float q = 0.f;
#pragma unroll
                for (int bj = 0; bj < 2; ++bj)
#pragma unroll
                    for (int n = 0; n < 2; ++n) { const f32x4 d = v[ai][bj][m][n] - mw; q += (d[0] * d[0] + d[1] * d[1]) + (d[2] * d[2] + d[3] * d[3]); }
                q += __shfl_xor(q, 16); q += __shfl_xor(q, 32);
                if (fq == 0) P[(ai * HALF + wr * 64 + m * 16 + fr) * 4 + wc] = (f32x2v){mw, q};
            }
        asm volatile("s_waitcnt lgkmcnt(0)" ::: "memory"); __builtin_amdgcn_s_barrier(); asm volatile("" ::: "memory");
#if defined(BROKEN_EXCHANGE_NO_WAIT)
#warning BROKEN CONTROL BUILD: the row-statistics exchange does not wait; results are wrong by design
        if (blockIdx.x >= 64) { const long long t0_ = clock64(); while (clock64() - t0_ < 60000) __builtin_amdgcn_s_sleep(8); }
#endif
        const int row = wid * 32 + (lane & 31);
        if (lane < 32) {
            const f32x2v a = P[row * 4 + 0], b = P[row * 4 + 1], c = P[row * 4 + 2], d = P[row * 4 + 3];
            const float mt = (a.x + b.x + c.x + d.x) * 0.25f;
            const float da = a.x - mt, db = b.x - mt, dc = c.x - mt, dd = d.x - mt;
            const float m2 = (a.y + b.y) + (c.y + d.y) + 64.0f * ((da * da + db * db) + (dc * dc + dd * dd));
            unsigned long long* slot = (unsigned long long*)xbuf + ((size_t)(u.pm * BM + row) * 4 + u.pn);
            __hip_atomic_store(slot, ((unsigned long long)__float_as_uint(m2) << 32) | __float_as_uint(mt), __ATOMIC_RELAXED, __HIP_MEMORY_SCOPE_AGENT);
        }
        asm volatile("s_waitcnt vmcnt(0)" ::: "memory");
        if (lane == 0) __hip_atomic_fetch_add(cnt + 64 * u.pm, 1u, __ATOMIC_RELAXED, __HIP_MEMORY_SCOPE_AGENT);
        if (wid == 0) {
            bool dead = false; const unsigned long long t0 = __builtin_amdgcn_s_memrealtime(); const unsigned want = 8u * (unsigned)ntn;
            for (;;) {
#if defined(BROKEN_EXCHANGE_NO_WAIT)
                break;
#endif
                if ((unsigned)__builtin_amdgcn_readfirstlane(__hip_atomic_load(cnt + 64 * u.pm, __ATOMIC_RELAXED, __HIP_MEMORY_SCOPE_AGENT)) >= want) break;
                if (__builtin_amdgcn_s_memrealtime() - t0 > 2000000ull) {
                    if (lane == 0) { unsigned expect = 0u; __hip_atomic_compare_exchange_strong(tmo + 1, &expect, code | (unsigned)(u.pm & 0xff), __ATOMIC_RELAXED, __ATOMIC_RELAXED, __HIP_MEMORY_SCOPE_AGENT);
                                     __hip_atomic_store(tmo, 1u, __ATOMIC_RELAXED, __HIP_MEMORY_SCOPE_AGENT); }
                    dead = true; break; }
                __builtin_amdgcn_s_sleep(2);
            }
            __builtin_amdgcn_fence(__ATOMIC_ACQUIRE, "agent");
            if (lane == 0) flag[0] = dead ? 1u : 0u;
        }
        asm volatile("s_waitcnt vmcnt(0) lgkmcnt(0)" ::: "memory"); __builtin_amdgcn_s_barrier(); asm volatile("" ::: "memory");
        const bool bad = flag[0] != 0u;
        if (lane < 32) {
            const unsigned long long* slot = (const unsigned long long*)xbuf + (size_t)(u.pm * BM + row) * 4; float mt[4], m2[4]; float ms = 0.f;
#pragma unroll
            for (int t = 0; t < 4; ++t) { if (t < ntn) { const unsigned long long w = __hip_atomic_load(slot + t, __ATOMIC_RELAXED, __HIP_MEMORY_SCOPE_AGENT); mt[t] = __uint_as_float((unsigned)w); m2[t] = __uint_as_float((unsigned)(w >> 32)); } else { mt[t] = 0.f; m2[t] = 0.f; } ms += mt[t]; }
            const float mean = ms / (float)ntn; float q = 0.f;
#pragma unroll
            for (int t = 0; t < 4; ++t) if (t < ntn) { const float dm = mt[t] - mean; q += m2[t] + 256.0f * dm * dm; }
            S[row] = (f32x2v){mean, 1.0f / sqrtf(q / (256.0f * (float)ntn) + eps)};
        }
        asm volatile("s_waitcnt lgkmcnt(0)" ::: "memory"); __builtin_amdgcn_s_barrier(); asm volatile("" ::: "memory");
        return bad;
    }
};
struct EpiLnRes {
    static constexpr bool PERM = false, AFTER_DRAIN = true;
    const float* base; float* out; int ldc; const float* bias; PanelStats st; unsigned poison;
    __device__ __forceinline__ void fused(f32x4 (&acc)[2][2][4][2], const Unit& u, int wr, int wc, int fr, int fq, PG8_LAS unsigned char* lds, int wid, int lane) const {
        typedef float f32x2v __attribute__((ext_vector_type(2)));
        const PG8_LAS f32x2v* S = (const PG8_LAS f32x2v*)(lds + 8192);
        const int col0 = u.pn * BM + wc * 32 + 4 * fq;
#pragma unroll
        for (int bj = 0; bj < 2; ++bj)
#pragma unroll
            for (int n = 0; n < 2; ++n) { const f32x4 bv = bias ? *(const f32x4*)(bias + col0 + bj * HALF + n * 16) : (f32x4){0.f, 0.f, 0.f, 0.f};
#pragma unroll
                for (int ai = 0; ai < 2; ++ai)
#pragma unroll
                    for (int m = 0; m < 4; ++m) acc[ai][bj][m][n] += bv; }
        f32x4 pre[4][2][2];
#pragma unroll
        for (int m = 0; m < 4; ++m) { const size_t off = (size_t)(u.pm * BM + wr * 64 + m * 16 + fr) * ldc + col0;
#pragma unroll
            for (int bj = 0; bj < 2; ++bj)
#pragma unroll
                for (int n = 0; n < 2; ++n) pre[m][bj][n] = *(const f32x4*)(base + off + bj * HALF + n * 16); }
        const bool bad = st.run(acc, u, wr, wc, fr, fq, lds, wid, lane) || poison != 0u;
        const float qnan = __builtin_nanf("");
#pragma unroll
        for (int ai = 0; ai < 2; ++ai)
#pragma unroll
            for (int m = 0; m < 4; ++m) { const int r = ai * HALF + wr * 64 + m * 16 + fr; const f32x2v sr = S[r]; const size_t off = (size_t)(u.pm * BM + r) * ldc + col0;
#pragma unroll
                for (int bj = 0; bj < 2; ++bj)
#pragma unroll
                    for (int n = 0; n < 2; ++n) { const f32x4 bs = ai == 0 ? pre[m][bj][n] : *(const f32x4*)(base + off + bj * HALF + n * 16); f32x4 o = bs + (acc[ai][bj][m][n] - sr.x) * sr.y;
                        if (bad) o = (f32x4){qnan, qnan, qnan, qnan}; *(f32x4*)(out + off + bj * HALF + n * 16) = o; }
                if (m & 1) asm volatile("" ::: "memory"); }
    }
};
struct EpiLnResLn {
    static constexpr bool PERM = false, AFTER_DRAIN = true;
    const float* base; float* out; bf16_t* xn; int ldc; const float* bias; PanelStats st1, st2; unsigned poison;
    __device__ __forceinline__ void fused(f32x4 (&acc)[2][2][4][2], const Unit& u, int wr, int wc, int fr, int fq, PG8_LAS unsigned char* lds, int wid, int lane) const {
        typedef float f32x2v __attribute__((ext_vector_type(2))); typedef unsigned u32x2v __attribute__((ext_vector_type(2)));
        const PG8_LAS f32x2v* S = (const PG8_LAS f32x2v*)(lds + 8192);
        const int col0 = u.pn * BM + wc * 32 + 4 * fq;
#pragma unroll
        for (int bj = 0; bj < 2; ++bj)
#pragma unroll
            for (int n = 0; n < 2; ++n) { const f32x4 bv = bias ? *(const f32x4*)(bias + col0 + bj * HALF + n * 16) : (f32x4){0.f, 0.f, 0.f, 0.f};
#pragma unroll
                for (int ai = 0; ai < 2; ++ai)
#pragma unroll
                    for (int m = 0; m < 4; ++m) acc[ai][bj][m][n] += bv; }
        bool bad = st1.run(acc, u, wr, wc, fr, fq, lds, wid, lane) || poison != 0u;
        const float qnan = __builtin_nanf("");
#pragma unroll
        for (int ai = 0; ai < 2; ++ai)
#pragma unroll
            for (int m = 0; m < 4; ++m) { const int r = ai * HALF + wr * 64 + m * 16 + fr; const f32x2v sr = S[r]; const size_t off = (size_t)(u.pm * BM + r) * ldc + col0;
#pragma unroll
                for (int bj = 0; bj < 2; ++bj)
#pragma unroll
                    for (int n = 0; n < 2; ++n) { const f32x4 bs = *(const f32x4*)(base + off + bj * HALF + n * 16); acc[ai][bj][m][n] = bs + (acc[ai][bj][m][n] - sr.x) * sr.y; }
                asm volatile("" : "+v"(acc[ai][0][m][0]), "+v"(acc[ai][0][m][1]), "+v"(acc[ai][1][m][0]), "+v"(acc[ai][1][m][1]));
                if (m & 1) asm volatile("" ::: "memory"); }
        const bool bad1 = bad;
        bad = st2.run(acc, u, wr, wc, fr, fq, lds, wid, lane) || bad;
#pragma unroll
        for (int ai = 0; ai < 2; ++ai)
#pragma unroll
            for (int m = 0; m < 4; ++m) { const int r = ai * HALF + wr * 64 + m * 16 + fr; const f32x2v sr = S[r]; const size_t off = (size_t)(u.pm * BM + r) * ldc + col0;
#pragma unroll
                for (int bj = 0; bj < 2; ++bj)
#pragma unroll
                    for (int n = 0; n < 2; ++n) { const f32x4 x1 = acc[ai][bj][m][n]; *(f32x4*)(out + off + bj * HALF + n * 16) = bad1 ? (f32x4){qnan, qnan, qnan, qnan} : x1;
                        const f32x4 o = (x1 - sr.x) * sr.y; u32x2v w; w.x = cvt_pk_bf16(o[0], o[1]); w.y = cvt_pk_bf16(o[2], o[3]);
                        if (bad) { w.x = 0x7fc07fc0u; w.y = 0x7fc07fc0u; } *(u32x2v*)(xn + off + bj * HALF + n * 16) = w; }
                asm volatile("" ::: "memory"); }
    }
};

template <class E, class = void> struct Perm2 { static constexpr bool v = false; };
template <class E> struct Perm2<E, decltype((void)E::PERM2)> { static constexpr bool v = E::PERM2; };
template <class E, class = void> struct MidSeg { static constexpr int v = 0; };
template <class E> struct MidSeg<E, decltype((void)E::MIDSEG)> { static constexpr int v = E::MIDSEG; };
template <class Epi, class Sched, bool ALIGN_EPI = false, bool SP2 = false>
__device__ __forceinline__ void gemm_phase(PG8_LAS unsigned char* lds, const Gemm g, const Sched& S, const Epi& E, int wid_in) {
    int lane_; asm volatile("v_mbcnt_lo_u32_b32 %0, -1, 0\n\tv_mbcnt_hi_u32_b32 %0, -1, %0" : "=v"(lane_));
    const int wid = wid_in, lane = lane_, tid = wid * 64 + lane, wr = wid >> 2, wc = wid & 3, fr = lane & 15, fq = lane >> 4;
    const int K = g.K, nt = K / BK;
    unsigned voffA[2], voffB[2];
#pragma unroll
    for (int i = 0; i < 2; ++i) { int R, C; stage_rc(tid * 16 + i * 8192, R, C); const int Rb = Perm2<Epi>::v ? (64 * (R >> 5) + 16 * ((R >> 2) & 3) + 4 * ((R >> 4) & 1) + (R & 3)) : Epi::PERM ? ((R & ~31) + perm32(R & 31)) : R;
        voffA[i] = (unsigned)(R * K + C) * 2u; voffB[i] = (unsigned)(Rb * K + C) * 2u; }
    const size_t kstep = (size_t)(BK * 2);
    const size_t hstep = (size_t)HALF * K * 2;
    const size_t hstepB = Perm2<Epi>::v ? (size_t)8 * K * 2 : hstep;
    const size_t tstep = 2 * hstep;
    const unsigned ldsw = (unsigned)wid * 1024u;
    const int aoff = lds_byte(wr * 64 + fr, fq * 8), boff = lds_byte(wc * 32 + fr, fq * 8);
#define PG8_SA(b, h) (((b) * 2 + (h)) * HTB)
#define PG8_SB(b, h) ((4 + (b) * 2 + (h)) * HTB)
#define PG8_STAGE(bufoff, gbase, voff) do { _Pragma("unroll") for (int _i = 0; _i < 2; ++_i) \
        __builtin_amdgcn_global_load_lds((const unsigned*)((const char*)(gbase) + (voff)[_i]), (PG8_LAS unsigned*)(lds + (bufoff) + ldsw + _i * 8192), 16, 0, 0); } while (0)
#define PG8_LDA(dst, b, h) do { _Pragma("unroll") for (int m = 0; m < 4; ++m) _Pragma("unroll") for (int k = 0; k < 2; ++k) dst[m][k] = *(const PG8_LAS bf16x8*)(lds + PG8_SA(b, h) + aoff + m * 2048 + k * 1024); } while (0)
#define PG8_LDB(dst, b, h) do { _Pragma("unroll") for (int n = 0; n < 2; ++n) _Pragma("unroll") for (int k = 0; k < 2; ++k) dst[n][k] = *(const PG8_LAS bf16x8*)(lds + PG8_SB(b, h) + boff + n * 2048 + k * 1024); } while (0)
#define PG8_MMA(ai, bj, At, Bt) do { __builtin_amdgcn_s_setprio(1); _Pragma("unroll") for (int m = 0; m < 4; ++m) _Pragma("unroll") for (int n = 0; n < 2; ++n) _Pragma("unroll") for (int k = 0; k < 2; ++k) \
        acc[ai][bj][m][n] = __builtin_amdgcn_mfma_f32_16x16x32_bf16(Bt[n][k], At[m][k], acc[ai][bj][m][n], 0, 0, 0); __builtin_amdgcn_s_setprio(0); } while (0)
#define PG8_WAIT_V(n) asm volatile("s_waitcnt vmcnt(" #n ")" ::: "memory")
#define PG8_WAIT_L(n) asm volatile("s_waitcnt lgkmcnt(" #n ")" ::: "memory")
#define PG8_BAR __builtin_amdgcn_s_barrier()
#define PG8_SCHED __builtin_amdgcn_sched_barrier(0)
    Unit cur, nxt; int ui = 0;
    if (!S.next(0, cur)) return;
    f32x4 acc[2][2][4][2];
#pragma unroll
    for (int a = 0; a < 2; ++a)
#pragma unroll
        for (int b = 0; b < 2; ++b)
#pragma unroll
            for (int m = 0; m < 4; ++m)
#pragma unroll
                for (int n = 0; n < 2; ++n) acc[a][b][m][n] = (f32x4){0.f, 0.f, 0.f, 0.f};
    bf16x8 At[4][2], B0[2][2], B1[2][2];
    const char* cA = (const char*)g.A + (size_t)cur.pm * tstep; const char* cB = (const char*)g.Bt + (size_t)cur.pn * tstep;
    S.a_ready(cur);
    if constexpr (SP2) {
        PG8_STAGE(PG8_SB(0, 0), cB, voffB); PG8_STAGE(PG8_SB(0, 1), cB + hstepB, voffB); PG8_STAGE(PG8_SA(0, 0), cA, voffA); PG8_STAGE(PG8_SA(0, 1), cA + hstep, voffA);
        if (wr == 1) PG8_BAR;
        PG8_WAIT_V(2); PG8_BAR;
        PG8_STAGE(PG8_SB(1, 0), cB + kstep, voffB); PG8_STAGE(PG8_SA(1, 0), cA + kstep, voffA); PG8_STAGE(PG8_SB(1, 1), cB + hstepB + kstep, voffB);
        PG8_WAIT_V(6); PG8_BAR;
    } else {
        PG8_STAGE(PG8_SB(0, 0), cB, voffB); PG8_STAGE(PG8_SA(0, 0), cA, voffA); PG8_STAGE(PG8_SB(0, 1), cB + hstepB, voffB); PG8_STAGE(PG8_SA(0, 1), cA + hstep, voffA);
        if (wr == 1) PG8_BAR;
        PG8_WAIT_V(4); PG8_BAR;
        PG8_STAGE(PG8_SB(1, 0), cB + kstep, voffB); PG8_STAGE(PG8_SA(1, 0), cA + kstep, voffA); PG8_STAGE(PG8_SB(1, 1), cB + hstepB + kstep, voffB);
        PG8_WAIT_V(6); PG8_BAR;
    }
    for (;;) {
        const bool has_next = S.next(ui + 1, nxt);
        const char* nA = has_next ? (const char*)g.A + (size_t)nxt.pm * tstep : cA; const char* nB = has_next ? (const char*)g.Bt + (size_t)nxt.pn * tstep : cB;
        for (int t = 0; t < nt; t += 2) {
            if constexpr (MidSeg<Epi>::v > 0) { if (t > 0 && t % MidSeg<Epi>::v == 0) E.mid(acc, cur, t / MidSeg<Epi>::v, wr, wc, fr, fq); }
            const bool last = (t == nt - 2);
            const char* a1 = cA + (size_t)(t + 1) * kstep;
            const char* a2 = last ? nA : cA + (size_t)(t + 2) * kstep; const char* b2 = last ? nB : cB + (size_t)(t + 2) * kstep;
            const char* a3 = a2 + kstep; const char* b3 = b2 + kstep;
            if (last && has_next) S.a_ready(nxt);
            if constexpr (SP2) {
            PG8_LDB(B0, 0, 0); PG8_LDB(B1, 0, 1); PG8_SCHED; PG8_LDA(At, 0, 0); PG8_STAGE(PG8_SA(1, 1), a1 + hstep, voffA);
            PG8_WAIT_V(8); PG8_WAIT_L(0); PG8_BAR; PG8_MMA(0, 0, At, B0); PG8_MMA(0, 1, At, B1); PG8_BAR; PG8_SCHED;
            PG8_LDA(At, 0, 1); PG8_STAGE(PG8_SB(0, 0), b2, voffB); PG8_STAGE(PG8_SB(0, 1), b2 + hstepB, voffB); PG8_STAGE(PG8_SA(0, 0), a2, voffA);
            PG8_WAIT_V(8); PG8_WAIT_L(0); PG8_BAR; PG8_MMA(1, 0, At, B0); PG8_MMA(1, 1, At, B1); PG8_BAR; PG8_SCHED;
            PG8_LDB(B0, 1, 0); PG8_LDB(B1, 1, 1); PG8_SCHED; PG8_LDA(At, 1, 0); PG8_STAGE(PG8_SA(0, 1), a2 + hstep, voffA);
            PG8_WAIT_V(8); PG8_WAIT_L(0); PG8_BAR; PG8_MMA(0, 0, At, B0); PG8_MMA(0, 1, At, B1); PG8_BAR; PG8_SCHED;
            PG8_LDA(At, 1, 1); PG8_STAGE(PG8_SB(1, 0), b3, voffB); PG8_STAGE(PG8_SB(1, 1), b3 + hstepB, voffB); PG8_STAGE(PG8_SA(1, 0), a3, voffA);
            PG8_WAIT_V(8); PG8_WAIT_L(0); PG8_BAR; PG8_MMA(1, 0, At, B0); PG8_MMA(1, 1, At, B1); PG8_BAR; PG8_SCHED;
            } else {
            PG8_LDB(B0, 0, 0); PG8_SCHED; PG8_LDA(At, 0, 0); PG8_STAGE(PG8_SA(1, 1), a1 + hstep, voffA);
            PG8_WAIT_L(8); PG8_BAR; PG8_WAIT_L(0); PG8_MMA(0, 0, At, B0); PG8_BAR; PG8_SCHED;
            PG8_LDB(B1, 0, 1); PG8_STAGE(PG8_SB(0, 0), b2, voffB);
            PG8_BAR; PG8_WAIT_L(0); PG8_MMA(0, 1, At, B1); PG8_BAR;
            PG8_LDA(At, 0, 1); PG8_STAGE(PG8_SA(0, 0), a2, voffA);
            PG8_BAR; PG8_WAIT_L(0); PG8_MMA(1, 0, At, B0); PG8_BAR; PG8_SCHED;
            PG8_STAGE(PG8_SB(0, 1), b2 + hstepB, voffB);
            PG8_WAIT_V(6); PG8_BAR; PG8_MMA(1, 1, At, B1); PG8_BAR;
            PG8_LDB(B0, 1, 0); PG8_SCHED; PG8_LDA(At, 1, 0); PG8_STAGE(PG8_SA(0, 1), a2 + hstep, voffA);
            PG8_WAIT_L(8); PG8_BAR; PG8_WAIT_L(0); PG8_MMA(0, 0, At, B0); PG8_BAR; PG8_SCHED;
            PG8_LDB(B1, 1, 1); PG8_STAGE(PG8_SB(1, 0), b3, voffB);
            PG8_BAR; PG8_WAIT_L(0); PG8_MMA(0, 1, At, B1); PG8_BAR;
            PG8_LDA(At, 1, 1); PG8_STAGE(PG8_SA(1, 0), a3, voffA);
            PG8_BAR; PG8_WAIT_L(0); PG8_MMA(1, 0, At, B0); PG8_BAR; PG8_SCHED;
            PG8_STAGE(PG8_SB(1, 1), b3 + hstepB, voffB);
            PG8_WAIT_V(6); PG8_BAR; PG8_MMA(1, 1, At, B1); PG8_BAR;
            }
        }
        if constexpr (ALIGN_EPI) { if (wr == 0) PG8_BAR; }
        if constexpr (!Epi::AFTER_DRAIN) { E(acc, cur, wr, wc, fr, fq); S.done(cur); }
        if (!has_next) break;
#pragma unroll
        for (int a = 0; a < 2; ++a)
#pragma unroll
            for (int b = 0; b < 2; ++b)
#pragma unroll
                for (int m = 0; m < 4; ++m)
#pragma unroll
                    for (int n = 0; n < 2; ++n) acc[a][b][m][n] = (f32x4){0.f, 0.f, 0.f, 0.f};
        cur = nxt; cA = nA; cB = nB; ++ui;
        if constexpr (ALIGN_EPI) { if (wr == 1) PG8_BAR; }
    }
    PG8_WAIT_V(0);
    if constexpr (!ALIGN_EPI) { if (wr == 0) PG8_BAR; }
    PG8_BAR;
    if constexpr (Epi::AFTER_DRAIN) { E.fused(acc, cur, wr, wc, fr, fq, lds, wid, lane); S.done(cur); }
#undef PG8_SA
#undef PG8_SB
#undef PG8_STAGE
#undef PG8_LDA
#undef PG8_LDB
#undef PG8_MMA
#undef PG8_WAIT_V
#undef PG8_WAIT_L
#undef PG8_BAR
#undef PG8_SCHED
}
}
namespace pg8 {
struct Gemm8 { const unsigned char* A; const unsigned char* Bt; int M, N, K; int scale_a, scale_b; };
template <class Epi, class Sched, bool ALIGN_EPI = false, bool SP2 = false>
__device__ __forceinline__ void gemm_phase_f8(PG8_LAS unsigned char* lds, const Gemm8 g, const Sched& S, const Epi& E, int wid_in) {
    int lane_; asm volatile("v_mbcnt_lo_u32_b32 %0, -1, 0\n\tv_mbcnt_hi_u32_b32 %0, -1, %0" : "=v"(lane_));
    const int wid = wid_in, lane = lane_, tid = wid * 64 + lane, wr = wid >> 2, wc = wid & 3, fr = lane & 15, fq = lane >> 4;
    const int K = g.K, nt = K / 128;
    unsigned voffA[2], voffB[2];
#pragma unroll
    for (int i = 0; i < 2; ++i) { int R, C; stage_rc(tid * 16 + i * 8192, R, C); const int Rb = Perm2<Epi>::v ? (64 * (R >> 5) + 16 * ((R >> 2) & 3) + 4 * ((R >> 4) & 1) + (R & 3)) : Epi::PERM ? ((R & ~31) + perm32(R & 31)) : R;
        voffA[i] = (unsigned)(R * K + 2 * C); voffB[i] = (unsigned)(Rb * K + 2 * C); }
    const size_t kstep = (size_t)(BK * 2);
    const size_t hstep = (size_t)HALF * K;
    const size_t hstepB = Perm2<Epi>::v ? (size_t)8 * K : hstep;
    const size_t tstep = 2 * hstep;
    const unsigned ldsw = (unsigned)wid * 1024u;
    const int aoff = lds_byte(wr * 64 + fr, fq * 16), boff = lds_byte(wc * 32 + fr, fq * 16);
#define PG8_SA(b, h) (((b) * 2 + (h)) * HTB)
#define PG8_SB(b, h) ((4 + (b) * 2 + (h)) * HTB)
#define PG8_STAGE(bufoff, gbase, voff) do { _Pragma("unroll") for (int _i = 0; _i < 2; ++_i) { unsigned keep_; \
        asm volatile("s_mov_b32 %0, m0\n\ts_mov_b32 m0, %3\n\ts_nop 0\n\tglobal_load_lds_dwordx4 %1, %2\n\ts_mov_b32 m0, %0" : "=&s"(keep_) : "v"((voff)[_i]), "s"((const char*)(gbase)), "s"((unsigned)(size_t)(lds + (bufoff) + ldsw + _i * 8192)) : "memory"); } } while (0)
#define PG8_LDA(dst, b, h) do { _Pragma("unroll") for (int m = 0; m < 4; ++m) { const u32x4 lo_ = *(const PG8_LAS u32x4*)(lds + PG8_SA(b, h) + aoff + m * 2048), hi_ = *(const PG8_LAS u32x4*)(lds + PG8_SA(b, h) + aoff + m * 2048 + 16); dst[m] = __builtin_bit_cast(i32x8, __builtin_shufflevector(lo_, hi_, 0, 1, 2, 3, 4, 5, 6, 7)); } } while (0)
#define PG8_LDB(dst, b, h) do { _Pragma("unroll") for (int n = 0; n < 2; ++n) { const u32x4 lo_ = *(const PG8_LAS u32x4*)(lds + PG8_SB(b, h) + boff + n * 2048), hi_ = *(const PG8_LAS u32x4*)(lds + PG8_SB(b, h) + boff + n * 2048 + 16); dst[n] = __builtin_bit_cast(i32x8, __builtin_shufflevector(lo_, hi_, 0, 1, 2, 3, 4, 5, 6, 7)); } } while (0)
#define PG8_MMA(ai, bj, At, Bt) do { __builtin_amdgcn_s_setprio(1); _Pragma("unroll") for (int m = 0; m < 4; ++m) _Pragma("unroll") for (int n = 0; n < 2; ++n) \
        acc[ai][bj][m][n] = __builtin_amdgcn_mfma_scale_f32_16x16x128_f8f6f4(Bt[n], At[m], acc[ai][bj][m][n], 0, 0, 0, g.scale_b, 0, g.scale_a); __builtin_amdgcn_s_setprio(0); } while (0)
#define PG8_WAIT_V(n) asm volatile("s_waitcnt vmcnt(" #n ")" ::: "memory")
#define PG8_WAIT_L(n) asm volatile("s_waitcnt lgkmcnt(" #n ")" ::: "memory")
#define PG8_BAR __builtin_amdgcn_s_barrier()
#define PG8_SCHED __builtin_amdgcn_sched_barrier(0)
    Unit cur, nxt; int ui = 0;
    if (!S.next(0, cur)) return;
    f32x4 acc[2][2][4][2];
#pragma unroll
    for (int a = 0; a < 2; ++a)
#pragma unroll
        for (int b = 0; b < 2; ++b)
#pragma unroll
            for (int m = 0; m < 4; ++m)
#pragma unroll
                for (int n = 0; n < 2; ++n) acc[a][b][m][n] = (f32x4){0.f, 0.f, 0.f, 0.f};
    typedef int i32x8 __attribute__((ext_vector_type(8))); i32x8 At[4], B0[2], B1[2];
    const char* cA = (const char*)g.A + (size_t)cur.pm * tstep; const char* cB = (const char*)g.Bt + (size_t)cur.pn * tstep;
    S.a_ready(cur);
    if constexpr (SP2) {
        PG8_STAGE(PG8_SB(0, 0), cB, voffB); PG8_STAGE(PG8_SB(0, 1), cB + hstepB, voffB); PG8_STAGE(PG8_SA(0, 0), cA, voffA); PG8_STAGE(PG8_SA(0, 1), cA + hstep, voffA);
        if (wr == 1) PG8_BAR;
        PG8_WAIT_V(2); PG8_BAR;
        PG8_STAGE(PG8_SB(1, 0), cB + kstep, voffB); PG8_STAGE(PG8_SA(1, 0), cA + kstep, voffA); PG8_STAGE(PG8_SB(1, 1), cB + hstepB + kstep, voffB);
        PG8_WAIT_V(6); PG8_BAR;
    } else {
        PG8_STAGE(PG8_SB(0, 0), cB, voffB); PG8_STAGE(PG8_SA(0, 0), cA, voffA); PG8_STAGE(PG8_SB(0, 1), cB + hstepB, voffB); PG8_STAGE(PG8_SA(0, 1), cA + hstep, voffA);
        if (wr == 1) PG8_BAR;
        PG8_WAIT_V(4); PG8_BAR;
        PG8_STAGE(PG8_SB(1, 0), cB + kstep, voffB); PG8_STAGE(PG8_SA(1, 0), cA + kstep, voffA); PG8_STAGE(PG8_SB(1, 1), cB + hstepB + kstep, voffB);
        PG8_WAIT_V(6); PG8_BAR;
    }
    for (;;) {
        const bool has_next = S.next(ui + 1, nxt);
        const char* nA = has_next ? (const char*)g.A + (size_t)nxt.pm * tstep : cA; const char* nB = has_next ? (const char*)g.Bt + (size_t)nxt.pn * tstep : cB;
#pragma unroll 1
        for (int t = 0; t < nt; t += 2) {
            const bool last = (t == nt - 2);
            const char* a1 = cA + (size_t)(t + 1) * kstep;
            const char* a2 = last ? nA : cA + (size_t)(t + 2) * kstep; const char* b2 = last ? nB : cB + (size_t)(t + 2) * kstep;
            const char* a3 = a2 + kstep; const char* b3 = b2 + kstep;
            if (last && has_next) S.a_ready(nxt);
            if constexpr (SP2) {
            PG8_LDB(B0, 0, 0); PG8_LDB(B1, 0, 1); PG8_SCHED; PG8_LDA(At, 0, 0); PG8_STAGE(PG8_SA(1, 1), a1 + hstep, voffA);
            PG8_WAIT_V(8); PG8_WAIT_L(0); PG8_BAR; PG8_MMA(0, 0, At, B0); PG8_MMA(0, 1, At, B1); PG8_BAR; PG8_SCHED;
            PG8_LDA(At, 0, 1); PG8_STAGE(PG8_SB(0, 0), b2, voffB); PG8_STAGE(PG8_SB(0, 1), b2 + hstepB, voffB); PG8_STAGE(PG8_SA(0, 0), a2, voffA);
            PG8_WAIT_V(8); PG8_WAIT_L(0); PG8_BAR; PG8_MMA(1, 0, At, B0); PG8_MMA(1, 1, At, B1); PG8_BAR; PG8_SCHED;
            PG8_LDB(B0, 1, 0); PG8_LDB(B1, 1, 1); PG8_SCHED; PG8_LDA(At, 1, 0); PG8_STAGE(PG8_SA(0, 1), a2 + hstep, voffA);
            PG8_WAIT_V(8); PG8_WAIT_L(0); PG8_BAR; PG8_MMA(0, 0, At, B0); PG8_MMA(0, 1, At, B1); PG8_BAR; PG8_SCHED;
            PG8_LDA(At, 1, 1); PG8_STAGE(PG8_SB(1, 0), b3, voffB); PG8_STAGE(PG8_SB(1, 1), b3 + hstepB, voffB); PG8_STAGE(PG8_SA(1, 0), a3, voffA);
            PG8_WAIT_V(8); PG8_WAIT_L(0); PG8_BAR; PG8_MMA(1, 0, At, B0); PG8_MMA(1, 1, At, B1); PG8_BAR; PG8_SCHED;
            } else {
            PG8_LDB(B0, 0, 0); PG8_SCHED; PG8_LDA(At, 0, 0); PG8_STAGE(PG8_SA(1, 1), a1 + hstep, voffA);
            PG8_WAIT_L(8); PG8_BAR; PG8_WAIT_L(0); PG8_MMA(0, 0, At, B0); PG8_BAR; PG8_SCHED;
            PG8_LDB(B1, 0, 1); PG8_STAGE(PG8_SB(0, 0), b2, voffB);
            PG8_BAR; PG8_WAIT_L(0); PG8_MMA(0, 1, At, B1); PG8_BAR;
            PG8_LDA(At, 0, 1); PG8_STAGE(PG8_SA(0, 0), a2, voffA);
            PG8_BAR; PG8_WAIT_L(0); PG8_MMA(1, 0, At, B0); PG8_BAR; PG8_SCHED;
            PG8_STAGE(PG8_SB(0, 1), b2 + hstepB, voffB);
            PG8_WAIT_V(6); PG8_BAR; PG8_MMA(1, 1, At, B1); PG8_BAR;
            PG8_LDB(B0, 1, 0); PG8_SCHED; PG8_LDA(At, 1, 0); PG8_STAGE(PG8_SA(0, 1), a2 + hstep, voffA);
            PG8_WAIT_L(8); PG8_BAR; PG8_WAIT_L(0); PG8_MMA(0, 0, At, B0); PG8_BAR; PG8_SCHED;
            PG8_LDB(B1, 1, 1); PG8_STAGE(PG8_SB(1, 0), b3, voffB);
            PG8_BAR; PG8_WAIT_L(0); PG8_MMA(0, 1, At, B1); PG8_BAR;
            PG8_LDA(At, 1, 1); PG8_STAGE(PG8_SA(1, 0), a3, voffA);
            PG8_BAR; PG8_WAIT_L(0); PG8_MMA(1, 0, At, B0); PG8_BAR; PG8_SCHED;
            PG8_STAGE(PG8_SB(1, 1), b3 + hstepB, voffB);
            PG8_WAIT_V(6); PG8_BAR; PG8_MMA(1, 1, At, B1); PG8_BAR;
            }
        }
        if constexpr (ALIGN_EPI) { if (wr == 0) PG8_BAR; }
        if constexpr (!Epi::AFTER_DRAIN) { int l2_; asm volatile("v_mbcnt_lo_u32_b32 %0, -1, 0\n\tv_mbcnt_hi_u32_b32 %0, -1, %0" : "=v"(l2_));
            E(acc, cur, wr, wc, l2_ & 15, l2_ >> 4); S.done(cur); }
        if (!has_next) break;
#pragma unroll
        for (int a = 0; a < 2; ++a)
#pragma unroll
            for (int b = 0; b < 2; ++b)
#pragma unroll
                for (int m = 0; m < 4; ++m)
#pragma unroll
                    for (int n = 0; n < 2; ++n) acc[a][b][m][n] = (f32x4){0.f, 0.f, 0.f, 0.f};
        cur = nxt; cA = nA; cB = nB; ++ui;
        if constexpr (ALIGN_EPI) { if (wr == 1) PG8_BAR; }
    }
    PG8_WAIT_V(0);
    if constexpr (!ALIGN_EPI) { if (wr == 0) PG8_BAR; }
    PG8_BAR;
    if constexpr (Epi::AFTER_DRAIN) { E.fused(acc, cur, wr, wc, fr, fq, lds, wid, lane); S.done(cur); }
#undef PG8_SA
#undef PG8_SB
#undef PG8_STAGE
#undef PG8_LDA
#undef PG8_LDB
#undef PG8_MMA
#undef PG8_WAIT_V
#undef PG8_WAIT_L
#undef PG8_BAR
#undef PG8_SCHED
}
}
namespace pg8 {
struct GemmA { const bf16_t* A; const bf16_t* Bt; int K; int rowA; size_t kstepA, hstepA, tstepA; };
template <class Epi, class Sched, bool ALIGN_EPI = false, bool SP2 = false>
__device__ __forceinline__ void gemm_phase_ga(PG8_LAS unsigned char* lds, const GemmA g, const Sched& S, const Epi& E, int wid_in) {
    int lane_; asm volatile("v_mbcnt_lo_u32_b32 %0, -1, 0\n\tv_mbcnt_hi_u32_b32 %0, -1, %0" : "=v"(lane_));
    const int wid = wid_in, lane = lane_, tid = wid * 64 + lane, wr = wid >> 2, wc = wid & 3, fr = lane & 15, fq = lane >> 4;
    const int K = g.K, nt = K / BK;
    unsigned voffA[2], voffB[2];
#pragma unroll
    for (int i = 0; i < 2; ++i) { int R, C; stage_rc(tid * 16 + i * 8192, R, C); const int Rb = Perm2<Epi>::v ? (64 * (R >> 5) + 16 * ((R >> 2) & 3) + 4 * ((R >> 4) & 1) + (R & 3)) : Epi::PERM ? ((R & ~31) + perm32(R & 31)) : R;
        voffA[i] = (unsigned)(R * g.rowA + C * 2); voffB[i] = (unsigned)(Rb * K + C) * 2u; }
    const size_t kstep = (size_t)(BK * 2);
    const size_t hstep = (size_t)HALF * K * 2;
    const size_t kstepA = g.kstepA, hstepA = g.hstepA, tstepA = g.tstepA;
    const size_t hstepB = Perm2<Epi>::v ? (size_t)8 * K * 2 : hstep;
    const size_t tstep = 2 * hstep;
    const unsigned ldsw = (unsigned)wid * 1024u;
    const int aoff = lds_byte(wr * 64 + fr, fq * 8), boff = lds_byte(wc * 32 + fr, fq * 8);
#define PG8_SA(b, h) (((b) * 2 + (h)) * HTB)
#define PG8_SB(b, h) ((4 + (b) * 2 + (h)) * HTB)
#define PG8_STAGE(bufoff, gbase, voff) do { _Pragma("unroll") for (int _i = 0; _i < 2; ++_i) \
        __builtin_amdgcn_global_load_lds((const unsigned*)((const char*)(gbase) + (voff)[_i]), (PG8_LAS unsigned*)(lds + (bufoff) + ldsw + _i * 8192), 16, 0, 0); } while (0)
#define PG8_LDA(dst, b, h) do { _Pragma("unroll") for (int m = 0; m < 4; ++m) _Pragma("unroll") for (int k = 0; k < 2; ++k) dst[m][k] = *(const PG8_LAS bf16x8*)(lds + PG8_SA(b, h) + aoff + m * 2048 + k * 1024); } while (0)
#define PG8_LDB(dst, b, h) do { _Pragma("unroll") for (int n = 0; n < 2; ++n) _Pragma("unroll") for (int k = 0; k < 2; ++k) dst[n][k] = *(const PG8_LAS bf16x8*)(lds + PG8_SB(b, h) + boff + n * 2048 + k * 1024); } while (0)
#define PG8_MMA(ai, bj, At, Bt) do { __builtin_amdgcn_s_setprio(1); _Pragma("unroll") for (int m = 0; m < 4; ++m) _Pragma("unroll") for (int n = 0; n < 2; ++n) _Pragma("unroll") for (int k = 0; k < 2; ++k) \
        acc[ai][bj][m][n] = __builtin_amdgcn_mfma_f32_16x16x32_bf16(Bt[n][k], At[m][k], acc[ai][bj][m][n], 0, 0, 0); __builtin_amdgcn_s_setprio(0); } while (0)
#define PG8_WAIT_V(n) asm volatile("s_waitcnt vmcnt(" #n ")" ::: "memory")
#define PG8_WAIT_L(n) asm volatile("s_waitcnt lgkmcnt(" #n ")" ::: "memory")
#define PG8_BAR __builtin_amdgcn_s_barrier()
#define PG8_SCHED __builtin_amdgcn_sched_barrier(0)
    Unit cur, nxt; int ui = 0;
    if (!S.next(0, cur)) return;
    f32x4 acc[2][2][4][2];
#pragma unroll
    for (int a = 0; a < 2; ++a)
#pragma unroll
        for (int b = 0; b < 2; ++b)
#pragma unroll
            for (int m = 0; m < 4; ++m)
#pragma unroll
                for (int n = 0; n < 2; ++n) acc[a][b][m][n] = (f32x4){0.f, 0.f, 0.f, 0.f};
    bf16x8 At[4][2], B0[2][2], B1[2][2];
    const char* cA = (const char*)g.A + (size_t)cur.pm * tstepA; const char* cB = (const char*)g.Bt + (size_t)cur.pn * tstep;
    S.a_ready(cur);
    if constexpr (SP2) {
        PG8_STAGE(PG8_SB(0, 0), cB, voffB); PG8_STAGE(PG8_SB(0, 1), cB + hstepB, voffB); PG8_STAGE(PG8_SA(0, 0), cA, voffA); PG8_STAGE(PG8_SA(0, 1), cA + hstepA, voffA);
        if (wr == 1) PG8_BAR;
        PG8_WAIT_V(2); PG8_BAR;
        PG8_STAGE(PG8_SB(1, 0), cB + kstep, voffB); PG8_STAGE(PG8_SA(1, 0), cA + kstepA, voffA); PG8_STAGE(PG8_SB(1, 1), cB + hstepB + kstep, voffB);
        PG8_WAIT_V(6); PG8_BAR;
    } else {
        PG8_STAGE(PG8_SB(0, 0), cB, voffB); PG8_STAGE(PG8_SA(0, 0), cA, voffA); PG8_STAGE(PG8_SB(0, 1), cB + hstepB, voffB); PG8_STAGE(PG8_SA(0, 1), cA + hstepA, voffA);
        if (wr == 1) PG8_BAR;
        PG8_WAIT_V(4); PG8_BAR;
        PG8_STAGE(PG8_SB(1, 0), cB + kstep, voffB); PG8_STAGE(PG8_SA(1, 0), cA + kstepA, voffA); PG8_STAGE(PG8_SB(1, 1), cB + hstepB + kstep, voffB);
        PG8_WAIT_V(6); PG8_BAR;
    }
    for (;;) {
        const bool has_next = S.next(ui + 1, nxt);
        const char* nA = has_next ? (const char*)g.A + (size_t)nxt.pm * tstepA : cA; const char* nB = has_next ? (const char*)g.Bt + (size_t)nxt.pn * tstep : cB;
        for (int t = 0; t < nt; t += 2) {
            if constexpr (MidSeg<Epi>::v > 0) { if (t > 0 && t % MidSeg<Epi>::v == 0) E.mid(acc, cur, t / MidSeg<Epi>::v, wr, wc, fr, fq); }
            const bool last = (t == nt - 2);
            const char* a1 = cA + (size_t)(t + 1) * kstepA;
            const char* a2 = last ? nA : cA + (size_t)(t + 2) * kstepA; const char* b2 = last ? nB : cB + (size_t)(t + 2) * kstep;
            const char* a3 = a2 + kstepA; const char* b3 = b2 + kstep;
            if (last && has_next) S.a_ready(nxt);
            if constexpr (SP2) {
            PG8_LDB(B0, 0, 0); PG8_LDB(B1, 0, 1); PG8_SCHED; PG8_LDA(At, 0, 0); PG8_STAGE(PG8_SA(1, 1), a1 + hstepA, voffA);
            PG8_WAIT_V(8); PG8_WAIT_L(0); PG8_BAR; PG8_MMA(0, 0, At, B0); PG8_MMA(0, 1, At, B1); PG8_BAR; PG8_SCHED;
            PG8_LDA(At, 0, 1); PG8_STAGE(PG8_SB(0, 0), b2, voffB); PG8_STAGE(PG8_SB(0, 1), b2 + hstepB, voffB); PG8_STAGE(PG8_SA(0, 0), a2, voffA);
            PG8_WAIT_V(8); PG8_WAIT_L(0); PG8_BAR; PG8_MMA(1, 0, At, B0); PG8_MMA(1, 1, At, B1); PG8_BAR; PG8_SCHED;
            PG8_LDB(B0, 1, 0); PG8_LDB(B1, 1, 1); PG8_SCHED; PG8_LDA(At, 1, 0); PG8_STAGE(PG8_SA(0, 1), a2 + hstepA, voffA);
            PG8_WAIT_V(8); PG8_WAIT_L(0); PG8_BAR; PG8_MMA(0, 0, At, B0); PG8_MMA(0, 1, At, B1); PG8_BAR; PG8_SCHED;
            PG8_LDA(At, 1, 1); PG8_STAGE(PG8_SB(1, 0), b3, voffB); PG8_STAGE(PG8_SB(1, 1), b3 + hstepB, voffB); PG8_STAGE(PG8_SA(1, 0), a3, voffA);
            PG8_WAIT_V(8); PG8_WAIT_L(0); PG8_BAR; PG8_MMA(1, 0, At, B0); PG8_MMA(1, 1, At, B1); PG8_BAR; PG8_SCHED;
            } else {
            PG8_LDB(B0, 0, 0); PG8_SCHED; PG8_LDA(At, 0, 0); PG8_STAGE(PG8_SA(1, 1), a1 + hstepA, voffA);
            PG8_WAIT_L(8); PG8_BAR; PG8_WAIT_L(0); PG8_MMA(0, 0, At, B0); PG8_BAR; PG8_SCHED;
            PG8_LDB(B1, 0, 1); PG8_STAGE(PG8_SB(0, 0), b2, voffB);
            PG8_BAR; PG8_WAIT_L(0); PG8_MMA(0, 1, At, B1); PG8_BAR;
            PG8_LDA(At, 0, 1); PG8_STAGE(PG8_SA(0, 0), a2, voffA);
            PG8_BAR; PG8_WAIT_L(0); PG8_MMA(1, 0, At, B0); PG8_BAR; PG8_SCHED;
            PG8_STAGE(PG8_SB(0, 1), b2 + hstepB, voffB);
            PG8_WAIT_V(6); PG8_BAR; PG8_MMA(1, 1, At, B1); PG8_BAR;
            PG8_LDB(B0, 1, 0); PG8_SCHED; PG8_LDA(At, 1, 0); PG8_STAGE(PG8_SA(0, 1), a2 + hstepA, voffA);
            PG8_WAIT_L(8); PG8_BAR; PG8_WAIT_L(0); PG8_MMA(0, 0, At, B0); PG8_BAR; PG8_SCHED;
            PG8_LDB(B1, 1, 1); PG8_STAGE(PG8_SB(1, 0), b3, voffB);
            PG8_BAR; PG8_WAIT_L(0); PG8_MMA(0, 1, At, B1); PG8_BAR;
            PG8_LDA(At, 1, 1); PG8_STAGE(PG8_SA(1, 0), a3, voffA);
            PG8_BAR; PG8_WAIT_L(0); PG8_MMA(1, 0, At, B0); PG8_BAR; PG8_SCHED;
            PG8_STAGE(PG8_SB(1, 1), b3 + hstepB, voffB);
            PG8_WAIT_V(6); PG8_BAR; PG8_MMA(1, 1, At, B1); PG8_BAR;
            }
        }
        if constexpr (ALIGN_EPI) { if (wr == 0) PG8_BAR; }
        if constexpr (!Epi::AFTER_DRAIN) { E(acc, cur, wr, wc, fr, fq); S.done(cur); }
        if (!has_next) break;
#pragma unroll
        for (int a = 0; a < 2; ++a)
#pragma unroll
            for (int b = 0; b < 2; ++b)
#pragma unroll
                for (int m = 0; m < 4; ++m)
#pragma unroll
                    for (int n = 0; n < 2; ++n) acc[a][b][m][n] = (f32x4){0.f, 0.f, 0.f, 0.f};
        cur = nxt; cA = nA; cB = nB; ++ui;
        if constexpr (ALIGN_EPI) { if (wr == 1) PG8_BAR; }
    }
    PG8_WAIT_V(0);
    if constexpr (!ALIGN_EPI) { if (wr == 0) PG8_BAR; }
    PG8_BAR;
    if constexpr (Epi::AFTER_DRAIN) { E.fused(acc, cur, wr, wc, fr, fq, lds, wid, lane); S.done(cur); }
#undef PG8_SA
#undef PG8_SB
#undef PG8_STAGE
#undef PG8_LDA
#undef PG8_LDB
#undef PG8_MMA
#undef PG8_WAIT_V
#undef PG8_WAIT_L
#undef PG8_BAR
#undef PG8_SCHED
}
}
#define GAS __attribute__((address_space(1)))
#define LAS __attribute__((address_space(3)))
typedef unsigned short bf16;
typedef unsigned v4u __attribute__((ext_vector_type(4)));
typedef float f32x4 __attribute__((ext_vector_type(4)));
typedef short bf16x8 __attribute__((ext_vector_type(8)));
typedef GAS unsigned gu32;
typedef GAS unsigned long long gu64;
#define RLX_AGENT __ATOMIC_RELAXED, __HIP_MEMORY_SCOPE_AGENT
#define LDS_WAIT() asm volatile("s_waitcnt lgkmcnt(0)" ::: "memory")
#define VM_WAIT() asm volatile("s_waitcnt vmcnt(0)" ::: "memory")
__device__ __forceinline__ unsigned long long rt() { return __builtin_amdgcn_s_memrealtime(); }
__device__ __forceinline__ unsigned f2bf(float f) { unsigned u = __builtin_bit_cast(unsigned, f); return (u + 0x7fffu + ((u >> 16) & 1u)) >> 16; }
__device__ __forceinline__ unsigned pk2(float lo, float hi) { return f2bf(lo) | (f2bf(hi) << 16); }

#define XB_TMO      128
#define XB_XCNT(j)  (256  + 64 * (j))
#define XB_XSUB(j)  (1280 + 64 * (j))
#define XB_XGEN(j)  (2304 + 64 * (j))
#define XB_TOP      3328
#define XB_TOPGEN   3392
#define XCD_BAR_WORDS 3456
#define XB_SPIN_CAP (1u << 18)

__device__ __forceinline__ unsigned xb_ld(unsigned* p)              { return __hip_atomic_load(p, __ATOMIC_RELAXED, __HIP_MEMORY_SCOPE_AGENT); }
__device__ __forceinline__ unsigned xb_add(unsigned* p, unsigned v) { return __hip_atomic_fetch_add(p, v, __ATOMIC_RELAXED, __HIP_MEMORY_SCOPE_AGENT); }
__device__ __forceinline__ unsigned xb_xcc_id() { return (unsigned)__builtin_amdgcn_s_getreg((3 << 11) | 20) & 0xFu; }
#define XB_SPIN(cond, bar) do { unsigned _sp = 0; while (cond) { __builtin_amdgcn_s_sleep(1); \
    if ((++_sp & 255u) == 0u) { if (xb_ld(&(bar)[XB_TMO])) break; if (_sp > XB_SPIN_CAP) { atomicAdd(&(bar)[XB_TMO], 1u); break; } } } } while (0)

struct XcdBarrier {
    int wv;
    unsigned* bar; unsigned x;
    volatile LAS unsigned* st;
};

__device__ __forceinline__ int xb_lane_id() { int l; asm volatile("v_mbcnt_lo_u32_b32 %0, -1, 0\n\tv_mbcnt_hi_u32_b32 %0, -1, %0" : "=v"(l)); return l; }
__device__ __forceinline__ XcdBarrier xcd_barrier_post(unsigned* bar, volatile LAS unsigned* st, int wv) {
    XcdBarrier b; b.wv = wv; b.bar = bar; b.x = xb_xcc_id(); b.st = st;
    if (wv == 0 && xb_lane_id() == 0) (void)xb_add(&bar[XB_XCNT(b.x)], 1u);
    return b;
}
__device__ __forceinline__ void xcd_barrier_complete(unsigned* bar, unsigned x, unsigned& nloc, unsigned& nx) {
    const unsigned G = gridDim.x * gridDim.y * gridDim.z;
    unsigned sum, cnt, mine, sp = 0u;
    for (;;) {
        sum = 0u; cnt = 0u; mine = 0u;
#pragma unroll
        for (unsigned j = 0; j < 16; ++j) { const unsigned c = xb_ld(&bar[XB_XCNT(j)]); sum += c; cnt += (c > 0u) ? 1u : 0u; mine = (j == x) ? c : mine; }
        if (sum == G) break;
        __builtin_amdgcn_s_sleep(1);
        if ((++sp & 255u) == 0u) { if (xb_ld(&bar[XB_TMO])) break; if (sp > XB_SPIN_CAP) { atomicAdd(&bar[XB_TMO], 1u); break; } }
    }
    nloc = mine > 0u ? mine : 1u; nx = cnt > 0u ? cnt : 1u;
}

__device__ __forceinline__ void xcd_barrier(const XcdBarrier& b) {
    asm volatile("s_waitcnt vmcnt(0)" ::: "memory");
    __syncthreads();
    if (b.wv == 0 && xb_lane_id() == 0) {
        unsigned* bar = b.bar;
        __builtin_amdgcn_s_waitcnt(0);
        unsigned nloc = b.st[0], nx = b.st[1];
        if (nloc == 0u) { xcd_barrier_complete(bar, b.x, nloc, nx); b.st[0] = nloc; b.st[1] = nx; }
        const unsigned old = xb_add(&bar[XB_XSUB(b.x)], 1u);
        const unsigned gen = old / nloc;
        if (old + 1u == (gen + 1u) * nloc) {
            __builtin_amdgcn_fence(__ATOMIC_RELEASE, "agent");
            asm volatile("s_waitcnt vmcnt(0)" ::: "memory");
            const unsigned og = xb_add(&bar[XB_TOP], 1u);
            const unsigned tg = og / nx;
            if (og + 1u == (tg + 1u) * nx) xb_add(&bar[XB_TOPGEN], 1u);
            else XB_SPIN(xb_ld(&bar[XB_TOPGEN]) == tg, bar);
            __builtin_amdgcn_fence(__ATOMIC_ACQUIRE, "agent");
            xb_add(&bar[XB_XGEN(b.x)], 1u);
            asm volatile("s_waitcnt vmcnt(0)" ::: "memory");
        } else {
            XB_SPIN(xb_ld(&bar[XB_XGEN(b.x)]) == gen, bar);
            __builtin_amdgcn_fence(__ATOMIC_ACQUIRE, "agent");
            asm volatile("s_waitcnt vmcnt(0)" ::: "memory");
        }
    }
    __syncthreads();
}
#define DI __device__ __forceinline__
constexpr int NWAVES = 8;
constexpr int NB = 16, SEQ = 2048, DM = 1024, MT = NB * SEQ;
constexpr int DIN_SRC = 6944, NPROJ = 7168;
constexpr int MEML = 256, MROWS = NB * MEML;
constexpr int NEXP = 32, TOPK = 4, DFF = 1024, MOEB = 256;
constexpr int NROWS = MT * TOPK;
constexpr int NBLK_MAX = (NROWS + NEXP * (MOEB - 1) + MOEB - 1) / MOEB;
constexpr int CAP = NBLK_MAX * MOEB;
constexpr float EPS = 1e-6f;
constexpr float NEGF = -1e30f;
constexpr int NB16 = 3584, NF8 = NPROJ - NB16;
constexpr int PC_MLQ = 0, PC_MLK = 512, PC_NQ = 1024, PC_NKC = 1536, PC_NKS = 1664, PC_NKW = 1792, PC_MQ = 1920, PC_MLI = 2432, PC_MLF = 2436, PC_NG = 2440,
              PC_MLV = 2560, PC_NVC = 3072, PC_NVS = 3200, PC_NVW = 3328, PC_MLO = 3584, PC_BRG = 4096;
__host__ __device__ constexpr int proj_srccol(int j) {
    return j < 1024 ? j : j < 1536 ? 2056 + (j - 1024) : j < 1664 ? 2568 + (j - 1536) : j < 1792 ? 2824 + (j - 1664) : j < 1920 ? 3080 + (j - 1792) : j < 2432 ? 3360 + (j - 1920)
         : j < 2440 ? 2048 + (j - 2432) : j < 2464 ? 3336 + (j - 2440) : j < 2560 ? -1
         : j < 3072 ? 1024 + (j - 2560) : j < 3200 ? 2696 + (j - 3072) : j < 3328 ? 2952 + (j - 3200) : j < 3456 ? 3208 + (j - 3328) : j < 3584 ? -1
         : j < 4096 ? 1536 + (j - 3584) : 3872 + (j - 4096);
}

constexpr size_t MiB = 1u << 20;
constexpr size_t WS_CTL = 0, CTL_ZERO_BYTES = 1 * MiB;
constexpr size_t WS_WIN = 1 * MiB, WS_WGU = 15 * MiB, WS_WDN = 143 * MiB, WS_WMKV = 207 * MiB, WS_WBR = 209 * MiB, WS_WOUT = 212 * MiB, WS_WC1 = 214 * MiB;
constexpr size_t WS_WIN8 = WS_WIN + 8 * MiB;
constexpr size_t WS_SMALL = 216 * MiB;
constexpr size_t WS_R1 = 218 * MiB;
constexpr size_t WS_PROJ = 282 * MiB;
constexpr size_t WS_R3 = 730 * MiB;
constexpr size_t WS_MEMKV = WS_R3, WS_MEMKN = WS_R3 + 8 * MiB, WS_QN = WS_R3 + 12 * MiB, WS_KSN = WS_R3 + 44 * MiB, WS_KWN = WS_R3 + 52 * MiB,
                 WS_MQN = WS_R3 + 60 * MiB, WS_MLQK = WS_R3 + 92 * MiB, WS_HID = WS_R3 + 156 * MiB, WS_KC = WS_R3 + 160 * MiB, WS_VC = WS_KC + MiB / 2,
                 WS_H0 = WS_R3 + 161 * MiB, WS_H1 = WS_H0 + 32 * MiB, WS_H2 = WS_H1 + 32 * MiB, WS_ROUTE = WS_H2 + 32 * MiB, WS_END = WS_ROUTE + 6 * MiB;
constexpr size_t WS_MLV = WS_R1, WS_VSN = WS_R1 + 32 * MiB, WS_VWN = WS_R1 + 40 * MiB;
constexpr size_t WS_U8 = WS_H2;
constexpr size_t WS_MEMN = WS_H0;
constexpr size_t WS_ACMP = WS_H1;
constexpr size_t WS_APERM = WS_PROJ;
constexpr size_t WS_ACT = WS_PROJ + 272 * MiB;
static_assert(WS_ACT + 272 * MiB <= WS_H0 + 96 * MiB && WS_END <= 1024 * MiB, "ws map");
constexpr size_t SM_ROPEC = 0, SM_ROPES = 256 * 1024, SM_CBIAS = 512 * 1024, SM_WRT = 1024 * 1024, SM_W2T = 1024 * 1024 + 256 * 1024;
constexpr size_t RT_TOKE = 0, RT_TOKPOS = 512 * 1024, RT_TOKW = 1024 * 1024, RT_TOKDEST = 1536 * 1024, RT_ROWW = 2048 * 1024;
constexpr int CW_BAR = 4096;
constexpr int CW_ECNT = 16384;
constexpr int CW_QCTR = 16384 + 64;

constexpr int RING_BYTES = 131072, LDSCTL_OFF = RING_BYTES, MISC_OFF = LDSCTL_OFF + 320, LDS_BYTES = 155648;

struct Args { const float* in[34]; float* out; unsigned char* ws; int ph_lo, ph_hi, li, pad; };

DI float bf2f(unsigned short h) { return __uint_as_float((unsigned)h << 16); }
DI float wave_sum(float v) {
#pragma unroll
    for (int o = 1; o < 64; o <<= 1) v += __shfl_xor(v, o);
    return v;
}
DI float wave_max(float v) {
#pragma unroll
    for (int o = 1; o < 64; o <<= 1) v = fmaxf(v, __shfl_xor(v, o));
    return v;
}
DI float sigm(float x) { return __builtin_amdgcn_rcpf(1.f + __expf(-x)); }
DI float logsig(float x) { return fminf(x, 0.f) - log1pf(__expf(-fabsf(x))); }

namespace pg8 {
struct EpiBf16Silu {
    static constexpr bool PERM = true, AFTER_DRAIN = false, PERM2 = true;
    bf16_t* O; int ldc; const float* bias; int silu;
    DI void operator()(const f32x4 (&acc)[2][2][4][2], const Unit& u, int wr, int wc, int fr, int fq) const {
        const int row0 = u.pm * BM + wr * 64 + fr; const int col0 = u.pn * BM + wc * 64 + 16 * fq;
#pragma unroll
        for (int ai = 0; ai < 2; ++ai)
#pragma unroll
            for (int m = 0; m < 4; ++m) { bf16_t* rowp = O + (size_t)(row0 + ai * HALF + m * 16) * ldc + col0;
#pragma unroll
                for (int bj = 0; bj < 2; ++bj) { f32x4 v0 = acc[ai][bj][m][0], v1 = acc[ai][bj][m][1];
                    if (bias) { v0 += *(const f32x4*)(bias + col0 + 8 * bj); v1 += *(const f32x4*)(bias + col0 + 8 * bj + 4); }
                    if (silu) {
#pragma unroll
                        for (int j = 0; j < 4; ++j) { v0[j] = v0[j] * __builtin_amdgcn_rcpf(1.f + __expf(-v0[j])); v1[j] = v1[j] * __builtin_amdgcn_rcpf(1.f + __expf(-v1[j])); } }
                    u32x4 w; w.x = cvt_pk_bf16(v0[0], v0[1]); w.y = cvt_pk_bf16(v0[2], v0[3]); w.z = cvt_pk_bf16(v1[0], v1[1]); w.w = cvt_pk_bf16(v1[2], v1[3]);
                    *(u32x4*)(rowp + 8 * bj) = w; } }
    }
};
template <int B> struct EpiGate {
    static constexpr bool PERM = false, AFTER_DRAIN = false;
    const bf16_t* proj; float* tmp; bf16_t* merged;
    DI void operator()(const f32x4 (&acc)[2][2][4][2], const Unit& u, int wr, int wc, int fr, int fq) const {
        typedef unsigned u32x2v __attribute__((ext_vector_type(2)));
        const int col0 = u.pn * BM + wc * 32 + 4 * fq;
#pragma unroll
        for (int ai = 0; ai < 2; ++ai)
#pragma unroll
            for (int m = 0; m < 4; ++m) { const size_t r = (size_t)(u.pm * BM + ai * HALF + wr * 64 + m * 16 + fr);
#pragma unroll
                for (int bj = 0; bj < 2; ++bj)
#pragma unroll
                    for (int n = 0; n < 2; ++n) { const int c = col0 + bj * HALF + n * 16;
                        const u32x2v gw = *(const u32x2v*)(proj + r * NPROJ + PC_BRG + B * DM + c);
                        f32x4 g; g[0] = __uint_as_float(gw.x << 16); g[1] = __uint_as_float(gw.x & 0xffff0000u); g[2] = __uint_as_float(gw.y << 16); g[3] = __uint_as_float(gw.y & 0xffff0000u);
                        f32x4 v = acc[ai][bj][m][n];
#pragma unroll
                        for (int j = 0; j < 4; ++j) v[j] = v[j] * __builtin_amdgcn_rcpf(1.f + __expf(-g[j]));
                        float* tp = tmp + r * DM + c;
                        if (B == 0) { *(f32x4*)tp = v; }
                        else if (B == 1) { *(f32x4*)tp = *(const f32x4*)tp + v; }
                        else { v = *(const f32x4*)tp + v; u32x2v w; w.x = cvt_pk_bf16(v[0], v[1]); w.y = cvt_pk_bf16(v[2], v[3]); *(u32x2v*)(merged + r * DM + c) = w; } } }
    }
};
struct EpiMerge {
    static constexpr bool PERM = false, AFTER_DRAIN = false;
    const bf16_t* proj; float* tmp; bf16_t* merged;
    DI void operator()(const f32x4 (&acc)[2][2][4][2], const Unit& u, int wr, int wc, int fr, int fq) const {
        typedef unsigned u32x2v __attribute__((ext_vector_type(2)));
        const int b = u.pn >> 2, pn = u.pn & 3, pm = u.pm & 127;
        const int col0 = pn * BM + wc * 32 + 4 * fq;
#pragma unroll
        for (int ai = 0; ai < 2; ++ai)
#pragma unroll
            for (int m = 0; m < 4; ++m) { const size_t r = (size_t)(pm * BM + ai * HALF + wr * 64 + m * 16 + fr);
#pragma unroll
                for (int bj = 0; bj < 2; ++bj)
#pragma unroll
                    for (int n = 0; n < 2; ++n) { const int c = col0 + bj * HALF + n * 16;
                        const u32x2v gw = *(const u32x2v*)(proj + r * NPROJ + PC_BRG + b * DM + c);
                        f32x4 g; g[0] = __uint_as_float(gw.x << 16); g[1] = __uint_as_float(gw.x & 0xffff0000u); g[2] = __uint_as_float(gw.y << 16); g[3] = __uint_as_float(gw.y & 0xffff0000u);
                        f32x4 v = acc[ai][bj][m][n];
#pragma unroll
                        for (int j = 0; j < 4; ++j) v[j] = v[j] * __builtin_amdgcn_rcpf(1.f + __expf(-g[j]));
                        float* tp = tmp + r * DM + c;
                        if (b == 0) { *(f32x4*)tp = v; }
                        else if (b == 1) { *(f32x4*)tp = *(const f32x4*)tp + v; }
                        else { v = *(const f32x4*)tp + v; u32x2v w; w.x = cvt_pk_bf16(v[0], v[1]); w.y = cvt_pk_bf16(v[2], v[3]); *(u32x2v*)(merged + r * DM + c) = w; } } }
    }
};
struct EpiMergeK {
    static constexpr bool PERM = true, AFTER_DRAIN = false; static constexpr int MIDSEG = 8;
    const bf16_t* proj; bf16_t* merged;
    DI static void ldg8(const bf16_t* p, float (&g)[8]) { const u32x4 w = *(const u32x4*)p; const unsigned ws_[4] = {w.x, w.y, w.z, w.w};
#pragma unroll
        for (int j = 0; j < 4; ++j) { g[2 * j] = __uint_as_float(ws_[j] << 16); g[2 * j + 1] = __uint_as_float(ws_[j] & 0xffff0000u); } }
    DI void mid(f32x4 (&acc)[2][2][4][2], const Unit& u, int seg, int wr, int wc, int fr, int fq) const {
        const int col0 = u.pn * BM + wc * 32 + 8 * fq;
#pragma unroll
        for (int ai = 0; ai < 2; ++ai)
#pragma unroll
            for (int m = 0; m < 4; ++m) { const size_t r = (size_t)(u.pm * BM + ai * HALF + wr * 64 + m * 16 + fr);
#pragma unroll
                for (int bj = 0; bj < 2; ++bj) { const bf16_t* gp = proj + r * NPROJ + PC_BRG + (seg - 1) * DM + col0 + bj * HALF;
                    float ga[8], gb[8]; ldg8(gp, ga); ldg8(gp + DM, gb);
#pragma unroll
                    for (int n = 0; n < 2; ++n)
#pragma unroll
                        for (int j = 0; j < 4; ++j) acc[ai][bj][m][n][j] *= (1.f + __expf(-gb[4 * n + j])) * __builtin_amdgcn_rcpf(1.f + __expf(-ga[4 * n + j])); } }
    }
    DI void operator()(const f32x4 (&acc)[2][2][4][2], const Unit& u, int wr, int wc, int fr, int fq) const {
        const int col0 = u.pn * BM + wc * 32 + 8 * fq;
#pragma unroll
        for (int ai = 0; ai < 2; ++ai)
#pragma unroll
            for (int m = 0; m < 4; ++m) { const size_t r = (size_t)(u.pm * BM + ai * HALF + wr * 64 + m * 16 + fr);
#pragma unroll
                for (int bj = 0; bj < 2; ++bj) { float g[8]; ldg8(proj + r * NPROJ + PC_BRG + 2 * DM + col0 + bj * HALF, g); float v[8];
#pragma unroll
                    for (int n = 0; n < 2; ++n)
#pragma unroll
                        for (int j = 0; j < 4; ++j) v[4 * n + j] = acc[ai][bj][m][n][j] * __builtin_amdgcn_rcpf(1.f + __expf(-g[4 * n + j]));
                    u32x4 w; w.x = cvt_pk_bf16(v[0], v[1]); w.y = cvt_pk_bf16(v[2], v[3]); w.z = cvt_pk_bf16(v[4], v[5]); w.w = cvt_pk_bf16(v[6], v[7]);
                    *(u32x4*)(merged + r * DM + col0 + bj * HALF) = w; } }
    }
};
struct MergeOrder {
    StaticOrder so;
    DI bool next(int i, Unit& u) const { const int tl = i / 3, b = i - 3 * tl; Unit t; if (!so.next(tl, t)) return false; u.pm = b * 128 + t.pm; u.pn = b * 4 + t.pn; return true; }
    DI void a_ready(const Unit&) const {}
    DI void done(const Unit&) const {}
};
struct EpiRes {
    static constexpr bool PERM = false, AFTER_DRAIN = false;
    const float* base; float* out;
    DI void operator()(const f32x4 (&acc)[2][2][4][2], const Unit& u, int wr, int wc, int fr, int fq) const {
        const int col0 = u.pn * BM + wc * 32 + 4 * fq;
#pragma unroll
        for (int ai = 0; ai < 2; ++ai)
#pragma unroll
            for (int m = 0; m < 4; ++m) { const size_t r = (size_t)(u.pm * BM + ai * HALF + wr * 64 + m * 16 + fr);
#pragma unroll
                for (int bj = 0; bj < 2; ++bj)
#pragma unroll
                    for (int n = 0; n < 2; ++n) { const int c = col0 + bj * HALF + n * 16; *(f32x4*)(out + r * DM + c) = *(const f32x4*)(base + r * DM + c) + acc[ai][bj][m][n]; } }
    }
};
struct EpiSwiglu {
    static constexpr bool PERM = true, AFTER_DRAIN = false, PERM2 = true;
    unsigned char* act; const float* bgu;
    DI void operator()(const f32x4 (&acc)[2][2][4][2], const Unit& u, int wr, int wc, int fr, int fq) const {
        typedef unsigned u32x2v __attribute__((ext_vector_type(2)));
        const int e = u.pn >> 3, pnl = u.pn & 7;
        const unsigned lc0 = (unsigned)(pnl * BM + wc * 64 + 16 * fq);
        const unsigned row0 = (unsigned)(u.pm * BM + wr * 64 + fr);
        const float* bp = bgu + e * 2048 + lc0;
        f32x4 bv[2][2];
#pragma unroll
        for (int bj = 0; bj < 2; ++bj)
#pragma unroll
            for (int n = 0; n < 2; ++n) bv[bj][n] = *(const f32x4*)(bp + 8 * bj + 4 * n);
#pragma unroll
        for (int ai = 0; ai < 2; ++ai)
#pragma unroll
            for (int m = 0; m < 4; ++m) { const unsigned rowoff = (row0 + ai * HALF + m * 16) * (unsigned)DFF;
                int q8[2] = {0, 0};
#pragma unroll
                for (int bj = 0; bj < 2; ++bj) { float o[4];
#pragma unroll
                    for (int n = 0; n < 2; ++n) { const f32x4 v = acc[ai][bj][m][n] + bv[bj][n];
#pragma unroll
                        for (int q = 0; q < 2; ++q) { const float gt = fminf(v[2 * q], 7.0f); const float up = fminf(fmaxf(v[2 * q + 1], -7.0f), 7.0f);
                            o[2 * n + q] = (up + 1.0f) * (gt * __builtin_amdgcn_rcpf(1.f + __expf(-1.702f * gt))); } }
                    q8[bj] = __builtin_amdgcn_cvt_pk_fp8_f32(o[0], o[1], q8[bj], false); q8[bj] = __builtin_amdgcn_cvt_pk_fp8_f32(o[2], o[3], q8[bj], true); }
                *(u32x2v*)(act + (rowoff + (lc0 >> 1))) = (u32x2v){(unsigned)q8[0], (unsigned)q8[1]}; }
    }
};
struct EpiDown {
    static constexpr bool PERM = true, AFTER_DRAIN = false;
    bf16_t* y; const float* bdn; const float* roww;
    DI void operator()(const f32x4 (&acc)[2][2][4][2], const Unit& u, int wr, int wc, int fr, int fq) const {
        const int e = u.pn >> 2, pnl = u.pn & 3;
        const int col0 = pnl * BM + wc * 32 + 8 * fq;
        const float* bp = bdn + e * DM + col0;
        f32x4 bv[2][2];
#pragma unroll
        for (int bj = 0; bj < 2; ++bj) { bv[bj][0] = *(const f32x4*)(bp + bj * HALF); bv[bj][1] = *(const f32x4*)(bp + bj * HALF + 4); }
        const unsigned row0 = (unsigned)(u.pm * BM + wr * 64 + fr);
#pragma unroll
        for (int ai = 0; ai < 2; ++ai)
#pragma unroll
            for (int m = 0; m < 4; ++m) { const unsigned r = row0 + ai * HALF + m * 16; const float rw = roww[r]; const unsigned off = r * (unsigned)DM + (unsigned)col0;
#pragma unroll
                for (int bj = 0; bj < 2; ++bj) { const f32x4 v0 = (acc[ai][bj][m][0] + bv[bj][0]) * rw, v1 = (acc[ai][bj][m][1] + bv[bj][1]) * rw;
                    u32x4 w; w.x = cvt_pk_bf16(v0[0], v0[1]); w.y = cvt_pk_bf16(v0[2], v0[3]); w.z = cvt_pk_bf16(v1[0], v1[1]); w.w = cvt_pk_bf16(v1[2], v1[3]);
                    *(u32x4*)(y + (off + bj * HALF)) = w; } }
    }
};
template <int NPN> struct MoeOrder {
    int nblk, G, c; const PG8_LAS unsigned char* blk_e;
    DI bool next(int i, Unit& u) const {
        int rb, pn;
        if (G == 256) { const int x = c & 7, j = c >> 3; rb = i * (256 / NPN) + x * (32 / NPN) + j / NPN; pn = j % NPN; }
        else { const int L = i * G + c; rb = L / NPN; pn = L % NPN; }
        if (rb >= nblk) return false;
        u.pm = rb; u.pn = __builtin_amdgcn_readfirstlane((int)blk_e[rb]) * NPN + pn; return true; }
    DI void a_ready(const Unit&) const {}
    DI void done(const Unit&) const {}
};
}

struct Frame {
    LAS unsigned char* lds; volatile LAS unsigned* MISC; unsigned* ctl; unsigned char* ws;
    int wave, G, bx;
    DI int lane_id() const { int l; asm volatile("v_mbcnt_lo_u32_b32 %0, -1, 0\n\tv_mbcnt_hi_u32_b32 %0, -1, %0" : "=v"(l)); return l; }
    DI int tid_id() const { return wave * 64 + lane_id(); }
    const float* const* in; float* out;
};
enum { I_X = 0, I_MEM, I_GMIX, I_WIN, I_CONVW, I_CONVB, I_MLBI, I_MLBF, I_MLGOUT, I_NGQ, I_NGK, I_CPK, I_CW1K, I_CB1K, I_CW2K, I_CPV, I_CW1V, I_CB1V, I_CW2V,
       I_GMEM, I_WMKV, I_MGQ, I_MGK, I_WBRML, I_WBRNSA, I_WBRMEM, I_WOUT, I_GFFN, I_WR, I_BR, I_WGU, I_BGU, I_WDN, I_BDN, N_IN };

template <class CM>
DI void tr_item(const float* W, int ldw, int K, bf16* WT, int k0, int n0, CM cm, LAS float* scr, int lane) {
    const int sc = cm(n0 + (lane & 31));
#pragma unroll 8
    for (int i = 0; i < 32; ++i) { const int kk = 2 * i + (lane >> 5); scr[kk * 33 + (lane & 31)] = sc >= 0 ? W[(size_t)(k0 + kk) * ldw + sc] : 0.f; }
    LDS_WAIT(); asm volatile("" ::: "memory");
    const int c = lane & 7;
#pragma unroll
    for (int j = 0; j < 4; ++j) { const int n = (lane >> 3) + 8 * j; const LAS float* s = scr + (8 * c) * 33 + n;
        v4u o; o.x = pk2(s[0 * 33], s[1 * 33]); o.y = pk2(s[2 * 33], s[3 * 33]); o.z = pk2(s[4 * 33], s[5 * 33]); o.w = pk2(s[6 * 33], s[7 * 33]);
        *(v4u*)(WT + (size_t)(n0 + n) * K + k0 + 8 * c) = o; }
    LDS_WAIT(); asm volatile("" ::: "memory");
}
DI void tr_item_f8(const float* W, int ldw, int K, unsigned char* WT, int k0, int n0, LAS float* scr, int lane) {
#pragma unroll 8
    for (int i = 0; i < 32; ++i) { const int kk = 2 * i + (lane >> 5); scr[kk * 33 + (lane & 31)] = W[(size_t)(k0 + kk) * ldw + n0 + (lane & 31)] * 256.0f; }
    LDS_WAIT(); asm volatile("" ::: "memory");
    const int c = lane & 7;
#pragma unroll
    for (int j = 0; j < 4; ++j) { const int n = (lane >> 3) + 8 * j; const LAS float* sp = scr + (8 * c) * 33 + n;
        int lo = 0, hi = 0;
        lo = __builtin_amdgcn_cvt_pk_fp8_f32(sp[0 * 33], sp[1 * 33], lo, false); lo = __builtin_amdgcn_cvt_pk_fp8_f32(sp[2 * 33], sp[3 * 33], lo, true);
        hi = __builtin_amdgcn_cvt_pk_fp8_f32(sp[4 * 33], sp[5 * 33], hi, false); hi = __builtin_amdgcn_cvt_pk_fp8_f32(sp[6 * 33], sp[7 * 33], hi, true);
        typedef unsigned u32x2t __attribute__((ext_vector_type(2)));
        *(u32x2t*)(WT + (size_t)(n0 + n) * K + k0 + 8 * c) = (u32x2t){(unsigned)lo, (unsigned)hi}; }
    LDS_WAIT(); asm volatile("" ::: "memory");
}
DI void tr_load_v4(const float* W, int ldw, int k0, int n0, int lane, f32x4 (&v)[8]) {
#pragma unroll
    for (int i = 0; i < 8; ++i) v[i] = *(const f32x4*)(W + (size_t)(k0 + 8 * i + (lane >> 3)) * ldw + n0 + 4 * (lane & 7));
}
DI void tr_put_v4(const f32x4 (&v)[8], LAS float* scr, int lane, float mul) {
#pragma unroll
    for (int i = 0; i < 8; ++i) { LAS float* d = scr + (8 * i + (lane >> 3)) * 33 + 4 * (lane & 7); d[0] = v[i].x * mul; d[1] = v[i].y * mul; d[2] = v[i].z * mul; d[3] = v[i].w * mul; }
    LDS_WAIT(); asm volatile("" ::: "memory");
}
DI void tr_load_v4x16(const float* W, int ldw, int k0, int n0, int lane, f32x4 (&v)[16]) {
#pragma unroll
    for (int i = 0; i < 16; ++i) v[i] = *(const f32x4*)(W + (size_t)(k0 + 8 * i + (lane >> 3)) * ldw + n0 + 4 * (lane & 7));
}
DI void tr_put_v4x16(const f32x4 (&v)[16], LAS float* scr, int lane, float mul) {
#pragma unroll
    for (int i = 0; i < 16; ++i) { LAS float* d = scr + (8 * i + (lane >> 3)) * 33 + 4 * (lane & 7); d[0] = v[i].x * mul; d[1] = v[i].y * mul; d[2] = v[i].z * mul; d[3] = v[i].w * mul; }
    LDS_WAIT(); asm volatile("" ::: "memory");
}
DI void tr_emit_f8x16(unsigned char* WT, int K, int k0, int n0, LAS float* scr, int lane) {
    const int c = lane & 7;
#pragma unroll
    for (int j = 0; j < 4; ++j) { const int n = (lane >> 3) + 8 * j; const LAS float* sp = scr + (16 * c) * 33 + n; unsigned q[4];
#pragma unroll
        for (int h = 0; h < 4; ++h) { int w = 0; w = __builtin_amdgcn_cvt_pk_fp8_f32(sp[(4 * h) * 33], sp[(4 * h + 1) * 33], w, false); w = __builtin_amdgcn_cvt_pk_fp8_f32(sp[(4 * h + 2) * 33], sp[(4 * h + 3) * 33], w, true); q[h] = (unsigned)w; }
        *(v4u*)(WT + (size_t)(n0 + n) * K + k0 + 16 * c) = (v4u){q[0], q[1], q[2], q[3]}; }
    LDS_WAIT(); asm volatile("" ::: "memory");
}
DI void tr_fill_v4(const float* W, int ldw, int k0, int n0, LAS float* scr, int lane, float mul) { f32x4 v[8]; tr_load_v4(W, ldw, k0, n0, lane, v); tr_put_v4(v, scr, lane, mul); }
DI void tr_emit_bf16(bf16* WT, int K, int k0, int n0, LAS float* scr, int lane) {
    const int c = lane & 7;
#pragma unroll
    for (int j = 0; j < 4; ++j) { const int n = (lane >> 3) + 8 * j; const LAS float* sp = scr + (8 * c) * 33 + n;
        v4u o; o.x = pk2(sp[0 * 33], sp[1 * 33]); o.y = pk2(sp[2 * 33], sp[3 * 33]); o.z = pk2(sp[4 * 33], sp[5 * 33]); o.w = pk2(sp[6 * 33], sp[7 * 33]);
        *(v4u*)(WT + (size_t)(n0 + n) * K + k0 + 8 * c) = o; }
    LDS_WAIT(); asm volatile("" ::: "memory");
}
DI void tr_emit_f8(unsigned char* WT, int K, int k0, int n0, LAS float* scr, int lane) {
    const int c = lane & 7;
#pragma unroll
    for (int j = 0; j < 4; ++j) { const int n = (lane >> 3) + 8 * j; const LAS float* sp = scr + (8 * c) * 33 + n;
        int lo = 0, hi = 0;
        lo = __builtin_amdgcn_cvt_pk_fp8_f32(sp[0 * 33], sp[1 * 33], lo, false); lo = __builtin_amdgcn_cvt_pk_fp8_f32(sp[2 * 33], sp[3 * 33], lo, true);
        hi = __builtin_amdgcn_cvt_pk_fp8_f32(sp[4 * 33], sp[5 * 33], hi, false); hi = __builtin_amdgcn_cvt_pk_fp8_f32(sp[6 * 33], sp[7 * 33], hi, true);
        typedef unsigned u32x2t __attribute__((ext_vector_type(2)));
        *(u32x2t*)(WT + (size_t)(n0 + n) * K + k0 + 8 * c) = (u32x2t){(unsigned)lo, (unsigned)hi}; }
    LDS_WAIT(); asm volatile("" ::: "memory");
}
template <class CM>
DI void tr_fill_v4cm(const float* W, int ldw, int k0, int n0, CM cm, LAS float* scr, int lane, float mul) {
    const int sc = cm(n0 + 4 * (lane & 7)); f32x4 v[8];
#pragma unroll
    for (int i = 0; i < 8; ++i) v[i] = sc >= 0 ? *(const f32x4*)(W + (size_t)(k0 + 8 * i + (lane >> 3)) * ldw + sc) : (f32x4){0.f, 0.f, 0.f, 0.f};
    tr_put_v4(v, scr, lane, mul);
}
template <class CM>
DI void tr_fill_cm(const float* W, int ldw, int k0, int n0, CM cm, LAS float* scr, int lane, float mul) {
    const int sc = cm(n0 + (lane & 31));
#pragma unroll 8
    for (int i = 0; i < 32; ++i) { const int kk = 2 * i + (lane >> 5); scr[kk * 33 + (lane & 31)] = sc >= 0 ? W[(size_t)(k0 + kk) * ldw + sc] * mul : 0.f; }
    LDS_WAIT(); asm volatile("" ::: "memory");
}
struct CmId { DI int operator()(int j) const { return j; } };
struct CmProj { DI int operator()(int j) const { return proj_srccol(j); } };

DI void rms_row_bf16(const float* xrow, const float* g, bf16* orow, int lane) {
    const f32x4* xr = (const f32x4*)xrow + lane; const f32x4* gr = (const f32x4*)g + lane;
    f32x4 v[4]; float s = 0.f;
#pragma unroll
    for (int j = 0; j < 4; ++j) { v[j] = xr[64 * j]; s += (v[j].x * v[j].x + v[j].y * v[j].y) + (v[j].z * v[j].z + v[j].w * v[j].w); }
    const float rstd = rsqrtf(wave_sum(s) * (1.f / DM) + EPS);
    unsigned long long* o8 = (unsigned long long*)orow + lane;
#pragma unroll
    for (int j = 0; j < 4; ++j) { const f32x4 gg = gr[64 * j];
        o8[64 * j] = (unsigned long long)pk2(v[j].x * rstd * gg.x, v[j].y * rstd * gg.y) | ((unsigned long long)pk2(v[j].z * rstd * gg.z, v[j].w * rstd * gg.w) << 32); }
}

DI void rms_row_f8(const float* xrow, const float* g, unsigned char* orow, int lane) {
    const f32x4* xr = (const f32x4*)xrow + lane; const f32x4* gr = (const f32x4*)g + lane;
    f32x4 v[4]; float s = 0.f;
#pragma unroll
    for (int j = 0; j < 4; ++j) { v[j] = xr[64 * j]; s += (v[j].x * v[j].x + v[j].y * v[j].y) + (v[j].z * v[j].z + v[j].w * v[j].w); }
    const float rstd = rsqrtf(wave_sum(s) * (1.f / DM) + EPS);
    unsigned* o4 = (unsigned*)orow + lane;
#pragma unroll
    for (int j = 0; j < 4; ++j) { const f32x4 gg = gr[64 * j]; int q8 = 0;
        q8 = __builtin_amdgcn_cvt_pk_fp8_f32(v[j].x * rstd * gg.x, v[j].y * rstd * gg.y, q8, false); q8 = __builtin_amdgcn_cvt_pk_fp8_f32(v[j].z * rstd * gg.z, v[j].w * rstd * gg.w, q8, true);
        o4[64 * j] = (unsigned)q8; }
}
template <int NR>
DI void rms_rows_both(const float* x0, const float* g, bf16* o0, unsigned char* o80, size_t step, int lane) {
    const f32x4* gr = (const f32x4*)g + lane;
    f32x4 v[NR][4];
#pragma unroll
    for (int q = 0; q < NR; ++q) { const f32x4* xr = (const f32x4*)(x0 + q * step * DM) + lane;
#pragma unroll
        for (int j = 0; j < 4; ++j) v[q][j] = xr[64 * j]; }
#pragma unroll
    for (int q = 0; q < NR; ++q) { float s = 0.f;
#pragma unroll
        for (int j = 0; j < 4; ++j) s += (v[q][j].x * v[q][j].x + v[q][j].y * v[q][j].y) + (v[q][j].z * v[q][j].z + v[q][j].w * v[q][j].w);
        const float rstd = rsqrtf(wave_sum(s) * (1.f / DM) + EPS);
        unsigned long long* o8 = (unsigned long long*)(o0 + q * step * DM) + lane; unsigned* o4 = (unsigned*)(o80 + q * step * DM) + lane;
#pragma unroll
        for (int j = 0; j < 4; ++j) { const f32x4 gg = gr[64 * j]; const float y0 = v[q][j].x * rstd * gg.x, y1 = v[q][j].y * rstd * gg.y, y2 = v[q][j].z * rstd * gg.z, y3 = v[q][j].w * rstd * gg.w;
            o8[64 * j] = (unsigned long long)pk2(y0, y1) | ((unsigned long long)pk2(y2, y3) << 32);
            int q8 = 0; q8 = __builtin_amdgcn_cvt_pk_fp8_f32(y0, y1, q8, false); q8 = __builtin_amdgcn_cvt_pk_fp8_f32(y2, y3, q8, true);
            o4[64 * j] = (unsigned)q8; } }
}
template <int PARTS = 0xf>
DI void p0_prologue(Frame& F) {
    LAS float* scr = (LAS float*)(F.lds + F.wave * 16384);
    const int gw = F.bx * NWAVES + F.wave, NGW = F.G * NWAVES;
    unsigned char* ws = F.ws;
    constexpr int IT_IN = 16 * (NPROJ / 32), IT_GU = 32 * 16 * 64, IT_DN = 32 * 16 * 32, IT_MKV = 16 * 32, IT_BR = 3 * 8 * 32, IT_OUT = 16 * 32, IT_C1 = 2 * 32 * 8;
    constexpr int NITEMS = IT_IN + IT_GU + IT_DN + IT_MKV + IT_BR + IT_OUT + IT_C1;
    if (PARTS & 1)
    {
        constexpr int JT_GU = 32 * 8 * 64, JT_DN = 32 * 8 * 32;
        struct D { const float* src; unsigned char* dst; int ldw, k0, n0; };
        auto dec = [&](int j) { D d; if (j < JT_GU) { const int e = j / 512, q = j % 512; d.src = F.in[I_WGU] + (size_t)e * DM * 2048; d.dst = (unsigned char*)(ws + WS_WGU) + (size_t)e * 2048 * DM; d.ldw = 2048; d.k0 = 128 * (q / 64); d.n0 = 32 * (q % 64); }
                                     else { const int jj = j - JT_GU, e = jj / 256, q = jj % 256; d.src = F.in[I_WDN] + (size_t)e * DFF * DM; d.dst = (unsigned char*)(ws + WS_WDN) + (size_t)e * DM * DFF; d.ldw = DM; d.k0 = 128 * (q / 32); d.n0 = 32 * (q % 32); } return d; };
        const int lane = F.lane_id();
        LAS float* scr2 = (LAS float*)(F.wave < 7 ? F.lds + F.wave * 16896 : F.lds + 135424);
        int j = gw; f32x4 va[16]; D da{};
        if (j < JT_GU + JT_DN) { da = dec(j); tr_load_v4x16(da.src, da.ldw, da.k0, da.n0, lane, va); }
#pragma unroll 1
        while (j < JT_GU + JT_DN) {
            const int jn = j + NGW; f32x4 vb[16]; D db{};
            if (jn < JT_GU + JT_DN) { db = dec(jn); tr_load_v4x16(db.src, db.ldw, db.k0, db.n0, lane, vb); }
            else {
#pragma unroll
                for (int i = 0; i < 16; ++i) vb[i] = va[i]; }
            tr_put_v4x16(va, scr2, lane, 256.0f); tr_emit_f8x16(da.dst, 1024, da.k0, da.n0, scr2, lane);
#pragma unroll
            for (int i = 0; i < 16; ++i) va[i] = vb[i];
            da = db; j = jn;
        }
        __syncthreads();
    }
    if (PARTS & 2)
    for (int it = gw; it < NITEMS; it += NGW) {
        int r = it;
        if (r < IT_IN) { const int kb = r / (NPROJ / 32), nb = r % (NPROJ / 32); if (32 * nb < NB16) { tr_fill_v4cm(F.in[I_WIN], DIN_SRC, 64 * kb, 32 * nb, CmProj(), scr, F.lane_id(), 1.0f); tr_emit_bf16((bf16*)(ws + WS_WIN), DM, 64 * kb, 32 * nb, scr, F.lane_id()); }
            else { tr_fill_v4cm(F.in[I_WIN], DIN_SRC, 64 * kb, 32 * nb, CmProj(), scr, F.lane_id(), 256.0f); tr_emit_f8((unsigned char*)(ws + WS_WIN8), DM, 64 * kb, 32 * nb - NB16, scr, F.lane_id()); }
            continue; } r -= IT_IN;
        if (r < IT_GU + IT_DN) continue; r -= IT_GU + IT_DN;
        if (r < IT_MKV) { const int kb = r / 32, nb = r % 32; tr_fill_v4(F.in[I_WMKV], 1024, 64 * kb, 32 * nb, scr, F.lane_id(), 1.0f); tr_emit_bf16((bf16*)(ws + WS_WMKV), 1024, 64 * kb, 32 * nb, scr, F.lane_id()); continue; } r -= IT_MKV;
        if (r < IT_BR) { const int b = r / 256, q = r % 256, kb = q / 32, nb = q % 32; tr_fill_v4(F.in[I_WBRML + b], 1024, 64 * kb, 32 * nb, scr, F.lane_id(), 1.0f); tr_emit_bf16((bf16*)(ws + WS_WBR), 1536, 512 * b + 64 * kb, 32 * nb, scr, F.lane_id()); continue; } r -= IT_BR;
        if (r < IT_OUT) { const int kb = r / 32, nb = r % 32; tr_fill_v4(F.in[I_WOUT], 1024, 64 * kb, 32 * nb, scr, F.lane_id(), 1.0f); tr_emit_bf16((bf16*)(ws + WS_WOUT), 1024, 64 * kb, 32 * nb, scr, F.lane_id()); continue; } r -= IT_OUT;
        { const int kv = r / 256, q = r % 256, kb = q / 8, nb = q % 8; tr_fill_v4(F.in[kv ? I_CW1V : I_CW1K], 256, 64 * kb, 32 * nb, scr, F.lane_id(), 1.0f); tr_emit_bf16((bf16*)(ws + WS_WC1) + (size_t)kv * 256 * 2048, 2048, 64 * kb, 32 * nb, scr, F.lane_id()); }
    }
    if (PARTS & 4)
    { int m = gw;
      for (; m + 3 * NGW < MT; m += 4 * NGW) rms_rows_both<4>(F.in[I_X] + (size_t)m * DM, F.in[I_GMIX], (bf16*)(ws + WS_R1) + (size_t)m * DM, (unsigned char*)(ws + WS_U8) + (size_t)m * DM, (size_t)NGW, F.lane_id());
      for (; m < MT; m += NGW) rms_rows_both<1>(F.in[I_X] + (size_t)m * DM, F.in[I_GMIX], (bf16*)(ws + WS_R1) + (size_t)m * DM, (unsigned char*)(ws + WS_U8) + (size_t)m * DM, (size_t)NGW, F.lane_id()); }
    for (int m = gw; m < MROWS; m += NGW) rms_row_bf16(F.in[I_MEM] + (size_t)m * DM, F.in[I_GMEM], (bf16*)(ws + WS_MEMN) + (size_t)m * DM, F.lane_id());
    float* rc = (float*)(ws + WS_SMALL + SM_ROPEC); float* rs = (float*)(ws + WS_SMALL + SM_ROPES);
    for (int i = F.bx * 512 + F.tid_id(); i < SEQ * 32; i += F.G * 512) {
        const int p = i >> 5, k = i & 31;
        const float invf = exp2f(-(float)k * (13.287712379549449f / 32.0f));
        const float ang = (float)p * invf;
        const float kf = rintf(ang * 0.15915494309189535f);
        float r = fmaf(-kf, 6.28125f, ang); r = fmaf(-kf, 1.9353071795864769e-3f, r);
        rc[i] = cosf(r); rs[i] = sinf(r);
    }
    { bf16* wrt = (bf16*)(ws + WS_SMALL + SM_WRT);
      for (int i = F.bx * 512 + F.tid_id(); i < 32 * 1024; i += F.G * 512) { const int e = i >> 10, k = i & 1023; const float w = F.in[I_WR][k * 32 + e]; const unsigned hi = f2bf(w); wrt[i] = (bf16)hi; wrt[32 * 1024 + i] = (bf16)f2bf(w - __uint_as_float(hi << 16)); } }
    { bf16* w2t = (bf16*)(ws + WS_SMALL + SM_W2T);
      for (int i = F.bx * 512 + F.tid_id(); i < 2 * 64 * 256; i += F.G * 512) { const int kv = i >> 14, d = (i >> 8) & 63, f = i & 255; w2t[i] = (bf16)f2bf(F.in[kv ? I_CW2V : I_CW2K][f * 64 + d]); } }
    for (int o = gw; o < 512; o += NGW) {
        const int kv = o >> 8, f = o & 255, lane = F.lane_id();
        const float* pe = F.in[kv ? I_CPV : I_CPK]; const float* w1 = F.in[kv ? I_CW1V : I_CW1K];
        float wv[32], pv[32];
#pragma unroll
        for (int i = 0; i < 32; ++i) { const int k = lane + 64 * i; wv[i] = w1[(size_t)k * 256 + f]; pv[i] = pe[k]; }
        float a = 0.f;
#pragma unroll
        for (int i = 0; i < 32; ++i) a = fmaf(pv[i], wv[i], a);
        a = wave_sum(a);
        if (lane == 0) ((float*)(ws + WS_SMALL + SM_CBIAS))[o] = a + F.in[kv ? I_CB1V : I_CB1K][f];
    }
}

DI void unpack8(const v4u& w, float (&f)[8]) {
    f[0] = __uint_as_float(w.x << 16); f[1] = __uint_as_float(w.x & 0xffff0000u); f[2] = __uint_as_float(w.y << 16); f[3] = __uint_as_float(w.y & 0xffff0000u);
    f[4] = __uint_as_float(w.z << 16); f[5] = __uint_as_float(w.z & 0xffff0000u); f[6] = __uint_as_float(w.w << 16); f[7] = __uint_as_float(w.w & 0xffff0000u);
}
DI v4u pack8f(const float (&f)[8]) { v4u o; o.x = pk2(f[0], f[1]); o.y = pk2(f[2], f[3]); o.z = pk2(f[4], f[5]); o.w = pk2(f[6], f[7]); return o; }
DI void load8f(const float* p, float (&f)[8]) { const f32x4 a = *(const f32x4*)p, b = *(const f32x4*)(p + 4); f[0] = a.x; f[1] = a.y; f[2] = a.z; f[3] = a.w; f[4] = b.x; f[5] = b.y; f[6] = b.z; f[7] = b.w; }
DI void norm_rope64(float (&f)[8], const float (&g)[8], const float (&c8)[8], const float (&s8)[8], int lane, float scale) {
    float ss = 0.f;
#pragma unroll
    for (int i = 0; i < 8; ++i) ss = fmaf(f[i], f[i], ss);
    ss += __shfl_xor(ss, 1); ss += __shfl_xor(ss, 2); ss += __shfl_xor(ss, 4);
    const float rstd = rsqrtf(ss * (1.f / 64.f) + EPS);
    const bool hi = (lane & 4) != 0;
#pragma unroll
    for (int i = 0; i < 8; ++i) { const float y = f[i] * rstd * g[i]; const float pt = __shfl_xor(y, 4); f[i] = (hi ? fmaf(pt, s8[i], y * c8[i]) : fmaf(-pt, s8[i], y * c8[i])) * scale; }
}
DI void p2_prep(Frame& F) {
    unsigned char* ws = F.ws;
    const int ncg = F.G >= 64 ? 32 : 0;
    if (F.bx < ncg) return;
    const int gw = (F.bx - ncg) * NWAVES + F.wave, NGW = (F.G - ncg) * NWAVES, lane = F.lane_id();
    const bf16* proj = (const bf16*)(ws + WS_PROJ);
    const float* rc = (const float*)(ws + WS_SMALL + SM_ROPEC); const float* rs = (const float*)(ws + WS_SMALL + SM_ROPES);
    bf16* qn = (bf16*)(ws + WS_QN); bf16* ksn = (bf16*)(ws + WS_KSN); bf16* kwn = (bf16*)(ws + WS_KWN); bf16* mqn = (bf16*)(ws + WS_MQN); bf16* mlqk = (bf16*)(ws + WS_MLQK);
    constexpr int NT = 4;
    {
        float gq8[8], mg8[8]; load8f(F.in[I_NGQ] + 8 * (lane & 7), gq8); load8f(F.in[I_MGQ] + 8 * (lane & 15), mg8);
        for (int t0 = gw * NT; t0 < MT; t0 += NGW * NT) {
            v4u a[NT], bq[NT]; float c8[NT][8], s8[NT][8];
#pragma unroll
            for (int u = 0; u < NT; ++u) { const int t = t0 + u, tau = t & 2047; const bf16* pr = proj + (size_t)t * NPROJ;
                a[u] = *(const v4u*)(pr + PC_NQ + 8 * lane); bq[u] = *(const v4u*)(pr + PC_MQ + 8 * lane);
                load8f(rc + tau * 32 + 8 * (lane & 3), c8[u]); load8f(rs + tau * 32 + 8 * (lane & 3), s8[u]); }
#pragma unroll
            for (int u = 0; u < NT; ++u) { const int t = t0 + u;
                float f[8]; unpack8(a[u], f);
                norm_rope64(f, gq8, c8[u], s8[u], lane, 0.125f * 1.4426950408889634f);
                *(v4u*)(qn + (size_t)t * 512 + 8 * lane) = pack8f(f);
                unpack8(bq[u], f);
                float ss = 0.f;
#pragma unroll
                for (int i = 0; i < 8; ++i) ss = fmaf(f[i], f[i], ss);
                ss += __shfl_xor(ss, 1); ss += __shfl_xor(ss, 2); ss += __shfl_xor(ss, 4); ss += __shfl_xor(ss, 8);
                const float rstd = rsqrtf(ss * (1.f / 128.f) + EPS) * (0.08838834764831845f * 1.4426950408889634f);
#pragma unroll
                for (int i = 0; i < 8; ++i) f[i] *= rstd * mg8[i];
                *(v4u*)(mqn + (size_t)t * 512 + 8 * lane) = pack8f(f);
                }
        }
    }
    {
        const int L = lane & 31, hd4 = L >> 3, j = L & 7, half = lane >> 5;
        float gk8[8]; load8f(F.in[I_NGK] + (1 + (hd4 >> 1)) * 64 + 8 * j, gk8);
        const int kcol = (hd4 < 2 ? PC_NKS + hd4 * 64 : PC_NKW + (hd4 - 2) * 64) + 8 * j;
        bf16* kdst = (hd4 < 2 ? ksn : kwn) + (hd4 & 1) * 64 + 8 * j;
        const int wv = L >> 4, jj = L & 15;
        bf16* vdst = (bf16*)(ws + (wv ? WS_VWN : WS_VSN)) + 8 * jj; const int vcol = (wv ? PC_NVW : PC_NVS) + 8 * jj;
        for (int tp0 = gw * NT; tp0 < MT / 2; tp0 += NGW * NT) {
            v4u a[NT]; float c8[NT][8], s8[NT][8];
#pragma unroll
            for (int u = 0; u < NT; ++u) { const int t = 2 * (tp0 + u) + half, tau = t & 2047; const bf16* pr = proj + (size_t)t * NPROJ;
                a[u] = *(const v4u*)(pr + kcol);
                load8f(rc + tau * 32 + 8 * (lane & 3), c8[u]); load8f(rs + tau * 32 + 8 * (lane & 3), s8[u]); }
#pragma unroll
            for (int u = 0; u < NT; ++u) { const int t = 2 * (tp0 + u) + half;
                float f[8]; unpack8(a[u], f);
                norm_rope64(f, gk8, c8[u], s8[u], lane, 1.0f);
                *(v4u*)(kdst + (size_t)t * 128) = pack8f(f); }
        }
    }
    for (int run = gw; run < MT / 16; run += NGW) {
        const int t0 = run * 16, tau0 = t0 & 2047;
#pragma unroll 1
        for (int sp = 0; sp < 2; ++sp) {
            const int ch = 512 * sp + 8 * lane;
            float w0[8], w1[8], w2[8], w3[8], bb[8];
            load8f(F.in[I_CONVW] + ch, w0); load8f(F.in[I_CONVW] + 1024 + ch, w1); load8f(F.in[I_CONVW] + 2048 + ch, w2); load8f(F.in[I_CONVW] + 3072 + ch, w3); load8f(F.in[I_CONVB] + ch, bb);
            float x0[8], x1[8], x2[8];
            if (tau0 >= 3) { unpack8(*(const v4u*)(proj + (size_t)(t0 - 3) * NPROJ + ch), x0); unpack8(*(const v4u*)(proj + (size_t)(t0 - 2) * NPROJ + ch), x1); unpack8(*(const v4u*)(proj + (size_t)(t0 - 1) * NPROJ + ch), x2); }
            else {
#pragma unroll
                for (int i = 0; i < 8; ++i) { x0[i] = 0.f; x1[i] = 0.f; x2[i] = 0.f; } }
#pragma unroll 1
            for (int k0 = 0; k0 < 16; k0 += 4) {
                v4u raw[4];
#pragma unroll
                for (int k = 0; k < 4; ++k) raw[k] = *(const v4u*)(proj + (size_t)(t0 + k0 + k) * NPROJ + ch);
#pragma unroll
                for (int k = 0; k < 4; ++k) { float x3[8], y[8]; unpack8(raw[k], x3);
#pragma unroll
                    for (int i = 0; i < 8; ++i) { const float a = fmaf(w3[i], x3[i], fmaf(w2[i], x2[i], fmaf(w1[i], x1[i], fmaf(w0[i], x0[i], bb[i])))); y[i] = a * sigm(a); x0[i] = x1[i]; x1[i] = x2[i]; x2[i] = x3[i]; }
                    *(v4u*)(mlqk + (size_t)(t0 + k0 + k) * 1024 + ch) = pack8f(y); }
            }
        }
    }
    {
        const bf16* memkv = (const bf16*)(ws + WS_MEMKV); bf16* memkn = (bf16*)(ws + WS_MEMKN);
        float kg8[8]; load8f(F.in[I_MGK] + 8 * (lane & 15), kg8);
        for (int r = gw; r < MROWS; r += NGW) {
            float f[8]; unpack8(*(const v4u*)(memkv + (size_t)r * 1024 + 8 * lane), f);
            float ss = 0.f;
#pragma unroll
            for (int i = 0; i < 8; ++i) ss = fmaf(f[i], f[i], ss);
            ss += __shfl_xor(ss, 1); ss += __shfl_xor(ss, 2); ss += __shfl_xor(ss, 4); ss += __shfl_xor(ss, 8);
            const float rstd = rsqrtf(ss * (1.f / 128.f) + EPS);
#pragma unroll
            for (int i = 0; i < 8; ++i) f[i] *= rstd * kg8[i];
            *(v4u*)(memkn + (size_t)r * 512 + 8 * lane) = pack8f(f);
        }
    }
}

DI void p4_kcvc(Frame& F) {
    unsigned char* ws = F.ws;
    const int gw = F.bx * NWAVES + F.wave, NGW = F.G * NWAVES, lane = F.lane_id();
    const bf16* hid = (const bf16*)(ws + WS_HID);
    const float* rc = (const float*)(ws + WS_SMALL + SM_ROPEC); const float* rs = (const float*)(ws + WS_SMALL + SM_ROPES);
    const float gk = F.in[I_NGK][lane];
    for (int it = gw; it < 2 * 4096; it += NGW) {
        const int kv = it >> 12, r = it & 4095, n = r & 127;
        bf16* dst = (bf16*)(ws + (kv ? WS_VC : WS_KC)) + (size_t)r * 64 + lane;
        if (n == 127) { *dst = 0; continue; }
        const bf16* hr = hid + (size_t)kv * 4096 * 256 + (size_t)r * 256; const float* w2 = F.in[kv ? I_CW2V : I_CW2K];
        float a = 0.f;
        for (int f = 0; f < 256; ++f) a = fmaf(bf2f(hr[f]), w2[f * 64 + lane], a);
        if (kv == 0) {
            const float y = a * rsqrtf(wave_sum(a * a) * (1.f / 64.f) + EPS) * gk;
            const int pos = 16 * n + 31; const float c = rc[pos * 32 + (lane & 31)], s = rs[pos * 32 + (lane & 31)];
            const float pt = __shfl_xor(y, 32);
            a = lane < 32 ? y * c - pt * s : y * c + pt * s;
        }
        *dst = (bf16)f2bf(a);
    }
}

typedef float f32x16 __attribute__((ext_vector_type(16)));
typedef float f32x2v __attribute__((ext_vector_type(2)));
typedef __bf16 bf16x2v __attribute__((ext_vector_type(2)));
typedef short s16x4 __attribute__((ext_vector_type(4)));
typedef unsigned u32x2 __attribute__((ext_vector_type(2)));
#define MFMA32(a, b, c) __builtin_amdgcn_mfma_f32_32x32x16_bf16((a), (b), (c), 0, 0, 0)
#define WG_BAR() do { asm volatile("s_waitcnt vmcnt(0) lgkmcnt(0)" ::: "memory"); __builtin_amdgcn_s_barrier(); asm volatile("" ::: "memory"); } while (0)
DI unsigned pkbf(float lo, float hi) { f32x2v v = {lo, hi}; return __builtin_bit_cast(unsigned, __builtin_convertvector(v, bf16x2v)); }
template <int S> DI bf16x8 pack8(const f32x16& x) {
    v4u p; p.x = pkbf(x[8 * S], x[8 * S + 1]); p.y = pkbf(x[8 * S + 2], x[8 * S + 3]); p.z = pkbf(x[8 * S + 4], x[8 * S + 5]); p.w = pkbf(x[8 * S + 6], x[8 * S + 7]);
    return __builtin_bit_cast(bf16x8, p);
}
DI int crow(int i, int h) { return (i & 3) + 8 * (i >> 2) + 4 * h; }
constexpr int AT_K = 0, AT_V = 32768, AT_IMP = 65536, AT_WM = 98304, AT_INV = 98368, AT_SC = 99392;

DI void glds16(const void* gsrc, unsigned lds_dst) { unsigned keep; asm volatile("s_mov_b32 %0, m0\n\ts_mov_b32 m0, %2\n\ts_nop 0\n\tglobal_load_lds_dwordx4 %1, off\n\ts_mov_b32 m0, %0" : "=&s"(keep) : "v"(gsrc), "s"(lds_dst) : "memory"); }
DI void at_load(LAS unsigned char* lds, int par, const void* kb, size_t kpitch, const void* vb, size_t vpitch, int wave, int lane) {
    const int row = 8 * wave + (lane >> 3), pc = lane & 7;
    const int kc = pc ^ ((row >> 1) & 7), vc = pc ^ (((row >> 1) & 1) << 2);
    glds16((const char*)kb + (size_t)row * kpitch + 16 * kc, (unsigned)(size_t)(lds + AT_K + par * 8192 + wave * 1024));
    glds16((const char*)vb + (size_t)row * vpitch + 16 * vc, (unsigned)(size_t)(lds + AT_V + par * 8192 + wave * 1024));
}
#define SB() __builtin_amdgcn_sched_barrier(0)
typedef __attribute__((address_space(3))) s16x4 lds_s16x4;
DI void at_qk(const LAS unsigned char* kbuf, const int (&ka)[4], const bf16x8 (&qf)[4], f32x16 (&s)[2]) {
    bf16x8 kf[2][4];
#pragma unroll
    for (int kb = 0; kb < 2; ++kb)
#pragma unroll
        for (int st = 0; st < 4; ++st) kf[kb][st] = *(const LAS bf16x8*)(kbuf + ka[st] + kb * 4096);
    SB();
#pragma unroll
    for (int kb = 0; kb < 2; ++kb) {
        f32x16 a;
#pragma unroll
        for (int i = 0; i < 16; ++i) a[i] = 0.f;
#pragma unroll
        for (int st = 0; st < 4; ++st) a = MFMA32(kf[kb][st], qf[st], a);
        s[kb] = a;
    }
}
DI void at_vload(const LAS unsigned char* vbuf, const int (&va)[2], int kb, bf16x8 (&vf)[2][2]) {
#pragma unroll
    for (int s2 = 0; s2 < 2; ++s2)
#pragma unroll
        for (int db = 0; db < 2; ++db) {
            const s16x4 lo = __builtin_amdgcn_ds_read_tr16_b64_v4i16((lds_s16x4*)(vbuf + va[db] + kb * 4096 + s2 * 2048));
            const s16x4 hi = __builtin_amdgcn_ds_read_tr16_b64_v4i16((lds_s16x4*)(vbuf + va[db] + kb * 4096 + s2 * 2048 + 1024));
            vf[s2][db] = __builtin_shufflevector(lo, hi, 0, 1, 2, 3, 4, 5, 6, 7); }
}
DI void at_pv1(const bf16x8 (&vf)[2][2], const f32x16& p, f32x16 (&o)[2]) {
    const bf16x8 pf0 = pack8<0>(p), pf1 = pack8<1>(p);
#pragma unroll
    for (int s2 = 0; s2 < 2; ++s2)
#pragma unroll
        for (int db = 0; db < 2; ++db) o[db] = MFMA32(vf[s2][db], s2 ? pf1 : pf0, o[db]);
}
DI void at_pv(const LAS unsigned char* vbuf, const int (&va)[2], const bf16x8 (&vf0)[2][2], const f32x16 (&p)[2], f32x16 (&o)[2]) {
    bf16x8 vf1[2][2]; at_vload(vbuf, va, 1, vf1);
    at_pv1(vf0, p[0], o);
    at_pv1(vf1, p[1], o);
}
DI void at_exp_all(f32x16 (&s)[2], float& l) {
#pragma unroll
    for (int kb = 0; kb < 2; ++kb)
#pragma unroll
        for (int i = 0; i < 16; ++i) { const float p = __builtin_amdgcn_exp2f(s[kb][i]); s[kb][i] = p; l += p; }
}
DI void at_wait(int n) {
    if (n >= 2) asm volatile("s_waitcnt vmcnt(4)" ::: "memory"); else if (n == 1) asm volatile("s_waitcnt vmcnt(2)" ::: "memory"); else asm volatile("s_waitcnt vmcnt(0)" ::: "memory");
    asm volatile("s_waitcnt lgkmcnt(0)" ::: "memory"); __builtin_amdgcn_s_barrier(); asm volatile("" ::: "memory");
}
template <bool STORE = true, bool DO_CMP = true, bool DO_SEL = true, bool DO_WIN = true>
DI void nsa_unit(Frame& F, int unit) {
    unsigned char* ws = F.ws; LAS unsigned char* lds = F.lds;
    int lane_ = F.lane_id();
    const int lane = lane_, wave = F.wave, r = lane & 31, h = lane >> 5, g = wave >> 1, qh = wave & 1;
    const int bh = unit & 31, qt = 31 - (unit >> 5), b = bh >> 1, hkv = bh & 1;
    const int qloc = 32 * qh + r, tau = 64 * qt + qloc, qq = tau & 63; const size_t t = (size_t)b * SEQ + tau;
    const bf16* proj = (const bf16*)(ws + WS_PROJ);
    const bf16* qn = (const bf16*)(ws + WS_QN); const bf16* ksn = (const bf16*)(ws + WS_KSN); const bf16* kwn = (const bf16*)(ws + WS_KWN);
    const bf16* kc = (const bf16*)(ws + WS_KC); const bf16* vc = (const bf16*)(ws + WS_VC); bf16* H1 = (bf16*)(ws + WS_H0);
    int ka[4], va[2];
    { const int f = (r >> 1) & 7, fs = f >> 1, hb = h ^ (f & 1);
#pragma unroll
      for (int st = 0; st < 4; ++st) ka[st] = r * 128 + 16 * (((st ^ fs) << 1) | hb);
      const int i16 = lane & 15, q = i16 >> 2, p = i16 & 3, g1 = (lane >> 4) & 1;
#pragma unroll
      for (int db = 0; db < 2; ++db) va[db] = (4 * h + q) * 128 + 16 * ((4 * db + 2 * g1 + (p >> 1)) ^ (((q >> 1) & 1) << 2)) + 8 * (p & 1); }
    bf16x8 qf[4];
#pragma unroll
    for (int st = 0; st < 4; ++st) qf[st] = *(const bf16x8*)(qn + t * 512 + (hkv * 4 + g) * 64 + 16 * st + 8 * h);
    float gate[3];
#pragma unroll
    for (int c = 0; c < 3; ++c) gate[c] = sigm(bf2f(proj[t * NPROJ + PC_NG + (hkv * 4 + g) * 3 + c]));
    f32x16 ofin[2];
#pragma unroll
    for (int i = 0; i < 16; ++i) { ofin[0][i] = 0.f; ofin[1][i] = 0.f; }
    WG_BAR();
    if (DO_CMP) {
        const int ncq = tau >= 31 ? ((tau - 31) >> 4) + 1 : 0;
        const int ntc = (((64 * qt + 63 - 31) >> 4) + 1 > 64) ? 2 : 1;
        const char* kb0 = (const char*)(kc + (size_t)(b * 2 + hkv) * 128 * 64); const char* vb0 = (const char*)(vc + (size_t)(b * 2 + hkv) * 128 * 64);
        at_load(lds, 0, kb0, 128, vb0, 128, wave, lane);
        if (ntc == 2) at_load(lds, 1, kb0 + 64 * 128, 128, vb0 + 64 * 128, 128, wave, lane);
        WG_BAR();
        f32x16 o[2]; float l = 0.f, prevEp = 0.f;
#pragma unroll
        for (int i = 0; i < 16; ++i) { o[0][i] = 0.f; o[1][i] = 0.f; }
        LAS float* I = (LAS float*)(lds + AT_IMP) + (g * 64 + qloc) * 32;
#pragma unroll 1
        for (int tile = 0; tile < 2; ++tile) {
            if (tile < ntc) {
                f32x16 s[2];
                at_qk(lds + AT_K + tile * 8192, ka, qf, s);
                bf16x8 vf[2][2]; at_vload(lds + AT_V + tile * 8192, va, 0, vf); SB();
#pragma unroll
                for (int kb = 0; kb < 2; ++kb)
#pragma unroll
                    for (int i = 0; i < 16; ++i) { const int n = 64 * tile + 32 * kb + crow(i, h); const float p = n < ncq ? __builtin_amdgcn_exp2f(s[kb][i]) : 0.f; s[kb][i] = p; l += p; }
#pragma unroll
                for (int kb = 0; kb < 2; ++kb)
#pragma unroll
                    for (int a = 0; a < 4; ++a) { const int idx = tile * 8 + kb * 4 + a; const float Gv = (s[kb][4 * a] + s[kb][4 * a + 1]) + (s[kb][4 * a + 2] + s[kb][4 * a + 3]);
                        const float Epv = __shfl_xor(s[kb][4 * a + 3], 32);
                        I[2 * idx + h] = Gv + (h ? Epv : prevEp); prevEp = Epv; }
                at_pv(lds + AT_V + tile * 8192, va, vf, s, o);
            } else {
#pragma unroll
                for (int idx = 8; idx < 16; ++idx) I[2 * idx + h] = 0.f;
            }
        }
        const float L = l + __shfl_xor(l, 32); const float inv = L > 0.f ? 1.f / L : 0.f;
        const float gi = gate[0] * inv;
#pragma unroll
        for (int i = 0; i < 16; ++i) { ofin[0][i] += gi * o[0][i]; ofin[1][i] += gi * o[1][i]; }
        if (h == 0) ((LAS float*)(lds + AT_INV))[g * 64 + qloc] = inv;
    }
    WG_BAR();
    unsigned sel = 0u, wm = 0u, um = 0u;
    if (!DO_CMP) { sel = (qt == 31) ? 0xffffffffu : ((1u << (qt + 1)) - 1u); wm = sel; um = sel; }
    else {
        const LAS float* I = (const LAS float*)(lds + AT_IMP) + qloc * 32;
        const LAS float* IV = (const LAS float*)(lds + AT_INV) + qloc;
        const float iv0 = IV[0], iv1 = IV[64], iv2 = IV[128], iv3 = IV[192];
        LAS unsigned* SC = (LAS unsigned*)(lds + AT_SC) + (qh * 32 + r) * 33;
        if (g == 0 && h == 0) {
#pragma unroll 8
            for (int j = 0; j < 32; ++j) { const float imp = (I[j] * iv0 + I[64 * 32 + j] * iv1) + (I[2 * 64 * 32 + j] * iv2 + I[3 * 64 * 32 + j] * iv3);
                const bool cand = (j >= 1) && (j <= qt - 2);
                SC[j] = cand ? ((__float_as_uint(imp) & ~31u) | (unsigned)(31 - j)) + 32u : 0u; }
        }
        WG_BAR();
        if (qt <= 7) sel = (1u << (qt + 1)) - 1u;
        else {
            sel = 1u | (1u << qt) | (1u << (qt - 1));
            unsigned prev = 0xffffffffu;
#pragma unroll 1
            for (int rd = 0; rd < 5; ++rd) { unsigned best = 0u;
#pragma unroll 8
                for (int j = 0; j < 32; ++j) { const unsigned kx = SC[j]; const unsigned cnd = kx < prev ? kx : 0u; best = cnd > best ? cnd : best; }
                prev = best; if (best) sel |= 1u << (31 - (int)(best & 31u)); }
        }
        sel &= (qt == 31) ? 0xffffffffu : ((1u << (qt + 1)) - 1u);
        wm = sel;
#pragma unroll
        for (int o = 1; o < 32; o <<= 1) wm |= (unsigned)__shfl_xor((int)wm, o);
        wm = (unsigned)__builtin_amdgcn_readfirstlane((int)wm);
        if (lane == 0) ((LAS unsigned*)(lds + AT_WM))[wave] = wm;
        WG_BAR();
        um = 0u;
#pragma unroll
        for (int w = 0; w < 8; ++w) um |= ((const LAS unsigned*)(lds + AT_WM))[w];
        um = (unsigned)__builtin_amdgcn_readfirstlane((int)um);
    }
    if (DO_SEL) {
        f32x16 o[2]; float l = 0.f;
#pragma unroll
        for (int i = 0; i < 16; ++i) { o[0][i] = 0.f; o[1][i] = 0.f; }
        const char* kbase = (const char*)(ksn + (size_t)b * SEQ * 128 + hkv * 64); const char* vbase = (const char*)(proj + (size_t)b * SEQ * NPROJ + PC_NVS + hkv * 64);
        unsigned rem = um, im = um; int k = 0; const int T = __popc(um);
#pragma unroll 1
        for (int i = 0; i < 3 && im; ++i) { const int jn = __ffs((int)im) - 1; im &= im - 1u; at_load(lds, i, kbase + (size_t)jn * 64 * 256, 256, vbase + (size_t)jn * 64 * (NPROJ * 2), NPROJ * 2, wave, lane); }
#pragma unroll 1
        while (rem) {
            const int j = __ffs((int)rem) - 1; rem &= rem - 1u;
            at_wait(T - k - 1);
#ifdef NSA_E1
            at_wait(T - k - 1);
#endif
            if (im) { const int jn = __ffs((int)im) - 1; im &= im - 1u; at_load(lds, (k + 3) & 3, kbase + (size_t)jn * 64 * 256, 256, vbase + (size_t)jn * 64 * (NPROJ * 2), NPROJ * 2, wave, lane); }
            const int par = k & 3;
            if ((wm >> j) & 1u) {
                f32x16 s[2];
                at_qk(lds + AT_K + par * 8192, ka, qf, s);
                bf16x8 vf[2][2]; at_vload(lds + AT_V + par * 8192, va, 0, vf); SB();
                const bool on = (sel >> j) & 1u;
                if (j != qt && __all(on)) at_exp_all(s, l);
                else { const int klim = j == qt ? qq : 63;
#pragma unroll
                    for (int kb = 0; kb < 2; ++kb)
#pragma unroll
                        for (int i = 0; i < 16; ++i) { const int key = 32 * kb + crow(i, h); const float p = (on && key <= klim) ? __builtin_amdgcn_exp2f(s[kb][i]) : 0.f; s[kb][i] = p; l += p; } }
                at_pv(lds + AT_V + par * 8192, va, vf, s, o);
            }
            ++k;
        }
        const float L = l + __shfl_xor(l, 32); const float gi = gate[1] * (L > 0.f ? 1.f / L : 0.f);
#pragma unroll
        for (int i = 0; i < 16; ++i) { ofin[0][i] += gi * o[0][i]; ofin[1][i] += gi * o[1][i]; }
    }
    WG_BAR();
    if (DO_WIN) {
        f32x16 o[2]; float l = 0.f;
#pragma unroll
        for (int i = 0; i < 16; ++i) { o[0][i] = 0.f; o[1][i] = 0.f; }
        const char* kbase = (const char*)(kwn + (size_t)b * SEQ * 128 + hkv * 64); const char* vbase = (const char*)(proj + (size_t)b * SEQ * NPROJ + PC_NVW + hkv * 64);
        const int jlo = qt > 8 ? qt - 8 : 0; const int T = qt - jlo + 1;
#ifdef NSA_E2
        f32x16 o2[2]; float l2 = 0.f;
#pragma unroll
        for (int i = 0; i < 16; ++i) { o2[0][i] = 0.f; o2[1][i] = 0.f; }
#endif
#pragma unroll 1
        for (int i = 0; i < 3 && i < T; ++i) at_load(lds, i, kbase + (size_t)(jlo + i) * 64 * 256, 256, vbase + (size_t)(jlo + i) * 64 * (NPROJ * 2), NPROJ * 2, wave, lane);
#pragma unroll 1
        for (int k = 0; k < T; ++k) {
            const int j = jlo + k, par = k & 3;
            at_wait(T - k - 1);
#ifdef NSA_E1
            at_wait(T - k - 1);
#endif
            if (k + 3 < T) at_load(lds, (k + 3) & 3, kbase + (size_t)(j + 3) * 64 * 256, 256, vbase + (size_t)(j + 3) * 64 * (NPROJ * 2), NPROJ * 2, wave, lane);
            f32x16 s[2];
            at_qk(lds + AT_K + par * 8192, ka, qf, s);
            bf16x8 vf[2][2]; at_vload(lds + AT_V + par * 8192, va, 0, vf); SB();
#ifdef NSA_E2
            { f32x16 s2[2]; asm volatile("" ::: "memory"); at_qk(lds + AT_K + par * 8192, ka, qf, s2); bf16x8 vf2[2][2]; at_vload(lds + AT_V + par * 8192, va, 0, vf2); SB(); at_exp_all(s2, l2); at_pv(lds + AT_V + par * 8192, va, vf2, s2, o2); }
#endif
            if (j != qt && j != qt - 8) at_exp_all(s, l);
            else { const int klo = (j == qt - 8) ? qq + 1 : 0, khi = (j == qt) ? qq : 63;
#pragma unroll
                for (int kb = 0; kb < 2; ++kb)
#pragma unroll
                    for (int i = 0; i < 16; ++i) { const int key = 32 * kb + crow(i, h); const float p = (key >= klo && key <= khi) ? __builtin_amdgcn_exp2f(s[kb][i]) : 0.f; s[kb][i] = p; l += p; } }
            at_pv(lds + AT_V + par * 8192, va, vf, s, o);
        }
#ifdef NSA_E2
        { const float z = l2 * 0.f;
#pragma unroll
          for (int i = 0; i < 16; ++i) { ofin[0][i] += z * o2[0][i]; ofin[1][i] += z * o2[1][i]; } }
#endif
        const float L = l + __shfl_xor(l, 32); const float gi = gate[2] * (L > 0.f ? 1.f / L : 0.f);
#pragma unroll
        for (int i = 0; i < 16; ++i) { ofin[0][i] += gi * o[0][i]; ofin[1][i] += gi * o[1][i]; }
    }
    if (!STORE) { asm volatile("" :: "v"(ofin[0]), "v"(ofin[1])); return; }
    WG_BAR();
#pragma unroll
    for (int db = 0; db < 2; ++db)
#pragma unroll
        for (int a = 0; a < 4; ++a) { u32x2 w; w.x = pkbf(ofin[db][4 * a], ofin[db][4 * a + 1]); w.y = pkbf(ofin[db][4 * a + 2], ofin[db][4 * a + 3]); *(LAS u32x2*)(lds + qloc * 528 + g * 128 + (32 * db + 8 * a + 4 * h) * 2) = w; }
    WG_BAR();
    { const int tid = wave * 64 + lane; bf16* obase = H1 + ((size_t)b * SEQ + 64 * qt) * 1536 + 512 + hkv * 256;
#pragma unroll
      for (int i = 0; i < 4; ++i) { const int piece = tid + 512 * i, row = piece >> 5, c = piece & 31; *(v4u*)(obase + (size_t)row * 1536 + 8 * c) = *(const LAS v4u*)(lds + row * 528 + 16 * c); } }
}
constexpr int ML_K = 0, ML_V = 32768, ML_VW = 65536, ML_C = 81920, ML_N = 114688, ML_SS = 115200, ML_WS = 116224, ML_GO = 120320, ML_ST = 135424;
DI int ml_fk(int s) { return ((s & 3) << 2) | ((s >> 2) & 3); }
DI void ml_load(LAS unsigned char* lds, int par, const char* kb, const char* vb, int wave, int lane) {
#pragma unroll
    for (int n2 = 0; n2 < 2; ++n2) { const int n = 2 * wave + n2, row = 4 * n + (lane >> 4), pc = lane & 15;
        const int kc = pc ^ ml_fk(row), vc = pc ^ ((row & 3) << 2);
        glds16(kb + (size_t)row * 2048 + 16 * kc, (unsigned)(size_t)(lds + ML_K + par * 16384 + n * 1024));
        glds16(vb + (size_t)row * (NPROJ * 2) + 16 * vc, (unsigned)(size_t)(lds + ML_V + par * 16384 + n * 1024)); }
}
DI bf16x8 ml_tr8(const LAS unsigned char* p) {
    const s16x4 lo = __builtin_amdgcn_ds_read_tr16_b64_v4i16((lds_s16x4*)p); const s16x4 hi = __builtin_amdgcn_ds_read_tr16_b64_v4i16((lds_s16x4*)(p + 1024));
    return __builtin_shufflevector(lo, hi, 0, 1, 2, 3, 4, 5, 6, 7);
}
template <int PM = 0xff>
DI void mlstm_unit2(Frame& F, int unit) {
    unsigned char* ws = F.ws; LAS unsigned char* lds = F.lds;
    int lane_ = F.lane_id();
    const int lane = lane_, wave = F.wave, tid = wave * 64 + lane, r = lane & 31, hh = lane >> 5, tb = wave >> 2, vb = wave & 3;
    const int b = unit >> 2, hd = unit & 3;
    const bf16* proj = (const bf16*)(ws + WS_PROJ); const bf16* mlqk = (const bf16*)(ws + WS_MLQK); bf16* H0 = (bf16*)(ws + WS_H0);
    const size_t tok0 = (size_t)b * SEQ;
    const char* kbase = (const char*)(mlqk + tok0 * 1024 + 512 + hd * 128); const char* vbase = (const char*)(proj + tok0 * NPROJ + PC_MLV + hd * 128);
    const float LOG2E = 1.4426950408889634f;
    const int i16 = lane & 15, q4 = i16 >> 2, p4 = i16 & 3, g1 = (lane >> 4) & 1;
    const int colsw = 16 * ((4 * vb + 2 * g1 + (p4 >> 1)) ^ (q4 << 2)) + 8 * (p4 & 1);
    const int base_c = (8 * hh + q4) * 256 + colsw;
    const int base_v = (4 * hh + q4) * 256 + colsw;
    const int fK = ml_fk(r), rowK = r * 256 + ((hh ^ (fK & 1)) << 4), F16 = (fK & 14) << 4;
    int base_kt[2][2];
#pragma unroll
    for (int blk = 0; blk < 2; ++blk)
#pragma unroll
        for (int hi = 0; hi < 2; ++hi) { const int kbp = 2 * tb + blk; base_kt[blk][hi] = (8 * hh + 4 * hi + q4) * 256 + 16 * ((4 * kbp + 2 * g1 + (p4 >> 1)) ^ ((q4 << 2) | ((2 * hh + hi) & 3))) + 8 * (p4 & 1); }
    LAS float* WS = (LAS float*)(lds + ML_WS) + wave * 128;
    LAS float* NV = (LAS float*)(lds + ML_N); LAS float* SS = (LAS float*)(lds + ML_SS);
    __syncthreads();
    for (int i = tid; i < 32768 / 16; i += 512) ((LAS v4u*)(lds + ML_C))[i] = (v4u){0u, 0u, 0u, 0u};
    if (tid < 128) NV[tid] = 0.f;
    f32x16 Cst[2];
#pragma unroll
    for (int i = 0; i < 16; ++i) { Cst[0][i] = 0.f; Cst[1][i] = 0.f; }
    if (tid < 128) ((LAS float*)(lds + ML_GO))[tid] = F.in[I_MLGOUT][hd * 128 + tid];
    const float bi = F.in[I_MLBI][hd], bfv = F.in[I_MLBF][hd];
    float m_prev = 0.f;
    ml_load(lds, 0, kbase, vbase, wave, lane);
    bf16x8 qf[8];
    { const bf16* qp = mlqk + (tok0 + 32 * tb + r) * 1024 + hd * 128 + 8 * hh;
#pragma unroll
      for (int st = 0; st < 8; ++st) qf[st] = *(const bf16x8*)(qp + 16 * st); }
    float gi_raw = bf2f(proj[(tok0 + lane) * NPROJ + PC_MLI + hd]), gf_raw = bf2f(proj[(tok0 + lane) * NPROJ + PC_MLF + hd]);
#pragma unroll 1
    for (int c = 0; c < 32; ++c) {
        const int par = c & 1; const size_t tokc = tok0 + 64 * c;
        WG_BAR();
        if ((PM & 1) && c > 0) {
            bf16* obase = H0 + (tokc - 64) * 1536 + hd * 128;
#pragma unroll
            for (int i = 0; i < 2; ++i) { const int piece = tid + 512 * i, row = piece >> 4, cc = piece & 15; *(v4u*)(obase + (size_t)row * 1536 + 8 * cc) = *(const LAS v4u*)(lds + ML_ST + row * 272 + 16 * cc); } }
        if (c < 31) ml_load(lds, par ^ 1, kbase + (size_t)(64 * (c + 1)) * 2048, vbase + (size_t)(64 * (c + 1)) * (NPROJ * 2), wave, lane);
        u32x2 og[4];
        { const bf16* op = proj + (tokc + 32 * tb + r) * NPROJ + PC_MLO + hd * 128 + 32 * vb + 4 * hh;
#pragma unroll
          for (int a = 0; a < 4; ++a) og[a] = *(const u32x2*)(op + 8 * a); }
        const float ig = gi_raw + bi, lf = logsig(gf_raw + bfv);
        float bc = lf;
        if (PM & 2) {
#pragma unroll
        for (int o = 1; o < 64; o <<= 1) { const float v = __shfl_up(bc, o); if (lane >= o) bc += v; } }
        const float rr = ig - bc;
        float cm = rr;
        if (PM & 2) {
#pragma unroll
        for (int o = 1; o < 64; o <<= 1) { const float v = __shfl_up(cm, o); if (lane >= o) cm = fmaxf(cm, v); } }
        const float M63 = fmaxf(m_prev, __shfl(cm, 63)), blast = __shfl(bc, 63);
        const float a_old = __expf(m_prev - M63), m_new = blast + M63;
        const int tl = 32 * tb + r;
        const float Mt = fmaxf(m_prev, __shfl(cm, tl)), bt = __shfl(bc, tl);
        const float inter = __expf(m_prev - Mt), m_t = bt + Mt;
        WS[lane] = rr * LOG2E; WS[64 + lane] = __expf(rr - M63);
        const float MtL = Mt * LOG2E;
        const LAS unsigned char* kbuf = lds + ML_K + par * 16384; const LAS unsigned char* vbuf = lds + ML_V + par * 16384;
        f32x16 wd[2]; float dsum = 0.f;
#pragma unroll
        for (int kb = 0; kb < 2; ++kb) {
#pragma unroll
            for (int i = 0; i < 16; ++i) wd[kb][i] = 0.f;
            if ((PM & 4) && kb <= tb) {
                f32x16 a = wd[kb]; bf16x8 kfr[8];
#pragma unroll
                for (int st = 0; st < 8; ++st) kfr[st] = *(const LAS bf16x8*)(kbuf + kb * 8192 + rowK + ((32 * st) ^ F16));
                SB();
#pragma unroll
                for (int st = 0; st < 8; ++st) a = MFMA32(kfr[st], qf[st], a);
#pragma unroll
                for (int i = 0; i < 16; ++i) { const int s = 32 * kb + crow(i, hh); const float e = __builtin_amdgcn_exp2f(WS[s] - MtL); const float w = (s <= tl) ? e * a[i] : 0.f; a[i] = w; dsum += w; }
                wd[kb] = a;
            }
        }
        f32x16 acc; bf16x8 cfr[8];
#pragma unroll
        for (int i = 0; i < 16; ++i) acc[i] = 0.f;
        if (PM & 8) {
#pragma unroll
        for (int st = 0; st < 8; ++st) cfr[st] = ml_tr8(lds + ML_C + base_c + st * 4096);
        SB();
#pragma unroll
        for (int st = 0; st < 8; ++st) acc = MFMA32(cfr[st], qf[st], acc); }
#pragma unroll
        for (int i = 0; i < 16; ++i) acc[i] *= inter;
#pragma unroll
        for (int kb = 0; kb < 2; ++kb) {
            if ((PM & 16) && kb <= tb) {
                const bf16x8 pf0 = pack8<0>(wd[kb]), pf1 = pack8<1>(wd[kb]);
                {
#pragma unroll
                  for (int s2 = 0; s2 < 2; ++s2) { const LAS unsigned char* p = vbuf + base_v + kb * 8192 + s2 * 4096;
                    const s16x4 lo = __builtin_amdgcn_ds_read_tr16_b64_v4i16((lds_s16x4*)p); const s16x4 hi = __builtin_amdgcn_ds_read_tr16_b64_v4i16((lds_s16x4*)(p + 2048));
                    const bf16x8 vf = __builtin_shufflevector(lo, hi, 0, 1, 2, 3, 4, 5, 6, 7);
                    acc = MFMA32(vf, s2 ? pf1 : pf0, acc); } }
            }
        }
        float qn_ = 0.f;
        if (PM & 32)
#pragma unroll
        for (int st = 0; st < 8; ++st) { const v4u qw = __builtin_bit_cast(v4u, qf[st]); const LAS float* np = NV + 16 * st + 8 * hh; const f32x4 n0 = *(const LAS f32x4*)np, n1 = *(const LAS f32x4*)(np + 4);
            qn_ = fmaf(__uint_as_float(qw.x << 16), n0[0], qn_); qn_ = fmaf(__uint_as_float(qw.x & 0xffff0000u), n0[1], qn_); qn_ = fmaf(__uint_as_float(qw.y << 16), n0[2], qn_); qn_ = fmaf(__uint_as_float(qw.y & 0xffff0000u), n0[3], qn_);
            qn_ = fmaf(__uint_as_float(qw.z << 16), n1[0], qn_); qn_ = fmaf(__uint_as_float(qw.z & 0xffff0000u), n1[1], qn_); qn_ = fmaf(__uint_as_float(qw.w << 16), n1[2], qn_); qn_ = fmaf(__uint_as_float(qw.w & 0xffff0000u), n1[3], qn_); }
        qn_ += __shfl_xor(qn_, 32); dsum += __shfl_xor(dsum, 32);
        const float den = inter * qn_ + dsum; const float rden = 1.f / fmaxf(fabsf(den), __expf(-m_t));
        float ssq = 0.f;
#pragma unroll
        for (int i = 0; i < 16; ++i) { acc[i] *= rden; ssq = fmaf(acc[i], acc[i], ssq); }
        ssq += __shfl_xor(ssq, 32);
        if (hh == 0) SS[vb * 64 + tl] = ssq;
        if (PM & 64)
#pragma unroll
        for (int k2 = 0; k2 < 2; ++k2) { const int ci = tid + 512 * k2, s = ci >> 4; const float w = WS[64 + s];
            const v4u x = *(const LAS v4u*)(vbuf + ci * 16); v4u y; const unsigned xs[4] = {x.x, x.y, x.z, x.w}; unsigned ys[4];
#pragma unroll
            for (int j = 0; j < 4; ++j) ys[j] = pkbf(__uint_as_float(xs[j] << 16) * w, __uint_as_float(xs[j] & 0xffff0000u) * w);
            y.x = ys[0]; y.y = ys[1]; y.z = ys[2]; y.w = ys[3]; *(LAS v4u*)(lds + ML_VW + ci * 16) = y; }
        asm volatile("s_waitcnt lgkmcnt(0)" ::: "memory"); __builtin_amdgcn_s_barrier(); asm volatile("" ::: "memory");
        if (c < 31) {
            const bf16* qp = mlqk + (tokc + 64 + 32 * tb + r) * 1024 + hd * 128 + 8 * hh;
#pragma unroll
            for (int st = 0; st < 8; ++st) qf[st] = *(const bf16x8*)(qp + 16 * st);
            gi_raw = bf2f(proj[(tokc + 64 + lane) * NPROJ + PC_MLI + hd]); gf_raw = bf2f(proj[(tokc + 64 + lane) * NPROJ + PC_MLF + hd]);
        }
        { const LAS float* GO = (const LAS float*)(lds + ML_GO) + 32 * vb + 4 * hh;
          const float rstd = rsqrtf(((SS[tl] + SS[64 + tl]) + (SS[128 + tl] + SS[192 + tl])) * (1.f / 128.f) + EPS);
#pragma unroll
          for (int a = 0; a < 4; ++a) { float o4[4]; const unsigned gw[2] = {og[a].x, og[a].y};
#pragma unroll
              for (int j = 0; j < 4; ++j) { const float ov = (j & 1) ? __uint_as_float(gw[j >> 1] & 0xffff0000u) : __uint_as_float(gw[j >> 1] << 16); o4[j] = acc[4 * a + j] * rstd * GO[8 * a + j] * sigm(ov); }
              u32x2 w; w.x = pkbf(o4[0], o4[1]); w.y = pkbf(o4[2], o4[3]); *(LAS u32x2*)(lds + ML_ST + tl * 272 + (32 * vb + 8 * a + 4 * hh) * 2) = w; } }
        if (PM & 128)
#pragma unroll
        for (int blk = 0; blk < 2; ++blk) {
            f32x16 cs = Cst[blk];
#pragma unroll
            for (int i = 0; i < 16; ++i) cs[i] *= a_old;
            bf16x8 afr[4], kfr2[4];
#pragma unroll
            for (int st = 0; st < 4; ++st) {
                afr[st] = ml_tr8(lds + ML_VW + base_c + st * 4096);
                const s16x4 lo = __builtin_amdgcn_ds_read_tr16_b64_v4i16((lds_s16x4*)(kbuf + base_kt[blk][0] + st * 4096)); const s16x4 hi = __builtin_amdgcn_ds_read_tr16_b64_v4i16((lds_s16x4*)(kbuf + base_kt[blk][1] + st * 4096));
                kfr2[st] = __builtin_shufflevector(lo, hi, 0, 1, 2, 3, 4, 5, 6, 7);
            }
            SB();
#pragma unroll
            for (int st = 0; st < 4; ++st) cs = MFMA32(afr[st], kfr2[st], cs);
            Cst[blk] = cs;
            const int kk = 32 * (2 * tb + blk) + r;
#pragma unroll
            for (int a = 0; a < 4; ++a) { u32x2 w; w.x = pkbf(cs[4 * a], cs[4 * a + 1]); w.y = pkbf(cs[4 * a + 2], cs[4 * a + 3]);
                *(LAS u32x2*)(lds + ML_C + kk * 256 + 16 * ((4 * vb + a) ^ ((r & 3) << 2)) + 8 * hh) = w; }
        }
        if ((PM & 64) && tid < 128) { float nv = NV[tid] * a_old;
#pragma unroll 8
            for (int s = 0; s < 64; ++s) { const unsigned short kvs = *(const LAS unsigned short*)(kbuf + s * 256 + 16 * ((tid >> 3) ^ ml_fk(s)) + 2 * (tid & 7)); nv = fmaf(WS[64 + s], bf2f(kvs), nv); }
            NV[tid] = nv; }
        m_prev = m_new;
    }
    __syncthreads();
    if (PM & 1) { bf16* obase = H0 + (tok0 + 64 * 31) * 1536 + hd * 128;
#pragma unroll
        for (int i = 0; i < 2; ++i) { const int piece = tid + 512 * i, row = piece >> 4, cc = piece & 15; *(v4u*)(obase + (size_t)row * 1536 + 8 * cc) = *(const LAS v4u*)(lds + ML_ST + row * 272 + 16 * cc); } }
    __syncthreads();
}
DI void mem_load(LAS unsigned char* lds, int par, const char* kb, const char* vb, int wave, int lane) {
#pragma unroll
    for (int n2 = 0; n2 < 2; ++n2) { const int n = 2 * wave + n2, row = 4 * n + (lane >> 4), pc = lane & 15;
        const int kc = pc ^ ml_fk(row), vc = pc ^ ((row & 3) << 2);
        glds16(kb + (size_t)row * 1024 + 16 * kc, (unsigned)(size_t)(lds + ML_K + par * 16384 + n * 1024));
        glds16(vb + (size_t)row * 2048 + 16 * vc, (unsigned)(size_t)(lds + ML_V + par * 16384 + n * 1024)); }
}
template <bool STORE = true, bool DMA = true, bool COMP = true>
DI void mem_unit(Frame& F, int unit) {
    unsigned char* ws = F.ws; LAS unsigned char* lds = F.lds;
    int lane_ = F.lane_id();
    const int lane = lane_, wave = F.wave, r = lane & 31, hh = lane >> 5;
    const int b = unit >> 5, hd = (unit >> 3) & 3, qt = unit & 7;
    const bf16* mqn = (const bf16*)(ws + WS_MQN); const bf16* memkn = (const bf16*)(ws + WS_MEMKN); const bf16* memkv = (const bf16*)(ws + WS_MEMKV); bf16* H2 = (bf16*)(ws + WS_H0);
    const size_t t = (size_t)b * SEQ + 256 * qt + 32 * wave + r;
    const char* kbase = (const char*)(memkn + (size_t)b * MEML * 512 + hd * 128); const char* vbase = (const char*)(memkv + (size_t)b * MEML * 1024 + 512 + hd * 128);
    const int i16 = lane & 15, q4 = i16 >> 2, p4 = i16 & 3, g1 = (lane >> 4) & 1;
    int base_v[4];
#pragma unroll
    for (int db = 0; db < 4; ++db) base_v[db] = (4 * hh + q4) * 256 + 16 * ((4 * db + 2 * g1 + (p4 >> 1)) ^ (q4 << 2)) + 8 * (p4 & 1);
    const int fK = ml_fk(r), rowK = r * 256 + ((hh ^ (fK & 1)) << 4), F16 = (fK & 14) << 4;
    bf16x8 qf[8];
#pragma unroll
    for (int st = 0; st < 8; ++st) qf[st] = *(const bf16x8*)(mqn + t * 512 + hd * 128 + 16 * st + 8 * hh);
    f32x16 o[4]; float l = 0.f;
#pragma unroll
    for (int db = 0; db < 4; ++db)
#pragma unroll
        for (int i = 0; i < 16; ++i) o[db][i] = 0.f;
    WG_BAR();
    if (DMA) mem_load(lds, 0, kbase, vbase, wave, lane);
#pragma unroll 1
    for (int tile = 0; tile < 4; ++tile) {
        const int par = tile & 1;
        WG_BAR();
        if (DMA && tile < 3) mem_load(lds, par ^ 1, kbase + (size_t)(64 * (tile + 1)) * 1024, vbase + (size_t)(64 * (tile + 1)) * 2048, wave, lane);
        const LAS unsigned char* kbuf = lds + ML_K + par * 16384; const LAS unsigned char* vbuf = lds + ML_V + par * 16384;
        if (COMP)
#pragma unroll
        for (int kb = 0; kb < 2; ++kb) {
            bf16x8 kf[8];
#pragma unroll
            for (int st = 0; st < 8; ++st) kf[st] = *(const LAS bf16x8*)(kbuf + kb * 8192 + rowK + ((32 * st) ^ F16));
            SB();
            f32x16 a;
#pragma unroll
            for (int i = 0; i < 16; ++i) a[i] = 0.f;
#pragma unroll
            for (int st = 0; st < 8; ++st) a = MFMA32(kf[st], qf[st], a);
            bf16x8 vf[2][4];
#pragma unroll
            for (int s2 = 0; s2 < 2; ++s2)
#pragma unroll
                for (int db = 0; db < 4; ++db) { const LAS unsigned char* p = vbuf + base_v[db] + kb * 8192 + s2 * 4096;
                    const s16x4 lo = __builtin_amdgcn_ds_read_tr16_b64_v4i16((lds_s16x4*)p); const s16x4 hi = __builtin_amdgcn_ds_read_tr16_b64_v4i16((lds_s16x4*)(p + 2048));
                    vf[s2][db] = __builtin_shufflevector(lo, hi, 0, 1, 2, 3, 4, 5, 6, 7); }
            SB();
#pragma unroll
            for (int i = 0; i < 16; ++i) { a[i] = __builtin_amdgcn_exp2f(a[i]); l += a[i]; }
            const bf16x8 pf0 = pack8<0>(a), pf1 = pack8<1>(a);
#pragma unroll
            for (int s2 = 0; s2 < 2; ++s2)
#pragma unroll
                for (int db = 0; db < 4; ++db) o[db] = MFMA32(vf[s2][db], s2 ? pf1 : pf0, o[db]);
        }
    }
    const float inv = 1.f / (l + __shfl_xor(l, 32));
    if (!STORE) {
#pragma unroll
        for (int db = 0; db < 4; ++db) asm volatile("" :: "v"(o[db]), "v"(inv));
        return; }
    WG_BAR();
#pragma unroll
    for (int db = 0; db < 4; ++db)
#pragma unroll
        for (int a = 0; a < 4; ++a) { u32x2 w; w.x = pkbf(o[db][4 * a] * inv, o[db][4 * a + 1] * inv); w.y = pkbf(o[db][4 * a + 2] * inv, o[db][4 * a + 3] * inv);
            *(LAS u32x2*)(lds + (32 * wave + r) * 272 + (32 * db + 8 * a + 4 * hh) * 2) = w; }
    WG_BAR();
    { const int tid = wave * 64 + lane; bf16* obase = H2 + ((size_t)b * SEQ + 256 * qt) * 1536 + 1024 + hd * 128;
#pragma unroll
      for (int i = 0; i < 8; ++i) { const int piece = tid + 512 * i, row = piece >> 4, c = piece & 15; *(v4u*)(obase + (size_t)row * 1536 + 8 * c) = *(const LAS v4u*)(lds + row * 272 + 16 * c); } }
}
DI int q_pop(Frame& F, unsigned* qc) {
    __syncthreads();
    if (F.tid_id() == 0) F.MISC[16] = atomicAdd(qc, 1u);
    __syncthreads();
    return (int)F.MISC[16];
}
template <bool ML, bool NSA, bool MEMA, bool MST = true, bool MDMA = true, bool MCOMP = true, bool NST = true, bool NCMP = true, bool NSEL = true, bool NWIN = true, int MLPM = 0xff>
DI void p5_queue(Frame& F, int cbase) {
    unsigned* qc = F.ctl + CW_QCTR + cbase;
    if (ML) {
#pragma unroll 1
        for (;;) { const int it = q_pop(F, qc); if (it >= 64) break; mlstm_unit2<MLPM>(F, it); }
    }
    if (NSA) {
#pragma unroll 1
        for (;;) { const int it = q_pop(F, qc + 64); if (it >= 1024) break; nsa_unit<NST, NCMP, NSEL, NWIN>(F, it); }
    }
    if (MEMA) {
#pragma unroll 1
        for (;;) { const int it = q_pop(F, qc + 128); if (it >= 512) break; mem_unit<MST, MDMA, MCOMP>(F, it); }
    }
    __syncthreads();
}
struct OneUnit { int pm; DI bool next(int i, pg8::Unit& u) const { if (i) return false; u.pm = pm; u.pn = 0; return true; } DI void a_ready(const pg8::Unit&) const {} DI void done(const pg8::Unit&) const {} };
DI void p2_compress(Frame& F) {
    unsigned char* ws = F.ws;
    if (F.G < 64 || F.bx >= 32) return;
    const int kv = F.bx >> 4, pm = F.bx & 15;
    typedef pg8::bf16_t b16;
    { pg8::GemmA g{(const b16*)(ws + WS_PROJ) + (kv ? PC_NVC : PC_NKC), (const b16*)(ws + WS_WC1) + (size_t)kv * 256 * 2048, 2048, 16 * NPROJ * 2, (size_t)NPROJ * 2, (size_t)128, (size_t)SEQ * NPROJ * 2};
      OneUnit S{pm};
      pg8::EpiBf16Silu E{(b16*)(ws + WS_HID) + (size_t)kv * 4096 * 256, 256, (const float*)(ws + WS_SMALL + SM_CBIAS) + kv * 256, 1};
      pg8::gemm_phase_ga<pg8::EpiBf16Silu, OneUnit, false, true>(F.lds, g, S, E, F.wave); }
    asm volatile("s_waitcnt vmcnt(0)" ::: "memory"); __syncthreads();
    const int lane = F.lane_id(), r = lane & 31, hh = lane >> 5;
    const int row = pm * 256 + F.wave * 32 + r, n = row & 127;
    const bf16* hid = (const bf16*)(ws + WS_HID) + (size_t)kv * 4096 * 256 + (size_t)row * 256 + 8 * hh;
    const bf16* w2t = (const bf16*)(ws + WS_SMALL + SM_W2T) + (size_t)kv * 64 * 256 + 8 * hh;
    f32x16 acc[2];
#pragma unroll
    for (int i = 0; i < 16; ++i) { acc[0][i] = 0.f; acc[1][i] = 0.f; }
#pragma unroll 4
    for (int st = 0; st < 16; ++st) { const bf16x8 hb = *(const bf16x8*)(hid + 16 * st);
        const bf16x8 w0 = *(const bf16x8*)(w2t + (size_t)r * 256 + 16 * st), w1 = *(const bf16x8*)(w2t + (size_t)(32 + r) * 256 + 16 * st);
        acc[0] = MFMA32(w0, hb, acc[0]); acc[1] = MFMA32(w1, hb, acc[1]); }
    if (kv == 0) {
        float ss = 0.f;
#pragma unroll
        for (int i = 0; i < 16; ++i) ss += acc[0][i] * acc[0][i] + acc[1][i] * acc[1][i];
        ss += __shfl_xor(ss, 32);
        const float rstd = rsqrtf(ss * (1.f / 64.f) + EPS);
        const float* rc = (const float*)(ws + WS_SMALL + SM_ROPEC); const float* rs = (const float*)(ws + WS_SMALL + SM_ROPES);
        const int pos = 16 * n + 31 < SEQ ? 16 * n + 31 : SEQ - 1;
#pragma unroll
        for (int i = 0; i < 16; ++i) { const int d = crow(i, hh); const float c = rc[pos * 32 + d], sn = rs[pos * 32 + d];
            const float y0 = acc[0][i] * rstd * F.in[I_NGK][d], y1 = acc[1][i] * rstd * F.in[I_NGK][32 + d];
            acc[0][i] = y0 * c - y1 * sn; acc[1][i] = y1 * c + y0 * sn; }
    }
    bf16* dst = (bf16*)(ws + (kv ? WS_VC : WS_KC)) + (size_t)row * 64 + 4 * hh;
#pragma unroll
    for (int db = 0; db < 2; ++db)
#pragma unroll
        for (int a = 0; a < 4; ++a) { u32x2 w; w.x = pkbf(acc[db][4 * a], acc[db][4 * a + 1]); w.y = pkbf(acc[db][4 * a + 2], acc[db][4 * a + 3]); if (n == 127) { w.x = 0u; w.y = 0u; }
            *(u32x2*)(dst + 32 * db + 8 * a) = w; }
}
DI void mlstm_unit(Frame& F, int unit) {
    unsigned char* ws = F.ws;
    const int b = unit >> 2, h = unit & 3, tid = F.tid_id(), kk = tid >> 7, c = tid & 127;
    const bf16* proj = (const bf16*)(ws + WS_PROJ); const bf16* mlqk = (const bf16*)(ws + WS_MLQK); bf16* H0 = (bf16*)(ws + WS_H0);
    LAS float* qs = (LAS float*)F.lds;
    LAS float* ks = qs + 16 * 128;
    LAS float* vs = ks + 16 * 128;
    LAS float* gi = vs + 16 * 128;
    LAS float* gf = gi + 16;
    LAS float* part = gf + 16;
    LAS float* pden = part + 2 * 4 * 128;
    LAS float* hb = pden + 8;
    float C[32], nn[32];
#pragma unroll
    for (int i = 0; i < 32; ++i) { C[i] = 0.f; nn[i] = 0.f; }
    float m = 0.f;
    const float bi = F.in[I_MLBI][h], bfv = F.in[I_MLBF][h];
    const float scale = 0.08838834764831845f;
#pragma unroll 1
    for (int t0 = 0; t0 < SEQ; t0 += 16) {
        __syncthreads();
        for (int i = tid; i < 16 * 128; i += 512) { const int s = i >> 7, d = i & 127; const size_t t = (size_t)b * SEQ + t0 + s;
            qs[i] = bf2f(mlqk[t * 1024 + h * 128 + d]); ks[i] = bf2f(mlqk[t * 1024 + 512 + h * 128 + d]); vs[i] = bf2f(proj[t * NPROJ + PC_MLV + h * 128 + d]); }
        if (tid < 16) { const size_t t = (size_t)b * SEQ + t0 + tid; gi[tid] = bf2f(proj[t * NPROJ + PC_MLI + h]) + bi; gf[tid] = logsig(bf2f(proj[t * NPROJ + PC_MLF + h]) + bfv); }
        __syncthreads();
#pragma unroll 1
        for (int s = 0; s < 16; ++s) {
            const float lf = gf[s], ig = gi[s];
            const float mn = fmaxf(lf + m, ig), a = __expf(lf + m - mn), bb = __expf(ig - mn);
            m = mn;
            const float v = vs[s * 128 + c];
            float pn = 0.f, pd = 0.f;
#pragma unroll
            for (int i = 0; i < 32; ++i) { const float kvv = ks[s * 128 + kk * 32 + i], qv = qs[s * 128 + kk * 32 + i];
                C[i] = a * C[i] + bb * kvv * v; nn[i] = a * nn[i] + bb * kvv; pn = fmaf(qv, C[i], pn); pd = fmaf(qv, nn[i], pd); }
            const int par = s & 1;
            part[(par * 4 + kk) * 128 + c] = pn; if (c == 0) pden[par * 4 + kk] = pd;
            __syncthreads();
            if (kk == 0) {
                const float num = (part[(par * 4 + 0) * 128 + c] + part[(par * 4 + 1) * 128 + c]) + (part[(par * 4 + 2) * 128 + c] + part[(par * 4 + 3) * 128 + c]);
                const float den = (pden[par * 4 + 0] + pden[par * 4 + 1]) + (pden[par * 4 + 2] + pden[par * 4 + 3]);
                hb[s * 128 + c] = num * scale / fmaxf(fabsf(den * scale), __expf(-mn));
            }
        }
        __syncthreads();
#pragma unroll
        for (int rr = 0; rr < 2; ++rr) { const int s = F.wave * 2 + rr; const size_t t = (size_t)b * SEQ + t0 + s;
            const float v0 = hb[s * 128 + F.lane_id()], v1 = hb[s * 128 + 64 + F.lane_id()];
            const float rstd = rsqrtf(wave_sum(v0 * v0 + v1 * v1) * (1.f / 128.f) + EPS);
            const float o0 = bf2f(proj[t * NPROJ + PC_MLO + h * 128 + F.lane_id()]), o1 = bf2f(proj[t * NPROJ + PC_MLO + h * 128 + 64 + F.lane_id()]);
            H0[t * 512 + h * 128 + F.lane_id()] = (bf16)f2bf(v0 * rstd * F.in[I_MLGOUT][h * 128 + F.lane_id()] * sigm(o0));
            H0[t * 512 + h * 128 + 64 + F.lane_id()] = (bf16)f2bf(v1 * rstd * F.in[I_MLGOUT][h * 128 + 64 + F.lane_id()] * sigm(o1)); }
    }
    __syncthreads();
}

DI void nsa_scores(const bf16* krow, bool valid, const LAS float* qs, float (&s)[4]) {
    s[0] = s[1] = s[2] = s[3] = 0.f;
    if (valid) {
#pragma unroll 2
        for (int c8 = 0; c8 < 8; ++c8) { const v4u kk = *(const v4u*)(krow + c8 * 8);
            const unsigned w[4] = {kk.x, kk.y, kk.z, kk.w};
#pragma unroll
            for (int j = 0; j < 4; ++j) { const float k0 = __uint_as_float(w[j] << 16), k1 = __uint_as_float(w[j] & 0xffff0000u); const int d = c8 * 8 + 2 * j;
#pragma unroll
                for (int g = 0; g < 4; ++g) s[g] = fmaf(k1, qs[g * 64 + d + 1], fmaf(k0, qs[g * 64 + d], s[g])); } }
    }
}
DI void nsa_wave(Frame& F, int item, LAS float* wl) {
    unsigned char* ws = F.ws; const int lane = F.lane_id();
    const int t = item >> 1, hkv = item & 1, b = t >> 11, tau = t & 2047;
    const bf16* proj = (const bf16*)(ws + WS_PROJ);
    const bf16* qn = (const bf16*)(ws + WS_QN); const bf16* ksn = (const bf16*)(ws + WS_KSN); const bf16* kwn = (const bf16*)(ws + WS_KWN);
    const bf16* kc = (const bf16*)(ws + WS_KC); const bf16* vc = (const bf16*)(ws + WS_VC); bf16* H1 = (bf16*)(ws + WS_H1);
    LAS float* qs = wl;
    LAS float* ps = wl + 256;
    LAS float* psum = wl + 768;
#pragma unroll
    for (int g = 0; g < 4; ++g) qs[g * 64 + lane] = bf2f(qn[(size_t)t * 512 + (hkv * 4 + g) * 64 + lane]);
    float ofin[4] = {0.f, 0.f, 0.f, 0.f};
    float gate[4][3];
#pragma unroll
    for (int g = 0; g < 4; ++g)
#pragma unroll
        for (int cidx = 0; cidx < 3; ++cidx) gate[g][cidx] = sigm(bf2f(proj[(size_t)t * NPROJ + PC_NG + (hkv * 4 + g) * 3 + cidx]));
    const int ncmp = tau >= 31 ? ((tau - 31) >> 4) + 1 : 0;
    {
        float l[4] = {0.f, 0.f, 0.f, 0.f}, o[4] = {0.f, 0.f, 0.f, 0.f};
        const size_t rbase = (size_t)(b * 2 + hkv) * 128;
#pragma unroll
        for (int blk = 0; blk < 2; ++blk) { const int n = blk * 64 + lane; const bool valid = n < ncmp; float s[4];
            nsa_scores(kc + (rbase + n) * 64, valid, qs, s);
#pragma unroll
            for (int g = 0; g < 4; ++g) { const float p = valid ? __expf(s[g]) : 0.f; l[g] += p; ps[g * 128 + n] = p; } }
        float inv[4];
#pragma unroll
        for (int g = 0; g < 4; ++g) { const float L = wave_sum(l[g]); inv[g] = L > 0.f ? 1.f / L : 0.f; }
#pragma unroll
        for (int blk = 0; blk < 2; ++blk) { const int n = blk * 64 + lane; psum[n] = (ps[0 * 128 + n] * inv[0] + ps[1 * 128 + n] * inv[1]) + (ps[2 * 128 + n] * inv[2] + ps[3 * 128 + n] * inv[3]); }
#pragma unroll 2
        for (int n = 0; n < ncmp; ++n) { const float vv = bf2f(vc[(rbase + n) * 64 + lane]);
#pragma unroll
            for (int g = 0; g < 4; ++g) o[g] = fmaf(ps[g * 128 + n], vv, o[g]); }
#pragma unroll
        for (int g = 0; g < 4; ++g) ofin[g] += gate[g][0] * o[g] * inv[g];
    }
    const int cur = tau >> 6;
    unsigned selmask = 0u;
    {
        float score = -3.0e38f;
        if (lane < 32) { const int j = lane; float imp = 0.f;
#pragma unroll
            for (int dn = -1; dn <= 3; ++dn) { const int n = 4 * j + dn; if (n >= 0 && n <= 126) imp += psum[n]; }
            const bool forced = (j == 0) || (j == cur) || (j == cur - 1);
            score = j > cur ? NEGF : imp + (forced ? 1.0e4f : 0.f); }
#pragma unroll 1
        for (int r = 0; r < 8; ++r) { const float mx = wave_max(score); const unsigned long long bal = __ballot(score == mx); const int win = __ffsll((long long)bal) - 1;
            selmask |= 1u << win; if (lane == win) score = -3.4e38f; }
    }
    {
        float l[4] = {0.f, 0.f, 0.f, 0.f}, o[4] = {0.f, 0.f, 0.f, 0.f};
#pragma unroll 1
        for (int j = 0; j <= cur; ++j) { if (!((selmask >> j) & 1u)) continue;
            const int kpos = 64 * j + lane; const bool valid = kpos <= tau; float s[4];
            nsa_scores(ksn + ((size_t)b * SEQ + kpos) * 128 + hkv * 64, valid, qs, s);
#pragma unroll
            for (int g = 0; g < 4; ++g) { const float p = valid ? __expf(s[g]) : 0.f; l[g] += p; ps[g * 128 + lane] = p; }
            const int nk = j == cur ? (tau & 63) + 1 : 64;
            const bf16* vb = proj + ((size_t)b * SEQ + 64 * j) * NPROJ + PC_NVS + hkv * 64 + lane;
#pragma unroll 2
            for (int k = 0; k < nk; ++k) { const float vv = bf2f(vb[(size_t)k * NPROJ]);
#pragma unroll
                for (int g = 0; g < 4; ++g) o[g] = fmaf(ps[g * 128 + k], vv, o[g]); } }
#pragma unroll
        for (int g = 0; g < 4; ++g) { const float L = wave_sum(l[g]); ofin[g] += gate[g][1] * o[g] * (L > 0.f ? 1.f / L : 0.f); }
    }
    {
        float l[4] = {0.f, 0.f, 0.f, 0.f}, o[4] = {0.f, 0.f, 0.f, 0.f};
        const int start = tau - 511 > 0 ? tau - 511 : 0;
#pragma unroll 1
        for (int base = start & ~63; base <= tau; base += 64) {
            const int kpos = base + lane; const bool valid = kpos >= start && kpos <= tau; float s[4];
            nsa_scores(kwn + ((size_t)b * SEQ + kpos) * 128 + hkv * 64, valid, qs, s);
#pragma unroll
            for (int g = 0; g < 4; ++g) { const float p = valid ? __expf(s[g]) : 0.f; l[g] += p; ps[g * 128 + lane] = p; }
            const int k0 = start > base ? start - base : 0, k1 = tau - base < 63 ? tau - base : 63;
            const bf16* vb = proj + ((size_t)b * SEQ + base) * NPROJ + PC_NVW + hkv * 64 + lane;
#pragma unroll 2
            for (int k = k0; k <= k1; ++k) { const float vv = bf2f(vb[(size_t)k * NPROJ]);
#pragma unroll
                for (int g = 0; g < 4; ++g) o[g] = fmaf(ps[g * 128 + k], vv, o[g]); } }
#pragma unroll
        for (int g = 0; g < 4; ++g) { const float L = wave_sum(l[g]); ofin[g] += gate[g][2] * o[g] * (L > 0.f ? 1.f / L : 0.f); }
    }
#pragma unroll
    for (int g = 0; g < 4; ++g) H1[(size_t)t * 512 + (hkv * 4 + g) * 64 + lane] = (bf16)f2bf(ofin[g]);
}
DI void mem_wave(Frame& F, int t, LAS float* wl) {
    unsigned char* ws = F.ws; const int lane = F.lane_id(); const int b = t >> 11;
    const bf16* mqn = (const bf16*)(ws + WS_MQN); const bf16* memkn = (const bf16*)(ws + WS_MEMKN); const bf16* memkv = (const bf16*)(ws + WS_MEMKV); bf16* H2 = (bf16*)(ws + WS_H2);
    LAS float* qs = wl;
    LAS float* ps = wl + 128;
#pragma unroll 1
    for (int h = 0; h < 4; ++h) {
        qs[lane] = bf2f(mqn[(size_t)t * 512 + h * 128 + lane]); qs[64 + lane] = bf2f(mqn[(size_t)t * 512 + h * 128 + 64 + lane]);
        float l = 0.f;
#pragma unroll 1
        for (int kq = 0; kq < 4; ++kq) { const int key = kq * 64 + lane; const bf16* kr = memkn + ((size_t)b * MEML + key) * 512 + h * 128; float s = 0.f;
#pragma unroll 2
            for (int c8 = 0; c8 < 16; ++c8) { const v4u kk = *(const v4u*)(kr + c8 * 8); const unsigned w[4] = {kk.x, kk.y, kk.z, kk.w};
#pragma unroll
                for (int j = 0; j < 4; ++j) s = fmaf(__uint_as_float(w[j] & 0xffff0000u), qs[c8 * 8 + 2 * j + 1], fmaf(__uint_as_float(w[j] << 16), qs[c8 * 8 + 2 * j], s)); }
            const float p = __expf(s); l += p; ps[key] = p; }
        const float inv = 1.f / wave_sum(l);
        float o0 = 0.f, o1 = 0.f;
        const bf16* vb = memkv + (size_t)b * MEML * 1024 + 512 + h * 128;
#pragma unroll 4
        for (int key = 0; key < MEML; ++key) { const float p = ps[key]; o0 = fmaf(p, bf2f(vb[(size_t)key * 1024 + lane]), o0); o1 = fmaf(p, bf2f(vb[(size_t)key * 1024 + 64 + lane]), o1); }
        H2[(size_t)t * 512 + h * 128 + lane] = (bf16)f2bf(o0 * inv); H2[(size_t)t * 512 + h * 128 + 64 + lane] = (bf16)f2bf(o1 * inv);
    }
}
DI void p5_mixers(Frame& F) {
    const int nml = F.G >= 128 ? 64 : 0;
#ifndef RPT_ML
#define RPT_ML 1
#endif
#ifndef RPT_NSA
#define RPT_NSA 1
#endif
#ifndef RPT_MEM
#define RPT_MEM 1
#endif
    if (F.bx < nml || nml == 0) { for (int rp = 0; rp < RPT_ML; ++rp) for (int u = F.bx; u < 64; u += (nml ? nml : F.G)) mlstm_unit2(F, u); }
    if (F.bx >= nml) {
        LAS float* wl = (LAS float*)(F.lds + F.wave * 4096);
        const int gw = (F.bx - nml) * NWAVES + F.wave, NGW = (F.G - nml) * NWAVES;
        for (int rp = 0; rp < RPT_NSA; ++rp) for (int u = F.bx - nml; u < 1024; u += F.G - nml) nsa_unit(F, u);
        __syncthreads();
        for (int rp = 0; rp < RPT_MEM; ++rp) for (int t = gw; t < MT; t += NGW) mem_wave(F, t, wl);
    }
}

DI void p8_router(Frame& F, int alt) {
    unsigned char* ws = F.ws + (size_t)alt * 3 * MiB; const int lane = F.lane_id(), tid = F.tid_id(), wave = F.wave, r = lane & 31, hh = lane >> 5;
    unsigned char* xn8 = (unsigned char*)(F.ws + WS_R1);
    int* tok_e = (int*)(ws + WS_ROUTE + RT_TOKE); int* tok_pos = (int*)(ws + WS_ROUTE + RT_TOKPOS); float* tok_w = (float*)(ws + WS_ROUTE + RT_TOKW);
    unsigned* gcnt = F.ctl + CW_ECNT + 64 * alt;
    const bf16* wrt = (const bf16*)(F.ws + WS_SMALL + SM_WRT);
    LAS unsigned char* img = F.lds;
    LAS float* part = (LAS float*)F.lds;
    LAS float* lg = (LAS float*)(F.lds + 4 * 64 * 33 * 4);
    LAS int* lcnt = (LAS int*)(F.lds + RING_BYTES + 1024);
    LAS int* lbase = lcnt + 32;
    LAS int* se = lbase + 32;
    LAS int* sp = se + 256;
    LAS float* sw = (LAS float*)(sp + 256);
    const float* gf = F.in[I_GFFN];
    for (int bt = F.bx; bt < MT / 64; bt += F.G) {
        __syncthreads();
        if (tid < 32) lcnt[tid] = 0;
        const f32x4* gr = (const f32x4*)gf + 4 * lane; const f32x4 g0 = gr[0], g1 = gr[1], g2 = gr[2], g3 = gr[3];
#pragma unroll 1
        for (int i0 = 0; i0 < 8; i0 += 4) {
            f32x4 v[4][4];
#pragma unroll
            for (int u = 0; u < 4; ++u) { const int t = bt * 64 + wave * 8 + i0 + u; const f32x4* xr = (const f32x4*)(F.out + (size_t)t * DM) + 4 * lane;
#pragma unroll
                for (int j = 0; j < 4; ++j) v[u][j] = xr[j]; }
#pragma unroll
            for (int u = 0; u < 4; ++u) { const int tl = wave * 8 + i0 + u, t = bt * 64 + tl; float sq = 0.f;
#pragma unroll
                for (int j = 0; j < 4; ++j) sq += (v[u][j].x * v[u][j].x + v[u][j].y * v[u][j].y) + (v[u][j].z * v[u][j].z + v[u][j].w * v[u][j].w);
                const float rstd = rsqrtf(wave_sum(sq) * (1.f / DM) + EPS);
                const f32x4 gg[4] = {g0, g1, g2, g3}; unsigned q[4]; unsigned bw[8];
#pragma unroll
                for (int j = 0; j < 4; ++j) { const float y0 = v[u][j].x * rstd * gg[j].x, y1 = v[u][j].y * rstd * gg[j].y, y2 = v[u][j].z * rstd * gg[j].z, y3 = v[u][j].w * rstd * gg[j].w;
                    bw[2 * j] = pk2(y0, y1); bw[2 * j + 1] = pk2(y2, y3);
                    int q8 = 0; q8 = __builtin_amdgcn_cvt_pk_fp8_f32(y0, y1, q8, false); q8 = __builtin_amdgcn_cvt_pk_fp8_f32(y2, y3, q8, true); q[j] = (unsigned)q8; }
                *((v4u*)(xn8 + (size_t)t * DM) + lane) = (v4u){q[0], q[1], q[2], q[3]};
                *(LAS v4u*)(img + tl * 2048 + 16 * ((2 * lane) ^ (tl & 15))) = (v4u){bw[0], bw[1], bw[2], bw[3]};
                *(LAS v4u*)(img + tl * 2048 + 16 * ((2 * lane + 1) ^ (tl & 15))) = (v4u){bw[4], bw[5], bw[6], bw[7]}; }
        }
        __syncthreads();
        {
            const int mb = wave & 1, kq = wave >> 1, trow = 32 * mb + r;
            f32x16 acc;
#pragma unroll
            for (int i = 0; i < 16; ++i) acc[i] = 0.f;
#pragma unroll 4
            for (int s2 = 0; s2 < 16; ++s2) { const int st = 16 * kq + s2;
                const bf16x8 xa = *(const LAS bf16x8*)(img + trow * 2048 + 16 * ((2 * st + hh) ^ (trow & 15)));
                const bf16x8 wh = *(const bf16x8*)(wrt + (size_t)r * 1024 + 16 * st + 8 * hh), wl = *(const bf16x8*)(wrt + 32 * 1024 + (size_t)r * 1024 + 16 * st + 8 * hh);
                acc = MFMA32(xa, wh, acc); acc = MFMA32(xa, wl, acc); }
            __syncthreads();
#pragma unroll
            for (int i = 0; i < 16; ++i) part[(kq * 64 + 32 * mb + crow(i, hh)) * 33 + r] = acc[i];
        }
        __syncthreads();
        for (int i = tid; i < 64 * 32; i += 512) { const int tk = i >> 5, e = i & 31; lg[tk * 33 + e] = ((part[(0 * 64 + tk) * 33 + e] + part[(1 * 64 + tk) * 33 + e]) + (part[(2 * 64 + tk) * 33 + e] + part[(3 * 64 + tk) * 33 + e])) + F.in[I_BR][e]; }
        __syncthreads();
        for (int i = 0; i < 8; ++i) {
            const int tl = wave * 8 + i, e = lane & 31;
            float sc = lg[tl * 33 + e]; int ek[4]; float vk[4];
#pragma unroll
            for (int rd = 0; rd < 4; ++rd) { const float mx = wave_max(sc); const unsigned long long bal = __ballot(sc == mx); const int win = (__ffsll((long long)bal) - 1) & 31;
                ek[rd] = win; vk[rd] = mx; if (e == win) sc = -3.4e38f; }
            const float e1 = __expf(vk[1] - vk[0]), e2 = __expf(vk[2] - vk[0]), e3 = __expf(vk[3] - vk[0]); const float inv = 1.f / (1.f + e1 + e2 + e3);
            if (lane == 0) {
                const float wk[4] = {inv, e1 * inv, e2 * inv, e3 * inv};
#pragma unroll
                for (int rd = 0; rd < 4; ++rd) { se[tl * 4 + rd] = ek[rd]; sw[tl * 4 + rd] = wk[rd]; sp[tl * 4 + rd] = atomicAdd((int*)&lcnt[ek[rd]], 1); }
            }
        }
        __syncthreads();
        if (tid < 32) lbase[tid] = (int)atomicAdd(&gcnt[tid], (unsigned)lcnt[tid]);
        __syncthreads();
        if (tid < 256) { const int t = bt * 64 + (tid >> 2), k = tid & 3; const int e = se[tid];
          tok_e[t * 4 + k] = e; tok_pos[t * 4 + k] = lbase[e] + sp[tid]; tok_w[t * 4 + k] = sw[tid]; }
    }
    __syncthreads();
}
DI int moe_tables(Frame& F, LAS int* pstart, LAS unsigned char* blk_e) {
    unsigned* gcnt = F.ctl + CW_ECNT;
    __syncthreads();
    if (F.wave == 0) {
        const int l = F.lane_id(); int pad = 0;
        if (l < NEXP) { const int cnt = (int)__hip_atomic_load(&gcnt[l], __ATOMIC_RELAXED, __HIP_MEMORY_SCOPE_AGENT); pad = (cnt + MOEB - 1) / MOEB * MOEB; }
        int inc = pad;
#pragma unroll
        for (int o = 1; o < 32; o <<= 1) { const int v = __shfl_up(inc, o); if (l >= o) inc += v; }
        if (l < NEXP) pstart[l] = inc - pad;
        if (l == NEXP - 1) pstart[NEXP] = inc;
    }
    __syncthreads();
    const int nblk = pstart[NEXP] / MOEB;
    for (int rb = F.tid_id(); rb < nblk; rb += 512) { int e = 0; while (e < NEXP - 1 && pstart[e + 1] <= rb * MOEB) ++e; blk_e[rb] = (unsigned char)e; }
    __syncthreads();
    return nblk;
}
DI void p9_scatter(Frame& F) {
    unsigned char* ws = F.ws; const int lane = F.lane_id();
    LAS int* pstart = (LAS int*)(F.lds + 65536); LAS unsigned char* blk_e = (LAS unsigned char*)(F.lds + 65536 + 256);
    moe_tables(F, pstart, blk_e);
    const unsigned char* xn8 = (const unsigned char*)(ws + WS_R1); unsigned char* aperm = (unsigned char*)(ws + WS_APERM);
    const int* tok_e = (const int*)(ws + WS_ROUTE + RT_TOKE); const int* tok_pos = (const int*)(ws + WS_ROUTE + RT_TOKPOS); const float* tok_w = (const float*)(ws + WS_ROUTE + RT_TOKW);
    int* tok_dest = (int*)(ws + WS_ROUTE + RT_TOKDEST); float* roww = (float*)(ws + WS_ROUTE + RT_ROWW);
    unsigned* gcnt = F.ctl + CW_ECNT;
    const int gw = F.bx * NWAVES + F.wave, NGW = F.G * NWAVES;
    for (int t4 = gw; t4 < MT / 4; t4 += NGW) {
        int dest = 0;
        if (lane < 16) { const int it = t4 * 16 + lane; dest = pstart[tok_e[it]] + tok_pos[it]; tok_dest[it] = dest; roww[dest] = tok_w[it]; }
        v4u v0[4];
#pragma unroll
        for (int q = 0; q < 4; ++q) { const v4u* src = (const v4u*)(xn8 + (size_t)(t4 * 4 + q) * DM); v0[q] = src[lane]; }
#pragma unroll
        for (int q = 0; q < 4; ++q)
#pragma unroll
            for (int k = 0; k < 4; ++k) { const int d = __shfl(dest, q * 4 + k); v4u* dst = (v4u*)(aperm + (size_t)d * DM); dst[lane] = v0[q]; }
    }
    for (int it = gw; it < NEXP * MOEB; it += NGW) { const int e = it >> 8, i = it & 255; const int cnt = (int)__hip_atomic_load(&gcnt[e], __ATOMIC_RELAXED, __HIP_MEMORY_SCOPE_AGENT); const int padded = (cnt + MOEB - 1) / MOEB * MOEB;
        if (i < padded - cnt) { const int dest = pstart[e] + cnt + i; v4u* dst = (v4u*)(aperm + (size_t)dest * DM); const v4u z = {0u, 0u, 0u, 0u}; dst[lane] = z; if (lane == 0) roww[dest] = 0.f; } }
}
DI void p12_combine(Frame& F) {
    unsigned char* ws = F.ws; const int lane = F.lane_id();
    const bf16* ybuf = (const bf16*)(ws + WS_APERM); const int* tok_dest = (const int*)(ws + WS_ROUTE + RT_TOKDEST);
    const int gw = F.bx * NWAVES + F.wave, NGW = F.G * NWAVES;
    for (int t2 = gw; t2 < MT / 2; t2 += NGW) {
        typedef int i32x4 __attribute__((ext_vector_type(4)));
        v4u w[2][4][2]; f32x4 a[2][2][2];
#pragma unroll
        for (int q = 0; q < 2; ++q) { const int t = 2 * t2 + q; const f32x4* orow = (const f32x4*)(F.out + (size_t)t * DM);
            const i32x4 d = *(const i32x4*)(tok_dest + t * 4); const int dd[4] = {d.x, d.y, d.z, d.w};
#pragma unroll
            for (int j = 0; j < 2; ++j) {
#pragma unroll
                for (int k = 0; k < 4; ++k) w[q][k][j] = *((const v4u*)(ybuf + (size_t)dd[k] * DM) + lane + 64 * j);
                a[q][j][0] = orow[2 * (lane + 64 * j)]; a[q][j][1] = orow[2 * (lane + 64 * j) + 1]; } }
#pragma unroll
        for (int q = 0; q < 2; ++q) { f32x4* orow = (f32x4*)(F.out + (size_t)(2 * t2 + q) * DM);
#pragma unroll
            for (int j = 0; j < 2; ++j) {
#pragma unroll
                for (int k = 0; k < 4; ++k) { const v4u ww = w[q][k][j];
                    a[q][j][0].x += __uint_as_float(ww.x << 16); a[q][j][0].y += __uint_as_float(ww.x & 0xffff0000u); a[q][j][0].z += __uint_as_float(ww.y << 16); a[q][j][0].w += __uint_as_float(ww.y & 0xffff0000u);
                    a[q][j][1].x += __uint_as_float(ww.z << 16); a[q][j][1].y += __uint_as_float(ww.z & 0xffff0000u); a[q][j][1].z += __uint_as_float(ww.w << 16); a[q][j][1].w += __uint_as_float(ww.w & 0xffff0000u); }
                orow[2 * (lane + 64 * j)] = a[q][j][0]; orow[2 * (lane + 64 * j) + 1] = a[q][j][1]; } }
    }
}

constexpr int N_PHASES = 13;
#ifndef MK_PER_PHASE
#define MK_PER_PHASE 0
#endif
__global__ void __launch_bounds__(NWAVES * 64, 2) fwd_kernel(Args args) {
    extern __shared__ __attribute__((aligned(16))) unsigned char lds_raw[];
    Frame F;
    F.lds = (LAS unsigned char*)lds_raw; F.MISC = (volatile LAS unsigned*)(F.lds + MISC_OFF);
    F.wave = __builtin_amdgcn_readfirstlane((int)(threadIdx.x >> 6)); F.G = gridDim.x; F.bx = blockIdx.x;
    F.ws = args.ws; F.ctl = (unsigned*)(args.ws + WS_CTL); F.in = args.in; F.out = args.out;
    unsigned char* ws = args.ws;
    for (int u = threadIdx.x; u < (LDS_BYTES - LDSCTL_OFF) / 4; u += NWAVES * 64) ((LAS unsigned*)(F.lds + LDSCTL_OFF))[u] = 0u;
    __syncthreads();
    const int lo = args.ph_lo, hi = args.ph_hi;
    XcdBarrier bar; bar.wv = F.wave; bar.bar = F.ctl + CW_BAR; bar.x = 0; bar.st = nullptr;
    if (hi - lo > 1) bar = xcd_barrier_post(F.ctl + CW_BAR, F.MISC + 8, F.wave);
#ifndef PH_MASK
#define PH_MASK 0x1fff
#endif
#define IN(k) (((PH_MASK >> (k)) & 1) && lo <= (k) && (k) < hi)
#define SEAM(k) do { if (IN(k) && IN((k) + 1)) xcd_barrier(bar); } while (0)
    typedef pg8::bf16_t b16;
#ifndef RPT_MASK
#define RPT_MASK 0
#endif
#define RPT(k) _Pragma("unroll") for (int rp_ = 0; rp_ < 1 + ((RPT_MASK >> (k)) & 1); ++rp_)
#ifndef P0PARTS
#define P0PARTS 0xf
#endif
    if (IN(0)) { p0_prologue<0xf>(F); if (RPT_MASK & 1) p0_prologue<P0PARTS>(F); } SEAM(0);
    if (IN(1)) RPT(1) {
        { pg8::Gemm8 g{(const unsigned char*)(ws + WS_U8), (const unsigned char*)(ws + WS_WIN8), MT, NF8, DM, 0x7f7f7f7f, 0x77777777}; pg8::StaticOrder S; S.init(MT, NF8, F.G, F.bx);
          pg8::EpiBf16Silu E{(b16*)(ws + WS_PROJ) + NB16, NPROJ, nullptr, 0};
          pg8::gemm_phase_f8<pg8::EpiBf16Silu, pg8::StaticOrder, true, true>(F.lds, g, S, E, F.wave); }
        { pg8::Gemm g{(const b16*)(ws + WS_R1), (const b16*)(ws + WS_WIN), MT, NB16, DM}; pg8::StaticOrder S; S.init(MT, NB16, F.G, F.bx);
          pg8::EpiBf16Silu E{(b16*)(ws + WS_PROJ), NPROJ, nullptr, 0};
          pg8::gemm_phase<pg8::EpiBf16Silu, pg8::StaticOrder, true, true>(F.lds, g, S, E, F.wave); }
        { pg8::Gemm g{(const b16*)(ws + WS_MEMN), (const b16*)(ws + WS_WMKV), MROWS, 1024, DM}; pg8::StaticOrder S; S.init(MROWS, 1024, F.G, (F.bx + 64) % F.G);
          pg8::EpiBf16Silu E{(b16*)(ws + WS_MEMKV), 1024, nullptr, 0};
          pg8::gemm_phase<pg8::EpiBf16Silu, pg8::StaticOrder, true, true>(F.lds, g, S, E, F.wave); }
    } SEAM(1);
    if (IN(2)) { RPT(2) { p2_compress(F); p2_prep(F); } }
    if (IN(2) && IN(5)) xcd_barrier(bar);
#ifndef RPT5_ML
#define RPT5_ML 0
#endif
#ifndef MLPROBE
#define MLPROBE 0xff
#endif
#ifndef NPROBE_ST
#define NPROBE_ST true
#endif
#ifndef NPROBE_CMP
#define NPROBE_CMP true
#endif
#ifndef NPROBE_SEL
#define NPROBE_SEL true
#endif
#ifndef NPROBE_WIN
#define NPROBE_WIN true
#endif
#ifndef MPROBE_ST
#define MPROBE_ST true
#endif
#ifndef MPROBE_DMA
#define MPROBE_DMA true
#endif
#ifndef MPROBE_COMP
#define MPROBE_COMP true
#endif
#ifndef RPT5_NSA
#define RPT5_NSA 0
#endif
#ifndef RPT5_MEM
#define RPT5_MEM 0
#endif
    if (IN(5)) { p5_queue<true, true, true>(F, 0);
        if (RPT5_ML || RPT5_NSA || RPT5_MEM) { xcd_barrier(bar); p5_queue<RPT5_ML != 0, RPT5_NSA != 0, RPT5_MEM != 0, MPROBE_ST, MPROBE_DMA, MPROBE_COMP, NPROBE_ST, NPROBE_CMP, NPROBE_SEL, NPROBE_WIN, MLPROBE>(F, 256); } } SEAM(5);
    if (IN(6)) RPT(6) {
        pg8::StaticOrder S; S.init(MT, DM, F.G, F.bx);
        pg8::Gemm g{(const b16*)(ws + WS_H0), (const b16*)(ws + WS_WBR), MT, DM, 1536};
        pg8::EpiMergeK E{(const b16*)(ws + WS_PROJ), (b16*)(ws + WS_R1)};
        pg8::gemm_phase<pg8::EpiMergeK, pg8::StaticOrder, true, true>(F.lds, g, S, E, F.wave);
    } SEAM(6);
    if (IN(7)) RPT(7) {
        pg8::Gemm g{(const b16*)(ws + WS_R1), (const b16*)(ws + WS_WOUT), MT, DM, DM}; pg8::StaticOrder S; S.init(MT, DM, F.G, F.bx);
        pg8::EpiRes E{F.in[I_X], F.out};
        pg8::gemm_phase<pg8::EpiRes, pg8::StaticOrder, true, true>(F.lds, g, S, E, F.wave);
    } SEAM(7);
    if (IN(8)) { p8_router(F, 0); if ((RPT_MASK >> 8) & 1) p8_router(F, 1); } SEAM(8);
    if (IN(9)) { RPT(9) p9_scatter(F); } SEAM(9);
    if (IN(10)) RPT(10) {
        LAS int* pstart = (LAS int*)(F.lds + RING_BYTES + 1024); LAS unsigned char* blk_e = (LAS unsigned char*)(F.lds + RING_BYTES + 1024 + 256);
        const int nblk = moe_tables(F, pstart, blk_e);
        pg8::Gemm8 g{(const unsigned char*)(ws + WS_APERM), (const unsigned char*)(ws + WS_WGU), CAP, NEXP * 2048, DM, 0x7f7f7f7f, 0x77777777};
        pg8::MoeOrder<8> S{nblk, F.G, F.bx, (const PG8_LAS unsigned char*)blk_e};
        pg8::EpiSwiglu E{(unsigned char*)(ws + WS_ACT), F.in[I_BGU]};
        pg8::gemm_phase_f8<pg8::EpiSwiglu, pg8::MoeOrder<8>, true, true>(F.lds, g, S, E, F.wave);
    } SEAM(10);
    if (IN(11)) RPT(11) {
        LAS int* pstart = (LAS int*)(F.lds + RING_BYTES + 1024); LAS unsigned char* blk_e = (LAS unsigned char*)(F.lds + RING_BYTES + 1024 + 256);
        const int nblk = moe_tables(F, pstart, blk_e);
        pg8::Gemm8 g{(const unsigned char*)(ws + WS_ACT), (const unsigned char*)(ws + WS_WDN), CAP, NEXP * DM, DFF, 0x7f7f7f7f, 0x77777777};
        pg8::MoeOrder<4> S{nblk, F.G, F.bx, (const PG8_LAS unsigned char*)blk_e};
        pg8::EpiDown E{(b16*)(ws + WS_APERM), F.in[I_BDN], (const float*)(ws + WS_ROUTE + RT_ROWW)};
        pg8::gemm_phase_f8<pg8::EpiDown, pg8::MoeOrder<4>, true, true>(F.lds, g, S, E, F.wave);
    } SEAM(11);
    if (IN(12)) { p12_combine(F); }
#undef IN
#undef SEAM
}

extern "C" void kernel_launch(void* const* d_in, const int* in_sizes, int n_in, void* d_out, int out_size, void* d_ws, size_t ws_size, hipStream_t stream) {
    static int grid = 0;
    if (grid == 0) {
        if (n_in != N_IN || out_size != MT * DM || ws_size < WS_END) { fprintf(stderr, "kernel_launch: unexpected shapes (n_in %d, out %d, ws %zu need %zu)\n", n_in, out_size, ws_size, (size_t)WS_END); grid = -1; return; }
        int dev = 0, cus = 0, per_cu = 0;
        if (hipGetDevice(&dev) != hipSuccess || hipDeviceGetAttribute(&cus, hipDeviceAttributeMultiprocessorCount, dev) != hipSuccess) { grid = -1; return; }
        if (hipFuncSetAttribute((const void*)fwd_kernel, hipFuncAttributeMaxDynamicSharedMemorySize, LDS_BYTES) != hipSuccess) { fprintf(stderr, "kernel_launch: hipFuncSetAttribute failed\n"); grid = -1; return; }
        if (hipOccupancyMaxActiveBlocksPerMultiprocessor(&per_cu, (const void*)fwd_kernel, NWAVES * 64, LDS_BYTES) != hipSuccess || per_cu < 1) { fprintf(stderr, "kernel_launch: occupancy query says %d\n", per_cu); }
        (void)hipGetLastError();
        grid = cus;
    }
    if (grid < 0) return;
    if (hipMemsetAsync((char*)d_ws + WS_CTL, 0, CTL_ZERO_BYTES, stream) != hipSuccess) return;
    Args a{};
    for (int i = 0; i < N_IN; ++i) a.in[i] = (const float*)d_in[i];
    a.out = (float*)d_out; a.ws = (unsigned char*)d_ws;
#if MK_PER_PHASE
    for (int p = 0; p < N_PHASES; ++p) { a.ph_lo = p; a.ph_hi = p + 1; a.li = 0; hipLaunchKernelGGL(fwd_kernel, dim3(grid), dim3(NWAVES * 64), LDS_BYTES, stream, a); }
#else
    a.ph_lo = 0; a.ph_hi = N_PHASES; a.li = 0;
    hipLaunchKernelGGL(fwd_kernel, dim3(grid), dim3(NWAVES * 64), LDS_BYTES, stream, a);
#endif
}
```

```cpp
#include <hip/hip_runtime.h>
#include <cstdio>
#include <cstdint>
namespace pg8 {
#define PG8_LAS __attribute__((address_space(3)))
typedef unsigned short bf16_t;
typedef short bf16x8 __attribute__((ext_vector_type(8)));
typedef float f32x4 __attribute__((ext_vector_type(4)));
typedef unsigned u32x4 __attribute__((ext_vector_type(4)));
constexpr int BM = 256, BK = 64, HALF = 128, HTB = HALF * BK * 2  , STAGE_BYTES = 8 * HTB, NXCD = 8, WGM = 8;

__host__ __device__ __forceinline__ int lds_byte(int r, int c) { const int st = (r >> 4) * 2 + (c >> 5), rr = r & 15, cc = c & 31, ob = rr * 64 + cc * 2; return st * 1024 + (ob ^ (((ob >> 9) & 1) << 5)); }
__host__ __device__ __forceinline__ void stage_rc(int b, int& R, int& C) { const int st = b / 1024, sb = b % 1024, swz = sb ^ (((sb >> 9) & 1) << 5); R = (st >> 1) * 16 + swz / 64; C = (st & 1) * 32 + (swz % 64) / 2; }
__host__ __device__ __forceinline__ int perm32(int rho) { const int n = rho >> 4, i = rho & 15; return 8 * (i >> 2) + 4 * n + (i & 3); }

struct Unit { int pm, pn; };
struct Gemm { const bf16_t* A; const bf16_t* Bt; int M, N, K; };

struct StaticOrder {
    int nM, nN, nwg, G, c;
    __host__ __device__ void init(int M, int N, int G_, int c_) { nM = M / BM; nN = N / BM; nwg = nM * nN; G = G_; c = c_; }
    __host__ __device__ bool next(int i, Unit& u) const {
        const long L = (long)i * G + c; if (L >= nwg) return false;
        int wgid = (int)L; { const int q = nwg / NXCD, r = nwg % NXCD, xcd = wgid % NXCD, off = wgid / NXCD; wgid = (xcd < r ? xcd * (q + 1) : r * (q + 1) + (xcd - r) * q) + off; }
        const int nig = WGM * nN, gid = wgid / nig, fm = gid * WGM, gsz = (nM - fm) < WGM ? (nM - fm) : WGM;
        u.pm = fm + ((wgid % nig) % gsz); u.pn = (wgid % nig) / gsz; return true;
    }
    __device__ __forceinline__ void a_ready(const Unit&) const {}
    __device__ __forceinline__ void done(const Unit&) const {}
};

__device__ __forceinline__ unsigned cvt_pk_bf16(float lo, float hi) { unsigned r; asm volatile("v_cvt_pk_bf16_f32 %0, %1, %2" : "=v"(r) : "v"(lo), "v"(hi)); return r; }
typedef float f32x2 __attribute__((ext_vector_type(2)));
__device__ __forceinline__ f32x2 gelu_pk(f32x2 v) {
    const f32x2 av = __builtin_elementwise_abs(v), d = av * 0.2316418882f + 1.0f;
    f32x2 t; t.x = __builtin_amdgcn_rcpf(d.x); t.y = __builtin_amdgcn_rcpf(d.y);
    f32x2 q = t * 0.5307027145f + (-0.7265760135f); q = q * t + 0.7107068705f; q = q * t + (-0.142248368f); q = q * t + 0.127414796f; q = q * t;
    const f32x2 s = (v * v) * (-0.72134752044f);
    f32x2 e; e.x = __builtin_amdgcn_exp2f(s.x); e.y = __builtin_amdgcn_exp2f(s.y);
    const f32x2 m = v * (q * e), r = v - m;
    f32x2 o; o.x = v.x < 0.f ? m.x : r.x; o.y = v.y < 0.f ? m.y : r.y; return o;
}

template <int ACT  > struct EpiBf16 {
    static constexpr bool PERM = true, AFTER_DRAIN = false; static_assert(ACT == 0 || ACT == 1, "EpiBf16: ACT is 0 (none) or 1 (gelu_pk)");
    bf16_t* O; int ldc; const float* bias; int split_cols; size_t split_stride; float scale0;
    __device__ __forceinline__ void operator()(const f32x4 (&acc)[2][2][4][2], const Unit& u, int wr, int wc, int fr, int fq) const {
        const int row0 = u.pm * BM + wr * 64 + fr; int colt = u.pn * BM; bf16_t* base = O;
        float sc = 1.f; if (split_cols) { const int t = colt / split_cols; base += (size_t)t * split_stride; colt -= t * split_cols; if (t == 0) sc = scale0; }
        const int col0 = colt + wc * 32 + 8 * fq, bcol0 = u.pn * BM + wc * 32 + 8 * fq;
        f32x4 bv[2][2];
#pragma unroll
        for (int bj = 0; bj < 2; ++bj)
#pragma unroll
            for (int n = 0; n < 2; ++n) bv[bj][n] = bias ? *(const f32x4*)(bias + bcol0 + bj * HALF + 4 * n) : (f32x4){0.f, 0.f, 0.f, 0.f};
#pragma unroll
        for (int ai = 0; ai < 2; ++ai)
#pragma unroll
            for (int m = 0; m < 4; ++m) { bf16_t* rowp = base + (size_t)(row0 + ai * HALF + m * 16) * ldc + col0;
#pragma unroll
                for (int bj = 0; bj < 2; ++bj) { f32x4 v0 = acc[ai][bj][m][0] + bv[bj][0], v1 = acc[ai][bj][m][1] + bv[bj][1];
                    if (ACT == 1) { f32x2 a = gelu_pk((f32x2){v0[0], v0[1]}), b = gelu_pk((f32x2){v0[2], v0[3]}), c = gelu_pk((f32x2){v1[0], v1[1]}), d = gelu_pk((f32x2){v1[2], v1[3]});
                        v0 = (f32x4){a.x, a.y, b.x, b.y}; v1 = (f32x4){c.x, c.y, d.x, d.y}; }
                    v0 = v0 * sc; v1 = v1 * sc; u32x4 w; w.x = cvt_pk_bf16(v0[0], v0[1]); w.y = cvt_pk_bf16(v0[2], v0[3]); w.z = cvt_pk_bf16(v1[0], v1[1]); w.w = cvt_pk_bf16(v1[2], v1[3]);
                    *(u32x4*)(rowp + bj * HALF) = w; } }
    }
};

struct PanelStats {
    unsigned* xbuf;
    unsigned* cnt;
    unsigned* tmo;
    int ntn; float eps;
    unsigned code;
    __device__ __forceinline__ bool run(const f32x4 (&v)[2][2][4][2], const Unit& u, int wr, int wc, int fr, int fq, PG8_LAS unsigned char* lds, int wid, int lane) const {
        typedef float f32x2v __attribute__((ext_vector_type(2)));
        PG8_LAS f32x2v* P = (PG8_LAS f32x2v*)lds;
        PG8_LAS f32x2v* S = (PG8_LAS f32x2v*)(lds + 8192);
        PG8_LAS unsigned* flag = (PG8_LAS unsigned*)(lds + 8192 + 2048);
#pragma unroll
        for (int ai = 0; ai < 2; ++ai)
#pragma unroll
            for (int m = 0; m < 4; ++m) {
                float s = 0.f;
#pragma unroll
                for (int bj = 0; bj < 2; ++bj)
#pragma unroll
                    for (int n = 0; n < 2; ++n) { const f32x4 x = v[ai][bj][m][n]; s += (x[0] + x[1]) + (x[2] + x[3]); }
                s += __shfl_xor(s, 16); s += __shfl_xor(s, 32);
                const float mw = s * (1.0f / 64.0f); float q = 0.f;
#pragma unroll
                for (int bj = 0; bj < 2; ++bj)
#pragma unroll
                    for (int n = 0; n < 2; ++n) { const f32x4 d = v[ai][bj][m][n] - mw; q += (d[0] * d[0] + d[1] * d[1]) + (d[2] * d[2] + d[3] * d[3]); }
                q += __shfl_xor(q, 16); q += __shfl_xor(q, 32);
                if (fq == 0) P[(ai * HALF + wr * 64 + m * 16 + fr) * 4 + wc] = (f32x2v){mw, q};
            }
        asm volatile("s_waitcnt lgkmcnt(0)" ::: "memory"); __builtin_amdgcn_s_barrier(); asm volatile("" ::: "memory");
#if defined(BROKEN_EXCHANGE_NO_WAIT)
#warning BROKEN CONTROL BUILD: the row-statistics exchange does not wait; results are wrong by design
        if (blockIdx.x >= 64) { const long long t0_ = clock64(); while (clock64() - t0_ < 60000) __builtin_amdgcn_s_sleep(8); }
#endif
        const int row = wid * 32 + (lane & 31);
        if (lane < 32) {
            const f32x2v a = P[row * 4 + 0], b = P[row * 4 + 1], c = P[row * 4 + 2], d = P[row * 4 + 3];
            const float mt = (a.x + b.x + c.x + d.x) * 0.25f;
            const float da = a.x - mt, db = b.x - mt, dc = c.x - mt, dd = d.x - mt;
            const float m2 = (a.y + b.y) + (c.y + d.y) + 64.0f * ((da * da + db * db) + (dc * dc + dd * dd));
            unsigned long long* slot = (unsigned long long*)xbuf + ((size_t)(u.pm * BM + row) * 4 + u.pn);
            __hip_atomic_store(slot, ((unsigned long long)__float_as_uint(m2) << 32) | __float_as_uint(mt), __ATOMIC_RELAXED, __HIP_MEMORY_SCOPE_AGENT);
        }
        asm volatile("s_waitcnt vmcnt(0)" ::: "memory");
        if (lane == 0) __hip_atomic_fetch_add(cnt + 64 * u.pm, 1u, __ATOMIC_RELAXED, __HIP_MEMORY_SCOPE_AGENT);
        if (wid == 0) {
            bool dead = false; const unsigned long long t0 = __builtin_amdgcn_s_memrealtime(); const unsigned want = 8u * (unsigned)ntn;
            for (;;) {
#if defined(BROKEN_EXCHANGE_NO_WAIT)
                break;
#endif
                if ((unsigned)__builtin_amdgcn_readfirstlane(__hip_atomic_load(cnt + 64 * u.pm, __ATOMIC_RELAXED, __HIP_MEMORY_SCOPE_AGENT)) >= want) break;
                if (__builtin_amdgcn_s_memrealtime() - t0 > 2000000ull) {
                    if (lane == 0) { unsigned expect = 0u; __hip_atomic_compare_exchange_strong(tmo + 1, &expect, code | (unsigned)(u.pm & 0xff), __ATOMIC_RELAXED, __ATOMIC_RELAXED, __HIP_MEMORY_SCOPE_AGENT);
                                     __hip_atomic_store(tmo, 1u, __ATOMIC_RELAXED, __HIP_MEMORY_SCOPE_AGENT); }
                    dead = true; break; }
                __builtin_amdgcn_s_sleep(2);
            }
            __builtin_amdgcn_fence(__ATOMIC_ACQUIRE, "agent");
            if (lane == 0) flag[0] = dead ? 1u : 0u;
        }
        asm volatile("s_waitcnt vmcnt(0) lgkmcnt(0)" ::: "memory"); __builtin_amdgcn_s_barrier(); asm volatile("" ::: "memory");
        const bool bad = flag[0] != 0u;
        if (lane < 32) {
            const unsigned long long* slot = (const unsigned long long*)xbuf + (size_t)(u.pm * BM + row) * 4; float mt[4], m2[4]; float ms = 0.f;
#pragma unroll
            for (int t = 0; t < 4; ++t) { if (t < ntn) { const unsigned long long w = __hip_atomic_load(slot + t, __ATOMIC_RELAXED, __HIP_MEMORY_SCOPE_AGENT); mt[t] = __uint_as_float((unsigned)w); m2[t] = __uint_as_float((unsigned)(w >> 32)); } else { mt[t] = 0.f; m2[t] = 0.f; } ms += mt[t]; }
            const float mean = ms / (float)ntn; float q = 0.f;
#pragma unroll
            for (int t = 0; t < 4; ++t) if (t < ntn) { const float dm = mt[t] - mean; q += m2[t] + 256.0f * dm * dm; }
            S[row] = (f32x2v){mean, 1.0f / sqrtf(q / (256.0f * (float)ntn) + eps)};
        }
        asm volatile("s_waitcnt lgkmcnt(0)" ::: "memory"); __builtin_amdgcn_s_barrier(); asm volatile("" ::: "memory");
        return bad;
    }
};
struct EpiLnRes {
    static constexpr bool PERM = false, AFTER_DRAIN = true;
    const float* base; float* out; int ldc; const float* bias; PanelStats st; unsigned poison;
    __device__ __forceinline__ void fused(f32x4 (&acc)[2][2][4][2], const Unit& u, int wr, int wc, int fr, int fq, PG8_LAS unsigned char* lds, int wid, int lane) const {
        typedef float f32x2v __attribute__((ext_vector_type(2)));
        const PG8_LAS f32x2v* S = (const PG8_LAS f32x2v*)(lds + 8192);
        const int col0 = u.pn * BM + wc * 32 + 4 * fq;
#pragma unroll
        for (int bj = 0; bj < 2; ++bj)
#pragma unroll
            for (int n = 0; n < 2; ++n) { const f32x4 bv = bias ? *(const f32x4*)(bias + col0 + bj * HALF + n * 16) : (f32x4){0.f, 0.f, 0.f, 0.f};
#pragma unroll
                for (int ai = 0; ai < 2; ++ai)
#pragma unroll
                    for (int m = 0; m < 4; ++m) acc[ai][bj][m][n] += bv; }
        f32x4 pre[4][2][2];
#pragma unroll
        for (int m = 0; m < 4; ++m) { const size_t off = (size_t)(u.pm * BM + wr * 64 + m * 16 + fr) * ldc + col0;
#pragma unroll
            for (int bj = 0; bj < 2; ++bj)
#pragma unroll
                for (int n = 0; n < 2; ++n) pre[m][bj][n] = *(const f32x4*)(base + off + bj * HALF + n * 16); }
        const bool bad = st.run(acc, u, wr, wc, fr, fq, lds, wid, lane) || poison != 0u;
        const float qnan = __builtin_nanf("");
#pragma unroll
        for (int ai = 0; ai < 2; ++ai)
#pragma unroll
            for (int m = 0; m < 4; ++m) { const int r = ai * HALF + wr * 64 + m * 16 + fr; const f32x2v sr = S[r]; const size_t off = (size_t)(u.pm * BM + r) * ldc + col0;
#pragma unroll
                for (int bj = 0; bj < 2; ++bj)
#pragma unroll
                    for (int n = 0; n < 2; ++n) { const f32x4 bs = ai == 0 ? pre[m][bj][n] : *(const f32x4*)(base + off + bj * HALF + n * 16); f32x4 o = bs + (acc[ai][bj][m][n] - sr.x) * sr.y;
                        if (bad) o = (f32x4){qnan, qnan, qnan, qnan}; *(f32x4*)(out + off + bj * HALF + n * 16) = o; }
                if (m & 1) asm volatile("" ::: "memory"); }
    }
};
struct EpiLnResLn {
    static constexpr bool PERM = false, AFTER_DRAIN = true;
    const float* base; float* out; bf16_t* xn; int ldc; const float* bias; PanelStats st1, st2; unsigned poison;
    __device__ __forceinline__ void fused(f32x4 (&acc)[2][2][4][2], const Unit& u, int wr, int wc, int fr, int fq, PG8_LAS unsigned char* lds, int wid, int lane) const {
        typedef float f32x2v __attribute__((ext_vector_type(2))); typedef unsigned u32x2v __attribute__((ext_vector_type(2)));
        const PG8_LAS f32x2v* S = (const PG8_LAS f32x2v*)(lds + 8192);
        const int col0 = u.pn * BM + wc * 32 + 4 * fq;
#pragma unroll
        for (int bj = 0; bj < 2; ++bj)
#pragma unroll
            for (int n = 0; n < 2; ++n) { const f32x4 bv = bias ? *(const f32x4*)(bias + col0 + bj * HALF + n * 16) : (f32x4){0.f, 0.f, 0.f, 0.f};
#pragma unroll
                for (int ai = 0; ai < 2; ++ai)
#pragma unroll
                    for (int m = 0; m < 4; ++m) acc[ai][bj][m][n] += bv; }
        bool bad = st1.run(acc, u, wr, wc, fr, fq, lds, wid, lane) || poison != 0u;
        const float qnan = __builtin_nanf("");
#pragma unroll
        for (int ai = 0; ai < 2; ++ai)
#pragma unroll
            for (int m = 0; m < 4; ++m) { const int r = ai * HALF + wr * 64 + m * 16 + fr; const f32x2v sr = S[r]; const size_t off = (size_t)(u.pm * BM + r) * ldc + col0;
#pragma unroll
                for (int bj = 0; bj < 2; ++bj)
#pragma unroll
                    for (int n = 0; n < 2; ++n) { const f32x4 bs = *(const f32x4*)(base + off + bj * HALF + n * 16); acc[ai][bj][m][n] = bs + (acc[ai][bj][m][n] - sr.x) * sr.y; }
                asm volatile("" : "+v"(acc[ai][0][m][0]), "+v"(acc[ai][0][m][1]), "+v"(acc[ai][1][m][0]), "+v"(acc[ai][1][m][1]));
                if (m & 1) asm volatile("" ::: "memory"); }
        const bool bad1 = bad;
        bad = st2.run(acc, u, wr, wc, fr, fq, lds, wid, lane) || bad;
#pragma unroll
        for (int ai = 0; ai < 2; ++ai)
#pragma unroll
            for (int m = 0; m < 4; ++m) { const int r = ai * HALF + wr * 64 + m * 16 + fr; const f32x2v sr = S[r]; const size_t off = (size_t)(u.pm * BM + r) * ldc + col0;
#pragma unroll
                for (int bj = 0; bj < 2; ++bj)
#pragma unroll
                    for (int n = 0; n < 2; ++n) { const f32x4 x1 = acc[ai][bj][m][n]; *(f32x4*)(out + off + bj * HALF + n * 16) = bad1 ? (f32x4){qnan, qnan, qnan, qnan} : x1;
                        const f32x4 o = (x1 - sr.x) * sr.y; u32x2v w; w.x = cvt_pk_bf16(o[0], o[1]); w.y = cvt_pk_bf16(o[2], o[3]);
                        if (bad) { w.x = 0x7fc07fc0u; w.y = 0x7fc07fc0u; } *(u32x2v*)(xn + off + bj * HALF + n * 16) = w; }
                asm volatile("" ::: "memory"); }
    }
};

template <class E, class = void> struct Perm2 { static constexpr bool v = false; };
template <class E> struct Perm2<E, decltype((void)E::PERM2)> { static constexpr bool v = E::PERM2; };
template <class E, class = void> struct MidSeg { static constexpr int v = 0; };
template <class E> struct MidSeg<E, decltype((void)E::MIDSEG)> { static constexpr int v = E::MIDSEG; };
template <class Epi, class Sched, bool ALIGN_EPI = false, bool SP2 = false>
__device__ __forceinline__ void gemm_phase(PG8_LAS unsigned char* lds, const Gemm g, const Sched& S, const Epi& E, int wid_in) {
    int lane_; asm volatile("v_mbcnt_lo_u32_b32 %0, -1, 0\n\tv_mbcnt_hi_u32_b32 %0, -1, %0" : "=v"(lane_));
    const int wid = wid_in, lane = lane_, tid = wid * 64 + lane, wr = wid >> 2, wc = wid & 3, fr = lane & 15, fq = lane >> 4;
    const int K = g.K, nt = K / BK;
    unsigned voffA[2], voffB[2];
#pragma unroll
    for (int i = 0; i < 2; ++i) { int R, C; stage_rc(tid * 16 + i * 8192, R, C); const int Rb = Perm2<Epi>::v ? (64 * (R >> 5) + 16 * ((R >> 2) & 3) + 4 * ((R >> 4) & 1) + (R & 3)) : Epi::PERM ? ((R & ~31) + perm32(R & 31)) : R;
        voffA[i] = (unsigned)(R * K + C) * 2u; voffB[i] = (unsigned)(Rb * K + C) * 2u; }
    const size_t kstep = (size_t)(BK * 2);
    const size_t hstep = (size_t)HALF * K * 2;
    const size_t hstepB = Perm2<Epi>::v ? (size_t)8 * K * 2 : hstep;
    const size_t tstep = 2 * hstep;
    const unsigned ldsw = (unsigned)wid * 1024u;
    const int aoff = lds_byte(wr * 64 + fr, fq * 8), boff = lds_byte(wc * 32 + fr, fq * 8);
#define PG8_SA(b, h) (((b) * 2 + (h)) * HTB)
#define PG8_SB(b, h) ((4 + (b) * 2 + (h)) * HTB)
#define PG8_STAGE(bufoff, gbase, voff) do { _Pragma("unroll") for (int _i = 0; _i < 2; ++_i) \
        __builtin_amdgcn_global_load_lds((const unsigned*)((const char*)(gbase) + (voff)[_i]), (PG8_LAS unsigned*)(lds + (bufoff) + ldsw + _i * 8192), 16, 0, 0); } while (0)
#define PG8_LDA(dst, b, h) do { _Pragma("unroll") for (int m = 0; m < 4; ++m) _Pragma("unroll") for (int k = 0; k < 2; ++k) dst[m][k] = *(const PG8_LAS bf16x8*)(lds + PG8_SA(b, h) + aoff + m * 2048 + k * 1024); } while (0)
#define PG8_LDB(dst, b, h) do { _Pragma("unroll") for (int n = 0; n < 2; ++n) _Pragma("unroll") for (int k = 0; k < 2; ++k) dst[n][k] = *(const PG8_LAS bf16x8*)(lds + PG8_SB(b, h) + boff + n * 2048 + k * 1024); } while (0)
#define PG8_MMA(ai, bj, At, Bt) do { __builtin_amdgcn_s_setprio(1); _Pragma("unroll") for (int m = 0; m < 4; ++m) _Pragma("unroll") for (int n = 0; n < 2; ++n) _Pragma("unroll") for (int k = 0; k < 2; ++k) \
        acc[ai][bj][m][n] = __builtin_amdgcn_mfma_f32_16x16x32_bf16(Bt[n][k], At[m][k], acc[ai][bj][m][n], 0, 0, 0); __builtin_amdgcn_s_setprio(0); } while (0)
#define PG8_WAIT_V(n) asm volatile("s_waitcnt vmcnt(" #n ")" ::: "memory")
#define PG8_WAIT_L(n) asm volatile("s_waitcnt lgkmcnt(" #n ")" ::: "memory")
#define PG8_BAR __builtin_amdgcn_s_barrier()
#define PG8_SCHED __builtin_amdgcn_sched_barrier(0)
    Unit cur, nxt; int ui = 0;
    if (!S.next(0, cur)) return;
    f32x4 acc[2][2][4][2];
#pragma unroll
    for (int a = 0; a < 2; ++a)
#pragma unroll
        for (int b = 0; b < 2; ++b)
#pragma unroll
            for (int m = 0; m < 4; ++m)
#pragma unroll
                for (int n = 0; n < 2; ++n) acc[a][b][m][n] = (f32x4){0.f, 0.f, 0.f, 0.f};
    bf16x8 At[4][2], B0[2][2], B1[2][2];
    const char* cA = (const char*)g.A + (size_t)cur.pm * tstep; const char* cB = (const char*)g.Bt + (size_t)cur.pn * tstep;
    S.a_ready(cur);
    if constexpr (SP2) {
        PG8_STAGE(PG8_SB(0, 0), cB, voffB); PG8_STAGE(PG8_SB(0, 1), cB + hstepB, voffB); PG8_STAGE(PG8_SA(0, 0), cA, voffA); PG8_STAGE(PG8_SA(0, 1), cA + hstep, voffA);
        if (wr == 1) PG8_BAR;
        PG8_WAIT_V(2); PG8_BAR;
        PG8_STAGE(PG8_SB(1, 0), cB + kstep, voffB); PG8_STAGE(PG8_SA(1, 0), cA + kstep, voffA); PG8_STAGE(PG8_SB(1, 1), cB + hstepB + kstep, voffB);
        PG8_WAIT_V(6); PG8_BAR;
    } else {
        PG8_STAGE(PG8_SB(0, 0), cB, voffB); PG8_STAGE(PG8_SA(0, 0), cA, voffA); PG8_STAGE(PG8_SB(0, 1), cB + hstepB, voffB); PG8_STAGE(PG8_SA(0, 1), cA + hstep, voffA);
        if (wr == 1) PG8_BAR;
        PG8_WAIT_V(4); PG8_BAR;
        PG8_STAGE(PG8_SB(1, 0), cB + kstep, voffB); PG8_STAGE(PG8_SA(1, 0), cA + kstep, voffA); PG8_STAGE(PG8_SB(1, 1), cB + hstepB + kstep, voffB);
        PG8_WAIT_V(6); PG8_BAR;
    }
    for (;;) {
        const bool has_next = S.next(ui + 1, nxt);
        const char* nA = has_next ? (const char*)g.A + (size_t)nxt.pm * tstep : cA; const char* nB = has_next ? (const char*)g.Bt + (size_t)nxt.pn * tstep : cB;
        for (int t = 0; t < nt; t += 2) {
            if constexpr (MidSeg<Epi>::v > 0) { if (t > 0 && t % MidSeg<Epi>::v == 0) E.mid(acc, cur, t / MidSeg<Epi>::v, wr, wc, fr, fq); }
            const bool last = (t == nt - 2);
            const char* a1 = cA + (size_t)(t + 1) * kstep;
            const char* a2 = last ? nA : cA + (size_t)(t + 2) * kstep; const char* b2 = last ? nB : cB + (size_t)(t + 2) * kstep;
            const char* a3 = a2 + kstep; const char* b3 = b2 + kstep;
            if (last && has_next) S.a_ready(nxt);
            if constexpr (SP2) {
            PG8_LDB(B0, 0, 0); PG8_LDB(B1, 0, 1); PG8_SCHED; PG8_LDA(At, 0, 0); PG8_STAGE(PG8_SA(1, 1), a1 + hstep, voffA);
            PG8_WAIT_V(8); PG8_WAIT_L(0); PG8_BAR; PG8_MMA(0, 0, At, B0); PG8_MMA(0, 1, At, B1); PG8_BAR; PG8_SCHED;
            PG8_LDA(At, 0, 1); PG8_STAGE(PG8_SB(0, 0), b2, voffB); PG8_STAGE(PG8_SB(0, 1), b2 + hstepB, voffB); PG8_STAGE(PG8_SA(0, 0), a2, voffA);
            PG8_WAIT_V(8); PG8_WAIT_L(0); PG8_BAR; PG8_MMA(1, 0, At, B0); PG8_MMA(1, 1, At, B1); PG8_BAR; PG8_SCHED;
            PG8_LDB(B0, 1, 0); PG8_LDB(B1, 1, 1); PG8_SCHED; PG8_LDA(At, 1, 0); PG8_STAGE(PG8_SA(0, 1), a2 + hstep, voffA);
            PG8_WAIT_V(8); PG8_WAIT_L(0); PG8_BAR; PG8_MMA(0, 0, At, B0); PG8_MMA(0, 1, At, B1); PG8_BAR; PG8_SCHED;
            PG8_LDA(At, 1, 1); PG8_STAGE(PG8_SB(1, 0), b3, voffB); PG8_STAGE(PG8_SB(1, 1), b3 + hstepB, voffB); PG8_STAGE(PG8_SA(1, 0), a3, voffA);
            PG8_WAIT_V(8); PG8_WAIT_L(0); PG8_BAR; PG8_MMA(1, 0, At, B0); PG8_MMA(1, 1, At, B1); PG8_BAR; PG8_SCHED;
            } else {
            PG8_LDB(B0, 0, 0); PG8_SCHED; PG8_LDA(At, 0, 0); PG8_STAGE(PG8_SA(1, 1), a1 + hstep, voffA);
            PG8_WAIT_L(8); PG8_BAR; PG8_WAIT_L(0); PG8_MMA(0, 0, At, B0); PG8_BAR; PG8_SCHED;
            PG8_LDB(B1, 0, 1); PG8_STAGE(PG8_SB(0, 0), b2, voffB);
            PG8_BAR; PG8_WAIT_L(0); PG8_MMA(0, 1, At, B1); PG8_BAR;
            PG8_LDA(At, 0, 1); PG8_STAGE(PG8_SA(0, 0), a2, voffA);
            PG8_BAR; PG8_WAIT_L(0); PG8_MMA(1, 0, At, B0); PG8_BAR; PG8_SCHED;
            PG8_STAGE(PG8_SB(0, 1), b2 + hstepB, voffB);
            PG8_WAIT_V(6); PG8_BAR; PG8_MMA(1, 1, At, B1); PG8_BAR;
            PG8_LDB(B0, 1, 0); PG8_SCHED; PG8_LDA(At, 1, 0); PG8_STAGE(PG8_SA(0, 1), a2 + hstep, voffA);
            PG8_WAIT_L(8); PG8_BAR; PG8_WAIT_L(0); PG8_MMA(0, 0, At, B0); PG8_BAR; PG8_SCHED;
            PG8_LDB(B1, 1, 1); PG8_STAGE(PG8_SB(1, 0), b3, voffB);
            PG8_BAR; PG8_WAIT_L(0); PG8_MMA(0, 1, At, B1); PG8_BAR;
            PG8_LDA(At, 1, 1); PG8_STAGE(PG8_SA(1, 0), a3, voffA);
            PG8_BAR; PG8_WAIT_L(0); PG8_MMA(1, 0, At, B0); PG8_BAR; PG8_SCHED;
            PG8_STAGE(PG8_SB(1, 1), b3 + hstepB, voffB);
            PG8_WAIT_V(6); PG8_BAR; PG8_MMA(1, 1, At, B1); PG8_BAR;
            }
        }
        if constexpr (ALIGN_EPI) { if (wr == 0) PG8_BAR; }
        if constexpr (!Epi::AFTER_DRAIN) { E(acc, cur, wr, wc, fr, fq); S.done(cur); }
        if (!has_next) break;
#pragma unroll
        for (int a = 0; a < 2; ++a)
#pragma unroll
            for (int b = 0; b < 2; ++b)
#pragma unroll
                for (int m = 0; m < 4; ++m)
#pragma unroll
                    for (int n = 0; n < 2; ++n) acc[a][b][m][n] = (f32x4){0.f, 0.f, 0.f, 0.f};
        cur = nxt; cA = nA; cB = nB; ++ui;
        if constexpr (ALIGN_EPI) { if (wr == 1) PG8_BAR; }
    }
    PG8_WAIT_V(0);
    if constexpr (!ALIGN_EPI) { if (wr == 0) PG8_BAR; }
    PG8_BAR;
    if constexpr (Epi::AFTER_DRAIN) { E.fused(acc, cur, wr, wc, fr, fq, lds, wid, lane); S.done(cur); }
#undef PG8_SA
#undef PG8_SB
#undef PG8_STAGE
#undef PG8_LDA
#undef PG8_LDB
#undef PG8_MMA
#undef PG8_WAIT_V
#undef PG8_WAIT_L
#undef PG8_BAR
#undef PG8_SCHED
}
}
namespace pg8 {
struct Gemm8 { const unsigned char* A; const unsigned char* Bt; int M, N, K; int scale_a, scale_b; };
template <class Epi, class Sched, bool ALIGN_EPI = false, bool SP2 = false>
__device__ __forceinline__ void gemm_phase_f8(PG8_LAS unsigned char* lds, const Gemm8 g, const Sched& S, const Epi& E, int wid_in) {
    int lane_; asm volatile("v_mbcnt_lo_u32_b32 %0, -1, 0\n\tv_mbcnt_hi_u32_b32 %0, -1, %0" : "=v"(lane_));
    const int wid = wid_in, lane = lane_, tid = wid * 64 + lane, wr = wid >> 2, wc = wid & 3, fr = lane & 15, fq = lane >> 4;
    const int K = g.K, nt = K / 128;
    unsigned voffA[2], voffB[2];
#pragma unroll
    for (int i = 0; i < 2; ++i) { int R, C; stage_rc(tid * 16 + i * 8192, R, C); const int Rb = Perm2<Epi>::v ? (64 * (R >> 5) + 16 * ((R >> 2) & 3) + 4 * ((R >> 4) & 1) + (R & 3)) : Epi::PERM ? ((R & ~31) + perm32(R & 31)) : R;
        voffA[i] = (unsigned)(R * K + 2 * C); voffB[i] = (unsigned)(Rb * K + 2 * C); }
    const size_t kstep = (size_t)(BK * 2);
    const size_t hstep = (size_t)HALF * K;
    const size_t hstepB = Perm2<Epi>::v ? (size_t)8 * K : hstep;
    const size_t tstep = 2 * hstep;
    const unsigned ldsw = (unsigned)wid * 1024u;
    const int aoff = lds_byte(wr * 64 + fr, fq * 16), boff = lds_byte(wc * 32 + fr, fq * 16);
#define PG8_SA(b, h) (((b) * 2 + (h)) * HTB)
#define PG8_SB(b, h) ((4 + (b) * 2 + (h)) * HTB)
#define PG8_STAGE(bufoff, gbase, voff) do { _Pragma("unroll") for (int _i = 0; _i < 2; ++_i) { unsigned keep_; \
        asm volatile("s_mov_b32 %0, m0\n\ts_mov_b32 m0, %3\n\ts_nop 0\n\tglobal_load_lds_dwordx4 %1, %2\n\ts_mov_b32 m0, %0" : "=&s"(keep_) : "v"((voff)[_i]), "s"((const char*)(gbase)), "s"((unsigned)(size_t)(lds + (bufoff) + ldsw + _i * 8192)) : "memory"); } } while (0)
#define PG8_LDA(dst, b, h) do { _Pragma("unroll") for (int m = 0; m < 4; ++m) { const u32x4 lo_ = *(const PG8_LAS u32x4*)(lds + PG8_SA(b, h) + aoff + m * 2048), hi_ = *(const PG8_LAS u32x4*)(lds + PG8_SA(b, h) + aoff + m * 2048 + 16); dst[m] = __builtin_bit_cast(i32x8, __builtin_shufflevector(lo_, hi_, 0, 1, 2, 3, 4, 5, 6, 7)); } } while (0)
#define PG8_LDB(dst, b, h) do { _Pragma("unroll") for (int n = 0; n < 2; ++n) { const u32x4 lo_ = *(const PG8_LAS u32x4*)(lds + PG8_SB(b, h) + boff + n * 2048), hi_ = *(const PG8_LAS u32x4*)(lds + PG8_SB(b, h) + boff + n * 2048 + 16); dst[n] = __builtin_bit_cast(i32x8, __builtin_shufflevector(lo_, hi_, 0, 1, 2, 3, 4, 5, 6, 7)); } } while (0)
#define PG8_MMA(ai, bj, At, Bt) do { __builtin_amdgcn_s_setprio(1); _Pragma("unroll") for (int m = 0; m < 4; ++m) _Pragma("unroll") for (int n = 0; n < 2; ++n) \
        acc[ai][bj][m][n] = __builtin_amdgcn_mfma_scale_f32_16x16x128_f8f6f4(Bt[n], At[m], acc[ai][bj][m][n], 0, 0, 0, g.scale_b, 0, g.scale_a); __builtin_amdgcn_s_setprio(0); } while (0)
#define PG8_WAIT_V(n) asm volatile("s_waitcnt vmcnt(" #n ")" ::: "memory")
#define PG8_WAIT_L(n) asm volatile("s_waitcnt lgkmcnt(" #n ")" ::: "memory")
#define PG8_BAR __builtin_amdgcn_s_barrier()
#define PG8_SCHED __builtin_amdgcn_sched_barrier(0)
    Unit cur, nxt; int ui = 0;
    if (!S.next(0, cur)) return;
    f32x4 acc[2][2][4][2];
#pragma unroll
    for (int a = 0; a < 2; ++a)
#pragma unroll
        for (int b = 0; b < 2; ++b)
#pragma unroll
            for (int m = 0; m < 4; ++m)
#pragma unroll
                for (int n = 0; n < 2; ++n) acc[a][b][m][n] = (f32x4){0.f, 0.f, 0.f, 0.f};
    typedef int i32x8 __attribute__((ext_vector_type(8))); i32x8 At[4], B0[2], B1[2];
    const char* cA = (const char*)g.A + (size_t)cur.pm * tstep; const char* cB = (const char*)g.Bt + (size_t)cur.pn * tstep;
    S.a_ready(cur);
    if constexpr (SP2) {
        PG8_STAGE(PG8_SB(0, 0), cB, voffB); PG8_STAGE(PG8_SB(0, 1), cB + hstepB, voffB); PG8_STAGE(PG8_SA(0, 0), cA, voffA); PG8_STAGE(PG8_SA(0, 1), cA + hstep, voffA);
        if (wr == 1) PG8_BAR;
        PG8_WAIT_V(2); PG8_BAR;
        PG8_STAGE(PG8_SB(1, 0), cB + kstep, voffB); PG8_STAGE(PG8_SA(1, 0), cA + kstep, voffA); PG8_STAGE(PG8_SB(1, 1), cB + hstepB + kstep, voffB);
        PG8_WAIT_V(6); PG8_BAR;
    } else {
        PG8_STAGE(PG8_SB(0, 0), cB, voffB); PG8_STAGE(PG8_SA(0, 0), cA, voffA); PG8_STAGE(PG8_SB(0, 1), cB + hstepB, voffB); PG8_STAGE(PG8_SA(0, 1), cA + hstep, voffA);
        if (wr == 1) PG8_BAR;
        PG8_WAIT_V(4); PG8_BAR;
        PG8_STAGE(PG8_SB(1, 0), cB + kstep, voffB); PG8_STAGE(PG8_SA(1, 0), cA + kstep, voffA); PG8_STAGE(PG8_SB(1, 1), cB + hstepB + kstep, voffB);
        PG8_WAIT_V(6); PG8_BAR;
    }
    for (;;) {
        const bool has_next = S.next(ui + 1, nxt);
        const char* nA = has_next ? (const char*)g.A + (size_t)nxt.pm * tstep : cA; const char* nB = has_next ? (const char*)g.Bt + (size_t)nxt.pn * tstep : cB;
#pragma unroll 1
        for (int t = 0; t < nt; t += 2) {
            const bool last = (t == nt - 2);
            const char* a1 = cA + (size_t)(t + 1) * kstep;
            const char* a2 = last ? nA : cA + (size_t)(t + 2) * kstep; const char* b2 = last ? nB : cB + (size_t)(t + 2) * kstep;
            const char* a3 = a2 + kstep; const char* b3 = b2 + kstep;
            if (last && has_next) S.a_ready(nxt);
            if constexpr (SP2) {
            PG8_LDB(B0, 0, 0); PG8_LDB(B1, 0, 1); PG8_SCHED; PG8_LDA(At, 0, 0); PG8_STAGE(PG8_SA(1, 1), a1 + hstep, voffA);
            PG8_WAIT_V(8); PG8_WAIT_L(0); PG8_BAR; PG8_MMA(0, 0, At, B0); PG8_MMA(0, 1, At, B1); PG8_BAR; PG8_SCHED;
            PG8_LDA(At, 0, 1); PG8_STAGE(PG8_SB(0, 0), b2, voffB); PG8_STAGE(PG8_SB(0, 1), b2 + hstepB, voffB); PG8_STAGE(PG8_SA(0, 0), a2, voffA);
            PG8_WAIT_V(8); PG8_WAIT_L(0); PG8_BAR; PG8_MMA(1, 0, At, B0); PG8_MMA(1, 1, At, B1); PG8_BAR; PG8_SCHED;
            PG8_LDB(B0, 1, 0); PG8_LDB(B1, 1, 1); PG8_SCHED; PG8_LDA(At, 1, 0); PG8_STAGE(PG8_SA(0, 1), a2 + hstep, voffA);
            PG8_WAIT_V(8); PG8_WAIT_L(0); PG8_BAR; PG8_MMA(0, 0, At, B0); PG8_MMA(0, 1, At, B1); PG8_BAR; PG8_SCHED;
            PG8_LDA(At, 1, 1); PG8_STAGE(PG8_SB(1, 0), b3, voffB); PG8_STAGE(PG8_SB(1, 1), b3 + hstepB, voffB); PG8_STAGE(PG8_SA(1, 0), a3, voffA);
            PG8_WAIT_V(8); PG8_WAIT_L(0); PG8_BAR; PG8_MMA(1, 0, At, B0); PG8_MMA(1, 1, At, B1); PG8_BAR; PG8_SCHED;
            } else {
            PG8_LDB(B0, 0, 0); PG8_SCHED; PG8_LDA(At, 0, 0); PG8_STAGE(PG8_SA(1, 1), a1 + hstep, voffA);
            PG8_WAIT_L(8); PG8_BAR; PG8_WAIT_L(0); PG8_MMA(0, 0, At, B0); PG8_BAR; PG8_SCHED;
            PG8_LDB(B1, 0, 1); PG8_STAGE(PG8_SB(0, 0), b2, voffB);
            PG8_BAR; PG8_WAIT_L(0); PG8_MMA(0, 1, At, B1); PG8_BAR;
            PG8_LDA(At, 0, 1); PG8_STAGE(PG8_SA(0, 0), a2, voffA);
            PG8_BAR; PG8_WAIT_L(0); PG8_MMA(1, 0, At, B0); PG8_BAR; PG8_SCHED;
            PG8_STAGE(PG8_SB(0, 1), b2 + hstepB, voffB);
            PG8_WAIT_V(6); PG8_BAR; PG8_MMA(1, 1, At, B1); PG8_BAR;
            PG8_LDB(B0, 1, 0); PG8_SCHED; PG8_LDA(At, 1, 0); PG8_STAGE(PG8_SA(0, 1), a2 + hstep, voffA);
            PG8_WAIT_L(8); PG8_BAR; PG8_WAIT_L(0); PG8_MMA(0, 0, At, B0); PG8_BAR; PG8_SCHED;
            PG8_LDB(B1, 1, 1); PG8_STAGE(PG8_SB(1, 0), b3, voffB);
            PG8_BAR; PG8_WAIT_L(0); PG8_MMA(0, 1, At, B1); PG8_BAR;
            PG8_LDA(At, 1, 1); PG8_STAGE(PG8_SA(1, 0), a3, voffA);
            PG8_BAR; PG8_WAIT_L(0); PG8_MMA(1, 0, At, B0); PG8_BAR; PG8_SCHED;
            PG8_STAGE(PG8_SB(1, 1), b3 + hstepB, voffB);
            PG8_WAIT_V(6); PG8_BAR; PG8_MMA(1, 1, At, B1); PG8_BAR;
            }
        }
        if constexpr (ALIGN_EPI) { if (wr == 0) PG8_BAR; }
        if constexpr (!Epi::AFTER_DRAIN) { int l2_; asm volatile("v_mbcnt_lo_u32_b32 %0, -1, 0\n\tv_mbcnt_hi_u32_b32 %0, -1, %0" : "=v"(l2_));
            E(acc, cur, wr, wc, l2_ & 15, l2_ >> 4); S.done(cur); }
        if (!has_next) break;
#pragma unroll
        for (int a = 0; a < 2; ++a)
#pragma unroll
            for (int b = 0; b < 2; ++b)
#pragma unroll
                for (int m = 0; m < 4; ++m)
#pragma unroll
                    for (int n = 0; n < 2; ++n) acc[a][b][m][n] = (f32x4){0.f, 0.f, 0.f, 0.f};
        cur = nxt; cA = nA; cB = nB; ++ui;
        if constexpr (ALIGN_EPI) { if (wr == 1) PG8_BAR; }
    }
    PG8_WAIT_V(0);
    if constexpr (!ALIGN_EPI) { if (wr == 0) PG8_BAR; }
    PG8_BAR;
    if constexpr (Epi::AFTER_DRAIN) { E.fused(acc, cur, wr, wc, fr, fq, lds, wid, lane); S.done(cur); }
#undef PG8_SA
#undef PG8_SB
#undef PG8_STAGE
#undef PG8_LDA
#undef PG8_LDB
#undef PG8_MMA
#undef PG8_WAIT_V
#undef PG8_WAIT_L
#undef PG8_BAR
#undef PG8_SCHED
}
}
namespace pg8 {
struct Gemm8G { const unsigned char* A; const unsigned char* Bt; const int* rowtok; int K; int scale_a, scale_b; };
template <class Epi, class Sched, bool ALIGN_EPI = false, bool SP2 = false>
__device__ __forceinline__ void gemm_phase_f8g(PG8_LAS unsigned char* lds, const Gemm8G g, const Sched& S, const Epi& E, int wid_in) {
    int lane_; asm volatile("v_mbcnt_lo_u32_b32 %0, -1, 0\n\tv_mbcnt_hi_u32_b32 %0, -1, %0" : "=v"(lane_));
    const int wid = wid_in, lane = lane_, tid = wid * 64 + lane, wr = wid >> 2, wc = wid & 3, fr = lane & 15, fq = lane >> 4;
    const int K = g.K, nt = K / 128;
    unsigned va[4], voffB0; int R0_, C0_;
    { int R, C; stage_rc(tid * 16, R, C); R0_ = R; C0_ = C; const int Rb = Perm2<Epi>::v ? (64 * (R >> 5) + 16 * ((R >> 2) & 3) + 4 * ((R >> 4) & 1) + (R & 3)) : Epi::PERM ? ((R & ~31) + perm32(R & 31)) : R;
      voffB0 = (unsigned)(Rb * K + 2 * C); }
    const size_t bstep1 = (size_t)(Perm2<Epi>::v ? 128 : 64) * K;
    PG8_LAS unsigned* tab = (PG8_LAS unsigned*)(lds + 135424);
    const size_t kstep = (size_t)(BK * 2);
    const size_t hstep = (size_t)HALF * K;
    const size_t hstepB = Perm2<Epi>::v ? (size_t)8 * K : hstep;
    const size_t tstep = 2 * hstep;
    const unsigned ldsw = (unsigned)wid * 1024u;
    const int aoff = lds_byte(wr * 64 + fr, fq * 16), boff = lds_byte(wc * 32 + fr, fq * 16);
#define PG8_SA(b, h) (((b) * 2 + (h)) * HTB)
#define PG8_SB(b, h) ((4 + (b) * 2 + (h)) * HTB)
#define PG8_GL(vo, sb, ldsaddr) do { unsigned keep_; asm volatile("s_mov_b32 %0, m0\n\ts_mov_b32 m0, %3\n\ts_nop 0\n\tglobal_load_lds_dwordx4 %1, %2\n\ts_mov_b32 m0, %0" : "=&s"(keep_) : "v"(vo), "s"((const char*)(sb)), "s"((unsigned)(size_t)(ldsaddr)) : "memory"); } while (0)
#define PG8_STAGE_B(bufoff, gbase) do { PG8_GL(voffB0, (gbase), lds + (bufoff) + ldsw); PG8_GL(voffB0, (gbase) + bstep1, lds + (bufoff) + ldsw + 8192); } while (0)
#define PG8_STAGE_A(bufoff, kbase, h) do { PG8_GL(va[2 * (h)], (kbase), lds + (bufoff) + ldsw); PG8_GL(va[2 * (h) + 1], (kbase), lds + (bufoff) + ldsw + 8192); } while (0)
#define PG8_LOADVA(slot) do { _Pragma("unroll") for (int h_ = 0; h_ < 2; ++h_) _Pragma("unroll") for (int i_ = 0; i_ < 2; ++i_) va[2 * h_ + i_] = tab[(slot) * 256 + h_ * 128 + R0_ + 64 * i_] * (unsigned)K + 2u * (unsigned)C0_; } while (0)
#define PG8_LDA(dst, b, h) do { _Pragma("unroll") for (int m = 0; m < 4; ++m) { const u32x4 lo_ = *(const PG8_LAS u32x4*)(lds + PG8_SA(b, h) + aoff + m * 2048), hi_ = *(const PG8_LAS u32x4*)(lds + PG8_SA(b, h) + aoff + m * 2048 + 16); dst[m] = __builtin_bit_cast(i32x8, __builtin_shufflevector(lo_, hi_, 0, 1, 2, 3, 4, 5, 6, 7)); } } while (0)
#define PG8_LDB(dst, b, h) do { _Pragma("unroll") for (int n = 0; n < 2; ++n) { const u32x4 lo_ = *(const PG8_LAS u32x4*)(lds + PG8_SB(b, h) + boff + n * 2048), hi_ = *(const PG8_LAS u32x4*)(lds + PG8_SB(b, h) + boff + n * 2048 + 16); dst[n] = __builtin_bit_cast(i32x8, __builtin_shufflevector(lo_, hi_, 0, 1, 2, 3, 4, 5, 6, 7)); } } while (0)
#define PG8_MMA(ai, bj, At, Bt) do { __builtin_amdgcn_s_setprio(1); _Pragma("unroll") for (int m = 0; m < 4; ++m) _Pragma("unroll") for (int n = 0; n < 2; ++n) \
        acc[ai][bj][m][n] = __builtin_amdgcn_mfma_scale_f32_16x16x128_f8f6f4(Bt[n], At[m], acc[ai][bj][m][n], 0, 0, 0, g.scale_b, 0, g.scale_a); __builtin_amdgcn_s_setprio(0); } while (0)
#define PG8_WAIT_V(n) asm volatile("s_waitcnt vmcnt(" #n ")" ::: "memory")
#define PG8_WAIT_L(n) asm volatile("s_waitcnt lgkmcnt(" #n ")" ::: "memory")
#define PG8_BAR __builtin_amdgcn_s_barrier()
#define PG8_SCHED __builtin_amdgcn_sched_barrier(0)
    Unit cur, nxt; int ui = 0;
    if (!S.next(0, cur)) return;
    f32x4 acc[2][2][4][2];
#pragma unroll
    for (int a = 0; a < 2; ++a)
#pragma unroll
        for (int b = 0; b < 2; ++b)
#pragma unroll
            for (int m = 0; m < 4; ++m)
#pragma unroll
                for (int n = 0; n < 2; ++n) acc[a][b][m][n] = (f32x4){0.f, 0.f, 0.f, 0.f};
    typedef int i32x8 __attribute__((ext_vector_type(8))); i32x8 At[4], B0[2], B1[2];
    const char* aB = (const char*)g.A; const char* cB = (const char*)g.Bt + (size_t)cur.pn * tstep;
    S.a_ready(cur);
    { if (tid < 256) {
#pragma unroll 1
        for (int u_ = 0; u_ < 17; ++u_) { Unit t_; if (!S.next(u_, t_)) break; tab[u_ * 256 + tid] = (unsigned)g.rowtok[t_.pm * 256 + tid]; } }
      asm volatile("s_waitcnt vmcnt(0) lgkmcnt(0)" ::: "memory"); PG8_BAR; asm volatile("" ::: "memory");
      PG8_LOADVA(0); }
    if constexpr (SP2) {
        PG8_STAGE_B(PG8_SB(0, 0), cB); PG8_STAGE_B(PG8_SB(0, 1), cB + hstepB); PG8_STAGE_A(PG8_SA(0, 0), aB, 0); PG8_STAGE_A(PG8_SA(0, 1), aB, 1);
        if (wr == 1) PG8_BAR;
        PG8_WAIT_V(2); PG8_BAR;
        PG8_STAGE_B(PG8_SB(1, 0), cB + kstep); PG8_STAGE_A(PG8_SA(1, 0), aB + kstep, 0); PG8_STAGE_B(PG8_SB(1, 1), cB + hstepB + kstep);
        PG8_WAIT_V(6); PG8_BAR;
    } else {
        PG8_STAGE_B(PG8_SB(0, 0), cB); PG8_STAGE_A(PG8_SA(0, 0), aB, 0); PG8_STAGE_B(PG8_SB(0, 1), cB + hstepB); PG8_STAGE_A(PG8_SA(0, 1), aB, 1);
        if (wr == 1) PG8_BAR;
        PG8_WAIT_V(4); PG8_BAR;
        PG8_STAGE_B(PG8_SB(1, 0), cB + kstep); PG8_STAGE_A(PG8_SA(1, 0), aB + kstep, 0); PG8_STAGE_B(PG8_SB(1, 1), cB + hstepB + kstep);
        PG8_WAIT_V(6); PG8_BAR;
    }
    for (;;) {
        const bool has_next = S.next(ui + 1, nxt);
        const char* nB = has_next ? (const char*)g.Bt + (size_t)nxt.pn * tstep : cB;
#pragma unroll 1
        for (int t = 0; t < nt; t += 2) {
            const bool last = (t == nt - 2);
            const char* a1 = aB + (size_t)(t + 1) * kstep;
            const char* a2 = last ? aB : aB + (size_t)(t + 2) * kstep; const char* b2 = last ? nB : cB + (size_t)(t + 2) * kstep;
            const char* a3 = a2 + kstep; const char* b3 = b2 + kstep;
            if (last && has_next) S.a_ready(nxt);
            if constexpr (SP2) {
            PG8_LDB(B0, 0, 0); PG8_LDB(B1, 0, 1); PG8_SCHED; PG8_LDA(At, 0, 0); PG8_STAGE_A(PG8_SA(1, 1), a1, 1); if (last && has_next) PG8_LOADVA(ui + 1);
            PG8_WAIT_V(8); PG8_WAIT_L(0); PG8_BAR; PG8_MMA(0, 0, At, B0); PG8_MMA(0, 1, At, B1); PG8_BAR; PG8_SCHED;
            PG8_LDA(At, 0, 1); PG8_STAGE_B(PG8_SB(0, 0), b2); PG8_STAGE_B(PG8_SB(0, 1), b2 + hstepB); PG8_STAGE_A(PG8_SA(0, 0), a2, 0);
            PG8_WAIT_V(8); PG8_WAIT_L(0); PG8_BAR; PG8_MMA(1, 0, At, B0); PG8_MMA(1, 1, At, B1); PG8_BAR; PG8_SCHED;
            PG8_LDB(B0, 1, 0); PG8_LDB(B1, 1, 1); PG8_SCHED; PG8_LDA(At, 1, 0); PG8_STAGE_A(PG8_SA(0, 1), a2, 1);
            PG8_WAIT_V(8); PG8_WAIT_L(0); PG8_BAR; PG8_MMA(0, 0, At, B0); PG8_MMA(0, 1, At, B1); PG8_BAR; PG8_SCHED;
            PG8_LDA(At, 1, 1); PG8_STAGE_B(PG8_SB(1, 0), b3); PG8_STAGE_B(PG8_SB(1, 1), b3 + hstepB); PG8_STAGE_A(PG8_SA(1, 0), a3, 0);
            PG8_WAIT_V(8); PG8_WAIT_L(0); PG8_BAR; PG8_MMA(1, 0, At, B0); PG8_MMA(1, 1, At, B1); PG8_BAR; PG8_SCHED;
            } else {
            PG8_LDB(B0, 0, 0); PG8_SCHED; PG8_LDA(At, 0, 0); PG8_STAGE_A(PG8_SA(1, 1), a1, 1); if (last && has_next) PG8_LOADVA(ui + 1);
            PG8_WAIT_L(8); PG8_BAR; PG8_WAIT_L(0); PG8_MMA(0, 0, At, B0); PG8_BAR; PG8_SCHED;
            PG8_LDB(B1, 0, 1); PG8_STAGE_B(PG8_SB(0, 0), b2);
            PG8_BAR; PG8_WAIT_L(0); PG8_MMA(0, 1, At, B1); PG8_BAR;
            PG8_LDA(At, 0, 1); PG8_STAGE_A(PG8_SA(0, 0), a2, 0);
            PG8_BAR; PG8_WAIT_L(0); PG8_MMA(1, 0, At, B0); PG8_BAR; PG8_SCHED;
            PG8_STAGE_B(PG8_SB(0, 1), b2 + hstepB);
            PG8_WAIT_V(6); PG8_BAR; PG8_MMA(1, 1, At, B1); PG8_BAR;
            PG8_LDB(B0, 1, 0); PG8_SCHED; PG8_LDA(At, 1, 0); PG8_STAGE_A(PG8_SA(0, 1), a2, 1);
            PG8_WAIT_L(8); PG8_BAR; PG8_WAIT_L(0); PG8_MMA(0, 0, At, B0); PG8_BAR; PG8_SCHED;
            PG8_LDB(B1, 1, 1); PG8_STAGE_B(PG8_SB(1, 0), b3);
            PG8_BAR; PG8_WAIT_L(0); PG8_MMA(0, 1, At, B1); PG8_BAR;
            PG8_LDA(At, 1, 1); PG8_STAGE_A(PG8_SA(1, 0), a3, 0);
            PG8_BAR; PG8_WAIT_L(0); PG8_MMA(1, 0, At, B0); PG8_BAR; PG8_SCHED;
            PG8_STAGE_B(PG8_SB(1, 1), b3 + hstepB);
            PG8_WAIT_V(6); PG8_BAR; PG8_MMA(1, 1, At, B1); PG8_BAR;
            }
        }
        if constexpr (ALIGN_EPI) { if (wr == 0) PG8_BAR; }
        if constexpr (!Epi::AFTER_DRAIN) { int l2_; asm volatile("v_mbcnt_lo_u32_b32 %0, -1, 0\n\tv_mbcnt_hi_u32_b32 %0, -1, %0" : "=v"(l2_));
            E(acc, cur, wr, wc, l2_ & 15, l2_ >> 4); S.done(cur); }
        if (!has_next) break;
#pragma unroll
        for (int a = 0; a < 2; ++a)
#pragma unroll
            for (int b = 0; b < 2; ++b)
#pragma unroll
                for (int m = 0; m < 4; ++m)
#pragma unroll
                    for (int n = 0; n < 2; ++n) acc[a][b][m][n] = (f32x4){0.f, 0.f, 0.f, 0.f};
        cur = nxt; cB = nB; ++ui;
        if constexpr (ALIGN_EPI) { if (wr == 1) PG8_BAR; }
    }
    PG8_WAIT_V(0);
    if constexpr (!ALIGN_EPI) { if (wr == 0) PG8_BAR; }
    PG8_BAR;
    if constexpr (Epi::AFTER_DRAIN) { E.fused(acc, cur, wr, wc, fr, fq, lds, wid, lane); S.done(cur); }
#undef PG8_SA
#undef PG8_SB
#undef PG8_GL
#undef PG8_STAGE_A
#undef PG8_STAGE_B
#undef PG8_LOADVA
#undef PG8_LDA
#undef PG8_LDB
#undef PG8_MMA
#undef PG8_WAIT_V
#undef PG8_WAIT_L
#undef PG8_BAR
#undef PG8_SCHED
}
}
namespace pg8 {
struct GemmA { const bf16_t* A; const bf16_t* Bt; int K; int rowA; size_t kstepA, hstepA, tstepA; };
template <class Epi, class Sched, bool ALIGN_EPI = false, bool SP2 = false>
__device__ __forceinline__ void gemm_phase_ga(PG8_LAS unsigned char* lds, const GemmA g, const Sched& S, const Epi& E, int wid_in) {
    int lane_; asm volatile("v_mbcnt_lo_u32_b32 %0, -1, 0\n\tv_mbcnt_hi_u32_b32 %0, -1, %0" : "=v"(lane_));
    const int wid = wid_in, lane = lane_, tid = wid * 64 + lane, wr = wid >> 2, wc = wid & 3, fr = lane & 15, fq = lane >> 4;
    const int K = g.K, nt = K / BK;
    unsigned voffA[2], voffB[2];
#pragma unroll
    for (int i = 0; i < 2; ++i) { int R, C; stage_rc(tid * 16 + i * 8192, R, C); const int Rb = Perm2<Epi>::v ? (64 * (R >> 5) + 16 * ((R >> 2) & 3) + 4 * ((R >> 4) & 1) + (R & 3)) : Epi::PERM ? ((R & ~31) + perm32(R & 31)) : R;
        voffA[i] = (unsigned)(R * g.rowA + C * 2); voffB[i] = (unsigned)(Rb * K + C) * 2u; }
    const size_t kstep = (size_t)(BK * 2);
    const size_t hstep = (size_t)HALF * K * 2;
    const size_t kstepA = g.kstepA, hstepA = g.hstepA, tstepA = g.tstepA;
    const size_t hstepB = Perm2<Epi>::v ? (size_t)8 * K * 2 : hstep;
    const size_t tstep = 2 * hstep;
    const unsigned ldsw = (unsigned)wid * 1024u;
    const int aoff = lds_byte(wr * 64 + fr, fq * 8), boff = lds_byte(wc * 32 + fr, fq * 8);
#define PG8_SA(b, h) (((b) * 2 + (h)) * HTB)
#define PG8_SB(b, h) ((4 + (b) * 2 + (h)) * HTB)
#define PG8_STAGE(bufoff, gbase, voff) do { _Pragma("unroll") for (int _i = 0; _i < 2; ++_i) \
        __builtin_amdgcn_global_load_lds((const unsigned*)((const char*)(gbase) + (voff)[_i]), (PG8_LAS unsigned*)(lds + (bufoff) + ldsw + _i * 8192), 16, 0, 0); } while (0)
#define PG8_LDA(dst, b, h) do { _Pragma("unroll") for (int m = 0; m < 4; ++m) _Pragma("unroll") for (int k = 0; k < 2; ++k) dst[m][k] = *(const PG8_LAS bf16x8*)(lds + PG8_SA(b, h) + aoff + m * 2048 + k * 1024); } while (0)
#define PG8_LDB(dst, b, h) do { _Pragma("unroll") for (int n = 0; n < 2; ++n) _Pragma("unroll") for (int k = 0; k < 2; ++k) dst[n][k] = *(const PG8_LAS bf16x8*)(lds + PG8_SB(b, h) + boff + n * 2048 + k * 1024); } while (0)
#define PG8_MMA(ai, bj, At, Bt) do { __builtin_amdgcn_s_setprio(1); _Pragma("unroll") for (int m = 0; m < 4; ++m) _Pragma("unroll") for (int n = 0; n < 2; ++n) _Pragma("unroll") for (int k = 0; k < 2; ++k) \
        acc[ai][bj][m][n] = __builtin_amdgcn_mfma_f32_16x16x32_bf16(Bt[n][k], At[m][k], acc[ai][bj][m][n], 0, 0, 0); __builtin_amdgcn_s_setprio(0); } while (0)
#define PG8_WAIT_V(n) asm volatile("s_waitcnt vmcnt(" #n ")" ::: "memory")
#define PG8_WAIT_L(n) asm volatile("s_waitcnt lgkmcnt(" #n ")" ::: "memory")
#define PG8_BAR __builtin_amdgcn_s_barrier()
#define PG8_SCHED __builtin_amdgcn_sched_barrier(0)
    Unit cur, nxt; int ui = 0;
    if (!S.next(0, cur)) return;
    f32x4 acc[2][2][4][2];
#pragma unroll
    for (int a = 0; a < 2; ++a)
#pragma unroll
        for (int b = 0; b < 2; ++b)
#pragma unroll
            for (int m = 0; m < 4; ++m)
#pragma unroll
                for (int n = 0; n < 2; ++n) acc[a][b][m][n] = (f32x4){0.f, 0.f, 0.f, 0.f};
    bf16x8 At[4][2], B0[2][2], B1[2][2];
    const char* cA = (const char*)g.A + (size_t)cur.pm * tstepA; const char* cB = (const char*)g.Bt + (size_t)cur.pn * tstep;
    S.a_ready(cur);
    if constexpr (SP2) {
        PG8_STAGE(PG8_SB(0, 0), cB, voffB); PG8_STAGE(PG8_SB(0, 1), cB + hstepB, voffB); PG8_STAGE(PG8_SA(0, 0), cA, voffA); PG8_STAGE(PG8_SA(0, 1), cA + hstepA, voffA);
        if (wr == 1) PG8_BAR;
        PG8_WAIT_V(2); PG8_BAR;
        PG8_STAGE(PG8_SB(1, 0), cB + kstep, voffB); PG8_STAGE(PG8_SA(1, 0), cA + kstepA, voffA); PG8_STAGE(PG8_SB(1, 1), cB + hstepB + kstep, voffB);
        PG8_WAIT_V(6); PG8_BAR;
    } else {
        PG8_STAGE(PG8_SB(0, 0), cB, voffB); PG8_STAGE(PG8_SA(0, 0), cA, voffA); PG8_STAGE(PG8_SB(0, 1), cB + hstepB, voffB); PG8_STAGE(PG8_SA(0, 1), cA + hstepA, voffA);
        if (wr == 1) PG8_BAR;
        PG8_WAIT_V(4); PG8_BAR;
        PG8_STAGE(PG8_SB(1, 0), cB + kstep, voffB); PG8_STAGE(PG8_SA(1, 0), cA + kstepA, voffA); PG8_STAGE(PG8_SB(1, 1), cB + hstepB + kstep, voffB);
        PG8_WAIT_V(6); PG8_BAR;
    }
    for (;;) {
        const bool has_next = S.next(ui + 1, nxt);
        const char* nA = has_next ? (const char*)g.A + (size_t)nxt.pm * tstepA : cA; const char* nB = has_next ? (const char*)g.Bt + (size_t)nxt.pn * tstep : cB;
        for (int t = 0; t < nt; t += 2) {
            if constexpr (MidSeg<Epi>::v > 0) { if (t > 0 && t % MidSeg<Epi>::v == 0) E.mid(acc, cur, t / MidSeg<Epi>::v, wr, wc, fr, fq); }
            const bool last = (t == nt - 2);
            const char* a1 = cA + (size_t)(t + 1) * kstepA;
            const char* a2 = last ? nA : cA + (size_t)(t + 2) * kstepA; const char* b2 = last ? nB : cB + (size_t)(t + 2) * kstep;
            const char* a3 = a2 + kstepA; const char* b3 = b2 + kstep;
            if (last && has_next) S.a_ready(nxt);
            if constexpr (SP2) {
            PG8_LDB(B0, 0, 0); PG8_LDB(B1, 0, 1); PG8_SCHED; PG8_LDA(At, 0, 0); PG8_STAGE(PG8_SA(1, 1), a1 + hstepA, voffA);
            PG8_WAIT_V(8); PG8_WAIT_L(0); PG8_BAR; PG8_MMA(0, 0, At, B0); PG8_MMA(0, 1, At, B1); PG8_BAR; PG8_SCHED;
            PG8_LDA(At, 0, 1); PG8_STAGE(PG8_SB(0, 0), b2, voffB); PG8_STAGE(PG8_SB(0, 1), b2 + hstepB, voffB); PG8_STAGE(PG8_SA(0, 0), a2, voffA);
            PG8_WAIT_V(8); PG8_WAIT_L(0); PG8_BAR; PG8_MMA(1, 0, At, B0); PG8_MMA(1, 1, At, B1); PG8_BAR; PG8_SCHED;
            PG8_LDB(B0, 1, 0); PG8_LDB(B1, 1, 1); PG8_SCHED; PG8_LDA(At, 1, 0); PG8_STAGE(PG8_SA(0, 1), a2 + hstepA, voffA);
            PG8_WAIT_V(8); PG8_WAIT_L(0); PG8_BAR; PG8_MMA(0, 0, At, B0); PG8_MMA(0, 1, At, B1); PG8_BAR; PG8_SCHED;
            PG8_LDA(At, 1, 1); PG8_STAGE(PG8_SB(1, 0), b3, voffB); PG8_STAGE(PG8_SB(1, 1), b3 + hstepB, voffB); PG8_STAGE(PG8_SA(1, 0), a3, voffA);
            PG8_WAIT_V(8); PG8_WAIT_L(0); PG8_BAR; PG8_MMA(1, 0, At, B0); PG8_MMA(1, 1, At, B1); PG8_BAR; PG8_SCHED;
            } else {
            PG8_LDB(B0, 0, 0); PG8_SCHED; PG8_LDA(At, 0, 0); PG8_STAGE(PG8_SA(1, 1), a1 + hstepA, voffA);
            PG8_WAIT_L(8); PG8_BAR; PG8_WAIT_L(0); PG8_MMA(0, 0, At, B0); PG8_BAR; PG8_SCHED;
            PG8_LDB(B1, 0, 1); PG8_STAGE(PG8_SB(0, 0), b2, voffB);
            PG8_BAR; PG8_WAIT_L(0); PG8_MMA(0, 1, At, B1); PG8_BAR;
            PG8_LDA(At, 0, 1); PG8_STAGE(PG8_SA(0, 0), a2, voffA);
            PG8_BAR; PG8_WAIT_L(0); PG8_MMA(1, 0, At, B0); PG8_BAR; PG8_SCHED;
            PG8_STAGE(PG8_SB(0, 1), b2 + hstepB, voffB);
            PG8_WAIT_V(6); PG8_BAR; PG8_MMA(1, 1, At, B1); PG8_BAR;
            PG8_LDB(B0, 1, 0); PG8_SCHED; PG8_LDA(At, 1, 0); PG8_STAGE(PG8_SA(0, 1), a2 + hstepA, voffA);
            PG8_WAIT_L(8); PG8_BAR; PG8_WAIT_L(0); PG8_MMA(0, 0, At, B0); PG8_BAR; PG8_SCHED;
            PG8_LDB(B1, 1, 1); PG8_STAGE(PG8_SB(1, 0), b3, voffB);
            PG8_BAR; PG8_WAIT_L(0); PG8_MMA(0, 1, At, B1); PG8_BAR;
            PG8_LDA(At, 1, 1); PG8_STAGE(PG8_SA(1, 0), a3, voffA);
            PG8_BAR; PG8_WAIT_L(0); PG8_MMA(1, 0, At, B0); PG8_BAR; PG8_SCHED;
            PG8_STAGE(PG8_SB(1, 1), b3 + hstepB, voffB);
            PG8_WAIT_V(6); PG8_BAR; PG8_MMA(1, 1, At, B1); PG8_BAR;
            }
        }
        if constexpr (ALIGN_EPI) { if (wr == 0) PG8_BAR; }
        if constexpr (!Epi::AFTER_DRAIN) { E(acc, cur, wr, wc, fr, fq); S.done(cur); }
        if (!has_next) break;
#pragma unroll
        for (int a = 0; a < 2; ++a)
#pragma unroll
            for (int b = 0; b < 2; ++b)
#pragma unroll
                for (int m = 0; m < 4; ++m)
#pragma unroll
                    for (int n = 0; n < 2; ++n) acc[a][b][m][n] = (f32x4){0.f, 0.f, 0.f, 0.f};
        cur = nxt; cA = nA; cB = nB; ++ui;
        if constexpr (ALIGN_EPI) { if (wr == 1) PG8_BAR; }
    }
    PG8_WAIT_V(0);
    if constexpr (!ALIGN_EPI) { if (wr == 0) PG8_BAR; }
    PG8_BAR;
    if constexpr (Epi::AFTER_DRAIN) { E.fused(acc, cur, wr, wc, fr, fq, lds, wid, lane); S.done(cur); }
#undef PG8_SA
#undef PG8_SB
#undef PG8_STAGE
#undef PG8_LDA
#undef PG8_LDB
#undef PG8_MMA
#undef PG8_WAIT_V
#undef PG8_WAIT_L
#undef PG8_BAR
#undef PG8_SCHED
}
}
#define GAS __attribute__((address_space(1)))
#define LAS __attribute__((address_space(3)))
typedef unsigned short bf16;
typedef unsigned v4u __attribute__((ext_vector_type(4)));
typedef float f32x4 __attribute__((ext_vector_type(4)));
typedef short bf16x8 __attribute__((ext_vector_type(8)));
typedef GAS unsigned gu32;
typedef GAS unsigned long long gu64;
#define RLX_AGENT __ATOMIC_RELAXED, __HIP_MEMORY_SCOPE_AGENT
#define LDS_WAIT() asm volatile("s_waitcnt lgkmcnt(0)" ::: "memory")
#define VM_WAIT() asm volatile("s_waitcnt vmcnt(0)" ::: "memory")
__device__ __forceinline__ unsigned long long rt() { return __builtin_amdgcn_s_memrealtime(); }
__device__ __forceinline__ unsigned f2bf(float f) { unsigned u = __builtin_bit_cast(unsigned, f); return (u + 0x7fffu + ((u >> 16) & 1u)) >> 16; }
__device__ __forceinline__ unsigned pk2(float lo, float hi) { return f2bf(lo) | (f2bf(hi) << 16); }

#define XB_TMO      128
#define XB_XCNT(j)  (256  + 64 * (j))
#define XB_XSUB(j)  (1280 + 64 * (j))
#define XB_XGEN(j)  (2304 + 64 * (j))
#define XB_TOP      3328
#define XB_TOPGEN   3392
#define XCD_BAR_WORDS 3456
#define XB_SPIN_CAP (1u << 18)

__device__ __forceinline__ unsigned xb_ld(unsigned* p)              { return __hip_atomic_load(p, __ATOMIC_RELAXED, __HIP_MEMORY_SCOPE_AGENT); }
__device__ __forceinline__ unsigned xb_add(unsigned* p, unsigned v) { return __hip_atomic_fetch_add(p, v, __ATOMIC_RELAXED, __HIP_MEMORY_SCOPE_AGENT); }
__device__ __forceinline__ unsigned xb_xcc_id() { return (unsigned)__builtin_amdgcn_s_getreg((3 << 11) | 20) & 0xFu; }
#define XB_SPIN(cond, bar) do { unsigned _sp = 0; while (cond) { __builtin_amdgcn_s_sleep(1); \
    if ((++_sp & 255u) == 0u) { if (xb_ld(&(bar)[XB_TMO])) break; if (_sp > XB_SPIN_CAP) { atomicAdd(&(bar)[XB_TMO], 1u); break; } } } } while (0)

struct XcdBarrier {
    int wv;
    unsigned* bar; unsigned x;
    volatile LAS unsigned* st;
};

__device__ __forceinline__ int xb_lane_id() { int l; asm volatile("v_mbcnt_lo_u32_b32 %0, -1, 0\n\tv_mbcnt_hi_u32_b32 %0, -1, %0" : "=v"(l)); return l; }
__device__ __forceinline__ XcdBarrier xcd_barrier_post(unsigned* bar, volatile LAS unsigned* st, int wv) {
    XcdBarrier b; b.wv = wv; b.bar = bar; b.x = xb_xcc_id(); b.st = st;
    if (wv == 0 && xb_lane_id() == 0) (void)xb_add(&bar[XB_XCNT(b.x)], 1u);
    return b;
}
__device__ __forceinline__ void xcd_barrier_complete(unsigned* bar, unsigned x, unsigned& nloc, unsigned& nx) {
    const unsigned G = gridDim.x * gridDim.y * gridDim.z;
    unsigned sum, cnt, mine, sp = 0u;
    for (;;) {
        sum = 0u; cnt = 0u; mine = 0u;
#pragma unroll
        for (unsigned j = 0; j < 16; ++j) { const unsigned c = xb_ld(&bar[XB_XCNT(j)]); sum += c; cnt += (c > 0u) ? 1u : 0u; mine = (j == x) ? c : mine; }
        if (sum == G) break;
        __builtin_amdgcn_s_sleep(1);
        if ((++sp & 255u) == 0u) { if (xb_ld(&bar[XB_TMO])) break; if (sp > XB_SPIN_CAP) { atomicAdd(&bar[XB_TMO], 1u); break; } }
    }
    nloc = mine > 0u ? mine : 1u; nx = cnt > 0u ? cnt : 1u;
}

__device__ __forceinline__ void xcd_barrier(const XcdBarrier& b) {
    asm volatile("s_waitcnt vmcnt(0)" ::: "memory");
    __syncthreads();
    if (b.wv == 0 && xb_lane_id() == 0) {
        unsigned* bar = b.bar;
        __builtin_amdgcn_s_waitcnt(0);
        unsigned nloc = b.st[0], nx = b.st[1];
        if (nloc == 0u) { xcd_barrier_complete(bar, b.x, nloc, nx); b.st[0] = nloc; b.st[1] = nx; }
        const unsigned old = xb_add(&bar[XB_XSUB(b.x)], 1u);
        const unsigned gen = old / nloc;
        if (old + 1u == (gen + 1u) * nloc) {
            __builtin_amdgcn_fence(__ATOMIC_RELEASE, "agent");
            asm volatile("s_waitcnt vmcnt(0)" ::: "memory");
            const unsigned og = xb_add(&bar[XB_TOP], 1u);
            const unsigned tg = og / nx;
            if (og + 1u == (tg + 1u) * nx) xb_add(&bar[XB_TOPGEN], 1u);
            else XB_SPIN(xb_ld(&bar[XB_TOPGEN]) == tg, bar);
            __builtin_amdgcn_fence(__ATOMIC_ACQUIRE, "agent");
            xb_add(&bar[XB_XGEN(b.x)], 1u);
            asm volatile("s_waitcnt vmcnt(0)" ::: "memory");
        } else {
            XB_SPIN(xb_ld(&bar[XB_XGEN(b.x)]) == gen, bar);
            __builtin_amdgcn_fence(__ATOMIC_ACQUIRE, "agent");
            asm volatile("s_waitcnt vmcnt(0)" ::: "memory");
        }
    }
    __syncthreads();
}
#define DI __device__ __forceinline__
constexpr int NWAVES = 8;
constexpr int NB = 16, SEQ = 2048, DM = 1024, MT = NB * SEQ;
constexpr int DIN_SRC = 6944, NPROJ = 7168;
constexpr int MEML = 256, MROWS = NB * MEML;
constexpr int NEXP = 32, TOPK = 4, DFF = 1024, MOEB = 256;
constexpr int NROWS = MT * TOPK;
constexpr int NBLK_MAX = (NROWS + NEXP * (MOEB - 1) + MOEB - 1) / MOEB;
constexpr int CAP = NBLK_MAX * MOEB;
constexpr float EPS = 1e-6f;
constexpr float NEGF = -1e30f;
constexpr int NB16 = 3584, NF8 = NPROJ - NB16;
constexpr int PC_MLQ = 0, PC_MLK = 512, PC_NQ = 1024, PC_NKC = 1536, PC_NKS = 1664, PC_NKW = 1792, PC_MQ = 1920, PC_MLI = 2432, PC_MLF = 2436, PC_NG = 2440,
              PC_MLV = 2560, PC_NVC = 3072, PC_NVS = 3200, PC_NVW = 3328, PC_MLO = 3584, PC_BRG = 4096;
__host__ __device__ constexpr int proj_srccol(int j) {
    return j < 1024 ? j : j < 1536 ? 2056 + (j - 1024) : j < 1664 ? 2568 + (j - 1536) : j < 1792 ? 2824 + (j - 1664) : j < 1920 ? 3080 + (j - 1792) : j < 2432 ? 3360 + (j - 1920)
         : j < 2440 ? 2048 + (j - 2432) : j < 2464 ? 3336 + (j - 2440) : j < 2560 ? -1
         : j < 3072 ? 1024 + (j - 2560) : j < 3200 ? 2696 + (j - 3072) : j < 3328 ? 2952 + (j - 3200) : j < 3456 ? 3208 + (j - 3328) : j < 3584 ? -1
         : j < 4096 ? 1536 + (j - 3584) : 3872 + (j - 4096);
}

constexpr size_t MiB = 1u << 20;
constexpr size_t WS_CTL = 0, CTL_ZERO_BYTES = 1 * MiB;
constexpr size_t WS_WIN = 1 * MiB, WS_WGU = 15 * MiB, WS_WDN = 143 * MiB, WS_WMKV = 207 * MiB, WS_WBR = 209 * MiB, WS_WOUT = 212 * MiB, WS_WC1 = 214 * MiB;
constexpr size_t WS_WIN8 = WS_WIN + 8 * MiB;
constexpr size_t WS_SMALL = 216 * MiB;
constexpr size_t WS_R1 = 218 * MiB;
constexpr size_t WS_PROJ = 282 * MiB;
constexpr size_t WS_R3 = 730 * MiB;
constexpr size_t WS_MEMKV = WS_R3, WS_MEMKN = WS_R3 + 8 * MiB, WS_QN = WS_R3 + 12 * MiB, WS_KSN = WS_R3 + 44 * MiB, WS_KWN = WS_R3 + 52 * MiB,
                 WS_MQN = WS_R3 + 60 * MiB, WS_MLQK = WS_R3 + 92 * MiB, WS_HID = WS_R3 + 156 * MiB, WS_KC = WS_R3 + 160 * MiB, WS_VC = WS_KC + MiB / 2,
                 WS_H0 = WS_R3 + 161 * MiB, WS_H1 = WS_H0 + 32 * MiB, WS_H2 = WS_H1 + 32 * MiB, WS_ROUTE = WS_H2 + 32 * MiB, WS_END = WS_ROUTE + 6 * MiB;
constexpr size_t WS_MLV = WS_R1, WS_VSN = WS_R1 + 32 * MiB, WS_VWN = WS_R1 + 40 * MiB;
constexpr size_t WS_U8 = WS_H2;
constexpr size_t WS_MEMN = WS_H0;
constexpr size_t WS_ACMP = WS_H1;
constexpr size_t WS_APERM = WS_PROJ;
constexpr size_t WS_ACT = WS_PROJ + 272 * MiB;
static_assert(WS_ACT + 272 * MiB <= WS_H0 + 96 * MiB && WS_END <= 1024 * MiB, "ws map");
constexpr size_t SM_ROPEC = 0, SM_ROPES = 256 * 1024, SM_CBIAS = 512 * 1024, SM_WRT = 1024 * 1024, SM_W2T = 1024 * 1024 + 256 * 1024;
constexpr size_t RT_TOKE = 0, RT_TOKPOS = 512 * 1024, RT_TOKW = 1024 * 1024, RT_TOKDEST = 1536 * 1024, RT_ROWW = 2048 * 1024, RT_ROWTOK = 3072 * 1024;
constexpr int CW_BAR = 4096;
constexpr int CW_ECNT = 16384;
constexpr int CW_QCTR = 16384 + 64;

constexpr int RING_BYTES = 131072, LDSCTL_OFF = RING_BYTES, MISC_OFF = LDSCTL_OFF + 320, LDS_BYTES = 155648;

struct Args { const float* in[34]; float* out; unsigned char* ws; int ph_lo, ph_hi, li, pad; };

DI float bf2f(unsigned short h) { return __uint_as_float((unsigned)h << 16); }
DI float wave_sum(float v) {
#pragma unroll
    for (int o = 1; o < 64; o <<= 1) v += __shfl_xor(v, o);
    return v;
}
DI float wave_max(float v) {
#pragma unroll
    for (int o = 1; o < 64; o <<= 1) v = fmaxf(v, __shfl_xor(v, o));
    return v;
}
DI float sigm(float x) { return __builtin_amdgcn_rcpf(1.f + __expf(-x)); }
DI float logsig(float x) { return fminf(x, 0.f) - log1pf(__expf(-fabsf(x))); }

namespace pg8 {
struct EpiBf16Silu {
    static constexpr bool PERM = true, AFTER_DRAIN = false, PERM2 = true;
    bf16_t* O; int ldc; const float* bias; int silu;
    DI void operator()(const f32x4 (&acc)[2][2][4][2], const Unit& u, int wr, int wc, int fr, int fq) const {
        const int row0 = u.pm * BM + wr * 64 + fr; const int col0 = u.pn * BM + wc * 64 + 16 * fq;
#pragma unroll
        for (int ai = 0; ai < 2; ++ai)
#pragma unroll
            for (int m = 0; m < 4; ++m) { bf16_t* rowp = O + (size_t)(row0 + ai * HALF + m * 16) * ldc + col0;
#pragma unroll
                for (int bj = 0; bj < 2; ++bj) { f32x4 v0 = acc[ai][bj][m][0], v1 = acc[ai][bj][m][1];
                    if (bias) { v0 += *(const f32x4*)(bias + col0 + 8 * bj); v1 += *(const f32x4*)(bias + col0 + 8 * bj + 4); }
                    if (silu) {
#pragma unroll
                        for (int j = 0; j < 4; ++j) { v0[j] = v0[j] * __builtin_amdgcn_rcpf(1.f + __expf(-v0[j])); v1[j] = v1[j] * __builtin_amdgcn_rcpf(1.f + __expf(-v1[j])); } }
                    u32x4 w; w.x = cvt_pk_bf16(v0[0], v0[1]); w.y = cvt_pk_bf16(v0[2], v0[3]); w.z = cvt_pk_bf16(v1[0], v1[1]); w.w = cvt_pk_bf16(v1[2], v1[3]);
                    *(u32x4*)(rowp + 8 * bj) = w; } }
    }
};
template <int B> struct EpiGate {
    static constexpr bool PERM = false, AFTER_DRAIN = false;
    const bf16_t* proj; float* tmp; bf16_t* merged;
    DI void operator()(const f32x4 (&acc)[2][2][4][2], const Unit& u, int wr, int wc, int fr, int fq) const {
        typedef unsigned u32x2v __attribute__((ext_vector_type(2)));
        const int col0 = u.pn * BM + wc * 32 + 4 * fq;
#pragma unroll
        for (int ai = 0; ai < 2; ++ai)
#pragma unroll
            for (int m = 0; m < 4; ++m) { const size_t r = (size_t)(u.pm * BM + ai * HALF + wr * 64 + m * 16 + fr);
#pragma unroll
                for (int bj = 0; bj < 2; ++bj)
#pragma unroll
                    for (int n = 0; n < 2; ++n) { const int c = col0 + bj * HALF + n * 16;
                        const u32x2v gw = *(const u32x2v*)(proj + r * NPROJ + PC_BRG + B * DM + c);
                        f32x4 g; g[0] = __uint_as_float(gw.x << 16); g[1] = __uint_as_float(gw.x & 0xffff0000u); g[2] = __uint_as_float(gw.y << 16); g[3] = __uint_as_float(gw.y & 0xffff0000u);
                        f32x4 v = acc[ai][bj][m][n];
#pragma unroll
                        for (int j = 0; j < 4; ++j) v[j] = v[j] * __builtin_amdgcn_rcpf(1.f + __expf(-g[j]));
                        float* tp = tmp + r * DM + c;
                        if (B == 0) { *(f32x4*)tp = v; }
                        else if (B == 1) { *(f32x4*)tp = *(const f32x4*)tp + v; }
                        else { v = *(const f32x4*)tp + v; u32x2v w; w.x = cvt_pk_bf16(v[0], v[1]); w.y = cvt_pk_bf16(v[2], v[3]); *(u32x2v*)(merged + r * DM + c) = w; } } }
    }
};
struct EpiMerge {
    static constexpr bool PERM = false, AFTER_DRAIN = false;
    const bf16_t* proj; float* tmp; bf16_t* merged;
    DI void operator()(const f32x4 (&acc)[2][2][4][2], const Unit& u, int wr, int wc, int fr, int fq) const {
        typedef unsigned u32x2v __attribute__((ext_vector_type(2)));
        const int b = u.pn >> 2, pn = u.pn & 3, pm = u.pm & 127;
        const int col0 = pn * BM + wc * 32 + 4 * fq;
#pragma unroll
        for (int ai = 0; ai < 2; ++ai)
#pragma unroll
            for (int m = 0; m < 4; ++m) { const size_t r = (size_t)(pm * BM + ai * HALF + wr * 64 + m * 16 + fr);
#pragma unroll
                for (int bj = 0; bj < 2; ++bj)
#pragma unroll
                    for (int n = 0; n < 2; ++n) { const int c = col0 + bj * HALF + n * 16;
                        const u32x2v gw = *(const u32x2v*)(proj + r * NPROJ + PC_BRG + b * DM + c);
                        f32x4 g; g[0] = __uint_as_float(gw.x << 16); g[1] = __uint_as_float(gw.x & 0xffff0000u); g[2] = __uint_as_float(gw.y << 16); g[3] = __uint_as_float(gw.y & 0xffff0000u);
                        f32x4 v = acc[ai][bj][m][n];
#pragma unroll
                        for (int j = 0; j < 4; ++j) v[j] = v[j] * __builtin_amdgcn_rcpf(1.f + __expf(-g[j]));
                        float* tp = tmp + r * DM + c;
                        if (b == 0) { *(f32x4*)tp = v; }
                        else if (b == 1) { *(f32x4*)tp = *(const f32x4*)tp + v; }
                        else { v = *(const f32x4*)tp + v; u32x2v w; w.x = cvt_pk_bf16(v[0], v[1]); w.y = cvt_pk_bf16(v[2], v[3]); *(u32x2v*)(merged + r * DM + c) = w; } } }
    }
};
struct EpiMergeK {
    static constexpr bool PERM = true, AFTER_DRAIN = false; static constexpr int MIDSEG = 8;
    const bf16_t* proj; bf16_t* merged;
    DI static void ldg8(const bf16_t* p, float (&g)[8]) { const u32x4 w = *(const u32x4*)p; const unsigned ws_[4] = {w.x, w.y, w.z, w.w};
#pragma unroll
        for (int j = 0; j < 4; ++j) { g[2 * j] = __uint_as_float(ws_[j] << 16); g[2 * j + 1] = __uint_as_float(ws_[j] & 0xffff0000u); } }
    DI void mid(f32x4 (&acc)[2][2][4][2], const Unit& u, int seg, int wr, int wc, int fr, int fq) const {
        const int col0 = u.pn * BM + wc * 32 + 8 * fq;
#pragma unroll
        for (int ai = 0; ai < 2; ++ai)
#pragma unroll
            for (int m = 0; m < 4; ++m) { const size_t r = (size_t)(u.pm * BM + ai * HALF + wr * 64 + m * 16 + fr);
#pragma unroll
                for (int bj = 0; bj < 2; ++bj) { const bf16_t* gp = proj + r * NPROJ + PC_BRG + (seg - 1) * DM + col0 + bj * HALF;
                    float ga[8], gb[8]; ldg8(gp, ga); ldg8(gp + DM, gb);
#pragma unroll
                    for (int n = 0; n < 2; ++n)
#pragma unroll
                        for (int j = 0; j < 4; ++j) acc[ai][bj][m][n][j] *= (1.f + __expf(-gb[4 * n + j])) * __builtin_amdgcn_rcpf(1.f + __expf(-ga[4 * n + j])); } }
    }
    DI void operator()(const f32x4 (&acc)[2][2][4][2], const Unit& u, int wr, int wc, int fr, int fq) const {
        const int col0 = u.pn * BM + wc * 32 + 8 * fq;
#pragma unroll
        for (int ai = 0; ai < 2; ++ai)
#pragma unroll
            for (int m = 0; m < 4; ++m) { const size_t r = (size_t)(u.pm * BM + ai * HALF + wr * 64 + m * 16 + fr);
#pragma unroll
                for (int bj = 0; bj < 2; ++bj) { float g[8]; ldg8(proj + r * NPROJ + PC_BRG + 2 * DM + col0 + bj * HALF, g); float v[8];
#pragma unroll
                    for (int n = 0; n < 2; ++n)
#pragma unroll
                        for (int j = 0; j < 4; ++j) v[4 * n + j] = acc[ai][bj][m][n][j] * __builtin_amdgcn_rcpf(1.f + __expf(-g[4 * n + j]));
                    u32x4 w; w.x = cvt_pk_bf16(v[0], v[1]); w.y = cvt_pk_bf16(v[2], v[3]); w.z = cvt_pk_bf16(v[4], v[5]); w.w = cvt_pk_bf16(v[6], v[7]);
                    *(u32x4*)(merged + r * DM + col0 + bj * HALF) = w; } }
    }
};
struct MergeOrder {
    StaticOrder so;
    DI bool next(int i, Unit& u) const { const int tl = i / 3, b = i - 3 * tl; Unit t; if (!so.next(tl, t)) return false; u.pm = b * 128 + t.pm; u.pn = b * 4 + t.pn; return true; }
    DI void a_ready(const Unit&) const {}
    DI void done(const Unit&) const {}
};
struct EpiRes {
    static constexpr bool PERM = false, AFTER_DRAIN = false;
    const float* base; float* out;
    DI void operator()(const f32x4 (&acc)[2][2][4][2], const Unit& u, int wr, int wc, int fr, int fq) const {
        const int col0 = u.pn * BM + wc * 32 + 4 * fq;
#pragma unroll
        for (int ai = 0; ai < 2; ++ai)
#pragma unroll
            for (int m = 0; m < 4; ++m) { const size_t r = (size_t)(u.pm * BM + ai * HALF + wr * 64 + m * 16 + fr);
#pragma unroll
                for (int bj = 0; bj < 2; ++bj)
#pragma unroll
                    for (int n = 0; n < 2; ++n) { const int c = col0 + bj * HALF + n * 16; *(f32x4*)(out + r * DM + c) = *(const f32x4*)(base + r * DM + c) + acc[ai][bj][m][n]; } }
    }
};
struct EpiSwiglu {
    static constexpr bool PERM = true, AFTER_DRAIN = false, PERM2 = true;
    unsigned char* act; const float* bgu;
    DI void operator()(const f32x4 (&acc)[2][2][4][2], const Unit& u, int wr, int wc, int fr, int fq) const {
        typedef unsigned u32x2v __attribute__((ext_vector_type(2)));
        const int e = u.pn >> 3, pnl = u.pn & 7;
        const unsigned lc0 = (unsigned)(pnl * BM + wc * 64 + 16 * fq);
        const unsigned row0 = (unsigned)(u.pm * BM + wr * 64 + fr);
        const float* bp = bgu + e * 2048 + lc0;
        f32x4 bv[2][2];
#pragma unroll
        for (int bj = 0; bj < 2; ++bj)
#pragma unroll
            for (int n = 0; n < 2; ++n) bv[bj][n] = *(const f32x4*)(bp + 8 * bj + 4 * n);
#pragma unroll
        for (int ai = 0; ai < 2; ++ai)
#pragma unroll
            for (int m = 0; m < 4; ++m) { const unsigned rowoff = (row0 + ai * HALF + m * 16) * (unsigned)DFF;
                int q8[2] = {0, 0};
#pragma unroll
                for (int bj = 0; bj < 2; ++bj) { float o[4];
#pragma unroll
                    for (int n = 0; n < 2; ++n) { const f32x4 v = acc[ai][bj][m][n] + bv[bj][n];
#pragma unroll
                        for (int q = 0; q < 2; ++q) { const float gt = fminf(v[2 * q], 7.0f); const float up = fminf(fmaxf(v[2 * q + 1], -7.0f), 7.0f);
                            o[2 * n + q] = (up + 1.0f) * (gt * __builtin_amdgcn_rcpf(1.f + __expf(-1.702f * gt))); } }
                    q8[bj] = __builtin_amdgcn_cvt_pk_fp8_f32(o[0], o[1], q8[bj], false); q8[bj] = __builtin_amdgcn_cvt_pk_fp8_f32(o[2], o[3], q8[bj], true); }
                *(u32x2v*)(act + (rowoff + (lc0 >> 1))) = (u32x2v){(unsigned)q8[0], (unsigned)q8[1]}; }
    }
};
struct EpiDown {
    static constexpr bool PERM = true, AFTER_DRAIN = false;
    bf16_t* y; const float* bdn; const float* roww;
    DI void operator()(const f32x4 (&acc)[2][2][4][2], const Unit& u, int wr, int wc, int fr, int fq) const {
        const int e = u.pn >> 2, pnl = u.pn & 3;
        const int col0 = pnl * BM + wc * 32 + 8 * fq;
        const float* bp = bdn + e * DM + col0;
        f32x4 bv[2][2];
#pragma unroll
        for (int bj = 0; bj < 2; ++bj) { bv[bj][0] = *(const f32x4*)(bp + bj * HALF); bv[bj][1] = *(const f32x4*)(bp + bj * HALF + 4); }
        const unsigned row0 = (unsigned)(u.pm * BM + wr * 64 + fr);
#pragma unroll
        for (int ai = 0; ai < 2; ++ai)
#pragma unroll
            for (int m = 0; m < 4; ++m) { const unsigned r = row0 + ai * HALF + m * 16; const float rw = roww[r]; const unsigned off = r * (unsigned)DM + (unsigned)col0;
#pragma unroll
                for (int bj = 0; bj < 2; ++bj) { const f32x4 v0 = (acc[ai][bj][m][0] + bv[bj][0]) * rw, v1 = (acc[ai][bj][m][1] + bv[bj][1]) * rw;
                    u32x4 w; w.x = cvt_pk_bf16(v0[0], v0[1]); w.y = cvt_pk_bf16(v0[2], v0[3]); w.z = cvt_pk_bf16(v1[0], v1[1]); w.w = cvt_pk_bf16(v1[2], v1[3]);
                    *(u32x4*)(y + (off + bj * HALF)) = w; } }
    }
};
template <int NPN> struct MoeOrder {
    int nblk, G, c; const PG8_LAS unsigned char* blk_e;
    DI bool next(int i, Unit& u) const {
        int rb, pn;
        if (G == 256) { const int x = c & 7, j = c >> 3; rb = i * (256 / NPN) + x * (32 / NPN) + j / NPN; pn = j % NPN; }
        else { const int L = i * G + c; rb = L / NPN; pn = L % NPN; }
        if (rb >= nblk) return false;
        u.pm = rb; u.pn = __builtin_amdgcn_readfirstlane((int)blk_e[rb]) * NPN + pn; return true; }
    DI void a_ready(const Unit&) const {}
    DI void done(const Unit&) const {}
};
}

struct Frame {
    LAS unsigned char* lds; volatile LAS unsigned* MISC; unsigned* ctl; unsigned char* ws;
    int wave, G, bx;
    DI int lane_id() const { int l; asm volatile("v_mbcnt_lo_u32_b32 %0, -1, 0\n\tv_mbcnt_hi_u32_b32 %0, -1, %0" : "=v"(l)); return l; }
    DI int tid_id() const { return wave * 64 + lane_id(); }
    const float* const* in; float* out;
};
enum { I_X = 0, I_MEM, I_GMIX, I_WIN, I_CONVW, I_CONVB, I_MLBI, I_MLBF, I_MLGOUT, I_NGQ, I_NGK, I_CPK, I_CW1K, I_CB1K, I_CW2K, I_CPV, I_CW1V, I_CB1V, I_CW2V,
       I_GMEM, I_WMKV, I_MGQ, I_MGK, I_WBRML, I_WBRNSA, I_WBRMEM, I_WOUT, I_GFFN, I_WR, I_BR, I_WGU, I_BGU, I_WDN, I_BDN, N_IN };

template <class CM>
DI void tr_item(const float* W, int ldw, int K, bf16* WT, int k0, int n0, CM cm, LAS float* scr, int lane) {
    const int sc = cm(n0 + (lane & 31));
#pragma unroll 8
    for (int i = 0; i < 32; ++i) { const int kk = 2 * i + (lane >> 5); scr[kk * 33 + (lane & 31)] = sc >= 0 ? W[(size_t)(k0 + kk) * ldw + sc] : 0.f; }
    LDS_WAIT(); asm volatile("" ::: "memory");
    const int c = lane & 7;
#pragma unroll
    for (int j = 0; j < 4; ++j) { const int n = (lane >> 3) + 8 * j; const LAS float* s = scr + (8 * c) * 33 + n;
        v4u o; o.x = pk2(s[0 * 33], s[1 * 33]); o.y = pk2(s[2 * 33], s[3 * 33]); o.z = pk2(s[4 * 33], s[5 * 33]); o.w = pk2(s[6 * 33], s[7 * 33]);
        *(v4u*)(WT + (size_t)(n0 + n) * K + k0 + 8 * c) = o; }
    LDS_WAIT(); asm volatile("" ::: "memory");
}
DI void tr_item_f8(const float* W, int ldw, int K, unsigned char* WT, int k0, int n0, LAS float* scr, int lane) {
#pragma unroll 8
    for (int i = 0; i < 32; ++i) { const int kk = 2 * i + (lane >> 5); scr[kk * 33 + (lane & 31)] = W[(size_t)(k0 + kk) * ldw + n0 + (lane & 31)] * 256.0f; }
    LDS_WAIT(); asm volatile("" ::: "memory");
    const int c = lane & 7;
#pragma unroll
    for (int j = 0; j < 4; ++j) { const int n = (lane >> 3) + 8 * j; const LAS float* sp = scr + (8 * c) * 33 + n;
        int lo = 0, hi = 0;
        lo = __builtin_amdgcn_cvt_pk_fp8_f32(sp[0 * 33], sp[1 * 33], lo, false); lo = __builtin_amdgcn_cvt_pk_fp8_f32(sp[2 * 33], sp[3 * 33], lo, true);
        hi = __builtin_amdgcn_cvt_pk_fp8_f32(sp[4 * 33], sp[5 * 33], hi, false); hi = __builtin_amdgcn_cvt_pk_fp8_f32(sp[6 * 33], sp[7 * 33], hi, true);
        typedef unsigned u32x2t __attribute__((ext_vector_type(2)));
        *(u32x2t*)(WT + (size_t)(n0 + n) * K + k0 + 8 * c) = (u32x2t){(unsigned)lo, (unsigned)hi}; }
    LDS_WAIT(); asm volatile("" ::: "memory");
}
DI void tr_load_v4(const float* W, int ldw, int k0, int n0, int lane, f32x4 (&v)[8]) {
#pragma unroll
    for (int i = 0; i < 8; ++i) v[i] = *(const f32x4*)(W + (size_t)(k0 + 8 * i + (lane >> 3)) * ldw + n0 + 4 * (lane & 7));
}
DI void tr_put_v4(const f32x4 (&v)[8], LAS float* scr, int lane, float mul) {
#pragma unroll
    for (int i = 0; i < 8; ++i) { LAS float* d = scr + (8 * i + (lane >> 3)) * 33 + 4 * (lane & 7); d[0] = v[i].x * mul; d[1] = v[i].y * mul; d[2] = v[i].z * mul; d[3] = v[i].w * mul; }
    LDS_WAIT(); asm volatile("" ::: "memory");
}
DI void tr_load_v4x16(const float* W, int ldw, int k0, int n0, int lane, f32x4 (&v)[16]) {
#pragma unroll
    for (int i = 0; i < 16; ++i) v[i] = *(const f32x4*)(W + (size_t)(k0 + 8 * i + (lane >> 3)) * ldw + n0 + 4 * (lane & 7));
}
DI void tr_put_v4x16(const f32x4 (&v)[16], LAS float* scr, int lane, float mul) {
#pragma unroll
    for (int i = 0; i < 16; ++i) { LAS float* d = scr + (8 * i + (lane >> 3)) * 33 + 4 * (lane & 7); d[0] = v[i].x * mul; d[1] = v[i].y * mul; d[2] = v[i].z * mul; d[3] = v[i].w * mul; }
    LDS_WAIT(); asm volatile("" ::: "memory");
}
DI void tr_emit_f8x16(unsigned char* WT, int K, int k0, int n0, LAS float* scr, int lane) {
    const int c = lane & 7;
#pragma unroll
    for (int j = 0; j < 4; ++j) { const int n = (lane >> 3) + 8 * j; const LAS float* sp = scr + (16 * c) * 33 + n; unsigned q[4];
#pragma unroll
        for (int h = 0; h < 4; ++h) { int w = 0; w = __builtin_amdgcn_cvt_pk_fp8_f32(sp[(4 * h) * 33], sp[(4 * h + 1) * 33], w, false); w = __builtin_amdgcn_cvt_pk_fp8_f32(sp[(4 * h + 2) * 33], sp[(4 * h + 3) * 33], w, true); q[h] = (unsigned)w; }
        *(v4u*)(WT + (size_t)(n0 + n) * K + k0 + 16 * c) = (v4u){q[0], q[1], q[2], q[3]}; }
    LDS_WAIT(); asm volatile("" ::: "memory");
}
DI void tr_fill_v4(const float* W, int ldw, int k0, int n0, LAS float* scr, int lane, float mul) { f32x4 v[8]; tr_load_v4(W, ldw, k0, n0, lane, v); tr_put_v4(v, scr, lane, mul); }
DI void tr_emit_bf16(bf16* WT, int K, int k0, int n0, LAS float* scr, int lane) {
    const int c = lane & 7;
#pragma unroll
    for (int j = 0; j < 4; ++j) { const int n = (lane >> 3) + 8 * j; const LAS float* sp = scr + (8 * c) * 33 + n;
        v4u o; o.x = pk2(sp[0 * 33], sp[1 * 33]); o.y = pk2(sp[2 * 33], sp[3 * 33]); o.z = pk2(sp[4 * 33], sp[5 * 33]); o.w = pk2(sp[6 * 33], sp[7 * 33]);
        *(v4u*)(WT + (size_t)(n0 + n) * K + k0 + 8 * c) = o; }
    LDS_WAIT(); asm volatile("" ::: "memory");
}
DI void tr_emit_f8(unsigned char* WT, int K, int k0, int n0, LAS float* scr, int lane) {
    const int c = lane & 7;
#pragma unroll
    for (int j = 0; j < 4; ++j) { const int n = (lane >> 3) + 8 * j; const LAS float* sp = scr + (8 * c) * 33 + n;
        int lo = 0, hi = 0;
        lo = __builtin_amdgcn_cvt_pk_fp8_f32(sp[0 * 33], sp[1 * 33], lo, false); lo = __builtin_amdgcn_cvt_pk_fp8_f32(sp[2 * 33], sp[3 * 33], lo, true);
        hi = __builtin_amdgcn_cvt_pk_fp8_f32(sp[4 * 33], sp[5 * 33], hi, false); hi = __builtin_amdgcn_cvt_pk_fp8_f32(sp[6 * 33], sp[7 * 33], hi, true);
        typedef unsigned u32x2t __attribute__((ext_vector_type(2)));
        *(u32x2t*)(WT + (size_t)(n0 + n) * K + k0 + 8 * c) = (u32x2t){(unsigned)lo, (unsigned)hi}; }
    LDS_WAIT(); asm volatile("" ::: "memory");
}
template <class CM>
DI void tr_fill_v4cm(const float* W, int ldw, int k0, int n0, CM cm, LAS float* scr, int lane, float mul) {
    const int sc = cm(n0 + 4 * (lane & 7)); f32x4 v[8];
#pragma unroll
    for (int i = 0; i < 8; ++i) v[i] = sc >= 0 ? *(const f32x4*)(W + (size_t)(k0 + 8 * i + (lane >> 3)) * ldw + sc) : (f32x4){0.f, 0.f, 0.f, 0.f};
    tr_put_v4(v, scr, lane, mul);
}
template <class CM>
DI void tr_fill_cm(const float* W, int ldw, int k0, int n0, CM cm, LAS float* scr, int lane, float mul) {
    const int sc = cm(n0 + (lane & 31));
#pragma unroll 8
    for (int i = 0; i < 32; ++i) { const int kk = 2 * i + (lane >> 5); scr[kk * 33 + (lane & 31)] = sc >= 0 ? W[(size_t)(k0 + kk) * ldw + sc] * mul : 0.f; }
    LDS_WAIT(); asm volatile("" ::: "memory");
}
struct CmId { DI int operator()(int j) const { return j; } };
struct CmProj { DI int operator()(int j) const { return proj_srccol(j); } };

DI void rms_row_bf16(const float* xrow, const float* g, bf16* orow, int lane) {
    const f32x4* xr = (const f32x4*)xrow + lane; const f32x4* gr = (const f32x4*)g + lane;
    f32x4 v[4]; float s = 0.f;
#pragma unroll
    for (int j = 0; j < 4; ++j) { v[j] = xr[64 * j]; s += (v[j].x * v[j].x + v[j].y * v[j].y) + (v[j].z * v[j].z + v[j].w * v[j].w); }
    const float rstd = rsqrtf(wave_sum(s) * (1.f / DM) + EPS);
    unsigned long long* o8 = (unsigned long long*)orow + lane;
#pragma unroll
    for (int j = 0; j < 4; ++j) { const f32x4 gg = gr[64 * j];
        o8[64 * j] = (unsigned long long)pk2(v[j].x * rstd * gg.x, v[j].y * rstd * gg.y) | ((unsigned long long)pk2(v[j].z * rstd * gg.z, v[j].w * rstd * gg.w) << 32); }
}

DI void rms_row_f8(const float* xrow, const float* g, unsigned char* orow, int lane) {
    const f32x4* xr = (const f32x4*)xrow + lane; const f32x4* gr = (const f32x4*)g + lane;
    f32x4 v[4]; float s = 0.f;
#pragma unroll
    for (int j = 0; j < 4; ++j) { v[j] = xr[64 * j]; s += (v[j].x * v[j].x + v[j].y * v[j].y) + (v[j].z * v[j].z + v[j].w * v[j].w); }
    const float rstd = rsqrtf(wave_sum(s) * (1.f / DM) + EPS);
    unsigned* o4 = (unsigned*)orow + lane;
#pragma unroll
    for (int j = 0; j < 4; ++j) { const f32x4 gg = gr[64 * j]; int q8 = 0;
        q8 = __builtin_amdgcn_cvt_pk_fp8_f32(v[j].x * rstd * gg.x, v[j].y * rstd * gg.y, q8, false); q8 = __builtin_amdgcn_cvt_pk_fp8_f32(v[j].z * rstd * gg.z, v[j].w * rstd * gg.w, q8, true);
        o4[64 * j] = (unsigned)q8; }
}
template <int NR>
DI void rms_rows_both(const float* x0, const float* g, bf16* o0, unsigned char* o80, size_t step, int lane) {
    const f32x4* gr = (const f32x4*)g + lane;
    f32x4 v[NR][4];
#pragma unroll
    for (int q = 0; q < NR; ++q) { const f32x4* xr = (const f32x4*)(x0 + q * step * DM) + lane;
#pragma unroll
        for (int j = 0; j < 4; ++j) v[q][j] = xr[64 * j]; }
#pragma unroll
    for (int q = 0; q < NR; ++q) { float s = 0.f;
#pragma unroll
        for (int j = 0; j < 4; ++j) s += (v[q][j].x * v[q][j].x + v[q][j].y * v[q][j].y) + (v[q][j].z * v[q][j].z + v[q][j].w * v[q][j].w);
        const float rstd = rsqrtf(wave_sum(s) * (1.f / DM) + EPS);
        unsigned long long* o8 = (unsigned long long*)(o0 + q * step * DM) + lane; unsigned* o4 = (unsigned*)(o80 + q * step * DM) + lane;
#pragma unroll
        for (int j = 0; j < 4; ++j) { const f32x4 gg = gr[64 * j]; const float y0 = v[q][j].x * rstd * gg.x, y1 = v[q][j].y * rstd * gg.y, y2 = v[q][j].z * rstd * gg.z, y3 = v[q][j].w * rstd * gg.w;
            o8[64 * j] = (unsigned long long)pk2(y0, y1) | ((unsigned long long)pk2(y2, y3) << 32);
            int q8 = 0; q8 = __builtin_amdgcn_cvt_pk_fp8_f32(y0, y1, q8, false); q8 = __builtin_amdgcn_cvt_pk_fp8_f32(y2, y3, q8, true);
            o4[64 * j] = (unsigned)q8; } }
}
template <int PARTS = 0xf>
DI void p0_prologue(Frame& F) {
    LAS float* scr = (LAS float*)(F.lds + F.wave * 16384);
    const int gw = F.bx * NWAVES + F.wave, NGW = F.G * NWAVES;
    unsigned char* ws = F.ws;
    constexpr int IT_IN = 16 * (NPROJ / 32), IT_GU = 32 * 16 * 64, IT_DN = 32 * 16 * 32, IT_MKV = 16 * 32, IT_BR = 3 * 8 * 32, IT_OUT = 16 * 32, IT_C1 = 2 * 32 * 8;
    constexpr int NITEMS = IT_IN + IT_GU + IT_DN + IT_MKV + IT_BR + IT_OUT + IT_C1;
    if (PARTS & 1)
    {
        constexpr int JT_GU = 32 * 8 * 64, JT_DN = 32 * 8 * 32;
        struct D { const float* src; unsigned char* dst; int ldw, k0, n0; };
        auto dec = [&](int j) { D d; if (j < JT_GU) { const int e = j / 512, q = j % 512; d.src = F.in[I_WGU] + (size_t)e * DM * 2048; d.dst = (unsigned char*)(ws + WS_WGU) + (size_t)e * 2048 * DM; d.ldw = 2048; d.k0 = 128 * (q / 64); d.n0 = 32 * (q % 64); }
                                     else { const int jj = j - JT_GU, e = jj / 256, q = jj % 256; d.src = F.in[I_WDN] + (size_t)e * DFF * DM; d.dst = (unsigned char*)(ws + WS_WDN) + (size_t)e * DM * DFF; d.ldw = DM; d.k0 = 128 * (q / 32); d.n0 = 32 * (q % 32); } return d; };
        const int lane = F.lane_id();
        LAS float* scr2 = (LAS float*)(F.wave < 7 ? F.lds + F.wave * 16896 : F.lds + 135424);
        int j = gw; f32x4 va[16]; D da{};
        if (j < JT_GU + JT_DN) { da = dec(j); tr_load_v4x16(da.src, da.ldw, da.k0, da.n0, lane, va); }
#pragma unroll 1
        while (j < JT_GU + JT_DN) {
            const int jn = j + NGW; f32x4 vb[16]; D db{};
            if (jn < JT_GU + JT_DN) { db = dec(jn); tr_load_v4x16(db.src, db.ldw, db.k0, db.n0, lane, vb); }
            else {
#pragma unroll
                for (int i = 0; i < 16; ++i) vb[i] = va[i]; }
            tr_put_v4x16(va, scr2, lane, 256.0f); tr_emit_f8x16(da.dst, 1024, da.k0, da.n0, scr2, lane);
#pragma unroll
            for (int i = 0; i < 16; ++i) va[i] = vb[i];
            da = db; j = jn;
        }
        __syncthreads();
    }
    if (PARTS & 2)
    for (int it = gw; it < NITEMS; it += NGW) {
        int r = it;
        if (r < IT_IN) { const int kb = r / (NPROJ / 32), nb = r % (NPROJ / 32); if (32 * nb < NB16) { tr_fill_v4cm(F.in[I_WIN], DIN_SRC, 64 * kb, 32 * nb, CmProj(), scr, F.lane_id(), 1.0f); tr_emit_bf16((bf16*)(ws + WS_WIN), DM, 64 * kb, 32 * nb, scr, F.lane_id()); }
            else { tr_fill_v4cm(F.in[I_WIN], DIN_SRC, 64 * kb, 32 * nb, CmProj(), scr, F.lane_id(), 256.0f); tr_emit_f8((unsigned char*)(ws + WS_WIN8), DM, 64 * kb, 32 * nb - NB16, scr, F.lane_id()); }
            continue; } r -= IT_IN;
        if (r < IT_GU + IT_DN) continue; r -= IT_GU + IT_DN;
        if (r < IT_MKV) { const int kb = r / 32, nb = r % 32; tr_fill_v4(F.in[I_WMKV], 1024, 64 * kb, 32 * nb, scr, F.lane_id(), 1.0f); tr_emit_bf16((bf16*)(ws + WS_WMKV), 1024, 64 * kb, 32 * nb, scr, F.lane_id()); continue; } r -= IT_MKV;
        if (r < IT_BR) { const int b = r / 256, q = r % 256, kb = q / 32, nb = q % 32; tr_fill_v4(F.in[I_WBRML + b], 1024, 64 * kb, 32 * nb, scr, F.lane_id(), 1.0f); tr_emit_bf16((bf16*)(ws + WS_WBR), 1536, 512 * b + 64 * kb, 32 * nb, scr, F.lane_id()); continue; } r -= IT_BR;
        if (r < IT_OUT) { const int kb = r / 32, nb = r % 32; tr_fill_v4(F.in[I_WOUT], 1024, 64 * kb, 32 * nb, scr, F.lane_id(), 1.0f); tr_emit_bf16((bf16*)(ws + WS_WOUT), 1024, 64 * kb, 32 * nb, scr, F.lane_id()); continue; } r -= IT_OUT;
        { const int kv = r / 256, q = r % 256, kb = q / 8, nb = q % 8; tr_fill_v4(F.in[kv ? I_CW1V : I_CW1K], 256, 64 * kb, 32 * nb, scr, F.lane_id(), 1.0f); tr_emit_bf16((bf16*)(ws + WS_WC1) + (size_t)kv * 256 * 2048, 2048, 64 * kb, 32 * nb, scr, F.lane_id()); }
    }
    if (PARTS & 4)
    { int m = gw;
      for (; m + 3 * NGW < MT; m += 4 * NGW) rms_rows_both<4>(F.in[I_X] + (size_t)m * DM, F.in[I_GMIX], (bf16*)(ws + WS_R1) + (size_t)m * DM, (unsigned char*)(ws + WS_U8) + (size_t)m * DM, (size_t)NGW, F.lane_id());
      for (; m < MT; m += NGW) rms_rows_both<1>(F.in[I_X] + (size_t)m * DM, F.in[I_GMIX], (bf16*)(ws + WS_R1) + (size_t)m * DM, (unsigned char*)(ws + WS_U8) + (size_t)m * DM, (size_t)NGW, F.lane_id()); }
    for (int m = gw; m < MROWS; m += NGW) rms_row_bf16(F.in[I_MEM] + (size_t)m * DM, F.in[I_GMEM], (bf16*)(ws + WS_MEMN) + (size_t)m * DM, F.lane_id());
    float* rc = (float*)(ws + WS_SMALL + SM_ROPEC); float* rs = (float*)(ws + WS_SMALL + SM_ROPES);
    for (int i = F.bx * 512 + F.tid_id(); i < SEQ * 32; i += F.G * 512) {
        const int p = i >> 5, k = i & 31;
        const float invf = exp2f(-(float)k * (13.287712379549449f / 32.0f));
        const float ang = (float)p * invf;
        const float kf = rintf(ang * 0.15915494309189535f);
        float r = fmaf(-kf, 6.28125f, ang); r = fmaf(-kf, 1.9353071795864769e-3f, r);
        rc[i] = cosf(r); rs[i] = sinf(r);
    }
    { bf16* wrt = (bf16*)(ws + WS_SMALL + SM_WRT);
      for (int i = F.bx * 512 + F.tid_id(); i < 32 * 1024; i += F.G * 512) { const int e = i >> 10, k = i & 1023; const float w = F.in[I_WR][k * 32 + e]; const unsigned hi = f2bf(w); wrt[i] = (bf16)hi; wrt[32 * 1024 + i] = (bf16)f2bf(w - __uint_as_float(hi << 16)); } }
    { bf16* w2t = (bf16*)(ws + WS_SMALL + SM_W2T);
      for (int i = F.bx * 512 + F.tid_id(); i < 2 * 64 * 256; i += F.G * 512) { const int kv = i >> 14, d = (i >> 8) & 63, f = i & 255; w2t[i] = (bf16)f2bf(F.in[kv ? I_CW2V : I_CW2K][f * 64 + d]); } }
    for (int o = gw; o < 512; o += NGW) {
        const int kv = o >> 8, f = o & 255, lane = F.lane_id();
        const float* pe = F.in[kv ? I_CPV : I_CPK]; const float* w1 = F.in[kv ? I_CW1V : I_CW1K];
        float wv[32], pv[32];
#pragma unroll
        for (int i = 0; i < 32; ++i) { const int k = lane + 64 * i; wv[i] = w1[(size_t)k * 256 + f]; pv[i] = pe[k]; }
        float a = 0.f;
#pragma unroll
        for (int i = 0; i < 32; ++i) a = fmaf(pv[i], wv[i], a);
        a = wave_sum(a);
        if (lane == 0) ((float*)(ws + WS_SMALL + SM_CBIAS))[o] = a + F.in[kv ? I_CB1V : I_CB1K][f];
    }
}

DI void unpack8(const v4u& w, float (&f)[8]) {
    f[0] = __uint_as_float(w.x << 16); f[1] = __uint_as_float(w.x & 0xffff0000u); f[2] = __uint_as_float(w.y << 16); f[3] = __uint_as_float(w.y & 0xffff0000u);
    f[4] = __uint_as_float(w.z << 16); f[5] = __uint_as_float(w.z & 0xffff0000u); f[6] = __uint_as_float(w.w << 16); f[7] = __uint_as_float(w.w & 0xffff0000u);
}
DI v4u pack8f(const float (&f)[8]) { v4u o; o.x = pk2(f[0], f[1]); o.y = pk2(f[2], f[3]); o.z = pk2(f[4], f[5]); o.w = pk2(f[6], f[7]); return o; }
DI void load8f(const float* p, float (&f)[8]) { const f32x4 a = *(const f32x4*)p, b = *(const f32x4*)(p + 4); f[0] = a.x; f[1] = a.y; f[2] = a.z; f[3] = a.w; f[4] = b.x; f[5] = b.y; f[6] = b.z; f[7] = b.w; }
DI void norm_rope64(float (&f)[8], const float (&g)[8], const float (&c8)[8], const float (&s8)[8], int lane, float scale) {
    float ss = 0.f;
#pragma unroll
    for (int i = 0; i < 8; ++i) ss = fmaf(f[i], f[i], ss);
    ss += __shfl_xor(ss, 1); ss += __shfl_xor(ss, 2); ss += __shfl_xor(ss, 4);
    const float rstd = rsqrtf(ss * (1.f / 64.f) + EPS);
    const bool hi = (lane & 4) != 0;
#pragma unroll
    for (int i = 0; i < 8; ++i) { const float y = f[i] * rstd * g[i]; const float pt = __shfl_xor(y, 4); f[i] = (hi ? fmaf(pt, s8[i], y * c8[i]) : fmaf(-pt, s8[i], y * c8[i])) * scale; }
}
DI void p2_prep(Frame& F) {
    unsigned char* ws = F.ws;
    const int ncg = F.G >= 64 ? 32 : 0;
    if (F.bx < ncg) return;
    const int gw = (F.bx - ncg) * NWAVES + F.wave, NGW = (F.G - ncg) * NWAVES, lane = F.lane_id();
    const bf16* proj = (const bf16*)(ws + WS_PROJ);
    const float* rc = (const float*)(ws + WS_SMALL + SM_ROPEC); const float* rs = (const float*)(ws + WS_SMALL + SM_ROPES);
    bf16* qn = (bf16*)(ws + WS_QN); bf16* ksn = (bf16*)(ws + WS_KSN); bf16* kwn = (bf16*)(ws + WS_KWN); bf16* mqn = (bf16*)(ws + WS_MQN); bf16* mlqk = (bf16*)(ws + WS_MLQK);
    constexpr int NT = 4;
    {
        float gq8[8], mg8[8]; load8f(F.in[I_NGQ] + 8 * (lane & 7), gq8); load8f(F.in[I_MGQ] + 8 * (lane & 15), mg8);
        for (int t0 = gw * NT; t0 < MT; t0 += NGW * NT) {
            v4u a[NT], bq[NT]; float c8[NT][8], s8[NT][8];
#pragma unroll
            for (int u = 0; u < NT; ++u) { const int t = t0 + u, tau = t & 2047; const bf16* pr = proj + (size_t)t * NPROJ;
                a[u] = *(const v4u*)(pr + PC_NQ + 8 * lane); bq[u] = *(const v4u*)(pr + PC_MQ + 8 * lane);
                load8f(rc + tau * 32 + 8 * (lane & 3), c8[u]); load8f(rs + tau * 32 + 8 * (lane & 3), s8[u]); }
#pragma unroll
            for (int u = 0; u < NT; ++u) { const int t = t0 + u;
                float f[8]; unpack8(a[u], f);
                norm_rope64(f, gq8, c8[u], s8[u], lane, 0.125f * 1.4426950408889634f);
                *(v4u*)(qn + (size_t)t * 512 + 8 * lane) = pack8f(f);
                unpack8(bq[u], f);
                float ss = 0.f;
#pragma unroll
                for (int i = 0; i < 8; ++i) ss = fmaf(f[i], f[i], ss);
                ss += __shfl_xor(ss, 1); ss += __shfl_xor(ss, 2); ss += __shfl_xor(ss, 4); ss += __shfl_xor(ss, 8);
                const float rstd = rsqrtf(ss * (1.f / 128.f) + EPS) * (0.08838834764831845f * 1.4426950408889634f);
#pragma unroll
                for (int i = 0; i < 8; ++i) f[i] *= rstd * mg8[i];
                *(v4u*)(mqn + (size_t)t * 512 + 8 * lane) = pack8f(f);
                }
        }
    }
    {
        const int L = lane & 31, hd4 = L >> 3, j = L & 7, half = lane >> 5;
        float gk8[8]; load8f(F.in[I_NGK] + (1 + (hd4 >> 1)) * 64 + 8 * j, gk8);
        const int kcol = (hd4 < 2 ? PC_NKS + hd4 * 64 : PC_NKW + (hd4 - 2) * 64) + 8 * j;
        bf16* kdst = (hd4 < 2 ? ksn : kwn) + (hd4 & 1) * 64 + 8 * j;
        const int wv = L >> 4, jj = L & 15;
        bf16* vdst = (bf16*)(ws + (wv ? WS_VWN : WS_VSN)) + 8 * jj; const int vcol = (wv ? PC_NVW : PC_NVS) + 8 * jj;
        for (int tp0 = gw * NT; tp0 < MT / 2; tp0 += NGW * NT) {
            v4u a[NT]; float c8[NT][8], s8[NT][8];
#pragma unroll
            for (int u = 0; u < NT; ++u) { const int t = 2 * (tp0 + u) + half, tau = t & 2047; const bf16* pr = proj + (size_t)t * NPROJ;
                a[u] = *(const v4u*)(pr + kcol);
                load8f(rc + tau * 32 + 8 * (lane & 3), c8[u]); load8f(rs + tau * 32 + 8 * (lane & 3), s8[u]); }
#pragma unroll
            for (int u = 0; u < NT; ++u) { const int t = 2 * (tp0 + u) + half;
                float f[8]; unpack8(a[u], f);
                norm_rope64(f, gk8, c8[u], s8[u], lane, 1.0f);
                *(v4u*)(kdst + (size_t)t * 128) = pack8f(f); }
        }
    }
    for (int run = gw; run < MT / 16; run += NGW) {
        const int t0 = run * 16, tau0 = t0 & 2047;
#pragma unroll 1
        for (int sp = 0; sp < 2; ++sp) {
            const int ch = 512 * sp + 8 * lane;
            float w0[8], w1[8], w2[8], w3[8], bb[8];
            load8f(F.in[I_CONVW] + ch, w0); load8f(F.in[I_CONVW] + 1024 + ch, w1); load8f(F.in[I_CONVW] + 2048 + ch, w2); load8f(F.in[I_CONVW] + 3072 + ch, w3); load8f(F.in[I_CONVB] + ch, bb);
            float x0[8], x1[8], x2[8];
            if (tau0 >= 3) { unpack8(*(const v4u*)(proj + (size_t)(t0 - 3) * NPROJ + ch), x0); unpack8(*(const v4u*)(proj + (size_t)(t0 - 2) * NPROJ + ch), x1); unpack8(*(const v4u*)(proj + (size_t)(t0 - 1) * NPROJ + ch), x2); }
            else {
#pragma unroll
                for (int i = 0; i < 8; ++i) { x0[i] = 0.f; x1[i] = 0.f; x2[i] = 0.f; } }
#pragma unroll 1
            for (int k0 = 0; k0 < 16; k0 += 4) {
                v4u raw[4];
#pragma unroll
                for (int k = 0; k < 4; ++k) raw[k] = *(const v4u*)(proj + (size_t)(t0 + k0 + k) * NPROJ + ch);
#pragma unroll
                for (int k = 0; k < 4; ++k) { float x3[8], y[8]; unpack8(raw[k], x3);
#pragma unroll
                    for (int i = 0; i < 8; ++i) { const float a = fmaf(w3[i], x3[i], fmaf(w2[i], x2[i], fmaf(w1[i], x1[i], fmaf(w0[i], x0[i], bb[i])))); y[i] = a * sigm(a); x0[i] = x1[i]; x1[i] = x2[i]; x2[i] = x3[i]; }
                    *(v4u*)(mlqk + (size_t)(t0 + k0 + k) * 1024 + ch) = pack8f(y); }
            }
        }
    }
    {
        const bf16* memkv = (const bf16*)(ws + WS_MEMKV); bf16* memkn = (bf16*)(ws + WS_MEMKN);
        float kg8[8]; load8f(F.in[I_MGK] + 8 * (lane & 15), kg8);
        for (int r = gw; r < MROWS; r += NGW) {
            float f[8]; unpack8(*(const v4u*)(memkv + (size_t)r * 1024 + 8 * lane), f);
            float ss = 0.f;
#pragma unroll
            for (int i = 0; i < 8; ++i) ss = fmaf(f[i], f[i], ss);
            ss += __shfl_xor(ss, 1); ss += __shfl_xor(ss, 2); ss += __shfl_xor(ss, 4); ss += __shfl_xor(ss, 8);
            const float rstd = rsqrtf(ss * (1.f / 128.f) + EPS);
#pragma unroll
            for (int i = 0; i < 8; ++i) f[i] *= rstd * kg8[i];
            *(v4u*)(memkn + (size_t)r * 512 + 8 * lane) = pack8f(f);
        }
    }
}

DI void p4_kcvc(Frame& F) {
    unsigned char* ws = F.ws;
    const int gw = F.bx * NWAVES + F.wave, NGW = F.G * NWAVES, lane = F.lane_id();
    const bf16* hid = (const bf16*)(ws + WS_HID);
    const float* rc = (const float*)(ws + WS_SMALL + SM_ROPEC); const float* rs = (const float*)(ws + WS_SMALL + SM_ROPES);
    const float gk = F.in[I_NGK][lane];
    for (int it = gw; it < 2 * 4096; it += NGW) {
        const int kv = it >> 12, r = it & 4095, n = r & 127;
        bf16* dst = (bf16*)(ws + (kv ? WS_VC : WS_KC)) + (size_t)r * 64 + lane;
        if (n == 127) { *dst = 0; continue; }
        const bf16* hr = hid + (size_t)kv * 4096 * 256 + (size_t)r * 256; const float* w2 = F.in[kv ? I_CW2V : I_CW2K];
        float a = 0.f;
        for (int f = 0; f < 256; ++f) a = fmaf(bf2f(hr[f]), w2[f * 64 + lane], a);
        if (kv == 0) {
            const float y = a * rsqrtf(wave_sum(a * a) * (1.f / 64.f) + EPS) * gk;
            const int pos = 16 * n + 31; const float c = rc[pos * 32 + (lane & 31)], s = rs[pos * 32 + (lane & 31)];
            const float pt = __shfl_xor(y, 32);
            a = lane < 32 ? y * c - pt * s : y * c + pt * s;
        }
        *dst = (bf16)f2bf(a);
    }
}

typedef float f32x16 __attribute__((ext_vector_type(16)));
typedef float f32x2v __attribute__((ext_vector_type(2)));
typedef __bf16 bf16x2v __attribute__((ext_vector_type(2)));
typedef short s16x4 __attribute__((ext_vector_type(4)));
typedef unsigned u32x2 __attribute__((ext_vector_type(2)));
#define MFMA32(a, b, c) __builtin_amdgcn_mfma_f32_32x32x16_bf16((a), (b), (c), 0, 0, 0)
#define WG_BAR() do { asm volatile("s_waitcnt vmcnt(0) lgkmcnt(0)" ::: "memory"); __builtin_amdgcn_s_barrier(); asm volatile("" ::: "memory"); } while (0)
DI unsigned pkbf(float lo, float hi) { f32x2v v = {lo, hi}; return __builtin_bit_cast(unsigned, __builtin_convertvector(v, bf16x2v)); }
template <int S> DI bf16x8 pack8(const f32x16& x) {
    v4u p; p.x = pkbf(x[8 * S], x[8 * S + 1]); p.y = pkbf(x[8 * S + 2], x[8 * S + 3]); p.z = pkbf(x[8 * S + 4], x[8 * S + 5]); p.w = pkbf(x[8 * S + 6], x[8 * S + 7]);
    return __builtin_bit_cast(bf16x8, p);
}
DI int crow(int i, int h) { return (i & 3) + 8 * (i >> 2) + 4 * h; }
constexpr int AT_K = 0, AT_V = 32768, AT_IMP = 65536, AT_WM = 98304, AT_INV = 98368, AT_SC = 99392;

DI void glds16(const void* gsrc, unsigned lds_dst) { unsigned keep; asm volatile("s_mov_b32 %0, m0\n\ts_mov_b32 m0, %2\n\ts_nop 0\n\tglobal_load_lds_dwordx4 %1, off\n\ts_mov_b32 m0, %0" : "=&s"(keep) : "v"(gsrc), "s"(lds_dst) : "memory"); }
DI void at_load(LAS unsigned char* lds, int par, const void* kb, size_t kpitch, const void* vb, size_t vpitch, int wave, int lane) {
    const int row = 8 * wave + (lane >> 3), pc = lane & 7;
    const int kc = pc ^ ((row >> 1) & 7), vc = pc ^ (((row >> 1) & 1) << 2);
    glds16((const char*)kb + (size_t)row * kpitch + 16 * kc, (unsigned)(size_t)(lds + AT_K + par * 8192 + wave * 1024));
    glds16((const char*)vb + (size_t)row * vpitch + 16 * vc, (unsigned)(size_t)(lds + AT_V + par * 8192 + wave * 1024));
}
#define SB() __builtin_amdgcn_sched_barrier(0)
typedef __attribute__((address_space(3))) s16x4 lds_s16x4;
DI void at_qk(const LAS unsigned char* kbuf, const int (&ka)[4], const bf16x8 (&qf)[4], f32x16 (&s)[2]) {
    bf16x8 kf[2][4];
#pragma unroll
    for (int kb = 0; kb < 2; ++kb)
#pragma unroll
        for (int st = 0; st < 4; ++st) kf[kb][st] = *(const LAS bf16x8*)(kbuf + ka[st] + kb * 4096);
    SB();
#pragma unroll
    for (int kb = 0; kb < 2; ++kb) {
        f32x16 a;
#pragma unroll
        for (int i = 0; i < 16; ++i) a[i] = 0.f;
#pragma unroll
        for (int st = 0; st < 4; ++st) a = MFMA32(kf[kb][st], qf[st], a);
        s[kb] = a;
    }
}
DI void at_vload(const LAS unsigned char* vbuf, const int (&va)[2], int kb, bf16x8 (&vf)[2][2]) {
#pragma unroll
    for (int s2 = 0; s2 < 2; ++s2)
#pragma unroll
        for (int db = 0; db < 2; ++db) {
            const s16x4 lo = __builtin_amdgcn_ds_read_tr16_b64_v4i16((lds_s16x4*)(vbuf + va[db] + kb * 4096 + s2 * 2048));
            const s16x4 hi = __builtin_amdgcn_ds_read_tr16_b64_v4i16((lds_s16x4*)(vbuf + va[db] + kb * 4096 + s2 * 2048 + 1024));
            vf[s2][db] = __builtin_shufflevector(lo, hi, 0, 1, 2, 3, 4, 5, 6, 7); }
}
DI void at_pv1(const bf16x8 (&vf)[2][2], const f32x16& p, f32x16 (&o)[2]) {
    const bf16x8 pf0 = pack8<0>(p), pf1 = pack8<1>(p);
#pragma unroll
    for (int s2 = 0; s2 < 2; ++s2)
#pragma unroll
        for (int db = 0; db < 2; ++db) o[db] = MFMA32(vf[s2][db], s2 ? pf1 : pf0, o[db]);
}
DI void at_pv(const LAS unsigned char* vbuf, const int (&va)[2], const bf16x8 (&vf0)[2][2], const f32x16 (&p)[2], f32x16 (&o)[2]) {
    bf16x8 vf1[2][2]; at_vload(vbuf, va, 1, vf1);
    at_pv1(vf0, p[0], o);
    at_pv1(vf1, p[1], o);
}
DI void at_exp_all(f32x16 (&s)[2], float& l) {
#pragma unroll
    for (int kb = 0; kb < 2; ++kb)
#pragma unroll
        for (int i = 0; i < 16; ++i) { const float p = __builtin_amdgcn_exp2f(s[kb][i]); s[kb][i] = p; l += p; }
}
DI void at_wait(int n) {
    if (n >= 2) asm volatile("s_waitcnt vmcnt(4)" ::: "memory"); else if (n == 1) asm volatile("s_waitcnt vmcnt(2)" ::: "memory"); else asm volatile("s_waitcnt vmcnt(0)" ::: "memory");
    asm volatile("s_waitcnt lgkmcnt(0)" ::: "memory"); __builtin_amdgcn_s_barrier(); asm volatile("" ::: "memory");
}
template <bool STORE = true, bool DO_CMP = true, bool DO_SEL = true, bool DO_WIN = true>
DI void nsa_unit(Frame& F, int unit) {
    unsigned char* ws = F.ws; LAS unsigned char* lds = F.lds;
    int lane_ = F.lane_id();
    const int lane = lane_, wave = F.wave, r = lane & 31, h = lane >> 5, g = wave >> 1, qh = wave & 1;
    const int bh = unit & 31, qt = 31 - (unit >> 5), b = bh >> 1, hkv = bh & 1;
    const int qloc = 32 * qh + r, tau = 64 * qt + qloc, qq = tau & 63; const size_t t = (size_t)b * SEQ + tau;
    const bf16* proj = (const bf16*)(ws + WS_PROJ);
    const bf16* qn = (const bf16*)(ws + WS_QN); const bf16* ksn = (const bf16*)(ws + WS_KSN); const bf16* kwn = (const bf16*)(ws + WS_KWN);
    const bf16* kc = (const bf16*)(ws + WS_KC); const bf16* vc = (const bf16*)(ws + WS_VC); bf16* H1 = (bf16*)(ws + WS_H0);
    int ka[4], va[2];
    { const int f = (r >> 1) & 7, fs = f >> 1, hb = h ^ (f & 1);
#pragma unroll
      for (int st = 0; st < 4; ++st) ka[st] = r * 128 + 16 * (((st ^ fs) << 1) | hb);
      const int i16 = lane & 15, q = i16 >> 2, p = i16 & 3, g1 = (lane >> 4) & 1;
#pragma unroll
      for (int db = 0; db < 2; ++db) va[db] = (4 * h + q) * 128 + 16 * ((4 * db + 2 * g1 + (p >> 1)) ^ (((q >> 1) & 1) << 2)) + 8 * (p & 1); }
    bf16x8 qf[4];
#pragma unroll
    for (int st = 0; st < 4; ++st) qf[st] = *(const bf16x8*)(qn + t * 512 + (hkv * 4 + g) * 64 + 16 * st + 8 * h);
    float gate[3];
#pragma unroll
    for (int c = 0; c < 3; ++c) gate[c] = sigm(bf2f(proj[t * NPROJ + PC_NG + (hkv * 4 + g) * 3 + c]));
    f32x16 ofin[2];
#pragma unroll
    for (int i = 0; i < 16; ++i) { ofin[0][i] = 0.f; ofin[1][i] = 0.f; }
    WG_BAR();
    if (DO_CMP) {
        const int ncq = tau >= 31 ? ((tau - 31) >> 4) + 1 : 0;
        const int ntc = (((64 * qt + 63 - 31) >> 4) + 1 > 64) ? 2 : 1;
        const char* kb0 = (const char*)(kc + (size_t)(b * 2 + hkv) * 128 * 64); const char* vb0 = (const char*)(vc + (size_t)(b * 2 + hkv) * 128 * 64);
        at_load(lds, 0, kb0, 128, vb0, 128, wave, lane);
        if (ntc == 2) at_load(lds, 1, kb0 + 64 * 128, 128, vb0 + 64 * 128, 128, wave, lane);
        WG_BAR();
        f32x16 o[2]; float l = 0.f, prevEp = 0.f;
#pragma unroll
        for (int i = 0; i < 16; ++i) { o[0][i] = 0.f; o[1][i] = 0.f; }
        LAS float* I = (LAS float*)(lds + AT_IMP) + (g * 64 + qloc) * 32;
#pragma unroll 1
        for (int tile = 0; tile < 2; ++tile) {
            if (tile < ntc) {
                f32x16 s[2];
                at_qk(lds + AT_K + tile * 8192, ka, qf, s);
                bf16x8 vf[2][2]; at_vload(lds + AT_V + tile * 8192, va, 0, vf); SB();
#pragma unroll
                for (int kb = 0; kb < 2; ++kb)
#pragma unroll
                    for (int i = 0; i < 16; ++i) { const int n = 64 * tile + 32 * kb + crow(i, h); const float p = n < ncq ? __builtin_amdgcn_exp2f(s[kb][i]) : 0.f; s[kb][i] = p; l += p; }
#pragma unroll
                for (int kb = 0; kb < 2; ++kb)
#pragma unroll
                    for (int a = 0; a < 4; ++a) { const int idx = tile * 8 + kb * 4 + a; const float Gv = (s[kb][4 * a] + s[kb][4 * a + 1]) + (s[kb][4 * a + 2] + s[kb][4 * a + 3]);
                        const float Epv = __shfl_xor(s[kb][4 * a + 3], 32);
                        I[2 * idx + h] = Gv + (h ? Epv : prevEp); prevEp = Epv; }
                at_pv(lds + AT_V + tile * 8192, va, vf, s, o);
            } else {
#pragma unroll
                for (int idx = 8; idx < 16; ++idx) I[2 * idx + h] = 0.f;
            }
        }
        const float L = l + __shfl_xor(l, 32); const float inv = L > 0.f ? 1.f / L : 0.f;
        const float gi = gate[0] * inv;
#pragma unroll
        for (int i = 0; i < 16; ++i) { ofin[0][i] += gi * o[0][i]; ofin[1][i] += gi * o[1][i]; }
        if (h == 0) ((LAS float*)(lds + AT_INV))[g * 64 + qloc] = inv;
    }
    WG_BAR();
    unsigned sel = 0u, wm = 0u, um = 0u;
    if (!DO_CMP) { sel = (qt == 31) ? 0xffffffffu : ((1u << (qt + 1)) - 1u); wm = sel; um = sel; }
    else {
        const LAS float* I = (const LAS float*)(lds + AT_IMP) + qloc * 32;
        const LAS float* IV = (const LAS float*)(lds + AT_INV) + qloc;
        const float iv0 = IV[0], iv1 = IV[64], iv2 = IV[128], iv3 = IV[192];
        LAS unsigned* SC = (LAS unsigned*)(lds + AT_SC) + (qh * 32 + r) * 33;
        if (h == 0) {
#pragma unroll
            for (int j = 8 * g; j < 8 * g + 8; ++j) { const float imp = (I[j] * iv0 + I[64 * 32 + j] * iv1) + (I[2 * 64 * 32 + j] * iv2 + I[3 * 64 * 32 + j] * iv3);
                const bool cand = (j >= 1) && (j <= qt - 2);
                SC[j] = cand ? ((__float_as_uint(imp) & ~31u) | (unsigned)(31 - j)) + 32u : 0u; }
        }
        WG_BAR();
        if (qt <= 7) sel = (1u << (qt + 1)) - 1u;
        else {
            sel = 1u | (1u << qt) | (1u << (qt - 1));
            unsigned prev = 0xffffffffu;
#pragma unroll 1
            for (int rd = 0; rd < 5; ++rd) { unsigned best = 0u;
#pragma unroll 8
                for (int j = 0; j < 32; ++j) { const unsigned kx = SC[j]; const unsigned cnd = kx < prev ? kx : 0u; best = cnd > best ? cnd : best; }
                prev = best; if (best) sel |= 1u << (31 - (int)(best & 31u)); }
        }
        sel &= (qt == 31) ? 0xffffffffu : ((1u << (qt + 1)) - 1u);
        wm = sel;
#pragma unroll
        for (int o = 1; o < 32; o <<= 1) wm |= (unsigned)__shfl_xor((int)wm, o);
        wm = (unsigned)__builtin_amdgcn_readfirstlane((int)wm);
        if (lane == 0) ((LAS unsigned*)(lds + AT_WM))[wave] = wm;
        WG_BAR();
        um = 0u;
#pragma unroll
        for (int w = 0; w < 8; ++w) um |= ((const LAS unsigned*)(lds + AT_WM))[w];
        um = (unsigned)__builtin_amdgcn_readfirstlane((int)um);
    }
    if (DO_SEL) {
        f32x16 o[2]; float l = 0.f;
#pragma unroll
        for (int i = 0; i < 16; ++i) { o[0][i] = 0.f; o[1][i] = 0.f; }
        const char* kbase = (const char*)(ksn + (size_t)b * SEQ * 128 + hkv * 64); const char* vbase = (const char*)(proj + (size_t)b * SEQ * NPROJ + PC_NVS + hkv * 64);
        unsigned rem = um, im = um; int k = 0; const int T = __popc(um);
#pragma unroll 1
        for (int i = 0; i < 3 && im; ++i) { const int jn = __ffs((int)im) - 1; im &= im - 1u; at_load(lds, i, kbase + (size_t)jn * 64 * 256, 256, vbase + (size_t)jn * 64 * (NPROJ * 2), NPROJ * 2, wave, lane); }
#pragma unroll 1
        while (rem) {
            const int j = __ffs((int)rem) - 1; rem &= rem - 1u;
            at_wait(T - k - 1);
#ifdef NSA_E1
            at_wait(T - k - 1);
#endif
            if (im) { const int jn = __ffs((int)im) - 1; im &= im - 1u; at_load(lds, (k + 3) & 3, kbase + (size_t)jn * 64 * 256, 256, vbase + (size_t)jn * 64 * (NPROJ * 2), NPROJ * 2, wave, lane); }
            const int par = k & 3;
            if ((wm >> j) & 1u) {
                f32x16 s[2];
                at_qk(lds + AT_K + par * 8192, ka, qf, s);
                bf16x8 vf[2][2]; at_vload(lds + AT_V + par * 8192, va, 0, vf); SB();
                const bool on = (sel >> j) & 1u;
                if (j != qt && __all(on)) at_exp_all(s, l);
                else { const int klim = j == qt ? qq : 63;
#pragma unroll
                    for (int kb = 0; kb < 2; ++kb)
#pragma unroll
                        for (int i = 0; i < 16; ++i) { const int key = 32 * kb + crow(i, h); const float p = (on && key <= klim) ? __builtin_amdgcn_exp2f(s[kb][i]) : 0.f; s[kb][i] = p; l += p; } }
                at_pv(lds + AT_V + par * 8192, va, vf, s, o);
            }
            ++k;
        }
        const float L = l + __shfl_xor(l, 32); const float gi = gate[1] * (L > 0.f ? 1.f / L : 0.f);
#pragma unroll
        for (int i = 0; i < 16; ++i) { ofin[0][i] += gi * o[0][i]; ofin[1][i] += gi * o[1][i]; }
    }
    WG_BAR();
    if (DO_WIN) {
        f32x16 o[2]; float l = 0.f;
#pragma unroll
        for (int i = 0; i < 16; ++i) { o[0][i] = 0.f; o[1][i] = 0.f; }
        const char* kbase = (const char*)(kwn + (size_t)b * SEQ * 128 + hkv * 64); const char* vbase = (const char*)(proj + (size_t)b * SEQ * NPROJ + PC_NVW + hkv * 64);
        const int jlo = qt > 8 ? qt - 8 : 0; const int T = qt - jlo + 1;
#ifdef NSA_E2
        f32x16 o2[2]; float l2 = 0.f;
#pragma unroll
        for (int i = 0; i < 16; ++i) { o2[0][i] = 0.f; o2[1][i] = 0.f; }
#endif
#pragma unroll 1
        for (int i = 0; i < 3 && i < T; ++i) at_load(lds, i, kbase + (size_t)(jlo + i) * 64 * 256, 256, vbase + (size_t)(jlo + i) * 64 * (NPROJ * 2), NPROJ * 2, wave, lane);
#pragma unroll 1
        for (int k = 0; k < T; ++k) {
            const int j = jlo + k, par = k & 3;
            at_wait(T - k - 1);
#ifdef NSA_E1
            at_wait(T - k - 1);
#endif
            if (k + 3 < T) at_load(lds, (k + 3) & 3, kbase + (size_t)(j + 3) * 64 * 256, 256, vbase + (size_t)(j + 3) * 64 * (NPROJ * 2), NPROJ * 2, wave, lane);
            f32x16 s[2];
            at_qk(lds + AT_K + par * 8192, ka, qf, s);
            bf16x8 vf[2][2]; at_vload(lds + AT_V + par * 8192, va, 0, vf); SB();
#ifdef NSA_E2
            { f32x16 s2[2]; asm volatile("" ::: "memory"); at_qk(lds + AT_K + par * 8192, ka, qf, s2); bf16x8 vf2[2][2]; at_vload(lds + AT_V + par * 8192, va, 0, vf2); SB(); at_exp_all(s2, l2); at_pv(lds + AT_V + par * 8192, va, vf2, s2, o2); }
#endif
            if (j != qt && j != qt - 8) at_exp_all(s, l);
            else { const int klo = (j == qt - 8) ? qq + 1 : 0, khi = (j == qt) ? qq : 63;
#pragma unroll
                for (int kb = 0; kb < 2; ++kb)
#pragma unroll
                    for (int i = 0; i < 16; ++i) { const int key = 32 * kb + crow(i, h); const float p = (key >= klo && key <= khi) ? __builtin_amdgcn_exp2f(s[kb][i]) : 0.f; s[kb][i] = p; l += p; } }
            at_pv(lds + AT_V + par * 8192, va, vf, s, o);
        }
#ifdef NSA_E2
        { const float z = l2 * 0.f;
#pragma unroll
          for (int i = 0; i < 16; ++i) { ofin[0][i] += z * o2[0][i]; ofin[1][i] += z * o2[1][i]; } }
#endif
        const float L = l + __shfl_xor(l, 32); const float gi = gate[2] * (L > 0.f ? 1.f / L : 0.f);
#pragma unroll
        for (int i = 0; i < 16; ++i) { ofin[0][i] += gi * o[0][i]; ofin[1][i] += gi * o[1][i]; }
    }
    if (!STORE) { asm volatile("" :: "v"(ofin[0]), "v"(ofin[1])); return; }
    WG_BAR();
#pragma unroll
    for (int db = 0; db < 2; ++db)
#pragma unroll
        for (int a = 0; a < 4; ++a) { u32x2 w; w.x = pkbf(ofin[db][4 * a], ofin[db][4 * a + 1]); w.y = pkbf(ofin[db][4 * a + 2], ofin[db][4 * a + 3]); *(LAS u32x2*)(lds + qloc * 528 + g * 128 + (32 * db + 8 * a + 4 * h) * 2) = w; }
    WG_BAR();
    { const int tid = wave * 64 + lane; bf16* obase = H1 + ((size_t)b * SEQ + 64 * qt) * 1536 + 512 + hkv * 256;
#pragma unroll
      for (int i = 0; i < 4; ++i) { const int piece = tid + 512 * i, row = piece >> 5, c = piece & 31; *(v4u*)(obase + (size_t)row * 1536 + 8 * c) = *(const LAS v4u*)(lds + row * 528 + 16 * c); } }
}
constexpr int ML_K = 0, ML_V = 32768, ML_VW = 65536, ML_C = 81920, ML_N = 114688, ML_SS = 115200, ML_WS = 116224, ML_GO = 120320, ML_ST = 135424;
DI int ml_fk(int s) { return ((s & 3) << 2) | ((s >> 2) & 3); }
DI void ml_load(LAS unsigned char* lds, int par, const char* kb, const char* vb, int wave, int lane) {
#pragma unroll
    for (int n2 = 0; n2 < 2; ++n2) { const int n = 2 * wave + n2, row = 4 * n + (lane >> 4), pc = lane & 15;
        const int kc = pc ^ ml_fk(row), vc = pc ^ ((row & 3) << 2);
        glds16(kb + (size_t)row * 2048 + 16 * kc, (unsigned)(size_t)(lds + ML_K + par * 16384 + n * 1024));
        glds16(vb + (size_t)row * (NPROJ * 2) + 16 * vc, (unsigned)(size_t)(lds + ML_V + par * 16384 + n * 1024)); }
}
DI bf16x8 ml_tr8(const LAS unsigned char* p) {
    const s16x4 lo = __builtin_amdgcn_ds_read_tr16_b64_v4i16((lds_s16x4*)p); const s16x4 hi = __builtin_amdgcn_ds_read_tr16_b64_v4i16((lds_s16x4*)(p + 1024));
    return __builtin_shufflevector(lo, hi, 0, 1, 2, 3, 4, 5, 6, 7);
}
template <int PM = 0xff>
DI void mlstm_unit2(Frame& F, int unit) {
    unsigned char* ws = F.ws; LAS unsigned char* lds = F.lds;
    int lane_ = F.lane_id();
    const int lane = lane_, wave = F.wave, tid = wave * 64 + lane, r = lane & 31, hh = lane >> 5, tb = wave >> 2, vb = wave & 3;
    const int b = unit >> 2, hd = unit & 3;
    const bf16* proj = (const bf16*)(ws + WS_PROJ); const bf16* mlqk = (const bf16*)(ws + WS_MLQK); bf16* H0 = (bf16*)(ws + WS_H0);
    const size_t tok0 = (size_t)b * SEQ;
    const char* kbase = (const char*)(mlqk + tok0 * 1024 + 512 + hd * 128); const char* vbase = (const char*)(proj + tok0 * NPROJ + PC_MLV + hd * 128);
    const float LOG2E = 1.4426950408889634f;
    const int i16 = lane & 15, q4 = i16 >> 2, p4 = i16 & 3, g1 = (lane >> 4) & 1;
    const int colsw = 16 * ((4 * vb + 2 * g1 + (p4 >> 1)) ^ (q4 << 2)) + 8 * (p4 & 1);
    const int base_c = (8 * hh + q4) * 256 + colsw;
    const int base_v = (4 * hh + q4) * 256 + colsw;
    const int fK = ml_fk(r), rowK = r * 256 + ((hh ^ (fK & 1)) << 4), F16 = (fK & 14) << 4;
    int base_kt[2][2];
#pragma unroll
    for (int blk = 0; blk < 2; ++blk)
#pragma unroll
        for (int hi = 0; hi < 2; ++hi) { const int kbp = 2 * tb + blk; base_kt[blk][hi] = (8 * hh + 4 * hi + q4) * 256 + 16 * ((4 * kbp + 2 * g1 + (p4 >> 1)) ^ ((q4 << 2) | ((2 * hh + hi) & 3))) + 8 * (p4 & 1); }
    LAS float* WS = (LAS float*)(lds + ML_WS) + wave * 128;
    LAS float* NV = (LAS float*)(lds + ML_N); LAS float* SS = (LAS float*)(lds + ML_SS);
    __syncthreads();
    for (int i = tid; i < 32768 / 16; i += 512) ((LAS v4u*)(lds + ML_C))[i] = (v4u){0u, 0u, 0u, 0u};
    if (tid < 128) NV[tid] = 0.f;
    f32x16 Cst[2];
#pragma unroll
    for (int i = 0; i < 16; ++i) { Cst[0][i] = 0.f; Cst[1][i] = 0.f; }
    if (tid < 128) ((LAS float*)(lds + ML_GO))[tid] = F.in[I_MLGOUT][hd * 128 + tid];
    const float bi = F.in[I_MLBI][hd], bfv = F.in[I_MLBF][hd];
    float m_prev = 0.f;
    ml_load(lds, 0, kbase, vbase, wave, lane);
    bf16x8 qf[8];
    { const bf16* qp = mlqk + (tok0 + 32 * tb + r) * 1024 + hd * 128 + 8 * hh;
#pragma unroll
      for (int st = 0; st < 8; ++st) qf[st] = *(const bf16x8*)(qp + 16 * st); }
    float gi_raw = bf2f(proj[(tok0 + lane) * NPROJ + PC_MLI + hd]), gf_raw = bf2f(proj[(tok0 + lane) * NPROJ + PC_MLF + hd]);
#pragma unroll 1
    for (int c = 0; c < 32; ++c) {
        const int par = c & 1; const size_t tokc = tok0 + 64 * c;
        WG_BAR();
        if ((PM & 1) && c > 0) {
            bf16* obase = H0 + (tokc - 64) * 1536 + hd * 128;
#pragma unroll
            for (int i = 0; i < 2; ++i) { const int piece = tid + 512 * i, row = piece >> 4, cc = piece & 15; *(v4u*)(obase + (size_t)row * 1536 + 8 * cc) = *(const LAS v4u*)(lds + ML_ST + row * 272 + 16 * cc); } }
        if (c < 31) ml_load(lds, par ^ 1, kbase + (size_t)(64 * (c + 1)) * 2048, vbase + (size_t)(64 * (c + 1)) * (NPROJ * 2), wave, lane);
        u32x2 og[4];
        { const bf16* op = proj + (tokc + 32 * tb + r) * NPROJ + PC_MLO + hd * 128 + 32 * vb + 4 * hh;
#pragma unroll
          for (int a = 0; a < 4; ++a) og[a] = *(const u32x2*)(op + 8 * a); }
        const float ig = gi_raw + bi, lf = logsig(gf_raw + bfv);
        float bc = lf;
        if (PM & 2) {
#pragma unroll
        for (int o = 1; o < 64; o <<= 1) { const float v = __shfl_up(bc, o); if (lane >= o) bc += v; } }
        const float rr = ig - bc;
        float cm = rr;
        if (PM & 2) {
#pragma unroll
        for (int o = 1; o < 64; o <<= 1) { const float v = __shfl_up(cm, o); if (lane >= o) cm = fmaxf(cm, v); } }
        const float M63 = fmaxf(m_prev, __shfl(cm, 63)), blast = __shfl(bc, 63);
        const float a_old = __expf(m_prev - M63), m_new = blast + M63;
        const int tl = 32 * tb + r;
        const float Mt = fmaxf(m_prev, __shfl(cm, tl)), bt = __shfl(bc, tl);
        const float inter = __expf(m_prev - Mt), m_t = bt + Mt;
        WS[lane] = rr * LOG2E; WS[64 + lane] = __expf(rr - M63);
        const float MtL = Mt * LOG2E;
        const LAS unsigned char* kbuf = lds + ML_K + par * 16384; const LAS unsigned char* vbuf = lds + ML_V + par * 16384;
        f32x16 wd[2]; float dsum = 0.f;
#pragma unroll
        for (int kb = 0; kb < 2; ++kb) {
#pragma unroll
            for (int i = 0; i < 16; ++i) wd[kb][i] = 0.f;
            if ((PM & 4) && kb <= tb) {
                f32x16 a = wd[kb]; bf16x8 kfr[8];
#pragma unroll
                for (int st = 0; st < 8; ++st) kfr[st] = *(const LAS bf16x8*)(kbuf + kb * 8192 + rowK + ((32 * st) ^ F16));
                SB();
#pragma unroll
                for (int st = 0; st < 8; ++st) a = MFMA32(kfr[st], qf[st], a);
#pragma unroll
                for (int i = 0; i < 16; ++i) { const int s = 32 * kb + crow(i, hh); const float e = __builtin_amdgcn_exp2f(WS[s] - MtL); const float w = (s <= tl) ? e * a[i] : 0.f; a[i] = w; dsum += w; }
                wd[kb] = a;
            }
        }
        f32x16 acc; bf16x8 cfr[8];
#pragma unroll
        for (int i = 0; i < 16; ++i) acc[i] = 0.f;
        if (PM & 8) {
#pragma unroll
        for (int st = 0; st < 8; ++st) cfr[st] = ml_tr8(lds + ML_C + base_c + st * 4096);
        SB();
#pragma unroll
        for (int st = 0; st < 8; ++st) acc = MFMA32(cfr[st], qf[st], acc); }
#pragma unroll
        for (int i = 0; i < 16; ++i) acc[i] *= inter;
#pragma unroll
        for (int kb = 0; kb < 2; ++kb) {
            if ((PM & 16) && kb <= tb) {
                const bf16x8 pf0 = pack8<0>(wd[kb]), pf1 = pack8<1>(wd[kb]);
                {
#pragma unroll
                  for (int s2 = 0; s2 < 2; ++s2) { const LAS unsigned char* p = vbuf + base_v + kb * 8192 + s2 * 4096;
                    const s16x4 lo = __builtin_amdgcn_ds_read_tr16_b64_v4i16((lds_s16x4*)p); const s16x4 hi = __builtin_amdgcn_ds_read_tr16_b64_v4i16((lds_s16x4*)(p + 2048));
                    const bf16x8 vf = __builtin_shufflevector(lo, hi, 0, 1, 2, 3, 4, 5, 6, 7);
                    acc = MFMA32(vf, s2 ? pf1 : pf0, acc); } }
            }
        }
        float qn_ = 0.f;
        if (PM & 32)
#pragma unroll
        for (int st = 0; st < 8; ++st) { const v4u qw = __builtin_bit_cast(v4u, qf[st]); const LAS float* np = NV + 16 * st + 8 * hh; const f32x4 n0 = *(const LAS f32x4*)np, n1 = *(const LAS f32x4*)(np + 4);
            qn_ = fmaf(__uint_as_float(qw.x << 16), n0[0], qn_); qn_ = fmaf(__uint_as_float(qw.x & 0xffff0000u), n0[1], qn_); qn_ = fmaf(__uint_as_float(qw.y << 16), n0[2], qn_); qn_ = fmaf(__uint_as_float(qw.y & 0xffff0000u), n0[3], qn_);
            qn_ = fmaf(__uint_as_float(qw.z << 16), n1[0], qn_); qn_ = fmaf(__uint_as_float(qw.z & 0xffff0000u), n1[1], qn_); qn_ = fmaf(__uint_as_float(qw.w << 16), n1[2], qn_); qn_ = fmaf(__uint_as_float(qw.w & 0xffff0000u), n1[3], qn_); }
        qn_ += __shfl_xor(qn_, 32); dsum += __shfl_xor(dsum, 32);
        const float den = inter * qn_ + dsum; const float rden = 1.f / fmaxf(fabsf(den), __expf(-m_t));
        float ssq = 0.f;
#pragma unroll
        for (int i = 0; i < 16; ++i) { acc[i] *= rden; ssq = fmaf(acc[i], acc[i], ssq); }
        ssq += __shfl_xor(ssq, 32);
        if (hh == 0) SS[vb * 64 + tl] = ssq;
        if (PM & 64)
#pragma unroll
        for (int k2 = 0; k2 < 2; ++k2) { const int ci = tid + 512 * k2, s = ci >> 4; const float w = WS[64 + s];
            const v4u x = *(const LAS v4u*)(vbuf + ci * 16); v4u y; const unsigned xs[4] = {x.x, x.y, x.z, x.w}; unsigned ys[4];
#pragma unroll
            for (int j = 0; j < 4; ++j) ys[j] = pkbf(__uint_as_float(xs[j] << 16) * w, __uint_as_float(xs[j] & 0xffff0000u) * w);
            y.x = ys[0]; y.y = ys[1]; y.z = ys[2]; y.w = ys[3]; *(LAS v4u*)(lds + ML_VW + ci * 16) = y; }
        asm volatile("s_waitcnt lgkmcnt(0)" ::: "memory"); __builtin_amdgcn_s_barrier(); asm volatile("" ::: "memory");
        if (c < 31) {
            const bf16* qp = mlqk + (tokc + 64 + 32 * tb + r) * 1024 + hd * 128 + 8 * hh;
#pragma unroll
            for (int st = 0; st < 8; ++st) qf[st] = *(const bf16x8*)(qp + 16 * st);
            gi_raw = bf2f(proj[(tokc + 64 + lane) * NPROJ + PC_MLI + hd]); gf_raw = bf2f(proj[(tokc + 64 + lane) * NPROJ + PC_MLF + hd]);
        }
        { const LAS float* GO = (const LAS float*)(lds + ML_GO) + 32 * vb + 4 * hh;
          const float rstd = rsqrtf(((SS[tl] + SS[64 + tl]) + (SS[128 + tl] + SS[192 + tl])) * (1.f / 128.f) + EPS);
#pragma unroll
          for (int a = 0; a < 4; ++a) { float o4[4]; const unsigned gw[2] = {og[a].x, og[a].y};
#pragma unroll
              for (int j = 0; j < 4; ++j) { const float ov = (j & 1) ? __uint_as_float(gw[j >> 1] & 0xffff0000u) : __uint_as_float(gw[j >> 1] << 16); o4[j] = acc[4 * a + j] * rstd * GO[8 * a + j] * sigm(ov); }
              u32x2 w; w.x = pkbf(o4[0], o4[1]); w.y = pkbf(o4[2], o4[3]); *(LAS u32x2*)(lds + ML_ST + tl * 272 + (32 * vb + 8 * a + 4 * hh) * 2) = w; } }
        if (PM & 128)
#pragma unroll
        for (int blk = 0; blk < 2; ++blk) {
            f32x16 cs = Cst[blk];
#pragma unroll
            for (int i = 0; i < 16; ++i) cs[i] *= a_old;
            bf16x8 afr[4], kfr2[4];
#pragma unroll
            for (int st = 0; st < 4; ++st) {
                afr[st] = ml_tr8(lds + ML_VW + base_c + st * 4096);
                const s16x4 lo = __builtin_amdgcn_ds_read_tr16_b64_v4i16((lds_s16x4*)(kbuf + base_kt[blk][0] + st * 4096)); const s16x4 hi = __builtin_amdgcn_ds_read_tr16_b64_v4i16((lds_s16x4*)(kbuf + base_kt[blk][1] + st * 4096));
                kfr2[st] = __builtin_shufflevector(lo, hi, 0, 1, 2, 3, 4, 5, 6, 7);
            }
            SB();
#pragma unroll
            for (int st = 0; st < 4; ++st) cs = MFMA32(afr[st], kfr2[st], cs);
            Cst[blk] = cs;
            const int kk = 32 * (2 * tb + blk) + r;
#pragma unroll
            for (int a = 0; a < 4; ++a) { u32x2 w; w.x = pkbf(cs[4 * a], cs[4 * a + 1]); w.y = pkbf(cs[4 * a + 2], cs[4 * a + 3]);
                *(LAS u32x2*)(lds + ML_C + kk * 256 + 16 * ((4 * vb + a) ^ ((r & 3) << 2)) + 8 * hh) = w; }
        }
        if ((PM & 64) && tid < 128) { float nv = NV[tid] * a_old;
#pragma unroll 8
            for (int s = 0; s < 64; ++s) { const unsigned short kvs = *(const LAS unsigned short*)(kbuf + s * 256 + 16 * ((tid >> 3) ^ ml_fk(s)) + 2 * (tid & 7)); nv = fmaf(WS[64 + s], bf2f(kvs), nv); }
            NV[tid] = nv; }
        m_prev = m_new;
    }
    __syncthreads();
    if (PM & 1) { bf16* obase = H0 + (tok0 + 64 * 31) * 1536 + hd * 128;
#pragma unroll
        for (int i = 0; i < 2; ++i) { const int piece = tid + 512 * i, row = piece >> 4, cc = piece & 15; *(v4u*)(obase + (size_t)row * 1536 + 8 * cc) = *(const LAS v4u*)(lds + ML_ST + row * 272 + 16 * cc); } }
    __syncthreads();
}
DI void mem_load(LAS unsigned char* lds, int par, const char* kb, const char* vb, int wave, int lane) {
#pragma unroll
    for (int n2 = 0; n2 < 2; ++n2) { const int n = 2 * wave + n2, row = 4 * n + (lane >> 4), pc = lane & 15;
        const int kc = pc ^ ml_fk(row), vc = pc ^ ((row & 3) << 2);
        glds16(kb + (size_t)row * 1024 + 16 * kc, (unsigned)(size_t)(lds + ML_K + par * 16384 + n * 1024));
        glds16(vb + (size_t)row * 2048 + 16 * vc, (unsigned)(size_t)(lds + ML_V + par * 16384 + n * 1024)); }
}
template <bool STORE = true, bool DMA = true, bool COMP = true>
DI void mem_unit(Frame& F, int unit) {
    unsigned char* ws = F.ws; LAS unsigned char* lds = F.lds;
    int lane_ = F.lane_id();
    const int lane = lane_, wave = F.wave, r = lane & 31, hh = lane >> 5;
    const int b = unit >> 5, hd = (unit >> 3) & 3, qt = unit & 7;
    const bf16* mqn = (const bf16*)(ws + WS_MQN); const bf16* memkn = (const bf16*)(ws + WS_MEMKN); const bf16* memkv = (const bf16*)(ws + WS_MEMKV); bf16* H2 = (bf16*)(ws + WS_H0);
    const size_t t = (size_t)b * SEQ + 256 * qt + 32 * wave + r;
    const char* kbase = (const char*)(memkn + (size_t)b * MEML * 512 + hd * 128); const char* vbase = (const char*)(memkv + (size_t)b * MEML * 1024 + 512 + hd * 128);
    const int i16 = lane & 15, q4 = i16 >> 2, p4 = i16 & 3, g1 = (lane >> 4) & 1;
    int base_v[4];
#pragma unroll
    for (int db = 0; db < 4; ++db) base_v[db] = (4 * hh + q4) * 256 + 16 * ((4 * db + 2 * g1 + (p4 >> 1)) ^ (q4 << 2)) + 8 * (p4 & 1);
    const int fK = ml_fk(r), rowK = r * 256 + ((hh ^ (fK & 1)) << 4), F16 = (fK & 14) << 4;
    bf16x8 qf[8];
#pragma unroll
    for (int st = 0; st < 8; ++st) qf[st] = *(const bf16x8*)(mqn + t * 512 + hd * 128 + 16 * st + 8 * hh);
    f32x16 o[4]; float l = 0.f;
#pragma unroll
    for (int db = 0; db < 4; ++db)
#pragma unroll
        for (int i = 0; i < 16; ++i) o[db][i] = 0.f;
    WG_BAR();
    if (DMA) mem_load(lds, 0, kbase, vbase, wave, lane);
#pragma unroll 1
    for (int tile = 0; tile < 4; ++tile) {
        const int par = tile & 1;
        WG_BAR();
        if (DMA && tile < 3) mem_load(lds, par ^ 1, kbase + (size_t)(64 * (tile + 1)) * 1024, vbase + (size_t)(64 * (tile + 1)) * 2048, wave, lane);
        const LAS unsigned char* kbuf = lds + ML_K + par * 16384; const LAS unsigned char* vbuf = lds + ML_V + par * 16384;
        if (COMP)
#pragma unroll
        for (int kb = 0; kb < 2; ++kb) {
            bf16x8 kf[8];
#pragma unroll
            for (int st = 0; st < 8; ++st) kf[st] = *(const LAS bf16x8*)(kbuf + kb * 8192 + rowK + ((32 * st) ^ F16));
            SB();
            f32x16 a;
#pragma unroll
            for (int i = 0; i < 16; ++i) a[i] = 0.f;
#pragma unroll
            for (int st = 0; st < 8; ++st) a = MFMA32(kf[st], qf[st], a);
            bf16x8 vf[2][4];
#pragma unroll
            for (int s2 = 0; s2 < 2; ++s2)
#pragma unroll
                for (int db = 0; db < 4; ++db) { const LAS unsigned char* p = vbuf + base_v[db] + kb * 8192 + s2 * 4096;
                    const s16x4 lo = __builtin_amdgcn_ds_read_tr16_b64_v4i16((lds_s16x4*)p); const s16x4 hi = __builtin_amdgcn_ds_read_tr16_b64_v4i16((lds_s16x4*)(p + 2048));
                    vf[s2][db] = __builtin_shufflevector(lo, hi, 0, 1, 2, 3, 4, 5, 6, 7); }
            SB();
#pragma unroll
            for (int i = 0; i < 16; ++i) { a[i] = __builtin_amdgcn_exp2f(a[i]); l += a[i]; }
            const bf16x8 pf0 = pack8<0>(a), pf1 = pack8<1>(a);
#pragma unroll
            for (int s2 = 0; s2 < 2; ++s2)
#pragma unroll
                for (int db = 0; db < 4; ++db) o[db] = MFMA32(vf[s2][db], s2 ? pf1 : pf0, o[db]);
        }
    }
    const float inv = 1.f / (l + __shfl_xor(l, 32));
    if (!STORE) {
#pragma unroll
        for (int db = 0; db < 4; ++db) asm volatile("" :: "v"(o[db]), "v"(inv));
        return; }
    WG_BAR();
#pragma unroll
    for (int db = 0; db < 4; ++db)
#pragma unroll
        for (int a = 0; a < 4; ++a) { u32x2 w; w.x = pkbf(o[db][4 * a] * inv, o[db][4 * a + 1] * inv); w.y = pkbf(o[db][4 * a + 2] * inv, o[db][4 * a + 3] * inv);
            *(LAS u32x2*)(lds + (32 * wave + r) * 272 + (32 * db + 8 * a + 4 * hh) * 2) = w; }
    WG_BAR();
    { const int tid = wave * 64 + lane; bf16* obase = H2 + ((size_t)b * SEQ + 256 * qt) * 1536 + 1024 + hd * 128;
#pragma unroll
      for (int i = 0; i < 8; ++i) { const int piece = tid + 512 * i, row = piece >> 4, c = piece & 15; *(v4u*)(obase + (size_t)row * 1536 + 8 * c) = *(const LAS v4u*)(lds + row * 272 + 16 * c); } }
}
DI int q_pop(Frame& F, unsigned* qc) {
    __syncthreads();
    if (F.tid_id() == 0) F.MISC[16] = atomicAdd(qc, 1u);
    __syncthreads();
    return (int)F.MISC[16];
}
template <bool ML, bool NSA, bool MEMA, bool MST = true, bool MDMA = true, bool MCOMP = true, bool NST = true, bool NCMP = true, bool NSEL = true, bool NWIN = true, int MLPM = 0xff>
DI void p5_queue(Frame& F, int cbase) {
    unsigned* qc = F.ctl + CW_QCTR + cbase;
    if (ML) {
#pragma unroll 1
        for (;;) { const int it = q_pop(F, qc); if (it >= 64) break; mlstm_unit2<MLPM>(F, it); }
    }
    if (NSA) {
#pragma unroll 1
        for (;;) { const int it = q_pop(F, qc + 64); if (it >= 1024) break; nsa_unit<NST, NCMP, NSEL, NWIN>(F, it); }
    }
    if (MEMA) {
#pragma unroll 1
        for (;;) { const int it = q_pop(F, qc + 128); if (it >= 512) break; mem_unit<MST, MDMA, MCOMP>(F, it); }
    }
    __syncthreads();
}
struct OneUnit { int pm; DI bool next(int i, pg8::Unit& u) const { if (i) return false; u.pm = pm; u.pn = 0; return true; } DI void a_ready(const pg8::Unit&) const {} DI void done(const pg8::Unit&) const {} };
DI void p2_compress(Frame& F) {
    unsigned char* ws = F.ws;
    if (F.G < 64 || F.bx >= 32) return;
    const int kv = F.bx >> 4, pm = F.bx & 15;
    typedef pg8::bf16_t b16;
    { pg8::GemmA g{(const b16*)(ws + WS_PROJ) + (kv ? PC_NVC : PC_NKC), (const b16*)(ws + WS_WC1) + (size_t)kv * 256 * 2048, 2048, 16 * NPROJ * 2, (size_t)NPROJ * 2, (size_t)128, (size_t)SEQ * NPROJ * 2};
      OneUnit S{pm};
      pg8::EpiBf16Silu E{(b16*)(ws + WS_HID) + (size_t)kv * 4096 * 256, 256, (const float*)(ws + WS_SMALL + SM_CBIAS) + kv * 256, 1};
      pg8::gemm_phase_ga<pg8::EpiBf16Silu, OneUnit, false, true>(F.lds, g, S, E, F.wave); }
    asm volatile("s_waitcnt vmcnt(0)" ::: "memory"); __syncthreads();
    const int lane = F.lane_id(), r = lane & 31, hh = lane >> 5;
    const int row = pm * 256 + F.wave * 32 + r, n = row & 127;
    const bf16* hid = (const bf16*)(ws + WS_HID) + (size_t)kv * 4096 * 256 + (size_t)row * 256 + 8 * hh;
    const bf16* w2t = (const bf16*)(ws + WS_SMALL + SM_W2T) + (size_t)kv * 64 * 256 + 8 * hh;
    f32x16 acc[2];
#pragma unroll
    for (int i = 0; i < 16; ++i) { acc[0][i] = 0.f; acc[1][i] = 0.f; }
#pragma unroll 4
    for (int st = 0; st < 16; ++st) { const bf16x8 hb = *(const bf16x8*)(hid + 16 * st);
        const bf16x8 w0 = *(const bf16x8*)(w2t + (size_t)r * 256 + 16 * st), w1 = *(const bf16x8*)(w2t + (size_t)(32 + r) * 256 + 16 * st);
        acc[0] = MFMA32(w0, hb, acc[0]); acc[1] = MFMA32(w1, hb, acc[1]); }
    if (kv == 0) {
        float ss = 0.f;
#pragma unroll
        for (int i = 0; i < 16; ++i) ss += acc[0][i] * acc[0][i] + acc[1][i] * acc[1][i];
        ss += __shfl_xor(ss, 32);
        const float rstd = rsqrtf(ss * (1.f / 64.f) + EPS);
        const float* rc = (const float*)(ws + WS_SMALL + SM_ROPEC); const float* rs = (const float*)(ws + WS_SMALL + SM_ROPES);
        const int pos = 16 * n + 31 < SEQ ? 16 * n + 31 : SEQ - 1;
#pragma unroll
        for (int i = 0; i < 16; ++i) { const int d = crow(i, hh); const float c = rc[pos * 32 + d], sn = rs[pos * 32 + d];
            const float y0 = acc[0][i] * rstd * F.in[I_NGK][d], y1 = acc[1][i] * rstd * F.in[I_NGK][32 + d];
            acc[0][i] = y0 * c - y1 * sn; acc[1][i] = y1 * c + y0 * sn; }
    }
    bf16* dst = (bf16*)(ws + (kv ? WS_VC : WS_KC)) + (size_t)row * 64 + 4 * hh;
#pragma unroll
    for (int db = 0; db < 2; ++db)
#pragma unroll
        for (int a = 0; a < 4; ++a) { u32x2 w; w.x = pkbf(acc[db][4 * a], acc[db][4 * a + 1]); w.y = pkbf(acc[db][4 * a + 2], acc[db][4 * a + 3]); if (n == 127) { w.x = 0u; w.y = 0u; }
            *(u32x2*)(dst + 32 * db + 8 * a) = w; }
}
DI void mlstm_unit(Frame& F, int unit) {
    unsigned char* ws = F.ws;
    const int b = unit >> 2, h = unit & 3, tid = F.tid_id(), kk = tid >> 7, c = tid & 127;
    const bf16* proj = (const bf16*)(ws + WS_PROJ); const bf16* mlqk = (const bf16*)(ws + WS_MLQK); bf16* H0 = (bf16*)(ws + WS_H0);
    LAS float* qs = (LAS float*)F.lds;
    LAS float* ks = qs + 16 * 128;
    LAS float* vs = ks + 16 * 128;
    LAS float* gi = vs + 16 * 128;
    LAS float* gf = gi + 16;
    LAS float* part = gf + 16;
    LAS float* pden = part + 2 * 4 * 128;
    LAS float* hb = pden + 8;
    float C[32], nn[32];
#pragma unroll
    for (int i = 0; i < 32; ++i) { C[i] = 0.f; nn[i] = 0.f; }
    float m = 0.f;
    const float bi = F.in[I_MLBI][h], bfv = F.in[I_MLBF][h];
    const float scale = 0.08838834764831845f;
#pragma unroll 1
    for (int t0 = 0; t0 < SEQ; t0 += 16) {
        __syncthreads();
        for (int i = tid; i < 16 * 128; i += 512) { const int s = i >> 7, d = i & 127; const size_t t = (size_t)b * SEQ + t0 + s;
            qs[i] = bf2f(mlqk[t * 1024 + h * 128 + d]); ks[i] = bf2f(mlqk[t * 1024 + 512 + h * 128 + d]); vs[i] = bf2f(proj[t * NPROJ + PC_MLV + h * 128 + d]); }
        if (tid < 16) { const size_t t = (size_t)b * SEQ + t0 + tid; gi[tid] = bf2f(proj[t * NPROJ + PC_MLI + h]) + bi; gf[tid] = logsig(bf2f(proj[t * NPROJ + PC_MLF + h]) + bfv); }
        __syncthreads();
#pragma unroll 1
        for (int s = 0; s < 16; ++s) {
            const float lf = gf[s], ig = gi[s];
            const float mn = fmaxf(lf + m, ig), a = __expf(lf + m - mn), bb = __expf(ig - mn);
            m = mn;
            const float v = vs[s * 128 + c];
            float pn = 0.f, pd = 0.f;
#pragma unroll
            for (int i = 0; i < 32; ++i) { const float kvv = ks[s * 128 + kk * 32 + i], qv = qs[s * 128 + kk * 32 + i];
                C[i] = a * C[i] + bb * kvv * v; nn[i] = a * nn[i] + bb * kvv; pn = fmaf(qv, C[i], pn); pd = fmaf(qv, nn[i], pd); }
            const int par = s & 1;
            part[(par * 4 + kk) * 128 + c] = pn; if (c == 0) pden[par * 4 + kk] = pd;
            __syncthreads();
            if (kk == 0) {
                const float num = (part[(par * 4 + 0) * 128 + c] + part[(par * 4 + 1) * 128 + c]) + (part[(par * 4 + 2) * 128 + c] + part[(par * 4 + 3) * 128 + c]);
                const float den = (pden[par * 4 + 0] + pden[par * 4 + 1]) + (pden[par * 4 + 2] + pden[par * 4 + 3]);
                hb[s * 128 + c] = num * scale / fmaxf(fabsf(den * scale), __expf(-mn));
            }
        }
        __syncthreads();
#pragma unroll
        for (int rr = 0; rr < 2; ++rr) { const int s = F.wave * 2 + rr; const size_t t = (size_t)b * SEQ + t0 + s;
            const float v0 = hb[s * 128 + F.lane_id()], v1 = hb[s * 128 + 64 + F.lane_id()];
            const float rstd = rsqrtf(wave_sum(v0 * v0 + v1 * v1) * (1.f / 128.f) + EPS);
            const float o0 = bf2f(proj[t * NPROJ + PC_MLO + h * 128 + F.lane_id()]), o1 = bf2f(proj[t * NPROJ + PC_MLO + h * 128 + 64 + F.lane_id()]);
            H0[t * 512 + h * 128 + F.lane_id()] = (bf16)f2bf(v0 * rstd * F.in[I_MLGOUT][h * 128 + F.lane_id()] * sigm(o0));
            H0[t * 512 + h * 128 + 64 + F.lane_id()] = (bf16)f2bf(v1 * rstd * F.in[I_MLGOUT][h * 128 + 64 + F.lane_id()] * sigm(o1)); }
    }
    __syncthreads();
}

DI void nsa_scores(const bf16* krow, bool valid, const LAS float* qs, float (&s)[4]) {
    s[0] = s[1] = s[2] = s[3] = 0.f;
    if (valid) {
#pragma unroll 2
        for (int c8 = 0; c8 < 8; ++c8) { const v4u kk = *(const v4u*)(krow + c8 * 8);
            const unsigned w[4] = {kk.x, kk.y, kk.z, kk.w};
#pragma unroll
            for (int j = 0; j < 4; ++j) { const float k0 = __uint_as_float(w[j] << 16), k1 = __uint_as_float(w[j] & 0xffff0000u); const int d = c8 * 8 + 2 * j;
#pragma unroll
                for (int g = 0; g < 4; ++g) s[g] = fmaf(k1, qs[g * 64 + d + 1], fmaf(k0, qs[g * 64 + d], s[g])); } }
    }
}
DI void nsa_wave(Frame& F, int item, LAS float* wl) {
    unsigned char* ws = F.ws; const int lane = F.lane_id();
    const int t = item >> 1, hkv = item & 1, b = t >> 11, tau = t & 2047;
    const bf16* proj = (const bf16*)(ws + WS_PROJ);
    const bf16* qn = (const bf16*)(ws + WS_QN); const bf16* ksn = (const bf16*)(ws + WS_KSN); const bf16* kwn = (const bf16*)(ws + WS_KWN);
    const bf16* kc = (const bf16*)(ws + WS_KC); const bf16* vc = (const bf16*)(ws + WS_VC); bf16* H1 = (bf16*)(ws + WS_H1);
    LAS float* qs = wl;
    LAS float* ps = wl + 256;
    LAS float* psum = wl + 768;
#pragma unroll
    for (int g = 0; g < 4; ++g) qs[g * 64 + lane] = bf2f(qn[(size_t)t * 512 + (hkv * 4 + g) * 64 + lane]);
    float ofin[4] = {0.f, 0.f, 0.f, 0.f};
    float gate[4][3];
#pragma unroll
    for (int g = 0; g < 4; ++g)
#pragma unroll
        for (int cidx = 0; cidx < 3; ++cidx) gate[g][cidx] = sigm(bf2f(proj[(size_t)t * NPROJ + PC_NG + (hkv * 4 + g) * 3 + cidx]));
    const int ncmp = tau >= 31 ? ((tau - 31) >> 4) + 1 : 0;
    {
        float l[4] = {0.f, 0.f, 0.f, 0.f}, o[4] = {0.f, 0.f, 0.f, 0.f};
        const size_t rbase = (size_t)(b * 2 + hkv) * 128;
#pragma unroll
        for (int blk = 0; blk < 2; ++blk) { const int n = blk * 64 + lane; const bool valid = n < ncmp; float s[4];
            nsa_scores(kc + (rbase + n) * 64, valid, qs, s);
#pragma unroll
            for (int g = 0; g < 4; ++g) { const float p = valid ? __expf(s[g]) : 0.f; l[g] += p; ps[g * 128 + n] = p; } }
        float inv[4];
#pragma unroll
        for (int g = 0; g < 4; ++g) { const float L = wave_sum(l[g]); inv[g] = L > 0.f ? 1.f / L : 0.f; }
#pragma unroll
        for (int blk = 0; blk < 2; ++blk) { const int n = blk * 64 + lane; psum[n] = (ps[0 * 128 + n] * inv[0] + ps[1 * 128 + n] * inv[1]) + (ps[2 * 128 + n] * inv[2] + ps[3 * 128 + n] * inv[3]); }
#pragma unroll 2
        for (int n = 0; n < ncmp; ++n) { const float vv = bf2f(vc[(rbase + n) * 64 + lane]);
#pragma unroll
            for (int g = 0; g < 4; ++g) o[g] = fmaf(ps[g * 128 + n], vv, o[g]); }
#pragma unroll
        for (int g = 0; g < 4; ++g) ofin[g] += gate[g][0] * o[g] * inv[g];
    }
    const int cur = tau >> 6;
    unsigned selmask = 0u;
    {
        float score = -3.0e38f;
        if (lane < 32) { const int j = lane; float imp = 0.f;
#pragma unroll
            for (int dn = -1; dn <= 3; ++dn) { const int n = 4 * j + dn; if (n >= 0 && n <= 126) imp += psum[n]; }
            const bool forced = (j == 0) || (j == cur) || (j == cur - 1);
            score = j > cur ? NEGF : imp + (forced ? 1.0e4f : 0.f); }
#pragma unroll 1
        for (int r = 0; r < 8; ++r) { const float mx = wave_max(score); const unsigned long long bal = __ballot(score == mx); const int win = __ffsll((long long)bal) - 1;
            selmask |= 1u << win; if (lane == win) score = -3.4e38f; }
    }
    {
        float l[4] = {0.f, 0.f, 0.f, 0.f}, o[4] = {0.f, 0.f, 0.f, 0.f};
#pragma unroll 1
        for (int j = 0; j <= cur; ++j) { if (!((selmask >> j) & 1u)) continue;
            const int kpos = 64 * j + lane; const bool valid = kpos <= tau; float s[4];
            nsa_scores(ksn + ((size_t)b * SEQ + kpos) * 128 + hkv * 64, valid, qs, s);
#pragma unroll
            for (int g = 0; g < 4; ++g) { const float p = valid ? __expf(s[g]) : 0.f; l[g] += p; ps[g * 128 + lane] = p; }
            const int nk = j == cur ? (tau & 63) + 1 : 64;
            const bf16* vb = proj + ((size_t)b * SEQ + 64 * j) * NPROJ + PC_NVS + hkv * 64 + lane;
#pragma unroll 2
            for (int k = 0; k < nk; ++k) { const float vv = bf2f(vb[(size_t)k * NPROJ]);
#pragma unroll
                for (int g = 0; g < 4; ++g) o[g] = fmaf(ps[g * 128 + k], vv, o[g]); } }
#pragma unroll
        for (int g = 0; g < 4; ++g) { const float L = wave_sum(l[g]); ofin[g] += gate[g][1] * o[g] * (L > 0.f ? 1.f / L : 0.f); }
    }
    {
        float l[4] = {0.f, 0.f, 0.f, 0.f}, o[4] = {0.f, 0.f, 0.f, 0.f};
        const int start = tau - 511 > 0 ? tau - 511 : 0;
#pragma unroll 1
        for (int base = start & ~63; base <= tau; base += 64) {
            const int kpos = base + lane; const bool valid = kpos >= start && kpos <= tau; float s[4];
            nsa_scores(kwn + ((size_t)b * SEQ + kpos) * 128 + hkv * 64, valid, qs, s);
#pragma unroll
            for (int g = 0; g < 4; ++g) { const float p = valid ? __expf(s[g]) : 0.f; l[g] += p; ps[g * 128 + lane] = p; }
            const int k0 = start > base ? start - base : 0, k1 = tau - base < 63 ? tau - base : 63;
            const bf16* vb = proj + ((size_t)b * SEQ + base) * NPROJ + PC_NVW + hkv * 64 + lane;
#pragma unroll 2
            for (int k = k0; k <= k1; ++k) { const float vv = bf2f(vb[(size_t)k * NPROJ]);
#pragma unroll
                for (int g = 0; g < 4; ++g) o[g] = fmaf(ps[g * 128 + k], vv, o[g]); } }
#pragma unroll
        for (int g = 0; g < 4; ++g) { const float L = wave_sum(l[g]); ofin[g] += gate[g][2] * o[g] * (L > 0.f ? 1.f / L : 0.f); }
    }
#pragma unroll
    for (int g = 0; g < 4; ++g) H1[(size_t)t * 512 + (hkv * 4 + g) * 64 + lane] = (bf16)f2bf(ofin[g]);
}
DI void mem_wave(Frame& F, int t, LAS float* wl) {
    unsigned char* ws = F.ws; const int lane = F.lane_id(); const int b = t >> 11;
    const bf16* mqn = (const bf16*)(ws + WS_MQN); const bf16* memkn = (const bf16*)(ws + WS_MEMKN); const bf16* memkv = (const bf16*)(ws + WS_MEMKV); bf16* H2 = (bf16*)(ws + WS_H2);
    LAS float* qs = wl;
    LAS float* ps = wl + 128;
#pragma unroll 1
    for (int h = 0; h < 4; ++h) {
        qs[lane] = bf2f(mqn[(size_t)t * 512 + h * 128 + lane]); qs[64 + lane] = bf2f(mqn[(size_t)t * 512 + h * 128 + 64 + lane]);
        float l = 0.f;
#pragma unroll 1
        for (int kq = 0; kq < 4; ++kq) { const int key = kq * 64 + lane; const bf16* kr = memkn + ((size_t)b * MEML + key) * 512 + h * 128; float s = 0.f;
#pragma unroll 2
            for (int c8 = 0; c8 < 16; ++c8) { const v4u kk = *(const v4u*)(kr + c8 * 8); const unsigned w[4] = {kk.x, kk.y, kk.z, kk.w};
#pragma unroll
                for (int j = 0; j < 4; ++j) s = fmaf(__uint_as_float(w[j] & 0xffff0000u), qs[c8 * 8 + 2 * j + 1], fmaf(__uint_as_float(w[j] << 16), qs[c8 * 8 + 2 * j], s)); }
            const float p = __expf(s); l += p; ps[key] = p; }
        const float inv = 1.f / wave_sum(l);
        float o0 = 0.f, o1 = 0.f;
        const bf16* vb = memkv + (size_t)b * MEML * 1024 + 512 + h * 128;
#pragma unroll 4
        for (int key = 0; key < MEML; ++key) { const float p = ps[key]; o0 = fmaf(p, bf2f(vb[(size_t)key * 1024 + lane]), o0); o1 = fmaf(p, bf2f(vb[(size_t)key * 1024 + 64 + lane]), o1); }
        H2[(size_t)t * 512 + h * 128 + lane] = (bf16)f2bf(o0 * inv); H2[(size_t)t * 512 + h * 128 + 64 + lane] = (bf16)f2bf(o1 * inv);
    }
}
DI void p5_mixers(Frame& F) {
    const int nml = F.G >= 128 ? 64 : 0;
#ifndef RPT_ML
#define RPT_ML 1
#endif
#ifndef RPT_NSA
#define RPT_NSA 1
#endif
#ifndef RPT_MEM
#define RPT_MEM 1
#endif
    if (F.bx < nml || nml == 0) { for (int rp = 0; rp < RPT_ML; ++rp) for (int u = F.bx; u < 64; u += (nml ? nml : F.G)) mlstm_unit2(F, u); }
    if (F.bx >= nml) {
        LAS float* wl = (LAS float*)(F.lds + F.wave * 4096);
        const int gw = (F.bx - nml) * NWAVES + F.wave, NGW = (F.G - nml) * NWAVES;
        for (int rp = 0; rp < RPT_NSA; ++rp) for (int u = F.bx - nml; u < 1024; u += F.G - nml) nsa_unit(F, u);
        __syncthreads();
        for (int rp = 0; rp < RPT_MEM; ++rp) for (int t = gw; t < MT; t += NGW) mem_wave(F, t, wl);
    }
}

DI void p8_router(Frame& F, int alt) {
    unsigned char* ws = F.ws + (size_t)alt * 3 * MiB; const int lane = F.lane_id(), tid = F.tid_id(), wave = F.wave, r = lane & 31, hh = lane >> 5;
    unsigned char* xn8 = (unsigned char*)(F.ws + WS_R1);
    int* tok_e = (int*)(ws + WS_ROUTE + RT_TOKE); int* tok_pos = (int*)(ws + WS_ROUTE + RT_TOKPOS); float* tok_w = (float*)(ws + WS_ROUTE + RT_TOKW);
    unsigned* gcnt = F.ctl + CW_ECNT + 64 * alt;
    const bf16* wrt = (const bf16*)(F.ws + WS_SMALL + SM_WRT);
    LAS unsigned char* img = F.lds;
    LAS float* part = (LAS float*)F.lds;
    LAS float* lg = (LAS float*)(F.lds + 4 * 64 * 33 * 4);
    LAS int* lcnt = (LAS int*)(F.lds + RING_BYTES + 1024);
    LAS int* lbase = lcnt + 32;
    LAS int* se = lbase + 32;
    LAS int* sp = se + 256;
    LAS float* sw = (LAS float*)(sp + 256);
    const float* gf = F.in[I_GFFN];
    for (int bt = F.bx; bt < MT / 64; bt += F.G) {
        __syncthreads();
        if (tid < 32) lcnt[tid] = 0;
        const f32x4* gr = (const f32x4*)gf + 4 * lane; const f32x4 g0 = gr[0], g1 = gr[1], g2 = gr[2], g3 = gr[3];
#pragma unroll 1
        for (int i0 = 0; i0 < 8; i0 += 4) {
            f32x4 v[4][4];
#pragma unroll
            for (int u = 0; u < 4; ++u) { const int t = bt * 64 + wave * 8 + i0 + u; const f32x4* xr = (const f32x4*)(F.out + (size_t)t * DM) + 4 * lane;
#pragma unroll
                for (int j = 0; j < 4; ++j) v[u][j] = xr[j]; }
#pragma unroll
            for (int u = 0; u < 4; ++u) { const int tl = wave * 8 + i0 + u, t = bt * 64 + tl; float sq = 0.f;
#pragma unroll
                for (int j = 0; j < 4; ++j) sq += (v[u][j].x * v[u][j].x + v[u][j].y * v[u][j].y) + (v[u][j].z * v[u][j].z + v[u][j].w * v[u][j].w);
                const float rstd = rsqrtf(wave_sum(sq) * (1.f / DM) + EPS);
                const f32x4 gg[4] = {g0, g1, g2, g3}; unsigned q[4]; unsigned bw[8];
#pragma unroll
                for (int j = 0; j < 4; ++j) { const float y0 = v[u][j].x * rstd * gg[j].x, y1 = v[u][j].y * rstd * gg[j].y, y2 = v[u][j].z * rstd * gg[j].z, y3 = v[u][j].w * rstd * gg[j].w;
                    bw[2 * j] = pk2(y0, y1); bw[2 * j + 1] = pk2(y2, y3);
                    int q8 = 0; q8 = __builtin_amdgcn_cvt_pk_fp8_f32(y0, y1, q8, false); q8 = __builtin_amdgcn_cvt_pk_fp8_f32(y2, y3, q8, true); q[j] = (unsigned)q8; }
                *((v4u*)(xn8 + (size_t)t * DM) + lane) = (v4u){q[0], q[1], q[2], q[3]};
                *(LAS v4u*)(img + tl * 2048 + 16 * ((2 * lane) ^ (tl & 15))) = (v4u){bw[0], bw[1], bw[2], bw[3]};
                *(LAS v4u*)(img + tl * 2048 + 16 * ((2 * lane + 1) ^ (tl & 15))) = (v4u){bw[4], bw[5], bw[6], bw[7]}; }
        }
        __syncthreads();
        {
            const int mb = wave & 1, kq = wave >> 1, trow = 32 * mb + r;
            f32x16 acc;
#pragma unroll
            for (int i = 0; i < 16; ++i) acc[i] = 0.f;
#pragma unroll 4
            for (int s2 = 0; s2 < 16; ++s2) { const int st = 16 * kq + s2;
                const bf16x8 xa = *(const LAS bf16x8*)(img + trow * 2048 + 16 * ((2 * st + hh) ^ (trow & 15)));
                const bf16x8 wh = *(const bf16x8*)(wrt + (size_t)r * 1024 + 16 * st + 8 * hh), wl = *(const bf16x8*)(wrt + 32 * 1024 + (size_t)r * 1024 + 16 * st + 8 * hh);
                acc = MFMA32(xa, wh, acc); acc = MFMA32(xa, wl, acc); }
            __syncthreads();
#pragma unroll
            for (int i = 0; i < 16; ++i) part[(kq * 64 + 32 * mb + crow(i, hh)) * 33 + r] = acc[i];
        }
        __syncthreads();
        for (int i = tid; i < 64 * 32; i += 512) { const int tk = i >> 5, e = i & 31; lg[tk * 33 + e] = ((part[(0 * 64 + tk) * 33 + e] + part[(1 * 64 + tk) * 33 + e]) + (part[(2 * 64 + tk) * 33 + e] + part[(3 * 64 + tk) * 33 + e])) + F.in[I_BR][e]; }
        __syncthreads();
        if (wave == 0) {
            const int tl = lane; float v[32];
#pragma unroll
            for (int e = 0; e < 32; ++e) v[e] = lg[tl * 33 + e];
            unsigned taken = 0u; int ek[4]; float vk[4];
#pragma unroll
            for (int rd = 0; rd < 4; ++rd) { float best = -3.4e38f; int bi = 0;
#pragma unroll
                for (int e = 0; e < 32; ++e) { const float x = ((taken >> e) & 1u) ? -3.4e38f : v[e]; if (x > best) { best = x; bi = e; } }
                taken |= 1u << bi; ek[rd] = bi; vk[rd] = best; }
            const float e1 = __expf(vk[1] - vk[0]), e2 = __expf(vk[2] - vk[0]), e3 = __expf(vk[3] - vk[0]); const float inv = 1.f / (1.f + e1 + e2 + e3);
            const float wk[4] = {inv, e1 * inv, e2 * inv, e3 * inv};
#pragma unroll
            for (int rd = 0; rd < 4; ++rd) { se[tl * 4 + rd] = ek[rd]; sw[tl * 4 + rd] = wk[rd]; sp[tl * 4 + rd] = atomicAdd((int*)&lcnt[ek[rd]], 1); }
        }
        __syncthreads();
        if (tid < 32) lbase[tid] = (int)atomicAdd(&gcnt[tid], (unsigned)lcnt[tid]);
        __syncthreads();
        if (tid < 256) { const int t = bt * 64 + (tid >> 2), k = tid & 3; const int e = se[tid];
          tok_e[t * 4 + k] = e; tok_pos[t * 4 + k] = lbase[e] + sp[tid]; tok_w[t * 4 + k] = sw[tid]; }
    }
    __syncthreads();
}
DI int moe_tables(Frame& F, LAS int* pstart, LAS unsigned char* blk_e) {
    unsigned* gcnt = F.ctl + CW_ECNT;
    __syncthreads();
    if (F.wave == 0) {
        const int l = F.lane_id(); int pad = 0;
        if (l < NEXP) { const int cnt = (int)__hip_atomic_load(&gcnt[l], __ATOMIC_RELAXED, __HIP_MEMORY_SCOPE_AGENT); pad = (cnt + MOEB - 1) / MOEB * MOEB; }
        int inc = pad;
#pragma unroll
        for (int o = 1; o < 32; o <<= 1) { const int v = __shfl_up(inc, o); if (l >= o) inc += v; }
        if (l < NEXP) pstart[l] = inc - pad;
        if (l == NEXP - 1) pstart[NEXP] = inc;
    }
    __syncthreads();
    const int nblk = pstart[NEXP] / MOEB;
    for (int rb = F.tid_id(); rb < nblk; rb += 512) { int e = 0; while (e < NEXP - 1 && pstart[e + 1] <= rb * MOEB) ++e; blk_e[rb] = (unsigned char)e; }
    __syncthreads();
    return nblk;
}
DI void p9_scatter(Frame& F) {
    unsigned char* ws = F.ws; const int lane = F.lane_id();
    LAS int* pstart = (LAS int*)(F.lds + 65536); LAS unsigned char* blk_e = (LAS unsigned char*)(F.lds + 65536 + 256);
    moe_tables(F, pstart, blk_e);
    const int* tok_e = (const int*)(ws + WS_ROUTE + RT_TOKE); const int* tok_pos = (const int*)(ws + WS_ROUTE + RT_TOKPOS); const float* tok_w = (const float*)(ws + WS_ROUTE + RT_TOKW);
    int* tok_dest = (int*)(ws + WS_ROUTE + RT_TOKDEST); float* roww = (float*)(ws + WS_ROUTE + RT_ROWW); int* rowtok = (int*)(ws + WS_ROUTE + RT_ROWTOK);
    unsigned* gcnt = F.ctl + CW_ECNT;
    for (int it = F.bx * 512 + F.tid_id(); it < NROWS; it += F.G * 512) {
        const int dest = pstart[tok_e[it]] + tok_pos[it];
        tok_dest[it] = dest; roww[dest] = tok_w[it]; rowtok[dest] = it >> 2; }
    for (int it = F.bx * 512 + F.tid_id(); it < NEXP * MOEB; it += F.G * 512) { const int e = it >> 8, i = it & 255; const int cnt = (int)__hip_atomic_load(&gcnt[e], __ATOMIC_RELAXED, __HIP_MEMORY_SCOPE_AGENT); const int padded = (cnt + MOEB - 1) / MOEB * MOEB;
        if (i < padded - cnt) { const int dest = pstart[e] + cnt + i; roww[dest] = 0.f; rowtok[dest] = 0; } }
    (void)lane;
}
DI void p12_combine(Frame& F) {
    unsigned char* ws = F.ws; const int lane = F.lane_id();
    const bf16* ybuf = (const bf16*)(ws + WS_APERM); const int* tok_dest = (const int*)(ws + WS_ROUTE + RT_TOKDEST);
    const int gw = F.bx * NWAVES + F.wave, NGW = F.G * NWAVES;
    for (int t2 = gw; t2 < MT / 2; t2 += NGW) {
        typedef int i32x4 __attribute__((ext_vector_type(4)));
        v4u w[2][4][2]; f32x4 a[2][2][2];
#pragma unroll
        for (int q = 0; q < 2; ++q) { const int t = 2 * t2 + q; const f32x4* orow = (const f32x4*)(F.out + (size_t)t * DM);
            const i32x4 d = *(const i32x4*)(tok_dest + t * 4); const int dd[4] = {d.x, d.y, d.z, d.w};
#pragma unroll
            for (int j = 0; j < 2; ++j) {
#pragma unroll
                for (int k = 0; k < 4; ++k) w[q][k][j] = *((const v4u*)(ybuf + (size_t)dd[k] * DM) + lane + 64 * j);
                a[q][j][0] = orow[2 * (lane + 64 * j)]; a[q][j][1] = orow[2 * (lane + 64 * j) + 1]; } }
#pragma unroll
        for (int q = 0; q < 2; ++q) { f32x4* orow = (f32x4*)(F.out + (size_t)(2 * t2 + q) * DM);
#pragma unroll
            for (int j = 0; j < 2; ++j) {
#pragma unroll
                for (int k = 0; k < 4; ++k) { const v4u ww = w[q][k][j];
                    a[q][j][0].x += __uint_as_float(ww.x << 16); a[q][j][0].y += __uint_as_float(ww.x & 0xffff0000u); a[q][j][0].z += __uint_as_float(ww.y << 16); a[q][j][0].w += __uint_as_float(ww.y & 0xffff0000u);
                    a[q][j][1].x += __uint_as_float(ww.z << 16); a[q][j][1].y += __uint_as_float(ww.z & 0xffff0000u); a[q][j][1].z += __uint_as_float(ww.w << 16); a[q][j][1].w += __uint_as_float(ww.w & 0xffff0000u); }
                orow[2 * (lane + 64 * j)] = a[q][j][0]; orow[2 * (lane + 64 * j) + 1] = a[q][j][1]; } }
    }
}

constexpr int N_PHASES = 13;
#ifndef MK_PER_PHASE
#define MK_PER_PHASE 0
#endif
__global__ void __launch_bounds__(NWAVES * 64, 2) fwd_kernel(Args args) {
    extern __shared__ __attribute__((aligned(16))) unsigned char lds_raw[];
    Frame F;
    F.lds = (LAS unsigned char*)lds_raw; F.MISC = (volatile LAS unsigned*)(F.lds + MISC_OFF);
    F.wave = __builtin_amdgcn_readfirstlane((int)(threadIdx.x >> 6)); F.G = gridDim.x; F.bx = blockIdx.x;
    F.ws = args.ws; F.ctl = (unsigned*)(args.ws + WS_CTL); F.in = args.in; F.out = args.out;
    unsigned char* ws = args.ws;
    for (int u = threadIdx.x; u < (LDS_BYTES - LDSCTL_OFF) / 4; u += NWAVES * 64) ((LAS unsigned*)(F.lds + LDSCTL_OFF))[u] = 0u;
    __syncthreads();
    const int lo = args.ph_lo, hi = args.ph_hi;
    XcdBarrier bar; bar.wv = F.wave; bar.bar = F.ctl + CW_BAR; bar.x = 0; bar.st = nullptr;
    if (hi - lo > 1) bar = xcd_barrier_post(F.ctl + CW_BAR, F.MISC + 8, F.wave);
#ifndef PH_MASK
#define PH_MASK 0x1fff
#endif
#define IN(k) (((PH_MASK >> (k)) & 1) && lo <= (k) && (k) < hi)
#define SEAM(k) do { if (IN(k) && IN((k) + 1)) xcd_barrier(bar); } while (0)
    typedef pg8::bf16_t b16;
#ifndef RPT_MASK
#define RPT_MASK 0
#endif
#define RPT(k) _Pragma("unroll") for (int rp_ = 0; rp_ < 1 + ((RPT_MASK >> (k)) & 1); ++rp_)
#ifndef P0PARTS
#define P0PARTS 0xf
#endif
    if (IN(0)) { p0_prologue<0xf>(F); if (RPT_MASK & 1) p0_prologue<P0PARTS>(F); } SEAM(0);
    if (IN(1)) RPT(1) {
        { pg8::Gemm8 g{(const unsigned char*)(ws + WS_U8), (const unsigned char*)(ws + WS_WIN8), MT, NF8, DM, 0x7f7f7f7f, 0x77777777}; pg8::StaticOrder S; S.init(MT, NF8, F.G, F.bx);
          pg8::EpiBf16Silu E{(b16*)(ws + WS_PROJ) + NB16, NPROJ, nullptr, 0};
          pg8::gemm_phase_f8<pg8::EpiBf16Silu, pg8::StaticOrder, true, true>(F.lds, g, S, E, F.wave); }
        { pg8::Gemm g{(const b16*)(ws + WS_R1), (const b16*)(ws + WS_WIN), MT, NB16, DM}; pg8::StaticOrder S; S.init(MT, NB16, F.G, F.bx);
          pg8::EpiBf16Silu E{(b16*)(ws + WS_PROJ), NPROJ, nullptr, 0};
          pg8::gemm_phase<pg8::EpiBf16Silu, pg8::StaticOrder, true, true>(F.lds, g, S, E, F.wave); }
        { pg8::Gemm g{(const b16*)(ws + WS_MEMN), (const b16*)(ws + WS_WMKV), MROWS, 1024, DM}; pg8::StaticOrder S; S.init(MROWS, 1024, F.G, (F.bx + 64) % F.G);
          pg8::EpiBf16Silu E{(b16*)(ws + WS_MEMKV), 1024, nullptr, 0};
          pg8::gemm_phase<pg8::EpiBf16Silu, pg8::StaticOrder, true, true>(F.lds, g, S, E, F.wave); }
    } SEAM(1);
    if (IN(2)) { RPT(2) { p2_compress(F); p2_prep(F); } }
    if (IN(2) && IN(5)) xcd_barrier(bar);
#ifndef RPT5_ML
#define RPT5_ML 0
#endif
#ifndef MLPROBE
#define MLPROBE 0xff
#endif
#ifndef NPROBE_ST
#define NPROBE_ST true
#endif
#ifndef NPROBE_CMP
#define NPROBE_CMP true
#endif
#ifndef NPROBE_SEL
#define NPROBE_SEL true
#endif
#ifndef NPROBE_WIN
#define NPROBE_WIN true
#endif
#ifndef MPROBE_ST
#define MPROBE_ST true
#endif
#ifndef MPROBE_DMA
#define MPROBE_DMA true
#endif
#ifndef MPROBE_COMP
#define MPROBE_COMP true
#endif
#ifndef RPT5_NSA
#define RPT5_NSA 0
#endif
#ifndef RPT5_MEM
#define RPT5_MEM 0
#endif
    if (IN(5)) { p5_queue<true, true, true>(F, 0);
        if (RPT5_ML || RPT5_NSA || RPT5_MEM) { xcd_barrier(bar); p5_queue<RPT5_ML != 0, RPT5_NSA != 0, RPT5_MEM != 0, MPROBE_ST, MPROBE_DMA, MPROBE_COMP, NPROBE_ST, NPROBE_CMP, NPROBE_SEL, NPROBE_WIN, MLPROBE>(F, 256); } } SEAM(5);
    if (IN(6)) RPT(6) {
        pg8::StaticOrder S; S.init(MT, DM, F.G, F.bx);
        pg8::Gemm g{(const b16*)(ws + WS_H0), (const b16*)(ws + WS_WBR), MT, DM, 1536};
        pg8::EpiMergeK E{(const b16*)(ws + WS_PROJ), (b16*)(ws + WS_R1)};
        pg8::gemm_phase<pg8::EpiMergeK, pg8::StaticOrder, true, true>(F.lds, g, S, E, F.wave);
    } SEAM(6);
    if (IN(7)) RPT(7) {
        pg8::Gemm g{(const b16*)(ws + WS_R1), (const b16*)(ws + WS_WOUT), MT, DM, DM}; pg8::StaticOrder S; S.init(MT, DM, F.G, F.bx);
        pg8::EpiRes E{F.in[I_X], F.out};
        pg8::gemm_phase<pg8::EpiRes, pg8::StaticOrder, true, true>(F.lds, g, S, E, F.wave);
    } SEAM(7);
    if (IN(8)) { p8_router(F, 0); if ((RPT_MASK >> 8) & 1) p8_router(F, 1); } SEAM(8);
    if (IN(9)) { RPT(9) p9_scatter(F); } SEAM(9);
    if (IN(10)) RPT(10) {
        LAS int* pstart = (LAS int*)(F.lds + RING_BYTES + 1024); LAS unsigned char* blk_e = (LAS unsigned char*)(F.lds + RING_BYTES + 1024 + 256);
        const int nblk = moe_tables(F, pstart, blk_e);
        pg8::Gemm8G g{(const unsigned char*)(ws + WS_R1), (const unsigned char*)(ws + WS_WGU), (const int*)(ws + WS_ROUTE + RT_ROWTOK), DM, 0x7f7f7f7f, 0x77777777};
        pg8::MoeOrder<8> S{nblk, F.G, F.bx, (const PG8_LAS unsigned char*)blk_e};
        pg8::EpiSwiglu E{(unsigned char*)(ws + WS_ACT), F.in[I_BGU]};
        pg8::gemm_phase_f8g<pg8::EpiSwiglu, pg8::MoeOrder<8>, true, true>(F.lds, g, S, E, F.wave);
    } SEAM(10);
    if (IN(11)) RPT(11) {
        LAS int* pstart = (LAS int*)(F.lds + RING_BYTES + 1024); LAS unsigned char* blk_e = (LAS unsigned char*)(F.lds + RING_BYTES + 1024 + 256);
        const int nblk = moe_tables(F, pstart, blk_e);
        pg8::Gemm8 g{(const unsigned char*)(ws + WS_ACT), (const unsigned char*)(ws + WS_WDN), CAP, NEXP * DM, DFF, 0x7f7f7f7f, 0x77777777};
        pg8::MoeOrder<4> S{nblk, F.G, F.bx, (const PG8_LAS unsigned char*)blk_e};
        pg8::EpiDown E{(b16*)(ws + WS_APERM), F.in[I_BDN], (const float*)(ws + WS_ROUTE + RT_ROWW)};
        pg8::gemm_phase_f8<pg8::EpiDown, pg8::MoeOrder<4>, true, true>(F.lds, g, S, E, F.wave);
    } SEAM(11);
    if (IN(12)) { p12_combine(F); }
#undef IN
#undef SEAM
}

extern "C" void kernel_launch(void* const* d_in, const int* in_sizes, int n_in, void* d_out, int out_size, void* d_ws, size_t ws_size, hipStream_t stream) {
    static int grid = 0;
    if (grid == 0) {
        if (n_in != N_IN || out_size != MT * DM || ws_size < WS_END) { fprintf(stderr, "kernel_launch: unexpected shapes (n_in %d, out %d, ws %zu need %zu)\n", n_in, out_size, ws_size, (size_t)WS_END); grid = -1; return; }
        int dev = 0, cus = 0, per_cu = 0;
        if (hipGetDevice(&dev) != hipSuccess || hipDeviceGetAttribute(&cus, hipDeviceAttributeMultiprocessorCount, dev) != hipSuccess) { grid = -1; return; }
        if (hipFuncSetAttribute((const void*)fwd_kernel, hipFuncAttributeMaxDynamicSharedMemorySize, LDS_BYTES) != hipSuccess) { fprintf(stderr, "kernel_launch: hipFuncSetAttribute failed\n"); grid = -1; return; }
        if (hipOccupancyMaxActiveBlocksPerMultiprocessor(&per_cu, (const void*)fwd_kernel, NWAVES * 64, LDS_BYTES) != hipSuccess || per_cu < 1) { fprintf(stderr, "kernel_launch: occupancy query says %d\n", per_cu); }
        (void)hipGetLastError();
        grid = cus;
    }
    if (grid < 0) return;
    if (hipMemsetAsync((char*)d_ws + WS_CTL, 0, CTL_ZERO_BYTES, stream) != hipSuccess) return;
    Args a{};
    for (int i = 0; i < N_IN; ++i) a.in[i] = (const float*)d_in[i];
    a.out = (float*)d_out; a.ws = (unsigned char*)d_ws;
#if MK_PER_PHASE
    for (int p = 0; p < N_PHASES; ++p) { a.ph_lo = p; a.ph_hi = p + 1; a.li = 0; hipLaunchKernelGGL(fwd_kernel, dim3(grid), dim3(NWAVES * 64), LDS_BYTES, stream, a); }
#else
    a.ph_lo = 0; a.ph_hi = N_PHASES; a.li = 0;
    hipLaunchKernelGGL(fwd_kernel, dim3(grid), dim3(NWAVES * 64), LDS_BYTES, stream, a);
#endif
}
```

```cpp
#include <hip/hip_runtime.h>
#include <cstdio>
#include <cstdint>
namespace pg8 {
#define PG8_LAS __attribute__((address_space(3)))
typedef unsigned short bf16_t;
typedef short bf16x8 __attribute__((ext_vector_type(8)));
typedef float f32x4 __attribute__((ext_vector_type(4)));
typedef unsigned u32x4 __attribute__((ext_vector_type(4)));
constexpr int BM = 256, BK = 64, HALF = 128, HTB = HALF * BK * 2  , STAGE_BYTES = 8 * HTB, NXCD = 8, WGM = 8;

__host__ __device__ __forceinline__ int lds_byte(int r, int c) { const int st = (r >> 4) * 2 + (c >> 5), rr = r & 15, cc = c & 31, ob = rr * 64 + cc * 2; return st * 1024 + (ob ^ (((ob >> 9) & 1) << 5)); }
__host__ __device__ __forceinline__ void stage_rc(int b, int& R, int& C) { const int st = b / 1024, sb = b % 1024, swz = sb ^ (((sb >> 9) & 1) << 5); R = (st >> 1) * 16 + swz / 64; C = (st & 1) * 32 + (swz % 64) / 2; }
__host__ __device__ __forceinline__ int perm32(int rho) { const int n = rho >> 4, i = rho & 15; return 8 * (i >> 2) + 4 * n + (i & 3); }

struct Unit { int pm, pn; };
struct Gemm { const bf16_t* A; const bf16_t* Bt; int M, N, K; };

struct StaticOrder {
    int nM, nN, nwg, G, c;
    __host__ __device__ void init(int M, int N, int G_, int c_) { nM = M / BM; nN = N / BM; nwg = nM * nN; G = G_; c = c_; }
    __host__ __device__ bool next(int i, Unit& u) const {
        const long L = (long)i * G + c; if (L >= nwg) return false;
        int wgid = (int)L; { const int q = nwg / NXCD, r = nwg % NXCD, xcd = wgid % NXCD, off = wgid / NXCD; wgid = (xcd < r ? xcd * (q + 1) : r * (q + 1) + (xcd - r) * q) + off; }
        const int nig = WGM * nN, gid = wgid / nig, fm = gid * WGM, gsz = (nM - fm) < WGM ? (nM - fm) : WGM;
        u.pm = fm + ((wgid % nig) % gsz); u.pn = (wgid % nig) / gsz; return true;
    }
    __device__ __forceinline__ void a_ready(const Unit&) const {}
    __device__ __forceinline__ void done(const Unit&) const {}
};

__device__ __forceinline__ unsigned cvt_pk_bf16(float lo, float hi) { unsigned r; asm volatile("v_cvt_pk_bf16_f32 %0, %1, %2" : "=v"(r) : "v"(lo), "v"(hi)); return r; }
typedef float f32x2 __attribute__((ext_vector_type(2)));
__device__ __forceinline__ f32x2 gelu_pk(f32x2 v) {
    const f32x2 av = __builtin_elementwise_abs(v), d = av * 0.2316418882f + 1.0f;
    f32x2 t; t.x = __builtin_amdgcn_rcpf(d.x); t.y = __builtin_amdgcn_rcpf(d.y);
    f32x2 q = t * 0.5307027145f + (-0.7265760135f); q = q * t + 0.7107068705f; q = q * t + (-0.142248368f); q = q * t + 0.127414796f; q = q * t;
    const f32x2 s = (v * v) * (-0.72134752044f);
    f32x2 e; e.x = __builtin_amdgcn_exp2f(s.x); e.y = __builtin_amdgcn_exp2f(s.y);
    const f32x2 m = v * (q * e), r = v - m;
    f32x2 o; o.x = v.x < 0.f ? m.x : r.x; o.y = v.y < 0.f ? m.y : r.y; return o;
}

template <int ACT  > struct EpiBf16 {
    static constexpr bool PERM = true, AFTER_DRAIN = false; static_assert(ACT == 0 || ACT == 1, "EpiBf16: ACT is 0 (none) or 1 (gelu_pk)");
    bf16_t* O; int ldc; const float* bias; int split_cols; size_t split_stride; float scale0;
    __device__ __forceinline__ void operator()(const f32x4 (&acc)[2][2][4][2], const Unit& u, int wr, int wc, int fr, int fq) const {
        const int row0 = u.pm * BM + wr * 64 + fr; int colt = u.pn * BM; bf16_t* base = O;
        float sc = 1.f; if (split_cols) { const int t = colt / split_cols; base += (size_t)t * split_stride; colt -= t * split_cols; if (t == 0) sc = scale0; }
        const int col0 = colt + wc * 32 + 8 * fq, bcol0 = u.pn * BM + wc * 32 + 8 * fq;
        f32x4 bv[2][2];
#pragma unroll
        for (int bj = 0; bj < 2; ++bj)
#pragma unroll
            for (int n = 0; n < 2; ++n) bv[bj][n] = bias ? *(const f32x4*)(bias + bcol0 + bj * HALF + 4 * n) : (f32x4){0.f, 0.f, 0.f, 0.f};
#pragma unroll
        for (int ai = 0; ai < 2; ++ai)
#pragma unroll
            for (int m = 0; m < 4; ++m) { bf16_t* rowp = base + (size_t)(row0 + ai * HALF + m * 16) * ldc + col0;
#pragma unroll
                for (int bj = 0; bj < 2; ++bj) { f32x4 v0 = acc[ai][bj][m][0] + bv[bj][0], v1 = acc[ai][bj][m][1] + bv[bj][1];
                    if (ACT == 1) { f32x2 a = gelu_pk((f32x2){v0[0], v0[1]}), b = gelu_pk((f32x2){v0[2], v0[3]}), c = gelu_pk((f32x2){v1[0], v1[1]}), d = gelu_pk((f32x2){v1[2], v1[3]});
                        v0 = (f32x4){a.x, a.y, b.x, b.y}; v1 = (f32x4){c.x, c.y, d.x, d.y}; }
                    v0 = v0 * sc; v1 = v1 * sc; u32x4 w; w.x = cvt_pk_bf16(v0[0], v0[1]); w.y = cvt_pk_bf16(v0[2], v0[3]); w.z = cvt_pk_bf16(v1[0], v1[1]); w.w = cvt_pk_bf16(v1[2], v1[3]);
                    *(u32x4*)(rowp + bj * HALF) = w; } }
    }
};

struct PanelStats {
    unsigned* xbuf;
    unsigned* cnt;
    unsigned* tmo;
    int ntn; float eps;
    unsigned code;
    __device__ __forceinline__ bool run(const f32x4 (&v)[2][2][4][2], const Unit& u, int wr, int wc, int fr, int fq, PG8_LAS unsigned char* lds, int wid, int lane) const {
        typedef float f32x2v __attribute__((ext_vector_type(2)));
        PG8_LAS f32x2v* P = (PG8_LAS f32x2v*)lds;
        PG8_LAS f32x2v* S = (PG8_LAS f32x2v*)(lds + 8192);
        PG8_LAS unsigned* flag = (PG8_LAS unsigned*)(lds + 8192 + 2048);
#pragma unroll
        for (int ai = 0; ai < 2; ++ai)
#pragma unroll
            for (int m = 0; m < 4; ++m) {
                float s = 0.f;
#pragma unroll
                for (int bj = 0; bj < 2; ++bj)
#pragma unroll
                    for (int n = 0; n < 2; ++n) { const f32x4 x = v[ai][bj][m][n]; s += (x[0] + x[1]) + (x[2] + x[3]); }
                s += __shfl_xor(s, 16); s += __shfl_xor(s, 32);
                const float mw = s * (1.0f / 64.0f); float q = 0.f;
#pragma unroll
                for (int bj = 0; bj < 2; ++bj)
#pragma unroll
                    for (int n = 0; n < 2; ++n) { const f32x4 d = v[ai][bj][m][n] - mw; q += (d[0] * d[0] + d[1] * d[1]) + (d[2] * d[2] + d[3] * d[3]); }
                q += __shfl_xor(q, 16); q += __shfl_xor(q, 32);
                if (fq == 0) P[(ai * HALF + wr * 64 + m * 16 + fr) * 4 + wc] = (f32x2v){mw, q};
            }
        asm volatile("s_waitcnt lgkmcnt(0)" ::: "memory"); __builtin_amdgcn_s_barrier(); asm volatile("" ::: "memory");
#if defined(BROKEN_EXCHANGE_NO_WAIT)
#warning BROKEN CONTROL BUILD: the row-statistics exchange does not wait; results are wrong by design
        if (blockIdx.x >= 64) { const long long t0_ = clock64(); while (clock64() - t0_ < 60000) __builtin_amdgcn_s_sleep(8); }
#endif
        const int row = wid * 32 + (lane & 31);
        if (lane < 32) {
            const f32x2v a = P[row * 4 + 0], b = P[row * 4 + 1], c = P[row * 4 + 2], d = P[row * 4 + 3];
            const float mt = (a.x + b.x + c.x + d.x) * 0.25f;
            const float da = a.x - mt, db = b.x - mt, dc = c.x - mt, dd = d.x - mt;
            const float m2 = (a.y + b.y) + (c.y + d.y) + 64.0f * ((da * da + db * db) + (dc * dc + dd * dd));
            unsigned long long* slot = (unsigned long long*)xbuf + ((size_t)(u.pm * BM + row) * 4 + u.pn);
            __hip_atomic_store(slot, ((unsigned long long)__float_as_uint(m2) << 32) | __float_as_uint(mt), __ATOMIC_RELAXED, __HIP_MEMORY_SCOPE_AGENT);
        }
        asm volatile("s_waitcnt vmcnt(0)" ::: "memory");
        if (lane == 0) __hip_atomic_fetch_add(cnt + 64 * u.pm, 1u, __ATOMIC_RELAXED, __HIP_MEMORY_SCOPE_AGENT);
        if (wid == 0) {
            bool dead = false; const unsigned long long t0 = __builtin_amdgcn_s_memrealtime(); const unsigned want = 8u * (unsigned)ntn;
            for (;;) {
#if defined(BROKEN_EXCHANGE_NO_WAIT)
                break;
#endif
                if ((unsigned)__builtin_amdgcn_readfirstlane(__hip_atomic_load(cnt + 64 * u.pm, __ATOMIC_RELAXED, __HIP_MEMORY_SCOPE_AGENT)) >= want) break;
                if (__builtin_amdgcn_s_memrealtime() - t0 > 2000000ull) {
                    if (lane == 0) { unsigned expect = 0u; __hip_atomic_compare_exchange_strong(tmo + 1, &expect, code | (unsigned)(u.pm & 0xff), __ATOMIC_RELAXED, __ATOMIC_RELAXED, __HIP_MEMORY_SCOPE_AGENT);
                                     __hip_atomic_store(tmo, 1u, __ATOMIC_RELAXED, __HIP_MEMORY_SCOPE_AGENT); }
                    dead = true; break; }
                __builtin_amdgcn_s_sleep(2);
            }
            __builtin_amdgcn_fence(__ATOMIC_ACQUIRE, "agent");
            if (lane == 0) flag[0] = dead ? 1u : 0u;
        }
        asm volatile("s_waitcnt vmcnt(0) lgkmcnt(0)" ::: "memory"); __builtin_amdgcn_s_barrier(); asm volatile("" ::: "memory");
        const bool bad = flag[0] != 0u;
        if (lane < 32) {
            const unsigned long long* slot = (const unsigned long long*)xbuf + (size_t)(u.pm * BM + row) * 4; float mt[4], m2[4]; float ms = 0.f;
#pragma unroll
            for (int t = 0; t < 4; ++t) { if (t < ntn) { const unsigned long long w = __hip_atomic_load(slot + t, __ATOMIC_RELAXED, __HIP_MEMORY_SCOPE_AGENT); mt[t] = __uint_as_float((unsigned)w); m2[t] = __uint_as_float((unsigned)(w >> 32)); } else { mt[t] = 0.f; m2[t] = 0.f; } ms += mt[t]; }
            const float mean = ms / (float)ntn; float q = 0.f;
#pragma unroll
            for (int t = 0; t < 4; ++t) if (t < ntn) { const float dm = mt[t] - mean; q += m2[t] + 256.0f * dm * dm; }
            S[row] = (f32x2v){mean, 1.0f / sqrtf(q / (256.0f * (float)ntn) + eps)};
        }
        asm volatile("s_waitcnt lgkmcnt(0)" ::: "memory"); __builtin_amdgcn_s_barrier(); asm volatile("" ::: "memory");
        return bad;
    }
};
struct EpiLnRes {
    static constexpr bool PERM = false, AFTER_DRAIN = true;
    const float* base; float* out; int ldc; const float* bias; PanelStats st; unsigned poison;
    __device__ __forceinline__ void fused(f32x4 (&acc)[2][2][4][2], const Unit& u, int wr, int wc, int fr, int fq, PG8_LAS unsigned char* lds, int wid, int lane) const {
        typedef float f32x2v __attribute__((ext_vector_type(2)));
        const PG8_LAS f32x2v* S = (const PG8_LAS f32x2v*)(lds + 8192);
        const int col0 = u.pn * BM + wc * 32 + 4 * fq;
#pragma unroll
        for (int bj = 0; bj < 2; ++bj)
#pragma unroll
            for (int n = 0; n < 2; ++n) { const f32x4 bv = bias ? *(const f32x4*)(bias + col0 + bj * HALF + n * 16) : (f32x4){0.f, 0.f, 0.f, 0.f};
#pragma unroll
                for (int ai = 0; ai < 2; ++ai)
#pragma unroll
                    for (int m = 0; m < 4; ++m) acc[ai][bj][m][n] += bv; }
        f32x4 pre[4][2][2];
#pragma unroll
        for (int m = 0; m < 4; ++m) { const size_t off = (size_t)(u.pm * BM + wr * 64 + m * 16 + fr) * ldc + col0;
#pragma unroll
            for (int bj = 0; bj < 2; ++bj)
#pragma unroll
                for (int n = 0; n < 2; ++n) pre[m][bj][n] = *(const f32x4*)(base + off + bj * HALF + n * 16); }
        const bool bad = st.run(acc, u, wr, wc, fr, fq, lds, wid, lane) || poison != 0u;
        const float qnan = __builtin_nanf("");
#pragma unroll
        for (int ai = 0; ai < 2; ++ai)
#pragma unroll
            for (int m = 0; m < 4; ++m) { const int r = ai * HALF + wr * 64 + m * 16 + fr; const f32x2v sr = S[r]; const size_t off = (size_t)(u.pm * BM + r) * ldc + col0;
#pragma unroll
                for (int bj = 0; bj < 2; ++bj)
#pragma unroll
                    for (int n = 0; n < 2; ++n) { const f32x4 bs = ai == 0 ? pre[m][bj][n] : *(const f32x4*)(base + off + bj * HALF + n * 16); f32x4 o = bs + (acc[ai][bj][m][n] - sr.x) * sr.y;
                        if (bad) o = (f32x4){qnan, qnan, qnan, qnan}; *(f32x4*)(out + off + bj * HALF + n * 16) = o; }
                if (m & 1) asm volatile("" ::: "memory"); }
    }
};
struct EpiLnResLn {
    static constexpr bool PERM = false, AFTER_DRAIN = true;
    const float* base; float* out; bf16_t* xn; int ldc; const float* bias; PanelStats st1, st2; unsigned poison;
    __device__ __forceinline__ void fused(f32x4 (&acc)[2][2][4][2], const Unit& u, int wr, int wc, int fr, int fq, PG8_LAS unsigned char* lds, int wid, int lane) const {
        typedef float f32x2v __attribute__((ext_vector_type(2))); typedef unsigned u32x2v __attribute__((ext_vector_type(2)));
        const PG8_LAS f32x2v* S = (const PG8_LAS f32x2v*)(lds + 8192);
        const int col0 = u.pn * BM + wc * 32 + 4 * fq;
#pragma unroll
        for (int bj = 0; bj < 2; ++bj)
#pragma unroll
            for (int n = 0; n < 2; ++n) { const f32x4 bv = bias ? *(const f32x4*)(bias + col0 + bj * HALF + n * 16) : (f32x4){0.f, 0.f, 0.f, 0.f};
#pragma unroll
                for (int ai = 0; ai < 2; ++ai)
#pragma unroll
                    for (int m = 0; m < 4; ++m) acc[ai][bj][m][n] += bv; }
        bool bad = st1.run(acc, u, wr, wc, fr, fq, lds, wid, lane) || poison != 0u;
        const float qnan = __builtin_nanf("");
#pragma unroll
        for (int ai = 0; ai < 2; ++ai)
#pragma unroll
            for (int m = 0; m < 4; ++m) { const int r = ai * HALF + wr * 64 + m * 16 + fr; const f32x2v sr = S[r]; const size_t off = (size_t)(u.pm * BM + r) * ldc + col0;
#pragma unroll
                for (int bj = 0; bj < 2; ++bj)
#pragma unroll
                    for (int n = 0; n < 2; ++n) { const f32x4 bs = *(const f32x4*)(base + off + bj * HALF + n * 16); acc[ai][bj][m][n] = bs + (acc[ai][bj][m][n] - sr.x) * sr.y; }
                asm volatile("" : "+v"(acc[ai][0][m][0]), "+v"(acc[ai][0][m][1]), "+v"(acc[ai][1][m][0]), "+v"(acc[ai][1][m][1]));
                if (m & 1) asm volatile("" ::: "memory"); }
        const bool bad1 = bad;
        bad = st2.run(acc, u, wr, wc, fr, fq, lds, wid, lane) || bad;
#pragma unroll
        for (int ai = 0; ai < 2; ++ai)
#pragma unroll
            for (int m = 0; m < 4; ++m) { const int r = ai * HALF + wr * 64 + m * 16 + fr; const f32x2v sr = S[r]; const size_t off = (size_t)(u.pm * BM + r) * ldc + col0;
#pragma unroll
                for (int bj = 0; bj < 2; ++bj)
#pragma unroll
                    for (int n = 0; n < 2; ++n) { const f32x4 x1 = acc[ai][bj][m][n]; *(f32x4*)(out + off + bj * HALF + n * 16) = bad1 ? (f32x4){qnan, qnan, qnan, qnan} : x1;
                        const f32x4 o = (x1 - sr.x) * sr.y; u32x2v w; w.x = cvt_pk_bf16(o[0], o[1]); w.y = cvt_pk_bf16(o[2], o[3]);
                        if (bad) { w.x = 0x7fc07fc0u; w.y = 0x7fc07fc0u; } *(u32x2v*)(xn + off + bj * HALF + n * 16) = w; }
                asm volatile("" ::: "memory"); }
    }
};

template <class E, class = void> struct Perm2 { static constexpr bool v = false; };
template <class E> struct Perm2<E, decltype((void)E::PERM2)> { static constexpr bool v = E::PERM2; };
template <class E, class = void> struct MidSeg { static constexpr int v = 0; };
template <class E> struct MidSeg<E, decltype((void)E::MIDSEG)> { static constexpr int v = E::MIDSEG; };
template <class Epi, class Sched, bool ALIGN_EPI = false, bool SP2 = false>
__device__ __forceinline__ void gemm_phase(PG8_LAS unsigned char* lds, const Gemm g, const Sched& S, const Epi& E, int wid_in) {
    int lane_; asm volatile("v_mbcnt_lo_u32_b32 %0, -1, 0\n\tv_mbcnt_hi_u32_b32 %0, -1, %0" : "=v"(lane_));
    const int wid = wid_in, lane = lane_, tid = wid * 64 + lane, wr = wid >> 2, wc = wid & 3, fr = lane & 15, fq = lane >> 4;
    const int K = g.K, nt = K / BK;
    unsigned voffA[2], voffB[2];
#pragma unroll
    for (int i = 0; i < 2; ++i) { int R, C; stage_rc(tid * 16 + i * 8192, R, C); const int Rb = Perm2<Epi>::v ? (64 * (R >> 5) + 16 * ((R >> 2) & 3) + 4 * ((R >> 4) & 1) + (R & 3)) : Epi::PERM ? ((R & ~31) + perm32(R & 31)) : R;
        voffA[i] = (unsigned)(R * K + C) * 2u; voffB[i] = (unsigned)(Rb * K + C) * 2u; }
    const size_t kstep = (size_t)(BK * 2);
    const size_t hstep = (size_t)HALF * K * 2;
    const size_t hstepB = Perm2<Epi>::v ? (size_t)8 * K * 2 : hstep;
    const size_t tstep = 2 * hstep;
    const unsigned ldsw = (unsigned)wid * 1024u;
    const int aoff = lds_byte(wr * 64 + fr, fq * 8), boff = lds_byte(wc * 32 + fr, fq * 8);
#define PG8_SA(b, h) (((b) * 2 + (h)) * HTB)
#define PG8_SB(b, h) ((4 + (b) * 2 + (h)) * HTB)
#define PG8_STAGE(bufoff, gbase, voff) do { _Pragma("unroll") for (int _i = 0; _i < 2; ++_i) \
        __builtin_amdgcn_global_load_lds((const unsigned*)((const char*)(gbase) + (voff)[_i]), (PG8_LAS unsigned*)(lds + (bufoff) + ldsw + _i * 8192), 16, 0, 0); } while (0)
#define PG8_LDA(dst, b, h) do { _Pragma("unroll") for (int m = 0; m < 4; ++m) _Pragma("unroll") for (int k = 0; k < 2; ++k) dst[m][k] = *(const PG8_LAS bf16x8*)(lds + PG8_SA(b, h) + aoff + m * 2048 + k * 1024); } while (0)
#define PG8_LDB(dst, b, h) do { _Pragma("unroll") for (int n = 0; n < 2; ++n) _Pragma("unroll") for (int k = 0; k < 2; ++k) dst[n][k] = *(const PG8_LAS bf16x8*)(lds + PG8_SB(b, h) + boff + n * 2048 + k * 1024); } while (0)
#define PG8_MMA(ai, bj, At, Bt) do { __builtin_amdgcn_s_setprio(1); _Pragma("unroll") for (int m = 0; m < 4; ++m) _Pragma("unroll") for (int n = 0; n < 2; ++n) _Pragma("unroll") for (int k = 0; k < 2; ++k) \
        acc[ai][bj][m][n] = __builtin_amdgcn_mfma_f32_16x16x32_bf16(Bt[n][k], At[m][k], acc[ai][bj][m][n], 0, 0, 0); __builtin_amdgcn_s_setprio(0); } while (0)
#define PG8_WAIT_V(n) asm volatile("s_waitcnt vmcnt(" #n ")" ::: "memory")
#define PG8_WAIT_L(n) asm volatile("s_waitcnt lgkmcnt(" #n ")" ::: "memory")
#define PG8_BAR __builtin_amdgcn_s_barrier()
#define PG8_SCHED __builtin_amdgcn_sched_barrier(0)
    Unit cur, nxt; int ui = 0;
    if (!S.next(0, cur)) return;
    f32x4 acc[2][2][4][2];
#pragma unroll
    for (int a = 0; a < 2; ++a)
#pragma unroll
        for (int b = 0; b < 2; ++b)
#pragma unroll
            for (int m = 0; m < 4; ++m)
#pragma unroll
                for (int n = 0; n < 2; ++n) acc[a][b][m][n] = (f32x4){0.f, 0.f, 0.f, 0.f};
    bf16x8 At[4][2], B0[2][2], B1[2][2];
    const char* cA = (const char*)g.A + (size_t)cur.pm * tstep; const char* cB = (const char*)g.Bt + (size_t)cur.pn * tstep;
    S.a_ready(cur);
    if constexpr (SP2) {
        PG8_STAGE(PG8_SB(0, 0), cB, voffB); PG8_STAGE(PG8_SB(0, 1), cB + hstepB, voffB); PG8_STAGE(PG8_SA(0, 0), cA, voffA); PG8_STAGE(PG8_SA(0, 1), cA + hstep, voffA);
        if (wr == 1) PG8_BAR;
        PG8_WAIT_V(2); PG8_BAR;
        PG8_STAGE(PG8_SB(1, 0), cB + kstep, voffB); PG8_STAGE(PG8_SA(1, 0), cA + kstep, voffA); PG8_STAGE(PG8_SB(1, 1), cB + hstepB + kstep, voffB);
        PG8_WAIT_V(6); PG8_BAR;
    } else {
        PG8_STAGE(PG8_SB(0, 0), cB, voffB); PG8_STAGE(PG8_SA(0, 0), cA, voffA); PG8_STAGE(PG8_SB(0, 1), cB + hstepB, voffB); PG8_STAGE(PG8_SA(0, 1), cA + hstep, voffA);
        if (wr == 1) PG8_BAR;
        PG8_WAIT_V(4); PG8_BAR;
        PG8_STAGE(PG8_SB(1, 0), cB + kstep, voffB); PG8_STAGE(PG8_SA(1, 0), cA + kstep, voffA); PG8_STAGE(PG8_SB(1, 1), cB + hstepB + kstep, voffB);
        PG8_WAIT_V(6); PG8_BAR;
    }
    for (;;) {
        const bool has_next = S.next(ui + 1, nxt);
        const char* nA = has_next ? (const char*)g.A + (size_t)nxt.pm * tstep : cA; const char* nB = has_next ? (const char*)g.Bt + (size_t)nxt.pn * tstep : cB;
        for (int t = 0; t < nt; t += 2) {
            if constexpr (MidSeg<Epi>::v > 0) { if (t > 0 && t % MidSeg<Epi>::v == 0) E.mid(acc, cur, t / MidSeg<Epi>::v, wr, wc, fr, fq); }
            const bool last = (t == nt - 2);
            const char* a1 = cA + (size_t)(t + 1) * kstep;
            const char* a2 = last ? nA : cA + (size_t)(t + 2) * kstep; const char* b2 = last ? nB : cB + (size_t)(t + 2) * kstep;
            const char* a3 = a2 + kstep; const char* b3 = b2 + kstep;
            if (last && has_next) S.a_ready(nxt);
            if constexpr (SP2) {
            PG8_LDB(B0, 0, 0); PG8_LDB(B1, 0, 1); PG8_SCHED; PG8_LDA(At, 0, 0); PG8_STAGE(PG8_SA(1, 1), a1 + hstep, voffA);
            PG8_WAIT_V(8); PG8_WAIT_L(0); PG8_BAR; PG8_MMA(0, 0, At, B0); PG8_MMA(0, 1, At, B1); PG8_BAR; PG8_SCHED;
            PG8_LDA(At, 0, 1); PG8_STAGE(PG8_SB(0, 0), b2, voffB); PG8_STAGE(PG8_SB(0, 1), b2 + hstepB, voffB); PG8_STAGE(PG8_SA(0, 0), a2, voffA);
            PG8_WAIT_V(8); PG8_WAIT_L(0); PG8_BAR; PG8_MMA(1, 0, At, B0); PG8_MMA(1, 1, At, B1); PG8_BAR; PG8_SCHED;
            PG8_LDB(B0, 1, 0); PG8_LDB(B1, 1, 1); PG8_SCHED; PG8_LDA(At, 1, 0); PG8_STAGE(PG8_SA(0, 1), a2 + hstep, voffA);
            PG8_WAIT_V(8); PG8_WAIT_L(0); PG8_BAR; PG8_MMA(0, 0, At, B0); PG8_MMA(0, 1, At, B1); PG8_BAR; PG8_SCHED;
            PG8_LDA(At, 1, 1); PG8_STAGE(PG8_SB(1, 0), b3, voffB); PG8_STAGE(PG8_SB(1, 1), b3 + hstepB, voffB); PG8_STAGE(PG8_SA(1, 0), a3, voffA);
            PG8_WAIT_V(8); PG8_WAIT_L(0); PG8_BAR; PG8_MMA(1, 0, At, B0); PG8_MMA(1, 1, At, B1); PG8_BAR; PG8_SCHED;
            } else {
            PG8_LDB(B0, 0, 0); PG8_SCHED; PG8_LDA(At, 0, 0); PG8_STAGE(PG8_SA(1, 1), a1 + hstep, voffA);
            PG8_WAIT_L(8); PG8_BAR; PG8_WAIT_L(0); PG8_MMA(0, 0, At, B0); PG8_BAR; PG8_SCHED;
            PG8_LDB(B1, 0, 1); PG8_STAGE(PG8_SB(0, 0), b2, voffB);
            PG8_BAR; PG8_WAIT_L(0); PG8_MMA(0, 1, At, B1); PG8_BAR;
            PG8_LDA(At, 0, 1); PG8_STAGE(PG8_SA(0, 0), a2, voffA);
            PG8_BAR; PG8_WAIT_L(0); PG8_MMA(1, 0, At, B0); PG8_BAR; PG8_SCHED;
            PG8_STAGE(PG8_SB(0, 1), b2 + hstepB, voffB);
            PG8_WAIT_V(6); PG8_BAR; PG8_MMA(1, 1, At, B1); PG8_BAR;
            PG8_LDB(B0, 1, 0); PG8_SCHED; PG8_LDA(At, 1, 0); PG8_STAGE(PG8_SA(0, 1), a2 + hstep, voffA);
            PG8_WAIT_L(8); PG8_BAR; PG8_WAIT_L(0); PG8_MMA(0, 0, At, B0); PG8_BAR; PG8_SCHED;
            PG8_LDB(B1, 1, 1); PG8_STAGE(PG8_SB(1, 0), b3, voffB);
            PG8_BAR; PG8_WAIT_L(0); PG8_MMA(0, 1, At, B1); PG8_BAR;
            PG8_LDA(At, 1, 1); PG8_STAGE(PG8_SA(1, 0), a3, voffA);
            PG8_BAR; PG8_WAIT_L(0); PG8_MMA(1, 0, At, B0); PG8_BAR; PG8_SCHED;
            PG8_STAGE(PG8_SB(1, 1), b3 + hstepB, voffB);
            PG8_WAIT_V(6); PG8_BAR; PG8_MMA(1, 1, At, B1); PG8_BAR;
            }
        }
        if constexpr (ALIGN_EPI) { if (wr == 0) PG8_BAR; }
        if constexpr (!Epi::AFTER_DRAIN) { E(acc, cur, wr, wc, fr, fq); S.done(cur); }
        if (!has_next) break;
#pragma unroll
        for (int a = 0; a < 2; ++a)
#pragma unroll
            for (int b = 0; b < 2; ++b)
#pragma unroll
                for (int m = 0; m < 4; ++m)
#pragma unroll
                    for (int n = 0; n < 2; ++n) acc[a][b][m][n] = (f32x4){0.f, 0.f, 0.f, 0.f};
        cur = nxt; cA = nA; cB = nB; ++ui;
        if constexpr (ALIGN_EPI) { if (wr == 1) PG8_BAR; }
    }
    PG8_WAIT_V(0);
    if constexpr (!ALIGN_EPI) { if (wr == 0) PG8_BAR; }
    PG8_BAR;
    if constexpr (Epi::AFTER_DRAIN) { E.fused(acc, cur, wr, wc, fr, fq, lds, wid, lane); S.done(cur); }
#undef PG8_SA
#undef PG8_SB
#undef PG8_STAGE
#undef PG8_LDA
#undef PG8_LDB
#undef PG8_MMA
#undef PG8_WAIT_V
#undef PG8_WAIT_L
#undef PG8_BAR
#undef PG8_SCHED
}
}
namespace pg8 {
struct Gemm8 { const unsigned char* A; const unsigned char* Bt; int M, N, K; int scale_a, scale_b; };
template <class Epi, class Sched, bool ALIGN_EPI = false, bool SP2 = false>
__device__ __forceinline__ void gemm_phase_f8(PG8_LAS unsigned char* lds, const Gemm8 g, const Sched& S, const Epi& E, int wid_in) {
    int lane_; asm volatile("v_mbcnt_lo_u32_b32 %0, -1, 0\n\tv_mbcnt_hi_u32_b32 %0, -1, %0" : "=v"(lane_));
    const int wid = wid_in, lane = lane_, tid = wid * 64 + lane, wr = wid >> 2, wc = wid & 3, fr = lane & 15, fq = lane >> 4;
    const int K = g.K, nt = K / 128;
    unsigned voffA[2], voffB[2];
#pragma unroll
    for (int i = 0; i < 2; ++i) { int R, C; stage_rc(tid * 16 + i * 8192, R, C); const int Rb = Perm2<Epi>::v ? (64 * (R >> 5) + 16 * ((R >> 2) & 3) + 4 * ((R >> 4) & 1) + (R & 3)) : Epi::PERM ? ((R & ~31) + perm32(R & 31)) : R;
        voffA[i] = (unsigned)(R * K + 2 * C); voffB[i] = (unsigned)(Rb * K + 2 * C); }
    const size_t kstep = (size_t)(BK * 2);
    const size_t hstep = (size_t)HALF * K;
    const size_t hstepB = Perm2<Epi>::v ? (size_t)8 * K : hstep;
    const size_t tstep = 2 * hstep;
    const unsigned ldsw = (unsigned)wid * 1024u;
    const int aoff = lds_byte(wr * 64 + fr, fq * 16), boff = lds_byte(wc * 32 + fr, fq * 16);
#define PG8_SA(b, h) (((b) * 2 + (h)) * HTB)
#define PG8_SB(b, h) ((4 + (b) * 2 + (h)) * HTB)
#define PG8_STAGE(bufoff, gbase, voff) do { _Pragma("unroll") for (int _i = 0; _i < 2; ++_i) { unsigned keep_; \
        asm volatile("s_mov_b32 %0, m0\n\ts_mov_b32 m0, %3\n\ts_nop 0\n\tglobal_load_lds_dwordx4 %1, %2\n\ts_mov_b32 m0, %0" : "=&s"(keep_) : "v"((voff)[_i]), "s"((const char*)(gbase)), "s"((unsigned)(size_t)(lds + (bufoff) + ldsw + _i * 8192)) : "memory"); } } while (0)
#define PG8_LDA(dst, b, h) do { _Pragma("unroll") for (int m = 0; m < 4; ++m) { const u32x4 lo_ = *(const PG8_LAS u32x4*)(lds + PG8_SA(b, h) + aoff + m * 2048), hi_ = *(const PG8_LAS u32x4*)(lds + PG8_SA(b, h) + aoff + m * 2048 + 16); dst[m] = __builtin_bit_cast(i32x8, __builtin_shufflevector(lo_, hi_, 0, 1, 2, 3, 4, 5, 6, 7)); } } while (0)
#define PG8_LDB(dst, b, h) do { _Pragma("unroll") for (int n = 0; n < 2; ++n) { const u32x4 lo_ = *(const PG8_LAS u32x4*)(lds + PG8_SB(b, h) + boff + n * 2048), hi_ = *(const PG8_LAS u32x4*)(lds + PG8_SB(b, h) + boff + n * 2048 + 16); dst[n] = __builtin_bit_cast(i32x8, __builtin_shufflevector(lo_, hi_, 0, 1, 2, 3, 4, 5, 6, 7)); } } while (0)
#define PG8_MMA(ai, bj, At, Bt) do { __builtin_amdgcn_s_setprio(1); _Pragma("unroll") for (int m = 0; m < 4; ++m) _Pragma("unroll") for (int n = 0; n < 2; ++n) \
        acc[ai][bj][m][n] = __builtin_amdgcn_mfma_scale_f32_16x16x128_f8f6f4(Bt[n], At[m], acc[ai][bj][m][n], 0, 0, 0, g.scale_b, 0, g.scale_a); __builtin_amdgcn_s_setprio(0); } while (0)
#define PG8_WAIT_V(n) asm volatile("s_waitcnt vmcnt(" #n ")" ::: "memory")
#define PG8_WAIT_L(n) asm volatile("s_waitcnt lgkmcnt(" #n ")" ::: "memory")
#define PG8_BAR __builtin_amdgcn_s_barrier()
#define PG8_SCHED __builtin_amdgcn_sched_barrier(0)
    Unit cur, nxt; int ui = 0;
    if (!S.next(0, cur)) return;
    f32x4 acc[2][2][4][2];
#pragma unroll
    for (int a = 0; a < 2; ++a)
#pragma unroll
        for (int b = 0; b < 2; ++b)
#pragma unroll
            for (int m = 0; m < 4; ++m)
#pragma unroll
                for (int n = 0; n < 2; ++n) acc[a][b][m][n] = (f32x4){0.f, 0.f, 0.f, 0.f};
    typedef int i32x8 __attribute__((ext_vector_type(8))); i32x8 At[4], B0[2], B1[2];
    const char* cA = (const char*)g.A + (size_t)cur.pm * tstep; const char* cB = (const char*)g.Bt + (size_t)cur.pn * tstep;
    S.a_ready(cur);
    if constexpr (SP2) {
        PG8_STAGE(PG8_SB(0, 0), cB, voffB); PG8_STAGE(PG8_SB(0, 1), cB + hstepB, voffB); PG8_STAGE(PG8_SA(0, 0), cA, voffA); PG8_STAGE(PG8_SA(0, 1), cA + hstep, voffA);
        if (wr == 1) PG8_BAR;
        PG8_WAIT_V(2); PG8_BAR;
        PG8_STAGE(PG8_SB(1, 0), cB + kstep, voffB); PG8_STAGE(PG8_SA(1, 0), cA + kstep, voffA); PG8_STAGE(PG8_SB(1, 1), cB + hstepB + kstep, voffB);
        PG8_WAIT_V(6); PG8_BAR;
    } else {
        PG8_STAGE(PG8_SB(0, 0), cB, voffB); PG8_STAGE(PG8_SA(0, 0), cA, voffA); PG8_STAGE(PG8_SB(0, 1), cB + hstepB, voffB); PG8_STAGE(PG8_SA(0, 1), cA + hstep, voffA);
        if (wr == 1) PG8_BAR;
        PG8_WAIT_V(4); PG8_BAR;
        PG8_STAGE(PG8_SB(1, 0), cB + kstep, voffB); PG8_STAGE(PG8_SA(1, 0), cA + kstep, voffA); PG8_STAGE(PG8_SB(1, 1), cB + hstepB + kstep, voffB);
        PG8_WAIT_V(6); PG8_BAR;
    }
    for (;;) {
        const bool has_next = S.next(ui + 1, nxt);
        const char* nA = has_next ? (const char*)g.A + (size_t)nxt.pm * tstep : cA; const char* nB = has_next ? (const char*)g.Bt + (size_t)nxt.pn * tstep : cB;
#pragma unroll 1
        for (int t = 0; t < nt; t += 2) {
            const bool last = (t == nt - 2);
            const char* a1 = cA + (size_t)(t + 1) * kstep;
            const char* a2 = last ? nA : cA + (size_t)(t + 2) * kstep; const char* b2 = last ? nB : cB + (size_t)(t + 2) * kstep;
            const char* a3 = a2 + kstep; const char* b3 = b2 + kstep;
            if (last && has_next) S.a_ready(nxt);
            if constexpr (SP2) {
            PG8_LDB(B0, 0, 0); PG8_LDB(B1, 0, 1); PG8_SCHED; PG8_LDA(At, 0, 0); PG8_STAGE(PG8_SA(1, 1), a1 + hstep, voffA);
            PG8_WAIT_V(8); PG8_WAIT_L(0); PG8_BAR; PG8_MMA(0, 0, At, B0); PG8_MMA(0, 1, At, B1); PG8_BAR; PG8_SCHED;
            PG8_LDA(At, 0, 1); PG8_STAGE(PG8_SB(0, 0), b2, voffB); PG8_STAGE(PG8_SB(0, 1), b2 + hstepB, voffB); PG8_STAGE(PG8_SA(0, 0), a2, voffA);
            PG8_WAIT_V(8); PG8_WAIT_L(0); PG8_BAR; PG8_MMA(1, 0, At, B0); PG8_MMA(1, 1, At, B1); PG8_BAR; PG8_SCHED;
            PG8_LDB(B0, 1, 0); PG8_LDB(B1, 1, 1); PG8_SCHED; PG8_LDA(At, 1, 0); PG8_STAGE(PG8_SA(0, 1), a2 + hstep, voffA);
            PG8_WAIT_V(8); PG8_WAIT_L(0); PG8_BAR; PG8_MMA(0, 0, At, B0); PG8_MMA(0, 1, At, B1); PG8_BAR; PG8_SCHED;
            PG8_LDA(At, 1, 1); PG8_STAGE(PG8_SB(1, 0), b3, voffB); PG8_STAGE(PG8_SB(1, 1), b3 + hstepB, voffB); PG8_STAGE(PG8_SA(1, 0), a3, voffA);
            PG8_WAIT_V(8); PG8_WAIT_L(0); PG8_BAR; PG8_MMA(1, 0, At, B0); PG8_MMA(1, 1, At, B1); PG8_BAR; PG8_SCHED;
            } else {
            PG8_LDB(B0, 0, 0); PG8_SCHED; PG8_LDA(At, 0, 0); PG8_STAGE(PG8_SA(1, 1), a1 + hstep, voffA);
            PG8_WAIT_L(8); PG8_BAR; PG8_WAIT_L(0); PG8_MMA(0, 0, At, B0); PG8_BAR; PG8_SCHED;
            PG8_LDB(B1, 0, 1); PG8_STAGE(PG8_SB(0, 0), b2, voffB);
            PG8_BAR; PG8_WAIT_L(0); PG8_MMA(0, 1, At, B1); PG8_BAR;
            PG8_LDA(At, 0, 1); PG8_STAGE(PG8_SA(0, 0), a2, voffA);
            PG8_BAR; PG8_WAIT_L(0); PG8_MMA(1, 0, At, B0); PG8_BAR; PG8_SCHED;
            PG8_STAGE(PG8_SB(0, 1), b2 + hstepB, voffB);
            PG8_WAIT_V(6); PG8_BAR; PG8_MMA(1, 1, At, B1); PG8_BAR;
            PG8_LDB(B0, 1, 0); PG8_SCHED; PG8_LDA(At, 1, 0); PG8_STAGE(PG8_SA(0, 1), a2 + hstep, voffA);
            PG8_WAIT_L(8); PG8_BAR; PG8_WAIT_L(0); PG8_MMA(0, 0, At, B0); PG8_BAR; PG8_SCHED;
            PG8_LDB(B1, 1, 1); PG8_STAGE(PG8_SB(1, 0), b3, voffB);
            PG8_BAR; PG8_WAIT_L(0); PG8_MMA(0, 1, At, B1); PG8_BAR;
            PG8_LDA(At, 1, 1); PG8_STAGE(PG8_SA(1, 0), a3, voffA);
            PG8_BAR; PG8_WAIT_L(0); PG8_MMA(1, 0, At, B0); PG8_BAR; PG8_SCHED;
            PG8_STAGE(PG8_SB(1, 1), b3 + hstepB, voffB);
            PG8_WAIT_V(6); PG8_BAR; PG8_MMA(1, 1, At, B1); PG8_BAR;
            }
        }
        if constexpr (ALIGN_EPI) { if (wr == 0) PG8_BAR; }
        if constexpr (!Epi::AFTER_DRAIN) { int l2_; asm volatile("v_mbcnt_lo_u32_b32 %0, -1, 0\n\tv_mbcnt_hi_u32_b32 %0, -1, %0" : "=v"(l2_));
            E(acc, cur, wr, wc, l2_ & 15, l2_ >> 4); S.done(cur); }
        if (!has_next) break;
#pragma unroll
        for (int a = 0; a < 2; ++a)
#pragma unroll
            for (int b = 0; b < 2; ++b)
#pragma unroll
                for (int m = 0; m < 4; ++m)
#pragma unroll
                    for (int n = 0; n < 2; ++n) acc[a][b][m][n] = (f32x4){0.f, 0.f, 0.f, 0.f};
        cur = nxt; cA = nA; cB = nB; ++ui;
        if constexpr (ALIGN_EPI) { if (wr == 1) PG8_BAR; }
    }
    PG8_WAIT_V(0);
    if constexpr (!ALIGN_EPI) { if (wr == 0) PG8_BAR; }
    PG8_BAR;
    if constexpr (Epi::AFTER_DRAIN) { E.fused(acc, cur, wr, wc, fr, fq, lds, wid, lane); S.done(cur); }
#undef PG8_SA
#undef PG8_SB
#undef PG8_STAGE
#undef PG8_LDA
#undef PG8_LDB
#undef PG8_MMA
#undef PG8_WAIT_V
#undef PG8_WAIT_L
#undef PG8_BAR
#undef PG8_SCHED
}
}
namespace pg8 {
struct Gemm8G { const unsigned char* A; const unsigned char* Bt; const int* rowtok; int K; int scale_a, scale_b; };
template <class Epi, class Sched, bool ALIGN_EPI = false, bool SP2 = false>
__device__ __forceinline__ void gemm_phase_f8g(PG8_LAS unsigned char* lds, const Gemm8G g, const Sched& S, const Epi& E, int wid_in) {
    int lane_; asm volatile("v_mbcnt_lo_u32_b32 %0, -1, 0\n\tv_mbcnt_hi_u32_b32 %0, -1, %0" : "=v"(lane_));
    const int wid = wid_in, lane = lane_, tid = wid * 64 + lane, wr = wid >> 2, wc = wid & 3, fr = lane & 15, fq = lane >> 4;
    const int K = g.K, nt = K / 128;
    unsigned va[4], voffB0; int R0_, C0_;
    { int R, C; stage_rc(tid * 16, R, C); R0_ = R; C0_ = C; const int Rb = Perm2<Epi>::v ? (64 * (R >> 5) + 16 * ((R >> 2) & 3) + 4 * ((R >> 4) & 1) + (R & 3)) : Epi::PERM ? ((R & ~31) + perm32(R & 31)) : R;
      voffB0 = (unsigned)(Rb * K + 2 * C); }
    const size_t bstep1 = (size_t)(Perm2<Epi>::v ? 128 : 64) * K;
    PG8_LAS unsigned* tab = (PG8_LAS unsigned*)(lds + 135424);
    const size_t kstep = (size_t)(BK * 2);
    const size_t hstep = (size_t)HALF * K;
    const size_t hstepB = Perm2<Epi>::v ? (size_t)8 * K : hstep;
    const size_t tstep = 2 * hstep;
    const unsigned ldsw = (unsigned)wid * 1024u;
    const int aoff = lds_byte(wr * 64 + fr, fq * 16), boff = lds_byte(wc * 32 + fr, fq * 16);
#define PG8_SA(b, h) (((b) * 2 + (h)) * HTB)
#define PG8_SB(b, h) ((4 + (b) * 2 + (h)) * HTB)
#define PG8_GL(vo, sb, ldsaddr) do { unsigned keep_; asm volatile("s_mov_b32 %0, m0\n\ts_mov_b32 m0, %3\n\ts_nop 0\n\tglobal_load_lds_dwordx4 %1, %2\n\ts_mov_b32 m0, %0" : "=&s"(keep_) : "v"(vo), "s"((const char*)(sb)), "s"((unsigned)(size_t)(ldsaddr)) : "memory"); } while (0)
#define PG8_STAGE_B(bufoff, gbase) do { PG8_GL(voffB0, (gbase), lds + (bufoff) + ldsw); PG8_GL(voffB0, (gbase) + bstep1, lds + (bufoff) + ldsw + 8192); } while (0)
#define PG8_STAGE_A(bufoff, kbase, h) do { PG8_GL(va[2 * (h)], (kbase), lds + (bufoff) + ldsw); PG8_GL(va[2 * (h) + 1], (kbase), lds + (bufoff) + ldsw + 8192); } while (0)
#define PG8_LOADVA(slot) do { _Pragma("unroll") for (int h_ = 0; h_ < 2; ++h_) _Pragma("unroll") for (int i_ = 0; i_ < 2; ++i_) va[2 * h_ + i_] = tab[(slot) * 256 + h_ * 128 + R0_ + 64 * i_] * (unsigned)K + 2u * (unsigned)C0_; } while (0)
#define PG8_LDA(dst, b, h) do { _Pragma("unroll") for (int m = 0; m < 4; ++m) { const u32x4 lo_ = *(const PG8_LAS u32x4*)(lds + PG8_SA(b, h) + aoff + m * 2048), hi_ = *(const PG8_LAS u32x4*)(lds + PG8_SA(b, h) + aoff + m * 2048 + 16); dst[m] = __builtin_bit_cast(i32x8, __builtin_shufflevector(lo_, hi_, 0, 1, 2, 3, 4, 5, 6, 7)); } } while (0)
#define PG8_LDB(dst, b, h) do { _Pragma("unroll") for (int n = 0; n < 2; ++n) { const u32x4 lo_ = *(const PG8_LAS u32x4*)(lds + PG8_SB(b, h) + boff + n * 2048), hi_ = *(const PG8_LAS u32x4*)(lds + PG8_SB(b, h) + boff + n * 2048 + 16); dst[n] = __builtin_bit_cast(i32x8, __builtin_shufflevector(lo_, hi_, 0, 1, 2, 3, 4, 5, 6, 7)); } } while (0)
#define PG8_MMA(ai, bj, At, Bt) do { __builtin_amdgcn_s_setprio(1); _Pragma("unroll") for (int m = 0; m < 4; ++m) _Pragma("unroll") for (int n = 0; n < 2; ++n) \
        acc[ai][bj][m][n] = __builtin_amdgcn_mfma_scale_f32_16x16x128_f8f6f4(Bt[n], At[m], acc[ai][bj][m][n], 0, 0, 0, g.scale_b, 0, g.scale_a); __builtin_amdgcn_s_setprio(0); } while (0)
#define PG8_WAIT_V(n) asm volatile("s_waitcnt vmcnt(" #n ")" ::: "memory")
#define PG8_WAIT_L(n) asm volatile("s_waitcnt lgkmcnt(" #n ")" ::: "memory")
#define PG8_BAR __builtin_amdgcn_s_barrier()
#define PG8_SCHED __builtin_amdgcn_sched_barrier(0)
    Unit cur, nxt; int ui = 0;
    if (!S.next(0, cur)) return;
    f32x4 acc[2][2][4][2];
#pragma unroll
    for (int a = 0; a < 2; ++a)
#pragma unroll
        for (int b = 0; b < 2; ++b)
#pragma unroll
            for (int m = 0; m < 4; ++m)
#pragma unroll
                for (int n = 0; n < 2; ++n) acc[a][b][m][n] = (f32x4){0.f, 0.f, 0.f, 0.f};
    typedef int i32x8 __attribute__((ext_vector_type(8))); i32x8 At[4], B0[2], B1[2];
    const char* aB = (const char*)g.A; const char* cB = (const char*)g.Bt + (size_t)cur.pn * tstep;
    S.a_ready(cur);
    { if (tid < 256) {
#pragma unroll 1
        for (int u_ = 0; u_ < 17; ++u_) { Unit t_; if (!S.next(u_, t_)) break; tab[u_ * 256 + tid] = (unsigned)g.rowtok[t_.pm * 256 + tid]; } }
      asm volatile("s_waitcnt vmcnt(0) lgkmcnt(0)" ::: "memory"); PG8_BAR; asm volatile("" ::: "memory");
      PG8_LOADVA(0); }
    if constexpr (SP2) {
        PG8_STAGE_B(PG8_SB(0, 0), cB); PG8_STAGE_B(PG8_SB(0, 1), cB + hstepB); PG8_STAGE_A(PG8_SA(0, 0), aB, 0); PG8_STAGE_A(PG8_SA(0, 1), aB, 1);
        if (wr == 1) PG8_BAR;
        PG8_WAIT_V(2); PG8_BAR;
        PG8_STAGE_B(PG8_SB(1, 0), cB + kstep); PG8_STAGE_A(PG8_SA(1, 0), aB + kstep, 0); PG8_STAGE_B(PG8_SB(1, 1), cB + hstepB + kstep);
        PG8_WAIT_V(6); PG8_BAR;
    } else {
        PG8_STAGE_B(PG8_SB(0, 0), cB); PG8_STAGE_A(PG8_SA(0, 0), aB, 0); PG8_STAGE_B(PG8_SB(0, 1), cB + hstepB); PG8_STAGE_A(PG8_SA(0, 1), aB, 1);
        if (wr == 1) PG8_BAR;
        PG8_WAIT_V(4); PG8_BAR;
        PG8_STAGE_B(PG8_SB(1, 0), cB + kstep); PG8_STAGE_A(PG8_SA(1, 0), aB + kstep, 0); PG8_STAGE_B(PG8_SB(1, 1), cB + hstepB + kstep);
        PG8_WAIT_V(6); PG8_BAR;
    }
    for (;;) {
        const bool has_next = S.next(ui + 1, nxt);
        const char* nB = has_next ? (const char*)g.Bt + (size_t)nxt.pn * tstep : cB;
#pragma unroll 1
        for (int t = 0; t < nt; t += 2) {
            const bool last = (t == nt - 2);
            const char* a1 = aB + (size_t)(t + 1) * kstep;
            const char* a2 = last ? aB : aB + (size_t)(t + 2) * kstep; const char* b2 = last ? nB : cB + (size_t)(t + 2) * kstep;
            const char* a3 = a2 + kstep; const char* b3 = b2 + kstep;
            if (last && has_next) S.a_ready(nxt);
            if constexpr (SP2) {
            PG8_LDB(B0, 0, 0); PG8_LDB(B1, 0, 1); PG8_SCHED; PG8_LDA(At, 0, 0); PG8_STAGE_A(PG8_SA(1, 1), a1, 1); if (last && has_next) PG8_LOADVA(ui + 1);
            PG8_WAIT_V(8); PG8_WAIT_L(0); PG8_BAR; PG8_MMA(0, 0, At, B0); PG8_MMA(0, 1, At, B1); PG8_BAR; PG8_SCHED;
            PG8_LDA(At, 0, 1); PG8_STAGE_B(PG8_SB(0, 0), b2); PG8_STAGE_B(PG8_SB(0, 1), b2 + hstepB); PG8_STAGE_A(PG8_SA(0, 0), a2, 0);
            PG8_WAIT_V(8); PG8_WAIT_L(0); PG8_BAR; PG8_MMA(1, 0, At, B0); PG8_MMA(1, 1, At, B1); PG8_BAR; PG8_SCHED;
            PG8_LDB(B0, 1, 0); PG8_LDB(B1, 1, 1); PG8_SCHED; PG8_LDA(At, 1, 0); PG8_STAGE_A(PG8_SA(0, 1), a2, 1);
            PG8_WAIT_V(8); PG8_WAIT_L(0); PG8_BAR; PG8_MMA(0, 0, At, B0); PG8_MMA(0, 1, At, B1); PG8_BAR; PG8_SCHED;
            PG8_LDA(At, 1, 1); PG8_STAGE_B(PG8_SB(1, 0), b3); PG8_STAGE_B(PG8_SB(1, 1), b3 + hstepB); PG8_STAGE_A(PG8_SA(1, 0), a3, 0);
            PG8_WAIT_V(8); PG8_WAIT_L(0); PG8_BAR; PG8_MMA(1, 0, At, B0); PG8_MMA(1, 1, At, B1); PG8_BAR; PG8_SCHED;
            } else {
            PG8_LDB(B0, 0, 0); PG8_SCHED; PG8_LDA(At, 0, 0); PG8_STAGE_A(PG8_SA(1, 1), a1, 1); if (last && has_next) PG8_LOADVA(ui + 1);
            PG8_WAIT_L(8); PG8_BAR; PG8_WAIT_L(0); PG8_MMA(0, 0, At, B0); PG8_BAR; PG8_SCHED;
            PG8_LDB(B1, 0, 1); PG8_STAGE_B(PG8_SB(0, 0), b2);
            PG8_BAR; PG8_WAIT_L(0); PG8_MMA(0, 1, At, B1); PG8_BAR;
            PG8_LDA(At, 0, 1); PG8_STAGE_A(PG8_SA(0, 0), a2, 0);
            PG8_BAR; PG8_WAIT_L(0); PG8_MMA(1, 0, At, B0); PG8_BAR; PG8_SCHED;
            PG8_STAGE_B(PG8_SB(0, 1), b2 + hstepB);
            PG8_WAIT_V(6); PG8_BAR; PG8_MMA(1, 1, At, B1); PG8_BAR;
            PG8_LDB(B0, 1, 0); PG8_SCHED; PG8_LDA(At, 1, 0); PG8_STAGE_A(PG8_SA(0, 1), a2, 1);
            PG8_WAIT_L(8); PG8_BAR; PG8_WAIT_L(0); PG8_MMA(0, 0, At, B0); PG8_BAR; PG8_SCHED;
            PG8_LDB(B1, 1, 1); PG8_STAGE_B(PG8_SB(1, 0), b3);
            PG8_BAR; PG8_WAIT_L(0); PG8_MMA(0, 1, At, B1); PG8_BAR;
            PG8_LDA(At, 1, 1); PG8_STAGE_A(PG8_SA(1, 0), a3, 0);
            PG8_BAR; PG8_WAIT_L(0); PG8_MMA(1, 0, At, B0); PG8_BAR; PG8_SCHED;
            PG8_STAGE_B(PG8_SB(1, 1), b3 + hstepB);
            PG8_WAIT_V(6); PG8_BAR; PG8_MMA(1, 1, At, B1); PG8_BAR;
            }
        }
        if constexpr (ALIGN_EPI) { if (wr == 0) PG8_BAR; }
        if constexpr (!Epi::AFTER_DRAIN) { int l2_; asm volatile("v_mbcnt_lo_u32_b32 %0, -1, 0\n\tv_mbcnt_hi_u32_b32 %0, -1, %0" : "=v"(l2_));
            E(acc, cur, wr, wc, l2_ & 15, l2_ >> 4); S.done(cur); }
        if (!has_next) break;
#pragma unroll
        for (int a = 0; a < 2; ++a)
#pragma unroll
            for (int b = 0; b < 2; ++b)
#pragma unroll
                for (int m = 0; m < 4; ++m)
#pragma unroll
                    for (int n = 0; n < 2; ++n) acc[a][b][m][n] = (f32x4){0.f, 0.f, 0.f, 0.f};
        cur = nxt; cB = nB; ++ui;
        if constexpr (ALIGN_EPI) { if (wr == 1) PG8_BAR; }
    }
    PG8_WAIT_V(0);
    if constexpr (!ALIGN_EPI) { if (wr == 0) PG8_BAR; }
    PG8_BAR;
    if constexpr (Epi::AFTER_DRAIN) { E.fused(acc, cur, wr, wc, fr, fq, lds, wid, lane); S.done(cur); }
#undef PG8_SA
#undef PG8_SB
#undef PG8_GL
#undef PG8_STAGE_A
#undef PG8_STAGE_B
#undef PG8_LOADVA
#undef PG8_LDA
#undef PG8_LDB
#undef PG8_MMA
#undef PG8_WAIT_V
#undef PG8_WAIT_L
#undef PG8_BAR
#undef PG8_SCHED
}
}
namespace pg8 {
struct GemmA { const bf16_t* A; const bf16_t* Bt; int K; int rowA; size_t kstepA, hstepA, tstepA; };
template <class Epi, class Sched, bool ALIGN_EPI = false, bool SP2 = false>
__device__ __forceinline__ void gemm_phase_ga(PG8_LAS unsigned char* lds, const GemmA g, const Sched& S, const Epi& E, int wid_in) {
    int lane_; asm volatile("v_mbcnt_lo_u32_b32 %0, -1, 0\n\tv_mbcnt_hi_u32_b32 %0, -1, %0" : "=v"(lane_));
    const int wid = wid_in, lane = lane_, tid = wid * 64 + lane, wr = wid >> 2, wc = wid & 3, fr = lane & 15, fq = lane >> 4;
    const int K = g.K, nt = K / BK;
    unsigned voffA[2], voffB[2];
#pragma unroll
    for (int i = 0; i < 2; ++i) { int R, C; stage_rc(tid * 16 + i * 8192, R, C); const int Rb = Perm2<Epi>::v ? (64 * (R >> 5) + 16 * ((R >> 2) & 3) + 4 * ((R >> 4) & 1) + (R & 3)) : Epi::PERM ? ((R & ~31) + perm32(R & 31)) : R;
        voffA[i] = (unsigned)(R * g.rowA + C * 2); voffB[i] = (unsigned)(Rb * K + C) * 2u; }
    const size_t kstep = (size_t)(BK * 2);
    const size_t hstep = (size_t)HALF * K * 2;
    const size_t kstepA = g.kstepA, hstepA = g.hstepA, tstepA = g.tstepA;
    const size_t hstepB = Perm2<Epi>::v ? (size_t)8 * K * 2 : hstep;
    const size_t tstep = 2 * hstep;
    const unsigned ldsw = (unsigned)wid * 1024u;
    const int aoff = lds_byte(wr * 64 + fr, fq * 8), boff = lds_byte(wc * 32 + fr, fq * 8);
#define PG8_SA(b, h) (((b) * 2 + (h)) * HTB)
#define PG8_SB(b, h) ((4 + (b) * 2 + (h)) * HTB)
#define PG8_STAGE(bufoff, gbase, voff) do { _Pragma("unroll") for (int _i = 0; _i < 2; ++_i) \
        __builtin_amdgcn_global_load_lds((const unsigned*)((const char*)(gbase) + (voff)[_i]), (PG8_LAS unsigned*)(lds + (bufoff) + ldsw + _i * 8192), 16, 0, 0); } while (0)
#define PG8_LDA(dst, b, h) do { _Pragma("unroll") for (int m = 0; m < 4; ++m) _Pragma("unroll") for (int k = 0; k < 2; ++k) dst[m][k] = *(const PG8_LAS bf16x8*)(lds + PG8_SA(b, h) + aoff + m * 2048 + k * 1024); } while (0)
#define PG8_LDB(dst, b, h) do { _Pragma("unroll") for (int n = 0; n < 2; ++n) _Pragma("unroll") for (int k = 0; k < 2; ++k) dst[n][k] = *(const PG8_LAS bf16x8*)(lds + PG8_SB(b, h) + boff + n * 2048 + k * 1024); } while (0)
#define PG8_MMA(ai, bj, At, Bt) do { __builtin_amdgcn_s_setprio(1); _Pragma("unroll") for (int m = 0; m < 4; ++m) _Pragma("unroll") for (int n = 0; n < 2; ++n) _Pragma("unroll") for (int k = 0; k < 2; ++k) \
        acc[ai][bj][m][n] = __builtin_amdgcn_mfma_f32_16x16x32_bf16(Bt[n][k], At[m][k], acc[ai][bj][m][n], 0, 0, 0); __builtin_amdgcn_s_setprio(0); } while (0)
#define PG8_WAIT_V(n) asm volatile("s_waitcnt vmcnt(" #n ")" ::: "memory")
#define PG8_WAIT_L(n) asm volatile("s_waitcnt lgkmcnt(" #n ")" ::: "memory")
#define PG8_BAR __builtin_amdgcn_s_barrier()
#define PG8_SCHED __builtin_amdgcn_sched_barrier(0)
    Unit cur, nxt; int ui = 0;
    if (!S.next(0, cur)) return;
    f32x4 acc[2][2][4][2];
#pragma unroll
    for (int a = 0; a < 2; ++a)
#pragma unroll
        for (int b = 0; b < 2; ++b)
#pragma unroll
            for (int m = 0; m < 4; ++m)
#pragma unroll
                for (int n = 0; n < 2; ++n) acc[a][b][m][n] = (f32x4){0.f, 0.f, 0.f, 0.f};
    bf16x8 At[4][2], B0[2][2], B1[2][2];
    const char* cA = (const char*)g.A + (size_t)cur.pm * tstepA; const char* cB = (const char*)g.Bt + (size_t)cur.pn * tstep;
    S.a_ready(cur);
    if constexpr (SP2) {
        PG8_STAGE(PG8_SB(0, 0), cB, voffB); PG8_STAGE(PG8_SB(0, 1), cB + hstepB, voffB); PG8_STAGE(PG8_SA(0, 0), cA, voffA); PG8_STAGE(PG8_SA(0, 1), cA + hstepA, voffA);
        if (wr == 1) PG8_BAR;
        PG8_WAIT_V(2); PG8_BAR;
        PG8_STAGE(PG8_SB(1, 0), cB + kstep, voffB); PG8_STAGE(PG8_SA(1, 0), cA + kstepA, voffA); PG8_STAGE(PG8_SB(1, 1), cB + hstepB + kstep, voffB);
        PG8_WAIT_V(6); PG8_BAR;
    } else {
        PG8_STAGE(PG8_SB(0, 0), cB, voffB); PG8_STAGE(PG8_SA(0, 0), cA, voffA); PG8_STAGE(PG8_SB(0, 1), cB + hstepB, voffB); PG8_STAGE(PG8_SA(0, 1), cA + hstepA, voffA);
        if (wr == 1) PG8_BAR;
        PG8_WAIT_V(4); PG8_BAR;
        PG8_STAGE(PG8_SB(1, 0), cB + kstep, voffB); PG8_STAGE(PG8_SA(1, 0), cA + kstepA, voffA); PG8_STAGE(PG8_SB(1, 1), cB + hstepB + kstep, voffB);
        PG8_WAIT_V(6); PG8_BAR;
    }
    for (;;) {
        const bool has_next = S.next(ui + 1, nxt);
        const char* nA = has_next ? (const char*)g.A + (size_t)nxt.pm * tstepA : cA; const char* nB = has_next ? (const char*)g.Bt + (size_t)nxt.pn * tstep : cB;
        for (int t = 0; t < nt; t += 2) {
            if constexpr (MidSeg<Epi>::v > 0) { if (t > 0 && t % MidSeg<Epi>::v == 0) E.mid(acc, cur, t / MidSeg<Epi>::v, wr, wc, fr, fq); }
            const bool last = (t == nt - 2);
            const char* a1 = cA + (size_t)(t + 1) * kstepA;
            const char* a2 = last ? nA : cA + (size_t)(t + 2) * kstepA; const char* b2 = last ? nB : cB + (size_t)(t + 2) * kstep;
            const char* a3 = a2 + kstepA; const char* b3 = b2 + kstep;
            if (last && has_next) S.a_ready(nxt);
            if constexpr (SP2) {
            PG8_LDB(B0, 0, 0); PG8_LDB(B1, 0, 1); PG8_SCHED; PG8_LDA(At, 0, 0); PG8_STAGE(PG8_SA(1, 1), a1 + hstepA, voffA);
            PG8_WAIT_V(8); PG8_WAIT_L(0); PG8_BAR; PG8_MMA(0, 0, At, B0); PG8_MMA(0, 1, At, B1); PG8_BAR; PG8_SCHED;
            PG8_LDA(At, 0, 1); PG8_STAGE(PG8_SB(0, 0), b2, voffB); PG8_STAGE(PG8_SB(0, 1), b2 + hstepB, voffB); PG8_STAGE(PG8_SA(0, 0), a2, voffA);
            PG8_WAIT_V(8); PG8_WAIT_L(0); PG8_BAR; PG8_MMA(1, 0, At, B0); PG8_MMA(1, 1, At, B1); PG8_BAR; PG8_SCHED;
            PG8_LDB(B0, 1, 0); PG8_LDB(B1, 1, 1); PG8_SCHED; PG8_LDA(At, 1, 0); PG8_STAGE(PG8_SA(0, 1), a2 + hstepA, voffA);
            PG8_WAIT_V(8); PG8_WAIT_L(0); PG8_BAR; PG8_MMA(0, 0, At, B0); PG8_MMA(0, 1, At, B1); PG8_BAR; PG8_SCHED;
            PG8_LDA(At, 1, 1); PG8_STAGE(PG8_SB(1, 0), b3, voffB); PG8_STAGE(PG8_SB(1, 1), b3 + hstepB, voffB); PG8_STAGE(PG8_SA(1, 0), a3, voffA);
            PG8_WAIT_V(8); PG8_WAIT_L(0); PG8_BAR; PG8_MMA(1, 0, At, B0); PG8_MMA(1, 1, At, B1); PG8_BAR; PG8_SCHED;
            } else {
            PG8_LDB(B0, 0, 0); PG8_SCHED; PG8_LDA(At, 0, 0); PG8_STAGE(PG8_SA(1, 1), a1 + hstepA, voffA);
            PG8_WAIT_L(8); PG8_BAR; PG8_WAIT_L(0); PG8_MMA(0, 0, At, B0); PG8_BAR; PG8_SCHED;
            PG8_LDB(B1, 0, 1); PG8_STAGE(PG8_SB(0, 0), b2, voffB);
            PG8_BAR; PG8_WAIT_L(0); PG8_MMA(0, 1, At, B1); PG8_BAR;
            PG8_LDA(At, 0, 1); PG8_STAGE(PG8_SA(0, 0), a2, voffA);
            PG8_BAR; PG8_WAIT_L(0); PG8_MMA(1, 0, At, B0); PG8_BAR; PG8_SCHED;
            PG8_STAGE(PG8_SB(0, 1), b2 + hstepB, voffB);
            PG8_WAIT_V(6); PG8_BAR; PG8_MMA(1, 1, At, B1); PG8_BAR;
            PG8_LDB(B0, 1, 0); PG8_SCHED; PG8_LDA(At, 1, 0); PG8_STAGE(PG8_SA(0, 1), a2 + hstepA, voffA);
            PG8_WAIT_L(8); PG8_BAR; PG8_WAIT_L(0); PG8_MMA(0, 0, At, B0); PG8_BAR; PG8_SCHED;
            PG8_LDB(B1, 1, 1); PG8_STAGE(PG8_SB(1, 0), b3, voffB);
            PG8_BAR; PG8_WAIT_L(0); PG8_MMA(0, 1, At, B1); PG8_BAR;
            PG8_LDA(At, 1, 1); PG8_STAGE(PG8_SA(1, 0), a3, voffA);
            PG8_BAR; PG8_WAIT_L(0); PG8_MMA(1, 0, At, B0); PG8_BAR; PG8_SCHED;
            PG8_STAGE(PG8_SB(1, 1), b3 + hstepB, voffB);
            PG8_WAIT_V(6); PG8_BAR; PG8_MMA(1, 1, At, B1); PG8_BAR;
            }
        }
        if constexpr (ALIGN_EPI) { if (wr == 0) PG8_BAR; }
        if constexpr (!Epi::AFTER_DRAIN) { E(acc, cur, wr, wc, fr, fq); S.done(cur); }
        if (!has_next) break;
#pragma unroll
        for (int a = 0; a < 2; ++a)
#pragma unroll
            for (int b = 0; b < 2; ++b)
#pragma unroll
                for (int m = 0; m < 4; ++m)
#pragma unroll
                    for (int n = 0; n < 2; ++n) acc[a][b][m][n] = (f32x4){0.f, 0.f, 0.f, 0.f};
        cur = nxt; cA = nA; cB = nB; ++ui;
        if constexpr (ALIGN_EPI) { if (wr == 1) PG8_BAR; }
    }
    PG8_WAIT_V(0);
    if constexpr (!ALIGN_EPI) { if (wr == 0) PG8_BAR; }
    PG8_BAR;
    if constexpr (Epi::AFTER_DRAIN) { E.fused(acc, cur, wr, wc, fr, fq, lds, wid, lane); S.done(cur); }
#undef PG8_SA
#undef PG8_SB
#undef PG8_STAGE
#undef PG8_LDA
#undef PG8_LDB
#undef PG8_MMA
#undef PG8_WAIT_V
#undef PG8_WAIT_L
#undef PG8_BAR
#undef PG8_SCHED
}
}
#define GAS __attribute__((address_space(1)))
#define LAS __attribute__((address_space(3)))
typedef unsigned short bf16;
typedef unsigned v4u __attribute__((ext_vector_type(4)));
typedef float f32x4 __attribute__((ext_vector_type(4)));
typedef short bf16x8 __attribute__((ext_vector_type(8)));
typedef GAS unsigned gu32;
typedef GAS unsigned long long gu64;
#define RLX_AGENT __ATOMIC_RELAXED, __HIP_MEMORY_SCOPE_AGENT
#define LDS_WAIT() asm volatile("s_waitcnt lgkmcnt(0)" ::: "memory")
#define VM_WAIT() asm volatile("s_waitcnt vmcnt(0)" ::: "memory")
__device__ __forceinline__ unsigned long long rt() { return __builtin_amdgcn_s_memrealtime(); }
__device__ __forceinline__ unsigned f2bf(float f) { unsigned u = __builtin_bit_cast(unsigned, f); return (u + 0x7fffu + ((u >> 16) & 1u)) >> 16; }
__device__ __forceinline__ unsigned pk2(float lo, float hi) { return f2bf(lo) | (f2bf(hi) << 16); }

#define XB_TMO      128
#define XB_XCNT(j)  (256  + 64 * (j))
#define XB_XSUB(j)  (1280 + 64 * (j))
#define XB_XGEN(j)  (2304 + 64 * (j))
#define XB_TOP      3328
#define XB_TOPGEN   3392
#define XCD_BAR_WORDS 3456
#define XB_SPIN_CAP (1u << 18)

__device__ __forceinline__ unsigned xb_ld(unsigned* p)              { return __hip_atomic_load(p, __ATOMIC_RELAXED, __HIP_MEMORY_SCOPE_AGENT); }
__device__ __forceinline__ unsigned xb_add(unsigned* p, unsigned v) { return __hip_atomic_fetch_add(p, v, __ATOMIC_RELAXED, __HIP_MEMORY_SCOPE_AGENT); }
__device__ __forceinline__ unsigned xb_xcc_id() { return (unsigned)__builtin_amdgcn_s_getreg((3 << 11) | 20) & 0xFu; }
#define XB_SPIN(cond, bar) do { unsigned _sp = 0; while (cond) { __builtin_amdgcn_s_sleep(1); \
    if ((++_sp & 255u) == 0u) { if (xb_ld(&(bar)[XB_TMO])) break; if (_sp > XB_SPIN_CAP) { atomicAdd(&(bar)[XB_TMO], 1u); break; } } } } while (0)

struct XcdBarrier {
    int wv;
    unsigned* bar; unsigned x;
    volatile LAS unsigned* st;
};

__device__ __forceinline__ int xb_lane_id() { int l; asm volatile("v_mbcnt_lo_u32_b32 %0, -1, 0\n\tv_mbcnt_hi_u32_b32 %0, -1, %0" : "=v"(l)); return l; }
__device__ __forceinline__ XcdBarrier xcd_barrier_post(unsigned* bar, volatile LAS unsigned* st, int wv) {
    XcdBarrier b; b.wv = wv; b.bar = bar; b.x = xb_xcc_id(); b.st = st;
    if (wv == 0 && xb_lane_id() == 0) (void)xb_add(&bar[XB_XCNT(b.x)], 1u);
    return b;
}
__device__ __forceinline__ void xcd_barrier_complete(unsigned* bar, unsigned x, unsigned& nloc, unsigned& nx) {
    const unsigned G = gridDim.x * gridDim.y * gridDim.z;
    unsigned sum, cnt, mine, sp = 0u;
    for (;;) {
        sum = 0u; cnt = 0u; mine = 0u;
#pragma unroll
        for (unsigned j = 0; j < 16; ++j) { const unsigned c = xb_ld(&bar[XB_XCNT(j)]); sum += c; cnt += (c > 0u) ? 1u : 0u; mine = (j == x) ? c : mine; }
        if (sum == G) break;
        __builtin_amdgcn_s_sleep(1);
        if ((++sp & 255u) == 0u) { if (xb_ld(&bar[XB_TMO])) break; if (sp > XB_SPIN_CAP) { atomicAdd(&bar[XB_TMO], 1u); break; } }
    }
    nloc = mine > 0u ? mine : 1u; nx = cnt > 0u ? cnt : 1u;
}

__device__ __forceinline__ void xcd_barrier(const XcdBarrier& b) {
    asm volatile("s_waitcnt vmcnt(0)" ::: "memory");
    __syncthreads();
    if (b.wv == 0 && xb_lane_id() == 0) {
        unsigned* bar = b.bar;
        __builtin_amdgcn_s_waitcnt(0);
        unsigned nloc = b.st[0], nx = b.st[1];
        if (nloc == 0u) { xcd_barrier_complete(bar, b.x, nloc, nx); b.st[0] = nloc; b.st[1] = nx; }
        const unsigned old = xb_add(&bar[XB_XSUB(b.x)], 1u);
        const unsigned gen = old / nloc;
        if (old + 1u == (gen + 1u) * nloc) {
            __builtin_amdgcn_fence(__ATOMIC_RELEASE, "agent");
            asm volatile("s_waitcnt vmcnt(0)" ::: "memory");
            const unsigned og = xb_add(&bar[XB_TOP], 1u);
            const unsigned tg = og / nx;
            if (og + 1u == (tg + 1u) * nx) xb_add(&bar[XB_TOPGEN], 1u);
            else XB_SPIN(xb_ld(&bar[XB_TOPGEN]) == tg, bar);
            __builtin_amdgcn_fence(__ATOMIC_ACQUIRE, "agent");
            xb_add(&bar[XB_XGEN(b.x)], 1u);
            asm volatile("s_waitcnt vmcnt(0)" ::: "memory");
        } else {
            XB_SPIN(xb_ld(&bar[XB_XGEN(b.x)]) == gen, bar);
            __builtin_amdgcn_fence(__ATOMIC_ACQUIRE, "agent");
            asm volatile("s_waitcnt vmcnt(0)" ::: "memory");
        }
    }
    __syncthreads();
}
#define DI __device__ __forceinline__
constexpr int NWAVES = 8;
constexpr int NB = 16, SEQ = 2048, DM = 1024, MT = NB * SEQ;
constexpr int DIN_SRC = 6944, NPROJ = 7168;
constexpr int MEML = 256, MROWS = NB * MEML;
constexpr int NEXP = 32, TOPK = 4, DFF = 1024, MOEB = 256;
constexpr int NROWS = MT * TOPK;
constexpr int NBLK_MAX = (NROWS + NEXP * (MOEB - 1) + MOEB - 1) / MOEB;
constexpr int CAP = NBLK_MAX * MOEB;
constexpr float EPS = 1e-6f;
constexpr float NEGF = -1e30f;
constexpr int NB16 = 3584, NF8 = NPROJ - NB16;
constexpr int PC_MLQ = 0, PC_MLK = 512, PC_NQ = 1024, PC_NKC = 1536, PC_NKS = 1664, PC_NKW = 1792, PC_MQ = 1920, PC_MLI = 2432, PC_MLF = 2436, PC_NG = 2440,
              PC_MLV = 2560, PC_NVC = 3072, PC_NVS = 3200, PC_NVW = 3328, PC_MLO = 3584, PC_BRG = 4096;
__host__ __device__ constexpr int proj_srccol(int j) {
    return j < 1024 ? j : j < 1536 ? 2056 + (j - 1024) : j < 1664 ? 2568 + (j - 1536) : j < 1792 ? 2824 + (j - 1664) : j < 1920 ? 3080 + (j - 1792) : j < 2432 ? 3360 + (j - 1920)
         : j < 2440 ? 2048 + (j - 2432) : j < 2464 ? 3336 + (j - 2440) : j < 2560 ? -1
         : j < 3072 ? 1024 + (j - 2560) : j < 3200 ? 2696 + (j - 3072) : j < 3328 ? 2952 + (j - 3200) : j < 3456 ? 3208 + (j - 3328) : j < 3584 ? -1
         : j < 4096 ? 1536 + (j - 3584) : 3872 + (j - 4096);
}

constexpr size_t MiB = 1u << 20;
constexpr size_t WS_CTL = 0, CTL_ZERO_BYTES = 1 * MiB;
constexpr size_t WS_WIN = 1 * MiB, WS_WGU = 15 * MiB, WS_WDN = 143 * MiB, WS_WMKV = 207 * MiB, WS_WBR = 209 * MiB, WS_WOUT = 212 * MiB, WS_WC1 = 214 * MiB;
constexpr size_t WS_WIN8 = WS_WIN + 8 * MiB;
constexpr size_t WS_SMALL = 216 * MiB;
constexpr size_t WS_R1 = 218 * MiB;
constexpr size_t WS_PROJ = 282 * MiB;
constexpr size_t WS_R3 = 730 * MiB;
constexpr size_t WS_MEMKV = WS_R3, WS_MEMKN = WS_R3 + 8 * MiB, WS_QN = WS_R3 + 12 * MiB, WS_KSN = WS_R3 + 44 * MiB, WS_KWN = WS_R3 + 52 * MiB,
                 WS_MQN = WS_R3 + 60 * MiB, WS_MLQK = WS_R3 + 92 * MiB, WS_HID = WS_R3 + 156 * MiB, WS_KC = WS_R3 + 160 * MiB, WS_VC = WS_KC + MiB / 2,
                 WS_H0 = WS_R3 + 161 * MiB, WS_H1 = WS_H0 + 32 * MiB, WS_H2 = WS_H1 + 32 * MiB, WS_ROUTE = WS_H2 + 32 * MiB, WS_END = WS_ROUTE + 6 * MiB;
constexpr size_t WS_MLV = WS_R1, WS_VSN = WS_R1 + 32 * MiB, WS_VWN = WS_R1 + 40 * MiB;
constexpr size_t WS_U8 = WS_H2;
constexpr size_t WS_MEMN = WS_H0;
constexpr size_t WS_ACMP = WS_H1;
constexpr size_t WS_APERM = WS_PROJ;
constexpr size_t WS_ACT = WS_PROJ + 272 * MiB;
static_assert(WS_ACT + 272 * MiB <= WS_H0 + 96 * MiB && WS_END <= 1024 * MiB, "ws map");
constexpr size_t SM_ROPEC = 0, SM_ROPES = 256 * 1024, SM_CBIAS = 512 * 1024, SM_WRT = 1024 * 1024, SM_W2T = 1024 * 1024 + 256 * 1024;
constexpr size_t RT_TOKE = 0, RT_TOKPOS = 512 * 1024, RT_TOKW = 1024 * 1024, RT_TOKDEST = 1536 * 1024, RT_ROWW = 2048 * 1024, RT_ROWTOK = 3072 * 1024;
constexpr int CW_BAR = 4096;
constexpr int CW_ECNT = 16384;
constexpr int CW_QCTR = 16384 + 64;

constexpr int RING_BYTES = 131072, LDSCTL_OFF = RING_BYTES, MISC_OFF = LDSCTL_OFF + 320, LDS_BYTES = 155648;

struct Args { const float* in[34]; float* out; unsigned char* ws; int ph_lo, ph_hi, li, pad; };

DI float bf2f(unsigned short h) { return __uint_as_float((unsigned)h << 16); }
DI float wave_sum(float v) {
#pragma unroll
    for (int o = 1; o < 64; o <<= 1) v += __shfl_xor(v, o);
    return v;
}
DI float wave_max(float v) {
#pragma unroll
    for (int o = 1; o < 64; o <<= 1) v = fmaxf(v, __shfl_xor(v, o));
    return v;
}
DI float sigm(float x) { return __builtin_amdgcn_rcpf(1.f + __expf(-x)); }
DI float logsig(float x) { return fminf(x, 0.f) - log1pf(__expf(-fabsf(x))); }

namespace pg8 {
struct EpiBf16Silu {
    static constexpr bool PERM = true, AFTER_DRAIN = false, PERM2 = true;
    bf16_t* O; int ldc; const float* bias; int silu;
    DI void operator()(const f32x4 (&acc)[2][2][4][2], const Unit& u, int wr, int wc, int fr, int fq) const {
        const int row0 = u.pm * BM + wr * 64 + fr; const int col0 = u.pn * BM + wc * 64 + 16 * fq;
#pragma unroll
        for (int ai = 0; ai < 2; ++ai)
#pragma unroll
            for (int m = 0; m < 4; ++m) { bf16_t* rowp = O + (size_t)(row0 + ai * HALF + m * 16) * ldc + col0;
#pragma unroll
                for (int bj = 0; bj < 2; ++bj) { f32x4 v0 = acc[ai][bj][m][0], v1 = acc[ai][bj][m][1];
                    if (bias) { v0 += *(const f32x4*)(bias + col0 + 8 * bj); v1 += *(const f32x4*)(bias + col0 + 8 * bj + 4); }
                    if (silu) {
#pragma unroll
                        for (int j = 0; j < 4; ++j) { v0[j] = v0[j] * __builtin_amdgcn_rcpf(1.f + __expf(-v0[j])); v1[j] = v1[j] * __builtin_amdgcn_rcpf(1.f + __expf(-v1[j])); } }
                    u32x4 w; w.x = cvt_pk_bf16(v0[0], v0[1]); w.y = cvt_pk_bf16(v0[2], v0[3]); w.z = cvt_pk_bf16(v1[0], v1[1]); w.w = cvt_pk_bf16(v1[2], v1[3]);
                    *(u32x4*)(rowp + 8 * bj) = w; } }
    }
};
template <int B> struct EpiGate {
    static constexpr bool PERM = false, AFTER_DRAIN = false;
    const bf16_t* proj; float* tmp; bf16_t* merged;
    DI void operator()(const f32x4 (&acc)[2][2][4][2], const Unit& u, int wr, int wc, int fr, int fq) const {
        typedef unsigned u32x2v __attribute__((ext_vector_type(2)));
        const int col0 = u.pn * BM + wc * 32 + 4 * fq;
#pragma unroll
        for (int ai = 0; ai < 2; ++ai)
#pragma unroll
            for (int m = 0; m < 4; ++m) { const size_t r = (size_t)(u.pm * BM + ai * HALF + wr * 64 + m * 16 + fr);
#pragma unroll
                for (int bj = 0; bj < 2; ++bj)
#pragma unroll
                    for (int n = 0; n < 2; ++n) { const int c = col0 + bj * HALF + n * 16;
                        const u32x2v gw = *(const u32x2v*)(proj + r * NPROJ + PC_BRG + B * DM + c);
                        f32x4 g; g[0] = __uint_as_float(gw.x << 16); g[1] = __uint_as_float(gw.x & 0xffff0000u); g[2] = __uint_as_float(gw.y << 16); g[3] = __uint_as_float(gw.y & 0xffff0000u);
                        f32x4 v = acc[ai][bj][m][n];
#pragma unroll
                        for (int j = 0; j < 4; ++j) v[j] = v[j] * __builtin_amdgcn_rcpf(1.f + __expf(-g[j]));
                        float* tp = tmp + r * DM + c;
                        if (B == 0) { *(f32x4*)tp = v; }
                        else if (B == 1) { *(f32x4*)tp = *(const f32x4*)tp + v; }
                        else { v = *(const f32x4*)tp + v; u32x2v w; w.x = cvt_pk_bf16(v[0], v[1]); w.y = cvt_pk_bf16(v[2], v[3]); *(u32x2v*)(merged + r * DM + c) = w; } } }
    }
};
struct EpiMerge {
    static constexpr bool PERM = false, AFTER_DRAIN = false;
    const bf16_t* proj; float* tmp; bf16_t* merged;
    DI void operator()(const f32x4 (&acc)[2][2][4][2], const Unit& u, int wr, int wc, int fr, int fq) const {
        typedef unsigned u32x2v __attribute__((ext_vector_type(2)));
        const int b = u.pn >> 2, pn = u.pn & 3, pm = u.pm & 127;
        const int col0 = pn * BM + wc * 32 + 4 * fq;
#pragma unroll
        for (int ai = 0; ai < 2; ++ai)
#pragma unroll
            for (int m = 0; m < 4; ++m) { const size_t r = (size_t)(pm * BM + ai * HALF + wr * 64 + m * 16 + fr);
#pragma unroll
                for (int bj = 0; bj < 2; ++bj)
#pragma unroll
                    for (int n = 0; n < 2; ++n) { const int c = col0 + bj * HALF + n * 16;
                        const u32x2v gw = *(const u32x2v*)(proj + r * NPROJ + PC_BRG + b * DM + c);
                        f32x4 g; g[0] = __uint_as_float(gw.x << 16); g[1] = __uint_as_float(gw.x & 0xffff0000u); g[2] = __uint_as_float(gw.y << 16); g[3] = __uint_as_float(gw.y & 0xffff0000u);
                        f32x4 v = acc[ai][bj][m][n];
#pragma unroll
                        for (int j = 0; j < 4; ++j) v[j] = v[j] * __builtin_amdgcn_rcpf(1.f + __expf(-g[j]));
                        float* tp = tmp + r * DM + c;
                        if (b == 0) { *(f32x4*)tp = v; }
                        else if (b == 1) { *(f32x4*)tp = *(const f32x4*)tp + v; }
                        else { v = *(const f32x4*)tp + v; u32x2v w; w.x = cvt_pk_bf16(v[0], v[1]); w.y = cvt_pk_bf16(v[2], v[3]); *(u32x2v*)(merged + r * DM + c) = w; } } }
    }
};
struct EpiMergeK {
    static constexpr bool PERM = true, AFTER_DRAIN = false; static constexpr int MIDSEG = 8;
    const bf16_t* proj; bf16_t* merged;
    DI static void ldg8(const bf16_t* p, float (&g)[8]) { const u32x4 w = *(const u32x4*)p; const unsigned ws_[4] = {w.x, w.y, w.z, w.w};
#pragma unroll
        for (int j = 0; j < 4; ++j) { g[2 * j] = __uint_as_float(ws_[j] << 16); g[2 * j + 1] = __uint_as_float(ws_[j] & 0xffff0000u); } }
    DI void mid(f32x4 (&acc)[2][2][4][2], const Unit& u, int seg, int wr, int wc, int fr, int fq) const {
        const int col0 = u.pn * BM + wc * 32 + 8 * fq;
#pragma unroll
        for (int ai = 0; ai < 2; ++ai)
#pragma unroll
            for (int m = 0; m < 4; ++m) { const size_t r = (size_t)(u.pm * BM + ai * HALF + wr * 64 + m * 16 + fr);
#pragma unroll
                for (int bj = 0; bj < 2; ++bj) { const bf16_t* gp = proj + r * NPROJ + PC_BRG + (seg - 1) * DM + col0 + bj * HALF;
                    float ga[8], gb[8]; ldg8(gp, ga); ldg8(gp + DM, gb);
#pragma unroll
                    for (int n = 0; n < 2; ++n)
#pragma unroll
                        for (int j = 0; j < 4; ++j) acc[ai][bj][m][n][j] *= (1.f + __expf(-gb[4 * n + j])) * __builtin_amdgcn_rcpf(1.f + __expf(-ga[4 * n + j])); } }
    }
    DI void operator()(const f32x4 (&acc)[2][2][4][2], const Unit& u, int wr, int wc, int fr, int fq) const {
        const int col0 = u.pn * BM + wc * 32 + 8 * fq;
#pragma unroll
        for (int ai = 0; ai < 2; ++ai)
#pragma unroll
            for (int m = 0; m < 4; ++m) { const size_t r = (size_t)(u.pm * BM + ai * HALF + wr * 64 + m * 16 + fr);
#pragma unroll
                for (int bj = 0; bj < 2; ++bj) { float g[8]; ldg8(proj + r * NPROJ + PC_BRG + 2 * DM + col0 + bj * HALF, g); float v[8];
#pragma unroll
                    for (int n = 0; n < 2; ++n)
#pragma unroll
                        for (int j = 0; j < 4; ++j) v[4 * n + j] = acc[ai][bj][m][n][j] * __builtin_amdgcn_rcpf(1.f + __expf(-g[4 * n + j]));
                    u32x4 w; w.x = cvt_pk_bf16(v[0], v[1]); w.y = cvt_pk_bf16(v[2], v[3]); w.z = cvt_pk_bf16(v[4], v[5]); w.w = cvt_pk_bf16(v[6], v[7]);
                    *(u32x4*)(merged + r * DM + col0 + bj * HALF) = w; } }
    }
};
struct MergeOrder {
    StaticOrder so;
    DI bool next(int i, Unit& u) const { const int tl = i / 3, b = i - 3 * tl; Unit t; if (!so.next(tl, t)) return false; u.pm = b * 128 + t.pm; u.pn = b * 4 + t.pn; return true; }
    DI void a_ready(const Unit&) const {}
    DI void done(const Unit&) const {}
};
struct EpiRes {
    static constexpr bool PERM = false, AFTER_DRAIN = false;
    const float* base; float* out;
    DI void operator()(const f32x4 (&acc)[2][2][4][2], const Unit& u, int wr, int wc, int fr, int fq) const {
        const int col0 = u.pn * BM + wc * 32 + 4 * fq;
#pragma unroll
        for (int ai = 0; ai < 2; ++ai)
#pragma unroll
            for (int m = 0; m < 4; ++m) { const size_t r = (size_t)(u.pm * BM + ai * HALF + wr * 64 + m * 16 + fr);
#pragma unroll
                for (int bj = 0; bj < 2; ++bj)
#pragma unroll
                    for (int n = 0; n < 2; ++n) { const int c = col0 + bj * HALF + n * 16; *(f32x4*)(out + r * DM + c) = *(const f32x4*)(base + r * DM + c) + acc[ai][bj][m][n]; } }
    }
};
struct EpiSwiglu {
    static constexpr bool PERM = true, AFTER_DRAIN = false, PERM2 = true;
    unsigned char* act; const float* bgu;
    DI void operator()(const f32x4 (&acc)[2][2][4][2], const Unit& u, int wr, int wc, int fr, int fq) const {
        typedef unsigned u32x2v __attribute__((ext_vector_type(2)));
        const int e = u.pn >> 3, pnl = u.pn & 7;
        const unsigned lc0 = (unsigned)(pnl * BM + wc * 64 + 16 * fq);
        const unsigned row0 = (unsigned)(u.pm * BM + wr * 64 + fr);
        const float* bp = bgu + e * 2048 + lc0;
        f32x4 bv[2][2];
#pragma unroll
        for (int bj = 0; bj < 2; ++bj)
#pragma unroll
            for (int n = 0; n < 2; ++n) bv[bj][n] = *(const f32x4*)(bp + 8 * bj + 4 * n);
#pragma unroll
        for (int ai = 0; ai < 2; ++ai)
#pragma unroll
            for (int m = 0; m < 4; ++m) { const unsigned rowoff = (row0 + ai * HALF + m * 16) * (unsigned)DFF;
                int q8[2] = {0, 0};
#pragma unroll
                for (int bj = 0; bj < 2; ++bj) { float o[4];
#pragma unroll
                    for (int n = 0; n < 2; ++n) { const f32x4 v = acc[ai][bj][m][n] + bv[bj][n];
#pragma unroll
                        for (int q = 0; q < 2; ++q) { const float gt = fminf(v[2 * q], 7.0f); const float up = fminf(fmaxf(v[2 * q + 1], -7.0f), 7.0f);
                            o[2 * n + q] = (up + 1.0f) * (gt * __builtin_amdgcn_rcpf(1.f + __expf(-1.702f * gt))); } }
                    q8[bj] = __builtin_amdgcn_cvt_pk_fp8_f32(o[0], o[1], q8[bj], false); q8[bj] = __builtin_amdgcn_cvt_pk_fp8_f32(o[2], o[3], q8[bj], true); }
                *(u32x2v*)(act + (rowoff + (lc0 >> 1))) = (u32x2v){(unsigned)q8[0], (unsigned)q8[1]}; }
    }
};
struct EpiDown {
    static constexpr bool PERM = true, AFTER_DRAIN = false, PERM2 = true;
    unsigned char* y; const float* bdn; const float* roww;
    DI void operator()(const f32x4 (&acc)[2][2][4][2], const Unit& u, int wr, int wc, int fr, int fq) const {
        const int e = u.pn >> 2, pnl = u.pn & 3;
        const int col0 = pnl * BM + wc * 64 + 16 * fq;
        const float* bp = bdn + e * DM + col0;
        f32x4 bv[2][2];
#pragma unroll
        for (int bj = 0; bj < 2; ++bj) { bv[bj][0] = *(const f32x4*)(bp + 8 * bj); bv[bj][1] = *(const f32x4*)(bp + 8 * bj + 4); }
        const unsigned row0 = (unsigned)(u.pm * BM + wr * 64 + fr);
#pragma unroll
        for (int ai = 0; ai < 2; ++ai)
#pragma unroll
            for (int m = 0; m < 4; ++m) { const unsigned r = row0 + ai * HALF + m * 16; const float rw = roww[r] * 8.0f; unsigned q[4];
#pragma unroll
                for (int bj = 0; bj < 2; ++bj)
#pragma unroll
                    for (int n = 0; n < 2; ++n) { const f32x4 v = (acc[ai][bj][m][n] + bv[bj][n]) * rw; int w = 0;
                        w = __builtin_amdgcn_cvt_pk_fp8_f32(v[0], v[1], w, false); w = __builtin_amdgcn_cvt_pk_fp8_f32(v[2], v[3], w, true); q[2 * bj + n] = (unsigned)w; }
                *(u32x4*)(y + (r * (unsigned)DM + (unsigned)col0)) = (u32x4){q[0], q[1], q[2], q[3]}; }
    }
};
template <int NPN> struct MoeOrder {
    int nblk, G, c; const PG8_LAS unsigned char* blk_e;
    DI bool next(int i, Unit& u) const {
        int rb, pn;
        if (G == 256) { const int x = c & 7, j = c >> 3; rb = i * (256 / NPN) + x * (32 / NPN) + j / NPN; pn = j % NPN; }
        else { const int L = i * G + c; rb = L / NPN; pn = L % NPN; }
        if (rb >= nblk) return false;
        u.pm = rb; u.pn = __builtin_amdgcn_readfirstlane((int)blk_e[rb]) * NPN + pn; return true; }
    DI void a_ready(const Unit&) const {}
    DI void done(const Unit&) const {}
};
}

struct Frame {
    LAS unsigned char* lds; volatile LAS unsigned* MISC; unsigned* ctl; unsigned char* ws;
    int wave, G, bx;
    DI int lane_id() const { int l; asm volatile("v_mbcnt_lo_u32_b32 %0, -1, 0\n\tv_mbcnt_hi_u32_b32 %0, -1, %0" : "=v"(l)); return l; }
    DI int tid_id() const { return wave * 64 + lane_id(); }
    const float* const* in; float* out;
};
enum { I_X = 0, I_MEM, I_GMIX, I_WIN, I_CONVW, I_CONVB, I_MLBI, I_MLBF, I_MLGOUT, I_NGQ, I_NGK, I_CPK, I_CW1K, I_CB1K, I_CW2K, I_CPV, I_CW1V, I_CB1V, I_CW2V,
       I_GMEM, I_WMKV, I_MGQ, I_MGK, I_WBRML, I_WBRNSA, I_WBRMEM, I_WOUT, I_GFFN, I_WR, I_BR, I_WGU, I_BGU, I_WDN, I_BDN, N_IN };

template <class CM>
DI void tr_item(const float* W, int ldw, int K, bf16* WT, int k0, int n0, CM cm, LAS float* scr, int lane) {
    const int sc = cm(n0 + (lane & 31));
#pragma unroll 8
    for (int i = 0; i < 32; ++i) { const int kk = 2 * i + (lane >> 5); scr[kk * 33 + (lane & 31)] = sc >= 0 ? W[(size_t)(k0 + kk) * ldw + sc] : 0.f; }
    LDS_WAIT(); asm volatile("" ::: "memory");
    const int c = lane & 7;
#pragma unroll
    for (int j = 0; j < 4; ++j) { const int n = (lane >> 3) + 8 * j; const LAS float* s = scr + (8 * c) * 33 + n;
        v4u o; o.x = pk2(s[0 * 33], s[1 * 33]); o.y = pk2(s[2 * 33], s[3 * 33]); o.z = pk2(s[4 * 33], s[5 * 33]); o.w = pk2(s[6 * 33], s[7 * 33]);
        *(v4u*)(WT + (size_t)(n0 + n) * K + k0 + 8 * c) = o; }
    LDS_WAIT(); asm volatile("" ::: "memory");
}
DI void tr_item_f8(const float* W, int ldw, int K, unsigned char* WT, int k0, int n0, LAS float* scr, int lane) {
#pragma unroll 8
    for (int i = 0; i < 32; ++i) { const int kk = 2 * i + (lane >> 5); scr[kk * 33 + (lane & 31)] = W[(size_t)(k0 + kk) * ldw + n0 + (lane & 31)] * 256.0f; }
    LDS_WAIT(); asm volatile("" ::: "memory");
    const int c = lane & 7;
#pragma unroll
    for (int j = 0; j < 4; ++j) { const int n = (lane >> 3) + 8 * j; const LAS float* sp = scr + (8 * c) * 33 + n;
        int lo = 0, hi = 0;
        lo = __builtin_amdgcn_cvt_pk_fp8_f32(sp[0 * 33], sp[1 * 33], lo, false); lo = __builtin_amdgcn_cvt_pk_fp8_f32(sp[2 * 33], sp[3 * 33], lo, true);
        hi = __builtin_amdgcn_cvt_pk_fp8_f32(sp[4 * 33], sp[5 * 33], hi, false); hi = __builtin_amdgcn_cvt_pk_fp8_f32(sp[6 * 33], sp[7 * 33], hi, true);
        typedef unsigned u32x2t __attribute__((ext_vector_type(2)));
        *(u32x2t*)(WT + (size_t)(n0 + n) * K + k0 + 8 * c) = (u32x2t){(unsigned)lo, (unsigned)hi}; }
    LDS_WAIT(); asm volatile("" ::: "memory");
}
DI void tr_load_v4(const float* W, int ldw, int k0, int n0, int lane, f32x4 (&v)[8]) {
#pragma unroll
    for (int i = 0; i < 8; ++i) v[i] = *(const f32x4*)(W + (size_t)(k0 + 8 * i + (lane >> 3)) * ldw + n0 + 4 * (lane & 7));
}
DI void tr_put_v4(const f32x4 (&v)[8], LAS float* scr, int lane, float mul) {
#pragma unroll
    for (int i = 0; i < 8; ++i) { LAS float* d = scr + (8 * i + (lane >> 3)) * 33 + 4 * (lane & 7); d[0] = v[i].x * mul; d[1] = v[i].y * mul; d[2] = v[i].z * mul; d[3] = v[i].w * mul; }
    LDS_WAIT(); asm volatile("" ::: "memory");
}
DI void tr_load_v4x16(const float* W, int ldw, int k0, int n0, int lane, f32x4 (&v)[16]) {
#pragma unroll
    for (int i = 0; i < 16; ++i) v[i] = *(const f32x4*)(W + (size_t)(k0 + 8 * i + (lane >> 3)) * ldw + n0 + 4 * (lane & 7));
}
DI void tr_put_v4x16(const f32x4 (&v)[16], LAS float* scr, int lane, float mul) {
#pragma unroll
    for (int i = 0; i < 16; ++i) { LAS float* d = scr + (8 * i + (lane >> 3)) * 33 + 4 * (lane & 7); d[0] = v[i].x * mul; d[1] = v[i].y * mul; d[2] = v[i].z * mul; d[3] = v[i].w * mul; }
    LDS_WAIT(); asm volatile("" ::: "memory");
}
DI void tr_emit_f8x16(unsigned char* WT, int K, int k0, int n0, LAS float* scr, int lane) {
    const int c = lane & 7;
#pragma unroll
    for (int j = 0; j < 4; ++j) { const int n = (lane >> 3) + 8 * j; const LAS float* sp = scr + (16 * c) * 33 + n; unsigned q[4];
#pragma unroll
        for (int h = 0; h < 4; ++h) { int w = 0; w = __builtin_amdgcn_cvt_pk_fp8_f32(sp[(4 * h) * 33], sp[(4 * h + 1) * 33], w, false); w = __builtin_amdgcn_cvt_pk_fp8_f32(sp[(4 * h + 2) * 33], sp[(4 * h + 3) * 33], w, true); q[h] = (unsigned)w; }
        *(v4u*)(WT + (size_t)(n0 + n) * K + k0 + 16 * c) = (v4u){q[0], q[1], q[2], q[3]}; }
    LDS_WAIT(); asm volatile("" ::: "memory");
}
DI void tr_fill_v4(const float* W, int ldw, int k0, int n0, LAS float* scr, int lane, float mul) { f32x4 v[8]; tr_load_v4(W, ldw, k0, n0, lane, v); tr_put_v4(v, scr, lane, mul); }
DI void tr_emit_bf16(bf16* WT, int K, int k0, int n0, LAS float* scr, int lane) {
    const int c = lane & 7;
#pragma unroll
    for (int j = 0; j < 4; ++j) { const int n = (lane >> 3) + 8 * j; const LAS float* sp = scr + (8 * c) * 33 + n;
        v4u o; o.x = pk2(sp[0 * 33], sp[1 * 33]); o.y = pk2(sp[2 * 33], sp[3 * 33]); o.z = pk2(sp[4 * 33], sp[5 * 33]); o.w = pk2(sp[6 * 33], sp[7 * 33]);
        *(v4u*)(WT + (size_t)(n0 + n) * K + k0 + 8 * c) = o; }
    LDS_WAIT(); asm volatile("" ::: "memory");
}
DI void tr_emit_f8(unsigned char* WT, int K, int k0, int n0, LAS float* scr, int lane) {
    const int c = lane & 7;
#pragma unroll
    for (int j = 0; j < 4; ++j) { const int n = (lane >> 3) + 8 * j; const LAS float* sp = scr + (8 * c) * 33 + n;
        int lo = 0, hi = 0;
        lo = __builtin_amdgcn_cvt_pk_fp8_f32(sp[0 * 33], sp[1 * 33], lo, false); lo = __builtin_amdgcn_cvt_pk_fp8_f32(sp[2 * 33], sp[3 * 33], lo, true);
        hi = __builtin_amdgcn_cvt_pk_fp8_f32(sp[4 * 33], sp[5 * 33], hi, false); hi = __builtin_amdgcn_cvt_pk_fp8_f32(sp[6 * 33], sp[7 * 33], hi, true);
        typedef unsigned u32x2t __attribute__((ext_vector_type(2)));
        *(u32x2t*)(WT + (size_t)(n0 + n) * K + k0 + 8 * c) = (u32x2t){(unsigned)lo, (unsigned)hi}; }
    LDS_WAIT(); asm volatile("" ::: "memory");
}
template <class CM>
DI void tr_fill_v4cm(const float* W, int ldw, int k0, int n0, CM cm, LAS float* scr, int lane, float mul) {
    const int sc = cm(n0 + 4 * (lane & 7)); f32x4 v[8];
#pragma unroll
    for (int i = 0; i < 8; ++i) v[i] = sc >= 0 ? *(const f32x4*)(W + (size_t)(k0 + 8 * i + (lane >> 3)) * ldw + sc) : (f32x4){0.f, 0.f, 0.f, 0.f};
    tr_put_v4(v, scr, lane, mul);
}
template <class CM>
DI void tr_fill_cm(const float* W, int ldw, int k0, int n0, CM cm, LAS float* scr, int lane, float mul) {
    const int sc = cm(n0 + (lane & 31));
#pragma unroll 8
    for (int i = 0; i < 32; ++i) { const int kk = 2 * i + (lane >> 5); scr[kk * 33 + (lane & 31)] = sc >= 0 ? W[(size_t)(k0 + kk) * ldw + sc] * mul : 0.f; }
    LDS_WAIT(); asm volatile("" ::: "memory");
}
struct CmId { DI int operator()(int j) const { return j; } };
struct CmProj { DI int operator()(int j) const { return proj_srccol(j); } };

DI void rms_row_bf16(const float* xrow, const float* g, bf16* orow, int lane) {
    const f32x4* xr = (const f32x4*)xrow + lane; const f32x4* gr = (const f32x4*)g + lane;
    f32x4 v[4]; float s = 0.f;
#pragma unroll
    for (int j = 0; j < 4; ++j) { v[j] = xr[64 * j]; s += (v[j].x * v[j].x + v[j].y * v[j].y) + (v[j].z * v[j].z + v[j].w * v[j].w); }
    const float rstd = rsqrtf(wave_sum(s) * (1.f / DM) + EPS);
    unsigned long long* o8 = (unsigned long long*)orow + lane;
#pragma unroll
    for (int j = 0; j < 4; ++j) { const f32x4 gg = gr[64 * j];
        o8[64 * j] = (unsigned long long)pk2(v[j].x * rstd * gg.x, v[j].y * rstd * gg.y) | ((unsigned long long)pk2(v[j].z * rstd * gg.z, v[j].w * rstd * gg.w) << 32); }
}

DI void rms_row_f8(const float* xrow, const float* g, unsigned char* orow, int lane) {
    const f32x4* xr = (const f32x4*)xrow + lane; const f32x4* gr = (const f32x4*)g + lane;
    f32x4 v[4]; float s = 0.f;
#pragma unroll
    for (int j = 0; j < 4; ++j) { v[j] = xr[64 * j]; s += (v[j].x * v[j].x + v[j].y * v[j].y) + (v[j].z * v[j].z + v[j].w * v[j].w); }
    const float rstd = rsqrtf(wave_sum(s) * (1.f / DM) + EPS);
    unsigned* o4 = (unsigned*)orow + lane;
#pragma unroll
    for (int j = 0; j < 4; ++j) { const f32x4 gg = gr[64 * j]; int q8 = 0;
        q8 = __builtin_amdgcn_cvt_pk_fp8_f32(v[j].x * rstd * gg.x, v[j].y * rstd * gg.y, q8, false); q8 = __builtin_amdgcn_cvt_pk_fp8_f32(v[j].z * rstd * gg.z, v[j].w * rstd * gg.w, q8, true);
        o4[64 * j] = (unsigned)q8; }
}
template <int NR>
DI void rms_rows_both(const float* x0, const float* g, bf16* o0, unsigned char* o80, size_t step, int lane) {
    const f32x4* gr = (const f32x4*)g + lane;
    f32x4 v[NR][4];
#pragma unroll
    for (int q = 0; q < NR; ++q) { const f32x4* xr = (const f32x4*)(x0 + q * step * DM) + lane;
#pragma unroll
        for (int j = 0; j < 4; ++j) v[q][j] = xr[64 * j]; }
#pragma unroll
    for (int q = 0; q < NR; ++q) { float s = 0.f;
#pragma unroll
        for (int j = 0; j < 4; ++j) s += (v[q][j].x * v[q][j].x + v[q][j].y * v[q][j].y) + (v[q][j].z * v[q][j].z + v[q][j].w * v[q][j].w);
        const float rstd = rsqrtf(wave_sum(s) * (1.f / DM) + EPS);
        unsigned long long* o8 = (unsigned long long*)(o0 + q * step * DM) + lane; unsigned* o4 = (unsigned*)(o80 + q * step * DM) + lane;
#pragma unroll
        for (int j = 0; j < 4; ++j) { const f32x4 gg = gr[64 * j]; const float y0 = v[q][j].x * rstd * gg.x, y1 = v[q][j].y * rstd * gg.y, y2 = v[q][j].z * rstd * gg.z, y3 = v[q][j].w * rstd * gg.w;
            o8[64 * j] = (unsigned long long)pk2(y0, y1) | ((unsigned long long)pk2(y2, y3) << 32);
            int q8 = 0; q8 = __builtin_amdgcn_cvt_pk_fp8_f32(y0, y1, q8, false); q8 = __builtin_amdgcn_cvt_pk_fp8_f32(y2, y3, q8, true);
            o4[64 * j] = (unsigned)q8; } }
}
template <int PARTS = 0xf>
DI void p0_prologue(Frame& F) {
    LAS float* scr = (LAS float*)(F.lds + F.wave * 16384);
    const int gw = F.bx * NWAVES + F.wave, NGW = F.G * NWAVES;
    unsigned char* ws = F.ws;
    constexpr int IT_IN = 16 * (NPROJ / 32), IT_GU = 32 * 16 * 64, IT_DN = 32 * 16 * 32, IT_MKV = 16 * 32, IT_BR = 3 * 8 * 32, IT_OUT = 16 * 32, IT_C1 = 2 * 32 * 8;
    constexpr int NITEMS = IT_IN + IT_GU + IT_DN + IT_MKV + IT_BR + IT_OUT + IT_C1;
    if (PARTS & 1)
    {
        constexpr int JT_GU = 32 * 8 * 64, JT_DN = 32 * 8 * 32;
        struct D { const float* src; unsigned char* dst; int ldw, k0, n0; };
        auto dec = [&](int j) { D d; if (j < JT_GU) { const int e = j / 512, q = j % 512; d.src = F.in[I_WGU] + (size_t)e * DM * 2048; d.dst = (unsigned char*)(ws + WS_WGU) + (size_t)e * 2048 * DM; d.ldw = 2048; d.k0 = 128 * (q / 64); d.n0 = 32 * (q % 64); }
                                     else { const int jj = j - JT_GU, e = jj / 256, q = jj % 256; d.src = F.in[I_WDN] + (size_t)e * DFF * DM; d.dst = (unsigned char*)(ws + WS_WDN) + (size_t)e * DM * DFF; d.ldw = DM; d.k0 = 128 * (q / 32); d.n0 = 32 * (q % 32); } return d; };
        const int lane = F.lane_id();
        LAS float* scr2 = (LAS float*)(F.wave < 7 ? F.lds + F.wave * 16896 : F.lds + 135424);
        int j = gw; f32x4 va[16]; D da{};
        if (j < JT_GU + JT_DN) { da = dec(j); tr_load_v4x16(da.src, da.ldw, da.k0, da.n0, lane, va); }
#pragma unroll 1
        while (j < JT_GU + JT_DN) {
            const int jn = j + NGW; f32x4 vb[16]; D db{};
            if (jn < JT_GU + JT_DN) { db = dec(jn); tr_load_v4x16(db.src, db.ldw, db.k0, db.n0, lane, vb); }
            else {
#pragma unroll
                for (int i = 0; i < 16; ++i) vb[i] = va[i]; }
            tr_put_v4x16(va, scr2, lane, 256.0f); tr_emit_f8x16(da.dst, 1024, da.k0, da.n0, scr2, lane);
#pragma unroll
            for (int i = 0; i < 16; ++i) va[i] = vb[i];
            da = db; j = jn;
        }
        __syncthreads();
    }
    if (PARTS & 2)
    for (int it = gw; it < NITEMS; it += NGW) {
        int r = it;
        if (r < IT_IN) { const int kb = r / (NPROJ / 32), nb = r % (NPROJ / 32); if (32 * nb < NB16) { tr_fill_v4cm(F.in[I_WIN], DIN_SRC, 64 * kb, 32 * nb, CmProj(), scr, F.lane_id(), 1.0f); tr_emit_bf16((bf16*)(ws + WS_WIN), DM, 64 * kb, 32 * nb, scr, F.lane_id()); }
            else { tr_fill_v4cm(F.in[I_WIN], DIN_SRC, 64 * kb, 32 * nb, CmProj(), scr, F.lane_id(), 256.0f); tr_emit_f8((unsigned char*)(ws + WS_WIN8), DM, 64 * kb, 32 * nb - NB16, scr, F.lane_id()); }
            continue; } r -= IT_IN;
        if (r < IT_GU + IT_DN) continue; r -= IT_GU + IT_DN;
        if (r < IT_MKV) { const int kb = r / 32, nb = r % 32; tr_fill_v4(F.in[I_WMKV], 1024, 64 * kb, 32 * nb, scr, F.lane_id(), 1.0f); tr_emit_bf16((bf16*)(ws + WS_WMKV), 1024, 64 * kb, 32 * nb, scr, F.lane_id()); continue; } r -= IT_MKV;
        if (r < IT_BR) { const int b = r / 256, q = r % 256, kb = q / 32, nb = q % 32; tr_fill_v4(F.in[I_WBRML + b], 1024, 64 * kb, 32 * nb, scr, F.lane_id(), 1.0f); tr_emit_bf16((bf16*)(ws + WS_WBR), 1536, 512 * b + 64 * kb, 32 * nb, scr, F.lane_id()); continue; } r -= IT_BR;
        if (r < IT_OUT) { const int kb = r / 32, nb = r % 32; tr_fill_v4(F.in[I_WOUT], 1024, 64 * kb, 32 * nb, scr, F.lane_id(), 1.0f); tr_emit_bf16((bf16*)(ws + WS_WOUT), 1024, 64 * kb, 32 * nb, scr, F.lane_id()); continue; } r -= IT_OUT;
        { const int kv = r / 256, q = r % 256, kb = q / 8, nb = q % 8; tr_fill_v4(F.in[kv ? I_CW1V : I_CW1K], 256, 64 * kb, 32 * nb, scr, F.lane_id(), 1.0f); tr_emit_bf16((bf16*)(ws + WS_WC1) + (size_t)kv * 256 * 2048, 2048, 64 * kb, 32 * nb, scr, F.lane_id()); }
    }
    if (PARTS & 4)
    { int m = gw;
      for (; m + 3 * NGW < MT; m += 4 * NGW) rms_rows_both<4>(F.in[I_X] + (size_t)m * DM, F.in[I_GMIX], (bf16*)(ws + WS_R1) + (size_t)m * DM, (unsigned char*)(ws + WS_U8) + (size_t)m * DM, (size_t)NGW, F.lane_id());
      for (; m < MT; m += NGW) rms_rows_both<1>(F.in[I_X] + (size_t)m * DM, F.in[I_GMIX], (bf16*)(ws + WS_R1) + (size_t)m * DM, (unsigned char*)(ws + WS_U8) + (size_t)m * DM, (size_t)NGW, F.lane_id()); }
    for (int m = gw; m < MROWS; m += NGW) rms_row_bf16(F.in[I_MEM] + (size_t)m * DM, F.in[I_GMEM], (bf16*)(ws + WS_MEMN) + (size_t)m * DM, F.lane_id());
    float* rc = (float*)(ws + WS_SMALL + SM_ROPEC); float* rs = (float*)(ws + WS_SMALL + SM_ROPES);
    for (int i = F.bx * 512 + F.tid_id(); i < SEQ * 32; i += F.G * 512) {
        const int p = i >> 5, k = i & 31;
        const float invf = exp2f(-(float)k * (13.287712379549449f / 32.0f));
        const float ang = (float)p * invf;
        const float kf = rintf(ang * 0.15915494309189535f);
        float r = fmaf(-kf, 6.28125f, ang); r = fmaf(-kf, 1.9353071795864769e-3f, r);
        rc[i] = cosf(r); rs[i] = sinf(r);
    }
    { bf16* wrt = (bf16*)(ws + WS_SMALL + SM_WRT);
      for (int i = F.bx * 512 + F.tid_id(); i < 32 * 1024; i += F.G * 512) { const int e = i >> 10, k = i & 1023; const float w = F.in[I_WR][k * 32 + e]; const unsigned hi = f2bf(w); wrt[i] = (bf16)hi; wrt[32 * 1024 + i] = (bf16)f2bf(w - __uint_as_float(hi << 16)); } }
    { bf16* w2t = (bf16*)(ws + WS_SMALL + SM_W2T);
      for (int i = F.bx * 512 + F.tid_id(); i < 2 * 64 * 256; i += F.G * 512) { const int kv = i >> 14, d = (i >> 8) & 63, f = i & 255; w2t[i] = (bf16)f2bf(F.in[kv ? I_CW2V : I_CW2K][f * 64 + d]); } }
    for (int o = gw; o < 512; o += NGW) {
        const int kv = o >> 8, f = o & 255, lane = F.lane_id();
        const float* pe = F.in[kv ? I_CPV : I_CPK]; const float* w1 = F.in[kv ? I_CW1V : I_CW1K];
        float wv[32], pv[32];
#pragma unroll
        for (int i = 0; i < 32; ++i) { const int k = lane + 64 * i; wv[i] = w1[(size_t)k * 256 + f]; pv[i] = pe[k]; }
        float a = 0.f;
#pragma unroll
        for (int i = 0; i < 32; ++i) a = fmaf(pv[i], wv[i], a);
        a = wave_sum(a);
        if (lane == 0) ((float*)(ws + WS_SMALL + SM_CBIAS))[o] = a + F.in[kv ? I_CB1V : I_CB1K][f];
    }
}

DI void unpack8(const v4u& w, float (&f)[8]) {
    f[0] = __uint_as_float(w.x << 16); f[1] = __uint_as_float(w.x & 0xffff0000u); f[2] = __uint_as_float(w.y << 16); f[3] = __uint_as_float(w.y & 0xffff0000u);
    f[4] = __uint_as_float(w.z << 16); f[5] = __uint_as_float(w.z & 0xffff0000u); f[6] = __uint_as_float(w.w << 16); f[7] = __uint_as_float(w.w & 0xffff0000u);
}
DI v4u pack8f(const float (&f)[8]) { v4u o; o.x = pk2(f[0], f[1]); o.y = pk2(f[2], f[3]); o.z = pk2(f[4], f[5]); o.w = pk2(f[6], f[7]); return o; }
DI void load8f(const float* p, float (&f)[8]) { const f32x4 a = *(const f32x4*)p, b = *(const f32x4*)(p + 4); f[0] = a.x; f[1] = a.y; f[2] = a.z; f[3] = a.w; f[4] = b.x; f[5] = b.y; f[6] = b.z; f[7] = b.w; }
DI void norm_rope64(float (&f)[8], const float (&g)[8], const float (&c8)[8], const float (&s8)[8], int lane, float scale) {
    float ss = 0.f;
#pragma unroll
    for (int i = 0; i < 8; ++i) ss = fmaf(f[i], f[i], ss);
    ss += __shfl_xor(ss, 1); ss += __shfl_xor(ss, 2); ss += __shfl_xor(ss, 4);
    const float rstd = rsqrtf(ss * (1.f / 64.f) + EPS);
    const bool hi = (lane & 4) != 0;
#pragma unroll
    for (int i = 0; i < 8; ++i) { const float y = f[i] * rstd * g[i]; const float pt = __shfl_xor(y, 4); f[i] = (hi ? fmaf(pt, s8[i], y * c8[i]) : fmaf(-pt, s8[i], y * c8[i])) * scale; }
}
DI void p2_prep(Frame& F) {
    unsigned char* ws = F.ws;
    const int ncg = F.G >= 64 ? 32 : 0;
    if (F.bx < ncg) return;
    const int gw = (F.bx - ncg) * NWAVES + F.wave, NGW = (F.G - ncg) * NWAVES, lane = F.lane_id();
    const bf16* proj = (const bf16*)(ws + WS_PROJ);
    const float* rc = (const float*)(ws + WS_SMALL + SM_ROPEC); const float* rs = (const float*)(ws + WS_SMALL + SM_ROPES);
    bf16* qn = (bf16*)(ws + WS_QN); bf16* ksn = (bf16*)(ws + WS_KSN); bf16* kwn = (bf16*)(ws + WS_KWN); bf16* mqn = (bf16*)(ws + WS_MQN); bf16* mlqk = (bf16*)(ws + WS_MLQK);
    constexpr int NT = 4;
    {
        float gq8[8], mg8[8]; load8f(F.in[I_NGQ] + 8 * (lane & 7), gq8); load8f(F.in[I_MGQ] + 8 * (lane & 15), mg8);
        for (int t0 = gw * NT; t0 < MT; t0 += NGW * NT) {
            v4u a[NT], bq[NT]; float c8[NT][8], s8[NT][8];
#pragma unroll
            for (int u = 0; u < NT; ++u) { const int t = t0 + u, tau = t & 2047; const bf16* pr = proj + (size_t)t * NPROJ;
                a[u] = *(const v4u*)(pr + PC_NQ + 8 * lane); bq[u] = *(const v4u*)(pr + PC_MQ + 8 * lane);
                load8f(rc + tau * 32 + 8 * (lane & 3), c8[u]); load8f(rs + tau * 32 + 8 * (lane & 3), s8[u]); }
#pragma unroll
            for (int u = 0; u < NT; ++u) { const int t = t0 + u;
                float f[8]; unpack8(a[u], f);
                norm_rope64(f, gq8, c8[u], s8[u], lane, 0.125f * 1.4426950408889634f);
                *(v4u*)(qn + (size_t)t * 512 + 8 * lane) = pack8f(f);
                unpack8(bq[u], f);
                float ss = 0.f;
#pragma unroll
                for (int i = 0; i < 8; ++i) ss = fmaf(f[i], f[i], ss);
                ss += __shfl_xor(ss, 1); ss += __shfl_xor(ss, 2); ss += __shfl_xor(ss, 4); ss += __shfl_xor(ss, 8);
                const float rstd = rsqrtf(ss * (1.f / 128.f) + EPS) * (0.08838834764831845f * 1.4426950408889634f);
#pragma unroll
                for (int i = 0; i < 8; ++i) f[i] *= rstd * mg8[i];
                *(v4u*)(mqn + (size_t)t * 512 + 8 * lane) = pack8f(f);
                }
        }
    }
    {
        const int L = lane & 31, hd4 = L >> 3, j = L & 7, half = lane >> 5;
        float gk8[8]; load8f(F.in[I_NGK] + (1 + (hd4 >> 1)) * 64 + 8 * j, gk8);
        const int kcol = (hd4 < 2 ? PC_NKS + hd4 * 64 : PC_NKW + (hd4 - 2) * 64) + 8 * j;
        bf16* kdst = (hd4 < 2 ? ksn : kwn) + (hd4 & 1) * 64 + 8 * j;
        const int wv = L >> 4, jj = L & 15;
        bf16* vdst = (bf16*)(ws + (wv ? WS_VWN : WS_VSN)) + 8 * jj; const int vcol = (wv ? PC_NVW : PC_NVS) + 8 * jj;
        for (int tp0 = gw * NT; tp0 < MT / 2; tp0 += NGW * NT) {
            v4u a[NT]; float c8[NT][8], s8[NT][8];
#pragma unroll
            for (int u = 0; u < NT; ++u) { const int t = 2 * (tp0 + u) + half, tau = t & 2047; const bf16* pr = proj + (size_t)t * NPROJ;
                a[u] = *(const v4u*)(pr + kcol);
                load8f(rc + tau * 32 + 8 * (lane & 3), c8[u]); load8f(rs + tau * 32 + 8 * (lane & 3), s8[u]); }
#pragma unroll
            for (int u = 0; u < NT; ++u) { const int t = 2 * (tp0 + u) + half;
                float f[8]; unpack8(a[u], f);
                norm_rope64(f, gk8, c8[u], s8[u], lane, 1.0f);
                *(v4u*)(kdst + (size_t)t * 128) = pack8f(f); }
        }
    }
    for (int run = gw; run < MT / 16; run += NGW) {
        const int t0 = run * 16, tau0 = t0 & 2047;
#pragma unroll 1
        for (int sp = 0; sp < 2; ++sp) {
            const int ch = 512 * sp + 8 * lane;
            float w0[8], w1[8], w2[8], w3[8], bb[8];
            load8f(F.in[I_CONVW] + ch, w0); load8f(F.in[I_CONVW] + 1024 + ch, w1); load8f(F.in[I_CONVW] + 2048 + ch, w2); load8f(F.in[I_CONVW] + 3072 + ch, w3); load8f(F.in[I_CONVB] + ch, bb);
            float x0[8], x1[8], x2[8];
            if (tau0 >= 3) { unpack8(*(const v4u*)(proj + (size_t)(t0 - 3) * NPROJ + ch), x0); unpack8(*(const v4u*)(proj + (size_t)(t0 - 2) * NPROJ + ch), x1); unpack8(*(const v4u*)(proj + (size_t)(t0 - 1) * NPROJ + ch), x2); }
            else {
#pragma unroll
                for (int i = 0; i < 8; ++i) { x0[i] = 0.f; x1[i] = 0.f; x2[i] = 0.f; } }
#pragma unroll 1
            for (int k0 = 0; k0 < 16; k0 += 4) {
                v4u raw[4];
#pragma unroll
                for (int k = 0; k < 4; ++k) raw[k] = *(const v4u*)(proj + (size_t)(t0 + k0 + k) * NPROJ + ch);
#pragma unroll
                for (int k = 0; k < 4; ++k) { float x3[8], y[8]; unpack8(raw[k], x3);
#pragma unroll
                    for (int i = 0; i < 8; ++i) { const float a = fmaf(w3[i], x3[i], fmaf(w2[i], x2[i], fmaf(w1[i], x1[i], fmaf(w0[i], x0[i], bb[i])))); y[i] = a * sigm(a); x0[i] = x1[i]; x1[i] = x2[i]; x2[i] = x3[i]; }
                    *(v4u*)(mlqk + (size_t)(t0 + k0 + k) * 1024 + ch) = pack8f(y); }
            }
        }
    }
    {
        const bf16* memkv = (const bf16*)(ws + WS_MEMKV); bf16* memkn = (bf16*)(ws + WS_MEMKN);
        float kg8[8]; load8f(F.in[I_MGK] + 8 * (lane & 15), kg8);
        for (int r = gw; r < MROWS; r += NGW) {
            float f[8]; unpack8(*(const v4u*)(memkv + (size_t)r * 1024 + 8 * lane), f);
            float ss = 0.f;
#pragma unroll
            for (int i = 0; i < 8; ++i) ss = fmaf(f[i], f[i], ss);
            ss += __shfl_xor(ss, 1); ss += __shfl_xor(ss, 2); ss += __shfl_xor(ss, 4); ss += __shfl_xor(ss, 8);
            const float rstd = rsqrtf(ss * (1.f / 128.f) + EPS);
#pragma unroll
            for (int i = 0; i < 8; ++i) f[i] *= rstd * kg8[i];
            *(v4u*)(memkn + (size_t)r * 512 + 8 * lane) = pack8f(f);
        }
    }
}

DI void p4_kcvc(Frame& F) {
    unsigned char* ws = F.ws;
    const int gw = F.bx * NWAVES + F.wave, NGW = F.G * NWAVES, lane = F.lane_id();
    const bf16* hid = (const bf16*)(ws + WS_HID);
    const float* rc = (const float*)(ws + WS_SMALL + SM_ROPEC); const float* rs = (const float*)(ws + WS_SMALL + SM_ROPES);
    const float gk = F.in[I_NGK][lane];
    for (int it = gw; it < 2 * 4096; it += NGW) {
        const int kv = it >> 12, r = it & 4095, n = r & 127;
        bf16* dst = (bf16*)(ws + (kv ? WS_VC : WS_KC)) + (size_t)r * 64 + lane;
        if (n == 127) { *dst = 0; continue; }
        const bf16* hr = hid + (size_t)kv * 4096 * 256 + (size_t)r * 256; const float* w2 = F.in[kv ? I_CW2V : I_CW2K];
        float a = 0.f;
        for (int f = 0; f < 256; ++f) a = fmaf(bf2f(hr[f]), w2[f * 64 + lane], a);
        if (kv == 0) {
            const float y = a * rsqrtf(wave_sum(a * a) * (1.f / 64.f) + EPS) * gk;
            const int pos = 16 * n + 31; const float c = rc[pos * 32 + (lane & 31)], s = rs[pos * 32 + (lane & 31)];
            const float pt = __shfl_xor(y, 32);
            a = lane < 32 ? y * c - pt * s : y * c + pt * s;
        }
        *dst = (bf16)f2bf(a);
    }
}

typedef float f32x16 __attribute__((ext_vector_type(16)));
typedef float f32x2v __attribute__((ext_vector_type(2)));
typedef __bf16 bf16x2v __attribute__((ext_vector_type(2)));
typedef short s16x4 __attribute__((ext_vector_type(4)));
typedef unsigned u32x2 __attribute__((ext_vector_type(2)));
#define MFMA32(a, b, c) __builtin_amdgcn_mfma_f32_32x32x16_bf16((a), (b), (c), 0, 0, 0)
#define WG_BAR() do { asm volatile("s_waitcnt vmcnt(0) lgkmcnt(0)" ::: "memory"); __builtin_amdgcn_s_barrier(); asm volatile("" ::: "memory"); } while (0)
DI unsigned pkbf(float lo, float hi) { f32x2v v = {lo, hi}; return __builtin_bit_cast(unsigned, __builtin_convertvector(v, bf16x2v)); }
template <int S> DI bf16x8 pack8(const f32x16& x) {
    v4u p; p.x = pkbf(x[8 * S], x[8 * S + 1]); p.y = pkbf(x[8 * S + 2], x[8 * S + 3]); p.z = pkbf(x[8 * S + 4], x[8 * S + 5]); p.w = pkbf(x[8 * S + 6], x[8 * S + 7]);
    return __builtin_bit_cast(bf16x8, p);
}
DI int crow(int i, int h) { return (i & 3) + 8 * (i >> 2) + 4 * h; }
constexpr int AT_K = 0, AT_V = 32768, AT_IMP = 65536, AT_WM = 98304, AT_INV = 98368, AT_SC = 99392;

DI void glds16(const void* gsrc, unsigned lds_dst) { unsigned keep; asm volatile("s_mov_b32 %0, m0\n\ts_mov_b32 m0, %2\n\ts_nop 0\n\tglobal_load_lds_dwordx4 %1, off\n\ts_mov_b32 m0, %0" : "=&s"(keep) : "v"(gsrc), "s"(lds_dst) : "memory"); }
DI void at_load(LAS unsigned char* lds, int par, const void* kb, size_t kpitch, const void* vb, size_t vpitch, int wave, int lane) {
    const int row = 8 * wave + (lane >> 3), pc = lane & 7;
    const int kc = pc ^ ((row >> 1) & 7), vc = pc ^ (((row >> 1) & 1) << 2);
    glds16((const char*)kb + (size_t)row * kpitch + 16 * kc, (unsigned)(size_t)(lds + AT_K + par * 8192 + wave * 1024));
    glds16((const char*)vb + (size_t)row * vpitch + 16 * vc, (unsigned)(size_t)(lds + AT_V + par * 8192 + wave * 1024));
}
#define SB() __builtin_amdgcn_sched_barrier(0)
typedef __attribute__((address_space(3))) s16x4 lds_s16x4;
DI void at_qk(const LAS unsigned char* kbuf, const int (&ka)[4], const bf16x8 (&qf)[4], f32x16 (&s)[2]) {
    bf16x8 kf[2][4];
#pragma unroll
    for (int kb = 0; kb < 2; ++kb)
#pragma unroll
        for (int st = 0; st < 4; ++st) kf[kb][st] = *(const LAS bf16x8*)(kbuf + ka[st] + kb * 4096);
    SB();
#pragma unroll
    for (int kb = 0; kb < 2; ++kb) {
        f32x16 a;
#pragma unroll
        for (int i = 0; i < 16; ++i) a[i] = 0.f;
#pragma unroll
        for (int st = 0; st < 4; ++st) a = MFMA32(kf[kb][st], qf[st], a);
        s[kb] = a;
    }
}
DI void at_vload(const LAS unsigned char* vbuf, const int (&va)[2], int kb, bf16x8 (&vf)[2][2]) {
#pragma unroll
    for (int s2 = 0; s2 < 2; ++s2)
#pragma unroll
        for (int db = 0; db < 2; ++db) {
            const s16x4 lo = __builtin_amdgcn_ds_read_tr16_b64_v4i16((lds_s16x4*)(vbuf + va[db] + kb * 4096 + s2 * 2048));
            const s16x4 hi = __builtin_amdgcn_ds_read_tr16_b64_v4i16((lds_s16x4*)(vbuf + va[db] + kb * 4096 + s2 * 2048 + 1024));
            vf[s2][db] = __builtin_shufflevector(lo, hi, 0, 1, 2, 3, 4, 5, 6, 7); }
}
DI void at_pv1(const bf16x8 (&vf)[2][2], const f32x16& p, f32x16 (&o)[2]) {
    const bf16x8 pf0 = pack8<0>(p), pf1 = pack8<1>(p);
#pragma unroll
    for (int s2 = 0; s2 < 2; ++s2)
#pragma unroll
        for (int db = 0; db < 2; ++db) o[db] = MFMA32(vf[s2][db], s2 ? pf1 : pf0, o[db]);
}
DI void at_pv(const LAS unsigned char* vbuf, const int (&va)[2], const bf16x8 (&vf0)[2][2], const f32x16 (&p)[2], f32x16 (&o)[2]) {
    bf16x8 vf1[2][2]; at_vload(vbuf, va, 1, vf1);
    at_pv1(vf0, p[0], o);
    at_pv1(vf1, p[1], o);
}
template <class MaskF>
DI void at_exp_pack(const f32x16 (&s)[2], float& l, bf16x8 (&pf)[2][2], MaskF valid) {
#pragma unroll
    for (int kb = 0; kb < 2; ++kb)
#pragma unroll
        for (int s2 = 0; s2 < 2; ++s2) { unsigned w[4];
#pragma unroll
            for (int q = 0; q < 4; ++q) { const int i0 = 8 * s2 + 2 * q;
                const float e0 = __builtin_amdgcn_exp2f(s[kb][i0]), e1 = __builtin_amdgcn_exp2f(s[kb][i0 + 1]);
                const float p0 = valid(kb, i0) ? e0 : 0.f, p1 = valid(kb, i0 + 1) ? e1 : 0.f; l += p0; l += p1; w[q] = pkbf(p0, p1); }
            pf[kb][s2] = __builtin_bit_cast(bf16x8, (v4u){w[0], w[1], w[2], w[3]}); }
}
struct MaskAll { DI bool operator()(int, int) const { return true; } };
DI void at_pv2(const LAS unsigned char* vbuf, const int (&va)[2], const bf16x8 (&vf0)[2][2], const bf16x8 (&pf)[2][2], f32x16 (&o)[2]) {
    bf16x8 vf1[2][2]; at_vload(vbuf, va, 1, vf1);
#pragma unroll
    for (int s2 = 0; s2 < 2; ++s2)
#pragma unroll
        for (int db = 0; db < 2; ++db) o[db] = MFMA32(vf0[s2][db], pf[0][s2], o[db]);
#pragma unroll
    for (int s2 = 0; s2 < 2; ++s2)
#pragma unroll
        for (int db = 0; db < 2; ++db) o[db] = MFMA32(vf1[s2][db], pf[1][s2], o[db]);
}
DI void at_exp_all(f32x16 (&s)[2], float& l) {
#pragma unroll
    for (int kb = 0; kb < 2; ++kb)
#pragma unroll
        for (int i = 0; i < 16; ++i) { const float p = __builtin_amdgcn_exp2f(s[kb][i]); s[kb][i] = p; l += p; }
}
DI void at_wait(int n) {
    if (n >= 2) asm volatile("s_waitcnt vmcnt(4)" ::: "memory"); else if (n == 1) asm volatile("s_waitcnt vmcnt(2)" ::: "memory"); else asm volatile("s_waitcnt vmcnt(0)" ::: "memory");
    asm volatile("s_waitcnt lgkmcnt(0)" ::: "memory"); __builtin_amdgcn_s_barrier(); asm volatile("" ::: "memory");
}
template <bool STORE = true, bool DO_CMP = true, bool DO_SEL = true, bool DO_WIN = true>
DI void nsa_unit(Frame& F, int unit) {
    unsigned char* ws = F.ws; LAS unsigned char* lds = F.lds;
    int lane_ = F.lane_id();
    const int lane = lane_, wave = F.wave, r = lane & 31, h = lane >> 5, g = wave >> 1, qh = wave & 1;
    const int bh = unit & 31, qt = 31 - (unit >> 5), b = bh >> 1, hkv = bh & 1;
    const int qloc = 32 * qh + r, tau = 64 * qt + qloc, qq = tau & 63; const size_t t = (size_t)b * SEQ + tau;
    const bf16* proj = (const bf16*)(ws + WS_PROJ);
    const bf16* qn = (const bf16*)(ws + WS_QN); const bf16* ksn = (const bf16*)(ws + WS_KSN); const bf16* kwn = (const bf16*)(ws + WS_KWN);
    const bf16* kc = (const bf16*)(ws + WS_KC); const bf16* vc = (const bf16*)(ws + WS_VC); bf16* H1 = (bf16*)(ws + WS_H0);
    int ka[4], va[2];
    { const int f = (r >> 1) & 7, fs = f >> 1, hb = h ^ (f & 1);
#pragma unroll
      for (int st = 0; st < 4; ++st) ka[st] = r * 128 + 16 * (((st ^ fs) << 1) | hb);
      const int i16 = lane & 15, q = i16 >> 2, p = i16 & 3, g1 = (lane >> 4) & 1;
#pragma unroll
      for (int db = 0; db < 2; ++db) va[db] = (4 * h + q) * 128 + 16 * ((4 * db + 2 * g1 + (p >> 1)) ^ (((q >> 1) & 1) << 2)) + 8 * (p & 1); }
    bf16x8 qf[4];
#pragma unroll
    for (int st = 0; st < 4; ++st) qf[st] = *(const bf16x8*)(qn + t * 512 + (hkv * 4 + g) * 64 + 16 * st + 8 * h);
    float gate[3];
#pragma unroll
    for (int c = 0; c < 3; ++c) gate[c] = sigm(bf2f(proj[t * NPROJ + PC_NG + (hkv * 4 + g) * 3 + c]));
    f32x16 ofin[2];
#pragma unroll
    for (int i = 0; i < 16; ++i) { ofin[0][i] = 0.f; ofin[1][i] = 0.f; }
    WG_BAR();
    if (DO_CMP) {
        const int ncq = tau >= 31 ? ((tau - 31) >> 4) + 1 : 0;
        const int ntc = (((64 * qt + 63 - 31) >> 4) + 1 > 64) ? 2 : 1;
        const char* kb0 = (const char*)(kc + (size_t)(b * 2 + hkv) * 128 * 64); const char* vb0 = (const char*)(vc + (size_t)(b * 2 + hkv) * 128 * 64);
        at_load(lds, 0, kb0, 128, vb0, 128, wave, lane);
        if (ntc == 2) at_load(lds, 1, kb0 + 64 * 128, 128, vb0 + 64 * 128, 128, wave, lane);
        WG_BAR();
        f32x16 o[2]; float l = 0.f, prevEp = 0.f;
#pragma unroll
        for (int i = 0; i < 16; ++i) { o[0][i] = 0.f; o[1][i] = 0.f; }
        LAS float* I = (LAS float*)(lds + AT_IMP) + (g * 64 + qloc) * 32;
#pragma unroll 1
        for (int tile = 0; tile < 2; ++tile) {
            if (tile < ntc) {
                f32x16 s[2];
                at_qk(lds + AT_K + tile * 8192, ka, qf, s);
                bf16x8 vf[2][2]; at_vload(lds + AT_V + tile * 8192, va, 0, vf); SB();
#pragma unroll
                for (int kb = 0; kb < 2; ++kb)
#pragma unroll
                    for (int i = 0; i < 16; ++i) { const int n = 64 * tile + 32 * kb + crow(i, h); const float p = n < ncq ? __builtin_amdgcn_exp2f(s[kb][i]) : 0.f; s[kb][i] = p; l += p; }
#pragma unroll
                for (int kb = 0; kb < 2; ++kb)
#pragma unroll
                    for (int a = 0; a < 4; ++a) { const int idx = tile * 8 + kb * 4 + a; const float Gv = (s[kb][4 * a] + s[kb][4 * a + 1]) + (s[kb][4 * a + 2] + s[kb][4 * a + 3]);
                        const float Epv = __shfl_xor(s[kb][4 * a + 3], 32);
                        I[2 * idx + h] = Gv + (h ? Epv : prevEp); prevEp = Epv; }
                at_pv(lds + AT_V + tile * 8192, va, vf, s, o);
            } else {
#pragma unroll
                for (int idx = 8; idx < 16; ++idx) I[2 * idx + h] = 0.f;
            }
        }
        const float L = l + __shfl_xor(l, 32); const float inv = L > 0.f ? 1.f / L : 0.f;
        const float gi = gate[0] * inv;
#pragma unroll
        for (int i = 0; i < 16; ++i) { ofin[0][i] += gi * o[0][i]; ofin[1][i] += gi * o[1][i]; }
        if (h == 0) ((LAS float*)(lds + AT_INV))[g * 64 + qloc] = inv;
    }
    WG_BAR();
    unsigned sel = 0u, wm = 0u, um = 0u;
    if (!DO_CMP) { sel = (qt == 31) ? 0xffffffffu : ((1u << (qt + 1)) - 1u); wm = sel; um = sel; }
    else {
        const LAS float* I = (const LAS float*)(lds + AT_IMP) + qloc * 32;
        const LAS float* IV = (const LAS float*)(lds + AT_INV) + qloc;
        const float iv0 = IV[0], iv1 = IV[64], iv2 = IV[128], iv3 = IV[192];
        LAS unsigned* SC = (LAS unsigned*)(lds + AT_SC) + (qh * 32 + r) * 33;
        if (h == 0) {
#pragma unroll
            for (int j = 8 * g; j < 8 * g + 8; ++j) { const float imp = (I[j] * iv0 + I[64 * 32 + j] * iv1) + (I[2 * 64 * 32 + j] * iv2 + I[3 * 64 * 32 + j] * iv3);
                const bool cand = (j >= 1) && (j <= qt - 2);
                SC[j] = cand ? ((__float_as_uint(imp) & ~31u) | (unsigned)(31 - j)) + 32u : 0u; }
        }
        WG_BAR();
        if (qt <= 7) sel = (1u << (qt + 1)) - 1u;
        else {
            sel = 1u | (1u << qt) | (1u << (qt - 1));
            unsigned prev = 0xffffffffu;
#pragma unroll 1
            for (int rd = 0; rd < 5; ++rd) { unsigned best = 0u;
#pragma unroll 8
                for (int j = 0; j < 32; ++j) { const unsigned kx = SC[j]; const unsigned cnd = kx < prev ? kx : 0u; best = cnd > best ? cnd : best; }
                prev = best; if (best) sel |= 1u << (31 - (int)(best & 31u)); }
        }
        sel &= (qt == 31) ? 0xffffffffu : ((1u << (qt + 1)) - 1u);
        wm = sel;
#pragma unroll
        for (int o = 1; o < 32; o <<= 1) wm |= (unsigned)__shfl_xor((int)wm, o);
        wm = (unsigned)__builtin_amdgcn_readfirstlane((int)wm);
        if (lane == 0) ((LAS unsigned*)(lds + AT_WM))[wave] = wm;
        WG_BAR();
        um = 0u;
#pragma unroll
        for (int w = 0; w < 8; ++w) um |= ((const LAS unsigned*)(lds + AT_WM))[w];
        um = (unsigned)__builtin_amdgcn_readfirstlane((int)um);
    }
    if (DO_SEL) {
        f32x16 o[2]; float l = 0.f;
#pragma unroll
        for (int i = 0; i < 16; ++i) { o[0][i] = 0.f; o[1][i] = 0.f; }
        const char* kbase = (const char*)(ksn + (size_t)b * SEQ * 128 + hkv * 64); const char* vbase = (const char*)(proj + (size_t)b * SEQ * NPROJ + PC_NVS + hkv * 64);
        unsigned rem = um, im = um; int k = 0; const int T = __popc(um);
#pragma unroll 1
        for (int i = 0; i < 3 && im; ++i) { const int jn = __ffs((int)im) - 1; im &= im - 1u; at_load(lds, i, kbase + (size_t)jn * 64 * 256, 256, vbase + (size_t)jn * 64 * (NPROJ * 2), NPROJ * 2, wave, lane); }
#pragma unroll 1
        while (rem) {
            const int j = __ffs((int)rem) - 1; rem &= rem - 1u;
            at_wait(T - k - 1);
#ifdef NSA_E1
            at_wait(T - k - 1);
#endif
            if (im) { const int jn = __ffs((int)im) - 1; im &= im - 1u; at_load(lds, (k + 3) & 3, kbase + (size_t)jn * 64 * 256, 256, vbase + (size_t)jn * 64 * (NPROJ * 2), NPROJ * 2, wave, lane); }
            const int par = k & 3;
            if ((wm >> j) & 1u) {
                f32x16 s[2];
                at_qk(lds + AT_K + par * 8192, ka, qf, s);
                bf16x8 vf[2][2]; at_vload(lds + AT_V + par * 8192, va, 0, vf); SB();
                const bool on = (sel >> j) & 1u;
                if (j != qt && __all(on)) at_exp_all(s, l);
                else { const int klim = j == qt ? qq : 63;
#pragma unroll
                    for (int kb = 0; kb < 2; ++kb)
#pragma unroll
                        for (int i = 0; i < 16; ++i) { const int key = 32 * kb + crow(i, h); const float p = (on && key <= klim) ? __builtin_amdgcn_exp2f(s[kb][i]) : 0.f; s[kb][i] = p; l += p; } }
                at_pv(lds + AT_V + par * 8192, va, vf, s, o);
            }
            ++k;
        }
        const float L = l + __shfl_xor(l, 32); const float gi = gate[1] * (L > 0.f ? 1.f / L : 0.f);
#pragma unroll
        for (int i = 0; i < 16; ++i) { ofin[0][i] += gi * o[0][i]; ofin[1][i] += gi * o[1][i]; }
    }
    WG_BAR();
    if (DO_WIN) {
        f32x16 o[2]; float l = 0.f;
#pragma unroll
        for (int i = 0; i < 16; ++i) { o[0][i] = 0.f; o[1][i] = 0.f; }
        const char* kbase = (const char*)(kwn + (size_t)b * SEQ * 128 + hkv * 64); const char* vbase = (const char*)(proj + (size_t)b * SEQ * NPROJ + PC_NVW + hkv * 64);
        const int jlo = qt > 8 ? qt - 8 : 0; const int T = qt - jlo + 1;
#ifdef NSA_E2
        f32x16 o2[2]; float l2 = 0.f;
#pragma unroll
        for (int i = 0; i < 16; ++i) { o2[0][i] = 0.f; o2[1][i] = 0.f; }
#endif
#pragma unroll 1
        for (int i = 0; i < 3 && i < T; ++i) at_load(lds, i, kbase + (size_t)(jlo + i) * 64 * 256, 256, vbase + (size_t)(jlo + i) * 64 * (NPROJ * 2), NPROJ * 2, wave, lane);
#pragma unroll 1
        for (int k = 0; k < T; ++k) {
            const int j = jlo + k, par = k & 3;
            at_wait(T - k - 1);
#ifdef NSA_E1
            at_wait(T - k - 1);
#endif
            if (k + 3 < T) at_load(lds, (k + 3) & 3, kbase + (size_t)(j + 3) * 64 * 256, 256, vbase + (size_t)(j + 3) * 64 * (NPROJ * 2), NPROJ * 2, wave, lane);
            f32x16 s[2];
            at_qk(lds + AT_K + par * 8192, ka, qf, s);
            bf16x8 vf[2][2]; at_vload(lds + AT_V + par * 8192, va, 0, vf); SB();
#ifdef NSA_E2
            { f32x16 s2[2]; asm volatile("" ::: "memory"); at_qk(lds + AT_K + par * 8192, ka, qf, s2); bf16x8 vf2[2][2]; at_vload(lds + AT_V + par * 8192, va, 0, vf2); SB(); at_exp_all(s2, l2); at_pv(lds + AT_V + par * 8192, va, vf2, s2, o2); }
#endif
            if (j != qt && j != qt - 8) at_exp_all(s, l);
            else { const int klo = (j == qt - 8) ? qq + 1 : 0, khi = (j == qt) ? qq : 63;
#pragma unroll
                for (int kb = 0; kb < 2; ++kb)
#pragma unroll
                    for (int i = 0; i < 16; ++i) { const int key = 32 * kb + crow(i, h); const float p = (key >= klo && key <= khi) ? __builtin_amdgcn_exp2f(s[kb][i]) : 0.f; s[kb][i] = p; l += p; } }
            at_pv(lds + AT_V + par * 8192, va, vf, s, o);
        }
#ifdef NSA_E2
        { const float z = l2 * 0.f;
#pragma unroll
          for (int i = 0; i < 16; ++i) { ofin[0][i] += z * o2[0][i]; ofin[1][i] += z * o2[1][i]; } }
#endif
        const float L = l + __shfl_xor(l, 32); const float gi = gate[2] * (L > 0.f ? 1.f / L : 0.f);
#pragma unroll
        for (int i = 0; i < 16; ++i) { ofin[0][i] += gi * o[0][i]; ofin[1][i] += gi * o[1][i]; }
    }
    if (!STORE) { asm volatile("" :: "v"(ofin[0]), "v"(ofin[1])); return; }
    WG_BAR();
#pragma unroll
    for (int db = 0; db < 2; ++db)
#pragma unroll
        for (int a = 0; a < 4; ++a) { u32x2 w; w.x = pkbf(ofin[db][4 * a], ofin[db][4 * a + 1]); w.y = pkbf(ofin[db][4 * a + 2], ofin[db][4 * a + 3]); *(LAS u32x2*)(lds + qloc * 528 + g * 128 + (32 * db + 8 * a + 4 * h) * 2) = w; }
    WG_BAR();
    { const int tid = wave * 64 + lane; bf16* obase = H1 + ((size_t)b * SEQ + 64 * qt) * 1536 + 512 + hkv * 256;
#pragma unroll
      for (int i = 0; i < 4; ++i) { const int piece = tid + 512 * i, row = piece >> 5, c = piece & 31; *(v4u*)(obase + (size_t)row * 1536 + 8 * c) = *(const LAS v4u*)(lds + row * 528 + 16 * c); } }
}
constexpr int ML_K = 0, ML_V = 32768, ML_VW = 65536, ML_C = 81920, ML_N = 114688, ML_SS = 115200, ML_WS = 116224, ML_GO = 120320, ML_ST = 135424;
DI int ml_fk(int s) { return ((s & 3) << 2) | ((s >> 2) & 3); }
DI void ml_load(LAS unsigned char* lds, int par, const char* kb, const char* vb, int wave, int lane) {
#pragma unroll
    for (int n2 = 0; n2 < 2; ++n2) { const int n = 2 * wave + n2, row = 4 * n + (lane >> 4), pc = lane & 15;
        const int kc = pc ^ ml_fk(row), vc = pc ^ ((row & 3) << 2);
        glds16(kb + (size_t)row * 2048 + 16 * kc, (unsigned)(size_t)(lds + ML_K + par * 16384 + n * 1024));
        glds16(vb + (size_t)row * (NPROJ * 2) + 16 * vc, (unsigned)(size_t)(lds + ML_V + par * 16384 + n * 1024)); }
}
DI bf16x8 ml_tr8(const LAS unsigned char* p) {
    const s16x4 lo = __builtin_amdgcn_ds_read_tr16_b64_v4i16((lds_s16x4*)p); const s16x4 hi = __builtin_amdgcn_ds_read_tr16_b64_v4i16((lds_s16x4*)(p + 1024));
    return __builtin_shufflevector(lo, hi, 0, 1, 2, 3, 4, 5, 6, 7);
}
template <int PM = 0xff>
DI void mlstm_unit2(Frame& F, int unit) {
    unsigned char* ws = F.ws; LAS unsigned char* lds = F.lds;
    int lane_ = F.lane_id();
    const int lane = lane_, wave = F.wave, tid = wave * 64 + lane, r = lane & 31, hh = lane >> 5, tb = wave >> 2, vb = wave & 3;
    const int b = unit >> 2, hd = unit & 3;
    const bf16* proj = (const bf16*)(ws + WS_PROJ); const bf16* mlqk = (const bf16*)(ws + WS_MLQK); bf16* H0 = (bf16*)(ws + WS_H0);
    const size_t tok0 = (size_t)b * SEQ;
    const char* kbase = (const char*)(mlqk + tok0 * 1024 + 512 + hd * 128); const char* vbase = (const char*)(proj + tok0 * NPROJ + PC_MLV + hd * 128);
    const float LOG2E = 1.4426950408889634f;
    const int i16 = lane & 15, q4 = i16 >> 2, p4 = i16 & 3, g1 = (lane >> 4) & 1;
    const int colsw = 16 * ((4 * vb + 2 * g1 + (p4 >> 1)) ^ (q4 << 2)) + 8 * (p4 & 1);
    const int base_c = (8 * hh + q4) * 256 + colsw;
    const int base_v = (4 * hh + q4) * 256 + colsw;
    const int fK = ml_fk(r), rowK = r * 256 + ((hh ^ (fK & 1)) << 4), F16 = (fK & 14) << 4;
    int base_kt[2][2];
#pragma unroll
    for (int blk = 0; blk < 2; ++blk)
#pragma unroll
        for (int hi = 0; hi < 2; ++hi) { const int kbp = 2 * tb + blk; base_kt[blk][hi] = (8 * hh + 4 * hi + q4) * 256 + 16 * ((4 * kbp + 2 * g1 + (p4 >> 1)) ^ ((q4 << 2) | ((2 * hh + hi) & 3))) + 8 * (p4 & 1); }
    LAS float* WS = (LAS float*)(lds + ML_WS) + wave * 128;
    LAS float* NV = (LAS float*)(lds + ML_N); LAS float* SS = (LAS float*)(lds + ML_SS);
    __syncthreads();
    for (int i = tid; i < 32768 / 16; i += 512) ((LAS v4u*)(lds + ML_C))[i] = (v4u){0u, 0u, 0u, 0u};
    if (tid < 128) NV[tid] = 0.f;
    f32x16 Cst[2];
#pragma unroll
    for (int i = 0; i < 16; ++i) { Cst[0][i] = 0.f; Cst[1][i] = 0.f; }
    if (tid < 128) ((LAS float*)(lds + ML_GO))[tid] = F.in[I_MLGOUT][hd * 128 + tid];
    const float bi = F.in[I_MLBI][hd], bfv = F.in[I_MLBF][hd];
    float m_prev = 0.f;
    ml_load(lds, 0, kbase, vbase, wave, lane);
    bf16x8 qf[8];
    { const bf16* qp = mlqk + (tok0 + 32 * tb + r) * 1024 + hd * 128 + 8 * hh;
#pragma unroll
      for (int st = 0; st < 8; ++st) qf[st] = *(const bf16x8*)(qp + 16 * st); }
    float gi_raw = bf2f(proj[(tok0 + lane) * NPROJ + PC_MLI + hd]), gf_raw = bf2f(proj[(tok0 + lane) * NPROJ + PC_MLF + hd]);
#pragma unroll 1
    for (int c = 0; c < 32; ++c) {
        const int par = c & 1; const size_t tokc = tok0 + 64 * c;
        WG_BAR();
        if ((PM & 1) && c > 0) {
            bf16* obase = H0 + (tokc - 64) * 1536 + hd * 128;
#pragma unroll
            for (int i = 0; i < 2; ++i) { const int piece = tid + 512 * i, row = piece >> 4, cc = piece & 15; *(v4u*)(obase + (size_t)row * 1536 + 8 * cc) = *(const LAS v4u*)(lds + ML_ST + row * 272 + 16 * cc); } }
        if (c < 31) ml_load(lds, par ^ 1, kbase + (size_t)(64 * (c + 1)) * 2048, vbase + (size_t)(64 * (c + 1)) * (NPROJ * 2), wave, lane);
        u32x2 og[4];
        { const bf16* op = proj + (tokc + 32 * tb + r) * NPROJ + PC_MLO + hd * 128 + 32 * vb + 4 * hh;
#pragma unroll
          for (int a = 0; a < 4; ++a) og[a] = *(const u32x2*)(op + 8 * a); }
        const float ig = gi_raw + bi, lf = logsig(gf_raw + bfv);
        float bc = lf;
        if (PM & 2) {
#pragma unroll
        for (int o = 1; o < 64; o <<= 1) { const float v = __shfl_up(bc, o); if (lane >= o) bc += v; } }
        const float rr = ig - bc;
        float cm = rr;
        if (PM & 2) {
#pragma unroll
        for (int o = 1; o < 64; o <<= 1) { const float v = __shfl_up(cm, o); if (lane >= o) cm = fmaxf(cm, v); } }
        const float M63 = fmaxf(m_prev, __shfl(cm, 63)), blast = __shfl(bc, 63);
        const float a_old = __expf(m_prev - M63), m_new = blast + M63;
        const int tl = 32 * tb + r;
        const float Mt = fmaxf(m_prev, __shfl(cm, tl)), bt = __shfl(bc, tl);
        const float inter = __expf(m_prev - Mt), m_t = bt + Mt;
        WS[lane] = rr * LOG2E; WS[64 + lane] = __expf(rr - M63);
        const float MtL = Mt * LOG2E;
        const LAS unsigned char* kbuf = lds + ML_K + par * 16384; const LAS unsigned char* vbuf = lds + ML_V + par * 16384;
        f32x16 wd[2]; float dsum = 0.f;
#pragma unroll
        for (int kb = 0; kb < 2; ++kb) {
#pragma unroll
            for (int i = 0; i < 16; ++i) wd[kb][i] = 0.f;
            if ((PM & 4) && kb <= tb) {
                f32x16 a = wd[kb]; bf16x8 kfr[8];
#pragma unroll
                for (int st = 0; st < 8; ++st) kfr[st] = *(const LAS bf16x8*)(kbuf + kb * 8192 + rowK + ((32 * st) ^ F16));
                SB();
#pragma unroll
                for (int st = 0; st < 8; ++st) a = MFMA32(kfr[st], qf[st], a);
#pragma unroll
                for (int i = 0; i < 16; ++i) { const int s = 32 * kb + crow(i, hh); const float e = __builtin_amdgcn_exp2f(WS[s] - MtL); const float w = (s <= tl) ? e * a[i] : 0.f; a[i] = w; dsum += w; }
                wd[kb] = a;
            }
        }
        f32x16 acc; bf16x8 cfr[8];
#pragma unroll
        for (int i = 0; i < 16; ++i) acc[i] = 0.f;
        if (PM & 8) {
#pragma unroll
        for (int st = 0; st < 8; ++st) cfr[st] = ml_tr8(lds + ML_C + base_c + st * 4096);
        SB();
#pragma unroll
        for (int st = 0; st < 8; ++st) acc = MFMA32(cfr[st], qf[st], acc); }
#pragma unroll
        for (int i = 0; i < 16; ++i) acc[i] *= inter;
#pragma unroll
        for (int kb = 0; kb < 2; ++kb) {
            if ((PM & 16) && kb <= tb) {
                const bf16x8 pf0 = pack8<0>(wd[kb]), pf1 = pack8<1>(wd[kb]);
                {
#pragma unroll
                  for (int s2 = 0; s2 < 2; ++s2) { const LAS unsigned char* p = vbuf + base_v + kb * 8192 + s2 * 4096;
                    const s16x4 lo = __builtin_amdgcn_ds_read_tr16_b64_v4i16((lds_s16x4*)p); const s16x4 hi = __builtin_amdgcn_ds_read_tr16_b64_v4i16((lds_s16x4*)(p + 2048));
                    const bf16x8 vf = __builtin_shufflevector(lo, hi, 0, 1, 2, 3, 4, 5, 6, 7);
                    acc = MFMA32(vf, s2 ? pf1 : pf0, acc); } }
            }
        }
        float qn_ = 0.f;
        if (PM & 32)
#pragma unroll
        for (int st = 0; st < 8; ++st) { const v4u qw = __builtin_bit_cast(v4u, qf[st]); const LAS float* np = NV + 16 * st + 8 * hh; const f32x4 n0 = *(const LAS f32x4*)np, n1 = *(const LAS f32x4*)(np + 4);
            qn_ = fmaf(__uint_as_float(qw.x << 16), n0[0], qn_); qn_ = fmaf(__uint_as_float(qw.x & 0xffff0000u), n0[1], qn_); qn_ = fmaf(__uint_as_float(qw.y << 16), n0[2], qn_); qn_ = fmaf(__uint_as_float(qw.y & 0xffff0000u), n0[3], qn_);
            qn_ = fmaf(__uint_as_float(qw.z << 16), n1[0], qn_); qn_ = fmaf(__uint_as_float(qw.z & 0xffff0000u), n1[1], qn_); qn_ = fmaf(__uint_as_float(qw.w << 16), n1[2], qn_); qn_ = fmaf(__uint_as_float(qw.w & 0xffff0000u), n1[3], qn_); }
        qn_ += __shfl_xor(qn_, 32); dsum += __shfl_xor(dsum, 32);
        const float den = inter * qn_ + dsum; const float rden = 1.f / fmaxf(fabsf(den), __expf(-m_t));
        float ssq = 0.f;
#pragma unroll
        for (int i = 0; i < 16; ++i) { acc[i] *= rden; ssq = fmaf(acc[i], acc[i], ssq); }
        ssq += __shfl_xor(ssq, 32);
        if (hh == 0) SS[vb * 64 + tl] = ssq;
        if (PM & 64)
#pragma unroll
        for (int k2 = 0; k2 < 2; ++k2) { const int ci = tid + 512 * k2, s = ci >> 4; const float w = WS[64 + s];
            const v4u x = *(const LAS v4u*)(vbuf + ci * 16); v4u y; const unsigned xs[4] = {x.x, x.y, x.z, x.w}; unsigned ys[4];
#pragma unroll
            for (int j = 0; j < 4; ++j) ys[j] = pkbf(__uint_as_float(xs[j] << 16) * w, __uint_as_float(xs[j] & 0xffff0000u) * w);
            y.x = ys[0]; y.y = ys[1]; y.z = ys[2]; y.w = ys[3]; *(LAS v4u*)(lds + ML_VW + ci * 16) = y; }
        asm volatile("s_waitcnt lgkmcnt(0)" ::: "memory"); __builtin_amdgcn_s_barrier(); asm volatile("" ::: "memory");
        if (c < 31) {
            const bf16* qp = mlqk + (tokc + 64 + 32 * tb + r) * 1024 + hd * 128 + 8 * hh;
#pragma unroll
            for (int st = 0; st < 8; ++st) qf[st] = *(const bf16x8*)(qp + 16 * st);
            gi_raw = bf2f(proj[(tokc + 64 + lane) * NPROJ + PC_MLI + hd]); gf_raw = bf2f(proj[(tokc + 64 + lane) * NPROJ + PC_MLF + hd]);
        }
        { const LAS float* GO = (const LAS float*)(lds + ML_GO) + 32 * vb + 4 * hh;
          const float rstd = rsqrtf(((SS[tl] + SS[64 + tl]) + (SS[128 + tl] + SS[192 + tl])) * (1.f / 128.f) + EPS);
#pragma unroll
          for (int a = 0; a < 4; ++a) { float o4[4]; const unsigned gw[2] = {og[a].x, og[a].y};
#pragma unroll
              for (int j = 0; j < 4; ++j) { const float ov = (j & 1) ? __uint_as_float(gw[j >> 1] & 0xffff0000u) : __uint_as_float(gw[j >> 1] << 16); o4[j] = acc[4 * a + j] * rstd * GO[8 * a + j] * sigm(ov); }
              u32x2 w; w.x = pkbf(o4[0], o4[1]); w.y = pkbf(o4[2], o4[3]); *(LAS u32x2*)(lds + ML_ST + tl * 272 + (32 * vb + 8 * a + 4 * hh) * 2) = w; } }
        if (PM & 128)
#pragma unroll
        for (int blk = 0; blk < 2; ++blk) {
            f32x16 cs = Cst[blk];
#pragma unroll
            for (int i = 0; i < 16; ++i) cs[i] *= a_old;
            bf16x8 afr[4], kfr2[4];
#pragma unroll
            for (int st = 0; st < 4; ++st) {
                afr[st] = ml_tr8(lds + ML_VW + base_c + st * 4096);
                const s16x4 lo = __builtin_amdgcn_ds_read_tr16_b64_v4i16((lds_s16x4*)(kbuf + base_kt[blk][0] + st * 4096)); const s16x4 hi = __builtin_amdgcn_ds_read_tr16_b64_v4i16((lds_s16x4*)(kbuf + base_kt[blk][1] + st * 4096));
                kfr2[st] = __builtin_shufflevector(lo, hi, 0, 1, 2, 3, 4, 5, 6, 7);
            }
            SB();
#pragma unroll
            for (int st = 0; st < 4; ++st) cs = MFMA32(afr[st], kfr2[st], cs);
            Cst[blk] = cs;
            const int kk = 32 * (2 * tb + blk) + r;
#pragma unroll
            for (int a = 0; a < 4; ++a) { u32x2 w; w.x = pkbf(cs[4 * a], cs[4 * a + 1]); w.y = pkbf(cs[4 * a + 2], cs[4 * a + 3]);
                *(LAS u32x2*)(lds + ML_C + kk * 256 + 16 * ((4 * vb + a) ^ ((r & 3) << 2)) + 8 * hh) = w; }
        }
        if ((PM & 64) && tid < 128) { float nv = NV[tid] * a_old;
#pragma unroll 8
            for (int s = 0; s < 64; ++s) { const unsigned short kvs = *(const LAS unsigned short*)(kbuf + s * 256 + 16 * ((tid >> 3) ^ ml_fk(s)) + 2 * (tid & 7)); nv = fmaf(WS[64 + s], bf2f(kvs), nv); }
            NV[tid] = nv; }
        m_prev = m_new;
    }
    __syncthreads();
    if (PM & 1) { bf16* obase = H0 + (tok0 + 64 * 31) * 1536 + hd * 128;
#pragma unroll
        for (int i = 0; i < 2; ++i) { const int piece = tid + 512 * i, row = piece >> 4, cc = piece & 15; *(v4u*)(obase + (size_t)row * 1536 + 8 * cc) = *(const LAS v4u*)(lds + ML_ST + row * 272 + 16 * cc); } }
    __syncthreads();
}
DI void mem_load(LAS unsigned char* lds, int par, const char* kb, const char* vb, int wave, int lane) {
#pragma unroll
    for (int n2 = 0; n2 < 2; ++n2) { const int n = 2 * wave + n2, row = 4 * n + (lane >> 4), pc = lane & 15;
        const int kc = pc ^ ml_fk(row), vc = pc ^ ((row & 3) << 2);
        glds16(kb + (size_t)row * 1024 + 16 * kc, (unsigned)(size_t)(lds + ML_K + par * 16384 + n * 1024));
        glds16(vb + (size_t)row * 2048 + 16 * vc, (unsigned)(size_t)(lds + ML_V + par * 16384 + n * 1024)); }
}
template <bool STORE = true, bool DMA = true, bool COMP = true>
DI void mem_unit(Frame& F, int unit) {
    unsigned char* ws = F.ws; LAS unsigned char* lds = F.lds;
    int lane_ = F.lane_id();
    const int lane = lane_, wave = F.wave, r = lane & 31, hh = lane >> 5;
    const int b = unit >> 5, hd = (unit >> 3) & 3, qt = unit & 7;
    const bf16* mqn = (const bf16*)(ws + WS_MQN); const bf16* memkn = (const bf16*)(ws + WS_MEMKN); const bf16* memkv = (const bf16*)(ws + WS_MEMKV); bf16* H2 = (bf16*)(ws + WS_H0);
    const size_t t = (size_t)b * SEQ + 256 * qt + 32 * wave + r;
    const char* kbase = (const char*)(memkn + (size_t)b * MEML * 512 + hd * 128); const char* vbase = (const char*)(memkv + (size_t)b * MEML * 1024 + 512 + hd * 128);
    const int i16 = lane & 15, q4 = i16 >> 2, p4 = i16 & 3, g1 = (lane >> 4) & 1;
    int base_v[4];
#pragma unroll
    for (int db = 0; db < 4; ++db) base_v[db] = (4 * hh + q4) * 256 + 16 * ((4 * db + 2 * g1 + (p4 >> 1)) ^ (q4 << 2)) + 8 * (p4 & 1);
    const int fK = ml_fk(r), rowK = r * 256 + ((hh ^ (fK & 1)) << 4), F16 = (fK & 14) << 4;
    bf16x8 qf[8];
#pragma unroll
    for (int st = 0; st < 8; ++st) qf[st] = *(const bf16x8*)(mqn + t * 512 + hd * 128 + 16 * st + 8 * hh);
    f32x16 o[4]; float l = 0.f;
#pragma unroll
    for (int db = 0; db < 4; ++db)
#pragma unroll
        for (int i = 0; i < 16; ++i) o[db][i] = 0.f;
    WG_BAR();
    if (DMA) mem_load(lds, 0, kbase, vbase, wave, lane);
#pragma unroll 1
    for (int tile = 0; tile < 4; ++tile) {
        const int par = tile & 1;
        WG_BAR();
        if (DMA && tile < 3) mem_load(lds, par ^ 1, kbase + (size_t)(64 * (tile + 1)) * 1024, vbase + (size_t)(64 * (tile + 1)) * 2048, wave, lane);
        const LAS unsigned char* kbuf = lds + ML_K + par * 16384; const LAS unsigned char* vbuf = lds + ML_V + par * 16384;
        if (COMP)
#pragma unroll
        for (int kb = 0; kb < 2; ++kb) {
            bf16x8 kf[8];
#pragma unroll
            for (int st = 0; st < 8; ++st) kf[st] = *(const LAS bf16x8*)(kbuf + kb * 8192 + rowK + ((32 * st) ^ F16));
            SB();
            f32x16 a;
#pragma unroll
            for (int i = 0; i < 16; ++i) a[i] = 0.f;
#pragma unroll
            for (int st = 0; st < 8; ++st) a = MFMA32(kf[st], qf[st], a);
            bf16x8 vf[2][4];
#pragma unroll
            for (int s2 = 0; s2 < 2; ++s2)
#pragma unroll
                for (int db = 0; db < 4; ++db) { const LAS unsigned char* p = vbuf + base_v[db] + kb * 8192 + s2 * 4096;
                    const s16x4 lo = __builtin_amdgcn_ds_read_tr16_b64_v4i16((lds_s16x4*)p); const s16x4 hi = __builtin_amdgcn_ds_read_tr16_b64_v4i16((lds_s16x4*)(p + 2048));
                    vf[s2][db] = __builtin_shufflevector(lo, hi, 0, 1, 2, 3, 4, 5, 6, 7); }
            SB();
#pragma unroll
            for (int i = 0; i < 16; ++i) { a[i] = __builtin_amdgcn_exp2f(a[i]); l += a[i]; }
            const bf16x8 pf0 = pack8<0>(a), pf1 = pack8<1>(a);
#pragma unroll
            for (int s2 = 0; s2 < 2; ++s2)
#pragma unroll
                for (int db = 0; db < 4; ++db) o[db] = MFMA32(vf[s2][db], s2 ? pf1 : pf0, o[db]);
        }
    }
    const float inv = 1.f / (l + __shfl_xor(l, 32));
    if (!STORE) {
#pragma unroll
        for (int db = 0; db < 4; ++db) asm volatile("" :: "v"(o[db]), "v"(inv));
        return; }
    WG_BAR();
#pragma unroll
    for (int db = 0; db < 4; ++db)
#pragma unroll
        for (int a = 0; a < 4; ++a) { u32x2 w; w.x = pkbf(o[db][4 * a] * inv, o[db][4 * a + 1] * inv); w.y = pkbf(o[db][4 * a + 2] * inv, o[db][4 * a + 3] * inv);
            *(LAS u32x2*)(lds + (32 * wave + r) * 272 + (32 * db + 8 * a + 4 * hh) * 2) = w; }
    WG_BAR();
    { const int tid = wave * 64 + lane; bf16* obase = H2 + ((size_t)b * SEQ + 256 * qt) * 1536 + 1024 + hd * 128;
#pragma unroll
      for (int i = 0; i < 8; ++i) { const int piece = tid + 512 * i, row = piece >> 4, c = piece & 15; *(v4u*)(obase + (size_t)row * 1536 + 8 * c) = *(const LAS v4u*)(lds + row * 272 + 16 * c); } }
}
DI int q_pop(Frame& F, unsigned* qc) {
    __syncthreads();
    if (F.tid_id() == 0) F.MISC[16] = atomicAdd(qc, 1u);
    __syncthreads();
    return (int)F.MISC[16];
}
template <bool ML, bool NSA, bool MEMA, bool MST = true, bool MDMA = true, bool MCOMP = true, bool NST = true, bool NCMP = true, bool NSEL = true, bool NWIN = true, int MLPM = 0xff>
DI void p5_queue(Frame& F, int cbase) {
    unsigned* qc = F.ctl + CW_QCTR + cbase;
    if (ML) {
#pragma unroll 1
        for (;;) { const int it = q_pop(F, qc); if (it >= 64) break; mlstm_unit2<MLPM>(F, it); }
    }
    if (NSA) {
#pragma unroll 1
        for (;;) { const int it = q_pop(F, qc + 64); if (it >= 1024) break; nsa_unit<NST, NCMP, NSEL, NWIN>(F, it); }
    }
    if (MEMA) {
#pragma unroll 1
        for (;;) { const int it = q_pop(F, qc + 128); if (it >= 512) break; mem_unit<MST, MDMA, MCOMP>(F, it); }
    }
    __syncthreads();
}
struct OneUnit { int pm; DI bool next(int i, pg8::Unit& u) const { if (i) return false; u.pm = pm; u.pn = 0; return true; } DI void a_ready(const pg8::Unit&) const {} DI void done(const pg8::Unit&) const {} };
DI void p2_compress(Frame& F) {
    unsigned char* ws = F.ws;
    if (F.G < 64 || F.bx >= 32) return;
    const int kv = F.bx >> 4, pm = F.bx & 15;
    typedef pg8::bf16_t b16;
    { pg8::GemmA g{(const b16*)(ws + WS_PROJ) + (kv ? PC_NVC : PC_NKC), (const b16*)(ws + WS_WC1) + (size_t)kv * 256 * 2048, 2048, 16 * NPROJ * 2, (size_t)NPROJ * 2, (size_t)128, (size_t)SEQ * NPROJ * 2};
      OneUnit S{pm};
      pg8::EpiBf16Silu E{(b16*)(ws + WS_HID) + (size_t)kv * 4096 * 256, 256, (const float*)(ws + WS_SMALL + SM_CBIAS) + kv * 256, 1};
      pg8::gemm_phase_ga<pg8::EpiBf16Silu, OneUnit, false, true>(F.lds, g, S, E, F.wave); }
    asm volatile("s_waitcnt vmcnt(0)" ::: "memory"); __syncthreads();
    const int lane = F.lane_id(), r = lane & 31, hh = lane >> 5;
    const int row = pm * 256 + F.wave * 32 + r, n = row & 127;
    const bf16* hid = (const bf16*)(ws + WS_HID) + (size_t)kv * 4096 * 256 + (size_t)row * 256 + 8 * hh;
    const bf16* w2t = (const bf16*)(ws + WS_SMALL + SM_W2T) + (size_t)kv * 64 * 256 + 8 * hh;
    f32x16 acc[2];
#pragma unroll
    for (int i = 0; i < 16; ++i) { acc[0][i] = 0.f; acc[1][i] = 0.f; }
#pragma unroll 4
    for (int st = 0; st < 16; ++st) { const bf16x8 hb = *(const bf16x8*)(hid + 16 * st);
        const bf16x8 w0 = *(const bf16x8*)(w2t + (size_t)r * 256 + 16 * st), w1 = *(const bf16x8*)(w2t + (size_t)(32 + r) * 256 + 16 * st);
        acc[0] = MFMA32(w0, hb, acc[0]); acc[1] = MFMA32(w1, hb, acc[1]); }
    if (kv == 0) {
        float ss = 0.f;
#pragma unroll
        for (int i = 0; i < 16; ++i) ss += acc[0][i] * acc[0][i] + acc[1][i] * acc[1][i];
        ss += __shfl_xor(ss, 32);
        const float rstd = rsqrtf(ss * (1.f / 64.f) + EPS);
        const float* rc = (const float*)(ws + WS_SMALL + SM_ROPEC); const float* rs = (const float*)(ws + WS_SMALL + SM_ROPES);
        const int pos = 16 * n + 31 < SEQ ? 16 * n + 31 : SEQ - 1;
#pragma unroll
        for (int i = 0; i < 16; ++i) { const int d = crow(i, hh); const float c = rc[pos * 32 + d], sn = rs[pos * 32 + d];
            const float y0 = acc[0][i] * rstd * F.in[I_NGK][d], y1 = acc[1][i] * rstd * F.in[I_NGK][32 + d];
            acc[0][i] = y0 * c - y1 * sn; acc[1][i] = y1 * c + y0 * sn; }
    }
    bf16* dst = (bf16*)(ws + (kv ? WS_VC : WS_KC)) + (size_t)row * 64 + 4 * hh;
#pragma unroll
    for (int db = 0; db < 2; ++db)
#pragma unroll
        for (int a = 0; a < 4; ++a) { u32x2 w; w.x = pkbf(acc[db][4 * a], acc[db][4 * a + 1]); w.y = pkbf(acc[db][4 * a + 2], acc[db][4 * a + 3]); if (n == 127) { w.x = 0u; w.y = 0u; }
            *(u32x2*)(dst + 32 * db + 8 * a) = w; }
}
DI void mlstm_unit(Frame& F, int unit) {
    unsigned char* ws = F.ws;
    const int b = unit >> 2, h = unit & 3, tid = F.tid_id(), kk = tid >> 7, c = tid & 127;
    const bf16* proj = (const bf16*)(ws + WS_PROJ); const bf16* mlqk = (const bf16*)(ws + WS_MLQK); bf16* H0 = (bf16*)(ws + WS_H0);
    LAS float* qs = (LAS float*)F.lds;
    LAS float* ks = qs + 16 * 128;
    LAS float* vs = ks + 16 * 128;
    LAS float* gi = vs + 16 * 128;
    LAS float* gf = gi + 16;
    LAS float* part = gf + 16;
    LAS float* pden = part + 2 * 4 * 128;
    LAS float* hb = pden + 8;
    float C[32], nn[32];
#pragma unroll
    for (int i = 0; i < 32; ++i) { C[i] = 0.f; nn[i] = 0.f; }
    float m = 0.f;
    const float bi = F.in[I_MLBI][h], bfv = F.in[I_MLBF][h];
    const float scale = 0.08838834764831845f;
#pragma unroll 1
    for (int t0 = 0; t0 < SEQ; t0 += 16) {
        __syncthreads();
        for (int i = tid; i < 16 * 128; i += 512) { const int s = i >> 7, d = i & 127; const size_t t = (size_t)b * SEQ + t0 + s;
            qs[i] = bf2f(mlqk[t * 1024 + h * 128 + d]); ks[i] = bf2f(mlqk[t * 1024 + 512 + h * 128 + d]); vs[i] = bf2f(proj[t * NPROJ + PC_MLV + h * 128 + d]); }
        if (tid < 16) { const size_t t = (size_t)b * SEQ + t0 + tid; gi[tid] = bf2f(proj[t * NPROJ + PC_MLI + h]) + bi; gf[tid] = logsig(bf2f(proj[t * NPROJ + PC_MLF + h]) + bfv); }
        __syncthreads();
#pragma unroll 1
        for (int s = 0; s < 16; ++s) {
            const float lf = gf[s], ig = gi[s];
            const float mn = fmaxf(lf + m, ig), a = __expf(lf + m - mn), bb = __expf(ig - mn);
            m = mn;
            const float v = vs[s * 128 + c];
            float pn = 0.f, pd = 0.f;
#pragma unroll
            for (int i = 0; i < 32; ++i) { const float kvv = ks[s * 128 + kk * 32 + i], qv = qs[s * 128 + kk * 32 + i];
                C[i] = a * C[i] + bb * kvv * v; nn[i] = a * nn[i] + bb * kvv; pn = fmaf(qv, C[i], pn); pd = fmaf(qv, nn[i], pd); }
            const int par = s & 1;
            part[(par * 4 + kk) * 128 + c] = pn; if (c == 0) pden[par * 4 + kk] = pd;
            __syncthreads();
            if (kk == 0) {
                const float num = (part[(par * 4 + 0) * 128 + c] + part[(par * 4 + 1) * 128 + c]) + (part[(par * 4 + 2) * 128 + c] + part[(par * 4 + 3) * 128 + c]);
                const float den = (pden[par * 4 + 0] + pden[par * 4 + 1]) + (pden[par * 4 + 2] + pden[par * 4 + 3]);
                hb[s * 128 + c] = num * scale / fmaxf(fabsf(den * scale), __expf(-mn));
            }
        }
        __syncthreads();
#pragma unroll
        for (int rr = 0; rr < 2; ++rr) { const int s = F.wave * 2 + rr; const size_t t = (size_t)b * SEQ + t0 + s;
            const float v0 = hb[s * 128 + F.lane_id()], v1 = hb[s * 128 + 64 + F.lane_id()];
            const float rstd = rsqrtf(wave_sum(v0 * v0 + v1 * v1) * (1.f / 128.f) + EPS);
            const float o0 = bf2f(proj[t * NPROJ + PC_MLO + h * 128 + F.lane_id()]), o1 = bf2f(proj[t * NPROJ + PC_MLO + h * 128 + 64 + F.lane_id()]);
            H0[t * 512 + h * 128 + F.lane_id()] = (bf16)f2bf(v0 * rstd * F.in[I_MLGOUT][h * 128 + F.lane_id()] * sigm(o0));
            H0[t * 512 + h * 128 + 64 + F.lane_id()] = (bf16)f2bf(v1 * rstd * F.in[I_MLGOUT][h * 128 + 64 + F.lane_id()] * sigm(o1)); }
    }
    __syncthreads();
}

DI void nsa_scores(const bf16* krow, bool valid, const LAS float* qs, float (&s)[4]) {
    s[0] = s[1] = s[2] = s[3] = 0.f;
    if (valid) {
#pragma unroll 2
        for (int c8 = 0; c8 < 8; ++c8) { const v4u kk = *(const v4u*)(krow + c8 * 8);
            const unsigned w[4] = {kk.x, kk.y, kk.z, kk.w};
#pragma unroll
            for (int j = 0; j < 4; ++j) { const float k0 = __uint_as_float(w[j] << 16), k1 = __uint_as_float(w[j] & 0xffff0000u); const int d = c8 * 8 + 2 * j;
#pragma unroll
                for (int g = 0; g < 4; ++g) s[g] = fmaf(k1, qs[g * 64 + d + 1], fmaf(k0, qs[g * 64 + d], s[g])); } }
    }
}
DI void nsa_wave(Frame& F, int item, LAS float* wl) {
    unsigned char* ws = F.ws; const int lane = F.lane_id();
    const int t = item >> 1, hkv = item & 1, b = t >> 11, tau = t & 2047;
    const bf16* proj = (const bf16*)(ws + WS_PROJ);
    const bf16* qn = (const bf16*)(ws + WS_QN); const bf16* ksn = (const bf16*)(ws + WS_KSN); const bf16* kwn = (const bf16*)(ws + WS_KWN);
    const bf16* kc = (const bf16*)(ws + WS_KC); const bf16* vc = (const bf16*)(ws + WS_VC); bf16* H1 = (bf16*)(ws + WS_H1);
    LAS float* qs = wl;
    LAS float* ps = wl + 256;
    LAS float* psum = wl + 768;
#pragma unroll
    for (int g = 0; g < 4; ++g) qs[g * 64 + lane] = bf2f(qn[(size_t)t * 512 + (hkv * 4 + g) * 64 + lane]);
    float ofin[4] = {0.f, 0.f, 0.f, 0.f};
    float gate[4][3];
#pragma unroll
    for (int g = 0; g < 4; ++g)
#pragma unroll
        for (int cidx = 0; cidx < 3; ++cidx) gate[g][cidx] = sigm(bf2f(proj[(size_t)t * NPROJ + PC_NG + (hkv * 4 + g) * 3 + cidx]));
    const int ncmp = tau >= 31 ? ((tau - 31) >> 4) + 1 : 0;
    {
        float l[4] = {0.f, 0.f, 0.f, 0.f}, o[4] = {0.f, 0.f, 0.f, 0.f};
        const size_t rbase = (size_t)(b * 2 + hkv) * 128;
#pragma unroll
        for (int blk = 0; blk < 2; ++blk) { const int n = blk * 64 + lane; const bool valid = n < ncmp; float s[4];
            nsa_scores(kc + (rbase + n) * 64, valid, qs, s);
#pragma unroll
            for (int g = 0; g < 4; ++g) { const float p = valid ? __expf(s[g]) : 0.f; l[g] += p; ps[g * 128 + n] = p; } }
        float inv[4];
#pragma unroll
        for (int g = 0; g < 4; ++g) { const float L = wave_sum(l[g]); inv[g] = L > 0.f ? 1.f / L : 0.f; }
#pragma unroll
        for (int blk = 0; blk < 2; ++blk) { const int n = blk * 64 + lane; psum[n] = (ps[0 * 128 + n] * inv[0] + ps[1 * 128 + n] * inv[1]) + (ps[2 * 128 + n] * inv[2] + ps[3 * 128 + n] * inv[3]); }
#pragma unroll 2
        for (int n = 0; n < ncmp; ++n) { const float vv = bf2f(vc[(rbase + n) * 64 + lane]);
#pragma unroll
            for (int g = 0; g < 4; ++g) o[g] = fmaf(ps[g * 128 + n], vv, o[g]); }
#pragma unroll
        for (int g = 0; g < 4; ++g) ofin[g] += gate[g][0] * o[g] * inv[g];
    }
    const int cur = tau >> 6;
    unsigned selmask = 0u;
    {
        float score = -3.0e38f;
        if (lane < 32) { const int j = lane; float imp = 0.f;
#pragma unroll
            for (int dn = -1; dn <= 3; ++dn) { const int n = 4 * j + dn; if (n >= 0 && n <= 126) imp += psum[n]; }
            const bool forced = (j == 0) || (j == cur) || (j == cur - 1);
            score = j > cur ? NEGF : imp + (forced ? 1.0e4f : 0.f); }
#pragma unroll 1
        for (int r = 0; r < 8; ++r) { const float mx = wave_max(score); const unsigned long long bal = __ballot(score == mx); const int win = __ffsll((long long)bal) - 1;
            selmask |= 1u << win; if (lane == win) score = -3.4e38f; }
    }
    {
        float l[4] = {0.f, 0.f, 0.f, 0.f}, o[4] = {0.f, 0.f, 0.f, 0.f};
#pragma unroll 1
        for (int j = 0; j <= cur; ++j) { if (!((selmask >> j) & 1u)) continue;
            const int kpos = 64 * j + lane; const bool valid = kpos <= tau; float s[4];
            nsa_scores(ksn + ((size_t)b * SEQ + kpos) * 128 + hkv * 64, valid, qs, s);
#pragma unroll
            for (int g = 0; g < 4; ++g) { const float p = valid ? __expf(s[g]) : 0.f; l[g] += p; ps[g * 128 + lane] = p; }
            const int nk = j == cur ? (tau & 63) + 1 : 64;
            const bf16* vb = proj + ((size_t)b * SEQ + 64 * j) * NPROJ + PC_NVS + hkv * 64 + lane;
#pragma unroll 2
            for (int k = 0; k < nk; ++k) { const float vv = bf2f(vb[(size_t)k * NPROJ]);
#pragma unroll
                for (int g = 0; g < 4; ++g) o[g] = fmaf(ps[g * 128 + k], vv, o[g]); } }
#pragma unroll
        for (int g = 0; g < 4; ++g) { const float L = wave_sum(l[g]); ofin[g] += gate[g][1] * o[g] * (L > 0.f ? 1.f / L : 0.f); }
    }
    {
        float l[4] = {0.f, 0.f, 0.f, 0.f}, o[4] = {0.f, 0.f, 0.f, 0.f};
        const int start = tau - 511 > 0 ? tau - 511 : 0;
#pragma unroll 1
        for (int base = start & ~63; base <= tau; base += 64) {
            const int kpos = base + lane; const bool valid = kpos >= start && kpos <= tau; float s[4];
            nsa_scores(kwn + ((size_t)b * SEQ + kpos) * 128 + hkv * 64, valid, qs, s);
#pragma unroll
            for (int g = 0; g < 4; ++g) { const float p = valid ? __expf(s[g]) : 0.f; l[g] += p; ps[g * 128 + lane] = p; }
            const int k0 = start > base ? start - base : 0, k1 = tau - base < 63 ? tau - base : 63;
            const bf16* vb = proj + ((size_t)b * SEQ + base) * NPROJ + PC_NVW + hkv * 64 + lane;
#pragma unroll 2
            for (int k = k0; k <= k1; ++k) { const float vv = bf2f(vb[(size_t)k * NPROJ]);
#pragma unroll
                for (int g = 0; g < 4; ++g) o[g] = fmaf(ps[g * 128 + k], vv, o[g]); } }
#pragma unroll
        for (int g = 0; g < 4; ++g) { const float L = wave_sum(l[g]); ofin[g] += gate[g][2] * o[g] * (L > 0.f ? 1.f / L : 0.f); }
    }
#pragma unroll
    for (int g = 0; g < 4; ++g) H1[(size_t)t * 512 + (hkv * 4 + g) * 64 + lane] = (bf16)f2bf(ofin[g]);
}
DI void mem_wave(Frame& F, int t, LAS float* wl) {
    unsigned char* ws = F.ws; const int lane = F.lane_id(); const int b = t >> 11;
    const bf16* mqn = (const bf16*)(ws + WS_MQN); const bf16* memkn = (const bf16*)(ws + WS_MEMKN); const bf16* memkv = (const bf16*)(ws + WS_MEMKV); bf16* H2 = (bf16*)(ws + WS_H2);
    LAS float* qs = wl;
    LAS float* ps = wl + 128;
#pragma unroll 1
    for (int h = 0; h < 4; ++h) {
        qs[lane] = bf2f(mqn[(size_t)t * 512 + h * 128 + lane]); qs[64 + lane] = bf2f(mqn[(size_t)t * 512 + h * 128 + 64 + lane]);
        float l = 0.f;
#pragma unroll 1
        for (int kq = 0; kq < 4; ++kq) { const int key = kq * 64 + lane; const bf16* kr = memkn + ((size_t)b * MEML + key) * 512 + h * 128; float s = 0.f;
#pragma unroll 2
            for (int c8 = 0; c8 < 16; ++c8) { const v4u kk = *(const v4u*)(kr + c8 * 8); const unsigned w[4] = {kk.x, kk.y, kk.z, kk.w};
#pragma unroll
                for (int j = 0; j < 4; ++j) s = fmaf(__uint_as_float(w[j] & 0xffff0000u), qs[c8 * 8 + 2 * j + 1], fmaf(__uint_as_float(w[j] << 16), qs[c8 * 8 + 2 * j], s)); }
            const float p = __expf(s); l += p; ps[key] = p; }
        const float inv = 1.f / wave_sum(l);
        float o0 = 0.f, o1 = 0.f;
        const bf16* vb = memkv + (size_t)b * MEML * 1024 + 512 + h * 128;
#pragma unroll 4
        for (int key = 0; key < MEML; ++key) { const float p = ps[key]; o0 = fmaf(p, bf2f(vb[(size_t)key * 1024 + lane]), o0); o1 = fmaf(p, bf2f(vb[(size_t)key * 1024 + 64 + lane]), o1); }
        H2[(size_t)t * 512 + h * 128 + lane] = (bf16)f2bf(o0 * inv); H2[(size_t)t * 512 + h * 128 + 64 + lane] = (bf16)f2bf(o1 * inv);
    }
}
DI void p5_mixers(Frame& F) {
    const int nml = F.G >= 128 ? 64 : 0;
#ifndef RPT_ML
#define RPT_ML 1
#endif
#ifndef RPT_NSA
#define RPT_NSA 1
#endif
#ifndef RPT_MEM
#define RPT_MEM 1
#endif
    if (F.bx < nml || nml == 0) { for (int rp = 0; rp < RPT_ML; ++rp) for (int u = F.bx; u < 64; u += (nml ? nml : F.G)) mlstm_unit2(F, u); }
    if (F.bx >= nml) {
        LAS float* wl = (LAS float*)(F.lds + F.wave * 4096);
        const int gw = (F.bx - nml) * NWAVES + F.wave, NGW = (F.G - nml) * NWAVES;
        for (int rp = 0; rp < RPT_NSA; ++rp) for (int u = F.bx - nml; u < 1024; u += F.G - nml) nsa_unit(F, u);
        __syncthreads();
        for (int rp = 0; rp < RPT_MEM; ++rp) for (int t = gw; t < MT; t += NGW) mem_wave(F, t, wl);
    }
}

DI void p8_router(Frame& F, int alt) {
    unsigned char* ws = F.ws + (size_t)alt * 3 * MiB; const int lane = F.lane_id(), tid = F.tid_id(), wave = F.wave, r = lane & 31, hh = lane >> 5;
    unsigned char* xn8 = (unsigned char*)(F.ws + WS_R1);
    int* tok_e = (int*)(ws + WS_ROUTE + RT_TOKE); int* tok_pos = (int*)(ws + WS_ROUTE + RT_TOKPOS); float* tok_w = (float*)(ws + WS_ROUTE + RT_TOKW);
    unsigned* gcnt = F.ctl + CW_ECNT + 64 * alt;
    const bf16* wrt = (const bf16*)(F.ws + WS_SMALL + SM_WRT);
    LAS unsigned char* img = F.lds;
    LAS float* part = (LAS float*)F.lds;
    LAS float* lg = (LAS float*)(F.lds + 4 * 64 * 33 * 4);
    LAS int* lcnt = (LAS int*)(F.lds + RING_BYTES + 1024);
    LAS int* lbase = lcnt + 32;
    LAS int* se = lbase + 32;
    LAS int* sp = se + 256;
    LAS float* sw = (LAS float*)(sp + 256);
    const float* gf = F.in[I_GFFN];
    for (int bt = F.bx; bt < MT / 64; bt += F.G) {
        __syncthreads();
        if (tid < 32) lcnt[tid] = 0;
        const f32x4* gr = (const f32x4*)gf + 4 * lane; const f32x4 g0 = gr[0], g1 = gr[1], g2 = gr[2], g3 = gr[3];
#pragma unroll 1
        for (int i0 = 0; i0 < 8; i0 += 4) {
            f32x4 v[4][4];
#pragma unroll
            for (int u = 0; u < 4; ++u) { const int t = bt * 64 + wave * 8 + i0 + u; const f32x4* xr = (const f32x4*)(F.out + (size_t)t * DM) + 4 * lane;
#pragma unroll
                for (int j = 0; j < 4; ++j) v[u][j] = xr[j]; }
#pragma unroll
            for (int u = 0; u < 4; ++u) { const int tl = wave * 8 + i0 + u, t = bt * 64 + tl; float sq = 0.f;
#pragma unroll
                for (int j = 0; j < 4; ++j) sq += (v[u][j].x * v[u][j].x + v[u][j].y * v[u][j].y) + (v[u][j].z * v[u][j].z + v[u][j].w * v[u][j].w);
                const float rstd = rsqrtf(wave_sum(sq) * (1.f / DM) + EPS);
                const f32x4 gg[4] = {g0, g1, g2, g3}; unsigned q[4]; unsigned bw[8];
#pragma unroll
                for (int j = 0; j < 4; ++j) { const float y0 = v[u][j].x * rstd * gg[j].x, y1 = v[u][j].y * rstd * gg[j].y, y2 = v[u][j].z * rstd * gg[j].z, y3 = v[u][j].w * rstd * gg[j].w;
                    bw[2 * j] = pk2(y0, y1); bw[2 * j + 1] = pk2(y2, y3);
                    int q8 = 0; q8 = __builtin_amdgcn_cvt_pk_fp8_f32(y0, y1, q8, false); q8 = __builtin_amdgcn_cvt_pk_fp8_f32(y2, y3, q8, true); q[j] = (unsigned)q8; }
                *((v4u*)(xn8 + (size_t)t * DM) + lane) = (v4u){q[0], q[1], q[2], q[3]};
                *(LAS v4u*)(img + tl * 2048 + 16 * ((2 * lane) ^ (tl & 15))) = (v4u){bw[0], bw[1], bw[2], bw[3]};
                *(LAS v4u*)(img + tl * 2048 + 16 * ((2 * lane + 1) ^ (tl & 15))) = (v4u){bw[4], bw[5], bw[6], bw[7]}; }
        }
        __syncthreads();
        {
            const int mb = wave & 1, kq = wave >> 1, trow = 32 * mb + r;
            f32x16 acc;
#pragma unroll
            for (int i = 0; i < 16; ++i) acc[i] = 0.f;
#pragma unroll 4
            for (int s2 = 0; s2 < 16; ++s2) { const int st = 16 * kq + s2;
                const bf16x8 xa = *(const LAS bf16x8*)(img + trow * 2048 + 16 * ((2 * st + hh) ^ (trow & 15)));
                const bf16x8 wh = *(const bf16x8*)(wrt + (size_t)r * 1024 + 16 * st + 8 * hh), wl = *(const bf16x8*)(wrt + 32 * 1024 + (size_t)r * 1024 + 16 * st + 8 * hh);
                acc = MFMA32(xa, wh, acc); acc = MFMA32(xa, wl, acc); }
            __syncthreads();
#pragma unroll
            for (int i = 0; i < 16; ++i) part[(kq * 64 + 32 * mb + crow(i, hh)) * 33 + r] = acc[i];
        }
        __syncthreads();
        for (int i = tid; i < 64 * 32; i += 512) { const int tk = i >> 5, e = i & 31; lg[tk * 33 + e] = ((part[(0 * 64 + tk) * 33 + e] + part[(1 * 64 + tk) * 33 + e]) + (part[(2 * 64 + tk) * 33 + e] + part[(3 * 64 + tk) * 33 + e])) + F.in[I_BR][e]; }
        __syncthreads();
        if (wave == 0) {
            const int tl = lane; float v[32];
#pragma unroll
            for (int e = 0; e < 32; ++e) v[e] = lg[tl * 33 + e];
            unsigned taken = 0u; int ek[4]; float vk[4];
#pragma unroll
            for (int rd = 0; rd < 4; ++rd) { float best = -3.4e38f; int bi = 0;
#pragma unroll
                for (int e = 0; e < 32; ++e) { const float x = ((taken >> e) & 1u) ? -3.4e38f : v[e]; if (x > best) { best = x; bi = e; } }
                taken |= 1u << bi; ek[rd] = bi; vk[rd] = best; }
            const float e1 = __expf(vk[1] - vk[0]), e2 = __expf(vk[2] - vk[0]), e3 = __expf(vk[3] - vk[0]); const float inv = 1.f / (1.f + e1 + e2 + e3);
            const float wk[4] = {inv, e1 * inv, e2 * inv, e3 * inv};
#pragma unroll
            for (int rd = 0; rd < 4; ++rd) { se[tl * 4 + rd] = ek[rd]; sw[tl * 4 + rd] = wk[rd]; sp[tl * 4 + rd] = atomicAdd((int*)&lcnt[ek[rd]], 1); }
        }
        __syncthreads();
        if (tid < 32) lbase[tid] = (int)atomicAdd(&gcnt[tid], (unsigned)lcnt[tid]);
        __syncthreads();
        if (tid < 256) { const int t = bt * 64 + (tid >> 2), k = tid & 3; const int e = se[tid];
          tok_e[t * 4 + k] = e; tok_pos[t * 4 + k] = lbase[e] + sp[tid]; tok_w[t * 4 + k] = sw[tid]; }
    }
    __syncthreads();
}
DI int moe_tables(Frame& F, LAS int* pstart, LAS unsigned char* blk_e) {
    unsigned* gcnt = F.ctl + CW_ECNT;
    __syncthreads();
    if (F.wave == 0) {
        const int l = F.lane_id(); int pad = 0;
        if (l < NEXP) { const int cnt = (int)__hip_atomic_load(&gcnt[l], __ATOMIC_RELAXED, __HIP_MEMORY_SCOPE_AGENT); pad = (cnt + MOEB - 1) / MOEB * MOEB; }
        int inc = pad;
#pragma unroll
        for (int o = 1; o < 32; o <<= 1) { const int v = __shfl_up(inc, o); if (l >= o) inc += v; }
        if (l < NEXP) pstart[l] = inc - pad;
        if (l == NEXP - 1) pstart[NEXP] = inc;
    }
    __syncthreads();
    const int nblk = pstart[NEXP] / MOEB;
    for (int rb = F.tid_id(); rb < nblk; rb += 512) { int e = 0; while (e < NEXP - 1 && pstart[e + 1] <= rb * MOEB) ++e; blk_e[rb] = (unsigned char)e; }
    __syncthreads();
    return nblk;
}
DI void p9_scatter(Frame& F) {
    unsigned char* ws = F.ws; const int lane = F.lane_id();
    LAS int* pstart = (LAS int*)(F.lds + 65536); LAS unsigned char* blk_e = (LAS unsigned char*)(F.lds + 65536 + 256);
    moe_tables(F, pstart, blk_e);
    const int* tok_e = (const int*)(ws + WS_ROUTE + RT_TOKE); const int* tok_pos = (const int*)(ws + WS_ROUTE + RT_TOKPOS); const float* tok_w = (const float*)(ws + WS_ROUTE + RT_TOKW);
    int* tok_dest = (int*)(ws + WS_ROUTE + RT_TOKDEST); float* roww = (float*)(ws + WS_ROUTE + RT_ROWW); int* rowtok = (int*)(ws + WS_ROUTE + RT_ROWTOK);
    unsigned* gcnt = F.ctl + CW_ECNT;
    for (int it = F.bx * 512 + F.tid_id(); it < NROWS; it += F.G * 512) {
        const int dest = pstart[tok_e[it]] + tok_pos[it];
        tok_dest[it] = dest; roww[dest] = tok_w[it]; rowtok[dest] = it >> 2; }
    for (int it = F.bx * 512 + F.tid_id(); it < NEXP * MOEB; it += F.G * 512) { const int e = it >> 8, i = it & 255; const int cnt = (int)__hip_atomic_load(&gcnt[e], __ATOMIC_RELAXED, __HIP_MEMORY_SCOPE_AGENT); const int padded = (cnt + MOEB - 1) / MOEB * MOEB;
        if (i < padded - cnt) { const int dest = pstart[e] + cnt + i; roww[dest] = 0.f; rowtok[dest] = 0; } }
    (void)lane;
}
DI void p12_combine(Frame& F) {
    unsigned char* ws = F.ws; const int lane = F.lane_id();
    const unsigned char* ybuf = (const unsigned char*)(ws + WS_APERM); const int* tok_dest = (const int*)(ws + WS_ROUTE + RT_TOKDEST);
    const int gw = F.bx * NWAVES + F.wave, NGW = F.G * NWAVES;
    typedef float f32x2t __attribute__((ext_vector_type(2)));
    for (int t2 = gw; t2 < MT / 2; t2 += NGW) {
        typedef int i32x4 __attribute__((ext_vector_type(4)));
        v4u w[2][4]; f32x4 a[2][4];
#pragma unroll
        for (int q = 0; q < 2; ++q) { const int t = 2 * t2 + q; const f32x4* orow = (const f32x4*)(F.out + (size_t)t * DM) + 4 * lane;
            const i32x4 d = *(const i32x4*)(tok_dest + t * 4); const int dd[4] = {d.x, d.y, d.z, d.w};
#pragma unroll
            for (int k = 0; k < 4; ++k) w[q][k] = *((const v4u*)(ybuf + (size_t)dd[k] * DM) + lane);
#pragma unroll
            for (int j = 0; j < 4; ++j) a[q][j] = orow[j]; }
#pragma unroll
        for (int q = 0; q < 2; ++q) { f32x4* orow = (f32x4*)(F.out + (size_t)(2 * t2 + q) * DM) + 4 * lane;
#pragma unroll
            for (int j = 0; j < 4; ++j) { f32x4 sacc = {0.f, 0.f, 0.f, 0.f};
#pragma unroll
                for (int k = 0; k < 4; ++k) { const unsigned ww = j == 0 ? w[q][k].x : j == 1 ? w[q][k].y : j == 2 ? w[q][k].z : w[q][k].w;
                    const f32x2t lo = __builtin_amdgcn_cvt_pk_f32_fp8((int)ww, false), hi = __builtin_amdgcn_cvt_pk_f32_fp8((int)ww, true);
                    sacc.x += lo.x; sacc.y += lo.y; sacc.z += hi.x; sacc.w += hi.y; }
                orow[j] = a[q][j] + sacc * 0.125f; } }
    }
}

constexpr int N_PHASES = 13;
#ifndef MK_PER_PHASE
#define MK_PER_PHASE 0
#endif
__global__ void __launch_bounds__(NWAVES * 64, 2) fwd_kernel(Args args) {
    extern __shared__ __attribute__((aligned(16))) unsigned char lds_raw[];
    Frame F;
    F.lds = (LAS unsigned char*)lds_raw; F.MISC = (volatile LAS unsigned*)(F.lds + MISC_OFF);
    F.wave = __builtin_amdgcn_readfirstlane((int)(threadIdx.x >> 6)); F.G = gridDim.x; F.bx = blockIdx.x;
    F.ws = args.ws; F.ctl = (unsigned*)(args.ws + WS_CTL); F.in = args.in; F.out = args.out;
    unsigned char* ws = args.ws;
    for (int u = threadIdx.x; u < (LDS_BYTES - LDSCTL_OFF) / 4; u += NWAVES * 64) ((LAS unsigned*)(F.lds + LDSCTL_OFF))[u] = 0u;
    __syncthreads();
    const int lo = args.ph_lo, hi = args.ph_hi;
    XcdBarrier bar; bar.wv = F.wave; bar.bar = F.ctl + CW_BAR; bar.x = 0; bar.st = nullptr;
    if (hi - lo > 1) bar = xcd_barrier_post(F.ctl + CW_BAR, F.MISC + 8, F.wave);
#ifndef PH_MASK
#define PH_MASK 0x1fff
#endif
#define IN(k) (((PH_MASK >> (k)) & 1) && lo <= (k) && (k) < hi)
#define SEAM(k) do { if (IN(k) && IN((k) + 1)) xcd_barrier(bar); } while (0)
    typedef pg8::bf16_t b16;
#ifndef RPT_MASK
#define RPT_MASK 0
#endif
#define RPT(k) _Pragma("unroll") for (int rp_ = 0; rp_ < 1 + ((RPT_MASK >> (k)) & 1); ++rp_)
#ifndef P0PARTS
#define P0PARTS 0xf
#endif
    if (IN(0)) { p0_prologue<0xf>(F); if (RPT_MASK & 1) p0_prologue<P0PARTS>(F); } SEAM(0);
    if (IN(1)) RPT(1) {
        { pg8::Gemm8 g{(const unsigned char*)(ws + WS_U8), (const unsigned char*)(ws + WS_WIN8), MT, NF8, DM, 0x7f7f7f7f, 0x77777777}; pg8::StaticOrder S; S.init(MT, NF8, F.G, F.bx);
          pg8::EpiBf16Silu E{(b16*)(ws + WS_PROJ) + NB16, NPROJ, nullptr, 0};
          pg8::gemm_phase_f8<pg8::EpiBf16Silu, pg8::StaticOrder, true, true>(F.lds, g, S, E, F.wave); }
        { pg8::Gemm g{(const b16*)(ws + WS_R1), (const b16*)(ws + WS_WIN), MT, NB16, DM}; pg8::StaticOrder S; S.init(MT, NB16, F.G, F.bx);
          pg8::EpiBf16Silu E{(b16*)(ws + WS_PROJ), NPROJ, nullptr, 0};
          pg8::gemm_phase<pg8::EpiBf16Silu, pg8::StaticOrder, true, true>(F.lds, g, S, E, F.wave); }
        { pg8::Gemm g{(const b16*)(ws + WS_MEMN), (const b16*)(ws + WS_WMKV), MROWS, 1024, DM}; pg8::StaticOrder S; S.init(MROWS, 1024, F.G, (F.bx + 64) % F.G);
          pg8::EpiBf16Silu E{(b16*)(ws + WS_MEMKV), 1024, nullptr, 0};
          pg8::gemm_phase<pg8::EpiBf16Silu, pg8::StaticOrder, true, true>(F.lds, g, S, E, F.wave); }
    } SEAM(1);
    if (IN(2)) { RPT(2) { p2_compress(F); p2_prep(F); } }
    if (IN(2) && IN(5)) xcd_barrier(bar);
#ifndef RPT5_ML
#define RPT5_ML 0
#endif
#ifndef MLPROBE
#define MLPROBE 0xff
#endif
#ifndef NPROBE_ST
#define NPROBE_ST true
#endif
#ifndef NPROBE_CMP
#define NPROBE_CMP true
#endif
#ifndef NPROBE_SEL
#define NPROBE_SEL true
#endif
#ifndef NPROBE_WIN
#define NPROBE_WIN true
#endif
#ifndef MPROBE_ST
#define MPROBE_ST true
#endif
#ifndef MPROBE_DMA
#define MPROBE_DMA true
#endif
#ifndef MPROBE_COMP
#define MPROBE_COMP true
#endif
#ifndef RPT5_NSA
#define RPT5_NSA 0
#endif
#ifndef RPT5_MEM
#define RPT5_MEM 0
#endif
    if (IN(5)) { p5_queue<true, true, true>(F, 0);
        if (RPT5_ML || RPT5_NSA || RPT5_MEM) { xcd_barrier(bar); p5_queue<RPT5_ML != 0, RPT5_NSA != 0, RPT5_MEM != 0, MPROBE_ST, MPROBE_DMA, MPROBE_COMP, NPROBE_ST, NPROBE_CMP, NPROBE_SEL, NPROBE_WIN, MLPROBE>(F, 256); } } SEAM(5);
    if (IN(6)) RPT(6) {
        pg8::StaticOrder S; S.init(MT, DM, F.G, F.bx);
        pg8::Gemm g{(const b16*)(ws + WS_H0), (const b16*)(ws + WS_WBR), MT, DM, 1536};
        pg8::EpiMergeK E{(const b16*)(ws + WS_PROJ), (b16*)(ws + WS_R1)};
        pg8::gemm_phase<pg8::EpiMergeK, pg8::StaticOrder, true, true>(F.lds, g, S, E, F.wave);
    } SEAM(6);
    if (IN(7)) RPT(7) {
        pg8::Gemm g{(const b16*)(ws + WS_R1), (const b16*)(ws + WS_WOUT), MT, DM, DM}; pg8::StaticOrder S; S.init(MT, DM, F.G, F.bx);
        pg8::EpiRes E{F.in[I_X], F.out};
        pg8::gemm_phase<pg8::EpiRes, pg8::StaticOrder, true, true>(F.lds, g, S, E, F.wave);
    } SEAM(7);
    if (IN(8)) { p8_router(F, 0); if ((RPT_MASK >> 8) & 1) p8_router(F, 1); } SEAM(8);
    if (IN(9)) { RPT(9) p9_scatter(F); } SEAM(9);
    if (IN(10)) RPT(10) {
        LAS int* pstart = (LAS int*)(F.lds + RING_BYTES + 1024); LAS unsigned char* blk_e = (LAS unsigned char*)(F.lds + RING_BYTES + 1024 + 256);
        const int nblk = moe_tables(F, pstart, blk_e);
        pg8::Gemm8G g{(const unsigned char*)(ws + WS_R1), (const unsigned char*)(ws + WS_WGU), (const int*)(ws + WS_ROUTE + RT_ROWTOK), DM, 0x7f7f7f7f, 0x77777777};
        pg8::MoeOrder<8> S{nblk, F.G, F.bx, (const PG8_LAS unsigned char*)blk_e};
        pg8::EpiSwiglu E{(unsigned char*)(ws + WS_ACT), F.in[I_BGU]};
        pg8::gemm_phase_f8g<pg8::EpiSwiglu, pg8::MoeOrder<8>, true, true>(F.lds, g, S, E, F.wave);
    } SEAM(10);
    if (IN(11)) RPT(11) {
        LAS int* pstart = (LAS int*)(F.lds + RING_BYTES + 1024); LAS unsigned char* blk_e = (LAS unsigned char*)(F.lds + RING_BYTES + 1024 + 256);
        const int nblk = moe_tables(F, pstart, blk_e);
        pg8::Gemm8 g{(const unsigned char*)(ws + WS_ACT), (const unsigned char*)(ws + WS_WDN), CAP, NEXP * DM, DFF, 0x7f7f7f7f, 0x77777777};
        pg8::MoeOrder<4> S{nblk, F.G, F.bx, (const PG8_LAS unsigned char*)blk_e};
        pg8::EpiDown E{(unsigned char*)(ws + WS_APERM), F.in[I_BDN], (const float*)(ws + WS_ROUTE + RT_ROWW)};
        pg8::gemm_phase_f8<pg8::EpiDown, pg8::MoeOrder<4>, true, true>(F.lds, g, S, E, F.wave);
    } SEAM(11);
    if (IN(12)) { p12_combine(F); }
#undef IN
#undef SEAM
}

extern "C" void kernel_launch(void* const* d_in, const int* in_sizes, int n_in, void* d_out, int out_size, void* d_ws, size_t ws_size, hipStream_t stream) {
    static int grid = 0;
    if (grid == 0) {
        if (n_in != N_IN || out_size != MT * DM || ws_size < WS_END) { fprintf(stderr, "kernel_launch: unexpected shapes (n_in %d, out %d, ws %zu need %zu)\n", n_in, out_size, ws_size, (size_t)WS_END); grid = -1; return; }
        int dev = 0, cus = 0, per_cu = 0;
        if (hipGetDevice(&dev) != hipSuccess || hipDeviceGetAttribute(&cus, hipDeviceAttributeMultiprocessorCount, dev) != hipSuccess) { grid = -1; return; }
        if (hipFuncSetAttribute((const void*)fwd_kernel, hipFuncAttributeMaxDynamicSharedMemorySize, LDS_BYTES) != hipSuccess) { fprintf(stderr, "kernel_launch: hipFuncSetAttribute failed\n"); grid = -1; return; }
        if (hipOccupancyMaxActiveBlocksPerMultiprocessor(&per_cu, (const void*)fwd_kernel, NWAVES * 64, LDS_BYTES) != hipSuccess || per_cu < 1) { fprintf(stderr, "kernel_launch: occupancy query says %d\n", per_cu); }
        (void)hipGetLastError();
        grid = cus;
    }
    if (grid < 0) return;
    if (hipMemsetAsync((char*)d_ws + WS_CTL, 0, CTL_ZERO_BYTES, stream) != hipSuccess) return;
    Args a{};
    for (int i = 0; i < N_IN; ++i) a.in[i] = (const float*)d_in[i];
    a.out = (float*)d_out; a.ws = (unsigned char*)d_ws;
#if MK_PER_PHASE
    for (int p = 0; p < N_PHASES; ++p) { a.ph_lo = p; a.ph_hi = p + 1; a.li = 0; hipLaunchKernelGGL(fwd_kernel, dim3(grid), dim3(NWAVES * 64), LDS_BYTES, stream, a); }
#else
    a.ph_lo = 0; a.ph_hi = N_PHASES; a.li = 0;
    hipLaunchKernelGGL(fwd_kernel, dim3(grid), dim3(NWAVES * 64), LDS_BYTES, stream, a);
#endif
}
```

```cpp
#include <hip/hip_runtime.h>
#include <cstdio>
#include <cstdint>
namespace pg8 {
#define PG8_LAS __attribute__((address_space(3)))
typedef unsigned short bf16_t;
typedef short bf16x8 __attribute__((ext_vector_type(8)));
typedef float f32x4 __attribute__((ext_vector_type(4)));
typedef unsigned u32x4 __attribute__((ext_vector_type(4)));
constexpr int BM = 256, BK = 64, HALF = 128, HTB = HALF * BK * 2  , STAGE_BYTES = 8 * HTB, NXCD = 8, WGM = 8;

__host__ __device__ __forceinline__ int lds_byte(int r, int c) { const int st = (r >> 4) * 2 + (c >> 5), rr = r & 15, cc = c & 31, ob = rr * 64 + cc * 2; return st * 1024 + (ob ^ (((ob >> 9) & 1) << 5)); }
__host__ __device__ __forceinline__ void stage_rc(int b, int& R, int& C) { const int st = b / 1024, sb = b % 1024, swz = sb ^ (((sb >> 9) & 1) << 5); R = (st >> 1) * 16 + swz / 64; C = (st & 1) * 32 + (swz % 64) / 2; }
__host__ __device__ __forceinline__ int perm32(int rho) { const int n = rho >> 4, i = rho & 15; return 8 * (i >> 2) + 4 * n + (i & 3); }

struct Unit { int pm, pn; };
struct Gemm { const bf16_t* A; const bf16_t* Bt; int M, N, K; };

struct StaticOrder {
    int nM, nN, nwg, G, c;
    __host__ __device__ void init(int M, int N, int G_, int c_) { nM = M / BM; nN = N / BM; nwg = nM * nN; G = G_; c = c_; }
    __host__ __device__ bool next(int i, Unit& u) const {
        const long L = (long)i * G + c; if (L >= nwg) return false;
        int wgid = (int)L; { const int q = nwg / NXCD, r = nwg % NXCD, xcd = wgid % NXCD, off = wgid / NXCD; wgid = (xcd < r ? xcd * (q + 1) : r * (q + 1) + (xcd - r) * q) + off; }
        const int nig = WGM * nN, gid = wgid / nig, fm = gid * WGM, gsz = (nM - fm) < WGM ? (nM - fm) : WGM;
        u.pm = fm + ((wgid % nig) % gsz); u.pn = (wgid % nig) / gsz; return true;
    }
    __device__ __forceinline__ void a_ready(const Unit&) const {}
    __device__ __forceinline__ void done(const Unit&) const {}
};

__device__ __forceinline__ unsigned cvt_pk_bf16(float lo, float hi) { unsigned r; asm volatile("v_cvt_pk_bf16_f32 %0, %1, %2" : "=v"(r) : "v"(lo), "v"(hi)); return r; }
typedef float f32x2 __attribute__((ext_vector_type(2)));
__device__ __forceinline__ f32x2 gelu_pk(f32x2 v) {
    const f32x2 av = __builtin_elementwise_abs(v), d = av * 0.2316418882f + 1.0f;
    f32x2 t; t.x = __builtin_amdgcn_rcpf(d.x); t.y = __builtin_amdgcn_rcpf(d.y);
    f32x2 q = t * 0.5307027145f + (-0.7265760135f); q = q * t + 0.7107068705f; q = q * t + (-0.142248368f); q = q * t + 0.127414796f; q = q * t;
    const f32x2 s = (v * v) * (-0.72134752044f);
    f32x2 e; e.x = __builtin_amdgcn_exp2f(s.x); e.y = __builtin_amdgcn_exp2f(s.y);
    const f32x2 m = v * (q * e), r = v - m;
    f32x2 o; o.x = v.x < 0.f ? m.x : r.x; o.y = v.y < 0.f ? m.y : r.y; return o;
}

template <int ACT  > struct EpiBf16 {
    static constexpr bool PERM = true, AFTER_DRAIN = false; static_assert(ACT == 0 || ACT == 1, "EpiBf16: ACT is 0 (none) or 1 (gelu_pk)");
    bf16_t* O; int ldc; const float* bias; int split_cols; size_t split_stride; float scale0;
    __device__ __forceinline__ void operator()(const f32x4 (&acc)[2][2][4][2], const Unit& u, int wr, int wc, int fr, int fq) const {
        const int row0 = u.pm * BM + wr * 64 + fr; int colt = u.pn * BM; bf16_t* base = O;
        float sc = 1.f; if (split_cols) { const int t = colt / split_cols; base += (size_t)t * split_stride; colt -= t * split_cols; if (t == 0) sc = scale0; }
        const int col0 = colt + wc * 32 + 8 * fq, bcol0 = u.pn * BM + wc * 32 + 8 * fq;
        f32x4 bv[2][2];
#pragma unroll
        for (int bj = 0; bj < 2; ++bj)
#pragma unroll
            for (int n = 0; n < 2; ++n) bv[bj][n] = bias ? *(const f32x4*)(bias + bcol0 + bj * HALF + 4 * n) : (f32x4){0.f, 0.f, 0.f, 0.f};
#pragma unroll
        for (int ai = 0; ai < 2; ++ai)
#pragma unroll
            for (int m = 0; m < 4; ++m) { bf16_t* rowp = base + (size_t)(row0 + ai * HALF + m * 16) * ldc + col0;
#pragma unroll
                for (int bj = 0; bj < 2; ++bj) { f32x4 v0 = acc[ai][bj][m][0] + bv[bj][0], v1 = acc[ai][bj][m][1] + bv[bj][1];
                    if (ACT == 1) { f32x2 a = gelu_pk((f32x2){v0[0], v0[1]}), b = gelu_pk((f32x2){v0[2], v0[3]}), c = gelu_pk((f32x2){v1[0], v1[1]}), d = gelu_pk((f32x2){v1[2], v1[3]});
                        v0 = (f32x4){a.x, a.y, b.x, b.y}; v1 = (f32x4){c.x, c.y, d.x, d.y}; }
                    v0 = v0 * sc; v1 = v1 * sc; u32x4 w; w.x = cvt_pk_bf16(v0[0], v0[1]); w.y = cvt_pk_bf16(v0[2], v0[3]); w.z = cvt_pk_bf16(v1[0], v1[1]); w.w = cvt_pk_bf16(v1[2], v1[3]);
                    *(u32x4*)(rowp + bj * HALF) = w; } }
    }
};

struct PanelStats {
    unsigned* xbuf;
    unsigned* cnt;
    unsigned* tmo;
    int ntn; float eps;
    unsigned code;
    __device__ __forceinline__ bool run(const f32x4 (&v)[2][2][4][2], const Unit& u, int wr, int wc, int fr, int fq, PG8_LAS unsigned char* lds, int wid, int lane) const {
        typedef float f32x2v __attribute__((ext_vector_type(2)));
        PG8_LAS f32x2v* P = (PG8_LAS f32x2v*)lds;
        PG8_LAS f32x2v* S = (PG8_LAS f32x2v*)(lds + 8192);
        PG8_LAS unsigned* flag = (PG8_LAS unsigned*)(lds + 8192 + 2048);
#pragma unroll
        for (int ai = 0; ai < 2; ++ai)
#pragma unroll
            for (int m = 0; m < 4; ++m) {
                float s = 0.f;
#pragma unroll
                for (int bj = 0; bj < 2; ++bj)
#pragma unroll
                    for (int n = 0; n < 2; ++n) { const f32x4 x = v[ai][bj][m][n]; s += (x[0] + x[1]) + (x[2] + x[3]); }
                s += __shfl_xor(s, 16); s += __shfl_xor(s, 32);
                const float mw = s * (1.0f / 64.0f); float q = 0.f;
#pragma unroll
                for (int bj = 0; bj < 2; ++bj)
#pragma unroll
                    for (int n = 0; n < 2; ++n) { const f32x4 d = v[ai][bj][m][n] - mw; q += (d[0] * d[0] + d[1] * d[1]) + (d[2] * d[2] + d[3] * d[3]); }
                q += __shfl_xor(q, 16); q += __shfl_xor(q, 32);
                if (fq == 0) P[(ai * HALF + wr * 64 + m * 16 + fr) * 4 + wc] = (f32x2v){mw, q};
            }
        asm volatile("s_waitcnt lgkmcnt(0)" ::: "memory"); __builtin_amdgcn_s_barrier(); asm volatile("" ::: "memory");
#if defined(BROKEN_EXCHANGE_NO_WAIT)
#warning BROKEN CONTROL BUILD: the row-statistics exchange does not wait; results are wrong by design
        if (blockIdx.x >= 64) { const long long t0_ = clock64(); while (clock64() - t0_ < 60000) __builtin_amdgcn_s_sleep(8); }
#endif
        const int row = wid * 32 + (lane & 31);
        if (lane < 32) {
            const f32x2v a = P[row * 4 + 0], b = P[row * 4 + 1], c = P[row * 4 + 2], d = P[row * 4 + 3];
            const float mt = (a.x + b.x + c.x + d.x) * 0.25f;
            const float da = a.x - mt, db = b.x - mt, dc = c.x - mt, dd = d.x - mt;
            const float m2 = (a.y + b.y) + (c.y + d.y) + 64.0f * ((da * da + db * db) + (dc * dc + dd * dd));
            unsigned long long* slot = (unsigned long long*)xbuf + ((size_t)(u.pm * BM + row) * 4 + u.pn);
            __hip_atomic_store(slot, ((unsigned long long)__float_as_uint(m2) << 32) | __float_as_uint(mt), __ATOMIC_RELAXED, __HIP_MEMORY_SCOPE_AGENT);
        }
        asm volatile("s_waitcnt vmcnt(0)" ::: "memory");
        if (lane == 0) __hip_atomic_fetch_add(cnt + 64 * u.pm, 1u, __ATOMIC_RELAXED, __HIP_MEMORY_SCOPE_AGENT);
        if (wid == 0) {
            bool dead = false; const unsigned long long t0 = __builtin_amdgcn_s_memrealtime(); const unsigned want = 8u * (unsigned)ntn;
            for (;;) {
#if defined(BROKEN_EXCHANGE_NO_WAIT)
                break;
#endif
                if ((unsigned)__builtin_amdgcn_readfirstlane(__hip_atomic_load(cnt + 64 * u.pm, __ATOMIC_RELAXED, __HIP_MEMORY_SCOPE_AGENT)) >= want) break;
                if (__builtin_amdgcn_s_memrealtime() - t0 > 2000000ull) {
                    if (lane == 0) { unsigned expect = 0u; __hip_atomic_compare_exchange_strong(tmo + 1, &expect, code | (unsigned)(u.pm & 0xff), __ATOMIC_RELAXED, __ATOMIC_RELAXED, __HIP_MEMORY_SCOPE_AGENT);
                                     __hip_atomic_store(tmo, 1u, __ATOMIC_RELAXED, __HIP_MEMORY_SCOPE_AGENT); }
                    dead = true; break; }
                __builtin_amdgcn_s_sleep(2);
            }
            __builtin_amdgcn_fence(__ATOMIC_ACQUIRE, "agent");
            if (lane == 0) flag[0] = dead ? 1u : 0u;
        }
        asm volatile("s_waitcnt vmcnt(0) lgkmcnt(0)" ::: "memory"); __builtin_amdgcn_s_barrier(); asm volatile("" ::: "memory");
        const bool bad = flag[0] != 0u;
        if (lane < 32) {
            const unsigned long long* slot = (const unsigned long long*)xbuf + (size_t)(u.pm * BM + row) * 4; float mt[4], m2[4]; float ms = 0.f;
#pragma unroll
            for (int t = 0; t < 4; ++t) { if (t < ntn) { const unsigned long long w = __hip_atomic_load(slot + t, __ATOMIC_RELAXED, __HIP_MEMORY_SCOPE_AGENT); mt[t] = __uint_as_float((unsigned)w); m2[t] = __uint_as_float((unsigned)(w >> 32)); } else { mt[t] = 0.f; m2[t] = 0.f; } ms += mt[t]; }
            const float mean = ms / (float)ntn; float q = 0.f;
#pragma unroll
            for (int t = 0; t < 4; ++t) if (t < ntn) { const float dm = mt[t] - mean; q += m2[t] + 256.0f * dm * dm; }
            S[row] = (f32x2v){mean, 1.0f / sqrtf(q / (256.0f * (float)ntn) + eps)};
        }
        asm volatile("s_waitcnt lgkmcnt(0)" ::: "memory"); __builtin_amdgcn_s_barrier(); asm volatile("" ::: "memory");
        return bad;
    }
};
struct EpiLnRes {
    static constexpr bool PERM = false, AFTER_DRAIN = true;
    const float* base; float* out; int ldc; const float* bias; PanelStats st; unsigned poison;
    __device__ __forceinline__ void fused(f32x4 (&acc)[2][2][4][2], const Unit& u, int wr, int wc, int fr, int fq, PG8_LAS unsigned char* lds, int wid, int lane) const {
        typedef float f32x2v __attribute__((ext_vector_type(2)));
        const PG8_LAS f32x2v* S = (const PG8_LAS f32x2v*)(lds + 8192);
        const int col0 = u.pn * BM + wc * 32 + 4 * fq;
#pragma unroll
        for (int bj = 0; bj < 2; ++bj)
#pragma unroll
            for (int n = 0; n < 2; ++n) { const f32x4 bv = bias ? *(const f32x4*)(bias + col0 + bj * HALF + n * 16) : (f32x4){0.f, 0.f, 0.f, 0.f};
#pragma unroll
                for (int ai = 0; ai < 2; ++ai)
#pragma unroll
                    for (int m = 0; m < 4; ++m) acc[ai][bj][m][n] += bv; }
        f32x4 pre[4][2][2];
#pragma unroll
        for (int m = 0; m < 4; ++m) { const size_t off = (size_t)(u.pm * BM + wr * 64 + m * 16 + fr) * ldc + col0;
#pragma unroll
            for (int bj = 0; bj < 2; ++bj)
#pragma unroll
                for (int n = 0; n < 2; ++n) pre[m][bj][n] = *(const f32x4*)(base + off + bj * HALF + n * 16); }
        const bool bad = st.run(acc, u, wr, wc, fr, fq, lds, wid, lane) || poison != 0u;
        const float qnan = __builtin_nanf("");
#pragma unroll
        for (int ai = 0; ai < 2; ++ai)
#pragma unroll
            for (int m = 0; m < 4; ++m) { const int r = ai * HALF + wr * 64 + m * 16 + fr; const f32x2v sr = S[r]; const size_t off = (size_t)(u.pm * BM + r) * ldc + col0;
#pragma unroll
                for (int bj = 0; bj < 2; ++bj)
#pragma unroll
                    for (int n = 0; n < 2; ++n) { const f32x4 bs = ai == 0 ? pre[m][bj][n] : *(const f32x4*)(base + off + bj * HALF + n * 16); f32x4 o = bs + (acc[ai][bj][m][n] - sr.x) * sr.y;
                        if (bad) o = (f32x4){qnan, qnan, qnan, qnan}; *(f32x4*)(out + off + bj * HALF + n * 16) = o; }
                if (m & 1) asm volatile("" ::: "memory"); }
    }
};
struct EpiLnResLn {
    static constexpr bool PERM = false, AFTER_DRAIN = true;
    const float* base; float* out; bf16_t* xn; int ldc; const float* bias; PanelStats st1, st2; unsigned poison;
    __device__ __forceinline__ void fused(f32x4 (&acc)[2][2][4][2], const Unit& u, int wr, int wc, int fr, int fq, PG8_LAS unsigned char* lds, int wid, int lane) const {
        typedef float f32x2v __attribute__((ext_vector_type(2))); typedef unsigned u32x2v __attribute__((ext_vector_type(2)));
        const PG8_LAS f32x2v* S = (const PG8_LAS f32x2v*)(lds + 8192);
        const int col0 = u.pn * BM + wc * 32 + 4 * fq;
#pragma unroll
        for (int bj = 0; bj < 2; ++bj)
#pragma unroll
            for (int n = 0; n < 2; ++n) { const f32x4 bv = bias ? *(const f32x4*)(bias + col0 + bj * HALF + n * 16) : (f32x4){0.f, 0.f, 0.f, 0.f};
#pragma unroll
                for (int ai = 0; ai < 2; ++ai)
#pragma unroll
                    for (int m = 0; m < 4; ++m) acc[ai][bj][m][n] += bv; }
        bool bad = st1.run(acc, u, wr, wc, fr, fq, lds, wid, lane) || poison != 0u;
        const float qnan = __builtin_nanf("");
#pragma unroll
        for (int ai = 0; ai < 2; ++ai)
#pragma unroll
            for (int m = 0; m < 4; ++m) { const int r = ai * HALF + wr * 64 + m * 16 + fr; const f32x2v sr = S[r]; const size_t off = (size_t)(u.pm * BM + r) * ldc + col0;
#pragma unroll
                for (int bj = 0; bj < 2; ++bj)
#pragma unroll
                    for (int n = 0; n < 2; ++n) { const f32x4 bs = *(const f32x4*)(base + off + bj * HALF + n * 16); acc[ai][bj][m][n] = bs + (acc[ai][bj][m][n] - sr.x) * sr.y; }
                asm volatile("" : "+v"(acc[ai][0][m][0]), "+v"(acc[ai][0][m][1]), "+v"(acc[ai][1][m][0]), "+v"(acc[ai][1][m][1]));
                if (m & 1) asm volatile("" ::: "memory"); }
        const bool bad1 = bad;
        bad = st2.run(acc, u, wr, wc, fr, fq, lds, wid, lane) || bad;
#pragma unroll
        for (int ai = 0; ai < 2; ++ai)
#pragma unroll
            for (int m = 0; m < 4; ++m) { const int r = ai * HALF + wr * 64 + m * 16 + fr; const f32x2v sr = S[r]; const size_t off = (size_t)(u.pm * BM + r) * ldc + col0;
#pragma unroll
                for (int bj = 0; bj < 2; ++bj)
#pragma unroll
                    for (int n = 0; n < 2; ++n) { const f32x4 x1 = acc[ai][bj][m][n]; *(f32x4*)(out + off + bj * HALF + n * 16) = bad1 ? (f32x4){qnan, qnan, qnan, qnan} : x1;
                        const f32x4 o = (x1 - sr.x) * sr.y; u32x2v w; w.x = cvt_pk_bf16(o[0], o[1]); w.y = cvt_pk_bf16(o[2], o[3]);
                        if (bad) { w.x = 0x7fc07fc0u; w.y = 0x7fc07fc0u; } *(u32x2v*)(xn + off + bj * HALF + n * 16) = w; }
                asm volatile("" ::: "memory"); }
    }
};

template <class E, class = void> struct Perm2 { static constexpr bool v = false; };
template <class E> struct Perm2<E, decltype((void)E::PERM2)> { static constexpr bool v = E::PERM2; };
template <class E, class = void> struct MidSeg { static constexpr int v = 0; };
template <class E> struct MidSeg<E, decltype((void)E::MIDSEG)> { static constexpr int v = E::MIDSEG; };
template <class Epi, class Sched, bool ALIGN_EPI = false, bool SP2 = false>
__device__ __forceinline__ void gemm_phase(PG8_LAS unsigned char* lds, const Gemm g, const Sched& S, const Epi& E, int wid_in) {
    int lane_; asm volatile("v_mbcnt_lo_u32_b32 %0, -1, 0\n\tv_mbcnt_hi_u32_b32 %0, -1, %0" : "=v"(lane_));
    const int wid = wid_in, lane = lane_, tid = wid * 64 + lane, wr = wid >> 2, wc = wid & 3, fr = lane & 15, fq = lane >> 4;
    const int K = g.K, nt = K / BK;
    unsigned voffA[2], voffB[2];
#pragma unroll
    for (int i = 0; i < 2; ++i) { int R, C; stage_rc(tid * 16 + i * 8192, R, C); const int Rb = Perm2<Epi>::v ? (64 * (R >> 5) + 16 * ((R >> 2) & 3) + 4 * ((R >> 4) & 1) + (R & 3)) : Epi::PERM ? ((R & ~31) + perm32(R & 31)) : R;
        voffA[i] = (unsigned)(R * K + C) * 2u; voffB[i] = (unsigned)(Rb * K + C) * 2u; }
    const size_t kstep = (size_t)(BK * 2);
    const size_t hstep = (size_t)HALF * K * 2;
    const size_t hstepB = Perm2<Epi>::v ? (size_t)8 * K * 2 : hstep;
    const size_t tstep = 2 * hstep;
    const unsigned ldsw = (unsigned)wid * 1024u;
    const int aoff = lds_byte(wr * 64 + fr, fq * 8), boff = lds_byte(wc * 32 + fr, fq * 8);
#define PG8_SA(b, h) (((b) * 2 + (h)) * HTB)
#define PG8_SB(b, h) ((4 + (b) * 2 + (h)) * HTB)
#define PG8_STAGE(bufoff, gbase, voff) do { _Pragma("unroll") for (int _i = 0; _i < 2; ++_i) \
        __builtin_amdgcn_global_load_lds((const unsigned*)((const char*)(gbase) + (voff)[_i]), (PG8_LAS unsigned*)(lds + (bufoff) + ldsw + _i * 8192), 16, 0, 0); } while (0)
#define PG8_LDA(dst, b, h) do { _Pragma("unroll") for (int m = 0; m < 4; ++m) _Pragma("unroll") for (int k = 0; k < 2; ++k) dst[m][k] = *(const PG8_LAS bf16x8*)(lds + PG8_SA(b, h) + aoff + m * 2048 + k * 1024); } while (0)
#define PG8_LDB(dst, b, h) do { _Pragma("unroll") for (int n = 0; n < 2; ++n) _Pragma("unroll") for (int k = 0; k < 2; ++k) dst[n][k] = *(const PG8_LAS bf16x8*)(lds + PG8_SB(b, h) + boff + n * 2048 + k * 1024); } while (0)
#define PG8_MMA(ai, bj, At, Bt) do { __builtin_amdgcn_s_setprio(1); _Pragma("unroll") for (int m = 0; m < 4; ++m) _Pragma("unroll") for (int n = 0; n < 2; ++n) _Pragma("unroll") for (int k = 0; k < 2; ++k) \
        acc[ai][bj][m][n] = __builtin_amdgcn_mfma_f32_16x16x32_bf16(Bt[n][k], At[m][k], acc[ai][bj][m][n], 0, 0, 0); __builtin_amdgcn_s_setprio(0); } while (0)
#define PG8_WAIT_V(n) asm volatile("s_waitcnt vmcnt(" #n ")" ::: "memory")
#define PG8_WAIT_L(n) asm volatile("s_waitcnt lgkmcnt(" #n ")" ::: "memory")
#define PG8_BAR __builtin_amdgcn_s_barrier()
#define PG8_SCHED __builtin_amdgcn_sched_barrier(0)
    Unit cur, nxt; int ui = 0;
    if (!S.next(0, cur)) return;
    f32x4 acc[2][2][4][2];
#pragma unroll
    for (int a = 0; a < 2; ++a)
#pragma unroll
        for (int b = 0; b < 2; ++b)
#pragma unroll
            for (int m = 0; m < 4; ++m)
#pragma unroll
                for (int n = 0; n < 2; ++n) acc[a][b][m][n] = (f32x4){0.f, 0.f, 0.f, 0.f};
    bf16x8 At[4][2], B0[2][2], B1[2][2];
    const char* cA = (const char*)g.A + (size_t)cur.pm * tstep; const char* cB = (const char*)g.Bt + (size_t)cur.pn * tstep;
    S.a_ready(cur);
    if constexpr (SP2) {
        PG8_STAGE(PG8_SB(0, 0), cB, voffB); PG8_STAGE(PG8_SB(0, 1), cB + hstepB, voffB); PG8_STAGE(PG8_SA(0, 0), cA, voffA); PG8_STAGE(PG8_SA(0, 1), cA + hstep, voffA);
        if (wr == 1) PG8_BAR;
        PG8_WAIT_V(2); PG8_BAR;
        PG8_STAGE(PG8_SB(1, 0), cB + kstep, voffB); PG8_STAGE(PG8_SA(1, 0), cA + kstep, voffA); PG8_STAGE(PG8_SB(1, 1), cB + hstepB + kstep, voffB);
        PG8_WAIT_V(6); PG8_BAR;
    } else {
        PG8_STAGE(PG8_SB(0, 0), cB, voffB); PG8_STAGE(PG8_SA(0, 0), cA, voffA); PG8_STAGE(PG8_SB(0, 1), cB + hstepB, voffB); PG8_STAGE(PG8_SA(0, 1), cA + hstep, voffA);
        if (wr == 1) PG8_BAR;
        PG8_WAIT_V(4); PG8_BAR;
        PG8_STAGE(PG8_SB(1, 0), cB + kstep, voffB); PG8_STAGE(PG8_SA(1, 0), cA + kstep, voffA); PG8_STAGE(PG8_SB(1, 1), cB + hstepB + kstep, voffB);
        PG8_WAIT_V(6); PG8_BAR;
    }
    for (;;) {
        const bool has_next = S.next(ui + 1, nxt);
        const char* nA = has_next ? (const char*)g.A + (size_t)nxt.pm * tstep : cA; const char* nB = has_next ? (const char*)g.Bt + (size_t)nxt.pn * tstep : cB;
        for (int t = 0; t < nt; t += 2) {
            if constexpr (MidSeg<Epi>::v > 0) { if (t > 0 && t % MidSeg<Epi>::v == 0) E.mid(acc, cur, t / MidSeg<Epi>::v, wr, wc, fr, fq); }
            const bool last = (t == nt - 2);
            const char* a1 = cA + (size_t)(t + 1) * kstep;
            const char* a2 = last ? nA : cA + (size_t)(t + 2) * kstep; const char* b2 = last ? nB : cB + (size_t)(t + 2) * kstep;
            const char* a3 = a2 + kstep; const char* b3 = b2 + kstep;
            if (last && has_next) S.a_ready(nxt);
            if constexpr (SP2) {
            PG8_LDB(B0, 0, 0); PG8_LDB(B1, 0, 1); PG8_SCHED; PG8_LDA(At, 0, 0); PG8_STAGE(PG8_SA(1, 1), a1 + hstep, voffA);
            PG8_WAIT_V(8); PG8_WAIT_L(0); PG8_BAR; PG8_MMA(0, 0, At, B0); PG8_MMA(0, 1, At, B1); PG8_BAR; PG8_SCHED;
            PG8_LDA(At, 0, 1); PG8_STAGE(PG8_SB(0, 0), b2, voffB); PG8_STAGE(PG8_SB(0, 1), b2 + hstepB, voffB); PG8_STAGE(PG8_SA(0, 0), a2, voffA);
            PG8_WAIT_V(8); PG8_WAIT_L(0); PG8_BAR; PG8_MMA(1, 0, At, B0); PG8_MMA(1, 1, At, B1); PG8_BAR; PG8_SCHED;
            PG8_LDB(B0, 1, 0); PG8_LDB(B1, 1, 1); PG8_SCHED; PG8_LDA(At, 1, 0); PG8_STAGE(PG8_SA(0, 1), a2 + hstep, voffA);
            PG8_WAIT_V(8); PG8_WAIT_L(0); PG8_BAR; PG8_MMA(0, 0, At, B0); PG8_MMA(0, 1, At, B1); PG8_BAR; PG8_SCHED;
            PG8_LDA(At, 1, 1); PG8_STAGE(PG8_SB(1, 0), b3, voffB); PG8_STAGE(PG8_SB(1, 1), b3 + hstepB, voffB); PG8_STAGE(PG8_SA(1, 0), a3, voffA);
            PG8_WAIT_V(8); PG8_WAIT_L(0); PG8_BAR; PG8_MMA(1, 0, At, B0); PG8_MMA(1, 1, At, B1); PG8_BAR; PG8_SCHED;
            } else {
            PG8_LDB(B0, 0, 0); PG8_SCHED; PG8_LDA(At, 0, 0); PG8_STAGE(PG8_SA(1, 1), a1 + hstep, voffA);
            PG8_WAIT_L(8); PG8_BAR; PG8_WAIT_L(0); PG8_MMA(0, 0, At, B0); PG8_BAR; PG8_SCHED;
            PG8_LDB(B1, 0, 1); PG8_STAGE(PG8_SB(0, 0), b2, voffB);
            PG8_BAR; PG8_WAIT_L(0); PG8_MMA(0, 1, At, B1); PG8_BAR;
            PG8_LDA(At, 0, 1); PG8_STAGE(PG8_SA(0, 0), a2, voffA);
            PG8_BAR; PG8_WAIT_L(0); PG8_MMA(1, 0, At, B0); PG8_BAR; PG8_SCHED;
            PG8_STAGE(PG8_SB(0, 1), b2 + hstepB, voffB);
            PG8_WAIT_V(6); PG8_BAR; PG8_MMA(1, 1, At, B1); PG8_BAR;
            PG8_LDB(B0, 1, 0); PG8_SCHED; PG8_LDA(At, 1, 0); PG8_STAGE(PG8_SA(0, 1), a2 + hstep, voffA);
            PG8_WAIT_L(8); PG8_BAR; PG8_WAIT_L(0); PG8_MMA(0, 0, At, B0); PG8_BAR; PG8_SCHED;
            PG8_LDB(B1, 1, 1); PG8_STAGE(PG8_SB(1, 0), b3, voffB);
            PG8_BAR; PG8_WAIT_L(0); PG8_MMA(0, 1, At, B1); PG8_BAR;
            PG8_LDA(At, 1, 1); PG8_STAGE(PG8_SA(1, 0), a3, voffA);
            PG8_BAR; PG8_WAIT_L(0); PG8_MMA(1, 0, At, B0); PG8_BAR; PG8_SCHED;
            PG8_STAGE(PG8_SB(1, 1), b3 + hstepB, voffB);
            PG8_WAIT_V(6); PG8_BAR; PG8_MMA(1, 1, At, B1); PG8_BAR;
            }
        }
        if constexpr (ALIGN_EPI) { if (wr == 0) PG8_BAR; }
        if constexpr (!Epi::AFTER_DRAIN) { E(acc, cur, wr, wc, fr, fq); S.done(cur); }
        if (!has_next) break;
#pragma unroll
        for (int a = 0; a < 2; ++a)
#pragma unroll
            for (int b = 0; b < 2; ++b)
#pragma unroll
                for (int m = 0; m < 4; ++m)
#pragma unroll
                    for (int n = 0; n < 2; ++n) acc[a][b][m][n] = (f32x4){0.f, 0.f, 0.f, 0.f};
        cur = nxt; cA = nA; cB = nB; ++ui;
        if constexpr (ALIGN_EPI) { if (wr == 1) PG8_BAR; }
    }
    PG8_WAIT_V(0);
    if constexpr (!ALIGN_EPI) { if (wr == 0) PG8_BAR; }
    PG8_BAR;
    if constexpr (Epi::AFTER_DRAIN) { E.fused(acc, cur, wr, wc, fr, fq, lds, wid, lane); S.done(cur); }
#undef PG8_SA
#undef PG8_SB
#undef PG8_STAGE
#undef PG8_LDA
#undef PG8_LDB
#undef PG8_MMA
#undef PG8_WAIT_V
#undef PG8_WAIT_L
#undef PG8_BAR
#undef PG8_SCHED
}
}
namespace pg8 {
struct Gemm8 { const unsigned char* A; const unsigned char* Bt; int M, N, K; int scale_a, scale_b; };
template <class Epi, class Sched, bool ALIGN_EPI = false, bool SP2 = false>
__device__ __forceinline__ void gemm_phase_f8(PG8_LAS unsigned char* lds, const Gemm8 g, const Sched& S, const Epi& E, int wid_in) {
    int lane_; asm volatile("v_mbcnt_lo_u32_b32 %0, -1, 0\n\tv_mbcnt_hi_u32_b32 %0, -1, %0" : "=v"(lane_));
    const int wid = wid_in, lane = lane_, tid = wid * 64 + lane, wr = wid >> 2, wc = wid & 3, fr = lane & 15, fq = lane >> 4;
    const int K = g.K, nt = K / 128;
    unsigned voffA[2], voffB[2];
#pragma unroll
    for (int i = 0; i < 2; ++i) { int R, C; stage_rc(tid * 16 + i * 8192, R, C); const int Rb = Perm2<Epi>::v ? (64 * (R >> 5) + 16 * ((R >> 2) & 3) + 4 * ((R >> 4) & 1) + (R & 3)) : Epi::PERM ? ((R & ~31) + perm32(R & 31)) : R;
        voffA[i] = (unsigned)(R * K + 2 * C); voffB[i] = (unsigned)(Rb * K + 2 * C); }
    const size_t kstep = (size_t)(BK * 2);
    const size_t hstep = (size_t)HALF * K;
    const size_t hstepB = Perm2<Epi>::v ? (size_t)8 * K : hstep;
    const size_t tstep = 2 * hstep;
    const unsigned ldsw = (unsigned)wid * 1024u;
    const int aoff = lds_byte(wr * 64 + fr, fq * 16), boff = lds_byte(wc * 32 + fr, fq * 16);
#define PG8_SA(b, h) (((b) * 2 + (h)) * HTB)
#define PG8_SB(b, h) ((4 + (b) * 2 + (h)) * HTB)
#define PG8_STAGE(bufoff, gbase, voff) do { _Pragma("unroll") for (int _i = 0; _i < 2; ++_i) { unsigned keep_; \
        asm volatile("s_mov_b32 %0, m0\n\ts_mov_b32 m0, %3\n\ts_nop 0\n\tglobal_load_lds_dwordx4 %1, %2\n\ts_mov_b32 m0, %0" : "=&s"(keep_) : "v"((voff)[_i]), "s"((const char*)(gbase)), "s"((unsigned)(size_t)(lds + (bufoff) + ldsw + _i * 8192)) : "memory"); } } while (0)
#define PG8_LDA(dst, b, h) do { _Pragma("unroll") for (int m = 0; m < 4; ++m) { const u32x4 lo_ = *(const PG8_LAS u32x4*)(lds + PG8_SA(b, h) + aoff + m * 2048), hi_ = *(const PG8_LAS u32x4*)(lds + PG8_SA(b, h) + aoff + m * 2048 + 16); dst[m] = __builtin_bit_cast(i32x8, __builtin_shufflevector(lo_, hi_, 0, 1, 2, 3, 4, 5, 6, 7)); } } while (0)
#define PG8_LDB(dst, b, h) do { _Pragma("unroll") for (int n = 0; n < 2; ++n) { const u32x4 lo_ = *(const PG8_LAS u32x4*)(lds + PG8_SB(b, h) + boff + n * 2048), hi_ = *(const PG8_LAS u32x4*)(lds + PG8_SB(b, h) + boff + n * 2048 + 16); dst[n] = __builtin_bit_cast(i32x8, __builtin_shufflevector(lo_, hi_, 0, 1, 2, 3, 4, 5, 6, 7)); } } while (0)
#define PG8_MMA(ai, bj, At, Bt) do { __builtin_amdgcn_s_setprio(1); _Pragma("unroll") for (int m = 0; m < 4; ++m) _Pragma("unroll") for (int n = 0; n < 2; ++n) \
        acc[ai][bj][m][n] = __builtin_amdgcn_mfma_scale_f32_16x16x128_f8f6f4(Bt[n], At[m], acc[ai][bj][m][n], 0, 0, 0, g.scale_b, 0, g.scale_a); __builtin_amdgcn_s_setprio(0); } while (0)
#define PG8_WAIT_V(n) asm volatile("s_waitcnt vmcnt(" #n ")" ::: "memory")
#define PG8_WAIT_L(n) asm volatile("s_waitcnt lgkmcnt(" #n ")" ::: "memory")
#define PG8_BAR __builtin_amdgcn_s_barrier()
#define PG8_SCHED __builtin_amdgcn_sched_barrier(0)
    Unit cur, nxt; int ui = 0;
    if (!S.next(0, cur)) return;
    f32x4 acc[2][2][4][2];
#pragma unroll
    for (int a = 0; a < 2; ++a)
#pragma unroll
        for (int b = 0; b < 2; ++b)
#pragma unroll
            for (int m = 0; m < 4; ++m)
#pragma unroll
                for (int n = 0; n < 2; ++n) acc[a][b][m][n] = (f32x4){0.f, 0.f, 0.f, 0.f};
    typedef int i32x8 __attribute__((ext_vector_type(8))); i32x8 At[4], B0[2], B1[2];
    const char* cA = (const char*)g.A + (size_t)cur.pm * tstep; const char* cB = (const char*)g.Bt + (size_t)cur.pn * tstep;
    S.a_ready(cur);
    if constexpr (SP2) {
        PG8_STAGE(PG8_SB(0, 0), cB, voffB); PG8_STAGE(PG8_SB(0, 1), cB + hstepB, voffB); PG8_STAGE(PG8_SA(0, 0), cA, voffA); PG8_STAGE(PG8_SA(0, 1), cA + hstep, voffA);
        if (wr == 1) PG8_BAR;
        PG8_WAIT_V(2); PG8_BAR;
        PG8_STAGE(PG8_SB(1, 0), cB + kstep, voffB); PG8_STAGE(PG8_SA(1, 0), cA + kstep, voffA); PG8_STAGE(PG8_SB(1, 1), cB + hstepB + kstep, voffB);
        PG8_WAIT_V(6); PG8_BAR;
    } else {
        PG8_STAGE(PG8_SB(0, 0), cB, voffB); PG8_STAGE(PG8_SA(0, 0), cA, voffA); PG8_STAGE(PG8_SB(0, 1), cB + hstepB, voffB); PG8_STAGE(PG8_SA(0, 1), cA + hstep, voffA);
        if (wr == 1) PG8_BAR;
        PG8_WAIT_V(4); PG8_BAR;
        PG8_STAGE(PG8_SB(1, 0), cB + kstep, voffB); PG8_STAGE(PG8_SA(1, 0), cA + kstep, voffA); PG8_STAGE(PG8_SB(1, 1), cB + hstepB + kstep, voffB);
        PG8_WAIT_V(6); PG8_BAR;
    }
    for (;;) {
        const bool has_next = S.next(ui + 1, nxt);
        const char* nA = has_next ? (const char*)g.A + (size_t)nxt.pm * tstep : cA; const char* nB = has_next ? (const char*)g.Bt + (size_t)nxt.pn * tstep : cB;
#pragma unroll 1
        for (int t = 0; t < nt; t += 2) {
            const bool last = (t == nt - 2);
            const char* a1 = cA + (size_t)(t + 1) * kstep;
            const char* a2 = last ? nA : cA + (size_t)(t + 2) * kstep; const char* b2 = last ? nB : cB + (size_t)(t + 2) * kstep;
            const char* a3 = a2 + kstep; const char* b3 = b2 + kstep;
            if (last && has_next) S.a_ready(nxt);
            if constexpr (SP2) {
            PG8_LDB(B0, 0, 0); PG8_LDB(B1, 0, 1); PG8_SCHED; PG8_LDA(At, 0, 0); PG8_STAGE(PG8_SA(1, 1), a1 + hstep, voffA);
            PG8_WAIT_V(8); PG8_WAIT_L(0); PG8_BAR; PG8_MMA(0, 0, At, B0); PG8_MMA(0, 1, At, B1); PG8_BAR; PG8_SCHED;
            PG8_LDA(At, 0, 1); PG8_STAGE(PG8_SB(0, 0), b2, voffB); PG8_STAGE(PG8_SB(0, 1), b2 + hstepB, voffB); PG8_STAGE(PG8_SA(0, 0), a2, voffA);
            PG8_WAIT_V(8); PG8_WAIT_L(0); PG8_BAR; PG8_MMA(1, 0, At, B0); PG8_MMA(1, 1, At, B1); PG8_BAR; PG8_SCHED;
            PG8_LDB(B0, 1, 0); PG8_LDB(B1, 1, 1); PG8_SCHED; PG8_LDA(At, 1, 0); PG8_STAGE(PG8_SA(0, 1), a2 + hstep, voffA);
            PG8_WAIT_V(8); PG8_WAIT_L(0); PG8_BAR; PG8_MMA(0, 0, At, B0); PG8_MMA(0, 1, At, B1); PG8_BAR; PG8_SCHED;
            PG8_LDA(At, 1, 1); PG8_STAGE(PG8_SB(1, 0), b3, voffB); PG8_STAGE(PG8_SB(1, 1), b3 + hstepB, voffB); PG8_STAGE(PG8_SA(1, 0), a3, voffA);
            PG8_WAIT_V(8); PG8_WAIT_L(0); PG8_BAR; PG8_MMA(1, 0, At, B0); PG8_MMA(1, 1, At, B1); PG8_BAR; PG8_SCHED;
            } else {
            PG8_LDB(B0, 0, 0); PG8_SCHED; PG8_LDA(At, 0, 0); PG8_STAGE(PG8_SA(1, 1), a1 + hstep, voffA);
            PG8_WAIT_L(8); PG8_BAR; PG8_WAIT_L(0); PG8_MMA(0, 0, At, B0); PG8_BAR; PG8_SCHED;
            PG8_LDB(B1, 0, 1); PG8_STAGE(PG8_SB(0, 0), b2, voffB);
            PG8_BAR; PG8_WAIT_L(0); PG8_MMA(0, 1, At, B1); PG8_BAR;
            PG8_LDA(At, 0, 1); PG8_STAGE(PG8_SA(0, 0), a2, voffA);
            PG8_BAR; PG8_WAIT_L(0); PG8_MMA(1, 0, At, B0); PG8_BAR; PG8_SCHED;
            PG8_STAGE(PG8_SB(0, 1), b2 + hstepB, voffB);
            PG8_WAIT_V(6); PG8_BAR; PG8_MMA(1, 1, At, B1); PG8_BAR;
            PG8_LDB(B0, 1, 0); PG8_SCHED; PG8_LDA(At, 1, 0); PG8_STAGE(PG8_SA(0, 1), a2 + hstep, voffA);
            PG8_WAIT_L(8); PG8_BAR; PG8_WAIT_L(0); PG8_MMA(0, 0, At, B0); PG8_BAR; PG8_SCHED;
            PG8_LDB(B1, 1, 1); PG8_STAGE(PG8_SB(1, 0), b3, voffB);
            PG8_BAR; PG8_WAIT_L(0); PG8_MMA(0, 1, At, B1); PG8_BAR;
            PG8_LDA(At, 1, 1); PG8_STAGE(PG8_SA(1, 0), a3, voffA);
            PG8_BAR; PG8_WAIT_L(0); PG8_MMA(1, 0, At, B0); PG8_BAR; PG8_SCHED;
            PG8_STAGE(PG8_SB(1, 1), b3 + hstepB, voffB);
            PG8_WAIT_V(6); PG8_BAR; PG8_MMA(1, 1, At, B1); PG8_BAR;
            }
        }
        if constexpr (ALIGN_EPI) { if (wr == 0) PG8_BAR; }
        if constexpr (!Epi::AFTER_DRAIN) { int l2_; asm volatile("v_mbcnt_lo_u32_b32 %0, -1, 0\n\tv_mbcnt_hi_u32_b32 %0, -1, %0" : "=v"(l2_));
            E(acc, cur, wr, wc, l2_ & 15, l2_ >> 4); S.done(cur); }
        if (!has_next) break;
#pragma unroll
        for (int a = 0; a < 2; ++a)
#pragma unroll
            for (int b = 0; b < 2; ++b)
#pragma unroll
                for (int m = 0; m < 4; ++m)
#pragma unroll
                    for (int n = 0; n < 2; ++n) acc[a][b][m][n] = (f32x4){0.f, 0.f, 0.f, 0.f};
        cur = nxt; cA = nA; cB = nB; ++ui;
        if constexpr (ALIGN_EPI) { if (wr == 1) PG8_BAR; }
    }
    PG8_WAIT_V(0);
    if constexpr (!ALIGN_EPI) { if (wr == 0) PG8_BAR; }
    PG8_BAR;
    if constexpr (Epi::AFTER_DRAIN) { E.fused(acc, cur, wr, wc, fr, fq, lds, wid, lane); S.done(cur); }
#undef PG8_SA
#undef PG8_SB
#undef PG8_STAGE
#undef PG8_LDA
#undef PG8_LDB
#undef PG8_MMA
#undef PG8_WAIT_V
#undef PG8_WAIT_L
#undef PG8_BAR
#undef PG8_SCHED
}
}
namespace pg8 {
struct Gemm8G { const unsigned char* A; const unsigned char* Bt; const int* rowtok; int K; int scale_a, scale_b; };
template <class Epi, class Sched, bool ALIGN_EPI = false, bool SP2 = false>
__device__ __forceinline__ void gemm_phase_f8g(PG8_LAS unsigned char* lds, const Gemm8G g, const Sched& S, const Epi& E, int wid_in) {
    int lane_; asm volatile("v_mbcnt_lo_u32_b32 %0, -1, 0\n\tv_mbcnt_hi_u32_b32 %0, -1, %0" : "=v"(lane_));
    const int wid = wid_in, lane = lane_, tid = wid * 64 + lane, wr = wid >> 2, wc = wid & 3, fr = lane & 15, fq = lane >> 4;
    const int K = g.K, nt = K / 128;
    unsigned va[4], voffB0; int R0_, C0_;
    { int R, C; stage_rc(tid * 16, R, C); R0_ = R; C0_ = C; const int Rb = Perm2<Epi>::v ? (64 * (R >> 5) + 16 * ((R >> 2) & 3) + 4 * ((R >> 4) & 1) + (R & 3)) : Epi::PERM ? ((R & ~31) + perm32(R & 31)) : R;
      voffB0 = (unsigned)(Rb * K + 2 * C); }
    const size_t bstep1 = (size_t)(Perm2<Epi>::v ? 128 : 64) * K;
    PG8_LAS unsigned* tab = (PG8_LAS unsigned*)(lds + 135424);
    const size_t kstep = (size_t)(BK * 2);
    const size_t hstep = (size_t)HALF * K;
    const size_t hstepB = Perm2<Epi>::v ? (size_t)8 * K : hstep;
    const size_t tstep = 2 * hstep;
    const unsigned ldsw = (unsigned)wid * 1024u;
    const int aoff = lds_byte(wr * 64 + fr, fq * 16), boff = lds_byte(wc * 32 + fr, fq * 16);
#define PG8_SA(b, h) (((b) * 2 + (h)) * HTB)
#define PG8_SB(b, h) ((4 + (b) * 2 + (h)) * HTB)
#define PG8_GL(vo, sb, ldsaddr) do { unsigned keep_; asm volatile("s_mov_b32 %0, m0\n\ts_mov_b32 m0, %3\n\ts_nop 0\n\tglobal_load_lds_dwordx4 %1, %2\n\ts_mov_b32 m0, %0" : "=&s"(keep_) : "v"(vo), "s"((const char*)(sb)), "s"((unsigned)(size_t)(ldsaddr)) : "memory"); } while (0)
#define PG8_STAGE_B(bufoff, gbase) do { PG8_GL(voffB0, (gbase), lds + (bufoff) + ldsw); PG8_GL(voffB0, (gbase) + bstep1, lds + (bufoff) + ldsw + 8192); } while (0)
#define PG8_STAGE_A(bufoff, kbase, h) do { PG8_GL(va[2 * (h)], (kbase), lds + (bufoff) + ldsw); PG8_GL(va[2 * (h) + 1], (kbase), lds + (bufoff) + ldsw + 8192); } while (0)
#define PG8_LOADVA(slot) do { _Pragma("unroll") for (int h_ = 0; h_ < 2; ++h_) _Pragma("unroll") for (int i_ = 0; i_ < 2; ++i_) va[2 * h_ + i_] = tab[(slot) * 256 + h_ * 128 + R0_ + 64 * i_] * (unsigned)K + 2u * (unsigned)C0_; } while (0)
#define PG8_LDA(dst, b, h) do { _Pragma("unroll") for (int m = 0; m < 4; ++m) { const u32x4 lo_ = *(const PG8_LAS u32x4*)(lds + PG8_SA(b, h) + aoff + m * 2048), hi_ = *(const PG8_LAS u32x4*)(lds + PG8_SA(b, h) + aoff + m * 2048 + 16); dst[m] = __builtin_bit_cast(i32x8, __builtin_shufflevector(lo_, hi_, 0, 1, 2, 3, 4, 5, 6, 7)); } } while (0)
#define PG8_LDB(dst, b, h) do { _Pragma("unroll") for (int n = 0; n < 2; ++n) { const u32x4 lo_ = *(const PG8_LAS u32x4*)(lds + PG8_SB(b, h) + boff + n * 2048), hi_ = *(const PG8_LAS u32x4*)(lds + PG8_SB(b, h) + boff + n * 2048 + 16); dst[n] = __builtin_bit_cast(i32x8, __builtin_shufflevector(lo_, hi_, 0, 1, 2, 3, 4, 5, 6, 7)); } } while (0)
#define PG8_MMA(ai, bj, At, Bt) do { __builtin_amdgcn_s_setprio(1); _Pragma("unroll") for (int m = 0; m < 4; ++m) _Pragma("unroll") for (int n = 0; n < 2; ++n) \
        acc[ai][bj][m][n] = __builtin_amdgcn_mfma_scale_f32_16x16x128_f8f6f4(Bt[n], At[m], acc[ai][bj][m][n], 0, 0, 0, g.scale_b, 0, g.scale_a); __builtin_amdgcn_s_setprio(0); } while (0)
#define PG8_WAIT_V(n) asm volatile("s_waitcnt vmcnt(" #n ")" ::: "memory")
#define PG8_WAIT_L(n) asm volatile("s_waitcnt lgkmcnt(" #n ")" ::: "memory")
#define PG8_BAR __builtin_amdgcn_s_barrier()
#define PG8_SCHED __builtin_amdgcn_sched_barrier(0)
    Unit cur, nxt; int ui = 0;
    if (!S.next(0, cur)) return;
    f32x4 acc[2][2][4][2];
#pragma unroll
    for (int a = 0; a < 2; ++a)
#pragma unroll
        for (int b = 0; b < 2; ++b)
#pragma unroll
            for (int m = 0; m < 4; ++m)
#pragma unroll
                for (int n = 0; n < 2; ++n) acc[a][b][m][n] = (f32x4){0.f, 0.f, 0.f, 0.f};
    typedef int i32x8 __attribute__((ext_vector_type(8))); i32x8 At[4], B0[2], B1[2];
    const char* aB = (const char*)g.A; const char* cB = (const char*)g.Bt + (size_t)cur.pn * tstep;
    S.a_ready(cur);
    { if (tid < 256) {
#pragma unroll 1
        for (int u_ = 0; u_ < 17; ++u_) { Unit t_; if (!S.next(u_, t_)) break; tab[u_ * 256 + tid] = (unsigned)g.rowtok[t_.pm * 256 + tid]; } }
      asm volatile("s_waitcnt vmcnt(0) lgkmcnt(0)" ::: "memory"); PG8_BAR; asm volatile("" ::: "memory");
      PG8_LOADVA(0); }
    if constexpr (SP2) {
        PG8_STAGE_B(PG8_SB(0, 0), cB); PG8_STAGE_B(PG8_SB(0, 1), cB + hstepB); PG8_STAGE_A(PG8_SA(0, 0), aB, 0); PG8_STAGE_A(PG8_SA(0, 1), aB, 1);
        if (wr == 1) PG8_BAR;
        PG8_WAIT_V(2); PG8_BAR;
        PG8_STAGE_B(PG8_SB(1, 0), cB + kstep); PG8_STAGE_A(PG8_SA(1, 0), aB + kstep, 0); PG8_STAGE_B(PG8_SB(1, 1), cB + hstepB + kstep);
        PG8_WAIT_V(6); PG8_BAR;
    } else {
        PG8_STAGE_B(PG8_SB(0, 0), cB); PG8_STAGE_A(PG8_SA(0, 0), aB, 0); PG8_STAGE_B(PG8_SB(0, 1), cB + hstepB); PG8_STAGE_A(PG8_SA(0, 1), aB, 1);
        if (wr == 1) PG8_BAR;
        PG8_WAIT_V(4); PG8_BAR;
        PG8_STAGE_B(PG8_SB(1, 0), cB + kstep); PG8_STAGE_A(PG8_SA(1, 0), aB + kstep, 0); PG8_STAGE_B(PG8_SB(1, 1), cB + hstepB + kstep);
        PG8_WAIT_V(6); PG8_BAR;
    }
    for (;;) {
        const bool has_next = S.next(ui + 1, nxt);
        const char* nB = has_next ? (const char*)g.Bt + (size_t)nxt.pn * tstep : cB;
#pragma unroll 1
        for (int t = 0; t < nt; t += 2) {
            const bool last = (t == nt - 2);
            const char* a1 = aB + (size_t)(t + 1) * kstep;
            const char* a2 = last ? aB : aB + (size_t)(t + 2) * kstep; const char* b2 = last ? nB : cB + (size_t)(t + 2) * kstep;
            const char* a3 = a2 + kstep; const char* b3 = b2 + kstep;
            if (last && has_next) S.a_ready(nxt);
            if constexpr (SP2) {
            PG8_LDB(B0, 0, 0); PG8_LDB(B1, 0, 1); PG8_SCHED; PG8_LDA(At, 0, 0); PG8_STAGE_A(PG8_SA(1, 1), a1, 1); if (last && has_next) PG8_LOADVA(ui + 1);
            PG8_WAIT_V(8); PG8_WAIT_L(0); PG8_BAR; PG8_MMA(0, 0, At, B0); PG8_MMA(0, 1, At, B1); PG8_BAR; PG8_SCHED;
            PG8_LDA(At, 0, 1); PG8_STAGE_B(PG8_SB(0, 0), b2); PG8_STAGE_B(PG8_SB(0, 1), b2 + hstepB); PG8_STAGE_A(PG8_SA(0, 0), a2, 0);
            PG8_WAIT_V(8); PG8_WAIT_L(0); PG8_BAR; PG8_MMA(1, 0, At, B0); PG8_MMA(1, 1, At, B1); PG8_BAR; PG8_SCHED;
            PG8_LDB(B0, 1, 0); PG8_LDB(B1, 1, 1); PG8_SCHED; PG8_LDA(At, 1, 0); PG8_STAGE_A(PG8_SA(0, 1), a2, 1);
            PG8_WAIT_V(8); PG8_WAIT_L(0); PG8_BAR; PG8_MMA(0, 0, At, B0); PG8_MMA(0, 1, At, B1); PG8_BAR; PG8_SCHED;
            PG8_LDA(At, 1, 1); PG8_STAGE_B(PG8_SB(1, 0), b3); PG8_STAGE_B(PG8_SB(1, 1), b3 + hstepB); PG8_STAGE_A(PG8_SA(1, 0), a3, 0);
            PG8_WAIT_V(8); PG8_WAIT_L(0); PG8_BAR; PG8_MMA(1, 0, At, B0); PG8_MMA(1, 1, At, B1); PG8_BAR; PG8_SCHED;
            } else {
            PG8_LDB(B0, 0, 0); PG8_SCHED; PG8_LDA(At, 0, 0); PG8_STAGE_A(PG8_SA(1, 1), a1, 1); if (last && has_next) PG8_LOADVA(ui + 1);
            PG8_WAIT_L(8); PG8_BAR; PG8_WAIT_L(0); PG8_MMA(0, 0, At, B0); PG8_BAR; PG8_SCHED;
            PG8_LDB(B1, 0, 1); PG8_STAGE_B(PG8_SB(0, 0), b2);
            PG8_BAR; PG8_WAIT_L(0); PG8_MMA(0, 1, At, B1); PG8_BAR;
            PG8_LDA(At, 0, 1); PG8_STAGE_A(PG8_SA(0, 0), a2, 0);
            PG8_BAR; PG8_WAIT_L(0); PG8_MMA(1, 0, At, B0); PG8_BAR; PG8_SCHED;
            PG8_STAGE_B(PG8_SB(0, 1), b2 + hstepB);
            PG8_WAIT_V(6); PG8_BAR; PG8_MMA(1, 1, At, B1); PG8_BAR;
            PG8_LDB(B0, 1, 0); PG8_SCHED; PG8_LDA(At, 1, 0); PG8_STAGE_A(PG8_SA(0, 1), a2, 1);
            PG8_WAIT_L(8); PG8_BAR; PG8_WAIT_L(0); PG8_MMA(0, 0, At, B0); PG8_BAR; PG8_SCHED;
            PG8_LDB(B1, 1, 1); PG8_STAGE_B(PG8_SB(1, 0), b3);
            PG8_BAR; PG8_WAIT_L(0); PG8_MMA(0, 1, At, B1); PG8_BAR;
            PG8_LDA(At, 1, 1); PG8_STAGE_A(PG8_SA(1, 0), a3, 0);
            PG8_BAR; PG8_WAIT_L(0); PG8_MMA(1, 0, At, B0); PG8_BAR; PG8_SCHED;
            PG8_STAGE_B(PG8_SB(1, 1), b3 + hstepB);
            PG8_WAIT_V(6); PG8_BAR; PG8_MMA(1, 1, At, B1); PG8_BAR;
            }
        }
        if constexpr (ALIGN_EPI) { if (wr == 0) PG8_BAR; }
        if constexpr (!Epi::AFTER_DRAIN) { int l2_; asm volatile("v_mbcnt_lo_u32_b32 %0, -1, 0\n\tv_mbcnt_hi_u32_b32 %0, -1, %0" : "=v"(l2_));
            E(acc, cur, wr, wc, l2_ & 15, l2_ >> 4); S.done(cur); }
        if (!has_next) break;
#pragma unroll
        for (int a = 0; a < 2; ++a)
#pragma unroll
            for (int b = 0; b < 2; ++b)
#pragma unroll
                for (int m = 0; m < 4; ++m)
#pragma unroll
                    for (int n = 0; n < 2; ++n) acc[a][b][m][n] = (f32x4){0.f, 0.f, 0.f, 0.f};
        cur = nxt; cB = nB; ++ui;
        if constexpr (ALIGN_EPI) { if (wr == 1) PG8_BAR; }
    }
    PG8_WAIT_V(0);
    if constexpr (!ALIGN_EPI) { if (wr == 0) PG8_BAR; }
    PG8_BAR;
    if constexpr (Epi::AFTER_DRAIN) { E.fused(acc, cur, wr, wc, fr, fq, lds, wid, lane); S.done(cur); }
#undef PG8_SA
#undef PG8_SB
#undef PG8_GL
#undef PG8_STAGE_A
#undef PG8_STAGE_B
#undef PG8_LOADVA
#undef PG8_LDA
#undef PG8_LDB
#undef PG8_MMA
#undef PG8_WAIT_V
#undef PG8_WAIT_L
#undef PG8_BAR
#undef PG8_SCHED
}
}
namespace pg8 {
struct GemmA { const bf16_t* A; const bf16_t* Bt; int K; int rowA; size_t kstepA, hstepA, tstepA; };
template <class Epi, class Sched, bool ALIGN_EPI = false, bool SP2 = false>
__device__ __forceinline__ void gemm_phase_ga(PG8_LAS unsigned char* lds, const GemmA g, const Sched& S, const Epi& E, int wid_in) {
    int lane_; asm volatile("v_mbcnt_lo_u32_b32 %0, -1, 0\n\tv_mbcnt_hi_u32_b32 %0, -1, %0" : "=v"(lane_));
    const int wid = wid_in, lane = lane_, tid = wid * 64 + lane, wr = wid >> 2, wc = wid & 3, fr = lane & 15, fq = lane >> 4;
    const int K = g.K, nt = K / BK;
    unsigned voffA[2], voffB[2];
#pragma unroll
    for (int i = 0; i < 2; ++i) { int R, C; stage_rc(tid * 16 + i * 8192, R, C); const int Rb = Perm2<Epi>::v ? (64 * (R >> 5) + 16 * ((R >> 2) & 3) + 4 * ((R >> 4) & 1) + (R & 3)) : Epi::PERM ? ((R & ~31) + perm32(R & 31)) : R;
        voffA[i] = (unsigned)(R * g.rowA + C * 2); voffB[i] = (unsigned)(Rb * K + C) * 2u; }
    const size_t kstep = (size_t)(BK * 2);
    const size_t hstep = (size_t)HALF * K * 2;
    const size_t kstepA = g.kstepA, hstepA = g.hstepA, tstepA = g.tstepA;
    const size_t hstepB = Perm2<Epi>::v ? (size_t)8 * K * 2 : hstep;
    const size_t tstep = 2 * hstep;
    const unsigned ldsw = (unsigned)wid * 1024u;
    const int aoff = lds_byte(wr * 64 + fr, fq * 8), boff = lds_byte(wc * 32 + fr, fq * 8);
#define PG8_SA(b, h) (((b) * 2 + (h)) * HTB)
#define PG8_SB(b, h) ((4 + (b) * 2 + (h)) * HTB)
#define PG8_STAGE(bufoff, gbase, voff) do { _Pragma("unroll") for (int _i = 0; _i < 2; ++_i) \
        __builtin_amdgcn_global_load_lds((const unsigned*)((const char*)(gbase) + (voff)[_i]), (PG8_LAS unsigned*)(lds + (bufoff) + ldsw + _i * 8192), 16, 0, 0); } while (0)
#define PG8_LDA(dst, b, h) do { _Pragma("unroll") for (int m = 0; m < 4; ++m) _Pragma("unroll") for (int k = 0; k < 2; ++k) dst[m][k] = *(const PG8_LAS bf16x8*)(lds + PG8_SA(b, h) + aoff + m * 2048 + k * 1024); } while (0)
#define PG8_LDB(dst, b, h) do { _Pragma("unroll") for (int n = 0; n < 2; ++n) _Pragma("unroll") for (int k = 0; k < 2; ++k) dst[n][k] = *(const PG8_LAS bf16x8*)(lds + PG8_SB(b, h) + boff + n * 2048 + k * 1024); } while (0)
#define PG8_MMA(ai, bj, At, Bt) do { __builtin_amdgcn_s_setprio(1); _Pragma("unroll") for (int m = 0; m < 4; ++m) _Pragma("unroll") for (int n = 0; n < 2; ++n) _Pragma("unroll") for (int k = 0; k < 2; ++k) \
        acc[ai][bj][m][n] = __builtin_amdgcn_mfma_f32_16x16x32_bf16(Bt[n][k], At[m][k], acc[ai][bj][m][n], 0, 0, 0); __builtin_amdgcn_s_setprio(0); } while (0)
#define PG8_WAIT_V(n) asm volatile("s_waitcnt vmcnt(" #n ")" ::: "memory")
#define PG8_WAIT_L(n) asm volatile("s_waitcnt lgkmcnt(" #n ")" ::: "memory")
#define PG8_BAR __builtin_amdgcn_s_barrier()
#define PG8_SCHED __builtin_amdgcn_sched_barrier(0)
    Unit cur, nxt; int ui = 0;
    if (!S.next(0, cur)) return;
    f32x4 acc[2][2][4][2];
#pragma unroll
    for (int a = 0; a < 2; ++a)
#pragma unroll
        for (int b = 0; b < 2; ++b)
#pragma unroll
            for (int m = 0; m < 4; ++m)
#pragma unroll
                for (int n = 0; n < 2; ++n) acc[a][b][m][n] = (f32x4){0.f, 0.f, 0.f, 0.f};
    bf16x8 At[4][2], B0[2][2], B1[2][2];
    const char* cA = (const char*)g.A + (size_t)cur.pm * tstepA; const char* cB = (const char*)g.Bt + (size_t)cur.pn * tstep;
    S.a_ready(cur);
    if constexpr (SP2) {
        PG8_STAGE(PG8_SB(0, 0), cB, voffB); PG8_STAGE(PG8_SB(0, 1), cB + hstepB, voffB); PG8_STAGE(PG8_SA(0, 0), cA, voffA); PG8_STAGE(PG8_SA(0, 1), cA + hstepA, voffA);
        if (wr == 1) PG8_BAR;
        PG8_WAIT_V(2); PG8_BAR;
        PG8_STAGE(PG8_SB(1, 0), cB + kstep, voffB); PG8_STAGE(PG8_SA(1, 0), cA + kstepA, voffA); PG8_STAGE(PG8_SB(1, 1), cB + hstepB + kstep, voffB);
        PG8_WAIT_V(6); PG8_BAR;
    } else {
        PG8_STAGE(PG8_SB(0, 0), cB, voffB); PG8_STAGE(PG8_SA(0, 0), cA, voffA); PG8_STAGE(PG8_SB(0, 1), cB + hstepB, voffB); PG8_STAGE(PG8_SA(0, 1), cA + hstepA, voffA);
        if (wr == 1) PG8_BAR;
        PG8_WAIT_V(4); PG8_BAR;
        PG8_STAGE(PG8_SB(1, 0), cB + kstep, voffB); PG8_STAGE(PG8_SA(1, 0), cA + kstepA, voffA); PG8_STAGE(PG8_SB(1, 1), cB + hstepB + kstep, voffB);
        PG8_WAIT_V(6); PG8_BAR;
    }
    for (;;) {
        const bool has_next = S.next(ui + 1, nxt);
        const char* nA = has_next ? (const char*)g.A + (size_t)nxt.pm * tstepA : cA; const char* nB = has_next ? (const char*)g.Bt + (size_t)nxt.pn * tstep : cB;
        for (int t = 0; t < nt; t += 2) {
            if constexpr (MidSeg<Epi>::v > 0) { if (t > 0 && t % MidSeg<Epi>::v == 0) E.mid(acc, cur, t / MidSeg<Epi>::v, wr, wc, fr, fq); }
            const bool last = (t == nt - 2);
            const char* a1 = cA + (size_t)(t + 1) * kstepA;
            const char* a2 = last ? nA : cA + (size_t)(t + 2) * kstepA; const char* b2 = last ? nB : cB + (size_t)(t + 2) * kstep;
            const char* a3 = a2 + kstepA; const char* b3 = b2 + kstep;
            if (last && has_next) S.a_ready(nxt);
            if constexpr (SP2) {
            PG8_LDB(B0, 0, 0); PG8_LDB(B1, 0, 1); PG8_SCHED; PG8_LDA(At, 0, 0); PG8_STAGE(PG8_SA(1, 1), a1 + hstepA, voffA);
            PG8_WAIT_V(8); PG8_WAIT_L(0); PG8_BAR; PG8_MMA(0, 0, At, B0); PG8_MMA(0, 1, At, B1); PG8_BAR; PG8_SCHED;
            PG8_LDA(At, 0, 1); PG8_STAGE(PG8_SB(0, 0), b2, voffB); PG8_STAGE(PG8_SB(0, 1), b2 + hstepB, voffB); PG8_STAGE(PG8_SA(0, 0), a2, voffA);
            PG8_WAIT_V(8); PG8_WAIT_L(0); PG8_BAR; PG8_MMA(1, 0, At, B0); PG8_MMA(1, 1, At, B1); PG8_BAR; PG8_SCHED;
            PG8_LDB(B0, 1, 0); PG8_LDB(B1, 1, 1); PG8_SCHED; PG8_LDA(At, 1, 0); PG8_STAGE(PG8_SA(0, 1), a2 + hstepA, voffA);
            PG8_WAIT_V(8); PG8_WAIT_L(0); PG8_BAR; PG8_MMA(0, 0, At, B0); PG8_MMA(0, 1, At, B1); PG8_BAR; PG8_SCHED;
            PG8_LDA(At, 1, 1); PG8_STAGE(PG8_SB(1, 0), b3, voffB); PG8_STAGE(PG8_SB(1, 1), b3 + hstepB, voffB); PG8_STAGE(PG8_SA(1, 0), a3, voffA);
            PG8_WAIT_V(8); PG8_WAIT_L(0); PG8_BAR; PG8_MMA(1, 0, At, B0); PG8_MMA(1, 1, At, B1); PG8_BAR; PG8_SCHED;
            } else {
            PG8_LDB(B0, 0, 0); PG8_SCHED; PG8_LDA(At, 0, 0); PG8_STAGE(PG8_SA(1, 1), a1 + hstepA, voffA);
            PG8_WAIT_L(8); PG8_BAR; PG8_WAIT_L(0); PG8_MMA(0, 0, At, B0); PG8_BAR; PG8_SCHED;
            PG8_LDB(B1, 0, 1); PG8_STAGE(PG8_SB(0, 0), b2, voffB);
            PG8_BAR; PG8_WAIT_L(0); PG8_MMA(0, 1, At, B1); PG8_BAR;
            PG8_LDA(At, 0, 1); PG8_STAGE(PG8_SA(0, 0), a2, voffA);
            PG8_BAR; PG8_WAIT_L(0); PG8_MMA(1, 0, At, B0); PG8_BAR; PG8_SCHED;
            PG8_STAGE(PG8_SB(0, 1), b2 + hstepB, voffB);
            PG8_WAIT_V(6); PG8_BAR; PG8_MMA(1, 1, At, B1); PG8_BAR;
            PG8_LDB(B0, 1, 0); PG8_SCHED; PG8_LDA(At, 1, 0); PG8_STAGE(PG8_SA(0, 1), a2 + hstepA, voffA);
            PG8_WAIT_L(8); PG8_BAR; PG8_WAIT_L(0); PG8_MMA(0, 0, At, B0); PG8_BAR; PG8_SCHED;
            PG8_LDB(B1, 1, 1); PG8_STAGE(PG8_SB(1, 0), b3, voffB);
            PG8_BAR; PG8_WAIT_L(0); PG8_MMA(0, 1, At, B1); PG8_BAR;
            PG8_LDA(At, 1, 1); PG8_STAGE(PG8_SA(1, 0), a3, voffA);
            PG8_BAR; PG8_WAIT_L(0); PG8_MMA(1, 0, At, B0); PG8_BAR; PG8_SCHED;
            PG8_STAGE(PG8_SB(1, 1), b3 + hstepB, voffB);
            PG8_WAIT_V(6); PG8_BAR; PG8_MMA(1, 1, At, B1); PG8_BAR;
            }
        }
        if constexpr (ALIGN_EPI) { if (wr == 0) PG8_BAR; }
        if constexpr (!Epi::AFTER_DRAIN) { E(acc, cur, wr, wc, fr, fq); S.done(cur); }
        if (!has_next) break;
#pragma unroll
        for (int a = 0; a < 2; ++a)
#pragma unroll
            for (int b = 0; b < 2; ++b)
#pragma unroll
                for (int m = 0; m < 4; ++m)
#pragma unroll
                    for (int n = 0; n < 2; ++n) acc[a][b][m][n] = (f32x4){0.f, 0.f, 0.f, 0.f};
        cur = nxt; cA = nA; cB = nB; ++ui;
        if constexpr (ALIGN_EPI) { if (wr == 1) PG8_BAR; }
    }
    PG8_WAIT_V(0);
    if constexpr (!ALIGN_EPI) { if (wr == 0) PG8_BAR; }
    PG8_BAR;
    if constexpr (Epi::AFTER_DRAIN) { E.fused(acc, cur, wr, wc, fr, fq, lds, wid, lane); S.done(cur); }
#undef PG8_SA
#undef PG8_SB
#undef PG8_STAGE
#undef PG8_LDA
#undef PG8_LDB
#undef PG8_MMA
#undef PG8_WAIT_V
#undef PG8_WAIT_L
#undef PG8_BAR
#undef PG8_SCHED
}
}
#define GAS __attribute__((address_space(1)))
#define LAS __attribute__((address_space(3)))
typedef unsigned short bf16;
typedef unsigned v4u __attribute__((ext_vector_type(4)));
typedef float f32x4 __attribute__((ext_vector_type(4)));
typedef short bf16x8 __attribute__((ext_vector_type(8)));
typedef GAS unsigned gu32;
typedef GAS unsigned long long gu64;
#define RLX_AGENT __ATOMIC_RELAXED, __HIP_MEMORY_SCOPE_AGENT
#define LDS_WAIT() asm volatile("s_waitcnt lgkmcnt(0)" ::: "memory")
#define VM_WAIT() asm volatile("s_waitcnt vmcnt(0)" ::: "memory")
__device__ __forceinline__ unsigned long long rt() { return __builtin_amdgcn_s_memrealtime(); }
__device__ __forceinline__ unsigned f2bf(float f) { unsigned u = __builtin_bit_cast(unsigned, f); return (u + 0x7fffu + ((u >> 16) & 1u)) >> 16; }
__device__ __forceinline__ unsigned pk2(float lo, float hi) { return f2bf(lo) | (f2bf(hi) << 16); }

#define XB_TMO      128
#define XB_XCNT(j)  (256  + 64 * (j))
#define XB_XSUB(j)  (1280 + 64 * (j))
#define XB_XGEN(j)  (2304 + 64 * (j))
#define XB_TOP      3328
#define XB_TOPGEN   3392
#define XCD_BAR_WORDS 3456
#define XB_SPIN_CAP (1u << 18)

__device__ __forceinline__ unsigned xb_ld(unsigned* p)              { return __hip_atomic_load(p, __ATOMIC_RELAXED, __HIP_MEMORY_SCOPE_AGENT); }
__device__ __forceinline__ unsigned xb_add(unsigned* p, unsigned v) { return __hip_atomic_fetch_add(p, v, __ATOMIC_RELAXED, __HIP_MEMORY_SCOPE_AGENT); }
__device__ __forceinline__ unsigned xb_xcc_id() { return (unsigned)__builtin_amdgcn_s_getreg((3 << 11) | 20) & 0xFu; }
#define XB_SPIN(cond, bar) do { unsigned _sp = 0; while (cond) { __builtin_amdgcn_s_sleep(1); \
    if ((++_sp & 255u) == 0u) { if (xb_ld(&(bar)[XB_TMO])) break; if (_sp > XB_SPIN_CAP) { atomicAdd(&(bar)[XB_TMO], 1u); break; } } } } while (0)

struct XcdBarrier {
    int wv;
    unsigned* bar; unsigned x;
    volatile LAS unsigned* st;
};

__device__ __forceinline__ int xb_lane_id() { int l; asm volatile("v_mbcnt_lo_u32_b32 %0, -1, 0\n\tv_mbcnt_hi_u32_b32 %0, -1, %0" : "=v"(l)); return l; }
__device__ __forceinline__ XcdBarrier xcd_barrier_post(unsigned* bar, volatile LAS unsigned* st, int wv) {
    XcdBarrier b; b.wv = wv; b.bar = bar; b.x = xb_xcc_id(); b.st = st;
    if (wv == 0 && xb_lane_id() == 0) (void)xb_add(&bar[XB_XCNT(b.x)], 1u);
    return b;
}
__device__ __forceinline__ void xcd_barrier_complete(unsigned* bar, unsigned x, unsigned& nloc, unsigned& nx) {
    const unsigned G = gridDim.x * gridDim.y * gridDim.z;
    unsigned sum, cnt, mine, sp = 0u;
    for (;;) {
        sum = 0u; cnt = 0u; mine = 0u;
#pragma unroll
        for (unsigned j = 0; j < 16; ++j) { const unsigned c = xb_ld(&bar[XB_XCNT(j)]); sum += c; cnt += (c > 0u) ? 1u : 0u; mine = (j == x) ? c : mine; }
        if (sum == G) break;
        __builtin_amdgcn_s_sleep(1);
        if ((++sp & 255u) == 0u) { if (xb_ld(&bar[XB_TMO])) break; if (sp > XB_SPIN_CAP) { atomicAdd(&bar[XB_TMO], 1u); break; } }
    }
    nloc = mine > 0u ? mine : 1u; nx = cnt > 0u ? cnt : 1u;
}

__device__ __forceinline__ void xcd_barrier(const XcdBarrier& b) {
    asm volatile("s_waitcnt vmcnt(0)" ::: "memory");
    __syncthreads();
    if (b.wv == 0 && xb_lane_id() == 0) {
        unsigned* bar = b.bar;
        __builtin_amdgcn_s_waitcnt(0);
        unsigned nloc = b.st[0], nx = b.st[1];
        if (nloc == 0u) { xcd_barrier_complete(bar, b.x, nloc, nx); b.st[0] = nloc; b.st[1] = nx; }
        const unsigned old = xb_add(&bar[XB_XSUB(b.x)], 1u);
        const unsigned gen = old / nloc;
        if (old + 1u == (gen + 1u) * nloc) {
            __builtin_amdgcn_fence(__ATOMIC_RELEASE, "agent");
            asm volatile("s_waitcnt vmcnt(0)" ::: "memory");
            const unsigned og = xb_add(&bar[XB_TOP], 1u);
            const unsigned tg = og / nx;
            if (og + 1u == (tg + 1u) * nx) xb_add(&bar[XB_TOPGEN], 1u);
            else XB_SPIN(xb_ld(&bar[XB_TOPGEN]) == tg, bar);
            __builtin_amdgcn_fence(__ATOMIC_ACQUIRE, "agent");
            xb_add(&bar[XB_XGEN(b.x)], 1u);
            asm volatile("s_waitcnt vmcnt(0)" ::: "memory");
        } else {
            XB_SPIN(xb_ld(&bar[XB_XGEN(b.x)]) == gen, bar);
            __builtin_amdgcn_fence(__ATOMIC_ACQUIRE, "agent");
            asm volatile("s_waitcnt vmcnt(0)" ::: "memory");
        }
    }
    __syncthreads();
}
#define DI __device__ __forceinline__
constexpr int NWAVES = 8;
constexpr int NB = 16, SEQ = 2048, DM = 1024, MT = NB * SEQ;
constexpr int DIN_SRC = 6944, NPROJ = 7168;
constexpr int MEML = 256, MROWS = NB * MEML;
constexpr int NEXP = 32, TOPK = 4, DFF = 1024, MOEB = 256;
constexpr int NROWS = MT * TOPK;
constexpr int NBLK_MAX = (NROWS + NEXP * (MOEB - 1) + MOEB - 1) / MOEB;
constexpr int CAP = NBLK_MAX * MOEB;
constexpr float EPS = 1e-6f;
constexpr float NEGF = -1e30f;
constexpr int NB16 = 3584, NF8 = NPROJ - NB16;
constexpr int PC_MLQ = 0, PC_MLK = 512, PC_NQ = 1024, PC_NKC = 1536, PC_NKS = 1664, PC_NKW = 1792, PC_MQ = 1920, PC_MLI = 2432, PC_MLF = 2436, PC_NG = 2440,
              PC_MLV = 2560, PC_NVC = 3072, PC_NVS = 3200, PC_NVW = 3328, PC_MLO = 3584, PC_BRG = 4096;
__host__ __device__ constexpr int proj_srccol(int j) {
    return j < 1024 ? j : j < 1536 ? 2056 + (j - 1024) : j < 1664 ? 2568 + (j - 1536) : j < 1792 ? 2824 + (j - 1664) : j < 1920 ? 3080 + (j - 1792) : j < 2432 ? 3360 + (j - 1920)
         : j < 2440 ? 2048 + (j - 2432) : j < 2464 ? 3336 + (j - 2440) : j < 2560 ? -1
         : j < 3072 ? 1024 + (j - 2560) : j < 3200 ? 2696 + (j - 3072) : j < 3328 ? 2952 + (j - 3200) : j < 3456 ? 3208 + (j - 3328) : j < 3584 ? -1
         : j < 4096 ? 1536 + (j - 3584) : 3872 + (j - 4096);
}

constexpr size_t MiB = 1u << 20;
constexpr size_t WS_CTL = 0, CTL_ZERO_BYTES = 1 * MiB;
constexpr size_t WS_WIN = 1 * MiB, WS_WGU = 15 * MiB, WS_WDN = 143 * MiB, WS_WMKV = 207 * MiB, WS_WBR = 209 * MiB, WS_WOUT = 212 * MiB, WS_WC1 = 214 * MiB;
constexpr size_t WS_WIN8 = WS_WIN + 8 * MiB;
constexpr size_t WS_SMALL = 216 * MiB;
constexpr size_t WS_R1 = 218 * MiB;
constexpr size_t WS_PROJ = 282 * MiB;
constexpr size_t WS_R3 = 730 * MiB;
constexpr size_t WS_MEMKV = WS_R3, WS_MEMKN = WS_R3 + 8 * MiB, WS_QN = WS_R3 + 12 * MiB, WS_KSN = WS_R3 + 44 * MiB, WS_KWN = WS_R3 + 52 * MiB,
                 WS_MQN = WS_R3 + 60 * MiB, WS_MLQK = WS_R3 + 92 * MiB, WS_HID = WS_R3 + 156 * MiB, WS_KC = WS_R3 + 160 * MiB, WS_VC = WS_KC + MiB / 2,
                 WS_H0 = WS_R3 + 161 * MiB, WS_H1 = WS_H0 + 32 * MiB, WS_H2 = WS_H1 + 32 * MiB, WS_ROUTE = WS_H2 + 32 * MiB, WS_END = WS_ROUTE + 6 * MiB;
constexpr size_t WS_MLV = WS_R1, WS_VSN = WS_R1 + 32 * MiB, WS_VWN = WS_R1 + 40 * MiB;
constexpr size_t WS_U8 = WS_H2;
constexpr size_t WS_MEMN = WS_H0;
constexpr size_t WS_ACMP = WS_H1;
constexpr size_t WS_APERM = WS_PROJ;
constexpr size_t WS_ACT = WS_PROJ + 272 * MiB;
static_assert(WS_ACT + 272 * MiB <= WS_H0 + 96 * MiB && WS_END <= 1024 * MiB, "ws map");
constexpr size_t SM_ROPEC = 0, SM_ROPES = 256 * 1024, SM_CBIAS = 512 * 1024, SM_WRT = 1024 * 1024, SM_W2T = 1024 * 1024 + 256 * 1024;
constexpr size_t RT_TOKE = 0, RT_TOKPOS = 512 * 1024, RT_TOKW = 1024 * 1024, RT_TOKDEST = 1536 * 1024, RT_ROWW = 2048 * 1024, RT_ROWTOK = 3072 * 1024;
constexpr int CW_BAR = 4096;
constexpr int CW_ECNT = 16384;
constexpr int CW_QCTR = 16384 + 64;

constexpr int RING_BYTES = 131072, LDSCTL_OFF = RING_BYTES, MISC_OFF = LDSCTL_OFF + 320, LDS_BYTES = 155648;

struct Args { const float* in[34]; float* out; unsigned char* ws; int ph_lo, ph_hi, li, pad; };

DI float bf2f(unsigned short h) { return __uint_as_float((unsigned)h << 16); }
DI float wave_sum(float v) {
#pragma unroll
    for (int o = 1; o < 64; o <<= 1) v += __shfl_xor(v, o);
    return v;
}
DI float wave_max(float v) {
#pragma unroll
    for (int o = 1; o < 64; o <<= 1) v = fmaxf(v, __shfl_xor(v, o));
    return v;
}
DI float sigm(float x) { return __builtin_amdgcn_rcpf(1.f + __expf(-x)); }
DI float logsig(float x) { return fminf(x, 0.f) - log1pf(__expf(-fabsf(x))); }

namespace pg8 {
struct EpiBf16Silu {
    static constexpr bool PERM = true, AFTER_DRAIN = false, PERM2 = true;
    bf16_t* O; int ldc; const float* bias; int silu;
    DI void operator()(const f32x4 (&acc)[2][2][4][2], const Unit& u, int wr, int wc, int fr, int fq) const {
        const int row0 = u.pm * BM + wr * 64 + fr; const int col0 = u.pn * BM + wc * 64 + 16 * fq;
#pragma unroll
        for (int ai = 0; ai < 2; ++ai)
#pragma unroll
            for (int m = 0; m < 4; ++m) { bf16_t* rowp = O + (size_t)(row0 + ai * HALF + m * 16) * ldc + col0;
#pragma unroll
                for (int bj = 0; bj < 2; ++bj) { f32x4 v0 = acc[ai][bj][m][0], v1 = acc[ai][bj][m][1];
                    if (bias) { v0 += *(const f32x4*)(bias + col0 + 8 * bj); v1 += *(const f32x4*)(bias + col0 + 8 * bj + 4); }
                    if (silu) {
#pragma unroll
                        for (int j = 0; j < 4; ++j) { v0[j] = v0[j] * __builtin_amdgcn_rcpf(1.f + __expf(-v0[j])); v1[j] = v1[j] * __builtin_amdgcn_rcpf(1.f + __expf(-v1[j])); } }
                    u32x4 w; w.x = cvt_pk_bf16(v0[0], v0[1]); w.y = cvt_pk_bf16(v0[2], v0[3]); w.z = cvt_pk_bf16(v1[0], v1[1]); w.w = cvt_pk_bf16(v1[2], v1[3]);
                    *(u32x4*)(rowp + 8 * bj) = w; } }
    }
};
template <int B> struct EpiGate {
    static constexpr bool PERM = false, AFTER_DRAIN = false;
    const bf16_t* proj; float* tmp; bf16_t* merged;
    DI void operator()(const f32x4 (&acc)[2][2][4][2], const Unit& u, int wr, int wc, int fr, int fq) const {
        typedef unsigned u32x2v __attribute__((ext_vector_type(2)));
        const int col0 = u.pn * BM + wc * 32 + 4 * fq;
#pragma unroll
        for (int ai = 0; ai < 2; ++ai)
#pragma unroll
            for (int m = 0; m < 4; ++m) { const size_t r = (size_t)(u.pm * BM + ai * HALF + wr * 64 + m * 16 + fr);
#pragma unroll
                for (int bj = 0; bj < 2; ++bj)
#pragma unroll
                    for (int n = 0; n < 2; ++n) { const int c = col0 + bj * HALF + n * 16;
                        const u32x2v gw = *(const u32x2v*)(proj + r * NPROJ + PC_BRG + B * DM + c);
                        f32x4 g; g[0] = __uint_as_float(gw.x << 16); g[1] = __uint_as_float(gw.x & 0xffff0000u); g[2] = __uint_as_float(gw.y << 16); g[3] = __uint_as_float(gw.y & 0xffff0000u);
                        f32x4 v = acc[ai][bj][m][n];
#pragma unroll
                        for (int j = 0; j < 4; ++j) v[j] = v[j] * __builtin_amdgcn_rcpf(1.f + __expf(-g[j]));
                        float* tp = tmp + r * DM + c;
                        if (B == 0) { *(f32x4*)tp = v; }
                        else if (B == 1) { *(f32x4*)tp = *(const f32x4*)tp + v; }
                        else { v = *(const f32x4*)tp + v; u32x2v w; w.x = cvt_pk_bf16(v[0], v[1]); w.y = cvt_pk_bf16(v[2], v[3]); *(u32x2v*)(merged + r * DM + c) = w; } } }
    }
};
struct EpiMerge {
    static constexpr bool PERM = false, AFTER_DRAIN = false;
    const bf16_t* proj; float* tmp; bf16_t* merged;
    DI void operator()(const f32x4 (&acc)[2][2][4][2], const Unit& u, int wr, int wc, int fr, int fq) const {
        typedef unsigned u32x2v __attribute__((ext_vector_type(2)));
        const int b = u.pn >> 2, pn = u.pn & 3, pm = u.pm & 127;
        const int col0 = pn * BM + wc * 32 + 4 * fq;
#pragma unroll
        for (int ai = 0; ai < 2; ++ai)
#pragma unroll
            for (int m = 0; m < 4; ++m) { const size_t r = (size_t)(pm * BM + ai * HALF + wr * 64 + m * 16 + fr);
#pragma unroll
                for (int bj = 0; bj < 2; ++bj)
#pragma unroll
                    for (int n = 0; n < 2; ++n) { const int c = col0 + bj * HALF + n * 16;
                        const u32x2v gw = *(const u32x2v*)(proj + r * NPROJ + PC_BRG + b * DM + c);
                        f32x4 g; g[0] = __uint_as_float(gw.x << 16); g[1] = __uint_as_float(gw.x & 0xffff0000u); g[2] = __uint_as_float(gw.y << 16); g[3] = __uint_as_float(gw.y & 0xffff0000u);
                        f32x4 v = acc[ai][bj][m][n];
#pragma unroll
                        for (int j = 0; j < 4; ++j) v[j] = v[j] * __builtin_amdgcn_rcpf(1.f + __expf(-g[j]));
                        float* tp = tmp + r * DM + c;
                        if (b == 0) { *(f32x4*)tp = v; }
                        else if (b == 1) { *(f32x4*)tp = *(const f32x4*)tp + v; }
                        else { v = *(const f32x4*)tp + v; u32x2v w; w.x = cvt_pk_bf16(v[0], v[1]); w.y = cvt_pk_bf16(v[2], v[3]); *(u32x2v*)(merged + r * DM + c) = w; } } }
    }
};
struct EpiMergeK {
    static constexpr bool PERM = true, AFTER_DRAIN = false; static constexpr int MIDSEG = 8;
    const bf16_t* proj; bf16_t* merged;
    DI static void ldg8(const bf16_t* p, float (&g)[8]) { const u32x4 w = *(const u32x4*)p; const unsigned ws_[4] = {w.x, w.y, w.z, w.w};
#pragma unroll
        for (int j = 0; j < 4; ++j) { g[2 * j] = __uint_as_float(ws_[j] << 16); g[2 * j + 1] = __uint_as_float(ws_[j] & 0xffff0000u); } }
    DI void mid(f32x4 (&acc)[2][2][4][2], const Unit& u, int seg, int wr, int wc, int fr, int fq) const {
        const int col0 = u.pn * BM + wc * 32 + 8 * fq;
#pragma unroll
        for (int ai = 0; ai < 2; ++ai)
#pragma unroll
            for (int m = 0; m < 4; ++m) { const size_t r = (size_t)(u.pm * BM + ai * HALF + wr * 64 + m * 16 + fr);
#pragma unroll
                for (int bj = 0; bj < 2; ++bj) { const bf16_t* gp = proj + r * NPROJ + PC_BRG + (seg - 1) * DM + col0 + bj * HALF;
                    float ga[8], gb[8]; ldg8(gp, ga); ldg8(gp + DM, gb);
#pragma unroll
                    for (int n = 0; n < 2; ++n)
#pragma unroll
                        for (int j = 0; j < 4; ++j) acc[ai][bj][m][n][j] *= (1.f + __expf(-gb[4 * n + j])) * __builtin_amdgcn_rcpf(1.f + __expf(-ga[4 * n + j])); } }
    }
    DI void operator()(const f32x4 (&acc)[2][2][4][2], const Unit& u, int wr, int wc, int fr, int fq) const {
        const int col0 = u.pn * BM + wc * 32 + 8 * fq;
#pragma unroll
        for (int ai = 0; ai < 2; ++ai)
#pragma unroll
            for (int m = 0; m < 4; ++m) { const size_t r = (size_t)(u.pm * BM + ai * HALF + wr * 64 + m * 16 + fr);
#pragma unroll
                for (int bj = 0; bj < 2; ++bj) { float g[8]; ldg8(proj + r * NPROJ + PC_BRG + 2 * DM + col0 + bj * HALF, g); float v[8];
#pragma unroll
                    for (int n = 0; n < 2; ++n)
#pragma unroll
                        for (int j = 0; j < 4; ++j) v[4 * n + j] = acc[ai][bj][m][n][j] * __builtin_amdgcn_rcpf(1.f + __expf(-g[4 * n + j]));
                    u32x4 w; w.x = cvt_pk_bf16(v[0], v[1]); w.y = cvt_pk_bf16(v[2], v[3]); w.z = cvt_pk_bf16(v[4], v[5]); w.w = cvt_pk_bf16(v[6], v[7]);
                    *(u32x4*)(merged + r * DM + col0 + bj * HALF) = w; } }
    }
};
struct MergeOrder {
    StaticOrder so;
    DI bool next(int i, Unit& u) const { const int tl = i / 3, b = i - 3 * tl; Unit t; if (!so.next(tl, t)) return false; u.pm = b * 128 + t.pm; u.pn = b * 4 + t.pn; return true; }
    DI void a_ready(const Unit&) const {}
    DI void done(const Unit&) const {}
};
struct EpiRes {
    static constexpr bool PERM = false, AFTER_DRAIN = false;
    const float* base; float* out;
    DI void operator()(const f32x4 (&acc)[2][2][4][2], const Unit& u, int wr, int wc, int fr, int fq) const {
        const int col0 = u.pn * BM + wc * 32 + 4 * fq;
#pragma unroll
        for (int ai = 0; ai < 2; ++ai)
#pragma unroll
            for (int m = 0; m < 4; ++m) { const size_t r = (size_t)(u.pm * BM + ai * HALF + wr * 64 + m * 16 + fr);
#pragma unroll
                for (int bj = 0; bj < 2; ++bj)
#pragma unroll
                    for (int n = 0; n < 2; ++n) { const int c = col0 + bj * HALF + n * 16; *(f32x4*)(out + r * DM + c) = *(const f32x4*)(base + r * DM + c) + acc[ai][bj][m][n]; } }
    }
};
struct EpiSwiglu {
    static constexpr bool PERM = true, AFTER_DRAIN = false, PERM2 = true;
    unsigned char* act; const float* bgu;
    DI void operator()(const f32x4 (&acc)[2][2][4][2], const Unit& u, int wr, int wc, int fr, int fq) const {
        typedef unsigned u32x2v __attribute__((ext_vector_type(2)));
        const int e = u.pn >> 3, pnl = u.pn & 7;
        const unsigned lc0 = (unsigned)(pnl * BM + wc * 64 + 16 * fq);
        const unsigned row0 = (unsigned)(u.pm * BM + wr * 64 + fr);
        const float* bp = bgu + e * 2048 + lc0;
        f32x4 bv[2][2];
#pragma unroll
        for (int bj = 0; bj < 2; ++bj)
#pragma unroll
            for (int n = 0; n < 2; ++n) bv[bj][n] = *(const f32x4*)(bp + 8 * bj + 4 * n);
#pragma unroll
        for (int ai = 0; ai < 2; ++ai)
#pragma unroll
            for (int m = 0; m < 4; ++m) { const unsigned rowoff = (row0 + ai * HALF + m * 16) * (unsigned)DFF;
                int q8[2] = {0, 0};
#pragma unroll
                for (int bj = 0; bj < 2; ++bj) { float o[4];
#pragma unroll
                    for (int n = 0; n < 2; ++n) { const f32x4 v = acc[ai][bj][m][n] + bv[bj][n];
#pragma unroll
                        for (int q = 0; q < 2; ++q) { const float gt = fminf(v[2 * q], 7.0f); const float up = fminf(fmaxf(v[2 * q + 1], -7.0f), 7.0f);
                            o[2 * n + q] = (up + 1.0f) * (gt * __builtin_amdgcn_rcpf(1.f + __expf(-1.702f * gt))); } }
                    q8[bj] = __builtin_amdgcn_cvt_pk_fp8_f32(o[0], o[1], q8[bj], false); q8[bj] = __builtin_amdgcn_cvt_pk_fp8_f32(o[2], o[3], q8[bj], true); }
                *(u32x2v*)(act + (rowoff + (lc0 >> 1))) = (u32x2v){(unsigned)q8[0], (unsigned)q8[1]}; }
    }
};
struct EpiDown {
    static constexpr bool PERM = true, AFTER_DRAIN = false, PERM2 = true;
    unsigned char* y; const float* bdn; const float* roww;
    DI void operator()(const f32x4 (&acc)[2][2][4][2], const Unit& u, int wr, int wc, int fr, int fq) const {
        const int e = u.pn >> 2, pnl = u.pn & 3;
        const int col0 = pnl * BM + wc * 64 + 16 * fq;
        const float* bp = bdn + e * DM + col0;
        f32x4 bv[2][2];
#pragma unroll
        for (int bj = 0; bj < 2; ++bj) { bv[bj][0] = *(const f32x4*)(bp + 8 * bj); bv[bj][1] = *(const f32x4*)(bp + 8 * bj + 4); }
        const unsigned row0 = (unsigned)(u.pm * BM + wr * 64 + fr);
#pragma unroll
        for (int ai = 0; ai < 2; ++ai)
#pragma unroll
            for (int m = 0; m < 4; ++m) { const unsigned r = row0 + ai * HALF + m * 16; const float rw = roww[r] * 8.0f; unsigned q[4];
#pragma unroll
                for (int bj = 0; bj < 2; ++bj)
#pragma unroll
                    for (int n = 0; n < 2; ++n) { const f32x4 v = (acc[ai][bj][m][n] + bv[bj][n]) * rw; int w = 0;
                        w = __builtin_amdgcn_cvt_pk_fp8_f32(v[0], v[1], w, false); w = __builtin_amdgcn_cvt_pk_fp8_f32(v[2], v[3], w, true); q[2 * bj + n] = (unsigned)w; }
                *(u32x4*)(y + (r * (unsigned)DM + (unsigned)col0)) = (u32x4){q[0], q[1], q[2], q[3]}; }
    }
};
template <int NPN> struct MoeOrder {
    int nblk, G, c; const PG8_LAS unsigned char* blk_e;
    DI bool next(int i, Unit& u) const {
        int rb, pn;
        if (G == 256) { const int x = c & 7, j = c >> 3; rb = i * (256 / NPN) + x * (32 / NPN) + j / NPN; pn = j % NPN; }
        else { const int L = i * G + c; rb = L / NPN; pn = L % NPN; }
        if (rb >= nblk) return false;
        u.pm = rb; u.pn = __builtin_amdgcn_readfirstlane((int)blk_e[rb]) * NPN + pn; return true; }
    DI void a_ready(const Unit&) const {}
    DI void done(const Unit&) const {}
};
}

struct Frame {
    LAS unsigned char* lds; volatile LAS unsigned* MISC; unsigned* ctl; unsigned char* ws;
    int wave, G, bx;
    DI int lane_id() const { int l; asm volatile("v_mbcnt_lo_u32_b32 %0, -1, 0\n\tv_mbcnt_hi_u32_b32 %0, -1, %0" : "=v"(l)); return l; }
    DI int tid_id() const { return wave * 64 + lane_id(); }
    const float* const* in; float* out;
};
enum { I_X = 0, I_MEM, I_GMIX, I_WIN, I_CONVW, I_CONVB, I_MLBI, I_MLBF, I_MLGOUT, I_NGQ, I_NGK, I_CPK, I_CW1K, I_CB1K, I_CW2K, I_CPV, I_CW1V, I_CB1V, I_CW2V,
       I_GMEM, I_WMKV, I_MGQ, I_MGK, I_WBRML, I_WBRNSA, I_WBRMEM, I_WOUT, I_GFFN, I_WR, I_BR, I_WGU, I_BGU, I_WDN, I_BDN, N_IN };

template <class CM>
DI void tr_item(const float* W, int ldw, int K, bf16* WT, int k0, int n0, CM cm, LAS float* scr, int lane) {
    const int sc = cm(n0 + (lane & 31));
#pragma unroll 8
    for (int i = 0; i < 32; ++i) { const int kk = 2 * i + (lane >> 5); scr[kk * 33 + (lane & 31)] = sc >= 0 ? W[(size_t)(k0 + kk) * ldw + sc] : 0.f; }
    LDS_WAIT(); asm volatile("" ::: "memory");
    const int c = lane & 7;
#pragma unroll
    for (int j = 0; j < 4; ++j) { const int n = (lane >> 3) + 8 * j; const LAS float* s = scr + (8 * c) * 33 + n;
        v4u o; o.x = pk2(s[0 * 33], s[1 * 33]); o.y = pk2(s[2 * 33], s[3 * 33]); o.z = pk2(s[4 * 33], s[5 * 33]); o.w = pk2(s[6 * 33], s[7 * 33]);
        *(v4u*)(WT + (size_t)(n0 + n) * K + k0 + 8 * c) = o; }
    LDS_WAIT(); asm volatile("" ::: "memory");
}
DI void tr_item_f8(const float* W, int ldw, int K, unsigned char* WT, int k0, int n0, LAS float* scr, int lane) {
#pragma unroll 8
    for (int i = 0; i < 32; ++i) { const int kk = 2 * i + (lane >> 5); scr[kk * 33 + (lane & 31)] = W[(size_t)(k0 + kk) * ldw + n0 + (lane & 31)] * 256.0f; }
    LDS_WAIT(); asm volatile("" ::: "memory");
    const int c = lane & 7;
#pragma unroll
    for (int j = 0; j < 4; ++j) { const int n = (lane >> 3) + 8 * j; const LAS float* sp = scr + (8 * c) * 33 + n;
        int lo = 0, hi = 0;
        lo = __builtin_amdgcn_cvt_pk_fp8_f32(sp[0 * 33], sp[1 * 33], lo, false); lo = __builtin_amdgcn_cvt_pk_fp8_f32(sp[2 * 33], sp[3 * 33], lo, true);
        hi = __builtin_amdgcn_cvt_pk_fp8_f32(sp[4 * 33], sp[5 * 33], hi, false); hi = __builtin_amdgcn_cvt_pk_fp8_f32(sp[6 * 33], sp[7 * 33], hi, true);
        typedef unsigned u32x2t __attribute__((ext_vector_type(2)));
        *(u32x2t*)(WT + (size_t)(n0 + n) * K + k0 + 8 * c) = (u32x2t){(unsigned)lo, (unsigned)hi}; }
    LDS_WAIT(); asm volatile("" ::: "memory");
}
DI void tr_load_v4(const float* W, int ldw, int k0, int n0, int lane, f32x4 (&v)[8]) {
#pragma unroll
    for (int i = 0; i < 8; ++i) v[i] = *(const f32x4*)(W + (size_t)(k0 + 8 * i + (lane >> 3)) * ldw + n0 + 4 * (lane & 7));
}
DI void tr_put_v4(const f32x4 (&v)[8], LAS float* scr, int lane, float mul) {
#pragma unroll
    for (int i = 0; i < 8; ++i) { LAS float* d = scr + (8 * i + (lane >> 3)) * 33 + 4 * (lane & 7); d[0] = v[i].x * mul; d[1] = v[i].y * mul; d[2] = v[i].z * mul; d[3] = v[i].w * mul; }
    LDS_WAIT(); asm volatile("" ::: "memory");
}
DI void tr_load_v4x16(const float* W, int ldw, int k0, int n0, int lane, f32x4 (&v)[16]) {
#pragma unroll
    for (int i = 0; i < 16; ++i) v[i] = *(const f32x4*)(W + (size_t)(k0 + 8 * i + (lane >> 3)) * ldw + n0 + 4 * (lane & 7));
}
DI void tr_put_v4x16(const f32x4 (&v)[16], LAS float* scr, int lane, float mul) {
#pragma unroll
    for (int i = 0; i < 16; ++i) { LAS float* d = scr + (8 * i + (lane >> 3)) * 33 + 4 * (lane & 7); d[0] = v[i].x * mul; d[1] = v[i].y * mul; d[2] = v[i].z * mul; d[3] = v[i].w * mul; }
    LDS_WAIT(); asm volatile("" ::: "memory");
}
DI void tr_emit_f8x16(unsigned char* WT, int K, int k0, int n0, LAS float* scr, int lane) {
    const int c = lane & 7;
#pragma unroll
    for (int j = 0; j < 4; ++j) { const int n = (lane >> 3) + 8 * j; const LAS float* sp = scr + (16 * c) * 33 + n; unsigned q[4];
#pragma unroll
        for (int h = 0; h < 4; ++h) { int w = 0; w = __builtin_amdgcn_cvt_pk_fp8_f32(sp[(4 * h) * 33], sp[(4 * h + 1) * 33], w, false); w = __builtin_amdgcn_cvt_pk_fp8_f32(sp[(4 * h + 2) * 33], sp[(4 * h + 3) * 33], w, true); q[h] = (unsigned)w; }
        *(v4u*)(WT + (size_t)(n0 + n) * K + k0 + 16 * c) = (v4u){q[0], q[1], q[2], q[3]}; }
    LDS_WAIT(); asm volatile("" ::: "memory");
}
DI void tr_fill_v4(const float* W, int ldw, int k0, int n0, LAS float* scr, int lane, float mul) { f32x4 v[8]; tr_load_v4(W, ldw, k0, n0, lane, v); tr_put_v4(v, scr, lane, mul); }
DI void tr_emit_bf16(bf16* WT, int K, int k0, int n0, LAS float* scr, int lane) {
    const int c = lane & 7;
#pragma unroll
    for (int j = 0; j < 4; ++j) { const int n = (lane >> 3) + 8 * j; const LAS float* sp = scr + (8 * c) * 33 + n;
        v4u o; o.x = pk2(sp[0 * 33], sp[1 * 33]); o.y = pk2(sp[2 * 33], sp[3 * 33]); o.z = pk2(sp[4 * 33], sp[5 * 33]); o.w = pk2(sp[6 * 33], sp[7 * 33]);
        *(v4u*)(WT + (size_t)(n0 + n) * K + k0 + 8 * c) = o; }
    LDS_WAIT(); asm volatile("" ::: "memory");
}
DI void tr_emit_f8(unsigned char* WT, int K, int k0, int n0, LAS float* scr, int lane) {
    const int c = lane & 7;
#pragma unroll
    for (int j = 0; j < 4; ++j) { const int n = (lane >> 3) + 8 * j; const LAS float* sp = scr + (8 * c) * 33 + n;
        int lo = 0, hi = 0;
        lo = __builtin_amdgcn_cvt_pk_fp8_f32(sp[0 * 33], sp[1 * 33], lo, false); lo = __builtin_amdgcn_cvt_pk_fp8_f32(sp[2 * 33], sp[3 * 33], lo, true);
        hi = __builtin_amdgcn_cvt_pk_fp8_f32(sp[4 * 33], sp[5 * 33], hi, false); hi = __builtin_amdgcn_cvt_pk_fp8_f32(sp[6 * 33], sp[7 * 33], hi, true);
        typedef unsigned u32x2t __attribute__((ext_vector_type(2)));
        *(u32x2t*)(WT + (size_t)(n0 + n) * K + k0 + 8 * c) = (u32x2t){(unsigned)lo, (unsigned)hi}; }
    LDS_WAIT(); asm volatile("" ::: "memory");
}
template <class CM>
DI void tr_fill_v4cm(const float* W, int ldw, int k0, int n0, CM cm, LAS float* scr, int lane, float mul) {
    const int sc = cm(n0 + 4 * (lane & 7)); f32x4 v[8];
#pragma unroll
    for (int i = 0; i < 8; ++i) v[i] = sc >= 0 ? *(const f32x4*)(W + (size_t)(k0 + 8 * i + (lane >> 3)) * ldw + sc) : (f32x4){0.f, 0.f, 0.f, 0.f};
    tr_put_v4(v, scr, lane, mul);
}
template <class CM>
DI void tr_fill_cm(const float* W, int ldw, int k0, int n0, CM cm, LAS float* scr, int lane, float mul) {
    const int sc = cm(n0 + (lane & 31));
#pragma unroll 8
    for (int i = 0; i < 32; ++i) { const int kk = 2 * i + (lane >> 5); scr[kk * 33 + (lane & 31)] = sc >= 0 ? W[(size_t)(k0 + kk) * ldw + sc] * mul : 0.f; }
    LDS_WAIT(); asm volatile("" ::: "memory");
}
struct CmId { DI int operator()(int j) const { return j; } };
struct CmProj { DI int operator()(int j) const { return proj_srccol(j); } };

DI void rms_row_bf16(const float* xrow, const float* g, bf16* orow, int lane) {
    const f32x4* xr = (const f32x4*)xrow + lane; const f32x4* gr = (const f32x4*)g + lane;
    f32x4 v[4]; float s = 0.f;
#pragma unroll
    for (int j = 0; j < 4; ++j) { v[j] = xr[64 * j]; s += (v[j].x * v[j].x + v[j].y * v[j].y) + (v[j].z * v[j].z + v[j].w * v[j].w); }
    const float rstd = rsqrtf(wave_sum(s) * (1.f / DM) + EPS);
    unsigned long long* o8 = (unsigned long long*)orow + lane;
#pragma unroll
    for (int j = 0; j < 4; ++j) { const f32x4 gg = gr[64 * j];
        o8[64 * j] = (unsigned long long)pk2(v[j].x * rstd * gg.x, v[j].y * rstd * gg.y) | ((unsigned long long)pk2(v[j].z * rstd * gg.z, v[j].w * rstd * gg.w) << 32); }
}

DI void rms_row_f8(const float* xrow, const float* g, unsigned char* orow, int lane) {
    const f32x4* xr = (const f32x4*)xrow + lane; const f32x4* gr = (const f32x4*)g + lane;
    f32x4 v[4]; float s = 0.f;
#pragma unroll
    for (int j = 0; j < 4; ++j) { v[j] = xr[64 * j]; s += (v[j].x * v[j].x + v[j].y * v[j].y) + (v[j].z * v[j].z + v[j].w * v[j].w); }
    const float rstd = rsqrtf(wave_sum(s) * (1.f / DM) + EPS);
    unsigned* o4 = (unsigned*)orow + lane;
#pragma unroll
    for (int j = 0; j < 4; ++j) { const f32x4 gg = gr[64 * j]; int q8 = 0;
        q8 = __builtin_amdgcn_cvt_pk_fp8_f32(v[j].x * rstd * gg.x, v[j].y * rstd * gg.y, q8, false); q8 = __builtin_amdgcn_cvt_pk_fp8_f32(v[j].z * rstd * gg.z, v[j].w * rstd * gg.w, q8, true);
        o4[64 * j] = (unsigned)q8; }
}
template <int NR>
DI void rms_rows_both(const float* x0, const float* g, bf16* o0, unsigned char* o80, size_t step, int lane) {
    const f32x4* gr = (const f32x4*)g + lane;
    f32x4 v[NR][4];
#pragma unroll
    for (int q = 0; q < NR; ++q) { const f32x4* xr = (const f32x4*)(x0 + q * step * DM) + lane;
#pragma unroll
        for (int j = 0; j < 4; ++j) v[q][j] = xr[64 * j]; }
#pragma unroll
    for (int q = 0; q < NR; ++q) { float s = 0.f;
#pragma unroll
        for (int j = 0; j < 4; ++j) s += (v[q][j].x * v[q][j].x + v[q][j].y * v[q][j].y) + (v[q][j].z * v[q][j].z + v[q][j].w * v[q][j].w);
        const float rstd = rsqrtf(wave_sum(s) * (1.f / DM) + EPS);
        unsigned long long* o8 = (unsigned long long*)(o0 + q * step * DM) + lane; unsigned* o4 = (unsigned*)(o80 + q * step * DM) + lane;
#pragma unroll
        for (int j = 0; j < 4; ++j) { const f32x4 gg = gr[64 * j]; const float y0 = v[q][j].x * rstd * gg.x, y1 = v[q][j].y * rstd * gg.y, y2 = v[q][j].z * rstd * gg.z, y3 = v[q][j].w * rstd * gg.w;
            o8[64 * j] = (unsigned long long)pk2(y0, y1) | ((unsigned long long)pk2(y2, y3) << 32);
            int q8 = 0; q8 = __builtin_amdgcn_cvt_pk_fp8_f32(y0, y1, q8, false); q8 = __builtin_amdgcn_cvt_pk_fp8_f32(y2, y3, q8, true);
            o4[64 * j] = (unsigned)q8; } }
}
template <int PARTS = 0xf>
DI void p0_prologue(Frame& F) {
    LAS float* scr = (LAS float*)(F.lds + F.wave * 16384);
    const int gw = F.bx * NWAVES + F.wave, NGW = F.G * NWAVES;
    unsigned char* ws = F.ws;
    constexpr int IT_IN = 16 * (NPROJ / 32), IT_GU = 32 * 16 * 64, IT_DN = 32 * 16 * 32, IT_MKV = 16 * 32, IT_BR = 3 * 8 * 32, IT_OUT = 16 * 32, IT_C1 = 2 * 32 * 8;
    constexpr int NITEMS = IT_IN + IT_GU + IT_DN + IT_MKV + IT_BR + IT_OUT + IT_C1;
    if (PARTS & 1)
    {
        constexpr int JT_GU = 32 * 8 * 64, JT_DN = 32 * 8 * 32;
        struct D { const float* src; unsigned char* dst; int ldw, k0, n0; };
        auto dec = [&](int j) { D d; if (j < JT_GU) { const int e = j / 512, q = j % 512; d.src = F.in[I_WGU] + (size_t)e * DM * 2048; d.dst = (unsigned char*)(ws + WS_WGU) + (size_t)e * 2048 * DM; d.ldw = 2048; d.k0 = 128 * (q / 64); d.n0 = 32 * (q % 64); }
                                     else { const int jj = j - JT_GU, e = jj / 256, q = jj % 256; d.src = F.in[I_WDN] + (size_t)e * DFF * DM; d.dst = (unsigned char*)(ws + WS_WDN) + (size_t)e * DM * DFF; d.ldw = DM; d.k0 = 128 * (q / 32); d.n0 = 32 * (q % 32); } return d; };
        const int lane = F.lane_id();
        LAS float* scr2 = (LAS float*)(F.wave < 7 ? F.lds + F.wave * 16896 : F.lds + 135424);
        int j = gw; f32x4 va[16]; D da{};
        if (j < JT_GU + JT_DN) { da = dec(j); tr_load_v4x16(da.src, da.ldw, da.k0, da.n0, lane, va); }
#pragma unroll 1
        while (j < JT_GU + JT_DN) {
            const int jn = j + NGW; f32x4 vb[16]; D db{};
            if (jn < JT_GU + JT_DN) { db = dec(jn); tr_load_v4x16(db.src, db.ldw, db.k0, db.n0, lane, vb); }
            else {
#pragma unroll
                for (int i = 0; i < 16; ++i) vb[i] = va[i]; }
            tr_put_v4x16(va, scr2, lane, 256.0f); tr_emit_f8x16(da.dst, 1024, da.k0, da.n0, scr2, lane);
#pragma unroll
            for (int i = 0; i < 16; ++i) va[i] = vb[i];
            da = db; j = jn;
        }
        __syncthreads();
    }
    if (PARTS & 2)
    for (int it = gw; it < NITEMS; it += NGW) {
        int r = it;
        if (r < IT_IN) { const int kb = r / (NPROJ / 32), nb = r % (NPROJ / 32); if (32 * nb < NB16) { tr_fill_v4cm(F.in[I_WIN], DIN_SRC, 64 * kb, 32 * nb, CmProj(), scr, F.lane_id(), 1.0f); tr_emit_bf16((bf16*)(ws + WS_WIN), DM, 64 * kb, 32 * nb, scr, F.lane_id()); }
            else { tr_fill_v4cm(F.in[I_WIN], DIN_SRC, 64 * kb, 32 * nb, CmProj(), scr, F.lane_id(), 256.0f); tr_emit_f8((unsigned char*)(ws + WS_WIN8), DM, 64 * kb, 32 * nb - NB16, scr, F.lane_id()); }
            continue; } r -= IT_IN;
        if (r < IT_GU + IT_DN) continue; r -= IT_GU + IT_DN;
        if (r < IT_MKV) { const int kb = r / 32, nb = r % 32; tr_fill_v4(F.in[I_WMKV], 1024, 64 * kb, 32 * nb, scr, F.lane_id(), 1.0f); tr_emit_bf16((bf16*)(ws + WS_WMKV), 1024, 64 * kb, 32 * nb, scr, F.lane_id()); continue; } r -= IT_MKV;
        if (r < IT_BR) { const int b = r / 256, q = r % 256, kb = q / 32, nb = q % 32; tr_fill_v4(F.in[I_WBRML + b], 1024, 64 * kb, 32 * nb, scr, F.lane_id(), 1.0f); tr_emit_bf16((bf16*)(ws + WS_WBR), 1536, 512 * b + 64 * kb, 32 * nb, scr, F.lane_id()); continue; } r -= IT_BR;
        if (r < IT_OUT) { const int kb = r / 32, nb = r % 32; tr_fill_v4(F.in[I_WOUT], 1024, 64 * kb, 32 * nb, scr, F.lane_id(), 1.0f); tr_emit_bf16((bf16*)(ws + WS_WOUT), 1024, 64 * kb, 32 * nb, scr, F.lane_id()); continue; } r -= IT_OUT;
        { const int kv = r / 256, q = r % 256, kb = q / 8, nb = q % 8; tr_fill_v4(F.in[kv ? I_CW1V : I_CW1K], 256, 64 * kb, 32 * nb, scr, F.lane_id(), 1.0f); tr_emit_bf16((bf16*)(ws + WS_WC1) + (size_t)kv * 256 * 2048, 2048, 64 * kb, 32 * nb, scr, F.lane_id()); }
    }
    if (PARTS & 4)
    { int m = gw;
      for (; m + 3 * NGW < MT; m += 4 * NGW) rms_rows_both<4>(F.in[I_X] + (size_t)m * DM, F.in[I_GMIX], (bf16*)(ws + WS_R1) + (size_t)m * DM, (unsigned char*)(ws + WS_U8) + (size_t)m * DM, (size_t)NGW, F.lane_id());
      for (; m < MT; m += NGW) rms_rows_both<1>(F.in[I_X] + (size_t)m * DM, F.in[I_GMIX], (bf16*)(ws + WS_R1) + (size_t)m * DM, (unsigned char*)(ws + WS_U8) + (size_t)m * DM, (size_t)NGW, F.lane_id()); }
    for (int m = gw; m < MROWS; m += NGW) rms_row_bf16(F.in[I_MEM] + (size_t)m * DM, F.in[I_GMEM], (bf16*)(ws + WS_MEMN) + (size_t)m * DM, F.lane_id());
    float* rc = (float*)(ws + WS_SMALL + SM_ROPEC); float* rs = (float*)(ws + WS_SMALL + SM_ROPES);
    for (int i = F.bx * 512 + F.tid_id(); i < SEQ * 32; i += F.G * 512) {
        const int p = i >> 5, k = i & 31;
        const float invf = exp2f(-(float)k * (13.287712379549449f / 32.0f));
        const float ang = (float)p * invf;
        const float kf = rintf(ang * 0.15915494309189535f);
        float r = fmaf(-kf, 6.28125f, ang); r = fmaf(-kf, 1.9353071795864769e-3f, r);
        rc[i] = cosf(r); rs[i] = sinf(r);
    }
    { bf16* wrt = (bf16*)(ws + WS_SMALL + SM_WRT);
      for (int i = F.bx * 512 + F.tid_id(); i < 32 * 1024; i += F.G * 512) { const int e = i >> 10, k = i & 1023; const float w = F.in[I_WR][k * 32 + e]; const unsigned hi = f2bf(w); wrt[i] = (bf16)hi; wrt[32 * 1024 + i] = (bf16)f2bf(w - __uint_as_float(hi << 16)); } }
    { bf16* w2t = (bf16*)(ws + WS_SMALL + SM_W2T);
      for (int i = F.bx * 512 + F.tid_id(); i < 2 * 64 * 256; i += F.G * 512) { const int kv = i >> 14, d = (i >> 8) & 63, f = i & 255; w2t[i] = (bf16)f2bf(F.in[kv ? I_CW2V : I_CW2K][f * 64 + d]); } }
    for (int o = gw; o < 512; o += NGW) {
        const int kv = o >> 8, f = o & 255, lane = F.lane_id();
        const float* pe = F.in[kv ? I_CPV : I_CPK]; const float* w1 = F.in[kv ? I_CW1V : I_CW1K];
        float wv[32], pv[32];
#pragma unroll
        for (int i = 0; i < 32; ++i) { const int k = lane + 64 * i; wv[i] = w1[(size_t)k * 256 + f]; pv[i] = pe[k]; }
        float a = 0.f;
#pragma unroll
        for (int i = 0; i < 32; ++i) a = fmaf(pv[i], wv[i], a);
        a = wave_sum(a);
        if (lane == 0) ((float*)(ws + WS_SMALL + SM_CBIAS))[o] = a + F.in[kv ? I_CB1V : I_CB1K][f];
    }
}

DI void unpack8(const v4u& w, float (&f)[8]) {
    f[0] = __uint_as_float(w.x << 16); f[1] = __uint_as_float(w.x & 0xffff0000u); f[2] = __uint_as_float(w.y << 16); f[3] = __uint_as_float(w.y & 0xffff0000u);
    f[4] = __uint_as_float(w.z << 16); f[5] = __uint_as_float(w.z & 0xffff0000u); f[6] = __uint_as_float(w.w << 16); f[7] = __uint_as_float(w.w & 0xffff0000u);
}
DI v4u pack8f(const float (&f)[8]) { v4u o; o.x = pk2(f[0], f[1]); o.y = pk2(f[2], f[3]); o.z = pk2(f[4], f[5]); o.w = pk2(f[6], f[7]); return o; }
DI void load8f(const float* p, float (&f)[8]) { const f32x4 a = *(const f32x4*)p, b = *(const f32x4*)(p + 4); f[0] = a.x; f[1] = a.y; f[2] = a.z; f[3] = a.w; f[4] = b.x; f[5] = b.y; f[6] = b.z; f[7] = b.w; }
DI void norm_rope64(float (&f)[8], const float (&g)[8], const float (&c8)[8], const float (&s8)[8], int lane, float scale) {
    float ss = 0.f;
#pragma unroll
    for (int i = 0; i < 8; ++i) ss = fmaf(f[i], f[i], ss);
    ss += __shfl_xor(ss, 1); ss += __shfl_xor(ss, 2); ss += __shfl_xor(ss, 4);
    const float rstd = rsqrtf(ss * (1.f / 64.f) + EPS);
    const bool hi = (lane & 4) != 0;
#pragma unroll
    for (int i = 0; i < 8; ++i) { const float y = f[i] * rstd * g[i]; const float pt = __shfl_xor(y, 4); f[i] = (hi ? fmaf(pt, s8[i], y * c8[i]) : fmaf(-pt, s8[i], y * c8[i])) * scale; }
}
DI void p2_prep(Frame& F) {
    unsigned char* ws = F.ws;
    const int ncg = F.G >= 64 ? 32 : 0;
    if (F.bx < ncg) return;
    const int gw = (F.bx - ncg) * NWAVES + F.wave, NGW = (F.G - ncg) * NWAVES, lane = F.lane_id();
    const bf16* proj = (const bf16*)(ws + WS_PROJ);
    const float* rc = (const float*)(ws + WS_SMALL + SM_ROPEC); const float* rs = (const float*)(ws + WS_SMALL + SM_ROPES);
    bf16* qn = (bf16*)(ws + WS_QN); bf16* ksn = (bf16*)(ws + WS_KSN); bf16* kwn = (bf16*)(ws + WS_KWN); bf16* mqn = (bf16*)(ws + WS_MQN); bf16* mlqk = (bf16*)(ws + WS_MLQK);
    constexpr int NT = 4;
    {
        float gq8[8], mg8[8]; load8f(F.in[I_NGQ] + 8 * (lane & 7), gq8); load8f(F.in[I_MGQ] + 8 * (lane & 15), mg8);
        for (int t0 = gw * NT; t0 < MT; t0 += NGW * NT) {
            v4u a[NT], bq[NT]; float c8[NT][8], s8[NT][8];
#pragma unroll
            for (int u = 0; u < NT; ++u) { const int t = t0 + u, tau = t & 2047; const bf16* pr = proj + (size_t)t * NPROJ;
                a[u] = *(const v4u*)(pr + PC_NQ + 8 * lane); bq[u] = *(const v4u*)(pr + PC_MQ + 8 * lane);
                load8f(rc + tau * 32 + 8 * (lane & 3), c8[u]); load8f(rs + tau * 32 + 8 * (lane & 3), s8[u]); }
#pragma unroll
            for (int u = 0; u < NT; ++u) { const int t = t0 + u;
                float f[8]; unpack8(a[u], f);
                norm_rope64(f, gq8, c8[u], s8[u], lane, 0.125f * 1.4426950408889634f);
                *(v4u*)(qn + (size_t)t * 512 + 8 * lane) = pack8f(f);
                unpack8(bq[u], f);
                float ss = 0.f;
#pragma unroll
                for (int i = 0; i < 8; ++i) ss = fmaf(f[i], f[i], ss);
                ss += __shfl_xor(ss, 1); ss += __shfl_xor(ss, 2); ss += __shfl_xor(ss, 4); ss += __shfl_xor(ss, 8);
                const float rstd = rsqrtf(ss * (1.f / 128.f) + EPS) * (0.08838834764831845f * 1.4426950408889634f);
#pragma unroll
                for (int i = 0; i < 8; ++i) f[i] *= rstd * mg8[i];
                *(v4u*)(mqn + (size_t)t * 512 + 8 * lane) = pack8f(f);
                }
        }
    }
    {
        const int L = lane & 31, hd4 = L >> 3, j = L & 7, half = lane >> 5;
        float gk8[8]; load8f(F.in[I_NGK] + (1 + (hd4 >> 1)) * 64 + 8 * j, gk8);
        const int kcol = (hd4 < 2 ? PC_NKS + hd4 * 64 : PC_NKW + (hd4 - 2) * 64) + 8 * j;
        bf16* kdst = (hd4 < 2 ? ksn : kwn) + (hd4 & 1) * 64 + 8 * j;
        const int wv = L >> 4, jj = L & 15;
        bf16* vdst = (bf16*)(ws + (wv ? WS_VWN : WS_VSN)) + 8 * jj; const int vcol = (wv ? PC_NVW : PC_NVS) + 8 * jj;
        for (int tp0 = gw * NT; tp0 < MT / 2; tp0 += NGW * NT) {
            v4u a[NT]; float c8[NT][8], s8[NT][8];
#pragma unroll
            for (int u = 0; u < NT; ++u) { const int t = 2 * (tp0 + u) + half, tau = t & 2047; const bf16* pr = proj + (size_t)t * NPROJ;
                a[u] = *(const v4u*)(pr + kcol);
                load8f(rc + tau * 32 + 8 * (lane & 3), c8[u]); load8f(rs + tau * 32 + 8 * (lane & 3), s8[u]); }
#pragma unroll
            for (int u = 0; u < NT; ++u) { const int t = 2 * (tp0 + u) + half;
                float f[8]; unpack8(a[u], f);
                norm_rope64(f, gk8, c8[u], s8[u], lane, 1.0f);
                *(v4u*)(kdst + (size_t)t * 128) = pack8f(f); }
        }
    }
    for (int run = gw; run < MT / 16; run += NGW) {
        const int t0 = run * 16, tau0 = t0 & 2047;
#pragma unroll 1
        for (int sp = 0; sp < 2; ++sp) {
            const int ch = 512 * sp + 8 * lane;
            float w0[8], w1[8], w2[8], w3[8], bb[8];
            load8f(F.in[I_CONVW] + ch, w0); load8f(F.in[I_CONVW] + 1024 + ch, w1); load8f(F.in[I_CONVW] + 2048 + ch, w2); load8f(F.in[I_CONVW] + 3072 + ch, w3); load8f(F.in[I_CONVB] + ch, bb);
            float x0[8], x1[8], x2[8];
            if (tau0 >= 3) { unpack8(*(const v4u*)(proj + (size_t)(t0 - 3) * NPROJ + ch), x0); unpack8(*(const v4u*)(proj + (size_t)(t0 - 2) * NPROJ + ch), x1); unpack8(*(const v4u*)(proj + (size_t)(t0 - 1) * NPROJ + ch), x2); }
            else {
#pragma unroll
                for (int i = 0; i < 8; ++i) { x0[i] = 0.f; x1[i] = 0.f; x2[i] = 0.f; } }
#pragma unroll 1
            for (int k0 = 0; k0 < 16; k0 += 4) {
                v4u raw[4];
#pragma unroll
                for (int k = 0; k < 4; ++k) raw[k] = *(const v4u*)(proj + (size_t)(t0 + k0 + k) * NPROJ + ch);
#pragma unroll
                for (int k = 0; k < 4; ++k) { float x3[8], y[8]; unpack8(raw[k], x3);
#pragma unroll
                    for (int i = 0; i < 8; ++i) { const float a = fmaf(w3[i], x3[i], fmaf(w2[i], x2[i], fmaf(w1[i], x1[i], fmaf(w0[i], x0[i], bb[i])))); y[i] = a * sigm(a); x0[i] = x1[i]; x1[i] = x2[i]; x2[i] = x3[i]; }
                    *(v4u*)(mlqk + (size_t)(t0 + k0 + k) * 1024 + ch) = pack8f(y); }
            }
        }
    }
    {
        const bf16* memkv = (const bf16*)(ws + WS_MEMKV); bf16* memkn = (bf16*)(ws + WS_MEMKN);
        float kg8[8]; load8f(F.in[I_MGK] + 8 * (lane & 15), kg8);
        for (int r = gw; r < MROWS; r += NGW) {
            float f[8]; unpack8(*(const v4u*)(memkv + (size_t)r * 1024 + 8 * lane), f);
            float ss = 0.f;
#pragma unroll
            for (int i = 0; i < 8; ++i) ss = fmaf(f[i], f[i], ss);
            ss += __shfl_xor(ss, 1); ss += __shfl_xor(ss, 2); ss += __shfl_xor(ss, 4); ss += __shfl_xor(ss, 8);
            const float rstd = rsqrtf(ss * (1.f / 128.f) + EPS);
#pragma unroll
            for (int i = 0; i < 8; ++i) f[i] *= rstd * kg8[i];
            *(v4u*)(memkn + (size_t)r * 512 + 8 * lane) = pack8f(f);
        }
    }
}

DI void p4_kcvc(Frame& F) {
    unsigned char* ws = F.ws;
    const int gw = F.bx * NWAVES + F.wave, NGW = F.G * NWAVES, lane = F.lane_id();
    const bf16* hid = (const bf16*)(ws + WS_HID);
    const float* rc = (const float*)(ws + WS_SMALL + SM_ROPEC); const float* rs = (const float*)(ws + WS_SMALL + SM_ROPES);
    const float gk = F.in[I_NGK][lane];
    for (int it = gw; it < 2 * 4096; it += NGW) {
        const int kv = it >> 12, r = it & 4095, n = r & 127;
        bf16* dst = (bf16*)(ws + (kv ? WS_VC : WS_KC)) + (size_t)r * 64 + lane;
        if (n == 127) { *dst = 0; continue; }
        const bf16* hr = hid + (size_t)kv * 4096 * 256 + (size_t)r * 256; const float* w2 = F.in[kv ? I_CW2V : I_CW2K];
        float a = 0.f;
        for (int f = 0; f < 256; ++f) a = fmaf(bf2f(hr[f]), w2[f * 64 + lane], a);
        if (kv == 0) {
            const float y = a * rsqrtf(wave_sum(a * a) * (1.f / 64.f) + EPS) * gk;
            const int pos = 16 * n + 31; const float c = rc[pos * 32 + (lane & 31)], s = rs[pos * 32 + (lane & 31)];
            const float pt = __shfl_xor(y, 32);
            a = lane < 32 ? y * c - pt * s : y * c + pt * s;
        }
        *dst = (bf16)f2bf(a);
    }
}

typedef float f32x16 __attribute__((ext_vector_type(16)));
typedef float f32x2v __attribute__((ext_vector_type(2)));
typedef __bf16 bf16x2v __attribute__((ext_vector_type(2)));
typedef short s16x4 __attribute__((ext_vector_type(4)));
typedef unsigned u32x2 __attribute__((ext_vector_type(2)));
#define MFMA32(a, b, c) __builtin_amdgcn_mfma_f32_32x32x16_bf16((a), (b), (c), 0, 0, 0)
#define WG_BAR() do { asm volatile("s_waitcnt vmcnt(0) lgkmcnt(0)" ::: "memory"); __builtin_amdgcn_s_barrier(); asm volatile("" ::: "memory"); } while (0)
DI unsigned pkbf(float lo, float hi) { f32x2v v = {lo, hi}; return __builtin_bit_cast(unsigned, __builtin_convertvector(v, bf16x2v)); }
template <int S> DI bf16x8 pack8(const f32x16& x) {
    v4u p; p.x = pkbf(x[8 * S], x[8 * S + 1]); p.y = pkbf(x[8 * S + 2], x[8 * S + 3]); p.z = pkbf(x[8 * S + 4], x[8 * S + 5]); p.w = pkbf(x[8 * S + 6], x[8 * S + 7]);
    return __builtin_bit_cast(bf16x8, p);
}
DI int crow(int i, int h) { return (i & 3) + 8 * (i >> 2) + 4 * h; }
constexpr int AT_K = 0, AT_V = 32768, AT_IMP = 65536, AT_WM = 98304, AT_INV = 98368, AT_SC = 99392;

DI void glds16(const void* gsrc, unsigned lds_dst) { unsigned keep; asm volatile("s_mov_b32 %0, m0\n\ts_mov_b32 m0, %2\n\ts_nop 0\n\tglobal_load_lds_dwordx4 %1, off\n\ts_mov_b32 m0, %0" : "=&s"(keep) : "v"(gsrc), "s"(lds_dst) : "memory"); }
DI void at_load(LAS unsigned char* lds, int par, const void* kb, size_t kpitch, const void* vb, size_t vpitch, int wave, int lane) {
    const int row = 8 * wave + (lane >> 3), pc = lane & 7;
    const int kc = pc ^ ((row >> 1) & 7), vc = pc ^ (((row >> 1) & 1) << 2);
    glds16((const char*)kb + (size_t)row * kpitch + 16 * kc, (unsigned)(size_t)(lds + AT_K + par * 8192 + wave * 1024));
    glds16((const char*)vb + (size_t)row * vpitch + 16 * vc, (unsigned)(size_t)(lds + AT_V + par * 8192 + wave * 1024));
}
#define SB() __builtin_amdgcn_sched_barrier(0)
typedef __attribute__((address_space(3))) s16x4 lds_s16x4;
DI void at_qk(const LAS unsigned char* kbuf, const int (&ka)[4], const bf16x8 (&qf)[4], f32x16 (&s)[2]) {
    bf16x8 kf[2][4];
#pragma unroll
    for (int kb = 0; kb < 2; ++kb)
#pragma unroll
        for (int st = 0; st < 4; ++st) kf[kb][st] = *(const LAS bf16x8*)(kbuf + ka[st] + kb * 4096);
    SB();
#pragma unroll
    for (int kb = 0; kb < 2; ++kb) {
        f32x16 a;
#pragma unroll
        for (int i = 0; i < 16; ++i) a[i] = 0.f;
#pragma unroll
        for (int st = 0; st < 4; ++st) a = MFMA32(kf[kb][st], qf[st], a);
        s[kb] = a;
    }
}
DI void at_vload(const LAS unsigned char* vbuf, const int (&va)[2], int kb, bf16x8 (&vf)[2][2]) {
#pragma unroll
    for (int s2 = 0; s2 < 2; ++s2)
#pragma unroll
        for (int db = 0; db < 2; ++db) {
            const s16x4 lo = __builtin_amdgcn_ds_read_tr16_b64_v4i16((lds_s16x4*)(vbuf + va[db] + kb * 4096 + s2 * 2048));
            const s16x4 hi = __builtin_amdgcn_ds_read_tr16_b64_v4i16((lds_s16x4*)(vbuf + va[db] + kb * 4096 + s2 * 2048 + 1024));
            vf[s2][db] = __builtin_shufflevector(lo, hi, 0, 1, 2, 3, 4, 5, 6, 7); }
}
DI void at_pv1(const bf16x8 (&vf)[2][2], const f32x16& p, f32x16 (&o)[2]) {
    const bf16x8 pf0 = pack8<0>(p), pf1 = pack8<1>(p);
#pragma unroll
    for (int s2 = 0; s2 < 2; ++s2)
#pragma unroll
        for (int db = 0; db < 2; ++db) o[db] = MFMA32(vf[s2][db], s2 ? pf1 : pf0, o[db]);
}
DI void at_pv(const LAS unsigned char* vbuf, const int (&va)[2], const bf16x8 (&vf0)[2][2], const f32x16 (&p)[2], f32x16 (&o)[2]) {
    bf16x8 vf1[2][2]; at_vload(vbuf, va, 1, vf1);
    at_pv1(vf0, p[0], o);
    at_pv1(vf1, p[1], o);
}
template <class MaskF>
DI void at_exp_pack(const f32x16 (&s)[2], float& l, bf16x8 (&pf)[2][2], MaskF valid) {
#pragma unroll
    for (int kb = 0; kb < 2; ++kb)
#pragma unroll
        for (int s2 = 0; s2 < 2; ++s2) { unsigned w[4];
#pragma unroll
            for (int q = 0; q < 4; ++q) { const int i0 = 8 * s2 + 2 * q;
                const float e0 = __builtin_amdgcn_exp2f(s[kb][i0]), e1 = __builtin_amdgcn_exp2f(s[kb][i0 + 1]);
                const float p0 = valid(kb, i0) ? e0 : 0.f, p1 = valid(kb, i0 + 1) ? e1 : 0.f; l += p0; l += p1; w[q] = pkbf(p0, p1); }
            pf[kb][s2] = __builtin_bit_cast(bf16x8, (v4u){w[0], w[1], w[2], w[3]}); }
}
struct MaskAll { DI bool operator()(int, int) const { return true; } };
DI void at_pv2(const LAS unsigned char* vbuf, const int (&va)[2], const bf16x8 (&vf0)[2][2], const bf16x8 (&pf)[2][2], f32x16 (&o)[2]) {
    bf16x8 vf1[2][2]; at_vload(vbuf, va, 1, vf1);
#pragma unroll
    for (int s2 = 0; s2 < 2; ++s2)
#pragma unroll
        for (int db = 0; db < 2; ++db) o[db] = MFMA32(vf0[s2][db], pf[0][s2], o[db]);
#pragma unroll
    for (int s2 = 0; s2 < 2; ++s2)
#pragma unroll
        for (int db = 0; db < 2; ++db) o[db] = MFMA32(vf1[s2][db], pf[1][s2], o[db]);
}
DI void at_exp_all(f32x16 (&s)[2], float& l) {
#pragma unroll
    for (int kb = 0; kb < 2; ++kb)
#pragma unroll
        for (int i = 0; i < 16; ++i) { const float p = __builtin_amdgcn_exp2f(s[kb][i]); s[kb][i] = p; l += p; }
}
DI void at_wait(int n) {
    if (n >= 2) asm volatile("s_waitcnt vmcnt(4)" ::: "memory"); else if (n == 1) asm volatile("s_waitcnt vmcnt(2)" ::: "memory"); else asm volatile("s_waitcnt vmcnt(0)" ::: "memory");
    asm volatile("s_waitcnt lgkmcnt(0)" ::: "memory"); __builtin_amdgcn_s_barrier(); asm volatile("" ::: "memory");
}
template <bool STORE = true, bool DO_CMP = true, bool DO_SEL = true, bool DO_WIN = true>
DI void nsa_unit(Frame& F, int unit) {
    unsigned char* ws = F.ws; LAS unsigned char* lds = F.lds;
    int lane_ = F.lane_id();
    const int lane = lane_, wave = F.wave, r = lane & 31, h = lane >> 5, g = wave >> 1, qh = wave & 1;
    const int bh = unit & 31, qt = 31 - (unit >> 5), b = bh >> 1, hkv = bh & 1;
    const int qloc = 32 * qh + r, tau = 64 * qt + qloc, qq = tau & 63; const size_t t = (size_t)b * SEQ + tau;
    const bf16* proj = (const bf16*)(ws + WS_PROJ);
    const bf16* qn = (const bf16*)(ws + WS_QN); const bf16* ksn = (const bf16*)(ws + WS_KSN); const bf16* kwn = (const bf16*)(ws + WS_KWN);
    const bf16* kc = (const bf16*)(ws + WS_KC); const bf16* vc = (const bf16*)(ws + WS_VC); bf16* H1 = (bf16*)(ws + WS_H0);
    int ka[4], va[2];
    { const int f = (r >> 1) & 7, fs = f >> 1, hb = h ^ (f & 1);
#pragma unroll
      for (int st = 0; st < 4; ++st) ka[st] = r * 128 + 16 * (((st ^ fs) << 1) | hb);
      const int i16 = lane & 15, q = i16 >> 2, p = i16 & 3, g1 = (lane >> 4) & 1;
#pragma unroll
      for (int db = 0; db < 2; ++db) va[db] = (4 * h + q) * 128 + 16 * ((4 * db + 2 * g1 + (p >> 1)) ^ (((q >> 1) & 1) << 2)) + 8 * (p & 1); }
    asm volatile("s_waitcnt lgkmcnt(0)" ::: "memory"); __builtin_amdgcn_s_barrier(); asm volatile("" ::: "memory");
    const int ntc = (((64 * qt + 63 - 31) >> 4) + 1 > 64) ? 2 : 1;
    if (DO_CMP) { const char* kb0 = (const char*)(kc + (size_t)(b * 2 + hkv) * 128 * 64); const char* vb0 = (const char*)(vc + (size_t)(b * 2 + hkv) * 128 * 64);
        at_load(lds, 0, kb0, 128, vb0, 128, wave, lane);
        if (ntc == 2) at_load(lds, 1, kb0 + 64 * 128, 128, vb0 + 64 * 128, 128, wave, lane); }
    bf16x8 qf[4];
#pragma unroll
    for (int st = 0; st < 4; ++st) qf[st] = *(const bf16x8*)(qn + t * 512 + (hkv * 4 + g) * 64 + 16 * st + 8 * h);
    float gate[3];
#pragma unroll
    for (int c = 0; c < 3; ++c) gate[c] = sigm(bf2f(proj[t * NPROJ + PC_NG + (hkv * 4 + g) * 3 + c]));
    f32x16 ofin[2];
#pragma unroll
    for (int i = 0; i < 16; ++i) { ofin[0][i] = 0.f; ofin[1][i] = 0.f; }
    if (DO_CMP) {
        const int ncq = tau >= 31 ? ((tau - 31) >> 4) + 1 : 0;
        WG_BAR();
        f32x16 o[2]; float l = 0.f, prevEp = 0.f;
#pragma unroll
        for (int i = 0; i < 16; ++i) { o[0][i] = 0.f; o[1][i] = 0.f; }
        LAS float* I = (LAS float*)(lds + AT_IMP) + (g * 64 + qloc) * 32;
#pragma unroll 1
        for (int tile = 0; tile < 2; ++tile) {
            if (tile < ntc) {
                f32x16 s[2];
                at_qk(lds + AT_K + tile * 8192, ka, qf, s);
                bf16x8 vf[2][2]; at_vload(lds + AT_V + tile * 8192, va, 0, vf); SB();
#pragma unroll
                for (int kb = 0; kb < 2; ++kb)
#pragma unroll
                    for (int i = 0; i < 16; ++i) { const int n = 64 * tile + 32 * kb + crow(i, h); const float p = n < ncq ? __builtin_amdgcn_exp2f(s[kb][i]) : 0.f; s[kb][i] = p; l += p; }
#pragma unroll
                for (int kb = 0; kb < 2; ++kb)
#pragma unroll
                    for (int a = 0; a < 4; ++a) { const int idx = tile * 8 + kb * 4 + a; const float Gv = (s[kb][4 * a] + s[kb][4 * a + 1]) + (s[kb][4 * a + 2] + s[kb][4 * a + 3]);
                        const float Epv = __shfl_xor(s[kb][4 * a + 3], 32);
                        I[2 * idx + h] = Gv + (h ? Epv : prevEp); prevEp = Epv; }
                at_pv(lds + AT_V + tile * 8192, va, vf, s, o);
            } else {
#pragma unroll
                for (int idx = 8; idx < 16; ++idx) I[2 * idx + h] = 0.f;
            }
        }
        const float L = l + __shfl_xor(l, 32); const float inv = L > 0.f ? 1.f / L : 0.f;
        const float gi = gate[0] * inv;
#pragma unroll
        for (int i = 0; i < 16; ++i) { ofin[0][i] += gi * o[0][i]; ofin[1][i] += gi * o[1][i]; }
        if (h == 0) ((LAS float*)(lds + AT_INV))[g * 64 + qloc] = inv;
    }
    WG_BAR();
    unsigned sel = 0u, wm = 0u, um = 0u;
    if (!DO_CMP) { sel = (qt == 31) ? 0xffffffffu : ((1u << (qt + 1)) - 1u); wm = sel; um = sel; }
    else {
        const LAS float* I = (const LAS float*)(lds + AT_IMP) + qloc * 32;
        const LAS float* IV = (const LAS float*)(lds + AT_INV) + qloc;
        const float iv0 = IV[0], iv1 = IV[64], iv2 = IV[128], iv3 = IV[192];
        LAS unsigned* SC = (LAS unsigned*)(lds + AT_SC) + (qh * 32 + r) * 33;
        if (h == 0) {
#pragma unroll
            for (int j = 8 * g; j < 8 * g + 8; ++j) { const float imp = (I[j] * iv0 + I[64 * 32 + j] * iv1) + (I[2 * 64 * 32 + j] * iv2 + I[3 * 64 * 32 + j] * iv3);
                const bool cand = (j >= 1) && (j <= qt - 2);
                SC[j] = cand ? ((__float_as_uint(imp) & ~31u) | (unsigned)(31 - j)) + 32u : 0u; }
        }
        WG_BAR();
        if (qt <= 7) sel = (1u << (qt + 1)) - 1u;
        else {
            sel = 1u | (1u << qt) | (1u << (qt - 1));
            unsigned prev = 0xffffffffu;
#pragma unroll 1
            for (int rd = 0; rd < 5; ++rd) { unsigned best = 0u;
#pragma unroll 8
                for (int j = 0; j < 32; ++j) { const unsigned kx = SC[j]; const unsigned cnd = kx < prev ? kx : 0u; best = cnd > best ? cnd : best; }
                prev = best; if (best) sel |= 1u << (31 - (int)(best & 31u)); }
        }
        sel &= (qt == 31) ? 0xffffffffu : ((1u << (qt + 1)) - 1u);
        wm = sel;
#pragma unroll
        for (int o = 1; o < 32; o <<= 1) wm |= (unsigned)__shfl_xor((int)wm, o);
        wm = (unsigned)__builtin_amdgcn_readfirstlane((int)wm);
        if (lane == 0) ((LAS unsigned*)(lds + AT_WM))[wave] = wm;
        WG_BAR();
        um = 0u;
#pragma unroll
        for (int w = 0; w < 8; ++w) um |= ((const LAS unsigned*)(lds + AT_WM))[w];
        um = (unsigned)__builtin_amdgcn_readfirstlane((int)um);
    }
    if (DO_SEL) {
        f32x16 o[2]; float l = 0.f;
#pragma unroll
        for (int i = 0; i < 16; ++i) { o[0][i] = 0.f; o[1][i] = 0.f; }
        const char* kbase = (const char*)(ksn + (size_t)b * SEQ * 128 + hkv * 64); const char* vbase = (const char*)(proj + (size_t)b * SEQ * NPROJ + PC_NVS + hkv * 64);
        unsigned rem = um, im = um; int k = 0; const int T = __popc(um);
#pragma unroll 1
        for (int i = 0; i < 3 && im; ++i) { const int jn = __ffs((int)im) - 1; im &= im - 1u; at_load(lds, i, kbase + (size_t)jn * 64 * 256, 256, vbase + (size_t)jn * 64 * (NPROJ * 2), NPROJ * 2, wave, lane); }
#pragma unroll 1
        while (rem) {
            const int j = __ffs((int)rem) - 1; rem &= rem - 1u;
            at_wait(T - k - 1);
#ifdef NSA_E1
            at_wait(T - k - 1);
#endif
            if (im) { const int jn = __ffs((int)im) - 1; im &= im - 1u; at_load(lds, (k + 3) & 3, kbase + (size_t)jn * 64 * 256, 256, vbase + (size_t)jn * 64 * (NPROJ * 2), NPROJ * 2, wave, lane); }
            const int par = k & 3;
            if ((wm >> j) & 1u) {
                f32x16 s[2];
                at_qk(lds + AT_K + par * 8192, ka, qf, s);
                bf16x8 vf[2][2]; at_vload(lds + AT_V + par * 8192, va, 0, vf); SB();
                const bool on = (sel >> j) & 1u;
                if (j != qt && __all(on)) at_exp_all(s, l);
                else { const int klim = j == qt ? qq : 63;
#pragma unroll
                    for (int kb = 0; kb < 2; ++kb)
#pragma unroll
                        for (int i = 0; i < 16; ++i) { const int key = 32 * kb + crow(i, h); const float p = (on && key <= klim) ? __builtin_amdgcn_exp2f(s[kb][i]) : 0.f; s[kb][i] = p; l += p; } }
                at_pv(lds + AT_V + par * 8192, va, vf, s, o);
            }
            ++k;
        }
        const float L = l + __shfl_xor(l, 32); const float gi = gate[1] * (L > 0.f ? 1.f / L : 0.f);
#pragma unroll
        for (int i = 0; i < 16; ++i) { ofin[0][i] += gi * o[0][i]; ofin[1][i] += gi * o[1][i]; }
    }
    WG_BAR();
    if (DO_WIN) {
        f32x16 o[2]; float l = 0.f;
#pragma unroll
        for (int i = 0; i < 16; ++i) { o[0][i] = 0.f; o[1][i] = 0.f; }
        const char* kbase = (const char*)(kwn + (size_t)b * SEQ * 128 + hkv * 64); const char* vbase = (const char*)(proj + (size_t)b * SEQ * NPROJ + PC_NVW + hkv * 64);
        const int jlo = qt > 8 ? qt - 8 : 0; const int T = qt - jlo + 1;
#ifdef NSA_E2
        f32x16 o2[2]; float l2 = 0.f;
#pragma unroll
        for (int i = 0; i < 16; ++i) { o2[0][i] = 0.f; o2[1][i] = 0.f; }
#endif
#pragma unroll 1
        for (int i = 0; i < 3 && i < T; ++i) at_load(lds, i, kbase + (size_t)(jlo + i) * 64 * 256, 256, vbase + (size_t)(jlo + i) * 64 * (NPROJ * 2), NPROJ * 2, wave, lane);
#pragma unroll 1
        for (int k = 0; k < T; ++k) {
            const int j = jlo + k, par = k & 3;
            at_wait(T - k - 1);
#ifdef NSA_E1
            at_wait(T - k - 1);
#endif
            if (k + 3 < T) at_load(lds, (k + 3) & 3, kbase + (size_t)(j + 3) * 64 * 256, 256, vbase + (size_t)(j + 3) * 64 * (NPROJ * 2), NPROJ * 2, wave, lane);
            f32x16 s[2];
            at_qk(lds + AT_K + par * 8192, ka, qf, s);
            bf16x8 vf[2][2]; at_vload(lds + AT_V + par * 8192, va, 0, vf); SB();
#ifdef NSA_E2
            { f32x16 s2[2]; asm volatile("" ::: "memory"); at_qk(lds + AT_K + par * 8192, ka, qf, s2); bf16x8 vf2[2][2]; at_vload(lds + AT_V + par * 8192, va, 0, vf2); SB(); at_exp_all(s2, l2); at_pv(lds + AT_V + par * 8192, va, vf2, s2, o2); }
#endif
            if (j != qt && j != qt - 8) at_exp_all(s, l);
            else { const int klo = (j == qt - 8) ? qq + 1 : 0, khi = (j == qt) ? qq : 63;
#pragma unroll
                for (int kb = 0; kb < 2; ++kb)
#pragma unroll
                    for (int i = 0; i < 16; ++i) { const int key = 32 * kb + crow(i, h); const float p = (key >= klo && key <= khi) ? __builtin_amdgcn_exp2f(s[kb][i]) : 0.f; s[kb][i] = p; l += p; } }
            at_pv(lds + AT_V + par * 8192, va, vf, s, o);
        }
#ifdef NSA_E2
        { const float z = l2 * 0.f;
#pragma unroll
          for (int i = 0; i < 16; ++i) { ofin[0][i] += z * o2[0][i]; ofin[1][i] += z * o2[1][i]; } }
#endif
        const float L = l + __shfl_xor(l, 32); const float gi = gate[2] * (L > 0.f ? 1.f / L : 0.f);
#pragma unroll
        for (int i = 0; i < 16; ++i) { ofin[0][i] += gi * o[0][i]; ofin[1][i] += gi * o[1][i]; }
    }
    if (!STORE) { asm volatile("" :: "v"(ofin[0]), "v"(ofin[1])); return; }
    WG_BAR();
#pragma unroll
    for (int db = 0; db < 2; ++db)
#pragma unroll
        for (int a = 0; a < 4; ++a) { u32x2 w; w.x = pkbf(ofin[db][4 * a], ofin[db][4 * a + 1]); w.y = pkbf(ofin[db][4 * a + 2], ofin[db][4 * a + 3]); *(LAS u32x2*)(lds + qloc * 528 + g * 128 + (32 * db + 8 * a + 4 * h) * 2) = w; }
    WG_BAR();
    { const int tid = wave * 64 + lane; bf16* obase = H1 + ((size_t)b * SEQ + 64 * qt) * 1536 + 512 + hkv * 256;
#pragma unroll
      for (int i = 0; i < 4; ++i) { const int piece = tid + 512 * i, row = piece >> 5, c = piece & 31; *(v4u*)(obase + (size_t)row * 1536 + 8 * c) = *(const LAS v4u*)(lds + row * 528 + 16 * c); } }
}
constexpr int ML_K = 0, ML_V = 32768, ML_VW = 65536, ML_C = 81920, ML_N = 114688, ML_SS = 115200, ML_WS = 116224, ML_GO = 120320, ML_ST = 135424;
DI int ml_fk(int s) { return ((s & 3) << 2) | ((s >> 2) & 3); }
DI void ml_load(LAS unsigned char* lds, int par, const char* kb, const char* vb, int wave, int lane) {
#pragma unroll
    for (int n2 = 0; n2 < 2; ++n2) { const int n = 2 * wave + n2, row = 4 * n + (lane >> 4), pc = lane & 15;
        const int kc = pc ^ ml_fk(row), vc = pc ^ ((row & 3) << 2);
        glds16(kb + (size_t)row * 2048 + 16 * kc, (unsigned)(size_t)(lds + ML_K + par * 16384 + n * 1024));
        glds16(vb + (size_t)row * (NPROJ * 2) + 16 * vc, (unsigned)(size_t)(lds + ML_V + par * 16384 + n * 1024)); }
}
DI bf16x8 ml_tr8(const LAS unsigned char* p) {
    const s16x4 lo = __builtin_amdgcn_ds_read_tr16_b64_v4i16((lds_s16x4*)p); const s16x4 hi = __builtin_amdgcn_ds_read_tr16_b64_v4i16((lds_s16x4*)(p + 1024));
    return __builtin_shufflevector(lo, hi, 0, 1, 2, 3, 4, 5, 6, 7);
}
template <int PM = 0xff>
DI void mlstm_unit2(Frame& F, int unit) {
    unsigned char* ws = F.ws; LAS unsigned char* lds = F.lds;
    int lane_ = F.lane_id();
    const int lane = lane_, wave = F.wave, tid = wave * 64 + lane, r = lane & 31, hh = lane >> 5, tb = wave >> 2, vb = wave & 3;
    const int b = unit >> 2, hd = unit & 3;
    const bf16* proj = (const bf16*)(ws + WS_PROJ); const bf16* mlqk = (const bf16*)(ws + WS_MLQK); bf16* H0 = (bf16*)(ws + WS_H0);
    const size_t tok0 = (size_t)b * SEQ;
    const char* kbase = (const char*)(mlqk + tok0 * 1024 + 512 + hd * 128); const char* vbase = (const char*)(proj + tok0 * NPROJ + PC_MLV + hd * 128);
    const float LOG2E = 1.4426950408889634f;
    const int i16 = lane & 15, q4 = i16 >> 2, p4 = i16 & 3, g1 = (lane >> 4) & 1;
    const int colsw = 16 * ((4 * vb + 2 * g1 + (p4 >> 1)) ^ (q4 << 2)) + 8 * (p4 & 1);
    const int base_c = (8 * hh + q4) * 256 + colsw;
    const int base_v = (4 * hh + q4) * 256 + colsw;
    const int fK = ml_fk(r), rowK = r * 256 + ((hh ^ (fK & 1)) << 4), F16 = (fK & 14) << 4;
    int base_kt[2][2];
#pragma unroll
    for (int blk = 0; blk < 2; ++blk)
#pragma unroll
        for (int hi = 0; hi < 2; ++hi) { const int kbp = 2 * tb + blk; base_kt[blk][hi] = (8 * hh + 4 * hi + q4) * 256 + 16 * ((4 * kbp + 2 * g1 + (p4 >> 1)) ^ ((q4 << 2) | ((2 * hh + hi) & 3))) + 8 * (p4 & 1); }
    LAS float* WS = (LAS float*)(lds + ML_WS) + wave * 128;
    LAS float* NV = (LAS float*)(lds + ML_N); LAS float* SS = (LAS float*)(lds + ML_SS);
    __syncthreads();
    for (int i = tid; i < 32768 / 16; i += 512) ((LAS v4u*)(lds + ML_C))[i] = (v4u){0u, 0u, 0u, 0u};
    if (tid < 128) NV[tid] = 0.f;
    f32x16 Cst[2];
#pragma unroll
    for (int i = 0; i < 16; ++i) { Cst[0][i] = 0.f; Cst[1][i] = 0.f; }
    if (tid < 128) ((LAS float*)(lds + ML_GO))[tid] = F.in[I_MLGOUT][hd * 128 + tid];
    const float bi = F.in[I_MLBI][hd], bfv = F.in[I_MLBF][hd];
    float m_prev = 0.f;
    ml_load(lds, 0, kbase, vbase, wave, lane);
    bf16x8 qf[8];
    { const bf16* qp = mlqk + (tok0 + 32 * tb + r) * 1024 + hd * 128 + 8 * hh;
#pragma unroll
      for (int st = 0; st < 8; ++st) qf[st] = *(const bf16x8*)(qp + 16 * st); }
    float gi_raw = bf2f(proj[(tok0 + lane) * NPROJ + PC_MLI + hd]), gf_raw = bf2f(proj[(tok0 + lane) * NPROJ + PC_MLF + hd]);
#pragma unroll 1
    for (int c = 0; c < 32; ++c) {
        const int par = c & 1; const size_t tokc = tok0 + 64 * c;
        WG_BAR();
        if ((PM & 1) && c > 0) {
            bf16* obase = H0 + (tokc - 64) * 1536 + hd * 128;
#pragma unroll
            for (int i = 0; i < 2; ++i) { const int piece = tid + 512 * i, row = piece >> 4, cc = piece & 15; *(v4u*)(obase + (size_t)row * 1536 + 8 * cc) = *(const LAS v4u*)(lds + ML_ST + row * 272 + 16 * cc); } }
        if (c < 31) ml_load(lds, par ^ 1, kbase + (size_t)(64 * (c + 1)) * 2048, vbase + (size_t)(64 * (c + 1)) * (NPROJ * 2), wave, lane);
        u32x2 og[4];
        { const bf16* op = proj + (tokc + 32 * tb + r) * NPROJ + PC_MLO + hd * 128 + 32 * vb + 4 * hh;
#pragma unroll
          for (int a = 0; a < 4; ++a) og[a] = *(const u32x2*)(op + 8 * a); }
        const float ig = gi_raw + bi, lf = logsig(gf_raw + bfv);
        float bc = lf;
        if (PM & 2) {
#pragma unroll
        for (int o = 1; o < 64; o <<= 1) { const float v = __shfl_up(bc, o); if (lane >= o) bc += v; } }
        const float rr = ig - bc;
        float cm = rr;
        if (PM & 2) {
#pragma unroll
        for (int o = 1; o < 64; o <<= 1) { const float v = __shfl_up(cm, o); if (lane >= o) cm = fmaxf(cm, v); } }
        const float M63 = fmaxf(m_prev, __shfl(cm, 63)), blast = __shfl(bc, 63);
        const float a_old = __expf(m_prev - M63), m_new = blast + M63;
        const int tl = 32 * tb + r;
        const float Mt = fmaxf(m_prev, __shfl(cm, tl)), bt = __shfl(bc, tl);
        const float inter = __expf(m_prev - Mt), m_t = bt + Mt;
        WS[lane] = rr * LOG2E; WS[64 + lane] = __expf(rr - M63);
        const float MtL = Mt * LOG2E;
        const LAS unsigned char* kbuf = lds + ML_K + par * 16384; const LAS unsigned char* vbuf = lds + ML_V + par * 16384;
        f32x16 wd[2]; float dsum = 0.f;
#pragma unroll
        for (int kb = 0; kb < 2; ++kb) {
#pragma unroll
            for (int i = 0; i < 16; ++i) wd[kb][i] = 0.f;
            if ((PM & 4) && kb <= tb) {
                f32x16 a = wd[kb]; bf16x8 kfr[8];
#pragma unroll
                for (int st = 0; st < 8; ++st) kfr[st] = *(const LAS bf16x8*)(kbuf + kb * 8192 + rowK + ((32 * st) ^ F16));
                SB();
#pragma unroll
                for (int st = 0; st < 8; ++st) a = MFMA32(kfr[st], qf[st], a);
#pragma unroll
                for (int i = 0; i < 16; ++i) { const int s = 32 * kb + crow(i, hh); const float e = __builtin_amdgcn_exp2f(WS[s] - MtL); const float w = (s <= tl) ? e * a[i] : 0.f; a[i] = w; dsum += w; }
                wd[kb] = a;
            }
        }
        f32x16 acc; bf16x8 cfr[8];
#pragma unroll
        for (int i = 0; i < 16; ++i) acc[i] = 0.f;
        if (PM & 8) {
#pragma unroll
        for (int st = 0; st < 8; ++st) cfr[st] = ml_tr8(lds + ML_C + base_c + st * 4096);
        SB();
#pragma unroll
        for (int st = 0; st < 8; ++st) acc = MFMA32(cfr[st], qf[st], acc); }
#pragma unroll
        for (int i = 0; i < 16; ++i) acc[i] *= inter;
#pragma unroll
        for (int kb = 0; kb < 2; ++kb) {
            if ((PM & 16) && kb <= tb) {
                const bf16x8 pf0 = pack8<0>(wd[kb]), pf1 = pack8<1>(wd[kb]);
                {
#pragma unroll
                  for (int s2 = 0; s2 < 2; ++s2) { const LAS unsigned char* p = vbuf + base_v + kb * 8192 + s2 * 4096;
                    const s16x4 lo = __builtin_amdgcn_ds_read_tr16_b64_v4i16((lds_s16x4*)p); const s16x4 hi = __builtin_amdgcn_ds_read_tr16_b64_v4i16((lds_s16x4*)(p + 2048));
                    const bf16x8 vf = __builtin_shufflevector(lo, hi, 0, 1, 2, 3, 4, 5, 6, 7);
                    acc = MFMA32(vf, s2 ? pf1 : pf0, acc); } }
            }
        }
        float qn_ = 0.f;
        if (PM & 32)
#pragma unroll
        for (int st = 0; st < 8; ++st) { const v4u qw = __builtin_bit_cast(v4u, qf[st]); const LAS float* np = NV + 16 * st + 8 * hh; const f32x4 n0 = *(const LAS f32x4*)np, n1 = *(const LAS f32x4*)(np + 4);
            qn_ = fmaf(__uint_as_float(qw.x << 16), n0[0], qn_); qn_ = fmaf(__uint_as_float(qw.x & 0xffff0000u), n0[1], qn_); qn_ = fmaf(__uint_as_float(qw.y << 16), n0[2], qn_); qn_ = fmaf(__uint_as_float(qw.y & 0xffff0000u), n0[3], qn_);
            qn_ = fmaf(__uint_as_float(qw.z << 16), n1[0], qn_); qn_ = fmaf(__uint_as_float(qw.z & 0xffff0000u), n1[1], qn_); qn_ = fmaf(__uint_as_float(qw.w << 16), n1[2], qn_); qn_ = fmaf(__uint_as_float(qw.w & 0xffff0000u), n1[3], qn_); }
        qn_ += __shfl_xor(qn_, 32); dsum += __shfl_xor(dsum, 32);
        const float den = inter * qn_ + dsum; const float rden = 1.f / fmaxf(fabsf(den), __expf(-m_t));
        float ssq = 0.f;
#pragma unroll
        for (int i = 0; i < 16; ++i) { acc[i] *= rden; ssq = fmaf(acc[i], acc[i], ssq); }
        ssq += __shfl_xor(ssq, 32);
        if (hh == 0) SS[vb * 64 + tl] = ssq;
        if (PM & 64)
#pragma unroll
        for (int k2 = 0; k2 < 2; ++k2) { const int ci = tid + 512 * k2, s = ci >> 4; const float w = WS[64 + s];
            const v4u x = *(const LAS v4u*)(vbuf + ci * 16); v4u y; const unsigned xs[4] = {x.x, x.y, x.z, x.w}; unsigned ys[4];
#pragma unroll
            for (int j = 0; j < 4; ++j) ys[j] = pkbf(__uint_as_float(xs[j] << 16) * w, __uint_as_float(xs[j] & 0xffff0000u) * w);
            y.x = ys[0]; y.y = ys[1]; y.z = ys[2]; y.w = ys[3]; *(LAS v4u*)(lds + ML_VW + ci * 16) = y; }
        asm volatile("s_waitcnt lgkmcnt(0)" ::: "memory"); __builtin_amdgcn_s_barrier(); asm volatile("" ::: "memory");
        if (c < 31) {
            const bf16* qp = mlqk + (tokc + 64 + 32 * tb + r) * 1024 + hd * 128 + 8 * hh;
#pragma unroll
            for (int st = 0; st < 8; ++st) qf[st] = *(const bf16x8*)(qp + 16 * st);
            gi_raw = bf2f(proj[(tokc + 64 + lane) * NPROJ + PC_MLI + hd]); gf_raw = bf2f(proj[(tokc + 64 + lane) * NPROJ + PC_MLF + hd]);
        }
        { const LAS float* GO = (const LAS float*)(lds + ML_GO) + 32 * vb + 4 * hh;
          const float rstd = rsqrtf(((SS[tl] + SS[64 + tl]) + (SS[128 + tl] + SS[192 + tl])) * (1.f / 128.f) + EPS);
#pragma unroll
          for (int a = 0; a < 4; ++a) { float o4[4]; const unsigned gw[2] = {og[a].x, og[a].y};
#pragma unroll
              for (int j = 0; j < 4; ++j) { const float ov = (j & 1) ? __uint_as_float(gw[j >> 1] & 0xffff0000u) : __uint_as_float(gw[j >> 1] << 16); o4[j] = acc[4 * a + j] * rstd * GO[8 * a + j] * sigm(ov); }
              u32x2 w; w.x = pkbf(o4[0], o4[1]); w.y = pkbf(o4[2], o4[3]); *(LAS u32x2*)(lds + ML_ST + tl * 272 + (32 * vb + 8 * a + 4 * hh) * 2) = w; } }
        if (PM & 128)
#pragma unroll
        for (int blk = 0; blk < 2; ++blk) {
            f32x16 cs = Cst[blk];
#pragma unroll
            for (int i = 0; i < 16; ++i) cs[i] *= a_old;
            bf16x8 afr[4], kfr2[4];
#pragma unroll
            for (int st = 0; st < 4; ++st) {
                afr[st] = ml_tr8(lds + ML_VW + base_c + st * 4096);
                const s16x4 lo = __builtin_amdgcn_ds_read_tr16_b64_v4i16((lds_s16x4*)(kbuf + base_kt[blk][0] + st * 4096)); const s16x4 hi = __builtin_amdgcn_ds_read_tr16_b64_v4i16((lds_s16x4*)(kbuf + base_kt[blk][1] + st * 4096));
                kfr2[st] = __builtin_shufflevector(lo, hi, 0, 1, 2, 3, 4, 5, 6, 7);
            }
            SB();
#pragma unroll
            for (int st = 0; st < 4; ++st) cs = MFMA32(afr[st], kfr2[st], cs);
            Cst[blk] = cs;
            const int kk = 32 * (2 * tb + blk) + r;
#pragma unroll
            for (int a = 0; a < 4; ++a) { u32x2 w; w.x = pkbf(cs[4 * a], cs[4 * a + 1]); w.y = pkbf(cs[4 * a + 2], cs[4 * a + 3]);
                *(LAS u32x2*)(lds + ML_C + kk * 256 + 16 * ((4 * vb + a) ^ ((r & 3) << 2)) + 8 * hh) = w; }
        }
        if ((PM & 64) && tid < 128) { float nv = NV[tid] * a_old;
#pragma unroll 8
            for (int s = 0; s < 64; ++s) { const unsigned short kvs = *(const LAS unsigned short*)(kbuf + s * 256 + 16 * ((tid >> 3) ^ ml_fk(s)) + 2 * (tid & 7)); nv = fmaf(WS[64 + s], bf2f(kvs), nv); }
            NV[tid] = nv; }
        m_prev = m_new;
    }
    __syncthreads();
    if (PM & 1) { bf16* obase = H0 + (tok0 + 64 * 31) * 1536 + hd * 128;
#pragma unroll
        for (int i = 0; i < 2; ++i) { const int piece = tid + 512 * i, row = piece >> 4, cc = piece & 15; *(v4u*)(obase + (size_t)row * 1536 + 8 * cc) = *(const LAS v4u*)(lds + ML_ST + row * 272 + 16 * cc); } }
    __syncthreads();
}
DI void mem_load(LAS unsigned char* lds, int par, const char* kb, const char* vb, int wave, int lane) {
#pragma unroll
    for (int n2 = 0; n2 < 2; ++n2) { const int n = 2 * wave + n2, row = 4 * n + (lane >> 4), pc = lane & 15;
        const int kc = pc ^ ml_fk(row), vc = pc ^ ((row & 3) << 2);
        glds16(kb + (size_t)row * 1024 + 16 * kc, (unsigned)(size_t)(lds + ML_K + par * 16384 + n * 1024));
        glds16(vb + (size_t)row * 2048 + 16 * vc, (unsigned)(size_t)(lds + ML_V + par * 16384 + n * 1024)); }
}
template <bool STORE = true, bool DMA = true, bool COMP = true>
DI void mem_unit(Frame& F, int unit) {
    unsigned char* ws = F.ws; LAS unsigned char* lds = F.lds;
    int lane_ = F.lane_id();
    const int lane = lane_, wave = F.wave, r = lane & 31, hh = lane >> 5;
    const int b = unit >> 5, hd = (unit >> 3) & 3, qt = unit & 7;
    const bf16* mqn = (const bf16*)(ws + WS_MQN); const bf16* memkn = (const bf16*)(ws + WS_MEMKN); const bf16* memkv = (const bf16*)(ws + WS_MEMKV); bf16* H2 = (bf16*)(ws + WS_H0);
    const size_t t = (size_t)b * SEQ + 256 * qt + 32 * wave + r;
    const char* kbase = (const char*)(memkn + (size_t)b * MEML * 512 + hd * 128); const char* vbase = (const char*)(memkv + (size_t)b * MEML * 1024 + 512 + hd * 128);
    const int i16 = lane & 15, q4 = i16 >> 2, p4 = i16 & 3, g1 = (lane >> 4) & 1;
    int base_v[4];
#pragma unroll
    for (int db = 0; db < 4; ++db) base_v[db] = (4 * hh + q4) * 256 + 16 * ((4 * db + 2 * g1 + (p4 >> 1)) ^ (q4 << 2)) + 8 * (p4 & 1);
    const int fK = ml_fk(r), rowK = r * 256 + ((hh ^ (fK & 1)) << 4), F16 = (fK & 14) << 4;
    asm volatile("s_waitcnt lgkmcnt(0)" ::: "memory"); __builtin_amdgcn_s_barrier(); asm volatile("" ::: "memory");
    if (DMA) mem_load(lds, 0, kbase, vbase, wave, lane);
    bf16x8 qf[8];
#pragma unroll
    for (int st = 0; st < 8; ++st) qf[st] = *(const bf16x8*)(mqn + t * 512 + hd * 128 + 16 * st + 8 * hh);
    f32x16 o[4]; float l = 0.f;
#pragma unroll
    for (int db = 0; db < 4; ++db)
#pragma unroll
        for (int i = 0; i < 16; ++i) o[db][i] = 0.f;
#pragma unroll 1
    for (int tile = 0; tile < 4; ++tile) {
        const int par = tile & 1;
        WG_BAR();
        if (DMA && tile < 3) mem_load(lds, par ^ 1, kbase + (size_t)(64 * (tile + 1)) * 1024, vbase + (size_t)(64 * (tile + 1)) * 2048, wave, lane);
        const LAS unsigned char* kbuf = lds + ML_K + par * 16384; const LAS unsigned char* vbuf = lds + ML_V + par * 16384;
        if (COMP)
#pragma unroll
        for (int kb = 0; kb < 2; ++kb) {
            bf16x8 kf[8];
#pragma unroll
            for (int st = 0; st < 8; ++st) kf[st] = *(const LAS bf16x8*)(kbuf + kb * 8192 + rowK + ((32 * st) ^ F16));
            SB();
            f32x16 a;
#pragma unroll
            for (int i = 0; i < 16; ++i) a[i] = 0.f;
#pragma unroll
            for (int st = 0; st < 8; ++st) a = MFMA32(kf[st], qf[st], a);
            bf16x8 vf[2][4];
#pragma unroll
            for (int s2 = 0; s2 < 2; ++s2)
#pragma unroll
                for (int db = 0; db < 4; ++db) { const LAS unsigned char* p = vbuf + base_v[db] + kb * 8192 + s2 * 4096;
                    const s16x4 lo = __builtin_amdgcn_ds_read_tr16_b64_v4i16((lds_s16x4*)p); const s16x4 hi = __builtin_amdgcn_ds_read_tr16_b64_v4i16((lds_s16x4*)(p + 2048));
                    vf[s2][db] = __builtin_shufflevector(lo, hi, 0, 1, 2, 3, 4, 5, 6, 7); }
            SB();
#pragma unroll
            for (int i = 0; i < 16; ++i) { a[i] = __builtin_amdgcn_exp2f(a[i]); l += a[i]; }
            const bf16x8 pf0 = pack8<0>(a), pf1 = pack8<1>(a);
#pragma unroll
            for (int s2 = 0; s2 < 2; ++s2)
#pragma unroll
                for (int db = 0; db < 4; ++db) o[db] = MFMA32(vf[s2][db], s2 ? pf1 : pf0, o[db]);
        }
    }
    const float inv = 1.f / (l + __shfl_xor(l, 32));
    if (!STORE) {
#pragma unroll
        for (int db = 0; db < 4; ++db) asm volatile("" :: "v"(o[db]), "v"(inv));
        return; }
    WG_BAR();
#pragma unroll
    for (int db = 0; db < 4; ++db)
#pragma unroll
        for (int a = 0; a < 4; ++a) { u32x2 w; w.x = pkbf(o[db][4 * a] * inv, o[db][4 * a + 1] * inv); w.y = pkbf(o[db][4 * a + 2] * inv, o[db][4 * a + 3] * inv);
            *(LAS u32x2*)(lds + (32 * wave + r) * 272 + (32 * db + 8 * a + 4 * hh) * 2) = w; }
    WG_BAR();
    { const int tid = wave * 64 + lane; bf16* obase = H2 + ((size_t)b * SEQ + 256 * qt) * 1536 + 1024 + hd * 128;
#pragma unroll
      for (int i = 0; i < 8; ++i) { const int piece = tid + 512 * i, row = piece >> 4, c = piece & 15; *(v4u*)(obase + (size_t)row * 1536 + 8 * c) = *(const LAS v4u*)(lds + row * 272 + 16 * c); } }
}
DI int q_pop(Frame& F, unsigned* qc) {
    __syncthreads();
    if (F.tid_id() == 0) F.MISC[16] = atomicAdd(qc, 1u);
    __syncthreads();
    return (int)F.MISC[16];
}
template <bool ML, bool NSA, bool MEMA, bool MST = true, bool MDMA = true, bool MCOMP = true, bool NST = true, bool NCMP = true, bool NSEL = true, bool NWIN = true, int MLPM = 0xff>
DI void p5_queue(Frame& F, int cbase) {
    unsigned* qc = F.ctl + CW_QCTR + cbase;
    if (ML) {
#pragma unroll 1
        for (;;) { const int it = q_pop(F, qc); if (it >= 64) break; mlstm_unit2<MLPM>(F, it); }
    }
    if (NSA) {
#pragma unroll 1
        for (;;) { const int it = q_pop(F, qc + 64); if (it >= 1024) break; nsa_unit<NST, NCMP, NSEL, NWIN>(F, it); }
    }
    if (MEMA) {
#pragma unroll 1
        for (;;) { const int it = q_pop(F, qc + 128); if (it >= 512) break; mem_unit<MST, MDMA, MCOMP>(F, it); }
    }
    __syncthreads();
}
struct OneUnit { int pm; DI bool next(int i, pg8::Unit& u) const { if (i) return false; u.pm = pm; u.pn = 0; return true; } DI void a_ready(const pg8::Unit&) const {} DI void done(const pg8::Unit&) const {} };
DI void p2_compress(Frame& F) {
    unsigned char* ws = F.ws;
    if (F.G < 64 || F.bx >= 32) return;
    const int kv = F.bx >> 4, pm = F.bx & 15;
    typedef pg8::bf16_t b16;
    { pg8::GemmA g{(const b16*)(ws + WS_PROJ) + (kv ? PC_NVC : PC_NKC), (const b16*)(ws + WS_WC1) + (size_t)kv * 256 * 2048, 2048, 16 * NPROJ * 2, (size_t)NPROJ * 2, (size_t)128, (size_t)SEQ * NPROJ * 2};
      OneUnit S{pm};
      pg8::EpiBf16Silu E{(b16*)(ws + WS_HID) + (size_t)kv * 4096 * 256, 256, (const float*)(ws + WS_SMALL + SM_CBIAS) + kv * 256, 1};
      pg8::gemm_phase_ga<pg8::EpiBf16Silu, OneUnit, false, true>(F.lds, g, S, E, F.wave); }
    asm volatile("s_waitcnt vmcnt(0)" ::: "memory"); __syncthreads();
    const int lane = F.lane_id(), r = lane & 31, hh = lane >> 5;
    const int row = pm * 256 + F.wave * 32 + r, n = row & 127;
    const bf16* hid = (const bf16*)(ws + WS_HID) + (size_t)kv * 4096 * 256 + (size_t)row * 256 + 8 * hh;
    const bf16* w2t = (const bf16*)(ws + WS_SMALL + SM_W2T) + (size_t)kv * 64 * 256 + 8 * hh;
    f32x16 acc[2];
#pragma unroll
    for (int i = 0; i < 16; ++i) { acc[0][i] = 0.f; acc[1][i] = 0.f; }
#pragma unroll 4
    for (int st = 0; st < 16; ++st) { const bf16x8 hb = *(const bf16x8*)(hid + 16 * st);
        const bf16x8 w0 = *(const bf16x8*)(w2t + (size_t)r * 256 + 16 * st), w1 = *(const bf16x8*)(w2t + (size_t)(32 + r) * 256 + 16 * st);
        acc[0] = MFMA32(w0, hb, acc[0]); acc[1] = MFMA32(w1, hb, acc[1]); }
    if (kv == 0) {
        float ss = 0.f;
#pragma unroll
        for (int i = 0; i < 16; ++i) ss += acc[0][i] * acc[0][i] + acc[1][i] * acc[1][i];
        ss += __shfl_xor(ss, 32);
        const float rstd = rsqrtf(ss * (1.f / 64.f) + EPS);
        const float* rc = (const float*)(ws + WS_SMALL + SM_ROPEC); const float* rs = (const float*)(ws + WS_SMALL + SM_ROPES);
        const int pos = 16 * n + 31 < SEQ ? 16 * n + 31 : SEQ - 1;
#pragma unroll
        for (int i = 0; i < 16; ++i) { const int d = crow(i, hh); const float c = rc[pos * 32 + d], sn = rs[pos * 32 + d];
            const float y0 = acc[0][i] * rstd * F.in[I_NGK][d], y1 = acc[1][i] * rstd * F.in[I_NGK][32 + d];
            acc[0][i] = y0 * c - y1 * sn; acc[1][i] = y1 * c + y0 * sn; }
    }
    bf16* dst = (bf16*)(ws + (kv ? WS_VC : WS_KC)) + (size_t)row * 64 + 4 * hh;
#pragma unroll
    for (int db = 0; db < 2; ++db)
#pragma unroll
        for (int a = 0; a < 4; ++a) { u32x2 w; w.x = pkbf(acc[db][4 * a], acc[db][4 * a + 1]); w.y = pkbf(acc[db][4 * a + 2], acc[db][4 * a + 3]); if (n == 127) { w.x = 0u; w.y = 0u; }
            *(u32x2*)(dst + 32 * db + 8 * a) = w; }
}
DI void mlstm_unit(Frame& F, int unit) {
    unsigned char* ws = F.ws;
    const int b = unit >> 2, h = unit & 3, tid = F.tid_id(), kk = tid >> 7, c = tid & 127;
    const bf16* proj = (const bf16*)(ws + WS_PROJ); const bf16* mlqk = (const bf16*)(ws + WS_MLQK); bf16* H0 = (bf16*)(ws + WS_H0);
    LAS float* qs = (LAS float*)F.lds;
    LAS float* ks = qs + 16 * 128;
    LAS float* vs = ks + 16 * 128;
    LAS float* gi = vs + 16 * 128;
    LAS float* gf = gi + 16;
    LAS float* part = gf + 16;
    LAS float* pden = part + 2 * 4 * 128;
    LAS float* hb = pden + 8;
    float C[32], nn[32];
#pragma unroll
    for (int i = 0; i < 32; ++i) { C[i] = 0.f; nn[i] = 0.f; }
    float m = 0.f;
    const float bi = F.in[I_MLBI][h], bfv = F.in[I_MLBF][h];
    const float scale = 0.08838834764831845f;
#pragma unroll 1
    for (int t0 = 0; t0 < SEQ; t0 += 16) {
        __syncthreads();
        for (int i = tid; i < 16 * 128; i += 512) { const int s = i >> 7, d = i & 127; const size_t t = (size_t)b * SEQ + t0 + s;
            qs[i] = bf2f(mlqk[t * 1024 + h * 128 + d]); ks[i] = bf2f(mlqk[t * 1024 + 512 + h * 128 + d]); vs[i] = bf2f(proj[t * NPROJ + PC_MLV + h * 128 + d]); }
        if (tid < 16) { const size_t t = (size_t)b * SEQ + t0 + tid; gi[tid] = bf2f(proj[t * NPROJ + PC_MLI + h]) + bi; gf[tid] = logsig(bf2f(proj[t * NPROJ + PC_MLF + h]) + bfv); }
        __syncthreads();
#pragma unroll 1
        for (int s = 0; s < 16; ++s) {
            const float lf = gf[s], ig = gi[s];
            const float mn = fmaxf(lf + m, ig), a = __expf(lf + m - mn), bb = __expf(ig - mn);
            m = mn;
            const float v = vs[s * 128 + c];
            float pn = 0.f, pd = 0.f;
#pragma unroll
            for (int i = 0; i < 32; ++i) { const float kvv = ks[s * 128 + kk * 32 + i], qv = qs[s * 128 + kk * 32 + i];
                C[i] = a * C[i] + bb * kvv * v; nn[i] = a * nn[i] + bb * kvv; pn = fmaf(qv, C[i], pn); pd = fmaf(qv, nn[i], pd); }
            const int par = s & 1;
            part[(par * 4 + kk) * 128 + c] = pn; if (c == 0) pden[par * 4 + kk] = pd;
            __syncthreads();
            if (kk == 0) {
                const float num = (part[(par * 4 + 0) * 128 + c] + part[(par * 4 + 1) * 128 + c]) + (part[(par * 4 + 2) * 128 + c] + part[(par * 4 + 3) * 128 + c]);
                const float den = (pden[par * 4 + 0] + pden[par * 4 + 1]) + (pden[par * 4 + 2] + pden[par * 4 + 3]);
                hb[s * 128 + c] = num * scale / fmaxf(fabsf(den * scale), __expf(-mn));
            }
        }
        __syncthreads();
#pragma unroll
        for (int rr = 0; rr < 2; ++rr) { const int s = F.wave * 2 + rr; const size_t t = (size_t)b * SEQ + t0 + s;
            const float v0 = hb[s * 128 + F.lane_id()], v1 = hb[s * 128 + 64 + F.lane_id()];
            const float rstd = rsqrtf(wave_sum(v0 * v0 + v1 * v1) * (1.f / 128.f) + EPS);
            const float o0 = bf2f(proj[t * NPROJ + PC_MLO + h * 128 + F.lane_id()]), o1 = bf2f(proj[t * NPROJ + PC_MLO + h * 128 + 64 + F.lane_id()]);
            H0[t * 512 + h * 128 + F.lane_id()] = (bf16)f2bf(v0 * rstd * F.in[I_MLGOUT][h * 128 + F.lane_id()] * sigm(o0));
            H0[t * 512 + h * 128 + 64 + F.lane_id()] = (bf16)f2bf(v1 * rstd * F.in[I_MLGOUT][h * 128 + 64 + F.lane_id()] * sigm(o1)); }
    }
    __syncthreads();
}

DI void nsa_scores(const bf16* krow, bool valid, const LAS float* qs, float (&s)[4]) {
    s[0] = s[1] = s[2] = s[3] = 0.f;
    if (valid) {
#pragma unroll 2
        for (int c8 = 0; c8 < 8; ++c8) { const v4u kk = *(const v4u*)(krow + c8 * 8);
            const unsigned w[4] = {kk.x, kk.y, kk.z, kk.w};
#pragma unroll
            for (int j = 0; j < 4; ++j) { const float k0 = __uint_as_float(w[j] << 16), k1 = __uint_as_float(w[j] & 0xffff0000u); const int d = c8 * 8 + 2 * j;
#pragma unroll
                for (int g = 0; g < 4; ++g) s[g] = fmaf(k1, qs[g * 64 + d + 1], fmaf(k0, qs[g * 64 + d], s[g])); } }
    }
}
DI void nsa_wave(Frame& F, int item, LAS float* wl) {
    unsigned char* ws = F.ws; const int lane = F.lane_id();
    const int t = item >> 1, hkv = item & 1, b = t >> 11, tau = t & 2047;
    const bf16* proj = (const bf16*)(ws + WS_PROJ);
    const bf16* qn = (const bf16*)(ws + WS_QN); const bf16* ksn = (const bf16*)(ws + WS_KSN); const bf16* kwn = (const bf16*)(ws + WS_KWN);
    const bf16* kc = (const bf16*)(ws + WS_KC); const bf16* vc = (const bf16*)(ws + WS_VC); bf16* H1 = (bf16*)(ws + WS_H1);
    LAS float* qs = wl;
    LAS float* ps = wl + 256;
    LAS float* psum = wl + 768;
#pragma unroll
    for (int g = 0; g < 4; ++g) qs[g * 64 + lane] = bf2f(qn[(size_t)t * 512 + (hkv * 4 + g) * 64 + lane]);
    float ofin[4] = {0.f, 0.f, 0.f, 0.f};
    float gate[4][3];
#pragma unroll
    for (int g = 0; g < 4; ++g)
#pragma unroll
        for (int cidx = 0; cidx < 3; ++cidx) gate[g][cidx] = sigm(bf2f(proj[(size_t)t * NPROJ + PC_NG + (hkv * 4 + g) * 3 + cidx]));
    const int ncmp = tau >= 31 ? ((tau - 31) >> 4) + 1 : 0;
    {
        float l[4] = {0.f, 0.f, 0.f, 0.f}, o[4] = {0.f, 0.f, 0.f, 0.f};
        const size_t rbase = (size_t)(b * 2 + hkv) * 128;
#pragma unroll
        for (int blk = 0; blk < 2; ++blk) { const int n = blk * 64 + lane; const bool valid = n < ncmp; float s[4];
            nsa_scores(kc + (rbase + n) * 64, valid, qs, s);
#pragma unroll
            for (int g = 0; g < 4; ++g) { const float p = valid ? __expf(s[g]) : 0.f; l[g] += p; ps[g * 128 + n] = p; } }
        float inv[4];
#pragma unroll
        for (int g = 0; g < 4; ++g) { const float L = wave_sum(l[g]); inv[g] = L > 0.f ? 1.f / L : 0.f; }
#pragma unroll
        for (int blk = 0; blk < 2; ++blk) { const int n = blk * 64 + lane; psum[n] = (ps[0 * 128 + n] * inv[0] + ps[1 * 128 + n] * inv[1]) + (ps[2 * 128 + n] * inv[2] + ps[3 * 128 + n] * inv[3]); }
#pragma unroll 2
        for (int n = 0; n < ncmp; ++n) { const float vv = bf2f(vc[(rbase + n) * 64 + lane]);
#pragma unroll
            for (int g = 0; g < 4; ++g) o[g] = fmaf(ps[g * 128 + n], vv, o[g]); }
#pragma unroll
        for (int g = 0; g < 4; ++g) ofin[g] += gate[g][0] * o[g] * inv[g];
    }
    const int cur = tau >> 6;
    unsigned selmask = 0u;
    {
        float score = -3.0e38f;
        if (lane < 32) { const int j = lane; float imp = 0.f;
#pragma unroll
            for (int dn = -1; dn <= 3; ++dn) { const int n = 4 * j + dn; if (n >= 0 && n <= 126) imp += psum[n]; }
            const bool forced = (j == 0) || (j == cur) || (j == cur - 1);
            score = j > cur ? NEGF : imp + (forced ? 1.0e4f : 0.f); }
#pragma unroll 1
        for (int r = 0; r < 8; ++r) { const float mx = wave_max(score); const unsigned long long bal = __ballot(score == mx); const int win = __ffsll((long long)bal) - 1;
            selmask |= 1u << win; if (lane == win) score = -3.4e38f; }
    }
    {
        float l[4] = {0.f, 0.f, 0.f, 0.f}, o[4] = {0.f, 0.f, 0.f, 0.f};
#pragma unroll 1
        for (int j = 0; j <= cur; ++j) { if (!((selmask >> j) & 1u)) continue;
            const int kpos = 64 * j + lane; const bool valid = kpos <= tau; float s[4];
            nsa_scores(ksn + ((size_t)b * SEQ + kpos) * 128 + hkv * 64, valid, qs, s);
#pragma unroll
            for (int g = 0; g < 4; ++g) { const float p = valid ? __expf(s[g]) : 0.f; l[g] += p; ps[g * 128 + lane] = p; }
            const int nk = j == cur ? (tau & 63) + 1 : 64;
            const bf16* vb = proj + ((size_t)b * SEQ + 64 * j) * NPROJ + PC_NVS + hkv * 64 + lane;
#pragma unroll 2
            for (int k = 0; k < nk; ++k) { const float vv = bf2f(vb[(size_t)k * NPROJ]);
#pragma unroll
                for (int g = 0; g < 4; ++g) o[g] = fmaf(ps[g * 128 + k], vv, o[g]); } }
#pragma unroll
        for (int g = 0; g < 4; ++g) { const float L = wave_sum(l[g]); ofin[g] += gate[g][1] * o[g] * (L > 0.f ? 1.f / L : 0.f); }
    }
    {
        float l[4] = {0.f, 0.f, 0.f, 0.f}, o[4] = {0.f, 0.f, 0.f, 0.f};
        const int start = tau - 511 > 0 ? tau - 511 : 0;
#pragma unroll 1
        for (int base = start & ~63; base <= tau; base += 64) {
            const int kpos = base + lane; const bool valid = kpos >= start && kpos <= tau; float s[4];
            nsa_scores(kwn + ((size_t)b * SEQ + kpos) * 128 + hkv * 64, valid, qs, s);
#pragma unroll
            for (int g = 0; g < 4; ++g) { const float p = valid ? __expf(s[g]) : 0.f; l[g] += p; ps[g * 128 + lane] = p; }
            const int k0 = start > base ? start - base : 0, k1 = tau - base < 63 ? tau - base : 63;
            const bf16* vb = proj + ((size_t)b * SEQ + base) * NPROJ + PC_NVW + hkv * 64 + lane;
#pragma unroll 2
            for (int k = k0; k <= k1; ++k) { const float vv = bf2f(vb[(size_t)k * NPROJ]);
#pragma unroll
                for (int g = 0; g < 4; ++g) o[g] = fmaf(ps[g * 128 + k], vv, o[g]); } }
#pragma unroll
        for (int g = 0; g < 4; ++g) { const float L = wave_sum(l[g]); ofin[g] += gate[g][2] * o[g] * (L > 0.f ? 1.f / L : 0.f); }
    }
#pragma unroll
    for (int g = 0; g < 4; ++g) H1[(size_t)t * 512 + (hkv * 4 + g) * 64 + lane] = (bf16)f2bf(ofin[g]);
}
DI void mem_wave(Frame& F, int t, LAS float* wl) {
    unsigned char* ws = F.ws; const int lane = F.lane_id(); const int b = t >> 11;
    const bf16* mqn = (const bf16*)(ws + WS_MQN); const bf16* memkn = (const bf16*)(ws + WS_MEMKN); const bf16* memkv = (const bf16*)(ws + WS_MEMKV); bf16* H2 = (bf16*)(ws + WS_H2);
    LAS float* qs = wl;
    LAS float* ps = wl + 128;
#pragma unroll 1
    for (int h = 0; h < 4; ++h) {
        qs[lane] = bf2f(mqn[(size_t)t * 512 + h * 128 + lane]); qs[64 + lane] = bf2f(mqn[(size_t)t * 512 + h * 128 + 64 + lane]);
        float l = 0.f;
#pragma unroll 1
        for (int kq = 0; kq < 4; ++kq) { const int key = kq * 64 + lane; const bf16* kr = memkn + ((size_t)b * MEML + key) * 512 + h * 128; float s = 0.f;
#pragma unroll 2
            for (int c8 = 0; c8 < 16; ++c8) { const v4u kk = *(const v4u*)(kr + c8 * 8); const unsigned w[4] = {kk.x, kk.y, kk.z, kk.w};
#pragma unroll
                for (int j = 0; j < 4; ++j) s = fmaf(__uint_as_float(w[j] & 0xffff0000u), qs[c8 * 8 + 2 * j + 1], fmaf(__uint_as_float(w[j] << 16), qs[c8 * 8 + 2 * j], s)); }
            const float p = __expf(s); l += p; ps[key] = p; }
        const float inv = 1.f / wave_sum(l);
        float o0 = 0.f, o1 = 0.f;
        const bf16* vb = memkv + (size_t)b * MEML * 1024 + 512 + h * 128;
#pragma unroll 4
        for (int key = 0; key < MEML; ++key) { const float p = ps[key]; o0 = fmaf(p, bf2f(vb[(size_t)key * 1024 + lane]), o0); o1 = fmaf(p, bf2f(vb[(size_t)key * 1024 + 64 + lane]), o1); }
        H2[(size_t)t * 512 + h * 128 + lane] = (bf16)f2bf(o0 * inv); H2[(size_t)t * 512 + h * 128 + 64 + lane] = (bf16)f2bf(o1 * inv);
    }
}
DI void p5_mixers(Frame& F) {
    const int nml = F.G >= 128 ? 64 : 0;
#ifndef RPT_ML
#define RPT_ML 1
#endif
#ifndef RPT_NSA
#define RPT_NSA 1
#endif
#ifndef RPT_MEM
#define RPT_MEM 1
#endif
    if (F.bx < nml || nml == 0) { for (int rp = 0; rp < RPT_ML; ++rp) for (int u = F.bx; u < 64; u += (nml ? nml : F.G)) mlstm_unit2(F, u); }
    if (F.bx >= nml) {
        LAS float* wl = (LAS float*)(F.lds + F.wave * 4096);
        const int gw = (F.bx - nml) * NWAVES + F.wave, NGW = (F.G - nml) * NWAVES;
        for (int rp = 0; rp < RPT_NSA; ++rp) for (int u = F.bx - nml; u < 1024; u += F.G - nml) nsa_unit(F, u);
        __syncthreads();
        for (int rp = 0; rp < RPT_MEM; ++rp) for (int t = gw; t < MT; t += NGW) mem_wave(F, t, wl);
    }
}

DI void p8_router(Frame& F, int alt) {
    unsigned char* ws = F.ws + (size_t)alt * 3 * MiB; const int lane = F.lane_id(), tid = F.tid_id(), wave = F.wave, r = lane & 31, hh = lane >> 5;
    unsigned char* xn8 = (unsigned char*)(F.ws + WS_R1);
    int* tok_e = (int*)(ws + WS_ROUTE + RT_TOKE); int* tok_pos = (int*)(ws + WS_ROUTE + RT_TOKPOS); float* tok_w = (float*)(ws + WS_ROUTE + RT_TOKW);
    unsigned* gcnt = F.ctl + CW_ECNT + 64 * alt;
    const bf16* wrt = (const bf16*)(F.ws + WS_SMALL + SM_WRT);
    LAS unsigned char* img = F.lds;
    LAS float* part = (LAS float*)F.lds;
    LAS float* lg = (LAS float*)(F.lds + 4 * 64 * 33 * 4);
    LAS int* lcnt = (LAS int*)(F.lds + RING_BYTES + 1024);
    LAS int* lbase = lcnt + 32;
    LAS int* se = lbase + 32;
    LAS int* sp = se + 256;
    LAS float* sw = (LAS float*)(sp + 256);
    const float* gf = F.in[I_GFFN];
    for (int bt = F.bx; bt < MT / 64; bt += F.G) {
        __syncthreads();
        if (tid < 32) lcnt[tid] = 0;
        const f32x4* gr = (const f32x4*)gf + 4 * lane; const f32x4 g0 = gr[0], g1 = gr[1], g2 = gr[2], g3 = gr[3];
#pragma unroll 1
        for (int i0 = 0; i0 < 8; i0 += 4) {
            f32x4 v[4][4];
#pragma unroll
            for (int u = 0; u < 4; ++u) { const int t = bt * 64 + wave * 8 + i0 + u; const f32x4* xr = (const f32x4*)(F.out + (size_t)t * DM) + 4 * lane;
#pragma unroll
                for (int j = 0; j < 4; ++j) v[u][j] = xr[j]; }
#pragma unroll
            for (int u = 0; u < 4; ++u) { const int tl = wave * 8 + i0 + u, t = bt * 64 + tl; float sq = 0.f;
#pragma unroll
                for (int j = 0; j < 4; ++j) sq += (v[u][j].x * v[u][j].x + v[u][j].y * v[u][j].y) + (v[u][j].z * v[u][j].z + v[u][j].w * v[u][j].w);
                const float rstd = rsqrtf(wave_sum(sq) * (1.f / DM) + EPS);
                const f32x4 gg[4] = {g0, g1, g2, g3}; unsigned q[4]; unsigned bw[8];
#pragma unroll
                for (int j = 0; j < 4; ++j) { const float y0 = v[u][j].x * rstd * gg[j].x, y1 = v[u][j].y * rstd * gg[j].y, y2 = v[u][j].z * rstd * gg[j].z, y3 = v[u][j].w * rstd * gg[j].w;
                    bw[2 * j] = pk2(y0, y1); bw[2 * j + 1] = pk2(y2, y3);
                    int q8 = 0; q8 = __builtin_amdgcn_cvt_pk_fp8_f32(y0, y1, q8, false); q8 = __builtin_amdgcn_cvt_pk_fp8_f32(y2, y3, q8, true); q[j] = (unsigned)q8; }
                *((v4u*)(xn8 + (size_t)t * DM) + lane) = (v4u){q[0], q[1], q[2], q[3]};
                *(LAS v4u*)(img + tl * 2048 + 16 * ((2 * lane) ^ (tl & 15))) = (v4u){bw[0], bw[1], bw[2], bw[3]};
                *(LAS v4u*)(img + tl * 2048 + 16 * ((2 * lane + 1) ^ (tl & 15))) = (v4u){bw[4], bw[5], bw[6], bw[7]}; }
        }
        __syncthreads();
        {
            const int mb = wave & 1, kq = wave >> 1, trow = 32 * mb + r;
            f32x16 acc;
#pragma unroll
            for (int i = 0; i < 16; ++i) acc[i] = 0.f;
#pragma unroll 4
            for (int s2 = 0; s2 < 16; ++s2) { const int st = 16 * kq + s2;
                const bf16x8 xa = *(const LAS bf16x8*)(img + trow * 2048 + 16 * ((2 * st + hh) ^ (trow & 15)));
                const bf16x8 wh = *(const bf16x8*)(wrt + (size_t)r * 1024 + 16 * st + 8 * hh), wl = *(const bf16x8*)(wrt + 32 * 1024 + (size_t)r * 1024 + 16 * st + 8 * hh);
                acc = MFMA32(xa, wh, acc); acc = MFMA32(xa, wl, acc); }
            __syncthreads();
#pragma unroll
            for (int i = 0; i < 16; ++i) part[(kq * 64 + 32 * mb + crow(i, hh)) * 33 + r] = acc[i];
        }
        __syncthreads();
        for (int i = tid; i < 64 * 32; i += 512) { const int tk = i >> 5, e = i & 31; lg[tk * 33 + e] = ((part[(0 * 64 + tk) * 33 + e] + part[(1 * 64 + tk) * 33 + e]) + (part[(2 * 64 + tk) * 33 + e] + part[(3 * 64 + tk) * 33 + e])) + F.in[I_BR][e]; }
        __syncthreads();
        if (wave == 0) {
            const int tl = lane; float v[32];
#pragma unroll
            for (int e = 0; e < 32; ++e) v[e] = lg[tl * 33 + e];
            unsigned taken = 0u; int ek[4]; float vk[4];
#pragma unroll
            for (int rd = 0; rd < 4; ++rd) { float best = -3.4e38f; int bi = 0;
#pragma unroll
                for (int e = 0; e < 32; ++e) { const float x = ((taken >> e) & 1u) ? -3.4e38f : v[e]; if (x > best) { best = x; bi = e; } }
                taken |= 1u << bi; ek[rd] = bi; vk[rd] = best; }
            const float e1 = __expf(vk[1] - vk[0]), e2 = __expf(vk[2] - vk[0]), e3 = __expf(vk[3] - vk[0]); const float inv = 1.f / (1.f + e1 + e2 + e3);
            const float wk[4] = {inv, e1 * inv, e2 * inv, e3 * inv};
#pragma unroll
            for (int rd = 0; rd < 4; ++rd) { se[tl * 4 + rd] = ek[rd]; sw[tl * 4 + rd] = wk[rd]; sp[tl * 4 + rd] = atomicAdd((int*)&lcnt[ek[rd]], 1); }
        }
        __syncthreads();
        if (tid < 32) lbase[tid] = (int)atomicAdd(&gcnt[tid], (unsigned)lcnt[tid]);
        __syncthreads();
        if (tid < 256) { const int t = bt * 64 + (tid >> 2), k = tid & 3; const int e = se[tid];
          tok_e[t * 4 + k] = e; tok_pos[t * 4 + k] = lbase[e] + sp[tid]; tok_w[t * 4 + k] = sw[tid]; }
    }
    __syncthreads();
}
DI int moe_tables(Frame& F, LAS int* pstart, LAS unsigned char* blk_e) {
    unsigned* gcnt = F.ctl + CW_ECNT;
    __syncthreads();
    if (F.wave == 0) {
        const int l = F.lane_id(); int pad = 0;
        if (l < NEXP) { const int cnt = (int)__hip_atomic_load(&gcnt[l], __ATOMIC_RELAXED, __HIP_MEMORY_SCOPE_AGENT); pad = (cnt + MOEB - 1) / MOEB * MOEB; }
        int inc = pad;
#pragma unroll
        for (int o = 1; o < 32; o <<= 1) { const int v = __shfl_up(inc, o); if (l >= o) inc += v; }
        if (l < NEXP) pstart[l] = inc - pad;
        if (l == NEXP - 1) pstart[NEXP] = inc;
    }
    __syncthreads();
    const int nblk = pstart[NEXP] / MOEB;
    for (int rb = F.tid_id(); rb < nblk; rb += 512) { int e = 0; while (e < NEXP - 1 && pstart[e + 1] <= rb * MOEB) ++e; blk_e[rb] = (unsigned char)e; }
    __syncthreads();
    return nblk;
}
DI void p9_scatter(Frame& F) {
    unsigned char* ws = F.ws; const int lane = F.lane_id();
    LAS int* pstart = (LAS int*)(F.lds + 65536); LAS unsigned char* blk_e = (LAS unsigned char*)(F.lds + 65536 + 256);
    moe_tables(F, pstart, blk_e);
    const int* tok_e = (const int*)(ws + WS_ROUTE + RT_TOKE); const int* tok_pos = (const int*)(ws + WS_ROUTE + RT_TOKPOS); const float* tok_w = (const float*)(ws + WS_ROUTE + RT_TOKW);
    int* tok_dest = (int*)(ws + WS_ROUTE + RT_TOKDEST); float* roww = (float*)(ws + WS_ROUTE + RT_ROWW); int* rowtok = (int*)(ws + WS_ROUTE + RT_ROWTOK);
    unsigned* gcnt = F.ctl + CW_ECNT;
    for (int it = F.bx * 512 + F.tid_id(); it < NROWS; it += F.G * 512) {
        const int dest = pstart[tok_e[it]] + tok_pos[it];
        tok_dest[it] = dest; roww[dest] = tok_w[it]; rowtok[dest] = it >> 2; }
    for (int it = F.bx * 512 + F.tid_id(); it < NEXP * MOEB; it += F.G * 512) { const int e = it >> 8, i = it & 255; const int cnt = (int)__hip_atomic_load(&gcnt[e], __ATOMIC_RELAXED, __HIP_MEMORY_SCOPE_AGENT); const int padded = (cnt + MOEB - 1) / MOEB * MOEB;
        if (i < padded - cnt) { const int dest = pstart[e] + cnt + i; roww[dest] = 0.f; rowtok[dest] = 0; } }
    (void)lane;
}
DI void p12_combine(Frame& F) {
    unsigned char* ws = F.ws; const int lane = F.lane_id();
    const unsigned char* ybuf = (const unsigned char*)(ws + WS_APERM); const int* tok_dest = (const int*)(ws + WS_ROUTE + RT_TOKDEST);
    const int gw = F.bx * NWAVES + F.wave, NGW = F.G * NWAVES;
    typedef float f32x2t __attribute__((ext_vector_type(2)));
    for (int t2 = gw; t2 < MT / 2; t2 += NGW) {
        typedef int i32x4 __attribute__((ext_vector_type(4)));
        v4u w[2][4]; f32x4 a[2][4];
#pragma unroll
        for (int q = 0; q < 2; ++q) { const int t = 2 * t2 + q; const f32x4* orow = (const f32x4*)(F.out + (size_t)t * DM) + 4 * lane;
            const i32x4 d = *(const i32x4*)(tok_dest + t * 4); const int dd[4] = {d.x, d.y, d.z, d.w};
#pragma unroll
            for (int k = 0; k < 4; ++k) w[q][k] = *((const v4u*)(ybuf + (size_t)dd[k] * DM) + lane);
#pragma unroll
            for (int j = 0; j < 4; ++j) a[q][j] = orow[j]; }
#pragma unroll
        for (int q = 0; q < 2; ++q) { f32x4* orow = (f32x4*)(F.out + (size_t)(2 * t2 + q) * DM) + 4 * lane;
#pragma unroll
            for (int j = 0; j < 4; ++j) { f32x4 sacc = {0.f, 0.f, 0.f, 0.f};
#pragma unroll
                for (int k = 0; k < 4; ++k) { const unsigned ww = j == 0 ? w[q][k].x : j == 1 ? w[q][k].y : j == 2 ? w[q][k].z : w[q][k].w;
                    const f32x2t lo = __builtin_amdgcn_cvt_pk_f32_fp8((int)ww, false), hi = __builtin_amdgcn_cvt_pk_f32_fp8((int)ww, true);
                    sacc.x += lo.x; sacc.y += lo.y; sacc.z += hi.x; sacc.w += hi.y; }
                orow[j] = a[q][j] + sacc * 0.125f; } }
    }
}

constexpr int N_PHASES = 13;
#ifndef MK_PER_PHASE
#define MK_PER_PHASE 0
#endif
__global__ void __launch_bounds__(NWAVES * 64, 2) fwd_kernel(Args args) {
    extern __shared__ __attribute__((aligned(16))) unsigned char lds_raw[];
    Frame F;
    F.lds = (LAS unsigned char*)lds_raw; F.MISC = (volatile LAS unsigned*)(F.lds + MISC_OFF);
    F.wave = __builtin_amdgcn_readfirstlane((int)(threadIdx.x >> 6)); F.G = gridDim.x; F.bx = blockIdx.x;
    F.ws = args.ws; F.ctl = (unsigned*)(args.ws + WS_CTL); F.in = args.in; F.out = args.out;
    unsigned char* ws = args.ws;
    for (int u = threadIdx.x; u < (LDS_BYTES - LDSCTL_OFF) / 4; u += NWAVES * 64) ((LAS unsigned*)(F.lds + LDSCTL_OFF))[u] = 0u;
    __syncthreads();
    const int lo = args.ph_lo, hi = args.ph_hi;
    XcdBarrier bar; bar.wv = F.wave; bar.bar = F.ctl + CW_BAR; bar.x = 0; bar.st = nullptr;
    if (hi - lo > 1) bar = xcd_barrier_post(F.ctl + CW_BAR, F.MISC + 8, F.wave);
#ifndef PH_MASK
#define PH_MASK 0x1fff
#endif
#define IN(k) (((PH_MASK >> (k)) & 1) && lo <= (k) && (k) < hi)
#define SEAM(k) do { if (IN(k) && IN((k) + 1)) xcd_barrier(bar); } while (0)
    typedef pg8::bf16_t b16;
#ifndef RPT_MASK
#define RPT_MASK 0
#endif
#define RPT(k) _Pragma("unroll") for (int rp_ = 0; rp_ < 1 + ((RPT_MASK >> (k)) & 1); ++rp_)
#ifndef P0PARTS
#define P0PARTS 0xf
#endif
    if (IN(0)) { p0_prologue<0xf>(F); if (RPT_MASK & 1) p0_prologue<P0PARTS>(F); } SEAM(0);
    if (IN(1)) RPT(1) {
        { pg8::Gemm8 g{(const unsigned char*)(ws + WS_U8), (const unsigned char*)(ws + WS_WIN8), MT, NF8, DM, 0x7f7f7f7f, 0x77777777}; pg8::StaticOrder S; S.init(MT, NF8, F.G, F.bx);
          pg8::EpiBf16Silu E{(b16*)(ws + WS_PROJ) + NB16, NPROJ, nullptr, 0};
          pg8::gemm_phase_f8<pg8::EpiBf16Silu, pg8::StaticOrder, true, true>(F.lds, g, S, E, F.wave); }
        { pg8::Gemm g{(const b16*)(ws + WS_R1), (const b16*)(ws + WS_WIN), MT, NB16, DM}; pg8::StaticOrder S; S.init(MT, NB16, F.G, F.bx);
          pg8::EpiBf16Silu E{(b16*)(ws + WS_PROJ), NPROJ, nullptr, 0};
          pg8::gemm_phase<pg8::EpiBf16Silu, pg8::StaticOrder, true, true>(F.lds, g, S, E, F.wave); }
        { pg8::Gemm g{(const b16*)(ws + WS_MEMN), (const b16*)(ws + WS_WMKV), MROWS, 1024, DM}; pg8::StaticOrder S; S.init(MROWS, 1024, F.G, (F.bx + 64) % F.G);
          pg8::EpiBf16Silu E{(b16*)(ws + WS_MEMKV), 1024, nullptr, 0};
          pg8::gemm_phase<pg8::EpiBf16Silu, pg8::StaticOrder, true, true>(F.lds, g, S, E, F.wave); }
    } SEAM(1);
    if (IN(2)) { RPT(2) { p2_compress(F); p2_prep(F); } }
    if (IN(2) && IN(5)) xcd_barrier(bar);
#ifndef RPT5_ML
#define RPT5_ML 0
#endif
#ifndef MLPROBE
#define MLPROBE 0xff
#endif
#ifndef NPROBE_ST
#define NPROBE_ST true
#endif
#ifndef NPROBE_CMP
#define NPROBE_CMP true
#endif
#ifndef NPROBE_SEL
#define NPROBE_SEL true
#endif
#ifndef NPROBE_WIN
#define NPROBE_WIN true
#endif
#ifndef MPROBE_ST
#define MPROBE_ST true
#endif
#ifndef MPROBE_DMA
#define MPROBE_DMA true
#endif
#ifndef MPROBE_COMP
#define MPROBE_COMP true
#endif
#ifndef RPT5_NSA
#define RPT5_NSA 0
#endif
#ifndef RPT5_MEM
#define RPT5_MEM 0
#endif
    if (IN(5)) { p5_queue<true, true, true>(F, 0);
        if (RPT5_ML || RPT5_NSA || RPT5_MEM) { xcd_barrier(bar); p5_queue<RPT5_ML != 0, RPT5_NSA != 0, RPT5_MEM != 0, MPROBE_ST, MPROBE_DMA, MPROBE_COMP, NPROBE_ST, NPROBE_CMP, NPROBE_SEL, NPROBE_WIN, MLPROBE>(F, 256); } } SEAM(5);
    if (IN(6)) RPT(6) {
        pg8::StaticOrder S; S.init(MT, DM, F.G, F.bx);
        pg8::Gemm g{(const b16*)(ws + WS_H0), (const b16*)(ws + WS_WBR), MT, DM, 1536};
        pg8::EpiMergeK E{(const b16*)(ws + WS_PROJ), (b16*)(ws + WS_R1)};
        pg8::gemm_phase<pg8::EpiMergeK, pg8::StaticOrder, true, true>(F.lds, g, S, E, F.wave);
    } SEAM(6);
    if (IN(7)) RPT(7) {
        pg8::Gemm g{(const b16*)(ws + WS_R1), (const b16*)(ws + WS_WOUT), MT, DM, DM}; pg8::StaticOrder S; S.init(MT, DM, F.G, F.bx);
        pg8::EpiRes E{F.in[I_X], F.out};
        pg8::gemm_phase<pg8::EpiRes, pg8::StaticOrder, true, true>(F.lds, g, S, E, F.wave);
    } SEAM(7);
    if (IN(8)) { p8_router(F, 0); if ((RPT_MASK >> 8) & 1) p8_router(F, 1); } SEAM(8);
    if (IN(9)) { RPT(9) p9_scatter(F); } SEAM(9);
    if (IN(10)) RPT(10) {
        LAS int* pstart = (LAS int*)(F.lds + RING_BYTES + 1024); LAS unsigned char* blk_e = (LAS unsigned char*)(F.lds + RING_BYTES + 1024 + 256);
        const int nblk = moe_tables(F, pstart, blk_e);
        pg8::Gemm8G g{(const unsigned char*)(ws + WS_R1), (const unsigned char*)(ws + WS_WGU), (const int*)(ws + WS_ROUTE + RT_ROWTOK), DM, 0x7f7f7f7f, 0x77777777};
        pg8::MoeOrder<8> S{nblk, F.G, F.bx, (const PG8_LAS unsigned char*)blk_e};
        pg8::EpiSwiglu E{(unsigned char*)(ws + WS_ACT), F.in[I_BGU]};
        pg8::gemm_phase_f8g<pg8::EpiSwiglu, pg8::MoeOrder<8>, true, true>(F.lds, g, S, E, F.wave);
    } SEAM(10);
    if (IN(11)) RPT(11) {
        LAS int* pstart = (LAS int*)(F.lds + RING_BYTES + 1024); LAS unsigned char* blk_e = (LAS unsigned char*)(F.lds + RING_BYTES + 1024 + 256);
        const int nblk = moe_tables(F, pstart, blk_e);
        pg8::Gemm8 g{(const unsigned char*)(ws + WS_ACT), (const unsigned char*)(ws + WS_WDN), CAP, NEXP * DM, DFF, 0x7f7f7f7f, 0x77777777};
        pg8::MoeOrder<4> S{nblk, F.G, F.bx, (const PG8_LAS unsigned char*)blk_e};
        pg8::EpiDown E{(unsigned char*)(ws + WS_APERM), F.in[I_BDN], (const float*)(ws + WS_ROUTE + RT_ROWW)};
        pg8::gemm_phase_f8<pg8::EpiDown, pg8::MoeOrder<4>, true, true>(F.lds, g, S, E, F.wave);
    } SEAM(11);
    if (IN(12)) { p12_combine(F); }
#undef IN
#undef SEAM
}

extern "C" void kernel_launch(void* const* d_in, const int* in_sizes, int n_in, void* d_out, int out_size, void* d_ws, size_t ws_size, hipStream_t stream) {
    static int grid = 0;
    if (grid == 0) {
        if (n_in != N_IN || out_size != MT * DM || ws_size < WS_END) { fprintf(stderr, "kernel_launch: unexpected shapes (n_in %d, out %d, ws %zu need %zu)\n", n_in, out_size, ws_size, (size_t)WS_END); grid = -1; return; }
        int dev = 0, cus = 0, per_cu = 0;
        if (hipGetDevice(&dev) != hipSuccess || hipDeviceGetAttribute(&cus, hipDeviceAttributeMultiprocessorCount, dev) != hipSuccess) { grid = -1; return; }
        if (hipFuncSetAttribute((const void*)fwd_kernel, hipFuncAttributeMaxDynamicSharedMemorySize, LDS_BYTES) != hipSuccess) { fprintf(stderr, "kernel_launch: hipFuncSetAttribute failed\n"); grid = -1; return; }
        if (hipOccupancyMaxActiveBlocksPerMultiprocessor(&per_cu, (const void*)fwd_kernel, NWAVES * 64, LDS_BYTES) != hipSuccess || per_cu < 1) { fprintf(stderr, "kernel_launch: occupancy query says %d\n", per_cu); }
        (void)hipGetLastError();
        grid = cus;
    }
    if (grid < 0) return;
    if (hipMemsetAsync((char*)d_ws + WS_CTL, 0, CTL_ZERO_BYTES, stream) != hipSuccess) return;
    Args a{};
    for (int i = 0; i < N_IN; ++i) a.in[i] = (const float*)d_in[i];
    a.out = (float*)d_out; a.ws = (unsigned char*)d_ws;
#if MK_PER_PHASE
    for (int p = 0; p < N_PHASES; ++p) { a.ph_lo = p; a.ph_hi = p + 1; a.li = 0; hipLaunchKernelGGL(fwd_kernel, dim3(grid), dim3(NWAVES * 64), LDS_BYTES, stream, a); }
#else
    a.ph_lo = 0; a.ph_hi = N_PHASES; a.li = 0;
    hipLaunchKernelGGL(fwd_kernel, dim3(grid), dim3(NWAVES * 64), LDS_BYTES, stream, a);
#endif
}
```

```cpp
#include <hip/hip_runtime.h>
#include <cstdio>
#include <cstdint>
namespace pg8 {
#define PG8_LAS __attribute__((address_space(3)))
typedef unsigned short bf16_t;
typedef short bf16x8 __attribute__((ext_vector_type(8)));
typedef float f32x4 __attribute__((ext_vector_type(4)));
typedef unsigned u32x4 __attribute__((ext_vector_type(4)));
constexpr int BM = 256, BK = 64, HALF = 128, HTB = HALF * BK * 2  , STAGE_BYTES = 8 * HTB, NXCD = 8, WGM = 8;

__host__ __device__ __forceinline__ int lds_byte(int r, int c) { const int st = (r >> 4) * 2 + (c >> 5), rr = r & 15, cc = c & 31, ob = rr * 64 + cc * 2; return st * 1024 + (ob ^ (((ob >> 9) & 1) << 5)); }
__host__ __device__ __forceinline__ void stage_rc(int b, int& R, int& C) { const int st = b / 1024, sb = b % 1024, swz = sb ^ (((sb >> 9) & 1) << 5); R = (st >> 1) * 16 + swz / 64; C = (st & 1) * 32 + (swz % 64) / 2; }
__host__ __device__ __forceinline__ int perm32(int rho) { const int n = rho >> 4, i = rho & 15; return 8 * (i >> 2) + 4 * n + (i & 3); }

struct Unit { int pm, pn; };
struct Gemm { const bf16_t* A; const bf16_t* Bt; int M, N, K; };

struct StaticOrder {
    int nM, nN, nwg, G, c;
    __host__ __device__ void init(int M, int N, int G_, int c_) { nM = M / BM; nN = N / BM; nwg = nM * nN; G = G_; c = c_; }
    __host__ __device__ bool next(int i, Unit& u) const {
        const long L = (long)i * G + c; if (L >= nwg) return false;
        int wgid = (int)L; { const int q = nwg / NXCD, r = nwg % NXCD, xcd = wgid % NXCD, off = wgid / NXCD; wgid = (xcd < r ? xcd * (q + 1) : r * (q + 1) + (xcd - r) * q) + off; }
        const int nig = WGM * nN, gid = wgid / nig, fm = gid * WGM, gsz = (nM - fm) < WGM ? (nM - fm) : WGM;
        u.pm = fm + ((wgid % nig) % gsz); u.pn = (wgid % nig) / gsz; return true;
    }
    __device__ __forceinline__ void a_ready(const Unit&) const {}
    __device__ __forceinline__ void done(const Unit&) const {}
};

__device__ __forceinline__ unsigned cvt_pk_bf16(float lo, float hi) { unsigned r; asm volatile("v_cvt_pk_bf16_f32 %0, %1, %2" : "=v"(r) : "v"(lo), "v"(hi)); return r; }
typedef float f32x2 __attribute__((ext_vector_type(2)));
__device__ __forceinline__ f32x2 gelu_pk(f32x2 v) {
    const f32x2 av = __builtin_elementwise_abs(v), d = av * 0.2316418882f + 1.0f;
    f32x2 t; t.x = __builtin_amdgcn_rcpf(d.x); t.y = __builtin_amdgcn_rcpf(d.y);
    f32x2 q = t * 0.5307027145f + (-0.7265760135f); q = q * t + 0.7107068705f; q = q * t + (-0.142248368f); q = q * t + 0.127414796f; q = q * t;
    const f32x2 s = (v * v) * (-0.72134752044f);
    f32x2 e; e.x = __builtin_amdgcn_exp2f(s.x); e.y = __builtin_amdgcn_exp2f(s.y);
    const f32x2 m = v * (q * e), r = v - m;
    f32x2 o; o.x = v.x < 0.f ? m.x : r.x; o.y = v.y < 0.f ? m.y : r.y; return o;
}

template <int ACT  > struct EpiBf16 {
    static constexpr bool PERM = true, AFTER_DRAIN = false; static_assert(ACT == 0 || ACT == 1, "EpiBf16: ACT is 0 (none) or 1 (gelu_pk)");
    bf16_t* O; int ldc; const float* bias; int split_cols; size_t split_stride; float scale0;
    __device__ __forceinline__ void operator()(const f32x4 (&acc)[2][2][4][2], const Unit& u, int wr, int wc, int fr, int fq) const {
        const int row0 = u.pm * BM + wr * 64 + fr; int colt = u.pn * BM; bf16_t* base = O;
        float sc = 1.f; if (split_cols) { const int t = colt / split_cols; base += (size_t)t * split_stride; colt -= t * split_cols; if (t == 0) sc = scale0; }
        const int col0 = colt + wc * 32 + 8 * fq, bcol0 = u.pn * BM + wc * 32 + 8 * fq;
        f32x4 bv[2][2];
#pragma unroll
        for (int bj = 0; bj < 2; ++bj)
#pragma unroll
            for (int n = 0; n < 2; ++n) bv[bj][n] = bias ? *(const f32x4*)(bias + bcol0 + bj * HALF + 4 * n) : (f32x4){0.f, 0.f, 0.f, 0.f};
#pragma unroll
        for (int ai = 0; ai < 2; ++ai)
#pragma unroll
            for (int m = 0; m < 4; ++m) { bf16_t* rowp = base + (size_t)(row0 + ai * HALF + m * 16) * ldc + col0;
#pragma unroll
                for (int bj = 0; bj < 2; ++bj) { f32x4 v0 = acc[ai][bj][m][0] + bv[bj][0], v1 = acc[ai][bj][m][1] + bv[bj][1];
                    if (ACT == 1) { f32x2 a = gelu_pk((f32x2){v0[0], v0[1]}), b = gelu_pk((f32x2){v0[2], v0[3]}), c = gelu_pk((f32x2){v1[0], v1[1]}), d = gelu_pk((f32x2){v1[2], v1[3]});
                        v0 = (f32x4){a.x, a.y, b.x, b.y}; v1 = (f32x4){c.x, c.y, d.x, d.y}; }
                    v0 = v0 * sc; v1 = v1 * sc; u32x4 w; w.x = cvt_pk_bf16(v0[0], v0[1]); w.y = cvt_pk_bf16(v0[2], v0[3]); w.z = cvt_pk_bf16(v1[0], v1[1]); w.w = cvt_pk_bf16(v1[2], v1[3]);
                    *(u32x4*)(rowp + bj * HALF) = w; } }
    }
};

struct PanelStats {
    unsigned* xbuf;
    unsigned* cnt;
    unsigned* tmo;
    int ntn; float eps;
    unsigned code;
    __device__ __forceinline__ bool run(const f32x4 (&v)[2][2][4][2], const Unit& u, int wr, int wc, int fr, int fq, PG8_LAS unsigned char* lds, int wid, int lane) const {
        typedef float f32x2v __attribute__((ext_vector_type(2)));
        PG8_LAS f32x2v* P = (PG8_LAS f32x2v*)lds;
        PG8_LAS f32x2v* S = (PG8_LAS f32x2v*)(lds + 8192);
        PG8_LAS unsigned* flag = (PG8_LAS unsigned*)(lds + 8192 + 2048);
#pragma unroll
        for (int ai = 0; ai < 2; ++ai)
#pragma unroll
            for (int m = 0; m < 4; ++m) {
                float s = 0.f;
#pragma unroll
                for (int bj = 0; bj < 2; ++bj)
#pragma unroll
                    for (int n = 0; n < 2; ++n) { const f32x4 x = v[ai][bj][m][n]; s += (x[0] + x[1]) + (x[2] + x[3]); }
                s += __shfl_xor(s, 16); s += __shfl_xor(s, 32);
                const float mw = s * (1.0f / 64.0f); float q = 0.f;
#pragma unroll
                for (int bj = 0; bj < 2; ++bj)
#pragma unroll
                    for (int n = 0; n < 2; ++n) { const f32x4 d = v[ai][bj][m][n] - mw; q += (d[0] * d[0] + d[1] * d[1]) + (d[2] * d[2] + d[3] * d[3]); }
                q += __shfl_xor(q, 16); q += __shfl_xor(q, 32);
                if (fq == 0) P[(ai * HALF + wr * 64 + m * 16 + fr) * 4 + wc] = (f32x2v){mw, q};
            }
        asm volatile("s_waitcnt lgkmcnt(0)" ::: "memory"); __builtin_amdgcn_s_barrier(); asm volatile("" ::: "memory");
#if defined(BROKEN_EXCHANGE_NO_WAIT)
#warning BROKEN CONTROL BUILD: the row-statistics exchange does not wait; results are wrong by design
        if (blockIdx.x >= 64) { const long long t0_ = clock64(); while (clock64() - t0_ < 60000) __builtin_amdgcn_s_sleep(8); }
#endif
        const int row = wid * 32 + (lane & 31);
        if (lane < 32) {
            const f32x2v a = P[row * 4 + 0], b = P[row * 4 + 1], c = P[row * 4 + 2], d = P[row * 4 + 3];
            const float mt = (a.x + b.x + c.x + d.x) * 0.25f;
            const float da = a.x - mt, db = b.x - mt, dc = c.x - mt, dd = d.x - mt;
            const float m2 = (a.y + b.y) + (c.y + d.y) + 64.0f * ((da * da + db * db) + (dc * dc + dd * dd));
            unsigned long long* slot = (unsigned long long*)xbuf + ((size_t)(u.pm * BM + row) * 4 + u.pn);
            __hip_atomic_store(slot, ((unsigned long long)__float_as_uint(m2) << 32) | __float_as_uint(mt), __ATOMIC_RELAXED, __HIP_MEMORY_SCOPE_AGENT);
        }
        asm volatile("s_waitcnt vmcnt(0)" ::: "memory");
        if (lane == 0) __hip_atomic_fetch_add(cnt + 64 * u.pm, 1u, __ATOMIC_RELAXED, __HIP_MEMORY_SCOPE_AGENT);
        if (wid == 0) {
            bool dead = false; const unsigned long long t0 = __builtin_amdgcn_s_memrealtime(); const unsigned want = 8u * (unsigned)ntn;
            for (;;) {
#if defined(BROKEN_EXCHANGE_NO_WAIT)
                break;
#endif
                if ((unsigned)__builtin_amdgcn_readfirstlane(__hip_atomic_load(cnt + 64 * u.pm, __ATOMIC_RELAXED, __HIP_MEMORY_SCOPE_AGENT)) >= want) break;
                if (__builtin_amdgcn_s_memrealtime() - t0 > 2000000ull) {
                    if (lane == 0) { unsigned expect = 0u; __hip_atomic_compare_exchange_strong(tmo + 1, &expect, code | (unsigned)(u.pm & 0xff), __ATOMIC_RELAXED, __ATOMIC_RELAXED, __HIP_MEMORY_SCOPE_AGENT);
                                     __hip_atomic_store(tmo, 1u, __ATOMIC_RELAXED, __HIP_MEMORY_SCOPE_AGENT); }
                    dead = true; break; }
                __builtin_amdgcn_s_sleep(2);
            }
            __builtin_amdgcn_fence(__ATOMIC_ACQUIRE, "agent");
            if (lane == 0) flag[0] = dead ? 1u : 0u;
        }
        asm volatile("s_waitcnt vmcnt(0) lgkmcnt(0)" ::: "memory"); __builtin_amdgcn_s_barrier(); asm volatile("" ::: "memory");
        const bool bad = flag[0] != 0u;
        if (lane < 32) {
            const unsigned long long* slot = (const unsigned long long*)xbuf + (size_t)(u.pm * BM + row) * 4; float mt[4], m2[4]; float ms = 0.f;
#pragma unroll
            for (int t = 0; t < 4; ++t) { if (t < ntn) { const unsigned long long w = __hip_atomic_load(slot + t, __ATOMIC_RELAXED, __HIP_MEMORY_SCOPE_AGENT); mt[t] = __uint_as_float((unsigned)w); m2[t] = __uint_as_float((unsigned)(w >> 32)); } else { mt[t] = 0.f; m2[t] = 0.f; } ms += mt[t]; }
            const float mean = ms / (float)ntn; float q = 0.f;
#pragma unroll
            for (int t = 0; t < 4; ++t) if (t < ntn) { const float dm = mt[t] - mean; q += m2[t] + 256.0f * dm * dm; }
            S[row] = (f32x2v){mean, 1.0f / sqrtf(q / (256.0f * (float)ntn) + eps)};
        }
        asm volatile("s_waitcnt lgkmcnt(0)" ::: "memory"); __builtin_amdgcn_s_barrier(); asm volatile("" ::: "memory");
        return bad;
    }
};
struct EpiLnRes {
    static constexpr bool PERM = false, AFTER_DRAIN = true;
    const float* base; float* out; int ldc; const float* bias; PanelStats st; unsigned poison;
    __device__ __forceinline__ void fused(f32x4 (&acc)[2][2][4][2], const Unit& u, int wr, int wc, int fr, int fq, PG8_LAS unsigned char* lds, int wid, int lane) const {
        typedef float f32x2v __attribute__((ext_vector_type(2)));
        const PG8_LAS f32x2v* S = (const PG8_LAS f32x2v*)(lds + 8192);
        const int col0 = u.pn * BM + wc * 32 + 4 * fq;
#pragma unroll
        for (int bj = 0; bj < 2; ++bj)
#pragma unroll
            for (int n = 0; n < 2; ++n) { const f32x4 bv = bias ? *(const f32x4*)(bias + col0 + bj * HALF + n * 16) : (f32x4){0.f, 0.f, 0.f, 0.f};
#pragma unroll
                for (int ai = 0; ai < 2; ++ai)
#pragma unroll
                    for (int m = 0; m < 4; ++m) acc[ai][bj][m][n] += bv; }
        f32x4 pre[4][2][2];
#pragma unroll
        for (int m = 0; m < 4; ++m) { const size_t off = (size_t)(u.pm * BM + wr * 64 + m * 16 + fr) * ldc + col0;
#pragma unroll
            for (int bj = 0; bj < 2; ++bj)
#pragma unroll
                for (int n = 0; n < 2; ++n) pre[m][bj][n] = *(const f32x4*)(base + off + bj * HALF + n * 16); }
        const bool bad = st.run(acc, u, wr, wc, fr, fq, lds, wid, lane) || poison != 0u;
        const float qnan = __builtin_nanf("");
#pragma unroll
        for (int ai = 0; ai < 2; ++ai)
#pragma unroll
            for (int m = 0; m < 4; ++m) { const int r = ai * HALF + wr * 64 + m * 16 + fr; const f32x2v sr = S[r]; const size_t off = (size_t)(u.pm * BM + r) * ldc + col0;
#pragma unroll
                for (int bj = 0; bj < 2; ++bj)
#pragma unroll
                    for (int n = 0; n < 2; ++n) { const f32x4 bs = ai == 0 ? pre[m][bj][n] : *(const f32x4*)(base + off + bj * HALF + n * 16); f32x4 o = bs + (acc[ai][bj][m][n] - sr.x) * sr.y;
                        if (bad) o = (f32x4){qnan, qnan, qnan, qnan}; *(f32x4*)(out + off + bj * HALF + n * 16) = o; }
                if (m & 1) asm volatile("" ::: "memory"); }
    }
};
struct EpiLnResLn {
    static constexpr bool PERM = false, AFTER_DRAIN = true;
    const float* base; float* out; bf16_t* xn; int ldc; const float* bias; PanelStats st1, st2; unsigned poison;
    __device__ __forceinline__ void fused(f32x4 (&acc)[2][2][4][2], const Unit& u, int wr, int wc, int fr, int fq, PG8_LAS unsigned char* lds, int wid, int lane) const {
        typedef float f32x2v __attribute__((ext_vector_type(2))); typedef unsigned u32x2v __attribute__((ext_vector_type(2)));
        const PG8_LAS f32x2v* S = (const PG8_LAS f32x2v*)(lds + 8192);
        const int col0 = u.pn * BM + wc * 32 + 4 * fq;
#pragma unroll
        for (int bj = 0; bj < 2; ++bj)
#pragma unroll
            for (int n = 0; n < 2; ++n) { const f32x4 bv = bias ? *(const f32x4*)(bias + col0 + bj * HALF + n * 16) : (f32x4){0.f, 0.f, 0.f, 0.f};
#pragma unroll
                for (int ai = 0; ai < 2; ++ai)
#pragma unroll
                    for (int m = 0; m < 4; ++m) acc[ai][bj][m][n] += bv; }
        bool bad = st1.run(acc, u, wr, wc, fr, fq, lds, wid, lane) || poison != 0u;
        const float qnan = __builtin_nanf("");
#pragma unroll
        for (int ai = 0; ai < 2; ++ai)
#pragma unroll
            for (int m = 0; m < 4; ++m) { const int r = ai * HALF + wr * 64 + m * 16 + fr; const f32x2v sr = S[r]; const size_t off = (size_t)(u.pm * BM + r) * ldc + col0;
#pragma unroll
                for (int bj = 0; bj < 2; ++bj)
#pragma unroll
                    for (int n = 0; n < 2; ++n) { const f32x4 bs = *(const f32x4*)(base + off + bj * HALF + n * 16); acc[ai][bj][m][n] = bs + (acc[ai][bj][m][n] - sr.x) * sr.y; }
                asm volatile("" : "+v"(acc[ai][0][m][0]), "+v"(acc[ai][0][m][1]), "+v"(acc[ai][1][m][0]), "+v"(acc[ai][1][m][1]));
                if (m & 1) asm volatile("" ::: "memory"); }
        const bool bad1 = bad;
        bad = st2.run(acc, u, wr, wc, fr, fq, lds, wid, lane) || bad;
#pragma unroll
        for (int ai = 0; ai < 2; ++ai)
#pragma unroll
            for (int m = 0; m < 4; ++m) { const int r = ai * HALF + wr * 64 + m * 16 + fr; const f32x2v sr = S[r]; const size_t off = (size_t)(u.pm * BM + r) * ldc + col0;
#pragma unroll
                for (int bj = 0; bj < 2; ++bj)
#pragma unroll
                    for (int n = 0; n < 2; ++n) { const f32x4 x1 = acc[ai][bj][m][n]; *(f32x4*)(out + off + bj * HALF + n * 16) = bad1 ? (f32x4){qnan, qnan, qnan, qnan} : x1;
                        const f32x4 o = (x1 - sr.x) * sr.y; u32x2v w; w.x = cvt_pk_bf16(o[0], o[1]); w.y = cvt_pk_bf16(o[2], o[3]);
                        if (bad) { w.x = 0x7fc07fc0u; w.y = 0x7fc07fc0u; } *(u32x2v*)(xn + off + bj * HALF + n * 16) = w; }
                asm volatile("" ::: "memory"); }
    }
};

template <class E, class = void> struct Perm2 { static constexpr bool v = false; };
template <class E> struct Perm2<E, decltype((void)E::PERM2)> { static constexpr bool v = E::PERM2; };
template <class E, class = void> struct MidSeg { static constexpr int v = 0; };
template <class E> struct MidSeg<E, decltype((void)E::MIDSEG)> { static constexpr int v = E::MIDSEG; };
template <class Epi, class Sched, bool ALIGN_EPI = false, bool SP2 = false>
__device__ __forceinline__ void gemm_phase(PG8_LAS unsigned char* lds, const Gemm g, const Sched& S, const Epi& E, int wid_in) {
    int lane_; asm volatile("v_mbcnt_lo_u32_b32 %0, -1, 0\n\tv_mbcnt_hi_u32_b32 %0, -1, %0" : "=v"(lane_));
    const int wid = wid_in, lane = lane_, tid = wid * 64 + lane, wr = wid >> 2, wc = wid & 3, fr = lane & 15, fq = lane >> 4;
    const int K = g.K, nt = K / BK;
    unsigned voffA[2], voffB[2];
#pragma unroll
    for (int i = 0; i < 2; ++i) { int R, C; stage_rc(tid * 16 + i * 8192, R, C); const int Rb = Perm2<Epi>::v ? (64 * (R >> 5) + 16 * ((R >> 2) & 3) + 4 * ((R >> 4) & 1) + (R & 3)) : Epi::PERM ? ((R & ~31) + perm32(R & 31)) : R;
        voffA[i] = (unsigned)(R * K + C) * 2u; voffB[i] = (unsigned)(Rb * K + C) * 2u; }
    const size_t kstep = (size_t)(BK * 2);
    const size_t hstep = (size_t)HALF * K * 2;
    const size_t hstepB = Perm2<Epi>::v ? (size_t)8 * K * 2 : hstep;
    const size_t tstep = 2 * hstep;
    const unsigned ldsw = (unsigned)wid * 1024u;
    const int aoff = lds_byte(wr * 64 + fr, fq * 8), boff = lds_byte(wc * 32 + fr, fq * 8);
#define PG8_SA(b, h) (((b) * 2 + (h)) * HTB)
#define PG8_SB(b, h) ((4 + (b) * 2 + (h)) * HTB)
#define PG8_STAGE(bufoff, gbase, voff) do { _Pragma("unroll") for (int _i = 0; _i < 2; ++_i) \
        __builtin_amdgcn_global_load_lds((const unsigned*)((const char*)(gbase) + (voff)[_i]), (PG8_LAS unsigned*)(lds + (bufoff) + ldsw + _i * 8192), 16, 0, 0); } while (0)
#define PG8_LDA(dst, b, h) do { _Pragma("unroll") for (int m = 0; m < 4; ++m) _Pragma("unroll") for (int k = 0; k < 2; ++k) dst[m][k] = *(const PG8_LAS bf16x8*)(lds + PG8_SA(b, h) + aoff + m * 2048 + k * 1024); } while (0)
#define PG8_LDB(dst, b, h) do { _Pragma("unroll") for (int n = 0; n < 2; ++n) _Pragma("unroll") for (int k = 0; k < 2; ++k) dst[n][k] = *(const PG8_LAS bf16x8*)(lds + PG8_SB(b, h) + boff + n * 2048 + k * 1024); } while (0)
#define PG8_MMA(ai, bj, At, Bt) do { __builtin_amdgcn_s_setprio(1); _Pragma("unroll") for (int m = 0; m < 4; ++m) _Pragma("unroll") for (int n = 0; n < 2; ++n) _Pragma("unroll") for (int k = 0; k < 2; ++k) \
        acc[ai][bj][m][n] = __builtin_amdgcn_mfma_f32_16x16x32_bf16(Bt[n][k], At[m][k], acc[ai][bj][m][n], 0, 0, 0); __builtin_amdgcn_s_setprio(0); } while (0)
#define PG8_WAIT_V(n) asm volatile("s_waitcnt vmcnt(" #n ")" ::: "memory")
#define PG8_WAIT_L(n) asm volatile("s_waitcnt lgkmcnt(" #n ")" ::: "memory")
#define PG8_BAR __builtin_amdgcn_s_barrier()
#define PG8_SCHED __builtin_amdgcn_sched_barrier(0)
    Unit cur, nxt; int ui = 0;
    if (!S.next(0, cur)) return;
    f32x4 acc[2][2][4][2];
#pragma unroll
    for (int a = 0; a < 2; ++a)
#pragma unroll
        for (int b = 0; b < 2; ++b)
#pragma unroll
            for (int m = 0; m < 4; ++m)
#pragma unroll
                for (int n = 0; n < 2; ++n) acc[a][b][m][n] = (f32x4){0.f, 0.f, 0.f, 0.f};
    bf16x8 At[4][2], B0[2][2], B1[2][2];
    const char* cA = (const char*)g.A + (size_t)cur.pm * tstep; const char* cB = (const char*)g.Bt + (size_t)cur.pn * tstep;
    S.a_ready(cur);
    if constexpr (SP2) {
        PG8_STAGE(PG8_SB(0, 0), cB, voffB); PG8_STAGE(PG8_SB(0, 1), cB + hstepB, voffB); PG8_STAGE(PG8_SA(0, 0), cA, voffA); PG8_STAGE(PG8_SA(0, 1), cA + hstep, voffA);
        if (wr == 1) PG8_BAR;
        PG8_WAIT_V(2); PG8_BAR;
        PG8_STAGE(PG8_SB(1, 0), cB + kstep, voffB); PG8_STAGE(PG8_SA(1, 0), cA + kstep, voffA); PG8_STAGE(PG8_SB(1, 1), cB + hstepB + kstep, voffB);
        PG8_WAIT_V(6); PG8_BAR;
    } else {
        PG8_STAGE(PG8_SB(0, 0), cB, voffB); PG8_STAGE(PG8_SA(0, 0), cA, voffA); PG8_STAGE(PG8_SB(0, 1), cB + hstepB, voffB); PG8_STAGE(PG8_SA(0, 1), cA + hstep, voffA);
        if (wr == 1) PG8_BAR;
        PG8_WAIT_V(4); PG8_BAR;
        PG8_STAGE(PG8_SB(1, 0), cB + kstep, voffB); PG8_STAGE(PG8_SA(1, 0), cA + kstep, voffA); PG8_STAGE(PG8_SB(1, 1), cB + hstepB + kstep, voffB);
        PG8_WAIT_V(6); PG8_BAR;
    }
    for (;;) {
        const bool has_next = S.next(ui + 1, nxt);
        const char* nA = has_next ? (const char*)g.A + (size_t)nxt.pm * tstep : cA; const char* nB = has_next ? (const char*)g.Bt + (size_t)nxt.pn * tstep : cB;
        for (int t = 0; t < nt; t += 2) {
            if constexpr (MidSeg<Epi>::v > 0) { if (t > 0 && t % MidSeg<Epi>::v == 0) E.mid(acc, cur, t / MidSeg<Epi>::v, wr, wc, fr, fq); }
            const bool last = (t == nt - 2);
            const char* a1 = cA + (size_t)(t + 1) * kstep;
            const char* a2 = last ? nA : cA + (size_t)(t + 2) * kstep; const char* b2 = last ? nB : cB + (size_t)(t + 2) * kstep;
            const char* a3 = a2 + kstep; const char* b3 = b2 + kstep;
            if (last && has_next) S.a_ready(nxt);
            if constexpr (SP2) {
            PG8_LDB(B0, 0, 0); PG8_LDB(B1, 0, 1); PG8_SCHED; PG8_LDA(At, 0, 0); PG8_STAGE(PG8_SA(1, 1), a1 + hstep, voffA);
            PG8_WAIT_V(8); PG8_WAIT_L(0); PG8_BAR; PG8_MMA(0, 0, At, B0); PG8_MMA(0, 1, At, B1); PG8_BAR; PG8_SCHED;
            PG8_LDA(At, 0, 1); PG8_STAGE(PG8_SB(0, 0), b2, voffB); PG8_STAGE(PG8_SB(0, 1), b2 + hstepB, voffB); PG8_STAGE(PG8_SA(0, 0), a2, voffA);
            PG8_WAIT_V(8); PG8_WAIT_L(0); PG8_BAR; PG8_MMA(1, 0, At, B0); PG8_MMA(1, 1, At, B1); PG8_BAR; PG8_SCHED;
            PG8_LDB(B0, 1, 0); PG8_LDB(B1, 1, 1); PG8_SCHED; PG8_LDA(At, 1, 0); PG8_STAGE(PG8_SA(0, 1), a2 + hstep, voffA);
            PG8_WAIT_V(8); PG8_WAIT_L(0); PG8_BAR; PG8_MMA(0, 0, At, B0); PG8_MMA(0, 1, At, B1); PG8_BAR; PG8_SCHED;
            PG8_LDA(At, 1, 1); PG8_STAGE(PG8_SB(1, 0), b3, voffB); PG8_STAGE(PG8_SB(1, 1), b3 + hstepB, voffB); PG8_STAGE(PG8_SA(1, 0), a3, voffA);
            PG8_WAIT_V(8); PG8_WAIT_L(0); PG8_BAR; PG8_MMA(1, 0, At, B0); PG8_MMA(1, 1, At, B1); PG8_BAR; PG8_SCHED;
            } else {
            PG8_LDB(B0, 0, 0); PG8_SCHED; PG8_LDA(At, 0, 0); PG8_STAGE(PG8_SA(1, 1), a1 + hstep, voffA);
            PG8_WAIT_L(8); PG8_BAR; PG8_WAIT_L(0); PG8_MMA(0, 0, At, B0); PG8_BAR; PG8_SCHED;
            PG8_LDB(B1, 0, 1); PG8_STAGE(PG8_SB(0, 0), b2, voffB);
            PG8_BAR; PG8_WAIT_L(0); PG8_MMA(0, 1, At, B1); PG8_BAR;
            PG8_LDA(At, 0, 1); PG8_STAGE(PG8_SA(0, 0), a2, voffA);
            PG8_BAR; PG8_WAIT_L(0); PG8_MMA(1, 0, At, B0); PG8_BAR; PG8_SCHED;
            PG8_STAGE(PG8_SB(0, 1), b2 + hstepB, voffB);
            PG8_WAIT_V(6); PG8_BAR; PG8_MMA(1, 1, At, B1); PG8_BAR;
            PG8_LDB(B0, 1, 0); PG8_SCHED; PG8_LDA(At, 1, 0); PG8_STAGE(PG8_SA(0, 1), a2 + hstep, voffA);
            PG8_WAIT_L(8); PG8_BAR; PG8_WAIT_L(0); PG8_MMA(0, 0, At, B0); PG8_BAR; PG8_SCHED;
            PG8_LDB(B1, 1, 1); PG8_STAGE(PG8_SB(1, 0), b3, voffB);
            PG8_BAR; PG8_WAIT_L(0); PG8_MMA(0, 1, At, B1); PG8_BAR;
            PG8_LDA(At, 1, 1); PG8_STAGE(PG8_SA(1, 0), a3, voffA);
            PG8_BAR; PG8_WAIT_L(0); PG8_MMA(1, 0, At, B0); PG8_BAR; PG8_SCHED;
            PG8_STAGE(PG8_SB(1, 1), b3 + hstepB, voffB);
            PG8_WAIT_V(6); PG8_BAR; PG8_MMA(1, 1, At, B1); PG8_BAR;
            }
        }
        if constexpr (ALIGN_EPI) { if (wr == 0) PG8_BAR; }
        if constexpr (!Epi::AFTER_DRAIN) { E(acc, cur, wr, wc, fr, fq); S.done(cur); }
        if (!has_next) break;
#pragma unroll
        for (int a = 0; a < 2; ++a)
#pragma unroll
            for (int b = 0; b < 2; ++b)
#pragma unroll
                for (int m = 0; m < 4; ++m)
#pragma unroll
                    for (int n = 0; n < 2; ++n) acc[a][b][m][n] = (f32x4){0.f, 0.f, 0.f, 0.f};
        cur = nxt; cA = nA; cB = nB; ++ui;
        if constexpr (ALIGN_EPI) { if (wr == 1) PG8_BAR; }
    }
    PG8_WAIT_V(0);
    if constexpr (!ALIGN_EPI) { if (wr == 0) PG8_BAR; }
    PG8_BAR;
    if constexpr (Epi::AFTER_DRAIN) { E.fused(acc, cur, wr, wc, fr, fq, lds, wid, lane); S.done(cur); }
#undef PG8_SA
#undef PG8_SB
#undef PG8_STAGE
#undef PG8_LDA
#undef PG8_LDB
#undef PG8_MMA
#undef PG8_WAIT_V
#undef PG8_WAIT_L
#undef PG8_BAR
#undef PG8_SCHED
}
}
namespace pg8 {
struct Gemm8 { const unsigned char* A; const unsigned char* Bt; int M, N, K; int scale_a, scale_b; };
template <class Epi, class Sched, bool ALIGN_EPI = false, bool SP2 = false>
__device__ __forceinline__ void gemm_phase_f8(PG8_LAS unsigned char* lds, const Gemm8 g, const Sched& S, const Epi& E, int wid_in) {
    int lane_; asm volatile("v_mbcnt_lo_u32_b32 %0, -1, 0\n\tv_mbcnt_hi_u32_b32 %0, -1, %0" : "=v"(lane_));
    const int wid = wid_in, lane = lane_, tid = wid * 64 + lane, wr = wid >> 2, wc = wid & 3, fr = lane & 15, fq = lane >> 4;
    const int K = g.K, nt = K / 128;
    unsigned voffA[2], voffB[2];
#pragma unroll
    for (int i = 0; i < 2; ++i) { int R, C; stage_rc(tid * 16 + i * 8192, R, C); const int Rb = Perm2<Epi>::v ? (64 * (R >> 5) + 16 * ((R >> 2) & 3) + 4 * ((R >> 4) & 1) + (R & 3)) : Epi::PERM ? ((R & ~31) + perm32(R & 31)) : R;
        voffA[i] = (unsigned)(R * K + 2 * C); voffB[i] = (unsigned)(Rb * K + 2 * C); }
    const size_t kstep = (size_t)(BK * 2);
    const size_t hstep = (size_t)HALF * K;
    const size_t hstepB = Perm2<Epi>::v ? (size_t)8 * K : hstep;
    const size_t tstep = 2 * hstep;
    const unsigned ldsw = (unsigned)wid * 1024u;
    const int aoff = lds_byte(wr * 64 + fr, fq * 16), boff = lds_byte(wc * 32 + fr, fq * 16);
#define PG8_SA(b, h) (((b) * 2 + (h)) * HTB)
#define PG8_SB(b, h) ((4 + (b) * 2 + (h)) * HTB)
#define PG8_STAGE(bufoff, gbase, voff) do { _Pragma("unroll") for (int _i = 0; _i < 2; ++_i) { unsigned keep_; \
        asm volatile("s_mov_b32 %0, m0\n\ts_mov_b32 m0, %3\n\ts_nop 0\n\tglobal_load_lds_dwordx4 %1, %2\n\ts_mov_b32 m0, %0" : "=&s"(keep_) : "v"((voff)[_i]), "s"((const char*)(gbase)), "s"((unsigned)(size_t)(lds + (bufoff) + ldsw + _i * 8192)) : "memory"); } } while (0)
#define PG8_LDA(dst, b, h) do { _Pragma("unroll") for (int m = 0; m < 4; ++m) { const u32x4 lo_ = *(const PG8_LAS u32x4*)(lds + PG8_SA(b, h) + aoff + m * 2048), hi_ = *(const PG8_LAS u32x4*)(lds + PG8_SA(b, h) + aoff + m * 2048 + 16); dst[m] = __builtin_bit_cast(i32x8, __builtin_shufflevector(lo_, hi_, 0, 1, 2, 3, 4, 5, 6, 7)); } } while (0)
#define PG8_LDB(dst, b, h) do { _Pragma("unroll") for (int n = 0; n < 2; ++n) { const u32x4 lo_ = *(const PG8_LAS u32x4*)(lds + PG8_SB(b, h) + boff + n * 2048), hi_ = *(const PG8_LAS u32x4*)(lds + PG8_SB(b, h) + boff + n * 2048 + 16); dst[n] = __builtin_bit_cast(i32x8, __builtin_shufflevector(lo_, hi_, 0, 1, 2, 3, 4, 5, 6, 7)); } } while (0)
#define PG8_MMA(ai, bj, At, Bt) do { __builtin_amdgcn_s_setprio(1); _Pragma("unroll") for (int m = 0; m < 4; ++m) _Pragma("unroll") for (int n = 0; n < 2; ++n) \
        acc[ai][bj][m][n] = __builtin_amdgcn_mfma_scale_f32_16x16x128_f8f6f4(Bt[n], At[m], acc[ai][bj][m][n], 0, 0, 0, g.scale_b, 0, g.scale_a); __builtin_amdgcn_s_setprio(0); } while (0)
#define PG8_WAIT_V(n) asm volatile("s_waitcnt vmcnt(" #n ")" ::: "memory")
#define PG8_WAIT_L(n) asm volatile("s_waitcnt lgkmcnt(" #n ")" ::: "memory")
#define PG8_BAR __builtin_amdgcn_s_barrier()
#define PG8_SCHED __builtin_amdgcn_sched_barrier(0)
    Unit cur, nxt; int ui = 0;
    if (!S.next(0, cur)) return;
    f32x4 acc[2][2][4][2];
#pragma unroll
    for (int a = 0; a < 2; ++a)
#pragma unroll
        for (int b = 0; b < 2; ++b)
#pragma unroll
            for (int m = 0; m < 4; ++m)
#pragma unroll
                for (int n = 0; n < 2; ++n) acc[a][b][m][n] = (f32x4){0.f, 0.f, 0.f, 0.f};
    typedef int i32x8 __attribute__((ext_vector_type(8))); i32x8 At[4], B0[2], B1[2];
    const char* cA = (const char*)g.A + (size_t)cur.pm * tstep; const char* cB = (const char*)g.Bt + (size_t)cur.pn * tstep;
    S.a_ready(cur);
    if constexpr (SP2) {
        PG8_STAGE(PG8_SB(0, 0), cB, voffB); PG8_STAGE(PG8_SB(0, 1), cB + hstepB, voffB); PG8_STAGE(PG8_SA(0, 0), cA, voffA); PG8_STAGE(PG8_SA(0, 1), cA + hstep, voffA);
        if (wr == 1) PG8_BAR;
        PG8_WAIT_V(2); PG8_BAR;
        PG8_STAGE(PG8_SB(1, 0), cB + kstep, voffB); PG8_STAGE(PG8_SA(1, 0), cA + kstep, voffA); PG8_STAGE(PG8_SB(1, 1), cB + hstepB + kstep, voffB);
        PG8_WAIT_V(6); PG8_BAR;
    } else {
        PG8_STAGE(PG8_SB(0, 0), cB, voffB); PG8_STAGE(PG8_SA(0, 0), cA, voffA); PG8_STAGE(PG8_SB(0, 1), cB + hstepB, voffB); PG8_STAGE(PG8_SA(0, 1), cA + hstep, voffA);
        if (wr == 1) PG8_BAR;
        PG8_WAIT_V(4); PG8_BAR;
        PG8_STAGE(PG8_SB(1, 0), cB + kstep, voffB); PG8_STAGE(PG8_SA(1, 0), cA + kstep, voffA); PG8_STAGE(PG8_SB(1, 1), cB + hstepB + kstep, voffB);
        PG8_WAIT_V(6); PG8_BAR;
    }
    for (;;) {
        const bool has_next = S.next(ui + 1, nxt);
        const char* nA = has_next ? (const char*)g.A + (size_t)nxt.pm * tstep : cA; const char* nB = has_next ? (const char*)g.Bt + (size_t)nxt.pn * tstep : cB;
#pragma unroll 1
        for (int t = 0; t < nt; t += 2) {
            const bool last = (t == nt - 2);
            const char* a1 = cA + (size_t)(t + 1) * kstep;
            const char* a2 = last ? nA : cA + (size_t)(t + 2) * kstep; const char* b2 = last ? nB : cB + (size_t)(t + 2) * kstep;
            const char* a3 = a2 + kstep; const char* b3 = b2 + kstep;
            if (last && has_next) S.a_ready(nxt);
            if constexpr (SP2) {
            PG8_LDB(B0, 0, 0); PG8_LDB(B1, 0, 1); PG8_SCHED; PG8_LDA(At, 0, 0); PG8_STAGE(PG8_SA(1, 1), a1 + hstep, voffA);
            PG8_WAIT_V(8); PG8_WAIT_L(0); PG8_BAR; PG8_MMA(0, 0, At, B0); PG8_MMA(0, 1, At, B1); PG8_BAR; PG8_SCHED;
            PG8_LDA(At, 0, 1); PG8_STAGE(PG8_SB(0, 0), b2, voffB); PG8_STAGE(PG8_SB(0, 1), b2 + hstepB, voffB); PG8_STAGE(PG8_SA(0, 0), a2, voffA);
            PG8_WAIT_V(8); PG8_WAIT_L(0); PG8_BAR; PG8_MMA(1, 0, At, B0); PG8_MMA(1, 1, At, B1); PG8_BAR; PG8_SCHED;
            PG8_LDB(B0, 1, 0); PG8_LDB(B1, 1, 1); PG8_SCHED; PG8_LDA(At, 1, 0); PG8_STAGE(PG8_SA(0, 1), a2 + hstep, voffA);
            PG8_WAIT_V(8); PG8_WAIT_L(0); PG8_BAR; PG8_MMA(0, 0, At, B0); PG8_MMA(0, 1, At, B1); PG8_BAR; PG8_SCHED;
            PG8_LDA(At, 1, 1); PG8_STAGE(PG8_SB(1, 0), b3, voffB); PG8_STAGE(PG8_SB(1, 1), b3 + hstepB, voffB); PG8_STAGE(PG8_SA(1, 0), a3, voffA);
            PG8_WAIT_V(8); PG8_WAIT_L(0); PG8_BAR; PG8_MMA(1, 0, At, B0); PG8_MMA(1, 1, At, B1); PG8_BAR; PG8_SCHED;
            } else {
            PG8_LDB(B0, 0, 0); PG8_SCHED; PG8_LDA(At, 0, 0); PG8_STAGE(PG8_SA(1, 1), a1 + hstep, voffA);
            PG8_WAIT_L(8); PG8_BAR; PG8_WAIT_L(0); PG8_MMA(0, 0, At, B0); PG8_BAR; PG8_SCHED;
            PG8_LDB(B1, 0, 1); PG8_STAGE(PG8_SB(0, 0), b2, voffB);
            PG8_BAR; PG8_WAIT_L(0); PG8_MMA(0, 1, At, B1); PG8_BAR;
            PG8_LDA(At, 0, 1); PG8_STAGE(PG8_SA(0, 0), a2, voffA);
            PG8_BAR; PG8_WAIT_L(0); PG8_MMA(1, 0, At, B0); PG8_BAR; PG8_SCHED;
            PG8_STAGE(PG8_SB(0, 1), b2 + hstepB, voffB);
            PG8_WAIT_V(6); PG8_BAR; PG8_MMA(1, 1, At, B1); PG8_BAR;
            PG8_LDB(B0, 1, 0); PG8_SCHED; PG8_LDA(At, 1, 0); PG8_STAGE(PG8_SA(0, 1), a2 + hstep, voffA);
            PG8_WAIT_L(8); PG8_BAR; PG8_WAIT_L(0); PG8_MMA(0, 0, At, B0); PG8_BAR; PG8_SCHED;
            PG8_LDB(B1, 1, 1); PG8_STAGE(PG8_SB(1, 0), b3, voffB);
            PG8_BAR; PG8_WAIT_L(0); PG8_MMA(0, 1, At, B1); PG8_BAR;
            PG8_LDA(At, 1, 1); PG8_STAGE(PG8_SA(1, 0), a3, voffA);
            PG8_BAR; PG8_WAIT_L(0); PG8_MMA(1, 0, At, B0); PG8_BAR; PG8_SCHED;
            PG8_STAGE(PG8_SB(1, 1), b3 + hstepB, voffB);
            PG8_WAIT_V(6); PG8_BAR; PG8_MMA(1, 1, At, B1); PG8_BAR;
            }
        }
        if constexpr (ALIGN_EPI) { if (wr == 0) PG8_BAR; }
        if constexpr (!Epi::AFTER_DRAIN) { int l2_; asm volatile("v_mbcnt_lo_u32_b32 %0, -1, 0\n\tv_mbcnt_hi_u32_b32 %0, -1, %0" : "=v"(l2_));
            E(acc, cur, wr, wc, l2_ & 15, l2_ >> 4); S.done(cur); }
        if (!has_next) break;
#pragma unroll
        for (int a = 0; a < 2; ++a)
#pragma unroll
            for (int b = 0; b < 2; ++b)
#pragma unroll
                for (int m = 0; m < 4; ++m)
#pragma unroll
                    for (int n = 0; n < 2; ++n) acc[a][b][m][n] = (f32x4){0.f, 0.f, 0.f, 0.f};
        cur = nxt; cA = nA; cB = nB; ++ui;
        if constexpr (ALIGN_EPI) { if (wr == 1) PG8_BAR; }
    }
    PG8_WAIT_V(0);
    if constexpr (!ALIGN_EPI) { if (wr == 0) PG8_BAR; }
    PG8_BAR;
    if constexpr (Epi::AFTER_DRAIN) { E.fused(acc, cur, wr, wc, fr, fq, lds, wid, lane); S.done(cur); }
#undef PG8_SA
#undef PG8_SB
#undef PG8_STAGE
#undef PG8_LDA
#undef PG8_LDB
#undef PG8_MMA
#undef PG8_WAIT_V
#undef PG8_WAIT_L
#undef PG8_BAR
#undef PG8_SCHED
}
}
namespace pg8 {
struct Gemm8G { const unsigned char* A; const unsigned char* Bt; const int* rowtok; int K; int scale_a, scale_b; };
template <class Epi, class Sched, bool ALIGN_EPI = false, bool SP2 = false>
__device__ __forceinline__ void gemm_phase_f8g(PG8_LAS unsigned char* lds, const Gemm8G g, const Sched& S, const Epi& E, int wid_in) {
    int lane_; asm volatile("v_mbcnt_lo_u32_b32 %0, -1, 0\n\tv_mbcnt_hi_u32_b32 %0, -1, %0" : "=v"(lane_));
    const int wid = wid_in, lane = lane_, tid = wid * 64 + lane, wr = wid >> 2, wc = wid & 3, fr = lane & 15, fq = lane >> 4;
    const int K = g.K, nt = K / 128;
    unsigned va[4], voffB0; int R0_, C0_;
    { int R, C; stage_rc(tid * 16, R, C); R0_ = R; C0_ = C; const int Rb = Perm2<Epi>::v ? (64 * (R >> 5) + 16 * ((R >> 2) & 3) + 4 * ((R >> 4) & 1) + (R & 3)) : Epi::PERM ? ((R & ~31) + perm32(R & 31)) : R;
      voffB0 = (unsigned)(Rb * K + 2 * C); }
    const size_t bstep1 = (size_t)(Perm2<Epi>::v ? 128 : 64) * K;
    PG8_LAS unsigned* tab = (PG8_LAS unsigned*)(lds + 135424);
    const size_t kstep = (size_t)(BK * 2);
    const size_t hstep = (size_t)HALF * K;
    const size_t hstepB = Perm2<Epi>::v ? (size_t)8 * K : hstep;
    const size_t tstep = 2 * hstep;
    const unsigned ldsw = (unsigned)wid * 1024u;
    const int aoff = lds_byte(wr * 64 + fr, fq * 16), boff = lds_byte(wc * 32 + fr, fq * 16);
#define PG8_SA(b, h) (((b) * 2 + (h)) * HTB)
#define PG8_SB(b, h) ((4 + (b) * 2 + (h)) * HTB)
#define PG8_GL(vo, sb, ldsaddr) do { unsigned keep_; asm volatile("s_mov_b32 %0, m0\n\ts_mov_b32 m0, %3\n\ts_nop 0\n\tglobal_load_lds_dwordx4 %1, %2\n\ts_mov_b32 m0, %0" : "=&s"(keep_) : "v"(vo), "s"((const char*)(sb)), "s"((unsigned)(size_t)(ldsaddr)) : "memory"); } while (0)
#define PG8_STAGE_B(bufoff, gbase) do { PG8_GL(voffB0, (gbase), lds + (bufoff) + ldsw); PG8_GL(voffB0, (gbase) + bstep1, lds + (bufoff) + ldsw + 8192); } while (0)
#define PG8_STAGE_A(bufoff, kbase, h) do { PG8_GL(va[2 * (h)], (kbase), lds + (bufoff) + ldsw); PG8_GL(va[2 * (h) + 1], (kbase), lds + (bufoff) + ldsw + 8192); } while (0)
#define PG8_LOADVA(slot) do { _Pragma("unroll") for (int h_ = 0; h_ < 2; ++h_) _Pragma("unroll") for (int i_ = 0; i_ < 2; ++i_) va[2 * h_ + i_] = tab[(slot) * 256 + h_ * 128 + R0_ + 64 * i_] * (unsigned)K + 2u * (unsigned)C0_; } while (0)
#define PG8_LDA(dst, b, h) do { _Pragma("unroll") for (int m = 0; m < 4; ++m) { const u32x4 lo_ = *(const PG8_LAS u32x4*)(lds + PG8_SA(b, h) + aoff + m * 2048), hi_ = *(const PG8_LAS u32x4*)(lds + PG8_SA(b, h) + aoff + m * 2048 + 16); dst[m] = __builtin_bit_cast(i32x8, __builtin_shufflevector(lo_, hi_, 0, 1, 2, 3, 4, 5, 6, 7)); } } while (0)
#define PG8_LDB(dst, b, h) do { _Pragma("unroll") for (int n = 0; n < 2; ++n) { const u32x4 lo_ = *(const PG8_LAS u32x4*)(lds + PG8_SB(b, h) + boff + n * 2048), hi_ = *(const PG8_LAS u32x4*)(lds + PG8_SB(b, h) + boff + n * 2048 + 16); dst[n] = __builtin_bit_cast(i32x8, __builtin_shufflevector(lo_, hi_, 0, 1, 2, 3, 4, 5, 6, 7)); } } while (0)
#define PG8_MMA(ai, bj, At, Bt) do { __builtin_amdgcn_s_setprio(1); _Pragma("unroll") for (int m = 0; m < 4; ++m) _Pragma("unroll") for (int n = 0; n < 2; ++n) \
        acc[ai][bj][m][n] = __builtin_amdgcn_mfma_scale_f32_16x16x128_f8f6f4(Bt[n], At[m], acc[ai][bj][m][n], 0, 0, 0, g.scale_b, 0, g.scale_a); __builtin_amdgcn_s_setprio(0); } while (0)
#define PG8_WAIT_V(n) asm volatile("s_waitcnt vmcnt(" #n ")" ::: "memory")
#define PG8_WAIT_L(n) asm volatile("s_waitcnt lgkmcnt(" #n ")" ::: "memory")
#define PG8_BAR __builtin_amdgcn_s_barrier()
#define PG8_SCHED __builtin_amdgcn_sched_barrier(0)
    Unit cur, nxt; int ui = 0;
    if (!S.next(0, cur)) return;
    f32x4 acc[2][2][4][2];
#pragma unroll
    for (int a = 0; a < 2; ++a)
#pragma unroll
        for (int b = 0; b < 2; ++b)
#pragma unroll
            for (int m = 0; m < 4; ++m)
#pragma unroll
                for (int n = 0; n < 2; ++n) acc[a][b][m][n] = (f32x4){0.f, 0.f, 0.f, 0.f};
    typedef int i32x8 __attribute__((ext_vector_type(8))); i32x8 At[4], B0[2], B1[2];
    const char* aB = (const char*)g.A; const char* cB = (const char*)g.Bt + (size_t)cur.pn * tstep;
    S.a_ready(cur);
    { if (tid < 256) {
#pragma unroll 1
        for (int u_ = 0; u_ < 17; ++u_) { Unit t_; if (!S.next(u_, t_)) break; tab[u_ * 256 + tid] = (unsigned)g.rowtok[t_.pm * 256 + tid]; } }
      asm volatile("s_waitcnt vmcnt(0) lgkmcnt(0)" ::: "memory"); PG8_BAR; asm volatile("" ::: "memory");
      PG8_LOADVA(0); }
    if constexpr (SP2) {
        PG8_STAGE_B(PG8_SB(0, 0), cB); PG8_STAGE_B(PG8_SB(0, 1), cB + hstepB); PG8_STAGE_A(PG8_SA(0, 0), aB, 0); PG8_STAGE_A(PG8_SA(0, 1), aB, 1);
        if (wr == 1) PG8_BAR;
        PG8_WAIT_V(2); PG8_BAR;
        PG8_STAGE_B(PG8_SB(1, 0), cB + kstep); PG8_STAGE_A(PG8_SA(1, 0), aB + kstep, 0); PG8_STAGE_B(PG8_SB(1, 1), cB + hstepB + kstep);
        PG8_WAIT_V(6); PG8_BAR;
    } else {
        PG8_STAGE_B(PG8_SB(0, 0), cB); PG8_STAGE_A(PG8_SA(0, 0), aB, 0); PG8_STAGE_B(PG8_SB(0, 1), cB + hstepB); PG8_STAGE_A(PG8_SA(0, 1), aB, 1);
        if (wr == 1) PG8_BAR;
        PG8_WAIT_V(4); PG8_BAR;
        PG8_STAGE_B(PG8_SB(1, 0), cB + kstep); PG8_STAGE_A(PG8_SA(1, 0), aB + kstep, 0); PG8_STAGE_B(PG8_SB(1, 1), cB + hstepB + kstep);
        PG8_WAIT_V(6); PG8_BAR;
    }
    for (;;) {
        const bool has_next = S.next(ui + 1, nxt);
        const char* nB = has_next ? (const char*)g.Bt + (size_t)nxt.pn * tstep : cB;
#pragma unroll 1
        for (int t = 0; t < nt; t += 2) {
            const bool last = (t == nt - 2);
            const char* a1 = aB + (size_t)(t + 1) * kstep;
            const char* a2 = last ? aB : aB + (size_t)(t + 2) * kstep; const char* b2 = last ? nB : cB + (size_t)(t + 2) * kstep;
            const char* a3 = a2 + kstep; const char* b3 = b2 + kstep;
            if (last && has_next) S.a_ready(nxt);
            if constexpr (SP2) {
            PG8_LDB(B0, 0, 0); PG8_LDB(B1, 0, 1); PG8_SCHED; PG8_LDA(At, 0, 0); PG8_STAGE_A(PG8_SA(1, 1), a1, 1); if (last && has_next) PG8_LOADVA(ui + 1);
            PG8_WAIT_V(8); PG8_WAIT_L(0); PG8_BAR; PG8_MMA(0, 0, At, B0); PG8_MMA(0, 1, At, B1); PG8_BAR; PG8_SCHED;
            PG8_LDA(At, 0, 1); PG8_STAGE_B(PG8_SB(0, 0), b2); PG8_STAGE_B(PG8_SB(0, 1), b2 + hstepB); PG8_STAGE_A(PG8_SA(0, 0), a2, 0);
            PG8_WAIT_V(8); PG8_WAIT_L(0); PG8_BAR; PG8_MMA(1, 0, At, B0); PG8_MMA(1, 1, At, B1); PG8_BAR; PG8_SCHED;
            PG8_LDB(B0, 1, 0); PG8_LDB(B1, 1, 1); PG8_SCHED; PG8_LDA(At, 1, 0); PG8_STAGE_A(PG8_SA(0, 1), a2, 1);
            PG8_WAIT_V(8); PG8_WAIT_L(0); PG8_BAR; PG8_MMA(0, 0, At, B0); PG8_MMA(0, 1, At, B1); PG8_BAR; PG8_SCHED;
            PG8_LDA(At, 1, 1); PG8_STAGE_B(PG8_SB(1, 0), b3); PG8_STAGE_B(PG8_SB(1, 1), b3 + hstepB); PG8_STAGE_A(PG8_SA(1, 0), a3, 0);
            PG8_WAIT_V(8); PG8_WAIT_L(0); PG8_BAR; PG8_MMA(1, 0, At, B0); PG8_MMA(1, 1, At, B1); PG8_BAR; PG8_SCHED;
            } else {
            PG8_LDB(B0, 0, 0); PG8_SCHED; PG8_LDA(At, 0, 0); PG8_STAGE_A(PG8_SA(1, 1), a1, 1); if (last && has_next) PG8_LOADVA(ui + 1);
            PG8_WAIT_L(8); PG8_BAR; PG8_WAIT_L(0); PG8_MMA(0, 0, At, B0); PG8_BAR; PG8_SCHED;
            PG8_LDB(B1, 0, 1); PG8_STAGE_B(PG8_SB(0, 0), b2);
            PG8_BAR; PG8_WAIT_L(0); PG8_MMA(0, 1, At, B1); PG8_BAR;
            PG8_LDA(At, 0, 1); PG8_STAGE_A(PG8_SA(0, 0), a2, 0);
            PG8_BAR; PG8_WAIT_L(0); PG8_MMA(1, 0, At, B0); PG8_BAR; PG8_SCHED;
            PG8_STAGE_B(PG8_SB(0, 1), b2 + hstepB);
            PG8_WAIT_V(6); PG8_BAR; PG8_MMA(1, 1, At, B1); PG8_BAR;
            PG8_LDB(B0, 1, 0); PG8_SCHED; PG8_LDA(At, 1, 0); PG8_STAGE_A(PG8_SA(0, 1), a2, 1);
            PG8_WAIT_L(8); PG8_BAR; PG8_WAIT_L(0); PG8_MMA(0, 0, At, B0); PG8_BAR; PG8_SCHED;
            PG8_LDB(B1, 1, 1); PG8_STAGE_B(PG8_SB(1, 0), b3);
            PG8_BAR; PG8_WAIT_L(0); PG8_MMA(0, 1, At, B1); PG8_BAR;
            PG8_LDA(At, 1, 1); PG8_STAGE_A(PG8_SA(1, 0), a3, 0);
            PG8_BAR; PG8_WAIT_L(0); PG8_MMA(1, 0, At, B0); PG8_BAR; PG8_SCHED;
            PG8_STAGE_B(PG8_SB(1, 1), b3 + hstepB);
            PG8_WAIT_V(6); PG8_BAR; PG8_MMA(1, 1, At, B1); PG8_BAR;
            }
        }
        if constexpr (ALIGN_EPI) { if (wr == 0) PG8_BAR; }
        if constexpr (!Epi::AFTER_DRAIN) { int l2_; asm volatile("v_mbcnt_lo_u32_b32 %0, -1, 0\n\tv_mbcnt_hi_u32_b32 %0, -1, %0" : "=v"(l2_));
            E(acc, cur, wr, wc, l2_ & 15, l2_ >> 4); S.done(cur); }
        if (!has_next) break;
#pragma unroll
        for (int a = 0; a < 2; ++a)
#pragma unroll
            for (int b = 0; b < 2; ++b)
#pragma unroll
                for (int m = 0; m < 4; ++m)
#pragma unroll
                    for (int n = 0; n < 2; ++n) acc[a][b][m][n] = (f32x4){0.f, 0.f, 0.f, 0.f};
        cur = nxt; cB = nB; ++ui;
        if constexpr (ALIGN_EPI) { if (wr == 1) PG8_BAR; }
    }
    PG8_WAIT_V(0);
    if constexpr (!ALIGN_EPI) { if (wr == 0) PG8_BAR; }
    PG8_BAR;
    if constexpr (Epi::AFTER_DRAIN) { E.fused(acc, cur, wr, wc, fr, fq, lds, wid, lane); S.done(cur); }
#undef PG8_SA
#undef PG8_SB
#undef PG8_GL
#undef PG8_STAGE_A
#undef PG8_STAGE_B
#undef PG8_LOADVA
#undef PG8_LDA
#undef PG8_LDB
#undef PG8_MMA
#undef PG8_WAIT_V
#undef PG8_WAIT_L
#undef PG8_BAR
#undef PG8_SCHED
}
}
namespace pg8 {
struct GemmA { const bf16_t* A; const bf16_t* Bt; int K; int rowA; size_t kstepA, hstepA, tstepA; };
template <class Epi, class Sched, bool ALIGN_EPI = false, bool SP2 = false>
__device__ __forceinline__ void gemm_phase_ga(PG8_LAS unsigned char* lds, const GemmA g, const Sched& S, const Epi& E, int wid_in) {
    int lane_; asm volatile("v_mbcnt_lo_u32_b32 %0, -1, 0\n\tv_mbcnt_hi_u32_b32 %0, -1, %0" : "=v"(lane_));
    const int wid = wid_in, lane = lane_, tid = wid * 64 + lane, wr = wid >> 2, wc = wid & 3, fr = lane & 15, fq = lane >> 4;
    const int K = g.K, nt = K / BK;
    unsigned voffA[2], voffB[2];
#pragma unroll
    for (int i = 0; i < 2; ++i) { int R, C; stage_rc(tid * 16 + i * 8192, R, C); const int Rb = Perm2<Epi>::v ? (64 * (R >> 5) + 16 * ((R >> 2) & 3) + 4 * ((R >> 4) & 1) + (R & 3)) : Epi::PERM ? ((R & ~31) + perm32(R & 31)) : R;
        voffA[i] = (unsigned)(R * g.rowA + C * 2); voffB[i] = (unsigned)(Rb * K + C) * 2u; }
    const size_t kstep = (size_t)(BK * 2);
    const size_t hstep = (size_t)HALF * K * 2;
    const size_t kstepA = g.kstepA, hstepA = g.hstepA, tstepA = g.tstepA;
    const size_t hstepB = Perm2<Epi>::v ? (size_t)8 * K * 2 : hstep;
    const size_t tstep = 2 * hstep;
    const unsigned ldsw = (unsigned)wid * 1024u;
    const int aoff = lds_byte(wr * 64 + fr, fq * 8), boff = lds_byte(wc * 32 + fr, fq * 8);
#define PG8_SA(b, h) (((b) * 2 + (h)) * HTB)
#define PG8_SB(b, h) ((4 + (b) * 2 + (h)) * HTB)
#define PG8_STAGE(bufoff, gbase, voff) do { _Pragma("unroll") for (int _i = 0; _i < 2; ++_i) \
        __builtin_amdgcn_global_load_lds((const unsigned*)((const char*)(gbase) + (voff)[_i]), (PG8_LAS unsigned*)(lds + (bufoff) + ldsw + _i * 8192), 16, 0, 0); } while (0)
#define PG8_LDA(dst, b, h) do { _Pragma("unroll") for (int m = 0; m < 4; ++m) _Pragma("unroll") for (int k = 0; k < 2; ++k) dst[m][k] = *(const PG8_LAS bf16x8*)(lds + PG8_SA(b, h) + aoff + m * 2048 + k * 1024); } while (0)
#define PG8_LDB(dst, b, h) do { _Pragma("unroll") for (int n = 0; n < 2; ++n) _Pragma("unroll") for (int k = 0; k < 2; ++k) dst[n][k] = *(const PG8_LAS bf16x8*)(lds + PG8_SB(b, h) + boff + n * 2048 + k * 1024); } while (0)
#define PG8_MMA(ai, bj, At, Bt) do { __builtin_amdgcn_s_setprio(1); _Pragma("unroll") for (int m = 0; m < 4; ++m) _Pragma("unroll") for (int n = 0; n < 2; ++n) _Pragma("unroll") for (int k = 0; k < 2; ++k) \
        acc[ai][bj][m][n] = __builtin_amdgcn_mfma_f32_16x16x32_bf16(Bt[n][k], At[m][k], acc[ai][bj][m][n], 0, 0, 0); __builtin_amdgcn_s_setprio(0); } while (0)
#define PG8_WAIT_V(n) asm volatile("s_waitcnt vmcnt(" #n ")" ::: "memory")
#define PG8_WAIT_L(n) asm volatile("s_waitcnt lgkmcnt(" #n ")" ::: "memory")
#define PG8_BAR __builtin_amdgcn_s_barrier()
#define PG8_SCHED __builtin_amdgcn_sched_barrier(0)
    Unit cur, nxt; int ui = 0;
    if (!S.next(0, cur)) return;
    f32x4 acc[2][2][4][2];
#pragma unroll
    for (int a = 0; a < 2; ++a)
#pragma unroll
        for (int b = 0; b < 2; ++b)
#pragma unroll
            for (int m = 0; m < 4; ++m)
#pragma unroll
                for (int n = 0; n < 2; ++n) acc[a][b][m][n] = (f32x4){0.f, 0.f, 0.f, 0.f};
    bf16x8 At[4][2], B0[2][2], B1[2][2];
    const char* cA = (const char*)g.A + (size_t)cur.pm * tstepA; const char* cB = (const char*)g.Bt + (size_t)cur.pn * tstep;
    S.a_ready(cur);
    if constexpr (SP2) {
        PG8_STAGE(PG8_SB(0, 0), cB, voffB); PG8_STAGE(PG8_SB(0, 1), cB + hstepB, voffB); PG8_STAGE(PG8_SA(0, 0), cA, voffA); PG8_STAGE(PG8_SA(0, 1), cA + hstepA, voffA);
        if (wr == 1) PG8_BAR;
        PG8_WAIT_V(2); PG8_BAR;
        PG8_STAGE(PG8_SB(1, 0), cB + kstep, voffB); PG8_STAGE(PG8_SA(1, 0), cA + kstepA, voffA); PG8_STAGE(PG8_SB(1, 1), cB + hstepB + kstep, voffB);
        PG8_WAIT_V(6); PG8_BAR;
    } else {
        PG8_STAGE(PG8_SB(0, 0), cB, voffB); PG8_STAGE(PG8_SA(0, 0), cA, voffA); PG8_STAGE(PG8_SB(0, 1), cB + hstepB, voffB); PG8_STAGE(PG8_SA(0, 1), cA + hstepA, voffA);
        if (wr == 1) PG8_BAR;
        PG8_WAIT_V(4); PG8_BAR;
        PG8_STAGE(PG8_SB(1, 0), cB + kstep, voffB); PG8_STAGE(PG8_SA(1, 0), cA + kstepA, voffA); PG8_STAGE(PG8_SB(1, 1), cB + hstepB + kstep, voffB);
        PG8_WAIT_V(6); PG8_BAR;
    }
    for (;;) {
        const bool has_next = S.next(ui + 1, nxt);
        const char* nA = has_next ? (const char*)g.A + (size_t)nxt.pm * tstepA : cA; const char* nB = has_next ? (const char*)g.Bt + (size_t)nxt.pn * tstep : cB;
        for (int t = 0; t < nt; t += 2) {
            if constexpr (MidSeg<Epi>::v > 0) { if (t > 0 && t % MidSeg<Epi>::v == 0) E.mid(acc, cur, t / MidSeg<Epi>::v, wr, wc, fr, fq); }
            const bool last = (t == nt - 2);
            const char* a1 = cA + (size_t)(t + 1) * kstepA;
            const char* a2 = last ? nA : cA + (size_t)(t + 2) * kstepA; const char* b2 = last ? nB : cB + (size_t)(t + 2) * kstep;
            const char* a3 = a2 + kstepA; const char* b3 = b2 + kstep;
            if (last && has_next) S.a_ready(nxt);
            if constexpr (SP2) {
            PG8_LDB(B0, 0, 0); PG8_LDB(B1, 0, 1); PG8_SCHED; PG8_LDA(At, 0, 0); PG8_STAGE(PG8_SA(1, 1), a1 + hstepA, voffA);
            PG8_WAIT_V(8); PG8_WAIT_L(0); PG8_BAR; PG8_MMA(0, 0, At, B0); PG8_MMA(0, 1, At, B1); PG8_BAR; PG8_SCHED;
            PG8_LDA(At, 0, 1); PG8_STAGE(PG8_SB(0, 0), b2, voffB); PG8_STAGE(PG8_SB(0, 1), b2 + hstepB, voffB); PG8_STAGE(PG8_SA(0, 0), a2, voffA);
            PG8_WAIT_V(8); PG8_WAIT_L(0); PG8_BAR; PG8_MMA(1, 0, At, B0); PG8_MMA(1, 1, At, B1); PG8_BAR; PG8_SCHED;
            PG8_LDB(B0, 1, 0); PG8_LDB(B1, 1, 1); PG8_SCHED; PG8_LDA(At, 1, 0); PG8_STAGE(PG8_SA(0, 1), a2 + hstepA, voffA);
            PG8_WAIT_V(8); PG8_WAIT_L(0); PG8_BAR; PG8_MMA(0, 0, At, B0); PG8_MMA(0, 1, At, B1); PG8_BAR; PG8_SCHED;
            PG8_LDA(At, 1, 1); PG8_STAGE(PG8_SB(1, 0), b3, voffB); PG8_STAGE(PG8_SB(1, 1), b3 + hstepB, voffB); PG8_STAGE(PG8_SA(1, 0), a3, voffA);
            PG8_WAIT_V(8); PG8_WAIT_L(0); PG8_BAR; PG8_MMA(1, 0, At, B0); PG8_MMA(1, 1, At, B1); PG8_BAR; PG8_SCHED;
            } else {
            PG8_LDB(B0, 0, 0); PG8_SCHED; PG8_LDA(At, 0, 0); PG8_STAGE(PG8_SA(1, 1), a1 + hstepA, voffA);
            PG8_WAIT_L(8); PG8_BAR; PG8_WAIT_L(0); PG8_MMA(0, 0, At, B0); PG8_BAR; PG8_SCHED;
            PG8_LDB(B1, 0, 1); PG8_STAGE(PG8_SB(0, 0), b2, voffB);
            PG8_BAR; PG8_WAIT_L(0); PG8_MMA(0, 1, At, B1); PG8_BAR;
            PG8_LDA(At, 0, 1); PG8_STAGE(PG8_SA(0, 0), a2, voffA);
            PG8_BAR; PG8_WAIT_L(0); PG8_MMA(1, 0, At, B0); PG8_BAR; PG8_SCHED;
            PG8_STAGE(PG8_SB(0, 1), b2 + hstepB, voffB);
            PG8_WAIT_V(6); PG8_BAR; PG8_MMA(1, 1, At, B1); PG8_BAR;
            PG8_LDB(B0, 1, 0); PG8_SCHED; PG8_LDA(At, 1, 0); PG8_STAGE(PG8_SA(0, 1), a2 + hstepA, voffA);
            PG8_WAIT_L(8); PG8_BAR; PG8_WAIT_L(0); PG8_MMA(0, 0, At, B0); PG8_BAR; PG8_SCHED;
            PG8_LDB(B1, 1, 1); PG8_STAGE(PG8_SB(1, 0), b3, voffB);
            PG8_BAR; PG8_WAIT_L(0); PG8_MMA(0, 1, At, B1); PG8_BAR;
            PG8_LDA(At, 1, 1); PG8_STAGE(PG8_SA(1, 0), a3, voffA);
            PG8_BAR; PG8_WAIT_L(0); PG8_MMA(1, 0, At, B0); PG8_BAR; PG8_SCHED;
            PG8_STAGE(PG8_SB(1, 1), b3 + hstepB, voffB);
            PG8_WAIT_V(6); PG8_BAR; PG8_MMA(1, 1, At, B1); PG8_BAR;
            }
        }
        if constexpr (ALIGN_EPI) { if (wr == 0) PG8_BAR; }
        if constexpr (!Epi::AFTER_DRAIN) { E(acc, cur, wr, wc, fr, fq); S.done(cur); }
        if (!has_next) break;
#pragma unroll
        for (int a = 0; a < 2; ++a)
#pragma unroll
            for (int b = 0; b < 2; ++b)
#pragma unroll
                for (int m = 0; m < 4; ++m)
#pragma unroll
                    for (int n = 0; n < 2; ++n) acc[a][b][m][n] = (f32x4){0.f, 0.f, 0.f, 0.f};
        cur = nxt; cA = nA; cB = nB; ++ui;
        if constexpr (ALIGN_EPI) { if (wr == 1) PG8_BAR; }
    }
    PG8_WAIT_V(0);
    if constexpr (!ALIGN_EPI) { if (wr == 0) PG8_BAR; }
    PG8_BAR;
    if constexpr (Epi::AFTER_DRAIN) { E.fused(acc, cur, wr, wc, fr, fq, lds, wid, lane); S.done(cur); }
#undef PG8_SA
#undef PG8_SB
#undef PG8_STAGE
#undef PG8_LDA
#undef PG8_LDB
#undef PG8_MMA
#undef PG8_WAIT_V
#undef PG8_WAIT_L
#undef PG8_BAR
#undef PG8_SCHED
}
}
#define GAS __attribute__((address_space(1)))
#define LAS __attribute__((address_space(3)))
typedef unsigned short bf16;
typedef unsigned v4u __attribute__((ext_vector_type(4)));
typedef float f32x4 __attribute__((ext_vector_type(4)));
typedef short bf16x8 __attribute__((ext_vector_type(8)));
typedef GAS unsigned gu32;
typedef GAS unsigned long long gu64;
#define RLX_AGENT __ATOMIC_RELAXED, __HIP_MEMORY_SCOPE_AGENT
#define LDS_WAIT() asm volatile("s_waitcnt lgkmcnt(0)" ::: "memory")
#define VM_WAIT() asm volatile("s_waitcnt vmcnt(0)" ::: "memory")
__device__ __forceinline__ unsigned long long rt() { return __builtin_amdgcn_s_memrealtime(); }
__device__ __forceinline__ unsigned f2bf(float f) { unsigned u = __builtin_bit_cast(unsigned, f); return (u + 0x7fffu + ((u >> 16) & 1u)) >> 16; }
__device__ __forceinline__ unsigned pk2(float lo, float hi) { return f2bf(lo) | (f2bf(hi) << 16); }

#define XB_TMO      128
#define XB_XCNT(j)  (256  + 64 * (j))
#define XB_XSUB(j)  (1280 + 64 * (j))
#define XB_XGEN(j)  (2304 + 64 * (j))
#define XB_TOP      3328
#define XB_TOPGEN   3392
#define XCD_BAR_WORDS 3456
#define XB_SPIN_CAP (1u << 18)

__device__ __forceinline__ unsigned xb_ld(unsigned* p)              { return __hip_atomic_load(p, __ATOMIC_RELAXED, __HIP_MEMORY_SCOPE_AGENT); }
__device__ __forceinline__ unsigned xb_add(unsigned* p, unsigned v) { return __hip_atomic_fetch_add(p, v, __ATOMIC_RELAXED, __HIP_MEMORY_SCOPE_AGENT); }
__device__ __forceinline__ unsigned xb_xcc_id() { return (unsigned)__builtin_amdgcn_s_getreg((3 << 11) | 20) & 0xFu; }
#define XB_SPIN(cond, bar) do { unsigned _sp = 0; while (cond) { __builtin_amdgcn_s_sleep(1); \
    if ((++_sp & 255u) == 0u) { if (xb_ld(&(bar)[XB_TMO])) break; if (_sp > XB_SPIN_CAP) { atomicAdd(&(bar)[XB_TMO], 1u); break; } } } } while (0)

struct XcdBarrier {
    int wv;
    unsigned* bar; unsigned x;
    volatile LAS unsigned* st;
};

__device__ __forceinline__ int xb_lane_id() { int l; asm volatile("v_mbcnt_lo_u32_b32 %0, -1, 0\n\tv_mbcnt_hi_u32_b32 %0, -1, %0" : "=v"(l)); return l; }
__device__ __forceinline__ XcdBarrier xcd_barrier_post(unsigned* bar, volatile LAS unsigned* st, int wv) {
    XcdBarrier b; b.wv = wv; b.bar = bar; b.x = xb_xcc_id(); b.st = st;
    if (wv == 0 && xb_lane_id() == 0) (void)xb_add(&bar[XB_XCNT(b.x)], 1u);
    return b;
}
__device__ __forceinline__ void xcd_barrier_complete(unsigned* bar, unsigned x, unsigned& nloc, unsigned& nx) {
    const unsigned G = gridDim.x * gridDim.y * gridDim.z;
    unsigned sum, cnt, mine, sp = 0u;
    for (;;) {
        sum = 0u; cnt = 0u; mine = 0u;
#pragma unroll
        for (unsigned j = 0; j < 16; ++j) { const unsigned c = xb_ld(&bar[XB_XCNT(j)]); sum += c; cnt += (c > 0u) ? 1u : 0u; mine = (j == x) ? c : mine; }
        if (sum == G) break;
        __builtin_amdgcn_s_sleep(1);
        if ((++sp & 255u) == 0u) { if (xb_ld(&bar[XB_TMO])) break; if (sp > XB_SPIN_CAP) { atomicAdd(&bar[XB_TMO], 1u); break; } }
    }
    nloc = mine > 0u ? mine : 1u; nx = cnt > 0u ? cnt : 1u;
}

__device__ __forceinline__ void xcd_barrier(const XcdBarrier& b) {
    asm volatile("s_waitcnt vmcnt(0)" ::: "memory");
    __syncthreads();
    if (b.wv == 0 && xb_lane_id() == 0) {
        unsigned* bar = b.bar;
        __builtin_amdgcn_s_waitcnt(0);
        unsigned nloc = b.st[0], nx = b.st[1];
        if (nloc == 0u) { xcd_barrier_complete(bar, b.x, nloc, nx); b.st[0] = nloc; b.st[1] = nx; }
        const unsigned old = xb_add(&bar[XB_XSUB(b.x)], 1u);
        const unsigned gen = old / nloc;
        if (old + 1u == (gen + 1u) * nloc) {
            __builtin_amdgcn_fence(__ATOMIC_RELEASE, "agent");
            asm volatile("s_waitcnt vmcnt(0)" ::: "memory");
            const unsigned og = xb_add(&bar[XB_TOP], 1u);
            const unsigned tg = og / nx;
            if (og + 1u == (tg + 1u) * nx) xb_add(&bar[XB_TOPGEN], 1u);
            else XB_SPIN(xb_ld(&bar[XB_TOPGEN]) == tg, bar);
            __builtin_amdgcn_fence(__ATOMIC_ACQUIRE, "agent");
            xb_add(&bar[XB_XGEN(b.x)], 1u);
            asm volatile("s_waitcnt vmcnt(0)" ::: "memory");
        } else {
            XB_SPIN(xb_ld(&bar[XB_XGEN(b.x)]) == gen, bar);
            __builtin_amdgcn_fence(__ATOMIC_ACQUIRE, "agent");
            asm volatile("s_waitcnt vmcnt(0)" ::: "memory");
        }
    }
    __syncthreads();
}
#define DI __device__ __forceinline__
constexpr int NWAVES = 8;
constexpr int NB = 16, SEQ = 2048, DM = 1024, MT = NB * SEQ;
constexpr int DIN_SRC = 6944, NPROJ = 7168;
constexpr int MEML = 256, MROWS = NB * MEML;
constexpr int NEXP = 32, TOPK = 4, DFF = 1024, MOEB = 256;
constexpr int NROWS = MT * TOPK;
constexpr int NBLK_MAX = (NROWS + NEXP * (MOEB - 1) + MOEB - 1) / MOEB;
constexpr int CAP = NBLK_MAX * MOEB;
constexpr float EPS = 1e-6f;
constexpr float NEGF = -1e30f;
constexpr int NB16 = 3584, NF8 = NPROJ - NB16;
constexpr int PC_MLQ = 0, PC_MLK = 512, PC_NQ = 1024, PC_NKC = 1536, PC_NKS = 1664, PC_NKW = 1792, PC_MQ = 1920, PC_MLI = 2432, PC_MLF = 2436, PC_NG = 2440,
              PC_MLV = 2560, PC_NVC = 3072, PC_NVS = 3200, PC_NVW = 3328, PC_MLO = 3584, PC_BRG = 4096;
__host__ __device__ constexpr int proj_srccol(int j) {
    return j < 1024 ? j : j < 1536 ? 2056 + (j - 1024) : j < 1664 ? 2568 + (j - 1536) : j < 1792 ? 2824 + (j - 1664) : j < 1920 ? 3080 + (j - 1792) : j < 2432 ? 3360 + (j - 1920)
         : j < 2440 ? 2048 + (j - 2432) : j < 2464 ? 3336 + (j - 2440) : j < 2560 ? -1
         : j < 3072 ? 1024 + (j - 2560) : j < 3200 ? 2696 + (j - 3072) : j < 3328 ? 2952 + (j - 3200) : j < 3456 ? 3208 + (j - 3328) : j < 3584 ? -1
         : j < 4096 ? 1536 + (j - 3584) : 3872 + (j - 4096);
}

constexpr size_t MiB = 1u << 20;
constexpr size_t WS_CTL = 0, CTL_ZERO_BYTES = 1 * MiB;
constexpr size_t WS_WIN = 1 * MiB, WS_WGU = 15 * MiB, WS_WDN = 143 * MiB, WS_WMKV = 207 * MiB, WS_WBR = 209 * MiB, WS_WOUT = 212 * MiB, WS_WC1 = 214 * MiB;
constexpr size_t WS_WIN8 = WS_WIN + 8 * MiB;
constexpr size_t WS_SMALL = 216 * MiB;
constexpr size_t WS_R1 = 218 * MiB;
constexpr size_t WS_PROJ = 282 * MiB;
constexpr size_t WS_R3 = 730 * MiB;
constexpr size_t WS_MEMKV = WS_R3, WS_MEMKN = WS_R3 + 8 * MiB, WS_QN = WS_R3 + 12 * MiB, WS_KSN = WS_R3 + 44 * MiB, WS_KWN = WS_R3 + 52 * MiB,
                 WS_MQN = WS_R3 + 60 * MiB, WS_MLQK = WS_R3 + 92 * MiB, WS_HID = WS_R3 + 156 * MiB, WS_KC = WS_R3 + 160 * MiB, WS_VC = WS_KC + MiB / 2,
                 WS_H0 = WS_R3 + 161 * MiB, WS_H1 = WS_H0 + 32 * MiB, WS_H2 = WS_H1 + 32 * MiB, WS_ROUTE = WS_H2 + 32 * MiB, WS_END = WS_ROUTE + 6 * MiB;
constexpr size_t WS_MLV = WS_R1, WS_VSN = WS_R1 + 32 * MiB, WS_VWN = WS_R1 + 40 * MiB;
constexpr size_t WS_U8 = WS_H2;
constexpr size_t WS_MEMN = WS_H0;
constexpr size_t WS_ACMP = WS_H1;
constexpr size_t WS_APERM = WS_PROJ;
constexpr size_t WS_ACT = WS_PROJ + 272 * MiB;
static_assert(WS_ACT + 272 * MiB <= WS_H0 + 96 * MiB && WS_END <= 1024 * MiB, "ws map");
constexpr size_t SM_ROPEC = 0, SM_ROPES = 256 * 1024, SM_CBIAS = 512 * 1024, SM_WRT = 1024 * 1024, SM_W2T = 1024 * 1024 + 256 * 1024;
constexpr size_t RT_TOKE = 0, RT_TOKPOS = 512 * 1024, RT_TOKW = 1024 * 1024, RT_TOKDEST = 1536 * 1024, RT_ROWW = 2048 * 1024, RT_ROWTOK = 3072 * 1024;
constexpr int CW_BAR = 4096;
constexpr int CW_ECNT = 16384;
constexpr int CW_QCTR = 16384 + 64;

constexpr int RING_BYTES = 131072, LDSCTL_OFF = RING_BYTES, MISC_OFF = LDSCTL_OFF + 320, LDS_BYTES = 155648;

struct Args { const float* in[34]; float* out; unsigned char* ws; int ph_lo, ph_hi, li, pad; };

DI float bf2f(unsigned short h) { return __uint_as_float((unsigned)h << 16); }
DI float wave_sum(float v) {
#pragma unroll
    for (int o = 1; o < 64; o <<= 1) v += __shfl_xor(v, o);
    return v;
}
DI float wave_max(float v) {
#pragma unroll
    for (int o = 1; o < 64; o <<= 1) v = fmaxf(v, __shfl_xor(v, o));
    return v;
}
DI float sigm(float x) { return __builtin_amdgcn_rcpf(1.f + __expf(-x)); }
DI float logsig(float x) { return fminf(x, 0.f) - log1pf(__expf(-fabsf(x))); }

namespace pg8 {
struct EpiBf16Silu {
    static constexpr bool PERM = true, AFTER_DRAIN = false, PERM2 = true;
    bf16_t* O; int ldc; const float* bias; int silu;
    DI void operator()(const f32x4 (&acc)[2][2][4][2], const Unit& u, int wr, int wc, int fr, int fq) const {
        const int row0 = u.pm * BM + wr * 64 + fr; const int col0 = u.pn * BM + wc * 64 + 16 * fq;
#pragma unroll
        for (int ai = 0; ai < 2; ++ai)
#pragma unroll
            for (int m = 0; m < 4; ++m) { bf16_t* rowp = O + (size_t)(row0 + ai * HALF + m * 16) * ldc + col0;
#pragma unroll
                for (int bj = 0; bj < 2; ++bj) { f32x4 v0 = acc[ai][bj][m][0], v1 = acc[ai][bj][m][1];
                    if (bias) { v0 += *(const f32x4*)(bias + col0 + 8 * bj); v1 += *(const f32x4*)(bias + col0 + 8 * bj + 4); }
                    if (silu) {
#pragma unroll
                        for (int j = 0; j < 4; ++j) { v0[j] = v0[j] * __builtin_amdgcn_rcpf(1.f + __expf(-v0[j])); v1[j] = v1[j] * __builtin_amdgcn_rcpf(1.f + __expf(-v1[j])); } }
                    u32x4 w; w.x = cvt_pk_bf16(v0[0], v0[1]); w.y = cvt_pk_bf16(v0[2], v0[3]); w.z = cvt_pk_bf16(v1[0], v1[1]); w.w = cvt_pk_bf16(v1[2], v1[3]);
                    *(u32x4*)(rowp + 8 * bj) = w; } }
    }
};
template <int B> struct EpiGate {
    static constexpr bool PERM = false, AFTER_DRAIN = false;
    const bf16_t* proj; float* tmp; bf16_t* merged;
    DI void operator()(const f32x4 (&acc)[2][2][4][2], const Unit& u, int wr, int wc, int fr, int fq) const {
        typedef unsigned u32x2v __attribute__((ext_vector_type(2)));
        const int col0 = u.pn * BM + wc * 32 + 4 * fq;
#pragma unroll
        for (int ai = 0; ai < 2; ++ai)
#pragma unroll
            for (int m = 0; m < 4; ++m) { const size_t r = (size_t)(u.pm * BM + ai * HALF + wr * 64 + m * 16 + fr);
#pragma unroll
                for (int bj = 0; bj < 2; ++bj)
#pragma unroll
                    for (int n = 0; n < 2; ++n) { const int c = col0 + bj * HALF + n * 16;
                        const u32x2v gw = *(const u32x2v*)(proj + r * NPROJ + PC_BRG + B * DM + c);
                        f32x4 g; g[0] = __uint_as_float(gw.x << 16); g[1] = __uint_as_float(gw.x & 0xffff0000u); g[2] = __uint_as_float(gw.y << 16); g[3] = __uint_as_float(gw.y & 0xffff0000u);
                        f32x4 v = acc[ai][bj][m][n];
#pragma unroll
                        for (int j = 0; j < 4; ++j) v[j] = v[j] * __builtin_amdgcn_rcpf(1.f + __expf(-g[j]));
                        float* tp = tmp + r * DM + c;
                        if (B == 0) { *(f32x4*)tp = v; }
                        else if (B == 1) { *(f32x4*)tp = *(const f32x4*)tp + v; }
                        else { v = *(const f32x4*)tp + v; u32x2v w; w.x = cvt_pk_bf16(v[0], v[1]); w.y = cvt_pk_bf16(v[2], v[3]); *(u32x2v*)(merged + r * DM + c) = w; } } }
    }
};
struct EpiMerge {
    static constexpr bool PERM = false, AFTER_DRAIN = false;
    const bf16_t* proj; float* tmp; bf16_t* merged;
    DI void operator()(const f32x4 (&acc)[2][2][4][2], const Unit& u, int wr, int wc, int fr, int fq) const {
        typedef unsigned u32x2v __attribute__((ext_vector_type(2)));
        const int b = u.pn >> 2, pn = u.pn & 3, pm = u.pm & 127;
        const int col0 = pn * BM + wc * 32 + 4 * fq;
#pragma unroll
        for (int ai = 0; ai < 2; ++ai)
#pragma unroll
            for (int m = 0; m < 4; ++m) { const size_t r = (size_t)(pm * BM + ai * HALF + wr * 64 + m * 16 + fr);
#pragma unroll
                for (int bj = 0; bj < 2; ++bj)
#pragma unroll
                    for (int n = 0; n < 2; ++n) { const int c = col0 + bj * HALF + n * 16;
                        const u32x2v gw = *(const u32x2v*)(proj + r * NPROJ + PC_BRG + b * DM + c);
                        f32x4 g; g[0] = __uint_as_float(gw.x << 16); g[1] = __uint_as_float(gw.x & 0xffff0000u); g[2] = __uint_as_float(gw.y << 16); g[3] = __uint_as_float(gw.y & 0xffff0000u);
                        f32x4 v = acc[ai][bj][m][n];
#pragma unroll
                        for (int j = 0; j < 4; ++j) v[j] = v[j] * __builtin_amdgcn_rcpf(1.f + __expf(-g[j]));
                        float* tp = tmp + r * DM + c;
                        if (b == 0) { *(f32x4*)tp = v; }
                        else if (b == 1) { *(f32x4*)tp = *(const f32x4*)tp + v; }
                        else { v = *(const f32x4*)tp + v; u32x2v w; w.x = cvt_pk_bf16(v[0], v[1]); w.y = cvt_pk_bf16(v[2], v[3]); *(u32x2v*)(merged + r * DM + c) = w; } } }
    }
};
struct EpiMergeK {
    static constexpr bool PERM = true, AFTER_DRAIN = false; static constexpr int MIDSEG = 8;
    const bf16_t* proj; bf16_t* merged;
    DI static void ldg8(const bf16_t* p, float (&g)[8]) { const u32x4 w = *(const u32x4*)p; const unsigned ws_[4] = {w.x, w.y, w.z, w.w};
#pragma unroll
        for (int j = 0; j < 4; ++j) { g[2 * j] = __uint_as_float(ws_[j] << 16); g[2 * j + 1] = __uint_as_float(ws_[j] & 0xffff0000u); } }
    DI void mid(f32x4 (&acc)[2][2][4][2], const Unit& u, int seg, int wr, int wc, int fr, int fq) const {
        const int col0 = u.pn * BM + wc * 32 + 8 * fq;
#pragma unroll
        for (int ai = 0; ai < 2; ++ai)
#pragma unroll
            for (int m = 0; m < 4; ++m) { const size_t r = (size_t)(u.pm * BM + ai * HALF + wr * 64 + m * 16 + fr);
#pragma unroll
                for (int bj = 0; bj < 2; ++bj) { const bf16_t* gp = proj + r * NPROJ + PC_BRG + (seg - 1) * DM + col0 + bj * HALF;
                    float ga[8], gb[8]; ldg8(gp, ga); ldg8(gp + DM, gb);
#pragma unroll
                    for (int n = 0; n < 2; ++n)
#pragma unroll
                        for (int j = 0; j < 4; ++j) acc[ai][bj][m][n][j] *= (1.f + __expf(-gb[4 * n + j])) * __builtin_amdgcn_rcpf(1.f + __expf(-ga[4 * n + j])); } }
    }
    DI void operator()(const f32x4 (&acc)[2][2][4][2], const Unit& u, int wr, int wc, int fr, int fq) const {
        const int col0 = u.pn * BM + wc * 32 + 8 * fq;
#pragma unroll
        for (int ai = 0; ai < 2; ++ai)
#pragma unroll
            for (int m = 0; m < 4; ++m) { const size_t r = (size_t)(u.pm * BM + ai * HALF + wr * 64 + m * 16 + fr);
#pragma unroll
                for (int bj = 0; bj < 2; ++bj) { float g[8]; ldg8(proj + r * NPROJ + PC_BRG + 2 * DM + col0 + bj * HALF, g); float v[8];
#pragma unroll
                    for (int n = 0; n < 2; ++n)
#pragma unroll
                        for (int j = 0; j < 4; ++j) v[4 * n + j] = acc[ai][bj][m][n][j] * __builtin_amdgcn_rcpf(1.f + __expf(-g[4 * n + j]));
                    u32x4 w; w.x = cvt_pk_bf16(v[0], v[1]); w.y = cvt_pk_bf16(v[2], v[3]); w.z = cvt_pk_bf16(v[4], v[5]); w.w = cvt_pk_bf16(v[6], v[7]);
                    *(u32x4*)(merged + r * DM + col0 + bj * HALF) = w; } }
    }
};
struct MergeOrder {
    StaticOrder so;
    DI bool next(int i, Unit& u) const { const int tl = i / 3, b = i - 3 * tl; Unit t; if (!so.next(tl, t)) return false; u.pm = b * 128 + t.pm; u.pn = b * 4 + t.pn; return true; }
    DI void a_ready(const Unit&) const {}
    DI void done(const Unit&) const {}
};
struct EpiRes {
    static constexpr bool PERM = false, AFTER_DRAIN = false;
    const float* base; float* out;
    DI void operator()(const f32x4 (&acc)[2][2][4][2], const Unit& u, int wr, int wc, int fr, int fq) const {
        const int col0 = u.pn * BM + wc * 32 + 4 * fq;
#pragma unroll
        for (int ai = 0; ai < 2; ++ai)
#pragma unroll
            for (int m = 0; m < 4; ++m) { const size_t r = (size_t)(u.pm * BM + ai * HALF + wr * 64 + m * 16 + fr);
#pragma unroll
                for (int bj = 0; bj < 2; ++bj)
#pragma unroll
                    for (int n = 0; n < 2; ++n) { const int c = col0 + bj * HALF + n * 16; *(f32x4*)(out + r * DM + c) = *(const f32x4*)(base + r * DM + c) + acc[ai][bj][m][n]; } }
    }
};
struct EpiSwiglu {
    static constexpr bool PERM = true, AFTER_DRAIN = false, PERM2 = true;
    unsigned char* act; const float* bgu;
    DI void operator()(const f32x4 (&acc)[2][2][4][2], const Unit& u, int wr, int wc, int fr, int fq) const {
        typedef unsigned u32x2v __attribute__((ext_vector_type(2)));
        const int e = u.pn >> 3, pnl = u.pn & 7;
        const unsigned lc0 = (unsigned)(pnl * BM + wc * 64 + 16 * fq);
        const unsigned row0 = (unsigned)(u.pm * BM + wr * 64 + fr);
        const float* bp = bgu + e * 2048 + lc0;
        f32x4 bv[2][2];
#pragma unroll
        for (int bj = 0; bj < 2; ++bj)
#pragma unroll
            for (int n = 0; n < 2; ++n) bv[bj][n] = *(const f32x4*)(bp + 8 * bj + 4 * n);
#pragma unroll
        for (int ai = 0; ai < 2; ++ai)
#pragma unroll
            for (int m = 0; m < 4; ++m) { const unsigned rowoff = (row0 + ai * HALF + m * 16) * (unsigned)DFF;
                int q8[2] = {0, 0};
#pragma unroll
                for (int bj = 0; bj < 2; ++bj) { float o[4];
#pragma unroll
                    for (int n = 0; n < 2; ++n) { const f32x4 v = acc[ai][bj][m][n] + bv[bj][n];
#pragma unroll
                        for (int q = 0; q < 2; ++q) { const float gt = fminf(v[2 * q], 7.0f); const float up = fminf(fmaxf(v[2 * q + 1], -7.0f), 7.0f);
                            o[2 * n + q] = (up + 1.0f) * (gt * __builtin_amdgcn_rcpf(1.f + __expf(-1.702f * gt))); } }
                    q8[bj] = __builtin_amdgcn_cvt_pk_fp8_f32(o[0], o[1], q8[bj], false); q8[bj] = __builtin_amdgcn_cvt_pk_fp8_f32(o[2], o[3], q8[bj], true); }
                *(u32x2v*)(act + (rowoff + (lc0 >> 1))) = (u32x2v){(unsigned)q8[0], (unsigned)q8[1]}; }
    }
};
struct EpiDown {
    static constexpr bool PERM = true, AFTER_DRAIN = false, PERM2 = true;
    unsigned char* y; const float* bdn; const float* roww;
    DI void operator()(const f32x4 (&acc)[2][2][4][2], const Unit& u, int wr, int wc, int fr, int fq) const {
        const int e = u.pn >> 2, pnl = u.pn & 3;
        const int col0 = pnl * BM + wc * 64 + 16 * fq;
        const float* bp = bdn + e * DM + col0;
        f32x4 bv[2][2];
#pragma unroll
        for (int bj = 0; bj < 2; ++bj) { bv[bj][0] = *(const f32x4*)(bp + 8 * bj); bv[bj][1] = *(const f32x4*)(bp + 8 * bj + 4); }
        const unsigned row0 = (unsigned)(u.pm * BM + wr * 64 + fr);
#pragma unroll
        for (int ai = 0; ai < 2; ++ai)
#pragma unroll
            for (int m = 0; m < 4; ++m) { const unsigned r = row0 + ai * HALF + m * 16; const float rw = roww[r] * 8.0f; unsigned q[4];
#pragma unroll
                for (int bj = 0; bj < 2; ++bj)
#pragma unroll
                    for (int n = 0; n < 2; ++n) { const f32x4 v = (acc[ai][bj][m][n] + bv[bj][n]) * rw; int w = 0;
                        w = __builtin_amdgcn_cvt_pk_fp8_f32(v[0], v[1], w, false); w = __builtin_amdgcn_cvt_pk_fp8_f32(v[2], v[3], w, true); q[2 * bj + n] = (unsigned)w; }
                *(u32x4*)(y + (r * (unsigned)DM + (unsigned)col0)) = (u32x4){q[0], q[1], q[2], q[3]}; }
    }
};
template <int NPN> struct MoeOrder {
    int nblk, G, c; const PG8_LAS unsigned char* blk_e;
    DI bool next(int i, Unit& u) const {
        int rb, pn;
        if (G == 256) { const int x = c & 7, j = c >> 3; rb = i * (256 / NPN) + x * (32 / NPN) + j / NPN; pn = j % NPN; }
        else { const int L = i * G + c; rb = L / NPN; pn = L % NPN; }
        if (rb >= nblk) return false;
        u.pm = rb; u.pn = __builtin_amdgcn_readfirstlane((int)blk_e[rb]) * NPN + pn; return true; }
    DI void a_ready(const Unit&) const {}
    DI void done(const Unit&) const {}
};
}

struct Frame {
    LAS unsigned char* lds; volatile LAS unsigned* MISC; unsigned* ctl; unsigned char* ws;
    int wave, G, bx;
    DI int lane_id() const { int l; asm volatile("v_mbcnt_lo_u32_b32 %0, -1, 0\n\tv_mbcnt_hi_u32_b32 %0, -1, %0" : "=v"(l)); return l; }
    DI int tid_id() const { return wave * 64 + lane_id(); }
    const float* const* in; float* out;
};
enum { I_X = 0, I_MEM, I_GMIX, I_WIN, I_CONVW, I_CONVB, I_MLBI, I_MLBF, I_MLGOUT, I_NGQ, I_NGK, I_CPK, I_CW1K, I_CB1K, I_CW2K, I_CPV, I_CW1V, I_CB1V, I_CW2V,
       I_GMEM, I_WMKV, I_MGQ, I_MGK, I_WBRML, I_WBRNSA, I_WBRMEM, I_WOUT, I_GFFN, I_WR, I_BR, I_WGU, I_BGU, I_WDN, I_BDN, N_IN };

template <class CM>
DI void tr_item(const float* W, int ldw, int K, bf16* WT, int k0, int n0, CM cm, LAS float* scr, int lane) {
    const int sc = cm(n0 + (lane & 31));
#pragma unroll 8
    for (int i = 0; i < 32; ++i) { const int kk = 2 * i + (lane >> 5); scr[kk * 33 + (lane & 31)] = sc >= 0 ? W[(size_t)(k0 + kk) * ldw + sc] : 0.f; }
    LDS_WAIT(); asm volatile("" ::: "memory");
    const int c = lane & 7;
#pragma unroll
    for (int j = 0; j < 4; ++j) { const int n = (lane >> 3) + 8 * j; const LAS float* s = scr + (8 * c) * 33 + n;
        v4u o; o.x = pk2(s[0 * 33], s[1 * 33]); o.y = pk2(s[2 * 33], s[3 * 33]); o.z = pk2(s[4 * 33], s[5 * 33]); o.w = pk2(s[6 * 33], s[7 * 33]);
        *(v4u*)(WT + (size_t)(n0 + n) * K + k0 + 8 * c) = o; }
    LDS_WAIT(); asm volatile("" ::: "memory");
}
DI void tr_item_f8(const float* W, int ldw, int K, unsigned char* WT, int k0, int n0, LAS float* scr, int lane) {
#pragma unroll 8
    for (int i = 0; i < 32; ++i) { const int kk = 2 * i + (lane >> 5); scr[kk * 33 + (lane & 31)] = W[(size_t)(k0 + kk) * ldw + n0 + (lane & 31)] * 256.0f; }
    LDS_WAIT(); asm volatile("" ::: "memory");
    const int c = lane & 7;
#pragma unroll
    for (int j = 0; j < 4; ++j) { const int n = (lane >> 3) + 8 * j; const LAS float* sp = scr + (8 * c) * 33 + n;
        int lo = 0, hi = 0;
        lo = __builtin_amdgcn_cvt_pk_fp8_f32(sp[0 * 33], sp[1 * 33], lo, false); lo = __builtin_amdgcn_cvt_pk_fp8_f32(sp[2 * 33], sp[3 * 33], lo, true);
        hi = __builtin_amdgcn_cvt_pk_fp8_f32(sp[4 * 33], sp[5 * 33], hi, false); hi = __builtin_amdgcn_cvt_pk_fp8_f32(sp[6 * 33], sp[7 * 33], hi, true);
        typedef unsigned u32x2t __attribute__((ext_vector_type(2)));
        *(u32x2t*)(WT + (size_t)(n0 + n) * K + k0 + 8 * c) = (u32x2t){(unsigned)lo, (unsigned)hi}; }
    LDS_WAIT(); asm volatile("" ::: "memory");
}
DI void tr_load_v4(const float* W, int ldw, int k0, int n0, int lane, f32x4 (&v)[8]) {
#pragma unroll
    for (int i = 0; i < 8; ++i) v[i] = *(const f32x4*)(W + (size_t)(k0 + 8 * i + (lane >> 3)) * ldw + n0 + 4 * (lane & 7));
}
DI void tr_put_v4(const f32x4 (&v)[8], LAS float* scr, int lane, float mul) {
#pragma unroll
    for (int i = 0; i < 8; ++i) { LAS float* d = scr + (8 * i + (lane >> 3)) * 33 + 4 * (lane & 7); d[0] = v[i].x * mul; d[1] = v[i].y * mul; d[2] = v[i].z * mul; d[3] = v[i].w * mul; }
    LDS_WAIT(); asm volatile("" ::: "memory");
}
DI void tr_load_v4x16(const float* W, int ldw, int k0, int n0, int lane, f32x4 (&v)[16]) {
#pragma unroll
    for (int i = 0; i < 16; ++i) v[i] = *(const f32x4*)(W + (size_t)(k0 + 8 * i + (lane >> 3)) * ldw + n0 + 4 * (lane & 7));
}
DI void tr_put_v4x16(const f32x4 (&v)[16], LAS float* scr, int lane, float mul) {
#pragma unroll
    for (int i = 0; i < 16; ++i) { LAS float* d = scr + (8 * i + (lane >> 3)) * 33 + 4 * (lane & 7); d[0] = v[i].x * mul; d[1] = v[i].y * mul; d[2] = v[i].z * mul; d[3] = v[i].w * mul; }
    LDS_WAIT(); asm volatile("" ::: "memory");
}
DI void tr_emit_f8x16(unsigned char* WT, int K, int k0, int n0, LAS float* scr, int lane) {
    const int c = lane & 7;
#pragma unroll
    for (int j = 0; j < 4; ++j) { const int n = (lane >> 3) + 8 * j; const LAS float* sp = scr + (16 * c) * 33 + n; unsigned q[4];
#pragma unroll
        for (int h = 0; h < 4; ++h) { int w = 0; w = __builtin_amdgcn_cvt_pk_fp8_f32(sp[(4 * h) * 33], sp[(4 * h + 1) * 33], w, false); w = __builtin_amdgcn_cvt_pk_fp8_f32(sp[(4 * h + 2) * 33], sp[(4 * h + 3) * 33], w, true); q[h] = (unsigned)w; }
        *(v4u*)(WT + (size_t)(n0 + n) * K + k0 + 16 * c) = (v4u){q[0], q[1], q[2], q[3]}; }
    LDS_WAIT(); asm volatile("" ::: "memory");
}
DI void tr_fill_v4(const float* W, int ldw, int k0, int n0, LAS float* scr, int lane, float mul) { f32x4 v[8]; tr_load_v4(W, ldw, k0, n0, lane, v); tr_put_v4(v, scr, lane, mul); }
DI void tr_emit_bf16(bf16* WT, int K, int k0, int n0, LAS float* scr, int lane) {
    const int c = lane & 7;
#pragma unroll
    for (int j = 0; j < 4; ++j) { const int n = (lane >> 3) + 8 * j; const LAS float* sp = scr + (8 * c) * 33 + n;
        v4u o; o.x = pk2(sp[0 * 33], sp[1 * 33]); o.y = pk2(sp[2 * 33], sp[3 * 33]); o.z = pk2(sp[4 * 33], sp[5 * 33]); o.w = pk2(sp[6 * 33], sp[7 * 33]);
        *(v4u*)(WT + (size_t)(n0 + n) * K + k0 + 8 * c) = o; }
    LDS_WAIT(); asm volatile("" ::: "memory");
}
DI void tr_emit_f8(unsigned char* WT, int K, int k0, int n0, LAS float* scr, int lane) {
    const int c = lane & 7;
#pragma unroll
    for (int j = 0; j < 4; ++j) { const int n = (lane >> 3) + 8 * j; const LAS float* sp = scr + (8 * c) * 33 + n;
        int lo = 0, hi = 0;
        lo = __builtin_amdgcn_cvt_pk_fp8_f32(sp[0 * 33], sp[1 * 33], lo, false); lo = __builtin_amdgcn_cvt_pk_fp8_f32(sp[2 * 33], sp[3 * 33], lo, true);
        hi = __builtin_amdgcn_cvt_pk_fp8_f32(sp[4 * 33], sp[5 * 33], hi, false); hi = __builtin_amdgcn_cvt_pk_fp8_f32(sp[6 * 33], sp[7 * 33], hi, true);
        typedef unsigned u32x2t __attribute__((ext_vector_type(2)));
        *(u32x2t*)(WT + (size_t)(n0 + n) * K + k0 + 8 * c) = (u32x2t){(unsigned)lo, (unsigned)hi}; }
    LDS_WAIT(); asm volatile("" ::: "memory");
}
template <class CM>
DI void tr_fill_v4cm(const float* W, int ldw, int k0, int n0, CM cm, LAS float* scr, int lane, float mul) {
    const int sc = cm(n0 + 4 * (lane & 7)); f32x4 v[8];
#pragma unroll
    for (int i = 0; i < 8; ++i) v[i] = sc >= 0 ? *(const f32x4*)(W + (size_t)(k0 + 8 * i + (lane >> 3)) * ldw + sc) : (f32x4){0.f, 0.f, 0.f, 0.f};
    tr_put_v4(v, scr, lane, mul);
}
template <class CM>
DI void tr_fill_cm(const float* W, int ldw, int k0, int n0, CM cm, LAS float* scr, int lane, float mul) {
    const int sc = cm(n0 + (lane & 31));
#pragma unroll 8
    for (int i = 0; i < 32; ++i) { const int kk = 2 * i + (lane >> 5); scr[kk * 33 + (lane & 31)] = sc >= 0 ? W[(size_t)(k0 + kk) * ldw + sc] * mul : 0.f; }
    LDS_WAIT(); asm volatile("" ::: "memory");
}
struct CmId { DI int operator()(int j) const { return j; } };
struct CmProj { DI int operator()(int j) const { return proj_srccol(j); } };

DI void rms_row_bf16(const float* xrow, const float* g, bf16* orow, int lane) {
    const f32x4* xr = (const f32x4*)xrow + lane; const f32x4* gr = (const f32x4*)g + lane;
    f32x4 v[4]; float s = 0.f;
#pragma unroll
    for (int j = 0; j < 4; ++j) { v[j] = xr[64 * j]; s += (v[j].x * v[j].x + v[j].y * v[j].y) + (v[j].z * v[j].z + v[j].w * v[j].w); }
    const float rstd = rsqrtf(wave_sum(s) * (1.f / DM) + EPS);
    unsigned long long* o8 = (unsigned long long*)orow + lane;
#pragma unroll
    for (int j = 0; j < 4; ++j) { const f32x4 gg = gr[64 * j];
        o8[64 * j] = (unsigned long long)pk2(v[j].x * rstd * gg.x, v[j].y * rstd * gg.y) | ((unsigned long long)pk2(v[j].z * rstd * gg.z, v[j].w * rstd * gg.w) << 32); }
}

DI void rms_row_f8(const float* xrow, const float* g, unsigned char* orow, int lane) {
    const f32x4* xr = (const f32x4*)xrow + lane; const f32x4* gr = (const f32x4*)g + lane;
    f32x4 v[4]; float s = 0.f;
#pragma unroll
    for (int j = 0; j < 4; ++j) { v[j] = xr[64 * j]; s += (v[j].x * v[j].x + v[j].y * v[j].y) + (v[j].z * v[j].z + v[j].w * v[j].w); }
    const float rstd = rsqrtf(wave_sum(s) * (1.f / DM) + EPS);
    unsigned* o4 = (unsigned*)orow + lane;
#pragma unroll
    for (int j = 0; j < 4; ++j) { const f32x4 gg = gr[64 * j]; int q8 = 0;
        q8 = __builtin_amdgcn_cvt_pk_fp8_f32(v[j].x * rstd * gg.x, v[j].y * rstd * gg.y, q8, false); q8 = __builtin_amdgcn_cvt_pk_fp8_f32(v[j].z * rstd * gg.z, v[j].w * rstd * gg.w, q8, true);
        o4[64 * j] = (unsigned)q8; }
}
template <int NR>
DI void rms_rows_both(const float* x0, const float* g, bf16* o0, unsigned char* o80, size_t step, int lane) {
    const f32x4* gr = (const f32x4*)g + lane;
    f32x4 v[NR][4];
#pragma unroll
    for (int q = 0; q < NR; ++q) { const f32x4* xr = (const f32x4*)(x0 + q * step * DM) + lane;
#pragma unroll
        for (int j = 0; j < 4; ++j) v[q][j] = xr[64 * j]; }
#pragma unroll
    for (int q = 0; q < NR; ++q) { float s = 0.f;
#pragma unroll
        for (int j = 0; j < 4; ++j) s += (v[q][j].x * v[q][j].x + v[q][j].y * v[q][j].y) + (v[q][j].z * v[q][j].z + v[q][j].w * v[q][j].w);
        const float rstd = rsqrtf(wave_sum(s) * (1.f / DM) + EPS);
        unsigned long long* o8 = (unsigned long long*)(o0 + q * step * DM) + lane; unsigned* o4 = (unsigned*)(o80 + q * step * DM) + lane;
#pragma unroll
        for (int j = 0; j < 4; ++j) { const f32x4 gg = gr[64 * j]; const float y0 = v[q][j].x * rstd * gg.x, y1 = v[q][j].y * rstd * gg.y, y2 = v[q][j].z * rstd * gg.z, y3 = v[q][j].w * rstd * gg.w;
            o8[64 * j] = (unsigned long long)pk2(y0, y1) | ((unsigned long long)pk2(y2, y3) << 32);
            int q8 = 0; q8 = __builtin_amdgcn_cvt_pk_fp8_f32(y0, y1, q8, false); q8 = __builtin_amdgcn_cvt_pk_fp8_f32(y2, y3, q8, true);
            o4[64 * j] = (unsigned)q8; } }
}
template <int PARTS = 0xf>
DI void p0_prologue(Frame& F) {
    LAS float* scr = (LAS float*)(F.lds + F.wave * 16384);
    const int gw = F.bx * NWAVES + F.wave, NGW = F.G * NWAVES;
    unsigned char* ws = F.ws;
    constexpr int IT_IN = 16 * (NPROJ / 32), IT_GU = 32 * 16 * 64, IT_DN = 32 * 16 * 32, IT_MKV = 16 * 32, IT_BR = 3 * 8 * 32, IT_OUT = 16 * 32, IT_C1 = 2 * 32 * 8;
    constexpr int NITEMS = IT_IN + IT_GU + IT_DN + IT_MKV + IT_BR + IT_OUT + IT_C1;
    if (PARTS & 1)
    {
        constexpr int JT_GU = 32 * 8 * 64, JT_DN = 32 * 8 * 32;
        struct D { const float* src; unsigned char* dst; int ldw, k0, n0; };
        auto dec = [&](int j) { D d; if (j < JT_GU) { const int e = j / 512, q = j % 512; d.src = F.in[I_WGU] + (size_t)e * DM * 2048; d.dst = (unsigned char*)(ws + WS_WGU) + (size_t)e * 2048 * DM; d.ldw = 2048; d.k0 = 128 * (q / 64); d.n0 = 32 * (q % 64); }
                                     else { const int jj = j - JT_GU, e = jj / 256, q = jj % 256; d.src = F.in[I_WDN] + (size_t)e * DFF * DM; d.dst = (unsigned char*)(ws + WS_WDN) + (size_t)e * DM * DFF; d.ldw = DM; d.k0 = 128 * (q / 32); d.n0 = 32 * (q % 32); } return d; };
        const int lane = F.lane_id();
        LAS float* scr2 = (LAS float*)(F.wave < 7 ? F.lds + F.wave * 16896 : F.lds + 135424);
        int j = gw; f32x4 va[16]; D da{};
        if (j < JT_GU + JT_DN) { da = dec(j); tr_load_v4x16(da.src, da.ldw, da.k0, da.n0, lane, va); }
#pragma unroll 1
        while (j < JT_GU + JT_DN) {
            const int jn = j + NGW; f32x4 vb[16]; D db{};
            if (jn < JT_GU + JT_DN) { db = dec(jn); tr_load_v4x16(db.src, db.ldw, db.k0, db.n0, lane, vb); }
            else {
#pragma unroll
                for (int i = 0; i < 16; ++i) vb[i] = va[i]; }
            tr_put_v4x16(va, scr2, lane, 256.0f); tr_emit_f8x16(da.dst, 1024, da.k0, da.n0, scr2, lane);
#pragma unroll
            for (int i = 0; i < 16; ++i) va[i] = vb[i];
            da = db; j = jn;
        }
        __syncthreads();
    }
    if (PARTS & 2)
    for (int it = gw; it < NITEMS; it += NGW) {
        int r = it;
        if (r < IT_IN) { const int kb = r / (NPROJ / 32), nb = r % (NPROJ / 32); if (32 * nb < NB16) { tr_fill_v4cm(F.in[I_WIN], DIN_SRC, 64 * kb, 32 * nb, CmProj(), scr, F.lane_id(), 1.0f); tr_emit_bf16((bf16*)(ws + WS_WIN), DM, 64 * kb, 32 * nb, scr, F.lane_id()); }
            else { tr_fill_v4cm(F.in[I_WIN], DIN_SRC, 64 * kb, 32 * nb, CmProj(), scr, F.lane_id(), 256.0f); tr_emit_f8((unsigned char*)(ws + WS_WIN8), DM, 64 * kb, 32 * nb - NB16, scr, F.lane_id()); }
            continue; } r -= IT_IN;
        if (r < IT_GU + IT_DN) continue; r -= IT_GU + IT_DN;
        if (r < IT_MKV) { const int kb = r / 32, nb = r % 32; tr_fill_v4(F.in[I_WMKV], 1024, 64 * kb, 32 * nb, scr, F.lane_id(), 1.0f); tr_emit_bf16((bf16*)(ws + WS_WMKV), 1024, 64 * kb, 32 * nb, scr, F.lane_id()); continue; } r -= IT_MKV;
        if (r < IT_BR) { const int b = r / 256, q = r % 256, kb = q / 32, nb = q % 32; tr_fill_v4(F.in[I_WBRML + b], 1024, 64 * kb, 32 * nb, scr, F.lane_id(), 1.0f); tr_emit_bf16((bf16*)(ws + WS_WBR), 1536, 512 * b + 64 * kb, 32 * nb, scr, F.lane_id()); continue; } r -= IT_BR;
        if (r < IT_OUT) { const int kb = r / 32, nb = r % 32; tr_fill_v4(F.in[I_WOUT], 1024, 64 * kb, 32 * nb, scr, F.lane_id(), 1.0f); tr_emit_bf16((bf16*)(ws + WS_WOUT), 1024, 64 * kb, 32 * nb, scr, F.lane_id()); continue; } r -= IT_OUT;
        { const int kv = r / 256, q = r % 256, kb = q / 8, nb = q % 8; tr_fill_v4(F.in[kv ? I_CW1V : I_CW1K], 256, 64 * kb, 32 * nb, scr, F.lane_id(), 1.0f); tr_emit_bf16((bf16*)(ws + WS_WC1) + (size_t)kv * 256 * 2048, 2048, 64 * kb, 32 * nb, scr, F.lane_id()); }
    }
    if (PARTS & 4)
    { int m = gw;
      for (; m + 3 * NGW < MT; m += 4 * NGW) rms_rows_both<4>(F.in[I_X] + (size_t)m * DM, F.in[I_GMIX], (bf16*)(ws + WS_R1) + (size_t)m * DM, (unsigned char*)(ws + WS_U8) + (size_t)m * DM, (size_t)NGW, F.lane_id());
      for (; m < MT; m += NGW) rms_rows_both<1>(F.in[I_X] + (size_t)m * DM, F.in[I_GMIX], (bf16*)(ws + WS_R1) + (size_t)m * DM, (unsigned char*)(ws + WS_U8) + (size_t)m * DM, (size_t)NGW, F.lane_id()); }
    for (int m = gw; m < MROWS; m += NGW) rms_row_bf16(F.in[I_MEM] + (size_t)m * DM, F.in[I_GMEM], (bf16*)(ws + WS_MEMN) + (size_t)m * DM, F.lane_id());
    float* rc = (float*)(ws + WS_SMALL + SM_ROPEC); float* rs = (float*)(ws + WS_SMALL + SM_ROPES);
    for (int i = F.bx * 512 + F.tid_id(); i < SEQ * 32; i += F.G * 512) {
        const int p = i >> 5, k = i & 31;
        const float invf = exp2f(-(float)k * (13.287712379549449f / 32.0f));
        const float ang = (float)p * invf;
        const float kf = rintf(ang * 0.15915494309189535f);
        float r = fmaf(-kf, 6.28125f, ang); r = fmaf(-kf, 1.9353071795864769e-3f, r);
        rc[i] = cosf(r); rs[i] = sinf(r);
    }
    { bf16* wrt = (bf16*)(ws + WS_SMALL + SM_WRT);
      for (int i = F.bx * 512 + F.tid_id(); i < 32 * 1024; i += F.G * 512) { const int e = i >> 10, k = i & 1023; const float w = F.in[I_WR][k * 32 + e]; const unsigned hi = f2bf(w); wrt[i] = (bf16)hi; wrt[32 * 1024 + i] = (bf16)f2bf(w - __uint_as_float(hi << 16)); } }
    { bf16* w2t = (bf16*)(ws + WS_SMALL + SM_W2T);
      for (int i = F.bx * 512 + F.tid_id(); i < 2 * 64 * 256; i += F.G * 512) { const int kv = i >> 14, d = (i >> 8) & 63, f = i & 255; w2t[i] = (bf16)f2bf(F.in[kv ? I_CW2V : I_CW2K][f * 64 + d]); } }
    for (int o = gw; o < 512; o += NGW) {
        const int kv = o >> 8, f = o & 255, lane = F.lane_id();
        const float* pe = F.in[kv ? I_CPV : I_CPK]; const float* w1 = F.in[kv ? I_CW1V : I_CW1K];
        float wv[32], pv[32];
#pragma unroll
        for (int i = 0; i < 32; ++i) { const int k = lane + 64 * i; wv[i] = w1[(size_t)k * 256 + f]; pv[i] = pe[k]; }
        float a = 0.f;
#pragma unroll
        for (int i = 0; i < 32; ++i) a = fmaf(pv[i], wv[i], a);
        a = wave_sum(a);
        if (lane == 0) ((float*)(ws + WS_SMALL + SM_CBIAS))[o] = a + F.in[kv ? I_CB1V : I_CB1K][f];
    }
}

DI void unpack8(const v4u& w, float (&f)[8]) {
    f[0] = __uint_as_float(w.x << 16); f[1] = __uint_as_float(w.x & 0xffff0000u); f[2] = __uint_as_float(w.y << 16); f[3] = __uint_as_float(w.y & 0xffff0000u);
    f[4] = __uint_as_float(w.z << 16); f[5] = __uint_as_float(w.z & 0xffff0000u); f[6] = __uint_as_float(w.w << 16); f[7] = __uint_as_float(w.w & 0xffff0000u);
}
DI v4u pack8f(const float (&f)[8]) { v4u o; o.x = pk2(f[0], f[1]); o.y = pk2(f[2], f[3]); o.z = pk2(f[4], f[5]); o.w = pk2(f[6], f[7]); return o; }
DI void load8f(const float* p, float (&f)[8]) { const f32x4 a = *(const f32x4*)p, b = *(const f32x4*)(p + 4); f[0] = a.x; f[1] = a.y; f[2] = a.z; f[3] = a.w; f[4] = b.x; f[5] = b.y; f[6] = b.z; f[7] = b.w; }
DI void norm_rope64(float (&f)[8], const float (&g)[8], const float (&c8)[8], const float (&s8)[8], int lane, float scale) {
    float ss = 0.f;
#pragma unroll
    for (int i = 0; i < 8; ++i) ss = fmaf(f[i], f[i], ss);
    ss += __shfl_xor(ss, 1); ss += __shfl_xor(ss, 2); ss += __shfl_xor(ss, 4);
    const float rstd = rsqrtf(ss * (1.f / 64.f) + EPS);
    const bool hi = (lane & 4) != 0;
#pragma unroll
    for (int i = 0; i < 8; ++i) { const float y = f[i] * rstd * g[i]; const float pt = __shfl_xor(y, 4); f[i] = (hi ? fmaf(pt, s8[i], y * c8[i]) : fmaf(-pt, s8[i], y * c8[i])) * scale; }
}
DI void p2_prep(Frame& F) {
    unsigned char* ws = F.ws;
    const int ncg = F.G >= 64 ? 32 : 0;
    if (F.bx < ncg) return;
    const int gw = (F.bx - ncg) * NWAVES + F.wave, NGW = (F.G - ncg) * NWAVES, lane = F.lane_id();
    const bf16* proj = (const bf16*)(ws + WS_PROJ);
    const float* rc = (const float*)(ws + WS_SMALL + SM_ROPEC); const float* rs = (const float*)(ws + WS_SMALL + SM_ROPES);
    bf16* qn = (bf16*)(ws + WS_QN); bf16* ksn = (bf16*)(ws + WS_KSN); bf16* kwn = (bf16*)(ws + WS_KWN); bf16* mqn = (bf16*)(ws + WS_MQN); bf16* mlqk = (bf16*)(ws + WS_MLQK);
    constexpr int NT = 4;
    {
        float gq8[8], mg8[8]; load8f(F.in[I_NGQ] + 8 * (lane & 7), gq8); load8f(F.in[I_MGQ] + 8 * (lane & 15), mg8);
        for (int t0 = gw * NT; t0 < MT; t0 += NGW * NT) {
            v4u a[NT], bq[NT]; float c8[NT][8], s8[NT][8];
#pragma unroll
            for (int u = 0; u < NT; ++u) { const int t = t0 + u, tau = t & 2047; const bf16* pr = proj + (size_t)t * NPROJ;
                a[u] = *(const v4u*)(pr + PC_NQ + 8 * lane); bq[u] = *(const v4u*)(pr + PC_MQ + 8 * lane);
                load8f(rc + tau * 32 + 8 * (lane & 3), c8[u]); load8f(rs + tau * 32 + 8 * (lane & 3), s8[u]); }
#pragma unroll
            for (int u = 0; u < NT; ++u) { const int t = t0 + u;
                float f[8]; unpack8(a[u], f);
                norm_rope64(f, gq8, c8[u], s8[u], lane, 0.125f * 1.4426950408889634f);
                *(v4u*)(qn + (size_t)t * 512 + 8 * lane) = pack8f(f);
                unpack8(bq[u], f);
                float ss = 0.f;
#pragma unroll
                for (int i = 0; i < 8; ++i) ss = fmaf(f[i], f[i], ss);
                ss += __shfl_xor(ss, 1); ss += __shfl_xor(ss, 2); ss += __shfl_xor(ss, 4); ss += __shfl_xor(ss, 8);
                const float rstd = rsqrtf(ss * (1.f / 128.f) + EPS) * (0.08838834764831845f * 1.4426950408889634f);
#pragma unroll
                for (int i = 0; i < 8; ++i) f[i] *= rstd * mg8[i];
                *(v4u*)(mqn + (size_t)t * 512 + 8 * lane) = pack8f(f);
                }
        }
    }
    {
        const int L = lane & 31, hd4 = L >> 3, j = L & 7, half = lane >> 5;
        float gk8[8]; load8f(F.in[I_NGK] + (1 + (hd4 >> 1)) * 64 + 8 * j, gk8);
        const int kcol = (hd4 < 2 ? PC_NKS + hd4 * 64 : PC_NKW + (hd4 - 2) * 64) + 8 * j;
        bf16* kdst = (hd4 < 2 ? ksn : kwn) + (hd4 & 1) * 64 + 8 * j;
        const int wv = L >> 4, jj = L & 15;
        bf16* vdst = (bf16*)(ws + (wv ? WS_VWN : WS_VSN)) + 8 * jj; const int vcol = (wv ? PC_NVW : PC_NVS) + 8 * jj;
        for (int tp0 = gw * NT; tp0 < MT / 2; tp0 += NGW * NT) {
            v4u a[NT]; float c8[NT][8], s8[NT][8];
#pragma unroll
            for (int u = 0; u < NT; ++u) { const int t = 2 * (tp0 + u) + half, tau = t & 2047; const bf16* pr = proj + (size_t)t * NPROJ;
                a[u] = *(const v4u*)(pr + kcol);
                load8f(rc + tau * 32 + 8 * (lane & 3), c8[u]); load8f(rs + tau * 32 + 8 * (lane & 3), s8[u]); }
#pragma unroll
            for (int u = 0; u < NT; ++u) { const int t = 2 * (tp0 + u) + half;
                float f[8]; unpack8(a[u], f);
                norm_rope64(f, gk8, c8[u], s8[u], lane, 1.0f);
                *(v4u*)(kdst + (size_t)t * 128) = pack8f(f); }
        }
    }
    for (int run = gw; run < MT / 16; run += NGW) {
        const int t0 = run * 16, tau0 = t0 & 2047;
#pragma unroll 1
        for (int sp = 0; sp < 2; ++sp) {
            const int ch = 512 * sp + 8 * lane;
            float w0[8], w1[8], w2[8], w3[8], bb[8];
            load8f(F.in[I_CONVW] + ch, w0); load8f(F.in[I_CONVW] + 1024 + ch, w1); load8f(F.in[I_CONVW] + 2048 + ch, w2); load8f(F.in[I_CONVW] + 3072 + ch, w3); load8f(F.in[I_CONVB] + ch, bb);
            float x0[8], x1[8], x2[8];
            if (tau0 >= 3) { unpack8(*(const v4u*)(proj + (size_t)(t0 - 3) * NPROJ + ch), x0); unpack8(*(const v4u*)(proj + (size_t)(t0 - 2) * NPROJ + ch), x1); unpack8(*(const v4u*)(proj + (size_t)(t0 - 1) * NPROJ + ch), x2); }
            else {
#pragma unroll
                for (int i = 0; i < 8; ++i) { x0[i] = 0.f; x1[i] = 0.f; x2[i] = 0.f; } }
#pragma unroll 1
            for (int k0 = 0; k0 < 16; k0 += 4) {
                v4u raw[4];
#pragma unroll
                for (int k = 0; k < 4; ++k) raw[k] = *(const v4u*)(proj + (size_t)(t0 + k0 + k) * NPROJ + ch);
#pragma unroll
                for (int k = 0; k < 4; ++k) { float x3[8], y[8]; unpack8(raw[k], x3);
#pragma unroll
                    for (int i = 0; i < 8; ++i) { const float a = fmaf(w3[i], x3[i], fmaf(w2[i], x2[i], fmaf(w1[i], x1[i], fmaf(w0[i], x0[i], bb[i])))); y[i] = a * sigm(a); x0[i] = x1[i]; x1[i] = x2[i]; x2[i] = x3[i]; }
                    *(v4u*)(mlqk + (size_t)(t0 + k0 + k) * 1024 + ch) = pack8f(y); }
            }
        }
    }
    {
        const bf16* memkv = (const bf16*)(ws + WS_MEMKV); bf16* memkn = (bf16*)(ws + WS_MEMKN);
        float kg8[8]; load8f(F.in[I_MGK] + 8 * (lane & 15), kg8);
        for (int r = gw; r < MROWS; r += NGW) {
            float f[8]; unpack8(*(const v4u*)(memkv + (size_t)r * 1024 + 8 * lane), f);
            float ss = 0.f;
#pragma unroll
            for (int i = 0; i < 8; ++i) ss = fmaf(f[i], f[i], ss);
            ss += __shfl_xor(ss, 1); ss += __shfl_xor(ss, 2); ss += __shfl_xor(ss, 4); ss += __shfl_xor(ss, 8);
            const float rstd = rsqrtf(ss * (1.f / 128.f) + EPS);
#pragma unroll
            for (int i = 0; i < 8; ++i) f[i] *= rstd * kg8[i];
            *(v4u*)(memkn + (size_t)r * 512 + 8 * lane) = pack8f(f);
        }
    }
}

DI void p4_kcvc(Frame& F) {
    unsigned char* ws = F.ws;
    const int gw = F.bx * NWAVES + F.wave, NGW = F.G * NWAVES, lane = F.lane_id();
    const bf16* hid = (const bf16*)(ws + WS_HID);
    const float* rc = (const float*)(ws + WS_SMALL + SM_ROPEC); const float* rs = (const float*)(ws + WS_SMALL + SM_ROPES);
    const float gk = F.in[I_NGK][lane];
    for (int it = gw; it < 2 * 4096; it += NGW) {
        const int kv = it >> 12, r = it & 4095, n = r & 127;
        bf16* dst = (bf16*)(ws + (kv ? WS_VC : WS_KC)) + (size_t)r * 64 + lane;
        if (n == 127) { *dst = 0; continue; }
        const bf16* hr = hid + (size_t)kv * 4096 * 256 + (size_t)r * 256; const float* w2 = F.in[kv ? I_CW2V : I_CW2K];
        float a = 0.f;
        for (int f = 0; f < 256; ++f) a = fmaf(bf2f(hr[f]), w2[f * 64 + lane], a);
        if (kv == 0) {
            const float y = a * rsqrtf(wave_sum(a * a) * (1.f / 64.f) + EPS) * gk;
            const int pos = 16 * n + 31; const float c = rc[pos * 32 + (lane & 31)], s = rs[pos * 32 + (lane & 31)];
            const float pt = __shfl_xor(y, 32);
            a = lane < 32 ? y * c - pt * s : y * c + pt * s;
        }
        *dst = (bf16)f2bf(a);
    }
}

typedef float f32x16 __attribute__((ext_vector_type(16)));
typedef float f32x2v __attribute__((ext_vector_type(2)));
typedef __bf16 bf16x2v __attribute__((ext_vector_type(2)));
typedef short s16x4 __attribute__((ext_vector_type(4)));
typedef unsigned u32x2 __attribute__((ext_vector_type(2)));
#define MFMA32(a, b, c) __builtin_amdgcn_mfma_f32_32x32x16_bf16((a), (b), (c), 0, 0, 0)
#define WG_BAR() do { asm volatile("s_waitcnt vmcnt(0) lgkmcnt(0)" ::: "memory"); __builtin_amdgcn_s_barrier(); asm volatile("" ::: "memory"); } while (0)
DI unsigned pkbf(float lo, float hi) { f32x2v v = {lo, hi}; return __builtin_bit_cast(unsigned, __builtin_convertvector(v, bf16x2v)); }
template <int S> DI bf16x8 pack8(const f32x16& x) {
    v4u p; p.x = pkbf(x[8 * S], x[8 * S + 1]); p.y = pkbf(x[8 * S + 2], x[8 * S + 3]); p.z = pkbf(x[8 * S + 4], x[8 * S + 5]); p.w = pkbf(x[8 * S + 6], x[8 * S + 7]);
    return __builtin_bit_cast(bf16x8, p);
}
DI int crow(int i, int h) { return (i & 3) + 8 * (i >> 2) + 4 * h; }
constexpr int AT_K = 0, AT_V = 32768, AT_IMP = 65536, AT_WM = 98304, AT_INV = 98368, AT_SC = 99392;

DI void glds16(const void* gsrc, unsigned lds_dst) { unsigned keep; asm volatile("s_mov_b32 %0, m0\n\ts_mov_b32 m0, %2\n\ts_nop 0\n\tglobal_load_lds_dwordx4 %1, off\n\ts_mov_b32 m0, %0" : "=&s"(keep) : "v"(gsrc), "s"(lds_dst) : "memory"); }
DI void at_load(LAS unsigned char* lds, int par, const void* kb, size_t kpitch, const void* vb, size_t vpitch, int wave, int lane) {
    const int row = 8 * wave + (lane >> 3), pc = lane & 7;
    const int kc = pc ^ ((row >> 1) & 7), vc = pc ^ (((row >> 1) & 1) << 2);
    glds16((const char*)kb + (size_t)row * kpitch + 16 * kc, (unsigned)(size_t)(lds + AT_K + par * 8192 + wave * 1024));
    glds16((const char*)vb + (size_t)row * vpitch + 16 * vc, (unsigned)(size_t)(lds + AT_V + par * 8192 + wave * 1024));
}
#define SB() __builtin_amdgcn_sched_barrier(0)
typedef __attribute__((address_space(3))) s16x4 lds_s16x4;
DI void at_qk(const LAS unsigned char* kbuf, const int (&ka)[4], const bf16x8 (&qf)[4], f32x16 (&s)[2]) {
    bf16x8 kf[2][4];
#pragma unroll
    for (int kb = 0; kb < 2; ++kb)
#pragma unroll
        for (int st = 0; st < 4; ++st) kf[kb][st] = *(const LAS bf16x8*)(kbuf + ka[st] + kb * 4096);
    SB();
#pragma unroll
    for (int kb = 0; kb < 2; ++kb) {
        f32x16 a;
#pragma unroll
        for (int i = 0; i < 16; ++i) a[i] = 0.f;
#pragma unroll
        for (int st = 0; st < 4; ++st) a = MFMA32(kf[kb][st], qf[st], a);
        s[kb] = a;
    }
}
DI void at_vload(const LAS unsigned char* vbuf, const int (&va)[2], int kb, bf16x8 (&vf)[2][2]) {
#pragma unroll
    for (int s2 = 0; s2 < 2; ++s2)
#pragma unroll
        for (int db = 0; db < 2; ++db) {
            const s16x4 lo = __builtin_amdgcn_ds_read_tr16_b64_v4i16((lds_s16x4*)(vbuf + va[db] + kb * 4096 + s2 * 2048));
            const s16x4 hi = __builtin_amdgcn_ds_read_tr16_b64_v4i16((lds_s16x4*)(vbuf + va[db] + kb * 4096 + s2 * 2048 + 1024));
            vf[s2][db] = __builtin_shufflevector(lo, hi, 0, 1, 2, 3, 4, 5, 6, 7); }
}
DI void at_pv1(const bf16x8 (&vf)[2][2], const f32x16& p, f32x16 (&o)[2]) {
    const bf16x8 pf0 = pack8<0>(p), pf1 = pack8<1>(p);
#pragma unroll
    for (int s2 = 0; s2 < 2; ++s2)
#pragma unroll
        for (int db = 0; db < 2; ++db) o[db] = MFMA32(vf[s2][db], s2 ? pf1 : pf0, o[db]);
}
DI void at_pv(const LAS unsigned char* vbuf, const int (&va)[2], const bf16x8 (&vf0)[2][2], const f32x16 (&p)[2], f32x16 (&o)[2]) {
    bf16x8 vf1[2][2]; at_vload(vbuf, va, 1, vf1);
    at_pv1(vf0, p[0], o);
    at_pv1(vf1, p[1], o);
}
template <class MaskF>
DI void at_exp_pack(const f32x16 (&s)[2], float& l, bf16x8 (&pf)[2][2], MaskF valid) {
#pragma unroll
    for (int kb = 0; kb < 2; ++kb)
#pragma unroll
        for (int s2 = 0; s2 < 2; ++s2) { unsigned w[4];
#pragma unroll
            for (int q = 0; q < 4; ++q) { const int i0 = 8 * s2 + 2 * q;
                const float e0 = __builtin_amdgcn_exp2f(s[kb][i0]), e1 = __builtin_amdgcn_exp2f(s[kb][i0 + 1]);
                const float p0 = valid(kb, i0) ? e0 : 0.f, p1 = valid(kb, i0 + 1) ? e1 : 0.f; l += p0; l += p1; w[q] = pkbf(p0, p1); }
            pf[kb][s2] = __builtin_bit_cast(bf16x8, (v4u){w[0], w[1], w[2], w[3]}); }
}
struct MaskAll { DI bool operator()(int, int) const { return true; } };
DI void at_pv2(const LAS unsigned char* vbuf, const int (&va)[2], const bf16x8 (&vf0)[2][2], const bf16x8 (&pf)[2][2], f32x16 (&o)[2]) {
    bf16x8 vf1[2][2]; at_vload(vbuf, va, 1, vf1);
#pragma unroll
    for (int s2 = 0; s2 < 2; ++s2)
#pragma unroll
        for (int db = 0; db < 2; ++db) o[db] = MFMA32(vf0[s2][db], pf[0][s2], o[db]);
#pragma unroll
    for (int s2 = 0; s2 < 2; ++s2)
#pragma unroll
        for (int db = 0; db < 2; ++db) o[db] = MFMA32(vf1[s2][db], pf[1][s2], o[db]);
}
DI void at_exp_all(f32x16 (&s)[2], float& l) {
#pragma unroll
    for (int kb = 0; kb < 2; ++kb)
#pragma unroll
        for (int i = 0; i < 16; ++i) { const float p = __builtin_amdgcn_exp2f(s[kb][i]); s[kb][i] = p; l += p; }
}
DI void at_wait(int n) {
    if (n >= 2) asm volatile("s_waitcnt vmcnt(4)" ::: "memory"); else if (n == 1) asm volatile("s_waitcnt vmcnt(2)" ::: "memory"); else asm volatile("s_waitcnt vmcnt(0)" ::: "memory");
    asm volatile("s_waitcnt lgkmcnt(0)" ::: "memory"); __builtin_amdgcn_s_barrier(); asm volatile("" ::: "memory");
}
template <bool STORE = true, bool DO_CMP = true, bool DO_SEL = true, bool DO_WIN = true>
DI void nsa_unit(Frame& F, int unit) {
    unsigned char* ws = F.ws; LAS unsigned char* lds = F.lds;
    int lane_ = F.lane_id();
    const int lane = lane_, wave = F.wave, r = lane & 31, h = lane >> 5, g = wave >> 1, qh = wave & 1;
    const int bh = unit & 31, qt = 31 - (unit >> 5), b = bh >> 1, hkv = bh & 1;
    const int qloc = 32 * qh + r, tau = 64 * qt + qloc, qq = tau & 63; const size_t t = (size_t)b * SEQ + tau;
    const bf16* proj = (const bf16*)(ws + WS_PROJ);
    const bf16* qn = (const bf16*)(ws + WS_QN); const bf16* ksn = (const bf16*)(ws + WS_KSN); const bf16* kwn = (const bf16*)(ws + WS_KWN);
    const bf16* kc = (const bf16*)(ws + WS_KC); const bf16* vc = (const bf16*)(ws + WS_VC); bf16* H1 = (bf16*)(ws + WS_H0);
    int ka[4], va[2];
    { const int f = (r >> 1) & 7, fs = f >> 1, hb = h ^ (f & 1);
#pragma unroll
      for (int st = 0; st < 4; ++st) ka[st] = r * 128 + 16 * (((st ^ fs) << 1) | hb);
      const int i16 = lane & 15, q = i16 >> 2, p = i16 & 3, g1 = (lane >> 4) & 1;
#pragma unroll
      for (int db = 0; db < 2; ++db) va[db] = (4 * h + q) * 128 + 16 * ((4 * db + 2 * g1 + (p >> 1)) ^ (((q >> 1) & 1) << 2)) + 8 * (p & 1); }
    asm volatile("s_waitcnt lgkmcnt(0)" ::: "memory"); __builtin_amdgcn_s_barrier(); asm volatile("" ::: "memory");
    const int ntc = (((64 * qt + 63 - 31) >> 4) + 1 > 64) ? 2 : 1;
    if (DO_CMP) { const char* kb0 = (const char*)(kc + (size_t)(b * 2 + hkv) * 128 * 64); const char* vb0 = (const char*)(vc + (size_t)(b * 2 + hkv) * 128 * 64);
        at_load(lds, 0, kb0, 128, vb0, 128, wave, lane);
        if (ntc == 2) at_load(lds, 1, kb0 + 64 * 128, 128, vb0 + 64 * 128, 128, wave, lane); }
    bf16x8 qf[4];
#pragma unroll
    for (int st = 0; st < 4; ++st) qf[st] = *(const bf16x8*)(qn + t * 512 + (hkv * 4 + g) * 64 + 16 * st + 8 * h);
    float gate[3];
#pragma unroll
    for (int c = 0; c < 3; ++c) gate[c] = sigm(bf2f(proj[t * NPROJ + PC_NG + (hkv * 4 + g) * 3 + c]));
    f32x16 ofin[2];
#pragma unroll
    for (int i = 0; i < 16; ++i) { ofin[0][i] = 0.f; ofin[1][i] = 0.f; }
    if (DO_CMP) {
        const int ncq = tau >= 31 ? ((tau - 31) >> 4) + 1 : 0;
        WG_BAR();
        f32x16 o[2]; float l = 0.f, prevEp = 0.f;
#pragma unroll
        for (int i = 0; i < 16; ++i) { o[0][i] = 0.f; o[1][i] = 0.f; }
        LAS float* I = (LAS float*)(lds + AT_IMP) + (g * 64 + qloc) * 32;
#pragma unroll 1
        for (int tile = 0; tile < 2; ++tile) {
            if (tile < ntc) {
                f32x16 s[2];
                at_qk(lds + AT_K + tile * 8192, ka, qf, s);
                bf16x8 vf[2][2]; at_vload(lds + AT_V + tile * 8192, va, 0, vf); SB();
#pragma unroll
                for (int kb = 0; kb < 2; ++kb)
#pragma unroll
                    for (int i = 0; i < 16; ++i) { const int n = 64 * tile + 32 * kb + crow(i, h); const float p = n < ncq ? __builtin_amdgcn_exp2f(s[kb][i]) : 0.f; s[kb][i] = p; l += p; }
#pragma unroll
                for (int kb = 0; kb < 2; ++kb)
#pragma unroll
                    for (int a = 0; a < 4; ++a) { const int idx = tile * 8 + kb * 4 + a; const float Gv = (s[kb][4 * a] + s[kb][4 * a + 1]) + (s[kb][4 * a + 2] + s[kb][4 * a + 3]);
                        const float Epv = __shfl_xor(s[kb][4 * a + 3], 32);
                        I[2 * idx + h] = Gv + (h ? Epv : prevEp); prevEp = Epv; }
                at_pv(lds + AT_V + tile * 8192, va, vf, s, o);
            } else {
#pragma unroll
                for (int idx = 8; idx < 16; ++idx) I[2 * idx + h] = 0.f;
            }
        }
        const float L = l + __shfl_xor(l, 32); const float inv = L > 0.f ? 1.f / L : 0.f;
        const float gi = gate[0] * inv;
#pragma unroll
        for (int i = 0; i < 16; ++i) { ofin[0][i] += gi * o[0][i]; ofin[1][i] += gi * o[1][i]; }
        if (h == 0) ((LAS float*)(lds + AT_INV))[g * 64 + qloc] = inv;
    }
    WG_BAR();
    unsigned sel = 0u, wm = 0u, um = 0u;
    if (!DO_CMP) { sel = (qt == 31) ? 0xffffffffu : ((1u << (qt + 1)) - 1u); wm = sel; um = sel; }
    else {
        const LAS float* I = (const LAS float*)(lds + AT_IMP) + qloc * 32;
        const LAS float* IV = (const LAS float*)(lds + AT_INV) + qloc;
        const float iv0 = IV[0], iv1 = IV[64], iv2 = IV[128], iv3 = IV[192];
        LAS unsigned* SC = (LAS unsigned*)(lds + AT_SC) + (qh * 32 + r) * 33;
        if (h == 0) {
#pragma unroll
            for (int j = 8 * g; j < 8 * g + 8; ++j) { const float imp = (I[j] * iv0 + I[64 * 32 + j] * iv1) + (I[2 * 64 * 32 + j] * iv2 + I[3 * 64 * 32 + j] * iv3);
                const bool cand = (j >= 1) && (j <= qt - 2);
                SC[j] = cand ? ((__float_as_uint(imp) & ~31u) | (unsigned)(31 - j)) + 32u : 0u; }
        }
        WG_BAR();
        if (qt <= 7) sel = (1u << (qt + 1)) - 1u;
        else {
            sel = 1u | (1u << qt) | (1u << (qt - 1));
            unsigned prev = 0xffffffffu;
#pragma unroll 1
            for (int rd = 0; rd < 5; ++rd) { unsigned best = 0u;
#pragma unroll 8
                for (int j = 0; j < 32; ++j) { const unsigned kx = SC[j]; const unsigned cnd = kx < prev ? kx : 0u; best = cnd > best ? cnd : best; }
                prev = best; if (best) sel |= 1u << (31 - (int)(best & 31u)); }
        }
        sel &= (qt == 31) ? 0xffffffffu : ((1u << (qt + 1)) - 1u);
        wm = sel;
#pragma unroll
        for (int o = 1; o < 32; o <<= 1) wm |= (unsigned)__shfl_xor((int)wm, o);
        wm = (unsigned)__builtin_amdgcn_readfirstlane((int)wm);
        if (lane == 0) ((LAS unsigned*)(lds + AT_WM))[wave] = wm;
        WG_BAR();
        um = 0u;
#pragma unroll
        for (int w = 0; w < 8; ++w) um |= ((const LAS unsigned*)(lds + AT_WM))[w];
        um = (unsigned)__builtin_amdgcn_readfirstlane((int)um);
    }
    if (DO_SEL) {
        f32x16 o[2]; float l = 0.f;
#pragma unroll
        for (int i = 0; i < 16; ++i) { o[0][i] = 0.f; o[1][i] = 0.f; }
        const char* kbase = (const char*)(ksn + (size_t)b * SEQ * 128 + hkv * 64); const char* vbase = (const char*)(proj + (size_t)b * SEQ * NPROJ + PC_NVS + hkv * 64);
        unsigned rem = um, im = um; int k = 0; const int T = __popc(um);
#pragma unroll 1
        for (int i = 0; i < 3 && im; ++i) { const int jn = __ffs((int)im) - 1; im &= im - 1u; at_load(lds, i, kbase + (size_t)jn * 64 * 256, 256, vbase + (size_t)jn * 64 * (NPROJ * 2), NPROJ * 2, wave, lane); }
#pragma unroll 1
        while (rem) {
            const int j = __ffs((int)rem) - 1; rem &= rem - 1u;
            at_wait(T - k - 1);
#ifdef NSA_E1
            at_wait(T - k - 1);
#endif
            if (im) { const int jn = __ffs((int)im) - 1; im &= im - 1u; at_load(lds, (k + 3) & 3, kbase + (size_t)jn * 64 * 256, 256, vbase + (size_t)jn * 64 * (NPROJ * 2), NPROJ * 2, wave, lane); }
            const int par = k & 3;
            if ((wm >> j) & 1u) {
                f32x16 s[2];
                at_qk(lds + AT_K + par * 8192, ka, qf, s);
                bf16x8 vf[2][2]; at_vload(lds + AT_V + par * 8192, va, 0, vf); SB();
                const bool on = (sel >> j) & 1u;
                if (j != qt && __all(on)) at_exp_all(s, l);
                else { const int klim = j == qt ? qq : 63;
#pragma unroll
                    for (int kb = 0; kb < 2; ++kb)
#pragma unroll
                        for (int i = 0; i < 16; ++i) { const int key = 32 * kb + crow(i, h); const float p = (on && key <= klim) ? __builtin_amdgcn_exp2f(s[kb][i]) : 0.f; s[kb][i] = p; l += p; } }
                at_pv(lds + AT_V + par * 8192, va, vf, s, o);
            }
            ++k;
        }
        const float L = l + __shfl_xor(l, 32); const float gi = gate[1] * (L > 0.f ? 1.f / L : 0.f);
#pragma unroll
        for (int i = 0; i < 16; ++i) { ofin[0][i] += gi * o[0][i]; ofin[1][i] += gi * o[1][i]; }
    }
    WG_BAR();
    if (DO_WIN) {
        f32x16 o[2]; float l = 0.f;
#pragma unroll
        for (int i = 0; i < 16; ++i) { o[0][i] = 0.f; o[1][i] = 0.f; }
        const char* kbase = (const char*)(kwn + (size_t)b * SEQ * 128 + hkv * 64); const char* vbase = (const char*)(proj + (size_t)b * SEQ * NPROJ + PC_NVW + hkv * 64);
        const int jlo = qt > 8 ? qt - 8 : 0; const int T = qt - jlo + 1;
#ifdef NSA_E2
        f32x16 o2[2]; float l2 = 0.f;
#pragma unroll
        for (int i = 0; i < 16; ++i) { o2[0][i] = 0.f; o2[1][i] = 0.f; }
#endif
#pragma unroll 1
        for (int i = 0; i < 3 && i < T; ++i) at_load(lds, i, kbase + (size_t)(jlo + i) * 64 * 256, 256, vbase + (size_t)(jlo + i) * 64 * (NPROJ * 2), NPROJ * 2, wave, lane);
#pragma unroll 1
        for (int k = 0; k < T; ++k) {
            const int j = jlo + k, par = k & 3;
            at_wait(T - k - 1);
#ifdef NSA_E1
            at_wait(T - k - 1);
#endif
            if (k + 3 < T) at_load(lds, (k + 3) & 3, kbase + (size_t)(j + 3) * 64 * 256, 256, vbase + (size_t)(j + 3) * 64 * (NPROJ * 2), NPROJ * 2, wave, lane);
            f32x16 s[2];
            at_qk(lds + AT_K + par * 8192, ka, qf, s);
            bf16x8 vf[2][2]; at_vload(lds + AT_V + par * 8192, va, 0, vf); SB();
#ifdef NSA_E2
            { f32x16 s2[2]; asm volatile("" ::: "memory"); at_qk(lds + AT_K + par * 8192, ka, qf, s2); bf16x8 vf2[2][2]; at_vload(lds + AT_V + par * 8192, va, 0, vf2); SB(); at_exp_all(s2, l2); at_pv(lds + AT_V + par * 8192, va, vf2, s2, o2); }
#endif
            if (j != qt && j != qt - 8) at_exp_all(s, l);
            else { const int klo = (j == qt - 8) ? qq + 1 : 0, khi = (j == qt) ? qq : 63;
#pragma unroll
                for (int kb = 0; kb < 2; ++kb)
#pragma unroll
                    for (int i = 0; i < 16; ++i) { const int key = 32 * kb + crow(i, h); const float p = (key >= klo && key <= khi) ? __builtin_amdgcn_exp2f(s[kb][i]) : 0.f; s[kb][i] = p; l += p; } }
            at_pv(lds + AT_V + par * 8192, va, vf, s, o);
        }
#ifdef NSA_E2
        { const float z = l2 * 0.f;
#pragma unroll
          for (int i = 0; i < 16; ++i) { ofin[0][i] += z * o2[0][i]; ofin[1][i] += z * o2[1][i]; } }
#endif
        const float L = l + __shfl_xor(l, 32); const float gi = gate[2] * (L > 0.f ? 1.f / L : 0.f);
#pragma unroll
        for (int i = 0; i < 16; ++i) { ofin[0][i] += gi * o[0][i]; ofin[1][i] += gi * o[1][i]; }
    }
    if (!STORE) { asm volatile("" :: "v"(ofin[0]), "v"(ofin[1])); return; }
    WG_BAR();
#pragma unroll
    for (int db = 0; db < 2; ++db)
#pragma unroll
        for (int a = 0; a < 4; ++a) { u32x2 w; w.x = pkbf(ofin[db][4 * a], ofin[db][4 * a + 1]); w.y = pkbf(ofin[db][4 * a + 2], ofin[db][4 * a + 3]); *(LAS u32x2*)(lds + qloc * 528 + g * 128 + (32 * db + 8 * a + 4 * h) * 2) = w; }
    WG_BAR();
    { const int tid = wave * 64 + lane; bf16* obase = H1 + ((size_t)b * SEQ + 64 * qt) * 1536 + 512 + hkv * 256;
#pragma unroll
      for (int i = 0; i < 4; ++i) { const int piece = tid + 512 * i, row = piece >> 5, c = piece & 31; *(v4u*)(obase + (size_t)row * 1536 + 8 * c) = *(const LAS v4u*)(lds + row * 528 + 16 * c); } }
}
constexpr int ML_K = 0, ML_V = 32768, ML_VW = 65536, ML_C = 81920, ML_N = 114688, ML_SS = 115200, ML_WS = 116224, ML_GO = 120320, ML_ST = 135424;
DI int ml_fk(int s) { return ((s & 3) << 2) | ((s >> 2) & 3); }
DI void ml_load(LAS unsigned char* lds, int par, const char* kb, const char* vb, int wave, int lane) {
#pragma unroll
    for (int n2 = 0; n2 < 2; ++n2) { const int n = 2 * wave + n2, row = 4 * n + (lane >> 4), pc = lane & 15;
        const int kc = pc ^ ml_fk(row), vc = pc ^ ((row & 3) << 2);
        glds16(kb + (size_t)row * 2048 + 16 * kc, (unsigned)(size_t)(lds + ML_K + par * 16384 + n * 1024));
        glds16(vb + (size_t)row * (NPROJ * 2) + 16 * vc, (unsigned)(size_t)(lds + ML_V + par * 16384 + n * 1024)); }
}
DI bf16x8 ml_tr8(const LAS unsigned char* p) {
    const s16x4 lo = __builtin_amdgcn_ds_read_tr16_b64_v4i16((lds_s16x4*)p); const s16x4 hi = __builtin_amdgcn_ds_read_tr16_b64_v4i16((lds_s16x4*)(p + 1024));
    return __builtin_shufflevector(lo, hi, 0, 1, 2, 3, 4, 5, 6, 7);
}
template <int PM = 0xff>
DI void mlstm_unit2(Frame& F, int unit) {
    unsigned char* ws = F.ws; LAS unsigned char* lds = F.lds;
    int lane_ = F.lane_id();
    const int lane = lane_, wave = F.wave, tid = wave * 64 + lane, r = lane & 31, hh = lane >> 5, tb = wave >> 2, vb = wave & 3;
    const int b = unit >> 2, hd = unit & 3;
    const bf16* proj = (const bf16*)(ws + WS_PROJ); const bf16* mlqk = (const bf16*)(ws + WS_MLQK); bf16* H0 = (bf16*)(ws + WS_H0);
    const size_t tok0 = (size_t)b * SEQ;
    const char* kbase = (const char*)(mlqk + tok0 * 1024 + 512 + hd * 128); const char* vbase = (const char*)(proj + tok0 * NPROJ + PC_MLV + hd * 128);
    const float LOG2E = 1.4426950408889634f;
    const int i16 = lane & 15, q4 = i16 >> 2, p4 = i16 & 3, g1 = (lane >> 4) & 1;
    const int colsw = 16 * ((4 * vb + 2 * g1 + (p4 >> 1)) ^ (q4 << 2)) + 8 * (p4 & 1);
    const int base_c = (8 * hh + q4) * 256 + colsw;
    const int base_v = (4 * hh + q4) * 256 + colsw;
    const int fK = ml_fk(r), rowK = r * 256 + ((hh ^ (fK & 1)) << 4), F16 = (fK & 14) << 4;
    int base_kt[2][2];
#pragma unroll
    for (int blk = 0; blk < 2; ++blk)
#pragma unroll
        for (int hi = 0; hi < 2; ++hi) { const int kbp = 2 * tb + blk; base_kt[blk][hi] = (8 * hh + 4 * hi + q4) * 256 + 16 * ((4 * kbp + 2 * g1 + (p4 >> 1)) ^ ((q4 << 2) | ((2 * hh + hi) & 3))) + 8 * (p4 & 1); }
    LAS float* WS = (LAS float*)(lds + ML_WS) + wave * 128;
    LAS float* NV = (LAS float*)(lds + ML_N); LAS float* SS = (LAS float*)(lds + ML_SS);
    __syncthreads();
    for (int i = tid; i < 32768 / 16; i += 512) ((LAS v4u*)(lds + ML_C))[i] = (v4u){0u, 0u, 0u, 0u};
    if (tid < 128) NV[tid] = 0.f;
    f32x16 Cst[2];
#pragma unroll
    for (int i = 0; i < 16; ++i) { Cst[0][i] = 0.f; Cst[1][i] = 0.f; }
    if (tid < 128) ((LAS float*)(lds + ML_GO))[tid] = F.in[I_MLGOUT][hd * 128 + tid];
    const float bi = F.in[I_MLBI][hd], bfv = F.in[I_MLBF][hd];
    float m_prev = 0.f, nst[2] = {0.f, 0.f};
    ml_load(lds, 0, kbase, vbase, wave, lane);
    bf16x8 qf[8];
    { const bf16* qp = mlqk + (tok0 + 32 * tb + r) * 1024 + hd * 128 + 8 * hh;
#pragma unroll
      for (int st = 0; st < 8; ++st) qf[st] = *(const bf16x8*)(qp + 16 * st); }
    float gi_raw = bf2f(proj[(tok0 + lane) * NPROJ + PC_MLI + hd]), gf_raw = bf2f(proj[(tok0 + lane) * NPROJ + PC_MLF + hd]);
#pragma unroll 1
    for (int c = 0; c < 32; ++c) {
        const int par = c & 1; const size_t tokc = tok0 + 64 * c;
        WG_BAR();
        if ((PM & 1) && c > 0) {
            bf16* obase = H0 + (tokc - 64) * 1536 + hd * 128;
#pragma unroll
            for (int i = 0; i < 2; ++i) { const int piece = tid + 512 * i, row = piece >> 4, cc = piece & 15; *(v4u*)(obase + (size_t)row * 1536 + 8 * cc) = *(const LAS v4u*)(lds + ML_ST + row * 272 + 16 * cc); } }
        if (c < 31) ml_load(lds, par ^ 1, kbase + (size_t)(64 * (c + 1)) * 2048, vbase + (size_t)(64 * (c + 1)) * (NPROJ * 2), wave, lane);
        u32x2 og[4];
        { const bf16* op = proj + (tokc + 32 * tb + r) * NPROJ + PC_MLO + hd * 128 + 32 * vb + 4 * hh;
#pragma unroll
          for (int a = 0; a < 4; ++a) og[a] = *(const u32x2*)(op + 8 * a); }
        const float ig = gi_raw + bi, lf = logsig(gf_raw + bfv);
        float bc = lf;
        if (PM & 2) {
#pragma unroll
        for (int o = 1; o < 64; o <<= 1) { const float v = __shfl_up(bc, o); if (lane >= o) bc += v; } }
        const float rr = ig - bc;
        float cm = rr;
        if (PM & 2) {
#pragma unroll
        for (int o = 1; o < 64; o <<= 1) { const float v = __shfl_up(cm, o); if (lane >= o) cm = fmaxf(cm, v); } }
        const float M63 = fmaxf(m_prev, __shfl(cm, 63)), blast = __shfl(bc, 63);
        const float a_old = __expf(m_prev - M63), m_new = blast + M63;
        const int tl = 32 * tb + r;
        const float Mt = fmaxf(m_prev, __shfl(cm, tl)), bt = __shfl(bc, tl);
        const float inter = __expf(m_prev - Mt), m_t = bt + Mt;
        WS[lane] = rr * LOG2E; WS[64 + lane] = __expf(rr - M63);
        const float MtL = Mt * LOG2E;
        const LAS unsigned char* kbuf = lds + ML_K + par * 16384; const LAS unsigned char* vbuf = lds + ML_V + par * 16384;
        f32x16 wd[2]; float dsum = 0.f;
#pragma unroll
        for (int kb = 0; kb < 2; ++kb) {
#pragma unroll
            for (int i = 0; i < 16; ++i) wd[kb][i] = 0.f;
            if ((PM & 4) && kb <= tb) {
                f32x16 a = wd[kb]; bf16x8 kfr[8];
#pragma unroll
                for (int st = 0; st < 8; ++st) kfr[st] = *(const LAS bf16x8*)(kbuf + kb * 8192 + rowK + ((32 * st) ^ F16));
                SB();
#pragma unroll
                for (int st = 0; st < 8; ++st) a = MFMA32(kfr[st], qf[st], a);
#pragma unroll
                for (int i = 0; i < 16; ++i) { const int s = 32 * kb + crow(i, hh); const float e = __builtin_amdgcn_exp2f(WS[s] - MtL); const float w = (s <= tl) ? e * a[i] : 0.f; a[i] = w; dsum += w; }
                wd[kb] = a;
            }
        }
        f32x16 acc; bf16x8 cfr[8];
#pragma unroll
        for (int i = 0; i < 16; ++i) acc[i] = 0.f;
        if (PM & 8) {
#pragma unroll
        for (int st = 0; st < 8; ++st) cfr[st] = ml_tr8(lds + ML_C + base_c + st * 4096);
        SB();
#pragma unroll
        for (int st = 0; st < 8; ++st) acc = MFMA32(cfr[st], qf[st], acc); }
#pragma unroll
        for (int i = 0; i < 16; ++i) acc[i] *= inter;
#pragma unroll
        for (int kb = 0; kb < 2; ++kb) {
            if ((PM & 16) && kb <= tb) {
                const bf16x8 pf0 = pack8<0>(wd[kb]), pf1 = pack8<1>(wd[kb]);
                {
#pragma unroll
                  for (int s2 = 0; s2 < 2; ++s2) { const LAS unsigned char* p = vbuf + base_v + kb * 8192 + s2 * 4096;
                    const s16x4 lo = __builtin_amdgcn_ds_read_tr16_b64_v4i16((lds_s16x4*)p); const s16x4 hi = __builtin_amdgcn_ds_read_tr16_b64_v4i16((lds_s16x4*)(p + 2048));
                    const bf16x8 vf = __builtin_shufflevector(lo, hi, 0, 1, 2, 3, 4, 5, 6, 7);
                    acc = MFMA32(vf, s2 ? pf1 : pf0, acc); } }
            }
        }
        float qn_ = 0.f;
        if (PM & 32)
#pragma unroll
        for (int st = 0; st < 8; ++st) { const v4u qw = __builtin_bit_cast(v4u, qf[st]); const LAS float* np = NV + 16 * st + 8 * hh; const f32x4 n0 = *(const LAS f32x4*)np, n1 = *(const LAS f32x4*)(np + 4);
            qn_ = fmaf(__uint_as_float(qw.x << 16), n0[0], qn_); qn_ = fmaf(__uint_as_float(qw.x & 0xffff0000u), n0[1], qn_); qn_ = fmaf(__uint_as_float(qw.y << 16), n0[2], qn_); qn_ = fmaf(__uint_as_float(qw.y & 0xffff0000u), n0[3], qn_);
            qn_ = fmaf(__uint_as_float(qw.z << 16), n1[0], qn_); qn_ = fmaf(__uint_as_float(qw.z & 0xffff0000u), n1[1], qn_); qn_ = fmaf(__uint_as_float(qw.w << 16), n1[2], qn_); qn_ = fmaf(__uint_as_float(qw.w & 0xffff0000u), n1[3], qn_); }
        qn_ += __shfl_xor(qn_, 32); dsum += __shfl_xor(dsum, 32);
        const float den = inter * qn_ + dsum; const float rden = 1.f / fmaxf(fabsf(den), __expf(-m_t));
        float ssq = 0.f;
#pragma unroll
        for (int i = 0; i < 16; ++i) { acc[i] *= rden; ssq = fmaf(acc[i], acc[i], ssq); }
        ssq += __shfl_xor(ssq, 32);
        if (hh == 0) SS[vb * 64 + tl] = ssq;
        if (PM & 64)
#pragma unroll
        for (int k2 = 0; k2 < 2; ++k2) { const int ci = tid + 512 * k2, s = ci >> 4; const float w = WS[64 + s];
            const v4u x = *(const LAS v4u*)(vbuf + ci * 16); v4u y; const unsigned xs[4] = {x.x, x.y, x.z, x.w}; unsigned ys[4];
#pragma unroll
            for (int j = 0; j < 4; ++j) ys[j] = pkbf(__uint_as_float(xs[j] << 16) * w, __uint_as_float(xs[j] & 0xffff0000u) * w);
            y.x = ys[0]; y.y = ys[1]; y.z = ys[2]; y.w = ys[3]; *(LAS v4u*)(lds + ML_VW + ci * 16) = y; }
        asm volatile("s_waitcnt lgkmcnt(0)" ::: "memory"); __builtin_amdgcn_s_barrier(); asm volatile("" ::: "memory");
        if (c < 31) {
            const bf16* qp = mlqk + (tokc + 64 + 32 * tb + r) * 1024 + hd * 128 + 8 * hh;
#pragma unroll
            for (int st = 0; st < 8; ++st) qf[st] = *(const bf16x8*)(qp + 16 * st);
            gi_raw = bf2f(proj[(tokc + 64 + lane) * NPROJ + PC_MLI + hd]); gf_raw = bf2f(proj[(tokc + 64 + lane) * NPROJ + PC_MLF + hd]);
        }
        { const LAS float* GO = (const LAS float*)(lds + ML_GO) + 32 * vb + 4 * hh;
          const float rstd = rsqrtf(((SS[tl] + SS[64 + tl]) + (SS[128 + tl] + SS[192 + tl])) * (1.f / 128.f) + EPS);
#pragma unroll
          for (int a = 0; a < 4; ++a) { float o4[4]; const unsigned gw[2] = {og[a].x, og[a].y};
#pragma unroll
              for (int j = 0; j < 4; ++j) { const float ov = (j & 1) ? __uint_as_float(gw[j >> 1] & 0xffff0000u) : __uint_as_float(gw[j >> 1] << 16); o4[j] = acc[4 * a + j] * rstd * GO[8 * a + j] * sigm(ov); }
              u32x2 w; w.x = pkbf(o4[0], o4[1]); w.y = pkbf(o4[2], o4[3]); *(LAS u32x2*)(lds + ML_ST + tl * 272 + (32 * vb + 8 * a + 4 * hh) * 2) = w; } }
        if (PM & 128)
#pragma unroll
        for (int blk = 0; blk < 2; ++blk) {
            f32x16 cs = Cst[blk];
#pragma unroll
            for (int i = 0; i < 16; ++i) cs[i] *= a_old;
            bf16x8 afr[4], kfr2[4];
#pragma unroll
            for (int st = 0; st < 4; ++st) {
                afr[st] = ml_tr8(lds + ML_VW + base_c + st * 4096);
                const s16x4 lo = __builtin_amdgcn_ds_read_tr16_b64_v4i16((lds_s16x4*)(kbuf + base_kt[blk][0] + st * 4096)); const s16x4 hi = __builtin_amdgcn_ds_read_tr16_b64_v4i16((lds_s16x4*)(kbuf + base_kt[blk][1] + st * 4096));
                kfr2[st] = __builtin_shufflevector(lo, hi, 0, 1, 2, 3, 4, 5, 6, 7);
            }
            SB();
#pragma unroll
            for (int st = 0; st < 4; ++st) cs = MFMA32(afr[st], kfr2[st], cs);
            Cst[blk] = cs;
            if ((PM & 64) && vb == 0) {
                f32x16 nc;
#pragma unroll
                for (int i = 0; i < 16; ++i) nc[i] = 0.f;
#pragma unroll
                for (int st = 0; st < 4; ++st) { const LAS float* wp = WS + 64 + 16 * st + 8 * hh; const f32x4 w0 = *(const LAS f32x4*)wp, w1 = *(const LAS f32x4*)(wp + 4);
                    const bf16x8 wf = __builtin_bit_cast(bf16x8, (v4u){pkbf(w0[0], w0[1]), pkbf(w0[2], w0[3]), pkbf(w1[0], w1[1]), pkbf(w1[2], w1[3])});
                    nc = MFMA32(wf, kfr2[st], nc); }
                nst[blk] = a_old * nst[blk] + nc[0];
                if (hh == 0) NV[32 * (2 * tb + blk) + r] = nst[blk];
            }
            const int kk = 32 * (2 * tb + blk) + r;
#pragma unroll
            for (int a = 0; a < 4; ++a) { u32x2 w; w.x = pkbf(cs[4 * a], cs[4 * a + 1]); w.y = pkbf(cs[4 * a + 2], cs[4 * a + 3]);
                *(LAS u32x2*)(lds + ML_C + kk * 256 + 16 * ((4 * vb + a) ^ ((r & 3) << 2)) + 8 * hh) = w; }
        }
        m_prev = m_new;
    }
    __syncthreads();
    if (PM & 1) { bf16* obase = H0 + (tok0 + 64 * 31) * 1536 + hd * 128;
#pragma unroll
        for (int i = 0; i < 2; ++i) { const int piece = tid + 512 * i, row = piece >> 4, cc = piece & 15; *(v4u*)(obase + (size_t)row * 1536 + 8 * cc) = *(const LAS v4u*)(lds + ML_ST + row * 272 + 16 * cc); } }
    __syncthreads();
}
DI void mem_load(LAS unsigned char* lds, int par, const char* kb, const char* vb, int wave, int lane) {
#pragma unroll
    for (int n2 = 0; n2 < 2; ++n2) { const int n = 2 * wave + n2, row = 4 * n + (lane >> 4), pc = lane & 15;
        const int kc = pc ^ ml_fk(row), vc = pc ^ ((row & 3) << 2);
        glds16(kb + (size_t)row * 1024 + 16 * kc, (unsigned)(size_t)(lds + ML_K + par * 16384 + n * 1024));
        glds16(vb + (size_t)row * 2048 + 16 * vc, (unsigned)(size_t)(lds + ML_V + par * 16384 + n * 1024)); }
}
template <bool STORE = true, bool DMA = true, bool COMP = true>
DI void mem_unit(Frame& F, int unit) {
    unsigned char* ws = F.ws; LAS unsigned char* lds = F.lds;
    int lane_ = F.lane_id();
    const int lane = lane_, wave = F.wave, r = lane & 31, hh = lane >> 5;
    const int b = unit >> 5, hd = (unit >> 3) & 3, qt = unit & 7;
    const bf16* mqn = (const bf16*)(ws + WS_MQN); const bf16* memkn = (const bf16*)(ws + WS_MEMKN); const bf16* memkv = (const bf16*)(ws + WS_MEMKV); bf16* H2 = (bf16*)(ws + WS_H0);
    const size_t t = (size_t)b * SEQ + 256 * qt + 32 * wave + r;
    const char* kbase = (const char*)(memkn + (size_t)b * MEML * 512 + hd * 128); const char* vbase = (const char*)(memkv + (size_t)b * MEML * 1024 + 512 + hd * 128);
    const int i16 = lane & 15, q4 = i16 >> 2, p4 = i16 & 3, g1 = (lane >> 4) & 1;
    int base_v[4];
#pragma unroll
    for (int db = 0; db < 4; ++db) base_v[db] = (4 * hh + q4) * 256 + 16 * ((4 * db + 2 * g1 + (p4 >> 1)) ^ (q4 << 2)) + 8 * (p4 & 1);
    const int fK = ml_fk(r), rowK = r * 256 + ((hh ^ (fK & 1)) << 4), F16 = (fK & 14) << 4;
    asm volatile("s_waitcnt lgkmcnt(0)" ::: "memory"); __builtin_amdgcn_s_barrier(); asm volatile("" ::: "memory");
    if (DMA) mem_load(lds, 0, kbase, vbase, wave, lane);
    bf16x8 qf[8];
#pragma unroll
    for (int st = 0; st < 8; ++st) qf[st] = *(const bf16x8*)(mqn + t * 512 + hd * 128 + 16 * st + 8 * hh);
    f32x16 o[4]; float l = 0.f;
#pragma unroll
    for (int db = 0; db < 4; ++db)
#pragma unroll
        for (int i = 0; i < 16; ++i) o[db][i] = 0.f;
#pragma unroll 1
    for (int tile = 0; tile < 4; ++tile) {
        const int par = tile & 1;
        WG_BAR();
        if (DMA && tile < 3) mem_load(lds, par ^ 1, kbase + (size_t)(64 * (tile + 1)) * 1024, vbase + (size_t)(64 * (tile + 1)) * 2048, wave, lane);
        const LAS unsigned char* kbuf = lds + ML_K + par * 16384; const LAS unsigned char* vbuf = lds + ML_V + par * 16384;
        if (COMP)
#pragma unroll
        for (int kb = 0; kb < 2; ++kb) {
            bf16x8 kf[8];
#pragma unroll
            for (int st = 0; st < 8; ++st) kf[st] = *(const LAS bf16x8*)(kbuf + kb * 8192 + rowK + ((32 * st) ^ F16));
            SB();
            f32x16 a;
#pragma unroll
            for (int i = 0; i < 16; ++i) a[i] = 0.f;
#pragma unroll
            for (int st = 0; st < 8; ++st) a = MFMA32(kf[st], qf[st], a);
            bf16x8 vf[2][4];
#pragma unroll
            for (int s2 = 0; s2 < 2; ++s2)
#pragma unroll
                for (int db = 0; db < 4; ++db) { const LAS unsigned char* p = vbuf + base_v[db] + kb * 8192 + s2 * 4096;
                    const s16x4 lo = __builtin_amdgcn_ds_read_tr16_b64_v4i16((lds_s16x4*)p); const s16x4 hi = __builtin_amdgcn_ds_read_tr16_b64_v4i16((lds_s16x4*)(p + 2048));
                    vf[s2][db] = __builtin_shufflevector(lo, hi, 0, 1, 2, 3, 4, 5, 6, 7); }
            SB();
#pragma unroll
            for (int i = 0; i < 16; ++i) { a[i] = __builtin_amdgcn_exp2f(a[i]); l += a[i]; }
            const bf16x8 pf0 = pack8<0>(a), pf1 = pack8<1>(a);
#pragma unroll
            for (int s2 = 0; s2 < 2; ++s2)
#pragma unroll
                for (int db = 0; db < 4; ++db) o[db] = MFMA32(vf[s2][db], s2 ? pf1 : pf0, o[db]);
        }
    }
    const float inv = 1.f / (l + __shfl_xor(l, 32));
    if (!STORE) {
#pragma unroll
        for (int db = 0; db < 4; ++db) asm volatile("" :: "v"(o[db]), "v"(inv));
        return; }
    WG_BAR();
#pragma unroll
    for (int db = 0; db < 4; ++db)
#pragma unroll
        for (int a = 0; a < 4; ++a) { u32x2 w; w.x = pkbf(o[db][4 * a] * inv, o[db][4 * a + 1] * inv); w.y = pkbf(o[db][4 * a + 2] * inv, o[db][4 * a + 3] * inv);
            *(LAS u32x2*)(lds + (32 * wave + r) * 272 + (32 * db + 8 * a + 4 * hh) * 2) = w; }
    WG_BAR();
    { const int tid = wave * 64 + lane; bf16* obase = H2 + ((size_t)b * SEQ + 256 * qt) * 1536 + 1024 + hd * 128;
#pragma unroll
      for (int i = 0; i < 8; ++i) { const int piece = tid + 512 * i, row = piece >> 4, c = piece & 15; *(v4u*)(obase + (size_t)row * 1536 + 8 * c) = *(const LAS v4u*)(lds + row * 272 + 16 * c); } }
}
DI int q_pop(Frame& F, unsigned* qc) {
    __syncthreads();
    if (F.tid_id() == 0) F.MISC[16] = atomicAdd(qc, 1u);
    __syncthreads();
    return (int)F.MISC[16];
}
template <bool ML, bool NSA, bool MEMA, bool MST = true, bool MDMA = true, bool MCOMP = true, bool NST = true, bool NCMP = true, bool NSEL = true, bool NWIN = true, int MLPM = 0xff>
DI void p5_queue(Frame& F, int cbase) {
    unsigned* qc = F.ctl + CW_QCTR + cbase;
    if (ML) {
#pragma unroll 1
        for (;;) { const int it = q_pop(F, qc); if (it >= 64) break; mlstm_unit2<MLPM>(F, it); }
    }
    if (NSA) {
#pragma unroll 1
        for (;;) { const int it = q_pop(F, qc + 64); if (it >= 1024) break; nsa_unit<NST, NCMP, NSEL, NWIN>(F, it); }
    }
    if (MEMA) {
#pragma unroll 1
        for (;;) { const int it = q_pop(F, qc + 128); if (it >= 512) break; mem_unit<MST, MDMA, MCOMP>(F, it); }
    }
    __syncthreads();
}
struct OneUnit { int pm; DI bool next(int i, pg8::Unit& u) const { if (i) return false; u.pm = pm; u.pn = 0; return true; } DI void a_ready(const pg8::Unit&) const {} DI void done(const pg8::Unit&) const {} };
DI void p2_compress(Frame& F) {
    unsigned char* ws = F.ws;
    if (F.G < 64 || F.bx >= 32) return;
    const int kv = F.bx >> 4, pm = F.bx & 15;
    typedef pg8::bf16_t b16;
    { pg8::GemmA g{(const b16*)(ws + WS_PROJ) + (kv ? PC_NVC : PC_NKC), (const b16*)(ws + WS_WC1) + (size_t)kv * 256 * 2048, 2048, 16 * NPROJ * 2, (size_t)NPROJ * 2, (size_t)128, (size_t)SEQ * NPROJ * 2};
      OneUnit S{pm};
      pg8::EpiBf16Silu E{(b16*)(ws + WS_HID) + (size_t)kv * 4096 * 256, 256, (const float*)(ws + WS_SMALL + SM_CBIAS) + kv * 256, 1};
      pg8::gemm_phase_ga<pg8::EpiBf16Silu, OneUnit, false, true>(F.lds, g, S, E, F.wave); }
    asm volatile("s_waitcnt vmcnt(0)" ::: "memory"); __syncthreads();
    const int lane = F.lane_id(), r = lane & 31, hh = lane >> 5;
    const int row = pm * 256 + F.wave * 32 + r, n = row & 127;
    const bf16* hid = (const bf16*)(ws + WS_HID) + (size_t)kv * 4096 * 256 + (size_t)row * 256 + 8 * hh;
    const bf16* w2t = (const bf16*)(ws + WS_SMALL + SM_W2T) + (size_t)kv * 64 * 256 + 8 * hh;
    f32x16 acc[2];
#pragma unroll
    for (int i = 0; i < 16; ++i) { acc[0][i] = 0.f; acc[1][i] = 0.f; }
#pragma unroll 4
    for (int st = 0; st < 16; ++st) { const bf16x8 hb = *(const bf16x8*)(hid + 16 * st);
        const bf16x8 w0 = *(const bf16x8*)(w2t + (size_t)r * 256 + 16 * st), w1 = *(const bf16x8*)(w2t + (size_t)(32 + r) * 256 + 16 * st);
        acc[0] = MFMA32(w0, hb, acc[0]); acc[1] = MFMA32(w1, hb, acc[1]); }
    if (kv == 0) {
        float ss = 0.f;
#pragma unroll
        for (int i = 0; i < 16; ++i) ss += acc[0][i] * acc[0][i] + acc[1][i] * acc[1][i];
        ss += __shfl_xor(ss, 32);
        const float rstd = rsqrtf(ss * (1.f / 64.f) + EPS);
        const float* rc = (const float*)(ws + WS_SMALL + SM_ROPEC); const float* rs = (const float*)(ws + WS_SMALL + SM_ROPES);
        const int pos = 16 * n + 31 < SEQ ? 16 * n + 31 : SEQ - 1;
#pragma unroll
        for (int i = 0; i < 16; ++i) { const int d = crow(i, hh); const float c = rc[pos * 32 + d], sn = rs[pos * 32 + d];
            const float y0 = acc[0][i] * rstd * F.in[I_NGK][d], y1 = acc[1][i] * rstd * F.in[I_NGK][32 + d];
            acc[0][i] = y0 * c - y1 * sn; acc[1][i] = y1 * c + y0 * sn; }
    }
    bf16* dst = (bf16*)(ws + (kv ? WS_VC : WS_KC)) + (size_t)row * 64 + 4 * hh;
#pragma unroll
    for (int db = 0; db < 2; ++db)
#pragma unroll
        for (int a = 0; a < 4; ++a) { u32x2 w; w.x = pkbf(acc[db][4 * a], acc[db][4 * a + 1]); w.y = pkbf(acc[db][4 * a + 2], acc[db][4 * a + 3]); if (n == 127) { w.x = 0u; w.y = 0u; }
            *(u32x2*)(dst + 32 * db + 8 * a) = w; }
}
DI void mlstm_unit(Frame& F, int unit) {
    unsigned char* ws = F.ws;
    const int b = unit >> 2, h = unit & 3, tid = F.tid_id(), kk = tid >> 7, c = tid & 127;
    const bf16* proj = (const bf16*)(ws + WS_PROJ); const bf16* mlqk = (const bf16*)(ws + WS_MLQK); bf16* H0 = (bf16*)(ws + WS_H0);
    LAS float* qs = (LAS float*)F.lds;
    LAS float* ks = qs + 16 * 128;
    LAS float* vs = ks + 16 * 128;
    LAS float* gi = vs + 16 * 128;
    LAS float* gf = gi + 16;
    LAS float* part = gf + 16;
    LAS float* pden = part + 2 * 4 * 128;
    LAS float* hb = pden + 8;
    float C[32], nn[32];
#pragma unroll
    for (int i = 0; i < 32; ++i) { C[i] = 0.f; nn[i] = 0.f; }
    float m = 0.f;
    const float bi = F.in[I_MLBI][h], bfv = F.in[I_MLBF][h];
    const float scale = 0.08838834764831845f;
#pragma unroll 1
    for (int t0 = 0; t0 < SEQ; t0 += 16) {
        __syncthreads();
        for (int i = tid; i < 16 * 128; i += 512) { const int s = i >> 7, d = i & 127; const size_t t = (size_t)b * SEQ + t0 + s;
            qs[i] = bf2f(mlqk[t * 1024 + h * 128 + d]); ks[i] = bf2f(mlqk[t * 1024 + 512 + h * 128 + d]); vs[i] = bf2f(proj[t * NPROJ + PC_MLV + h * 128 + d]); }
        if (tid < 16) { const size_t t = (size_t)b * SEQ + t0 + tid; gi[tid] = bf2f(proj[t * NPROJ + PC_MLI + h]) + bi; gf[tid] = logsig(bf2f(proj[t * NPROJ + PC_MLF + h]) + bfv); }
        __syncthreads();
#pragma unroll 1
        for (int s = 0; s < 16; ++s) {
            const float lf = gf[s], ig = gi[s];
            const float mn = fmaxf(lf + m, ig), a = __expf(lf + m - mn), bb = __expf(ig - mn);
            m = mn;
            const float v = vs[s * 128 + c];
            float pn = 0.f, pd = 0.f;
#pragma unroll
            for (int i = 0; i < 32; ++i) { const float kvv = ks[s * 128 + kk * 32 + i], qv = qs[s * 128 + kk * 32 + i];
                C[i] = a * C[i] + bb * kvv * v; nn[i] = a * nn[i] + bb * kvv; pn = fmaf(qv, C[i], pn); pd = fmaf(qv, nn[i], pd); }
            const int par = s & 1;
            part[(par * 4 + kk) * 128 + c] = pn; if (c == 0) pden[par * 4 + kk] = pd;
            __syncthreads();
            if (kk == 0) {
                const float num = (part[(par * 4 + 0) * 128 + c] + part[(par * 4 + 1) * 128 + c]) + (part[(par * 4 + 2) * 128 + c] + part[(par * 4 + 3) * 128 + c]);
                const float den = (pden[par * 4 + 0] + pden[par * 4 + 1]) + (pden[par * 4 + 2] + pden[par * 4 + 3]);
                hb[s * 128 + c] = num * scale / fmaxf(fabsf(den * scale), __expf(-mn));
            }
        }
        __syncthreads();
#pragma unroll
        for (int rr = 0; rr < 2; ++rr) { const int s = F.wave * 2 + rr; const size_t t = (size_t)b * SEQ + t0 + s;
            const float v0 = hb[s * 128 + F.lane_id()], v1 = hb[s * 128 + 64 + F.lane_id()];
            const float rstd = rsqrtf(wave_sum(v0 * v0 + v1 * v1) * (1.f / 128.f) + EPS);
            const float o0 = bf2f(proj[t * NPROJ + PC_MLO + h * 128 + F.lane_id()]), o1 = bf2f(proj[t * NPROJ + PC_MLO + h * 128 + 64 + F.lane_id()]);
            H0[t * 512 + h * 128 + F.lane_id()] = (bf16)f2bf(v0 * rstd * F.in[I_MLGOUT][h * 128 + F.lane_id()] * sigm(o0));
            H0[t * 512 + h * 128 + 64 + F.lane_id()] = (bf16)f2bf(v1 * rstd * F.in[I_MLGOUT][h * 128 + 64 + F.lane_id()] * sigm(o1)); }
    }
    __syncthreads();
}

DI void nsa_scores(const bf16* krow, bool valid, const LAS float* qs, float (&s)[4]) {
    s[0] = s[1] = s[2] = s[3] = 0.f;
    if (valid) {
#pragma unroll 2
        for (int c8 = 0; c8 < 8; ++c8) { const v4u kk = *(const v4u*)(krow + c8 * 8);
            const unsigned w[4] = {kk.x, kk.y, kk.z, kk.w};
#pragma unroll
            for (int j = 0; j < 4; ++j) { const float k0 = __uint_as_float(w[j] << 16), k1 = __uint_as_float(w[j] & 0xffff0000u); const int d = c8 * 8 + 2 * j;
#pragma unroll
                for (int g = 0; g < 4; ++g) s[g] = fmaf(k1, qs[g * 64 + d + 1], fmaf(k0, qs[g * 64 + d], s[g])); } }
    }
}
DI void nsa_wave(Frame& F, int item, LAS float* wl) {
    unsigned char* ws = F.ws; const int lane = F.lane_id();
    const int t = item >> 1, hkv = item & 1, b = t >> 11, tau = t & 2047;
    const bf16* proj = (const bf16*)(ws + WS_PROJ);
    const bf16* qn = (const bf16*)(ws + WS_QN); const bf16* ksn = (const bf16*)(ws + WS_KSN); const bf16* kwn = (const bf16*)(ws + WS_KWN);
    const bf16* kc = (const bf16*)(ws + WS_KC); const bf16* vc = (const bf16*)(ws + WS_VC); bf16* H1 = (bf16*)(ws + WS_H1);
    LAS float* qs = wl;
    LAS float* ps = wl + 256;
    LAS float* psum = wl + 768;
#pragma unroll
    for (int g = 0; g < 4; ++g) qs[g * 64 + lane] = bf2f(qn[(size_t)t * 512 + (hkv * 4 + g) * 64 + lane]);
    float ofin[4] = {0.f, 0.f, 0.f, 0.f};
    float gate[4][3];
#pragma unroll
    for (int g = 0; g < 4; ++g)
#pragma unroll
        for (int cidx = 0; cidx < 3; ++cidx) gate[g][cidx] = sigm(bf2f(proj[(size_t)t * NPROJ + PC_NG + (hkv * 4 + g) * 3 + cidx]));
    const int ncmp = tau >= 31 ? ((tau - 31) >> 4) + 1 : 0;
    {
        float l[4] = {0.f, 0.f, 0.f, 0.f}, o[4] = {0.f, 0.f, 0.f, 0.f};
        const size_t rbase = (size_t)(b * 2 + hkv) * 128;
#pragma unroll
        for (int blk = 0; blk < 2; ++blk) { const int n = blk * 64 + lane; const bool valid = n < ncmp; float s[4];
            nsa_scores(kc + (rbase + n) * 64, valid, qs, s);
#pragma unroll
            for (int g = 0; g < 4; ++g) { const float p = valid ? __expf(s[g]) : 0.f; l[g] += p; ps[g * 128 + n] = p; } }
        float inv[4];
#pragma unroll
        for (int g = 0; g < 4; ++g) { const float L = wave_sum(l[g]); inv[g] = L > 0.f ? 1.f / L : 0.f; }
#pragma unroll
        for (int blk = 0; blk < 2; ++blk) { const int n = blk * 64 + lane; psum[n] = (ps[0 * 128 + n] * inv[0] + ps[1 * 128 + n] * inv[1]) + (ps[2 * 128 + n] * inv[2] + ps[3 * 128 + n] * inv[3]); }
#pragma unroll 2
        for (int n = 0; n < ncmp; ++n) { const float vv = bf2f(vc[(rbase + n) * 64 + lane]);
#pragma unroll
            for (int g = 0; g < 4; ++g) o[g] = fmaf(ps[g * 128 + n], vv, o[g]); }
#pragma unroll
        for (int g = 0; g < 4; ++g) ofin[g] += gate[g][0] * o[g] * inv[g];
    }
    const int cur = tau >> 6;
    unsigned selmask = 0u;
    {
        float score = -3.0e38f;
        if (lane < 32) { const int j = lane; float imp = 0.f;
#pragma unroll
            for (int dn = -1; dn <= 3; ++dn) { const int n = 4 * j + dn; if (n >= 0 && n <= 126) imp += psum[n]; }
            const bool forced = (j == 0) || (j == cur) || (j == cur - 1);
            score = j > cur ? NEGF : imp + (forced ? 1.0e4f : 0.f); }
#pragma unroll 1
        for (int r = 0; r < 8; ++r) { const float mx = wave_max(score); const unsigned long long bal = __ballot(score == mx); const int win = __ffsll((long long)bal) - 1;
            selmask |= 1u << win; if (lane == win) score = -3.4e38f; }
    }
    {
        float l[4] = {0.f, 0.f, 0.f, 0.f}, o[4] = {0.f, 0.f, 0.f, 0.f};
#pragma unroll 1
        for (int j = 0; j <= cur; ++j) { if (!((selmask >> j) & 1u)) continue;
            const int kpos = 64 * j + lane; const bool valid = kpos <= tau; float s[4];
            nsa_scores(ksn + ((size_t)b * SEQ + kpos) * 128 + hkv * 64, valid, qs, s);
#pragma unroll
            for (int g = 0; g < 4; ++g) { const float p = valid ? __expf(s[g]) : 0.f; l[g] += p; ps[g * 128 + lane] = p; }
            const int nk = j == cur ? (tau & 63) + 1 : 64;
            const bf16* vb = proj + ((size_t)b * SEQ + 64 * j) * NPROJ + PC_NVS + hkv * 64 + lane;
#pragma unroll 2
            for (int k = 0; k < nk; ++k) { const float vv = bf2f(vb[(size_t)k * NPROJ]);
#pragma unroll
                for (int g = 0; g < 4; ++g) o[g] = fmaf(ps[g * 128 + k], vv, o[g]); } }
#pragma unroll
        for (int g = 0; g < 4; ++g) { const float L = wave_sum(l[g]); ofin[g] += gate[g][1] * o[g] * (L > 0.f ? 1.f / L : 0.f); }
    }
    {
        float l[4] = {0.f, 0.f, 0.f, 0.f}, o[4] = {0.f, 0.f, 0.f, 0.f};
        const int start = tau - 511 > 0 ? tau - 511 : 0;
#pragma unroll 1
        for (int base = start & ~63; base <= tau; base += 64) {
            const int kpos = base + lane; const bool valid = kpos >= start && kpos <= tau; float s[4];
            nsa_scores(kwn + ((size_t)b * SEQ + kpos) * 128 + hkv * 64, valid, qs, s);
#pragma unroll
            for (int g = 0; g < 4; ++g) { const float p = valid ? __expf(s[g]) : 0.f; l[g] += p; ps[g * 128 + lane] = p; }
            const int k0 = start > base ? start - base : 0, k1 = tau - base < 63 ? tau - base : 63;
            const bf16* vb = proj + ((size_t)b * SEQ + base) * NPROJ + PC_NVW + hkv * 64 + lane;
#pragma unroll 2
            for (int k = k0; k <= k1; ++k) { const float vv = bf2f(vb[(size_t)k * NPROJ]);
#pragma unroll
                for (int g = 0; g < 4; ++g) o[g] = fmaf(ps[g * 128 + k], vv, o[g]); } }
#pragma unroll
        for (int g = 0; g < 4; ++g) { const float L = wave_sum(l[g]); ofin[g] += gate[g][2] * o[g] * (L > 0.f ? 1.f / L : 0.f); }
    }
#pragma unroll
    for (int g = 0; g < 4; ++g) H1[(size_t)t * 512 + (hkv * 4 + g) * 64 + lane] = (bf16)f2bf(ofin[g]);
}
DI void mem_wave(Frame& F, int t, LAS float* wl) {
    unsigned char* ws = F.ws; const int lane = F.lane_id(); const int b = t >> 11;
    const bf16* mqn = (const bf16*)(ws + WS_MQN); const bf16* memkn = (const bf16*)(ws + WS_MEMKN); const bf16* memkv = (const bf16*)(ws + WS_MEMKV); bf16* H2 = (bf16*)(ws + WS_H2);
    LAS float* qs = wl;
    LAS float* ps = wl + 128;
#pragma unroll 1
    for (int h = 0; h < 4; ++h) {
        qs[lane] = bf2f(mqn[(size_t)t * 512 + h * 128 + lane]); qs[64 + lane] = bf2f(mqn[(size_t)t * 512 + h * 128 + 64 + lane]);
        float l = 0.f;
#pragma unroll 1
        for (int kq = 0; kq < 4; ++kq) { const int key = kq * 64 + lane; const bf16* kr = memkn + ((size_t)b * MEML + key) * 512 + h * 128; float s = 0.f;
#pragma unroll 2
            for (int c8 = 0; c8 < 16; ++c8) { const v4u kk = *(const v4u*)(kr + c8 * 8); const unsigned w[4] = {kk.x, kk.y, kk.z, kk.w};
#pragma unroll
                for (int j = 0; j < 4; ++j) s = fmaf(__uint_as_float(w[j] & 0xffff0000u), qs[c8 * 8 + 2 * j + 1], fmaf(__uint_as_float(w[j] << 16), qs[c8 * 8 + 2 * j], s)); }
            const float p = __expf(s); l += p; ps[key] = p; }
        const float inv = 1.f / wave_sum(l);
        float o0 = 0.f, o1 = 0.f;
        const bf16* vb = memkv + (size_t)b * MEML * 1024 + 512 + h * 128;
#pragma unroll 4
        for (int key = 0; key < MEML; ++key) { const float p = ps[key]; o0 = fmaf(p, bf2f(vb[(size_t)key * 1024 + lane]), o0); o1 = fmaf(p, bf2f(vb[(size_t)key * 1024 + 64 + lane]), o1); }
        H2[(size_t)t * 512 + h * 128 + lane] = (bf16)f2bf(o0 * inv); H2[(size_t)t * 512 + h * 128 + 64 + lane] = (bf16)f2bf(o1 * inv);
    }
}
DI void p5_mixers(Frame& F) {
    const int nml = F.G >= 128 ? 64 : 0;
#ifndef RPT_ML
#define RPT_ML 1
#endif
#ifndef RPT_NSA
#define RPT_NSA 1
#endif
#ifndef RPT_MEM
#define RPT_MEM 1
#endif
    if (F.bx < nml || nml == 0) { for (int rp = 0; rp < RPT_ML; ++rp) for (int u = F.bx; u < 64; u += (nml ? nml : F.G)) mlstm_unit2(F, u); }
    if (F.bx >= nml) {
        LAS float* wl = (LAS float*)(F.lds + F.wave * 4096);
        const int gw = (F.bx - nml) * NWAVES + F.wave, NGW = (F.G - nml) * NWAVES;
        for (int rp = 0; rp < RPT_NSA; ++rp) for (int u = F.bx - nml; u < 1024; u += F.G - nml) nsa_unit(F, u);
        __syncthreads();
        for (int rp = 0; rp < RPT_MEM; ++rp) for (int t = gw; t < MT; t += NGW) mem_wave(F, t, wl);
    }
}

DI void p8_router(Frame& F, int alt) {
    unsigned char* ws = F.ws + (size_t)alt * 3 * MiB; const int lane = F.lane_id(), tid = F.tid_id(), wave = F.wave, r = lane & 31, hh = lane >> 5;
    unsigned char* xn8 = (unsigned char*)(F.ws + WS_R1);
    int* tok_e = (int*)(ws + WS_ROUTE + RT_TOKE); int* tok_pos = (int*)(ws + WS_ROUTE + RT_TOKPOS); float* tok_w = (float*)(ws + WS_ROUTE + RT_TOKW);
    unsigned* gcnt = F.ctl + CW_ECNT + 64 * alt;
    const bf16* wrt = (const bf16*)(F.ws + WS_SMALL + SM_WRT);
    LAS unsigned char* img = F.lds;
    LAS float* part = (LAS float*)F.lds;
    LAS float* lg = (LAS float*)(F.lds + 4 * 64 * 33 * 4);
    LAS int* lcnt = (LAS int*)(F.lds + RING_BYTES + 1024);
    LAS int* lbase = lcnt + 32;
    LAS int* se = lbase + 32;
    LAS int* sp = se + 256;
    LAS float* sw = (LAS float*)(sp + 256);
    const float* gf = F.in[I_GFFN];
    for (int bt = F.bx; bt < MT / 64; bt += F.G) {
        __syncthreads();
        if (tid < 32) lcnt[tid] = 0;
        const f32x4* gr = (const f32x4*)gf + 4 * lane; const f32x4 g0 = gr[0], g1 = gr[1], g2 = gr[2], g3 = gr[3];
#pragma unroll 1
        for (int i0 = 0; i0 < 8; i0 += 4) {
            f32x4 v[4][4];
#pragma unroll
            for (int u = 0; u < 4; ++u) { const int t = bt * 64 + wave * 8 + i0 + u; const f32x4* xr = (const f32x4*)(F.out + (size_t)t * DM) + 4 * lane;
#pragma unroll
                for (int j = 0; j < 4; ++j) v[u][j] = xr[j]; }
#pragma unroll
            for (int u = 0; u < 4; ++u) { const int tl = wave * 8 + i0 + u, t = bt * 64 + tl; float sq = 0.f;
#pragma unroll
                for (int j = 0; j < 4; ++j) sq += (v[u][j].x * v[u][j].x + v[u][j].y * v[u][j].y) + (v[u][j].z * v[u][j].z + v[u][j].w * v[u][j].w);
                const float rstd = rsqrtf(wave_sum(sq) * (1.f / DM) + EPS);
                const f32x4 gg[4] = {g0, g1, g2, g3}; unsigned q[4]; unsigned bw[8];
#pragma unroll
                for (int j = 0; j < 4; ++j) { const float y0 = v[u][j].x * rstd * gg[j].x, y1 = v[u][j].y * rstd * gg[j].y, y2 = v[u][j].z * rstd * gg[j].z, y3 = v[u][j].w * rstd * gg[j].w;
                    bw[2 * j] = pk2(y0, y1); bw[2 * j + 1] = pk2(y2, y3);
                    int q8 = 0; q8 = __builtin_amdgcn_cvt_pk_fp8_f32(y0, y1, q8, false); q8 = __builtin_amdgcn_cvt_pk_fp8_f32(y2, y3, q8, true); q[j] = (unsigned)q8; }
                *((v4u*)(xn8 + (size_t)t * DM) + lane) = (v4u){q[0], q[1], q[2], q[3]};
                *(LAS v4u*)(img + tl * 2048 + 16 * ((2 * lane) ^ (tl & 15))) = (v4u){bw[0], bw[1], bw[2], bw[3]};
                *(LAS v4u*)(img + tl * 2048 + 16 * ((2 * lane + 1) ^ (tl & 15))) = (v4u){bw[4], bw[5], bw[6], bw[7]}; }
        }
        __syncthreads();
        {
            const int mb = wave & 1, kq = wave >> 1, trow = 32 * mb + r;
            f32x16 acc;
#pragma unroll
            for (int i = 0; i < 16; ++i) acc[i] = 0.f;
#pragma unroll 4
            for (int s2 = 0; s2 < 16; ++s2) { const int st = 16 * kq + s2;
                const bf16x8 xa = *(const LAS bf16x8*)(img + trow * 2048 + 16 * ((2 * st + hh) ^ (trow & 15)));
                const bf16x8 wh = *(const bf16x8*)(wrt + (size_t)r * 1024 + 16 * st + 8 * hh), wl = *(const bf16x8*)(wrt + 32 * 1024 + (size_t)r * 1024 + 16 * st + 8 * hh);
                acc = MFMA32(xa, wh, acc); acc = MFMA32(xa, wl, acc); }
            __syncthreads();
#pragma unroll
            for (int i = 0; i < 16; ++i) part[(kq * 64 + 32 * mb + crow(i, hh)) * 33 + r] = acc[i];
        }
        __syncthreads();
        for (int i = tid; i < 64 * 32; i += 512) { const int tk = i >> 5, e = i & 31; lg[tk * 33 + e] = ((part[(0 * 64 + tk) * 33 + e] + part[(1 * 64 + tk) * 33 + e]) + (part[(2 * 64 + tk) * 33 + e] + part[(3 * 64 + tk) * 33 + e])) + F.in[I_BR][e]; }
        __syncthreads();
        if (wave == 0) {
            const int tl = lane; float v[32];
#pragma unroll
            for (int e = 0; e < 32; ++e) v[e] = lg[tl * 33 + e];
            unsigned taken = 0u; int ek[4]; float vk[4];
#pragma unroll
            for (int rd = 0; rd < 4; ++rd) { float best = -3.4e38f; int bi = 0;
#pragma unroll
                for (int e = 0; e < 32; ++e) { const float x = ((taken >> e) & 1u) ? -3.4e38f : v[e]; if (x > best) { best = x; bi = e; } }
                taken |= 1u << bi; ek[rd] = bi; vk[rd] = best; }
            const float e1 = __expf(vk[1] - vk[0]), e2 = __expf(vk[2] - vk[0]), e3 = __expf(vk[3] - vk[0]); const float inv = 1.f / (1.f + e1 + e2 + e3);
            const float wk[4] = {inv, e1 * inv, e2 * inv, e3 * inv};
#pragma unroll
            for (int rd = 0; rd < 4; ++rd) { se[tl * 4 + rd] = ek[rd]; sw[tl * 4 + rd] = wk[rd]; sp[tl * 4 + rd] = atomicAdd((int*)&lcnt[ek[rd]], 1); }
        }
        __syncthreads();
        if (tid < 32) lbase[tid] = (int)atomicAdd(&gcnt[tid], (unsigned)lcnt[tid]);
        __syncthreads();
        if (tid < 256) { const int t = bt * 64 + (tid >> 2), k = tid & 3; const int e = se[tid];
          tok_e[t * 4 + k] = e; tok_pos[t * 4 + k] = lbase[e] + sp[tid]; tok_w[t * 4 + k] = sw[tid]; }
    }
    __syncthreads();
}
DI int moe_tables(Frame& F, LAS int* pstart, LAS unsigned char* blk_e) {
    unsigned* gcnt = F.ctl + CW_ECNT;
    __syncthreads();
    if (F.wave == 0) {
        const int l = F.lane_id(); int pad = 0;
        if (l < NEXP) { const int cnt = (int)__hip_atomic_load(&gcnt[l], __ATOMIC_RELAXED, __HIP_MEMORY_SCOPE_AGENT); pad = (cnt + MOEB - 1) / MOEB * MOEB; }
        int inc = pad;
#pragma unroll
        for (int o = 1; o < 32; o <<= 1) { const int v = __shfl_up(inc, o); if (l >= o) inc += v; }
        if (l < NEXP) pstart[l] = inc - pad;
        if (l == NEXP - 1) pstart[NEXP] = inc;
    }
    __syncthreads();
    const int nblk = pstart[NEXP] / MOEB;
    for (int rb = F.tid_id(); rb < nblk; rb += 512) { int e = 0; while (e < NEXP - 1 && pstart[e + 1] <= rb * MOEB) ++e; blk_e[rb] = (unsigned char)e; }
    __syncthreads();
    return nblk;
}
DI void p9_scatter(Frame& F) {
    unsigned char* ws = F.ws; const int lane = F.lane_id();
    LAS int* pstart = (LAS int*)(F.lds + 65536); LAS unsigned char* blk_e = (LAS unsigned char*)(F.lds + 65536 + 256);
    moe_tables(F, pstart, blk_e);
    const int* tok_e = (const int*)(ws + WS_ROUTE + RT_TOKE); const int* tok_pos = (const int*)(ws + WS_ROUTE + RT_TOKPOS); const float* tok_w = (const float*)(ws + WS_ROUTE + RT_TOKW);
    int* tok_dest = (int*)(ws + WS_ROUTE + RT_TOKDEST); float* roww = (float*)(ws + WS_ROUTE + RT_ROWW); int* rowtok = (int*)(ws + WS_ROUTE + RT_ROWTOK);
    unsigned* gcnt = F.ctl + CW_ECNT;
    for (int it = F.bx * 512 + F.tid_id(); it < NROWS; it += F.G * 512) {
        const int dest = pstart[tok_e[it]] + tok_pos[it];
        tok_dest[it] = dest; roww[dest] = tok_w[it]; rowtok[dest] = it >> 2; }
    for (int it = F.bx * 512 + F.tid_id(); it < NEXP * MOEB; it += F.G * 512) { const int e = it >> 8, i = it & 255; const int cnt = (int)__hip_atomic_load(&gcnt[e], __ATOMIC_RELAXED, __HIP_MEMORY_SCOPE_AGENT); const int padded = (cnt + MOEB - 1) / MOEB * MOEB;
        if (i < padded - cnt) { const int dest = pstart[e] + cnt + i; roww[dest] = 0.f; rowtok[dest] = 0; } }
    (void)lane;
}
DI void p12_combine(Frame& F) {
    unsigned char* ws = F.ws; const int lane = F.lane_id();
    const unsigned char* ybuf = (const unsigned char*)(ws + WS_APERM); const int* tok_dest = (const int*)(ws + WS_ROUTE + RT_TOKDEST);
    const int gw = F.bx * NWAVES + F.wave, NGW = F.G * NWAVES;
    typedef float f32x2t __attribute__((ext_vector_type(2)));
    for (int t2 = gw; t2 < MT / 2; t2 += NGW) {
        typedef int i32x4 __attribute__((ext_vector_type(4)));
        v4u w[2][4]; f32x4 a[2][4];
#pragma unroll
        for (int q = 0; q < 2; ++q) { const int t = 2 * t2 + q; const f32x4* orow = (const f32x4*)(F.out + (size_t)t * DM) + 4 * lane;
            const i32x4 d = *(const i32x4*)(tok_dest + t * 4); const int dd[4] = {d.x, d.y, d.z, d.w};
#pragma unroll
            for (int k = 0; k < 4; ++k) w[q][k] = *((const v4u*)(ybuf + (size_t)dd[k] * DM) + lane);
#pragma unroll
            for (int j = 0; j < 4; ++j) a[q][j] = orow[j]; }
#pragma unroll
        for (int q = 0; q < 2; ++q) { f32x4* orow = (f32x4*)(F.out + (size_t)(2 * t2 + q) * DM) + 4 * lane;
#pragma unroll
            for (int j = 0; j < 4; ++j) { f32x4 sacc = {0.f, 0.f, 0.f, 0.f};
#pragma unroll
                for (int k = 0; k < 4; ++k) { const unsigned ww = j == 0 ? w[q][k].x : j == 1 ? w[q][k].y : j == 2 ? w[q][k].z : w[q][k].w;
                    const f32x2t lo = __builtin_amdgcn_cvt_pk_f32_fp8((int)ww, false), hi = __builtin_amdgcn_cvt_pk_f32_fp8((int)ww, true);
                    sacc.x += lo.x; sacc.y += lo.y; sacc.z += hi.x; sacc.w += hi.y; }
                orow[j] = a[q][j] + sacc * 0.125f; } }
    }
}

constexpr int N_PHASES = 13;
#ifndef MK_PER_PHASE
#define MK_PER_PHASE 0
#endif
__global__ void __launch_bounds__(NWAVES * 64, 2) fwd_kernel(Args args) {
    extern __shared__ __attribute__((aligned(16))) unsigned char lds_raw[];
    Frame F;
    F.lds = (LAS unsigned char*)lds_raw; F.MISC = (volatile LAS unsigned*)(F.lds + MISC_OFF);
    F.wave = __builtin_amdgcn_readfirstlane((int)(threadIdx.x >> 6)); F.G = gridDim.x; F.bx = blockIdx.x;
    F.ws = args.ws; F.ctl = (unsigned*)(args.ws + WS_CTL); F.in = args.in; F.out = args.out;
    unsigned char* ws = args.ws;
    for (int u = threadIdx.x; u < (LDS_BYTES - LDSCTL_OFF) / 4; u += NWAVES * 64) ((LAS unsigned*)(F.lds + LDSCTL_OFF))[u] = 0u;
    __syncthreads();
    const int lo = args.ph_lo, hi = args.ph_hi;
    XcdBarrier bar; bar.wv = F.wave; bar.bar = F.ctl + CW_BAR; bar.x = 0; bar.st = nullptr;
    if (hi - lo > 1) bar = xcd_barrier_post(F.ctl + CW_BAR, F.MISC + 8, F.wave);
#ifndef PH_MASK
#define PH_MASK 0x1fff
#endif
#define IN(k) (((PH_MASK >> (k)) & 1) && lo <= (k) && (k) < hi)
#define SEAM(k) do { if (IN(k) && IN((k) + 1)) xcd_barrier(bar); } while (0)
    typedef pg8::bf16_t b16;
#ifndef RPT_MASK
#define RPT_MASK 0
#endif
#define RPT(k) _Pragma("unroll") for (int rp_ = 0; rp_ < 1 + ((RPT_MASK >> (k)) & 1); ++rp_)
#ifndef P0PARTS
#define P0PARTS 0xf
#endif
    if (IN(0)) { p0_prologue<0xf>(F); if (RPT_MASK & 1) p0_prologue<P0PARTS>(F); } SEAM(0);
    if (IN(1)) RPT(1) {
        { pg8::Gemm8 g{(const unsigned char*)(ws + WS_U8), (const unsigned char*)(ws + WS_WIN8), MT, NF8, DM, 0x7f7f7f7f, 0x77777777}; pg8::StaticOrder S; S.init(MT, NF8, F.G, F.bx);
          pg8::EpiBf16Silu E{(b16*)(ws + WS_PROJ) + NB16, NPROJ, nullptr, 0};
          pg8::gemm_phase_f8<pg8::EpiBf16Silu, pg8::StaticOrder, true, true>(F.lds, g, S, E, F.wave); }
        { pg8::Gemm g{(const b16*)(ws + WS_R1), (const b16*)(ws + WS_WIN), MT, NB16, DM}; pg8::StaticOrder S; S.init(MT, NB16, F.G, F.bx);
          pg8::EpiBf16Silu E{(b16*)(ws + WS_PROJ), NPROJ, nullptr, 0};
          pg8::gemm_phase<pg8::EpiBf16Silu, pg8::StaticOrder, true, true>(F.lds, g, S, E, F.wave); }
        { pg8::Gemm g{(const b16*)(ws + WS_MEMN), (const b16*)(ws + WS_WMKV), MROWS, 1024, DM}; pg8::StaticOrder S; S.init(MROWS, 1024, F.G, (F.bx + 64) % F.G);
          pg8::EpiBf16Silu E{(b16*)(ws + WS_MEMKV), 1024, nullptr, 0};
          pg8::gemm_phase<pg8::EpiBf16Silu, pg8::StaticOrder, true, true>(F.lds, g, S, E, F.wave); }
    } SEAM(1);
    if (IN(2)) { RPT(2) { p2_compress(F); p2_prep(F); } }
    if (IN(2) && IN(5)) xcd_barrier(bar);
#ifndef RPT5_ML
#define RPT5_ML 0
#endif
#ifndef MLPROBE
#define MLPROBE 0xff
#endif
#ifndef NPROBE_ST
#define NPROBE_ST true
#endif
#ifndef NPROBE_CMP
#define NPROBE_CMP true
#endif
#ifndef NPROBE_SEL
#define NPROBE_SEL true
#endif
#ifndef NPROBE_WIN
#define NPROBE_WIN true
#endif
#ifndef MPROBE_ST
#define MPROBE_ST true
#endif
#ifndef MPROBE_DMA
#define MPROBE_DMA true
#endif
#ifndef MPROBE_COMP
#define MPROBE_COMP true
#endif
#ifndef RPT5_NSA
#define RPT5_NSA 0
#endif
#ifndef RPT5_MEM
#define RPT5_MEM 0
#endif
    if (IN(5)) { p5_queue<true, true, true>(F, 0);
        if (RPT5_ML || RPT5_NSA || RPT5_MEM) { xcd_barrier(bar); p5_queue<RPT5_ML != 0, RPT5_NSA != 0, RPT5_MEM != 0, MPROBE_ST, MPROBE_DMA, MPROBE_COMP, NPROBE_ST, NPROBE_CMP, NPROBE_SEL, NPROBE_WIN, MLPROBE>(F, 256); } } SEAM(5);
    if (IN(6)) RPT(6) {
        pg8::StaticOrder S; S.init(MT, DM, F.G, F.bx);
        pg8::Gemm g{(const b16*)(ws + WS_H0), (const b16*)(ws + WS_WBR), MT, DM, 1536};
        pg8::EpiMergeK E{(const b16*)(ws + WS_PROJ), (b16*)(ws + WS_R1)};
        pg8::gemm_phase<pg8::EpiMergeK, pg8::StaticOrder, true, true>(F.lds, g, S, E, F.wave);
    } SEAM(6);
    if (IN(7)) RPT(7) {
        pg8::Gemm g{(const b16*)(ws + WS_R1), (const b16*)(ws + WS_WOUT), MT, DM, DM}; pg8::StaticOrder S; S.init(MT, DM, F.G, F.bx);
        pg8::EpiRes E{F.in[I_X], F.out};
        pg8::gemm_phase<pg8::EpiRes, pg8::StaticOrder, true, true>(F.lds, g, S, E, F.wave);
    } SEAM(7);
    if (IN(8)) { p8_router(F, 0); if ((RPT_MASK >> 8) & 1) p8_router(F, 1); } SEAM(8);
    if (IN(9)) { RPT(9) p9_scatter(F); } SEAM(9);
    if (IN(10)) RPT(10) {
        LAS int* pstart = (LAS int*)(F.lds + RING_BYTES + 1024); LAS unsigned char* blk_e = (LAS unsigned char*)(F.lds + RING_BYTES + 1024 + 256);
        const int nblk = moe_tables(F, pstart, blk_e);
        pg8::Gemm8G g{(const unsigned char*)(ws + WS_R1), (const unsigned char*)(ws + WS_WGU), (const int*)(ws + WS_ROUTE + RT_ROWTOK), DM, 0x7f7f7f7f, 0x77777777};
        pg8::MoeOrder<8> S{nblk, F.G, F.bx, (const PG8_LAS unsigned char*)blk_e};
        pg8::EpiSwiglu E{(unsigned char*)(ws + WS_ACT), F.in[I_BGU]};
        pg8::gemm_phase_f8g<pg8::EpiSwiglu, pg8::MoeOrder<8>, true, true>(F.lds, g, S, E, F.wave);
    } SEAM(10);
    if (IN(11)) RPT(11) {
        LAS int* pstart = (LAS int*)(F.lds + RING_BYTES + 1024); LAS unsigned char* blk_e = (LAS unsigned char*)(F.lds + RING_BYTES + 1024 + 256);
        const int nblk = moe_tables(F, pstart, blk_e);
        pg8::Gemm8 g{(const unsigned char*)(ws + WS_ACT), (const unsigned char*)(ws + WS_WDN), CAP, NEXP * DM, DFF, 0x7f7f7f7f, 0x77777777};
        pg8::MoeOrder<4> S{nblk, F.G, F.bx, (const PG8_LAS unsigned char*)blk_e};
        pg8::EpiDown E{(unsigned char*)(ws + WS_APERM), F.in[I_BDN], (const float*)(ws + WS_ROUTE + RT_ROWW)};
        pg8::gemm_phase_f8<pg8::EpiDown, pg8::MoeOrder<4>, true, true>(F.lds, g, S, E, F.wave);
    } SEAM(11);
    if (IN(12)) { p12_combine(F); }
#undef IN
#undef SEAM
}

extern "C" void kernel_launch(void* const* d_in, const int* in_sizes, int n_in, void* d_out, int out_size, void* d_ws, size_t ws_size, hipStream_t stream) {
    static int grid = 0;
    if (grid == 0) {
        if (n_in != N_IN || out_size != MT * DM || ws_size < WS_END) { fprintf(stderr, "kernel_launch: unexpected shapes (n_in %d, out %d, ws %zu need %zu)\n", n_in, out_size, ws_size, (size_t)WS_END); grid = -1; return; }
        int dev = 0, cus = 0, per_cu = 0;
        if (hipGetDevice(&dev) != hipSuccess || hipDeviceGetAttribute(&cus, hipDeviceAttributeMultiprocessorCount, dev) != hipSuccess) { grid = -1; return; }
        if (hipFuncSetAttribute((const void*)fwd_kernel, hipFuncAttributeMaxDynamicSharedMemorySize, LDS_BYTES) != hipSuccess) { fprintf(stderr, "kernel_launch: hipFuncSetAttribute failed\n"); grid = -1; return; }
        if (hipOccupancyMaxActiveBlocksPerMultiprocessor(&per_cu, (const void*)fwd_kernel, NWAVES * 64, LDS_BYTES) != hipSuccess || per_cu < 1) { fprintf(stderr, "kernel_launch: occupancy query says %d\n", per_cu); }
        (void)hipGetLastError();
        grid = cus;
    }
    if (grid < 0) return;
    if (hipMemsetAsync((char*)d_ws + WS_CTL, 0, CTL_ZERO_BYTES, stream) != hipSuccess) return;
    Args a{};
    for (int i = 0; i < N_IN; ++i) a.in[i] = (const float*)d_in[i];
    a.out = (float*)d_out; a.ws = (unsigned char*)d_ws;
#if MK_PER_PHASE
    for (int p = 0; p < N_PHASES; ++p) { a.ph_lo = p; a.ph_hi = p + 1; a.li = 0; hipLaunchKernelGGL(fwd_kernel, dim3(grid), dim3(NWAVES * 64), LDS_BYTES, stream, a); }
#else
    a.ph_lo = 0; a.ph_hi = N_PHASES; a.li = 0;
    hipLaunchKernelGGL(fwd_kernel, dim3(grid), dim3(NWAVES * 64), LDS_BYTES, stream, a);
#endif
}
```
